# Optimizing an MI355X kernel written in HIP

```python
import math
import jax, jax.numpy as jnp
from jax import lax
import numpy as np

D_MODEL = 1024
BATCH = 4
SEQ = 4096
DEPTH = 2

GRID_W = 64
P_DIM = 256
EPS = 1e-6

A_HEADS = 4
A_DK = 128
A_DV = 128
A_KDIM = A_HEADS * A_DK
A_WIDTH = A_HEADS * A_DV
A_CHUNK = 64

B_HEADS = 8
B_HEADDIM = 64
B_WIDTH = B_HEADS * B_HEADDIM
B_GROUPS = 2
B_STATE = 128
B_CONV = 5
B_CONV_DIM = B_WIDTH + 2 * B_GROUPS * B_STATE
B_CHUNK = 128

C_HEADS = 16
C_HEADDIM = 64
C_WIDTH = C_HEADS * C_HEADDIM
NA_ROWS = 8
NA_COLS = 16
NA_COL_BLOCK = 16
NA_KEY_COLS = 32

D_FF = 2816
N_EXPERTS = 8
TOP_K = 2
D_FF_EXPERT = 3584

N_EVEN = (DEPTH + 1) // 2
N_ODD = DEPTH // 2
EVEN_SPLITS = (A_KDIM, A_KDIM, A_KDIM, A_WIDTH, A_WIDTH, B_WIDTH, B_CONV_DIM, B_HEADS, B_HEADS)
EVEN_IN = sum(EVEN_SPLITS)

kernel_name = 'hybrid_hgrn2_ssd_natten_moe_encoder'


def _split(u, sizes):
    idx = np.cumsum(np.array(sizes))[:-1].tolist()
    return jnp.split(u, idx, axis=-1)


def rmsnorm(x, g):
    xf = x.astype(jnp.float32)
    y = xf * lax.rsqrt(jnp.mean(xf * xf, axis=-1, keepdims=True) + EPS)
    return (y * g.astype(jnp.float32)).astype(x.dtype)


def segsum(a):
    T = a.shape[-1]
    cs = jnp.cumsum(a, axis=-1)
    diff = cs[..., :, None] - cs[..., None, :]
    mask = jnp.tril(jnp.ones((T, T), dtype=bool))
    return jnp.where(mask, diff, -jnp.inf)


def gla_chunk_scan(q, k, v, logf):
    Bsz, H, S, dk = q.shape
    dv = v.shape[-1]
    C = A_CHUNK
    nc = S // C
    chunks = lambda t: t.reshape(Bsz, H, nc, C, t.shape[-1]).transpose(2, 0, 1, 3, 4)
    causal = jnp.tril(jnp.ones((C, C), dtype=bool))[:, :, None]

    def step(state, inp):
        qi, ki, vi, gi = inp
        b = jnp.cumsum(gi, axis=2)
        diff = b[:, :, :, None, :] - b[:, :, None, :, :]
        decay = jnp.where(causal, jnp.exp(jnp.where(causal, diff, 0.0)), 0.0)
        attn = jnp.einsum('bhtk,bhtsk,bhsk->bhts', qi, decay, ki)
        o = jnp.einsum('bhts,bhsv->bhtv', attn, vi) + jnp.einsum('bhtk,bhkv->bhtv', qi * jnp.exp(b), state)
        b_last = b[:, :, -1:, :]
        new_state = state * jnp.exp(b_last[:, :, 0, :, None]) + jnp.einsum('bhsk,bhsv->bhkv', ki * jnp.exp(b_last - b), vi)
        return new_state, o

    state0 = jnp.zeros((Bsz, H, dk, dv), jnp.float32)
    _, out = lax.scan(step, state0, (chunks(q), chunks(k), chunks(v), chunks(logf)))
    return out.transpose(1, 2, 0, 3, 4).reshape(Bsz, H, S, dv)


def hgrn2_mixer(q_raw, ff_raw, fb_raw, i_raw, g_raw, lb, norm_g):
    Bsz, S, _ = q_raw.shape
    f32 = jnp.float32
    heads = lambda t, d: t.reshape(Bsz, S, A_HEADS, d).transpose(0, 2, 1, 3).astype(f32)
    q = heads(jax.nn.silu(q_raw), A_DK)
    v = heads(i_raw, A_DV)
    lbh = lb.reshape(A_HEADS, A_DK)[None, :, None, :]

    def gates(f_raw):
        f = lbh + (1.0 - lbh) * jax.nn.sigmoid(heads(f_raw, A_DK))
        return 1.0 - f, jnp.log(f)

    k_f, lf_f = gates(ff_raw)
    k_b, lf_b = gates(fb_raw)
    flip = lambda t: jnp.flip(t, axis=2)
    o = gla_chunk_scan(q, k_f, v, lf_f) + flip(gla_chunk_scan(flip(q), flip(k_b), flip(v), flip(lf_b)))
    o = o.transpose(0, 2, 1, 3).astype(q_raw.dtype)
    o = rmsnorm(o, norm_g) * jax.nn.silu(g_raw.reshape(Bsz, S, A_HEADS, A_DV))
    return o.reshape(Bsz, S, A_WIDTH)


def ssd_chunked(xs, dt, a_coef, Bm, Cm):
    Bsz, S, H, P = xs.shape
    G, N = Bm.shape[-2:]
    R = H // G
    Q = B_CHUNK
    nc = S // Q
    f32 = jnp.float32
    xc = (xs.astype(f32) * dt[..., None]).reshape(Bsz, nc, Q, G, R, P)
    Bc = Bm.astype(f32).reshape(Bsz, nc, Q, G, N)
    Cc = Cm.astype(f32).reshape(Bsz, nc, Q, G, N)
    a = (dt * a_coef).reshape(Bsz, nc, Q, G, R).transpose(0, 3, 4, 1, 2)
    a_cs = jnp.cumsum(a, axis=-1)
    L = jnp.exp(segsum(a))
    scores = jnp.einsum('bctgn,bcsgn->bgcts', Cc, Bc)
    y_diag = jnp.einsum('bgcts,bgrcts,bcsgrp->bctgrp', scores, L, xc)
    decay_states = jnp.exp(a_cs[..., -1:] - a_cs)
    states = jnp.einsum('bcsgn,bgrcs,bcsgrp->bcgrpn', Bc, decay_states, xc)
    chunk_a = jnp.pad(a_cs[..., -1], [(0, 0), (0, 0), (0, 0), (1, 0)])
    decay_chunk = jnp.exp(segsum(chunk_a))
    states = jnp.concatenate([jnp.zeros_like(states[:, :1]), states], axis=1)
    states = jnp.einsum('bgrzc,bcgrpn->bzgrpn', decay_chunk, states)[:, :-1]
    y_off = jnp.einsum('bctgn,bcgrpn,bgrct->bctgrp', Cc, states, jnp.exp(a_cs))
    return (y_diag + y_off).reshape(Bsz, S, H, P)


def mamba2_mixer(z, xBC, dt_f_raw, dt_b_raw, conv_w, conv_b, A_log, dt_bias, D_skip, norm_g):
    Bsz, S, Cdim = xBC.shape
    f32 = jnp.float32
    xBC = lax.conv_general_dilated(xBC, conv_w[:, None, :], window_strides=(1,),
                                   padding=[(B_CONV // 2, B_CONV // 2)],
                                   dimension_numbers=('NWC', 'WIO', 'NWC'),
                                   feature_group_count=Cdim)
    xBC = jax.nn.silu(xBC + conv_b)
    xs, Bm, Cm = _split(xBC, (B_WIDTH, B_GROUPS * B_STATE, B_GROUPS * B_STATE))
    xs = xs.reshape(Bsz, S, B_HEADS, B_HEADDIM)
    Bm = Bm.reshape(Bsz, S, B_GROUPS, B_STATE)
    Cm = Cm.reshape(Bsz, S, B_GROUPS, B_STATE)
    A = -jnp.exp(A_log.astype(f32))
    dtb = dt_bias.astype(f32)
    dt_f = jax.nn.softplus(dt_f_raw.astype(f32) + dtb[0])
    dt_b = jax.nn.softplus(dt_b_raw.astype(f32) + dtb[1])
    flip = lambda t: jnp.flip(t, axis=1)
    y = (ssd_chunked(xs, dt_f, A[0], Bm, Cm)
         + flip(ssd_chunked(flip(xs), flip(dt_b), A[1], flip(Bm), flip(Cm)))
         + D_skip.astype(f32)[:, None] * xs.astype(f32))
    y = y.reshape(Bsz, S, B_WIDTH).astype(z.dtype) * jax.nn.silu(z)
    y = rmsnorm(y.reshape(Bsz, S, B_GROUPS, B_WIDTH // B_GROUPS), norm_g.reshape(B_GROUPS, B_WIDTH // B_GROUPS))
    return y.reshape(Bsz, S, B_WIDTH)


def _na_column_tables():
    n_cb = GRID_W // NA_COL_BLOCK
    j = np.arange(n_cb)
    blk_start = np.clip(j * NA_COL_BLOCK - NA_COLS // 2, 0, GRID_W - NA_KEY_COLS)
    col_idx = blk_start[:, None] + np.arange(NA_KEY_COLS)[None, :]
    qcol = j[:, None] * NA_COL_BLOCK + np.arange(NA_COL_BLOCK)[None, :]
    qs = np.clip(qcol - NA_COLS // 2, 0, GRID_W - NA_COLS)
    kc = col_idx[:, None, :]
    valid = (kc >= qs[:, :, None]) & (kc < qs[:, :, None] + NA_COLS)
    dc_idx = np.clip(kc - qcol[:, :, None] + (NA_COLS - 1), 0, 2 * NA_COLS - 2)
    return col_idx.astype(np.int32), valid, dc_idx.astype(np.int32)


def neighborhood_attention(q, k, v, rpb):
    Bsz, S, H, dh = q.shape
    rows = S // GRID_W
    kh = min(NA_ROWS, rows)
    n_cb = GRID_W // NA_COL_BLOCK
    col_idx, valid, dc_idx = _na_column_tables()
    valid = jnp.asarray(valid)[:, :, None, :]
    grid = lambda t: t.reshape(Bsz, rows, GRID_W, H, dh).transpose(1, 0, 3, 2, 4)
    qg, kg, vg = grid(q), grid(k), grid(v)
    scale = C_HEADDIM ** -0.5

    def row_block(args):
        r, q_row = args
        qb = q_row.reshape(Bsz, H, n_cb, NA_COL_BLOCK, dh)
        rs = jnp.clip(r - kh // 2, 0, rows - kh)
        kr = lax.dynamic_slice_in_dim(kg, rs, kh, axis=0)[:, :, :, col_idx, :]
        vr = lax.dynamic_slice_in_dim(vg, rs, kh, axis=0)[:, :, :, col_idx, :]
        s = jnp.einsum('bhjqd,rbhjkd->bhjqrk', qb, kr).astype(jnp.float32) * scale
        dr = rs + jnp.arange(kh) - r + (NA_ROWS - 1)
        bias = rpb[:, dr][:, :, dc_idx].transpose(0, 2, 3, 1, 4)
        s = jnp.where(valid, s + bias.astype(jnp.float32)[None], -jnp.inf)
        pr = jax.nn.softmax(s.reshape(Bsz, H, n_cb, NA_COL_BLOCK, kh * NA_KEY_COLS), axis=-1)
        pr = pr.reshape(s.shape).astype(v.dtype)
        o = jnp.einsum('bhjqrk,rbhjkd->bhjqd', pr, vr)
        return o.reshape(Bsz, H, GRID_W, dh)

    out = lax.map(row_block, (jnp.arange(rows), qg))
    return out.transpose(1, 0, 3, 2, 4).reshape(Bsz, S, H * dh)


def swiglu(h, w_gate, w_up, w_down):
    return (jax.nn.silu(h @ w_gate) * (h @ w_up)) @ w_down


def moe_swiglu(h, w_router, w_gate, w_up, w_down):
    logits = (h @ w_router).astype(jnp.float32)
    top_val, top_idx = lax.top_k(logits, TOP_K)
    wts = jax.nn.softmax(top_val, axis=-1)
    gates = jnp.sum(jax.nn.one_hot(top_idx, N_EXPERTS, dtype=jnp.float32) * wts[..., None], axis=-2)
    gates = gates.astype(h.dtype)
    out = jnp.zeros_like(h)
    for e in range(N_EXPERTS):
        out = out + gates[..., e:e + 1] * swiglu(h, w_gate[e], w_up[e], w_down[e])
    return out


def setup_inputs(seed: int = 0) -> dict:
    key = jax.random.key(seed)
    keys = iter(jax.random.split(key, 64))
    nk = lambda: next(keys)
    f32 = jnp.float32

    def w(shape, fan_in):
        return jax.random.normal(nk(), shape, f32) * fan_in ** -0.5

    def gain(shape):
        return 1.0 + 0.05 * jax.random.normal(nk(), shape, f32)

    def small(shape, s=0.02):
        return s * jax.random.normal(nk(), shape, f32)

    NE, NO, D = N_EVEN, N_ODD, D_MODEL
    x = jax.random.normal(nk(), (BATCH, SEQ, D), f32)
    p = jax.random.normal(nk(), (DEPTH, BATCH, SEQ, P_DIM), f32)
    hgrn_lb_raw = 0.5 * jax.random.normal(nk(), (DEPTH + 1, A_KDIM), f32)
    dt0 = jnp.exp(jax.random.uniform(nk(), (NE, 2, B_HEADS), f32, math.log(1e-3), math.log(1e-1)))
    return {
        'x': x,
        'p': p,
        'hgrn_lb_raw': hgrn_lb_raw,
        'e_norm_mix_pre': gain((NE, D)),
        'e_w_in': w((NE, D, EVEN_IN), D),
        'e_conv_w': w((NE, B_CONV, B_CONV_DIM), B_CONV),
        'e_conv_b': small((NE, B_CONV_DIM)),
        'e_A_log': jnp.log(jax.random.uniform(nk(), (NE, 2, B_HEADS), f32, 1.0, 16.0)),
        'e_dt_bias': dt0 + jnp.log(-jnp.expm1(-dt0)),
        'e_D': gain((NE, B_HEADS)),
        'e_a_norm': gain((NE, A_DV)),
        'e_b_norm': gain((NE, B_WIDTH)),
        'e_w_out': w((NE, A_WIDTH + B_WIDTH, D), A_WIDTH + B_WIDTH),
        'e_norm_mix_post': gain((NE, D)),
        'e_norm_ffn_pre': gain((NE, D)),
        'e_w_ffn_gate': w((NE, D, D_FF), D),
        'e_w_ffn_up': w((NE, D, D_FF), D),
        'e_w_ffn_down': w((NE, D_FF, D), D_FF),
        'e_norm_ffn_post': gain((NE, D)),
        'o_norm_mix_pre': gain((NO, D)),
        'o_w_qkv': w((NO, D, 3 * C_WIDTH), D),
        'o_rpb': small((NO, C_HEADS, 2 * NA_ROWS - 1, 2 * NA_COLS - 1), 0.5),
        'o_w_out': w((NO, C_WIDTH, D), C_WIDTH),
        'o_norm_mix_post': gain((NO, D)),
        'o_norm_ffn_pre': gain((NO, D)),
        'o_w_router': w((NO, D, N_EXPERTS), D),
        'o_w_exp_gate': w((NO, N_EXPERTS, D, D_FF_EXPERT), D),
        'o_w_exp_up': w((NO, N_EXPERTS, D, D_FF_EXPERT), D),
        'o_w_exp_down': w((NO, N_EXPERTS, D_FF_EXPERT, D), D_FF_EXPERT),
        'o_norm_ffn_post': gain((NO, D)),
        'ple_norm_in': gain((DEPTH, D)),
        'ple_w_gate': w((DEPTH, D, D), D),
        'ple_w_proj': w((DEPTH, P_DIM, D), P_DIM),
        'ple_norm_post': gain((DEPTH, D)),
    }


def reference(x, p, hgrn_lb_raw,
              e_norm_mix_pre, e_w_in, e_conv_w, e_conv_b, e_A_log, e_dt_bias, e_D,
              e_a_norm, e_b_norm, e_w_out, e_norm_mix_post,
              e_norm_ffn_pre, e_w_ffn_gate, e_w_ffn_up, e_w_ffn_down, e_norm_ffn_post,
              o_norm_mix_pre, o_w_qkv, o_rpb, o_w_out, o_norm_mix_post,
              o_norm_ffn_pre, o_w_router, o_w_exp_gate, o_w_exp_up, o_w_exp_down, o_norm_ffn_post,
              ple_norm_in, ple_w_gate, ple_w_proj, ple_norm_post):
    Bsz, S, D = x.shape
    lb_all = jnp.cumsum(jax.nn.softmax(hgrn_lb_raw.astype(jnp.float32), axis=0), axis=0)
    for li in range(DEPTH):
        j = li // 2
        if li % 2 == 0:
            h = rmsnorm(x, e_norm_mix_pre[j])
            u = h @ e_w_in[j]
            q_a, ff_a, fb_a, i_a, g_a, z_b, xbc_b, dtf_b, dtb_b = _split(u, EVEN_SPLITS)
            o_a = hgrn2_mixer(q_a, ff_a, fb_a, i_a, g_a, lb_all[li], e_a_norm[j])
            o_b = mamba2_mixer(z_b, xbc_b, dtf_b, dtb_b, e_conv_w[j], e_conv_b[j],
                               e_A_log[j], e_dt_bias[j], e_D[j], e_b_norm[j])
            mix = jnp.concatenate([o_a, o_b], axis=-1) @ e_w_out[j]
            x = x + rmsnorm(mix, e_norm_mix_post[j])
            h = rmsnorm(x, e_norm_ffn_pre[j])
            x = x + rmsnorm(swiglu(h, e_w_ffn_gate[j], e_w_ffn_up[j], e_w_ffn_down[j]), e_norm_ffn_post[j])
        else:
            h = rmsnorm(x, o_norm_mix_pre[j])
            q_c, k_c, v_c = jnp.split(h @ o_w_qkv[j], 3, axis=-1)
            heads = lambda t: t.reshape(Bsz, S, C_HEADS, C_HEADDIM)
            o_c = neighborhood_attention(heads(q_c), heads(k_c), heads(v_c), o_rpb[j])
            x = x + rmsnorm(o_c @ o_w_out[j], o_norm_mix_post[j])
            h = rmsnorm(x, o_norm_ffn_pre[j])
            moe = moe_swiglu(h, o_w_router[j], o_w_exp_gate[j], o_w_exp_up[j], o_w_exp_down[j])
            x = x + rmsnorm(moe, o_norm_ffn_post[j])
        gate = jax.nn.sigmoid(rmsnorm(x, ple_norm_in[li]) @ ple_w_gate[li])
        x = x + rmsnorm(gate * (p[li] @ ple_w_proj[li]), ple_norm_post[li])
    return x
```

```cpp
#include <hip/hip_runtime.h>
#include <stdint.h>
#include <stdio.h>

#define DEVI __device__ __forceinline__
#define LAS __attribute__((address_space(3)))
typedef unsigned short bf16_t;

constexpr int NB = 4, SEQ = 4096, DM = 1024, MT = NB * SEQ;
constexpr int EVEN_IN = 4112, DFF = 2816, NEXP = 8, DFFE = 3584, PDIM = 256;
constexpr float EPS = 1e-6f;
constexpr int NTHR = 512;
constexpr int LDS_BYTES = 147456;
constexpr int MISC_OFF = 131072 + 320;

constexpr size_t MiB = 1u << 20;
constexpr size_t WS_CTL = 0, CTL_ZERO_BYTES = 1 * MiB;
constexpr size_t WS_LIST = 1 * MiB;
constexpr size_t WS_GATE = WS_LIST + 512 * 1024;
constexpr size_t WS_T0 = 2 * MiB, WS_T1 = WS_T0 + 64 * MiB, WS_T2 = WS_T1 + 64 * MiB;
constexpr size_t WS_BIG = WS_T2 + 64 * MiB;
constexpr size_t WS_END = WS_BIG + 258 * MiB;
constexpr int CW_CNT = 64;
constexpr int CW_BAR = 4096;

DEVI int opq(int x) { asm volatile("" : "+v"(x)); return x; }
DEVI float bf2f(bf16_t b) { return __uint_as_float(((unsigned)b) << 16); }
DEVI bf16_t f2bf(float f) { unsigned u = __float_as_uint(f); u += 0x7FFFu + ((u >> 16) & 1u); return (bf16_t)(u >> 16); }
DEVI float silu_f(float x) { return x / (1.f + __expf(-x)); }
DEVI float sigmoid_f(float x) { return 1.f / (1.f + __expf(-x)); }
DEVI float softplus_f(float x) { return x > 20.f ? x : log1pf(__expf(x)); }
DEVI float wave_sum(float v) {
#pragma unroll
    for (int o = 1; o < 64; o <<= 1) v += __shfl_xor(v, o);
    return v;
}

DEVI void ph_norm(const float* xsrc, float* xdst, const float* y, const float* y2, const float* gpost, const float* gnext, float* hout, int vb0, int vbs) {
    const int tidq = opq((int)threadIdx.x); const int wid = tidq >> 6, lane = tidq & 63;
    for (int row = vb0 * 8 + wid; row < MT; row += vbs * 8) {
        float4 xv[4];
#pragma unroll
        for (int i = 0; i < 4; ++i) xv[i] = *(const float4*)(xsrc + (size_t)row * DM + i * 256 + lane * 4);
        if (y) {
            float4 yv[4]; float ss = 0.f;
#pragma unroll
            for (int i = 0; i < 4; ++i) {
                yv[i] = *(const float4*)(y + (size_t)row * DM + i * 256 + lane * 4);
                if (y2) { float4 t = *(const float4*)(y2 + (size_t)row * DM + i * 256 + lane * 4); yv[i].x += t.x; yv[i].y += t.y; yv[i].z += t.z; yv[i].w += t.w; }
                ss += yv[i].x * yv[i].x + yv[i].y * yv[i].y + yv[i].z * yv[i].z + yv[i].w * yv[i].w;
            }
            ss = wave_sum(ss);
            const float r = rsqrtf(ss * (1.f / DM) + EPS);
#pragma unroll
            for (int i = 0; i < 4; ++i) {
                float4 g = *(const float4*)(gpost + i * 256 + lane * 4);
                xv[i].x += yv[i].x * r * g.x; xv[i].y += yv[i].y * r * g.y; xv[i].z += yv[i].z * r * g.z; xv[i].w += yv[i].w * r * g.w;
            }
        }
        if (xdst) {
#pragma unroll
            for (int i = 0; i < 4; ++i) *(float4*)(xdst + (size_t)row * DM + i * 256 + lane * 4) = xv[i];
        }
        if (hout) {
            float ss = 0.f;
#pragma unroll
            for (int i = 0; i < 4; ++i) ss += xv[i].x * xv[i].x + xv[i].y * xv[i].y + xv[i].z * xv[i].z + xv[i].w * xv[i].w;
            ss = wave_sum(ss);
            const float r = rsqrtf(ss * (1.f / DM) + EPS);
#pragma unroll
            for (int i = 0; i < 4; ++i) {
                float4 g = *(const float4*)(gnext + i * 256 + lane * 4);
                float4 o; o.x = xv[i].x * r * g.x; o.y = xv[i].y * r * g.y; o.z = xv[i].z * r * g.z; o.w = xv[i].w * r * g.w;
                *(float4*)(hout + (size_t)row * DM + i * 256 + lane * 4) = o;
            }
        }
    }
}

struct GemmN {
    const void* A; int lda; const int* rowmap; int rowshift; const int* mcount; int M; int arow0;
    const float* W; const float* W2; int ldw; int N; int K;
};
template <bool DUAL, bool ABF, class EP>
DEVI void ph_gemm_naive(float* lds, const GemmN g, const EP& ep, int vb0, int vbs) {
    const int Mv = g.mcount ? (int)__hip_atomic_load((const unsigned*)g.mcount, __ATOMIC_RELAXED, __HIP_MEMORY_SCOPE_AGENT) : g.M;
    const int tm = (Mv + 127) / 128, tn = (g.N + 127) / 128;
    float* As = lds;
    float* Bs = lds + 16 * 132;
    float* Bs2 = Bs + 16 * 128;
    const int tid = opq((int)threadIdx.x), ty = tid >> 5, tx = tid & 31;
    for (int t = vb0; t < tm * tn; t += vbs) {
        const int m0 = (t / tn) * 128, n0 = (t % tn) * 128;
        float acc[8][4], acc2[8][4];
#pragma unroll
        for (int i = 0; i < 8; ++i)
#pragma unroll
            for (int j = 0; j < 4; ++j) { acc[i][j] = 0.f; acc2[i][j] = 0.f; }
        const int ar = tid >> 2, ac = (tid & 3) * 4;
        const int grow = m0 + ar; const bool aval = grow < Mv;
        size_t arow = 0;
        if (aval) arow = g.rowmap ? (size_t)(g.rowmap[grow] >> g.rowshift) : (size_t)(g.arow0 + grow);
        const int bk = tid >> 5, bc = (tid & 31) * 4; const bool bval = (n0 + bc) < g.N;
        for (int k0 = 0; k0 < g.K; k0 += 16) {
            float a4[4] = {0.f, 0.f, 0.f, 0.f};
            if (aval) {
                if (ABF) { const bf16_t* ap = (const bf16_t*)g.A + arow * g.lda + k0 + ac; a4[0] = bf2f(ap[0]); a4[1] = bf2f(ap[1]); a4[2] = bf2f(ap[2]); a4[3] = bf2f(ap[3]); }
                else { const float4 v = *(const float4*)((const float*)g.A + arow * g.lda + k0 + ac); a4[0] = v.x; a4[1] = v.y; a4[2] = v.z; a4[3] = v.w; }
            }
            float4 b = make_float4(0.f, 0.f, 0.f, 0.f), b2 = b;
            if (bval) { b = *(const float4*)(g.W + (size_t)(k0 + bk) * g.ldw + n0 + bc); if (DUAL) b2 = *(const float4*)(g.W2 + (size_t)(k0 + bk) * g.ldw + n0 + bc); }
            __syncthreads();
#pragma unroll
            for (int i = 0; i < 4; ++i) As[(ac + i) * 132 + ar] = a4[i];
            *(float4*)(Bs + bk * 128 + bc) = b;
            if (DUAL) *(float4*)(Bs2 + bk * 128 + bc) = b2;
            __syncthreads();
#pragma unroll
            for (int kk = 0; kk < 16; ++kk) {
                const float4 a0 = *(const float4*)(As + kk * 132 + ty * 8), a1 = *(const float4*)(As + kk * 132 + ty * 8 + 4);
                const float a[8] = {a0.x, a0.y, a0.z, a0.w, a1.x, a1.y, a1.z, a1.w};
                const float4 bv = *(const float4*)(Bs + kk * 128 + tx * 4);
                const float bb[4] = {bv.x, bv.y, bv.z, bv.w};
#pragma unroll
                for (int i = 0; i < 8; ++i)
#pragma unroll
                    for (int j = 0; j < 4; ++j) acc[i][j] += a[i] * bb[j];
                if (DUAL) {
                    const float4 cv = *(const float4*)(Bs2 + kk * 128 + tx * 4);
                    const float cc[4] = {cv.x, cv.y, cv.z, cv.w};
#pragma unroll
                    for (int i = 0; i < 8; ++i)
#pragma unroll
                        for (int j = 0; j < 4; ++j) acc2[i][j] += a[i] * cc[j];
                }
            }
        }
#pragma unroll
        for (int i = 0; i < 8; ++i)
#pragma unroll
            for (int j = 0; j < 4; ++j) {
                const int m = m0 + ty * 8 + i, n = n0 + tx * 4 + j;
                if (m < Mv && n < g.N) ep(m, n, acc[i][j], acc2[i][j]);
            }
    }
    __syncthreads();
}
struct EpStoreF32 { float* C; int ldc; DEVI void operator()(int m, int n, float a, float) const { C[(size_t)m * ldc + n] = a; } };
struct EpSwigluF32 { float* C; int ldc; DEVI void operator()(int m, int n, float a, float b) const { C[(size_t)m * ldc + n] = silu_f(a) * b; } };
struct EpSwigluBf16 { bf16_t* C; int ldc; int row0; DEVI void operator()(int m, int n, float a, float b) const { C[(size_t)(row0 + m) * ldc + n] = f2bf(silu_f(a) * b); } };
struct EpSigmoid { float* C; int ldc; DEVI void operator()(int m, int n, float a, float) const { C[(size_t)m * ldc + n] = sigmoid_f(a); } };
struct EpMul { float* C; int ldc; DEVI void operator()(int m, int n, float a, float) const { C[(size_t)m * ldc + n] *= a; } };
struct EpMoeDown { float* Y0; size_t slot_stride; const int* list; const float* gate; DEVI void operator()(int m, int n, float a, float) const {
    const int ts = list[m]; Y0[(size_t)(ts & 1) * slot_stride + (size_t)(ts >> 1) * DM + n] = a * gate[m]; } };

DEVI float lb_of(const float* lbraw, int ch) {
    const float r0 = lbraw[ch], r1 = lbraw[512 + ch], r2 = lbraw[1024 + ch];
    const float mx = fmaxf(r0, fmaxf(r1, r2));
    const float e0 = __expf(r0 - mx), e1 = __expf(r1 - mx), e2 = __expf(r2 - mx);
    return e0 / (e0 + e1 + e2);
}
DEVI void ph_hgrn_naive(float* lds, const float* u, const float* lbraw, float* oacc, int vb0, int vbs) {
    float* sq = lds; float* sk = lds + 2048; float* sf = lds + 4096; float* sv = lds + 6144;
    const int tid = opq((int)threadIdx.x), j = tid >> 2, kq = tid & 3;
    for (int vb = vb0; vb < 32; vb += vbs) {
        const int dir = vb & 1, h = (vb >> 1) & 3, b = vb >> 3;
        float st[32];
#pragma unroll
        for (int i = 0; i < 32; ++i) st[i] = 0.f;
        for (int tb = 0; tb < SEQ / 16; ++tb) {
            __syncthreads();
            for (int e = tid; e < 2048; e += NTHR) {
                const int i = e >> 7, c = e & 127;
                const int t = dir ? (SEQ - 1 - (tb * 16 + i)) : (tb * 16 + i);
                const float* ur = u + (size_t)(b * SEQ + t) * EVEN_IN;
                const int ch = h * 128 + c;
                const float qr = ur[ch], fr = ur[(dir ? 1024 : 512) + ch], vr = ur[1536 + ch];
                const float lb = lb_of(lbraw, ch);
                const float f = lb + (1.f - lb) * sigmoid_f(fr);
                sq[e] = silu_f(qr); sk[e] = 1.f - f; sf[e] = f; sv[e] = vr;
            }
            __syncthreads();
            for (int i = 0; i < 16; ++i) {
                const float vj = sv[i * 128 + j]; float acc = 0.f;
#pragma unroll
                for (int kk = 0; kk < 32; ++kk) {
                    const int kidx = kk * 4 + kq;
                    st[kk] = sf[i * 128 + kidx] * st[kk] + sk[i * 128 + kidx] * vj;
                    acc += st[kk] * sq[i * 128 + kidx];
                }
                acc += __shfl_xor(acc, 1); acc += __shfl_xor(acc, 2);
                if (kq == 0) {
                    const int t = dir ? (SEQ - 1 - (tb * 16 + i)) : (tb * 16 + i);
                    atomicAdd(&oacc[(size_t)(b * SEQ + t) * DM + h * 128 + j], acc);
                }
            }
        }
    }
    __syncthreads();
}

DEVI void ph_conv_naive(const float* u, const float* cw, const float* cb, float* xconv, int vb0, int vbs) {
    for (size_t e = (size_t)vb0 * NTHR + opq((int)threadIdx.x); e < (size_t)MT * 1024; e += (size_t)vbs * NTHR) {
        const int c = (int)(e & 1023); const int tok = (int)(e >> 10); const int t = tok & (SEQ - 1);
        float acc = cb[c];
#pragma unroll
        for (int j = 0; j < 5; ++j) { const int tt = t + j - 2; if (tt >= 0 && tt < SEQ) acc += u[(size_t)(tok + j - 2) * EVEN_IN + 3072 + c] * cw[j * 1024 + c]; }
        xconv[e] = silu_f(acc);
    }
}
DEVI void ph_ssd_naive(float* lds, const float* u, const float* xconv, const float* A_log, const float* dt_bias, float* oacc, int vb0, int vbs) {
    float* sx = lds; float* sB = lds + 1024; float* sC = lds + 1024 + 2048; float* sdt = lds + 1024 + 4096;
    const int tid = opq((int)threadIdx.x), p = tid >> 3, nq = tid & 7;
    for (int vb = vb0; vb < 64; vb += vbs) {
        const int dir = vb & 1, hd = (vb >> 1) & 7, b = vb >> 4, g = hd >> 2;
        const float A = -__expf(A_log[dir * 8 + hd]); const float dtb = dt_bias[dir * 8 + hd];
        float st[16];
#pragma unroll
        for (int i = 0; i < 16; ++i) st[i] = 0.f;
        for (int tb = 0; tb < SEQ / 16; ++tb) {
            __syncthreads();
            for (int e = tid; e < 2048; e += NTHR) {
                const int i = e >> 7, n = e & 127;
                const int t = dir ? (SEQ - 1 - (tb * 16 + i)) : (tb * 16 + i);
                const float* xr = xconv + (size_t)(b * SEQ + t) * 1024;
                sB[e] = xr[512 + g * 128 + n]; sC[e] = xr[768 + g * 128 + n];
                if (e < 1024) { const int i2 = e >> 6, pp = e & 63; const int t2 = dir ? (SEQ - 1 - (tb * 16 + i2)) : (tb * 16 + i2); sx[e] = xconv[(size_t)(b * SEQ + t2) * 1024 + hd * 64 + pp]; }
                if (e < 16) { const int t3 = dir ? (SEQ - 1 - (tb * 16 + e)) : (tb * 16 + e); sdt[e] = softplus_f(u[(size_t)(b * SEQ + t3) * EVEN_IN + 4096 + dir * 8 + hd] + dtb); }
            }
            __syncthreads();
            for (int i = 0; i < 16; ++i) {
                const float dt = sdt[i]; const float a = __expf(dt * A); const float xv = sx[i * 64 + p] * dt; float acc = 0.f;
#pragma unroll
                for (int nn = 0; nn < 16; ++nn) { const int n = nn * 8 + nq; st[nn] = a * st[nn] + xv * sB[i * 128 + n]; acc += st[nn] * sC[i * 128 + n]; }
                acc += __shfl_xor(acc, 1); acc += __shfl_xor(acc, 2); acc += __shfl_xor(acc, 4);
                if (nq == 0) {
                    const int t = dir ? (SEQ - 1 - (tb * 16 + i)) : (tb * 16 + i);
                    atomicAdd(&oacc[(size_t)(b * SEQ + t) * DM + 512 + hd * 64 + p], acc);
                }
            }
        }
    }
    __syncthreads();
}
DEVI void ph_mixfin_naive(const float* u, const float* xconv, const float* oacc, const float* a_norm, const float* b_norm, const float* Dskip, float* ocat, int vb0, int vbs) {
    const int tidq = opq((int)threadIdx.x); const int wid = tidq >> 6, lane = tidq & 63;
    for (int row = vb0 * 8 + wid; row < MT; row += vbs * 8) {
        const int c0 = lane * 16; float v[16]; float ss = 0.f;
        const float* ur = u + (size_t)row * EVEN_IN;
        if (lane < 32) {
#pragma unroll
            for (int i = 0; i < 16; ++i) { v[i] = oacc[(size_t)row * DM + c0 + i]; ss += v[i] * v[i]; }
        } else {
#pragma unroll
            for (int i = 0; i < 16; ++i) { const int cc = c0 - 512 + i;
                float y = oacc[(size_t)row * DM + 512 + cc] + Dskip[cc >> 6] * xconv[(size_t)row * 1024 + cc];
                y *= silu_f(ur[2560 + cc]); v[i] = y; ss += y * y; }
        }
        ss += __shfl_xor(ss, 1); ss += __shfl_xor(ss, 2); ss += __shfl_xor(ss, 4);
        const float s8 = ss + __shfl_xor(ss, 8);
        if (lane < 32) {
            const float r = rsqrtf(ss * (1.f / 128.f) + EPS);
#pragma unroll
            for (int i = 0; i < 16; ++i) { const int c = c0 + i; v[i] = v[i] * r * a_norm[c & 127] * silu_f(ur[2048 + c]); }
        } else {
            const float r = rsqrtf(s8 * (1.f / 256.f) + EPS);
#pragma unroll
            for (int i = 0; i < 16; ++i) { const int cc = c0 - 512 + i; v[i] = v[i] * r * b_norm[cc]; }
        }
#pragma unroll
        for (int i = 0; i < 16; ++i) ocat[(size_t)row * DM + c0 + i] = v[i];
    }
}

DEVI void ph_na_naive(const float* qkv, const float* rpb, float* oc, int vb0, int vbs) {
    for (int e4 = vb0 * NTHR + opq((int)threadIdx.x); e4 < MT * 16 * 4; e4 += vbs * NTHR) {
        const int dq = e4 & 3, e = e4 >> 2;
        const int hd = e / MT, tok = e % MT;
        const int b = tok >> 12, t = tok & 4095, r = t >> 6, c = t & 63;
        const int rs = min(max(r - 4, 0), 56), qs = min(max(c - 8, 0), 48);
        float q[16], o[16];
        const float* qp = qkv + (size_t)tok * 3072 + hd * 64 + dq * 16;
#pragma unroll
        for (int d = 0; d < 16; ++d) { q[d] = qp[d]; o[d] = 0.f; }
        float m = -1e30f, l = 0.f;
        for (int dr = 0; dr < 8; ++dr)
            for (int dc = 0; dc < 16; ++dc) {
                const int kr = rs + dr, kc = qs + dc;
                const size_t kt = (size_t)b * SEQ + kr * 64 + kc;
                const float* kp = qkv + kt * 3072 + 1024 + hd * 64 + dq * 16;
                const float* vp = qkv + kt * 3072 + 2048 + hd * 64 + dq * 16;
                float s = 0.f;
#pragma unroll
                for (int d = 0; d < 16; ++d) s += q[d] * kp[d];
                s += __shfl_xor(s, 1); s += __shfl_xor(s, 2);
                s = s * 0.125f + rpb[hd * 465 + (kr - r + 7) * 31 + (kc - c + 15)];
                const float mn = fmaxf(m, s); const float al = __expf(m - mn), pe = __expf(s - mn);
                l = l * al + pe; m = mn;
#pragma unroll
                for (int d = 0; d < 16; ++d) o[d] = o[d] * al + pe * vp[d];
            }
        const float il = 1.f / l;
        float* op = oc + (size_t)tok * DM + hd * 64 + dq * 16;
#pragma unroll
        for (int d = 0; d < 16; ++d) op[d] = o[d] * il;
    }
}

DEVI void ph_route(const float* h, const float* wr, unsigned* cnt, int* list, float* gatev, int vb0, int vbs) {
    const int tidq = opq((int)threadIdx.x); const int wid = tidq >> 6, lane = tidq & 63;
    for (int row = vb0 * 8 + wid; row < MT; row += vbs * 8) {
        float lg[8];
#pragma unroll
        for (int e = 0; e < 8; ++e) lg[e] = 0.f;
        for (int i = 0; i < 16; ++i) { const int k = i * 64 + lane; const float hv = h[(size_t)row * DM + k];
#pragma unroll
            for (int e = 0; e < 8; ++e) lg[e] += hv * wr[k * 8 + e]; }
#pragma unroll
        for (int e = 0; e < 8; ++e) lg[e] = wave_sum(lg[e]);
        if (lane == 0) {
            int e1 = 0; float v1 = lg[0];
#pragma unroll
            for (int e = 1; e < 8; ++e) if (lg[e] > v1) { v1 = lg[e]; e1 = e; }
            int e2 = -1; float v2 = -3.0e38f;
#pragma unroll
            for (int e = 0; e < 8; ++e) if (e != e1 && lg[e] > v2) { v2 = lg[e]; e2 = e; }
            const float ex = __expf(v2 - v1); const float w1 = 1.f / (1.f + ex), w2 = ex / (1.f + ex);
            const int p1 = (int)atomicAdd(&cnt[e1], 1u); list[e1 * MT + p1] = row * 2; gatev[e1 * MT + p1] = w1;
            const int p2 = (int)atomicAdd(&cnt[e2], 1u); list[e2 * MT + p2] = row * 2 + 1; gatev[e2 * MT + p2] = w2;
        }
    }
}

#define XB_TMO      128
#define XB_XCNT(j)  (256  + 64 * (j))
#define XB_XSUB(j)  (1280 + 64 * (j))
#define XB_XGEN(j)  (2304 + 64 * (j))
#define XB_TOP      3328
#define XB_TOPGEN   3392
#define XCD_BAR_WORDS 3456
#define XB_SPIN_CAP (1u << 18)

__device__ __forceinline__ unsigned xb_ld(unsigned* p)              { return __hip_atomic_load(p, __ATOMIC_RELAXED, __HIP_MEMORY_SCOPE_AGENT); }
__device__ __forceinline__ unsigned xb_add(unsigned* p, unsigned v) { return __hip_atomic_fetch_add(p, v, __ATOMIC_RELAXED, __HIP_MEMORY_SCOPE_AGENT); }
__device__ __forceinline__ unsigned xb_xcc_id() { return (unsigned)__builtin_amdgcn_s_getreg((3 << 11) | 20) & 0xFu; }
#define XB_SPIN(cond, bar) do { unsigned _sp = 0; while (cond) { __builtin_amdgcn_s_sleep(1); \
    if ((++_sp & 255u) == 0u) { if (xb_ld(&(bar)[XB_TMO])) break; if (_sp > XB_SPIN_CAP) { atomicAdd(&(bar)[XB_TMO], 1u); break; } } } } while (0)

struct XcdBarrier {
    unsigned* bar; unsigned x;
    volatile LAS unsigned* st;
};

__device__ __forceinline__ XcdBarrier xcd_barrier_post(unsigned* bar, volatile LAS unsigned* st) {
    XcdBarrier b; b.bar = bar; b.x = xb_xcc_id(); b.st = st;
    if (threadIdx.x == 0) (void)xb_add(&bar[XB_XCNT(b.x)], 1u);
    return b;
}
__device__ __forceinline__ void xcd_barrier_complete(unsigned* bar, unsigned x, unsigned& nloc, unsigned& nx) {
    const unsigned G = gridDim.x * gridDim.y * gridDim.z;
    unsigned sum, cnt, mine, sp = 0u;
    for (;;) {
        sum = 0u; cnt = 0u; mine = 0u;
#pragma unroll
        for (unsigned j = 0; j < 16; ++j) { const unsigned c = xb_ld(&bar[XB_XCNT(j)]); sum += c; cnt += (c > 0u) ? 1u : 0u; mine = (j == x) ? c : mine; }
        if (sum == G) break;
        __builtin_amdgcn_s_sleep(1);
        if ((++sp & 255u) == 0u) { if (xb_ld(&bar[XB_TMO])) break; if (sp > XB_SPIN_CAP) { atomicAdd(&bar[XB_TMO], 1u); break; } }
    }
    nloc = mine > 0u ? mine : 1u; nx = cnt > 0u ? cnt : 1u;
}

__device__ __forceinline__ void xcd_barrier(const XcdBarrier& b) {
    asm volatile("s_waitcnt vmcnt(0)" ::: "memory");
    __syncthreads();
    if (threadIdx.x == 0) {
        unsigned* bar = b.bar;
        __builtin_amdgcn_s_waitcnt(0);
        unsigned nloc = b.st[0], nx = b.st[1];
        if (nloc == 0u) { xcd_barrier_complete(bar, b.x, nloc, nx); b.st[0] = nloc; b.st[1] = nx; }
        const unsigned old = xb_add(&bar[XB_XSUB(b.x)], 1u);
        const unsigned gen = old / nloc;
        if (old + 1u == (gen + 1u) * nloc) {
            __builtin_amdgcn_fence(__ATOMIC_RELEASE, "agent");
            asm volatile("s_waitcnt vmcnt(0)" ::: "memory");
            const unsigned og = xb_add(&bar[XB_TOP], 1u);
            const unsigned tg = og / nx;
            if (og + 1u == (tg + 1u) * nx) xb_add(&bar[XB_TOPGEN], 1u);
            else XB_SPIN(xb_ld(&bar[XB_TOPGEN]) == tg, bar);
            __builtin_amdgcn_fence(__ATOMIC_ACQUIRE, "agent");
            xb_add(&bar[XB_XGEN(b.x)], 1u);
            asm volatile("s_waitcnt vmcnt(0)" ::: "memory");
        } else {
            XB_SPIN(xb_ld(&bar[XB_XGEN(b.x)]) == gen, bar);
            __builtin_amdgcn_fence(__ATOMIC_ACQUIRE, "agent");
            asm volatile("s_waitcnt vmcnt(0)" ::: "memory");
        }
    }
    __syncthreads();
}


struct Args { const float* in[34]; float* out; unsigned char* ws; int ph_lo, ph_hi; };
constexpr int N_PHASES = 24;

__global__ void __launch_bounds__(NTHR, 2) fwd(Args a) {
    extern __shared__ __attribute__((aligned(16))) unsigned char lds_raw[];
    float* lds = (float*)lds_raw;
    const int vb0 = blockIdx.x, vbs = gridDim.x;
    const int lo = a.ph_lo, hi = a.ph_hi;
#define IN(k) (lo <= (k) && (k) < hi)
#define SEAM(k) do { if (IN(k) && IN((k) + 1)) xcd_barrier(bar); } while (0)
    volatile LAS unsigned* misc = (volatile LAS unsigned*)((LAS unsigned char*)lds_raw + MISC_OFF);
    if (threadIdx.x < 4) misc[threadIdx.x] = 0u;
    __syncthreads();
    XcdBarrier bar = xcd_barrier_post((unsigned*)(a.ws + WS_CTL) + CW_BAR, misc);
    unsigned char* ws = a.ws;
    unsigned* ctl = (unsigned*)(ws + WS_CTL);
    unsigned* cnt = ctl + CW_CNT;
    int* list = (int*)(ws + WS_LIST); float* gatev = (float*)(ws + WS_GATE);
    float* T0 = (float*)(ws + WS_T0); float* T1 = (float*)(ws + WS_T1); float* T2 = (float*)(ws + WS_T2);
    float* BIG = (float*)(ws + WS_BIG);
    float* X = a.out;
    const float* x_in = a.in[0]; const float* p_in = a.in[1];

    if (IN(0)) {
        ph_norm(x_in, X, nullptr, nullptr, nullptr, a.in[3], T0, vb0, vbs);
        for (size_t e = (size_t)vb0 * NTHR + threadIdx.x; e < (size_t)MT * DM / 4; e += (size_t)vbs * NTHR) ((float4*)T1)[e] = make_float4(0.f, 0.f, 0.f, 0.f);
    }
    SEAM(0);
    if (IN(1)) { GemmN g{T0, DM, nullptr, 0, nullptr, MT, 0, a.in[4], nullptr, EVEN_IN, EVEN_IN, DM}; ph_gemm_naive<false, false>(lds, g, EpStoreF32{BIG, EVEN_IN}, vb0, vbs); }
    SEAM(1);
    if (IN(2)) { ph_conv_naive(BIG, a.in[5], a.in[6], T0, vb0, vbs); ph_hgrn_naive(lds, BIG, a.in[2], T1, vb0, vbs); }
    SEAM(2);
    if (IN(3)) { ph_ssd_naive(lds, BIG, T0, a.in[7], a.in[8], T1, vb0, vbs); }
    SEAM(3);
    if (IN(4)) { ph_mixfin_naive(BIG, T0, T1, a.in[10], a.in[11], a.in[9], T2, vb0, vbs); }
    SEAM(4);
    if (IN(5)) { GemmN g{T2, DM, nullptr, 0, nullptr, MT, 0, a.in[12], nullptr, DM, DM, DM}; ph_gemm_naive<false, false>(lds, g, EpStoreF32{T1, DM}, vb0, vbs); }
    SEAM(5);
    if (IN(6)) { ph_norm(X, X, T1, nullptr, a.in[13], a.in[14], T0, vb0, vbs); }
    SEAM(6);
    if (IN(7)) { GemmN g{T0, DM, nullptr, 0, nullptr, MT, 0, a.in[15], a.in[16], DFF, DFF, DM}; ph_gemm_naive<true, false>(lds, g, EpSwigluF32{BIG, DFF}, vb0, vbs); }
    SEAM(7);
    if (IN(8)) { GemmN g{BIG, DFF, nullptr, 0, nullptr, MT, 0, a.in[17], nullptr, DM, DM, DFF}; ph_gemm_naive<false, false>(lds, g, EpStoreF32{T1, DM}, vb0, vbs); }
    SEAM(8);
    if (IN(9)) { ph_norm(X, X, T1, nullptr, a.in[18], a.in[30], T0, vb0, vbs); }
    SEAM(9);
    if (IN(10)) { GemmN g{T0, DM, nullptr, 0, nullptr, MT, 0, a.in[31], nullptr, DM, DM, DM}; ph_gemm_naive<false, false>(lds, g, EpSigmoid{T1, DM}, vb0, vbs); }
    SEAM(10);
    if (IN(11)) { GemmN g{p_in, PDIM, nullptr, 0, nullptr, MT, 0, a.in[32], nullptr, DM, DM, PDIM}; ph_gemm_naive<false, false>(lds, g, EpMul{T1, DM}, vb0, vbs); }
    SEAM(11);
    if (IN(12)) { ph_norm(X, X, T1, nullptr, a.in[33], a.in[19], T0, vb0, vbs); }
    SEAM(12);
    if (IN(13)) { GemmN g{T0, DM, nullptr, 0, nullptr, MT, 0, a.in[20], nullptr, 3072, 3072, DM}; ph_gemm_naive<false, false>(lds, g, EpStoreF32{BIG, 3072}, vb0, vbs); }
    SEAM(13);
    if (IN(14)) { ph_na_naive(BIG, a.in[21], T1, vb0, vbs); }
    SEAM(14);
    if (IN(15)) { GemmN g{T1, DM, nullptr, 0, nullptr, MT, 0, a.in[22], nullptr, DM, DM, DM}; ph_gemm_naive<false, false>(lds, g, EpStoreF32{T2, DM}, vb0, vbs); }
    SEAM(15);
    if (IN(16)) { ph_norm(X, X, T2, nullptr, a.in[23], a.in[24], T0, vb0, vbs); }
    SEAM(16);
    if (IN(17)) { ph_route(T0, a.in[25], cnt, list, gatev, vb0, vbs); }
    SEAM(17);
    if (IN(18)) {
        int off = 0;
        for (int e = 0; e < NEXP; ++e) {
            GemmN g{T0, DM, list + e * MT, 1, (const int*)(cnt + e), MT, 0, a.in[26] + (size_t)e * DM * DFFE, a.in[27] + (size_t)e * DM * DFFE, DFFE, DFFE, DM};
            ph_gemm_naive<true, false>(lds, g, EpSwigluBf16{(bf16_t*)BIG, DFFE, off}, vb0, vbs);
            off += (int)__hip_atomic_load(cnt + e, __ATOMIC_RELAXED, __HIP_MEMORY_SCOPE_AGENT);
        }
    }
    SEAM(18);
    if (IN(19)) {
        int off = 0;
        for (int e = 0; e < NEXP; ++e) {
            GemmN g{BIG, DFFE, nullptr, 0, (const int*)(cnt + e), MT, off, a.in[28] + (size_t)e * DFFE * DM, nullptr, DM, DM, DFFE};
            ph_gemm_naive<false, true>(lds, g, EpMoeDown{T1, (size_t)(WS_T2 - WS_T1) / 4, list + e * MT, gatev + e * MT}, vb0, vbs);
            off += (int)__hip_atomic_load(cnt + e, __ATOMIC_RELAXED, __HIP_MEMORY_SCOPE_AGENT);
        }
    }
    SEAM(19);
    if (IN(20)) { ph_norm(X, X, T1, T2, a.in[29], a.in[30] + DM, T0, vb0, vbs); }
    SEAM(20);
    if (IN(21)) { GemmN g{T0, DM, nullptr, 0, nullptr, MT, 0, a.in[31] + (size_t)DM * DM, nullptr, DM, DM, DM}; ph_gemm_naive<false, false>(lds, g, EpSigmoid{T1, DM}, vb0, vbs); }
    SEAM(21);
    if (IN(22)) { GemmN g{p_in + (size_t)MT * PDIM, PDIM, nullptr, 0, nullptr, MT, 0, a.in[32] + (size_t)PDIM * DM, nullptr, DM, DM, PDIM}; ph_gemm_naive<false, false>(lds, g, EpMul{T1, DM}, vb0, vbs); }
    SEAM(22);
    if (IN(23)) { ph_norm(X, X, T1, nullptr, a.in[33] + DM, nullptr, nullptr, vb0, vbs); }
#undef IN
}

extern "C" void kernel_launch(void* const* d_in, const int* in_sizes, int n_in, void* d_out, int out_size, void* d_ws, size_t ws_size, hipStream_t stream) {
    static int grid = 0;
    if (grid == 0) {
        if (n_in != 34 || out_size != MT * DM || ws_size < WS_END) { fprintf(stderr, "kernel_launch: unexpected shapes n_in %d out %d ws %zu (need %zu)\n", n_in, out_size, ws_size, (size_t)WS_END); grid = -1; return; }
        int dev = 0, cus = 0;
        if (hipGetDevice(&dev) != hipSuccess || hipDeviceGetAttribute(&cus, hipDeviceAttributeMultiprocessorCount, dev) != hipSuccess) { grid = -1; return; }
        if (hipFuncSetAttribute((const void*)fwd, hipFuncAttributeMaxDynamicSharedMemorySize, LDS_BYTES) != hipSuccess) { fprintf(stderr, "hipFuncSetAttribute failed\n"); grid = -1; return; }
        (void)hipGetLastError();
        grid = cus;
    }
    if (grid < 0) return;
    (void)hipMemsetAsync((char*)d_ws + WS_CTL, 0, CTL_ZERO_BYTES, stream);
    Args a{};
    for (int i = 0; i < 34; ++i) a.in[i] = (const float*)d_in[i];
    a.out = (float*)d_out; a.ws = (unsigned char*)d_ws;
#ifndef MK_PER_PHASE
    a.ph_lo = 0; a.ph_hi = N_PHASES;
    hipLaunchKernelGGL(fwd, dim3(grid), dim3(NTHR), LDS_BYTES, stream, a);
#else
    for (int ph = 0; ph < N_PHASES; ++ph) {
        a.ph_lo = ph; a.ph_hi = ph + 1;
        hipLaunchKernelGGL(fwd, dim3(grid), dim3(NTHR), LDS_BYTES, stream, a);
    }
#endif
}
```

```cpp
#include <hip/hip_runtime.h>
#include <stdint.h>
#include <stdio.h>

#define DEVI __device__ __forceinline__
#define LAS __attribute__((address_space(3)))
typedef unsigned short bf16_t;

constexpr int NB = 4, SEQ = 4096, DM = 1024, MT = NB * SEQ;
constexpr int EVEN_IN = 4112, UW = 4096, DFF = 2816, NEXP = 8, DFFE = 3584, PDIM = 256;
constexpr float EPS = 1e-6f;
constexpr int NTHR = 512;
constexpr int LDS_BYTES = 147456;
constexpr int MISC_OFF = 131072 + 320;
constexpr int MOE_ROWS = 2 * MT + NEXP * 256;

constexpr size_t MiB = 1u << 20;
constexpr size_t WS_CTL = 0, CTL_ZERO_BYTES = 1 * MiB;
constexpr size_t WS_LIST = 1 * MiB;
constexpr size_t WS_GATE = WS_LIST + 512 * 1024;
constexpr size_t WS_DT = 2 * MiB;
constexpr size_t WS_W = 3 * MiB;
constexpr size_t W_IN = WS_W, W_OUTE = W_IN + 8 * MiB, W_GU = W_OUTE + 2 * MiB, W_DN = W_GU + 11 * MiB, W_PG = W_DN + 6 * MiB, W_PP = W_PG + 4 * MiB,
                 W_QKV = W_PP + 1 * MiB, W_OUTO = W_QKV + 6 * MiB, W_EGU = W_OUTO + 2 * MiB, W_EDN = W_EGU + 112 * MiB, W_END = W_EDN + 56 * MiB;
constexpr size_t WS_HB = W_END;
constexpr size_t WS_R = WS_HB + 32 * MiB;
constexpr size_t WS_UB = WS_R;
constexpr size_t WS_PB0 = WS_R + 88 * MiB;
constexpr size_t WS_T1 = WS_R + 128 * MiB;
constexpr size_t WS_T2 = WS_T1 + 64 * MiB;
constexpr size_t WS_PB1 = WS_R + 240 * MiB;
constexpr size_t WS_END = WS_T2 + 64 * MiB;
constexpr size_t WS_Y = W_EGU;
static_assert(WS_R + (size_t)MOE_ROWS * DFFE * 2 <= WS_PB1 && WS_PB1 + 8 * MiB <= WS_END && WS_END <= 510 * MiB, "ws map");
constexpr int CW_CNT = 64;
constexpr int CW_BAR = 4096;

DEVI int opq(int x) { asm volatile("" : "+v"(x)); return x; }
DEVI float bf2f(bf16_t b) { return __uint_as_float(((unsigned)b) << 16); }
DEVI bf16_t f2bf(float f) { unsigned u = __float_as_uint(f); u += 0x7FFFu + ((u >> 16) & 1u); return (bf16_t)(u >> 16); }
DEVI float silu_f(float x) { return x / (1.f + __expf(-x)); }
DEVI float sigmoid_f(float x) { return 1.f / (1.f + __expf(-x)); }
DEVI float softplus_f(float x) { return x > 20.f ? x : log1pf(__expf(x)); }
DEVI float wave_sum(float v) {
#pragma unroll
    for (int o = 1; o < 64; o <<= 1) v += __shfl_xor(v, o);
    return v;
}


typedef short bf16x8 __attribute__((ext_vector_type(8)));
typedef float f32x4 __attribute__((ext_vector_type(4)));
typedef unsigned u32x4 __attribute__((ext_vector_type(4)));
typedef unsigned u32x2 __attribute__((ext_vector_type(2)));
DEVI unsigned pk2(float lo, float hi) { return (unsigned)f2bf(lo) | ((unsigned)f2bf(hi) << 16); }
DEVI float bflo(unsigned w) { return __uint_as_float(w << 16); }
DEVI float bfhi(unsigned w) { return __uint_as_float(w & 0xffff0000u); }

struct NormA { const float* xsrc; float* xdst; const float* y; const bf16_t* yb; const float* gpost; const float* gnext; bf16_t* hout;
               const float* win; float* dtraw; const float* wr; unsigned* cnt; int* list; float* gatev; };
template <int YMODE, bool HOUT, bool DT, bool ROUTE>
DEVI void ph_norm(const NormA& A, int vb0, int vbs) {
    const int tidq = opq((int)threadIdx.x); const int wid = tidq >> 6, lane = tidq & 63;
    for (int row = vb0 * 8 + wid; row < MT; row += vbs * 8) {
        float4 xv[4];
#pragma unroll
        for (int i = 0; i < 4; ++i) xv[i] = *(const float4*)(A.xsrc + (size_t)row * DM + i * 256 + lane * 4);
        if (YMODE != 0) {
            float4 yv[4]; float ss = 0.f;
#pragma unroll
            for (int i = 0; i < 4; ++i) {
                if (YMODE == 1) yv[i] = *(const float4*)(A.y + (size_t)row * DM + i * 256 + lane * 4);
                else { const u32x2 a = *(const u32x2*)(A.yb + (size_t)row * DM + i * 256 + lane * 4), b = *(const u32x2*)(A.yb + (size_t)MT * DM + (size_t)row * DM + i * 256 + lane * 4);
                       yv[i].x = bflo(a.x) + bflo(b.x); yv[i].y = bfhi(a.x) + bfhi(b.x); yv[i].z = bflo(a.y) + bflo(b.y); yv[i].w = bfhi(a.y) + bfhi(b.y); }
                ss += yv[i].x * yv[i].x + yv[i].y * yv[i].y + yv[i].z * yv[i].z + yv[i].w * yv[i].w;
            }
            ss = wave_sum(ss);
            const float r = rsqrtf(ss * (1.f / DM) + EPS);
#pragma unroll
            for (int i = 0; i < 4; ++i) {
                const float4 g = *(const float4*)(A.gpost + i * 256 + lane * 4);
                xv[i].x += yv[i].x * r * g.x; xv[i].y += yv[i].y * r * g.y; xv[i].z += yv[i].z * r * g.z; xv[i].w += yv[i].w * r * g.w;
            }
        }
#pragma unroll
        for (int i = 0; i < 4; ++i) *(float4*)(A.xdst + (size_t)row * DM + i * 256 + lane * 4) = xv[i];
        if (HOUT) {
            float ss = 0.f;
#pragma unroll
            for (int i = 0; i < 4; ++i) ss += xv[i].x * xv[i].x + xv[i].y * xv[i].y + xv[i].z * xv[i].z + xv[i].w * xv[i].w;
            ss = wave_sum(ss);
            const float r = rsqrtf(ss * (1.f / DM) + EPS);
            float4 hv[4];
#pragma unroll
            for (int i = 0; i < 4; ++i) {
                const float4 g = *(const float4*)(A.gnext + i * 256 + lane * 4);
                hv[i].x = xv[i].x * r * g.x; hv[i].y = xv[i].y * r * g.y; hv[i].z = xv[i].z * r * g.z; hv[i].w = xv[i].w * r * g.w;
                u32x2 o; o.x = pk2(hv[i].x, hv[i].y); o.y = pk2(hv[i].z, hv[i].w);
                *(u32x2*)(A.hout + (size_t)row * DM + i * 256 + lane * 4) = o;
            }
            if (DT) {
                float d[16];
#pragma unroll
                for (int j = 0; j < 16; ++j) d[j] = 0.f;
#pragma unroll
                for (int i = 0; i < 4; ++i) {
                    const float hh[4] = {hv[i].x, hv[i].y, hv[i].z, hv[i].w};
#pragma unroll
                    for (int q = 0; q < 4; ++q) {
                        const float* wp = A.win + (size_t)(i * 256 + lane * 4 + q) * EVEN_IN + 4096;
#pragma unroll
                        for (int j4 = 0; j4 < 4; ++j4) { const float4 w = *(const float4*)(wp + j4 * 4);
                            d[j4 * 4 + 0] += hh[q] * w.x; d[j4 * 4 + 1] += hh[q] * w.y; d[j4 * 4 + 2] += hh[q] * w.z; d[j4 * 4 + 3] += hh[q] * w.w; }
                    }
                }
#pragma unroll
                for (int j = 0; j < 16; ++j) d[j] = wave_sum(d[j]);
                if (lane == 0) {
#pragma unroll
                    for (int j4 = 0; j4 < 4; ++j4) *(float4*)(A.dtraw + (size_t)row * 16 + j4 * 4) = make_float4(d[j4 * 4], d[j4 * 4 + 1], d[j4 * 4 + 2], d[j4 * 4 + 3]);
                }
            }
            if (ROUTE) {
                float lg[8];
#pragma unroll
                for (int e = 0; e < 8; ++e) lg[e] = 0.f;
#pragma unroll
                for (int i = 0; i < 4; ++i) {
                    const float hh[4] = {hv[i].x, hv[i].y, hv[i].z, hv[i].w};
#pragma unroll
                    for (int q = 0; q < 4; ++q) {
                        const float* wp = A.wr + (size_t)(i * 256 + lane * 4 + q) * 8;
                        const float4 w0 = *(const float4*)wp, w1 = *(const float4*)(wp + 4);
                        lg[0] += hh[q] * w0.x; lg[1] += hh[q] * w0.y; lg[2] += hh[q] * w0.z; lg[3] += hh[q] * w0.w;
                        lg[4] += hh[q] * w1.x; lg[5] += hh[q] * w1.y; lg[6] += hh[q] * w1.z; lg[7] += hh[q] * w1.w;
                    }
                }
#pragma unroll
                for (int e = 0; e < 8; ++e) lg[e] = wave_sum(lg[e]);
                if (lane == 0) {
                    int e1 = 0; float v1 = lg[0];
#pragma unroll
                    for (int e = 1; e < 8; ++e) if (lg[e] > v1) { v1 = lg[e]; e1 = e; }
                    int e2 = 0; float v2 = -3.0e38f;
#pragma unroll
                    for (int e = 0; e < 8; ++e) if (e != e1 && lg[e] > v2) { v2 = lg[e]; e2 = e; }
                    const float ex = __expf(v2 - v1); const float w1 = 1.f / (1.f + ex), w2 = ex / (1.f + ex);
                    const int p1 = (int)atomicAdd(&A.cnt[e1], 1u); A.list[e1 * MT + p1] = row * 2; A.gatev[e1 * MT + p1] = w1;
                    const int p2 = (int)atomicAdd(&A.cnt[e2], 1u); A.list[e2 * MT + p2] = row * 2 + 1; A.gatev[e2 * MT + p2] = w2;
                }
            }
        }
    }
}

DEVI void transpose_item(const float* W, int ldw, int K, int k0, int n0, bf16_t* WT, int drow0, LAS float* scr, int lane) {
#pragma unroll 8
    for (int i = 0; i < 32; ++i) { const int kk = 2 * i + (lane >> 5); scr[kk * 33 + (lane & 31)] = W[(size_t)(k0 + kk) * ldw + n0 + (lane & 31)]; }
    asm volatile("s_waitcnt lgkmcnt(0)" ::: "memory");
    const int c = lane & 7;
#pragma unroll
    for (int j = 0; j < 4; ++j) { const int n = (lane >> 3) + 8 * j; const LAS float* sp = scr + (8 * c) * 33 + n;
        u32x4 o; o.x = pk2(sp[0 * 33], sp[1 * 33]); o.y = pk2(sp[2 * 33], sp[3 * 33]); o.z = pk2(sp[4 * 33], sp[5 * 33]); o.w = pk2(sp[6 * 33], sp[7 * 33]);
        *(u32x4*)(WT + (size_t)(drow0 + n) * K + k0 + 8 * c) = o; }
    asm volatile("s_waitcnt lgkmcnt(0)" ::: "memory");
}
struct Job { int in_idx; unsigned src_off; int ldw; int K; int ncols; unsigned long long dst; int mode; int item0; };
constexpr int NJOBS = 11 + 24;
struct JobTable { Job j[NJOBS]; int total; };
constexpr JobTable make_jobs() {
    JobTable t{}; int n = 0, it = 0;
    auto add = [&](int idx, unsigned off, int ldw, int K, int ncols, unsigned long long dst, int mode) { t.j[n] = Job{idx, off, ldw, K, ncols, dst, mode, it}; it += (K / 64) * (ncols / 32); ++n; };
    add(4, 0, EVEN_IN, DM, UW, W_IN, 0);
    add(12, 0, DM, DM, DM, W_OUTE, 0);
    add(15, 0, DFF, DM, DFF, W_GU, 1);
    add(16, 0, DFF, DM, DFF, W_GU, 2);
    add(17, 0, DM, DFF, DM, W_DN, 0);
    add(31, 0, DM, DM, DM, W_PG, 0);
    add(31, DM * DM, DM, DM, DM, W_PG + 2 * MiB, 0);
    add(32, 0, DM, PDIM, DM, W_PP, 0);
    add(32, PDIM * DM, DM, PDIM, DM, W_PP + 512 * 1024, 0);
    add(20, 0, 3072, DM, 3072, W_QKV, 0);
    add(22, 0, DM, DM, DM, W_OUTO, 0);
    for (int e = 0; e < NEXP; ++e) {
        add(26, (unsigned)e * DM * DFFE, DFFE, DM, DFFE, W_EGU + (unsigned long long)e * 14 * MiB, 1);
        add(27, (unsigned)e * DM * DFFE, DFFE, DM, DFFE, W_EGU + (unsigned long long)e * 14 * MiB, 2);
        add(28, (unsigned)e * DFFE * DM, DM, DFFE, DM, W_EDN + (unsigned long long)e * 7 * MiB, 0);
    }
    t.total = it; return t;
}
__device__ const JobTable g_jobs = make_jobs();
DEVI void ph_convert_weights(LAS unsigned char* lds, const float* const* in, unsigned char* ws, int vb0, int vbs) {
    const int tidq = opq((int)threadIdx.x); const int wid = __builtin_amdgcn_readfirstlane(tidq >> 6), lane = tidq & 63;
    LAS float* scr = (LAS float*)(lds + wid * 16384);
    const int total = g_jobs.total;
    int jb = 0;
    for (int it = vb0 * 8 + wid; it < total; it += vbs * 8) {
        while (jb + 1 < NJOBS && g_jobs.j[jb + 1].item0 <= it) ++jb;
        const Job J = g_jobs.j[jb];
        const int r = it - J.item0; const int nblk = J.ncols / 32; const int kb = r / nblk, nb = r % nblk;
        const int n0 = nb * 32; int drow0 = n0;
        if (J.mode != 0) drow0 = (n0 >> 7) * 256 + (n0 & 127) + (J.mode == 2 ? 128 : 0);
        transpose_item(in[J.in_idx] + J.src_off, J.ldw, J.K, kb * 64, n0, (bf16_t*)(ws + J.dst), drow0, scr, lane);
    }
}
DEVI void ph_cvt_rows(const float* src, bf16_t* dst, size_t n4, int vb0, int vbs) {
    for (size_t e = (size_t)vb0 * NTHR + opq((int)threadIdx.x); e < n4; e += (size_t)vbs * NTHR) {
        const float4 v = ((const float4*)src)[e]; u32x2 o; o.x = pk2(v.x, v.y); o.y = pk2(v.z, v.w); ((u32x2*)dst)[e] = o; }
}

namespace pg8 {
constexpr int BM = 256, BK = 64, HALF = 128, HTB = HALF * BK * 2, STAGE_BYTES = 8 * HTB, NXCD = 8, WGM = 8;
__host__ __device__ __forceinline__ int lds_byte(int r, int c) { const int st = (r >> 4) * 2 + (c >> 5), rr = r & 15, cc = c & 31, ob = rr * 64 + cc * 2; return st * 1024 + (ob ^ (((ob >> 9) & 1) << 5)); }
__host__ __device__ __forceinline__ void stage_rc(int b, int& R, int& C) { const int st = b / 1024, sb = b % 1024, swz = sb ^ (((sb >> 9) & 1) << 5); R = (st >> 1) * 16 + swz / 64; C = (st & 1) * 32 + (swz % 64) / 2; }
__host__ __device__ __forceinline__ int perm32(int rho) { const int n = rho >> 4, i = rho & 15; return 8 * (i >> 2) + 4 * n + (i & 3); }
struct Unit { int pm, pn; int row0; int mvalid; int e; int mbase; const char* B; };
DEVI void xcd_tile(int L, int nwg, int nM, int nN, int& pm, int& pn) {
    int wgid = L; { const int q = nwg / NXCD, r = nwg % NXCD, xcd = wgid % NXCD, off = wgid / NXCD; wgid = (xcd < r ? xcd * (q + 1) : r * (q + 1) + (xcd - r) * q) + off; }
    const int nig = WGM * nN, gid = wgid / nig, fm = gid * WGM, gsz = (nM - fm) < WGM ? (nM - fm) : WGM;
    pm = fm + ((wgid % nig) % gsz); pn = (wgid % nig) / gsz;
}
struct DenseOrder {
    static constexpr bool GATHER = false;
    int nM, nN, nwg, G, c; const char* Bt; size_t tstepB;
    DEVI void init(int M, int N, int K, const bf16_t* Bt_, int G_, int c_) { nM = M / BM; nN = N / BM; nwg = nM * nN; G = G_; c = c_; Bt = (const char*)Bt_; tstepB = (size_t)BM * K * 2; }
    DEVI bool next(int i, Unit& u) const { const long L = (long)i * G + c; if (L >= nwg) return false; xcd_tile((int)L, nwg, nM, nN, u.pm, u.pn); u.row0 = u.pm * BM; u.mvalid = BM; u.e = 0; u.mbase = 0; u.B = Bt + (size_t)u.pn * tstepB; return true; }
    DEVI int arow(const Unit& u, int r) const { return u.row0 + r; }
};
struct MoeOrder {
    int nM, nN, nwg, G, c; const char* Bt; size_t estepB, tstepB; const volatile LAS int* tab; const int* list; bool gather;
    static constexpr bool GATHER = true;
    DEVI void init(const unsigned* cnt, volatile LAS int* tab_, int N, int K, const bf16_t* Bt_, size_t estep_bytes, const int* list_, bool gather_, int G_, int c_) {
        __syncthreads();
        if (threadIdx.x == 0) { int t = 0;
            for (int e = 0; e < 8; ++e) { const int n = (int)__hip_atomic_load(cnt + e, __ATOMIC_RELAXED, __HIP_MEMORY_SCOPE_AGENT); tab_[16 + e] = n; tab_[e] = t; t += (n + BM - 1) / BM; }
            tab_[8] = t; }
        __syncthreads();
        tab = tab_; nM = __builtin_amdgcn_readfirstlane(tab_[8]); nN = N / BM; nwg = nM * nN; G = G_; c = c_; Bt = (const char*)Bt_; estepB = estep_bytes; tstepB = (size_t)BM * K * 2; list = list_; gather = gather_;
    }
    DEVI bool next(int i, Unit& u) const { const long L = (long)i * G + c; if (L >= nwg) return false; xcd_tile((int)L, nwg, nM, nN, u.pm, u.pn);
        int e = 0;
        for (int k = 1; k < 8; ++k) if (u.pm >= __builtin_amdgcn_readfirstlane(tab[k])) e = k;
        const int t0 = __builtin_amdgcn_readfirstlane(tab[e]), n = __builtin_amdgcn_readfirstlane(tab[16 + e]);
        u.e = e; u.row0 = u.pm * BM; const int m0 = (u.pm - t0) * BM; u.mbase = m0; u.mvalid = (n - m0) < BM ? (n - m0) : BM; u.B = Bt + (size_t)e * estepB + (size_t)u.pn * tstepB; return true; }
    DEVI int arow(const Unit& u, int r) const {
        if (!gather) return u.row0 + r;
        const int m = u.mbase + r;
        return (r < u.mvalid) ? (list[u.e * MT + m] >> 1) : 0;
    }
};
DEVI unsigned cvt_pk_bf16(float lo, float hi) { unsigned r; asm volatile("v_cvt_pk_bf16_f32 %0, %1, %2" : "=v"(r) : "v"(lo), "v"(hi)); return r; }

struct EpiF32 { static constexpr bool PERM = false; float* C; int ldc;
    DEVI void operator()(const f32x4 (&acc)[2][2][4][2], const Unit& u, int wr, int wc, int fr, int fq) const {
        const int row0 = u.row0 + wr * 64 + fr, col0 = u.pn * BM + wc * 32 + 4 * fq;
#pragma unroll
        for (int ai = 0; ai < 2; ++ai)
#pragma unroll
            for (int m = 0; m < 4; ++m) { float* rowp = C + (size_t)(row0 + ai * HALF + m * 16) * ldc + col0;
#pragma unroll
                for (int bj = 0; bj < 2; ++bj)
#pragma unroll
                    for (int n = 0; n < 2; ++n) *(f32x4*)(rowp + bj * HALF + n * 16) = acc[ai][bj][m][n]; }
    } };
struct EpiPleGate { static constexpr bool PERM = false; float* C; int ldc;
    DEVI void operator()(const f32x4 (&acc)[2][2][4][2], const Unit& u, int wr, int wc, int fr, int fq) const {
        const int row0 = u.row0 + wr * 64 + fr, col0 = u.pn * BM + wc * 32 + 4 * fq;
#pragma unroll
        for (int ai = 0; ai < 2; ++ai)
#pragma unroll
            for (int m = 0; m < 4; ++m) { float* rowp = C + (size_t)(row0 + ai * HALF + m * 16) * ldc + col0;
#pragma unroll
                for (int bj = 0; bj < 2; ++bj)
#pragma unroll
                    for (int n = 0; n < 2; ++n) { const f32x4 pp = *(const f32x4*)(rowp + bj * HALF + n * 16); const f32x4 a = acc[ai][bj][m][n]; f32x4 o;
                        o.x = sigmoid_f(a.x) * pp.x; o.y = sigmoid_f(a.y) * pp.y; o.z = sigmoid_f(a.z) * pp.z; o.w = sigmoid_f(a.w) * pp.w;
                        *(f32x4*)(rowp + bj * HALF + n * 16) = o; } }
    } };
struct EpiBf16 { static constexpr bool PERM = true; bf16_t* O; int ldc;
    DEVI void operator()(const f32x4 (&acc)[2][2][4][2], const Unit& u, int wr, int wc, int fr, int fq) const {
        const int row0 = u.row0 + wr * 64 + fr, col0 = u.pn * BM + wc * 32 + 8 * fq;
#pragma unroll
        for (int ai = 0; ai < 2; ++ai)
#pragma unroll
            for (int m = 0; m < 4; ++m) { bf16_t* rowp = O + (size_t)(row0 + ai * HALF + m * 16) * ldc + col0;
#pragma unroll
                for (int bj = 0; bj < 2; ++bj) { const f32x4 v0 = acc[ai][bj][m][0], v1 = acc[ai][bj][m][1];
                    u32x4 w; w.x = cvt_pk_bf16(v0[0], v0[1]); w.y = cvt_pk_bf16(v0[2], v0[3]); w.z = cvt_pk_bf16(v1[0], v1[1]); w.w = cvt_pk_bf16(v1[2], v1[3]);
                    *(u32x4*)(rowp + bj * HALF) = w; } }
    } };
struct EpiSwiglu { static constexpr bool PERM = true; bf16_t* O; int ldc;
    DEVI void operator()(const f32x4 (&acc)[2][2][4][2], const Unit& u, int wr, int wc, int fr, int fq) const {
        const int row0 = u.row0 + wr * 64 + fr, col0 = u.pn * HALF + wc * 32 + 8 * fq;
#pragma unroll
        for (int ai = 0; ai < 2; ++ai)
#pragma unroll
            for (int m = 0; m < 4; ++m) { bf16_t* rowp = O + (size_t)(row0 + ai * HALF + m * 16) * ldc + col0;
                const f32x4 g0 = acc[ai][0][m][0], g1 = acc[ai][0][m][1], u0 = acc[ai][1][m][0], u1 = acc[ai][1][m][1];
                u32x4 w; w.x = cvt_pk_bf16(silu_f(g0[0]) * u0[0], silu_f(g0[1]) * u0[1]); w.y = cvt_pk_bf16(silu_f(g0[2]) * u0[2], silu_f(g0[3]) * u0[3]);
                w.z = cvt_pk_bf16(silu_f(g1[0]) * u1[0], silu_f(g1[1]) * u1[1]); w.w = cvt_pk_bf16(silu_f(g1[2]) * u1[2], silu_f(g1[3]) * u1[3]);
                *(u32x4*)rowp = w; }
    } };
struct EpiMoeDown { static constexpr bool PERM = true; bf16_t* Y; const int* list; const float* gatev;
    DEVI void operator()(const f32x4 (&acc)[2][2][4][2], const Unit& u, int wr, int wc, int fr, int fq) const {
        const int col0 = u.pn * BM + wc * 32 + 8 * fq;
        const int mbase = u.mbase;
#pragma unroll
        for (int ai = 0; ai < 2; ++ai)
#pragma unroll
            for (int m = 0; m < 4; ++m) { const int rl = wr * 64 + fr + ai * HALF + m * 16;
                if (rl < u.mvalid) {
                    const int tsl = list[u.e * MT + mbase + rl]; const float gt = gatev[u.e * MT + mbase + rl];
                    bf16_t* rowp = Y + (size_t)(tsl & 1) * ((size_t)MT * DM) + (size_t)(tsl >> 1) * DM + col0;
#pragma unroll
                    for (int bj = 0; bj < 2; ++bj) { const f32x4 v0 = acc[ai][bj][m][0], v1 = acc[ai][bj][m][1];
                        u32x4 w; w.x = cvt_pk_bf16(v0[0] * gt, v0[1] * gt); w.y = cvt_pk_bf16(v0[2] * gt, v0[3] * gt); w.z = cvt_pk_bf16(v1[0] * gt, v1[1] * gt); w.w = cvt_pk_bf16(v1[2] * gt, v1[3] * gt);
                        *(u32x4*)(rowp + bj * HALF) = w; } } }
    } };

template <class Epi, class Sched>
DEVI void gemm_phase(LAS unsigned char* lds, const bf16_t* A, const int K, const Sched& S, const Epi& E) {
    const int tid = opq((int)threadIdx.x), wid = __builtin_amdgcn_readfirstlane(tid >> 6), lane = tid & 63, wr = wid >> 2, wc = wid & 3, fr = lane & 15, fq = lane >> 4;
    const int nt = K / BK;
    int Rl[2], Cl[2]; unsigned voffB[2];
#pragma unroll
    for (int i = 0; i < 2; ++i) { int R, C; stage_rc(tid * 16 + i * 8192, R, C); Rl[i] = R; Cl[i] = C; const int Rb = Epi::PERM ? ((R & ~31) + perm32(R & 31)) : R; voffB[i] = (unsigned)(Rb * K + C) * 2u; }
    const size_t kstep = (size_t)(BK * 2);
    const size_t hstep = (size_t)HALF * K * 2;
    const unsigned ldsw = (unsigned)wid * 1024u;
    const int aoff = lds_byte(wr * 64 + fr, fq * 8), boff = lds_byte(wc * 32 + fr, fq * 8);
#define PG8_SA(b, h) (((b) * 2 + (h)) * HTB)
#define PG8_SB(b, h) ((4 + (b) * 2 + (h)) * HTB)
#define PG8_STAGE(bufoff, gbase, voff) do { _Pragma("unroll") for (int _i = 0; _i < 2; ++_i) \
        __builtin_amdgcn_global_load_lds((const unsigned*)((const char*)(gbase) + (voff)[_i]), (LAS unsigned*)(lds + (bufoff) + ldsw + _i * 8192), 16, 0, 0); } while (0)
#define PG8_LDA(dst, b, h) do { _Pragma("unroll") for (int m = 0; m < 4; ++m) _Pragma("unroll") for (int k = 0; k < 2; ++k) dst[m][k] = *(const LAS bf16x8*)(lds + PG8_SA(b, h) + aoff + m * 2048 + k * 1024); } while (0)
#define PG8_LDB(dst, b, h) do { _Pragma("unroll") for (int n = 0; n < 2; ++n) _Pragma("unroll") for (int k = 0; k < 2; ++k) dst[n][k] = *(const LAS bf16x8*)(lds + PG8_SB(b, h) + boff + n * 2048 + k * 1024); } while (0)
#define PG8_MMA(ai, bj, At, Bt) do { __builtin_amdgcn_s_setprio(1); _Pragma("unroll") for (int m = 0; m < 4; ++m) _Pragma("unroll") for (int n = 0; n < 2; ++n) _Pragma("unroll") for (int k = 0; k < 2; ++k) \
        acc[ai][bj][m][n] = __builtin_amdgcn_mfma_f32_16x16x32_bf16(Bt[n][k], At[m][k], acc[ai][bj][m][n], 0, 0, 0); __builtin_amdgcn_s_setprio(0); } while (0)
#define PG8_WAIT_V(n) asm volatile("s_waitcnt vmcnt(" #n ")" ::: "memory")
#define PG8_WAIT_L(n) asm volatile("s_waitcnt lgkmcnt(" #n ")" ::: "memory")
#define PG8_BAR __builtin_amdgcn_s_barrier()
#define PG8_SCHED __builtin_amdgcn_sched_barrier(0)
    Unit cur, nxt; int ui = 0;
    if (!S.next(0, cur)) return;
    f32x4 acc[2][2][4][2];
#pragma unroll
    for (int a = 0; a < 2; ++a)
#pragma unroll
        for (int b = 0; b < 2; ++b)
#pragma unroll
            for (int m = 0; m < 4; ++m)
#pragma unroll
                for (int n = 0; n < 2; ++n) acc[a][b][m][n] = (f32x4){0.f, 0.f, 0.f, 0.f};
    bf16x8 At[4][2], B0[2][2], B1[2][2];
    unsigned oc[2][2], on[2][2];
#pragma unroll
    for (int h = 0; h < 2; ++h)
#pragma unroll
        for (int i = 0; i < 2; ++i) oc[h][i] = ((unsigned)S.arow(cur, h * HALF + Rl[i]) * (unsigned)K + (unsigned)Cl[i]) * 2u;
    if (Sched::GATHER) { asm volatile("s_waitcnt vmcnt(0)" ::: "memory"); asm volatile("" : "+v"(oc[0][0]), "+v"(oc[0][1]), "+v"(oc[1][0]), "+v"(oc[1][1])); }
    const char* const Ab = (const char*)A;
    const char* cB = cur.B;
    PG8_STAGE(PG8_SB(0, 0), cB, voffB); PG8_STAGE(PG8_SA(0, 0), Ab, oc[0]); PG8_STAGE(PG8_SB(0, 1), cB + hstep, voffB); PG8_STAGE(PG8_SA(0, 1), Ab, oc[1]);
    if (wr == 1) PG8_BAR;
    PG8_WAIT_V(4); PG8_BAR;
    PG8_STAGE(PG8_SB(1, 0), cB + kstep, voffB); PG8_STAGE(PG8_SA(1, 0), Ab + kstep, oc[0]); PG8_STAGE(PG8_SB(1, 1), cB + hstep + kstep, voffB);
    PG8_WAIT_V(6); PG8_BAR;
    for (;;) {
        const bool has_next = S.next(ui + 1, nxt);
        if (has_next) {
#pragma unroll
            for (int h = 0; h < 2; ++h)
#pragma unroll
                for (int i = 0; i < 2; ++i) on[h][i] = ((unsigned)S.arow(nxt, h * HALF + Rl[i]) * (unsigned)K + (unsigned)Cl[i]) * 2u;
            if (Sched::GATHER) { asm volatile("s_waitcnt vmcnt(0)" ::: "memory"); asm volatile("" : "+v"(on[0][0]), "+v"(on[0][1]), "+v"(on[1][0]), "+v"(on[1][1])); }
        } else {
#pragma unroll
            for (int h = 0; h < 2; ++h)
#pragma unroll
                for (int i = 0; i < 2; ++i) on[h][i] = oc[h][i];
        }
        const char* nB = has_next ? nxt.B : cB;
        for (int t = 0; t < nt; t += 2) {
            const bool last = (t == nt - 2);
            const char* a1 = Ab + (size_t)(t + 1) * kstep;
            const char* a2 = last ? Ab : Ab + (size_t)(t + 2) * kstep; const char* b2 = last ? nB : cB + (size_t)(t + 2) * kstep;
            const char* a3 = a2 + kstep; const char* b3 = b2 + kstep;
            unsigned o2[2][2];
#pragma unroll
            for (int h = 0; h < 2; ++h)
#pragma unroll
                for (int i = 0; i < 2; ++i) o2[h][i] = last ? on[h][i] : oc[h][i];
            PG8_LDB(B0, 0, 0); PG8_SCHED; PG8_LDA(At, 0, 0); PG8_STAGE(PG8_SA(1, 1), a1, oc[1]);
            PG8_WAIT_L(8); PG8_BAR; PG8_WAIT_L(0); PG8_MMA(0, 0, At, B0); PG8_BAR; PG8_SCHED;
            PG8_LDB(B1, 0, 1); PG8_STAGE(PG8_SB(0, 0), b2, voffB);
            PG8_BAR; PG8_WAIT_L(0); PG8_MMA(0, 1, At, B1); PG8_BAR;
            PG8_LDA(At, 0, 1); PG8_STAGE(PG8_SA(0, 0), a2, o2[0]);
            PG8_BAR; PG8_WAIT_L(0); PG8_MMA(1, 0, At, B0); PG8_BAR; PG8_SCHED;
            PG8_STAGE(PG8_SB(0, 1), b2 + hstep, voffB);
            PG8_WAIT_V(6); PG8_BAR; PG8_MMA(1, 1, At, B1); PG8_BAR;
            PG8_LDB(B0, 1, 0); PG8_SCHED; PG8_LDA(At, 1, 0); PG8_STAGE(PG8_SA(0, 1), a2, o2[1]);
            PG8_WAIT_L(8); PG8_BAR; PG8_WAIT_L(0); PG8_MMA(0, 0, At, B0); PG8_BAR; PG8_SCHED;
            PG8_LDB(B1, 1, 1); PG8_STAGE(PG8_SB(1, 0), b3, voffB);
            PG8_BAR; PG8_WAIT_L(0); PG8_MMA(0, 1, At, B1); PG8_BAR;
            PG8_LDA(At, 1, 1); PG8_STAGE(PG8_SA(1, 0), a3, o2[0]);
            PG8_BAR; PG8_WAIT_L(0); PG8_MMA(1, 0, At, B0); PG8_BAR; PG8_SCHED;
            PG8_STAGE(PG8_SB(1, 1), b3 + hstep, voffB);
            PG8_WAIT_V(6); PG8_BAR; PG8_MMA(1, 1, At, B1); PG8_BAR;
        }
        E(acc, cur, wr, wc, fr, fq);
        if (!has_next) break;
#pragma unroll
        for (int a = 0; a < 2; ++a)
#pragma unroll
            for (int b = 0; b < 2; ++b)
#pragma unroll
                for (int m = 0; m < 4; ++m)
#pragma unroll
                    for (int n = 0; n < 2; ++n) acc[a][b][m][n] = (f32x4){0.f, 0.f, 0.f, 0.f};
        cur = nxt; cB = nB; ++ui;
#pragma unroll
        for (int h = 0; h < 2; ++h)
#pragma unroll
            for (int i = 0; i < 2; ++i) oc[h][i] = on[h][i];
    }
    PG8_WAIT_V(0);
    if (wr == 0) PG8_BAR;
    PG8_BAR;
#undef PG8_SA
#undef PG8_SB
#undef PG8_STAGE
#undef PG8_LDA
#undef PG8_LDB
#undef PG8_MMA
#undef PG8_WAIT_V
#undef PG8_WAIT_L
#undef PG8_BAR
#undef PG8_SCHED
}
}

DEVI float lb_of(const float* lbraw, int ch) {
    const float r0 = lbraw[ch], r1 = lbraw[512 + ch], r2 = lbraw[1024 + ch];
    const float mx = fmaxf(r0, fmaxf(r1, r2));
    const float e0 = __expf(r0 - mx), e1 = __expf(r1 - mx), e2 = __expf(r2 - mx);
    return e0 / (e0 + e1 + e2);
}
DEVI void ph_hgrn_naive(float* lds, const bf16_t* u, const float* lbraw, float* oacc, int vb0, int vbs) {
    float* sq = lds; float* sk = lds + 2048; float* sf = lds + 4096; float* sv = lds + 6144;
    const int tid = opq((int)threadIdx.x), j = tid >> 2, kq = tid & 3;
    for (int vb = vb0; vb < 32; vb += vbs) {
        const int dir = vb & 1, h = (vb >> 1) & 3, b = vb >> 3;
        float st[32];
#pragma unroll
        for (int i = 0; i < 32; ++i) st[i] = 0.f;
        for (int tb = 0; tb < SEQ / 16; ++tb) {
            __syncthreads();
            for (int e = tid; e < 2048; e += NTHR) {
                const int i = e >> 7, c = e & 127;
                const int t = dir ? (SEQ - 1 - (tb * 16 + i)) : (tb * 16 + i);
                const bf16_t* ur = u + (size_t)(b * SEQ + t) * UW;
                const int ch = h * 128 + c;
                const float qr = bf2f(ur[ch]), fr = bf2f(ur[(dir ? 1024 : 512) + ch]), vr = bf2f(ur[1536 + ch]);
                const float lb = lb_of(lbraw, ch);
                const float f = lb + (1.f - lb) * sigmoid_f(fr);
                sq[e] = silu_f(qr); sk[e] = 1.f - f; sf[e] = f; sv[e] = vr;
            }
            __syncthreads();
            for (int i = 0; i < 16; ++i) {
                const float vj = sv[i * 128 + j]; float acc = 0.f;
#pragma unroll
                for (int kk = 0; kk < 32; ++kk) {
                    const int kidx = kk * 4 + kq;
                    st[kk] = sf[i * 128 + kidx] * st[kk] + sk[i * 128 + kidx] * vj;
                    acc += st[kk] * sq[i * 128 + kidx];
                }
                acc += __shfl_xor(acc, 1); acc += __shfl_xor(acc, 2);
                if (kq == 0) {
                    const int t = dir ? (SEQ - 1 - (tb * 16 + i)) : (tb * 16 + i);
                    atomicAdd(&oacc[(size_t)(b * SEQ + t) * DM + h * 128 + j], acc);
                }
            }
        }
    }
    __syncthreads();
}

DEVI void ph_conv_naive(const bf16_t* u, const float* cw, const float* cb, bf16_t* xconv, int vb0, int vbs) {
    for (size_t e = (size_t)vb0 * NTHR + opq((int)threadIdx.x); e < (size_t)MT * 1024; e += (size_t)vbs * NTHR) {
        const int c = (int)(e & 1023); const int tok = (int)(e >> 10); const int t = tok & (SEQ - 1);
        float acc = cb[c];
#pragma unroll
        for (int j = 0; j < 5; ++j) { const int tt = t + j - 2; if (tt >= 0 && tt < SEQ) acc += bf2f(u[(size_t)(tok + j - 2) * UW + 3072 + c]) * cw[j * 1024 + c]; }
        xconv[e] = f2bf(silu_f(acc));
    }
}
DEVI void ph_ssd_naive(float* lds, const float* dtraw, const bf16_t* xconv, const float* A_log, const float* dt_bias, float* oacc, int vb0, int vbs) {
    float* sx = lds; float* sB = lds + 1024; float* sC = lds + 1024 + 2048; float* sdt = lds + 1024 + 4096;
    const int tid = opq((int)threadIdx.x), p = tid >> 3, nq = tid & 7;
    for (int vb = vb0; vb < 64; vb += vbs) {
        const int dir = vb & 1, hd = (vb >> 1) & 7, b = vb >> 4, g = hd >> 2;
        const float A = -__expf(A_log[dir * 8 + hd]); const float dtb = dt_bias[dir * 8 + hd];
        float st[16];
#pragma unroll
        for (int i = 0; i < 16; ++i) st[i] = 0.f;
        for (int tb = 0; tb < SEQ / 16; ++tb) {
            __syncthreads();
            for (int e = tid; e < 2048; e += NTHR) {
                const int i = e >> 7, n = e & 127;
                const int t = dir ? (SEQ - 1 - (tb * 16 + i)) : (tb * 16 + i);
                const bf16_t* xr = xconv + (size_t)(b * SEQ + t) * 1024;
                sB[e] = bf2f(xr[512 + g * 128 + n]); sC[e] = bf2f(xr[768 + g * 128 + n]);
                if (e < 1024) { const int i2 = e >> 6, pp = e & 63; const int t2 = dir ? (SEQ - 1 - (tb * 16 + i2)) : (tb * 16 + i2); sx[e] = bf2f(xconv[(size_t)(b * SEQ + t2) * 1024 + hd * 64 + pp]); }
                if (e < 16) { const int t3 = dir ? (SEQ - 1 - (tb * 16 + e)) : (tb * 16 + e); sdt[e] = softplus_f(dtraw[(size_t)(b * SEQ + t3) * 16 + dir * 8 + hd] + dtb); }
            }
            __syncthreads();
            for (int i = 0; i < 16; ++i) {
                const float dt = sdt[i]; const float a = __expf(dt * A); const float xv = sx[i * 64 + p] * dt; float acc = 0.f;
#pragma unroll
                for (int nn = 0; nn < 16; ++nn) { const int n = nn * 8 + nq; st[nn] = a * st[nn] + xv * sB[i * 128 + n]; acc += st[nn] * sC[i * 128 + n]; }
                acc += __shfl_xor(acc, 1); acc += __shfl_xor(acc, 2); acc += __shfl_xor(acc, 4);
                if (nq == 0) {
                    const int t = dir ? (SEQ - 1 - (tb * 16 + i)) : (tb * 16 + i);
                    atomicAdd(&oacc[(size_t)(b * SEQ + t) * DM + 512 + hd * 64 + p], acc);
                }
            }
        }
    }
    __syncthreads();
}
DEVI void ph_mixfin_naive(const bf16_t* u, const bf16_t* xconv, const float* oacc, const float* a_norm, const float* b_norm, const float* Dskip, bf16_t* ocat, int vb0, int vbs) {
    const int tidq = opq((int)threadIdx.x); const int wid = tidq >> 6, lane = tidq & 63;
    for (int row = vb0 * 8 + wid; row < MT; row += vbs * 8) {
        const int c0 = lane * 16; float v[16]; float ss = 0.f;
        const bf16_t* ur = u + (size_t)row * UW;
        if (lane < 32) {
#pragma unroll
            for (int i = 0; i < 16; ++i) { v[i] = oacc[(size_t)row * DM + c0 + i]; ss += v[i] * v[i]; }
        } else {
#pragma unroll
            for (int i = 0; i < 16; ++i) { const int cc = c0 - 512 + i;
                float y = oacc[(size_t)row * DM + 512 + cc] + Dskip[cc >> 6] * bf2f(xconv[(size_t)row * 1024 + cc]);
                y *= silu_f(bf2f(ur[2560 + cc])); v[i] = y; ss += y * y; }
        }
        ss += __shfl_xor(ss, 1); ss += __shfl_xor(ss, 2); ss += __shfl_xor(ss, 4);
        const float s8 = ss + __shfl_xor(ss, 8);
        if (lane < 32) {
            const float r = rsqrtf(ss * (1.f / 128.f) + EPS);
#pragma unroll
            for (int i = 0; i < 16; ++i) { const int c = c0 + i; v[i] = v[i] * r * a_norm[c & 127] * silu_f(bf2f(ur[2048 + c])); }
        } else {
            const float r = rsqrtf(s8 * (1.f / 256.f) + EPS);
#pragma unroll
            for (int i = 0; i < 16; ++i) { const int cc = c0 - 512 + i; v[i] = v[i] * r * b_norm[cc]; }
        }
#pragma unroll
        for (int i = 0; i < 16; ++i) ocat[(size_t)row * DM + c0 + i] = f2bf(v[i]);
    }
}

DEVI void ph_na_naive(const bf16_t* qkv, const float* rpb, bf16_t* oc, int vb0, int vbs) {
    for (int e4 = vb0 * NTHR + opq((int)threadIdx.x); e4 < MT * 16 * 4; e4 += vbs * NTHR) {
        const int dq = e4 & 3, e = e4 >> 2;
        const int hd = e / MT, tok = e % MT;
        const int b = tok >> 12, t = tok & 4095, r = t >> 6, c = t & 63;
        const int rs = min(max(r - 4, 0), 56), qs = min(max(c - 8, 0), 48);
        float q[16], o[16];
        const bf16_t* qp = qkv + (size_t)tok * 3072 + hd * 64 + dq * 16;
#pragma unroll
        for (int d = 0; d < 16; ++d) { q[d] = bf2f(qp[d]); o[d] = 0.f; }
        float m = -1e30f, l = 0.f;
        for (int dr = 0; dr < 8; ++dr)
            for (int dc = 0; dc < 16; ++dc) {
                const int kr = rs + dr, kc = qs + dc;
                const size_t kt = (size_t)b * SEQ + kr * 64 + kc;
                const bf16_t* kp = qkv + kt * 3072 + 1024 + hd * 64 + dq * 16;
                const bf16_t* vp = qkv + kt * 3072 + 2048 + hd * 64 + dq * 16;
                float s = 0.f;
#pragma unroll
                for (int d = 0; d < 16; ++d) s += q[d] * bf2f(kp[d]);
                s += __shfl_xor(s, 1); s += __shfl_xor(s, 2);
                s = s * 0.125f + rpb[hd * 465 + (kr - r + 7) * 31 + (kc - c + 15)];
                const float mn = fmaxf(m, s); const float al = __expf(m - mn), pe = __expf(s - mn);
                l = l * al + pe; m = mn;
#pragma unroll
                for (int d = 0; d < 16; ++d) o[d] = o[d] * al + pe * bf2f(vp[d]);
            }
        const float il = 1.f / l;
        bf16_t* op = oc + (size_t)tok * DM + hd * 64 + dq * 16;
#pragma unroll
        for (int d = 0; d < 16; ++d) op[d] = f2bf(o[d] * il);
    }
}

#define XB_TMO      128
#define XB_XCNT(j)  (256  + 64 * (j))
#define XB_XSUB(j)  (1280 + 64 * (j))
#define XB_XGEN(j)  (2304 + 64 * (j))
#define XB_TOP      3328
#define XB_TOPGEN   3392
#define XCD_BAR_WORDS 3456
#define XB_SPIN_CAP (1u << 18)

__device__ __forceinline__ unsigned xb_ld(unsigned* p)              { return __hip_atomic_load(p, __ATOMIC_RELAXED, __HIP_MEMORY_SCOPE_AGENT); }
__device__ __forceinline__ unsigned xb_add(unsigned* p, unsigned v) { return __hip_atomic_fetch_add(p, v, __ATOMIC_RELAXED, __HIP_MEMORY_SCOPE_AGENT); }
__device__ __forceinline__ unsigned xb_xcc_id() { return (unsigned)__builtin_amdgcn_s_getreg((3 << 11) | 20) & 0xFu; }
#define XB_SPIN(cond, bar) do { unsigned _sp = 0; while (cond) { __builtin_amdgcn_s_sleep(1); \
    if ((++_sp & 255u) == 0u) { if (xb_ld(&(bar)[XB_TMO])) break; if (_sp > XB_SPIN_CAP) { atomicAdd(&(bar)[XB_TMO], 1u); break; } } } } while (0)

struct XcdBarrier {
    unsigned* bar; unsigned x;
    volatile LAS unsigned* st;
};

__device__ __forceinline__ XcdBarrier xcd_barrier_post(unsigned* bar, volatile LAS unsigned* st) {
    XcdBarrier b; b.bar = bar; b.x = xb_xcc_id(); b.st = st;
    if (threadIdx.x == 0) (void)xb_add(&bar[XB_XCNT(b.x)], 1u);
    return b;
}
__device__ __forceinline__ void xcd_barrier_complete(unsigned* bar, unsigned x, unsigned& nloc, unsigned& nx) {
    const unsigned G = gridDim.x * gridDim.y * gridDim.z;
    unsigned sum, cnt, mine, sp = 0u;
    for (;;) {
        sum = 0u; cnt = 0u; mine = 0u;
#pragma unroll
        for (unsigned j = 0; j < 16; ++j) { const unsigned c = xb_ld(&bar[XB_XCNT(j)]); sum += c; cnt += (c > 0u) ? 1u : 0u; mine = (j == x) ? c : mine; }
        if (sum == G) break;
        __builtin_amdgcn_s_sleep(1);
        if ((++sp & 255u) == 0u) { if (xb_ld(&bar[XB_TMO])) break; if (sp > XB_SPIN_CAP) { atomicAdd(&bar[XB_TMO], 1u); break; } }
    }
    nloc = mine > 0u ? mine : 1u; nx = cnt > 0u ? cnt : 1u;
}

__device__ __forceinline__ void xcd_barrier(const XcdBarrier& b) {
    asm volatile("s_waitcnt vmcnt(0)" ::: "memory");
    __syncthreads();
    if (threadIdx.x == 0) {
        unsigned* bar = b.bar;
        __builtin_amdgcn_s_waitcnt(0);
        unsigned nloc = b.st[0], nx = b.st[1];
        if (nloc == 0u) { xcd_barrier_complete(bar, b.x, nloc, nx); b.st[0] = nloc; b.st[1] = nx; }
        const unsigned old = xb_add(&bar[XB_XSUB(b.x)], 1u);
        const unsigned gen = old / nloc;
        if (old + 1u == (gen + 1u) * nloc) {
            __builtin_amdgcn_fence(__ATOMIC_RELEASE, "agent");
            asm volatile("s_waitcnt vmcnt(0)" ::: "memory");
            const unsigned og = xb_add(&bar[XB_TOP], 1u);
            const unsigned tg = og / nx;
            if (og + 1u == (tg + 1u) * nx) xb_add(&bar[XB_TOPGEN], 1u);
            else XB_SPIN(xb_ld(&bar[XB_TOPGEN]) == tg, bar);
            __builtin_amdgcn_fence(__ATOMIC_ACQUIRE, "agent");
            xb_add(&bar[XB_XGEN(b.x)], 1u);
            asm volatile("s_waitcnt vmcnt(0)" ::: "memory");
        } else {
            XB_SPIN(xb_ld(&bar[XB_XGEN(b.x)]) == gen, bar);
            __builtin_amdgcn_fence(__ATOMIC_ACQUIRE, "agent");
            asm volatile("s_waitcnt vmcnt(0)" ::: "memory");
        }
    }
    __syncthreads();
}


struct Args { const float* in[34]; float* out; unsigned char* ws; int ph_lo, ph_hi; };
constexpr int N_PHASES = 21;

__global__ void __launch_bounds__(NTHR, 2) fwd(Args a) {
    extern __shared__ __attribute__((aligned(16))) unsigned char lds_raw[];
    float* lds = (float*)lds_raw;
    LAS unsigned char* ldsl = (LAS unsigned char*)lds_raw;
    const int vb0 = blockIdx.x, vbs = gridDim.x;
    const int lo = a.ph_lo, hi = a.ph_hi;
#define IN(k) (lo <= (k) && (k) < hi)
#define SEAM(k) do { if (IN(k) && IN((k) + 1)) xcd_barrier(bar); } while (0)
    volatile LAS unsigned* misc = (volatile LAS unsigned*)(ldsl + MISC_OFF);
    if (threadIdx.x < 4) misc[threadIdx.x] = 0u;
    __syncthreads();
    XcdBarrier bar = xcd_barrier_post((unsigned*)(a.ws + WS_CTL) + CW_BAR, misc);
    unsigned char* ws = a.ws;
    unsigned* ctl = (unsigned*)(ws + WS_CTL);
    unsigned* cnt = ctl + CW_CNT;
    int* list = (int*)(ws + WS_LIST); float* gatev = (float*)(ws + WS_GATE);
    float* dtraw = (float*)(ws + WS_DT);
    bf16_t* HB = (bf16_t*)(ws + WS_HB); bf16_t* UB = (bf16_t*)(ws + WS_UB);
    float* T1 = (float*)(ws + WS_T1); float* T2 = (float*)(ws + WS_T2);
    bf16_t* T2b = (bf16_t*)(ws + WS_T2);
    bf16_t* PB0 = (bf16_t*)(ws + WS_PB0); bf16_t* PB1 = (bf16_t*)(ws + WS_PB1);
    bf16_t* YB = (bf16_t*)(ws + WS_Y);
    float* X = a.out;
    const float* x_in = a.in[0]; const float* p_in = a.in[1];
    const int G = (int)gridDim.x, cb = (int)blockIdx.x;

    if (IN(0)) {
        ph_convert_weights(ldsl, a.in, ws, vb0, vbs);
        NormA A{x_in, X, nullptr, nullptr, nullptr, a.in[3], HB, a.in[4], dtraw, nullptr, nullptr, nullptr, nullptr};
        ph_norm<0, true, true, false>(A, vb0, vbs);
        for (size_t e = (size_t)vb0 * NTHR + threadIdx.x; e < (size_t)MT * DM / 4; e += (size_t)vbs * NTHR) ((float4*)T1)[e] = make_float4(0.f, 0.f, 0.f, 0.f);
    }
    SEAM(0);
    if (IN(1)) { pg8::DenseOrder S; S.init(MT, UW, DM, (const bf16_t*)(ws + W_IN), G, cb); pg8::gemm_phase(ldsl, HB, DM, S, pg8::EpiBf16{UB, UW}); }
    SEAM(1);
    if (IN(2)) { ph_conv_naive(UB, a.in[5], a.in[6], HB, vb0, vbs); ph_hgrn_naive(lds, UB, a.in[2], T1, vb0, vbs); }
    SEAM(2);
    if (IN(3)) { ph_ssd_naive(lds, dtraw, HB, a.in[7], a.in[8], T1, vb0, vbs); }
    SEAM(3);
    if (IN(4)) { ph_mixfin_naive(UB, HB, T1, a.in[10], a.in[11], a.in[9], T2b, vb0, vbs); }
    SEAM(4);
    if (IN(5)) { pg8::DenseOrder S; S.init(MT, DM, DM, (const bf16_t*)(ws + W_OUTE), G, cb); pg8::gemm_phase(ldsl, T2b, DM, S, pg8::EpiF32{T1, DM}); }
    SEAM(5);
    if (IN(6)) {
        NormA A{X, X, T1, nullptr, a.in[13], a.in[14], HB, nullptr, nullptr, nullptr, nullptr, nullptr, nullptr};
        ph_norm<1, true, false, false>(A, vb0, vbs);
        ph_cvt_rows(p_in, PB0, (size_t)MT * PDIM / 4, vb0, vbs);
    }
    SEAM(6);
    if (IN(7)) { pg8::DenseOrder S; S.init(MT, 2 * DFF, DM, (const bf16_t*)(ws + W_GU), G, cb); pg8::gemm_phase(ldsl, HB, DM, S, pg8::EpiSwiglu{UB, DFF}); }
    SEAM(7);
    if (IN(8)) { pg8::DenseOrder S; S.init(MT, DM, DFF, (const bf16_t*)(ws + W_DN), G, cb); pg8::gemm_phase(ldsl, UB, DFF, S, pg8::EpiF32{T1, DM}); }
    SEAM(8);
    if (IN(9)) {
        { pg8::DenseOrder S; S.init(MT, DM, PDIM, (const bf16_t*)(ws + W_PP), G, cb); pg8::gemm_phase(ldsl, PB0, PDIM, S, pg8::EpiF32{T2, DM}); }
        NormA A{X, X, T1, nullptr, a.in[18], a.in[30], HB, nullptr, nullptr, nullptr, nullptr, nullptr, nullptr};
        ph_norm<1, true, false, false>(A, vb0, vbs);
    }
    SEAM(9);
    if (IN(10)) { pg8::DenseOrder S; S.init(MT, DM, DM, (const bf16_t*)(ws + W_PG), G, cb); pg8::gemm_phase(ldsl, HB, DM, S, pg8::EpiPleGate{T2, DM}); }
    SEAM(10);
    if (IN(11)) {
        NormA A{X, X, T2, nullptr, a.in[33], a.in[19], HB, nullptr, nullptr, nullptr, nullptr, nullptr, nullptr};
        ph_norm<1, true, false, false>(A, vb0, vbs);
    }
    SEAM(11);
    if (IN(12)) { pg8::DenseOrder S; S.init(MT, 3072, DM, (const bf16_t*)(ws + W_QKV), G, cb); pg8::gemm_phase(ldsl, HB, DM, S, pg8::EpiBf16{UB, 3072}); }
    SEAM(12);
    if (IN(13)) { ph_na_naive(UB, a.in[21], T2b, vb0, vbs); }
    SEAM(13);
    if (IN(14)) { pg8::DenseOrder S; S.init(MT, DM, DM, (const bf16_t*)(ws + W_OUTO), G, cb); pg8::gemm_phase(ldsl, T2b, DM, S, pg8::EpiF32{T1, DM}); }
    SEAM(14);
    if (IN(15)) {
        NormA A{X, X, T1, nullptr, a.in[23], a.in[24], HB, nullptr, nullptr, a.in[25], cnt, list, gatev};
        ph_norm<1, true, false, true>(A, vb0, vbs);
        ph_cvt_rows(p_in + (size_t)MT * PDIM, PB1, (size_t)MT * PDIM / 4, vb0, vbs);
    }
    SEAM(15);
    if (IN(16)) { pg8::MoeOrder S; S.init(cnt, (volatile LAS int*)(ldsl + MISC_OFF + 64), 2 * DFFE, DM, (const bf16_t*)(ws + W_EGU), (size_t)14 * MiB, list, true, G, cb); pg8::gemm_phase(ldsl, HB, DM, S, pg8::EpiSwiglu{UB, DFFE}); }
    SEAM(16);
    if (IN(17)) { pg8::MoeOrder S; S.init(cnt, (volatile LAS int*)(ldsl + MISC_OFF + 64), DM, DFFE, (const bf16_t*)(ws + W_EDN), (size_t)7 * MiB, list, false, G, cb); pg8::gemm_phase(ldsl, UB, DFFE, S, pg8::EpiMoeDown{YB, list, gatev}); }
    SEAM(17);
    if (IN(18)) {
        { pg8::DenseOrder S; S.init(MT, DM, PDIM, (const bf16_t*)(ws + W_PP + 512 * 1024), G, cb); pg8::gemm_phase(ldsl, PB1, PDIM, S, pg8::EpiF32{T1, DM}); }
        NormA A{X, X, nullptr, YB, a.in[29], a.in[30] + DM, HB, nullptr, nullptr, nullptr, nullptr, nullptr, nullptr};
        ph_norm<2, true, false, false>(A, vb0, vbs);
    }
    SEAM(18);
    if (IN(19)) { pg8::DenseOrder S; S.init(MT, DM, DM, (const bf16_t*)(ws + W_PG + 2 * MiB), G, cb); pg8::gemm_phase(ldsl, HB, DM, S, pg8::EpiPleGate{T1, DM}); }
    SEAM(19);
    if (IN(20)) {
        NormA A{X, X, T1, nullptr, a.in[33] + DM, nullptr, nullptr, nullptr, nullptr, nullptr, nullptr, nullptr, nullptr};
        ph_norm<1, false, false, false>(A, vb0, vbs);
    }
#undef IN
#undef SEAM
}

extern "C" void kernel_launch(void* const* d_in, const int* in_sizes, int n_in, void* d_out, int out_size, void* d_ws, size_t ws_size, hipStream_t stream) {
    static int grid = 0;
    if (grid == 0) {
        if (n_in != 34 || out_size != MT * DM || ws_size < WS_END) { fprintf(stderr, "kernel_launch: unexpected shapes n_in %d out %d ws %zu (need %zu)\n", n_in, out_size, ws_size, (size_t)WS_END); grid = -1; return; }
        int dev = 0, cus = 0;
        if (hipGetDevice(&dev) != hipSuccess || hipDeviceGetAttribute(&cus, hipDeviceAttributeMultiprocessorCount, dev) != hipSuccess) { grid = -1; return; }
        if (hipFuncSetAttribute((const void*)fwd, hipFuncAttributeMaxDynamicSharedMemorySize, LDS_BYTES) != hipSuccess) { fprintf(stderr, "hipFuncSetAttribute failed\n"); grid = -1; return; }
        (void)hipGetLastError();
        grid = cus;
    }
    if (grid < 0) return;
    (void)hipMemsetAsync((char*)d_ws + WS_CTL, 0, CTL_ZERO_BYTES, stream);
    Args a{};
    for (int i = 0; i < 34; ++i) a.in[i] = (const float*)d_in[i];
    a.out = (float*)d_out; a.ws = (unsigned char*)d_ws;
#ifndef MK_PER_PHASE
    a.ph_lo = 0; a.ph_hi = N_PHASES;
    hipLaunchKernelGGL(fwd, dim3(grid), dim3(NTHR), LDS_BYTES, stream, a);
#else
    for (int ph = 0; ph < N_PHASES; ++ph) {
        a.ph_lo = ph; a.ph_hi = ph + 1;
        hipLaunchKernelGGL(fwd, dim3(grid), dim3(NTHR), LDS_BYTES, stream, a);
    }
#endif
}
```

```cpp
#include <hip/hip_runtime.h>
#include <stdint.h>
#include <stdio.h>

#define DEVI __device__ __forceinline__
#define LAS __attribute__((address_space(3)))
typedef unsigned short bf16_t;

constexpr int NB = 4, SEQ = 4096, DM = 1024, MT = NB * SEQ;
constexpr int EVEN_IN = 4112, UW = 4096, DFF = 2816, NEXP = 8, DFFE = 3584, PDIM = 256;
constexpr float EPS = 1e-6f;
constexpr int NTHR = 512;
constexpr int LDS_BYTES = 147456;
constexpr int MISC_OFF = 131072 + 320;
constexpr int MOE_ROWS = 2 * MT + NEXP * 256;

constexpr size_t MiB = 1u << 20;
constexpr size_t WS_CTL = 0, CTL_ZERO_BYTES = 1 * MiB;
constexpr size_t WS_LIST = 1 * MiB;
constexpr size_t WS_GATE = WS_LIST + 512 * 1024;
constexpr size_t WS_DT = 2 * MiB;
constexpr size_t WS_W = 3 * MiB;
constexpr size_t W_IN = WS_W, W_OUTE = W_IN + 8 * MiB, W_GU = W_OUTE + 2 * MiB, W_DN = W_GU + 11 * MiB, W_PG = W_DN + 6 * MiB, W_PP = W_PG + 4 * MiB,
                 W_QKV = W_PP + 1 * MiB, W_OUTO = W_QKV + 6 * MiB, W_EGU = W_OUTO + 2 * MiB, W_EDN = W_EGU + 112 * MiB, W_END = W_EDN + 56 * MiB;
constexpr size_t WS_HB = W_END;
constexpr size_t WS_R = WS_HB + 32 * MiB;
constexpr size_t WS_UB = WS_R;
constexpr size_t WS_PB0 = WS_R + 88 * MiB;
constexpr size_t WS_T1 = WS_R + 128 * MiB;
constexpr size_t WS_T2 = WS_T1 + 64 * MiB;
constexpr size_t WS_PB1 = WS_R + 240 * MiB;
constexpr size_t WS_END = WS_T2 + 64 * MiB;
constexpr size_t WS_Y = W_EGU;
constexpr size_t WS_MS = W_EGU;
constexpr size_t WS_HS = W_EGU + 64 * MiB;
constexpr size_t WS_XT = W_EDN;
constexpr size_t WS_VT = W_EDN + 24 * MiB;
constexpr size_t WS_MD = W_EDN + 40 * MiB;
constexpr size_t WS_HD = W_EDN + 41 * MiB;
static_assert(WS_R + (size_t)MOE_ROWS * DFFE * 2 <= WS_PB1 && WS_PB1 + 8 * MiB <= WS_END && WS_END <= 510 * MiB, "ws map");
constexpr int CW_CNT = 64;
constexpr int CW_BAR = 4096;

DEVI int opq(int x) { asm volatile("" : "+v"(x)); return x; }
DEVI float bf2f(bf16_t b) { return __uint_as_float(((unsigned)b) << 16); }
DEVI bf16_t f2bf(float f) { unsigned u = __float_as_uint(f); u += 0x7FFFu + ((u >> 16) & 1u); return (bf16_t)(u >> 16); }
DEVI float silu_f(float x) { return x / (1.f + __expf(-x)); }
DEVI float sigmoid_f(float x) { return 1.f / (1.f + __expf(-x)); }
DEVI float softplus_f(float x) { return x > 20.f ? x : log1pf(__expf(x)); }
DEVI float wave_sum(float v) {
#pragma unroll
    for (int o = 1; o < 64; o <<= 1) v += __shfl_xor(v, o);
    return v;
}


typedef short bf16x8 __attribute__((ext_vector_type(8)));
typedef float f32x4 __attribute__((ext_vector_type(4)));
typedef unsigned u32x4 __attribute__((ext_vector_type(4)));
typedef unsigned u32x2 __attribute__((ext_vector_type(2)));
DEVI unsigned pk2(float lo, float hi) { return (unsigned)f2bf(lo) | ((unsigned)f2bf(hi) << 16); }
DEVI float bflo(unsigned w) { return __uint_as_float(w << 16); }
DEVI float bfhi(unsigned w) { return __uint_as_float(w & 0xffff0000u); }

struct NormA { const float* xsrc; float* xdst; const float* y; const bf16_t* yb; const float* gpost; const float* gnext; bf16_t* hout;
               const float* win; float* dtraw; const float* wr; unsigned* cnt; int* list; float* gatev; };
template <int YMODE, bool HOUT, bool DT, bool ROUTE>
DEVI void ph_norm(const NormA& A, int vb0, int vbs) {
    const int tidq = opq((int)threadIdx.x); const int wid = tidq >> 6, lane = tidq & 63;
    for (int row = vb0 * 8 + wid; row < MT; row += vbs * 8) {
        float4 xv[4];
#pragma unroll
        for (int i = 0; i < 4; ++i) xv[i] = *(const float4*)(A.xsrc + (size_t)row * DM + i * 256 + lane * 4);
        if (YMODE != 0) {
            float4 yv[4]; float ss = 0.f;
#pragma unroll
            for (int i = 0; i < 4; ++i) {
                if (YMODE == 1) yv[i] = *(const float4*)(A.y + (size_t)row * DM + i * 256 + lane * 4);
                else { const u32x2 a = *(const u32x2*)(A.yb + (size_t)row * DM + i * 256 + lane * 4), b = *(const u32x2*)(A.yb + (size_t)MT * DM + (size_t)row * DM + i * 256 + lane * 4);
                       yv[i].x = bflo(a.x) + bflo(b.x); yv[i].y = bfhi(a.x) + bfhi(b.x); yv[i].z = bflo(a.y) + bflo(b.y); yv[i].w = bfhi(a.y) + bfhi(b.y); }
                ss += yv[i].x * yv[i].x + yv[i].y * yv[i].y + yv[i].z * yv[i].z + yv[i].w * yv[i].w;
            }
            ss = wave_sum(ss);
            const float r = rsqrtf(ss * (1.f / DM) + EPS);
#pragma unroll
            for (int i = 0; i < 4; ++i) {
                const float4 g = *(const float4*)(A.gpost + i * 256 + lane * 4);
                xv[i].x += yv[i].x * r * g.x; xv[i].y += yv[i].y * r * g.y; xv[i].z += yv[i].z * r * g.z; xv[i].w += yv[i].w * r * g.w;
            }
        }
#pragma unroll
        for (int i = 0; i < 4; ++i) *(float4*)(A.xdst + (size_t)row * DM + i * 256 + lane * 4) = xv[i];
        if (HOUT) {
            float ss = 0.f;
#pragma unroll
            for (int i = 0; i < 4; ++i) ss += xv[i].x * xv[i].x + xv[i].y * xv[i].y + xv[i].z * xv[i].z + xv[i].w * xv[i].w;
            ss = wave_sum(ss);
            const float r = rsqrtf(ss * (1.f / DM) + EPS);
            float4 hv[4];
#pragma unroll
            for (int i = 0; i < 4; ++i) {
                const float4 g = *(const float4*)(A.gnext + i * 256 + lane * 4);
                hv[i].x = xv[i].x * r * g.x; hv[i].y = xv[i].y * r * g.y; hv[i].z = xv[i].z * r * g.z; hv[i].w = xv[i].w * r * g.w;
                u32x2 o; o.x = pk2(hv[i].x, hv[i].y); o.y = pk2(hv[i].z, hv[i].w);
                *(u32x2*)(A.hout + (size_t)row * DM + i * 256 + lane * 4) = o;
            }
            if (DT) {
                float d[16];
#pragma unroll
                for (int j = 0; j < 16; ++j) d[j] = 0.f;
#pragma unroll
                for (int i = 0; i < 4; ++i) {
                    const float hh[4] = {hv[i].x, hv[i].y, hv[i].z, hv[i].w};
#pragma unroll
                    for (int q = 0; q < 4; ++q) {
                        const float* wp = A.win + (size_t)(i * 256 + lane * 4 + q) * EVEN_IN + 4096;
#pragma unroll
                        for (int j4 = 0; j4 < 4; ++j4) { const float4 w = *(const float4*)(wp + j4 * 4);
                            d[j4 * 4 + 0] += hh[q] * w.x; d[j4 * 4 + 1] += hh[q] * w.y; d[j4 * 4 + 2] += hh[q] * w.z; d[j4 * 4 + 3] += hh[q] * w.w; }
                    }
                }
#pragma unroll
                for (int j = 0; j < 16; ++j) d[j] = wave_sum(d[j]);
                if (lane == 0) {
#pragma unroll
                    for (int j4 = 0; j4 < 4; ++j4) *(float4*)(A.dtraw + (size_t)row * 16 + j4 * 4) = make_float4(d[j4 * 4], d[j4 * 4 + 1], d[j4 * 4 + 2], d[j4 * 4 + 3]);
                }
            }
            if (ROUTE) {
                float lg[8];
#pragma unroll
                for (int e = 0; e < 8; ++e) lg[e] = 0.f;
#pragma unroll
                for (int i = 0; i < 4; ++i) {
                    const float hh[4] = {hv[i].x, hv[i].y, hv[i].z, hv[i].w};
#pragma unroll
                    for (int q = 0; q < 4; ++q) {
                        const float* wp = A.wr + (size_t)(i * 256 + lane * 4 + q) * 8;
                        const float4 w0 = *(const float4*)wp, w1 = *(const float4*)(wp + 4);
                        lg[0] += hh[q] * w0.x; lg[1] += hh[q] * w0.y; lg[2] += hh[q] * w0.z; lg[3] += hh[q] * w0.w;
                        lg[4] += hh[q] * w1.x; lg[5] += hh[q] * w1.y; lg[6] += hh[q] * w1.z; lg[7] += hh[q] * w1.w;
                    }
                }
#pragma unroll
                for (int e = 0; e < 8; ++e) lg[e] = wave_sum(lg[e]);
                if (lane == 0) {
                    int e1 = 0; float v1 = lg[0];
#pragma unroll
                    for (int e = 1; e < 8; ++e) if (lg[e] > v1) { v1 = lg[e]; e1 = e; }
                    int e2 = 0; float v2 = -3.0e38f;
#pragma unroll
                    for (int e = 0; e < 8; ++e) if (e != e1 && lg[e] > v2) { v2 = lg[e]; e2 = e; }
                    const float ex = __expf(v2 - v1); const float w1 = 1.f / (1.f + ex), w2 = ex / (1.f + ex);
                    const int p1 = (int)atomicAdd(&A.cnt[e1], 1u); A.list[e1 * MT + p1] = row * 2; A.gatev[e1 * MT + p1] = w1;
                    const int p2 = (int)atomicAdd(&A.cnt[e2], 1u); A.list[e2 * MT + p2] = row * 2 + 1; A.gatev[e2 * MT + p2] = w2;
                }
            }
        }
    }
}

DEVI void transpose_item(const float* W, int ldw, int K, int k0, int n0, bf16_t* WT, int drow0, LAS float* scr, int lane) {
#pragma unroll 8
    for (int i = 0; i < 32; ++i) { const int kk = 2 * i + (lane >> 5); scr[kk * 33 + (lane & 31)] = W[(size_t)(k0 + kk) * ldw + n0 + (lane & 31)]; }
    asm volatile("s_waitcnt lgkmcnt(0)" ::: "memory");
    const int c = lane & 7;
#pragma unroll
    for (int j = 0; j < 4; ++j) { const int n = (lane >> 3) + 8 * j; const LAS float* sp = scr + (8 * c) * 33 + n;
        u32x4 o; o.x = pk2(sp[0 * 33], sp[1 * 33]); o.y = pk2(sp[2 * 33], sp[3 * 33]); o.z = pk2(sp[4 * 33], sp[5 * 33]); o.w = pk2(sp[6 * 33], sp[7 * 33]);
        *(u32x4*)(WT + (size_t)(drow0 + n) * K + k0 + 8 * c) = o; }
    asm volatile("s_waitcnt lgkmcnt(0)" ::: "memory");
}
struct Job { int in_idx; unsigned src_off; int ldw; int K; int ncols; unsigned long long dst; int mode; int item0; };
constexpr int NJOBS = 11 + 24;
struct JobTable { Job j[NJOBS]; int total; };
constexpr JobTable make_jobs() {
    JobTable t{}; int n = 0, it = 0;
    auto add = [&](int idx, unsigned off, int ldw, int K, int ncols, unsigned long long dst, int mode) { t.j[n] = Job{idx, off, ldw, K, ncols, dst, mode, it}; it += (K / 64) * (ncols / 32); ++n; };
    add(4, 0, EVEN_IN, DM, UW, W_IN, 0);
    add(12, 0, DM, DM, DM, W_OUTE, 0);
    add(15, 0, DFF, DM, DFF, W_GU, 1);
    add(16, 0, DFF, DM, DFF, W_GU, 2);
    add(17, 0, DM, DFF, DM, W_DN, 0);
    add(31, 0, DM, DM, DM, W_PG, 0);
    add(31, DM * DM, DM, DM, DM, W_PG + 2 * MiB, 0);
    add(32, 0, DM, PDIM, DM, W_PP, 0);
    add(32, PDIM * DM, DM, PDIM, DM, W_PP + 512 * 1024, 0);
    add(20, 0, 3072, DM, 3072, W_QKV, 0);
    add(22, 0, DM, DM, DM, W_OUTO, 0);
    for (int e = 0; e < NEXP; ++e) {
        add(26, (unsigned)e * DM * DFFE, DFFE, DM, DFFE, W_EGU + (unsigned long long)e * 14 * MiB, 1);
        add(27, (unsigned)e * DM * DFFE, DFFE, DM, DFFE, W_EGU + (unsigned long long)e * 14 * MiB, 2);
        add(28, (unsigned)e * DFFE * DM, DM, DFFE, DM, W_EDN + (unsigned long long)e * 7 * MiB, 0);
    }
    t.total = it; return t;
}
__device__ const JobTable g_jobs = make_jobs();
constexpr int ITEMS_DENSE = make_jobs().j[11].item0, ITEMS_ALL = make_jobs().total;
DEVI void ph_convert_weights(LAS unsigned char* lds, const float* const* in, unsigned char* ws, int it_lo, int it_hi, int vb0, int vbs) {
    const int tidq = opq((int)threadIdx.x); const int wid = __builtin_amdgcn_readfirstlane(tidq >> 6), lane = tidq & 63;
    LAS float* scr = (LAS float*)(lds + wid * 16384);
    int jb = 0;
    for (int it = it_lo + vb0 * 8 + wid; it < it_hi; it += vbs * 8) {
        while (jb + 1 < NJOBS && g_jobs.j[jb + 1].item0 <= it) ++jb;
        const Job J = g_jobs.j[jb];
        const int r = it - J.item0; const int nblk = J.ncols / 32; const int kb = r / nblk, nb = r % nblk;
        const int n0 = nb * 32; int drow0 = n0;
        if (J.mode != 0) drow0 = (n0 >> 7) * 256 + (n0 & 127) + (J.mode == 2 ? 128 : 0);
        transpose_item(in[J.in_idx] + J.src_off, J.ldw, J.K, kb * 64, n0, (bf16_t*)(ws + J.dst), drow0, scr, lane);
    }
}
DEVI void ph_cvt_rows(const float* src, bf16_t* dst, size_t n4, int vb0, int vbs) {
    for (size_t e = (size_t)vb0 * NTHR + opq((int)threadIdx.x); e < n4; e += (size_t)vbs * NTHR) {
        const float4 v = ((const float4*)src)[e]; u32x2 o; o.x = pk2(v.x, v.y); o.y = pk2(v.z, v.w); ((u32x2*)dst)[e] = o; }
}

namespace pg8 {
constexpr int BM = 256, BK = 64, HALF = 128, HTB = HALF * BK * 2, STAGE_BYTES = 8 * HTB, NXCD = 8, WGM = 8;
__host__ __device__ __forceinline__ int lds_byte(int r, int c) { const int st = (r >> 4) * 2 + (c >> 5), rr = r & 15, cc = c & 31, ob = rr * 64 + cc * 2; return st * 1024 + (ob ^ (((ob >> 9) & 1) << 5)); }
__host__ __device__ __forceinline__ void stage_rc(int b, int& R, int& C) { const int st = b / 1024, sb = b % 1024, swz = sb ^ (((sb >> 9) & 1) << 5); R = (st >> 1) * 16 + swz / 64; C = (st & 1) * 32 + (swz % 64) / 2; }
__host__ __device__ __forceinline__ int perm32(int rho) { const int n = rho >> 4, i = rho & 15; return 8 * (i >> 2) + 4 * n + (i & 3); }
struct Unit { int pm, pn; int row0; int mvalid; int e; int mbase; const char* B; };
DEVI void xcd_tile(int L, int nwg, int nM, int nN, int& pm, int& pn) {
    int wgid = L; { const int q = nwg / NXCD, r = nwg % NXCD, xcd = wgid % NXCD, off = wgid / NXCD; wgid = (xcd < r ? xcd * (q + 1) : r * (q + 1) + (xcd - r) * q) + off; }
    const int nig = WGM * nN, gid = wgid / nig, fm = gid * WGM, gsz = (nM - fm) < WGM ? (nM - fm) : WGM;
    pm = fm + ((wgid % nig) % gsz); pn = (wgid % nig) / gsz;
}
struct DenseOrder {
    static constexpr bool GATHER = false;
    int nM, nN, nwg, G, c; const char* Bt; size_t tstepB;
    DEVI void init(int M, int N, int K, const bf16_t* Bt_, int G_, int c_) { nM = M / BM; nN = N / BM; nwg = nM * nN; G = G_; c = c_; Bt = (const char*)Bt_; tstepB = (size_t)BM * K * 2; }
    DEVI bool next(int i, Unit& u) const { const long L = (long)i * G + c; if (L >= nwg) return false; xcd_tile((int)L, nwg, nM, nN, u.pm, u.pn); u.row0 = u.pm * BM; u.mvalid = BM; u.e = 0; u.mbase = 0; u.B = Bt + (size_t)u.pn * tstepB; return true; }
    DEVI int arow(const Unit& u, int r) const { return u.row0 + r; }
};
struct MoeOrder {
    int nM, nN, nwg, G, c; const char* Bt; size_t estepB, tstepB; const volatile LAS int* tab; const int* list; bool gather;
    static constexpr bool GATHER = true;
    DEVI void init(const unsigned* cnt, volatile LAS int* tab_, int N, int K, const bf16_t* Bt_, size_t estep_bytes, const int* list_, bool gather_, int G_, int c_) {
        __syncthreads();
        if (threadIdx.x == 0) { int t = 0;
            for (int e = 0; e < 8; ++e) { const int n = (int)__hip_atomic_load(cnt + e, __ATOMIC_RELAXED, __HIP_MEMORY_SCOPE_AGENT); tab_[16 + e] = n; tab_[e] = t; t += (n + BM - 1) / BM; }
            tab_[8] = t; }
        __syncthreads();
        tab = tab_; nM = __builtin_amdgcn_readfirstlane(tab_[8]); nN = N / BM; nwg = nM * nN; G = G_; c = c_; Bt = (const char*)Bt_; estepB = estep_bytes; tstepB = (size_t)BM * K * 2; list = list_; gather = gather_;
    }
    DEVI bool next(int i, Unit& u) const { const long L = (long)i * G + c; if (L >= nwg) return false; xcd_tile((int)L, nwg, nM, nN, u.pm, u.pn);
        int e = 0;
        for (int k = 1; k < 8; ++k) if (u.pm >= __builtin_amdgcn_readfirstlane(tab[k])) e = k;
        const int t0 = __builtin_amdgcn_readfirstlane(tab[e]), n = __builtin_amdgcn_readfirstlane(tab[16 + e]);
        u.e = e; u.row0 = u.pm * BM; const int m0 = (u.pm - t0) * BM; u.mbase = m0; u.mvalid = (n - m0) < BM ? (n - m0) : BM; u.B = Bt + (size_t)e * estepB + (size_t)u.pn * tstepB; return true; }
    DEVI int arow(const Unit& u, int r) const {
        if (!gather) return u.row0 + r;
        const int m = u.mbase + r;
        return (r < u.mvalid) ? (list[u.e * MT + m] >> 1) : 0;
    }
};
DEVI unsigned cvt_pk_bf16(float lo, float hi) { unsigned r; asm volatile("v_cvt_pk_bf16_f32 %0, %1, %2" : "=v"(r) : "v"(lo), "v"(hi)); return r; }

struct EpiF32 { static constexpr bool PERM = false; float* C; int ldc;
    DEVI void operator()(const f32x4 (&acc)[2][2][4][2], const Unit& u, int wr, int wc, int fr, int fq) const {
        const int row0 = u.row0 + wr * 64 + fr, col0 = u.pn * BM + wc * 32 + 4 * fq;
#pragma unroll
        for (int ai = 0; ai < 2; ++ai)
#pragma unroll
            for (int m = 0; m < 4; ++m) { float* rowp = C + (size_t)(row0 + ai * HALF + m * 16) * ldc + col0;
#pragma unroll
                for (int bj = 0; bj < 2; ++bj)
#pragma unroll
                    for (int n = 0; n < 2; ++n) *(f32x4*)(rowp + bj * HALF + n * 16) = acc[ai][bj][m][n]; }
    } };
struct EpiPleGate { static constexpr bool PERM = false; float* C; int ldc;
    DEVI void operator()(const f32x4 (&acc)[2][2][4][2], const Unit& u, int wr, int wc, int fr, int fq) const {
        const int row0 = u.row0 + wr * 64 + fr, col0 = u.pn * BM + wc * 32 + 4 * fq;
#pragma unroll
        for (int ai = 0; ai < 2; ++ai)
#pragma unroll
            for (int m = 0; m < 4; ++m) { float* rowp = C + (size_t)(row0 + ai * HALF + m * 16) * ldc + col0;
#pragma unroll
                for (int bj = 0; bj < 2; ++bj)
#pragma unroll
                    for (int n = 0; n < 2; ++n) { const f32x4 pp = *(const f32x4*)(rowp + bj * HALF + n * 16); const f32x4 a = acc[ai][bj][m][n]; f32x4 o;
                        o.x = sigmoid_f(a.x) * pp.x; o.y = sigmoid_f(a.y) * pp.y; o.z = sigmoid_f(a.z) * pp.z; o.w = sigmoid_f(a.w) * pp.w;
                        *(f32x4*)(rowp + bj * HALF + n * 16) = o; } }
    } };
struct EpiBf16 { static constexpr bool PERM = true; bf16_t* O; int ldc;
    DEVI void operator()(const f32x4 (&acc)[2][2][4][2], const Unit& u, int wr, int wc, int fr, int fq) const {
        const int row0 = u.row0 + wr * 64 + fr, col0 = u.pn * BM + wc * 32 + 8 * fq;
#pragma unroll
        for (int ai = 0; ai < 2; ++ai)
#pragma unroll
            for (int m = 0; m < 4; ++m) { bf16_t* rowp = O + (size_t)(row0 + ai * HALF + m * 16) * ldc + col0;
#pragma unroll
                for (int bj = 0; bj < 2; ++bj) { const f32x4 v0 = acc[ai][bj][m][0], v1 = acc[ai][bj][m][1];
                    u32x4 w; w.x = cvt_pk_bf16(v0[0], v0[1]); w.y = cvt_pk_bf16(v0[2], v0[3]); w.z = cvt_pk_bf16(v1[0], v1[1]); w.w = cvt_pk_bf16(v1[2], v1[3]);
                    *(u32x4*)(rowp + bj * HALF) = w; } }
    } };
struct EpiSwiglu { static constexpr bool PERM = true; bf16_t* O; int ldc;
    DEVI void operator()(const f32x4 (&acc)[2][2][4][2], const Unit& u, int wr, int wc, int fr, int fq) const {
        const int row0 = u.row0 + wr * 64 + fr, col0 = u.pn * HALF + wc * 32 + 8 * fq;
#pragma unroll
        for (int ai = 0; ai < 2; ++ai)
#pragma unroll
            for (int m = 0; m < 4; ++m) { bf16_t* rowp = O + (size_t)(row0 + ai * HALF + m * 16) * ldc + col0;
                const f32x4 g0 = acc[ai][0][m][0], g1 = acc[ai][0][m][1], u0 = acc[ai][1][m][0], u1 = acc[ai][1][m][1];
                u32x4 w; w.x = cvt_pk_bf16(silu_f(g0[0]) * u0[0], silu_f(g0[1]) * u0[1]); w.y = cvt_pk_bf16(silu_f(g0[2]) * u0[2], silu_f(g0[3]) * u0[3]);
                w.z = cvt_pk_bf16(silu_f(g1[0]) * u1[0], silu_f(g1[1]) * u1[1]); w.w = cvt_pk_bf16(silu_f(g1[2]) * u1[2], silu_f(g1[3]) * u1[3]);
                *(u32x4*)rowp = w; }
    } };
struct EpiMoeDown { static constexpr bool PERM = true; bf16_t* Y; const int* list; const float* gatev;
    DEVI void operator()(const f32x4 (&acc)[2][2][4][2], const Unit& u, int wr, int wc, int fr, int fq) const {
        const int col0 = u.pn * BM + wc * 32 + 8 * fq;
        const int mbase = u.mbase;
#pragma unroll
        for (int ai = 0; ai < 2; ++ai)
#pragma unroll
            for (int m = 0; m < 4; ++m) { const int rl = wr * 64 + fr + ai * HALF + m * 16;
                if (rl < u.mvalid) {
                    const int tsl = list[u.e * MT + mbase + rl]; const float gt = gatev[u.e * MT + mbase + rl];
                    bf16_t* rowp = Y + (size_t)(tsl & 1) * ((size_t)MT * DM) + (size_t)(tsl >> 1) * DM + col0;
#pragma unroll
                    for (int bj = 0; bj < 2; ++bj) { const f32x4 v0 = acc[ai][bj][m][0], v1 = acc[ai][bj][m][1];
                        u32x4 w; w.x = cvt_pk_bf16(v0[0] * gt, v0[1] * gt); w.y = cvt_pk_bf16(v0[2] * gt, v0[3] * gt); w.z = cvt_pk_bf16(v1[0] * gt, v1[1] * gt); w.w = cvt_pk_bf16(v1[2] * gt, v1[3] * gt);
                        *(u32x4*)(rowp + bj * HALF) = w; } } }
    } };

template <class Epi, class Sched>
DEVI void gemm_phase(LAS unsigned char* lds, const bf16_t* A, const int K, const Sched& S, const Epi& E) {
    const int tid = opq((int)threadIdx.x), wid = __builtin_amdgcn_readfirstlane(tid >> 6), lane = tid & 63, wr = wid >> 2, wc = wid & 3, fr = lane & 15, fq = lane >> 4;
    const int nt = K / BK;
    int Rl[2], Cl[2]; unsigned voffB[2];
#pragma unroll
    for (int i = 0; i < 2; ++i) { int R, C; stage_rc(tid * 16 + i * 8192, R, C); Rl[i] = R; Cl[i] = C; const int Rb = Epi::PERM ? ((R & ~31) + perm32(R & 31)) : R; voffB[i] = (unsigned)(Rb * K + C) * 2u; }
    const size_t kstep = (size_t)(BK * 2);
    const size_t hstep = (size_t)HALF * K * 2;
    const unsigned ldsw = (unsigned)wid * 1024u;
    const int aoff = lds_byte(wr * 64 + fr, fq * 8), boff = lds_byte(wc * 32 + fr, fq * 8);
#define PG8_SA(b, h) (((b) * 2 + (h)) * HTB)
#define PG8_SB(b, h) ((4 + (b) * 2 + (h)) * HTB)
#define PG8_STAGE(bufoff, gbase, voff) do { _Pragma("unroll") for (int _i = 0; _i < 2; ++_i) \
        __builtin_amdgcn_global_load_lds((const unsigned*)((const char*)(gbase) + (voff)[_i]), (LAS unsigned*)(lds + (bufoff) + ldsw + _i * 8192), 16, 0, 0); } while (0)
#define PG8_LDA(dst, b, h) do { _Pragma("unroll") for (int m = 0; m < 4; ++m) _Pragma("unroll") for (int k = 0; k < 2; ++k) dst[m][k] = *(const LAS bf16x8*)(lds + PG8_SA(b, h) + aoff + m * 2048 + k * 1024); } while (0)
#define PG8_LDB(dst, b, h) do { _Pragma("unroll") for (int n = 0; n < 2; ++n) _Pragma("unroll") for (int k = 0; k < 2; ++k) dst[n][k] = *(const LAS bf16x8*)(lds + PG8_SB(b, h) + boff + n * 2048 + k * 1024); } while (0)
#define PG8_MMA(ai, bj, At, Bt) do { __builtin_amdgcn_s_setprio(1); _Pragma("unroll") for (int m = 0; m < 4; ++m) _Pragma("unroll") for (int n = 0; n < 2; ++n) _Pragma("unroll") for (int k = 0; k < 2; ++k) \
        acc[ai][bj][m][n] = __builtin_amdgcn_mfma_f32_16x16x32_bf16(Bt[n][k], At[m][k], acc[ai][bj][m][n], 0, 0, 0); __builtin_amdgcn_s_setprio(0); } while (0)
#define PG8_WAIT_V(n) asm volatile("s_waitcnt vmcnt(" #n ")" ::: "memory")
#define PG8_WAIT_L(n) asm volatile("s_waitcnt lgkmcnt(" #n ")" ::: "memory")
#define PG8_BAR __builtin_amdgcn_s_barrier()
#define PG8_SCHED __builtin_amdgcn_sched_barrier(0)
    Unit cur, nxt; int ui = 0;
    if (!S.next(0, cur)) return;
    f32x4 acc[2][2][4][2];
#pragma unroll
    for (int a = 0; a < 2; ++a)
#pragma unroll
        for (int b = 0; b < 2; ++b)
#pragma unroll
            for (int m = 0; m < 4; ++m)
#pragma unroll
                for (int n = 0; n < 2; ++n) acc[a][b][m][n] = (f32x4){0.f, 0.f, 0.f, 0.f};
    bf16x8 At[4][2], B0[2][2], B1[2][2];
    unsigned oc[2][2], on[2][2];
#pragma unroll
    for (int h = 0; h < 2; ++h)
#pragma unroll
        for (int i = 0; i < 2; ++i) oc[h][i] = ((unsigned)S.arow(cur, h * HALF + Rl[i]) * (unsigned)K + (unsigned)Cl[i]) * 2u;
    if (Sched::GATHER) { asm volatile("s_waitcnt vmcnt(0)" ::: "memory"); asm volatile("" : "+v"(oc[0][0]), "+v"(oc[0][1]), "+v"(oc[1][0]), "+v"(oc[1][1])); }
    const char* const Ab = (const char*)A;
    const char* cB = cur.B;
    PG8_STAGE(PG8_SB(0, 0), cB, voffB); PG8_STAGE(PG8_SA(0, 0), Ab, oc[0]); PG8_STAGE(PG8_SB(0, 1), cB + hstep, voffB); PG8_STAGE(PG8_SA(0, 1), Ab, oc[1]);
    if (wr == 1) PG8_BAR;
    PG8_WAIT_V(4); PG8_BAR;
    PG8_STAGE(PG8_SB(1, 0), cB + kstep, voffB); PG8_STAGE(PG8_SA(1, 0), Ab + kstep, oc[0]); PG8_STAGE(PG8_SB(1, 1), cB + hstep + kstep, voffB);
    PG8_WAIT_V(6); PG8_BAR;
    for (;;) {
        const bool has_next = S.next(ui + 1, nxt);
        if (has_next) {
#pragma unroll
            for (int h = 0; h < 2; ++h)
#pragma unroll
                for (int i = 0; i < 2; ++i) on[h][i] = ((unsigned)S.arow(nxt, h * HALF + Rl[i]) * (unsigned)K + (unsigned)Cl[i]) * 2u;
            if (Sched::GATHER) { asm volatile("s_waitcnt vmcnt(0)" ::: "memory"); asm volatile("" : "+v"(on[0][0]), "+v"(on[0][1]), "+v"(on[1][0]), "+v"(on[1][1])); }
        } else {
#pragma unroll
            for (int h = 0; h < 2; ++h)
#pragma unroll
                for (int i = 0; i < 2; ++i) on[h][i] = oc[h][i];
        }
        const char* nB = has_next ? nxt.B : cB;
        for (int t = 0; t < nt; t += 2) {
            const bool last = (t == nt - 2);
            const char* a1 = Ab + (size_t)(t + 1) * kstep;
            const char* a2 = last ? Ab : Ab + (size_t)(t + 2) * kstep; const char* b2 = last ? nB : cB + (size_t)(t + 2) * kstep;
            const char* a3 = a2 + kstep; const char* b3 = b2 + kstep;
            unsigned o2[2][2];
#pragma unroll
            for (int h = 0; h < 2; ++h)
#pragma unroll
                for (int i = 0; i < 2; ++i) o2[h][i] = last ? on[h][i] : oc[h][i];
            PG8_LDB(B0, 0, 0); PG8_SCHED; PG8_LDA(At, 0, 0); PG8_STAGE(PG8_SA(1, 1), a1, oc[1]);
            PG8_WAIT_L(8); PG8_BAR; PG8_WAIT_L(0); PG8_MMA(0, 0, At, B0); PG8_BAR; PG8_SCHED;
            PG8_LDB(B1, 0, 1); PG8_STAGE(PG8_SB(0, 0), b2, voffB);
            PG8_BAR; PG8_WAIT_L(0); PG8_MMA(0, 1, At, B1); PG8_BAR;
            PG8_LDA(At, 0, 1); PG8_STAGE(PG8_SA(0, 0), a2, o2[0]);
            PG8_BAR; PG8_WAIT_L(0); PG8_MMA(1, 0, At, B0); PG8_BAR; PG8_SCHED;
            PG8_STAGE(PG8_SB(0, 1), b2 + hstep, voffB);
            PG8_WAIT_V(6); PG8_BAR; PG8_MMA(1, 1, At, B1); PG8_BAR;
            PG8_LDB(B0, 1, 0); PG8_SCHED; PG8_LDA(At, 1, 0); PG8_STAGE(PG8_SA(0, 1), a2, o2[1]);
            PG8_WAIT_L(8); PG8_BAR; PG8_WAIT_L(0); PG8_MMA(0, 0, At, B0); PG8_BAR; PG8_SCHED;
            PG8_LDB(B1, 1, 1); PG8_STAGE(PG8_SB(1, 0), b3, voffB);
            PG8_BAR; PG8_WAIT_L(0); PG8_MMA(0, 1, At, B1); PG8_BAR;
            PG8_LDA(At, 1, 1); PG8_STAGE(PG8_SA(1, 0), a3, o2[0]);
            PG8_BAR; PG8_WAIT_L(0); PG8_MMA(1, 0, At, B0); PG8_BAR; PG8_SCHED;
            PG8_STAGE(PG8_SB(1, 1), b3 + hstep, voffB);
            PG8_WAIT_V(6); PG8_BAR; PG8_MMA(1, 1, At, B1); PG8_BAR;
        }
        E(acc, cur, wr, wc, fr, fq);
        if (!has_next) break;
#pragma unroll
        for (int a = 0; a < 2; ++a)
#pragma unroll
            for (int b = 0; b < 2; ++b)
#pragma unroll
                for (int m = 0; m < 4; ++m)
#pragma unroll
                    for (int n = 0; n < 2; ++n) acc[a][b][m][n] = (f32x4){0.f, 0.f, 0.f, 0.f};
        cur = nxt; cB = nB; ++ui;
#pragma unroll
        for (int h = 0; h < 2; ++h)
#pragma unroll
            for (int i = 0; i < 2; ++i) oc[h][i] = on[h][i];
    }
    PG8_WAIT_V(0);
    if (wr == 0) PG8_BAR;
    PG8_BAR;
#undef PG8_SA
#undef PG8_SB
#undef PG8_STAGE
#undef PG8_LDA
#undef PG8_LDB
#undef PG8_MMA
#undef PG8_WAIT_V
#undef PG8_WAIT_L
#undef PG8_BAR
#undef PG8_SCHED
}
}

DEVI float lb_of(const float* lbraw, int ch) {
    const float r0 = lbraw[ch], r1 = lbraw[512 + ch], r2 = lbraw[1024 + ch];
    const float mx = fmaxf(r0, fmaxf(r1, r2));
    const float e0 = __expf(r0 - mx), e1 = __expf(r1 - mx), e2 = __expf(r2 - mx);
    return e0 / (e0 + e1 + e2);
}
DEVI void ph_hgrn_naive(float* lds, const bf16_t* u, const float* lbraw, float* oacc, int vb0, int vbs) {
    float* sq = lds; float* sk = lds + 2048; float* sf = lds + 4096; float* sv = lds + 6144;
    const int tid = opq((int)threadIdx.x), j = tid >> 2, kq = tid & 3;
    for (int vb = vb0; vb < 32; vb += vbs) {
        const int dir = vb & 1, h = (vb >> 1) & 3, b = vb >> 3;
        float st[32];
#pragma unroll
        for (int i = 0; i < 32; ++i) st[i] = 0.f;
        for (int tb = 0; tb < SEQ / 16; ++tb) {
            __syncthreads();
            for (int e = tid; e < 2048; e += NTHR) {
                const int i = e >> 7, c = e & 127;
                const int t = dir ? (SEQ - 1 - (tb * 16 + i)) : (tb * 16 + i);
                const bf16_t* ur = u + (size_t)(b * SEQ + t) * UW;
                const int ch = h * 128 + c;
                const float qr = bf2f(ur[ch]), fr = bf2f(ur[(dir ? 1024 : 512) + ch]), vr = bf2f(ur[1536 + ch]);
                const float lb = lb_of(lbraw, ch);
                const float f = lb + (1.f - lb) * sigmoid_f(fr);
                sq[e] = silu_f(qr); sk[e] = 1.f - f; sf[e] = f; sv[e] = vr;
            }
            __syncthreads();
            for (int i = 0; i < 16; ++i) {
                const float vj = sv[i * 128 + j]; float acc = 0.f;
#pragma unroll
                for (int kk = 0; kk < 32; ++kk) {
                    const int kidx = kk * 4 + kq;
                    st[kk] = sf[i * 128 + kidx] * st[kk] + sk[i * 128 + kidx] * vj;
                    acc += st[kk] * sq[i * 128 + kidx];
                }
                acc += __shfl_xor(acc, 1); acc += __shfl_xor(acc, 2);
                if (kq == 0) {
                    const int t = dir ? (SEQ - 1 - (tb * 16 + i)) : (tb * 16 + i);
                    atomicAdd(&oacc[(size_t)(b * SEQ + t) * DM + h * 128 + j], acc);
                }
            }
        }
    }
    __syncthreads();
}

DEVI void ph_mixfin_hgrn(const bf16_t* u, const float* oacc, const float* a_norm, bf16_t* ocat, int vb0, int vbs) {
    const int tidq = opq((int)threadIdx.x); const int hw = tidq >> 5, l32 = tidq & 31;
    for (int row = vb0 * 16 + hw; row < MT; row += vbs * 16) {
        const int c0 = l32 * 16; float v[16]; float ss = 0.f;
        const bf16_t* ur = u + (size_t)row * UW;
#pragma unroll
        for (int i = 0; i < 16; ++i) { v[i] = oacc[(size_t)row * DM + c0 + i]; ss += v[i] * v[i]; }
        ss += __shfl_xor(ss, 1); ss += __shfl_xor(ss, 2); ss += __shfl_xor(ss, 4);
        const float r = rsqrtf(ss * (1.f / 128.f) + EPS);
#pragma unroll
        for (int i = 0; i < 16; ++i) { const int c = c0 + i; ocat[(size_t)row * DM + c] = f2bf(v[i] * r * a_norm[c & 127] * silu_f(bf2f(ur[2048 + c]))); }
    }
}


constexpr int HQ = 0, HK = 17408, HKH = 34816, HV = 53248, HDV = 71680, HGL = 73728, HOT = 75776, H_END = HOT + 64 * 528;
static_assert(H_END <= 131072, "hgrn lds");
constexpr size_t HS_SCAN = (size_t)16 * 16384;
DEVI float hgrn_prep(LAS unsigned char* lds, const bf16_t* u, float lbv, int dir, size_t tokbase, int h, int c, int I) {
    float g[16], kk[16], qq[16];
    const bf16_t* up = u + (tokbase + 16 * I) * UW + h * 128 + c;
    const int fcol = dir ? 1024 : 512;
#pragma unroll
    for (int j = 0; j < 16; ++j) {
        const float fr = bf2f(up[(size_t)j * UW + fcol]), qr = bf2f(up[(size_t)j * UW]);
        const float f = lbv + (1.f - lbv) * sigmoid_f(fr);
        g[j] = __logf(f); kk[j] = 1.f - f; qq[j] = silu_f(qr);
    }
    float run = 0.f;
#pragma unroll
    for (int jj = 0; jj < 16; ++jj) { const int j = dir ? 15 - jj : jj; run += g[j]; g[j] = run; }
    const float G = run;
    float kh[16];
#pragma unroll
    for (int j = 0; j < 16; ++j) {
        const float qt = qq[j] * __expf(g[j]), kt = kk[j] * __expf(-g[j]);
        kh[j] = kk[j] * __expf(G - g[j]);
        *(LAS bf16_t*)(lds + HQ + (16 * I + j) * 272 + c * 2) = f2bf(qt);
        *(LAS bf16_t*)(lds + HK + (16 * I + j) * 272 + c * 2) = f2bf(kt);
    }
    u32x4 w0, w1;
    w0.x = pk2(kh[0], kh[1]); w0.y = pk2(kh[2], kh[3]); w0.z = pk2(kh[4], kh[5]); w0.w = pk2(kh[6], kh[7]);
    w1.x = pk2(kh[8], kh[9]); w1.y = pk2(kh[10], kh[11]); w1.z = pk2(kh[12], kh[13]); w1.w = pk2(kh[14], kh[15]);
    *(LAS u32x4*)(lds + HKH + c * 144 + I * 32) = w0; *(LAS u32x4*)(lds + HKH + c * 144 + I * 32 + 16) = w1;
    *(LAS float*)(lds + HDV + (I * 128 + c) * 4) = __expf(G);
    return G;
}
DEVI void hgrn_update(LAS unsigned char* lds, f32x4 (&Sacc)[8], int I, int wid, int fr, int fq) {
    const u32x4 z4 = {0u, 0u, 0u, 0u};
    const u32x4 vb = (fq < 2) ? *(const LAS u32x4*)(lds + HV + (16 * wid + fr) * 144 + (16 * I + 8 * fq) * 2) : z4;
#pragma unroll
    for (int m = 0; m < 8; ++m) {
        const f32x4 dv = *(const LAS f32x4*)(lds + HDV + (I * 128 + 16 * m + 4 * fq) * 4);
        const u32x4 ka = (fq < 2) ? *(const LAS u32x4*)(lds + HKH + (16 * m + fr) * 144 + (16 * I + 8 * fq) * 2) : z4;
        Sacc[m] = __builtin_amdgcn_mfma_f32_16x16x32_bf16(__builtin_bit_cast(bf16x8, ka), __builtin_bit_cast(bf16x8, vb), Sacc[m] * dv, 0, 0, 0);
    }
}
DEVI void stage_vt(LAS unsigned char* lds, const bf16_t* VT, int b, int h, int t0, int tid) {
    for (int e = tid; e < 128 * 8; e += NTHR) { const int r = e >> 3, cch = e & 7; *(LAS u32x4*)(lds + HV + r * 144 + cch * 16) = *(const u32x4*)(VT + ((size_t)b * 512 + h * 128 + r) * SEQ + t0 + cch * 8); }
}
DEVI void ph_hgrn_states(LAS unsigned char* lds, const bf16_t* u, const bf16_t* VT, const float* lbraw, float* HS, float* HD, int vb0, int vbs) {
    const int tid = opq((int)threadIdx.x), wid = __builtin_amdgcn_readfirstlane(tid >> 6), lane = tid & 63, fr = lane & 15, fq = lane >> 4;
    const int pc = tid & 127, pI = tid >> 7;
    for (int unit = vb0; unit < NB * 4 * 2 * 16; unit += vbs) {
        const int seg = unit & 15, dir = (unit >> 4) & 1, h = (unit >> 5) & 3, b = unit >> 7;
        const float lbv = lb_of(lbraw, h * 128 + pc);
        f32x4 Sacc[8];
#pragma unroll
        for (int m = 0; m < 8; ++m) Sacc[m] = (f32x4){0.f, 0.f, 0.f, 0.f};
        float gsum = 0.f;
#pragma unroll 1
        for (int sbi = 0; sbi < 4; ++sbi) {
            const int sb = dir ? 3 - sbi : sbi;
            const int t0 = seg * 256 + sb * 64;
            __syncthreads();
            const float G = hgrn_prep(lds, u, lbv, dir, (size_t)b * SEQ + t0, h, pc, pI);
            *(LAS float*)(lds + HGL + (pI * 128 + pc) * 4) = G;
            stage_vt(lds, VT, b, h, t0, tid);
            __syncthreads();
            if (tid < 128) gsum += *(const LAS float*)(lds + HGL + tid * 4) + *(const LAS float*)(lds + HGL + (128 + tid) * 4) + *(const LAS float*)(lds + HGL + (256 + tid) * 4) + *(const LAS float*)(lds + HGL + (384 + tid) * 4);
#pragma unroll 1
            for (int ii = 0; ii < 4; ++ii) { const int I = dir ? 3 - ii : ii; hgrn_update(lds, Sacc, I, wid, fr, fq); }
        }
        const size_t scan = (size_t)(b * 4 + h) * 2 + dir;
        float* dst = HS + scan * HS_SCAN + (size_t)seg * 16384;
#pragma unroll
        for (int m = 0; m < 8; ++m)
#pragma unroll
            for (int rg = 0; rg < 4; ++rg) dst[(16 * m + 4 * fq + rg) * 128 + 16 * wid + fr] = Sacc[m][rg];
        if (tid < 128) HD[(scan * 16 + seg) * 128 + tid] = __expf(gsum);
    }
    __syncthreads();
}
DEVI void ph_hgrn_scan(float* HS, const float* HD, int vb0, int vbs) {
    const int tid = opq((int)threadIdx.x);
    for (int idx = vb0 * NTHR + tid; idx < 32 * 4096; idx += vbs * NTHR) {
        const int scan = idx >> 12, e4 = idx & 4095, kch = e4 >> 5; const int dir = scan & 1;
        float4* base = (float4*)(HS + (size_t)scan * HS_SCAN) + e4;
        const float* hd = HD + (size_t)scan * 16 * 128 + kch;
        float4 st = make_float4(0.f, 0.f, 0.f, 0.f);
        for (int i = 0; i < 16; ++i) {
            const int sg = dir ? 15 - i : i;
            const float4 d = base[(size_t)sg * 4096]; const float dec = hd[sg * 128];
            base[(size_t)sg * 4096] = st;
            st.x = st.x * dec + d.x; st.y = st.y * dec + d.y; st.z = st.z * dec + d.z; st.w = st.w * dec + d.w;
        }
    }
}
DEVI void ph_hgrn_out(LAS unsigned char* lds, const bf16_t* u, const bf16_t* VT, const float* lbraw, const float* a_norm, const float* HS, float* OF, bf16_t* ocat, int vb0, int vbs) {
    const int tid = opq((int)threadIdx.x), wid = __builtin_amdgcn_readfirstlane(tid >> 6), lane = tid & 63, fr = lane & 15, fq = lane >> 4;
    const int pc = tid & 127, pI = tid >> 7;
    const int otok = tid >> 3, opart = tid & 7;
    for (int unit = vb0; unit < NB * 4 * 16; unit += vbs) {
        const int seg = unit & 15, h = (unit >> 4) & 3, b = unit >> 6;
        const float lbv = lb_of(lbraw, h * 128 + pc);
#pragma unroll 1
        for (int dir = 0; dir < 2; ++dir) {
            const size_t scan = (size_t)(b * 4 + h) * 2 + dir;
            const float* src = HS + scan * HS_SCAN + (size_t)seg * 16384;
            f32x4 Sacc[8];
#pragma unroll
            for (int m = 0; m < 8; ++m)
#pragma unroll
                for (int rg = 0; rg < 4; ++rg) Sacc[m][rg] = src[(16 * m + 4 * fq + rg) * 128 + 16 * wid + fr];
#pragma unroll 1
            for (int sbi = 0; sbi < 4; ++sbi) {
                const int sb = dir ? 3 - sbi : sbi;
                const int t0 = seg * 256 + sb * 64;
                const size_t tokb = (size_t)b * SEQ + t0;
                __syncthreads();
                (void)hgrn_prep(lds, u, lbv, dir, tokb, h, pc, pI);
                stage_vt(lds, VT, b, h, t0, tid);
                __syncthreads();
#pragma unroll 1
                for (int ii = 0; ii < 4; ++ii) {
                    const int I = dir ? 3 - ii : ii;
                    f32x4 oT = {0.f, 0.f, 0.f, 0.f};
                    const LAS unsigned char* qrow = lds + HQ + (16 * I + fr) * 272;
#pragma unroll
                    for (int ks = 0; ks < 4; ++ks) {
                        u32x4 sa; sa.x = pg8::cvt_pk_bf16(Sacc[2 * ks][0], Sacc[2 * ks][1]); sa.y = pg8::cvt_pk_bf16(Sacc[2 * ks][2], Sacc[2 * ks][3]);
                        sa.z = pg8::cvt_pk_bf16(Sacc[2 * ks + 1][0], Sacc[2 * ks + 1][1]); sa.w = pg8::cvt_pk_bf16(Sacc[2 * ks + 1][2], Sacc[2 * ks + 1][3]);
                        const u32x2 q0 = *(const LAS u32x2*)(qrow + (32 * ks + 4 * fq) * 2), q1 = *(const LAS u32x2*)(qrow + (32 * ks + 16 + 4 * fq) * 2);
                        u32x4 qb; qb.x = q0.x; qb.y = q0.y; qb.z = q1.x; qb.w = q1.y;
                        oT = __builtin_amdgcn_mfma_f32_16x16x32_bf16(__builtin_bit_cast(bf16x8, sa), __builtin_bit_cast(bf16x8, qb), oT, 0, 0, 0);
                    }
                    f32x4 sT = {0.f, 0.f, 0.f, 0.f};
                    const LAS unsigned char* krow = lds + HK + (16 * I + fr) * 272;
#pragma unroll
                    for (int ks = 0; ks < 4; ++ks) {
                        const bf16x8 ka = *(const LAS bf16x8*)(krow + (32 * ks + 8 * fq) * 2), qb = *(const LAS bf16x8*)(qrow + (32 * ks + 8 * fq) * 2);
                        sT = __builtin_amdgcn_mfma_f32_16x16x32_bf16(ka, qb, sT, 0, 0, 0);
                    }
                    float pv[4];
#pragma unroll
                    for (int rg = 0; rg < 4; ++rg) { const int sl = 4 * fq + rg; const bool ok = dir ? (sl >= fr) : (sl <= fr); pv[rg] = ok ? sT[rg] : 0.f; }
                    u32x4 pb; pb.x = pg8::cvt_pk_bf16(pv[0], pv[1]); pb.y = pg8::cvt_pk_bf16(pv[2], pv[3]); pb.z = 0u; pb.w = 0u;
                    const u32x2 v0 = *(const LAS u32x2*)(lds + HV + (16 * wid + fr) * 144 + (16 * I + 4 * fq) * 2);
                    u32x4 va; va.x = v0.x; va.y = v0.y; va.z = 0u; va.w = 0u;
                    oT = __builtin_amdgcn_mfma_f32_16x16x32_bf16(__builtin_bit_cast(bf16x8, va), __builtin_bit_cast(bf16x8, pb), oT, 0, 0, 0);
                    *(LAS f32x4*)(lds + HOT + (16 * I + fr) * 528 + (16 * wid + 4 * fq) * 4) = oT;
                    hgrn_update(lds, Sacc, I, wid, fr, fq);
                }
                __syncthreads();
                const LAS float* orow = (const LAS float*)(lds + HOT + otok * 528) + opart * 16;
                float* ofp = OF + (tokb + otok) * 512 + h * 128 + opart * 16;
                if (dir == 0) {
#pragma unroll
                    for (int q4 = 0; q4 < 4; ++q4) { const f32x4 v = *(const LAS f32x4*)(orow + q4 * 4);
                        __hip_atomic_store((unsigned long long*)(ofp + q4 * 4), (unsigned long long)__float_as_uint(v[0]) | ((unsigned long long)__float_as_uint(v[1]) << 32), __ATOMIC_RELAXED, __HIP_MEMORY_SCOPE_AGENT);
                        __hip_atomic_store((unsigned long long*)(ofp + q4 * 4 + 2), (unsigned long long)__float_as_uint(v[2]) | ((unsigned long long)__float_as_uint(v[3]) << 32), __ATOMIC_RELAXED, __HIP_MEMORY_SCOPE_AGENT); }
                } else {
                    float v[16]; float ss = 0.f;
#pragma unroll
                    for (int q2 = 0; q2 < 8; ++q2) { const unsigned long long w = __hip_atomic_load((unsigned long long*)(ofp + q2 * 2), __ATOMIC_RELAXED, __HIP_MEMORY_SCOPE_AGENT);
                        v[2 * q2] = __uint_as_float((unsigned)w) + orow[2 * q2]; v[2 * q2 + 1] = __uint_as_float((unsigned)(w >> 32)) + orow[2 * q2 + 1];
                        ss += v[2 * q2] * v[2 * q2] + v[2 * q2 + 1] * v[2 * q2 + 1]; }
                    ss += __shfl_xor(ss, 1); ss += __shfl_xor(ss, 2); ss += __shfl_xor(ss, 4);
                    const float rn = rsqrtf(ss * (1.f / 128.f) + EPS);
                    const bf16_t* gp = u + (tokb + otok) * UW + 2048 + h * 128 + opart * 16;
                    const u32x4 g0 = *(const u32x4*)gp, g1 = *(const u32x4*)(gp + 8);
                    const unsigned gw[8] = {g0.x, g0.y, g0.z, g0.w, g1.x, g1.y, g1.z, g1.w};
                    unsigned ow[8];
#pragma unroll
                    for (int q2 = 0; q2 < 8; ++q2) { const float an0 = a_norm[opart * 16 + 2 * q2], an1 = a_norm[opart * 16 + 2 * q2 + 1];
                        ow[q2] = pk2(v[2 * q2] * rn * an0 * silu_f(bflo(gw[q2])), v[2 * q2 + 1] * rn * an1 * silu_f(bfhi(gw[q2]))); }
                    bf16_t* op = ocat + (tokb + otok) * DM + h * 128 + opart * 16;
                    u32x4 o0, o1; o0.x = ow[0]; o0.y = ow[1]; o0.z = ow[2]; o0.w = ow[3]; o1.x = ow[4]; o1.y = ow[5]; o1.z = ow[6]; o1.w = ow[7];
                    *(u32x4*)op = o0; *(u32x4*)(op + 8) = o1;
                }
            }
            asm volatile("s_waitcnt vmcnt(0)" ::: "memory");
        }
    }
    __syncthreads();
}

DEVI void ph_prep(const bf16_t* u, const float* cw, const float* cb, bf16_t* xconv, bf16_t* XT, bf16_t* VT, int vb0, int vbs) {
    const int tid = opq((int)threadIdx.x);
    for (int unit = vb0; unit < NB * 32 * 3; unit += vbs) {
        const int cg = unit % 3, tb = (unit / 3) & 31, b = unit / 96;
        const int t0 = tb * 128;
        if (cg < 2) {
            const int ch = cg * 512 + tid;
            float w[5];
#pragma unroll
            for (int j = 0; j < 5; ++j) w[j] = cw[j * 1024 + ch];
            const float bias = cb[ch];
            const bf16_t* up = u + (size_t)b * SEQ * UW + 3072 + ch;
            float v0, v1, v2, v3;
            v0 = (t0 - 2 >= 0) ? bf2f(up[(size_t)(t0 - 2) * UW]) : 0.f;
            v1 = (t0 - 1 >= 0) ? bf2f(up[(size_t)(t0 - 1) * UW]) : 0.f;
            v2 = bf2f(up[(size_t)t0 * UW]);
            v3 = bf2f(up[(size_t)(t0 + 1) * UW]);
            for (int t8 = 0; t8 < 128; t8 += 8) {
                float nx[8];
#pragma unroll
                for (int i = 0; i < 8; ++i) { const int tt = t0 + t8 + i + 2; nx[i] = (tt < SEQ) ? bf2f(up[(size_t)tt * UW]) : 0.f; }
                unsigned pk[4];
#pragma unroll
                for (int i = 0; i < 8; ++i) {
                    const float o = silu_f(bias + w[0] * v0 + w[1] * v1 + w[2] * v2 + w[3] * v3 + w[4] * nx[i]);
                    const bf16_t ob = f2bf(o);
                    xconv[(size_t)(b * SEQ + t0 + t8 + i) * 1024 + ch] = ob;
                    if (i & 1) pk[i >> 1] |= ((unsigned)ob << 16); else pk[i >> 1] = ob;
                    v0 = v1; v1 = v2; v2 = v3; v3 = nx[i];
                }
                if (ch < 768) { u32x4 o4; o4.x = pk[0]; o4.y = pk[1]; o4.z = pk[2]; o4.w = pk[3]; *(u32x4*)(XT + ((size_t)b * 768 + ch) * SEQ + t0 + t8) = o4; }
            }
        } else {
            const int ch = tid;
            const bf16_t* up = u + (size_t)b * SEQ * UW + 1536 + ch;
            for (int t8 = 0; t8 < 128; t8 += 8) {
                unsigned pk[4];
#pragma unroll
                for (int i = 0; i < 8; ++i) { const unsigned ob = up[(size_t)(t0 + t8 + i) * UW]; if (i & 1) pk[i >> 1] |= (ob << 16); else pk[i >> 1] = ob; }
                u32x4 o4; o4.x = pk[0]; o4.y = pk[1]; o4.z = pk[2]; o4.w = pk[3]; *(u32x4*)(VT + ((size_t)b * 512 + ch) * SEQ + t0 + t8) = o4;
            }
        }
    }
}

constexpr int MB_XT = 0, MB_BX = 256 * 272, MB_DT = MB_BX + 128 * 272, MB_CS = MB_DT + 8 * 128 * 4, MB_TOT = MB_CS + 8 * 128 * 4, MB_END = MB_TOT + 64;
static_assert(MB_END <= 131072, "mamba lds");
constexpr size_t MS_SCAN = (size_t)32 * 8192;
DEVI bf16x8 pack8(const float* v) { u32x4 w; w.x = pg8::cvt_pk_bf16(v[0], v[1]); w.y = pg8::cvt_pk_bf16(v[2], v[3]); w.z = pg8::cvt_pk_bf16(v[4], v[5]); w.w = pg8::cvt_pk_bf16(v[6], v[7]); return __builtin_bit_cast(bf16x8, w); }
DEVI void mamba_tables(LAS unsigned char* lds, const float* dtraw, const float* A_log, const float* dt_bias, int b, int g, int c, int wid, int lane) {
    LAS float* tdt = (LAS float*)(lds + MB_DT); LAS float* tcs = (LAS float*)(lds + MB_CS); LAS float* ttot = (LAS float*)(lds + MB_TOT);
    const int r = wid >> 1, dir = wid & 1, hd = 4 * g + r;
    const float A = -__expf(A_log[dir * 8 + hd]), bias = dt_bias[dir * 8 + hd];
    const size_t tk = (size_t)b * SEQ + c * 128 + 2 * lane;
    const float dt0 = softplus_f(dtraw[tk * 16 + dir * 8 + hd] + bias), dt1 = softplus_f(dtraw[(tk + 1) * 16 + dir * 8 + hd] + bias);
    const float a0 = dt0 * A, a1 = dt1 * A;
    float sc = a0 + a1;
#pragma unroll
    for (int off = 1; off < 64; off <<= 1) { const float v = __shfl_up(sc, off); if (lane >= off) sc += v; }
    const float total = __shfl(sc, 63);
    const float pre0 = sc - a1, pre1 = sc;
    const float c0 = dir ? (total - pre0 + a0) : pre0, c1 = dir ? (total - pre1 + a1) : pre1;
    tdt[wid * 128 + 2 * lane] = dt0; tdt[wid * 128 + 2 * lane + 1] = dt1;
    tcs[wid * 128 + 2 * lane] = c0; tcs[wid * 128 + 2 * lane + 1] = c1;
    if (lane == 0) ttot[wid] = total;
}
DEVI void stage_rows(LAS unsigned char* dst, const bf16_t* src, size_t src_stride, int rows, int tid) {
    for (int e = tid; e < rows * 16; e += NTHR) { const int r = e >> 4, cch = e & 15; *(LAS u32x4*)(dst + r * 272 + cch * 16) = *(const u32x4*)(src + (size_t)r * src_stride + cch * 8); }
}
DEVI void ph_mamba_states(LAS unsigned char* lds, const bf16_t* XT, const float* dtraw, const float* A_log, const float* dt_bias, float* MS, float* MD, int vb0, int vbs) {
    const int tid = opq((int)threadIdx.x), wid = __builtin_amdgcn_readfirstlane(tid >> 6), lane = tid & 63, fr = lane & 15, fq = lane >> 4;
    LAS float* tdt = (LAS float*)(lds + MB_DT); LAS float* tcs = (LAS float*)(lds + MB_CS); LAS float* ttot = (LAS float*)(lds + MB_TOT);
    for (int unit = vb0; unit < NB * 2 * 32; unit += vbs) {
        const int c = unit & 31, g = (unit >> 5) & 1, b = unit >> 6;
        __syncthreads();
        stage_rows(lds + MB_XT, XT + ((size_t)b * 768 + g * 256) * SEQ + c * 128, SEQ, 256, tid);
        stage_rows(lds + MB_BX, XT + ((size_t)b * 768 + 512 + g * 128) * SEQ + c * 128, SEQ, 128, tid);
        mamba_tables(lds, dtraw, A_log, dt_bias, b, g, c, wid, lane);
        __syncthreads();
        if (lane == 0) MD[((size_t)(b * 8 + 4 * g + (wid >> 1)) * 2 + (wid & 1)) * 32 + c] = __expf(ttot[wid]);
        for (int hdd = 0; hdd < 8; ++hdd) {
            const int r = hdd >> 1, dir = hdd & 1, hd = 4 * g + r;
            const float tot = ttot[hdd];
            f32x4 acc[4];
#pragma unroll
            for (int pt = 0; pt < 4; ++pt) acc[pt] = (f32x4){0.f, 0.f, 0.f, 0.f};
#pragma unroll
            for (int ks = 0; ks < 4; ++ks) {
                const int s0 = 32 * ks + 8 * fq;
                const u32x4 braw = *(const LAS u32x4*)(lds + MB_BX + (16 * wid + fr) * 272 + s0 * 2);
                float bw[8];
                const unsigned bu[4] = {braw.x, braw.y, braw.z, braw.w};
#pragma unroll
                for (int j = 0; j < 8; ++j) { const float bv = (j & 1) ? bfhi(bu[j >> 1]) : bflo(bu[j >> 1]);
                    bw[j] = bv * tdt[hdd * 128 + s0 + j] * __expf(tot - tcs[hdd * 128 + s0 + j]); }
                const bf16x8 Bf = pack8(bw);
#pragma unroll
                for (int pt = 0; pt < 4; ++pt) {
                    const bf16x8 Af = *(const LAS bf16x8*)(lds + MB_XT + (r * 64 + 16 * pt + fr) * 272 + s0 * 2);
                    acc[pt] = __builtin_amdgcn_mfma_f32_16x16x32_bf16(Af, Bf, acc[pt], 0, 0, 0);
                }
            }
            float* dst = MS + ((size_t)(b * 8 + hd) * 2 + dir) * MS_SCAN + (size_t)c * 8192;
#pragma unroll
            for (int pt = 0; pt < 4; ++pt)
#pragma unroll
                for (int rg = 0; rg < 4; ++rg) dst[(16 * pt + 4 * fq + rg) * 128 + 16 * wid + fr] = acc[pt][rg];
        }
    }
    __syncthreads();
}
DEVI void ph_mamba_scan(float* MS, const float* MD, int vb0, int vbs) {
    const int tid = opq((int)threadIdx.x);
    for (int idx = vb0 * NTHR + tid; idx < 64 * 2048; idx += vbs * NTHR) {
        const int scan = idx >> 11, e4 = idx & 2047; const int dir = scan & 1;
        float4* base = (float4*)(MS + (size_t)scan * MS_SCAN) + e4;
        const float* md = MD + (size_t)scan * 32;
        float4 h = make_float4(0.f, 0.f, 0.f, 0.f);
        for (int i = 0; i < 32; ++i) {
            const int c = dir ? 31 - i : i;
            const float4 d = base[(size_t)c * 2048]; const float dec = md[c];
            base[(size_t)c * 2048] = h;
            h.x = h.x * dec + d.x; h.y = h.y * dec + d.y; h.z = h.z * dec + d.z; h.w = h.w * dec + d.w;
        }
    }
}
DEVI void ph_mamba_out(LAS unsigned char* lds, const bf16_t* u, const bf16_t* xconv, const bf16_t* XT, const float* dtraw, const float* A_log, const float* dt_bias, const float* Dskip, const float* b_norm,
                       const float* MS, bf16_t* ocat, int vb0, int vbs) {
    const int tid = opq((int)threadIdx.x), wid = __builtin_amdgcn_readfirstlane(tid >> 6), lane = tid & 63, fr = lane & 15, fq = lane >> 4;
    LAS float* tdt = (LAS float*)(lds + MB_DT); LAS float* tcs = (LAS float*)(lds + MB_CS);
    for (int unit = vb0; unit < NB * 2 * 32; unit += vbs) {
        const int c = unit & 31, g = (unit >> 5) & 1, b = unit >> 6;
        const size_t tok0 = (size_t)b * SEQ + c * 128;
        __syncthreads();
        stage_rows(lds + MB_XT, XT + ((size_t)b * 768 + g * 256) * SEQ + c * 128, SEQ, 256, tid);
        stage_rows(lds + MB_BX, xconv + tok0 * 1024 + 512 + g * 128, 1024, 128, tid);
        mamba_tables(lds, dtraw, A_log, dt_bias, b, g, c, wid, lane);
        const int tl = 16 * wid + fr;
        bf16x8 Cf[4];
#pragma unroll
        for (int ks = 0; ks < 4; ++ks) Cf[ks] = *(const bf16x8*)(xconv + (tok0 + tl) * 1024 + 768 + g * 128 + 32 * ks + 8 * fq);
        __syncthreads();
        f32x4 GT[8];
#pragma unroll
        for (int st = 0; st < 8; ++st) { GT[st] = (f32x4){0.f, 0.f, 0.f, 0.f};
#pragma unroll
            for (int ks = 0; ks < 4; ++ks) { const bf16x8 Af = *(const LAS bf16x8*)(lds + MB_BX + (16 * st + fr) * 272 + (32 * ks + 8 * fq) * 2);
                GT[st] = __builtin_amdgcn_mfma_f32_16x16x32_bf16(Af, Cf[ks], GT[st], 0, 0, 0); } }
        float ss = 0.f;
#pragma unroll 1
        for (int r = 0; r < 4; ++r) {
            const int hd = 4 * g + r;
            f32x4 yv[4];
#pragma unroll
            for (int pt = 0; pt < 4; ++pt) yv[pt] = (f32x4){0.f, 0.f, 0.f, 0.f};
#pragma unroll 1
            for (int dir = 0; dir < 2; ++dir) {
                const int hdd = r * 2 + dir;
                const float cst = tcs[hdd * 128 + tl];
                f32x4 yo[4];
                const float* hin = MS + ((size_t)(b * 8 + hd) * 2 + dir) * MS_SCAN + (size_t)c * 8192;
#pragma unroll
                for (int pt = 0; pt < 4; ++pt) { yo[pt] = (f32x4){0.f, 0.f, 0.f, 0.f};
#pragma unroll
                    for (int ks = 0; ks < 4; ++ks) { const float* hp = hin + (16 * pt + fr) * 128 + 32 * ks + 8 * fq;
                        const float4 h0 = *(const float4*)hp, h1 = *(const float4*)(hp + 4);
                        const float hv[8] = {h0.x, h0.y, h0.z, h0.w, h1.x, h1.y, h1.z, h1.w};
                        yo[pt] = __builtin_amdgcn_mfma_f32_16x16x32_bf16(pack8(hv), Cf[ks], yo[pt], 0, 0, 0); } }
                const float eo = __expf(cst);
#pragma unroll
                for (int pt = 0; pt < 4; ++pt) yv[pt] += yo[pt] * eo;
#pragma unroll
                for (int kp = 0; kp < 4; ++kp) {
                    const bool skip = dir ? (2 * kp + 1 < wid) : (2 * kp > wid);
                    if (!skip) {
                        float pv[8];
#pragma unroll
                        for (int hlf = 0; hlf < 2; ++hlf)
#pragma unroll
                            for (int rg = 0; rg < 4; ++rg) { const int st = 2 * kp + hlf, sl = 16 * st + 4 * fq + rg;
                                const bool ok = dir ? (sl >= tl) : (sl <= tl);
                                const float e = __expf(fminf(cst - tcs[hdd * 128 + sl], 0.f));
                                pv[hlf * 4 + rg] = ok ? GT[st][rg] * e * tdt[hdd * 128 + sl] : 0.f; }
                        const bf16x8 Pf = pack8(pv);
#pragma unroll
                        for (int pt = 0; pt < 4; ++pt) {
                            const LAS unsigned char* xr = lds + MB_XT + (r * 64 + 16 * pt + fr) * 272;
                            const u32x2 x0 = *(const LAS u32x2*)(xr + (32 * kp + 4 * fq) * 2), x1 = *(const LAS u32x2*)(xr + (32 * kp + 16 + 4 * fq) * 2);
                            u32x4 xa; xa.x = x0.x; xa.y = x0.y; xa.z = x1.x; xa.w = x1.y;
                            yv[pt] = __builtin_amdgcn_mfma_f32_16x16x32_bf16(__builtin_bit_cast(bf16x8, xa), Pf, yv[pt], 0, 0, 0);
                        }
                    }
                }
            }
            const float Dk = Dskip[hd];
#pragma unroll
            for (int pt = 0; pt < 4; ++pt) {
                const int p0 = 16 * pt + 4 * fq;
                const u32x2 xr = *(const u32x2*)(xconv + (tok0 + tl) * 1024 + hd * 64 + p0);
                const u32x2 zr = *(const u32x2*)(u + (tok0 + tl) * UW + 2560 + hd * 64 + p0);
                const float xs[4] = {bflo(xr.x), bfhi(xr.x), bflo(xr.y), bfhi(xr.y)}, zs[4] = {bflo(zr.x), bfhi(zr.x), bflo(zr.y), bfhi(zr.y)};
                float yy[4];
#pragma unroll
                for (int rg = 0; rg < 4; ++rg) { const float y = (yv[pt][rg] + Dk * xs[rg]) * silu_f(zs[rg]); yy[rg] = y; ss += y * y; }
                const unsigned long long o = (unsigned long long)pk2(yy[0], yy[1]) | ((unsigned long long)pk2(yy[2], yy[3]) << 32);
                __hip_atomic_store((unsigned long long*)(ocat + (tok0 + tl) * DM + 512 + g * 256 + r * 64 + p0), o, __ATOMIC_RELAXED, __HIP_MEMORY_SCOPE_AGENT);
            }
        }
        ss += __shfl_xor(ss, 16); ss += __shfl_xor(ss, 32);
        const float rn = rsqrtf(ss * (1.f / 256.f) + EPS);
        asm volatile("s_waitcnt vmcnt(0)" ::: "memory");
#pragma unroll 1
        for (int r = 0; r < 4; ++r)
#pragma unroll
            for (int pt = 0; pt < 4; ++pt) {
                const int cc = g * 256 + r * 64 + 16 * pt + 4 * fq;
                unsigned long long* op = (unsigned long long*)(ocat + (tok0 + tl) * DM + 512 + cc);
                const unsigned long long v = __hip_atomic_load(op, __ATOMIC_RELAXED, __HIP_MEMORY_SCOPE_AGENT);
                const unsigned vlo = (unsigned)v, vhi = (unsigned)(v >> 32);
                const float4 bn = *(const float4*)(b_norm + cc);
                const unsigned long long o = (unsigned long long)pk2(bflo(vlo) * rn * bn.x, bfhi(vlo) * rn * bn.y) | ((unsigned long long)pk2(bflo(vhi) * rn * bn.z, bfhi(vhi) * rn * bn.w) << 32);
                *op = o;
            }
    }
    __syncthreads();
}

DEVI void ph_na_naive(const bf16_t* qkv, const float* rpb, bf16_t* oc, int vb0, int vbs) {
    for (int e4 = vb0 * NTHR + opq((int)threadIdx.x); e4 < MT * 16 * 4; e4 += vbs * NTHR) {
        const int dq = e4 & 3, e = e4 >> 2;
        const int hd = e / MT, tok = e % MT;
        const int b = tok >> 12, t = tok & 4095, r = t >> 6, c = t & 63;
        const int rs = min(max(r - 4, 0), 56), qs = min(max(c - 8, 0), 48);
        float q[16], o[16];
        const bf16_t* qp = qkv + (size_t)tok * 3072 + hd * 64 + dq * 16;
#pragma unroll
        for (int d = 0; d < 16; ++d) { q[d] = bf2f(qp[d]); o[d] = 0.f; }
        float m = -1e30f, l = 0.f;
        for (int dr = 0; dr < 8; ++dr)
            for (int dc = 0; dc < 16; ++dc) {
                const int kr = rs + dr, kc = qs + dc;
                const size_t kt = (size_t)b * SEQ + kr * 64 + kc;
                const bf16_t* kp = qkv + kt * 3072 + 1024 + hd * 64 + dq * 16;
                const bf16_t* vp = qkv + kt * 3072 + 2048 + hd * 64 + dq * 16;
                float s = 0.f;
#pragma unroll
                for (int d = 0; d < 16; ++d) s += q[d] * bf2f(kp[d]);
                s += __shfl_xor(s, 1); s += __shfl_xor(s, 2);
                s = s * 0.125f + rpb[hd * 465 + (kr - r + 7) * 31 + (kc - c + 15)];
                const float mn = fmaxf(m, s); const float al = __expf(m - mn), pe = __expf(s - mn);
                l = l * al + pe; m = mn;
#pragma unroll
                for (int d = 0; d < 16; ++d) o[d] = o[d] * al + pe * bf2f(vp[d]);
            }
        const float il = 1.f / l;
        bf16_t* op = oc + (size_t)tok * DM + hd * 64 + dq * 16;
#pragma unroll
        for (int d = 0; d < 16; ++d) op[d] = f2bf(o[d] * il);
    }
}

#define XB_TMO      128
#define XB_XCNT(j)  (256  + 64 * (j))
#define XB_XSUB(j)  (1280 + 64 * (j))
#define XB_XGEN(j)  (2304 + 64 * (j))
#define XB_TOP      3328
#define XB_TOPGEN   3392
#define XCD_BAR_WORDS 3456
#define XB_SPIN_CAP (1u << 18)

__device__ __forceinline__ unsigned xb_ld(unsigned* p)              { return __hip_atomic_load(p, __ATOMIC_RELAXED, __HIP_MEMORY_SCOPE_AGENT); }
__device__ __forceinline__ unsigned xb_add(unsigned* p, unsigned v) { return __hip_atomic_fetch_add(p, v, __ATOMIC_RELAXED, __HIP_MEMORY_SCOPE_AGENT); }
__device__ __forceinline__ unsigned xb_xcc_id() { return (unsigned)__builtin_amdgcn_s_getreg((3 << 11) | 20) & 0xFu; }
#define XB_SPIN(cond, bar) do { unsigned _sp = 0; while (cond) { __builtin_amdgcn_s_sleep(1); \
    if ((++_sp & 255u) == 0u) { if (xb_ld(&(bar)[XB_TMO])) break; if (_sp > XB_SPIN_CAP) { atomicAdd(&(bar)[XB_TMO], 1u); break; } } } } while (0)

struct XcdBarrier {
    unsigned* bar; unsigned x;
    volatile LAS unsigned* st;
};

__device__ __forceinline__ XcdBarrier xcd_barrier_post(unsigned* bar, volatile LAS unsigned* st) {
    XcdBarrier b; b.bar = bar; b.x = xb_xcc_id(); b.st = st;
    if (threadIdx.x == 0) (void)xb_add(&bar[XB_XCNT(b.x)], 1u);
    return b;
}
__device__ __forceinline__ void xcd_barrier_complete(unsigned* bar, unsigned x, unsigned& nloc, unsigned& nx) {
    const unsigned G = gridDim.x * gridDim.y * gridDim.z;
    unsigned sum, cnt, mine, sp = 0u;
    for (;;) {
        sum = 0u; cnt = 0u; mine = 0u;
#pragma unroll
        for (unsigned j = 0; j < 16; ++j) { const unsigned c = xb_ld(&bar[XB_XCNT(j)]); sum += c; cnt += (c > 0u) ? 1u : 0u; mine = (j == x) ? c : mine; }
        if (sum == G) break;
        __builtin_amdgcn_s_sleep(1);
        if ((++sp & 255u) == 0u) { if (xb_ld(&bar[XB_TMO])) break; if (sp > XB_SPIN_CAP) { atomicAdd(&bar[XB_TMO], 1u); break; } }
    }
    nloc = mine > 0u ? mine : 1u; nx = cnt > 0u ? cnt : 1u;
}

__device__ __forceinline__ void xcd_barrier(const XcdBarrier& b) {
    asm volatile("s_waitcnt vmcnt(0)" ::: "memory");
    __syncthreads();
    if (threadIdx.x == 0) {
        unsigned* bar = b.bar;
        __builtin_amdgcn_s_waitcnt(0);
        unsigned nloc = b.st[0], nx = b.st[1];
        if (nloc == 0u) { xcd_barrier_complete(bar, b.x, nloc, nx); b.st[0] = nloc; b.st[1] = nx; }
        const unsigned old = xb_add(&bar[XB_XSUB(b.x)], 1u);
        const unsigned gen = old / nloc;
        if (old + 1u == (gen + 1u) * nloc) {
            __builtin_amdgcn_fence(__ATOMIC_RELEASE, "agent");
            asm volatile("s_waitcnt vmcnt(0)" ::: "memory");
            const unsigned og = xb_add(&bar[XB_TOP], 1u);
            const unsigned tg = og / nx;
            if (og + 1u == (tg + 1u) * nx) xb_add(&bar[XB_TOPGEN], 1u);
            else XB_SPIN(xb_ld(&bar[XB_TOPGEN]) == tg, bar);
            __builtin_amdgcn_fence(__ATOMIC_ACQUIRE, "agent");
            xb_add(&bar[XB_XGEN(b.x)], 1u);
            asm volatile("s_waitcnt vmcnt(0)" ::: "memory");
        } else {
            XB_SPIN(xb_ld(&bar[XB_XGEN(b.x)]) == gen, bar);
            __builtin_amdgcn_fence(__ATOMIC_ACQUIRE, "agent");
            asm volatile("s_waitcnt vmcnt(0)" ::: "memory");
        }
    }
    __syncthreads();
}


struct Args { const float* in[34]; float* out; unsigned char* ws; int ph_lo, ph_hi; };
constexpr int N_PHASES = 22;

__global__ void __launch_bounds__(NTHR, 2) fwd(Args a) {
    extern __shared__ __attribute__((aligned(16))) unsigned char lds_raw[];
    float* lds = (float*)lds_raw;
    LAS unsigned char* ldsl = (LAS unsigned char*)lds_raw;
    const int vb0 = blockIdx.x, vbs = gridDim.x;
    const int lo = a.ph_lo, hi = a.ph_hi;
#define IN(k) (lo <= (k) && (k) < hi)
#define SEAM(k) do { if (IN(k) && IN((k) + 1)) xcd_barrier(bar); } while (0)
    volatile LAS unsigned* misc = (volatile LAS unsigned*)(ldsl + MISC_OFF);
    if (threadIdx.x < 4) misc[threadIdx.x] = 0u;
    __syncthreads();
    XcdBarrier bar = xcd_barrier_post((unsigned*)(a.ws + WS_CTL) + CW_BAR, misc);
    unsigned char* ws = a.ws;
    unsigned* ctl = (unsigned*)(ws + WS_CTL);
    unsigned* cnt = ctl + CW_CNT;
    int* list = (int*)(ws + WS_LIST); float* gatev = (float*)(ws + WS_GATE);
    float* dtraw = (float*)(ws + WS_DT);
    bf16_t* HB = (bf16_t*)(ws + WS_HB); bf16_t* UB = (bf16_t*)(ws + WS_UB);
    float* T1 = (float*)(ws + WS_T1); float* T2 = (float*)(ws + WS_T2);
    bf16_t* T2b = (bf16_t*)(ws + WS_T2);
    bf16_t* PB0 = (bf16_t*)(ws + WS_PB0); bf16_t* PB1 = (bf16_t*)(ws + WS_PB1);
    bf16_t* YB = (bf16_t*)(ws + WS_Y);
    float* MS = (float*)(ws + WS_MS); float* MD = (float*)(ws + WS_MD);
    float* HS = (float*)(ws + WS_HS); float* HD = (float*)(ws + WS_HD);
    bf16_t* XT = (bf16_t*)(ws + WS_XT); bf16_t* VT = (bf16_t*)(ws + WS_VT);
    float* X = a.out;
    const float* x_in = a.in[0]; const float* p_in = a.in[1];
    const int G = (int)gridDim.x, cb = (int)blockIdx.x;

    if (IN(0)) {
        ph_convert_weights(ldsl, a.in, ws, 0, ITEMS_DENSE, vb0, vbs);
        NormA A{x_in, X, nullptr, nullptr, nullptr, a.in[3], HB, a.in[4], dtraw, nullptr, nullptr, nullptr, nullptr};
        ph_norm<0, true, true, false>(A, vb0, vbs);
    }
    SEAM(0);
    if (IN(1)) { pg8::DenseOrder S; S.init(MT, UW, DM, (const bf16_t*)(ws + W_IN), G, cb); pg8::gemm_phase(ldsl, HB, DM, S, pg8::EpiBf16{UB, UW}); }
    SEAM(1);
    if (IN(2)) { ph_prep(UB, a.in[5], a.in[6], HB, XT, VT, vb0, vbs); }
    SEAM(2);
    if (IN(3)) { ph_hgrn_states(ldsl, UB, VT, a.in[2], HS, HD, vb0, vbs); ph_mamba_states(ldsl, XT, dtraw, a.in[7], a.in[8], MS, MD, vb0, vbs); }
    SEAM(3);
    if (IN(4)) { ph_hgrn_scan(HS, HD, vb0, vbs); ph_mamba_scan(MS, MD, vb0, vbs); }
    SEAM(4);
    if (IN(5)) { ph_hgrn_out(ldsl, UB, VT, a.in[2], a.in[10], HS, T1, T2b, vb0, vbs); ph_mamba_out(ldsl, UB, HB, XT, dtraw, a.in[7], a.in[8], a.in[9], a.in[11], MS, T2b, vb0, vbs); }
    SEAM(5);
    if (IN(6)) { pg8::DenseOrder S; S.init(MT, DM, DM, (const bf16_t*)(ws + W_OUTE), G, cb); pg8::gemm_phase(ldsl, T2b, DM, S, pg8::EpiF32{T1, DM}); }
    SEAM(6);
    if (IN(7)) {
        NormA A{X, X, T1, nullptr, a.in[13], a.in[14], HB, nullptr, nullptr, nullptr, nullptr, nullptr, nullptr};
        ph_norm<1, true, false, false>(A, vb0, vbs);
        ph_cvt_rows(p_in, PB0, (size_t)MT * PDIM / 4, vb0, vbs);
        ph_convert_weights(ldsl, a.in, ws, ITEMS_DENSE, ITEMS_ALL, vb0, vbs);
    }
    SEAM(7);
    if (IN(8)) { pg8::DenseOrder S; S.init(MT, 2 * DFF, DM, (const bf16_t*)(ws + W_GU), G, cb); pg8::gemm_phase(ldsl, HB, DM, S, pg8::EpiSwiglu{UB, DFF}); }
    SEAM(8);
    if (IN(9)) { pg8::DenseOrder S; S.init(MT, DM, DFF, (const bf16_t*)(ws + W_DN), G, cb); pg8::gemm_phase(ldsl, UB, DFF, S, pg8::EpiF32{T1, DM}); }
    SEAM(9);
    if (IN(10)) {
        { pg8::DenseOrder S; S.init(MT, DM, PDIM, (const bf16_t*)(ws + W_PP), G, cb); pg8::gemm_phase(ldsl, PB0, PDIM, S, pg8::EpiF32{T2, DM}); }
        NormA A{X, X, T1, nullptr, a.in[18], a.in[30], HB, nullptr, nullptr, nullptr, nullptr, nullptr, nullptr};
        ph_norm<1, true, false, false>(A, vb0, vbs);
    }
    SEAM(10);
    if (IN(11)) { pg8::DenseOrder S; S.init(MT, DM, DM, (const bf16_t*)(ws + W_PG), G, cb); pg8::gemm_phase(ldsl, HB, DM, S, pg8::EpiPleGate{T2, DM}); }
    SEAM(11);
    if (IN(12)) {
        NormA A{X, X, T2, nullptr, a.in[33], a.in[19], HB, nullptr, nullptr, nullptr, nullptr, nullptr, nullptr};
        ph_norm<1, true, false, false>(A, vb0, vbs);
    }
    SEAM(12);
    if (IN(13)) { pg8::DenseOrder S; S.init(MT, 3072, DM, (const bf16_t*)(ws + W_QKV), G, cb); pg8::gemm_phase(ldsl, HB, DM, S, pg8::EpiBf16{UB, 3072}); }
    SEAM(13);
    if (IN(14)) { ph_na_naive(UB, a.in[21], T2b, vb0, vbs); }
    SEAM(14);
    if (IN(15)) { pg8::DenseOrder S; S.init(MT, DM, DM, (const bf16_t*)(ws + W_OUTO), G, cb); pg8::gemm_phase(ldsl, T2b, DM, S, pg8::EpiF32{T1, DM}); }
    SEAM(15);
    if (IN(16)) {
        NormA A{X, X, T1, nullptr, a.in[23], a.in[24], HB, nullptr, nullptr, a.in[25], cnt, list, gatev};
        ph_norm<1, true, false, true>(A, vb0, vbs);
        ph_cvt_rows(p_in + (size_t)MT * PDIM, PB1, (size_t)MT * PDIM / 4, vb0, vbs);
    }
    SEAM(16);
    if (IN(17)) { pg8::MoeOrder S; S.init(cnt, (volatile LAS int*)(ldsl + MISC_OFF + 64), 2 * DFFE, DM, (const bf16_t*)(ws + W_EGU), (size_t)14 * MiB, list, true, G, cb); pg8::gemm_phase(ldsl, HB, DM, S, pg8::EpiSwiglu{UB, DFFE}); }
    SEAM(17);
    if (IN(18)) { pg8::MoeOrder S; S.init(cnt, (volatile LAS int*)(ldsl + MISC_OFF + 64), DM, DFFE, (const bf16_t*)(ws + W_EDN), (size_t)7 * MiB, list, false, G, cb); pg8::gemm_phase(ldsl, UB, DFFE, S, pg8::EpiMoeDown{YB, list, gatev}); }
    SEAM(18);
    if (IN(19)) {
        { pg8::DenseOrder S; S.init(MT, DM, PDIM, (const bf16_t*)(ws + W_PP + 512 * 1024), G, cb); pg8::gemm_phase(ldsl, PB1, PDIM, S, pg8::EpiF32{T1, DM}); }
        NormA A{X, X, nullptr, YB, a.in[29], a.in[30] + DM, HB, nullptr, nullptr, nullptr, nullptr, nullptr, nullptr};
        ph_norm<2, true, false, false>(A, vb0, vbs);
    }
    SEAM(19);
    if (IN(20)) { pg8::DenseOrder S; S.init(MT, DM, DM, (const bf16_t*)(ws + W_PG + 2 * MiB), G, cb); pg8::gemm_phase(ldsl, HB, DM, S, pg8::EpiPleGate{T1, DM}); }
    SEAM(20);
    if (IN(21)) {
        NormA A{X, X, T1, nullptr, a.in[33] + DM, nullptr, nullptr, nullptr, nullptr, nullptr, nullptr, nullptr, nullptr};
        ph_norm<1, false, false, false>(A, vb0, vbs);
    }
#undef IN
#undef SEAM
}

extern "C" void kernel_launch(void* const* d_in, const int* in_sizes, int n_in, void* d_out, int out_size, void* d_ws, size_t ws_size, hipStream_t stream) {
    static int grid = 0;
    if (grid == 0) {
        if (n_in != 34 || out_size != MT * DM || ws_size < WS_END) { fprintf(stderr, "kernel_launch: unexpected shapes n_in %d out %d ws %zu (need %zu)\n", n_in, out_size, ws_size, (size_t)WS_END); grid = -1; return; }
        int dev = 0, cus = 0;
        if (hipGetDevice(&dev) != hipSuccess || hipDeviceGetAttribute(&cus, hipDeviceAttributeMultiprocessorCount, dev) != hipSuccess) { grid = -1; return; }
        if (hipFuncSetAttribute((const void*)fwd, hipFuncAttributeMaxDynamicSharedMemorySize, LDS_BYTES) != hipSuccess) { fprintf(stderr, "hipFuncSetAttribute failed\n"); grid = -1; return; }
        (void)hipGetLastError();
        grid = cus;
    }
    if (grid < 0) return;
    (void)hipMemsetAsync((char*)d_ws + WS_CTL, 0, CTL_ZERO_BYTES, stream);
    Args a{};
    for (int i = 0; i < 34; ++i) a.in[i] = (const float*)d_in[i];
    a.out = (float*)d_out; a.ws = (unsigned char*)d_ws;
#ifndef MK_PER_PHASE
    a.ph_lo = 0; a.ph_hi = N_PHASES;
    hipLaunchKernelGGL(fwd, dim3(grid), dim3(NTHR), LDS_BYTES, stream, a);
#else
    for (int ph = 0; ph < N_PHASES; ++ph) {
        a.ph_lo = ph; a.ph_hi = ph + 1;
        hipLaunchKernelGGL(fwd, dim3(grid), dim3(NTHR), LDS_BYTES, stream, a);
    }
#endif
}
```

```cpp
#include <hip/hip_runtime.h>
#include <stdint.h>
#include <stdio.h>

#define DEVI __device__ __forceinline__
#define LAS __attribute__((address_space(3)))
typedef unsigned short bf16_t;

constexpr int NB = 4, SEQ = 4096, DM = 1024, MT = NB * SEQ;
constexpr int EVEN_IN = 4112, UW = 4096, DFF = 2816, NEXP = 8, DFFE = 3584, PDIM = 256;
constexpr float EPS = 1e-6f;
constexpr int NTHR = 512;
constexpr int LDS_BYTES = 147456;
constexpr int MISC_OFF = 131072 + 320;
constexpr int MOE_ROWS = 2 * MT + NEXP * 256;

constexpr size_t MiB = 1u << 20;
constexpr size_t WS_CTL = 0, CTL_ZERO_BYTES = 1 * MiB;
constexpr size_t WS_LIST = 1 * MiB;
constexpr size_t WS_GATE = WS_LIST + 512 * 1024;
constexpr size_t WS_DT = 2 * MiB;
constexpr size_t WS_W = 3 * MiB;
constexpr size_t W_IN = WS_W, W_OUTE = W_IN + 8 * MiB, W_GU = W_OUTE + 2 * MiB, W_DN = W_GU + 11 * MiB, W_PG = W_DN + 6 * MiB, W_PP = W_PG + 4 * MiB,
                 W_QKV = W_PP + 1 * MiB, W_OUTO = W_QKV + 6 * MiB, W_EGU = W_OUTO + 2 * MiB, W_EDN = W_EGU + 112 * MiB, W_END = W_EDN + 56 * MiB;
constexpr size_t WS_XB = W_END;
constexpr size_t WS_R = WS_XB + 32 * MiB;
constexpr size_t WS_UB = WS_R;
constexpr size_t WS_PB0 = WS_R + 88 * MiB;
constexpr size_t WS_YA = WS_R + 128 * MiB;
constexpr size_t WS_OF = WS_R + 160 * MiB;
constexpr size_t WS_OC = WS_R + 192 * MiB;
constexpr size_t WS_YP = WS_R + 224 * MiB;
constexpr size_t WS_YP1 = WS_R;
constexpr size_t WS_PB1 = WS_R + 240 * MiB;
constexpr size_t WS_END = WS_R + 256 * MiB;
constexpr size_t WS_Y = W_EGU;
constexpr size_t WS_MS = W_EGU;
constexpr size_t WS_HS = W_EGU + 64 * MiB;
constexpr size_t WS_XT = W_EDN;
constexpr size_t WS_VT = W_EDN + 24 * MiB;
constexpr size_t WS_MD = W_EDN + 40 * MiB;
constexpr size_t WS_HD = W_EDN + 41 * MiB;
static_assert(WS_R + (size_t)MOE_ROWS * DFFE * 2 <= WS_PB1 && WS_PB1 + 8 * MiB <= WS_END && WS_END <= 510 * MiB, "ws map");
constexpr size_t WS_RS = WS_CTL + 512 * 1024;
constexpr int CW_CNT = 64;
constexpr int CW_BAR = 4096;

DEVI int opq(int x) { asm volatile("" : "+v"(x)); return x; }
DEVI float bf2f(bf16_t b) { return __uint_as_float(((unsigned)b) << 16); }
DEVI bf16_t f2bf(float f) { unsigned u = __float_as_uint(f); u += 0x7FFFu + ((u >> 16) & 1u); return (bf16_t)(u >> 16); }
DEVI float silu_f(float x) { return x / (1.f + __expf(-x)); }
DEVI float sigmoid_f(float x) { return 1.f / (1.f + __expf(-x)); }
DEVI float softplus_f(float x) { return x > 20.f ? x : log1pf(__expf(x)); }
DEVI float wave_sum(float v) {
#pragma unroll
    for (int o = 1; o < 64; o <<= 1) v += __shfl_xor(v, o);
    return v;
}


typedef short bf16x8 __attribute__((ext_vector_type(8)));
typedef float f32x4 __attribute__((ext_vector_type(4)));
typedef unsigned u32x4 __attribute__((ext_vector_type(4)));
typedef unsigned u32x2 __attribute__((ext_vector_type(2)));
DEVI unsigned pk2(float lo, float hi) { return (unsigned)f2bf(lo) | ((unsigned)f2bf(hi) << 16); }
DEVI float bflo(unsigned w) { return __uint_as_float(w << 16); }
DEVI float bfhi(unsigned w) { return __uint_as_float(w & 0xffff0000u); }

struct NormB { const float* xin; bf16_t* XB; const bf16_t* y; const float* gpost; float* rs; const float* gnext;
               const float* win; float* dtraw; const float* wr; unsigned* cnt; int* list; float* gatev; float* xout; };
DEVI void unpack8(const u32x4 w, float* v) { v[0] = bflo(w.x); v[1] = bfhi(w.x); v[2] = bflo(w.y); v[3] = bfhi(w.y); v[4] = bflo(w.z); v[5] = bfhi(w.z); v[6] = bflo(w.w); v[7] = bfhi(w.w); }
template <int YMODE, bool FINAL, bool DT, bool ROUTE>
DEVI void ph_norm2(const NormB& A, int vb0, int vbs) {
    const int tidq = opq((int)threadIdx.x); const int wid = tidq >> 6, lane = tidq & 63;
    for (int row = vb0 * 8 + wid; row < MT; row += vbs * 8) {
        float xv[16];
        if (YMODE == 0) {
#pragma unroll
            for (int i = 0; i < 2; ++i) { const float4 p0 = *(const float4*)(A.xin + (size_t)row * DM + i * 512 + lane * 8), p1 = *(const float4*)(A.xin + (size_t)row * DM + i * 512 + lane * 8 + 4);
                xv[i * 8 + 0] = p0.x; xv[i * 8 + 1] = p0.y; xv[i * 8 + 2] = p0.z; xv[i * 8 + 3] = p0.w; xv[i * 8 + 4] = p1.x; xv[i * 8 + 5] = p1.y; xv[i * 8 + 6] = p1.z; xv[i * 8 + 7] = p1.w; }
        } else {
#pragma unroll
            for (int i = 0; i < 2; ++i) unpack8(*(const u32x4*)(A.XB + (size_t)row * DM + i * 512 + lane * 8), xv + i * 8);
            float yv[16]; float ss = 0.f;
#pragma unroll
            for (int i = 0; i < 2; ++i) {
                unpack8(*(const u32x4*)(A.y + (size_t)row * DM + i * 512 + lane * 8), yv + i * 8);
                if (YMODE == 2) { float y2[8]; unpack8(*(const u32x4*)(A.y + (size_t)MT * DM + (size_t)row * DM + i * 512 + lane * 8), y2);
#pragma unroll
                    for (int j = 0; j < 8; ++j) yv[i * 8 + j] += y2[j]; }
            }
#pragma unroll
            for (int j = 0; j < 16; ++j) ss += yv[j] * yv[j];
            ss = wave_sum(ss);
            const float r = rsqrtf(ss * (1.f / DM) + EPS);
#pragma unroll
            for (int i = 0; i < 2; ++i) { const float4 g0 = *(const float4*)(A.gpost + i * 512 + lane * 8), g1 = *(const float4*)(A.gpost + i * 512 + lane * 8 + 4);
                const float gg[8] = {g0.x, g0.y, g0.z, g0.w, g1.x, g1.y, g1.z, g1.w};
#pragma unroll
                for (int j = 0; j < 8; ++j) xv[i * 8 + j] += yv[i * 8 + j] * r * gg[j]; }
        }
        if (FINAL) {
#pragma unroll
            for (int i = 0; i < 2; ++i) { float* op = A.xout + (size_t)row * DM + i * 512 + lane * 8;
                *(float4*)op = make_float4(xv[i * 8], xv[i * 8 + 1], xv[i * 8 + 2], xv[i * 8 + 3]); *(float4*)(op + 4) = make_float4(xv[i * 8 + 4], xv[i * 8 + 5], xv[i * 8 + 6], xv[i * 8 + 7]); }
        } else {
#pragma unroll
            for (int i = 0; i < 2; ++i) { u32x4 o; o.x = pk2(xv[i * 8], xv[i * 8 + 1]); o.y = pk2(xv[i * 8 + 2], xv[i * 8 + 3]); o.z = pk2(xv[i * 8 + 4], xv[i * 8 + 5]); o.w = pk2(xv[i * 8 + 6], xv[i * 8 + 7]);
                *(u32x4*)(A.XB + (size_t)row * DM + i * 512 + lane * 8) = o; }
            float ss = 0.f;
#pragma unroll
            for (int j = 0; j < 16; ++j) ss += xv[j] * xv[j];
            ss = wave_sum(ss);
            const float r2 = rsqrtf(ss * (1.f / DM) + EPS);
            if (lane == 0) A.rs[row] = r2;
            if (DT || ROUTE) {
                float hv[16];
#pragma unroll
                for (int i = 0; i < 2; ++i) { const float4 g0 = *(const float4*)(A.gnext + i * 512 + lane * 8), g1 = *(const float4*)(A.gnext + i * 512 + lane * 8 + 4);
                    const float gg[8] = {g0.x, g0.y, g0.z, g0.w, g1.x, g1.y, g1.z, g1.w};
#pragma unroll
                    for (int j = 0; j < 8; ++j) hv[i * 8 + j] = xv[i * 8 + j] * r2 * gg[j]; }
                if (DT) {
                    float d[16];
#pragma unroll
                    for (int j = 0; j < 16; ++j) d[j] = 0.f;
#pragma unroll
                    for (int q = 0; q < 16; ++q) {
                        const float* wp = A.win + (size_t)((q >> 3) * 512 + lane * 8 + (q & 7)) * EVEN_IN + 4096;
#pragma unroll
                        for (int j4 = 0; j4 < 4; ++j4) { const float4 w = *(const float4*)(wp + j4 * 4);
                            d[j4 * 4 + 0] += hv[q] * w.x; d[j4 * 4 + 1] += hv[q] * w.y; d[j4 * 4 + 2] += hv[q] * w.z; d[j4 * 4 + 3] += hv[q] * w.w; }
                    }
#pragma unroll
                    for (int j = 0; j < 16; ++j) d[j] = wave_sum(d[j]);
                    if (lane == 0) {
#pragma unroll
                        for (int j4 = 0; j4 < 4; ++j4) *(float4*)(A.dtraw + (size_t)row * 16 + j4 * 4) = make_float4(d[j4 * 4], d[j4 * 4 + 1], d[j4 * 4 + 2], d[j4 * 4 + 3]);
                    }
                }
                if (ROUTE) {
                    float lg[8];
#pragma unroll
                    for (int e = 0; e < 8; ++e) lg[e] = 0.f;
#pragma unroll
                    for (int q = 0; q < 16; ++q) {
                        const float* wp = A.wr + (size_t)((q >> 3) * 512 + lane * 8 + (q & 7)) * 8;
                        const float4 w0 = *(const float4*)wp, w1 = *(const float4*)(wp + 4);
                        lg[0] += hv[q] * w0.x; lg[1] += hv[q] * w0.y; lg[2] += hv[q] * w0.z; lg[3] += hv[q] * w0.w;
                        lg[4] += hv[q] * w1.x; lg[5] += hv[q] * w1.y; lg[6] += hv[q] * w1.z; lg[7] += hv[q] * w1.w;
                    }
#pragma unroll
                    for (int e = 0; e < 8; ++e) lg[e] = wave_sum(lg[e]);
                    if (lane == 0) {
                        int e1 = 0; float v1 = lg[0];
#pragma unroll
                        for (int e = 1; e < 8; ++e) if (lg[e] > v1) { v1 = lg[e]; e1 = e; }
                        int e2 = 0; float v2 = -3.0e38f;
#pragma unroll
                        for (int e = 0; e < 8; ++e) if (e != e1 && lg[e] > v2) { v2 = lg[e]; e2 = e; }
                        const float ex = __expf(v2 - v1); const float w1 = 1.f / (1.f + ex), w2 = ex / (1.f + ex);
                        const int p1 = (int)atomicAdd(&A.cnt[e1], 1u); A.list[e1 * MT + p1] = row * 2; A.gatev[e1 * MT + p1] = w1;
                        const int p2 = (int)atomicAdd(&A.cnt[e2], 1u); A.list[e2 * MT + p2] = row * 2 + 1; A.gatev[e2 * MT + p2] = w2;
                    }
                }
            }
        }
    }
}

DEVI void transpose_item(const float* W, int ldw, int K, int k0, int n0, bf16_t* WT, int drow0, LAS float* scr, int lane, const float* gain) {
#pragma unroll 8
    for (int i = 0; i < 32; ++i) { const int kk = 2 * i + (lane >> 5); scr[kk * 33 + (lane & 31)] = W[(size_t)(k0 + kk) * ldw + n0 + (lane & 31)] * (gain ? gain[k0 + kk] : 1.f); }
    asm volatile("s_waitcnt lgkmcnt(0)" ::: "memory");
    const int c = lane & 7;
#pragma unroll
    for (int j = 0; j < 4; ++j) { const int n = (lane >> 3) + 8 * j; const LAS float* sp = scr + (8 * c) * 33 + n;
        u32x4 o; o.x = pk2(sp[0 * 33], sp[1 * 33]); o.y = pk2(sp[2 * 33], sp[3 * 33]); o.z = pk2(sp[4 * 33], sp[5 * 33]); o.w = pk2(sp[6 * 33], sp[7 * 33]);
        *(u32x4*)(WT + (size_t)(drow0 + n) * K + k0 + 8 * c) = o; }
    asm volatile("s_waitcnt lgkmcnt(0)" ::: "memory");
}
struct Job { int in_idx; unsigned src_off; int ldw; int K; int ncols; unsigned long long dst; int mode; int item0; int gain_idx; int gain_off; };
constexpr int NJOBS = 11 + 24;
struct JobTable { Job j[NJOBS]; int total; };
constexpr JobTable make_jobs() {
    JobTable t{}; int n = 0, it = 0;
    auto add = [&](int idx, unsigned off, int ldw, int K, int ncols, unsigned long long dst, int mode, int gi, int go) { t.j[n] = Job{idx, off, ldw, K, ncols, dst, mode, it, gi, go}; it += (K / 64) * (ncols / 32); ++n; };
    add(4, 0, EVEN_IN, DM, UW, W_IN, 0, 3, 0);
    add(12, 0, DM, DM, DM, W_OUTE, 0, -1, 0);
    add(15, 0, DFF, DM, DFF, W_GU, 1, 14, 0);
    add(16, 0, DFF, DM, DFF, W_GU, 2, 14, 0);
    add(17, 0, DM, DFF, DM, W_DN, 0, -1, 0);
    add(31, 0, DM, DM, DM, W_PG, 0, 30, 0);
    add(31, DM * DM, DM, DM, DM, W_PG + 2 * MiB, 0, 30, DM);
    add(32, 0, DM, PDIM, DM, W_PP, 0, -1, 0);
    add(32, PDIM * DM, DM, PDIM, DM, W_PP + 512 * 1024, 0, -1, 0);
    add(20, 0, 3072, DM, 3072, W_QKV, 0, 19, 0);
    add(22, 0, DM, DM, DM, W_OUTO, 0, -1, 0);
    for (int e = 0; e < NEXP; ++e) {
        add(26, (unsigned)e * DM * DFFE, DFFE, DM, DFFE, W_EGU + (unsigned long long)e * 14 * MiB, 1, 24, 0);
        add(27, (unsigned)e * DM * DFFE, DFFE, DM, DFFE, W_EGU + (unsigned long long)e * 14 * MiB, 2, 24, 0);
        add(28, (unsigned)e * DFFE * DM, DM, DFFE, DM, W_EDN + (unsigned long long)e * 7 * MiB, 0, -1, 0);
    }
    t.total = it; return t;
}
__device__ const JobTable g_jobs = make_jobs();
constexpr int ITEMS_DENSE = make_jobs().j[11].item0, ITEMS_ALL = make_jobs().total;
DEVI void ph_convert_weights(LAS unsigned char* lds, const float* const* in, unsigned char* ws, int it_lo, int it_hi, int vb0, int vbs) {
    const int tidq = opq((int)threadIdx.x); const int wid = __builtin_amdgcn_readfirstlane(tidq >> 6), lane = tidq & 63;
    LAS float* scr = (LAS float*)(lds + wid * 16384);
    int jb = 0;
    for (int it = it_lo + vb0 * 8 + wid; it < it_hi; it += vbs * 8) {
        while (jb + 1 < NJOBS && g_jobs.j[jb + 1].item0 <= it) ++jb;
        const Job J = g_jobs.j[jb];
        const int r = it - J.item0; const int nblk = J.ncols / 32; const int kb = r / nblk, nb = r % nblk;
        const int n0 = nb * 32; int drow0 = n0;
        if (J.mode != 0) drow0 = (n0 >> 7) * 256 + (n0 & 127) + (J.mode == 2 ? 128 : 0);
        transpose_item(in[J.in_idx] + J.src_off, J.ldw, J.K, kb * 64, n0, (bf16_t*)(ws + J.dst), drow0, scr, lane, J.gain_idx >= 0 ? in[J.gain_idx] + J.gain_off : nullptr);
    }
}
DEVI void ph_cvt_rows(const float* src, bf16_t* dst, size_t n4, int vb0, int vbs) {
    for (size_t e = (size_t)vb0 * NTHR + opq((int)threadIdx.x); e < n4; e += (size_t)vbs * NTHR) {
        const float4 v = ((const float4*)src)[e]; u32x2 o; o.x = pk2(v.x, v.y); o.y = pk2(v.z, v.w); ((u32x2*)dst)[e] = o; }
}

namespace pg8 {
constexpr int BM = 256, BK = 64, HALF = 128, HTB = HALF * BK * 2, STAGE_BYTES = 8 * HTB, NXCD = 8, WGM = 8;
__host__ __device__ __forceinline__ int lds_byte(int r, int c) { const int st = (r >> 4) * 2 + (c >> 5), rr = r & 15, cc = c & 31, ob = rr * 64 + cc * 2; return st * 1024 + (ob ^ (((ob >> 9) & 1) << 5)); }
__host__ __device__ __forceinline__ void stage_rc(int b, int& R, int& C) { const int st = b / 1024, sb = b % 1024, swz = sb ^ (((sb >> 9) & 1) << 5); R = (st >> 1) * 16 + swz / 64; C = (st & 1) * 32 + (swz % 64) / 2; }
__host__ __device__ __forceinline__ int perm32(int rho) { const int n = rho >> 4, i = rho & 15; return 8 * (i >> 2) + 4 * n + (i & 3); }
struct Unit { int pm, pn; int row0; int mvalid; int e; int mbase; const char* B; };
DEVI void xcd_tile(int L, int nwg, int nM, int nN, int& pm, int& pn) {
    int wgid = L; { const int q = nwg / NXCD, r = nwg % NXCD, xcd = wgid % NXCD, off = wgid / NXCD; wgid = (xcd < r ? xcd * (q + 1) : r * (q + 1) + (xcd - r) * q) + off; }
    const int nig = WGM * nN, gid = wgid / nig, fm = gid * WGM, gsz = (nM - fm) < WGM ? (nM - fm) : WGM;
    pm = fm + ((wgid % nig) % gsz); pn = (wgid % nig) / gsz;
}
struct DenseOrder {
    static constexpr bool GATHER = false;
    int nM, nN, nwg, G, c; const char* Bt; size_t tstepB;
    DEVI void init(int M, int N, int K, const bf16_t* Bt_, int G_, int c_) { nM = M / BM; nN = N / BM; nwg = nM * nN; G = G_; c = c_; Bt = (const char*)Bt_; tstepB = (size_t)BM * K * 2; }
    DEVI bool next(int i, Unit& u) const { const long L = (long)i * G + c; if (L >= nwg) return false; xcd_tile((int)L, nwg, nM, nN, u.pm, u.pn); u.row0 = u.pm * BM; u.mvalid = BM; u.e = 0; u.mbase = 0; u.B = Bt + (size_t)u.pn * tstepB; return true; }
    DEVI int arow(const Unit& u, int r) const { return u.row0 + r; }
};
struct MoeOrder {
    int nM, nN, nwg, G, c; const char* Bt; size_t estepB, tstepB; const volatile LAS int* tab; const int* list; bool gather;
    static constexpr bool GATHER = true;
    DEVI void init(const unsigned* cnt, volatile LAS int* tab_, int N, int K, const bf16_t* Bt_, size_t estep_bytes, const int* list_, bool gather_, int G_, int c_) {
        __syncthreads();
        if (threadIdx.x == 0) { int t = 0;
            for (int e = 0; e < 8; ++e) { const int n = (int)__hip_atomic_load(cnt + e, __ATOMIC_RELAXED, __HIP_MEMORY_SCOPE_AGENT); tab_[16 + e] = n; tab_[e] = t; t += (n + BM - 1) / BM; }
            tab_[8] = t; }
        __syncthreads();
        tab = tab_; nM = __builtin_amdgcn_readfirstlane(tab_[8]); nN = N / BM; nwg = nM * nN; G = G_; c = c_; Bt = (const char*)Bt_; estepB = estep_bytes; tstepB = (size_t)BM * K * 2; list = list_; gather = gather_;
    }
    DEVI bool next(int i, Unit& u) const { const long L = (long)i * G + c; if (L >= nwg) return false; xcd_tile((int)L, nwg, nM, nN, u.pm, u.pn);
        int e = 0;
        for (int k = 1; k < 8; ++k) if (u.pm >= __builtin_amdgcn_readfirstlane(tab[k])) e = k;
        const int t0 = __builtin_amdgcn_readfirstlane(tab[e]), n = __builtin_amdgcn_readfirstlane(tab[16 + e]);
        u.e = e; u.row0 = u.pm * BM; const int m0 = (u.pm - t0) * BM; u.mbase = m0; u.mvalid = (n - m0) < BM ? (n - m0) : BM; u.B = Bt + (size_t)e * estepB + (size_t)u.pn * tstepB; return true; }
    DEVI int arow(const Unit& u, int r) const {
        if (!gather) return u.row0 + r;
        const int m = u.mbase + r;
        return (r < u.mvalid) ? (list[u.e * MT + m] >> 1) : 0;
    }
};
DEVI unsigned cvt_pk_bf16(float lo, float hi) { unsigned r; asm volatile("v_cvt_pk_bf16_f32 %0, %1, %2" : "=v"(r) : "v"(lo), "v"(hi)); return r; }

struct EpiBf16 { static constexpr bool PERM = true; bf16_t* O; int ldc; const float* rs;
    DEVI void operator()(const f32x4 (&acc)[2][2][4][2], const Unit& u, int wr, int wc, int fr, int fq) const {
        const int row0 = u.row0 + wr * 64 + fr, col0 = u.pn * BM + wc * 32 + 8 * fq;
#pragma unroll
        for (int ai = 0; ai < 2; ++ai)
#pragma unroll
            for (int m = 0; m < 4; ++m) { const int row = row0 + ai * HALF + m * 16; bf16_t* rowp = O + (size_t)row * ldc + col0;
                const float sc = rs ? rs[row] : 1.f;
#pragma unroll
                for (int bj = 0; bj < 2; ++bj) { const f32x4 v0 = acc[ai][bj][m][0] * sc, v1 = acc[ai][bj][m][1] * sc;
                    u32x4 w; w.x = cvt_pk_bf16(v0[0], v0[1]); w.y = cvt_pk_bf16(v0[2], v0[3]); w.z = cvt_pk_bf16(v1[0], v1[1]); w.w = cvt_pk_bf16(v1[2], v1[3]);
                    *(u32x4*)(rowp + bj * HALF) = w; } }
    } };
struct EpiPleGate { static constexpr bool PERM = true; bf16_t* T; int ldc; const float* rs;
    DEVI void operator()(const f32x4 (&acc)[2][2][4][2], const Unit& u, int wr, int wc, int fr, int fq) const {
        const int row0 = u.row0 + wr * 64 + fr, col0 = u.pn * BM + wc * 32 + 8 * fq;
#pragma unroll
        for (int ai = 0; ai < 2; ++ai)
#pragma unroll
            for (int m = 0; m < 4; ++m) { const int row = row0 + ai * HALF + m * 16; bf16_t* rowp = T + (size_t)row * ldc + col0;
                const float sc = rs[row];
#pragma unroll
                for (int bj = 0; bj < 2; ++bj) { const f32x4 v0 = acc[ai][bj][m][0] * sc, v1 = acc[ai][bj][m][1] * sc;
                    const u32x4 pp = *(const u32x4*)(rowp + bj * HALF);
                    u32x4 w; w.x = cvt_pk_bf16(sigmoid_f(v0[0]) * bflo(pp.x), sigmoid_f(v0[1]) * bfhi(pp.x)); w.y = cvt_pk_bf16(sigmoid_f(v0[2]) * bflo(pp.y), sigmoid_f(v0[3]) * bfhi(pp.y));
                    w.z = cvt_pk_bf16(sigmoid_f(v1[0]) * bflo(pp.z), sigmoid_f(v1[1]) * bfhi(pp.z)); w.w = cvt_pk_bf16(sigmoid_f(v1[2]) * bflo(pp.w), sigmoid_f(v1[3]) * bfhi(pp.w));
                    *(u32x4*)(rowp + bj * HALF) = w; } }
    } };
struct EpiSwiglu { static constexpr bool PERM = true; bf16_t* O; int ldc; const float* rs; const int* list;
    DEVI void operator()(const f32x4 (&acc)[2][2][4][2], const Unit& u, int wr, int wc, int fr, int fq) const {
        const int row0 = u.row0 + wr * 64 + fr, col0 = u.pn * HALF + wc * 32 + 8 * fq;
#pragma unroll
        for (int ai = 0; ai < 2; ++ai)
#pragma unroll
            for (int m = 0; m < 4; ++m) { const int rl = wr * 64 + fr + ai * HALF + m * 16; bf16_t* rowp = O + (size_t)(u.row0 + rl) * ldc + col0;
                float sc;
                if (list) sc = (rl < u.mvalid) ? rs[list[u.e * MT + u.mbase + rl] >> 1] : 0.f; else sc = rs[u.row0 + rl];
                const f32x4 g0 = acc[ai][0][m][0] * sc, g1 = acc[ai][0][m][1] * sc, u0 = acc[ai][1][m][0] * sc, u1 = acc[ai][1][m][1] * sc;
                u32x4 w; w.x = cvt_pk_bf16(silu_f(g0[0]) * u0[0], silu_f(g0[1]) * u0[1]); w.y = cvt_pk_bf16(silu_f(g0[2]) * u0[2], silu_f(g0[3]) * u0[3]);
                w.z = cvt_pk_bf16(silu_f(g1[0]) * u1[0], silu_f(g1[1]) * u1[1]); w.w = cvt_pk_bf16(silu_f(g1[2]) * u1[2], silu_f(g1[3]) * u1[3]);
                *(u32x4*)rowp = w; }
    } };
struct EpiMoeDown { static constexpr bool PERM = true; bf16_t* Y; const int* list; const float* gatev;
    DEVI void operator()(const f32x4 (&acc)[2][2][4][2], const Unit& u, int wr, int wc, int fr, int fq) const {
        const int col0 = u.pn * BM + wc * 32 + 8 * fq;
        const int mbase = u.mbase;
#pragma unroll
        for (int ai = 0; ai < 2; ++ai)
#pragma unroll
            for (int m = 0; m < 4; ++m) { const int rl = wr * 64 + fr + ai * HALF + m * 16;
                if (rl < u.mvalid) {
                    const int tsl = list[u.e * MT + mbase + rl]; const float gt = gatev[u.e * MT + mbase + rl];
                    bf16_t* rowp = Y + (size_t)(tsl & 1) * ((size_t)MT * DM) + (size_t)(tsl >> 1) * DM + col0;
#pragma unroll
                    for (int bj = 0; bj < 2; ++bj) { const f32x4 v0 = acc[ai][bj][m][0], v1 = acc[ai][bj][m][1];
                        u32x4 w; w.x = cvt_pk_bf16(v0[0] * gt, v0[1] * gt); w.y = cvt_pk_bf16(v0[2] * gt, v0[3] * gt); w.z = cvt_pk_bf16(v1[0] * gt, v1[1] * gt); w.w = cvt_pk_bf16(v1[2] * gt, v1[3] * gt);
                        *(u32x4*)(rowp + bj * HALF) = w; } } }
    } };

template <class Epi, class Sched>
DEVI void gemm_phase(LAS unsigned char* lds, const bf16_t* A, const int K, const Sched& S, const Epi& E) {
    const int tid = opq((int)threadIdx.x), wid = __builtin_amdgcn_readfirstlane(tid >> 6), lane = tid & 63, wr = wid >> 2, wc = wid & 3, fr = lane & 15, fq = lane >> 4;
    const int nt = K / BK;
    int Rl[2], Cl[2]; unsigned voffB[2];
#pragma unroll
    for (int i = 0; i < 2; ++i) { int R, C; stage_rc(tid * 16 + i * 8192, R, C); Rl[i] = R; Cl[i] = C; const int Rb = Epi::PERM ? ((R & ~31) + perm32(R & 31)) : R; voffB[i] = (unsigned)(Rb * K + C) * 2u; }
    const size_t kstep = (size_t)(BK * 2);
    const size_t hstep = (size_t)HALF * K * 2;
    const unsigned ldsw = (unsigned)wid * 1024u;
    const int aoff = lds_byte(wr * 64 + fr, fq * 8), boff = lds_byte(wc * 32 + fr, fq * 8);
#define PG8_SA(b, h) (((b) * 2 + (h)) * HTB)
#define PG8_SB(b, h) ((4 + (b) * 2 + (h)) * HTB)
#define PG8_STAGE(bufoff, gbase, voff) do { _Pragma("unroll") for (int _i = 0; _i < 2; ++_i) \
        __builtin_amdgcn_global_load_lds((const unsigned*)((const char*)(gbase) + (voff)[_i]), (LAS unsigned*)(lds + (bufoff) + ldsw + _i * 8192), 16, 0, 0); } while (0)
#define PG8_LDA(dst, b, h) do { _Pragma("unroll") for (int m = 0; m < 4; ++m) _Pragma("unroll") for (int k = 0; k < 2; ++k) dst[m][k] = *(const LAS bf16x8*)(lds + PG8_SA(b, h) + aoff + m * 2048 + k * 1024); } while (0)
#define PG8_LDB(dst, b, h) do { _Pragma("unroll") for (int n = 0; n < 2; ++n) _Pragma("unroll") for (int k = 0; k < 2; ++k) dst[n][k] = *(const LAS bf16x8*)(lds + PG8_SB(b, h) + boff + n * 2048 + k * 1024); } while (0)
#define PG8_MMA(ai, bj, At, Bt) do { __builtin_amdgcn_s_setprio(1); _Pragma("unroll") for (int m = 0; m < 4; ++m) _Pragma("unroll") for (int n = 0; n < 2; ++n) _Pragma("unroll") for (int k = 0; k < 2; ++k) \
        acc[ai][bj][m][n] = __builtin_amdgcn_mfma_f32_16x16x32_bf16(Bt[n][k], At[m][k], acc[ai][bj][m][n], 0, 0, 0); __builtin_amdgcn_s_setprio(0); } while (0)
#define PG8_WAIT_V(n) asm volatile("s_waitcnt vmcnt(" #n ")" ::: "memory")
#define PG8_WAIT_L(n) asm volatile("s_waitcnt lgkmcnt(" #n ")" ::: "memory")
#define PG8_BAR __builtin_amdgcn_s_barrier()
#define PG8_SCHED __builtin_amdgcn_sched_barrier(0)
    Unit cur, nxt; int ui = 0;
    if (!S.next(0, cur)) return;
    f32x4 acc[2][2][4][2];
#pragma unroll
    for (int a = 0; a < 2; ++a)
#pragma unroll
        for (int b = 0; b < 2; ++b)
#pragma unroll
            for (int m = 0; m < 4; ++m)
#pragma unroll
                for (int n = 0; n < 2; ++n) acc[a][b][m][n] = (f32x4){0.f, 0.f, 0.f, 0.f};
    bf16x8 At[4][2], B0[2][2], B1[2][2];
    unsigned oc[2][2], on[2][2];
#pragma unroll
    for (int h = 0; h < 2; ++h)
#pragma unroll
        for (int i = 0; i < 2; ++i) oc[h][i] = ((unsigned)S.arow(cur, h * HALF + Rl[i]) * (unsigned)K + (unsigned)Cl[i]) * 2u;
    if (Sched::GATHER) { asm volatile("s_waitcnt vmcnt(0)" ::: "memory"); asm volatile("" : "+v"(oc[0][0]), "+v"(oc[0][1]), "+v"(oc[1][0]), "+v"(oc[1][1])); }
    const char* const Ab = (const char*)A;
    const char* cB = cur.B;
    PG8_STAGE(PG8_SB(0, 0), cB, voffB); PG8_STAGE(PG8_SA(0, 0), Ab, oc[0]); PG8_STAGE(PG8_SB(0, 1), cB + hstep, voffB); PG8_STAGE(PG8_SA(0, 1), Ab, oc[1]);
    if (wr == 1) PG8_BAR;
    PG8_WAIT_V(4); PG8_BAR;
    PG8_STAGE(PG8_SB(1, 0), cB + kstep, voffB); PG8_STAGE(PG8_SA(1, 0), Ab + kstep, oc[0]); PG8_STAGE(PG8_SB(1, 1), cB + hstep + kstep, voffB);
    PG8_WAIT_V(6); PG8_BAR;
    for (;;) {
        const bool has_next = S.next(ui + 1, nxt);
        if (has_next) {
#pragma unroll
            for (int h = 0; h < 2; ++h)
#pragma unroll
                for (int i = 0; i < 2; ++i) on[h][i] = ((unsigned)S.arow(nxt, h * HALF + Rl[i]) * (unsigned)K + (unsigned)Cl[i]) * 2u;
            if (Sched::GATHER) { asm volatile("s_waitcnt vmcnt(0)" ::: "memory"); asm volatile("" : "+v"(on[0][0]), "+v"(on[0][1]), "+v"(on[1][0]), "+v"(on[1][1])); }
        } else {
#pragma unroll
            for (int h = 0; h < 2; ++h)
#pragma unroll
                for (int i = 0; i < 2; ++i) on[h][i] = oc[h][i];
        }
        const char* nB = has_next ? nxt.B : cB;
        for (int t = 0; t < nt; t += 2) {
            const bool last = (t == nt - 2);
            const char* a1 = Ab + (size_t)(t + 1) * kstep;
            const char* a2 = last ? Ab : Ab + (size_t)(t + 2) * kstep; const char* b2 = last ? nB : cB + (size_t)(t + 2) * kstep;
            const char* a3 = a2 + kstep; const char* b3 = b2 + kstep;
            unsigned o2[2][2];
#pragma unroll
            for (int h = 0; h < 2; ++h)
#pragma unroll
                for (int i = 0; i < 2; ++i) o2[h][i] = last ? on[h][i] : oc[h][i];
            PG8_LDB(B0, 0, 0); PG8_SCHED; PG8_LDA(At, 0, 0); PG8_STAGE(PG8_SA(1, 1), a1, oc[1]);
            PG8_WAIT_L(8); PG8_BAR; PG8_WAIT_L(0); PG8_MMA(0, 0, At, B0); PG8_BAR; PG8_SCHED;
            PG8_LDB(B1, 0, 1); PG8_STAGE(PG8_SB(0, 0), b2, voffB);
            PG8_BAR; PG8_WAIT_L(0); PG8_MMA(0, 1, At, B1); PG8_BAR;
            PG8_LDA(At, 0, 1); PG8_STAGE(PG8_SA(0, 0), a2, o2[0]);
            PG8_BAR; PG8_WAIT_L(0); PG8_MMA(1, 0, At, B0); PG8_BAR; PG8_SCHED;
            PG8_STAGE(PG8_SB(0, 1), b2 + hstep, voffB);
            PG8_WAIT_V(6); PG8_BAR; PG8_MMA(1, 1, At, B1); PG8_BAR;
            PG8_LDB(B0, 1, 0); PG8_SCHED; PG8_LDA(At, 1, 0); PG8_STAGE(PG8_SA(0, 1), a2, o2[1]);
            PG8_WAIT_L(8); PG8_BAR; PG8_WAIT_L(0); PG8_MMA(0, 0, At, B0); PG8_BAR; PG8_SCHED;
            PG8_LDB(B1, 1, 1); PG8_STAGE(PG8_SB(1, 0), b3, voffB);
            PG8_BAR; PG8_WAIT_L(0); PG8_MMA(0, 1, At, B1); PG8_BAR;
            PG8_LDA(At, 1, 1); PG8_STAGE(PG8_SA(1, 0), a3, o2[0]);
            PG8_BAR; PG8_WAIT_L(0); PG8_MMA(1, 0, At, B0); PG8_BAR; PG8_SCHED;
            PG8_STAGE(PG8_SB(1, 1), b3 + hstep, voffB);
            PG8_WAIT_V(6); PG8_BAR; PG8_MMA(1, 1, At, B1); PG8_BAR;
        }
        E(acc, cur, wr, wc, fr, fq);
        if (!has_next) break;
#pragma unroll
        for (int a = 0; a < 2; ++a)
#pragma unroll
            for (int b = 0; b < 2; ++b)
#pragma unroll
                for (int m = 0; m < 4; ++m)
#pragma unroll
                    for (int n = 0; n < 2; ++n) acc[a][b][m][n] = (f32x4){0.f, 0.f, 0.f, 0.f};
        cur = nxt; cB = nB; ++ui;
#pragma unroll
        for (int h = 0; h < 2; ++h)
#pragma unroll
            for (int i = 0; i < 2; ++i) oc[h][i] = on[h][i];
    }
    PG8_WAIT_V(0);
    if (wr == 0) PG8_BAR;
    PG8_BAR;
#undef PG8_SA
#undef PG8_SB
#undef PG8_STAGE
#undef PG8_LDA
#undef PG8_LDB
#undef PG8_MMA
#undef PG8_WAIT_V
#undef PG8_WAIT_L
#undef PG8_BAR
#undef PG8_SCHED
}
}

DEVI float lb_of(const float* lbraw, int ch) {
    const float r0 = lbraw[ch], r1 = lbraw[512 + ch], r2 = lbraw[1024 + ch];
    const float mx = fmaxf(r0, fmaxf(r1, r2));
    const float e0 = __expf(r0 - mx), e1 = __expf(r1 - mx), e2 = __expf(r2 - mx);
    return e0 / (e0 + e1 + e2);
}
DEVI void ph_hgrn_naive(float* lds, const bf16_t* u, const float* lbraw, float* oacc, int vb0, int vbs) {
    float* sq = lds; float* sk = lds + 2048; float* sf = lds + 4096; float* sv = lds + 6144;
    const int tid = opq((int)threadIdx.x), j = tid >> 2, kq = tid & 3;
    for (int vb = vb0; vb < 32; vb += vbs) {
        const int dir = vb & 1, h = (vb >> 1) & 3, b = vb >> 3;
        float st[32];
#pragma unroll
        for (int i = 0; i < 32; ++i) st[i] = 0.f;
        for (int tb = 0; tb < SEQ / 16; ++tb) {
            __syncthreads();
            for (int e = tid; e < 2048; e += NTHR) {
                const int i = e >> 7, c = e & 127;
                const int t = dir ? (SEQ - 1 - (tb * 16 + i)) : (tb * 16 + i);
                const bf16_t* ur = u + (size_t)(b * SEQ + t) * UW;
                const int ch = h * 128 + c;
                const float qr = bf2f(ur[ch]), fr = bf2f(ur[(dir ? 1024 : 512) + ch]), vr = bf2f(ur[1536 + ch]);
                const float lb = lb_of(lbraw, ch);
                const float f = lb + (1.f - lb) * sigmoid_f(fr);
                sq[e] = silu_f(qr); sk[e] = 1.f - f; sf[e] = f; sv[e] = vr;
            }
            __syncthreads();
            for (int i = 0; i < 16; ++i) {
                const float vj = sv[i * 128 + j]; float acc = 0.f;
#pragma unroll
                for (int kk = 0; kk < 32; ++kk) {
                    const int kidx = kk * 4 + kq;
                    st[kk] = sf[i * 128 + kidx] * st[kk] + sk[i * 128 + kidx] * vj;
                    acc += st[kk] * sq[i * 128 + kidx];
                }
                acc += __shfl_xor(acc, 1); acc += __shfl_xor(acc, 2);
                if (kq == 0) {
                    const int t = dir ? (SEQ - 1 - (tb * 16 + i)) : (tb * 16 + i);
                    atomicAdd(&oacc[(size_t)(b * SEQ + t) * DM + h * 128 + j], acc);
                }
            }
        }
    }
    __syncthreads();
}

DEVI void ph_mixfin_hgrn(const bf16_t* u, const float* oacc, const float* a_norm, bf16_t* ocat, int vb0, int vbs) {
    const int tidq = opq((int)threadIdx.x); const int hw = tidq >> 5, l32 = tidq & 31;
    for (int row = vb0 * 16 + hw; row < MT; row += vbs * 16) {
        const int c0 = l32 * 16; float v[16]; float ss = 0.f;
        const bf16_t* ur = u + (size_t)row * UW;
#pragma unroll
        for (int i = 0; i < 16; ++i) { v[i] = oacc[(size_t)row * DM + c0 + i]; ss += v[i] * v[i]; }
        ss += __shfl_xor(ss, 1); ss += __shfl_xor(ss, 2); ss += __shfl_xor(ss, 4);
        const float r = rsqrtf(ss * (1.f / 128.f) + EPS);
#pragma unroll
        for (int i = 0; i < 16; ++i) { const int c = c0 + i; ocat[(size_t)row * DM + c] = f2bf(v[i] * r * a_norm[c & 127] * silu_f(bf2f(ur[2048 + c]))); }
    }
}


constexpr int HQ = 0, HK = 17408, HKH = 34816, HV = 53248, HDV = 71680, HGL = 73728, HOT = 75776, H_END = HOT + 64 * 528;
static_assert(H_END <= 131072, "hgrn lds");
constexpr size_t HS_SCAN = (size_t)16 * 16384;
DEVI float hgrn_prep(LAS unsigned char* lds, const bf16_t* u, float lbv, int dir, size_t tokbase, int h, int c, int I) {
    float g[16], kk[16], qq[16];
    const bf16_t* up = u + (tokbase + 16 * I) * UW + h * 128 + c;
    const int fcol = dir ? 1024 : 512;
#pragma unroll
    for (int j = 0; j < 16; ++j) {
        const float fr = bf2f(up[(size_t)j * UW + fcol]), qr = bf2f(up[(size_t)j * UW]);
        const float f = lbv + (1.f - lbv) * sigmoid_f(fr);
        g[j] = __logf(f); kk[j] = 1.f - f; qq[j] = silu_f(qr);
    }
    float run = 0.f;
#pragma unroll
    for (int jj = 0; jj < 16; ++jj) { const int j = dir ? 15 - jj : jj; run += g[j]; g[j] = run; }
    const float G = run;
    float kh[16];
#pragma unroll
    for (int j = 0; j < 16; ++j) {
        const float qt = qq[j] * __expf(g[j]), kt = kk[j] * __expf(-g[j]);
        kh[j] = kk[j] * __expf(G - g[j]);
        *(LAS bf16_t*)(lds + HQ + (16 * I + j) * 272 + c * 2) = f2bf(qt);
        *(LAS bf16_t*)(lds + HK + (16 * I + j) * 272 + c * 2) = f2bf(kt);
    }
    u32x4 w0, w1;
    w0.x = pk2(kh[0], kh[1]); w0.y = pk2(kh[2], kh[3]); w0.z = pk2(kh[4], kh[5]); w0.w = pk2(kh[6], kh[7]);
    w1.x = pk2(kh[8], kh[9]); w1.y = pk2(kh[10], kh[11]); w1.z = pk2(kh[12], kh[13]); w1.w = pk2(kh[14], kh[15]);
    *(LAS u32x4*)(lds + HKH + c * 144 + I * 32) = w0; *(LAS u32x4*)(lds + HKH + c * 144 + I * 32 + 16) = w1;
    *(LAS float*)(lds + HDV + (I * 128 + c) * 4) = __expf(G);
    return G;
}
DEVI void hgrn_update(LAS unsigned char* lds, f32x4 (&Sacc)[8], int I, int wid, int fr, int fq) {
    const u32x4 z4 = {0u, 0u, 0u, 0u};
    const u32x4 vb = (fq < 2) ? *(const LAS u32x4*)(lds + HV + (16 * wid + fr) * 144 + (16 * I + 8 * fq) * 2) : z4;
#pragma unroll
    for (int m = 0; m < 8; ++m) {
        const f32x4 dv = *(const LAS f32x4*)(lds + HDV + (I * 128 + 16 * m + 4 * fq) * 4);
        const u32x4 ka = (fq < 2) ? *(const LAS u32x4*)(lds + HKH + (16 * m + fr) * 144 + (16 * I + 8 * fq) * 2) : z4;
        Sacc[m] = __builtin_amdgcn_mfma_f32_16x16x32_bf16(__builtin_bit_cast(bf16x8, ka), __builtin_bit_cast(bf16x8, vb), Sacc[m] * dv, 0, 0, 0);
    }
}
DEVI void stage_vt(LAS unsigned char* lds, const bf16_t* VT, int b, int h, int t0, int tid) {
    for (int e = tid; e < 128 * 8; e += NTHR) { const int r = e >> 3, cch = e & 7; *(LAS u32x4*)(lds + HV + r * 144 + cch * 16) = *(const u32x4*)(VT + ((size_t)b * 512 + h * 128 + r) * SEQ + t0 + cch * 8); }
}
DEVI void ph_hgrn_states(LAS unsigned char* lds, const bf16_t* u, const bf16_t* VT, const float* lbraw, float* HS, float* HD, int vb0, int vbs) {
    const int tid = opq((int)threadIdx.x), wid = __builtin_amdgcn_readfirstlane(tid >> 6), lane = tid & 63, fr = lane & 15, fq = lane >> 4;
    const int pc = tid & 127, pI = tid >> 7;
    for (int unit = vb0; unit < NB * 4 * 2 * 16; unit += vbs) {
        const int seg = unit & 15, dir = (unit >> 4) & 1, h = (unit >> 5) & 3, b = unit >> 7;
        const float lbv = lb_of(lbraw, h * 128 + pc);
        f32x4 Sacc[8];
#pragma unroll
        for (int m = 0; m < 8; ++m) Sacc[m] = (f32x4){0.f, 0.f, 0.f, 0.f};
        float gsum = 0.f;
#pragma unroll 1
        for (int sbi = 0; sbi < 4; ++sbi) {
            const int sb = dir ? 3 - sbi : sbi;
            const int t0 = seg * 256 + sb * 64;
            __syncthreads();
            const float G = hgrn_prep(lds, u, lbv, dir, (size_t)b * SEQ + t0, h, pc, pI);
            *(LAS float*)(lds + HGL + (pI * 128 + pc) * 4) = G;
            stage_vt(lds, VT, b, h, t0, tid);
            __syncthreads();
            if (tid < 128) gsum += *(const LAS float*)(lds + HGL + tid * 4) + *(const LAS float*)(lds + HGL + (128 + tid) * 4) + *(const LAS float*)(lds + HGL + (256 + tid) * 4) + *(const LAS float*)(lds + HGL + (384 + tid) * 4);
#pragma unroll 1
            for (int ii = 0; ii < 4; ++ii) { const int I = dir ? 3 - ii : ii; hgrn_update(lds, Sacc, I, wid, fr, fq); }
        }
        const size_t scan = (size_t)(b * 4 + h) * 2 + dir;
        float* dst = HS + scan * HS_SCAN + (size_t)seg * 16384;
#pragma unroll
        for (int m = 0; m < 8; ++m)
#pragma unroll
            for (int rg = 0; rg < 4; ++rg) dst[(16 * m + 4 * fq + rg) * 128 + 16 * wid + fr] = Sacc[m][rg];
        if (tid < 128) HD[(scan * 16 + seg) * 128 + tid] = __expf(gsum);
    }
    __syncthreads();
}
DEVI void ph_hgrn_scan(float* HS, const float* HD, int vb0, int vbs) {
    const int tid = opq((int)threadIdx.x);
    for (int idx = vb0 * NTHR + tid; idx < 32 * 4096; idx += vbs * NTHR) {
        const int scan = idx >> 12, e4 = idx & 4095, kch = e4 >> 5; const int dir = scan & 1;
        float4* base = (float4*)(HS + (size_t)scan * HS_SCAN) + e4;
        const float* hd = HD + (size_t)scan * 16 * 128 + kch;
        float4 st = make_float4(0.f, 0.f, 0.f, 0.f);
        for (int i = 0; i < 16; ++i) {
            const int sg = dir ? 15 - i : i;
            const float4 d = base[(size_t)sg * 4096]; const float dec = hd[sg * 128];
            base[(size_t)sg * 4096] = st;
            st.x = st.x * dec + d.x; st.y = st.y * dec + d.y; st.z = st.z * dec + d.z; st.w = st.w * dec + d.w;
        }
    }
}
DEVI void ph_hgrn_out(LAS unsigned char* lds, const bf16_t* u, const bf16_t* VT, const float* lbraw, const float* a_norm, const float* HS, float* OF, bf16_t* ocat, int vb0, int vbs) {
    const int tid = opq((int)threadIdx.x), wid = __builtin_amdgcn_readfirstlane(tid >> 6), lane = tid & 63, fr = lane & 15, fq = lane >> 4;
    const int pc = tid & 127, pI = tid >> 7;
    const int otok = tid >> 3, opart = tid & 7;
    for (int unit = vb0; unit < NB * 4 * 16; unit += vbs) {
        const int seg = unit & 15, h = (unit >> 4) & 3, b = unit >> 6;
        const float lbv = lb_of(lbraw, h * 128 + pc);
#pragma unroll 1
        for (int dir = 0; dir < 2; ++dir) {
            const size_t scan = (size_t)(b * 4 + h) * 2 + dir;
            const float* src = HS + scan * HS_SCAN + (size_t)seg * 16384;
            f32x4 Sacc[8];
#pragma unroll
            for (int m = 0; m < 8; ++m)
#pragma unroll
                for (int rg = 0; rg < 4; ++rg) Sacc[m][rg] = src[(16 * m + 4 * fq + rg) * 128 + 16 * wid + fr];
#pragma unroll 1
            for (int sbi = 0; sbi < 4; ++sbi) {
                const int sb = dir ? 3 - sbi : sbi;
                const int t0 = seg * 256 + sb * 64;
                const size_t tokb = (size_t)b * SEQ + t0;
                __syncthreads();
                (void)hgrn_prep(lds, u, lbv, dir, tokb, h, pc, pI);
                stage_vt(lds, VT, b, h, t0, tid);
                __syncthreads();
#pragma unroll 1
                for (int ii = 0; ii < 4; ++ii) {
                    const int I = dir ? 3 - ii : ii;
                    f32x4 oT = {0.f, 0.f, 0.f, 0.f};
                    const LAS unsigned char* qrow = lds + HQ + (16 * I + fr) * 272;
#pragma unroll
                    for (int ks = 0; ks < 4; ++ks) {
                        u32x4 sa; sa.x = pg8::cvt_pk_bf16(Sacc[2 * ks][0], Sacc[2 * ks][1]); sa.y = pg8::cvt_pk_bf16(Sacc[2 * ks][2], Sacc[2 * ks][3]);
                        sa.z = pg8::cvt_pk_bf16(Sacc[2 * ks + 1][0], Sacc[2 * ks + 1][1]); sa.w = pg8::cvt_pk_bf16(Sacc[2 * ks + 1][2], Sacc[2 * ks + 1][3]);
                        const u32x2 q0 = *(const LAS u32x2*)(qrow + (32 * ks + 4 * fq) * 2), q1 = *(const LAS u32x2*)(qrow + (32 * ks + 16 + 4 * fq) * 2);
                        u32x4 qb; qb.x = q0.x; qb.y = q0.y; qb.z = q1.x; qb.w = q1.y;
                        oT = __builtin_amdgcn_mfma_f32_16x16x32_bf16(__builtin_bit_cast(bf16x8, sa), __builtin_bit_cast(bf16x8, qb), oT, 0, 0, 0);
                    }
                    f32x4 sT = {0.f, 0.f, 0.f, 0.f};
                    const LAS unsigned char* krow = lds + HK + (16 * I + fr) * 272;
#pragma unroll
                    for (int ks = 0; ks < 4; ++ks) {
                        const bf16x8 ka = *(const LAS bf16x8*)(krow + (32 * ks + 8 * fq) * 2), qb = *(const LAS bf16x8*)(qrow + (32 * ks + 8 * fq) * 2);
                        sT = __builtin_amdgcn_mfma_f32_16x16x32_bf16(ka, qb, sT, 0, 0, 0);
                    }
                    float pv[4];
#pragma unroll
                    for (int rg = 0; rg < 4; ++rg) { const int sl = 4 * fq + rg; const bool ok = dir ? (sl >= fr) : (sl <= fr); pv[rg] = ok ? sT[rg] : 0.f; }
                    u32x4 pb; pb.x = pg8::cvt_pk_bf16(pv[0], pv[1]); pb.y = pg8::cvt_pk_bf16(pv[2], pv[3]); pb.z = 0u; pb.w = 0u;
                    const u32x2 v0 = *(const LAS u32x2*)(lds + HV + (16 * wid + fr) * 144 + (16 * I + 4 * fq) * 2);
                    u32x4 va; va.x = v0.x; va.y = v0.y; va.z = 0u; va.w = 0u;
                    oT = __builtin_amdgcn_mfma_f32_16x16x32_bf16(__builtin_bit_cast(bf16x8, va), __builtin_bit_cast(bf16x8, pb), oT, 0, 0, 0);
                    *(LAS f32x4*)(lds + HOT + (16 * I + fr) * 528 + (16 * wid + 4 * fq) * 4) = oT;
                    hgrn_update(lds, Sacc, I, wid, fr, fq);
                }
                __syncthreads();
                const LAS float* orow = (const LAS float*)(lds + HOT + otok * 528) + opart * 16;
                float* ofp = OF + (tokb + otok) * 512 + h * 128 + opart * 16;
                if (dir == 0) {
#pragma unroll
                    for (int q4 = 0; q4 < 4; ++q4) { const f32x4 v = *(const LAS f32x4*)(orow + q4 * 4);
                        __hip_atomic_store((unsigned long long*)(ofp + q4 * 4), (unsigned long long)__float_as_uint(v[0]) | ((unsigned long long)__float_as_uint(v[1]) << 32), __ATOMIC_RELAXED, __HIP_MEMORY_SCOPE_AGENT);
                        __hip_atomic_store((unsigned long long*)(ofp + q4 * 4 + 2), (unsigned long long)__float_as_uint(v[2]) | ((unsigned long long)__float_as_uint(v[3]) << 32), __ATOMIC_RELAXED, __HIP_MEMORY_SCOPE_AGENT); }
                } else {
                    float v[16]; float ss = 0.f;
#pragma unroll
                    for (int q2 = 0; q2 < 8; ++q2) { const unsigned long long w = __hip_atomic_load((unsigned long long*)(ofp + q2 * 2), __ATOMIC_RELAXED, __HIP_MEMORY_SCOPE_AGENT);
                        v[2 * q2] = __uint_as_float((unsigned)w) + orow[2 * q2]; v[2 * q2 + 1] = __uint_as_float((unsigned)(w >> 32)) + orow[2 * q2 + 1];
                        ss += v[2 * q2] * v[2 * q2] + v[2 * q2 + 1] * v[2 * q2 + 1]; }
                    ss += __shfl_xor(ss, 1); ss += __shfl_xor(ss, 2); ss += __shfl_xor(ss, 4);
                    const float rn = rsqrtf(ss * (1.f / 128.f) + EPS);
                    const bf16_t* gp = u + (tokb + otok) * UW + 2048 + h * 128 + opart * 16;
                    const u32x4 g0 = *(const u32x4*)gp, g1 = *(const u32x4*)(gp + 8);
                    const unsigned gw[8] = {g0.x, g0.y, g0.z, g0.w, g1.x, g1.y, g1.z, g1.w};
                    unsigned ow[8];
#pragma unroll
                    for (int q2 = 0; q2 < 8; ++q2) { const float an0 = a_norm[opart * 16 + 2 * q2], an1 = a_norm[opart * 16 + 2 * q2 + 1];
                        ow[q2] = pk2(v[2 * q2] * rn * an0 * silu_f(bflo(gw[q2])), v[2 * q2 + 1] * rn * an1 * silu_f(bfhi(gw[q2]))); }
                    bf16_t* op = ocat + (tokb + otok) * DM + h * 128 + opart * 16;
                    u32x4 o0, o1; o0.x = ow[0]; o0.y = ow[1]; o0.z = ow[2]; o0.w = ow[3]; o1.x = ow[4]; o1.y = ow[5]; o1.z = ow[6]; o1.w = ow[7];
                    *(u32x4*)op = o0; *(u32x4*)(op + 8) = o1;
                }
            }
            asm volatile("s_waitcnt vmcnt(0)" ::: "memory");
        }
    }
    __syncthreads();
}

DEVI void ph_prep(const bf16_t* u, const float* cw, const float* cb, bf16_t* xconv, bf16_t* XT, bf16_t* VT, int vb0, int vbs) {
    const int tid = opq((int)threadIdx.x);
    for (int unit = vb0; unit < NB * 32 * 3; unit += vbs) {
        const int cg = unit % 3, tb = (unit / 3) & 31, b = unit / 96;
        const int t0 = tb * 128;
        if (cg < 2) {
            const int ch = cg * 512 + tid;
            float w[5];
#pragma unroll
            for (int j = 0; j < 5; ++j) w[j] = cw[j * 1024 + ch];
            const float bias = cb[ch];
            const bf16_t* up = u + (size_t)b * SEQ * UW + 3072 + ch;
            float v0, v1, v2, v3;
            v0 = (t0 - 2 >= 0) ? bf2f(up[(size_t)(t0 - 2) * UW]) : 0.f;
            v1 = (t0 - 1 >= 0) ? bf2f(up[(size_t)(t0 - 1) * UW]) : 0.f;
            v2 = bf2f(up[(size_t)t0 * UW]);
            v3 = bf2f(up[(size_t)(t0 + 1) * UW]);
            for (int t8 = 0; t8 < 128; t8 += 8) {
                float nx[8];
#pragma unroll
                for (int i = 0; i < 8; ++i) { const int tt = t0 + t8 + i + 2; nx[i] = (tt < SEQ) ? bf2f(up[(size_t)tt * UW]) : 0.f; }
                unsigned pk[4];
#pragma unroll
                for (int i = 0; i < 8; ++i) {
                    const float o = silu_f(bias + w[0] * v0 + w[1] * v1 + w[2] * v2 + w[3] * v3 + w[4] * nx[i]);
                    const bf16_t ob = f2bf(o);
                    xconv[(size_t)(b * SEQ + t0 + t8 + i) * 1024 + ch] = ob;
                    if (i & 1) pk[i >> 1] |= ((unsigned)ob << 16); else pk[i >> 1] = ob;
                    v0 = v1; v1 = v2; v2 = v3; v3 = nx[i];
                }
                if (ch < 768) { u32x4 o4; o4.x = pk[0]; o4.y = pk[1]; o4.z = pk[2]; o4.w = pk[3]; *(u32x4*)(XT + ((size_t)b * 768 + ch) * SEQ + t0 + t8) = o4; }
            }
        } else {
            const int ch = tid;
            const bf16_t* up = u + (size_t)b * SEQ * UW + 1536 + ch;
            for (int t8 = 0; t8 < 128; t8 += 8) {
                unsigned pk[4];
#pragma unroll
                for (int i = 0; i < 8; ++i) { const unsigned ob = up[(size_t)(t0 + t8 + i) * UW]; if (i & 1) pk[i >> 1] |= (ob << 16); else pk[i >> 1] = ob; }
                u32x4 o4; o4.x = pk[0]; o4.y = pk[1]; o4.z = pk[2]; o4.w = pk[3]; *(u32x4*)(VT + ((size_t)b * 512 + ch) * SEQ + t0 + t8) = o4;
            }
        }
    }
}

constexpr int MB_XT = 0, MB_BX = 256 * 272, MB_DT = MB_BX + 128 * 272, MB_CS = MB_DT + 8 * 128 * 4, MB_TOT = MB_CS + 8 * 128 * 4, MB_END = MB_TOT + 64;
static_assert(MB_END <= 131072, "mamba lds");
constexpr size_t MS_SCAN = (size_t)32 * 8192;
DEVI bf16x8 pack8(const float* v) { u32x4 w; w.x = pg8::cvt_pk_bf16(v[0], v[1]); w.y = pg8::cvt_pk_bf16(v[2], v[3]); w.z = pg8::cvt_pk_bf16(v[4], v[5]); w.w = pg8::cvt_pk_bf16(v[6], v[7]); return __builtin_bit_cast(bf16x8, w); }
DEVI void mamba_tables(LAS unsigned char* lds, const float* dtraw, const float* A_log, const float* dt_bias, int b, int g, int c, int wid, int lane) {
    LAS float* tdt = (LAS float*)(lds + MB_DT); LAS float* tcs = (LAS float*)(lds + MB_CS); LAS float* ttot = (LAS float*)(lds + MB_TOT);
    const int r = wid >> 1, dir = wid & 1, hd = 4 * g + r;
    const float A = -__expf(A_log[dir * 8 + hd]), bias = dt_bias[dir * 8 + hd];
    const size_t tk = (size_t)b * SEQ + c * 128 + 2 * lane;
    const float dt0 = softplus_f(dtraw[tk * 16 + dir * 8 + hd] + bias), dt1 = softplus_f(dtraw[(tk + 1) * 16 + dir * 8 + hd] + bias);
    const float a0 = dt0 * A, a1 = dt1 * A;
    float sc = a0 + a1;
#pragma unroll
    for (int off = 1; off < 64; off <<= 1) { const float v = __shfl_up(sc, off); if (lane >= off) sc += v; }
    const float total = __shfl(sc, 63);
    const float pre0 = sc - a1, pre1 = sc;
    const float c0 = dir ? (total - pre0 + a0) : pre0, c1 = dir ? (total - pre1 + a1) : pre1;
    tdt[wid * 128 + 2 * lane] = dt0; tdt[wid * 128 + 2 * lane + 1] = dt1;
    tcs[wid * 128 + 2 * lane] = c0; tcs[wid * 128 + 2 * lane + 1] = c1;
    if (lane == 0) ttot[wid] = total;
}
DEVI void stage_rows(LAS unsigned char* dst, const bf16_t* src, size_t src_stride, int rows, int tid) {
    for (int e = tid; e < rows * 16; e += NTHR) { const int r = e >> 4, cch = e & 15; *(LAS u32x4*)(dst + r * 272 + cch * 16) = *(const u32x4*)(src + (size_t)r * src_stride + cch * 8); }
}
DEVI void ph_mamba_states(LAS unsigned char* lds, const bf16_t* XT, const float* dtraw, const float* A_log, const float* dt_bias, float* MS, float* MD, int vb0, int vbs) {
    const int tid = opq((int)threadIdx.x), wid = __builtin_amdgcn_readfirstlane(tid >> 6), lane = tid & 63, fr = lane & 15, fq = lane >> 4;
    LAS float* tdt = (LAS float*)(lds + MB_DT); LAS float* tcs = (LAS float*)(lds + MB_CS); LAS float* ttot = (LAS float*)(lds + MB_TOT);
    for (int unit = vb0; unit < NB * 2 * 32; unit += vbs) {
        const int c = unit & 31, g = (unit >> 5) & 1, b = unit >> 6;
        __syncthreads();
        stage_rows(lds + MB_XT, XT + ((size_t)b * 768 + g * 256) * SEQ + c * 128, SEQ, 256, tid);
        stage_rows(lds + MB_BX, XT + ((size_t)b * 768 + 512 + g * 128) * SEQ + c * 128, SEQ, 128, tid);
        mamba_tables(lds, dtraw, A_log, dt_bias, b, g, c, wid, lane);
        __syncthreads();
        if (lane == 0) MD[((size_t)(b * 8 + 4 * g + (wid >> 1)) * 2 + (wid & 1)) * 32 + c] = __expf(ttot[wid]);
        for (int hdd = 0; hdd < 8; ++hdd) {
            const int r = hdd >> 1, dir = hdd & 1, hd = 4 * g + r;
            const float tot = ttot[hdd];
            f32x4 acc[4];
#pragma unroll
            for (int pt = 0; pt < 4; ++pt) acc[pt] = (f32x4){0.f, 0.f, 0.f, 0.f};
#pragma unroll
            for (int ks = 0; ks < 4; ++ks) {
                const int s0 = 32 * ks + 8 * fq;
                const u32x4 braw = *(const LAS u32x4*)(lds + MB_BX + (16 * wid + fr) * 272 + s0 * 2);
                float bw[8];
                const unsigned bu[4] = {braw.x, braw.y, braw.z, braw.w};
#pragma unroll
                for (int j = 0; j < 8; ++j) { const float bv = (j & 1) ? bfhi(bu[j >> 1]) : bflo(bu[j >> 1]);
                    bw[j] = bv * tdt[hdd * 128 + s0 + j] * __expf(tot - tcs[hdd * 128 + s0 + j]); }
                const bf16x8 Bf = pack8(bw);
#pragma unroll
                for (int pt = 0; pt < 4; ++pt) {
                    const bf16x8 Af = *(const LAS bf16x8*)(lds + MB_XT + (r * 64 + 16 * pt + fr) * 272 + s0 * 2);
                    acc[pt] = __builtin_amdgcn_mfma_f32_16x16x32_bf16(Af, Bf, acc[pt], 0, 0, 0);
                }
            }
            float* dst = MS + ((size_t)(b * 8 + hd) * 2 + dir) * MS_SCAN + (size_t)c * 8192;
#pragma unroll
            for (int pt = 0; pt < 4; ++pt)
#pragma unroll
                for (int rg = 0; rg < 4; ++rg) dst[(16 * pt + 4 * fq + rg) * 128 + 16 * wid + fr] = acc[pt][rg];
        }
    }
    __syncthreads();
}
DEVI void ph_mamba_scan(float* MS, const float* MD, int vb0, int vbs) {
    const int tid = opq((int)threadIdx.x);
    for (int idx = vb0 * NTHR + tid; idx < 64 * 2048; idx += vbs * NTHR) {
        const int scan = idx >> 11, e4 = idx & 2047; const int dir = scan & 1;
        float4* base = (float4*)(MS + (size_t)scan * MS_SCAN) + e4;
        const float* md = MD + (size_t)scan * 32;
        float4 h = make_float4(0.f, 0.f, 0.f, 0.f);
        for (int i = 0; i < 32; ++i) {
            const int c = dir ? 31 - i : i;
            const float4 d = base[(size_t)c * 2048]; const float dec = md[c];
            base[(size_t)c * 2048] = h;
            h.x = h.x * dec + d.x; h.y = h.y * dec + d.y; h.z = h.z * dec + d.z; h.w = h.w * dec + d.w;
        }
    }
}
DEVI void ph_mamba_out(LAS unsigned char* lds, const bf16_t* u, const bf16_t* xconv, const bf16_t* XT, const float* dtraw, const float* A_log, const float* dt_bias, const float* Dskip, const float* b_norm,
                       const float* MS, bf16_t* ocat, int vb0, int vbs) {
    const int tid = opq((int)threadIdx.x), wid = __builtin_amdgcn_readfirstlane(tid >> 6), lane = tid & 63, fr = lane & 15, fq = lane >> 4;
    LAS float* tdt = (LAS float*)(lds + MB_DT); LAS float* tcs = (LAS float*)(lds + MB_CS);
    for (int unit = vb0; unit < NB * 2 * 32; unit += vbs) {
        const int c = unit & 31, g = (unit >> 5) & 1, b = unit >> 6;
        const size_t tok0 = (size_t)b * SEQ + c * 128;
        __syncthreads();
        stage_rows(lds + MB_XT, XT + ((size_t)b * 768 + g * 256) * SEQ + c * 128, SEQ, 256, tid);
        stage_rows(lds + MB_BX, xconv + tok0 * 1024 + 512 + g * 128, 1024, 128, tid);
        mamba_tables(lds, dtraw, A_log, dt_bias, b, g, c, wid, lane);
        const int tl = 16 * wid + fr;
        bf16x8 Cf[4];
#pragma unroll
        for (int ks = 0; ks < 4; ++ks) Cf[ks] = *(const bf16x8*)(xconv + (tok0 + tl) * 1024 + 768 + g * 128 + 32 * ks + 8 * fq);
        __syncthreads();
        f32x4 GT[8];
#pragma unroll
        for (int st = 0; st < 8; ++st) { GT[st] = (f32x4){0.f, 0.f, 0.f, 0.f};
#pragma unroll
            for (int ks = 0; ks < 4; ++ks) { const bf16x8 Af = *(const LAS bf16x8*)(lds + MB_BX + (16 * st + fr) * 272 + (32 * ks + 8 * fq) * 2);
                GT[st] = __builtin_amdgcn_mfma_f32_16x16x32_bf16(Af, Cf[ks], GT[st], 0, 0, 0); } }
        float ss = 0.f;
#pragma unroll 1
        for (int r = 0; r < 4; ++r) {
            const int hd = 4 * g + r;
            f32x4 yv[4];
#pragma unroll
            for (int pt = 0; pt < 4; ++pt) yv[pt] = (f32x4){0.f, 0.f, 0.f, 0.f};
#pragma unroll 1
            for (int dir = 0; dir < 2; ++dir) {
                const int hdd = r * 2 + dir;
                const float cst = tcs[hdd * 128 + tl];
                f32x4 yo[4];
                const float* hin = MS + ((size_t)(b * 8 + hd) * 2 + dir) * MS_SCAN + (size_t)c * 8192;
#pragma unroll
                for (int pt = 0; pt < 4; ++pt) { yo[pt] = (f32x4){0.f, 0.f, 0.f, 0.f};
#pragma unroll
                    for (int ks = 0; ks < 4; ++ks) { const float* hp = hin + (16 * pt + fr) * 128 + 32 * ks + 8 * fq;
                        const float4 h0 = *(const float4*)hp, h1 = *(const float4*)(hp + 4);
                        const float hv[8] = {h0.x, h0.y, h0.z, h0.w, h1.x, h1.y, h1.z, h1.w};
                        yo[pt] = __builtin_amdgcn_mfma_f32_16x16x32_bf16(pack8(hv), Cf[ks], yo[pt], 0, 0, 0); } }
                const float eo = __expf(cst);
#pragma unroll
                for (int pt = 0; pt < 4; ++pt) yv[pt] += yo[pt] * eo;
#pragma unroll
                for (int kp = 0; kp < 4; ++kp) {
                    const bool skip = dir ? (2 * kp + 1 < wid) : (2 * kp > wid);
                    if (!skip) {
                        float pv[8];
#pragma unroll
                        for (int hlf = 0; hlf < 2; ++hlf)
#pragma unroll
                            for (int rg = 0; rg < 4; ++rg) { const int st = 2 * kp + hlf, sl = 16 * st + 4 * fq + rg;
                                const bool ok = dir ? (sl >= tl) : (sl <= tl);
                                const float e = __expf(fminf(cst - tcs[hdd * 128 + sl], 0.f));
                                pv[hlf * 4 + rg] = ok ? GT[st][rg] * e * tdt[hdd * 128 + sl] : 0.f; }
                        const bf16x8 Pf = pack8(pv);
#pragma unroll
                        for (int pt = 0; pt < 4; ++pt) {
                            const LAS unsigned char* xr = lds + MB_XT + (r * 64 + 16 * pt + fr) * 272;
                            const u32x2 x0 = *(const LAS u32x2*)(xr + (32 * kp + 4 * fq) * 2), x1 = *(const LAS u32x2*)(xr + (32 * kp + 16 + 4 * fq) * 2);
                            u32x4 xa; xa.x = x0.x; xa.y = x0.y; xa.z = x1.x; xa.w = x1.y;
                            yv[pt] = __builtin_amdgcn_mfma_f32_16x16x32_bf16(__builtin_bit_cast(bf16x8, xa), Pf, yv[pt], 0, 0, 0);
                        }
                    }
                }
            }
            const float Dk = Dskip[hd];
#pragma unroll
            for (int pt = 0; pt < 4; ++pt) {
                const int p0 = 16 * pt + 4 * fq;
                const u32x2 xr = *(const u32x2*)(xconv + (tok0 + tl) * 1024 + hd * 64 + p0);
                const u32x2 zr = *(const u32x2*)(u + (tok0 + tl) * UW + 2560 + hd * 64 + p0);
                const float xs[4] = {bflo(xr.x), bfhi(xr.x), bflo(xr.y), bfhi(xr.y)}, zs[4] = {bflo(zr.x), bfhi(zr.x), bflo(zr.y), bfhi(zr.y)};
                float yy[4];
#pragma unroll
                for (int rg = 0; rg < 4; ++rg) { const float y = (yv[pt][rg] + Dk * xs[rg]) * silu_f(zs[rg]); yy[rg] = y; ss += y * y; }
                const unsigned long long o = (unsigned long long)pk2(yy[0], yy[1]) | ((unsigned long long)pk2(yy[2], yy[3]) << 32);
                __hip_atomic_store((unsigned long long*)(ocat + (tok0 + tl) * DM + 512 + g * 256 + r * 64 + p0), o, __ATOMIC_RELAXED, __HIP_MEMORY_SCOPE_AGENT);
            }
        }
        ss += __shfl_xor(ss, 16); ss += __shfl_xor(ss, 32);
        const float rn = rsqrtf(ss * (1.f / 256.f) + EPS);
        asm volatile("s_waitcnt vmcnt(0)" ::: "memory");
#pragma unroll 1
        for (int r = 0; r < 4; ++r)
#pragma unroll
            for (int pt = 0; pt < 4; ++pt) {
                const int cc = g * 256 + r * 64 + 16 * pt + 4 * fq;
                unsigned long long* op = (unsigned long long*)(ocat + (tok0 + tl) * DM + 512 + cc);
                const unsigned long long v = __hip_atomic_load(op, __ATOMIC_RELAXED, __HIP_MEMORY_SCOPE_AGENT);
                const unsigned vlo = (unsigned)v, vhi = (unsigned)(v >> 32);
                const float4 bn = *(const float4*)(b_norm + cc);
                const unsigned long long o = (unsigned long long)pk2(bflo(vlo) * rn * bn.x, bfhi(vlo) * rn * bn.y) | ((unsigned long long)pk2(bflo(vhi) * rn * bn.z, bfhi(vhi) * rn * bn.w) << 32);
                *op = o;
            }
    }
    __syncthreads();
}


constexpr int NA_VT = 0, NA_VSTRIDE = 9 * 64 * 2 + 16, NA_BIAS = 64 * NA_VSTRIDE, NA_END = NA_BIAS + 480 * 4;
static_assert(NA_END <= 131072, "na lds");
DEVI void ph_na(LAS unsigned char* lds, const bf16_t* qkv, const float* rpb, bf16_t* oc, int vb0, int vbs) {
    const int tid = opq((int)threadIdx.x), wid = __builtin_amdgcn_readfirstlane(tid >> 6), lane = tid & 63, fr = lane & 15, fq = lane >> 4;
    LAS float* bl = (LAS float*)(lds + NA_BIAS);
    for (int unit = vb0; unit < NB * 16 * 32; unit += vbs) {
        const int rp = unit & 31, h = (unit >> 5) & 15, b = unit >> 9;
        const int r0 = 2 * rp, rs0 = min(max(r0 - 4, 0), 56);
        __syncthreads();
        for (int e = tid; e < 465; e += NTHR) bl[e] = rpb[h * 465 + e];
        for (int task = wid; task < 72; task += 8) {
            const int krow = task >> 3, ch = task & 7, kr = rs0 + krow;
            if (kr < 64) {
                const u32x4 v = *(const u32x4*)(qkv + ((size_t)b * SEQ + kr * 64 + lane) * 3072 + 2048 + h * 64 + ch * 8);
                const unsigned vw[4] = {v.x, v.y, v.z, v.w};
#pragma unroll
                for (int i = 0; i < 8; ++i) *(LAS bf16_t*)(lds + NA_VT + (ch * 8 + i) * NA_VSTRIDE + (krow * 64 + lane) * 2) = (bf16_t)((i & 1) ? (vw[i >> 1] >> 16) : (vw[i >> 1] & 0xffffu));
            }
        }
        __syncthreads();
        const int r = r0 + (wid >> 2), j = wid & 3;
        const int rs = min(max(r - 4, 0), 56), roff = rs - rs0;
        const int bs = (j == 0) ? 0 : (j == 1) ? 8 : (j == 2) ? 24 : 32;
        const int c = 16 * j + fr, qs = min(max(c - 8, 0), 48);
        const size_t qtok = (size_t)b * SEQ + r * 64 + c;
        bf16x8 Qf[2];
#pragma unroll
        for (int ks = 0; ks < 2; ++ks) Qf[ks] = *(const bf16x8*)(qkv + qtok * 3072 + h * 64 + 32 * ks + 8 * fq);
        const bf16_t* kbase = qkv + ((size_t)b * SEQ + rs * 64 + bs + fr) * 3072 + 1024 + h * 64 + 8 * fq;
        bf16x8 kn[4];
#pragma unroll
        for (int q = 0; q < 4; ++q) kn[q] = *(const bf16x8*)(kbase + (size_t)((q >> 1) * 16) * 3072 + (q & 1) * 32);
        f32x4 O[4];
#pragma unroll
        for (int dt = 0; dt < 4; ++dt) O[dt] = (f32x4){0.f, 0.f, 0.f, 0.f};
        float mrun = -1e30f, lrun = 0.f;
#pragma unroll 1
        for (int dr = 0; dr < 8; ++dr) {
            bf16x8 kc[4];
#pragma unroll
            for (int q = 0; q < 4; ++q) kc[q] = kn[q];
            const int drn = dr < 7 ? dr + 1 : 7;
#pragma unroll
            for (int q = 0; q < 4; ++q) kn[q] = *(const bf16x8*)(kbase + ((size_t)drn * 64 + (q >> 1) * 16) * 3072 + (q & 1) * 32);
            float sv[8]; float mloc = -1e30f;
            const LAS float* brow = bl + (rs + dr - r + 7) * 31;
#pragma unroll
            for (int kg = 0; kg < 2; ++kg) {
                f32x4 acc = {0.f, 0.f, 0.f, 0.f};
                acc = __builtin_amdgcn_mfma_f32_16x16x32_bf16(kc[kg * 2], Qf[0], acc, 0, 0, 0);
                acc = __builtin_amdgcn_mfma_f32_16x16x32_bf16(kc[kg * 2 + 1], Qf[1], acc, 0, 0, 0);
#pragma unroll
                for (int rg = 0; rg < 4; ++rg) {
                    const int kcol = bs + 16 * kg + 4 * fq + rg;
                    const bool ok = (kcol >= qs) && (kcol < qs + 16);
                    const int dc = min(max(kcol - c + 15, 0), 30);
                    const float sc = ok ? acc[rg] * 0.125f + brow[dc] : -1e30f;
                    sv[kg * 4 + rg] = sc; mloc = fmaxf(mloc, sc);
                }
            }
            mloc = fmaxf(mloc, __shfl_xor(mloc, 16)); mloc = fmaxf(mloc, __shfl_xor(mloc, 32));
            const float mnew = fmaxf(mrun, mloc);
            const float alpha = __expf(mrun - mnew);
            float psum = 0.f;
#pragma unroll
            for (int i = 0; i < 8; ++i) { const float p = __expf(sv[i] - mnew); sv[i] = p; psum += p; }
            psum += __shfl_xor(psum, 16); psum += __shfl_xor(psum, 32);
            lrun = lrun * alpha + psum; mrun = mnew;
            const bf16x8 Pf = pack8(sv);
            const int koff = ((roff + dr) * 64 + bs + 4 * fq) * 2;
#pragma unroll
            for (int dt = 0; dt < 4; ++dt) {
                const LAS unsigned char* vr = lds + NA_VT + (16 * dt + fr) * NA_VSTRIDE + koff;
                const u32x2 v0 = *(const LAS u32x2*)vr, v1 = *(const LAS u32x2*)(vr + 32);
                u32x4 va; va.x = v0.x; va.y = v0.y; va.z = v1.x; va.w = v1.y;
                O[dt] = __builtin_amdgcn_mfma_f32_16x16x32_bf16(__builtin_bit_cast(bf16x8, va), Pf, O[dt] * alpha, 0, 0, 0);
            }
        }
        const float il = 1.f / lrun;
#pragma unroll
        for (int dt = 0; dt < 4; ++dt) {
            u32x2 o; o.x = pk2(O[dt][0] * il, O[dt][1] * il); o.y = pk2(O[dt][2] * il, O[dt][3] * il);
            *(u32x2*)(oc + qtok * DM + h * 64 + 16 * dt + 4 * fq) = o;
        }
    }
    __syncthreads();
}

DEVI void ph_na_naive(const bf16_t* qkv, const float* rpb, bf16_t* oc, int vb0, int vbs) {
    for (int e4 = vb0 * NTHR + opq((int)threadIdx.x); e4 < MT * 16 * 4; e4 += vbs * NTHR) {
        const int dq = e4 & 3, e = e4 >> 2;
        const int hd = e / MT, tok = e % MT;
        const int b = tok >> 12, t = tok & 4095, r = t >> 6, c = t & 63;
        const int rs = min(max(r - 4, 0), 56), qs = min(max(c - 8, 0), 48);
        float q[16], o[16];
        const bf16_t* qp = qkv + (size_t)tok * 3072 + hd * 64 + dq * 16;
#pragma unroll
        for (int d = 0; d < 16; ++d) { q[d] = bf2f(qp[d]); o[d] = 0.f; }
        float m = -1e30f, l = 0.f;
        for (int dr = 0; dr < 8; ++dr)
            for (int dc = 0; dc < 16; ++dc) {
                const int kr = rs + dr, kc = qs + dc;
                const size_t kt = (size_t)b * SEQ + kr * 64 + kc;
                const bf16_t* kp = qkv + kt * 3072 + 1024 + hd * 64 + dq * 16;
                const bf16_t* vp = qkv + kt * 3072 + 2048 + hd * 64 + dq * 16;
                float s = 0.f;
#pragma unroll
                for (int d = 0; d < 16; ++d) s += q[d] * bf2f(kp[d]);
                s += __shfl_xor(s, 1); s += __shfl_xor(s, 2);
                s = s * 0.125f + rpb[hd * 465 + (kr - r + 7) * 31 + (kc - c + 15)];
                const float mn = fmaxf(m, s); const float al = __expf(m - mn), pe = __expf(s - mn);
                l = l * al + pe; m = mn;
#pragma unroll
                for (int d = 0; d < 16; ++d) o[d] = o[d] * al + pe * bf2f(vp[d]);
            }
        const float il = 1.f / l;
        bf16_t* op = oc + (size_t)tok * DM + hd * 64 + dq * 16;
#pragma unroll
        for (int d = 0; d < 16; ++d) op[d] = f2bf(o[d] * il);
    }
}

#define XB_TMO      128
#define XB_XCNT(j)  (256  + 64 * (j))
#define XB_XSUB(j)  (1280 + 64 * (j))
#define XB_XGEN(j)  (2304 + 64 * (j))
#define XB_TOP      3328
#define XB_TOPGEN   3392
#define XCD_BAR_WORDS 3456
#define XB_SPIN_CAP (1u << 18)

__device__ __forceinline__ unsigned xb_ld(unsigned* p)              { return __hip_atomic_load(p, __ATOMIC_RELAXED, __HIP_MEMORY_SCOPE_AGENT); }
__device__ __forceinline__ unsigned xb_add(unsigned* p, unsigned v) { return __hip_atomic_fetch_add(p, v, __ATOMIC_RELAXED, __HIP_MEMORY_SCOPE_AGENT); }
__device__ __forceinline__ unsigned xb_xcc_id() { return (unsigned)__builtin_amdgcn_s_getreg((3 << 11) | 20) & 0xFu; }
#define XB_SPIN(cond, bar) do { unsigned _sp = 0; while (cond) { __builtin_amdgcn_s_sleep(1); \
    if ((++_sp & 255u) == 0u) { if (xb_ld(&(bar)[XB_TMO])) break; if (_sp > XB_SPIN_CAP) { atomicAdd(&(bar)[XB_TMO], 1u); break; } } } } while (0)

struct XcdBarrier {
    unsigned* bar; unsigned x;
    volatile LAS unsigned* st;
};

__device__ __forceinline__ XcdBarrier xcd_barrier_post(unsigned* bar, volatile LAS unsigned* st) {
    XcdBarrier b; b.bar = bar; b.x = xb_xcc_id(); b.st = st;
    if (threadIdx.x == 0) (void)xb_add(&bar[XB_XCNT(b.x)], 1u);
    return b;
}
__device__ __forceinline__ void xcd_barrier_complete(unsigned* bar, unsigned x, unsigned& nloc, unsigned& nx) {
    const unsigned G = gridDim.x * gridDim.y * gridDim.z;
    unsigned sum, cnt, mine, sp = 0u;
    for (;;) {
        sum = 0u; cnt = 0u; mine = 0u;
#pragma unroll
        for (unsigned j = 0; j < 16; ++j) { const unsigned c = xb_ld(&bar[XB_XCNT(j)]); sum += c; cnt += (c > 0u) ? 1u : 0u; mine = (j == x) ? c : mine; }
        if (sum == G) break;
        __builtin_amdgcn_s_sleep(1);
        if ((++sp & 255u) == 0u) { if (xb_ld(&bar[XB_TMO])) break; if (sp > XB_SPIN_CAP) { atomicAdd(&bar[XB_TMO], 1u); break; } }
    }
    nloc = mine > 0u ? mine : 1u; nx = cnt > 0u ? cnt : 1u;
}

__device__ __forceinline__ void xcd_barrier(const XcdBarrier& b) {
    asm volatile("s_waitcnt vmcnt(0)" ::: "memory");
    __syncthreads();
    if (threadIdx.x == 0) {
        unsigned* bar = b.bar;
        __builtin_amdgcn_s_waitcnt(0);
        unsigned nloc = b.st[0], nx = b.st[1];
        if (nloc == 0u) { xcd_barrier_complete(bar, b.x, nloc, nx); b.st[0] = nloc; b.st[1] = nx; }
        const unsigned old = xb_add(&bar[XB_XSUB(b.x)], 1u);
        const unsigned gen = old / nloc;
        if (old + 1u == (gen + 1u) * nloc) {
            __builtin_amdgcn_fence(__ATOMIC_RELEASE, "agent");
            asm volatile("s_waitcnt vmcnt(0)" ::: "memory");
            const unsigned og = xb_add(&bar[XB_TOP], 1u);
            const unsigned tg = og / nx;
            if (og + 1u == (tg + 1u) * nx) xb_add(&bar[XB_TOPGEN], 1u);
            else XB_SPIN(xb_ld(&bar[XB_TOPGEN]) == tg, bar);
            __builtin_amdgcn_fence(__ATOMIC_ACQUIRE, "agent");
            xb_add(&bar[XB_XGEN(b.x)], 1u);
            asm volatile("s_waitcnt vmcnt(0)" ::: "memory");
        } else {
            XB_SPIN(xb_ld(&bar[XB_XGEN(b.x)]) == gen, bar);
            __builtin_amdgcn_fence(__ATOMIC_ACQUIRE, "agent");
            asm volatile("s_waitcnt vmcnt(0)" ::: "memory");
        }
    }
    __syncthreads();
}


struct Args { const float* in[34]; float* out; unsigned char* ws; int ph_lo, ph_hi; };
constexpr int N_PHASES = 22;

__global__ void __launch_bounds__(NTHR, 2) fwd(Args a) {
    extern __shared__ __attribute__((aligned(16))) unsigned char lds_raw[];
    float* lds = (float*)lds_raw;
    LAS unsigned char* ldsl = (LAS unsigned char*)lds_raw;
    const int vb0 = blockIdx.x, vbs = gridDim.x;
    const int lo = a.ph_lo, hi = a.ph_hi;
#define IN(k) (lo <= (k) && (k) < hi)
#define SEAM(k) do { if (IN(k) && IN((k) + 1)) xcd_barrier(bar); } while (0)
    volatile LAS unsigned* misc = (volatile LAS unsigned*)(ldsl + MISC_OFF);
    if (threadIdx.x < 4) misc[threadIdx.x] = 0u;
    __syncthreads();
    XcdBarrier bar = xcd_barrier_post((unsigned*)(a.ws + WS_CTL) + CW_BAR, misc);
    unsigned char* ws = a.ws;
    unsigned* ctl = (unsigned*)(ws + WS_CTL);
    unsigned* cnt = ctl + CW_CNT;
    int* list = (int*)(ws + WS_LIST); float* gatev = (float*)(ws + WS_GATE);
    float* dtraw = (float*)(ws + WS_DT); float* RS = (float*)(ws + WS_RS);
    bf16_t* XB = (bf16_t*)(ws + WS_XB); bf16_t* UB = (bf16_t*)(ws + WS_UB);
    bf16_t* YA = (bf16_t*)(ws + WS_YA); float* OF = (float*)(ws + WS_OF); bf16_t* OC = (bf16_t*)(ws + WS_OC);
    bf16_t* YP = (bf16_t*)(ws + WS_YP); bf16_t* YP1 = (bf16_t*)(ws + WS_YP1); bf16_t* XC = (bf16_t*)(ws + WS_YP);
    bf16_t* PB0 = (bf16_t*)(ws + WS_PB0); bf16_t* PB1 = (bf16_t*)(ws + WS_PB1);
    bf16_t* YB = (bf16_t*)(ws + WS_Y);
    float* MS = (float*)(ws + WS_MS); float* MD = (float*)(ws + WS_MD);
    float* HS = (float*)(ws + WS_HS); float* HD = (float*)(ws + WS_HD);
    bf16_t* XT = (bf16_t*)(ws + WS_XT); bf16_t* VT = (bf16_t*)(ws + WS_VT);
    const float* p_in = a.in[1];
    const int G = (int)gridDim.x, cb = (int)blockIdx.x;
    const NormB NB0{nullptr, XB, nullptr, nullptr, RS, nullptr, nullptr, nullptr, nullptr, nullptr, nullptr, nullptr, nullptr};

    if (IN(0)) {
        ph_convert_weights(ldsl, a.in, ws, 0, ITEMS_DENSE, vb0, vbs);
        NormB A = NB0; A.xin = a.in[0]; A.gnext = a.in[3]; A.win = a.in[4]; A.dtraw = dtraw;
        ph_norm2<0, false, true, false>(A, vb0, vbs);
    }
    SEAM(0);
    if (IN(1)) { pg8::DenseOrder S; S.init(MT, UW, DM, (const bf16_t*)(ws + W_IN), G, cb); pg8::gemm_phase(ldsl, XB, DM, S, pg8::EpiBf16{UB, UW, RS}); }
    SEAM(1);
    if (IN(2)) { ph_prep(UB, a.in[5], a.in[6], XC, XT, VT, vb0, vbs); }
    SEAM(2);
    if (IN(3)) { ph_hgrn_states(ldsl, UB, VT, a.in[2], HS, HD, vb0, vbs); ph_mamba_states(ldsl, XT, dtraw, a.in[7], a.in[8], MS, MD, vb0, vbs); }
    SEAM(3);
    if (IN(4)) { ph_hgrn_scan(HS, HD, vb0, vbs); ph_mamba_scan(MS, MD, vb0, vbs); }
    SEAM(4);
    if (IN(5)) { ph_hgrn_out(ldsl, UB, VT, a.in[2], a.in[10], HS, OF, OC, vb0, vbs); ph_mamba_out(ldsl, UB, XC, XT, dtraw, a.in[7], a.in[8], a.in[9], a.in[11], MS, OC, vb0, vbs); }
    SEAM(5);
    if (IN(6)) { pg8::DenseOrder S; S.init(MT, DM, DM, (const bf16_t*)(ws + W_OUTE), G, cb); pg8::gemm_phase(ldsl, OC, DM, S, pg8::EpiBf16{YA, DM, nullptr}); }
    SEAM(6);
    if (IN(7)) {
        NormB A = NB0; A.y = YA; A.gpost = a.in[13];
        ph_norm2<1, false, false, false>(A, vb0, vbs);
        ph_cvt_rows(p_in, PB0, (size_t)MT * PDIM / 4, vb0, vbs);
        ph_convert_weights(ldsl, a.in, ws, ITEMS_DENSE, ITEMS_ALL, vb0, vbs);
    }
    SEAM(7);
    if (IN(8)) { pg8::DenseOrder S; S.init(MT, 2 * DFF, DM, (const bf16_t*)(ws + W_GU), G, cb); pg8::gemm_phase(ldsl, XB, DM, S, pg8::EpiSwiglu{UB, DFF, RS, nullptr}); }
    SEAM(8);
    if (IN(9)) { pg8::DenseOrder S; S.init(MT, DM, DFF, (const bf16_t*)(ws + W_DN), G, cb); pg8::gemm_phase(ldsl, UB, DFF, S, pg8::EpiBf16{YA, DM, nullptr}); }
    SEAM(9);
    if (IN(10)) {
        { pg8::DenseOrder S; S.init(MT, DM, PDIM, (const bf16_t*)(ws + W_PP), G, cb); pg8::gemm_phase(ldsl, PB0, PDIM, S, pg8::EpiBf16{YP, DM, nullptr}); }
        NormB A = NB0; A.y = YA; A.gpost = a.in[18];
        ph_norm2<1, false, false, false>(A, vb0, vbs);
    }
    SEAM(10);
    if (IN(11)) { pg8::DenseOrder S; S.init(MT, DM, DM, (const bf16_t*)(ws + W_PG), G, cb); pg8::gemm_phase(ldsl, XB, DM, S, pg8::EpiPleGate{YP, DM, RS}); }
    SEAM(11);
    if (IN(12)) {
        NormB A = NB0; A.y = YP; A.gpost = a.in[33];
        ph_norm2<1, false, false, false>(A, vb0, vbs);
    }
    SEAM(12);
    if (IN(13)) { pg8::DenseOrder S; S.init(MT, 3072, DM, (const bf16_t*)(ws + W_QKV), G, cb); pg8::gemm_phase(ldsl, XB, DM, S, pg8::EpiBf16{UB, 3072, RS}); }
    SEAM(13);
    if (IN(14)) { ph_na(ldsl, UB, a.in[21], OC, vb0, vbs); }
    SEAM(14);
    if (IN(15)) { pg8::DenseOrder S; S.init(MT, DM, DM, (const bf16_t*)(ws + W_OUTO), G, cb); pg8::gemm_phase(ldsl, OC, DM, S, pg8::EpiBf16{YA, DM, nullptr}); }
    SEAM(15);
    if (IN(16)) {
        NormB A = NB0; A.y = YA; A.gpost = a.in[23]; A.gnext = a.in[24]; A.wr = a.in[25]; A.cnt = cnt; A.list = list; A.gatev = gatev;
        ph_norm2<1, false, false, true>(A, vb0, vbs);
        ph_cvt_rows(p_in + (size_t)MT * PDIM, PB1, (size_t)MT * PDIM / 4, vb0, vbs);
    }
    SEAM(16);
    if (IN(17)) { pg8::MoeOrder S; S.init(cnt, (volatile LAS int*)(ldsl + MISC_OFF + 64), 2 * DFFE, DM, (const bf16_t*)(ws + W_EGU), (size_t)14 * MiB, list, true, G, cb); pg8::gemm_phase(ldsl, XB, DM, S, pg8::EpiSwiglu{UB, DFFE, RS, list}); }
    SEAM(17);
    if (IN(18)) { pg8::MoeOrder S; S.init(cnt, (volatile LAS int*)(ldsl + MISC_OFF + 64), DM, DFFE, (const bf16_t*)(ws + W_EDN), (size_t)7 * MiB, list, false, G, cb); pg8::gemm_phase(ldsl, UB, DFFE, S, pg8::EpiMoeDown{YB, list, gatev}); }
    SEAM(18);
    if (IN(19)) {
        { pg8::DenseOrder S; S.init(MT, DM, PDIM, (const bf16_t*)(ws + W_PP + 512 * 1024), G, cb); pg8::gemm_phase(ldsl, PB1, PDIM, S, pg8::EpiBf16{YP1, DM, nullptr}); }
        NormB A = NB0; A.y = YB; A.gpost = a.in[29];
        ph_norm2<2, false, false, false>(A, vb0, vbs);
    }
    SEAM(19);
    if (IN(20)) { pg8::DenseOrder S; S.init(MT, DM, DM, (const bf16_t*)(ws + W_PG + 2 * MiB), G, cb); pg8::gemm_phase(ldsl, XB, DM, S, pg8::EpiPleGate{YP1, DM, RS}); }
    SEAM(20);
    if (IN(21)) {
        NormB A = NB0; A.y = YP1; A.gpost = a.in[33] + DM; A.xout = a.out;
        ph_norm2<1, true, false, false>(A, vb0, vbs);
    }
#undef IN
#undef SEAM
}

extern "C" void kernel_launch(void* const* d_in, const int* in_sizes, int n_in, void* d_out, int out_size, void* d_ws, size_t ws_size, hipStream_t stream) {
    static int grid = 0;
    if (grid == 0) {
        if (n_in != 34 || out_size != MT * DM || ws_size < WS_END) { fprintf(stderr, "kernel_launch: unexpected shapes n_in %d out %d ws %zu (need %zu)\n", n_in, out_size, ws_size, (size_t)WS_END); grid = -1; return; }
        int dev = 0, cus = 0;
        if (hipGetDevice(&dev) != hipSuccess || hipDeviceGetAttribute(&cus, hipDeviceAttributeMultiprocessorCount, dev) != hipSuccess) { grid = -1; return; }
        if (hipFuncSetAttribute((const void*)fwd, hipFuncAttributeMaxDynamicSharedMemorySize, LDS_BYTES) != hipSuccess) { fprintf(stderr, "hipFuncSetAttribute failed\n"); grid = -1; return; }
        (void)hipGetLastError();
        grid = cus;
    }
    if (grid < 0) return;
    (void)hipMemsetAsync((char*)d_ws + WS_CTL, 0, CTL_ZERO_BYTES, stream);
    Args a{};
    for (int i = 0; i < 34; ++i) a.in[i] = (const float*)d_in[i];
    a.out = (float*)d_out; a.ws = (unsigned char*)d_ws;
#ifndef MK_PER_PHASE
    a.ph_lo = 0; a.ph_hi = N_PHASES;
    hipLaunchKernelGGL(fwd, dim3(grid), dim3(NTHR), LDS_BYTES, stream, a);
#else
    for (int ph = 0; ph < N_PHASES; ++ph) {
        a.ph_lo = ph; a.ph_hi = ph + 1;
        hipLaunchKernelGGL(fwd, dim3(grid), dim3(NTHR), LDS_BYTES, stream, a);
    }
#endif
}
```

```cpp
#include <hip/hip_runtime.h>
#include <stdint.h>
#include <stdio.h>

#define DEVI __device__ __forceinline__
#define LAS __attribute__((address_space(3)))
typedef unsigned short bf16_t;

constexpr int NB = 4, SEQ = 4096, DM = 1024, MT = NB * SEQ;
constexpr int EVEN_IN = 4112, UW = 4096, DFF = 2816, NEXP = 8, DFFE = 3584, PDIM = 256;
constexpr float EPS = 1e-6f;
constexpr int NTHR = 512;
constexpr int LDS_BYTES = 147456;
constexpr int MISC_OFF = 131072 + 320;
constexpr int MOE_ROWS = 2 * MT + NEXP * 256;

constexpr size_t MiB = 1u << 20;
constexpr size_t WS_CTL = 0, CTL_ZERO_BYTES = 1 * MiB;
constexpr size_t WS_LIST = 1 * MiB;
constexpr size_t WS_GATE = WS_LIST + 512 * 1024;
constexpr size_t WS_DT = 2 * MiB;
constexpr size_t WS_W = 3 * MiB;
constexpr size_t W_IN = WS_W, W_OUTE = W_IN + 8 * MiB, W_GU = W_OUTE + 2 * MiB, W_DN = W_GU + 11 * MiB, W_PG = W_DN + 6 * MiB, W_PP = W_PG + 4 * MiB,
                 W_QKV = W_PP + 1 * MiB, W_OUTO = W_QKV + 6 * MiB, W_EGU = W_OUTO + 2 * MiB, W_EDN = W_EGU + 112 * MiB, W_END = W_EDN + 56 * MiB;
constexpr size_t WS_XB = W_END;
constexpr size_t WS_R = WS_XB + 32 * MiB;
constexpr size_t WS_UB = WS_R;
constexpr size_t WS_PB0 = WS_R + 88 * MiB;
constexpr size_t WS_YA = WS_R + 128 * MiB;
constexpr size_t WS_OF = WS_R + 160 * MiB;
constexpr size_t WS_OC = WS_R + 192 * MiB;
constexpr size_t WS_YP = WS_R + 224 * MiB;
constexpr size_t WS_YP1 = WS_R;
constexpr size_t WS_PB1 = W_EDN + 32 * MiB;
constexpr size_t WS_XG8 = WS_R + 120 * MiB;
constexpr size_t WS_END = WS_R + 256 * MiB;
constexpr size_t WS_Y = W_EGU;
constexpr size_t WS_MS = W_EGU;
constexpr size_t WS_HS = W_EGU + 64 * MiB;
constexpr size_t WS_XT = W_EDN;
constexpr size_t WS_VT = W_EDN + 24 * MiB;
constexpr size_t WS_MD = W_EDN + 40 * MiB;
constexpr size_t WS_HD = W_EDN + 41 * MiB;
static_assert(WS_R + (size_t)MOE_ROWS * DFFE <= WS_XG8 && WS_XG8 + 128 * MiB <= WS_END && WS_END <= 510 * MiB, "ws map");
constexpr size_t WS_RS = WS_CTL + 512 * 1024;
constexpr int CW_CNT = 64;
constexpr int CW_BAR = 4096;

DEVI int opq(int x) { asm volatile("" : "+v"(x)); return x; }
DEVI float bf2f(bf16_t b) { return __uint_as_float(((unsigned)b) << 16); }
DEVI bf16_t f2bf(float f) { unsigned u = __float_as_uint(f); u += 0x7FFFu + ((u >> 16) & 1u); return (bf16_t)(u >> 16); }
DEVI float silu_f(float x) { return x / (1.f + __expf(-x)); }
DEVI float sigmoid_f(float x) { return 1.f / (1.f + __expf(-x)); }
DEVI float softplus_f(float x) { return x > 20.f ? x : log1pf(__expf(x)); }
DEVI float wave_sum(float v) {
#pragma unroll
    for (int o = 1; o < 64; o <<= 1) v += __shfl_xor(v, o);
    return v;
}


typedef short bf16x8 __attribute__((ext_vector_type(8)));
typedef float f32x4 __attribute__((ext_vector_type(4)));
typedef unsigned u32x4 __attribute__((ext_vector_type(4)));
typedef unsigned u32x2 __attribute__((ext_vector_type(2)));
DEVI unsigned pk2(float lo, float hi) { return (unsigned)f2bf(lo) | ((unsigned)f2bf(hi) << 16); }
DEVI float bflo(unsigned w) { return __uint_as_float(w << 16); }
DEVI float bfhi(unsigned w) { return __uint_as_float(w & 0xffff0000u); }

DEVI unsigned pg8_pk4(float a, float b, float c, float d) {
    a = fminf(fmaxf(a, -448.f), 448.f); b = fminf(fmaxf(b, -448.f), 448.f); c = fminf(fmaxf(c, -448.f), 448.f); d = fminf(fmaxf(d, -448.f), 448.f);
    int p = __builtin_amdgcn_cvt_pk_fp8_f32(a, b, 0, false); p = __builtin_amdgcn_cvt_pk_fp8_f32(c, d, p, true); return (unsigned)p; }
struct NormB { const float* xin; bf16_t* XB; const bf16_t* y; const float* gpost; float* rs; const float* gnext;
               const float* win; float* dtraw; const float* wr; unsigned* cnt; int* list; float* gatev; float* rsl; float* xout; unsigned char* x8; };
DEVI void unpack8(const u32x4 w, float* v) { v[0] = bflo(w.x); v[1] = bfhi(w.x); v[2] = bflo(w.y); v[3] = bfhi(w.y); v[4] = bflo(w.z); v[5] = bfhi(w.z); v[6] = bflo(w.w); v[7] = bfhi(w.w); }
template <int YMODE, bool FINAL, bool DT, bool ROUTE>
DEVI void ph_norm2(const NormB& A, int vb0, int vbs) {
    const int tidq = opq((int)threadIdx.x); const int wid = tidq >> 6, lane = tidq & 63;
    constexpr int R = (DT || ROUTE) ? 2 : 4;
    for (int row0 = (vb0 * 8 + wid) * R; row0 < MT; row0 += vbs * 8 * R) {
        float xv[R][16]; float yv[R][16];
#pragma unroll
        for (int rr = 0; rr < R; ++rr) {
            const size_t ro = (size_t)(row0 + rr) * DM + lane * 8;
            if (YMODE == 0) {
#pragma unroll
                for (int i = 0; i < 2; ++i) { const float4 p0 = *(const float4*)(A.xin + ro + i * 512), p1 = *(const float4*)(A.xin + ro + i * 512 + 4);
                    xv[rr][i * 8 + 0] = p0.x; xv[rr][i * 8 + 1] = p0.y; xv[rr][i * 8 + 2] = p0.z; xv[rr][i * 8 + 3] = p0.w; xv[rr][i * 8 + 4] = p1.x; xv[rr][i * 8 + 5] = p1.y; xv[rr][i * 8 + 6] = p1.z; xv[rr][i * 8 + 7] = p1.w; }
            } else {
#pragma unroll
                for (int i = 0; i < 2; ++i) {
                    unpack8(*(const u32x4*)(A.XB + ro + i * 512), xv[rr] + i * 8);
                    unpack8(*(const u32x4*)(A.y + ro + i * 512), yv[rr] + i * 8);
                    if (YMODE == 2) { float y2[8]; unpack8(*(const u32x4*)(A.y + (size_t)MT * DM + ro + i * 512), y2);
#pragma unroll
                        for (int j = 0; j < 8; ++j) yv[rr][i * 8 + j] += y2[j]; }
                }
            }
        }
        if (YMODE != 0) {
            float gg[16];
#pragma unroll
            for (int i = 0; i < 2; ++i) { const float4 g0 = *(const float4*)(A.gpost + i * 512 + lane * 8), g1 = *(const float4*)(A.gpost + i * 512 + lane * 8 + 4);
                gg[i * 8 + 0] = g0.x; gg[i * 8 + 1] = g0.y; gg[i * 8 + 2] = g0.z; gg[i * 8 + 3] = g0.w; gg[i * 8 + 4] = g1.x; gg[i * 8 + 5] = g1.y; gg[i * 8 + 6] = g1.z; gg[i * 8 + 7] = g1.w; }
            float ss[R];
#pragma unroll
            for (int rr = 0; rr < R; ++rr) { ss[rr] = 0.f;
#pragma unroll
                for (int j = 0; j < 16; ++j) ss[rr] += yv[rr][j] * yv[rr][j]; }
#pragma unroll
            for (int o = 1; o < 64; o <<= 1)
#pragma unroll
                for (int rr = 0; rr < R; ++rr) ss[rr] += __shfl_xor(ss[rr], o);
#pragma unroll
            for (int rr = 0; rr < R; ++rr) { const float r = rsqrtf(ss[rr] * (1.f / DM) + EPS);
#pragma unroll
                for (int j = 0; j < 16; ++j) xv[rr][j] += yv[rr][j] * r * gg[j]; }
        }
        if (FINAL) {
#pragma unroll
            for (int rr = 0; rr < R; ++rr)
#pragma unroll
                for (int i = 0; i < 2; ++i) { float* op = A.xout + (size_t)(row0 + rr) * DM + i * 512 + lane * 8;
                    *(float4*)op = make_float4(xv[rr][i * 8], xv[rr][i * 8 + 1], xv[rr][i * 8 + 2], xv[rr][i * 8 + 3]); *(float4*)(op + 4) = make_float4(xv[rr][i * 8 + 4], xv[rr][i * 8 + 5], xv[rr][i * 8 + 6], xv[rr][i * 8 + 7]); }
        } else {
            float ss[R];
#pragma unroll
            for (int rr = 0; rr < R; ++rr) {
#pragma unroll
                for (int i = 0; i < 2; ++i) { u32x4 o; o.x = pk2(xv[rr][i * 8], xv[rr][i * 8 + 1]); o.y = pk2(xv[rr][i * 8 + 2], xv[rr][i * 8 + 3]); o.z = pk2(xv[rr][i * 8 + 4], xv[rr][i * 8 + 5]); o.w = pk2(xv[rr][i * 8 + 6], xv[rr][i * 8 + 7]);
                    *(u32x4*)(A.XB + (size_t)(row0 + rr) * DM + i * 512 + lane * 8) = o;
                }
                ss[rr] = 0.f;
#pragma unroll
                for (int j = 0; j < 16; ++j) ss[rr] += xv[rr][j] * xv[rr][j];
            }
#pragma unroll
            for (int o = 1; o < 64; o <<= 1)
#pragma unroll
                for (int rr = 0; rr < R; ++rr) ss[rr] += __shfl_xor(ss[rr], o);
            float r2[R];
#pragma unroll
            for (int rr = 0; rr < R; ++rr) { r2[rr] = rsqrtf(ss[rr] * (1.f / DM) + EPS); if (lane == 0) A.rs[row0 + rr] = r2[rr]; }
            if (DT || ROUTE) {
                float gn[16];
#pragma unroll
                for (int i = 0; i < 2; ++i) { const float4 g0 = *(const float4*)(A.gnext + i * 512 + lane * 8), g1 = *(const float4*)(A.gnext + i * 512 + lane * 8 + 4);
                    gn[i * 8 + 0] = g0.x; gn[i * 8 + 1] = g0.y; gn[i * 8 + 2] = g0.z; gn[i * 8 + 3] = g0.w; gn[i * 8 + 4] = g1.x; gn[i * 8 + 5] = g1.y; gn[i * 8 + 6] = g1.z; gn[i * 8 + 7] = g1.w; }
#pragma unroll 1
                for (int rr = 0; rr < R; ++rr) {
                    const int row = row0 + rr;
                    float hv[16];
#pragma unroll
                    for (int j = 0; j < 16; ++j) hv[j] = (rr == 0 ? xv[0][j] : xv[R - 1][j]) * (rr == 0 ? r2[0] : r2[R - 1]) * gn[j];
                    if (DT) {
                        float d[16];
#pragma unroll
                        for (int j = 0; j < 16; ++j) d[j] = 0.f;
#pragma unroll
                        for (int q = 0; q < 16; ++q) {
                            const float* wp = A.win + (size_t)((q >> 3) * 512 + lane * 8 + (q & 7)) * EVEN_IN + 4096;
#pragma unroll
                            for (int j4 = 0; j4 < 4; ++j4) { const float4 w = *(const float4*)(wp + j4 * 4);
                                d[j4 * 4 + 0] += hv[q] * w.x; d[j4 * 4 + 1] += hv[q] * w.y; d[j4 * 4 + 2] += hv[q] * w.z; d[j4 * 4 + 3] += hv[q] * w.w; }
                        }
#pragma unroll
                        for (int j = 0; j < 16; ++j) d[j] = wave_sum(d[j]);
                        if (lane == 0) {
#pragma unroll
                            for (int j4 = 0; j4 < 4; ++j4) *(float4*)(A.dtraw + (size_t)row * 16 + j4 * 4) = make_float4(d[j4 * 4], d[j4 * 4 + 1], d[j4 * 4 + 2], d[j4 * 4 + 3]);
                        }
                    }
                    if (ROUTE) {
                        float lg[8];
#pragma unroll
                        for (int e = 0; e < 8; ++e) lg[e] = 0.f;
#pragma unroll
                        for (int q = 0; q < 16; ++q) {
                            const float* wp = A.wr + (size_t)((q >> 3) * 512 + lane * 8 + (q & 7)) * 8;
                            const float4 w0 = *(const float4*)wp, w1 = *(const float4*)(wp + 4);
                            lg[0] += hv[q] * w0.x; lg[1] += hv[q] * w0.y; lg[2] += hv[q] * w0.z; lg[3] += hv[q] * w0.w;
                            lg[4] += hv[q] * w1.x; lg[5] += hv[q] * w1.y; lg[6] += hv[q] * w1.z; lg[7] += hv[q] * w1.w;
                        }
#pragma unroll
                        for (int e = 0; e < 8; ++e) lg[e] = wave_sum(lg[e]);
                        int dst1 = 0, dst2 = 0;
                        if (lane == 0) {
                            const float rcur = (rr == 0 ? r2[0] : r2[R - 1]);
                            int e1 = 0; float v1 = lg[0];
#pragma unroll
                            for (int e = 1; e < 8; ++e) if (lg[e] > v1) { v1 = lg[e]; e1 = e; }
                            int e2 = 0; float v2 = -3.0e38f;
#pragma unroll
                            for (int e = 0; e < 8; ++e) if (e != e1 && lg[e] > v2) { v2 = lg[e]; e2 = e; }
                            const float ex = __expf(v2 - v1); const float w1 = 1.f / (1.f + ex), w2 = ex / (1.f + ex);
                            const int p1 = (int)atomicAdd(&A.cnt[e1], 1u); A.list[e1 * MT + p1] = row * 2; A.gatev[e1 * MT + p1] = w1; A.rsl[e1 * MT + p1] = rcur;
                            const int p2 = (int)atomicAdd(&A.cnt[e2], 1u); A.list[e2 * MT + p2] = row * 2 + 1; A.gatev[e2 * MT + p2] = w2; A.rsl[e2 * MT + p2] = rcur;
                            dst1 = e1 * MT + p1; dst2 = e2 * MT + p2;
                        }
                        dst1 = __builtin_amdgcn_readfirstlane(dst1); dst2 = __builtin_amdgcn_readfirstlane(dst2);
#pragma unroll
                        for (int i = 0; i < 2; ++i) { u32x2 o8;
                            const float* xs = (rr == 0 ? xv[0] : xv[R - 1]) + i * 8;
                            o8.x = pg8_pk4(xs[0], xs[1], xs[2], xs[3]); o8.y = pg8_pk4(xs[4], xs[5], xs[6], xs[7]);
                            *(u32x2*)(A.x8 + (size_t)dst1 * DM + i * 512 + lane * 8) = o8; *(u32x2*)(A.x8 + (size_t)dst2 * DM + i * 512 + lane * 8) = o8; }
                    }
                }
            }
        }
    }
}

DEVI void transpose_item(const float* W, int ldw, int K, int k0, int n0, bf16_t* WT, int drow0, LAS float* scr, int lane, const float* gain) {
#pragma unroll 8
    for (int i = 0; i < 32; ++i) { const int kk = 2 * i + (lane >> 5); scr[kk * 33 + (lane & 31)] = W[(size_t)(k0 + kk) * ldw + n0 + (lane & 31)]; }
    asm volatile("s_waitcnt lgkmcnt(0)" ::: "memory");
    const int c = lane & 7;
    float4 ga = make_float4(1.f, 1.f, 1.f, 1.f), gb = ga;
    if (gain) { ga = *(const float4*)(gain + k0 + 8 * c); gb = *(const float4*)(gain + k0 + 8 * c + 4); }
#pragma unroll
    for (int j = 0; j < 4; ++j) { const int n = (lane >> 3) + 8 * j; const LAS float* sp = scr + (8 * c) * 33 + n;
        u32x4 o; o.x = pk2(sp[0 * 33] * ga.x, sp[1 * 33] * ga.y); o.y = pk2(sp[2 * 33] * ga.z, sp[3 * 33] * ga.w); o.z = pk2(sp[4 * 33] * gb.x, sp[5 * 33] * gb.y); o.w = pk2(sp[6 * 33] * gb.z, sp[7 * 33] * gb.w);
        *(u32x4*)(WT + (size_t)(drow0 + n) * K + k0 + 8 * c) = o; }
    asm volatile("s_waitcnt lgkmcnt(0)" ::: "memory");
}
DEVI void transpose_item_fp8(const float* W, int ldw, int K, int k0, int n0, unsigned char* WT8, int drow0, LAS float* scr, int lane, const float* gain) {
#pragma unroll 8
    for (int i = 0; i < 32; ++i) { const int kk = 2 * i + (lane >> 5); scr[kk * 33 + (lane & 31)] = W[(size_t)(k0 + kk) * ldw + n0 + (lane & 31)]; }
    asm volatile("s_waitcnt lgkmcnt(0)" ::: "memory");
    const int c = lane & 7;
    float4 ga = make_float4(64.f, 64.f, 64.f, 64.f), gb = ga;
    if (gain) { ga = *(const float4*)(gain + k0 + 8 * c); gb = *(const float4*)(gain + k0 + 8 * c + 4); ga.x *= 64.f; ga.y *= 64.f; ga.z *= 64.f; ga.w *= 64.f; gb.x *= 64.f; gb.y *= 64.f; gb.z *= 64.f; gb.w *= 64.f; }
#pragma unroll
    for (int j = 0; j < 4; ++j) { const int n = (lane >> 3) + 8 * j; const LAS float* sp = scr + (8 * c) * 33 + n;
        u32x2 o; o.x = pg8_pk4(sp[0 * 33] * ga.x, sp[1 * 33] * ga.y, sp[2 * 33] * ga.z, sp[3 * 33] * ga.w); o.y = pg8_pk4(sp[4 * 33] * gb.x, sp[5 * 33] * gb.y, sp[6 * 33] * gb.z, sp[7 * 33] * gb.w);
        *(u32x2*)(WT8 + (size_t)(drow0 + n) * K + k0 + 8 * c) = o; }
    asm volatile("s_waitcnt lgkmcnt(0)" ::: "memory");
}
struct Job { int in_idx; unsigned src_off; int ldw; int K; int ncols; unsigned long long dst; int mode; int item0; int gain_idx; int gain_off; int fp8; };
constexpr int NJOBS = 11 + 24;
struct JobTable { Job j[NJOBS]; int total; };
constexpr JobTable make_jobs() {
    JobTable t{}; int n = 0, it = 0;
    auto add = [&](int idx, unsigned off, int ldw, int K, int ncols, unsigned long long dst, int mode, int gi, int go, int f8 = 0) { t.j[n] = Job{idx, off, ldw, K, ncols, dst, mode, it, gi, go, f8}; it += (K / 64) * (ncols / 32); ++n; };
    add(4, 0, EVEN_IN, DM, UW, W_IN, 0, 3, 0);
    add(12, 0, DM, DM, DM, W_OUTE, 0, -1, 0);
    add(15, 0, DFF, DM, DFF, W_GU, 1, 14, 0);
    add(16, 0, DFF, DM, DFF, W_GU, 2, 14, 0);
    add(17, 0, DM, DFF, DM, W_DN, 0, -1, 0);
    add(31, 0, DM, DM, DM, W_PG, 0, 30, 0);
    add(31, DM * DM, DM, DM, DM, W_PG + 2 * MiB, 0, 30, DM);
    add(32, 0, DM, PDIM, DM, W_PP, 0, -1, 0);
    add(32, PDIM * DM, DM, PDIM, DM, W_PP + 512 * 1024, 0, -1, 0);
    add(20, 0, 3072, DM, 3072, W_QKV, 0, 19, 0);
    add(22, 0, DM, DM, DM, W_OUTO, 0, -1, 0);
    for (int e = 0; e < NEXP; ++e) {
        add(26, (unsigned)e * DM * DFFE, DFFE, DM, DFFE, W_EGU + (unsigned long long)e * 7 * MiB, 1, 24, 0, 1);
        add(27, (unsigned)e * DM * DFFE, DFFE, DM, DFFE, W_EGU + (unsigned long long)e * 7 * MiB, 2, 24, 0, 1);
        add(28, (unsigned)e * DFFE * DM, DM, DFFE, DM, W_EDN + (unsigned long long)e * (7 * MiB / 2), 0, -1, 0, 1);
    }
    t.total = it; return t;
}
__device__ const JobTable g_jobs = make_jobs();
constexpr int ITEMS_DENSE = make_jobs().j[11].item0, ITEMS_ALL = make_jobs().total;
DEVI void ph_convert_weights(LAS unsigned char* lds, const float* const* in, unsigned char* ws, int it_lo, int it_hi, int vb0, int vbs) {
    const int tidq = opq((int)threadIdx.x); const int wid = __builtin_amdgcn_readfirstlane(tidq >> 6), lane = tidq & 63;
    LAS float* scr = (LAS float*)(lds + wid * 16384);
    int jb = 0;
    for (int it = it_lo + vb0 * 8 + wid; it < it_hi; it += vbs * 8) {
        while (jb + 1 < NJOBS && g_jobs.j[jb + 1].item0 <= it) ++jb;
        const Job J = g_jobs.j[jb];
        const int r = it - J.item0; const int nblk = J.ncols / 32; const int kb = r / nblk, nb = r % nblk;
        const int n0 = nb * 32; int drow0 = n0;
        if (J.mode != 0) drow0 = (n0 >> 7) * 256 + (n0 & 127) + (J.mode == 2 ? 128 : 0);
        const float* gp = J.gain_idx >= 0 ? in[J.gain_idx] + J.gain_off : nullptr;
        if (J.fp8) transpose_item_fp8(in[J.in_idx] + J.src_off, J.ldw, J.K, kb * 64, n0, ws + J.dst, drow0, scr, lane, gp);
        else transpose_item(in[J.in_idx] + J.src_off, J.ldw, J.K, kb * 64, n0, (bf16_t*)(ws + J.dst), drow0, scr, lane, gp);
    }
}
DEVI void ph_cvt_rows(const float* src, bf16_t* dst, size_t n4, int vb0, int vbs) {
    for (size_t e = (size_t)vb0 * NTHR + opq((int)threadIdx.x); e < n4; e += (size_t)vbs * NTHR) {
        const float4 v = ((const float4*)src)[e]; u32x2 o; o.x = pk2(v.x, v.y); o.y = pk2(v.z, v.w); ((u32x2*)dst)[e] = o; }
}

namespace pg8 {
constexpr int BM = 256, BK = 64, HALF = 128, HTB = HALF * BK * 2, STAGE_BYTES = 8 * HTB, NXCD = 8, WGM = 8;
__host__ __device__ __forceinline__ int lds_byte(int r, int c) { const int st = (r >> 4) * 2 + (c >> 5), rr = r & 15, cc = c & 31, ob = rr * 64 + cc * 2; return st * 1024 + (ob ^ (((ob >> 9) & 1) << 5)); }
__host__ __device__ __forceinline__ void stage_rc(int b, int& R, int& C) { const int st = b / 1024, sb = b % 1024, swz = sb ^ (((sb >> 9) & 1) << 5); R = (st >> 1) * 16 + swz / 64; C = (st & 1) * 32 + (swz % 64) / 2; }
__host__ __device__ __forceinline__ int perm32(int rho) { const int n = rho >> 4, i = rho & 15; return 8 * (i >> 2) + 4 * n + (i & 3); }
struct Unit { int pm, pn; int row0; int arow0; int mvalid; int e; int mbase; const char* B; };
DEVI void xcd_tile(int L, int nwg, int nM, int nN, int& pm, int& pn) {
    int wgid = L; { const int q = nwg / NXCD, r = nwg % NXCD, xcd = wgid % NXCD, off = wgid / NXCD; wgid = (xcd < r ? xcd * (q + 1) : r * (q + 1) + (xcd - r) * q) + off; }
    const int nig = WGM * nN, gid = wgid / nig, fm = gid * WGM, gsz = (nM - fm) < WGM ? (nM - fm) : WGM;
    pm = fm + ((wgid % nig) % gsz); pn = (wgid % nig) / gsz;
}
struct DenseOrder {
    int nM, nN, nwg, G, c; const char* Bt; size_t tstepB;
    DEVI void init(int M, int N, int K, const bf16_t* Bt_, int G_, int c_) { nM = M / BM; nN = N / BM; nwg = nM * nN; G = G_; c = c_; Bt = (const char*)Bt_; tstepB = (size_t)BM * K * 2; }
    DEVI bool next(int i, Unit& u) const { const long L = (long)i * G + c; if (L >= nwg) return false; xcd_tile((int)L, nwg, nM, nN, u.pm, u.pn); u.row0 = u.pm * BM; u.arow0 = u.row0; u.mvalid = BM; u.e = 0; u.mbase = 0; u.B = Bt + (size_t)u.pn * tstepB; return true; }
};
struct MoeOrder {
    int nM, nN, nwg, G, c; const char* Bt; size_t estepB, tstepB; const volatile LAS int* tab; bool per_expert;
    DEVI void init(const unsigned* cnt, volatile LAS int* tab_, int N, int K, const bf16_t* Bt_, size_t estep_bytes, bool per_expert_, int G_, int c_) {
        __syncthreads();
        if (threadIdx.x == 0) { int t = 0;
            for (int e = 0; e < 8; ++e) { const int n = (int)__hip_atomic_load(cnt + e, __ATOMIC_RELAXED, __HIP_MEMORY_SCOPE_AGENT); tab_[16 + e] = n; tab_[e] = t; t += (n + BM - 1) / BM; }
            tab_[8] = t; }
        __syncthreads();
        tab = tab_; nM = __builtin_amdgcn_readfirstlane(tab_[8]); nN = N / BM; nwg = nM * nN; G = G_; c = c_; Bt = (const char*)Bt_; estepB = estep_bytes; tstepB = (size_t)BM * K * 2; per_expert = per_expert_;
    }
    DEVI bool next(int i, Unit& u) const { const long L = (long)i * G + c; if (L >= nwg) return false; xcd_tile((int)L, nwg, nM, nN, u.pm, u.pn);
        int e = 0;
        for (int k = 1; k < 8; ++k) if (u.pm >= __builtin_amdgcn_readfirstlane(tab[k])) e = k;
        const int t0 = __builtin_amdgcn_readfirstlane(tab[e]), n = __builtin_amdgcn_readfirstlane(tab[16 + e]);
        u.e = e; u.row0 = u.pm * BM; const int m0 = (u.pm - t0) * BM; u.mbase = m0; u.arow0 = per_expert ? e * MT + m0 : u.row0; u.mvalid = (n - m0) < BM ? (n - m0) : BM; u.B = Bt + (size_t)e * estepB + (size_t)u.pn * tstepB; return true; }
};
DEVI unsigned cvt_pk_bf16(float lo, float hi) { unsigned r; asm volatile("v_cvt_pk_bf16_f32 %0, %1, %2" : "=v"(r) : "v"(lo), "v"(hi)); return r; }

struct EpiBf16 { static constexpr bool PERM = true; bf16_t* O; int ldc; const float* rs;
    DEVI void operator()(const f32x4 (&acc)[2][2][4][2], const Unit& u, int wr, int wc, int fr, int fq) const {
        const int row0 = u.row0 + wr * 64 + fr, col0 = u.pn * BM + wc * 32 + 8 * fq;
#pragma unroll
        for (int ai = 0; ai < 2; ++ai)
#pragma unroll
            for (int m = 0; m < 4; ++m) { const int row = row0 + ai * HALF + m * 16; bf16_t* rowp = O + (size_t)row * ldc + col0;
                const float sc = rs ? rs[row] : 1.f;
#pragma unroll
                for (int bj = 0; bj < 2; ++bj) { const f32x4 v0 = acc[ai][bj][m][0] * sc, v1 = acc[ai][bj][m][1] * sc;
                    u32x4 w; w.x = cvt_pk_bf16(v0[0], v0[1]); w.y = cvt_pk_bf16(v0[2], v0[3]); w.z = cvt_pk_bf16(v1[0], v1[1]); w.w = cvt_pk_bf16(v1[2], v1[3]);
                    *(u32x4*)(rowp + bj * HALF) = w; } }
    } };
struct EpiPleGate { static constexpr bool PERM = true; bf16_t* T; int ldc; const float* rs;
    DEVI void operator()(const f32x4 (&acc)[2][2][4][2], const Unit& u, int wr, int wc, int fr, int fq) const {
        const int row0 = u.row0 + wr * 64 + fr, col0 = u.pn * BM + wc * 32 + 8 * fq;
#pragma unroll
        for (int ai = 0; ai < 2; ++ai)
#pragma unroll
            for (int m = 0; m < 4; ++m) { const int row = row0 + ai * HALF + m * 16; bf16_t* rowp = T + (size_t)row * ldc + col0;
                const float sc = rs[row];
#pragma unroll
                for (int bj = 0; bj < 2; ++bj) { const f32x4 v0 = acc[ai][bj][m][0] * sc, v1 = acc[ai][bj][m][1] * sc;
                    const u32x4 pp = *(const u32x4*)(rowp + bj * HALF);
                    u32x4 w; w.x = cvt_pk_bf16(sigmoid_f(v0[0]) * bflo(pp.x), sigmoid_f(v0[1]) * bfhi(pp.x)); w.y = cvt_pk_bf16(sigmoid_f(v0[2]) * bflo(pp.y), sigmoid_f(v0[3]) * bfhi(pp.y));
                    w.z = cvt_pk_bf16(sigmoid_f(v1[0]) * bflo(pp.z), sigmoid_f(v1[1]) * bfhi(pp.z)); w.w = cvt_pk_bf16(sigmoid_f(v1[2]) * bflo(pp.w), sigmoid_f(v1[3]) * bfhi(pp.w));
                    *(u32x4*)(rowp + bj * HALF) = w; } }
    } };
struct EpiSwiglu { static constexpr bool PERM = true; bf16_t* O; int ldc; const float* rs; int grouped;
    DEVI void operator()(const f32x4 (&acc)[2][2][4][2], const Unit& u, int wr, int wc, int fr, int fq) const {
        const int row0 = u.row0 + wr * 64 + fr, col0 = u.pn * HALF + wc * 32 + 8 * fq;
#pragma unroll
        for (int ai = 0; ai < 2; ++ai)
#pragma unroll
            for (int m = 0; m < 4; ++m) { const int rl = wr * 64 + fr + ai * HALF + m * 16; bf16_t* rowp = O + (size_t)(u.row0 + rl) * ldc + col0;
                float sc;
                if (grouped) sc = (rl < u.mvalid) ? rs[u.e * MT + u.mbase + rl] : 0.f; else sc = rs[u.row0 + rl];
                const f32x4 g0 = acc[ai][0][m][0] * sc, g1 = acc[ai][0][m][1] * sc, u0 = acc[ai][1][m][0] * sc, u1 = acc[ai][1][m][1] * sc;
                u32x4 w; w.x = cvt_pk_bf16(silu_f(g0[0]) * u0[0], silu_f(g0[1]) * u0[1]); w.y = cvt_pk_bf16(silu_f(g0[2]) * u0[2], silu_f(g0[3]) * u0[3]);
                w.z = cvt_pk_bf16(silu_f(g1[0]) * u1[0], silu_f(g1[1]) * u1[1]); w.w = cvt_pk_bf16(silu_f(g1[2]) * u1[2], silu_f(g1[3]) * u1[3]);
                *(u32x4*)rowp = w; }
    } };
constexpr float W8_SCALE = 64.f, ACT8_SCALE = 8.f;
struct EpiSwiglu8 { static constexpr bool PERM = true; unsigned char* O; int ldc; const float* rs;
    DEVI void operator()(const f32x4 (&acc)[2][2][4][2], const Unit& u, int wr, int wc, int fr, int fq) const {
        const int col0 = u.pn * HALF + wc * 32 + 8 * fq;
#pragma unroll
        for (int ai = 0; ai < 2; ++ai)
#pragma unroll
            for (int m = 0; m < 4; ++m) { const int rl = wr * 64 + fr + ai * HALF + m * 16; unsigned char* rowp = O + (size_t)(u.row0 + rl) * ldc + col0;
                const float sc = (rl < u.mvalid) ? rs[u.e * MT + u.mbase + rl] * (1.f / W8_SCALE) : 0.f;
                const f32x4 g0 = acc[ai][0][m][0] * sc, g1 = acc[ai][0][m][1] * sc, u0 = acc[ai][1][m][0] * (sc * ACT8_SCALE), u1 = acc[ai][1][m][1] * (sc * ACT8_SCALE);
                u32x2 w; w.x = pg8_pk4(silu_f(g0[0]) * u0[0], silu_f(g0[1]) * u0[1], silu_f(g0[2]) * u0[2], silu_f(g0[3]) * u0[3]);
                w.y = pg8_pk4(silu_f(g1[0]) * u1[0], silu_f(g1[1]) * u1[1], silu_f(g1[2]) * u1[2], silu_f(g1[3]) * u1[3]);
                *(u32x2*)rowp = w; }
    } };
struct EpiMoeDown { static constexpr bool PERM = true; bf16_t* Y; const int* list; const float* gatev; float oscale;
    DEVI void operator()(const f32x4 (&acc)[2][2][4][2], const Unit& u, int wr, int wc, int fr, int fq) const {
        const int col0 = u.pn * BM + wc * 32 + 8 * fq;
        const int mbase = u.mbase;
#pragma unroll
        for (int ai = 0; ai < 2; ++ai)
#pragma unroll
            for (int m = 0; m < 4; ++m) { const int rl = wr * 64 + fr + ai * HALF + m * 16;
                if (rl < u.mvalid) {
                    const int tsl = list[u.e * MT + mbase + rl]; const float gt = gatev[u.e * MT + mbase + rl] * oscale;
                    bf16_t* rowp = Y + (size_t)(tsl & 1) * ((size_t)MT * DM) + (size_t)(tsl >> 1) * DM + col0;
#pragma unroll
                    for (int bj = 0; bj < 2; ++bj) { const f32x4 v0 = acc[ai][bj][m][0], v1 = acc[ai][bj][m][1];
                        u32x4 w; w.x = cvt_pk_bf16(v0[0] * gt, v0[1] * gt); w.y = cvt_pk_bf16(v0[2] * gt, v0[3] * gt); w.z = cvt_pk_bf16(v1[0] * gt, v1[1] * gt); w.w = cvt_pk_bf16(v1[2] * gt, v1[3] * gt);
                        *(u32x4*)(rowp + bj * HALF) = w; } } }
    } };

typedef int v8i __attribute__((ext_vector_type(8)));
typedef int v4i __attribute__((ext_vector_type(4)));
DEVI v8i cat8(const bf16x8 lo, const bf16x8 hi) { const v4i a = __builtin_bit_cast(v4i, lo), b = __builtin_bit_cast(v4i, hi); return __builtin_shufflevector(a, b, 0, 1, 2, 3, 4, 5, 6, 7); }
struct Frag16 { bf16x8 k[2]; };
struct Frag8 { v8i v; };
template <bool F> struct FragSel { typedef Frag16 T; };
template <> struct FragSel<true> { typedef Frag8 T; };
template <class Epi, class Sched, bool FP8 = false>
DEVI void gemm_phase(LAS unsigned char* lds, const bf16_t* A, const int K, const Sched& S, const Epi& E) {
    const int tid = opq((int)threadIdx.x), wid = __builtin_amdgcn_readfirstlane(tid >> 6), lane = tid & 63, wr = wid >> 2, wc = wid & 3, fr = lane & 15, fq = lane >> 4;
    const int nt = K / BK;
    unsigned voffA[2], voffB[2];
#pragma unroll
    for (int i = 0; i < 2; ++i) { int R, C; stage_rc(tid * 16 + i * 8192, R, C); const int Rb = Epi::PERM ? ((R & ~31) + perm32(R & 31)) : R;
        voffA[i] = (unsigned)(R * K + C) * 2u; voffB[i] = (unsigned)(Rb * K + C) * 2u; }
    const size_t kstep = (size_t)(BK * 2);
    const size_t hstep = (size_t)HALF * K * 2;
    const size_t rstep = (size_t)K * 2;
    const unsigned ldsw = (unsigned)wid * 1024u;
    const int aoff = lds_byte(wr * 64 + fr, fq * 8), boff = lds_byte(wc * 32 + fr, fq * 8);
#define PG8_SA(b, h) (((b) * 2 + (h)) * HTB)
#define PG8_SB(b, h) ((4 + (b) * 2 + (h)) * HTB)
#define PG8_STAGE(bufoff, gbase, voff) do { _Pragma("unroll") for (int _i = 0; _i < 2; ++_i) \
        __builtin_amdgcn_global_load_lds((const unsigned*)((const char*)(gbase) + (voff)[_i]), (LAS unsigned*)(lds + (bufoff) + ldsw + _i * 8192), 16, 0, 0); } while (0)
#define PG8_LDA(dst, b, h) do { _Pragma("unroll") for (int m = 0; m < 4; ++m) { if constexpr (FP8) dst[m].v = cat8(*(const LAS bf16x8*)(lds + PG8_SA(b, h) + aoff + m * 2048), *(const LAS bf16x8*)(lds + PG8_SA(b, h) + aoff + m * 2048 + 1024)); \
        else { _Pragma("unroll") for (int k = 0; k < 2; ++k) dst[m].k[k] = *(const LAS bf16x8*)(lds + PG8_SA(b, h) + aoff + m * 2048 + k * 1024); } } } while (0)
#define PG8_LDB(dst, b, h) do { _Pragma("unroll") for (int n = 0; n < 2; ++n) { if constexpr (FP8) dst[n].v = cat8(*(const LAS bf16x8*)(lds + PG8_SB(b, h) + boff + n * 2048), *(const LAS bf16x8*)(lds + PG8_SB(b, h) + boff + n * 2048 + 1024)); \
        else { _Pragma("unroll") for (int k = 0; k < 2; ++k) dst[n].k[k] = *(const LAS bf16x8*)(lds + PG8_SB(b, h) + boff + n * 2048 + k * 1024); } } } while (0)
#define PG8_MMA(ai, bj, At, Bt) do { __builtin_amdgcn_s_setprio(1); _Pragma("unroll") for (int m = 0; m < 4; ++m) _Pragma("unroll") for (int n = 0; n < 2; ++n) { \
        if constexpr (FP8) asm volatile("s_nop 1\n\tv_mfma_scale_f32_16x16x128_f8f6f4 %0, %1, %2, %0, %3, %3 op_sel_hi:[0,0,0]" : "+v"(acc[ai][bj][m][n]) : "v"(Bt[n].v), "v"(At[m].v), "v"(sc1)); \
        else { _Pragma("unroll") for (int k = 0; k < 2; ++k) acc[ai][bj][m][n] = __builtin_amdgcn_mfma_f32_16x16x32_bf16(Bt[n].k[k], At[m].k[k], acc[ai][bj][m][n], 0, 0, 0); } } \
        __builtin_amdgcn_s_setprio(0); } while (0)
#define PG8_WAIT_V(n) asm volatile("s_waitcnt vmcnt(" #n ")" ::: "memory")
#define PG8_WAIT_L(n) asm volatile("s_waitcnt lgkmcnt(" #n ")" ::: "memory")
#define PG8_BAR __builtin_amdgcn_s_barrier()
#define PG8_SCHED __builtin_amdgcn_sched_barrier(0)
    Unit cur, nxt; int ui = 0;
    if (!S.next(0, cur)) return;
    int sc1 = 0x7F7F7F7F; asm volatile("" : "+v"(sc1));
    f32x4 acc[2][2][4][2];
#pragma unroll
    for (int a = 0; a < 2; ++a)
#pragma unroll
        for (int b = 0; b < 2; ++b)
#pragma unroll
            for (int m = 0; m < 4; ++m)
#pragma unroll
                for (int n = 0; n < 2; ++n) acc[a][b][m][n] = (f32x4){0.f, 0.f, 0.f, 0.f};
    typename FragSel<FP8>::T At[4], B0[2], B1[2];
    const char* cA = (const char*)A + (size_t)cur.arow0 * rstep;
    const char* cB = cur.B;
    PG8_STAGE(PG8_SB(0, 0), cB, voffB); PG8_STAGE(PG8_SA(0, 0), cA, voffA); PG8_STAGE(PG8_SB(0, 1), cB + hstep, voffB); PG8_STAGE(PG8_SA(0, 1), cA + hstep, voffA);
    if (wr == 1) PG8_BAR;
    PG8_WAIT_V(4); PG8_BAR;
    PG8_STAGE(PG8_SB(1, 0), cB + kstep, voffB); PG8_STAGE(PG8_SA(1, 0), cA + kstep, voffA); PG8_STAGE(PG8_SB(1, 1), cB + hstep + kstep, voffB);
    PG8_WAIT_V(6); PG8_BAR;
    for (;;) {
        const bool has_next = S.next(ui + 1, nxt);
        const char* nA = has_next ? (const char*)A + (size_t)nxt.arow0 * rstep : cA; const char* nB = has_next ? nxt.B : cB;
#pragma unroll 1
        for (int t = 0; t < nt; t += 2) {
            const bool last = (t == nt - 2);
            const char* a1 = cA + (size_t)(t + 1) * kstep;
            const char* a2 = last ? nA : cA + (size_t)(t + 2) * kstep; const char* b2 = last ? nB : cB + (size_t)(t + 2) * kstep;
            const char* a3 = a2 + kstep; const char* b3 = b2 + kstep;
            PG8_LDB(B0, 0, 0); PG8_SCHED; PG8_LDA(At, 0, 0); PG8_STAGE(PG8_SA(1, 1), a1 + hstep, voffA);
            PG8_WAIT_L(8); PG8_BAR; PG8_WAIT_L(0); PG8_MMA(0, 0, At, B0); PG8_BAR; PG8_SCHED;
            PG8_LDB(B1, 0, 1); PG8_STAGE(PG8_SB(0, 0), b2, voffB);
            PG8_BAR; PG8_WAIT_L(0); PG8_MMA(0, 1, At, B1); PG8_BAR;
            PG8_LDA(At, 0, 1); PG8_STAGE(PG8_SA(0, 0), a2, voffA);
            PG8_BAR; PG8_WAIT_L(0); PG8_MMA(1, 0, At, B0); PG8_BAR; PG8_SCHED;
            PG8_STAGE(PG8_SB(0, 1), b2 + hstep, voffB);
            PG8_WAIT_V(6); PG8_BAR; PG8_MMA(1, 1, At, B1); PG8_BAR;
            PG8_LDB(B0, 1, 0); PG8_SCHED; PG8_LDA(At, 1, 0); PG8_STAGE(PG8_SA(0, 1), a2 + hstep, voffA);
            PG8_WAIT_L(8); PG8_BAR; PG8_WAIT_L(0); PG8_MMA(0, 0, At, B0); PG8_BAR; PG8_SCHED;
            PG8_LDB(B1, 1, 1); PG8_STAGE(PG8_SB(1, 0), b3, voffB);
            PG8_BAR; PG8_WAIT_L(0); PG8_MMA(0, 1, At, B1); PG8_BAR;
            PG8_LDA(At, 1, 1); PG8_STAGE(PG8_SA(1, 0), a3, voffA);
            PG8_BAR; PG8_WAIT_L(0); PG8_MMA(1, 0, At, B0); PG8_BAR; PG8_SCHED;
            PG8_STAGE(PG8_SB(1, 1), b3 + hstep, voffB);
            PG8_WAIT_V(6); PG8_BAR; PG8_MMA(1, 1, At, B1); PG8_BAR;
        }
        if constexpr (FP8) asm volatile("s_nop 15\n\ts_nop 15" ::: "memory");
        E(acc, cur, wr, wc, fr, fq);
        if (!has_next) break;
#pragma unroll
        for (int a = 0; a < 2; ++a)
#pragma unroll
            for (int b = 0; b < 2; ++b)
#pragma unroll
                for (int m = 0; m < 4; ++m)
#pragma unroll
                    for (int n = 0; n < 2; ++n) acc[a][b][m][n] = (f32x4){0.f, 0.f, 0.f, 0.f};
        cur = nxt; cA = nA; cB = nB; ++ui;
        if constexpr (FP8) asm volatile("s_nop 7" ::: "memory");
    }
    PG8_WAIT_V(0);
    if (wr == 0) PG8_BAR;
    PG8_BAR;
#undef PG8_SA
#undef PG8_SB
#undef PG8_STAGE
#undef PG8_LDA
#undef PG8_LDB
#undef PG8_MMA
#undef PG8_WAIT_V
#undef PG8_WAIT_L
#undef PG8_BAR
#undef PG8_SCHED
}
}

DEVI float lb_of(const float* lbraw, int ch) {
    const float r0 = lbraw[ch], r1 = lbraw[512 + ch], r2 = lbraw[1024 + ch];
    const float mx = fmaxf(r0, fmaxf(r1, r2));
    const float e0 = __expf(r0 - mx), e1 = __expf(r1 - mx), e2 = __expf(r2 - mx);
    return e0 / (e0 + e1 + e2);
}
DEVI void ph_hgrn_naive(float* lds, const bf16_t* u, const float* lbraw, float* oacc, int vb0, int vbs) {
    float* sq = lds; float* sk = lds + 2048; float* sf = lds + 4096; float* sv = lds + 6144;
    const int tid = opq((int)threadIdx.x), j = tid >> 2, kq = tid & 3;
    for (int vb = vb0; vb < 32; vb += vbs) {
        const int dir = vb & 1, h = (vb >> 1) & 3, b = vb >> 3;
        float st[32];
#pragma unroll
        for (int i = 0; i < 32; ++i) st[i] = 0.f;
        for (int tb = 0; tb < SEQ / 16; ++tb) {
            __syncthreads();
            for (int e = tid; e < 2048; e += NTHR) {
                const int i = e >> 7, c = e & 127;
                const int t = dir ? (SEQ - 1 - (tb * 16 + i)) : (tb * 16 + i);
                const bf16_t* ur = u + (size_t)(b * SEQ + t) * UW;
                const int ch = h * 128 + c;
                const float qr = bf2f(ur[ch]), fr = bf2f(ur[(dir ? 1024 : 512) + ch]), vr = bf2f(ur[1536 + ch]);
                const float lb = lb_of(lbraw, ch);
                const float f = lb + (1.f - lb) * sigmoid_f(fr);
                sq[e] = silu_f(qr); sk[e] = 1.f - f; sf[e] = f; sv[e] = vr;
            }
            __syncthreads();
            for (int i = 0; i < 16; ++i) {
                const float vj = sv[i * 128 + j]; float acc = 0.f;
#pragma unroll
                for (int kk = 0; kk < 32; ++kk) {
                    const int kidx = kk * 4 + kq;
                    st[kk] = sf[i * 128 + kidx] * st[kk] + sk[i * 128 + kidx] * vj;
                    acc += st[kk] * sq[i * 128 + kidx];
                }
                acc += __shfl_xor(acc, 1); acc += __shfl_xor(acc, 2);
                if (kq == 0) {
                    const int t = dir ? (SEQ - 1 - (tb * 16 + i)) : (tb * 16 + i);
                    atomicAdd(&oacc[(size_t)(b * SEQ + t) * DM + h * 128 + j], acc);
                }
            }
        }
    }
    __syncthreads();
}

DEVI void ph_mixfin_hgrn(const bf16_t* u, const float* oacc, const float* a_norm, bf16_t* ocat, int vb0, int vbs) {
    const int tidq = opq((int)threadIdx.x); const int hw = tidq >> 5, l32 = tidq & 31;
    for (int row = vb0 * 16 + hw; row < MT; row += vbs * 16) {
        const int c0 = l32 * 16; float v[16]; float ss = 0.f;
        const bf16_t* ur = u + (size_t)row * UW;
#pragma unroll
        for (int i = 0; i < 16; ++i) { v[i] = oacc[(size_t)row * DM + c0 + i]; ss += v[i] * v[i]; }
        ss += __shfl_xor(ss, 1); ss += __shfl_xor(ss, 2); ss += __shfl_xor(ss, 4);
        const float r = rsqrtf(ss * (1.f / 128.f) + EPS);
#pragma unroll
        for (int i = 0; i < 16; ++i) { const int c = c0 + i; ocat[(size_t)row * DM + c] = f2bf(v[i] * r * a_norm[c & 127] * silu_f(bf2f(ur[2048 + c]))); }
    }
}


constexpr int HQ = 0, HK = 17408, HKH = 34816, HV = 53248, HDV = 71680, HGL = 73728, HOT = 75776, H_END = HOT + 64 * 528;
static_assert(H_END <= 131072, "hgrn lds");
constexpr size_t HS_SCAN = (size_t)16 * 16384;
DEVI float hgrn_prep(LAS unsigned char* lds, const bf16_t* u, float lbv, int dir, size_t tokbase, int h, int c, int I) {
    float g[16], kk[16], qq[16];
    const bf16_t* up = u + (tokbase + 16 * I) * UW + h * 128 + c;
    const int fcol = dir ? 1024 : 512;
#pragma unroll
    for (int j = 0; j < 16; ++j) {
        const float fr = bf2f(up[(size_t)j * UW + fcol]), qr = bf2f(up[(size_t)j * UW]);
        const float f = lbv + (1.f - lbv) * sigmoid_f(fr);
        g[j] = __logf(f); kk[j] = 1.f - f; qq[j] = silu_f(qr);
    }
    float run = 0.f;
#pragma unroll
    for (int jj = 0; jj < 16; ++jj) { const int j = dir ? 15 - jj : jj; run += g[j]; g[j] = run; }
    const float G = run;
    float kh[16];
#pragma unroll
    for (int j = 0; j < 16; ++j) {
        const float qt = qq[j] * __expf(g[j]), kt = kk[j] * __expf(-g[j]);
        kh[j] = kk[j] * __expf(G - g[j]);
        *(LAS bf16_t*)(lds + HQ + (16 * I + j) * 272 + c * 2) = f2bf(qt);
        *(LAS bf16_t*)(lds + HK + (16 * I + j) * 272 + c * 2) = f2bf(kt);
    }
    u32x4 w0, w1;
    w0.x = pk2(kh[0], kh[1]); w0.y = pk2(kh[2], kh[3]); w0.z = pk2(kh[4], kh[5]); w0.w = pk2(kh[6], kh[7]);
    w1.x = pk2(kh[8], kh[9]); w1.y = pk2(kh[10], kh[11]); w1.z = pk2(kh[12], kh[13]); w1.w = pk2(kh[14], kh[15]);
    *(LAS u32x4*)(lds + HKH + c * 144 + I * 32) = w0; *(LAS u32x4*)(lds + HKH + c * 144 + I * 32 + 16) = w1;
    *(LAS float*)(lds + HDV + (I * 128 + c) * 4) = __expf(G);
    return G;
}
DEVI void hgrn_update(LAS unsigned char* lds, f32x4 (&Sacc)[8], int I, int wid, int fr, int fq) {
    const u32x4 z4 = {0u, 0u, 0u, 0u};
    const u32x4 vb = (fq < 2) ? *(const LAS u32x4*)(lds + HV + (16 * wid + fr) * 144 + (16 * I + 8 * fq) * 2) : z4;
#pragma unroll
    for (int m = 0; m < 8; ++m) {
        const f32x4 dv = *(const LAS f32x4*)(lds + HDV + (I * 128 + 16 * m + 4 * fq) * 4);
        const u32x4 ka = (fq < 2) ? *(const LAS u32x4*)(lds + HKH + (16 * m + fr) * 144 + (16 * I + 8 * fq) * 2) : z4;
        Sacc[m] = __builtin_amdgcn_mfma_f32_16x16x32_bf16(__builtin_bit_cast(bf16x8, ka), __builtin_bit_cast(bf16x8, vb), Sacc[m] * dv, 0, 0, 0);
    }
}
DEVI void stage_vt(LAS unsigned char* lds, const bf16_t* VT, int b, int h, int t0, int tid) {
    for (int e = tid; e < 128 * 8; e += NTHR) { const int r = e >> 3, cch = e & 7; *(LAS u32x4*)(lds + HV + r * 144 + cch * 16) = *(const u32x4*)(VT + ((size_t)b * 512 + h * 128 + r) * SEQ + t0 + cch * 8); }
}
DEVI void ph_hgrn_states(LAS unsigned char* lds, const bf16_t* u, const bf16_t* VT, const float* lbraw, float* HS, float* HD, int vb0, int vbs) {
    const int tid = opq((int)threadIdx.x), wid = __builtin_amdgcn_readfirstlane(tid >> 6), lane = tid & 63, fr = lane & 15, fq = lane >> 4;
    const int pc = tid & 127, pI = tid >> 7;
    for (int unit = vb0; unit < NB * 4 * 2 * 16; unit += vbs) {
        const int seg = unit & 15, dir = (unit >> 4) & 1, h = (unit >> 5) & 3, b = unit >> 7;
        const float lbv = lb_of(lbraw, h * 128 + pc);
        f32x4 Sacc[8];
#pragma unroll
        for (int m = 0; m < 8; ++m) Sacc[m] = (f32x4){0.f, 0.f, 0.f, 0.f};
        float gsum = 0.f;
#pragma unroll 1
        for (int sbi = 0; sbi < 4; ++sbi) {
            const int sb = dir ? 3 - sbi : sbi;
            const int t0 = seg * 256 + sb * 64;
            __syncthreads();
            const float G = hgrn_prep(lds, u, lbv, dir, (size_t)b * SEQ + t0, h, pc, pI);
            *(LAS float*)(lds + HGL + (pI * 128 + pc) * 4) = G;
            stage_vt(lds, VT, b, h, t0, tid);
            __syncthreads();
            if (tid < 128) gsum += *(const LAS float*)(lds + HGL + tid * 4) + *(const LAS float*)(lds + HGL + (128 + tid) * 4) + *(const LAS float*)(lds + HGL + (256 + tid) * 4) + *(const LAS float*)(lds + HGL + (384 + tid) * 4);
#pragma unroll 1
            for (int ii = 0; ii < 4; ++ii) { const int I = dir ? 3 - ii : ii; hgrn_update(lds, Sacc, I, wid, fr, fq); }
        }
        const size_t scan = (size_t)(b * 4 + h) * 2 + dir;
        float* dst = HS + scan * HS_SCAN + (size_t)seg * 16384;
#pragma unroll
        for (int m = 0; m < 8; ++m)
#pragma unroll
            for (int rg = 0; rg < 4; ++rg) dst[(16 * m + 4 * fq + rg) * 128 + 16 * wid + fr] = Sacc[m][rg];
        if (tid < 128) HD[(scan * 16 + seg) * 128 + tid] = __expf(gsum);
    }
    __syncthreads();
}
DEVI void ph_hgrn_scan(float* HS, const float* HD, int vb0, int vbs) {
    const int tid = opq((int)threadIdx.x);
    for (int idx = vb0 * NTHR + tid; idx < 32 * 4096; idx += vbs * NTHR) {
        const int scan = idx >> 12, e4 = idx & 4095, kch = e4 >> 5; const int dir = scan & 1;
        float4* base = (float4*)(HS + (size_t)scan * HS_SCAN) + e4;
        const float* hd = HD + (size_t)scan * 16 * 128 + kch;
        float4 st = make_float4(0.f, 0.f, 0.f, 0.f);
        for (int i = 0; i < 16; ++i) {
            const int sg = dir ? 15 - i : i;
            const float4 d = base[(size_t)sg * 4096]; const float dec = hd[sg * 128];
            base[(size_t)sg * 4096] = st;
            st.x = st.x * dec + d.x; st.y = st.y * dec + d.y; st.z = st.z * dec + d.z; st.w = st.w * dec + d.w;
        }
    }
}
DEVI void ph_hgrn_out(LAS unsigned char* lds, const bf16_t* u, const bf16_t* VT, const float* lbraw, const float* a_norm, const float* HS, float* OF, bf16_t* ocat, int vb0, int vbs) {
    const int tid = opq((int)threadIdx.x), wid = __builtin_amdgcn_readfirstlane(tid >> 6), lane = tid & 63, fr = lane & 15, fq = lane >> 4;
    const int pc = tid & 127, pI = tid >> 7;
    const int otok = tid >> 3, opart = tid & 7;
    for (int unit = vb0; unit < NB * 4 * 16; unit += vbs) {
        const int seg = unit & 15, h = (unit >> 4) & 3, b = unit >> 6;
        const float lbv = lb_of(lbraw, h * 128 + pc);
#pragma unroll 1
        for (int dir = 0; dir < 2; ++dir) {
            const size_t scan = (size_t)(b * 4 + h) * 2 + dir;
            const float* src = HS + scan * HS_SCAN + (size_t)seg * 16384;
            f32x4 Sacc[8];
#pragma unroll
            for (int m = 0; m < 8; ++m)
#pragma unroll
                for (int rg = 0; rg < 4; ++rg) Sacc[m][rg] = src[(16 * m + 4 * fq + rg) * 128 + 16 * wid + fr];
#pragma unroll 1
            for (int sbi = 0; sbi < 4; ++sbi) {
                const int sb = dir ? 3 - sbi : sbi;
                const int t0 = seg * 256 + sb * 64;
                const size_t tokb = (size_t)b * SEQ + t0;
                __syncthreads();
                (void)hgrn_prep(lds, u, lbv, dir, tokb, h, pc, pI);
                stage_vt(lds, VT, b, h, t0, tid);
                __syncthreads();
#pragma unroll 1
                for (int ii = 0; ii < 4; ++ii) {
                    const int I = dir ? 3 - ii : ii;
                    f32x4 oT = {0.f, 0.f, 0.f, 0.f};
                    const LAS unsigned char* qrow = lds + HQ + (16 * I + fr) * 272;
#pragma unroll
                    for (int ks = 0; ks < 4; ++ks) {
                        u32x4 sa; sa.x = pg8::cvt_pk_bf16(Sacc[2 * ks][0], Sacc[2 * ks][1]); sa.y = pg8::cvt_pk_bf16(Sacc[2 * ks][2], Sacc[2 * ks][3]);
                        sa.z = pg8::cvt_pk_bf16(Sacc[2 * ks + 1][0], Sacc[2 * ks + 1][1]); sa.w = pg8::cvt_pk_bf16(Sacc[2 * ks + 1][2], Sacc[2 * ks + 1][3]);
                        const u32x2 q0 = *(const LAS u32x2*)(qrow + (32 * ks + 4 * fq) * 2), q1 = *(const LAS u32x2*)(qrow + (32 * ks + 16 + 4 * fq) * 2);
                        u32x4 qb; qb.x = q0.x; qb.y = q0.y; qb.z = q1.x; qb.w = q1.y;
                        oT = __builtin_amdgcn_mfma_f32_16x16x32_bf16(__builtin_bit_cast(bf16x8, sa), __builtin_bit_cast(bf16x8, qb), oT, 0, 0, 0);
                    }
                    f32x4 sT = {0.f, 0.f, 0.f, 0.f};
                    const LAS unsigned char* krow = lds + HK + (16 * I + fr) * 272;
#pragma unroll
                    for (int ks = 0; ks < 4; ++ks) {
                        const bf16x8 ka = *(const LAS bf16x8*)(krow + (32 * ks + 8 * fq) * 2), qb = *(const LAS bf16x8*)(qrow + (32 * ks + 8 * fq) * 2);
                        sT = __builtin_amdgcn_mfma_f32_16x16x32_bf16(ka, qb, sT, 0, 0, 0);
                    }
                    float pv[4];
#pragma unroll
                    for (int rg = 0; rg < 4; ++rg) { const int sl = 4 * fq + rg; const bool ok = dir ? (sl >= fr) : (sl <= fr); pv[rg] = ok ? sT[rg] : 0.f; }
                    u32x4 pb; pb.x = pg8::cvt_pk_bf16(pv[0], pv[1]); pb.y = pg8::cvt_pk_bf16(pv[2], pv[3]); pb.z = 0u; pb.w = 0u;
                    const u32x2 v0 = *(const LAS u32x2*)(lds + HV + (16 * wid + fr) * 144 + (16 * I + 4 * fq) * 2);
                    u32x4 va; va.x = v0.x; va.y = v0.y; va.z = 0u; va.w = 0u;
                    oT = __builtin_amdgcn_mfma_f32_16x16x32_bf16(__builtin_bit_cast(bf16x8, va), __builtin_bit_cast(bf16x8, pb), oT, 0, 0, 0);
                    *(LAS f32x4*)(lds + HOT + (16 * I + fr) * 528 + (16 * wid + 4 * fq) * 4) = oT;
                    hgrn_update(lds, Sacc, I, wid, fr, fq);
                }
                __syncthreads();
                const LAS float* orow = (const LAS float*)(lds + HOT + otok * 528) + opart * 16;
                float* ofp = OF + (tokb + otok) * 512 + h * 128 + opart * 16;
                if (dir == 0) {
#pragma unroll
                    for (int q4 = 0; q4 < 4; ++q4) { const f32x4 v = *(const LAS f32x4*)(orow + q4 * 4);
                        __hip_atomic_store((unsigned long long*)(ofp + q4 * 4), (unsigned long long)__float_as_uint(v[0]) | ((unsigned long long)__float_as_uint(v[1]) << 32), __ATOMIC_RELAXED, __HIP_MEMORY_SCOPE_AGENT);
                        __hip_atomic_store((unsigned long long*)(ofp + q4 * 4 + 2), (unsigned long long)__float_as_uint(v[2]) | ((unsigned long long)__float_as_uint(v[3]) << 32), __ATOMIC_RELAXED, __HIP_MEMORY_SCOPE_AGENT); }
                } else {
                    float v[16]; float ss = 0.f;
#pragma unroll
                    for (int q2 = 0; q2 < 8; ++q2) { const unsigned long long w = __hip_atomic_load((unsigned long long*)(ofp + q2 * 2), __ATOMIC_RELAXED, __HIP_MEMORY_SCOPE_AGENT);
                        v[2 * q2] = __uint_as_float((unsigned)w) + orow[2 * q2]; v[2 * q2 + 1] = __uint_as_float((unsigned)(w >> 32)) + orow[2 * q2 + 1];
                        ss += v[2 * q2] * v[2 * q2] + v[2 * q2 + 1] * v[2 * q2 + 1]; }
                    ss += __shfl_xor(ss, 1); ss += __shfl_xor(ss, 2); ss += __shfl_xor(ss, 4);
                    const float rn = rsqrtf(ss * (1.f / 128.f) + EPS);
                    const bf16_t* gp = u + (tokb + otok) * UW + 2048 + h * 128 + opart * 16;
                    const u32x4 g0 = *(const u32x4*)gp, g1 = *(const u32x4*)(gp + 8);
                    const unsigned gw[8] = {g0.x, g0.y, g0.z, g0.w, g1.x, g1.y, g1.z, g1.w};
                    unsigned ow[8];
#pragma unroll
                    for (int q2 = 0; q2 < 8; ++q2) { const float an0 = a_norm[opart * 16 + 2 * q2], an1 = a_norm[opart * 16 + 2 * q2 + 1];
                        ow[q2] = pk2(v[2 * q2] * rn * an0 * silu_f(bflo(gw[q2])), v[2 * q2 + 1] * rn * an1 * silu_f(bfhi(gw[q2]))); }
                    bf16_t* op = ocat + (tokb + otok) * DM + h * 128 + opart * 16;
                    u32x4 o0, o1; o0.x = ow[0]; o0.y = ow[1]; o0.z = ow[2]; o0.w = ow[3]; o1.x = ow[4]; o1.y = ow[5]; o1.z = ow[6]; o1.w = ow[7];
                    *(u32x4*)op = o0; *(u32x4*)(op + 8) = o1;
                }
            }
            asm volatile("s_waitcnt vmcnt(0)" ::: "memory");
        }
    }
    __syncthreads();
}

DEVI void ph_prep(const bf16_t* u, const float* cw, const float* cb, bf16_t* xconv, bf16_t* XT, bf16_t* VT, int vb0, int vbs) {
    const int tid = opq((int)threadIdx.x);
    for (int unit = vb0; unit < NB * 32 * 3; unit += vbs) {
        const int cg = unit % 3, tb = (unit / 3) & 31, b = unit / 96;
        const int t0 = tb * 128;
        if (cg < 2) {
            const int ch = cg * 512 + tid;
            float w[5];
#pragma unroll
            for (int j = 0; j < 5; ++j) w[j] = cw[j * 1024 + ch];
            const float bias = cb[ch];
            const bf16_t* up = u + (size_t)b * SEQ * UW + 3072 + ch;
            float v0, v1, v2, v3;
            v0 = (t0 - 2 >= 0) ? bf2f(up[(size_t)(t0 - 2) * UW]) : 0.f;
            v1 = (t0 - 1 >= 0) ? bf2f(up[(size_t)(t0 - 1) * UW]) : 0.f;
            v2 = bf2f(up[(size_t)t0 * UW]);
            v3 = bf2f(up[(size_t)(t0 + 1) * UW]);
            for (int t8 = 0; t8 < 128; t8 += 8) {
                float nx[8];
#pragma unroll
                for (int i = 0; i < 8; ++i) { const int tt = t0 + t8 + i + 2; nx[i] = (tt < SEQ) ? bf2f(up[(size_t)tt * UW]) : 0.f; }
                unsigned pk[4];
#pragma unroll
                for (int i = 0; i < 8; ++i) {
                    const float o = silu_f(bias + w[0] * v0 + w[1] * v1 + w[2] * v2 + w[3] * v3 + w[4] * nx[i]);
                    const bf16_t ob = f2bf(o);
                    xconv[(size_t)(b * SEQ + t0 + t8 + i) * 1024 + ch] = ob;
                    if (i & 1) pk[i >> 1] |= ((unsigned)ob << 16); else pk[i >> 1] = ob;
                    v0 = v1; v1 = v2; v2 = v3; v3 = nx[i];
                }
                if (ch < 768) { u32x4 o4; o4.x = pk[0]; o4.y = pk[1]; o4.z = pk[2]; o4.w = pk[3]; *(u32x4*)(XT + ((size_t)b * 768 + ch) * SEQ + t0 + t8) = o4; }
            }
        } else {
            const int ch = tid;
            const bf16_t* up = u + (size_t)b * SEQ * UW + 1536 + ch;
            for (int t8 = 0; t8 < 128; t8 += 8) {
                unsigned pk[4];
#pragma unroll
                for (int i = 0; i < 8; ++i) { const unsigned ob = up[(size_t)(t0 + t8 + i) * UW]; if (i & 1) pk[i >> 1] |= (ob << 16); else pk[i >> 1] = ob; }
                u32x4 o4; o4.x = pk[0]; o4.y = pk[1]; o4.z = pk[2]; o4.w = pk[3]; *(u32x4*)(VT + ((size_t)b * 512 + ch) * SEQ + t0 + t8) = o4;
            }
        }
    }
}

constexpr int MB_XT = 0, MB_BX = 256 * 272, MB_DT = MB_BX + 128 * 272, MB_CS = MB_DT + 8 * 128 * 4, MB_TOT = MB_CS + 8 * 128 * 4, MB_END = MB_TOT + 64;
static_assert(MB_END <= 131072, "mamba lds");
constexpr size_t MS_SCAN = (size_t)32 * 8192;
DEVI bf16x8 pack8(const float* v) { u32x4 w; w.x = pg8::cvt_pk_bf16(v[0], v[1]); w.y = pg8::cvt_pk_bf16(v[2], v[3]); w.z = pg8::cvt_pk_bf16(v[4], v[5]); w.w = pg8::cvt_pk_bf16(v[6], v[7]); return __builtin_bit_cast(bf16x8, w); }
DEVI void mamba_tables(LAS unsigned char* lds, const float* dtraw, const float* A_log, const float* dt_bias, int b, int g, int c, int wid, int lane) {
    LAS float* tdt = (LAS float*)(lds + MB_DT); LAS float* tcs = (LAS float*)(lds + MB_CS); LAS float* ttot = (LAS float*)(lds + MB_TOT);
    const int r = wid >> 1, dir = wid & 1, hd = 4 * g + r;
    const float A = -__expf(A_log[dir * 8 + hd]), bias = dt_bias[dir * 8 + hd];
    const size_t tk = (size_t)b * SEQ + c * 128 + 2 * lane;
    const float dt0 = softplus_f(dtraw[tk * 16 + dir * 8 + hd] + bias), dt1 = softplus_f(dtraw[(tk + 1) * 16 + dir * 8 + hd] + bias);
    const float a0 = dt0 * A, a1 = dt1 * A;
    float sc = a0 + a1;
#pragma unroll
    for (int off = 1; off < 64; off <<= 1) { const float v = __shfl_up(sc, off); if (lane >= off) sc += v; }
    const float total = __shfl(sc, 63);
    const float pre0 = sc - a1, pre1 = sc;
    const float c0 = dir ? (total - pre0 + a0) : pre0, c1 = dir ? (total - pre1 + a1) : pre1;
    tdt[wid * 128 + 2 * lane] = dt0; tdt[wid * 128 + 2 * lane + 1] = dt1;
    tcs[wid * 128 + 2 * lane] = c0; tcs[wid * 128 + 2 * lane + 1] = c1;
    if (lane == 0) ttot[wid] = total;
}
DEVI void stage_rows(LAS unsigned char* dst, const bf16_t* src, size_t src_stride, int rows, int tid) {
    for (int e = tid; e < rows * 16; e += NTHR) { const int r = e >> 4, cch = e & 15; *(LAS u32x4*)(dst + r * 272 + cch * 16) = *(const u32x4*)(src + (size_t)r * src_stride + cch * 8); }
}
DEVI void ph_mamba_states(LAS unsigned char* lds, const bf16_t* XT, const float* dtraw, const float* A_log, const float* dt_bias, float* MS, float* MD, int vb0, int vbs) {
    const int tid = opq((int)threadIdx.x), wid = __builtin_amdgcn_readfirstlane(tid >> 6), lane = tid & 63, fr = lane & 15, fq = lane >> 4;
    LAS float* tdt = (LAS float*)(lds + MB_DT); LAS float* tcs = (LAS float*)(lds + MB_CS); LAS float* ttot = (LAS float*)(lds + MB_TOT);
    for (int unit = vb0; unit < NB * 2 * 32; unit += vbs) {
        const int c = unit & 31, g = (unit >> 5) & 1, b = unit >> 6;
        __syncthreads();
        stage_rows(lds + MB_XT, XT + ((size_t)b * 768 + g * 256) * SEQ + c * 128, SEQ, 256, tid);
        stage_rows(lds + MB_BX, XT + ((size_t)b * 768 + 512 + g * 128) * SEQ + c * 128, SEQ, 128, tid);
        mamba_tables(lds, dtraw, A_log, dt_bias, b, g, c, wid, lane);
        __syncthreads();
        if (lane == 0) MD[((size_t)(b * 8 + 4 * g + (wid >> 1)) * 2 + (wid & 1)) * 32 + c] = __expf(ttot[wid]);
        for (int hdd = 0; hdd < 8; ++hdd) {
            const int r = hdd >> 1, dir = hdd & 1, hd = 4 * g + r;
            const float tot = ttot[hdd];
            f32x4 acc[4];
#pragma unroll
            for (int pt = 0; pt < 4; ++pt) acc[pt] = (f32x4){0.f, 0.f, 0.f, 0.f};
#pragma unroll
            for (int ks = 0; ks < 4; ++ks) {
                const int s0 = 32 * ks + 8 * fq;
                const u32x4 braw = *(const LAS u32x4*)(lds + MB_BX + (16 * wid + fr) * 272 + s0 * 2);
                float bw[8];
                const unsigned bu[4] = {braw.x, braw.y, braw.z, braw.w};
#pragma unroll
                for (int j = 0; j < 8; ++j) { const float bv = (j & 1) ? bfhi(bu[j >> 1]) : bflo(bu[j >> 1]);
                    bw[j] = bv * tdt[hdd * 128 + s0 + j] * __expf(tot - tcs[hdd * 128 + s0 + j]); }
                const bf16x8 Bf = pack8(bw);
#pragma unroll
                for (int pt = 0; pt < 4; ++pt) {
                    const bf16x8 Af = *(const LAS bf16x8*)(lds + MB_XT + (r * 64 + 16 * pt + fr) * 272 + s0 * 2);
                    acc[pt] = __builtin_amdgcn_mfma_f32_16x16x32_bf16(Af, Bf, acc[pt], 0, 0, 0);
                }
            }
            float* dst = MS + ((size_t)(b * 8 + hd) * 2 + dir) * MS_SCAN + (size_t)c * 8192;
#pragma unroll
            for (int pt = 0; pt < 4; ++pt)
#pragma unroll
                for (int rg = 0; rg < 4; ++rg) dst[(16 * pt + 4 * fq + rg) * 128 + 16 * wid + fr] = acc[pt][rg];
        }
    }
    __syncthreads();
}
DEVI void ph_mamba_scan(float* MS, const float* MD, int vb0, int vbs) {
    const int tid = opq((int)threadIdx.x);
    for (int idx = vb0 * NTHR + tid; idx < 64 * 2048; idx += vbs * NTHR) {
        const int scan = idx >> 11, e4 = idx & 2047; const int dir = scan & 1;
        float4* base = (float4*)(MS + (size_t)scan * MS_SCAN) + e4;
        const float* md = MD + (size_t)scan * 32;
        float4 h = make_float4(0.f, 0.f, 0.f, 0.f);
        for (int i = 0; i < 32; ++i) {
            const int c = dir ? 31 - i : i;
            const float4 d = base[(size_t)c * 2048]; const float dec = md[c];
            base[(size_t)c * 2048] = h;
            h.x = h.x * dec + d.x; h.y = h.y * dec + d.y; h.z = h.z * dec + d.z; h.w = h.w * dec + d.w;
        }
    }
}
DEVI void ph_mamba_out(LAS unsigned char* lds, const bf16_t* u, const bf16_t* xconv, const bf16_t* XT, const float* dtraw, const float* A_log, const float* dt_bias, const float* Dskip, const float* b_norm,
                       const float* MS, bf16_t* ocat, int vb0, int vbs) {
    const int tid = opq((int)threadIdx.x), wid = __builtin_amdgcn_readfirstlane(tid >> 6), lane = tid & 63, fr = lane & 15, fq = lane >> 4;
    LAS float* tdt = (LAS float*)(lds + MB_DT); LAS float* tcs = (LAS float*)(lds + MB_CS);
    for (int unit = vb0; unit < NB * 2 * 32; unit += vbs) {
        const int c = unit & 31, g = (unit >> 5) & 1, b = unit >> 6;
        const size_t tok0 = (size_t)b * SEQ + c * 128;
        __syncthreads();
        stage_rows(lds + MB_XT, XT + ((size_t)b * 768 + g * 256) * SEQ + c * 128, SEQ, 256, tid);
        stage_rows(lds + MB_BX, xconv + tok0 * 1024 + 512 + g * 128, 1024, 128, tid);
        mamba_tables(lds, dtraw, A_log, dt_bias, b, g, c, wid, lane);
        const int tl = 16 * wid + fr;
        bf16x8 Cf[4];
#pragma unroll
        for (int ks = 0; ks < 4; ++ks) Cf[ks] = *(const bf16x8*)(xconv + (tok0 + tl) * 1024 + 768 + g * 128 + 32 * ks + 8 * fq);
        __syncthreads();
        f32x4 GT[8];
#pragma unroll
        for (int st = 0; st < 8; ++st) { GT[st] = (f32x4){0.f, 0.f, 0.f, 0.f};
#pragma unroll
            for (int ks = 0; ks < 4; ++ks) { const bf16x8 Af = *(const LAS bf16x8*)(lds + MB_BX + (16 * st + fr) * 272 + (32 * ks + 8 * fq) * 2);
                GT[st] = __builtin_amdgcn_mfma_f32_16x16x32_bf16(Af, Cf[ks], GT[st], 0, 0, 0); } }
        float ss = 0.f;
#pragma unroll 1
        for (int r = 0; r < 4; ++r) {
            const int hd = 4 * g + r;
            f32x4 yv[4];
#pragma unroll
            for (int pt = 0; pt < 4; ++pt) yv[pt] = (f32x4){0.f, 0.f, 0.f, 0.f};
#pragma unroll 1
            for (int dir = 0; dir < 2; ++dir) {
                const int hdd = r * 2 + dir;
                const float cst = tcs[hdd * 128 + tl];
                f32x4 yo[4];
                const float* hin = MS + ((size_t)(b * 8 + hd) * 2 + dir) * MS_SCAN + (size_t)c * 8192;
#pragma unroll
                for (int pt = 0; pt < 4; ++pt) { yo[pt] = (f32x4){0.f, 0.f, 0.f, 0.f};
#pragma unroll
                    for (int ks = 0; ks < 4; ++ks) { const float* hp = hin + (16 * pt + fr) * 128 + 32 * ks + 8 * fq;
                        const float4 h0 = *(const float4*)hp, h1 = *(const float4*)(hp + 4);
                        const float hv[8] = {h0.x, h0.y, h0.z, h0.w, h1.x, h1.y, h1.z, h1.w};
                        yo[pt] = __builtin_amdgcn_mfma_f32_16x16x32_bf16(pack8(hv), Cf[ks], yo[pt], 0, 0, 0); } }
                const float eo = __expf(cst);
#pragma unroll
                for (int pt = 0; pt < 4; ++pt) yv[pt] += yo[pt] * eo;
#pragma unroll
                for (int kp = 0; kp < 4; ++kp) {
                    const bool skip = dir ? (2 * kp + 1 < wid) : (2 * kp > wid);
                    if (!skip) {
                        float pv[8];
#pragma unroll
                        for (int hlf = 0; hlf < 2; ++hlf)
#pragma unroll
                            for (int rg = 0; rg < 4; ++rg) { const int st = 2 * kp + hlf, sl = 16 * st + 4 * fq + rg;
                                const bool ok = dir ? (sl >= tl) : (sl <= tl);
                                const float e = __expf(fminf(cst - tcs[hdd * 128 + sl], 0.f));
                                pv[hlf * 4 + rg] = ok ? GT[st][rg] * e * tdt[hdd * 128 + sl] : 0.f; }
                        const bf16x8 Pf = pack8(pv);
#pragma unroll
                        for (int pt = 0; pt < 4; ++pt) {
                            const LAS unsigned char* xr = lds + MB_XT + (r * 64 + 16 * pt + fr) * 272;
                            const u32x2 x0 = *(const LAS u32x2*)(xr + (32 * kp + 4 * fq) * 2), x1 = *(const LAS u32x2*)(xr + (32 * kp + 16 + 4 * fq) * 2);
                            u32x4 xa; xa.x = x0.x; xa.y = x0.y; xa.z = x1.x; xa.w = x1.y;
                            yv[pt] = __builtin_amdgcn_mfma_f32_16x16x32_bf16(__builtin_bit_cast(bf16x8, xa), Pf, yv[pt], 0, 0, 0);
                        }
                    }
                }
            }
            const float Dk = Dskip[hd];
#pragma unroll
            for (int pt = 0; pt < 4; ++pt) {
                const int p0 = 16 * pt + 4 * fq;
                const u32x2 xr = *(const u32x2*)(xconv + (tok0 + tl) * 1024 + hd * 64 + p0);
                const u32x2 zr = *(const u32x2*)(u + (tok0 + tl) * UW + 2560 + hd * 64 + p0);
                const float xs[4] = {bflo(xr.x), bfhi(xr.x), bflo(xr.y), bfhi(xr.y)}, zs[4] = {bflo(zr.x), bfhi(zr.x), bflo(zr.y), bfhi(zr.y)};
                float yy[4];
#pragma unroll
                for (int rg = 0; rg < 4; ++rg) { const float y = (yv[pt][rg] + Dk * xs[rg]) * silu_f(zs[rg]); yy[rg] = y; ss += y * y; }
                const unsigned long long o = (unsigned long long)pk2(yy[0], yy[1]) | ((unsigned long long)pk2(yy[2], yy[3]) << 32);
                __hip_atomic_store((unsigned long long*)(ocat + (tok0 + tl) * DM + 512 + g * 256 + r * 64 + p0), o, __ATOMIC_RELAXED, __HIP_MEMORY_SCOPE_AGENT);
            }
        }
        ss += __shfl_xor(ss, 16); ss += __shfl_xor(ss, 32);
        const float rn = rsqrtf(ss * (1.f / 256.f) + EPS);
        asm volatile("s_waitcnt vmcnt(0)" ::: "memory");
#pragma unroll 1
        for (int r = 0; r < 4; ++r)
#pragma unroll
            for (int pt = 0; pt < 4; ++pt) {
                const int cc = g * 256 + r * 64 + 16 * pt + 4 * fq;
                unsigned long long* op = (unsigned long long*)(ocat + (tok0 + tl) * DM + 512 + cc);
                const unsigned long long v = __hip_atomic_load(op, __ATOMIC_RELAXED, __HIP_MEMORY_SCOPE_AGENT);
                const unsigned vlo = (unsigned)v, vhi = (unsigned)(v >> 32);
                const float4 bn = *(const float4*)(b_norm + cc);
                const unsigned long long o = (unsigned long long)pk2(bflo(vlo) * rn * bn.x, bfhi(vlo) * rn * bn.y) | ((unsigned long long)pk2(bflo(vhi) * rn * bn.z, bfhi(vhi) * rn * bn.w) << 32);
                *op = o;
            }
    }
    __syncthreads();
}


constexpr int NA_VT = 0, NA_VSTRIDE = 9 * 64 * 2 + 16, NA_BIAS = 64 * NA_VSTRIDE, NA_END = NA_BIAS + 480 * 4;
static_assert(NA_END <= 131072, "na lds");
DEVI void ph_na(LAS unsigned char* lds, const bf16_t* qkv, const float* rpb, bf16_t* oc, int vb0, int vbs) {
    const int tid = opq((int)threadIdx.x), wid = __builtin_amdgcn_readfirstlane(tid >> 6), lane = tid & 63, fr = lane & 15, fq = lane >> 4;
    LAS float* bl = (LAS float*)(lds + NA_BIAS);
    for (int unit = vb0; unit < NB * 16 * 32; unit += vbs) {
        const int rp = unit & 31, h = (unit >> 5) & 15, b = unit >> 9;
        const int r0 = 2 * rp, rs0 = min(max(r0 - 4, 0), 56);
        __syncthreads();
        for (int e = tid; e < 465; e += NTHR) bl[e] = rpb[h * 465 + e];
        for (int task = wid; task < 72; task += 8) {
            const int krow = task >> 3, ch = task & 7, kr = rs0 + krow;
            if (kr < 64) {
                const u32x4 v = *(const u32x4*)(qkv + ((size_t)b * SEQ + kr * 64 + lane) * 3072 + 2048 + h * 64 + ch * 8);
                const unsigned vw[4] = {v.x, v.y, v.z, v.w};
#pragma unroll
                for (int i = 0; i < 8; ++i) *(LAS bf16_t*)(lds + NA_VT + (ch * 8 + i) * NA_VSTRIDE + (krow * 64 + lane) * 2) = (bf16_t)((i & 1) ? (vw[i >> 1] >> 16) : (vw[i >> 1] & 0xffffu));
            }
        }
        __syncthreads();
        const int r = r0 + (wid >> 2), j = wid & 3;
        const int rs = min(max(r - 4, 0), 56), roff = rs - rs0;
        const int bs = (j == 0) ? 0 : (j == 1) ? 8 : (j == 2) ? 24 : 32;
        const int c = 16 * j + fr, qs = min(max(c - 8, 0), 48);
        const size_t qtok = (size_t)b * SEQ + r * 64 + c;
        bf16x8 Qf[2];
#pragma unroll
        for (int ks = 0; ks < 2; ++ks) Qf[ks] = *(const bf16x8*)(qkv + qtok * 3072 + h * 64 + 32 * ks + 8 * fq);
        const bf16_t* kbase = qkv + ((size_t)b * SEQ + rs * 64 + bs + fr) * 3072 + 1024 + h * 64 + 8 * fq;
        bf16x8 kn[4];
#pragma unroll
        for (int q = 0; q < 4; ++q) kn[q] = *(const bf16x8*)(kbase + (size_t)((q >> 1) * 16) * 3072 + (q & 1) * 32);
        f32x4 O[4];
#pragma unroll
        for (int dt = 0; dt < 4; ++dt) O[dt] = (f32x4){0.f, 0.f, 0.f, 0.f};
        float mrun = -1e30f, lrun = 0.f;
#pragma unroll 1
        for (int dr = 0; dr < 8; ++dr) {
            bf16x8 kc[4];
#pragma unroll
            for (int q = 0; q < 4; ++q) kc[q] = kn[q];
            const int drn = dr < 7 ? dr + 1 : 7;
#pragma unroll
            for (int q = 0; q < 4; ++q) kn[q] = *(const bf16x8*)(kbase + ((size_t)drn * 64 + (q >> 1) * 16) * 3072 + (q & 1) * 32);
            float sv[8]; float mloc = -1e30f;
            const LAS float* brow = bl + (rs + dr - r + 7) * 31;
#pragma unroll
            for (int kg = 0; kg < 2; ++kg) {
                f32x4 acc = {0.f, 0.f, 0.f, 0.f};
                acc = __builtin_amdgcn_mfma_f32_16x16x32_bf16(kc[kg * 2], Qf[0], acc, 0, 0, 0);
                acc = __builtin_amdgcn_mfma_f32_16x16x32_bf16(kc[kg * 2 + 1], Qf[1], acc, 0, 0, 0);
#pragma unroll
                for (int rg = 0; rg < 4; ++rg) {
                    const int kcol = bs + 16 * kg + 4 * fq + rg;
                    const bool ok = (kcol >= qs) && (kcol < qs + 16);
                    const int dc = min(max(kcol - c + 15, 0), 30);
                    const float sc = ok ? acc[rg] * 0.125f + brow[dc] : -1e30f;
                    sv[kg * 4 + rg] = sc; mloc = fmaxf(mloc, sc);
                }
            }
            mloc = fmaxf(mloc, __shfl_xor(mloc, 16)); mloc = fmaxf(mloc, __shfl_xor(mloc, 32));
            const float mnew = fmaxf(mrun, mloc);
            const float alpha = __expf(mrun - mnew);
            float psum = 0.f;
#pragma unroll
            for (int i = 0; i < 8; ++i) { const float p = __expf(sv[i] - mnew); sv[i] = p; psum += p; }
            psum += __shfl_xor(psum, 16); psum += __shfl_xor(psum, 32);
            lrun = lrun * alpha + psum; mrun = mnew;
            const bf16x8 Pf = pack8(sv);
            const int koff = ((roff + dr) * 64 + bs + 4 * fq) * 2;
#pragma unroll
            for (int dt = 0; dt < 4; ++dt) {
                const LAS unsigned char* vr = lds + NA_VT + (16 * dt + fr) * NA_VSTRIDE + koff;
                const u32x2 v0 = *(const LAS u32x2*)vr, v1 = *(const LAS u32x2*)(vr + 32);
                u32x4 va; va.x = v0.x; va.y = v0.y; va.z = v1.x; va.w = v1.y;
                O[dt] = __builtin_amdgcn_mfma_f32_16x16x32_bf16(__builtin_bit_cast(bf16x8, va), Pf, O[dt] * alpha, 0, 0, 0);
            }
        }
        const float il = 1.f / lrun;
#pragma unroll
        for (int dt = 0; dt < 4; ++dt) {
            u32x2 o; o.x = pk2(O[dt][0] * il, O[dt][1] * il); o.y = pk2(O[dt][2] * il, O[dt][3] * il);
            *(u32x2*)(oc + qtok * DM + h * 64 + 16 * dt + 4 * fq) = o;
        }
    }
    __syncthreads();
}

DEVI void ph_na_naive(const bf16_t* qkv, const float* rpb, bf16_t* oc, int vb0, int vbs) {
    for (int e4 = vb0 * NTHR + opq((int)threadIdx.x); e4 < MT * 16 * 4; e4 += vbs * NTHR) {
        const int dq = e4 & 3, e = e4 >> 2;
        const int hd = e / MT, tok = e % MT;
        const int b = tok >> 12, t = tok & 4095, r = t >> 6, c = t & 63;
        const int rs = min(max(r - 4, 0), 56), qs = min(max(c - 8, 0), 48);
        float q[16], o[16];
        const bf16_t* qp = qkv + (size_t)tok * 3072 + hd * 64 + dq * 16;
#pragma unroll
        for (int d = 0; d < 16; ++d) { q[d] = bf2f(qp[d]); o[d] = 0.f; }
        float m = -1e30f, l = 0.f;
        for (int dr = 0; dr < 8; ++dr)
            for (int dc = 0; dc < 16; ++dc) {
                const int kr = rs + dr, kc = qs + dc;
                const size_t kt = (size_t)b * SEQ + kr * 64 + kc;
                const bf16_t* kp = qkv + kt * 3072 + 1024 + hd * 64 + dq * 16;
                const bf16_t* vp = qkv + kt * 3072 + 2048 + hd * 64 + dq * 16;
                float s = 0.f;
#pragma unroll
                for (int d = 0; d < 16; ++d) s += q[d] * bf2f(kp[d]);
                s += __shfl_xor(s, 1); s += __shfl_xor(s, 2);
                s = s * 0.125f + rpb[hd * 465 + (kr - r + 7) * 31 + (kc - c + 15)];
                const float mn = fmaxf(m, s); const float al = __expf(m - mn), pe = __expf(s - mn);
                l = l * al + pe; m = mn;
#pragma unroll
                for (int d = 0; d < 16; ++d) o[d] = o[d] * al + pe * bf2f(vp[d]);
            }
        const float il = 1.f / l;
        bf16_t* op = oc + (size_t)tok * DM + hd * 64 + dq * 16;
#pragma unroll
        for (int d = 0; d < 16; ++d) op[d] = f2bf(o[d] * il);
    }
}

#define XB_TMO      128
#define XB_XCNT(j)  (256  + 64 * (j))
#define XB_XSUB(j)  (1280 + 64 * (j))
#define XB_XGEN(j)  (2304 + 64 * (j))
#define XB_TOP      3328
#define XB_TOPGEN   3392
#define XCD_BAR_WORDS 3456
#define XB_SPIN_CAP (1u << 18)

__device__ __forceinline__ unsigned xb_ld(unsigned* p)              { return __hip_atomic_load(p, __ATOMIC_RELAXED, __HIP_MEMORY_SCOPE_AGENT); }
__device__ __forceinline__ unsigned xb_add(unsigned* p, unsigned v) { return __hip_atomic_fetch_add(p, v, __ATOMIC_RELAXED, __HIP_MEMORY_SCOPE_AGENT); }
__device__ __forceinline__ unsigned xb_xcc_id() { return (unsigned)__builtin_amdgcn_s_getreg((3 << 11) | 20) & 0xFu; }
#define XB_SPIN(cond, bar) do { unsigned _sp = 0; while (cond) { __builtin_amdgcn_s_sleep(1); \
    if ((++_sp & 255u) == 0u) { if (xb_ld(&(bar)[XB_TMO])) break; if (_sp > XB_SPIN_CAP) { atomicAdd(&(bar)[XB_TMO], 1u); break; } } } } while (0)

struct XcdBarrier {
    unsigned* bar; unsigned x;
    volatile LAS unsigned* st;
};

__device__ __forceinline__ XcdBarrier xcd_barrier_post(unsigned* bar, volatile LAS unsigned* st) {
    XcdBarrier b; b.bar = bar; b.x = xb_xcc_id(); b.st = st;
    if (threadIdx.x == 0) (void)xb_add(&bar[XB_XCNT(b.x)], 1u);
    return b;
}
__device__ __forceinline__ void xcd_barrier_complete(unsigned* bar, unsigned x, unsigned& nloc, unsigned& nx) {
    const unsigned G = gridDim.x * gridDim.y * gridDim.z;
    unsigned sum, cnt, mine, sp = 0u;
    for (;;) {
        sum = 0u; cnt = 0u; mine = 0u;
#pragma unroll
        for (unsigned j = 0; j < 16; ++j) { const unsigned c = xb_ld(&bar[XB_XCNT(j)]); sum += c; cnt += (c > 0u) ? 1u : 0u; mine = (j == x) ? c : mine; }
        if (sum == G) break;
        __builtin_amdgcn_s_sleep(1);
        if ((++sp & 255u) == 0u) { if (xb_ld(&bar[XB_TMO])) break; if (sp > XB_SPIN_CAP) { atomicAdd(&bar[XB_TMO], 1u); break; } }
    }
    nloc = mine > 0u ? mine : 1u; nx = cnt > 0u ? cnt : 1u;
}

__device__ __forceinline__ void xcd_barrier(const XcdBarrier& b) {
    asm volatile("s_waitcnt vmcnt(0)" ::: "memory");
    __syncthreads();
    if (threadIdx.x == 0) {
        unsigned* bar = b.bar;
        __builtin_amdgcn_s_waitcnt(0);
        unsigned nloc = b.st[0], nx = b.st[1];
        if (nloc == 0u) { xcd_barrier_complete(bar, b.x, nloc, nx); b.st[0] = nloc; b.st[1] = nx; }
        const unsigned old = xb_add(&bar[XB_XSUB(b.x)], 1u);
        const unsigned gen = old / nloc;
        if (old + 1u == (gen + 1u) * nloc) {
            __builtin_amdgcn_fence(__ATOMIC_RELEASE, "agent");
            asm volatile("s_waitcnt vmcnt(0)" ::: "memory");
            const unsigned og = xb_add(&bar[XB_TOP], 1u);
            const unsigned tg = og / nx;
            if (og + 1u == (tg + 1u) * nx) xb_add(&bar[XB_TOPGEN], 1u);
            else XB_SPIN(xb_ld(&bar[XB_TOPGEN]) == tg, bar);
            __builtin_amdgcn_fence(__ATOMIC_ACQUIRE, "agent");
            xb_add(&bar[XB_XGEN(b.x)], 1u);
            asm volatile("s_waitcnt vmcnt(0)" ::: "memory");
        } else {
            XB_SPIN(xb_ld(&bar[XB_XGEN(b.x)]) == gen, bar);
            __builtin_amdgcn_fence(__ATOMIC_ACQUIRE, "agent");
            asm volatile("s_waitcnt vmcnt(0)" ::: "memory");
        }
    }
    __syncthreads();
}


struct Args { const float* in[34]; float* out; unsigned char* ws; int ph_lo, ph_hi; };
constexpr int N_PHASES = 22;

__global__ void __launch_bounds__(NTHR, 2) fwd(Args a) {
    extern __shared__ __attribute__((aligned(16))) unsigned char lds_raw[];
    float* lds = (float*)lds_raw;
    LAS unsigned char* ldsl = (LAS unsigned char*)lds_raw;
    const int vb0 = blockIdx.x, vbs = gridDim.x;
    const int lo = a.ph_lo, hi = a.ph_hi;
#define IN(k) (lo <= (k) && (k) < hi)
#define SEAM(k) do { if (IN(k) && IN((k) + 1)) xcd_barrier(bar); } while (0)
    volatile LAS unsigned* misc = (volatile LAS unsigned*)(ldsl + MISC_OFF);
    if (threadIdx.x < 4) misc[threadIdx.x] = 0u;
    __syncthreads();
    XcdBarrier bar = xcd_barrier_post((unsigned*)(a.ws + WS_CTL) + CW_BAR, misc);
    unsigned char* ws = a.ws;
    unsigned* ctl = (unsigned*)(ws + WS_CTL);
    unsigned* cnt = ctl + CW_CNT;
    int* list = (int*)(ws + WS_LIST); float* gatev = (float*)(ws + WS_GATE);
    float* dtraw = (float*)(ws + WS_DT); float* RS = (float*)(ws + WS_RS);
    bf16_t* XB = (bf16_t*)(ws + WS_XB); bf16_t* UB = (bf16_t*)(ws + WS_UB);
    bf16_t* YA = (bf16_t*)(ws + WS_YA); float* OF = (float*)(ws + WS_OF); bf16_t* OC = (bf16_t*)(ws + WS_OC);
    bf16_t* YP = (bf16_t*)(ws + WS_YP); bf16_t* YP1 = (bf16_t*)(ws + WS_YP1); bf16_t* XC = (bf16_t*)(ws + WS_YP);
    bf16_t* PB0 = (bf16_t*)(ws + WS_PB0); bf16_t* PB1 = (bf16_t*)(ws + WS_PB1);
    bf16_t* YB = (bf16_t*)(ws + WS_Y);
    float* MS = (float*)(ws + WS_MS); float* MD = (float*)(ws + WS_MD);
    float* HS = (float*)(ws + WS_HS); float* HD = (float*)(ws + WS_HD);
    bf16_t* XT = (bf16_t*)(ws + WS_XT); bf16_t* VT = (bf16_t*)(ws + WS_VT);
    const float* p_in = a.in[1];
    const int G = (int)gridDim.x, cb = (int)blockIdx.x;
    const NormB NB0{nullptr, XB, nullptr, nullptr, RS, nullptr, nullptr, nullptr, nullptr, nullptr, nullptr, nullptr, nullptr, nullptr, nullptr};
    unsigned char* XG8 = ws + WS_XG8;
    float* rsl = (float*)(ws + WS_DT);

    if (IN(0)) {
        ph_convert_weights(ldsl, a.in, ws, 0, ITEMS_DENSE, vb0, vbs);
        NormB A = NB0; A.xin = a.in[0]; A.gnext = a.in[3]; A.win = a.in[4]; A.dtraw = dtraw;
        ph_norm2<0, false, true, false>(A, vb0, vbs);
    }
    SEAM(0);
    if (IN(1)) { pg8::DenseOrder S; S.init(MT, UW, DM, (const bf16_t*)(ws + W_IN), G, cb); pg8::gemm_phase(ldsl, XB, DM, S, pg8::EpiBf16{UB, UW, RS}); }
    SEAM(1);
    if (IN(2)) { ph_prep(UB, a.in[5], a.in[6], XC, XT, VT, vb0, vbs); }
    SEAM(2);
    if (IN(3)) { ph_hgrn_states(ldsl, UB, VT, a.in[2], HS, HD, vb0, vbs); ph_mamba_states(ldsl, XT, dtraw, a.in[7], a.in[8], MS, MD, vb0, vbs); }
    SEAM(3);
    if (IN(4)) { ph_hgrn_scan(HS, HD, vb0, vbs); ph_mamba_scan(MS, MD, vb0, vbs); }
    SEAM(4);
    if (IN(5)) { ph_hgrn_out(ldsl, UB, VT, a.in[2], a.in[10], HS, OF, OC, vb0, vbs); ph_mamba_out(ldsl, UB, XC, XT, dtraw, a.in[7], a.in[8], a.in[9], a.in[11], MS, OC, vb0, vbs); }
    SEAM(5);
    if (IN(6)) { pg8::DenseOrder S; S.init(MT, DM, DM, (const bf16_t*)(ws + W_OUTE), G, cb); pg8::gemm_phase(ldsl, OC, DM, S, pg8::EpiBf16{YA, DM, nullptr}); }
    SEAM(6);
    if (IN(7)) {
        NormB A = NB0; A.y = YA; A.gpost = a.in[13];
        ph_norm2<1, false, false, false>(A, vb0, vbs);
        ph_cvt_rows(p_in, PB0, (size_t)MT * PDIM / 4, vb0, vbs);
        ph_convert_weights(ldsl, a.in, ws, ITEMS_DENSE, ITEMS_ALL, vb0, vbs);
    }
    SEAM(7);
    if (IN(8)) { pg8::DenseOrder S; S.init(MT, 2 * DFF, DM, (const bf16_t*)(ws + W_GU), G, cb); pg8::gemm_phase(ldsl, XB, DM, S, pg8::EpiSwiglu{UB, DFF, RS, 0}); }
    SEAM(8);
    if (IN(9)) { pg8::DenseOrder S; S.init(MT, DM, DFF, (const bf16_t*)(ws + W_DN), G, cb); pg8::gemm_phase(ldsl, UB, DFF, S, pg8::EpiBf16{YA, DM, nullptr}); }
    SEAM(9);
    if (IN(10)) {
        { pg8::DenseOrder S; S.init(MT, DM, PDIM, (const bf16_t*)(ws + W_PP), G, cb); pg8::gemm_phase(ldsl, PB0, PDIM, S, pg8::EpiBf16{YP, DM, nullptr}); }
        NormB A = NB0; A.y = YA; A.gpost = a.in[18];
        ph_norm2<1, false, false, false>(A, vb0, vbs);
    }
    SEAM(10);
    if (IN(11)) { pg8::DenseOrder S; S.init(MT, DM, DM, (const bf16_t*)(ws + W_PG), G, cb); pg8::gemm_phase(ldsl, XB, DM, S, pg8::EpiPleGate{YP, DM, RS}); }
    SEAM(11);
    if (IN(12)) {
        NormB A = NB0; A.y = YP; A.gpost = a.in[33];
        ph_norm2<1, false, false, false>(A, vb0, vbs);
    }
    SEAM(12);
    if (IN(13)) { pg8::DenseOrder S; S.init(MT, 3072, DM, (const bf16_t*)(ws + W_QKV), G, cb); pg8::gemm_phase(ldsl, XB, DM, S, pg8::EpiBf16{UB, 3072, RS}); }
    SEAM(13);
    if (IN(14)) { ph_na(ldsl, UB, a.in[21], OC, vb0, vbs); }
    SEAM(14);
    if (IN(15)) { pg8::DenseOrder S; S.init(MT, DM, DM, (const bf16_t*)(ws + W_OUTO), G, cb); pg8::gemm_phase(ldsl, OC, DM, S, pg8::EpiBf16{YP1, DM, nullptr}); }
    SEAM(15);
    if (IN(16)) {
        NormB A = NB0; A.y = YP1; A.gpost = a.in[23]; A.gnext = a.in[24]; A.wr = a.in[25]; A.cnt = cnt; A.list = list; A.gatev = gatev; A.rsl = rsl; A.x8 = XG8;
        ph_norm2<1, false, false, true>(A, vb0, vbs);
        ph_cvt_rows(p_in + (size_t)MT * PDIM, PB1, (size_t)MT * PDIM / 4, vb0, vbs);
    }
    SEAM(16);
    if (IN(17)) { pg8::MoeOrder S; S.init(cnt, (volatile LAS int*)(ldsl + MISC_OFF + 64), 2 * DFFE, DM / 2, (const bf16_t*)(ws + W_EGU), (size_t)7 * MiB, true, G, cb);
        pg8::gemm_phase<pg8::EpiSwiglu8, pg8::MoeOrder, true>(ldsl, (const bf16_t*)XG8, DM / 2, S, pg8::EpiSwiglu8{(unsigned char*)UB, DFFE, rsl}); }
    SEAM(17);
    if (IN(18)) { pg8::MoeOrder S; S.init(cnt, (volatile LAS int*)(ldsl + MISC_OFF + 64), DM, DFFE / 2, (const bf16_t*)(ws + W_EDN), (size_t)(7 * MiB / 2), false, G, cb);
        pg8::gemm_phase<pg8::EpiMoeDown, pg8::MoeOrder, true>(ldsl, UB, DFFE / 2, S, pg8::EpiMoeDown{YB, list, gatev, 1.f / (pg8::W8_SCALE * pg8::ACT8_SCALE)}); }
    SEAM(18);
    if (IN(19)) {
        { pg8::DenseOrder S; S.init(MT, DM, PDIM, (const bf16_t*)(ws + W_PP + 512 * 1024), G, cb); pg8::gemm_phase(ldsl, PB1, PDIM, S, pg8::EpiBf16{YP1, DM, nullptr}); }
        NormB A = NB0; A.y = YB; A.gpost = a.in[29];
        ph_norm2<2, false, false, false>(A, vb0, vbs);
    }
    SEAM(19);
    if (IN(20)) { pg8::DenseOrder S; S.init(MT, DM, DM, (const bf16_t*)(ws + W_PG + 2 * MiB), G, cb); pg8::gemm_phase(ldsl, XB, DM, S, pg8::EpiPleGate{YP1, DM, RS}); }
    SEAM(20);
    if (IN(21)) {
        NormB A = NB0; A.y = YP1; A.gpost = a.in[33] + DM; A.xout = a.out;
        ph_norm2<1, true, false, false>(A, vb0, vbs);
    }
#undef IN
#undef SEAM
}

extern "C" void kernel_launch(void* const* d_in, const int* in_sizes, int n_in, void* d_out, int out_size, void* d_ws, size_t ws_size, hipStream_t stream) {
    static int grid = 0;
    if (grid == 0) {
        if (n_in != 34 || out_size != MT * DM || ws_size < WS_END) { fprintf(stderr, "kernel_launch: unexpected shapes n_in %d out %d ws %zu (need %zu)\n", n_in, out_size, ws_size, (size_t)WS_END); grid = -1; return; }
        int dev = 0, cus = 0;
        if (hipGetDevice(&dev) != hipSuccess || hipDeviceGetAttribute(&cus, hipDeviceAttributeMultiprocessorCount, dev) != hipSuccess) { grid = -1; return; }
        if (hipFuncSetAttribute((const void*)fwd, hipFuncAttributeMaxDynamicSharedMemorySize, LDS_BYTES) != hipSuccess) { fprintf(stderr, "hipFuncSetAttribute failed\n"); grid = -1; return; }
        (void)hipGetLastError();
        grid = cus;
    }
    if (grid < 0) return;
    (void)hipMemsetAsync((char*)d_ws + WS_CTL, 0, CTL_ZERO_BYTES, stream);
    Args a{};
    for (int i = 0; i < 34; ++i) a.in[i] = (const float*)d_in[i];
    a.out = (float*)d_out; a.ws = (unsigned char*)d_ws;
#ifndef MK_PER_PHASE
    a.ph_lo = 0; a.ph_hi = N_PHASES;
    hipLaunchKernelGGL(fwd, dim3(grid), dim3(NTHR), LDS_BYTES, stream, a);
#else
    for (int ph = 0; ph < N_PHASES; ++ph) {
        a.ph_lo = ph; a.ph_hi = ph + 1;
        hipLaunchKernelGGL(fwd, dim3(grid), dim3(NTHR), LDS_BYTES, stream, a);
    }
#endif
}
```

```cpp
#include <hip/hip_runtime.h>
#include <stdint.h>
#include <stdio.h>

#define DEVI __device__ __forceinline__
#define LAS __attribute__((address_space(3)))
typedef unsigned short bf16_t;

constexpr int NB = 4, SEQ = 4096, DM = 1024, MT = NB * SEQ;
constexpr int EVEN_IN = 4112, UW = 4096, DFF = 2816, NEXP = 8, DFFE = 3584, PDIM = 256;
constexpr float EPS = 1e-6f;
constexpr int NTHR = 512;
constexpr int LDS_BYTES = 147456;
constexpr int MISC_OFF = 131072 + 320;
constexpr int MOE_ROWS = 2 * MT + NEXP * 256;

constexpr size_t MiB = 1u << 20;
constexpr size_t WS_CTL = 0, CTL_ZERO_BYTES = 1 * MiB;
constexpr size_t WS_LIST = 1 * MiB;
constexpr size_t WS_GATE = WS_LIST + 512 * 1024;
constexpr size_t WS_DT = 2 * MiB;
constexpr size_t WS_W = 3 * MiB;
constexpr size_t W_IN = WS_W, W_OUTE = W_IN + 8 * MiB, W_GU = W_OUTE + 2 * MiB, W_DN = W_GU + 11 * MiB, W_PG = W_DN + 6 * MiB, W_PP = W_PG + 4 * MiB,
                 W_QKV = W_PP + 1 * MiB, W_OUTO = W_QKV + 6 * MiB, W_EGU = W_OUTO + 2 * MiB, W_EDN = W_EGU + 112 * MiB, W_END = W_EDN + 56 * MiB;
constexpr size_t WS_XB = W_END;
constexpr size_t WS_R = WS_XB + 32 * MiB;
constexpr size_t WS_UB = WS_R;
constexpr size_t WS_PB0 = WS_R + 88 * MiB;
constexpr size_t WS_YA = WS_R + 128 * MiB;
constexpr size_t WS_OF = WS_R + 160 * MiB;
constexpr size_t WS_OC = WS_R + 192 * MiB;
constexpr size_t WS_YP = WS_R + 224 * MiB;
constexpr size_t WS_YP1 = WS_R;
constexpr size_t WS_PB1 = W_EDN + 32 * MiB;
constexpr size_t WS_XG8 = WS_R + 120 * MiB;
constexpr size_t WS_END = WS_R + 256 * MiB;
constexpr size_t WS_Y = W_EGU;
constexpr size_t WS_MS = W_EGU;
constexpr size_t WS_HS = W_EGU + 64 * MiB;
constexpr size_t WS_XT = W_EDN;
constexpr size_t WS_VT = W_EDN + 24 * MiB;
constexpr size_t WS_MD = W_EDN + 40 * MiB;
constexpr size_t WS_HD = W_EDN + 41 * MiB;
static_assert(WS_R + (size_t)MOE_ROWS * DFFE <= WS_XG8 && WS_XG8 + 128 * MiB <= WS_END && WS_END <= 510 * MiB, "ws map");
constexpr size_t WS_RS = WS_CTL + 512 * 1024;
constexpr int CW_CNT = 64;
constexpr int CW_BAR = 4096;

DEVI int opq(int x) { asm volatile("" : "+v"(x)); return x; }
DEVI float bf2f(bf16_t b) { return __uint_as_float(((unsigned)b) << 16); }
DEVI bf16_t f2bf(float f) { unsigned u = __float_as_uint(f); u += 0x7FFFu + ((u >> 16) & 1u); return (bf16_t)(u >> 16); }
DEVI float silu_f(float x) { return x / (1.f + __expf(-x)); }
DEVI float sigmoid_f(float x) { return 1.f / (1.f + __expf(-x)); }
DEVI float softplus_f(float x) { return x > 20.f ? x : log1pf(__expf(x)); }
DEVI float wave_sum(float v) {
#pragma unroll
    for (int o = 1; o < 64; o <<= 1) v += __shfl_xor(v, o);
    return v;
}


typedef short bf16x8 __attribute__((ext_vector_type(8)));
typedef float f32x4 __attribute__((ext_vector_type(4)));
typedef unsigned u32x4 __attribute__((ext_vector_type(4)));
typedef unsigned u32x2 __attribute__((ext_vector_type(2)));
DEVI unsigned pk2(float lo, float hi) { return (unsigned)f2bf(lo) | ((unsigned)f2bf(hi) << 16); }
DEVI float bflo(unsigned w) { return __uint_as_float(w << 16); }
DEVI float bfhi(unsigned w) { return __uint_as_float(w & 0xffff0000u); }

DEVI unsigned pg8_pk4(float a, float b, float c, float d) {
    a = fminf(fmaxf(a, -448.f), 448.f); b = fminf(fmaxf(b, -448.f), 448.f); c = fminf(fmaxf(c, -448.f), 448.f); d = fminf(fmaxf(d, -448.f), 448.f);
    int p = __builtin_amdgcn_cvt_pk_fp8_f32(a, b, 0, false); p = __builtin_amdgcn_cvt_pk_fp8_f32(c, d, p, true); return (unsigned)p; }
struct NormB { const float* xin; bf16_t* XB; const bf16_t* y; const float* gpost; float* rs; const float* gnext;
               const float* win; float* dtraw; const float* wr; unsigned* cnt; int* list; float* gatev; float* rsl; float* xout; unsigned char* x8; };
DEVI void unpack8(const u32x4 w, float* v) { v[0] = bflo(w.x); v[1] = bfhi(w.x); v[2] = bflo(w.y); v[3] = bfhi(w.y); v[4] = bflo(w.z); v[5] = bfhi(w.z); v[6] = bflo(w.w); v[7] = bfhi(w.w); }
template <int YMODE, bool FINAL, bool DT, bool ROUTE>
DEVI void ph_norm2(const NormB& A, int vb0, int vbs) {
    const int tidq = opq((int)threadIdx.x); const int wid = tidq >> 6, lane = tidq & 63;
    constexpr int R = (DT || ROUTE) ? 2 : 4;
    for (int row0 = (vb0 * 8 + wid) * R; row0 < MT; row0 += vbs * 8 * R) {
        float xv[R][16]; float yv[R][16];
#pragma unroll
        for (int rr = 0; rr < R; ++rr) {
            const size_t ro = (size_t)(row0 + rr) * DM + lane * 8;
            if (YMODE == 0) {
#pragma unroll
                for (int i = 0; i < 2; ++i) { const float4 p0 = *(const float4*)(A.xin + ro + i * 512), p1 = *(const float4*)(A.xin + ro + i * 512 + 4);
                    xv[rr][i * 8 + 0] = p0.x; xv[rr][i * 8 + 1] = p0.y; xv[rr][i * 8 + 2] = p0.z; xv[rr][i * 8 + 3] = p0.w; xv[rr][i * 8 + 4] = p1.x; xv[rr][i * 8 + 5] = p1.y; xv[rr][i * 8 + 6] = p1.z; xv[rr][i * 8 + 7] = p1.w; }
            } else {
#pragma unroll
                for (int i = 0; i < 2; ++i) {
                    unpack8(*(const u32x4*)(A.XB + ro + i * 512), xv[rr] + i * 8);
                    unpack8(*(const u32x4*)(A.y + ro + i * 512), yv[rr] + i * 8);
                    if (YMODE == 2) { float y2[8]; unpack8(*(const u32x4*)(A.y + (size_t)MT * DM + ro + i * 512), y2);
#pragma unroll
                        for (int j = 0; j < 8; ++j) yv[rr][i * 8 + j] += y2[j]; }
                }
            }
        }
        if (YMODE != 0) {
            float gg[16];
#pragma unroll
            for (int i = 0; i < 2; ++i) { const float4 g0 = *(const float4*)(A.gpost + i * 512 + lane * 8), g1 = *(const float4*)(A.gpost + i * 512 + lane * 8 + 4);
                gg[i * 8 + 0] = g0.x; gg[i * 8 + 1] = g0.y; gg[i * 8 + 2] = g0.z; gg[i * 8 + 3] = g0.w; gg[i * 8 + 4] = g1.x; gg[i * 8 + 5] = g1.y; gg[i * 8 + 6] = g1.z; gg[i * 8 + 7] = g1.w; }
            float ss[R];
#pragma unroll
            for (int rr = 0; rr < R; ++rr) { ss[rr] = 0.f;
#pragma unroll
                for (int j = 0; j < 16; ++j) ss[rr] += yv[rr][j] * yv[rr][j]; }
#pragma unroll
            for (int o = 1; o < 64; o <<= 1)
#pragma unroll
                for (int rr = 0; rr < R; ++rr) ss[rr] += __shfl_xor(ss[rr], o);
#pragma unroll
            for (int rr = 0; rr < R; ++rr) { const float r = rsqrtf(ss[rr] * (1.f / DM) + EPS);
#pragma unroll
                for (int j = 0; j < 16; ++j) xv[rr][j] += yv[rr][j] * r * gg[j]; }
        }
        if (FINAL) {
#pragma unroll
            for (int rr = 0; rr < R; ++rr)
#pragma unroll
                for (int i = 0; i < 2; ++i) { float* op = A.xout + (size_t)(row0 + rr) * DM + i * 512 + lane * 8;
                    *(float4*)op = make_float4(xv[rr][i * 8], xv[rr][i * 8 + 1], xv[rr][i * 8 + 2], xv[rr][i * 8 + 3]); *(float4*)(op + 4) = make_float4(xv[rr][i * 8 + 4], xv[rr][i * 8 + 5], xv[rr][i * 8 + 6], xv[rr][i * 8 + 7]); }
        } else {
            float ss[R];
#pragma unroll
            for (int rr = 0; rr < R; ++rr) {
#pragma unroll
                for (int i = 0; i < 2; ++i) { u32x4 o; o.x = pk2(xv[rr][i * 8], xv[rr][i * 8 + 1]); o.y = pk2(xv[rr][i * 8 + 2], xv[rr][i * 8 + 3]); o.z = pk2(xv[rr][i * 8 + 4], xv[rr][i * 8 + 5]); o.w = pk2(xv[rr][i * 8 + 6], xv[rr][i * 8 + 7]);
                    *(u32x4*)(A.XB + (size_t)(row0 + rr) * DM + i * 512 + lane * 8) = o;
                }
                ss[rr] = 0.f;
#pragma unroll
                for (int j = 0; j < 16; ++j) ss[rr] += xv[rr][j] * xv[rr][j];
            }
#pragma unroll
            for (int o = 1; o < 64; o <<= 1)
#pragma unroll
                for (int rr = 0; rr < R; ++rr) ss[rr] += __shfl_xor(ss[rr], o);
            float r2[R];
#pragma unroll
            for (int rr = 0; rr < R; ++rr) { r2[rr] = rsqrtf(ss[rr] * (1.f / DM) + EPS); if (lane == 0) A.rs[row0 + rr] = r2[rr]; }
            if (DT || ROUTE) {
                float gn[16];
#pragma unroll
                for (int i = 0; i < 2; ++i) { const float4 g0 = *(const float4*)(A.gnext + i * 512 + lane * 8), g1 = *(const float4*)(A.gnext + i * 512 + lane * 8 + 4);
                    gn[i * 8 + 0] = g0.x; gn[i * 8 + 1] = g0.y; gn[i * 8 + 2] = g0.z; gn[i * 8 + 3] = g0.w; gn[i * 8 + 4] = g1.x; gn[i * 8 + 5] = g1.y; gn[i * 8 + 6] = g1.z; gn[i * 8 + 7] = g1.w; }
#pragma unroll 1
                for (int rr = 0; rr < R; ++rr) {
                    const int row = row0 + rr;
                    float hv[16];
#pragma unroll
                    for (int j = 0; j < 16; ++j) hv[j] = (rr == 0 ? xv[0][j] : xv[R - 1][j]) * (rr == 0 ? r2[0] : r2[R - 1]) * gn[j];
                    if (DT) {
                        float d[16];
#pragma unroll
                        for (int j = 0; j < 16; ++j) d[j] = 0.f;
#pragma unroll
                        for (int q = 0; q < 16; ++q) {
                            const float* wp = A.win + (size_t)((q >> 3) * 512 + lane * 8 + (q & 7)) * EVEN_IN + 4096;
#pragma unroll
                            for (int j4 = 0; j4 < 4; ++j4) { const float4 w = *(const float4*)(wp + j4 * 4);
                                d[j4 * 4 + 0] += hv[q] * w.x; d[j4 * 4 + 1] += hv[q] * w.y; d[j4 * 4 + 2] += hv[q] * w.z; d[j4 * 4 + 3] += hv[q] * w.w; }
                        }
#pragma unroll
                        for (int j = 0; j < 16; ++j) d[j] = wave_sum(d[j]);
                        if (lane == 0) {
#pragma unroll
                            for (int j4 = 0; j4 < 4; ++j4) *(float4*)(A.dtraw + (size_t)row * 16 + j4 * 4) = make_float4(d[j4 * 4], d[j4 * 4 + 1], d[j4 * 4 + 2], d[j4 * 4 + 3]);
                        }
                    }
                    if (ROUTE) {
                        float lg[8];
#pragma unroll
                        for (int e = 0; e < 8; ++e) lg[e] = 0.f;
#pragma unroll
                        for (int q = 0; q < 16; ++q) {
                            const float* wp = A.wr + (size_t)((q >> 3) * 512 + lane * 8 + (q & 7)) * 8;
                            const float4 w0 = *(const float4*)wp, w1 = *(const float4*)(wp + 4);
                            lg[0] += hv[q] * w0.x; lg[1] += hv[q] * w0.y; lg[2] += hv[q] * w0.z; lg[3] += hv[q] * w0.w;
                            lg[4] += hv[q] * w1.x; lg[5] += hv[q] * w1.y; lg[6] += hv[q] * w1.z; lg[7] += hv[q] * w1.w;
                        }
#pragma unroll
                        for (int e = 0; e < 8; ++e) lg[e] = wave_sum(lg[e]);
                        int dst1 = 0, dst2 = 0;
                        if (lane == 0) {
                            const float rcur = (rr == 0 ? r2[0] : r2[R - 1]);
                            int e1 = 0; float v1 = lg[0];
#pragma unroll
                            for (int e = 1; e < 8; ++e) if (lg[e] > v1) { v1 = lg[e]; e1 = e; }
                            int e2 = 0; float v2 = -3.0e38f;
#pragma unroll
                            for (int e = 0; e < 8; ++e) if (e != e1 && lg[e] > v2) { v2 = lg[e]; e2 = e; }
                            const float ex = __expf(v2 - v1); const float w1 = 1.f / (1.f + ex), w2 = ex / (1.f + ex);
                            const int p1 = (int)atomicAdd(&A.cnt[e1], 1u); A.list[e1 * MT + p1] = row * 2; A.gatev[e1 * MT + p1] = w1; A.rsl[e1 * MT + p1] = rcur;
                            const int p2 = (int)atomicAdd(&A.cnt[e2], 1u); A.list[e2 * MT + p2] = row * 2 + 1; A.gatev[e2 * MT + p2] = w2; A.rsl[e2 * MT + p2] = rcur;
                            dst1 = e1 * MT + p1; dst2 = e2 * MT + p2;
                        }
                        dst1 = __builtin_amdgcn_readfirstlane(dst1); dst2 = __builtin_amdgcn_readfirstlane(dst2);
#pragma unroll
                        for (int i = 0; i < 2; ++i) { u32x2 o8;
                            const float* xs = (rr == 0 ? xv[0] : xv[R - 1]) + i * 8;
                            o8.x = pg8_pk4(xs[0], xs[1], xs[2], xs[3]); o8.y = pg8_pk4(xs[4], xs[5], xs[6], xs[7]);
                            *(u32x2*)(A.x8 + (size_t)dst1 * DM + i * 512 + lane * 8) = o8; *(u32x2*)(A.x8 + (size_t)dst2 * DM + i * 512 + lane * 8) = o8; }
                    }
                }
            }
        }
    }
}

DEVI void transpose_item(const float* W, int ldw, int K, int k0, int n0, bf16_t* WT, int drow0, LAS float* scr, int lane, const float* gain) {
#pragma unroll 8
    for (int i = 0; i < 32; ++i) { const int kk = 2 * i + (lane >> 5); scr[kk * 33 + (lane & 31)] = W[(size_t)(k0 + kk) * ldw + n0 + (lane & 31)]; }
    asm volatile("s_waitcnt lgkmcnt(0)" ::: "memory");
    const int c = lane & 7;
    float4 ga = make_float4(1.f, 1.f, 1.f, 1.f), gb = ga;
    if (gain) { ga = *(const float4*)(gain + k0 + 8 * c); gb = *(const float4*)(gain + k0 + 8 * c + 4); }
#pragma unroll
    for (int j = 0; j < 4; ++j) { const int n = (lane >> 3) + 8 * j; const LAS float* sp = scr + (8 * c) * 33 + n;
        u32x4 o; o.x = pk2(sp[0 * 33] * ga.x, sp[1 * 33] * ga.y); o.y = pk2(sp[2 * 33] * ga.z, sp[3 * 33] * ga.w); o.z = pk2(sp[4 * 33] * gb.x, sp[5 * 33] * gb.y); o.w = pk2(sp[6 * 33] * gb.z, sp[7 * 33] * gb.w);
        *(u32x4*)(WT + (size_t)(drow0 + n) * K + k0 + 8 * c) = o; }
    asm volatile("s_waitcnt lgkmcnt(0)" ::: "memory");
}
DEVI void transpose_item_fp8(const float* W, int ldw, int K, int k0, int n0, unsigned char* WT8, int drow0, LAS float* scr, int lane, const float* gain) {
#pragma unroll 8
    for (int i = 0; i < 32; ++i) { const int kk = 2 * i + (lane >> 5); scr[kk * 33 + (lane & 31)] = W[(size_t)(k0 + kk) * ldw + n0 + (lane & 31)]; }
    asm volatile("s_waitcnt lgkmcnt(0)" ::: "memory");
    const int c = lane & 7;
    float4 ga = make_float4(64.f, 64.f, 64.f, 64.f), gb = ga;
    if (gain) { ga = *(const float4*)(gain + k0 + 8 * c); gb = *(const float4*)(gain + k0 + 8 * c + 4); ga.x *= 64.f; ga.y *= 64.f; ga.z *= 64.f; ga.w *= 64.f; gb.x *= 64.f; gb.y *= 64.f; gb.z *= 64.f; gb.w *= 64.f; }
#pragma unroll
    for (int j = 0; j < 4; ++j) { const int n = (lane >> 3) + 8 * j; const LAS float* sp = scr + (8 * c) * 33 + n;
        u32x2 o; o.x = pg8_pk4(sp[0 * 33] * ga.x, sp[1 * 33] * ga.y, sp[2 * 33] * ga.z, sp[3 * 33] * ga.w); o.y = pg8_pk4(sp[4 * 33] * gb.x, sp[5 * 33] * gb.y, sp[6 * 33] * gb.z, sp[7 * 33] * gb.w);
        *(u32x2*)(WT8 + (size_t)(drow0 + n) * K + k0 + 8 * c) = o; }
    asm volatile("s_waitcnt lgkmcnt(0)" ::: "memory");
}
struct Job { int in_idx; unsigned src_off; int ldw; int K; int ncols; unsigned long long dst; int mode; int item0; int gain_idx; int gain_off; int fp8; };
constexpr int NJOBS = 11 + 24;
struct JobTable { Job j[NJOBS]; int total; };
constexpr JobTable make_jobs() {
    JobTable t{}; int n = 0, it = 0;
    auto add = [&](int idx, unsigned off, int ldw, int K, int ncols, unsigned long long dst, int mode, int gi, int go, int f8 = 0) { t.j[n] = Job{idx, off, ldw, K, ncols, dst, mode, it, gi, go, f8}; it += (K / 64) * (ncols / 32); ++n; };
    add(4, 0, EVEN_IN, DM, UW, W_IN, 0, 3, 0);
    add(12, 0, DM, DM, DM, W_OUTE, 0, -1, 0);
    add(15, 0, DFF, DM, DFF, W_GU, 1, 14, 0);
    add(16, 0, DFF, DM, DFF, W_GU, 2, 14, 0);
    add(17, 0, DM, DFF, DM, W_DN, 0, -1, 0);
    add(31, 0, DM, DM, DM, W_PG, 0, 30, 0);
    add(31, DM * DM, DM, DM, DM, W_PG + 2 * MiB, 0, 30, DM);
    add(32, 0, DM, PDIM, DM, W_PP, 0, -1, 0);
    add(32, PDIM * DM, DM, PDIM, DM, W_PP + 512 * 1024, 0, -1, 0);
    add(20, 0, 3072, DM, 3072, W_QKV, 0, 19, 0);
    add(22, 0, DM, DM, DM, W_OUTO, 0, -1, 0);
    for (int e = 0; e < NEXP; ++e) {
        add(26, (unsigned)e * DM * DFFE, DFFE, DM, DFFE, W_EGU + (unsigned long long)e * 7 * MiB, 1, 24, 0, 1);
        add(27, (unsigned)e * DM * DFFE, DFFE, DM, DFFE, W_EGU + (unsigned long long)e * 7 * MiB, 2, 24, 0, 1);
        add(28, (unsigned)e * DFFE * DM, DM, DFFE, DM, W_EDN + (unsigned long long)e * (7 * MiB / 2), 0, -1, 0, 1);
    }
    t.total = it; return t;
}
__device__ const JobTable g_jobs = make_jobs();
constexpr int ITEMS_DENSE = make_jobs().j[11].item0, ITEMS_ALL = make_jobs().total;
DEVI void ph_convert_weights(LAS unsigned char* lds, const float* const* in, unsigned char* ws, int it_lo, int it_hi, int vb0, int vbs) {
    const int tidq = opq((int)threadIdx.x); const int wid = __builtin_amdgcn_readfirstlane(tidq >> 6), lane = tidq & 63;
    LAS float* scr = (LAS float*)(lds + wid * 16384);
    int jb = 0;
    for (int it = it_lo + vb0 * 8 + wid; it < it_hi; it += vbs * 8) {
        while (jb + 1 < NJOBS && g_jobs.j[jb + 1].item0 <= it) ++jb;
        const Job J = g_jobs.j[jb];
        const int r = it - J.item0; const int nblk = J.ncols / 32; const int kb = r / nblk, nb = r % nblk;
        const int n0 = nb * 32; int drow0 = n0;
        if (J.mode != 0) drow0 = (n0 >> 7) * 256 + (n0 & 127) + (J.mode == 2 ? 128 : 0);
        const float* gp = J.gain_idx >= 0 ? in[J.gain_idx] + J.gain_off : nullptr;
        if (J.fp8) transpose_item_fp8(in[J.in_idx] + J.src_off, J.ldw, J.K, kb * 64, n0, ws + J.dst, drow0, scr, lane, gp);
        else transpose_item(in[J.in_idx] + J.src_off, J.ldw, J.K, kb * 64, n0, (bf16_t*)(ws + J.dst), drow0, scr, lane, gp);
    }
}
DEVI void ph_cvt_rows(const float* src, bf16_t* dst, size_t n4, int vb0, int vbs) {
    for (size_t e = (size_t)vb0 * NTHR + opq((int)threadIdx.x); e < n4; e += (size_t)vbs * NTHR) {
        const float4 v = ((const float4*)src)[e]; u32x2 o; o.x = pk2(v.x, v.y); o.y = pk2(v.z, v.w); ((u32x2*)dst)[e] = o; }
}

namespace pg8 {
constexpr int BM = 256, BK = 64, HALF = 128, HTB = HALF * BK * 2, STAGE_BYTES = 8 * HTB, NXCD = 8, WGM = 8;
__host__ __device__ __forceinline__ int lds_byte(int r, int c) { const int st = (r >> 4) * 2 + (c >> 5), rr = r & 15, cc = c & 31, ob = rr * 64 + cc * 2; return st * 1024 + (ob ^ (((ob >> 9) & 1) << 5)); }
__host__ __device__ __forceinline__ void stage_rc(int b, int& R, int& C) { const int st = b / 1024, sb = b % 1024, swz = sb ^ (((sb >> 9) & 1) << 5); R = (st >> 1) * 16 + swz / 64; C = (st & 1) * 32 + (swz % 64) / 2; }
__host__ __device__ __forceinline__ int perm32(int rho) { const int n = rho >> 4, i = rho & 15; return 8 * (i >> 2) + 4 * n + (i & 3); }
struct Unit { int pm, pn; int row0; int arow0; int mvalid; int e; int mbase; const char* B; };
DEVI void xcd_tile(int L, int nwg, int nM, int nN, int& pm, int& pn) {
    int wgid = L; { const int q = nwg / NXCD, r = nwg % NXCD, xcd = wgid % NXCD, off = wgid / NXCD; wgid = (xcd < r ? xcd * (q + 1) : r * (q + 1) + (xcd - r) * q) + off; }
    const int nig = WGM * nN, gid = wgid / nig, fm = gid * WGM, gsz = (nM - fm) < WGM ? (nM - fm) : WGM;
    pm = fm + ((wgid % nig) % gsz); pn = (wgid % nig) / gsz;
}
struct DenseOrder {
    int nM, nN, nwg, G, c; const char* Bt; size_t tstepB;
    DEVI void init(int M, int N, int K, const bf16_t* Bt_, int G_, int c_) { nM = M / BM; nN = N / BM; nwg = nM * nN; G = G_; c = c_; Bt = (const char*)Bt_; tstepB = (size_t)BM * K * 2; }
    DEVI bool next(int i, Unit& u) const { const long L = (long)i * G + c; if (L >= nwg) return false; xcd_tile((int)L, nwg, nM, nN, u.pm, u.pn); u.row0 = u.pm * BM; u.arow0 = u.row0; u.mvalid = BM; u.e = 0; u.mbase = 0; u.B = Bt + (size_t)u.pn * tstepB; return true; }
};
struct TailOrder {
    int nM, nN, nwg, nb, r; const char* Bt; size_t tstepB;
    DEVI void init(int M, int N, int K, const bf16_t* Bt_, int G_, int c_, int first) { nM = M / BM; nN = N / BM; nwg = nM * nN; Bt = (const char*)Bt_; tstepB = (size_t)BM * K * 2;
        if (first >= G_) first = 0; nb = G_ - first; r = c_ - first; }
    DEVI bool next(int i, Unit& u) const { if (r < 0) return false; const long L = (long)i * nb + r; if (L >= nwg) return false; u.pm = (int)L / nN; u.pn = (int)L % nN; u.row0 = u.pm * BM; u.arow0 = u.row0; u.mvalid = BM; u.e = 0; u.mbase = 0; u.B = Bt + (size_t)u.pn * tstepB; return true; }
};
struct MoeOrder {
    int nM, nN, nwg, G, c; const char* Bt; size_t estepB, tstepB; const volatile LAS int* tab; bool per_expert;
    DEVI void init(const unsigned* cnt, volatile LAS int* tab_, int N, int K, const bf16_t* Bt_, size_t estep_bytes, bool per_expert_, int G_, int c_) {
        __syncthreads();
        if (threadIdx.x == 0) { int t = 0;
            for (int e = 0; e < 8; ++e) { const int n = (int)__hip_atomic_load(cnt + e, __ATOMIC_RELAXED, __HIP_MEMORY_SCOPE_AGENT); tab_[16 + e] = n; tab_[e] = t; t += (n + BM - 1) / BM; }
            tab_[8] = t; }
        __syncthreads();
        tab = tab_; nM = __builtin_amdgcn_readfirstlane(tab_[8]); nN = N / BM; nwg = nM * nN; G = G_; c = c_; Bt = (const char*)Bt_; estepB = estep_bytes; tstepB = (size_t)BM * K * 2; per_expert = per_expert_;
    }
    DEVI bool next(int i, Unit& u) const { const long L = (long)i * G + c; if (L >= nwg) return false; xcd_tile((int)L, nwg, nM, nN, u.pm, u.pn);
        int e = 0;
        for (int k = 1; k < 8; ++k) if (u.pm >= __builtin_amdgcn_readfirstlane(tab[k])) e = k;
        const int t0 = __builtin_amdgcn_readfirstlane(tab[e]), n = __builtin_amdgcn_readfirstlane(tab[16 + e]);
        u.e = e; u.row0 = u.pm * BM; const int m0 = (u.pm - t0) * BM; u.mbase = m0; u.arow0 = per_expert ? e * MT + m0 : u.row0; u.mvalid = (n - m0) < BM ? (n - m0) : BM; u.B = Bt + (size_t)e * estepB + (size_t)u.pn * tstepB; return true; }
};
DEVI unsigned cvt_pk_bf16(float lo, float hi) { unsigned r; asm volatile("v_cvt_pk_bf16_f32 %0, %1, %2" : "=v"(r) : "v"(lo), "v"(hi)); return r; }

struct EpiBf16 { static constexpr bool PERM = true; bf16_t* O; int ldc; const float* rs;
    DEVI void operator()(const f32x4 (&acc)[2][2][4][2], const Unit& u, int wr, int wc, int fr, int fq) const {
        const int row0 = u.row0 + wr * 64 + fr, col0 = u.pn * BM + wc * 32 + 8 * fq;
#pragma unroll
        for (int ai = 0; ai < 2; ++ai)
#pragma unroll
            for (int m = 0; m < 4; ++m) { const int row = row0 + ai * HALF + m * 16; bf16_t* rowp = O + (size_t)row * ldc + col0;
                const float sc = rs ? rs[row] : 1.f;
#pragma unroll
                for (int bj = 0; bj < 2; ++bj) { const f32x4 v0 = acc[ai][bj][m][0] * sc, v1 = acc[ai][bj][m][1] * sc;
                    u32x4 w; w.x = cvt_pk_bf16(v0[0], v0[1]); w.y = cvt_pk_bf16(v0[2], v0[3]); w.z = cvt_pk_bf16(v1[0], v1[1]); w.w = cvt_pk_bf16(v1[2], v1[3]);
                    *(u32x4*)(rowp + bj * HALF) = w; } }
    } };
struct EpiPleGate { static constexpr bool PERM = true; bf16_t* T; int ldc; const float* rs;
    DEVI void operator()(const f32x4 (&acc)[2][2][4][2], const Unit& u, int wr, int wc, int fr, int fq) const {
        const int row0 = u.row0 + wr * 64 + fr, col0 = u.pn * BM + wc * 32 + 8 * fq;
#pragma unroll
        for (int ai = 0; ai < 2; ++ai)
#pragma unroll
            for (int m = 0; m < 4; ++m) { const int row = row0 + ai * HALF + m * 16; bf16_t* rowp = T + (size_t)row * ldc + col0;
                const float sc = rs[row];
#pragma unroll
                for (int bj = 0; bj < 2; ++bj) { const f32x4 v0 = acc[ai][bj][m][0] * sc, v1 = acc[ai][bj][m][1] * sc;
                    const u32x4 pp = *(const u32x4*)(rowp + bj * HALF);
                    u32x4 w; w.x = cvt_pk_bf16(sigmoid_f(v0[0]) * bflo(pp.x), sigmoid_f(v0[1]) * bfhi(pp.x)); w.y = cvt_pk_bf16(sigmoid_f(v0[2]) * bflo(pp.y), sigmoid_f(v0[3]) * bfhi(pp.y));
                    w.z = cvt_pk_bf16(sigmoid_f(v1[0]) * bflo(pp.z), sigmoid_f(v1[1]) * bfhi(pp.z)); w.w = cvt_pk_bf16(sigmoid_f(v1[2]) * bflo(pp.w), sigmoid_f(v1[3]) * bfhi(pp.w));
                    *(u32x4*)(rowp + bj * HALF) = w; } }
    } };
struct EpiSwiglu { static constexpr bool PERM = true; bf16_t* O; int ldc; const float* rs; int grouped;
    DEVI void operator()(const f32x4 (&acc)[2][2][4][2], const Unit& u, int wr, int wc, int fr, int fq) const {
        const int row0 = u.row0 + wr * 64 + fr, col0 = u.pn * HALF + wc * 32 + 8 * fq;
#pragma unroll
        for (int ai = 0; ai < 2; ++ai)
#pragma unroll
            for (int m = 0; m < 4; ++m) { const int rl = wr * 64 + fr + ai * HALF + m * 16; bf16_t* rowp = O + (size_t)(u.row0 + rl) * ldc + col0;
                float sc;
                if (grouped) sc = (rl < u.mvalid) ? rs[u.e * MT + u.mbase + rl] : 0.f; else sc = rs[u.row0 + rl];
                const f32x4 g0 = acc[ai][0][m][0] * sc, g1 = acc[ai][0][m][1] * sc, u0 = acc[ai][1][m][0] * sc, u1 = acc[ai][1][m][1] * sc;
                u32x4 w; w.x = cvt_pk_bf16(silu_f(g0[0]) * u0[0], silu_f(g0[1]) * u0[1]); w.y = cvt_pk_bf16(silu_f(g0[2]) * u0[2], silu_f(g0[3]) * u0[3]);
                w.z = cvt_pk_bf16(silu_f(g1[0]) * u1[0], silu_f(g1[1]) * u1[1]); w.w = cvt_pk_bf16(silu_f(g1[2]) * u1[2], silu_f(g1[3]) * u1[3]);
                *(u32x4*)rowp = w; }
    } };
constexpr float W8_SCALE = 64.f, ACT8_SCALE = 8.f;
struct EpiSwiglu8 { static constexpr bool PERM = true; unsigned char* O; int ldc; const float* rs;
    DEVI void operator()(const f32x4 (&acc)[2][2][4][2], const Unit& u, int wr, int wc, int fr, int fq) const {
        const int col0 = u.pn * HALF + wc * 32 + 8 * fq;
#pragma unroll
        for (int ai = 0; ai < 2; ++ai)
#pragma unroll
            for (int m = 0; m < 4; ++m) { const int rl = wr * 64 + fr + ai * HALF + m * 16; unsigned char* rowp = O + (size_t)(u.row0 + rl) * ldc + col0;
                const float sc = (rl < u.mvalid) ? rs[u.e * MT + u.mbase + rl] * (1.f / W8_SCALE) : 0.f;
                const f32x4 g0 = acc[ai][0][m][0] * sc, g1 = acc[ai][0][m][1] * sc, u0 = acc[ai][1][m][0] * (sc * ACT8_SCALE), u1 = acc[ai][1][m][1] * (sc * ACT8_SCALE);
                u32x2 w; w.x = pg8_pk4(silu_f(g0[0]) * u0[0], silu_f(g0[1]) * u0[1], silu_f(g0[2]) * u0[2], silu_f(g0[3]) * u0[3]);
                w.y = pg8_pk4(silu_f(g1[0]) * u1[0], silu_f(g1[1]) * u1[1], silu_f(g1[2]) * u1[2], silu_f(g1[3]) * u1[3]);
                *(u32x2*)rowp = w; }
    } };
struct EpiMoeDown { static constexpr bool PERM = true; bf16_t* Y; const int* list; const float* gatev; float oscale;
    DEVI void operator()(const f32x4 (&acc)[2][2][4][2], const Unit& u, int wr, int wc, int fr, int fq) const {
        const int col0 = u.pn * BM + wc * 32 + 8 * fq;
        const int mbase = u.mbase;
#pragma unroll
        for (int ai = 0; ai < 2; ++ai)
#pragma unroll
            for (int m = 0; m < 4; ++m) { const int rl = wr * 64 + fr + ai * HALF + m * 16;
                if (rl < u.mvalid) {
                    const int tsl = list[u.e * MT + mbase + rl]; const float gt = gatev[u.e * MT + mbase + rl] * oscale;
                    bf16_t* rowp = Y + (size_t)(tsl & 1) * ((size_t)MT * DM) + (size_t)(tsl >> 1) * DM + col0;
#pragma unroll
                    for (int bj = 0; bj < 2; ++bj) { const f32x4 v0 = acc[ai][bj][m][0], v1 = acc[ai][bj][m][1];
                        u32x4 w; w.x = cvt_pk_bf16(v0[0] * gt, v0[1] * gt); w.y = cvt_pk_bf16(v0[2] * gt, v0[3] * gt); w.z = cvt_pk_bf16(v1[0] * gt, v1[1] * gt); w.w = cvt_pk_bf16(v1[2] * gt, v1[3] * gt);
                        *(u32x4*)(rowp + bj * HALF) = w; } } }
    } };

typedef int v8i __attribute__((ext_vector_type(8)));
typedef int v4i __attribute__((ext_vector_type(4)));
DEVI v8i cat8(const bf16x8 lo, const bf16x8 hi) { const v4i a = __builtin_bit_cast(v4i, lo), b = __builtin_bit_cast(v4i, hi); return __builtin_shufflevector(a, b, 0, 1, 2, 3, 4, 5, 6, 7); }
struct Frag16 { bf16x8 k[2]; };
struct Frag8 { v8i v; };
template <bool F> struct FragSel { typedef Frag16 T; };
template <> struct FragSel<true> { typedef Frag8 T; };
template <class Epi, class Sched, bool FP8 = false>
DEVI void gemm_phase(LAS unsigned char* lds, const bf16_t* A, const int K, const Sched& S, const Epi& E) {
    const int tid = opq((int)threadIdx.x), wid = __builtin_amdgcn_readfirstlane(tid >> 6), lane = tid & 63, wr = wid >> 2, wc = wid & 3, fr = lane & 15, fq = lane >> 4;
    const int nt = K / BK;
    unsigned voffA[2], voffB[2];
#pragma unroll
    for (int i = 0; i < 2; ++i) { int R, C; stage_rc(tid * 16 + i * 8192, R, C); const int Rb = Epi::PERM ? ((R & ~31) + perm32(R & 31)) : R;
        voffA[i] = (unsigned)(R * K + C) * 2u; voffB[i] = (unsigned)(Rb * K + C) * 2u; }
    const size_t kstep = (size_t)(BK * 2);
    const size_t hstep = (size_t)HALF * K * 2;
    const size_t rstep = (size_t)K * 2;
    const unsigned ldsw = (unsigned)wid * 1024u;
    const int aoff = lds_byte(wr * 64 + fr, fq * 8), boff = lds_byte(wc * 32 + fr, fq * 8);
#define PG8_SA(b, h) (((b) * 2 + (h)) * HTB)
#define PG8_SB(b, h) ((4 + (b) * 2 + (h)) * HTB)
#define PG8_STAGE(bufoff, gbase, voff) do { _Pragma("unroll") for (int _i = 0; _i < 2; ++_i) \
        __builtin_amdgcn_global_load_lds((const unsigned*)((const char*)(gbase) + (voff)[_i]), (LAS unsigned*)(lds + (bufoff) + ldsw + _i * 8192), 16, 0, 0); } while (0)
#define PG8_LDA(dst, b, h) do { _Pragma("unroll") for (int m = 0; m < 4; ++m) { if constexpr (FP8) dst[m].v = cat8(*(const LAS bf16x8*)(lds + PG8_SA(b, h) + aoff + m * 2048), *(const LAS bf16x8*)(lds + PG8_SA(b, h) + aoff + m * 2048 + 1024)); \
        else { _Pragma("unroll") for (int k = 0; k < 2; ++k) dst[m].k[k] = *(const LAS bf16x8*)(lds + PG8_SA(b, h) + aoff + m * 2048 + k * 1024); } } } while (0)
#define PG8_LDB(dst, b, h) do { _Pragma("unroll") for (int n = 0; n < 2; ++n) { if constexpr (FP8) dst[n].v = cat8(*(const LAS bf16x8*)(lds + PG8_SB(b, h) + boff + n * 2048), *(const LAS bf16x8*)(lds + PG8_SB(b, h) + boff + n * 2048 + 1024)); \
        else { _Pragma("unroll") for (int k = 0; k < 2; ++k) dst[n].k[k] = *(const LAS bf16x8*)(lds + PG8_SB(b, h) + boff + n * 2048 + k * 1024); } } } while (0)
#define PG8_MMA(ai, bj, At, Bt) do { __builtin_amdgcn_s_setprio(1); _Pragma("unroll") for (int m = 0; m < 4; ++m) _Pragma("unroll") for (int n = 0; n < 2; ++n) { \
        if constexpr (FP8) asm volatile("s_nop 1\n\tv_mfma_scale_f32_16x16x128_f8f6f4 %0, %1, %2, %0, %3, %3 op_sel_hi:[0,0,0]" : "+v"(acc[ai][bj][m][n]) : "v"(Bt[n].v), "v"(At[m].v), "v"(sc1)); \
        else { _Pragma("unroll") for (int k = 0; k < 2; ++k) acc[ai][bj][m][n] = __builtin_amdgcn_mfma_f32_16x16x32_bf16(Bt[n].k[k], At[m].k[k], acc[ai][bj][m][n], 0, 0, 0); } } \
        __builtin_amdgcn_s_setprio(0); } while (0)
#define PG8_WAIT_V(n) asm volatile("s_waitcnt vmcnt(" #n ")" ::: "memory")
#define PG8_WAIT_L(n) asm volatile("s_waitcnt lgkmcnt(" #n ")" ::: "memory")
#define PG8_BAR __builtin_amdgcn_s_barrier()
#define PG8_SCHED __builtin_amdgcn_sched_barrier(0)
    Unit cur, nxt; int ui = 0;
    if (!S.next(0, cur)) return;
    int sc1 = 0x7F7F7F7F; asm volatile("" : "+v"(sc1));
    f32x4 acc[2][2][4][2];
#pragma unroll
    for (int a = 0; a < 2; ++a)
#pragma unroll
        for (int b = 0; b < 2; ++b)
#pragma unroll
            for (int m = 0; m < 4; ++m)
#pragma unroll
                for (int n = 0; n < 2; ++n) acc[a][b][m][n] = (f32x4){0.f, 0.f, 0.f, 0.f};
    typename FragSel<FP8>::T At[4], B0[2], B1[2];
    const char* cA = (const char*)A + (size_t)cur.arow0 * rstep;
    const char* cB = cur.B;
    PG8_STAGE(PG8_SB(0, 0), cB, voffB); PG8_STAGE(PG8_SA(0, 0), cA, voffA); PG8_STAGE(PG8_SB(0, 1), cB + hstep, voffB); PG8_STAGE(PG8_SA(0, 1), cA + hstep, voffA);
    if (wr == 1) PG8_BAR;
    PG8_WAIT_V(4); PG8_BAR;
    PG8_STAGE(PG8_SB(1, 0), cB + kstep, voffB); PG8_STAGE(PG8_SA(1, 0), cA + kstep, voffA); PG8_STAGE(PG8_SB(1, 1), cB + hstep + kstep, voffB);
    PG8_WAIT_V(6); PG8_BAR;
    for (;;) {
        const bool has_next = S.next(ui + 1, nxt);
        const char* nA = has_next ? (const char*)A + (size_t)nxt.arow0 * rstep : cA; const char* nB = has_next ? nxt.B : cB;
#pragma unroll 1
        for (int t = 0; t < nt; t += 2) {
            const bool last = (t == nt - 2);
            const char* a1 = cA + (size_t)(t + 1) * kstep;
            const char* a2 = last ? nA : cA + (size_t)(t + 2) * kstep; const char* b2 = last ? nB : cB + (size_t)(t + 2) * kstep;
            const char* a3 = a2 + kstep; const char* b3 = b2 + kstep;
            PG8_LDB(B0, 0, 0); PG8_SCHED; PG8_LDA(At, 0, 0); PG8_STAGE(PG8_SA(1, 1), a1 + hstep, voffA);
            PG8_WAIT_L(8); PG8_BAR; PG8_WAIT_L(0); PG8_MMA(0, 0, At, B0); PG8_BAR; PG8_SCHED;
            PG8_LDB(B1, 0, 1); PG8_STAGE(PG8_SB(0, 0), b2, voffB);
            PG8_BAR; PG8_WAIT_L(0); PG8_MMA(0, 1, At, B1); PG8_BAR;
            PG8_LDA(At, 0, 1); PG8_STAGE(PG8_SA(0, 0), a2, voffA);
            PG8_BAR; PG8_WAIT_L(0); PG8_MMA(1, 0, At, B0); PG8_BAR; PG8_SCHED;
            PG8_STAGE(PG8_SB(0, 1), b2 + hstep, voffB);
            PG8_WAIT_V(6); PG8_BAR; PG8_MMA(1, 1, At, B1); PG8_BAR;
            PG8_LDB(B0, 1, 0); PG8_SCHED; PG8_LDA(At, 1, 0); PG8_STAGE(PG8_SA(0, 1), a2 + hstep, voffA);
            PG8_WAIT_L(8); PG8_BAR; PG8_WAIT_L(0); PG8_MMA(0, 0, At, B0); PG8_BAR; PG8_SCHED;
            PG8_LDB(B1, 1, 1); PG8_STAGE(PG8_SB(1, 0), b3, voffB);
            PG8_BAR; PG8_WAIT_L(0); PG8_MMA(0, 1, At, B1); PG8_BAR;
            PG8_LDA(At, 1, 1); PG8_STAGE(PG8_SA(1, 0), a3, voffA);
            PG8_BAR; PG8_WAIT_L(0); PG8_MMA(1, 0, At, B0); PG8_BAR; PG8_SCHED;
            PG8_STAGE(PG8_SB(1, 1), b3 + hstep, voffB);
            PG8_WAIT_V(6); PG8_BAR; PG8_MMA(1, 1, At, B1); PG8_BAR;
        }
        if constexpr (FP8) asm volatile("s_nop 15\n\ts_nop 15" ::: "memory");
        E(acc, cur, wr, wc, fr, fq);
        if (!has_next) break;
#pragma unroll
        for (int a = 0; a < 2; ++a)
#pragma unroll
            for (int b = 0; b < 2; ++b)
#pragma unroll
                for (int m = 0; m < 4; ++m)
#pragma unroll
                    for (int n = 0; n < 2; ++n) acc[a][b][m][n] = (f32x4){0.f, 0.f, 0.f, 0.f};
        cur = nxt; cA = nA; cB = nB; ++ui;
        if constexpr (FP8) asm volatile("s_nop 7" ::: "memory");
    }
    PG8_WAIT_V(0);
    if (wr == 0) PG8_BAR;
    PG8_BAR;
#undef PG8_SA
#undef PG8_SB
#undef PG8_STAGE
#undef PG8_LDA
#undef PG8_LDB
#undef PG8_MMA
#undef PG8_WAIT_V
#undef PG8_WAIT_L
#undef PG8_BAR
#undef PG8_SCHED
}
}

DEVI float lb_of(const float* lbraw, int ch) {
    const float r0 = lbraw[ch], r1 = lbraw[512 + ch], r2 = lbraw[1024 + ch];
    const float mx = fmaxf(r0, fmaxf(r1, r2));
    const float e0 = __expf(r0 - mx), e1 = __expf(r1 - mx), e2 = __expf(r2 - mx);
    return e0 / (e0 + e1 + e2);
}
DEVI void ph_hgrn_naive(float* lds, const bf16_t* u, const float* lbraw, float* oacc, int vb0, int vbs) {
    float* sq = lds; float* sk = lds + 2048; float* sf = lds + 4096; float* sv = lds + 6144;
    const int tid = opq((int)threadIdx.x), j = tid >> 2, kq = tid & 3;
    for (int vb = vb0; vb < 32; vb += vbs) {
        const int dir = vb & 1, h = (vb >> 1) & 3, b = vb >> 3;
        float st[32];
#pragma unroll
        for (int i = 0; i < 32; ++i) st[i] = 0.f;
        for (int tb = 0; tb < SEQ / 16; ++tb) {
            __syncthreads();
            for (int e = tid; e < 2048; e += NTHR) {
                const int i = e >> 7, c = e & 127;
                const int t = dir ? (SEQ - 1 - (tb * 16 + i)) : (tb * 16 + i);
                const bf16_t* ur = u + (size_t)(b * SEQ + t) * UW;
                const int ch = h * 128 + c;
                const float qr = bf2f(ur[ch]), fr = bf2f(ur[(dir ? 1024 : 512) + ch]), vr = bf2f(ur[1536 + ch]);
                const float lb = lb_of(lbraw, ch);
                const float f = lb + (1.f - lb) * sigmoid_f(fr);
                sq[e] = silu_f(qr); sk[e] = 1.f - f; sf[e] = f; sv[e] = vr;
            }
            __syncthreads();
            for (int i = 0; i < 16; ++i) {
                const float vj = sv[i * 128 + j]; float acc = 0.f;
#pragma unroll
                for (int kk = 0; kk < 32; ++kk) {
                    const int kidx = kk * 4 + kq;
                    st[kk] = sf[i * 128 + kidx] * st[kk] + sk[i * 128 + kidx] * vj;
                    acc += st[kk] * sq[i * 128 + kidx];
                }
                acc += __shfl_xor(acc, 1); acc += __shfl_xor(acc, 2);
                if (kq == 0) {
                    const int t = dir ? (SEQ - 1 - (tb * 16 + i)) : (tb * 16 + i);
                    atomicAdd(&oacc[(size_t)(b * SEQ + t) * DM + h * 128 + j], acc);
                }
            }
        }
    }
    __syncthreads();
}

DEVI void ph_mixfin_hgrn(const bf16_t* u, const float* oacc, const float* a_norm, bf16_t* ocat, int vb0, int vbs) {
    const int tidq = opq((int)threadIdx.x); const int hw = tidq >> 5, l32 = tidq & 31;
    for (int row = vb0 * 16 + hw; row < MT; row += vbs * 16) {
        const int c0 = l32 * 16; float v[16]; float ss = 0.f;
        const bf16_t* ur = u + (size_t)row * UW;
#pragma unroll
        for (int i = 0; i < 16; ++i) { v[i] = oacc[(size_t)row * DM + c0 + i]; ss += v[i] * v[i]; }
        ss += __shfl_xor(ss, 1); ss += __shfl_xor(ss, 2); ss += __shfl_xor(ss, 4);
        const float r = rsqrtf(ss * (1.f / 128.f) + EPS);
#pragma unroll
        for (int i = 0; i < 16; ++i) { const int c = c0 + i; ocat[(size_t)row * DM + c] = f2bf(v[i] * r * a_norm[c & 127] * silu_f(bf2f(ur[2048 + c]))); }
    }
}


constexpr int HQ = 0, HK = 17408, HKH = 34816, HV = 53248, HDV = 71680, HZERO = 73728, HOT = 75776, H_END = HOT + 64 * 528;
static_assert(H_END <= 131072, "hgrn lds");
constexpr size_t HS_SCAN = (size_t)16 * 16384;
DEVI void hgrn_prep(LAS unsigned char* lds, const bf16_t* u, float lbv, int dir, size_t tokbase, int h, int c, int I) {
    float ff[16], kk[16], qq[16];
    const bf16_t* up = u + (tokbase + 16 * I) * UW + h * 128 + c;
    const int fcol = dir ? 1024 : 512;
#pragma unroll
    for (int j = 0; j < 16; ++j) {
        const float fr = bf2f(up[(size_t)j * UW + fcol]), qr = bf2f(up[(size_t)j * UW]);
        const float f = lbv + (1.f - lbv) * sigmoid_f(fr);
        ff[j] = f; kk[j] = 1.f - f; qq[j] = silu_f(qr);
    }
    float run = 1.f;
#pragma unroll
    for (int jj = 0; jj < 16; ++jj) { const int j = dir ? 15 - jj : jj; run *= ff[j]; ff[j] = run; }
    const float PG = run;
    float kh[16];
#pragma unroll
    for (int j = 0; j < 16; ++j) {
        const float kt = kk[j] * __builtin_amdgcn_rcpf(ff[j]);
        kh[j] = kt * PG;
        *(LAS bf16_t*)(lds + HQ + (16 * I + j) * 272 + c * 2) = f2bf(qq[j] * ff[j]);
        *(LAS bf16_t*)(lds + HK + (16 * I + j) * 272 + c * 2) = f2bf(kt);
    }
    u32x4 w0, w1;
    w0.x = pk2(kh[0], kh[1]); w0.y = pk2(kh[2], kh[3]); w0.z = pk2(kh[4], kh[5]); w0.w = pk2(kh[6], kh[7]);
    w1.x = pk2(kh[8], kh[9]); w1.y = pk2(kh[10], kh[11]); w1.z = pk2(kh[12], kh[13]); w1.w = pk2(kh[14], kh[15]);
    *(LAS u32x4*)(lds + HKH + c * 144 + I * 32) = w0; *(LAS u32x4*)(lds + HKH + c * 144 + I * 32 + 16) = w1;
    *(LAS float*)(lds + HDV + (I * 128 + c) * 4) = PG;
}
DEVI void hgrn_update(LAS unsigned char* lds, f32x4 (&Sacc)[8], int I, int wid, int fr, int fq) {
    const int voff = (fq < 2) ? HV + (16 * wid + fr) * 144 + (16 * I + 8 * fq) * 2 : HZERO;
    const int koff = (fq < 2) ? HKH + fr * 144 + (16 * I + 8 * fq) * 2 : HZERO;
    const int kstep = (fq < 2) ? 16 * 144 : 0;
    const bf16x8 vb = *(const LAS bf16x8*)(lds + voff);
    bf16x8 ka[8]; f32x4 dv[8];
#pragma unroll
    for (int m = 0; m < 8; ++m) { ka[m] = *(const LAS bf16x8*)(lds + koff + m * kstep); dv[m] = *(const LAS f32x4*)(lds + HDV + (I * 128 + 16 * m + 4 * fq) * 4); }
#pragma unroll
    for (int m = 0; m < 8; ++m) Sacc[m] = __builtin_amdgcn_mfma_f32_16x16x32_bf16(ka[m], vb, Sacc[m] * dv[m], 0, 0, 0);
}
DEVI void stage_vt(LAS unsigned char* lds, const bf16_t* VT, int b, int h, int t0, int tid) {
    for (int e = tid; e < 128 * 8; e += NTHR) { const int r = e >> 3, cch = e & 7; *(LAS u32x4*)(lds + HV + r * 144 + cch * 16) = *(const u32x4*)(VT + ((size_t)b * 512 + h * 128 + r) * SEQ + t0 + cch * 8); }
}
DEVI void ph_hgrn_states(LAS unsigned char* lds, const bf16_t* u, const bf16_t* VT, const float* lbraw, float* HS, float* HD, int vb0, int vbs) {
    const int tid = opq((int)threadIdx.x), wid = __builtin_amdgcn_readfirstlane(tid >> 6), lane = tid & 63, fr = lane & 15, fq = lane >> 4;
    const int pc = tid & 127, pI = tid >> 7;
    for (int unit = vb0; unit < NB * 4 * 2 * 16; unit += vbs) {
        const int seg = unit & 15, dir = (unit >> 4) & 1, h = (unit >> 5) & 3, b = unit >> 7;
        const float lbv = lb_of(lbraw, h * 128 + pc);
        f32x4 Sacc[8];
#pragma unroll
        for (int m = 0; m < 8; ++m) Sacc[m] = (f32x4){0.f, 0.f, 0.f, 0.f};
        float gprod = 1.f;
        if (tid < 4) *(LAS unsigned*)(lds + HZERO + tid * 4) = 0u;
#pragma unroll 1
        for (int sbi = 0; sbi < 4; ++sbi) {
            const int sb = dir ? 3 - sbi : sbi;
            const int t0 = seg * 256 + sb * 64;
            __syncthreads();
            hgrn_prep(lds, u, lbv, dir, (size_t)b * SEQ + t0, h, pc, pI);
            stage_vt(lds, VT, b, h, t0, tid);
            __syncthreads();
            if (tid < 128) gprod *= (*(const LAS float*)(lds + HDV + tid * 4) * *(const LAS float*)(lds + HDV + (128 + tid) * 4)) * (*(const LAS float*)(lds + HDV + (256 + tid) * 4) * *(const LAS float*)(lds + HDV + (384 + tid) * 4));
#pragma unroll 1
            for (int ii = 0; ii < 4; ++ii) { const int I = dir ? 3 - ii : ii; hgrn_update(lds, Sacc, I, wid, fr, fq); }
        }
        const size_t scan = (size_t)(b * 4 + h) * 2 + dir;
        float* dst = HS + scan * HS_SCAN + (size_t)seg * 16384;
#pragma unroll
        for (int m = 0; m < 8; ++m)
#pragma unroll
            for (int rg = 0; rg < 4; ++rg) dst[(16 * m + 4 * fq + rg) * 128 + 16 * wid + fr] = Sacc[m][rg];
        if (tid < 128) HD[(scan * 16 + seg) * 128 + tid] = gprod;
    }
    __syncthreads();
}
DEVI void ph_hgrn_scan(float* HS, const float* HD, int vb0, int vbs) {
    const int tid = opq((int)threadIdx.x);
    for (int idx = vb0 * NTHR + tid; idx < 32 * 4096; idx += vbs * NTHR) {
        const int scan = idx >> 12, e4 = idx & 4095, kch = e4 >> 5; const int dir = scan & 1;
        float4* base = (float4*)(HS + (size_t)scan * HS_SCAN) + e4;
        const float* hd = HD + (size_t)scan * 16 * 128 + kch;
        float4 d[16]; float dec[16];
#pragma unroll
        for (int i = 0; i < 16; ++i) { d[i] = base[(size_t)i * 4096]; dec[i] = hd[i * 128]; }
        float4 st = make_float4(0.f, 0.f, 0.f, 0.f);
        if (dir == 0) {
#pragma unroll
            for (int i = 0; i < 16; ++i) { const float4 t = d[i]; d[i] = st; st.x = st.x * dec[i] + t.x; st.y = st.y * dec[i] + t.y; st.z = st.z * dec[i] + t.z; st.w = st.w * dec[i] + t.w; }
        } else {
#pragma unroll
            for (int i = 15; i >= 0; --i) { const float4 t = d[i]; d[i] = st; st.x = st.x * dec[i] + t.x; st.y = st.y * dec[i] + t.y; st.z = st.z * dec[i] + t.z; st.w = st.w * dec[i] + t.w; }
        }
#pragma unroll
        for (int i = 0; i < 16; ++i) base[(size_t)i * 4096] = d[i];
    }
}
DEVI void ph_hgrn_out(LAS unsigned char* lds, const bf16_t* u, const bf16_t* VT, const float* lbraw, const float* a_norm, const float* HS, float* OF, bf16_t* ocat, int vb0, int vbs) {
    const int tid = opq((int)threadIdx.x), wid = __builtin_amdgcn_readfirstlane(tid >> 6), lane = tid & 63, fr = lane & 15, fq = lane >> 4;
    const int pc = tid & 127, pI = tid >> 7;
    const int otok = tid >> 3, opart = tid & 7;
    for (int unit = vb0; unit < NB * 4 * 16; unit += vbs) {
        const int seg = unit & 15, h = (unit >> 4) & 3, b = unit >> 6;
        const float lbv = lb_of(lbraw, h * 128 + pc);
        if (tid < 4) *(LAS unsigned*)(lds + HZERO + tid * 4) = 0u;
#pragma unroll 1
        for (int dir = 0; dir < 2; ++dir) {
            const size_t scan = (size_t)(b * 4 + h) * 2 + dir;
            const float* src = HS + scan * HS_SCAN + (size_t)seg * 16384;
            f32x4 Sacc[8];
#pragma unroll
            for (int m = 0; m < 8; ++m)
#pragma unroll
                for (int rg = 0; rg < 4; ++rg) Sacc[m][rg] = src[(16 * m + 4 * fq + rg) * 128 + 16 * wid + fr];
#pragma unroll 1
            for (int sbi = 0; sbi < 4; ++sbi) {
                const int sb = dir ? 3 - sbi : sbi;
                const int t0 = seg * 256 + sb * 64;
                const size_t tokb = (size_t)b * SEQ + t0;
                __syncthreads();
                hgrn_prep(lds, u, lbv, dir, tokb, h, pc, pI);
                stage_vt(lds, VT, b, h, t0, tid);
                __syncthreads();
#pragma unroll 1
                for (int ii = 0; ii < 4; ++ii) {
                    const int I = dir ? 3 - ii : ii;
                    f32x4 oT = {0.f, 0.f, 0.f, 0.f};
                    const LAS unsigned char* qrow = lds + HQ + (16 * I + fr) * 272;
#pragma unroll
                    for (int ks = 0; ks < 4; ++ks) {
                        u32x4 sa; sa.x = pg8::cvt_pk_bf16(Sacc[2 * ks][0], Sacc[2 * ks][1]); sa.y = pg8::cvt_pk_bf16(Sacc[2 * ks][2], Sacc[2 * ks][3]);
                        sa.z = pg8::cvt_pk_bf16(Sacc[2 * ks + 1][0], Sacc[2 * ks + 1][1]); sa.w = pg8::cvt_pk_bf16(Sacc[2 * ks + 1][2], Sacc[2 * ks + 1][3]);
                        const u32x2 q0 = *(const LAS u32x2*)(qrow + (32 * ks + 4 * fq) * 2), q1 = *(const LAS u32x2*)(qrow + (32 * ks + 16 + 4 * fq) * 2);
                        u32x4 qb; qb.x = q0.x; qb.y = q0.y; qb.z = q1.x; qb.w = q1.y;
                        oT = __builtin_amdgcn_mfma_f32_16x16x32_bf16(__builtin_bit_cast(bf16x8, sa), __builtin_bit_cast(bf16x8, qb), oT, 0, 0, 0);
                    }
                    f32x4 sT = {0.f, 0.f, 0.f, 0.f};
                    const LAS unsigned char* krow = lds + HK + (16 * I + fr) * 272;
#pragma unroll
                    for (int ks = 0; ks < 4; ++ks) {
                        const bf16x8 ka = *(const LAS bf16x8*)(krow + (32 * ks + 8 * fq) * 2), qb = *(const LAS bf16x8*)(qrow + (32 * ks + 8 * fq) * 2);
                        sT = __builtin_amdgcn_mfma_f32_16x16x32_bf16(ka, qb, sT, 0, 0, 0);
                    }
                    float pv[4];
#pragma unroll
                    for (int rg = 0; rg < 4; ++rg) { const int sl = 4 * fq + rg; const bool ok = dir ? (sl >= fr) : (sl <= fr); pv[rg] = ok ? sT[rg] : 0.f; }
                    u32x4 pb; pb.x = pg8::cvt_pk_bf16(pv[0], pv[1]); pb.y = pg8::cvt_pk_bf16(pv[2], pv[3]); pb.z = 0u; pb.w = 0u;
                    const u32x2 v0 = *(const LAS u32x2*)(lds + HV + (16 * wid + fr) * 144 + (16 * I + 4 * fq) * 2);
                    u32x4 va; va.x = v0.x; va.y = v0.y; va.z = 0u; va.w = 0u;
                    oT = __builtin_amdgcn_mfma_f32_16x16x32_bf16(__builtin_bit_cast(bf16x8, va), __builtin_bit_cast(bf16x8, pb), oT, 0, 0, 0);
                    if (dir == 0) *(f32x4*)(OF + (tokb + 16 * I + fr) * 512 + h * 128 + 16 * wid + 4 * fq) = oT;
                    else *(LAS f32x4*)(lds + HOT + (16 * I + fr) * 528 + (16 * wid + 4 * fq) * 4) = oT;
                    hgrn_update(lds, Sacc, I, wid, fr, fq);
                }
                if (dir == 1) {
                    __syncthreads();
                    const LAS float* orow = (const LAS float*)(lds + HOT + otok * 528) + opart * 16;
                    float* ofp = OF + (tokb + otok) * 512 + h * 128 + opart * 16;
                    float v[16]; float ss = 0.f;
#pragma unroll
                    for (int q2 = 0; q2 < 8; ++q2) { const unsigned long long w = __hip_atomic_load((unsigned long long*)(ofp + q2 * 2), __ATOMIC_RELAXED, __HIP_MEMORY_SCOPE_AGENT);
                        v[2 * q2] = __uint_as_float((unsigned)w) + orow[2 * q2]; v[2 * q2 + 1] = __uint_as_float((unsigned)(w >> 32)) + orow[2 * q2 + 1];
                        ss += v[2 * q2] * v[2 * q2] + v[2 * q2 + 1] * v[2 * q2 + 1]; }
                    ss += __shfl_xor(ss, 1); ss += __shfl_xor(ss, 2); ss += __shfl_xor(ss, 4);
                    const float rn = rsqrtf(ss * (1.f / 128.f) + EPS);
                    const bf16_t* gp = u + (tokb + otok) * UW + 2048 + h * 128 + opart * 16;
                    const u32x4 g0 = *(const u32x4*)gp, g1 = *(const u32x4*)(gp + 8);
                    const unsigned gw[8] = {g0.x, g0.y, g0.z, g0.w, g1.x, g1.y, g1.z, g1.w};
                    unsigned ow[8];
#pragma unroll
                    for (int q2 = 0; q2 < 8; ++q2) { const float an0 = a_norm[opart * 16 + 2 * q2], an1 = a_norm[opart * 16 + 2 * q2 + 1];
                        ow[q2] = pk2(v[2 * q2] * rn * an0 * silu_f(bflo(gw[q2])), v[2 * q2 + 1] * rn * an1 * silu_f(bfhi(gw[q2]))); }
                    bf16_t* op = ocat + (tokb + otok) * DM + h * 128 + opart * 16;
                    u32x4 o0, o1; o0.x = ow[0]; o0.y = ow[1]; o0.z = ow[2]; o0.w = ow[3]; o1.x = ow[4]; o1.y = ow[5]; o1.z = ow[6]; o1.w = ow[7];
                    *(u32x4*)op = o0; *(u32x4*)(op + 8) = o1;
                }
            }
            asm volatile("s_waitcnt vmcnt(0)" ::: "memory");
        }
    }
    __syncthreads();
}

DEVI void ph_prep(const bf16_t* u, const float* cw, const float* cb, bf16_t* xconv, bf16_t* XT, bf16_t* VT, int vb0, int vbs) {
    const int tid = opq((int)threadIdx.x);
    for (int unit = vb0; unit < NB * 32 * 3; unit += vbs) {
        const int cg = unit % 3, tb = (unit / 3) & 31, b = unit / 96;
        const int t0 = tb * 128;
        if (cg < 2) {
            const int ch = cg * 512 + tid;
            float w[5];
#pragma unroll
            for (int j = 0; j < 5; ++j) w[j] = cw[j * 1024 + ch];
            const float bias = cb[ch];
            const bf16_t* up = u + (size_t)b * SEQ * UW + 3072 + ch;
            float v0, v1, v2, v3;
            v0 = (t0 - 2 >= 0) ? bf2f(up[(size_t)(t0 - 2) * UW]) : 0.f;
            v1 = (t0 - 1 >= 0) ? bf2f(up[(size_t)(t0 - 1) * UW]) : 0.f;
            v2 = bf2f(up[(size_t)t0 * UW]);
            v3 = bf2f(up[(size_t)(t0 + 1) * UW]);
            for (int t8 = 0; t8 < 128; t8 += 32) {
                float nx[32];
#pragma unroll
                for (int i = 0; i < 32; ++i) { const int tt = t0 + t8 + i + 2; nx[i] = (tt < SEQ) ? bf2f(up[(size_t)tt * UW]) : 0.f; }
                unsigned pk[16];
#pragma unroll
                for (int i = 0; i < 32; ++i) {
                    const float o = silu_f(bias + w[0] * v0 + w[1] * v1 + w[2] * v2 + w[3] * v3 + w[4] * nx[i]);
                    const bf16_t ob = f2bf(o);
                    xconv[(size_t)(b * SEQ + t0 + t8 + i) * 1024 + ch] = ob;
                    if (i & 1) pk[i >> 1] |= ((unsigned)ob << 16); else pk[i >> 1] = ob;
                    v0 = v1; v1 = v2; v2 = v3; v3 = nx[i];
                }
                if (ch < 768) {
#pragma unroll
                    for (int q = 0; q < 4; ++q) { u32x4 o4; o4.x = pk[4 * q]; o4.y = pk[4 * q + 1]; o4.z = pk[4 * q + 2]; o4.w = pk[4 * q + 3]; *(u32x4*)(XT + ((size_t)b * 768 + ch) * SEQ + t0 + t8 + 8 * q) = o4; } }
            }
        } else {
            const int ch = tid;
            const bf16_t* up = u + (size_t)b * SEQ * UW + 1536 + ch;
            for (int t8 = 0; t8 < 128; t8 += 32) {
                unsigned pk[16];
#pragma unroll
                for (int i = 0; i < 32; ++i) { const unsigned ob = up[(size_t)(t0 + t8 + i) * UW]; if (i & 1) pk[i >> 1] |= (ob << 16); else pk[i >> 1] = ob; }
#pragma unroll
                for (int q = 0; q < 4; ++q) { u32x4 o4; o4.x = pk[4 * q]; o4.y = pk[4 * q + 1]; o4.z = pk[4 * q + 2]; o4.w = pk[4 * q + 3]; *(u32x4*)(VT + ((size_t)b * 512 + ch) * SEQ + t0 + t8 + 8 * q) = o4; }
            }
        }
    }
}

constexpr int MB_XT = 0, MB_BX = 256 * 272, MB_DT = MB_BX + 128 * 272, MB_CS = MB_DT + 8 * 128 * 4, MB_TOT = MB_CS + 8 * 128 * 4, MB_END = MB_TOT + 64;
static_assert(MB_END <= 131072, "mamba lds");
constexpr size_t MS_SCAN = (size_t)32 * 8192;
DEVI bf16x8 pack8(const float* v) { u32x4 w; w.x = pg8::cvt_pk_bf16(v[0], v[1]); w.y = pg8::cvt_pk_bf16(v[2], v[3]); w.z = pg8::cvt_pk_bf16(v[4], v[5]); w.w = pg8::cvt_pk_bf16(v[6], v[7]); return __builtin_bit_cast(bf16x8, w); }
DEVI void mamba_tables(LAS unsigned char* lds, const float* dtraw, const float* A_log, const float* dt_bias, int b, int g, int c, int wid, int lane) {
    LAS float* tdt = (LAS float*)(lds + MB_DT); LAS float* tcs = (LAS float*)(lds + MB_CS); LAS float* ttot = (LAS float*)(lds + MB_TOT);
    const int r = wid >> 1, dir = wid & 1, hd = 4 * g + r;
    const float A = -__expf(A_log[dir * 8 + hd]), bias = dt_bias[dir * 8 + hd];
    const size_t tk = (size_t)b * SEQ + c * 128 + 2 * lane;
    const float dt0 = softplus_f(dtraw[tk * 16 + dir * 8 + hd] + bias), dt1 = softplus_f(dtraw[(tk + 1) * 16 + dir * 8 + hd] + bias);
    const float a0 = dt0 * A, a1 = dt1 * A;
    float sc = a0 + a1;
#pragma unroll
    for (int off = 1; off < 64; off <<= 1) { const float v = __shfl_up(sc, off); if (lane >= off) sc += v; }
    const float total = __shfl(sc, 63);
    const float pre0 = sc - a1, pre1 = sc;
    const float c0 = dir ? (total - pre0 + a0) : pre0, c1 = dir ? (total - pre1 + a1) : pre1;
    tdt[wid * 128 + 2 * lane] = dt0; tdt[wid * 128 + 2 * lane + 1] = dt1;
    tcs[wid * 128 + 2 * lane] = c0; tcs[wid * 128 + 2 * lane + 1] = c1;
    if (lane == 0) ttot[wid] = total;
}
DEVI void stage_rows(LAS unsigned char* dst, const bf16_t* src, size_t src_stride, int rows, int tid) {
    for (int e = tid; e < rows * 16; e += NTHR) { const int r = e >> 4, cch = e & 15; *(LAS u32x4*)(dst + r * 272 + cch * 16) = *(const u32x4*)(src + (size_t)r * src_stride + cch * 8); }
}
DEVI void ph_mamba_states(LAS unsigned char* lds, const bf16_t* XT, const float* dtraw, const float* A_log, const float* dt_bias, float* MS, float* MD, int vb0, int vbs) {
    const int tid = opq((int)threadIdx.x), wid = __builtin_amdgcn_readfirstlane(tid >> 6), lane = tid & 63, fr = lane & 15, fq = lane >> 4;
    LAS float* tdt = (LAS float*)(lds + MB_DT); LAS float* tcs = (LAS float*)(lds + MB_CS); LAS float* ttot = (LAS float*)(lds + MB_TOT);
    for (int unit = vb0; unit < NB * 2 * 32; unit += vbs) {
        const int c = unit & 31, g = (unit >> 5) & 1, b = unit >> 6;
        __syncthreads();
        stage_rows(lds + MB_XT, XT + ((size_t)b * 768 + g * 256) * SEQ + c * 128, SEQ, 256, tid);
        stage_rows(lds + MB_BX, XT + ((size_t)b * 768 + 512 + g * 128) * SEQ + c * 128, SEQ, 128, tid);
        mamba_tables(lds, dtraw, A_log, dt_bias, b, g, c, wid, lane);
        __syncthreads();
        if (lane == 0) MD[((size_t)(b * 8 + 4 * g + (wid >> 1)) * 2 + (wid & 1)) * 32 + c] = __expf(ttot[wid]);
        for (int hdd = 0; hdd < 8; ++hdd) {
            const int r = hdd >> 1, dir = hdd & 1, hd = 4 * g + r;
            const float tot = ttot[hdd];
            f32x4 acc[4];
#pragma unroll
            for (int pt = 0; pt < 4; ++pt) acc[pt] = (f32x4){0.f, 0.f, 0.f, 0.f};
#pragma unroll
            for (int ks = 0; ks < 4; ++ks) {
                const int s0 = 32 * ks + 8 * fq;
                const u32x4 braw = *(const LAS u32x4*)(lds + MB_BX + (16 * wid + fr) * 272 + s0 * 2);
                float bw[8];
                const unsigned bu[4] = {braw.x, braw.y, braw.z, braw.w};
#pragma unroll
                for (int j = 0; j < 8; ++j) { const float bv = (j & 1) ? bfhi(bu[j >> 1]) : bflo(bu[j >> 1]);
                    bw[j] = bv * tdt[hdd * 128 + s0 + j] * __expf(tot - tcs[hdd * 128 + s0 + j]); }
                const bf16x8 Bf = pack8(bw);
#pragma unroll
                for (int pt = 0; pt < 4; ++pt) {
                    const bf16x8 Af = *(const LAS bf16x8*)(lds + MB_XT + (r * 64 + 16 * pt + fr) * 272 + s0 * 2);
                    acc[pt] = __builtin_amdgcn_mfma_f32_16x16x32_bf16(Af, Bf, acc[pt], 0, 0, 0);
                }
            }
            float* dst = MS + ((size_t)(b * 8 + hd) * 2 + dir) * MS_SCAN + (size_t)c * 8192;
#pragma unroll
            for (int pt = 0; pt < 4; ++pt)
#pragma unroll
                for (int rg = 0; rg < 4; ++rg) dst[(16 * pt + 4 * fq + rg) * 128 + 16 * wid + fr] = acc[pt][rg];
        }
    }
    __syncthreads();
}
DEVI void ph_mamba_scan(float* MS, const float* MD, int vb0, int vbs) {
    const int tid = opq((int)threadIdx.x);
    for (int idx = vb0 * NTHR + tid; idx < 64 * 2048; idx += vbs * NTHR) {
        const int scan = idx >> 11, e4 = idx & 2047; const int dir = scan & 1;
        float4* base = (float4*)(MS + (size_t)scan * MS_SCAN) + e4;
        const float* md = MD + (size_t)scan * 32;
        float4 h = make_float4(0.f, 0.f, 0.f, 0.f);
#pragma unroll 1
        for (int half = 0; half < 2; ++half) {
            const int c0 = (dir ? 1 - half : half) * 16;
            float4 d[16]; float dec[16];
#pragma unroll
            for (int i = 0; i < 16; ++i) { d[i] = base[(size_t)(c0 + i) * 2048]; dec[i] = md[c0 + i]; }
            if (dir == 0) {
#pragma unroll
                for (int i = 0; i < 16; ++i) { const float4 t = d[i]; d[i] = h; h.x = h.x * dec[i] + t.x; h.y = h.y * dec[i] + t.y; h.z = h.z * dec[i] + t.z; h.w = h.w * dec[i] + t.w; }
            } else {
#pragma unroll
                for (int i = 15; i >= 0; --i) { const float4 t = d[i]; d[i] = h; h.x = h.x * dec[i] + t.x; h.y = h.y * dec[i] + t.y; h.z = h.z * dec[i] + t.z; h.w = h.w * dec[i] + t.w; }
            }
#pragma unroll
            for (int i = 0; i < 16; ++i) base[(size_t)(c0 + i) * 2048] = d[i];
        }
    }
}
DEVI void ph_mamba_out(LAS unsigned char* lds, const bf16_t* u, const bf16_t* xconv, const bf16_t* XT, const float* dtraw, const float* A_log, const float* dt_bias, const float* Dskip, const float* b_norm,
                       const float* MS, bf16_t* ocat, int vb0, int vbs) {
    const int tid = opq((int)threadIdx.x), wid = __builtin_amdgcn_readfirstlane(tid >> 6), lane = tid & 63, fr = lane & 15, fq = lane >> 4;
    LAS float* tdt = (LAS float*)(lds + MB_DT); LAS float* tcs = (LAS float*)(lds + MB_CS);
    for (int unit = vb0; unit < NB * 2 * 32; unit += vbs) {
        const int c = unit & 31, g = (unit >> 5) & 1, b = unit >> 6;
        const size_t tok0 = (size_t)b * SEQ + c * 128;
        __syncthreads();
        stage_rows(lds + MB_XT, XT + ((size_t)b * 768 + g * 256) * SEQ + c * 128, SEQ, 256, tid);
        stage_rows(lds + MB_BX, xconv + tok0 * 1024 + 512 + g * 128, 1024, 128, tid);
        mamba_tables(lds, dtraw, A_log, dt_bias, b, g, c, wid, lane);
        const int tl = 16 * wid + fr;
        bf16x8 Cf[4];
#pragma unroll
        for (int ks = 0; ks < 4; ++ks) Cf[ks] = *(const bf16x8*)(xconv + (tok0 + tl) * 1024 + 768 + g * 128 + 32 * ks + 8 * fq);
        __syncthreads();
        f32x4 GT[8];
#pragma unroll
        for (int st = 0; st < 8; ++st) { GT[st] = (f32x4){0.f, 0.f, 0.f, 0.f};
#pragma unroll
            for (int ks = 0; ks < 4; ++ks) { const bf16x8 Af = *(const LAS bf16x8*)(lds + MB_BX + (16 * st + fr) * 272 + (32 * ks + 8 * fq) * 2);
                GT[st] = __builtin_amdgcn_mfma_f32_16x16x32_bf16(Af, Cf[ks], GT[st], 0, 0, 0); } }
        float ss = 0.f;
#pragma unroll 1
        for (int r = 0; r < 4; ++r) {
            const int hd = 4 * g + r;
            f32x4 yv[4];
#pragma unroll
            for (int pt = 0; pt < 4; ++pt) yv[pt] = (f32x4){0.f, 0.f, 0.f, 0.f};
#pragma unroll 1
            for (int dir = 0; dir < 2; ++dir) {
                const int hdd = r * 2 + dir;
                const float cst = tcs[hdd * 128 + tl];
                f32x4 yo[4];
                const float* hin = MS + ((size_t)(b * 8 + hd) * 2 + dir) * MS_SCAN + (size_t)c * 8192;
#pragma unroll
                for (int pt = 0; pt < 4; ++pt) { yo[pt] = (f32x4){0.f, 0.f, 0.f, 0.f};
#pragma unroll
                    for (int ks = 0; ks < 4; ++ks) { const float* hp = hin + (16 * pt + fr) * 128 + 32 * ks + 8 * fq;
                        const float4 h0 = *(const float4*)hp, h1 = *(const float4*)(hp + 4);
                        const float hv[8] = {h0.x, h0.y, h0.z, h0.w, h1.x, h1.y, h1.z, h1.w};
                        yo[pt] = __builtin_amdgcn_mfma_f32_16x16x32_bf16(pack8(hv), Cf[ks], yo[pt], 0, 0, 0); } }
                const float eo = __expf(cst);
#pragma unroll
                for (int pt = 0; pt < 4; ++pt) yv[pt] += yo[pt] * eo;
#pragma unroll
                for (int kp = 0; kp < 4; ++kp) {
                    const bool skip = dir ? (2 * kp + 1 < wid) : (2 * kp > wid);
                    if (!skip) {
                        float pv[8];
#pragma unroll
                        for (int hlf = 0; hlf < 2; ++hlf)
#pragma unroll
                            for (int rg = 0; rg < 4; ++rg) { const int st = 2 * kp + hlf, sl = 16 * st + 4 * fq + rg;
                                const bool ok = dir ? (sl >= tl) : (sl <= tl);
                                const float e = __expf(fminf(cst - tcs[hdd * 128 + sl], 0.f));
                                pv[hlf * 4 + rg] = ok ? GT[st][rg] * e * tdt[hdd * 128 + sl] : 0.f; }
                        const bf16x8 Pf = pack8(pv);
#pragma unroll
                        for (int pt = 0; pt < 4; ++pt) {
                            const LAS unsigned char* xr = lds + MB_XT + (r * 64 + 16 * pt + fr) * 272;
                            const u32x2 x0 = *(const LAS u32x2*)(xr + (32 * kp + 4 * fq) * 2), x1 = *(const LAS u32x2*)(xr + (32 * kp + 16 + 4 * fq) * 2);
                            u32x4 xa; xa.x = x0.x; xa.y = x0.y; xa.z = x1.x; xa.w = x1.y;
                            yv[pt] = __builtin_amdgcn_mfma_f32_16x16x32_bf16(__builtin_bit_cast(bf16x8, xa), Pf, yv[pt], 0, 0, 0);
                        }
                    }
                }
            }
            const float Dk = Dskip[hd];
#pragma unroll
            for (int pt = 0; pt < 4; ++pt) {
                const int p0 = 16 * pt + 4 * fq;
                const u32x2 xr = *(const u32x2*)(xconv + (tok0 + tl) * 1024 + hd * 64 + p0);
                const u32x2 zr = *(const u32x2*)(u + (tok0 + tl) * UW + 2560 + hd * 64 + p0);
                const float xs[4] = {bflo(xr.x), bfhi(xr.x), bflo(xr.y), bfhi(xr.y)}, zs[4] = {bflo(zr.x), bfhi(zr.x), bflo(zr.y), bfhi(zr.y)};
                float yy[4];
#pragma unroll
                for (int rg = 0; rg < 4; ++rg) { const float y = (yv[pt][rg] + Dk * xs[rg]) * silu_f(zs[rg]); yy[rg] = y; ss += y * y; }
                const unsigned long long o = (unsigned long long)pk2(yy[0], yy[1]) | ((unsigned long long)pk2(yy[2], yy[3]) << 32);
                __hip_atomic_store((unsigned long long*)(ocat + (tok0 + tl) * DM + 512 + g * 256 + r * 64 + p0), o, __ATOMIC_RELAXED, __HIP_MEMORY_SCOPE_AGENT);
            }
        }
        ss += __shfl_xor(ss, 16); ss += __shfl_xor(ss, 32);
        const float rn = rsqrtf(ss * (1.f / 256.f) + EPS);
        asm volatile("s_waitcnt vmcnt(0)" ::: "memory");
#pragma unroll 1
        for (int r = 0; r < 4; ++r)
#pragma unroll
            for (int pt = 0; pt < 4; ++pt) {
                const int cc = g * 256 + r * 64 + 16 * pt + 4 * fq;
                unsigned long long* op = (unsigned long long*)(ocat + (tok0 + tl) * DM + 512 + cc);
                const unsigned long long v = __hip_atomic_load(op, __ATOMIC_RELAXED, __HIP_MEMORY_SCOPE_AGENT);
                const unsigned vlo = (unsigned)v, vhi = (unsigned)(v >> 32);
                const float4 bn = *(const float4*)(b_norm + cc);
                const unsigned long long o = (unsigned long long)pk2(bflo(vlo) * rn * bn.x, bfhi(vlo) * rn * bn.y) | ((unsigned long long)pk2(bflo(vhi) * rn * bn.z, bfhi(vhi) * rn * bn.w) << 32);
                *op = o;
            }
    }
    __syncthreads();
}


constexpr int NA_VT = 0, NA_VSTRIDE = 9 * 64 * 2 + 16, NA_BIAS = 64 * NA_VSTRIDE, NA_END = NA_BIAS + 480 * 4;
static_assert(NA_END <= 131072, "na lds");
DEVI void ph_na(LAS unsigned char* lds, const bf16_t* qkv, const float* rpb, bf16_t* oc, int vb0, int vbs) {
    const int tid = opq((int)threadIdx.x), wid = __builtin_amdgcn_readfirstlane(tid >> 6), lane = tid & 63, fr = lane & 15, fq = lane >> 4;
    LAS float* bl = (LAS float*)(lds + NA_BIAS);
    for (int unit = vb0; unit < NB * 16 * 32; unit += vbs) {
        const int rp = unit & 31, h = (unit >> 5) & 15, b = unit >> 9;
        const int r0 = 2 * rp, rs0 = min(max(r0 - 4, 0), 56);
        __syncthreads();
        for (int e = tid; e < 465; e += NTHR) bl[e] = rpb[h * 465 + e];
        for (int task = wid; task < 72; task += 8) {
            const int krow = task >> 3, ch = task & 7, kr = rs0 + krow;
            if (kr < 64) {
                const u32x4 v = *(const u32x4*)(qkv + ((size_t)b * SEQ + kr * 64 + lane) * 3072 + 2048 + h * 64 + ch * 8);
                const unsigned vw[4] = {v.x, v.y, v.z, v.w};
#pragma unroll
                for (int i = 0; i < 8; ++i) *(LAS bf16_t*)(lds + NA_VT + (ch * 8 + i) * NA_VSTRIDE + (krow * 64 + lane) * 2) = (bf16_t)((i & 1) ? (vw[i >> 1] >> 16) : (vw[i >> 1] & 0xffffu));
            }
        }
        __syncthreads();
        const int r = r0 + (wid >> 2), j = wid & 3;
        const int rs = min(max(r - 4, 0), 56), roff = rs - rs0;
        const int bs = (j == 0) ? 0 : (j == 1) ? 8 : (j == 2) ? 24 : 32;
        const int c = 16 * j + fr, qs = min(max(c - 8, 0), 48);
        const size_t qtok = (size_t)b * SEQ + r * 64 + c;
        bf16x8 Qf[2];
#pragma unroll
        for (int ks = 0; ks < 2; ++ks) Qf[ks] = *(const bf16x8*)(qkv + qtok * 3072 + h * 64 + 32 * ks + 8 * fq);
        const bf16_t* kbase = qkv + ((size_t)b * SEQ + rs * 64 + bs + fr) * 3072 + 1024 + h * 64 + 8 * fq;
        bf16x8 kn[4];
#pragma unroll
        for (int q = 0; q < 4; ++q) kn[q] = *(const bf16x8*)(kbase + (size_t)((q >> 1) * 16) * 3072 + (q & 1) * 32);
        f32x4 O[4];
#pragma unroll
        for (int dt = 0; dt < 4; ++dt) O[dt] = (f32x4){0.f, 0.f, 0.f, 0.f};
        float mrun = -1e30f, lrun = 0.f;
#pragma unroll 1
        for (int dr = 0; dr < 8; ++dr) {
            bf16x8 kc[4];
#pragma unroll
            for (int q = 0; q < 4; ++q) kc[q] = kn[q];
            const int drn = dr < 7 ? dr + 1 : 7;
#pragma unroll
            for (int q = 0; q < 4; ++q) kn[q] = *(const bf16x8*)(kbase + ((size_t)drn * 64 + (q >> 1) * 16) * 3072 + (q & 1) * 32);
            float sv[8]; float mloc = -1e30f;
            const LAS float* brow = bl + (rs + dr - r + 7) * 31;
#pragma unroll
            for (int kg = 0; kg < 2; ++kg) {
                f32x4 acc = {0.f, 0.f, 0.f, 0.f};
                acc = __builtin_amdgcn_mfma_f32_16x16x32_bf16(kc[kg * 2], Qf[0], acc, 0, 0, 0);
                acc = __builtin_amdgcn_mfma_f32_16x16x32_bf16(kc[kg * 2 + 1], Qf[1], acc, 0, 0, 0);
#pragma unroll
                for (int rg = 0; rg < 4; ++rg) {
                    const int kcol = bs + 16 * kg + 4 * fq + rg;
                    const bool ok = (kcol >= qs) && (kcol < qs + 16);
                    const int dc = min(max(kcol - c + 15, 0), 30);
                    const float sc = ok ? acc[rg] * 0.125f + brow[dc] : -1e30f;
                    sv[kg * 4 + rg] = sc; mloc = fmaxf(mloc, sc);
                }
            }
            mloc = fmaxf(mloc, __shfl_xor(mloc, 16)); mloc = fmaxf(mloc, __shfl_xor(mloc, 32));
            const float mnew = fmaxf(mrun, mloc);
            const float alpha = __expf(mrun - mnew);
            float psum = 0.f;
#pragma unroll
            for (int i = 0; i < 8; ++i) { const float p = __expf(sv[i] - mnew); sv[i] = p; psum += p; }
            psum += __shfl_xor(psum, 16); psum += __shfl_xor(psum, 32);
            lrun = lrun * alpha + psum; mrun = mnew;
            const bf16x8 Pf = pack8(sv);
            const int koff = ((roff + dr) * 64 + bs + 4 * fq) * 2;
#pragma unroll
            for (int dt = 0; dt < 4; ++dt) {
                const LAS unsigned char* vr = lds + NA_VT + (16 * dt + fr) * NA_VSTRIDE + koff;
                const u32x2 v0 = *(const LAS u32x2*)vr, v1 = *(const LAS u32x2*)(vr + 32);
                u32x4 va; va.x = v0.x; va.y = v0.y; va.z = v1.x; va.w = v1.y;
                O[dt] = __builtin_amdgcn_mfma_f32_16x16x32_bf16(__builtin_bit_cast(bf16x8, va), Pf, O[dt] * alpha, 0, 0, 0);
            }
        }
        const float il = 1.f / lrun;
#pragma unroll
        for (int dt = 0; dt < 4; ++dt) {
            u32x2 o; o.x = pk2(O[dt][0] * il, O[dt][1] * il); o.y = pk2(O[dt][2] * il, O[dt][3] * il);
            *(u32x2*)(oc + qtok * DM + h * 64 + 16 * dt + 4 * fq) = o;
        }
    }
    __syncthreads();
}

DEVI void ph_na_naive(const bf16_t* qkv, const float* rpb, bf16_t* oc, int vb0, int vbs) {
    for (int e4 = vb0 * NTHR + opq((int)threadIdx.x); e4 < MT * 16 * 4; e4 += vbs * NTHR) {
        const int dq = e4 & 3, e = e4 >> 2;
        const int hd = e / MT, tok = e % MT;
        const int b = tok >> 12, t = tok & 4095, r = t >> 6, c = t & 63;
        const int rs = min(max(r - 4, 0), 56), qs = min(max(c - 8, 0), 48);
        float q[16], o[16];
        const bf16_t* qp = qkv + (size_t)tok * 3072 + hd * 64 + dq * 16;
#pragma unroll
        for (int d = 0; d < 16; ++d) { q[d] = bf2f(qp[d]); o[d] = 0.f; }
        float m = -1e30f, l = 0.f;
        for (int dr = 0; dr < 8; ++dr)
            for (int dc = 0; dc < 16; ++dc) {
                const int kr = rs + dr, kc = qs + dc;
                const size_t kt = (size_t)b * SEQ + kr * 64 + kc;
                const bf16_t* kp = qkv + kt * 3072 + 1024 + hd * 64 + dq * 16;
                const bf16_t* vp = qkv + kt * 3072 + 2048 + hd * 64 + dq * 16;
                float s = 0.f;
#pragma unroll
                for (int d = 0; d < 16; ++d) s += q[d] * bf2f(kp[d]);
                s += __shfl_xor(s, 1); s += __shfl_xor(s, 2);
                s = s * 0.125f + rpb[hd * 465 + (kr - r + 7) * 31 + (kc - c + 15)];
                const float mn = fmaxf(m, s); const float al = __expf(m - mn), pe = __expf(s - mn);
                l = l * al + pe; m = mn;
#pragma unroll
                for (int d = 0; d < 16; ++d) o[d] = o[d] * al + pe * bf2f(vp[d]);
            }
        const float il = 1.f / l;
        bf16_t* op = oc + (size_t)tok * DM + hd * 64 + dq * 16;
#pragma unroll
        for (int d = 0; d < 16; ++d) op[d] = f2bf(o[d] * il);
    }
}

#define XB_TMO      128
#define XB_XCNT(j)  (256  + 64 * (j))
#define XB_XSUB(j)  (1280 + 64 * (j))
#define XB_XGEN(j)  (2304 + 64 * (j))
#define XB_TOP      3328
#define XB_TOPGEN   3392
#define XCD_BAR_WORDS 3456
#define XB_SPIN_CAP (1u << 18)

__device__ __forceinline__ unsigned xb_ld(unsigned* p)              { return __hip_atomic_load(p, __ATOMIC_RELAXED, __HIP_MEMORY_SCOPE_AGENT); }
__device__ __forceinline__ unsigned xb_add(unsigned* p, unsigned v) { return __hip_atomic_fetch_add(p, v, __ATOMIC_RELAXED, __HIP_MEMORY_SCOPE_AGENT); }
__device__ __forceinline__ unsigned xb_xcc_id() { return (unsigned)__builtin_amdgcn_s_getreg((3 << 11) | 20) & 0xFu; }
#define XB_SPIN(cond, bar) do { unsigned _sp = 0; while (cond) { __builtin_amdgcn_s_sleep(1); \
    if ((++_sp & 255u) == 0u) { if (xb_ld(&(bar)[XB_TMO])) break; if (_sp > XB_SPIN_CAP) { atomicAdd(&(bar)[XB_TMO], 1u); break; } } } } while (0)

struct XcdBarrier {
    unsigned* bar; unsigned x;
    volatile LAS unsigned* st;
};

__device__ __forceinline__ XcdBarrier xcd_barrier_post(unsigned* bar, volatile LAS unsigned* st) {
    XcdBarrier b; b.bar = bar; b.x = xb_xcc_id(); b.st = st;
    if (threadIdx.x == 0) (void)xb_add(&bar[XB_XCNT(b.x)], 1u);
    return b;
}
__device__ __forceinline__ void xcd_barrier_complete(unsigned* bar, unsigned x, unsigned& nloc, unsigned& nx) {
    const unsigned G = gridDim.x * gridDim.y * gridDim.z;
    unsigned sum, cnt, mine, sp = 0u;
    for (;;) {
        sum = 0u; cnt = 0u; mine = 0u;
#pragma unroll
        for (unsigned j = 0; j < 16; ++j) { const unsigned c = xb_ld(&bar[XB_XCNT(j)]); sum += c; cnt += (c > 0u) ? 1u : 0u; mine = (j == x) ? c : mine; }
        if (sum == G) break;
        __builtin_amdgcn_s_sleep(1);
        if ((++sp & 255u) == 0u) { if (xb_ld(&bar[XB_TMO])) break; if (sp > XB_SPIN_CAP) { atomicAdd(&bar[XB_TMO], 1u); break; } }
    }
    nloc = mine > 0u ? mine : 1u; nx = cnt > 0u ? cnt : 1u;
}

__device__ __forceinline__ void xcd_barrier(const XcdBarrier& b) {
    asm volatile("s_waitcnt vmcnt(0)" ::: "memory");
    __syncthreads();
    if (threadIdx.x == 0) {
        unsigned* bar = b.bar;
        __builtin_amdgcn_s_waitcnt(0);
        unsigned nloc = b.st[0], nx = b.st[1];
        if (nloc == 0u) { xcd_barrier_complete(bar, b.x, nloc, nx); b.st[0] = nloc; b.st[1] = nx; }
        const unsigned old = xb_add(&bar[XB_XSUB(b.x)], 1u);
        const unsigned gen = old / nloc;
        if (old + 1u == (gen + 1u) * nloc) {
            __builtin_amdgcn_fence(__ATOMIC_RELEASE, "agent");
            asm volatile("s_waitcnt vmcnt(0)" ::: "memory");
            const unsigned og = xb_add(&bar[XB_TOP], 1u);
            const unsigned tg = og / nx;
            if (og + 1u == (tg + 1u) * nx) xb_add(&bar[XB_TOPGEN], 1u);
            else XB_SPIN(xb_ld(&bar[XB_TOPGEN]) == tg, bar);
            __builtin_amdgcn_fence(__ATOMIC_ACQUIRE, "agent");
            xb_add(&bar[XB_XGEN(b.x)], 1u);
            asm volatile("s_waitcnt vmcnt(0)" ::: "memory");
        } else {
            XB_SPIN(xb_ld(&bar[XB_XGEN(b.x)]) == gen, bar);
            __builtin_amdgcn_fence(__ATOMIC_ACQUIRE, "agent");
            asm volatile("s_waitcnt vmcnt(0)" ::: "memory");
        }
    }
    __syncthreads();
}


struct Args { const float* in[34]; float* out; unsigned char* ws; int ph_lo, ph_hi; };
constexpr int N_PHASES = 22;

__global__ void __launch_bounds__(NTHR, 2) fwd(Args a) {
    extern __shared__ __attribute__((aligned(16))) unsigned char lds_raw[];
    float* lds = (float*)lds_raw;
    LAS unsigned char* ldsl = (LAS unsigned char*)lds_raw;
    const int vb0 = blockIdx.x, vbs = gridDim.x;
    const int lo = a.ph_lo, hi = a.ph_hi;
#define IN(k) (lo <= (k) && (k) < hi)
#define SEAM(k) do { if (IN(k) && IN((k) + 1)) xcd_barrier(bar); } while (0)
    volatile LAS unsigned* misc = (volatile LAS unsigned*)(ldsl + MISC_OFF);
    if (threadIdx.x < 4) misc[threadIdx.x] = 0u;
    __syncthreads();
    XcdBarrier bar = xcd_barrier_post((unsigned*)(a.ws + WS_CTL) + CW_BAR, misc);
    unsigned char* ws = a.ws;
    unsigned* ctl = (unsigned*)(ws + WS_CTL);
    unsigned* cnt = ctl + CW_CNT;
    int* list = (int*)(ws + WS_LIST); float* gatev = (float*)(ws + WS_GATE);
    float* dtraw = (float*)(ws + WS_DT); float* RS = (float*)(ws + WS_RS);
    bf16_t* XB = (bf16_t*)(ws + WS_XB); bf16_t* UB = (bf16_t*)(ws + WS_UB);
    bf16_t* YA = (bf16_t*)(ws + WS_YA); float* OF = (float*)(ws + WS_OF); bf16_t* OC = (bf16_t*)(ws + WS_OC);
    bf16_t* YP = (bf16_t*)(ws + WS_YP); bf16_t* YP1 = (bf16_t*)(ws + WS_YP1); bf16_t* XC = (bf16_t*)(ws + WS_YP);
    bf16_t* PB0 = (bf16_t*)(ws + WS_PB0); bf16_t* PB1 = (bf16_t*)(ws + WS_PB1);
    bf16_t* YB = (bf16_t*)(ws + WS_Y);
    float* MS = (float*)(ws + WS_MS); float* MD = (float*)(ws + WS_MD);
    float* HS = (float*)(ws + WS_HS); float* HD = (float*)(ws + WS_HD);
    bf16_t* XT = (bf16_t*)(ws + WS_XT); bf16_t* VT = (bf16_t*)(ws + WS_VT);
    const float* p_in = a.in[1];
    const int G = (int)gridDim.x, cb = (int)blockIdx.x;
    const NormB NB0{nullptr, XB, nullptr, nullptr, RS, nullptr, nullptr, nullptr, nullptr, nullptr, nullptr, nullptr, nullptr, nullptr, nullptr};
    unsigned char* XG8 = ws + WS_XG8;
    float* rsl = (float*)(ws + WS_DT);

    if (IN(0)) {
        ph_convert_weights(ldsl, a.in, ws, 0, ITEMS_DENSE, vb0, vbs);
        NormB A = NB0; A.xin = a.in[0]; A.gnext = a.in[3]; A.win = a.in[4]; A.dtraw = dtraw;
        ph_norm2<0, false, true, false>(A, vb0, vbs);
    }
    SEAM(0);
    if (IN(1)) { pg8::DenseOrder S; S.init(MT, UW, DM, (const bf16_t*)(ws + W_IN), G, cb); pg8::gemm_phase(ldsl, XB, DM, S, pg8::EpiBf16{UB, UW, RS}); }
    SEAM(1);
    if (IN(2)) { ph_prep(UB, a.in[5], a.in[6], XC, XT, VT, vb0, vbs); }
    SEAM(2);
    if (IN(3)) { ph_hgrn_states(ldsl, UB, VT, a.in[2], HS, HD, vb0, vbs); ph_mamba_states(ldsl, XT, dtraw, a.in[7], a.in[8], MS, MD, vb0, vbs); }
    SEAM(3);
    if (IN(4)) { ph_hgrn_scan(HS, HD, vb0, vbs); ph_mamba_scan(MS, MD, vb0, vbs); }
    SEAM(4);
    if (IN(5)) { ph_hgrn_out(ldsl, UB, VT, a.in[2], a.in[10], HS, OF, OC, vb0, vbs); ph_mamba_out(ldsl, UB, XC, XT, dtraw, a.in[7], a.in[8], a.in[9], a.in[11], MS, OC, vb0, vbs); }
    SEAM(5);
    if (IN(6)) { pg8::DenseOrder S; S.init(MT, DM, DM, (const bf16_t*)(ws + W_OUTE), G, cb); pg8::gemm_phase(ldsl, OC, DM, S, pg8::EpiBf16{YA, DM, nullptr}); }
    SEAM(6);
    if (IN(7)) {
        NormB A = NB0; A.y = YA; A.gpost = a.in[13];
        ph_norm2<1, false, false, false>(A, vb0, vbs);
        ph_cvt_rows(p_in, PB0, (size_t)MT * PDIM / 4, vb0, vbs);
        ph_convert_weights(ldsl, a.in, ws, ITEMS_DENSE, ITEMS_ALL, vb0, vbs);
    }
    SEAM(7);
    if (IN(8)) {
        { pg8::DenseOrder S; S.init(MT, 2 * DFF, DM, (const bf16_t*)(ws + W_GU), G, cb); pg8::gemm_phase(ldsl, XB, DM, S, pg8::EpiSwiglu{UB, DFF, RS, 0}); }
        { pg8::TailOrder S; S.init(MT, DM, PDIM, (const bf16_t*)(ws + W_PP), G, cb, (MT / 256) * (2 * DFF / 256) % G); pg8::gemm_phase(ldsl, PB0, PDIM, S, pg8::EpiBf16{YP, DM, nullptr}); }
    }
    SEAM(8);
    if (IN(9)) { pg8::DenseOrder S; S.init(MT, DM, DFF, (const bf16_t*)(ws + W_DN), G, cb); pg8::gemm_phase(ldsl, UB, DFF, S, pg8::EpiBf16{YA, DM, nullptr}); }
    SEAM(9);
    if (IN(10)) {
        NormB A = NB0; A.y = YA; A.gpost = a.in[18];
        ph_norm2<1, false, false, false>(A, vb0, vbs);
    }
    SEAM(10);
    if (IN(11)) { pg8::DenseOrder S; S.init(MT, DM, DM, (const bf16_t*)(ws + W_PG), G, cb); pg8::gemm_phase(ldsl, XB, DM, S, pg8::EpiPleGate{YP, DM, RS}); }
    SEAM(11);
    if (IN(12)) {
        NormB A = NB0; A.y = YP; A.gpost = a.in[33];
        ph_norm2<1, false, false, false>(A, vb0, vbs);
    }
    SEAM(12);
    if (IN(13)) { pg8::DenseOrder S; S.init(MT, 3072, DM, (const bf16_t*)(ws + W_QKV), G, cb); pg8::gemm_phase(ldsl, XB, DM, S, pg8::EpiBf16{UB, 3072, RS}); }
    SEAM(13);
    if (IN(14)) { ph_na(ldsl, UB, a.in[21], OC, vb0, vbs); }
    SEAM(14);
    if (IN(15)) { pg8::DenseOrder S; S.init(MT, DM, DM, (const bf16_t*)(ws + W_OUTO), G, cb); pg8::gemm_phase(ldsl, OC, DM, S, pg8::EpiBf16{YP1, DM, nullptr}); }
    SEAM(15);
    if (IN(16)) {
        NormB A = NB0; A.y = YP1; A.gpost = a.in[23]; A.gnext = a.in[24]; A.wr = a.in[25]; A.cnt = cnt; A.list = list; A.gatev = gatev; A.rsl = rsl; A.x8 = XG8;
        ph_norm2<1, false, false, true>(A, vb0, vbs);
        ph_cvt_rows(p_in + (size_t)MT * PDIM, PB1, (size_t)MT * PDIM / 4, vb0, vbs);
    }
    SEAM(16);
    if (IN(17)) { pg8::MoeOrder S; S.init(cnt, (volatile LAS int*)(ldsl + MISC_OFF + 64), 2 * DFFE, DM / 2, (const bf16_t*)(ws + W_EGU), (size_t)7 * MiB, true, G, cb);
        pg8::gemm_phase<pg8::EpiSwiglu8, pg8::MoeOrder, true>(ldsl, (const bf16_t*)XG8, DM / 2, S, pg8::EpiSwiglu8{(unsigned char*)UB, DFFE, rsl}); }
    SEAM(17);
    if (IN(18)) { pg8::MoeOrder S; S.init(cnt, (volatile LAS int*)(ldsl + MISC_OFF + 64), DM, DFFE / 2, (const bf16_t*)(ws + W_EDN), (size_t)(7 * MiB / 2), false, G, cb);
        pg8::gemm_phase<pg8::EpiMoeDown, pg8::MoeOrder, true>(ldsl, UB, DFFE / 2, S, pg8::EpiMoeDown{YB, list, gatev, 1.f / (pg8::W8_SCALE * pg8::ACT8_SCALE)});
        { pg8::TailOrder T; T.init(MT, DM, PDIM, (const bf16_t*)(ws + W_PP + 512 * 1024), G, cb, S.nwg % G); pg8::gemm_phase(ldsl, PB1, PDIM, T, pg8::EpiBf16{YP, DM, nullptr}); } }
    SEAM(18);
    if (IN(19)) {
        NormB A = NB0; A.y = YB; A.gpost = a.in[29];
        ph_norm2<2, false, false, false>(A, vb0, vbs);
    }
    SEAM(19);
    if (IN(20)) { pg8::DenseOrder S; S.init(MT, DM, DM, (const bf16_t*)(ws + W_PG + 2 * MiB), G, cb); pg8::gemm_phase(ldsl, XB, DM, S, pg8::EpiPleGate{YP, DM, RS}); }
    SEAM(20);
    if (IN(21)) {
        NormB A = NB0; A.y = YP; A.gpost = a.in[33] + DM; A.xout = a.out;
        ph_norm2<1, true, false, false>(A, vb0, vbs);
    }
#undef IN
#undef SEAM
}

extern "C" void kernel_launch(void* const* d_in, const int* in_sizes, int n_in, void* d_out, int out_size, void* d_ws, size_t ws_size, hipStream_t stream) {
    static int grid = 0;
    if (grid == 0) {
        if (n_in != 34 || out_size != MT * DM || ws_size < WS_END) { fprintf(stderr, "kernel_launch: unexpected shapes n_in %d out %d ws %zu (need %zu)\n", n_in, out_size, ws_size, (size_t)WS_END); grid = -1; return; }
        int dev = 0, cus = 0;
        if (hipGetDevice(&dev) != hipSuccess || hipDeviceGetAttribute(&cus, hipDeviceAttributeMultiprocessorCount, dev) != hipSuccess) { grid = -1; return; }
        if (hipFuncSetAttribute((const void*)fwd, hipFuncAttributeMaxDynamicSharedMemorySize, LDS_BYTES) != hipSuccess) { fprintf(stderr, "hipFuncSetAttribute failed\n"); grid = -1; return; }
        (void)hipGetLastError();
        grid = cus;
    }
    if (grid < 0) return;
    (void)hipMemsetAsync((char*)d_ws + WS_CTL, 0, CTL_ZERO_BYTES, stream);
    Args a{};
    for (int i = 0; i < 34; ++i) a.in[i] = (const float*)d_in[i];
    a.out = (float*)d_out; a.ws = (unsigned char*)d_ws;
#ifndef MK_PER_PHASE
    a.ph_lo = 0; a.ph_hi = N_PHASES;
    hipLaunchKernelGGL(fwd, dim3(grid), dim3(NTHR), LDS_BYTES, stream, a);
#else
    for (int ph = 0; ph < N_PHASES; ++ph) {
        a.ph_lo = ph; a.ph_hi = ph + 1;
        hipLaunchKernelGGL(fwd, dim3(grid), dim3(NTHR), LDS_BYTES, stream, a);
    }
#endif
}
```

```cpp
#include <hip/hip_runtime.h>
#include <stdint.h>
#include <stdio.h>

#define DEVI __device__ __forceinline__
#define LAS __attribute__((address_space(3)))
typedef unsigned short bf16_t;

constexpr int NB = 4, SEQ = 4096, DM = 1024, MT = NB * SEQ;
constexpr int EVEN_IN = 4112, UW = 4096, DFF = 2816, NEXP = 8, DFFE = 3584, PDIM = 256;
constexpr float EPS = 1e-6f;
constexpr int NTHR = 512;
constexpr int LDS_BYTES = 147456;
constexpr int MISC_OFF = 131072 + 320;
constexpr int MOE_ROWS = 2 * MT + NEXP * 256;

constexpr size_t MiB = 1u << 20;
constexpr size_t WS_CTL = 0, CTL_ZERO_BYTES = 1 * MiB;
constexpr size_t WS_LIST = 1 * MiB;
constexpr size_t WS_GATE = WS_LIST + 512 * 1024;
constexpr size_t WS_DT = 2 * MiB;
constexpr size_t WS_W = 3 * MiB;
constexpr size_t W_IN = WS_W, W_OUTE = W_IN + 8 * MiB, W_GU = W_OUTE + 2 * MiB, W_DN = W_GU + 11 * MiB, W_PG = W_DN + 6 * MiB, W_PP = W_PG + 4 * MiB,
                 W_QKV = W_PP + 1 * MiB, W_OUTO = W_QKV + 6 * MiB, W_EGU = W_OUTO + 2 * MiB, W_EDN = W_EGU + 112 * MiB, W_END = W_EDN + 56 * MiB;
constexpr size_t WS_XB = W_END;
constexpr size_t WS_R = WS_XB + 32 * MiB;
constexpr size_t WS_UB = WS_R;
constexpr size_t WS_PB0 = WS_R + 88 * MiB;
constexpr size_t WS_YA = WS_R + 128 * MiB;
constexpr size_t WS_OF = WS_R + 160 * MiB;
constexpr size_t WS_OC = WS_R + 192 * MiB;
constexpr size_t WS_YP = WS_R + 224 * MiB;
constexpr size_t WS_YP1 = WS_R;
constexpr size_t WS_PB1 = W_EDN + 32 * MiB;
constexpr size_t WS_XG8 = WS_R + 120 * MiB;
constexpr size_t WS_END = WS_R + 256 * MiB;
constexpr size_t WS_Y = W_EGU;
constexpr size_t WS_MS = W_EGU;
constexpr size_t WS_HS = W_EGU + 64 * MiB;
constexpr size_t WS_XT = W_EDN;
constexpr size_t WS_VT = W_EDN + 24 * MiB;
constexpr size_t WS_MD = W_EDN + 40 * MiB;
constexpr size_t WS_HD = W_EDN + 41 * MiB;
static_assert(WS_R + (size_t)MOE_ROWS * DFFE <= WS_XG8 && WS_XG8 + 128 * MiB <= WS_END && WS_END <= 510 * MiB, "ws map");
constexpr size_t WS_RS = WS_CTL + 512 * 1024;
constexpr int CW_CNT = 64;
constexpr int CW_BAR = 4096;

DEVI int opq(int x) { asm volatile("" : "+v"(x)); return x; }
DEVI float bf2f(bf16_t b) { return __uint_as_float(((unsigned)b) << 16); }
DEVI unsigned cvt2bf(float lo, float hi) { unsigned r; asm("v_cvt_pk_bf16_f32 %0, %1, %2" : "=v"(r) : "v"(lo), "v"(hi)); return r; }
DEVI bf16_t f2bf(float f) { return (bf16_t)(cvt2bf(f, 0.f) & 0xffffu); }
DEVI float silu_f(float x) { return x * __builtin_amdgcn_rcpf(1.f + __builtin_amdgcn_exp2f(-1.44269504f * x)); }
DEVI float sigmoid_f(float x) { return __builtin_amdgcn_rcpf(1.f + __builtin_amdgcn_exp2f(-1.44269504f * x)); }
DEVI float softplus_f(float x) { return x > 20.f ? x : log1pf(__expf(x)); }
DEVI float wave_sum(float v) {
#pragma unroll
    for (int o = 1; o < 64; o <<= 1) v += __shfl_xor(v, o);
    return v;
}


typedef short bf16x8 __attribute__((ext_vector_type(8)));
typedef float f32x4 __attribute__((ext_vector_type(4)));
typedef unsigned u32x4 __attribute__((ext_vector_type(4)));
typedef unsigned u32x2 __attribute__((ext_vector_type(2)));
DEVI unsigned pk2(float lo, float hi) { return cvt2bf(lo, hi); }
DEVI float bflo(unsigned w) { return __uint_as_float(w << 16); }
DEVI float bfhi(unsigned w) { return __uint_as_float(w & 0xffff0000u); }

DEVI unsigned pg8_pk4(float a, float b, float c, float d) {
    a = __builtin_amdgcn_fmed3f(a, -448.f, 448.f); b = __builtin_amdgcn_fmed3f(b, -448.f, 448.f); c = __builtin_amdgcn_fmed3f(c, -448.f, 448.f); d = __builtin_amdgcn_fmed3f(d, -448.f, 448.f);
    int p = __builtin_amdgcn_cvt_pk_fp8_f32(a, b, 0, false); p = __builtin_amdgcn_cvt_pk_fp8_f32(c, d, p, true); return (unsigned)p; }
struct NormB { const float* xin; bf16_t* XB; const bf16_t* y; const float* gpost; float* rs; const float* gnext;
               const float* win; float* dtraw; const float* wr; unsigned* cnt; int* list; float* gatev; float* rsl; float* xout; unsigned char* x8; };
DEVI void unpack8(const u32x4 w, float* v) { v[0] = bflo(w.x); v[1] = bfhi(w.x); v[2] = bflo(w.y); v[3] = bfhi(w.y); v[4] = bflo(w.z); v[5] = bfhi(w.z); v[6] = bflo(w.w); v[7] = bfhi(w.w); }
template <int YMODE, bool FINAL, bool DT, bool ROUTE>
DEVI void ph_norm2(const NormB& A, int vb0, int vbs) {
    const int tidq = opq((int)threadIdx.x); const int wid = tidq >> 6, lane = tidq & 63;
    constexpr int R = (DT || ROUTE) ? 2 : 4;
    for (int row0 = (vb0 * 8 + wid) * R; row0 < MT; row0 += vbs * 8 * R) {
        float xv[R][16]; float yv[R][16];
#pragma unroll
        for (int rr = 0; rr < R; ++rr) {
            const size_t ro = (size_t)(row0 + rr) * DM + lane * 8;
            if (YMODE == 0) {
#pragma unroll
                for (int i = 0; i < 2; ++i) { const float4 p0 = *(const float4*)(A.xin + ro + i * 512), p1 = *(const float4*)(A.xin + ro + i * 512 + 4);
                    xv[rr][i * 8 + 0] = p0.x; xv[rr][i * 8 + 1] = p0.y; xv[rr][i * 8 + 2] = p0.z; xv[rr][i * 8 + 3] = p0.w; xv[rr][i * 8 + 4] = p1.x; xv[rr][i * 8 + 5] = p1.y; xv[rr][i * 8 + 6] = p1.z; xv[rr][i * 8 + 7] = p1.w; }
            } else {
#pragma unroll
                for (int i = 0; i < 2; ++i) {
                    unpack8(*(const u32x4*)(A.XB + ro + i * 512), xv[rr] + i * 8);
                    unpack8(*(const u32x4*)(A.y + ro + i * 512), yv[rr] + i * 8);
                    if (YMODE == 2) { float y2[8]; unpack8(*(const u32x4*)(A.y + (size_t)MT * DM + ro + i * 512), y2);
#pragma unroll
                        for (int j = 0; j < 8; ++j) yv[rr][i * 8 + j] += y2[j]; }
                }
            }
        }
        if (YMODE != 0) {
            float gg[16];
#pragma unroll
            for (int i = 0; i < 2; ++i) { const float4 g0 = *(const float4*)(A.gpost + i * 512 + lane * 8), g1 = *(const float4*)(A.gpost + i * 512 + lane * 8 + 4);
                gg[i * 8 + 0] = g0.x; gg[i * 8 + 1] = g0.y; gg[i * 8 + 2] = g0.z; gg[i * 8 + 3] = g0.w; gg[i * 8 + 4] = g1.x; gg[i * 8 + 5] = g1.y; gg[i * 8 + 6] = g1.z; gg[i * 8 + 7] = g1.w; }
            float ss[R];
#pragma unroll
            for (int rr = 0; rr < R; ++rr) { ss[rr] = 0.f;
#pragma unroll
                for (int j = 0; j < 16; ++j) ss[rr] += yv[rr][j] * yv[rr][j]; }
#pragma unroll
            for (int o = 1; o < 64; o <<= 1)
#pragma unroll
                for (int rr = 0; rr < R; ++rr) ss[rr] += __shfl_xor(ss[rr], o);
#pragma unroll
            for (int rr = 0; rr < R; ++rr) { const float r = rsqrtf(ss[rr] * (1.f / DM) + EPS);
#pragma unroll
                for (int j = 0; j < 16; ++j) xv[rr][j] += yv[rr][j] * r * gg[j]; }
        }
        if (FINAL) {
#pragma unroll
            for (int rr = 0; rr < R; ++rr)
#pragma unroll
                for (int i = 0; i < 2; ++i) { float* op = A.xout + (size_t)(row0 + rr) * DM + i * 512 + lane * 8;
                    *(float4*)op = make_float4(xv[rr][i * 8], xv[rr][i * 8 + 1], xv[rr][i * 8 + 2], xv[rr][i * 8 + 3]); *(float4*)(op + 4) = make_float4(xv[rr][i * 8 + 4], xv[rr][i * 8 + 5], xv[rr][i * 8 + 6], xv[rr][i * 8 + 7]); }
        } else {
            float ss[R];
#pragma unroll
            for (int rr = 0; rr < R; ++rr) {
#pragma unroll
                for (int i = 0; i < 2; ++i) { u32x4 o; o.x = pk2(xv[rr][i * 8], xv[rr][i * 8 + 1]); o.y = pk2(xv[rr][i * 8 + 2], xv[rr][i * 8 + 3]); o.z = pk2(xv[rr][i * 8 + 4], xv[rr][i * 8 + 5]); o.w = pk2(xv[rr][i * 8 + 6], xv[rr][i * 8 + 7]);
                    *(u32x4*)(A.XB + (size_t)(row0 + rr) * DM + i * 512 + lane * 8) = o;
                }
                ss[rr] = 0.f;
#pragma unroll
                for (int j = 0; j < 16; ++j) ss[rr] += xv[rr][j] * xv[rr][j];
            }
#pragma unroll
            for (int o = 1; o < 64; o <<= 1)
#pragma unroll
                for (int rr = 0; rr < R; ++rr) ss[rr] += __shfl_xor(ss[rr], o);
            float r2[R];
#pragma unroll
            for (int rr = 0; rr < R; ++rr) { r2[rr] = rsqrtf(ss[rr] * (1.f / DM) + EPS); if (lane == 0) A.rs[row0 + rr] = r2[rr]; }
            if (DT || ROUTE) {
                float gn[16];
#pragma unroll
                for (int i = 0; i < 2; ++i) { const float4 g0 = *(const float4*)(A.gnext + i * 512 + lane * 8), g1 = *(const float4*)(A.gnext + i * 512 + lane * 8 + 4);
                    gn[i * 8 + 0] = g0.x; gn[i * 8 + 1] = g0.y; gn[i * 8 + 2] = g0.z; gn[i * 8 + 3] = g0.w; gn[i * 8 + 4] = g1.x; gn[i * 8 + 5] = g1.y; gn[i * 8 + 6] = g1.z; gn[i * 8 + 7] = g1.w; }
#pragma unroll 1
                for (int rr = 0; rr < R; ++rr) {
                    const int row = row0 + rr;
                    float hv[16];
#pragma unroll
                    for (int j = 0; j < 16; ++j) hv[j] = (rr == 0 ? xv[0][j] : xv[R - 1][j]) * (rr == 0 ? r2[0] : r2[R - 1]) * gn[j];
                    if (DT) {
                        float d[16];
#pragma unroll
                        for (int j = 0; j < 16; ++j) d[j] = 0.f;
#pragma unroll
                        for (int q = 0; q < 16; ++q) {
                            const float* wp = A.win + (size_t)((q >> 3) * 512 + lane * 8 + (q & 7)) * EVEN_IN + 4096;
#pragma unroll
                            for (int j4 = 0; j4 < 4; ++j4) { const float4 w = *(const float4*)(wp + j4 * 4);
                                d[j4 * 4 + 0] += hv[q] * w.x; d[j4 * 4 + 1] += hv[q] * w.y; d[j4 * 4 + 2] += hv[q] * w.z; d[j4 * 4 + 3] += hv[q] * w.w; }
                        }
#pragma unroll
                        for (int j = 0; j < 16; ++j) d[j] = wave_sum(d[j]);
                        if (lane == 0) {
#pragma unroll
                            for (int j4 = 0; j4 < 4; ++j4) *(float4*)(A.dtraw + (size_t)row * 16 + j4 * 4) = make_float4(d[j4 * 4], d[j4 * 4 + 1], d[j4 * 4 + 2], d[j4 * 4 + 3]);
                        }
                    }
                    if (ROUTE) {
                        float lg[8];
#pragma unroll
                        for (int e = 0; e < 8; ++e) lg[e] = 0.f;
#pragma unroll
                        for (int q = 0; q < 16; ++q) {
                            const float* wp = A.wr + (size_t)((q >> 3) * 512 + lane * 8 + (q & 7)) * 8;
                            const float4 w0 = *(const float4*)wp, w1 = *(const float4*)(wp + 4);
                            lg[0] += hv[q] * w0.x; lg[1] += hv[q] * w0.y; lg[2] += hv[q] * w0.z; lg[3] += hv[q] * w0.w;
                            lg[4] += hv[q] * w1.x; lg[5] += hv[q] * w1.y; lg[6] += hv[q] * w1.z; lg[7] += hv[q] * w1.w;
                        }
#pragma unroll
                        for (int e = 0; e < 8; ++e) lg[e] = wave_sum(lg[e]);
                        int dst1 = 0, dst2 = 0;
                        if (lane == 0) {
                            const float rcur = (rr == 0 ? r2[0] : r2[R - 1]);
                            int e1 = 0; float v1 = lg[0];
#pragma unroll
                            for (int e = 1; e < 8; ++e) if (lg[e] > v1) { v1 = lg[e]; e1 = e; }
                            int e2 = 0; float v2 = -3.0e38f;
#pragma unroll
                            for (int e = 0; e < 8; ++e) if (e != e1 && lg[e] > v2) { v2 = lg[e]; e2 = e; }
                            const float ex = __expf(v2 - v1); const float w1 = 1.f / (1.f + ex), w2 = ex / (1.f + ex);
                            const int p1 = (int)atomicAdd(&A.cnt[e1], 1u); A.list[e1 * MT + p1] = row * 2; A.gatev[e1 * MT + p1] = w1; A.rsl[e1 * MT + p1] = rcur;
                            const int p2 = (int)atomicAdd(&A.cnt[e2], 1u); A.list[e2 * MT + p2] = row * 2 + 1; A.gatev[e2 * MT + p2] = w2; A.rsl[e2 * MT + p2] = rcur;
                            dst1 = e1 * MT + p1; dst2 = e2 * MT + p2;
                        }
                        dst1 = __builtin_amdgcn_readfirstlane(dst1); dst2 = __builtin_amdgcn_readfirstlane(dst2);
#pragma unroll
                        for (int i = 0; i < 2; ++i) { u32x2 o8;
                            const float* xs = (rr == 0 ? xv[0] : xv[R - 1]) + i * 8;
                            o8.x = pg8_pk4(xs[0], xs[1], xs[2], xs[3]); o8.y = pg8_pk4(xs[4], xs[5], xs[6], xs[7]);
                            *(u32x2*)(A.x8 + (size_t)dst1 * DM + i * 512 + lane * 8) = o8; *(u32x2*)(A.x8 + (size_t)dst2 * DM + i * 512 + lane * 8) = o8; }
                    }
                }
            }
        }
    }
}

DEVI void transpose_item(const float* W, int ldw, int K, int k0, int n0, bf16_t* WT, int drow0, LAS float* scr, int lane, const float* gain) {
    {
        const int ka = lane >> 3, n4 = (lane & 7) * 4;
        float4 wv[8];
#pragma unroll
        for (int i = 0; i < 8; ++i) wv[i] = *(const float4*)(W + (size_t)(k0 + i * 8 + ka) * ldw + n0 + n4);
#pragma unroll
        for (int i = 0; i < 8; ++i) { LAS float* d = scr + (i * 8 + ka) * 33 + n4; d[0] = wv[i].x; d[1] = wv[i].y; d[2] = wv[i].z; d[3] = wv[i].w; }
    }
    asm volatile("s_waitcnt lgkmcnt(0)" ::: "memory");
    const int c = lane & 7;
    float4 ga = make_float4(1.f, 1.f, 1.f, 1.f), gb = ga;
    if (gain) { ga = *(const float4*)(gain + k0 + 8 * c); gb = *(const float4*)(gain + k0 + 8 * c + 4); }
#pragma unroll
    for (int j = 0; j < 4; ++j) { const int n = (lane >> 3) + 8 * j; const LAS float* sp = scr + (8 * c) * 33 + n;
        u32x4 o; o.x = pk2(sp[0 * 33] * ga.x, sp[1 * 33] * ga.y); o.y = pk2(sp[2 * 33] * ga.z, sp[3 * 33] * ga.w); o.z = pk2(sp[4 * 33] * gb.x, sp[5 * 33] * gb.y); o.w = pk2(sp[6 * 33] * gb.z, sp[7 * 33] * gb.w);
        *(u32x4*)(WT + (size_t)(drow0 + n) * K + k0 + 8 * c) = o; }
    asm volatile("s_waitcnt lgkmcnt(0)" ::: "memory");
}
DEVI void transpose_item_fp8(const float* W, int ldw, int K, int k0, int n0, unsigned char* WT8, int drow0, LAS float* scr, int lane, const float* gain) {
    {
        const int ka = lane >> 3, n4 = (lane & 7) * 4;
        float4 wv[8];
#pragma unroll
        for (int i = 0; i < 8; ++i) wv[i] = *(const float4*)(W + (size_t)(k0 + i * 8 + ka) * ldw + n0 + n4);
#pragma unroll
        for (int i = 0; i < 8; ++i) { LAS float* d = scr + (i * 8 + ka) * 33 + n4; d[0] = wv[i].x; d[1] = wv[i].y; d[2] = wv[i].z; d[3] = wv[i].w; }
    }
    asm volatile("s_waitcnt lgkmcnt(0)" ::: "memory");
    const int c = lane & 7;
    float4 ga = make_float4(64.f, 64.f, 64.f, 64.f), gb = ga;
    if (gain) { ga = *(const float4*)(gain + k0 + 8 * c); gb = *(const float4*)(gain + k0 + 8 * c + 4); ga.x *= 64.f; ga.y *= 64.f; ga.z *= 64.f; ga.w *= 64.f; gb.x *= 64.f; gb.y *= 64.f; gb.z *= 64.f; gb.w *= 64.f; }
#pragma unroll
    for (int j = 0; j < 4; ++j) { const int n = (lane >> 3) + 8 * j; const LAS float* sp = scr + (8 * c) * 33 + n;
        u32x2 o; o.x = pg8_pk4(sp[0 * 33] * ga.x, sp[1 * 33] * ga.y, sp[2 * 33] * ga.z, sp[3 * 33] * ga.w); o.y = pg8_pk4(sp[4 * 33] * gb.x, sp[5 * 33] * gb.y, sp[6 * 33] * gb.z, sp[7 * 33] * gb.w);
        *(u32x2*)(WT8 + (size_t)(drow0 + n) * K + k0 + 8 * c) = o; }
    asm volatile("s_waitcnt lgkmcnt(0)" ::: "memory");
}
struct Job { int in_idx; unsigned src_off; int ldw; int K; int ncols; unsigned long long dst; int mode; int item0; int gain_idx; int gain_off; int fp8; };
constexpr int NJOBS = 11 + 24;
struct JobTable { Job j[NJOBS]; int total; };
constexpr JobTable make_jobs() {
    JobTable t{}; int n = 0, it = 0;
    auto add = [&](int idx, unsigned off, int ldw, int K, int ncols, unsigned long long dst, int mode, int gi, int go, int f8 = 0) { t.j[n] = Job{idx, off, ldw, K, ncols, dst, mode, it, gi, go, f8}; it += (K / 64) * (ncols / 32); ++n; };
    add(4, 0, EVEN_IN, DM, UW, W_IN, 0, 3, 0);
    add(12, 0, DM, DM, DM, W_OUTE, 0, -1, 0);
    add(15, 0, DFF, DM, DFF, W_GU, 1, 14, 0);
    add(16, 0, DFF, DM, DFF, W_GU, 2, 14, 0);
    add(17, 0, DM, DFF, DM, W_DN, 0, -1, 0);
    add(31, 0, DM, DM, DM, W_PG, 0, 30, 0);
    add(31, DM * DM, DM, DM, DM, W_PG + 2 * MiB, 0, 30, DM);
    add(32, 0, DM, PDIM, DM, W_PP, 0, -1, 0);
    add(32, PDIM * DM, DM, PDIM, DM, W_PP + 512 * 1024, 0, -1, 0);
    add(20, 0, 3072, DM, 3072, W_QKV, 0, 19, 0);
    add(22, 0, DM, DM, DM, W_OUTO, 0, -1, 0);
    for (int e = 0; e < NEXP; ++e) {
        add(26, (unsigned)e * DM * DFFE, DFFE, DM, DFFE, W_EGU + (unsigned long long)e * 7 * MiB, 1, 24, 0, 1);
        add(27, (unsigned)e * DM * DFFE, DFFE, DM, DFFE, W_EGU + (unsigned long long)e * 7 * MiB, 2, 24, 0, 1);
        add(28, (unsigned)e * DFFE * DM, DM, DFFE, DM, W_EDN + (unsigned long long)e * (7 * MiB / 2), 0, -1, 0, 1);
    }
    t.total = it; return t;
}
__device__ const JobTable g_jobs = make_jobs();
constexpr int ITEMS_DENSE = make_jobs().j[11].item0, ITEMS_ALL = make_jobs().total;
DEVI void ph_convert_weights(LAS unsigned char* lds, const float* const* in, unsigned char* ws, int it_lo, int it_hi, int vb0, int vbs) {
    const int tidq = opq((int)threadIdx.x); const int wid = __builtin_amdgcn_readfirstlane(tidq >> 6), lane = tidq & 63;
    LAS float* scr = (LAS float*)(lds + wid * 16384);
    int jb = 0;
    for (int it = it_lo + vb0 * 8 + wid; it < it_hi; it += vbs * 8) {
        while (jb + 1 < NJOBS && g_jobs.j[jb + 1].item0 <= it) ++jb;
        const Job J = g_jobs.j[jb];
        const int r = it - J.item0; const int nblk = J.ncols / 32; const int kb = r / nblk, nb = r % nblk;
        const int n0 = nb * 32; int drow0 = n0;
        if (J.mode != 0) drow0 = (n0 >> 7) * 256 + (n0 & 127) + (J.mode == 2 ? 128 : 0);
        const float* gp = J.gain_idx >= 0 ? in[J.gain_idx] + J.gain_off : nullptr;
        if (J.fp8) transpose_item_fp8(in[J.in_idx] + J.src_off, J.ldw, J.K, kb * 64, n0, ws + J.dst, drow0, scr, lane, gp);
        else transpose_item(in[J.in_idx] + J.src_off, J.ldw, J.K, kb * 64, n0, (bf16_t*)(ws + J.dst), drow0, scr, lane, gp);
    }
}
DEVI void ph_cvt_rows(const float* src, bf16_t* dst, size_t n4, int vb0, int vbs) {
    for (size_t e = (size_t)vb0 * NTHR + opq((int)threadIdx.x); e < n4; e += (size_t)vbs * NTHR) {
        const float4 v = ((const float4*)src)[e]; u32x2 o; o.x = pk2(v.x, v.y); o.y = pk2(v.z, v.w); ((u32x2*)dst)[e] = o; }
}

namespace pg8 {
constexpr int BM = 256, BK = 64, HALF = 128, HTB = HALF * BK * 2, STAGE_BYTES = 8 * HTB, NXCD = 8, WGM = 8;
__host__ __device__ __forceinline__ int lds_byte(int r, int c) { const int st = (r >> 4) * 2 + (c >> 5), rr = r & 15, cc = c & 31, ob = rr * 64 + cc * 2; return st * 1024 + (ob ^ (((ob >> 9) & 1) << 5)); }
__host__ __device__ __forceinline__ void stage_rc(int b, int& R, int& C) { const int st = b / 1024, sb = b % 1024, swz = sb ^ (((sb >> 9) & 1) << 5); R = (st >> 1) * 16 + swz / 64; C = (st & 1) * 32 + (swz % 64) / 2; }
__host__ __device__ __forceinline__ int perm32(int rho) { const int n = rho >> 4, i = rho & 15; return 8 * (i >> 2) + 4 * n + (i & 3); }
struct Unit { int pm, pn; int row0; int arow0; int mvalid; int e; int mbase; const char* B; };
DEVI void xcd_tile(int L, int nwg, int nM, int nN, int& pm, int& pn) {
    int wgid = L; { const int q = nwg / NXCD, r = nwg % NXCD, xcd = wgid % NXCD, off = wgid / NXCD; wgid = (xcd < r ? xcd * (q + 1) : r * (q + 1) + (xcd - r) * q) + off; }
    const int nig = WGM * nN, gid = wgid / nig, fm = gid * WGM, gsz = (nM - fm) < WGM ? (nM - fm) : WGM;
    pm = fm + ((wgid % nig) % gsz); pn = (wgid % nig) / gsz;
}
struct DenseOrder {
    int nM, nN, nwg, G, c; const char* Bt; size_t tstepB;
    DEVI void init(int M, int N, int K, const bf16_t* Bt_, int G_, int c_) { nM = M / BM; nN = N / BM; nwg = nM * nN; G = G_; c = c_; Bt = (const char*)Bt_; tstepB = (size_t)BM * K * 2; }
    DEVI bool next(int i, Unit& u) const { const long L = (long)i * G + c; if (L >= nwg) return false; xcd_tile((int)L, nwg, nM, nN, u.pm, u.pn); u.row0 = u.pm * BM; u.arow0 = u.row0; u.mvalid = BM; u.e = 0; u.mbase = 0; u.B = Bt + (size_t)u.pn * tstepB; return true; }
};
struct TailOrder {
    int nM, nN, nwg, nb, r; const char* Bt; size_t tstepB;
    DEVI void init(int M, int N, int K, const bf16_t* Bt_, int G_, int c_, int first) { nM = M / BM; nN = N / BM; nwg = nM * nN; Bt = (const char*)Bt_; tstepB = (size_t)BM * K * 2;
        if (first >= G_) first = 0; nb = G_ - first; r = c_ - first; }
    DEVI bool next(int i, Unit& u) const { if (r < 0) return false; const long L = (long)i * nb + r; if (L >= nwg) return false; u.pm = (int)L / nN; u.pn = (int)L % nN; u.row0 = u.pm * BM; u.arow0 = u.row0; u.mvalid = BM; u.e = 0; u.mbase = 0; u.B = Bt + (size_t)u.pn * tstepB; return true; }
};
struct MoeOrder {
    int nM, nN, nwg, G, c; const char* Bt; size_t estepB, tstepB; const volatile LAS int* tab; bool per_expert;
    DEVI void init(const unsigned* cnt, volatile LAS int* tab_, int N, int K, const bf16_t* Bt_, size_t estep_bytes, bool per_expert_, int G_, int c_) {
        __syncthreads();
        if (threadIdx.x == 0) { int t = 0;
            for (int e = 0; e < 8; ++e) { const int n = (int)__hip_atomic_load(cnt + e, __ATOMIC_RELAXED, __HIP_MEMORY_SCOPE_AGENT); tab_[16 + e] = n; tab_[e] = t; t += (n + BM - 1) / BM; }
            tab_[8] = t; }
        __syncthreads();
        tab = tab_; nM = __builtin_amdgcn_readfirstlane(tab_[8]); nN = N / BM; nwg = nM * nN; G = G_; c = c_; Bt = (const char*)Bt_; estepB = estep_bytes; tstepB = (size_t)BM * K * 2; per_expert = per_expert_;
    }
    DEVI bool next(int i, Unit& u) const { const long L = (long)i * G + c; if (L >= nwg) return false; xcd_tile((int)L, nwg, nM, nN, u.pm, u.pn);
        int e = 0;
        for (int k = 1; k < 8; ++k) if (u.pm >= __builtin_amdgcn_readfirstlane(tab[k])) e = k;
        const int t0 = __builtin_amdgcn_readfirstlane(tab[e]), n = __builtin_amdgcn_readfirstlane(tab[16 + e]);
        u.e = e; u.row0 = u.pm * BM; const int m0 = (u.pm - t0) * BM; u.mbase = m0; u.arow0 = per_expert ? e * MT + m0 : u.row0; u.mvalid = (n - m0) < BM ? (n - m0) : BM; u.B = Bt + (size_t)e * estepB + (size_t)u.pn * tstepB; return true; }
};
DEVI unsigned cvt_pk_bf16(float lo, float hi) { unsigned r; asm volatile("v_cvt_pk_bf16_f32 %0, %1, %2" : "=v"(r) : "v"(lo), "v"(hi)); return r; }

struct Pre8 { float v[8]; };
struct Pre16 { float v[8]; int t[8]; };
struct EpiBf16 { static constexpr bool PERM = true; bf16_t* O; int ldc; const float* rs;
    typedef Pre8 Pre;
    DEVI void pre(Pre& P, const Unit& u, int wr, int fr) const {
#pragma unroll
        for (int q = 0; q < 8; ++q) P.v[q] = rs ? rs[u.row0 + wr * 64 + fr + (q >> 2) * HALF + (q & 3) * 16] : 1.f; }
    DEVI void operator()(const f32x4 (&acc)[2][2][4][2], const Unit& u, int wr, int wc, int fr, int fq, const Pre& P) const {
        const int row0 = u.row0 + wr * 64 + fr, col0 = u.pn * BM + wc * 32 + 8 * fq;
#pragma unroll
        for (int ai = 0; ai < 2; ++ai)
#pragma unroll
            for (int m = 0; m < 4; ++m) { const int row = row0 + ai * HALF + m * 16; bf16_t* rowp = O + (size_t)row * ldc + col0;
                const float sc = P.v[ai * 4 + m];
#pragma unroll
                for (int bj = 0; bj < 2; ++bj) { const f32x4 v0 = acc[ai][bj][m][0] * sc, v1 = acc[ai][bj][m][1] * sc;
                    u32x4 w; w.x = cvt_pk_bf16(v0[0], v0[1]); w.y = cvt_pk_bf16(v0[2], v0[3]); w.z = cvt_pk_bf16(v1[0], v1[1]); w.w = cvt_pk_bf16(v1[2], v1[3]);
                    *(u32x4*)(rowp + bj * HALF) = w; } }
    } };
struct EpiPleGate { static constexpr bool PERM = true; bf16_t* T; int ldc; const float* rs;
    typedef Pre8 Pre;
    DEVI void pre(Pre& P, const Unit& u, int wr, int fr) const {
#pragma unroll
        for (int q = 0; q < 8; ++q) P.v[q] = rs[u.row0 + wr * 64 + fr + (q >> 2) * HALF + (q & 3) * 16]; }
    DEVI void operator()(const f32x4 (&acc)[2][2][4][2], const Unit& u, int wr, int wc, int fr, int fq, const Pre& P) const {
        const int row0 = u.row0 + wr * 64 + fr, col0 = u.pn * BM + wc * 32 + 8 * fq;
#pragma unroll
        for (int ai = 0; ai < 2; ++ai)
#pragma unroll
            for (int m = 0; m < 4; ++m) { const int row = row0 + ai * HALF + m * 16; bf16_t* rowp = T + (size_t)row * ldc + col0;
                const float sc = P.v[ai * 4 + m];
#pragma unroll
                for (int bj = 0; bj < 2; ++bj) { const f32x4 v0 = acc[ai][bj][m][0] * sc, v1 = acc[ai][bj][m][1] * sc;
                    const u32x4 pp = *(const u32x4*)(rowp + bj * HALF);
                    u32x4 w; w.x = cvt_pk_bf16(sigmoid_f(v0[0]) * bflo(pp.x), sigmoid_f(v0[1]) * bfhi(pp.x)); w.y = cvt_pk_bf16(sigmoid_f(v0[2]) * bflo(pp.y), sigmoid_f(v0[3]) * bfhi(pp.y));
                    w.z = cvt_pk_bf16(sigmoid_f(v1[0]) * bflo(pp.z), sigmoid_f(v1[1]) * bfhi(pp.z)); w.w = cvt_pk_bf16(sigmoid_f(v1[2]) * bflo(pp.w), sigmoid_f(v1[3]) * bfhi(pp.w));
                    *(u32x4*)(rowp + bj * HALF) = w; } }
    } };
struct EpiSwiglu { static constexpr bool PERM = true; bf16_t* O; int ldc; const float* rs; int grouped;
    typedef Pre8 Pre;
    DEVI void pre(Pre& P, const Unit& u, int wr, int fr) const {
        const float* rsb = grouped ? rs + u.e * MT + u.mbase : rs + u.row0; const int vm1 = (grouped ? u.mvalid : BM) - 1;
#pragma unroll
        for (int q = 0; q < 8; ++q) { const int rl = wr * 64 + fr + (q >> 2) * HALF + (q & 3) * 16; const float v = rsb[rl <= vm1 ? rl : vm1]; P.v[q] = rl <= vm1 ? v : 0.f; } }
    DEVI void operator()(const f32x4 (&acc)[2][2][4][2], const Unit& u, int wr, int wc, int fr, int fq, const Pre& P) const {
        const int row0 = u.row0 + wr * 64 + fr, col0 = u.pn * HALF + wc * 32 + 8 * fq;
#pragma unroll
        for (int ai = 0; ai < 2; ++ai)
#pragma unroll
            for (int m = 0; m < 4; ++m) { const int rl = wr * 64 + fr + ai * HALF + m * 16; bf16_t* rowp = O + (size_t)(u.row0 + rl) * ldc + col0;
                const float sc = P.v[ai * 4 + m];
                const f32x4 g0 = acc[ai][0][m][0] * sc, g1 = acc[ai][0][m][1] * sc, u0 = acc[ai][1][m][0] * sc, u1 = acc[ai][1][m][1] * sc;
                u32x4 w; w.x = cvt_pk_bf16(silu_f(g0[0]) * u0[0], silu_f(g0[1]) * u0[1]); w.y = cvt_pk_bf16(silu_f(g0[2]) * u0[2], silu_f(g0[3]) * u0[3]);
                w.z = cvt_pk_bf16(silu_f(g1[0]) * u1[0], silu_f(g1[1]) * u1[1]); w.w = cvt_pk_bf16(silu_f(g1[2]) * u1[2], silu_f(g1[3]) * u1[3]);
                *(u32x4*)rowp = w; }
    } };
constexpr float W8_SCALE = 64.f, ACT8_SCALE = 8.f;
struct EpiSwiglu8 { static constexpr bool PERM = true; unsigned char* O; int ldc; const float* rs;
    typedef Pre8 Pre;
    DEVI void pre(Pre& P, const Unit& u, int wr, int fr) const {
        const float* rsb = rs + u.e * MT + u.mbase; const int vm1 = u.mvalid - 1;
#pragma unroll
        for (int q = 0; q < 8; ++q) { const int rl = wr * 64 + fr + (q >> 2) * HALF + (q & 3) * 16; const float v = rsb[rl <= vm1 ? rl : vm1]; P.v[q] = rl <= vm1 ? v * (1.f / W8_SCALE) : 0.f; } }
    DEVI void operator()(const f32x4 (&acc)[2][2][4][2], const Unit& u, int wr, int wc, int fr, int fq, const Pre& P) const {
        const int col0 = u.pn * HALF + wc * 32 + 8 * fq;
#pragma unroll
        for (int ai = 0; ai < 2; ++ai)
#pragma unroll
            for (int m = 0; m < 4; ++m) { const int rl = wr * 64 + fr + ai * HALF + m * 16; unsigned char* rowp = O + (size_t)(u.row0 + rl) * ldc + col0;
                const float sc = P.v[ai * 4 + m];
                const f32x4 g0 = acc[ai][0][m][0] * sc, g1 = acc[ai][0][m][1] * sc, u0 = acc[ai][1][m][0] * (sc * ACT8_SCALE), u1 = acc[ai][1][m][1] * (sc * ACT8_SCALE);
                u32x2 w; w.x = pg8_pk4(silu_f(g0[0]) * u0[0], silu_f(g0[1]) * u0[1], silu_f(g0[2]) * u0[2], silu_f(g0[3]) * u0[3]);
                w.y = pg8_pk4(silu_f(g1[0]) * u1[0], silu_f(g1[1]) * u1[1], silu_f(g1[2]) * u1[2], silu_f(g1[3]) * u1[3]);
                *(u32x2*)rowp = w; }
    } };
struct EpiMoeDown { static constexpr bool PERM = true; bf16_t* Y; const int* list; const float* gatev; float oscale;
    typedef Pre16 Pre;
    DEVI void pre(Pre& P, const Unit& u, int wr, int fr) const {
        const int* lb = list + u.e * MT + u.mbase; const float* gb = gatev + u.e * MT + u.mbase; const int vm1 = u.mvalid - 1;
#pragma unroll
        for (int q = 0; q < 8; ++q) { const int rl = wr * 64 + fr + (q >> 2) * HALF + (q & 3) * 16; const int ri = rl <= vm1 ? rl : vm1; P.t[q] = lb[ri]; P.v[q] = gb[ri] * oscale; } }
    DEVI void operator()(const f32x4 (&acc)[2][2][4][2], const Unit& u, int wr, int wc, int fr, int fq, const Pre& P) const {
        const int col0 = u.pn * BM + wc * 32 + 8 * fq;
        const int mbase = u.mbase;
#pragma unroll
        for (int ai = 0; ai < 2; ++ai)
#pragma unroll
            for (int m = 0; m < 4; ++m) { const int rl = wr * 64 + fr + ai * HALF + m * 16;
                const int tsl = P.t[ai * 4 + m]; const float gt = P.v[ai * 4 + m];
                if (rl < u.mvalid) {
                    bf16_t* rowp = Y + (size_t)(tsl & 1) * ((size_t)MT * DM) + (size_t)(tsl >> 1) * DM + col0;
#pragma unroll
                    for (int bj = 0; bj < 2; ++bj) { const f32x4 v0 = acc[ai][bj][m][0], v1 = acc[ai][bj][m][1];
                        u32x4 w; w.x = cvt_pk_bf16(v0[0] * gt, v0[1] * gt); w.y = cvt_pk_bf16(v0[2] * gt, v0[3] * gt); w.z = cvt_pk_bf16(v1[0] * gt, v1[1] * gt); w.w = cvt_pk_bf16(v1[2] * gt, v1[3] * gt);
                        *(u32x4*)(rowp + bj * HALF) = w; } } }
    } };

typedef int v8i __attribute__((ext_vector_type(8)));
typedef int v4i __attribute__((ext_vector_type(4)));
DEVI v8i cat8(const bf16x8 lo, const bf16x8 hi) { const v4i a = __builtin_bit_cast(v4i, lo), b = __builtin_bit_cast(v4i, hi); return __builtin_shufflevector(a, b, 0, 1, 2, 3, 4, 5, 6, 7); }
struct Frag16 { bf16x8 k[2]; };
struct Frag8 { v8i v; };
template <bool F> struct FragSel { typedef Frag16 T; };
template <> struct FragSel<true> { typedef Frag8 T; };
template <class Epi, class Sched, bool FP8 = false>
DEVI void gemm_phase(LAS unsigned char* lds, const bf16_t* A, const int K, const Sched& S, const Epi& E) {
    const int tid = opq((int)threadIdx.x), wid = __builtin_amdgcn_readfirstlane(tid >> 6), lane = tid & 63, wr = wid >> 2, wc = wid & 3, fr = lane & 15, fq = lane >> 4;
    const int nt = K / BK;
    unsigned voffA[2], voffB[2];
#pragma unroll
    for (int i = 0; i < 2; ++i) { int R, C; stage_rc(tid * 16 + i * 8192, R, C); const int Rb = Epi::PERM ? ((R & ~31) + perm32(R & 31)) : R;
        voffA[i] = (unsigned)(R * K + C) * 2u; voffB[i] = (unsigned)(Rb * K + C) * 2u; }
    const size_t kstep = (size_t)(BK * 2);
    const size_t hstep = (size_t)HALF * K * 2;
    const size_t rstep = (size_t)K * 2;
    const unsigned ldsw = (unsigned)wid * 1024u;
    const int aoff = lds_byte(wr * 64 + fr, fq * 8), boff = lds_byte(wc * 32 + fr, fq * 8);
#define PG8_SA(b, h) (((b) * 2 + (h)) * HTB)
#define PG8_SB(b, h) ((4 + (b) * 2 + (h)) * HTB)
#define PG8_STAGE(bufoff, gbase, voff) do { _Pragma("unroll") for (int _i = 0; _i < 2; ++_i) \
        __builtin_amdgcn_global_load_lds((const unsigned*)((const char*)(gbase) + (voff)[_i]), (LAS unsigned*)(lds + (bufoff) + ldsw + _i * 8192), 16, 0, 0); } while (0)
#define PG8_LDA(dst, b, h) do { _Pragma("unroll") for (int m = 0; m < 4; ++m) { if constexpr (FP8) dst[m].v = cat8(*(const LAS bf16x8*)(lds + PG8_SA(b, h) + aoff + m * 2048), *(const LAS bf16x8*)(lds + PG8_SA(b, h) + aoff + m * 2048 + 1024)); \
        else { _Pragma("unroll") for (int k = 0; k < 2; ++k) dst[m].k[k] = *(const LAS bf16x8*)(lds + PG8_SA(b, h) + aoff + m * 2048 + k * 1024); } } } while (0)
#define PG8_LDB(dst, b, h) do { _Pragma("unroll") for (int n = 0; n < 2; ++n) { if constexpr (FP8) dst[n].v = cat8(*(const LAS bf16x8*)(lds + PG8_SB(b, h) + boff + n * 2048), *(const LAS bf16x8*)(lds + PG8_SB(b, h) + boff + n * 2048 + 1024)); \
        else { _Pragma("unroll") for (int k = 0; k < 2; ++k) dst[n].k[k] = *(const LAS bf16x8*)(lds + PG8_SB(b, h) + boff + n * 2048 + k * 1024); } } } while (0)
#define PG8_MMA(ai, bj, At, Bt) do { __builtin_amdgcn_s_setprio(1); _Pragma("unroll") for (int m = 0; m < 4; ++m) _Pragma("unroll") for (int n = 0; n < 2; ++n) { \
        if constexpr (FP8) asm volatile("s_nop 1\n\tv_mfma_scale_f32_16x16x128_f8f6f4 %0, %1, %2, %0, %3, %3 op_sel_hi:[0,0,0]" : "+v"(acc[ai][bj][m][n]) : "v"(Bt[n].v), "v"(At[m].v), "v"(sc1)); \
        else { _Pragma("unroll") for (int k = 0; k < 2; ++k) acc[ai][bj][m][n] = __builtin_amdgcn_mfma_f32_16x16x32_bf16(Bt[n].k[k], At[m].k[k], acc[ai][bj][m][n], 0, 0, 0); } } \
        __builtin_amdgcn_s_setprio(0); } while (0)
#define PG8_WAIT_V(n) asm volatile("s_waitcnt vmcnt(" #n ")" ::: "memory")
#define PG8_WAIT_L(n) asm volatile("s_waitcnt lgkmcnt(" #n ")" ::: "memory")
#define PG8_BAR __builtin_amdgcn_s_barrier()
#define PG8_SCHED __builtin_amdgcn_sched_barrier(0)
    Unit cur, nxt; int ui = 0;
    if (!S.next(0, cur)) return;
    int sc1 = 0x7F7F7F7F; asm volatile("" : "+v"(sc1));
    f32x4 acc[2][2][4][2];
#pragma unroll
    for (int a = 0; a < 2; ++a)
#pragma unroll
        for (int b = 0; b < 2; ++b)
#pragma unroll
            for (int m = 0; m < 4; ++m)
#pragma unroll
                for (int n = 0; n < 2; ++n) acc[a][b][m][n] = (f32x4){0.f, 0.f, 0.f, 0.f};
    typename FragSel<FP8>::T At[4], B0[2], B1[2];
    const char* cA = (const char*)A + (size_t)cur.arow0 * rstep;
    const char* cB = cur.B;
    typename Epi::Pre pre; E.pre(pre, cur, wr, fr);
    PG8_STAGE(PG8_SB(0, 0), cB, voffB); PG8_STAGE(PG8_SA(0, 0), cA, voffA); PG8_STAGE(PG8_SB(0, 1), cB + hstep, voffB); PG8_STAGE(PG8_SA(0, 1), cA + hstep, voffA);
    if (wr == 1) PG8_BAR;
    PG8_WAIT_V(4); PG8_BAR;
    PG8_STAGE(PG8_SB(1, 0), cB + kstep, voffB); PG8_STAGE(PG8_SA(1, 0), cA + kstep, voffA); PG8_STAGE(PG8_SB(1, 1), cB + hstep + kstep, voffB);
    PG8_WAIT_V(6); PG8_BAR;
    for (;;) {
        const bool has_next = S.next(ui + 1, nxt);
        const char* nA = has_next ? (const char*)A + (size_t)nxt.arow0 * rstep : cA; const char* nB = has_next ? nxt.B : cB;
#pragma unroll 1
        for (int t = 0; t < nt; t += 2) {
            const bool last = (t == nt - 2);
            const char* a1 = cA + (size_t)(t + 1) * kstep;
            const char* a2 = last ? nA : cA + (size_t)(t + 2) * kstep; const char* b2 = last ? nB : cB + (size_t)(t + 2) * kstep;
            const char* a3 = a2 + kstep; const char* b3 = b2 + kstep;
            PG8_LDB(B0, 0, 0); PG8_SCHED; PG8_LDA(At, 0, 0); PG8_STAGE(PG8_SA(1, 1), a1 + hstep, voffA);
            PG8_WAIT_L(8); PG8_BAR; PG8_WAIT_L(0); PG8_MMA(0, 0, At, B0); PG8_BAR; PG8_SCHED;
            PG8_LDB(B1, 0, 1); PG8_STAGE(PG8_SB(0, 0), b2, voffB);
            PG8_BAR; PG8_WAIT_L(0); PG8_MMA(0, 1, At, B1); PG8_BAR;
            PG8_LDA(At, 0, 1); PG8_STAGE(PG8_SA(0, 0), a2, voffA);
            PG8_BAR; PG8_WAIT_L(0); PG8_MMA(1, 0, At, B0); PG8_BAR; PG8_SCHED;
            PG8_STAGE(PG8_SB(0, 1), b2 + hstep, voffB);
            PG8_WAIT_V(6); PG8_BAR; PG8_MMA(1, 1, At, B1); PG8_BAR;
            PG8_LDB(B0, 1, 0); PG8_SCHED; PG8_LDA(At, 1, 0); PG8_STAGE(PG8_SA(0, 1), a2 + hstep, voffA);
            PG8_WAIT_L(8); PG8_BAR; PG8_WAIT_L(0); PG8_MMA(0, 0, At, B0); PG8_BAR; PG8_SCHED;
            PG8_LDB(B1, 1, 1); PG8_STAGE(PG8_SB(1, 0), b3, voffB);
            PG8_BAR; PG8_WAIT_L(0); PG8_MMA(0, 1, At, B1); PG8_BAR;
            PG8_LDA(At, 1, 1); PG8_STAGE(PG8_SA(1, 0), a3, voffA);
            PG8_BAR; PG8_WAIT_L(0); PG8_MMA(1, 0, At, B0); PG8_BAR; PG8_SCHED;
            PG8_STAGE(PG8_SB(1, 1), b3 + hstep, voffB);
            PG8_WAIT_V(6); PG8_BAR; PG8_MMA(1, 1, At, B1); PG8_BAR;
        }
        if constexpr (FP8) asm volatile("s_nop 15\n\ts_nop 15" ::: "memory");
        E(acc, cur, wr, wc, fr, fq, pre);
        if (!has_next) break;
#pragma unroll
        for (int a = 0; a < 2; ++a)
#pragma unroll
            for (int b = 0; b < 2; ++b)
#pragma unroll
                for (int m = 0; m < 4; ++m)
#pragma unroll
                    for (int n = 0; n < 2; ++n) acc[a][b][m][n] = (f32x4){0.f, 0.f, 0.f, 0.f};
        cur = nxt; cA = nA; cB = nB; ++ui;
        E.pre(pre, cur, wr, fr);
        if constexpr (FP8) asm volatile("s_nop 7" ::: "memory");
    }
    PG8_WAIT_V(0);
    if (wr == 0) PG8_BAR;
    PG8_BAR;
#undef PG8_SA
#undef PG8_SB
#undef PG8_STAGE
#undef PG8_LDA
#undef PG8_LDB
#undef PG8_MMA
#undef PG8_WAIT_V
#undef PG8_WAIT_L
#undef PG8_BAR
#undef PG8_SCHED
}
}

DEVI float lb_of(const float* lbraw, int ch) {
    const float r0 = lbraw[ch], r1 = lbraw[512 + ch], r2 = lbraw[1024 + ch];
    const float mx = fmaxf(r0, fmaxf(r1, r2));
    const float e0 = __expf(r0 - mx), e1 = __expf(r1 - mx), e2 = __expf(r2 - mx);
    return e0 / (e0 + e1 + e2);
}
DEVI void ph_hgrn_naive(float* lds, const bf16_t* u, const float* lbraw, float* oacc, int vb0, int vbs) {
    float* sq = lds; float* sk = lds + 2048; float* sf = lds + 4096; float* sv = lds + 6144;
    const int tid = opq((int)threadIdx.x), j = tid >> 2, kq = tid & 3;
    for (int vb = vb0; vb < 32; vb += vbs) {
        const int dir = vb & 1, h = (vb >> 1) & 3, b = vb >> 3;
        float st[32];
#pragma unroll
        for (int i = 0; i < 32; ++i) st[i] = 0.f;
        for (int tb = 0; tb < SEQ / 16; ++tb) {
            __syncthreads();
            for (int e = tid; e < 2048; e += NTHR) {
                const int i = e >> 7, c = e & 127;
                const int t = dir ? (SEQ - 1 - (tb * 16 + i)) : (tb * 16 + i);
                const bf16_t* ur = u + (size_t)(b * SEQ + t) * UW;
                const int ch = h * 128 + c;
                const float qr = bf2f(ur[ch]), fr = bf2f(ur[(dir ? 1024 : 512) + ch]), vr = bf2f(ur[1536 + ch]);
                const float lb = lb_of(lbraw, ch);
                const float f = lb + (1.f - lb) * sigmoid_f(fr);
                sq[e] = silu_f(qr); sk[e] = 1.f - f; sf[e] = f; sv[e] = vr;
            }
            __syncthreads();
            for (int i = 0; i < 16; ++i) {
                const float vj = sv[i * 128 + j]; float acc = 0.f;
#pragma unroll
                for (int kk = 0; kk < 32; ++kk) {
                    const int kidx = kk * 4 + kq;
                    st[kk] = sf[i * 128 + kidx] * st[kk] + sk[i * 128 + kidx] * vj;
                    acc += st[kk] * sq[i * 128 + kidx];
                }
                acc += __shfl_xor(acc, 1); acc += __shfl_xor(acc, 2);
                if (kq == 0) {
                    const int t = dir ? (SEQ - 1 - (tb * 16 + i)) : (tb * 16 + i);
                    atomicAdd(&oacc[(size_t)(b * SEQ + t) * DM + h * 128 + j], acc);
                }
            }
        }
    }
    __syncthreads();
}

DEVI void ph_mixfin_hgrn(const bf16_t* u, const float* oacc, const float* a_norm, bf16_t* ocat, int vb0, int vbs) {
    const int tidq = opq((int)threadIdx.x); const int hw = tidq >> 5, l32 = tidq & 31;
    for (int row = vb0 * 16 + hw; row < MT; row += vbs * 16) {
        const int c0 = l32 * 16; float v[16]; float ss = 0.f;
        const bf16_t* ur = u + (size_t)row * UW;
#pragma unroll
        for (int i = 0; i < 16; ++i) { v[i] = oacc[(size_t)row * DM + c0 + i]; ss += v[i] * v[i]; }
        ss += __shfl_xor(ss, 1); ss += __shfl_xor(ss, 2); ss += __shfl_xor(ss, 4);
        const float r = rsqrtf(ss * (1.f / 128.f) + EPS);
#pragma unroll
        for (int i = 0; i < 16; ++i) { const int c = c0 + i; ocat[(size_t)row * DM + c] = f2bf(v[i] * r * a_norm[c & 127] * silu_f(bf2f(ur[2048 + c]))); }
    }
}


constexpr int HQ = 0, HK = 17408, HKH = 34816, HV = 53248, HDV = 71680, HZERO = 73728, HOT = 75776, H_END = HOT + 64 * 528;
static_assert(H_END <= 131072, "hgrn lds");
constexpr size_t HS_SCAN = (size_t)16 * 16384;
struct HgrnRaw { unsigned qf[16]; u32x4 v0, v1; };
DEVI void hgrn_load(HgrnRaw& R, const bf16_t* u, const bf16_t* VT, int dir, int b, int h, int t0, int c, int I, int tid) {
    const bf16_t* up = u + ((size_t)b * SEQ + t0 + 16 * I) * UW + h * 128 + c;
    const int fcol = dir ? 1024 : 512;
#pragma unroll
    for (int j = 0; j < 16; ++j) R.qf[j] = (unsigned)up[(size_t)j * UW] | ((unsigned)up[(size_t)j * UW + fcol] << 16);
    { const int e = tid, r = e >> 3, cch = e & 7; R.v0 = *(const u32x4*)(VT + ((size_t)b * 512 + h * 128 + r) * SEQ + t0 + cch * 8); }
    { const int e = tid + NTHR, r = e >> 3, cch = e & 7; R.v1 = *(const u32x4*)(VT + ((size_t)b * 512 + h * 128 + r) * SEQ + t0 + cch * 8); }
}
DEVI void hgrn_prep(LAS unsigned char* lds, const HgrnRaw& R, float lbv, int dir, int c, int I, int tid) {
    float ff[16], kk[16], qq[16];
    { const int e = tid, r = e >> 3, cch = e & 7; *(LAS u32x4*)(lds + HV + r * 144 + cch * 16) = R.v0; }
    { const int e = tid + NTHR, r = e >> 3, cch = e & 7; *(LAS u32x4*)(lds + HV + r * 144 + cch * 16) = R.v1; }
#pragma unroll
    for (int j = 0; j < 16; ++j) {
        const float fr = bfhi(R.qf[j]), qr = bflo(R.qf[j]);
        const float f = lbv + (1.f - lbv) * sigmoid_f(fr);
        ff[j] = f; kk[j] = 1.f - f; qq[j] = silu_f(qr);
    }
    float run = 1.f;
#pragma unroll
    for (int jj = 0; jj < 16; ++jj) { const int j = dir ? 15 - jj : jj; run *= ff[j]; ff[j] = run; }
    const float PG = run;
    float kh[16];
#pragma unroll
    for (int j = 0; j < 16; ++j) {
        const float kt = kk[j] * __builtin_amdgcn_rcpf(ff[j]);
        kh[j] = kt * PG;
        *(LAS bf16_t*)(lds + HQ + (16 * I + j) * 272 + c * 2) = f2bf(qq[j] * ff[j]);
        *(LAS bf16_t*)(lds + HK + (16 * I + j) * 272 + c * 2) = f2bf(kt);
    }
    u32x4 w0, w1;
    w0.x = pk2(kh[0], kh[1]); w0.y = pk2(kh[2], kh[3]); w0.z = pk2(kh[4], kh[5]); w0.w = pk2(kh[6], kh[7]);
    w1.x = pk2(kh[8], kh[9]); w1.y = pk2(kh[10], kh[11]); w1.z = pk2(kh[12], kh[13]); w1.w = pk2(kh[14], kh[15]);
    *(LAS u32x4*)(lds + HKH + c * 144 + I * 32) = w0; *(LAS u32x4*)(lds + HKH + c * 144 + I * 32 + 16) = w1;
    *(LAS float*)(lds + HDV + (I * 128 + c) * 4) = PG;
}
DEVI void hgrn_update(LAS unsigned char* lds, f32x4 (&Sacc)[8], int I, int wid, int fr, int fq) {
    const int voff = (fq < 2) ? HV + (16 * wid + fr) * 144 + (16 * I + 8 * fq) * 2 : HZERO;
    const int koff = (fq < 2) ? HKH + fr * 144 + (16 * I + 8 * fq) * 2 : HZERO;
    const int kstep = (fq < 2) ? 16 * 144 : 0;
    const bf16x8 vb = *(const LAS bf16x8*)(lds + voff);
    bf16x8 ka[8]; f32x4 dv[8];
#pragma unroll
    for (int m = 0; m < 8; ++m) { ka[m] = *(const LAS bf16x8*)(lds + koff + m * kstep); dv[m] = *(const LAS f32x4*)(lds + HDV + (I * 128 + 16 * m + 4 * fq) * 4); }
#pragma unroll
    for (int m = 0; m < 8; ++m) Sacc[m] = __builtin_amdgcn_mfma_f32_16x16x32_bf16(ka[m], vb, Sacc[m] * dv[m], 0, 0, 0);
}
DEVI void stage_vt(LAS unsigned char* lds, const bf16_t* VT, int b, int h, int t0, int tid) {
    for (int e = tid; e < 128 * 8; e += NTHR) { const int r = e >> 3, cch = e & 7; *(LAS u32x4*)(lds + HV + r * 144 + cch * 16) = *(const u32x4*)(VT + ((size_t)b * 512 + h * 128 + r) * SEQ + t0 + cch * 8); }
}
DEVI void ph_hgrn_states(LAS unsigned char* lds, const bf16_t* u, const bf16_t* VT, const float* lbraw, float* HS, float* HD, int vb0, int vbs) {
    const int tid = opq((int)threadIdx.x), wid = __builtin_amdgcn_readfirstlane(tid >> 6), lane = tid & 63, fr = lane & 15, fq = lane >> 4;
    const int pc = tid & 127, pI = tid >> 7;
    for (int unit = vb0; unit < NB * 4 * 2 * 16; unit += vbs) {
        const int seg = unit & 15, dir = (unit >> 4) & 1, h = (unit >> 5) & 3, b = unit >> 7;
        const float lbv = lb_of(lbraw, h * 128 + pc);
        f32x4 Sacc[8];
#pragma unroll
        for (int m = 0; m < 8; ++m) Sacc[m] = (f32x4){0.f, 0.f, 0.f, 0.f};
        float gprod = 1.f;
        if (tid < 4) *(LAS unsigned*)(lds + HZERO + tid * 4) = 0u;
        HgrnRaw R; hgrn_load(R, u, VT, dir, b, h, seg * 256 + (dir ? 3 : 0) * 64, pc, pI, tid);
#pragma unroll 1
        for (int sbi = 0; sbi < 4; ++sbi) {
            const int sb = dir ? 3 - sbi : sbi;
            const int t0 = seg * 256 + sb * 64;
            __syncthreads();
            hgrn_prep(lds, R, lbv, dir, pc, pI, tid);
            if (sbi < 3) { const int sbn = dir ? 3 - (sbi + 1) : sbi + 1; hgrn_load(R, u, VT, dir, b, h, seg * 256 + sbn * 64, pc, pI, tid); }
            __syncthreads();
            if (tid < 128) gprod *= (*(const LAS float*)(lds + HDV + tid * 4) * *(const LAS float*)(lds + HDV + (128 + tid) * 4)) * (*(const LAS float*)(lds + HDV + (256 + tid) * 4) * *(const LAS float*)(lds + HDV + (384 + tid) * 4));
#pragma unroll 1
            for (int ii = 0; ii < 4; ++ii) { const int I = dir ? 3 - ii : ii; hgrn_update(lds, Sacc, I, wid, fr, fq); }
        }
        const size_t scan = (size_t)(b * 4 + h) * 2 + dir;
        float* dst = HS + scan * HS_SCAN + (size_t)seg * 16384;
#pragma unroll
        for (int m = 0; m < 8; ++m)
#pragma unroll
            for (int rg = 0; rg < 4; ++rg) dst[(16 * m + 4 * fq + rg) * 128 + 16 * wid + fr] = Sacc[m][rg];
        if (tid < 128) HD[(scan * 16 + seg) * 128 + tid] = gprod;
    }
    __syncthreads();
}
DEVI void ph_hgrn_scan(float* HS, const float* HD, int vb0, int vbs) {
    const int tid = opq((int)threadIdx.x);
    for (int idx = vb0 * NTHR + tid; idx < 32 * 4096; idx += vbs * NTHR) {
        const int scan = idx >> 12, e4 = idx & 4095, kch = e4 >> 5; const int dir = scan & 1;
        float4* base = (float4*)(HS + (size_t)scan * HS_SCAN) + e4;
        const float* hd = HD + (size_t)scan * 16 * 128 + kch;
        float4 d[16]; float dec[16];
#pragma unroll
        for (int i = 0; i < 16; ++i) { d[i] = base[(size_t)i * 4096]; dec[i] = hd[i * 128]; }
        float4 st = make_float4(0.f, 0.f, 0.f, 0.f);
        if (dir == 0) {
#pragma unroll
            for (int i = 0; i < 16; ++i) { const float4 t = d[i]; d[i] = st; st.x = st.x * dec[i] + t.x; st.y = st.y * dec[i] + t.y; st.z = st.z * dec[i] + t.z; st.w = st.w * dec[i] + t.w; }
        } else {
#pragma unroll
            for (int i = 15; i >= 0; --i) { const float4 t = d[i]; d[i] = st; st.x = st.x * dec[i] + t.x; st.y = st.y * dec[i] + t.y; st.z = st.z * dec[i] + t.z; st.w = st.w * dec[i] + t.w; }
        }
#pragma unroll
        for (int i = 0; i < 16; ++i) base[(size_t)i * 4096] = d[i];
    }
}
DEVI void ph_hgrn_out(LAS unsigned char* lds, const bf16_t* u, const bf16_t* VT, const float* lbraw, const float* a_norm, const float* HS, float* OF, bf16_t* ocat, int vb0, int vbs) {
    const int tid = opq((int)threadIdx.x), wid = __builtin_amdgcn_readfirstlane(tid >> 6), lane = tid & 63, fr = lane & 15, fq = lane >> 4;
    const int pc = tid & 127, pI = tid >> 7;
    const int otok = tid >> 3, opart = tid & 7;
    for (int unit = vb0; unit < NB * 4 * 16; unit += vbs) {
        const int seg = unit & 15, h = (unit >> 4) & 3, b = unit >> 6;
        const float lbv = lb_of(lbraw, h * 128 + pc);
        if (tid < 4) *(LAS unsigned*)(lds + HZERO + tid * 4) = 0u;
#pragma unroll 1
        for (int dir = 0; dir < 2; ++dir) {
            const size_t scan = (size_t)(b * 4 + h) * 2 + dir;
            const float* src = HS + scan * HS_SCAN + (size_t)seg * 16384;
            f32x4 Sacc[8];
#pragma unroll
            for (int m = 0; m < 8; ++m)
#pragma unroll
                for (int rg = 0; rg < 4; ++rg) Sacc[m][rg] = src[(16 * m + 4 * fq + rg) * 128 + 16 * wid + fr];
            HgrnRaw R; hgrn_load(R, u, VT, dir, b, h, seg * 256 + (dir ? 3 : 0) * 64, pc, pI, tid);
#pragma unroll 1
            for (int sbi = 0; sbi < 4; ++sbi) {
                const int sb = dir ? 3 - sbi : sbi;
                const int t0 = seg * 256 + sb * 64;
                const size_t tokb = (size_t)b * SEQ + t0;
                __syncthreads();
                hgrn_prep(lds, R, lbv, dir, pc, pI, tid);
                if (sbi < 3) { const int sbn = dir ? 3 - (sbi + 1) : sbi + 1; hgrn_load(R, u, VT, dir, b, h, seg * 256 + sbn * 64, pc, pI, tid); }
                __syncthreads();
#pragma unroll 1
                for (int ii = 0; ii < 4; ++ii) {
                    const int I = dir ? 3 - ii : ii;
                    f32x4 oT = {0.f, 0.f, 0.f, 0.f};
                    const LAS unsigned char* qrow = lds + HQ + (16 * I + fr) * 272;
#pragma unroll
                    for (int ks = 0; ks < 4; ++ks) {
                        u32x4 sa; sa.x = pg8::cvt_pk_bf16(Sacc[2 * ks][0], Sacc[2 * ks][1]); sa.y = pg8::cvt_pk_bf16(Sacc[2 * ks][2], Sacc[2 * ks][3]);
                        sa.z = pg8::cvt_pk_bf16(Sacc[2 * ks + 1][0], Sacc[2 * ks + 1][1]); sa.w = pg8::cvt_pk_bf16(Sacc[2 * ks + 1][2], Sacc[2 * ks + 1][3]);
                        const u32x2 q0 = *(const LAS u32x2*)(qrow + (32 * ks + 4 * fq) * 2), q1 = *(const LAS u32x2*)(qrow + (32 * ks + 16 + 4 * fq) * 2);
                        u32x4 qb; qb.x = q0.x; qb.y = q0.y; qb.z = q1.x; qb.w = q1.y;
                        oT = __builtin_amdgcn_mfma_f32_16x16x32_bf16(__builtin_bit_cast(bf16x8, sa), __builtin_bit_cast(bf16x8, qb), oT, 0, 0, 0);
                    }
                    f32x4 sT = {0.f, 0.f, 0.f, 0.f};
                    const LAS unsigned char* krow = lds + HK + (16 * I + fr) * 272;
#pragma unroll
                    for (int ks = 0; ks < 4; ++ks) {
                        const bf16x8 ka = *(const LAS bf16x8*)(krow + (32 * ks + 8 * fq) * 2), qb = *(const LAS bf16x8*)(qrow + (32 * ks + 8 * fq) * 2);
                        sT = __builtin_amdgcn_mfma_f32_16x16x32_bf16(ka, qb, sT, 0, 0, 0);
                    }
                    float pv[4];
#pragma unroll
                    for (int rg = 0; rg < 4; ++rg) { const int sl = 4 * fq + rg; const bool ok = dir ? (sl >= fr) : (sl <= fr); pv[rg] = ok ? sT[rg] : 0.f; }
                    u32x4 pb; pb.x = pg8::cvt_pk_bf16(pv[0], pv[1]); pb.y = pg8::cvt_pk_bf16(pv[2], pv[3]); pb.z = 0u; pb.w = 0u;
                    const u32x2 v0 = *(const LAS u32x2*)(lds + HV + (16 * wid + fr) * 144 + (16 * I + 4 * fq) * 2);
                    u32x4 va; va.x = v0.x; va.y = v0.y; va.z = 0u; va.w = 0u;
                    oT = __builtin_amdgcn_mfma_f32_16x16x32_bf16(__builtin_bit_cast(bf16x8, va), __builtin_bit_cast(bf16x8, pb), oT, 0, 0, 0);
                    if (dir == 0) *(f32x4*)(OF + (tokb + 16 * I + fr) * 512 + h * 128 + 16 * wid + 4 * fq) = oT;
                    else *(LAS f32x4*)(lds + HOT + (16 * I + fr) * 528 + (16 * wid + 4 * fq) * 4) = oT;
                    hgrn_update(lds, Sacc, I, wid, fr, fq);
                }
                if (dir == 1) {
                    __syncthreads();
                    const LAS float* orow = (const LAS float*)(lds + HOT + otok * 528) + opart * 16;
                    float* ofp = OF + (tokb + otok) * 512 + h * 128 + opart * 16;
                    float v[16]; float ss = 0.f;
#pragma unroll
                    for (int q2 = 0; q2 < 8; ++q2) { const unsigned long long w = __hip_atomic_load((unsigned long long*)(ofp + q2 * 2), __ATOMIC_RELAXED, __HIP_MEMORY_SCOPE_AGENT);
                        v[2 * q2] = __uint_as_float((unsigned)w) + orow[2 * q2]; v[2 * q2 + 1] = __uint_as_float((unsigned)(w >> 32)) + orow[2 * q2 + 1];
                        ss += v[2 * q2] * v[2 * q2] + v[2 * q2 + 1] * v[2 * q2 + 1]; }
                    ss += __shfl_xor(ss, 1); ss += __shfl_xor(ss, 2); ss += __shfl_xor(ss, 4);
                    const float rn = rsqrtf(ss * (1.f / 128.f) + EPS);
                    const bf16_t* gp = u + (tokb + otok) * UW + 2048 + h * 128 + opart * 16;
                    const u32x4 g0 = *(const u32x4*)gp, g1 = *(const u32x4*)(gp + 8);
                    const unsigned gw[8] = {g0.x, g0.y, g0.z, g0.w, g1.x, g1.y, g1.z, g1.w};
                    unsigned ow[8];
#pragma unroll
                    for (int q2 = 0; q2 < 8; ++q2) { const float an0 = a_norm[opart * 16 + 2 * q2], an1 = a_norm[opart * 16 + 2 * q2 + 1];
                        ow[q2] = pk2(v[2 * q2] * rn * an0 * silu_f(bflo(gw[q2])), v[2 * q2 + 1] * rn * an1 * silu_f(bfhi(gw[q2]))); }
                    bf16_t* op = ocat + (tokb + otok) * DM + h * 128 + opart * 16;
                    u32x4 o0, o1; o0.x = ow[0]; o0.y = ow[1]; o0.z = ow[2]; o0.w = ow[3]; o1.x = ow[4]; o1.y = ow[5]; o1.z = ow[6]; o1.w = ow[7];
                    *(u32x4*)op = o0; *(u32x4*)(op + 8) = o1;
                }
            }
            asm volatile("s_waitcnt vmcnt(0)" ::: "memory");
        }
    }
    __syncthreads();
}

DEVI void ph_prep(const bf16_t* u, const float* cw, const float* cb, bf16_t* xconv, bf16_t* XT, bf16_t* VT, int vb0, int vbs) {
    const int tid = opq((int)threadIdx.x);
    for (int unit = vb0; unit < NB * 32 * 3; unit += vbs) {
        const int cg = unit % 3, tb = (unit / 3) & 31, b = unit / 96;
        const int t0 = tb * 128;
        if (cg < 2) {
            const int ch = cg * 512 + tid;
            float w[5];
#pragma unroll
            for (int j = 0; j < 5; ++j) w[j] = cw[j * 1024 + ch];
            const float bias = cb[ch];
            const bf16_t* up = u + (size_t)b * SEQ * UW + 3072 + ch;
            float v0, v1, v2, v3;
            v0 = (t0 - 2 >= 0) ? bf2f(up[(size_t)(t0 - 2) * UW]) : 0.f;
            v1 = (t0 - 1 >= 0) ? bf2f(up[(size_t)(t0 - 1) * UW]) : 0.f;
            v2 = bf2f(up[(size_t)t0 * UW]);
            v3 = bf2f(up[(size_t)(t0 + 1) * UW]);
            for (int t8 = 0; t8 < 128; t8 += 32) {
                float nx[32];
#pragma unroll
                for (int i = 0; i < 32; ++i) { const int tt = t0 + t8 + i + 2; nx[i] = (tt < SEQ) ? bf2f(up[(size_t)tt * UW]) : 0.f; }
                unsigned pk[16];
#pragma unroll
                for (int i = 0; i < 32; ++i) {
                    const float o = silu_f(bias + w[0] * v0 + w[1] * v1 + w[2] * v2 + w[3] * v3 + w[4] * nx[i]);
                    const bf16_t ob = f2bf(o);
                    xconv[(size_t)(b * SEQ + t0 + t8 + i) * 1024 + ch] = ob;
                    if (i & 1) pk[i >> 1] |= ((unsigned)ob << 16); else pk[i >> 1] = ob;
                    v0 = v1; v1 = v2; v2 = v3; v3 = nx[i];
                }
                if (ch < 768) {
#pragma unroll
                    for (int q = 0; q < 4; ++q) { u32x4 o4; o4.x = pk[4 * q]; o4.y = pk[4 * q + 1]; o4.z = pk[4 * q + 2]; o4.w = pk[4 * q + 3]; *(u32x4*)(XT + ((size_t)b * 768 + ch) * SEQ + t0 + t8 + 8 * q) = o4; } }
            }
        } else {
            const int ch = tid;
            const bf16_t* up = u + (size_t)b * SEQ * UW + 1536 + ch;
            for (int t8 = 0; t8 < 128; t8 += 32) {
                unsigned pk[16];
#pragma unroll
                for (int i = 0; i < 32; ++i) { const unsigned ob = up[(size_t)(t0 + t8 + i) * UW]; if (i & 1) pk[i >> 1] |= (ob << 16); else pk[i >> 1] = ob; }
#pragma unroll
                for (int q = 0; q < 4; ++q) { u32x4 o4; o4.x = pk[4 * q]; o4.y = pk[4 * q + 1]; o4.z = pk[4 * q + 2]; o4.w = pk[4 * q + 3]; *(u32x4*)(VT + ((size_t)b * 512 + ch) * SEQ + t0 + t8 + 8 * q) = o4; }
            }
        }
    }
}

constexpr int MB_XT = 0, MB_BX = 256 * 272, MB_DT = MB_BX + 128 * 272, MB_CS = MB_DT + 8 * 128 * 4, MB_TOT = MB_CS + 8 * 128 * 4, MB_END = MB_TOT + 64;
static_assert(MB_END <= 131072, "mamba lds");
constexpr size_t MS_SCAN = (size_t)32 * 8192;
DEVI bf16x8 pack8(const float* v) { u32x4 w; w.x = pg8::cvt_pk_bf16(v[0], v[1]); w.y = pg8::cvt_pk_bf16(v[2], v[3]); w.z = pg8::cvt_pk_bf16(v[4], v[5]); w.w = pg8::cvt_pk_bf16(v[6], v[7]); return __builtin_bit_cast(bf16x8, w); }
DEVI void mamba_tables(LAS unsigned char* lds, const float* dtraw, const float* A_log, const float* dt_bias, int b, int g, int c, int wid, int lane) {
    LAS float* tdt = (LAS float*)(lds + MB_DT); LAS float* tcs = (LAS float*)(lds + MB_CS); LAS float* ttot = (LAS float*)(lds + MB_TOT);
    const int r = wid >> 1, dir = wid & 1, hd = 4 * g + r;
    const float A = -__expf(A_log[dir * 8 + hd]), bias = dt_bias[dir * 8 + hd];
    const size_t tk = (size_t)b * SEQ + c * 128 + 2 * lane;
    const float dt0 = softplus_f(dtraw[tk * 16 + dir * 8 + hd] + bias), dt1 = softplus_f(dtraw[(tk + 1) * 16 + dir * 8 + hd] + bias);
    const float a0 = dt0 * A, a1 = dt1 * A;
    float sc = a0 + a1;
#pragma unroll
    for (int off = 1; off < 64; off <<= 1) { const float v = __shfl_up(sc, off); if (lane >= off) sc += v; }
    const float total = __shfl(sc, 63);
    const float pre0 = sc - a1, pre1 = sc;
    const float c0 = dir ? (total - pre0 + a0) : pre0, c1 = dir ? (total - pre1 + a1) : pre1;
    tdt[wid * 128 + 2 * lane] = dt0; tdt[wid * 128 + 2 * lane + 1] = dt1;
    tcs[wid * 128 + 2 * lane] = c0; tcs[wid * 128 + 2 * lane + 1] = c1;
    if (lane == 0) ttot[wid] = total;
}
DEVI void stage_rows(LAS unsigned char* dst, const bf16_t* src, size_t src_stride, int rows, int tid) {
    for (int e = tid; e < rows * 16; e += NTHR) { const int r = e >> 4, cch = e & 15; *(LAS u32x4*)(dst + r * 272 + cch * 16) = *(const u32x4*)(src + (size_t)r * src_stride + cch * 8); }
}
DEVI void ph_mamba_states(LAS unsigned char* lds, const bf16_t* XT, const float* dtraw, const float* A_log, const float* dt_bias, float* MS, float* MD, int vb0, int vbs) {
    const int tid = opq((int)threadIdx.x), wid = __builtin_amdgcn_readfirstlane(tid >> 6), lane = tid & 63, fr = lane & 15, fq = lane >> 4;
    LAS float* tdt = (LAS float*)(lds + MB_DT); LAS float* tcs = (LAS float*)(lds + MB_CS); LAS float* ttot = (LAS float*)(lds + MB_TOT);
    for (int unit = vb0; unit < NB * 2 * 32; unit += vbs) {
        const int c = unit & 31, g = (unit >> 5) & 1, b = unit >> 6;
        __syncthreads();
        stage_rows(lds + MB_XT, XT + ((size_t)b * 768 + g * 256) * SEQ + c * 128, SEQ, 256, tid);
        stage_rows(lds + MB_BX, XT + ((size_t)b * 768 + 512 + g * 128) * SEQ + c * 128, SEQ, 128, tid);
        mamba_tables(lds, dtraw, A_log, dt_bias, b, g, c, wid, lane);
        __syncthreads();
        if (lane == 0) MD[((size_t)(b * 8 + 4 * g + (wid >> 1)) * 2 + (wid & 1)) * 32 + c] = __expf(ttot[wid]);
        for (int hdd = 0; hdd < 8; ++hdd) {
            const int r = hdd >> 1, dir = hdd & 1, hd = 4 * g + r;
            const float tot = ttot[hdd];
            f32x4 acc[4];
#pragma unroll
            for (int pt = 0; pt < 4; ++pt) acc[pt] = (f32x4){0.f, 0.f, 0.f, 0.f};
#pragma unroll
            for (int ks = 0; ks < 4; ++ks) {
                const int s0 = 32 * ks + 8 * fq;
                const u32x4 braw = *(const LAS u32x4*)(lds + MB_BX + (16 * wid + fr) * 272 + s0 * 2);
                float bw[8];
                const unsigned bu[4] = {braw.x, braw.y, braw.z, braw.w};
#pragma unroll
                for (int j = 0; j < 8; ++j) { const float bv = (j & 1) ? bfhi(bu[j >> 1]) : bflo(bu[j >> 1]);
                    bw[j] = bv * tdt[hdd * 128 + s0 + j] * __expf(tot - tcs[hdd * 128 + s0 + j]); }
                const bf16x8 Bf = pack8(bw);
#pragma unroll
                for (int pt = 0; pt < 4; ++pt) {
                    const bf16x8 Af = *(const LAS bf16x8*)(lds + MB_XT + (r * 64 + 16 * pt + fr) * 272 + s0 * 2);
                    acc[pt] = __builtin_amdgcn_mfma_f32_16x16x32_bf16(Af, Bf, acc[pt], 0, 0, 0);
                }
            }
            float* dst = MS + ((size_t)(b * 8 + hd) * 2 + dir) * MS_SCAN + (size_t)c * 8192;
#pragma unroll
            for (int pt = 0; pt < 4; ++pt)
#pragma unroll
                for (int rg = 0; rg < 4; ++rg) dst[(16 * pt + 4 * fq + rg) * 128 + 16 * wid + fr] = acc[pt][rg];
        }
    }
    __syncthreads();
}
DEVI void ph_mamba_scan(float* MS, const float* MD, int vb0, int vbs) {
    const int tid = opq((int)threadIdx.x);
    for (int idx = vb0 * NTHR + tid; idx < 64 * 2048; idx += vbs * NTHR) {
        const int scan = idx >> 11, e4 = idx & 2047; const int dir = scan & 1;
        float4* base = (float4*)(MS + (size_t)scan * MS_SCAN) + e4;
        const float* md = MD + (size_t)scan * 32;
        float4 h = make_float4(0.f, 0.f, 0.f, 0.f);
#pragma unroll 1
        for (int half = 0; half < 2; ++half) {
            const int c0 = (dir ? 1 - half : half) * 16;
            float4 d[16]; float dec[16];
#pragma unroll
            for (int i = 0; i < 16; ++i) { d[i] = base[(size_t)(c0 + i) * 2048]; dec[i] = md[c0 + i]; }
            if (dir == 0) {
#pragma unroll
                for (int i = 0; i < 16; ++i) { const float4 t = d[i]; d[i] = h; h.x = h.x * dec[i] + t.x; h.y = h.y * dec[i] + t.y; h.z = h.z * dec[i] + t.z; h.w = h.w * dec[i] + t.w; }
            } else {
#pragma unroll
                for (int i = 15; i >= 0; --i) { const float4 t = d[i]; d[i] = h; h.x = h.x * dec[i] + t.x; h.y = h.y * dec[i] + t.y; h.z = h.z * dec[i] + t.z; h.w = h.w * dec[i] + t.w; }
            }
#pragma unroll
            for (int i = 0; i < 16; ++i) base[(size_t)(c0 + i) * 2048] = d[i];
        }
    }
}
DEVI void ph_mamba_out(LAS unsigned char* lds, const bf16_t* u, const bf16_t* xconv, const bf16_t* XT, const float* dtraw, const float* A_log, const float* dt_bias, const float* Dskip, const float* b_norm,
                       const float* MS, bf16_t* ocat, int vb0, int vbs) {
    const int tid = opq((int)threadIdx.x), wid = __builtin_amdgcn_readfirstlane(tid >> 6), lane = tid & 63, fr = lane & 15, fq = lane >> 4;
    LAS float* tdt = (LAS float*)(lds + MB_DT); LAS float* tcs = (LAS float*)(lds + MB_CS);
    for (int unit = vb0; unit < NB * 2 * 32; unit += vbs) {
        const int c = unit & 31, g = (unit >> 5) & 1, b = unit >> 6;
        const size_t tok0 = (size_t)b * SEQ + c * 128;
        __syncthreads();
        stage_rows(lds + MB_XT, XT + ((size_t)b * 768 + g * 256) * SEQ + c * 128, SEQ, 256, tid);
        stage_rows(lds + MB_BX, xconv + tok0 * 1024 + 512 + g * 128, 1024, 128, tid);
        mamba_tables(lds, dtraw, A_log, dt_bias, b, g, c, wid, lane);
        const int tl = 16 * wid + fr;
        bf16x8 Cf[4];
#pragma unroll
        for (int ks = 0; ks < 4; ++ks) Cf[ks] = *(const bf16x8*)(xconv + (tok0 + tl) * 1024 + 768 + g * 128 + 32 * ks + 8 * fq);
        __syncthreads();
        f32x4 GT[8];
#pragma unroll
        for (int st = 0; st < 8; ++st) { GT[st] = (f32x4){0.f, 0.f, 0.f, 0.f};
#pragma unroll
            for (int ks = 0; ks < 4; ++ks) { const bf16x8 Af = *(const LAS bf16x8*)(lds + MB_BX + (16 * st + fr) * 272 + (32 * ks + 8 * fq) * 2);
                GT[st] = __builtin_amdgcn_mfma_f32_16x16x32_bf16(Af, Cf[ks], GT[st], 0, 0, 0); } }
        float ss = 0.f;
        __syncthreads();
        float4 hpre[4];
        { const float* hin0 = MS + ((size_t)(b * 8 + 4 * g) * 2) * MS_SCAN + (size_t)c * 8192;
#pragma unroll
          for (int q = 0; q < 4; ++q) hpre[q] = ((const float4*)hin0)[tid + q * NTHR]; }
#pragma unroll 1
        for (int r = 0; r < 4; ++r) {
            const int hd = 4 * g + r;
            f32x4 yv[4];
#pragma unroll
            for (int pt = 0; pt < 4; ++pt) yv[pt] = (f32x4){0.f, 0.f, 0.f, 0.f};
#pragma unroll 1
            for (int dir = 0; dir < 2; ++dir) {
                const int hdd = r * 2 + dir;
                const float cst = tcs[hdd * 128 + tl];
                LAS unsigned char* hbuf = lds + MB_BX + (hdd & 1) * 17408;
#pragma unroll
                for (int q = 0; q < 4; ++q) { const int e4 = tid + q * NTHR, pp = e4 >> 5, n4 = (e4 & 31) * 4;
                    u32x2 w; w.x = pk2(hpre[q].x, hpre[q].y); w.y = pk2(hpre[q].z, hpre[q].w); *(LAS u32x2*)(hbuf + pp * 272 + n4 * 2) = w; }
                if (hdd < 7) { const int hn = hdd + 1; const float* hinn = MS + ((size_t)(b * 8 + 4 * g + (hn >> 1)) * 2 + (hn & 1)) * MS_SCAN + (size_t)c * 8192;
#pragma unroll
                    for (int q = 0; q < 4; ++q) hpre[q] = ((const float4*)hinn)[tid + q * NTHR]; }
                __syncthreads();
                f32x4 yo[4];
#pragma unroll
                for (int pt = 0; pt < 4; ++pt) { yo[pt] = (f32x4){0.f, 0.f, 0.f, 0.f};
#pragma unroll
                    for (int ks = 0; ks < 4; ++ks) { const bf16x8 hf = *(const LAS bf16x8*)(hbuf + (16 * pt + fr) * 272 + (32 * ks + 8 * fq) * 2);
                        yo[pt] = __builtin_amdgcn_mfma_f32_16x16x32_bf16(hf, Cf[ks], yo[pt], 0, 0, 0); } }
                const float eo = __expf(cst);
#pragma unroll
                for (int pt = 0; pt < 4; ++pt) yv[pt] += yo[pt] * eo;
#pragma unroll
                for (int kp = 0; kp < 4; ++kp) {
                    const bool skip = dir ? (2 * kp + 1 < wid) : (2 * kp > wid);
                    if (!skip) {
                        float pv[8];
#pragma unroll
                        for (int hlf = 0; hlf < 2; ++hlf)
#pragma unroll
                            for (int rg = 0; rg < 4; ++rg) { const int st = 2 * kp + hlf, sl = 16 * st + 4 * fq + rg;
                                const bool ok = dir ? (sl >= tl) : (sl <= tl);
                                const float e = __expf(fminf(cst - tcs[hdd * 128 + sl], 0.f));
                                pv[hlf * 4 + rg] = ok ? GT[st][rg] * e * tdt[hdd * 128 + sl] : 0.f; }
                        const bf16x8 Pf = pack8(pv);
#pragma unroll
                        for (int pt = 0; pt < 4; ++pt) {
                            const LAS unsigned char* xr = lds + MB_XT + (r * 64 + 16 * pt + fr) * 272;
                            const u32x2 x0 = *(const LAS u32x2*)(xr + (32 * kp + 4 * fq) * 2), x1 = *(const LAS u32x2*)(xr + (32 * kp + 16 + 4 * fq) * 2);
                            u32x4 xa; xa.x = x0.x; xa.y = x0.y; xa.z = x1.x; xa.w = x1.y;
                            yv[pt] = __builtin_amdgcn_mfma_f32_16x16x32_bf16(__builtin_bit_cast(bf16x8, xa), Pf, yv[pt], 0, 0, 0);
                        }
                    }
                }
            }
            const float Dk = Dskip[hd];
#pragma unroll
            for (int pt = 0; pt < 4; ++pt) {
                const int p0 = 16 * pt + 4 * fq;
                const u32x2 xr = *(const u32x2*)(xconv + (tok0 + tl) * 1024 + hd * 64 + p0);
                const u32x2 zr = *(const u32x2*)(u + (tok0 + tl) * UW + 2560 + hd * 64 + p0);
                const float xs[4] = {bflo(xr.x), bfhi(xr.x), bflo(xr.y), bfhi(xr.y)}, zs[4] = {bflo(zr.x), bfhi(zr.x), bflo(zr.y), bfhi(zr.y)};
                float yy[4];
#pragma unroll
                for (int rg = 0; rg < 4; ++rg) { const float y = (yv[pt][rg] + Dk * xs[rg]) * silu_f(zs[rg]); yy[rg] = y; ss += y * y; }
                const unsigned long long o = (unsigned long long)pk2(yy[0], yy[1]) | ((unsigned long long)pk2(yy[2], yy[3]) << 32);
                __hip_atomic_store((unsigned long long*)(ocat + (tok0 + tl) * DM + 512 + g * 256 + r * 64 + p0), o, __ATOMIC_RELAXED, __HIP_MEMORY_SCOPE_AGENT);
            }
        }
        ss += __shfl_xor(ss, 16); ss += __shfl_xor(ss, 32);
        const float rn = rsqrtf(ss * (1.f / 256.f) + EPS);
        asm volatile("s_waitcnt vmcnt(0)" ::: "memory");
#pragma unroll 1
        for (int r = 0; r < 4; ++r)
#pragma unroll
            for (int pt = 0; pt < 4; ++pt) {
                const int cc = g * 256 + r * 64 + 16 * pt + 4 * fq;
                unsigned long long* op = (unsigned long long*)(ocat + (tok0 + tl) * DM + 512 + cc);
                const unsigned long long v = __hip_atomic_load(op, __ATOMIC_RELAXED, __HIP_MEMORY_SCOPE_AGENT);
                const unsigned vlo = (unsigned)v, vhi = (unsigned)(v >> 32);
                const float4 bn = *(const float4*)(b_norm + cc);
                const unsigned long long o = (unsigned long long)pk2(bflo(vlo) * rn * bn.x, bfhi(vlo) * rn * bn.y) | ((unsigned long long)pk2(bflo(vhi) * rn * bn.z, bfhi(vhi) * rn * bn.w) << 32);
                *op = o;
            }
    }
    __syncthreads();
}


constexpr int NA_RING = 12, NA_VT = 0, NA_VSTRIDE = NA_RING * 64 * 2 + 16, NA_BIAS = 64 * NA_VSTRIDE, NA_END = NA_BIAS + 480 * 4;
static_assert(NA_END <= 131072, "na lds");
DEVI void ph_na(LAS unsigned char* lds, const bf16_t* qkv, const float* rpb, bf16_t* oc, int vb0, int vbs) {
    const int tid = opq((int)threadIdx.x), wid = __builtin_amdgcn_readfirstlane(tid >> 6), lane = tid & 63, fr = lane & 15, fq = lane >> 4;
    LAS float* bl = (LAS float*)(lds + NA_BIAS);
    for (int chunk = vb0; chunk < NB * 16 * 4; chunk += vbs) {
        const int qr4 = chunk & 3, h = (chunk >> 2) & 15, b = chunk >> 6;
        __syncthreads();
        for (int e = tid; e < 465; e += NTHR) bl[e] = rpb[h * 465 + e];
        int staged_hi = -1;
#pragma unroll 1
        for (int ui = 0; ui < 8; ++ui) {
            const int rp = qr4 * 8 + ui;
            const int r0 = 2 * rp, rs0 = min(max(r0 - 4, 0), 56);
            const int need_hi = min(rs0 + 8, 63);
            const int lo = max(staged_hi + 1, rs0);
            for (int task = wid; task < (need_hi - lo + 1) * 8; task += 8) {
                const int kr = lo + (task >> 3), ch = task & 7, slot = kr % NA_RING;
                const u32x4 v = *(const u32x4*)(qkv + ((size_t)b * SEQ + kr * 64 + lane) * 3072 + 2048 + h * 64 + ch * 8);
                const unsigned vw[4] = {v.x, v.y, v.z, v.w};
#pragma unroll
                for (int i = 0; i < 8; ++i) *(LAS bf16_t*)(lds + NA_VT + (ch * 8 + i) * NA_VSTRIDE + (slot * 64 + lane) * 2) = (bf16_t)((i & 1) ? (vw[i >> 1] >> 16) : (vw[i >> 1] & 0xffffu));
            }
            staged_hi = need_hi > staged_hi ? need_hi : staged_hi;
            __syncthreads();
            const int r = r0 + (wid >> 2), j = wid & 3;
            const int rs = min(max(r - 4, 0), 56);
            const int bs = (j == 0) ? 0 : (j == 1) ? 8 : (j == 2) ? 24 : 32;
            const int c = 16 * j + fr, qs = min(max(c - 8, 0), 48);
            const size_t qtok = (size_t)b * SEQ + r * 64 + c;
            bf16x8 Qf[2];
#pragma unroll
            for (int ks = 0; ks < 2; ++ks) Qf[ks] = *(const bf16x8*)(qkv + qtok * 3072 + h * 64 + 32 * ks + 8 * fq);
            const bf16_t* kbase = qkv + ((size_t)b * SEQ + rs * 64 + bs + fr) * 3072 + 1024 + h * 64 + 8 * fq;
            bf16x8 kn[4];
#pragma unroll
            for (int q = 0; q < 4; ++q) kn[q] = *(const bf16x8*)(kbase + (size_t)((q >> 1) * 16) * 3072 + (q & 1) * 32);
            f32x4 O[4];
#pragma unroll
            for (int dt = 0; dt < 4; ++dt) O[dt] = (f32x4){0.f, 0.f, 0.f, 0.f};
            float mrun = -1e30f, lrun = 0.f;
#pragma unroll 1
            for (int dr = 0; dr < 8; ++dr) {
                bf16x8 kc[4];
#pragma unroll
                for (int q = 0; q < 4; ++q) kc[q] = kn[q];
                const int drn = dr < 7 ? dr + 1 : 7;
#pragma unroll
                for (int q = 0; q < 4; ++q) kn[q] = *(const bf16x8*)(kbase + ((size_t)drn * 64 + (q >> 1) * 16) * 3072 + (q & 1) * 32);
                float sv[8]; float mloc = -1e30f;
                const LAS float* brow = bl + (rs + dr - r + 7) * 31;
#pragma unroll
                for (int kg = 0; kg < 2; ++kg) {
                    f32x4 acc = {0.f, 0.f, 0.f, 0.f};
                    acc = __builtin_amdgcn_mfma_f32_16x16x32_bf16(kc[kg * 2], Qf[0], acc, 0, 0, 0);
                    acc = __builtin_amdgcn_mfma_f32_16x16x32_bf16(kc[kg * 2 + 1], Qf[1], acc, 0, 0, 0);
#pragma unroll
                    for (int rg = 0; rg < 4; ++rg) {
                        const int kcol = bs + 16 * kg + 4 * fq + rg;
                        const bool ok = (kcol >= qs) && (kcol < qs + 16);
                        const int dc = min(max(kcol - c + 15, 0), 30);
                        const float sc = ok ? acc[rg] * 0.125f + brow[dc] : -1e30f;
                        sv[kg * 4 + rg] = sc; mloc = fmaxf(mloc, sc);
                    }
                }
                mloc = fmaxf(mloc, __shfl_xor(mloc, 16)); mloc = fmaxf(mloc, __shfl_xor(mloc, 32));
                const float mnew = fmaxf(mrun, mloc);
                const float alpha = __expf(mrun - mnew);
                float psum = 0.f;
#pragma unroll
                for (int i = 0; i < 8; ++i) { const float p = __expf(sv[i] - mnew); sv[i] = p; psum += p; }
                psum += __shfl_xor(psum, 16); psum += __shfl_xor(psum, 32);
                lrun = lrun * alpha + psum; mrun = mnew;
                const bf16x8 Pf = pack8(sv);
                const int koff = (((rs + dr) % NA_RING) * 64 + bs + 4 * fq) * 2;
#pragma unroll
                for (int dt = 0; dt < 4; ++dt) {
                    const LAS unsigned char* vr = lds + NA_VT + (16 * dt + fr) * NA_VSTRIDE + koff;
                    const u32x2 v0 = *(const LAS u32x2*)vr, v1 = *(const LAS u32x2*)(vr + 32);
                    u32x4 va; va.x = v0.x; va.y = v0.y; va.z = v1.x; va.w = v1.y;
                    O[dt] = __builtin_amdgcn_mfma_f32_16x16x32_bf16(__builtin_bit_cast(bf16x8, va), Pf, O[dt] * alpha, 0, 0, 0);
                }
            }
            const float il = 1.f / lrun;
#pragma unroll
            for (int dt = 0; dt < 4; ++dt) {
                u32x2 o; o.x = pk2(O[dt][0] * il, O[dt][1] * il); o.y = pk2(O[dt][2] * il, O[dt][3] * il);
                *(u32x2*)(oc + qtok * DM + h * 64 + 16 * dt + 4 * fq) = o;
            }
        }
    }
    __syncthreads();
}

DEVI void ph_na_naive(const bf16_t* qkv, const float* rpb, bf16_t* oc, int vb0, int vbs) {
    for (int e4 = vb0 * NTHR + opq((int)threadIdx.x); e4 < MT * 16 * 4; e4 += vbs * NTHR) {
        const int dq = e4 & 3, e = e4 >> 2;
        const int hd = e / MT, tok = e % MT;
        const int b = tok >> 12, t = tok & 4095, r = t >> 6, c = t & 63;
        const int rs = min(max(r - 4, 0), 56), qs = min(max(c - 8, 0), 48);
        float q[16], o[16];
        const bf16_t* qp = qkv + (size_t)tok * 3072 + hd * 64 + dq * 16;
#pragma unroll
        for (int d = 0; d < 16; ++d) { q[d] = bf2f(qp[d]); o[d] = 0.f; }
        float m = -1e30f, l = 0.f;
        for (int dr = 0; dr < 8; ++dr)
            for (int dc = 0; dc < 16; ++dc) {
                const int kr = rs + dr, kc = qs + dc;
                const size_t kt = (size_t)b * SEQ + kr * 64 + kc;
                const bf16_t* kp = qkv + kt * 3072 + 1024 + hd * 64 + dq * 16;
                const bf16_t* vp = qkv + kt * 3072 + 2048 + hd * 64 + dq * 16;
                float s = 0.f;
#pragma unroll
                for (int d = 0; d < 16; ++d) s += q[d] * bf2f(kp[d]);
                s += __shfl_xor(s, 1); s += __shfl_xor(s, 2);
                s = s * 0.125f + rpb[hd * 465 + (kr - r + 7) * 31 + (kc - c + 15)];
                const float mn = fmaxf(m, s); const float al = __expf(m - mn), pe = __expf(s - mn);
                l = l * al + pe; m = mn;
#pragma unroll
                for (int d = 0; d < 16; ++d) o[d] = o[d] * al + pe * bf2f(vp[d]);
            }
        const float il = 1.f / l;
        bf16_t* op = oc + (size_t)tok * DM + hd * 64 + dq * 16;
#pragma unroll
        for (int d = 0; d < 16; ++d) op[d] = f2bf(o[d] * il);
    }
}

#define XB_TMO      128
#define XB_XCNT(j)  (256  + 64 * (j))
#define XB_XSUB(j)  (1280 + 64 * (j))
#define XB_XGEN(j)  (2304 + 64 * (j))
#define XB_TOP      3328
#define XB_TOPGEN   3392
#define XCD_BAR_WORDS 3456
#define XB_SPIN_CAP (1u << 18)

__device__ __forceinline__ unsigned xb_ld(unsigned* p)              { return __hip_atomic_load(p, __ATOMIC_RELAXED, __HIP_MEMORY_SCOPE_AGENT); }
__device__ __forceinline__ unsigned xb_add(unsigned* p, unsigned v) { return __hip_atomic_fetch_add(p, v, __ATOMIC_RELAXED, __HIP_MEMORY_SCOPE_AGENT); }
__device__ __forceinline__ unsigned xb_xcc_id() { return (unsigned)__builtin_amdgcn_s_getreg((3 << 11) | 20) & 0xFu; }
#define XB_SPIN(cond, bar) do { unsigned _sp = 0; while (cond) { __builtin_amdgcn_s_sleep(1); \
    if ((++_sp & 255u) == 0u) { if (xb_ld(&(bar)[XB_TMO])) break; if (_sp > XB_SPIN_CAP) { atomicAdd(&(bar)[XB_TMO], 1u); break; } } } } while (0)

struct XcdBarrier {
    unsigned* bar; unsigned x;
    volatile LAS unsigned* st;
};

__device__ __forceinline__ XcdBarrier xcd_barrier_post(unsigned* bar, volatile LAS unsigned* st) {
    XcdBarrier b; b.bar = bar; b.x = xb_xcc_id(); b.st = st;
    if (threadIdx.x == 0) (void)xb_add(&bar[XB_XCNT(b.x)], 1u);
    return b;
}
__device__ __forceinline__ void xcd_barrier_complete(unsigned* bar, unsigned x, unsigned& nloc, unsigned& nx) {
    const unsigned G = gridDim.x * gridDim.y * gridDim.z;
    unsigned sum, cnt, mine, sp = 0u;
    for (;;) {
        sum = 0u; cnt = 0u; mine = 0u;
#pragma unroll
        for (unsigned j = 0; j < 16; ++j) { const unsigned c = xb_ld(&bar[XB_XCNT(j)]); sum += c; cnt += (c > 0u) ? 1u : 0u; mine = (j == x) ? c : mine; }
        if (sum == G) break;
        __builtin_amdgcn_s_sleep(1);
        if ((++sp & 255u) == 0u) { if (xb_ld(&bar[XB_TMO])) break; if (sp > XB_SPIN_CAP) { atomicAdd(&bar[XB_TMO], 1u); break; } }
    }
    nloc = mine > 0u ? mine : 1u; nx = cnt > 0u ? cnt : 1u;
}

__device__ __forceinline__ void xcd_barrier(const XcdBarrier& b) {
    asm volatile("s_waitcnt vmcnt(0)" ::: "memory");
    __syncthreads();
    if (threadIdx.x == 0) {
        unsigned* bar = b.bar;
        __builtin_amdgcn_s_waitcnt(0);
        unsigned nloc = b.st[0], nx = b.st[1];
        if (nloc == 0u) { xcd_barrier_complete(bar, b.x, nloc, nx); b.st[0] = nloc; b.st[1] = nx; }
        const unsigned old = xb_add(&bar[XB_XSUB(b.x)], 1u);
        const unsigned gen = old / nloc;
        if (old + 1u == (gen + 1u) * nloc) {
            __builtin_amdgcn_fence(__ATOMIC_RELEASE, "agent");
            asm volatile("s_waitcnt vmcnt(0)" ::: "memory");
            const unsigned og = xb_add(&bar[XB_TOP], 1u);
            const unsigned tg = og / nx;
            if (og + 1u == (tg + 1u) * nx) xb_add(&bar[XB_TOPGEN], 1u);
            else XB_SPIN(xb_ld(&bar[XB_TOPGEN]) == tg, bar);
            __builtin_amdgcn_fence(__ATOMIC_ACQUIRE, "agent");
            xb_add(&bar[XB_XGEN(b.x)], 1u);
            asm volatile("s_waitcnt vmcnt(0)" ::: "memory");
        } else {
            XB_SPIN(xb_ld(&bar[XB_XGEN(b.x)]) == gen, bar);
            __builtin_amdgcn_fence(__ATOMIC_ACQUIRE, "agent");
            asm volatile("s_waitcnt vmcnt(0)" ::: "memory");
        }
    }
    __syncthreads();
}


struct Args { const float* in[34]; float* out; unsigned char* ws; int ph_lo, ph_hi; };
constexpr int N_PHASES = 22;

__global__ void __launch_bounds__(NTHR, 2) fwd(Args a) {
    extern __shared__ __attribute__((aligned(16))) unsigned char lds_raw[];
    float* lds = (float*)lds_raw;
    LAS unsigned char* ldsl = (LAS unsigned char*)lds_raw;
    const int vb0 = blockIdx.x, vbs = gridDim.x;
    const int lo = a.ph_lo, hi = a.ph_hi;
#define IN(k) (lo <= (k) && (k) < hi)
#define SEAM(k) do { if (IN(k) && IN((k) + 1)) xcd_barrier(bar); } while (0)
    volatile LAS unsigned* misc = (volatile LAS unsigned*)(ldsl + MISC_OFF);
    if (threadIdx.x < 4) misc[threadIdx.x] = 0u;
    __syncthreads();
    XcdBarrier bar = xcd_barrier_post((unsigned*)(a.ws + WS_CTL) + CW_BAR, misc);
    unsigned char* ws = a.ws;
    unsigned* ctl = (unsigned*)(ws + WS_CTL);
    unsigned* cnt = ctl + CW_CNT;
    int* list = (int*)(ws + WS_LIST); float* gatev = (float*)(ws + WS_GATE);
    float* dtraw = (float*)(ws + WS_DT); float* RS = (float*)(ws + WS_RS);
    bf16_t* XB = (bf16_t*)(ws + WS_XB); bf16_t* UB = (bf16_t*)(ws + WS_UB);
    bf16_t* YA = (bf16_t*)(ws + WS_YA); float* OF = (float*)(ws + WS_OF); bf16_t* OC = (bf16_t*)(ws + WS_OC);
    bf16_t* YP = (bf16_t*)(ws + WS_YP); bf16_t* YP1 = (bf16_t*)(ws + WS_YP1); bf16_t* XC = (bf16_t*)(ws + WS_YP);
    bf16_t* PB0 = (bf16_t*)(ws + WS_PB0); bf16_t* PB1 = (bf16_t*)(ws + WS_PB1);
    bf16_t* YB = (bf16_t*)(ws + WS_Y);
    float* MS = (float*)(ws + WS_MS); float* MD = (float*)(ws + WS_MD);
    float* HS = (float*)(ws + WS_HS); float* HD = (float*)(ws + WS_HD);
    bf16_t* XT = (bf16_t*)(ws + WS_XT); bf16_t* VT = (bf16_t*)(ws + WS_VT);
    const float* p_in = a.in[1];
    const int G = (int)gridDim.x, cb = (int)blockIdx.x;
    const NormB NB0{nullptr, XB, nullptr, nullptr, RS, nullptr, nullptr, nullptr, nullptr, nullptr, nullptr, nullptr, nullptr, nullptr, nullptr};
    unsigned char* XG8 = ws + WS_XG8;
    float* rsl = (float*)(ws + WS_DT);

    if (IN(0)) {
        ph_convert_weights(ldsl, a.in, ws, 0, ITEMS_DENSE, vb0, vbs);
        NormB A = NB0; A.xin = a.in[0]; A.gnext = a.in[3]; A.win = a.in[4]; A.dtraw = dtraw;
        ph_norm2<0, false, true, false>(A, vb0, vbs);
    }
    SEAM(0);
    if (IN(1)) { pg8::DenseOrder S; S.init(MT, UW, DM, (const bf16_t*)(ws + W_IN), G, cb); pg8::gemm_phase(ldsl, XB, DM, S, pg8::EpiBf16{UB, UW, RS}); }
    SEAM(1);
    if (IN(2)) { ph_prep(UB, a.in[5], a.in[6], XC, XT, VT, vb0, vbs); }
    SEAM(2);
    if (IN(3)) { ph_hgrn_states(ldsl, UB, VT, a.in[2], HS, HD, vb0, vbs); ph_mamba_states(ldsl, XT, dtraw, a.in[7], a.in[8], MS, MD, vb0, vbs); }
    SEAM(3);
    if (IN(4)) { ph_hgrn_scan(HS, HD, vb0, vbs); ph_mamba_scan(MS, MD, vb0, vbs); }
    SEAM(4);
    if (IN(5)) { ph_hgrn_out(ldsl, UB, VT, a.in[2], a.in[10], HS, OF, OC, vb0, vbs); ph_mamba_out(ldsl, UB, XC, XT, dtraw, a.in[7], a.in[8], a.in[9], a.in[11], MS, OC, vb0, vbs); }
    SEAM(5);
    if (IN(6)) { pg8::DenseOrder S; S.init(MT, DM, DM, (const bf16_t*)(ws + W_OUTE), G, cb); pg8::gemm_phase(ldsl, OC, DM, S, pg8::EpiBf16{YA, DM, nullptr}); }
    SEAM(6);
    if (IN(7)) {
        NormB A = NB0; A.y = YA; A.gpost = a.in[13];
        ph_norm2<1, false, false, false>(A, vb0, vbs);
        ph_cvt_rows(p_in, PB0, (size_t)MT * PDIM / 4, vb0, vbs);
        ph_convert_weights(ldsl, a.in, ws, ITEMS_DENSE, ITEMS_ALL, vb0, vbs);
    }
    SEAM(7);
    if (IN(8)) {
        { pg8::DenseOrder S; S.init(MT, 2 * DFF, DM, (const bf16_t*)(ws + W_GU), G, cb); pg8::gemm_phase(ldsl, XB, DM, S, pg8::EpiSwiglu{UB, DFF, RS, 0}); }
        { pg8::TailOrder S; S.init(MT, DM, PDIM, (const bf16_t*)(ws + W_PP), G, cb, (MT / 256) * (2 * DFF / 256) % G); pg8::gemm_phase(ldsl, PB0, PDIM, S, pg8::EpiBf16{YP, DM, nullptr}); }
    }
    SEAM(8);
    if (IN(9)) { pg8::DenseOrder S; S.init(MT, DM, DFF, (const bf16_t*)(ws + W_DN), G, cb); pg8::gemm_phase(ldsl, UB, DFF, S, pg8::EpiBf16{YA, DM, nullptr}); }
    SEAM(9);
    if (IN(10)) {
        NormB A = NB0; A.y = YA; A.gpost = a.in[18];
        ph_norm2<1, false, false, false>(A, vb0, vbs);
    }
    SEAM(10);
    if (IN(11)) { pg8::DenseOrder S; S.init(MT, DM, DM, (const bf16_t*)(ws + W_PG), G, cb); pg8::gemm_phase(ldsl, XB, DM, S, pg8::EpiPleGate{YP, DM, RS}); }
    SEAM(11);
    if (IN(12)) {
        NormB A = NB0; A.y = YP; A.gpost = a.in[33];
        ph_norm2<1, false, false, false>(A, vb0, vbs);
    }
    SEAM(12);
    if (IN(13)) { pg8::DenseOrder S; S.init(MT, 3072, DM, (const bf16_t*)(ws + W_QKV), G, cb); pg8::gemm_phase(ldsl, XB, DM, S, pg8::EpiBf16{UB, 3072, RS}); }
    SEAM(13);
    if (IN(14)) { ph_na(ldsl, UB, a.in[21], OC, vb0, vbs); }
    SEAM(14);
    if (IN(15)) { pg8::DenseOrder S; S.init(MT, DM, DM, (const bf16_t*)(ws + W_OUTO), G, cb); pg8::gemm_phase(ldsl, OC, DM, S, pg8::EpiBf16{YP1, DM, nullptr}); }
    SEAM(15);
    if (IN(16)) {
        NormB A = NB0; A.y = YP1; A.gpost = a.in[23]; A.gnext = a.in[24]; A.wr = a.in[25]; A.cnt = cnt; A.list = list; A.gatev = gatev; A.rsl = rsl; A.x8 = XG8;
        ph_norm2<1, false, false, true>(A, vb0, vbs);
        ph_cvt_rows(p_in + (size_t)MT * PDIM, PB1, (size_t)MT * PDIM / 4, vb0, vbs);
    }
    SEAM(16);
    if (IN(17)) { pg8::MoeOrder S; S.init(cnt, (volatile LAS int*)(ldsl + MISC_OFF + 64), 2 * DFFE, DM / 2, (const bf16_t*)(ws + W_EGU), (size_t)7 * MiB, true, G, cb);
        pg8::gemm_phase<pg8::EpiSwiglu8, pg8::MoeOrder, true>(ldsl, (const bf16_t*)XG8, DM / 2, S, pg8::EpiSwiglu8{(unsigned char*)UB, DFFE, rsl}); }
    SEAM(17);
    if (IN(18)) { pg8::MoeOrder S; S.init(cnt, (volatile LAS int*)(ldsl + MISC_OFF + 64), DM, DFFE / 2, (const bf16_t*)(ws + W_EDN), (size_t)(7 * MiB / 2), false, G, cb);
        pg8::gemm_phase<pg8::EpiMoeDown, pg8::MoeOrder, true>(ldsl, UB, DFFE / 2, S, pg8::EpiMoeDown{YB, list, gatev, 1.f / (pg8::W8_SCALE * pg8::ACT8_SCALE)});
        { pg8::TailOrder T; T.init(MT, DM, PDIM, (const bf16_t*)(ws + W_PP + 512 * 1024), G, cb, S.nwg % G); pg8::gemm_phase(ldsl, PB1, PDIM, T, pg8::EpiBf16{YP, DM, nullptr}); } }
    SEAM(18);
    if (IN(19)) {
        NormB A = NB0; A.y = YB; A.gpost = a.in[29];
        ph_norm2<2, false, false, false>(A, vb0, vbs);
    }
    SEAM(19);
    if (IN(20)) { pg8::DenseOrder S; S.init(MT, DM, DM, (const bf16_t*)(ws + W_PG + 2 * MiB), G, cb); pg8::gemm_phase(ldsl, XB, DM, S, pg8::EpiPleGate{YP, DM, RS}); }
    SEAM(20);
    if (IN(21)) {
        NormB A = NB0; A.y = YP; A.gpost = a.in[33] + DM; A.xout = a.out;
        ph_norm2<1, true, false, false>(A, vb0, vbs);
    }
#undef IN
#undef SEAM
}

extern "C" void kernel_launch(void* const* d_in, const int* in_sizes, int n_in, void* d_out, int out_size, void* d_ws, size_t ws_size, hipStream_t stream) {
    static int grid = 0;
    if (grid == 0) {
        if (n_in != 34 || out_size != MT * DM || ws_size < WS_END) { fprintf(stderr, "kernel_launch: unexpected shapes n_in %d out %d ws %zu (need %zu)\n", n_in, out_size, ws_size, (size_t)WS_END); grid = -1; return; }
        int dev = 0, cus = 0;
        if (hipGetDevice(&dev) != hipSuccess || hipDeviceGetAttribute(&cus, hipDeviceAttributeMultiprocessorCount, dev) != hipSuccess) { grid = -1; return; }
        if (hipFuncSetAttribute((const void*)fwd, hipFuncAttributeMaxDynamicSharedMemorySize, LDS_BYTES) != hipSuccess) { fprintf(stderr, "hipFuncSetAttribute failed\n"); grid = -1; return; }
        (void)hipGetLastError();
        grid = cus;
    }
    if (grid < 0) return;
    (void)hipMemsetAsync((char*)d_ws + WS_CTL, 0, CTL_ZERO_BYTES, stream);
    Args a{};
    for (int i = 0; i < 34; ++i) a.in[i] = (const float*)d_in[i];
    a.out = (float*)d_out; a.ws = (unsigned char*)d_ws;
#ifndef MK_PER_PHASE
    a.ph_lo = 0; a.ph_hi = N_PHASES;
    hipLaunchKernelGGL(fwd, dim3(grid), dim3(NTHR), LDS_BYTES, stream, a);
#else
    for (int ph = 0; ph < N_PHASES; ++ph) {
        a.ph_lo = ph; a.ph_hi = ph + 1;
        hipLaunchKernelGGL(fwd, dim3(grid), dim3(NTHR), LDS_BYTES, stream, a);
    }
#endif
}
```

```cpp
#include <hip/hip_runtime.h>
#include <stdint.h>
#include <stdio.h>

#define DEVI __device__ __forceinline__
#define LAS __attribute__((address_space(3)))
typedef unsigned short bf16_t;

constexpr int NB = 4, SEQ = 4096, DM = 1024, MT = NB * SEQ;
constexpr int EVEN_IN = 4112, UW = 4096, DFF = 2816, NEXP = 8, DFFE = 3584, PDIM = 256;
constexpr float EPS = 1e-6f;
constexpr int NTHR = 512;
constexpr int LDS_BYTES = 147456;
constexpr int MISC_OFF = 131072 + 320;
constexpr int MOE_ROWS = 2 * MT + NEXP * 256;

constexpr size_t MiB = 1u << 20;
constexpr size_t WS_CTL = 0, CTL_ZERO_BYTES = 1 * MiB;
constexpr size_t WS_LIST = 1 * MiB;
constexpr size_t WS_GATE = WS_LIST + 512 * 1024;
constexpr size_t WS_DT = 2 * MiB;
constexpr size_t WS_W = 3 * MiB;
constexpr size_t W_IN = WS_W, W_OUTE = W_IN + 8 * MiB, W_GU = W_OUTE + 2 * MiB, W_DN = W_GU + 11 * MiB, W_PG = W_DN + 6 * MiB, W_PP = W_PG + 4 * MiB,
                 W_QKV = W_PP + 1 * MiB, W_OUTO = W_QKV + 6 * MiB, W_EGU = W_OUTO + 2 * MiB, W_EDN = W_EGU + 112 * MiB, W_END = W_EDN + 56 * MiB;
constexpr size_t WS_XB = W_END;
constexpr size_t WS_R = WS_XB + 32 * MiB;
constexpr size_t WS_UB = WS_R;
constexpr size_t WS_PB0 = WS_R + 88 * MiB;
constexpr size_t WS_YA = WS_R + 128 * MiB;
constexpr size_t WS_OF = WS_R + 160 * MiB;
constexpr size_t WS_OC = WS_R + 192 * MiB;
constexpr size_t WS_YP = WS_R + 224 * MiB;
constexpr size_t WS_YP1 = WS_R;
constexpr size_t WS_PB1 = W_EDN + 32 * MiB;
constexpr size_t WS_XG8 = WS_R + 120 * MiB;
constexpr size_t WS_END = WS_R + 256 * MiB;
constexpr size_t WS_Y = W_EGU;
constexpr size_t WS_MS = W_EGU;
constexpr size_t WS_HS = W_EGU + 64 * MiB;
constexpr size_t WS_XT = W_EDN;
constexpr size_t WS_VT = W_EDN + 24 * MiB;
constexpr size_t WS_MD = W_EDN + 40 * MiB;
constexpr size_t WS_HD = W_EDN + 41 * MiB;
static_assert(WS_R + (size_t)MOE_ROWS * DFFE <= WS_XG8 && WS_XG8 + 128 * MiB <= WS_END && WS_END <= 510 * MiB, "ws map");
constexpr size_t WS_RS = WS_CTL + 512 * 1024;
constexpr int CW_CNT = 64;
constexpr int CW_BAR = 4096;

DEVI int opq(int x) { asm volatile("" : "+v"(x)); return x; }
DEVI float bf2f(bf16_t b) { return __uint_as_float(((unsigned)b) << 16); }
DEVI unsigned cvt2bf(float lo, float hi) { unsigned r; asm("v_cvt_pk_bf16_f32 %0, %1, %2" : "=v"(r) : "v"(lo), "v"(hi)); return r; }
DEVI bf16_t f2bf(float f) { return (bf16_t)(cvt2bf(f, 0.f) & 0xffffu); }
DEVI float silu_f(float x) { return x * __builtin_amdgcn_rcpf(1.f + __builtin_amdgcn_exp2f(-1.44269504f * x)); }
DEVI float sigmoid_f(float x) { return __builtin_amdgcn_rcpf(1.f + __builtin_amdgcn_exp2f(-1.44269504f * x)); }
DEVI float softplus_f(float x) { return x > 20.f ? x : log1pf(__expf(x)); }
DEVI float wave_sum(float v) {
#pragma unroll
    for (int o = 1; o < 64; o <<= 1) v += __shfl_xor(v, o);
    return v;
}


typedef short bf16x8 __attribute__((ext_vector_type(8)));
typedef float f32x4 __attribute__((ext_vector_type(4)));
typedef unsigned u32x4 __attribute__((ext_vector_type(4)));
typedef unsigned u32x2 __attribute__((ext_vector_type(2)));
DEVI unsigned pk2(float lo, float hi) { return cvt2bf(lo, hi); }
DEVI float bflo(unsigned w) { return __uint_as_float(w << 16); }
DEVI float bfhi(unsigned w) { return __uint_as_float(w & 0xffff0000u); }

DEVI unsigned pg8_pk4(float a, float b, float c, float d) {
    a = __builtin_amdgcn_fmed3f(a, -448.f, 448.f); b = __builtin_amdgcn_fmed3f(b, -448.f, 448.f); c = __builtin_amdgcn_fmed3f(c, -448.f, 448.f); d = __builtin_amdgcn_fmed3f(d, -448.f, 448.f);
    int p = __builtin_amdgcn_cvt_pk_fp8_f32(a, b, 0, false); p = __builtin_amdgcn_cvt_pk_fp8_f32(c, d, p, true); return (unsigned)p; }
struct NormB { const float* xin; bf16_t* XB; const bf16_t* y; const float* gpost; float* rs; const float* gnext;
               const float* win; float* dtraw; const float* wr; unsigned* cnt; int* list; float* gatev; float* rsl; float* xout; unsigned char* x8; };
DEVI void unpack8(const u32x4 w, float* v) { v[0] = bflo(w.x); v[1] = bfhi(w.x); v[2] = bflo(w.y); v[3] = bfhi(w.y); v[4] = bflo(w.z); v[5] = bfhi(w.z); v[6] = bflo(w.w); v[7] = bfhi(w.w); }
template <int YMODE, bool FINAL, bool DT, bool ROUTE>
DEVI void ph_norm2(const NormB& A, int vb0, int vbs, LAS float* wl = nullptr) {
    const int tidq = opq((int)threadIdx.x); const int wid = tidq >> 6, lane = tidq & 63;
    if (DT || ROUTE) {
        constexpr int NJ = DT ? 16 : 8;
        __syncthreads();
        for (int e = tidq; e < DM * NJ / 4; e += NTHR) { const int k = e / (NJ / 4), j4 = (e % (NJ / 4)) * 4;
            const float4 w = DT ? *(const float4*)(A.win + (size_t)k * EVEN_IN + 4096 + j4) : *(const float4*)(A.wr + (size_t)k * 8 + j4);
            wl[(j4 + 0) * DM + k] = w.x; wl[(j4 + 1) * DM + k] = w.y; wl[(j4 + 2) * DM + k] = w.z; wl[(j4 + 3) * DM + k] = w.w; }
        __syncthreads();
    }
    constexpr int R = (DT || ROUTE) ? 2 : 4;
    for (int row0 = (vb0 * 8 + wid) * R; row0 < MT; row0 += vbs * 8 * R) {
        float xv[R][16]; float yv[R][16];
#pragma unroll
        for (int rr = 0; rr < R; ++rr) {
            const size_t ro = (size_t)(row0 + rr) * DM + lane * 8;
            if (YMODE == 0) {
#pragma unroll
                for (int i = 0; i < 2; ++i) { const float4 p0 = *(const float4*)(A.xin + ro + i * 512), p1 = *(const float4*)(A.xin + ro + i * 512 + 4);
                    xv[rr][i * 8 + 0] = p0.x; xv[rr][i * 8 + 1] = p0.y; xv[rr][i * 8 + 2] = p0.z; xv[rr][i * 8 + 3] = p0.w; xv[rr][i * 8 + 4] = p1.x; xv[rr][i * 8 + 5] = p1.y; xv[rr][i * 8 + 6] = p1.z; xv[rr][i * 8 + 7] = p1.w; }
            } else {
#pragma unroll
                for (int i = 0; i < 2; ++i) {
                    unpack8(*(const u32x4*)(A.XB + ro + i * 512), xv[rr] + i * 8);
                    unpack8(*(const u32x4*)(A.y + ro + i * 512), yv[rr] + i * 8);
                    if (YMODE == 2) { float y2[8]; unpack8(*(const u32x4*)(A.y + (size_t)MT * DM + ro + i * 512), y2);
#pragma unroll
                        for (int j = 0; j < 8; ++j) yv[rr][i * 8 + j] += y2[j]; }
                }
            }
        }
        if (YMODE != 0) {
            float gg[16];
#pragma unroll
            for (int i = 0; i < 2; ++i) { const float4 g0 = *(const float4*)(A.gpost + i * 512 + lane * 8), g1 = *(const float4*)(A.gpost + i * 512 + lane * 8 + 4);
                gg[i * 8 + 0] = g0.x; gg[i * 8 + 1] = g0.y; gg[i * 8 + 2] = g0.z; gg[i * 8 + 3] = g0.w; gg[i * 8 + 4] = g1.x; gg[i * 8 + 5] = g1.y; gg[i * 8 + 6] = g1.z; gg[i * 8 + 7] = g1.w; }
            float ss[R];
#pragma unroll
            for (int rr = 0; rr < R; ++rr) { ss[rr] = 0.f;
#pragma unroll
                for (int j = 0; j < 16; ++j) ss[rr] += yv[rr][j] * yv[rr][j]; }
#pragma unroll
            for (int o = 1; o < 64; o <<= 1)
#pragma unroll
                for (int rr = 0; rr < R; ++rr) ss[rr] += __shfl_xor(ss[rr], o);
#pragma unroll
            for (int rr = 0; rr < R; ++rr) { const float r = rsqrtf(ss[rr] * (1.f / DM) + EPS);
#pragma unroll
                for (int j = 0; j < 16; ++j) xv[rr][j] += yv[rr][j] * r * gg[j]; }
        }
        if (FINAL) {
#pragma unroll
            for (int rr = 0; rr < R; ++rr)
#pragma unroll
                for (int i = 0; i < 2; ++i) { float* op = A.xout + (size_t)(row0 + rr) * DM + i * 512 + lane * 8;
                    *(float4*)op = make_float4(xv[rr][i * 8], xv[rr][i * 8 + 1], xv[rr][i * 8 + 2], xv[rr][i * 8 + 3]); *(float4*)(op + 4) = make_float4(xv[rr][i * 8 + 4], xv[rr][i * 8 + 5], xv[rr][i * 8 + 6], xv[rr][i * 8 + 7]); }
        } else {
            float ss[R];
#pragma unroll
            for (int rr = 0; rr < R; ++rr) {
#pragma unroll
                for (int i = 0; i < 2; ++i) { u32x4 o; o.x = pk2(xv[rr][i * 8], xv[rr][i * 8 + 1]); o.y = pk2(xv[rr][i * 8 + 2], xv[rr][i * 8 + 3]); o.z = pk2(xv[rr][i * 8 + 4], xv[rr][i * 8 + 5]); o.w = pk2(xv[rr][i * 8 + 6], xv[rr][i * 8 + 7]);
                    *(u32x4*)(A.XB + (size_t)(row0 + rr) * DM + i * 512 + lane * 8) = o;
                }
                ss[rr] = 0.f;
#pragma unroll
                for (int j = 0; j < 16; ++j) ss[rr] += xv[rr][j] * xv[rr][j];
            }
#pragma unroll
            for (int o = 1; o < 64; o <<= 1)
#pragma unroll
                for (int rr = 0; rr < R; ++rr) ss[rr] += __shfl_xor(ss[rr], o);
            float r2[R];
#pragma unroll
            for (int rr = 0; rr < R; ++rr) { r2[rr] = rsqrtf(ss[rr] * (1.f / DM) + EPS); if (lane == 0) A.rs[row0 + rr] = r2[rr]; }
            if (DT || ROUTE) {
                float gn[16];
#pragma unroll
                for (int i = 0; i < 2; ++i) { const float4 g0 = *(const float4*)(A.gnext + i * 512 + lane * 8), g1 = *(const float4*)(A.gnext + i * 512 + lane * 8 + 4);
                    gn[i * 8 + 0] = g0.x; gn[i * 8 + 1] = g0.y; gn[i * 8 + 2] = g0.z; gn[i * 8 + 3] = g0.w; gn[i * 8 + 4] = g1.x; gn[i * 8 + 5] = g1.y; gn[i * 8 + 6] = g1.z; gn[i * 8 + 7] = g1.w; }
#pragma unroll 1
                for (int rr = 0; rr < R; ++rr) {
                    const int row = row0 + rr;
                    float hv[16];
#pragma unroll
                    for (int j = 0; j < 16; ++j) hv[j] = (rr == 0 ? xv[0][j] : xv[R - 1][j]) * (rr == 0 ? r2[0] : r2[R - 1]) * gn[j];
                    if (DT) {
                        float dk = 0.f;
#pragma unroll 1
                        for (int j = 0; j < 16; ++j) {
                            float p = 0.f;
#pragma unroll
                            for (int i = 0; i < 2; ++i) { const LAS float* wp = wl + j * DM + i * 512 + lane * 8;
                                const f32x4 w0 = *(const LAS f32x4*)wp, w1 = *(const LAS f32x4*)(wp + 4);
                                p += hv[i * 8 + 0] * w0[0] + hv[i * 8 + 1] * w0[1] + hv[i * 8 + 2] * w0[2] + hv[i * 8 + 3] * w0[3] + hv[i * 8 + 4] * w1[0] + hv[i * 8 + 5] * w1[1] + hv[i * 8 + 6] * w1[2] + hv[i * 8 + 7] * w1[3]; }
                            p = wave_sum(p);
                            dk = (lane == j) ? p : dk;
                        }
                        if (lane < 16) A.dtraw[(size_t)row * 16 + lane] = dk;
                    }
                    if (ROUTE) {
                        float lk = 0.f;
#pragma unroll 1
                        for (int e = 0; e < 8; ++e) {
                            float p = 0.f;
#pragma unroll
                            for (int i = 0; i < 2; ++i) { const LAS float* wp = wl + e * DM + i * 512 + lane * 8;
                                const f32x4 w0 = *(const LAS f32x4*)wp, w1 = *(const LAS f32x4*)(wp + 4);
                                p += hv[i * 8 + 0] * w0[0] + hv[i * 8 + 1] * w0[1] + hv[i * 8 + 2] * w0[2] + hv[i * 8 + 3] * w0[3] + hv[i * 8 + 4] * w1[0] + hv[i * 8 + 5] * w1[1] + hv[i * 8 + 6] * w1[2] + hv[i * 8 + 7] * w1[3]; }
                            p = wave_sum(p);
                            lk = (lane == e) ? p : lk;
                        }
                        float lg[8];
#pragma unroll
                        for (int e = 0; e < 8; ++e) lg[e] = __shfl(lk, e);
                        int dst1 = 0, dst2 = 0;
                        if (lane == 0) {
                            const float rcur = (rr == 0 ? r2[0] : r2[R - 1]);
                            int e1 = 0; float v1 = lg[0];
#pragma unroll
                            for (int e = 1; e < 8; ++e) if (lg[e] > v1) { v1 = lg[e]; e1 = e; }
                            int e2 = 0; float v2 = -3.0e38f;
#pragma unroll
                            for (int e = 0; e < 8; ++e) if (e != e1 && lg[e] > v2) { v2 = lg[e]; e2 = e; }
                            const float ex = __expf(v2 - v1); const float w1 = 1.f / (1.f + ex), w2 = ex / (1.f + ex);
                            const int p1 = (int)atomicAdd(&A.cnt[e1], 1u); A.list[e1 * MT + p1] = row * 2; A.gatev[e1 * MT + p1] = w1; A.rsl[e1 * MT + p1] = rcur;
                            const int p2 = (int)atomicAdd(&A.cnt[e2], 1u); A.list[e2 * MT + p2] = row * 2 + 1; A.gatev[e2 * MT + p2] = w2; A.rsl[e2 * MT + p2] = rcur;
                            dst1 = e1 * MT + p1; dst2 = e2 * MT + p2;
                        }
                        dst1 = __builtin_amdgcn_readfirstlane(dst1); dst2 = __builtin_amdgcn_readfirstlane(dst2);
#pragma unroll
                        for (int i = 0; i < 2; ++i) { u32x2 o8;
                            const float* xs = (rr == 0 ? xv[0] : xv[R - 1]) + i * 8;
                            o8.x = pg8_pk4(xs[0], xs[1], xs[2], xs[3]); o8.y = pg8_pk4(xs[4], xs[5], xs[6], xs[7]);
                            *(u32x2*)(A.x8 + (size_t)dst1 * DM + i * 512 + lane * 8) = o8; *(u32x2*)(A.x8 + (size_t)dst2 * DM + i * 512 + lane * 8) = o8; }
                    }
                }
            }
        }
    }
}

DEVI void transpose_item(const float* W, int ldw, int K, int k0, int n0, bf16_t* WT, int drow0, LAS float* scr, int lane, const float* gain) {
    {
        const int ka = lane >> 3, n4 = (lane & 7) * 4;
        float4 wv[8];
#pragma unroll
        for (int i = 0; i < 8; ++i) wv[i] = *(const float4*)(W + (size_t)(k0 + i * 8 + ka) * ldw + n0 + n4);
#pragma unroll
        for (int i = 0; i < 8; ++i) { LAS float* d = scr + (i * 8 + ka) * 33 + n4; d[0] = wv[i].x; d[1] = wv[i].y; d[2] = wv[i].z; d[3] = wv[i].w; }
    }
    asm volatile("s_waitcnt lgkmcnt(0)" ::: "memory");
    const int c = lane & 7;
    float4 ga = make_float4(1.f, 1.f, 1.f, 1.f), gb = ga;
    if (gain) { ga = *(const float4*)(gain + k0 + 8 * c); gb = *(const float4*)(gain + k0 + 8 * c + 4); }
#pragma unroll
    for (int j = 0; j < 4; ++j) { const int n = (lane >> 3) + 8 * j; const LAS float* sp = scr + (8 * c) * 33 + n;
        u32x4 o; o.x = pk2(sp[0 * 33] * ga.x, sp[1 * 33] * ga.y); o.y = pk2(sp[2 * 33] * ga.z, sp[3 * 33] * ga.w); o.z = pk2(sp[4 * 33] * gb.x, sp[5 * 33] * gb.y); o.w = pk2(sp[6 * 33] * gb.z, sp[7 * 33] * gb.w);
        *(u32x4*)(WT + (size_t)(drow0 + n) * K + k0 + 8 * c) = o; }
    asm volatile("s_waitcnt lgkmcnt(0)" ::: "memory");
}
DEVI void transpose_item_fp8(const float* W, int ldw, int K, int k0, int n0, unsigned char* WT8, int drow0, LAS float* scr, int lane, const float* gain) {
    {
        const int ka = lane >> 3, n4 = (lane & 7) * 4;
        float4 wv[8];
#pragma unroll
        for (int i = 0; i < 8; ++i) wv[i] = *(const float4*)(W + (size_t)(k0 + i * 8 + ka) * ldw + n0 + n4);
#pragma unroll
        for (int i = 0; i < 8; ++i) { LAS float* d = scr + (i * 8 + ka) * 33 + n4; d[0] = wv[i].x; d[1] = wv[i].y; d[2] = wv[i].z; d[3] = wv[i].w; }
    }
    asm volatile("s_waitcnt lgkmcnt(0)" ::: "memory");
    const int c = lane & 7;
    float4 ga = make_float4(64.f, 64.f, 64.f, 64.f), gb = ga;
    if (gain) { ga = *(const float4*)(gain + k0 + 8 * c); gb = *(const float4*)(gain + k0 + 8 * c + 4); ga.x *= 64.f; ga.y *= 64.f; ga.z *= 64.f; ga.w *= 64.f; gb.x *= 64.f; gb.y *= 64.f; gb.z *= 64.f; gb.w *= 64.f; }
#pragma unroll
    for (int j = 0; j < 4; ++j) { const int n = (lane >> 3) + 8 * j; const LAS float* sp = scr + (8 * c) * 33 + n;
        u32x2 o; o.x = pg8_pk4(sp[0 * 33] * ga.x, sp[1 * 33] * ga.y, sp[2 * 33] * ga.z, sp[3 * 33] * ga.w); o.y = pg8_pk4(sp[4 * 33] * gb.x, sp[5 * 33] * gb.y, sp[6 * 33] * gb.z, sp[7 * 33] * gb.w);
        *(u32x2*)(WT8 + (size_t)(drow0 + n) * K + k0 + 8 * c) = o; }
    asm volatile("s_waitcnt lgkmcnt(0)" ::: "memory");
}
struct Job { int in_idx; unsigned src_off; int ldw; int K; int ncols; unsigned long long dst; int mode; int item0; int gain_idx; int gain_off; int fp8; };
constexpr int NJOBS = 11 + 24;
struct JobTable { Job j[NJOBS]; int total; };
constexpr JobTable make_jobs() {
    JobTable t{}; int n = 0, it = 0;
    auto add = [&](int idx, unsigned off, int ldw, int K, int ncols, unsigned long long dst, int mode, int gi, int go, int f8 = 0) { t.j[n] = Job{idx, off, ldw, K, ncols, dst, mode, it, gi, go, f8}; it += (K / 64) * (ncols / 32); ++n; };
    add(4, 0, EVEN_IN, DM, UW, W_IN, 0, 3, 0);
    add(12, 0, DM, DM, DM, W_OUTE, 0, -1, 0);
    add(15, 0, DFF, DM, DFF, W_GU, 1, 14, 0);
    add(16, 0, DFF, DM, DFF, W_GU, 2, 14, 0);
    add(17, 0, DM, DFF, DM, W_DN, 0, -1, 0);
    add(31, 0, DM, DM, DM, W_PG, 0, 30, 0);
    add(31, DM * DM, DM, DM, DM, W_PG + 2 * MiB, 0, 30, DM);
    add(32, 0, DM, PDIM, DM, W_PP, 0, -1, 0);
    add(32, PDIM * DM, DM, PDIM, DM, W_PP + 512 * 1024, 0, -1, 0);
    add(20, 0, 3072, DM, 3072, W_QKV, 0, 19, 0);
    add(22, 0, DM, DM, DM, W_OUTO, 0, -1, 0);
    for (int e = 0; e < NEXP; ++e) {
        add(26, (unsigned)e * DM * DFFE, DFFE, DM, DFFE, W_EGU + (unsigned long long)e * 7 * MiB, 1, 24, 0, 1);
        add(27, (unsigned)e * DM * DFFE, DFFE, DM, DFFE, W_EGU + (unsigned long long)e * 7 * MiB, 2, 24, 0, 1);
        add(28, (unsigned)e * DFFE * DM, DM, DFFE, DM, W_EDN + (unsigned long long)e * (7 * MiB / 2), 0, -1, 0, 1);
    }
    t.total = it; return t;
}
__device__ const JobTable g_jobs = make_jobs();
constexpr int ITEMS_DENSE = make_jobs().j[11].item0, ITEMS_ALL = make_jobs().total;
DEVI void ph_convert_weights(LAS unsigned char* lds, const float* const* in, unsigned char* ws, int it_lo, int it_hi, int vb0, int vbs) {
    const int tidq = opq((int)threadIdx.x); const int wid = __builtin_amdgcn_readfirstlane(tidq >> 6), lane = tidq & 63;
    LAS float* scr = (LAS float*)(lds + wid * 16384);
    int jb = 0;
    for (int it = it_lo + vb0 * 8 + wid; it < it_hi; it += vbs * 8) {
        while (jb + 1 < NJOBS && g_jobs.j[jb + 1].item0 <= it) ++jb;
        const Job J = g_jobs.j[jb];
        const int r = it - J.item0; const int nblk = J.ncols / 32; const int kb = r / nblk, nb = r % nblk;
        const int n0 = nb * 32; int drow0 = n0;
        if (J.mode != 0) drow0 = (n0 >> 7) * 256 + (n0 & 127) + (J.mode == 2 ? 128 : 0);
        const float* gp = J.gain_idx >= 0 ? in[J.gain_idx] + J.gain_off : nullptr;
        if (J.fp8) transpose_item_fp8(in[J.in_idx] + J.src_off, J.ldw, J.K, kb * 64, n0, ws + J.dst, drow0, scr, lane, gp);
        else transpose_item(in[J.in_idx] + J.src_off, J.ldw, J.K, kb * 64, n0, (bf16_t*)(ws + J.dst), drow0, scr, lane, gp);
    }
}
DEVI void ph_cvt_rows(const float* src, bf16_t* dst, size_t n4, int vb0, int vbs) {
    for (size_t e = (size_t)vb0 * NTHR + opq((int)threadIdx.x); e < n4; e += (size_t)vbs * NTHR) {
        const float4 v = ((const float4*)src)[e]; u32x2 o; o.x = pk2(v.x, v.y); o.y = pk2(v.z, v.w); ((u32x2*)dst)[e] = o; }
}

namespace pg8 {
constexpr int BM = 256, BK = 64, HALF = 128, HTB = HALF * BK * 2, STAGE_BYTES = 8 * HTB, NXCD = 8, WGM = 8;
__host__ __device__ __forceinline__ int lds_byte(int r, int c) { const int st = (r >> 4) * 2 + (c >> 5), rr = r & 15, cc = c & 31, ob = rr * 64 + cc * 2; return st * 1024 + (ob ^ (((ob >> 9) & 1) << 5)); }
__host__ __device__ __forceinline__ void stage_rc(int b, int& R, int& C) { const int st = b / 1024, sb = b % 1024, swz = sb ^ (((sb >> 9) & 1) << 5); R = (st >> 1) * 16 + swz / 64; C = (st & 1) * 32 + (swz % 64) / 2; }
__host__ __device__ __forceinline__ int perm32(int rho) { const int n = rho >> 4, i = rho & 15; return 8 * (i >> 2) + 4 * n + (i & 3); }
struct Unit { int pm, pn; int row0; int arow0; int mvalid; int e; int mbase; const char* B; };
DEVI void xcd_tile(int L, int nwg, int nM, int nN, int& pm, int& pn) {
    int wgid = L; { const int q = nwg / NXCD, r = nwg % NXCD, xcd = wgid % NXCD, off = wgid / NXCD; wgid = (xcd < r ? xcd * (q + 1) : r * (q + 1) + (xcd - r) * q) + off; }
    const int nig = WGM * nN, gid = wgid / nig, fm = gid * WGM, gsz = (nM - fm) < WGM ? (nM - fm) : WGM;
    pm = fm + ((wgid % nig) % gsz); pn = (wgid % nig) / gsz;
}
struct DenseOrder {
    int nM, nN, nwg, G, c; const char* Bt; size_t tstepB;
    DEVI void init(int M, int N, int K, const bf16_t* Bt_, int G_, int c_) { nM = M / BM; nN = N / BM; nwg = nM * nN; G = G_; c = c_; Bt = (const char*)Bt_; tstepB = (size_t)BM * K * 2; }
    DEVI bool next(int i, Unit& u) const { const long L = (long)i * G + c; if (L >= nwg) return false; xcd_tile((int)L, nwg, nM, nN, u.pm, u.pn); u.row0 = u.pm * BM; u.arow0 = u.row0; u.mvalid = BM; u.e = 0; u.mbase = 0; u.B = Bt + (size_t)u.pn * tstepB; return true; }
};
struct TailOrder {
    int nM, nN, nwg, nb, r; const char* Bt; size_t tstepB;
    DEVI void init(int M, int N, int K, const bf16_t* Bt_, int G_, int c_, int first) { nM = M / BM; nN = N / BM; nwg = nM * nN; Bt = (const char*)Bt_; tstepB = (size_t)BM * K * 2;
        if (first >= G_) first = 0; nb = G_ - first; r = c_ - first; }
    DEVI bool next(int i, Unit& u) const { if (r < 0) return false; const long L = (long)i * nb + r; if (L >= nwg) return false; u.pm = (int)L / nN; u.pn = (int)L % nN; u.row0 = u.pm * BM; u.arow0 = u.row0; u.mvalid = BM; u.e = 0; u.mbase = 0; u.B = Bt + (size_t)u.pn * tstepB; return true; }
};
struct MoeOrder {
    int nM, nN, nwg, G, c; const char* Bt; size_t estepB, tstepB; const volatile LAS int* tab; bool per_expert;
    DEVI void init(const unsigned* cnt, volatile LAS int* tab_, int N, int K, const bf16_t* Bt_, size_t estep_bytes, bool per_expert_, int G_, int c_) {
        __syncthreads();
        if (threadIdx.x < 8) tab_[16 + threadIdx.x] = (int)__hip_atomic_load(cnt + threadIdx.x, __ATOMIC_RELAXED, __HIP_MEMORY_SCOPE_AGENT);
        __syncthreads();
        if (threadIdx.x == 0) { int t = 0;
            for (int e = 0; e < 8; ++e) { const int n = tab_[16 + e]; tab_[e] = t; t += (n + BM - 1) / BM; }
            tab_[8] = t; }
        __syncthreads();
        tab = tab_; nM = __builtin_amdgcn_readfirstlane(tab_[8]); nN = N / BM; nwg = nM * nN; G = G_; c = c_; Bt = (const char*)Bt_; estepB = estep_bytes; tstepB = (size_t)BM * K * 2; per_expert = per_expert_;
    }
    DEVI bool next(int i, Unit& u) const { const long L = (long)i * G + c; if (L >= nwg) return false; xcd_tile((int)L, nwg, nM, nN, u.pm, u.pn);
        int e = 0;
        for (int k = 1; k < 8; ++k) if (u.pm >= __builtin_amdgcn_readfirstlane(tab[k])) e = k;
        const int t0 = __builtin_amdgcn_readfirstlane(tab[e]), n = __builtin_amdgcn_readfirstlane(tab[16 + e]);
        u.e = e; u.row0 = u.pm * BM; const int m0 = (u.pm - t0) * BM; u.mbase = m0; u.arow0 = per_expert ? e * MT + m0 : u.row0; u.mvalid = (n - m0) < BM ? (n - m0) : BM; u.B = Bt + (size_t)e * estepB + (size_t)u.pn * tstepB; return true; }
};
DEVI unsigned cvt_pk_bf16(float lo, float hi) { unsigned r; asm volatile("v_cvt_pk_bf16_f32 %0, %1, %2" : "=v"(r) : "v"(lo), "v"(hi)); return r; }

struct Pre8 { float v[8]; };
struct Pre16 { float v[8]; int t[8]; };
struct EpiBf16 { static constexpr bool PERM = true; bf16_t* O; int ldc; const float* rs;
    typedef Pre8 Pre;
    DEVI void pre(Pre& P, const Unit& u, int wr, int fr) const {
#pragma unroll
        for (int q = 0; q < 8; ++q) P.v[q] = rs ? rs[u.row0 + wr * 64 + fr + (q >> 2) * HALF + (q & 3) * 16] : 1.f; }
    DEVI void operator()(const f32x4 (&acc)[2][2][4][2], const Unit& u, int wr, int wc, int fr, int fq, const Pre& P) const {
        const int row0 = u.row0 + wr * 64 + fr, col0 = u.pn * BM + wc * 32 + 8 * fq;
#pragma unroll
        for (int ai = 0; ai < 2; ++ai)
#pragma unroll
            for (int m = 0; m < 4; ++m) { const int row = row0 + ai * HALF + m * 16; bf16_t* rowp = O + (size_t)row * ldc + col0;
                const float sc = P.v[ai * 4 + m];
#pragma unroll
                for (int bj = 0; bj < 2; ++bj) { const f32x4 v0 = acc[ai][bj][m][0] * sc, v1 = acc[ai][bj][m][1] * sc;
                    u32x4 w; w.x = cvt_pk_bf16(v0[0], v0[1]); w.y = cvt_pk_bf16(v0[2], v0[3]); w.z = cvt_pk_bf16(v1[0], v1[1]); w.w = cvt_pk_bf16(v1[2], v1[3]);
                    *(u32x4*)(rowp + bj * HALF) = w; } }
    } };
struct EpiPleGate { static constexpr bool PERM = true; bf16_t* T; int ldc; const float* rs;
    typedef Pre8 Pre;
    DEVI void pre(Pre& P, const Unit& u, int wr, int fr) const {
#pragma unroll
        for (int q = 0; q < 8; ++q) P.v[q] = rs[u.row0 + wr * 64 + fr + (q >> 2) * HALF + (q & 3) * 16]; }
    DEVI void operator()(const f32x4 (&acc)[2][2][4][2], const Unit& u, int wr, int wc, int fr, int fq, const Pre& P) const {
        const int row0 = u.row0 + wr * 64 + fr, col0 = u.pn * BM + wc * 32 + 8 * fq;
#pragma unroll
        for (int ai = 0; ai < 2; ++ai)
#pragma unroll
            for (int m = 0; m < 4; ++m) { const int row = row0 + ai * HALF + m * 16; bf16_t* rowp = T + (size_t)row * ldc + col0;
                const float sc = P.v[ai * 4 + m];
#pragma unroll
                for (int bj = 0; bj < 2; ++bj) { const f32x4 v0 = acc[ai][bj][m][0] * sc, v1 = acc[ai][bj][m][1] * sc;
                    const u32x4 pp = *(const u32x4*)(rowp + bj * HALF);
                    u32x4 w; w.x = cvt_pk_bf16(sigmoid_f(v0[0]) * bflo(pp.x), sigmoid_f(v0[1]) * bfhi(pp.x)); w.y = cvt_pk_bf16(sigmoid_f(v0[2]) * bflo(pp.y), sigmoid_f(v0[3]) * bfhi(pp.y));
                    w.z = cvt_pk_bf16(sigmoid_f(v1[0]) * bflo(pp.z), sigmoid_f(v1[1]) * bfhi(pp.z)); w.w = cvt_pk_bf16(sigmoid_f(v1[2]) * bflo(pp.w), sigmoid_f(v1[3]) * bfhi(pp.w));
                    *(u32x4*)(rowp + bj * HALF) = w; } }
    } };
struct EpiSwiglu { static constexpr bool PERM = true; bf16_t* O; int ldc; const float* rs; int grouped;
    typedef Pre8 Pre;
    DEVI void pre(Pre& P, const Unit& u, int wr, int fr) const {
        const float* rsb = grouped ? rs + u.e * MT + u.mbase : rs + u.row0; const int vm1 = (grouped ? u.mvalid : BM) - 1;
#pragma unroll
        for (int q = 0; q < 8; ++q) { const int rl = wr * 64 + fr + (q >> 2) * HALF + (q & 3) * 16; P.v[q] = rsb[rl <= vm1 ? rl : vm1]; } }
    DEVI void operator()(const f32x4 (&acc)[2][2][4][2], const Unit& u, int wr, int wc, int fr, int fq, const Pre& P) const {
        const int row0 = u.row0 + wr * 64 + fr, col0 = u.pn * HALF + wc * 32 + 8 * fq; const int vm1e = (grouped ? u.mvalid : BM) - 1;
#pragma unroll
        for (int ai = 0; ai < 2; ++ai)
#pragma unroll
            for (int m = 0; m < 4; ++m) { const int rl = wr * 64 + fr + ai * HALF + m * 16; bf16_t* rowp = O + (size_t)(u.row0 + rl) * ldc + col0;
                const float sc = rl <= vm1e ? P.v[ai * 4 + m] : 0.f;
                const f32x4 g0 = acc[ai][0][m][0] * sc, g1 = acc[ai][0][m][1] * sc, u0 = acc[ai][1][m][0] * sc, u1 = acc[ai][1][m][1] * sc;
                u32x4 w; w.x = cvt_pk_bf16(silu_f(g0[0]) * u0[0], silu_f(g0[1]) * u0[1]); w.y = cvt_pk_bf16(silu_f(g0[2]) * u0[2], silu_f(g0[3]) * u0[3]);
                w.z = cvt_pk_bf16(silu_f(g1[0]) * u1[0], silu_f(g1[1]) * u1[1]); w.w = cvt_pk_bf16(silu_f(g1[2]) * u1[2], silu_f(g1[3]) * u1[3]);
                *(u32x4*)rowp = w; }
    } };
constexpr float W8_SCALE = 64.f, ACT8_SCALE = 8.f;
struct EpiSwiglu8 { static constexpr bool PERM = true; unsigned char* O; int ldc; const float* rs;
    typedef Pre8 Pre;
    DEVI void pre(Pre& P, const Unit& u, int wr, int fr) const {
        const float* rsb = rs + u.e * MT + u.mbase; const int vm1 = u.mvalid - 1;
#pragma unroll
        for (int q = 0; q < 8; ++q) { const int rl = wr * 64 + fr + (q >> 2) * HALF + (q & 3) * 16; P.v[q] = rsb[rl <= vm1 ? rl : vm1]; } }
    DEVI void operator()(const f32x4 (&acc)[2][2][4][2], const Unit& u, int wr, int wc, int fr, int fq, const Pre& P) const {
        const int col0 = u.pn * HALF + wc * 32 + 8 * fq;
#pragma unroll
        for (int ai = 0; ai < 2; ++ai)
#pragma unroll
            for (int m = 0; m < 4; ++m) { const int rl = wr * 64 + fr + ai * HALF + m * 16; unsigned char* rowp = O + (size_t)(u.row0 + rl) * ldc + col0;
                const float sc = rl < u.mvalid ? P.v[ai * 4 + m] * (1.f / W8_SCALE) : 0.f;
                const f32x4 g0 = acc[ai][0][m][0] * sc, g1 = acc[ai][0][m][1] * sc, u0 = acc[ai][1][m][0] * (sc * ACT8_SCALE), u1 = acc[ai][1][m][1] * (sc * ACT8_SCALE);
                u32x2 w; w.x = pg8_pk4(silu_f(g0[0]) * u0[0], silu_f(g0[1]) * u0[1], silu_f(g0[2]) * u0[2], silu_f(g0[3]) * u0[3]);
                w.y = pg8_pk4(silu_f(g1[0]) * u1[0], silu_f(g1[1]) * u1[1], silu_f(g1[2]) * u1[2], silu_f(g1[3]) * u1[3]);
                *(u32x2*)rowp = w; }
    } };
struct EpiMoeDown { static constexpr bool PERM = true; bf16_t* Y; const int* list; const float* gatev; float oscale;
    typedef Pre16 Pre;
    DEVI void pre(Pre& P, const Unit& u, int wr, int fr) const {
        const int* lb = list + u.e * MT + u.mbase; const float* gb = gatev + u.e * MT + u.mbase; const int vm1 = u.mvalid - 1;
#pragma unroll
        for (int q = 0; q < 8; ++q) { const int rl = wr * 64 + fr + (q >> 2) * HALF + (q & 3) * 16; const int ri = rl <= vm1 ? rl : vm1; P.t[q] = lb[ri]; P.v[q] = gb[ri]; } }
    DEVI void operator()(const f32x4 (&acc)[2][2][4][2], const Unit& u, int wr, int wc, int fr, int fq, const Pre& P) const {
        const int col0 = u.pn * BM + wc * 32 + 8 * fq;
        const int mbase = u.mbase;
#pragma unroll
        for (int ai = 0; ai < 2; ++ai)
#pragma unroll
            for (int m = 0; m < 4; ++m) { const int rl = wr * 64 + fr + ai * HALF + m * 16;
                const int tsl = P.t[ai * 4 + m]; const float gt = P.v[ai * 4 + m] * oscale;
                if (rl < u.mvalid) {
                    bf16_t* rowp = Y + (size_t)(tsl & 1) * ((size_t)MT * DM) + (size_t)(tsl >> 1) * DM + col0;
#pragma unroll
                    for (int bj = 0; bj < 2; ++bj) { const f32x4 v0 = acc[ai][bj][m][0], v1 = acc[ai][bj][m][1];
                        u32x4 w; w.x = cvt_pk_bf16(v0[0] * gt, v0[1] * gt); w.y = cvt_pk_bf16(v0[2] * gt, v0[3] * gt); w.z = cvt_pk_bf16(v1[0] * gt, v1[1] * gt); w.w = cvt_pk_bf16(v1[2] * gt, v1[3] * gt);
                        *(u32x4*)(rowp + bj * HALF) = w; } } }
    } };

typedef int v8i __attribute__((ext_vector_type(8)));
typedef int v4i __attribute__((ext_vector_type(4)));
DEVI v8i cat8(const bf16x8 lo, const bf16x8 hi) { const v4i a = __builtin_bit_cast(v4i, lo), b = __builtin_bit_cast(v4i, hi); return __builtin_shufflevector(a, b, 0, 1, 2, 3, 4, 5, 6, 7); }
struct Frag16 { bf16x8 k[2]; };
struct Frag8 { v8i v; };
template <bool F> struct FragSel { typedef Frag16 T; };
template <> struct FragSel<true> { typedef Frag8 T; };
template <class Epi, class Sched, bool FP8 = false>
DEVI void gemm_phase(LAS unsigned char* lds, const bf16_t* A, const int K, const Sched& S, const Epi& E) {
    const int tid = opq((int)threadIdx.x), wid = __builtin_amdgcn_readfirstlane(tid >> 6), lane = tid & 63, wr = wid >> 2, wc = wid & 3, fr = lane & 15, fq = lane >> 4;
    const int nt = K / BK;
    unsigned voffA[2], voffB[2];
#pragma unroll
    for (int i = 0; i < 2; ++i) { int R, C; stage_rc(tid * 16 + i * 8192, R, C); const int Rb = Epi::PERM ? ((R & ~31) + perm32(R & 31)) : R;
        voffA[i] = (unsigned)(R * K + C) * 2u; voffB[i] = (unsigned)(Rb * K + C) * 2u; }
    const size_t kstep = (size_t)(BK * 2);
    const size_t hstep = (size_t)HALF * K * 2;
    const size_t rstep = (size_t)K * 2;
    const unsigned ldsw = (unsigned)wid * 1024u;
    const int aoff = lds_byte(wr * 64 + fr, fq * 8), boff = lds_byte(wc * 32 + fr, fq * 8);
#define PG8_SA(b, h) (((b) * 2 + (h)) * HTB)
#define PG8_SB(b, h) ((4 + (b) * 2 + (h)) * HTB)
#define PG8_STAGE(bufoff, gbase, voff) do { _Pragma("unroll") for (int _i = 0; _i < 2; ++_i) \
        __builtin_amdgcn_global_load_lds((const unsigned*)((const char*)(gbase) + (voff)[_i]), (LAS unsigned*)(lds + (bufoff) + ldsw + _i * 8192), 16, 0, 0); } while (0)
#define PG8_LDA(dst, b, h) do { _Pragma("unroll") for (int m = 0; m < 4; ++m) { if constexpr (FP8) dst[m].v = cat8(*(const LAS bf16x8*)(lds + PG8_SA(b, h) + aoff + m * 2048), *(const LAS bf16x8*)(lds + PG8_SA(b, h) + aoff + m * 2048 + 1024)); \
        else { _Pragma("unroll") for (int k = 0; k < 2; ++k) dst[m].k[k] = *(const LAS bf16x8*)(lds + PG8_SA(b, h) + aoff + m * 2048 + k * 1024); } } } while (0)
#define PG8_LDB(dst, b, h) do { _Pragma("unroll") for (int n = 0; n < 2; ++n) { if constexpr (FP8) dst[n].v = cat8(*(const LAS bf16x8*)(lds + PG8_SB(b, h) + boff + n * 2048), *(const LAS bf16x8*)(lds + PG8_SB(b, h) + boff + n * 2048 + 1024)); \
        else { _Pragma("unroll") for (int k = 0; k < 2; ++k) dst[n].k[k] = *(const LAS bf16x8*)(lds + PG8_SB(b, h) + boff + n * 2048 + k * 1024); } } } while (0)
#define PG8_MMA(ai, bj, At, Bt) do { __builtin_amdgcn_s_setprio(1); _Pragma("unroll") for (int m = 0; m < 4; ++m) _Pragma("unroll") for (int n = 0; n < 2; ++n) { \
        if constexpr (FP8) asm volatile("s_nop 1\n\tv_mfma_scale_f32_16x16x128_f8f6f4 %0, %1, %2, %0, %3, %3 op_sel_hi:[0,0,0]" : "+v"(acc[ai][bj][m][n]) : "v"(Bt[n].v), "v"(At[m].v), "v"(sc1)); \
        else { _Pragma("unroll") for (int k = 0; k < 2; ++k) acc[ai][bj][m][n] = __builtin_amdgcn_mfma_f32_16x16x32_bf16(Bt[n].k[k], At[m].k[k], acc[ai][bj][m][n], 0, 0, 0); } } \
        __builtin_amdgcn_s_setprio(0); } while (0)
#define PG8_WAIT_V(n) asm volatile("s_waitcnt vmcnt(" #n ")" ::: "memory")
#define PG8_WAIT_L(n) asm volatile("s_waitcnt lgkmcnt(" #n ")" ::: "memory")
#define PG8_BAR __builtin_amdgcn_s_barrier()
#define PG8_SCHED __builtin_amdgcn_sched_barrier(0)
    Unit cur, nxt; int ui = 0;
    if (!S.next(0, cur)) return;
    int sc1 = 0x7F7F7F7F; asm volatile("" : "+v"(sc1));
    f32x4 acc[2][2][4][2];
#pragma unroll
    for (int a = 0; a < 2; ++a)
#pragma unroll
        for (int b = 0; b < 2; ++b)
#pragma unroll
            for (int m = 0; m < 4; ++m)
#pragma unroll
                for (int n = 0; n < 2; ++n) acc[a][b][m][n] = (f32x4){0.f, 0.f, 0.f, 0.f};
    typename FragSel<FP8>::T At[4], B0[2], B1[2];
    const char* cA = (const char*)A + (size_t)cur.arow0 * rstep;
    const char* cB = cur.B;
    typename Epi::Pre pre; E.pre(pre, cur, wr, fr);
    PG8_STAGE(PG8_SB(0, 0), cB, voffB); PG8_STAGE(PG8_SA(0, 0), cA, voffA); PG8_STAGE(PG8_SB(0, 1), cB + hstep, voffB); PG8_STAGE(PG8_SA(0, 1), cA + hstep, voffA);
    if (wr == 1) PG8_BAR;
    PG8_WAIT_V(4); PG8_BAR;
    PG8_STAGE(PG8_SB(1, 0), cB + kstep, voffB); PG8_STAGE(PG8_SA(1, 0), cA + kstep, voffA); PG8_STAGE(PG8_SB(1, 1), cB + hstep + kstep, voffB);
    PG8_WAIT_V(6); PG8_BAR;
    for (;;) {
        const bool has_next = S.next(ui + 1, nxt);
        const char* nA = has_next ? (const char*)A + (size_t)nxt.arow0 * rstep : cA; const char* nB = has_next ? nxt.B : cB;
#pragma unroll 1
        for (int t = 0; t < nt; t += 2) {
            const bool last = (t == nt - 2);
            const char* a1 = cA + (size_t)(t + 1) * kstep;
            const char* a2 = last ? nA : cA + (size_t)(t + 2) * kstep; const char* b2 = last ? nB : cB + (size_t)(t + 2) * kstep;
            const char* a3 = a2 + kstep; const char* b3 = b2 + kstep;
            PG8_LDB(B0, 0, 0); PG8_SCHED; PG8_LDA(At, 0, 0); PG8_STAGE(PG8_SA(1, 1), a1 + hstep, voffA);
            PG8_WAIT_L(8); PG8_BAR; PG8_WAIT_L(0); PG8_MMA(0, 0, At, B0); PG8_BAR; PG8_SCHED;
            PG8_LDB(B1, 0, 1); PG8_STAGE(PG8_SB(0, 0), b2, voffB);
            PG8_BAR; PG8_WAIT_L(0); PG8_MMA(0, 1, At, B1); PG8_BAR;
            PG8_LDA(At, 0, 1); PG8_STAGE(PG8_SA(0, 0), a2, voffA);
            PG8_BAR; PG8_WAIT_L(0); PG8_MMA(1, 0, At, B0); PG8_BAR; PG8_SCHED;
            PG8_STAGE(PG8_SB(0, 1), b2 + hstep, voffB);
            PG8_WAIT_V(6); PG8_BAR; PG8_MMA(1, 1, At, B1); PG8_BAR;
            PG8_LDB(B0, 1, 0); PG8_SCHED; PG8_LDA(At, 1, 0); PG8_STAGE(PG8_SA(0, 1), a2 + hstep, voffA);
            PG8_WAIT_L(8); PG8_BAR; PG8_WAIT_L(0); PG8_MMA(0, 0, At, B0); PG8_BAR; PG8_SCHED;
            PG8_LDB(B1, 1, 1); PG8_STAGE(PG8_SB(1, 0), b3, voffB);
            PG8_BAR; PG8_WAIT_L(0); PG8_MMA(0, 1, At, B1); PG8_BAR;
            PG8_LDA(At, 1, 1); PG8_STAGE(PG8_SA(1, 0), a3, voffA);
            PG8_BAR; PG8_WAIT_L(0); PG8_MMA(1, 0, At, B0); PG8_BAR; PG8_SCHED;
            PG8_STAGE(PG8_SB(1, 1), b3 + hstep, voffB);
            PG8_WAIT_V(6); PG8_BAR; PG8_MMA(1, 1, At, B1); PG8_BAR;
        }
        if constexpr (FP8) asm volatile("s_nop 15\n\ts_nop 15" ::: "memory");
        E(acc, cur, wr, wc, fr, fq, pre);
        if (!has_next) break;
#pragma unroll
        for (int a = 0; a < 2; ++a)
#pragma unroll
            for (int b = 0; b < 2; ++b)
#pragma unroll
                for (int m = 0; m < 4; ++m)
#pragma unroll
                    for (int n = 0; n < 2; ++n) acc[a][b][m][n] = (f32x4){0.f, 0.f, 0.f, 0.f};
        cur = nxt; cA = nA; cB = nB; ++ui;
        E.pre(pre, cur, wr, fr);
        if constexpr (FP8) asm volatile("s_nop 7" ::: "memory");
    }
    PG8_WAIT_V(0);
    if (wr == 0) PG8_BAR;
    PG8_BAR;
#undef PG8_SA
#undef PG8_SB
#undef PG8_STAGE
#undef PG8_LDA
#undef PG8_LDB
#undef PG8_MMA
#undef PG8_WAIT_V
#undef PG8_WAIT_L
#undef PG8_BAR
#undef PG8_SCHED
}
}

DEVI float lb_of(const float* lbraw, int ch) {
    const float r0 = lbraw[ch], r1 = lbraw[512 + ch], r2 = lbraw[1024 + ch];
    const float mx = fmaxf(r0, fmaxf(r1, r2));
    const float e0 = __expf(r0 - mx), e1 = __expf(r1 - mx), e2 = __expf(r2 - mx);
    return e0 / (e0 + e1 + e2);
}
DEVI void ph_hgrn_naive(float* lds, const bf16_t* u, const float* lbraw, float* oacc, int vb0, int vbs) {
    float* sq = lds; float* sk = lds + 2048; float* sf = lds + 4096; float* sv = lds + 6144;
    const int tid = opq((int)threadIdx.x), j = tid >> 2, kq = tid & 3;
    for (int vb = vb0; vb < 32; vb += vbs) {
        const int dir = vb & 1, h = (vb >> 1) & 3, b = vb >> 3;
        float st[32];
#pragma unroll
        for (int i = 0; i < 32; ++i) st[i] = 0.f;
        for (int tb = 0; tb < SEQ / 16; ++tb) {
            __syncthreads();
            for (int e = tid; e < 2048; e += NTHR) {
                const int i = e >> 7, c = e & 127;
                const int t = dir ? (SEQ - 1 - (tb * 16 + i)) : (tb * 16 + i);
                const bf16_t* ur = u + (size_t)(b * SEQ + t) * UW;
                const int ch = h * 128 + c;
                const float qr = bf2f(ur[ch]), fr = bf2f(ur[(dir ? 1024 : 512) + ch]), vr = bf2f(ur[1536 + ch]);
                const float lb = lb_of(lbraw, ch);
                const float f = lb + (1.f - lb) * sigmoid_f(fr);
                sq[e] = silu_f(qr); sk[e] = 1.f - f; sf[e] = f; sv[e] = vr;
            }
            __syncthreads();
            for (int i = 0; i < 16; ++i) {
                const float vj = sv[i * 128 + j]; float acc = 0.f;
#pragma unroll
                for (int kk = 0; kk < 32; ++kk) {
                    const int kidx = kk * 4 + kq;
                    st[kk] = sf[i * 128 + kidx] * st[kk] + sk[i * 128 + kidx] * vj;
                    acc += st[kk] * sq[i * 128 + kidx];
                }
                acc += __shfl_xor(acc, 1); acc += __shfl_xor(acc, 2);
                if (kq == 0) {
                    const int t = dir ? (SEQ - 1 - (tb * 16 + i)) : (tb * 16 + i);
                    atomicAdd(&oacc[(size_t)(b * SEQ + t) * DM + h * 128 + j], acc);
                }
            }
        }
    }
    __syncthreads();
}

DEVI void ph_mixfin_hgrn(const bf16_t* u, const float* oacc, const float* a_norm, bf16_t* ocat, int vb0, int vbs) {
    const int tidq = opq((int)threadIdx.x); const int hw = tidq >> 5, l32 = tidq & 31;
    for (int row = vb0 * 16 + hw; row < MT; row += vbs * 16) {
        const int c0 = l32 * 16; float v[16]; float ss = 0.f;
        const bf16_t* ur = u + (size_t)row * UW;
#pragma unroll
        for (int i = 0; i < 16; ++i) { v[i] = oacc[(size_t)row * DM + c0 + i]; ss += v[i] * v[i]; }
        ss += __shfl_xor(ss, 1); ss += __shfl_xor(ss, 2); ss += __shfl_xor(ss, 4);
        const float r = rsqrtf(ss * (1.f / 128.f) + EPS);
#pragma unroll
        for (int i = 0; i < 16; ++i) { const int c = c0 + i; ocat[(size_t)row * DM + c] = f2bf(v[i] * r * a_norm[c & 127] * silu_f(bf2f(ur[2048 + c]))); }
    }
}


constexpr int HQ = 0, HK = 17408, HKH = 34816, HV = 53248, HDV = 71680, HZERO = 73728, HOT = 75776, H_END = HOT + 64 * 528;
static_assert(H_END <= 131072, "hgrn lds");
constexpr size_t HS_SCAN = (size_t)16 * 16384;
struct HgrnRaw { unsigned qf[16]; u32x4 v0, v1; };
DEVI void hgrn_load(HgrnRaw& R, const bf16_t* u, const bf16_t* VT, int dir, int b, int h, int t0, int c, int I, int tid) {
    const bf16_t* up = u + ((size_t)b * SEQ + t0 + 16 * I) * UW + h * 128 + c;
    const int fcol = dir ? 1024 : 512;
#pragma unroll
    for (int j = 0; j < 16; ++j) R.qf[j] = (unsigned)up[(size_t)j * UW] | ((unsigned)up[(size_t)j * UW + fcol] << 16);
    { const int e = tid, r = e >> 3, cch = e & 7; R.v0 = *(const u32x4*)(VT + ((size_t)b * 512 + h * 128 + r) * SEQ + t0 + cch * 8); }
    { const int e = tid + NTHR, r = e >> 3, cch = e & 7; R.v1 = *(const u32x4*)(VT + ((size_t)b * 512 + h * 128 + r) * SEQ + t0 + cch * 8); }
}
DEVI void hgrn_prep(LAS unsigned char* lds, const HgrnRaw& R, float lbv, int dir, int c, int I, int tid) {
    float ff[16], kk[16], qq[16];
    { const int e = tid, r = e >> 3, cch = e & 7; *(LAS u32x4*)(lds + HV + r * 144 + cch * 16) = R.v0; }
    { const int e = tid + NTHR, r = e >> 3, cch = e & 7; *(LAS u32x4*)(lds + HV + r * 144 + cch * 16) = R.v1; }
#pragma unroll
    for (int j = 0; j < 16; ++j) {
        const float fr = bfhi(R.qf[j]), qr = bflo(R.qf[j]);
        const float f = lbv + (1.f - lbv) * sigmoid_f(fr);
        ff[j] = f; kk[j] = 1.f - f; qq[j] = silu_f(qr);
    }
    float run = 1.f;
#pragma unroll
    for (int jj = 0; jj < 16; ++jj) { const int j = dir ? 15 - jj : jj; run *= ff[j]; ff[j] = run; }
    const float PG = run;
    float kh[16];
#pragma unroll
    for (int j = 0; j < 16; ++j) {
        const float kt = kk[j] * __builtin_amdgcn_rcpf(ff[j]);
        kh[j] = kt * PG;
        *(LAS bf16_t*)(lds + HQ + (16 * I + j) * 272 + c * 2) = f2bf(qq[j] * ff[j]);
        *(LAS bf16_t*)(lds + HK + (16 * I + j) * 272 + c * 2) = f2bf(kt);
    }
    u32x4 w0, w1;
    w0.x = pk2(kh[0], kh[1]); w0.y = pk2(kh[2], kh[3]); w0.z = pk2(kh[4], kh[5]); w0.w = pk2(kh[6], kh[7]);
    w1.x = pk2(kh[8], kh[9]); w1.y = pk2(kh[10], kh[11]); w1.z = pk2(kh[12], kh[13]); w1.w = pk2(kh[14], kh[15]);
    *(LAS u32x4*)(lds + HKH + c * 144 + I * 32) = w0; *(LAS u32x4*)(lds + HKH + c * 144 + I * 32 + 16) = w1;
    *(LAS float*)(lds + HDV + (I * 128 + c) * 4) = PG;
}
DEVI void hgrn_update(LAS unsigned char* lds, f32x4 (&Sacc)[8], int I, int wid, int fr, int fq) {
    const int voff = (fq < 2) ? HV + (16 * wid + fr) * 144 + (16 * I + 8 * fq) * 2 : HZERO;
    const int koff = (fq < 2) ? HKH + fr * 144 + (16 * I + 8 * fq) * 2 : HZERO;
    const int kstep = (fq < 2) ? 16 * 144 : 0;
    const bf16x8 vb = *(const LAS bf16x8*)(lds + voff);
    bf16x8 ka[8]; f32x4 dv[8];
#pragma unroll
    for (int m = 0; m < 8; ++m) { ka[m] = *(const LAS bf16x8*)(lds + koff + m * kstep); dv[m] = *(const LAS f32x4*)(lds + HDV + (I * 128 + 16 * m + 4 * fq) * 4); }
#pragma unroll
    for (int m = 0; m < 8; ++m) Sacc[m] = __builtin_amdgcn_mfma_f32_16x16x32_bf16(ka[m], vb, Sacc[m] * dv[m], 0, 0, 0);
}
DEVI void stage_vt(LAS unsigned char* lds, const bf16_t* VT, int b, int h, int t0, int tid) {
    for (int e = tid; e < 128 * 8; e += NTHR) { const int r = e >> 3, cch = e & 7; *(LAS u32x4*)(lds + HV + r * 144 + cch * 16) = *(const u32x4*)(VT + ((size_t)b * 512 + h * 128 + r) * SEQ + t0 + cch * 8); }
}
DEVI void ph_hgrn_states(LAS unsigned char* lds, const bf16_t* u, const bf16_t* VT, const float* lbraw, float* HS, float* HD, int vb0, int vbs) {
    const int tid = opq((int)threadIdx.x), wid = __builtin_amdgcn_readfirstlane(tid >> 6), lane = tid & 63, fr = lane & 15, fq = lane >> 4;
    const int pc = tid & 127, pI = tid >> 7;
    for (int unit = vb0; unit < NB * 4 * 2 * 16; unit += vbs) {
        const int seg = unit & 15, dir = (unit >> 4) & 1, h = (unit >> 5) & 3, b = unit >> 7;
        const float lbv = lb_of(lbraw, h * 128 + pc);
        f32x4 Sacc[8];
#pragma unroll
        for (int m = 0; m < 8; ++m) Sacc[m] = (f32x4){0.f, 0.f, 0.f, 0.f};
        float gprod = 1.f;
        if (tid < 4) *(LAS unsigned*)(lds + HZERO + tid * 4) = 0u;
        HgrnRaw R; hgrn_load(R, u, VT, dir, b, h, seg * 256 + (dir ? 3 : 0) * 64, pc, pI, tid);
#pragma unroll 1
        for (int sbi = 0; sbi < 4; ++sbi) {
            const int sb = dir ? 3 - sbi : sbi;
            const int t0 = seg * 256 + sb * 64;
            __syncthreads();
            hgrn_prep(lds, R, lbv, dir, pc, pI, tid);
            if (sbi < 3) { const int sbn = dir ? 3 - (sbi + 1) : sbi + 1; hgrn_load(R, u, VT, dir, b, h, seg * 256 + sbn * 64, pc, pI, tid); }
            __syncthreads();
            if (tid < 128) gprod *= (*(const LAS float*)(lds + HDV + tid * 4) * *(const LAS float*)(lds + HDV + (128 + tid) * 4)) * (*(const LAS float*)(lds + HDV + (256 + tid) * 4) * *(const LAS float*)(lds + HDV + (384 + tid) * 4));
#pragma unroll 1
            for (int ii = 0; ii < 4; ++ii) { const int I = dir ? 3 - ii : ii; hgrn_update(lds, Sacc, I, wid, fr, fq); }
        }
        const size_t scan = (size_t)(b * 4 + h) * 2 + dir;
        float* dst = HS + scan * HS_SCAN + (size_t)seg * 16384;
#pragma unroll
        for (int m = 0; m < 8; ++m)
#pragma unroll
            for (int rg = 0; rg < 4; ++rg) dst[(16 * m + 4 * fq + rg) * 128 + 16 * wid + fr] = Sacc[m][rg];
        if (tid < 128) HD[(scan * 16 + seg) * 128 + tid] = gprod;
    }
    __syncthreads();
}
DEVI void ph_hgrn_scan(float* HS, const float* HD, int vb0, int vbs) {
    const int tid = opq((int)threadIdx.x);
    for (int idx = vb0 * NTHR + tid; idx < 32 * 4096; idx += vbs * NTHR) {
        const int scan = idx >> 12, e4 = idx & 4095, kch = e4 >> 5; const int dir = scan & 1;
        float4* base = (float4*)(HS + (size_t)scan * HS_SCAN) + e4;
        const float* hd = HD + (size_t)scan * 16 * 128 + kch;
        float4 d[16]; float dec[16];
#pragma unroll
        for (int i = 0; i < 16; ++i) { d[i] = base[(size_t)i * 4096]; dec[i] = hd[i * 128]; }
        float4 st = make_float4(0.f, 0.f, 0.f, 0.f);
        if (dir == 0) {
#pragma unroll
            for (int i = 0; i < 16; ++i) { const float4 t = d[i]; d[i] = st; st.x = st.x * dec[i] + t.x; st.y = st.y * dec[i] + t.y; st.z = st.z * dec[i] + t.z; st.w = st.w * dec[i] + t.w; }
        } else {
#pragma unroll
            for (int i = 15; i >= 0; --i) { const float4 t = d[i]; d[i] = st; st.x = st.x * dec[i] + t.x; st.y = st.y * dec[i] + t.y; st.z = st.z * dec[i] + t.z; st.w = st.w * dec[i] + t.w; }
        }
#pragma unroll
        for (int i = 0; i < 16; ++i) base[(size_t)i * 4096] = d[i];
    }
}
DEVI void ph_hgrn_out(LAS unsigned char* lds, const bf16_t* u, const bf16_t* VT, const float* lbraw, const float* a_norm, const float* HS, float* OF, bf16_t* ocat, int vb0, int vbs) {
    const int tid = opq((int)threadIdx.x), wid = __builtin_amdgcn_readfirstlane(tid >> 6), lane = tid & 63, fr = lane & 15, fq = lane >> 4;
    const int pc = tid & 127, pI = tid >> 7;
    const int otok = tid >> 3, opart = tid & 7;
    for (int unit = vb0; unit < NB * 4 * 16; unit += vbs) {
        const int seg = unit & 15, h = (unit >> 4) & 3, b = unit >> 6;
        const float lbv = lb_of(lbraw, h * 128 + pc);
        if (tid < 4) *(LAS unsigned*)(lds + HZERO + tid * 4) = 0u;
#pragma unroll 1
        for (int dir = 0; dir < 2; ++dir) {
            const size_t scan = (size_t)(b * 4 + h) * 2 + dir;
            const float* src = HS + scan * HS_SCAN + (size_t)seg * 16384;
            f32x4 Sacc[8];
#pragma unroll
            for (int m = 0; m < 8; ++m)
#pragma unroll
                for (int rg = 0; rg < 4; ++rg) Sacc[m][rg] = src[(16 * m + 4 * fq + rg) * 128 + 16 * wid + fr];
            HgrnRaw R; hgrn_load(R, u, VT, dir, b, h, seg * 256 + (dir ? 3 : 0) * 64, pc, pI, tid);
#pragma unroll 1
            for (int sbi = 0; sbi < 4; ++sbi) {
                const int sb = dir ? 3 - sbi : sbi;
                const int t0 = seg * 256 + sb * 64;
                const size_t tokb = (size_t)b * SEQ + t0;
                __syncthreads();
                hgrn_prep(lds, R, lbv, dir, pc, pI, tid);
                if (sbi < 3) { const int sbn = dir ? 3 - (sbi + 1) : sbi + 1; hgrn_load(R, u, VT, dir, b, h, seg * 256 + sbn * 64, pc, pI, tid); }
                __syncthreads();
#pragma unroll 1
                for (int ii = 0; ii < 4; ++ii) {
                    const int I = dir ? 3 - ii : ii;
                    f32x4 oT = {0.f, 0.f, 0.f, 0.f};
                    const LAS unsigned char* qrow = lds + HQ + (16 * I + fr) * 272;
#pragma unroll
                    for (int ks = 0; ks < 4; ++ks) {
                        u32x4 sa; sa.x = pg8::cvt_pk_bf16(Sacc[2 * ks][0], Sacc[2 * ks][1]); sa.y = pg8::cvt_pk_bf16(Sacc[2 * ks][2], Sacc[2 * ks][3]);
                        sa.z = pg8::cvt_pk_bf16(Sacc[2 * ks + 1][0], Sacc[2 * ks + 1][1]); sa.w = pg8::cvt_pk_bf16(Sacc[2 * ks + 1][2], Sacc[2 * ks + 1][3]);
                        const u32x2 q0 = *(const LAS u32x2*)(qrow + (32 * ks + 4 * fq) * 2), q1 = *(const LAS u32x2*)(qrow + (32 * ks + 16 + 4 * fq) * 2);
                        u32x4 qb; qb.x = q0.x; qb.y = q0.y; qb.z = q1.x; qb.w = q1.y;
                        oT = __builtin_amdgcn_mfma_f32_16x16x32_bf16(__builtin_bit_cast(bf16x8, sa), __builtin_bit_cast(bf16x8, qb), oT, 0, 0, 0);
                    }
                    f32x4 sT = {0.f, 0.f, 0.f, 0.f};
                    const LAS unsigned char* krow = lds + HK + (16 * I + fr) * 272;
#pragma unroll
                    for (int ks = 0; ks < 4; ++ks) {
                        const bf16x8 ka = *(const LAS bf16x8*)(krow + (32 * ks + 8 * fq) * 2), qb = *(const LAS bf16x8*)(qrow + (32 * ks + 8 * fq) * 2);
                        sT = __builtin_amdgcn_mfma_f32_16x16x32_bf16(ka, qb, sT, 0, 0, 0);
                    }
                    float pv[4];
#pragma unroll
                    for (int rg = 0; rg < 4; ++rg) { const int sl = 4 * fq + rg; const bool ok = dir ? (sl >= fr) : (sl <= fr); pv[rg] = ok ? sT[rg] : 0.f; }
                    u32x4 pb; pb.x = pg8::cvt_pk_bf16(pv[0], pv[1]); pb.y = pg8::cvt_pk_bf16(pv[2], pv[3]); pb.z = 0u; pb.w = 0u;
                    const u32x2 v0 = *(const LAS u32x2*)(lds + HV + (16 * wid + fr) * 144 + (16 * I + 4 * fq) * 2);
                    u32x4 va; va.x = v0.x; va.y = v0.y; va.z = 0u; va.w = 0u;
                    oT = __builtin_amdgcn_mfma_f32_16x16x32_bf16(__builtin_bit_cast(bf16x8, va), __builtin_bit_cast(bf16x8, pb), oT, 0, 0, 0);
                    if (dir == 0) *(f32x4*)(OF + (tokb + 16 * I + fr) * 512 + h * 128 + 16 * wid + 4 * fq) = oT;
                    else *(LAS f32x4*)(lds + HOT + (16 * I + fr) * 528 + (16 * wid + 4 * fq) * 4) = oT;
                    hgrn_update(lds, Sacc, I, wid, fr, fq);
                }
                if (dir == 1) {
                    __syncthreads();
                    const LAS float* orow = (const LAS float*)(lds + HOT + otok * 528) + opart * 16;
                    float* ofp = OF + (tokb + otok) * 512 + h * 128 + opart * 16;
                    float v[16]; float ss = 0.f;
#pragma unroll
                    for (int q2 = 0; q2 < 8; ++q2) { const unsigned long long w = __hip_atomic_load((unsigned long long*)(ofp + q2 * 2), __ATOMIC_RELAXED, __HIP_MEMORY_SCOPE_AGENT);
                        v[2 * q2] = __uint_as_float((unsigned)w) + orow[2 * q2]; v[2 * q2 + 1] = __uint_as_float((unsigned)(w >> 32)) + orow[2 * q2 + 1];
                        ss += v[2 * q2] * v[2 * q2] + v[2 * q2 + 1] * v[2 * q2 + 1]; }
                    ss += __shfl_xor(ss, 1); ss += __shfl_xor(ss, 2); ss += __shfl_xor(ss, 4);
                    const float rn = rsqrtf(ss * (1.f / 128.f) + EPS);
                    const bf16_t* gp = u + (tokb + otok) * UW + 2048 + h * 128 + opart * 16;
                    const u32x4 g0 = *(const u32x4*)gp, g1 = *(const u32x4*)(gp + 8);
                    const unsigned gw[8] = {g0.x, g0.y, g0.z, g0.w, g1.x, g1.y, g1.z, g1.w};
                    unsigned ow[8];
#pragma unroll
                    for (int q2 = 0; q2 < 8; ++q2) { const float an0 = a_norm[opart * 16 + 2 * q2], an1 = a_norm[opart * 16 + 2 * q2 + 1];
                        ow[q2] = pk2(v[2 * q2] * rn * an0 * silu_f(bflo(gw[q2])), v[2 * q2 + 1] * rn * an1 * silu_f(bfhi(gw[q2]))); }
                    bf16_t* op = ocat + (tokb + otok) * DM + h * 128 + opart * 16;
                    u32x4 o0, o1; o0.x = ow[0]; o0.y = ow[1]; o0.z = ow[2]; o0.w = ow[3]; o1.x = ow[4]; o1.y = ow[5]; o1.z = ow[6]; o1.w = ow[7];
                    *(u32x4*)op = o0; *(u32x4*)(op + 8) = o1;
                }
            }
            asm volatile("s_waitcnt vmcnt(0)" ::: "memory");
        }
    }
    __syncthreads();
}

DEVI void ph_prep(const bf16_t* u, const float* cw, const float* cb, bf16_t* xconv, bf16_t* XT, bf16_t* VT, int vb0, int vbs) {
    const int tid = opq((int)threadIdx.x);
    for (int unit = vb0; unit < NB * 32 * 3; unit += vbs) {
        const int cg = unit % 3, tb = (unit / 3) & 31, b = unit / 96;
        const int t0 = tb * 128;
        if (cg < 2) {
            const int ch = cg * 512 + tid;
            float w[5];
#pragma unroll
            for (int j = 0; j < 5; ++j) w[j] = cw[j * 1024 + ch];
            const float bias = cb[ch];
            const bf16_t* up = u + (size_t)b * SEQ * UW + 3072 + ch;
            float v0, v1, v2, v3;
            v0 = (t0 - 2 >= 0) ? bf2f(up[(size_t)(t0 - 2) * UW]) : 0.f;
            v1 = (t0 - 1 >= 0) ? bf2f(up[(size_t)(t0 - 1) * UW]) : 0.f;
            v2 = bf2f(up[(size_t)t0 * UW]);
            v3 = bf2f(up[(size_t)(t0 + 1) * UW]);
            for (int t8 = 0; t8 < 128; t8 += 32) {
                float nx[32];
#pragma unroll
                for (int i = 0; i < 32; ++i) { const int tt = t0 + t8 + i + 2; nx[i] = (tt < SEQ) ? bf2f(up[(size_t)tt * UW]) : 0.f; }
                unsigned pk[16];
#pragma unroll
                for (int i = 0; i < 32; ++i) {
                    const float o = silu_f(bias + w[0] * v0 + w[1] * v1 + w[2] * v2 + w[3] * v3 + w[4] * nx[i]);
                    const bf16_t ob = f2bf(o);
                    xconv[(size_t)(b * SEQ + t0 + t8 + i) * 1024 + ch] = ob;
                    if (i & 1) pk[i >> 1] |= ((unsigned)ob << 16); else pk[i >> 1] = ob;
                    v0 = v1; v1 = v2; v2 = v3; v3 = nx[i];
                }
                if (ch < 768) {
#pragma unroll
                    for (int q = 0; q < 4; ++q) { u32x4 o4; o4.x = pk[4 * q]; o4.y = pk[4 * q + 1]; o4.z = pk[4 * q + 2]; o4.w = pk[4 * q + 3]; *(u32x4*)(XT + ((size_t)b * 768 + ch) * SEQ + t0 + t8 + 8 * q) = o4; } }
            }
        } else {
            const int ch = tid;
            const bf16_t* up = u + (size_t)b * SEQ * UW + 1536 + ch;
            for (int t8 = 0; t8 < 128; t8 += 32) {
                unsigned pk[16];
#pragma unroll
                for (int i = 0; i < 32; ++i) { const unsigned ob = up[(size_t)(t0 + t8 + i) * UW]; if (i & 1) pk[i >> 1] |= (ob << 16); else pk[i >> 1] = ob; }
#pragma unroll
                for (int q = 0; q < 4; ++q) { u32x4 o4; o4.x = pk[4 * q]; o4.y = pk[4 * q + 1]; o4.z = pk[4 * q + 2]; o4.w = pk[4 * q + 3]; *(u32x4*)(VT + ((size_t)b * 512 + ch) * SEQ + t0 + t8 + 8 * q) = o4; }
            }
        }
    }
}

constexpr int MB_XT = 0, MB_BX = 256 * 272, MB_DT = MB_BX + 128 * 272, MB_CS = MB_DT + 8 * 128 * 4, MB_TOT = MB_CS + 8 * 128 * 4, MB_END = MB_TOT + 64;
static_assert(MB_END <= 131072, "mamba lds");
constexpr size_t MS_SCAN = (size_t)32 * 8192;
DEVI bf16x8 pack8(const float* v) { u32x4 w; w.x = pg8::cvt_pk_bf16(v[0], v[1]); w.y = pg8::cvt_pk_bf16(v[2], v[3]); w.z = pg8::cvt_pk_bf16(v[4], v[5]); w.w = pg8::cvt_pk_bf16(v[6], v[7]); return __builtin_bit_cast(bf16x8, w); }
DEVI void mamba_tables(LAS unsigned char* lds, const float* dtraw, const float* A_log, const float* dt_bias, int b, int g, int c, int wid, int lane) {
    LAS float* tdt = (LAS float*)(lds + MB_DT); LAS float* tcs = (LAS float*)(lds + MB_CS); LAS float* ttot = (LAS float*)(lds + MB_TOT);
    const int r = wid >> 1, dir = wid & 1, hd = 4 * g + r;
    const float A = -__expf(A_log[dir * 8 + hd]), bias = dt_bias[dir * 8 + hd];
    const size_t tk = (size_t)b * SEQ + c * 128 + 2 * lane;
    const float dt0 = softplus_f(dtraw[tk * 16 + dir * 8 + hd] + bias), dt1 = softplus_f(dtraw[(tk + 1) * 16 + dir * 8 + hd] + bias);
    const float a0 = dt0 * A, a1 = dt1 * A;
    float sc = a0 + a1;
#pragma unroll
    for (int off = 1; off < 64; off <<= 1) { const float v = __shfl_up(sc, off); if (lane >= off) sc += v; }
    const float total = __shfl(sc, 63);
    const float pre0 = sc - a1, pre1 = sc;
    const float c0 = dir ? (total - pre0 + a0) : pre0, c1 = dir ? (total - pre1 + a1) : pre1;
    tdt[wid * 128 + 2 * lane] = dt0; tdt[wid * 128 + 2 * lane + 1] = dt1;
    tcs[wid * 128 + 2 * lane] = c0; tcs[wid * 128 + 2 * lane + 1] = c1;
    if (lane == 0) ttot[wid] = total;
}
DEVI void stage_rows(LAS unsigned char* dst, const bf16_t* src, size_t src_stride, int rows, int tid) {
    for (int e = tid; e < rows * 16; e += NTHR) { const int r = e >> 4, cch = e & 15; *(LAS u32x4*)(dst + r * 272 + cch * 16) = *(const u32x4*)(src + (size_t)r * src_stride + cch * 8); }
}
DEVI void ph_mamba_states(LAS unsigned char* lds, const bf16_t* XT, const float* dtraw, const float* A_log, const float* dt_bias, float* MS, float* MD, int vb0, int vbs) {
    const int tid = opq((int)threadIdx.x), wid = __builtin_amdgcn_readfirstlane(tid >> 6), lane = tid & 63, fr = lane & 15, fq = lane >> 4;
    LAS float* tdt = (LAS float*)(lds + MB_DT); LAS float* tcs = (LAS float*)(lds + MB_CS); LAS float* ttot = (LAS float*)(lds + MB_TOT);
    for (int unit = vb0; unit < NB * 2 * 32; unit += vbs) {
        const int c = unit & 31, g = (unit >> 5) & 1, b = unit >> 6;
        __syncthreads();
        stage_rows(lds + MB_XT, XT + ((size_t)b * 768 + g * 256) * SEQ + c * 128, SEQ, 256, tid);
        stage_rows(lds + MB_BX, XT + ((size_t)b * 768 + 512 + g * 128) * SEQ + c * 128, SEQ, 128, tid);
        mamba_tables(lds, dtraw, A_log, dt_bias, b, g, c, wid, lane);
        __syncthreads();
        if (lane == 0) MD[((size_t)(b * 8 + 4 * g + (wid >> 1)) * 2 + (wid & 1)) * 32 + c] = __expf(ttot[wid]);
        for (int hdd = 0; hdd < 8; ++hdd) {
            const int r = hdd >> 1, dir = hdd & 1, hd = 4 * g + r;
            const float tot = ttot[hdd];
            f32x4 acc[4];
#pragma unroll
            for (int pt = 0; pt < 4; ++pt) acc[pt] = (f32x4){0.f, 0.f, 0.f, 0.f};
#pragma unroll
            for (int ks = 0; ks < 4; ++ks) {
                const int s0 = 32 * ks + 8 * fq;
                const u32x4 braw = *(const LAS u32x4*)(lds + MB_BX + (16 * wid + fr) * 272 + s0 * 2);
                float bw[8];
                const unsigned bu[4] = {braw.x, braw.y, braw.z, braw.w};
#pragma unroll
                for (int j = 0; j < 8; ++j) { const float bv = (j & 1) ? bfhi(bu[j >> 1]) : bflo(bu[j >> 1]);
                    bw[j] = bv * tdt[hdd * 128 + s0 + j] * __expf(tot - tcs[hdd * 128 + s0 + j]); }
                const bf16x8 Bf = pack8(bw);
#pragma unroll
                for (int pt = 0; pt < 4; ++pt) {
                    const bf16x8 Af = *(const LAS bf16x8*)(lds + MB_XT + (r * 64 + 16 * pt + fr) * 272 + s0 * 2);
                    acc[pt] = __builtin_amdgcn_mfma_f32_16x16x32_bf16(Af, Bf, acc[pt], 0, 0, 0);
                }
            }
            float* dst = MS + ((size_t)(b * 8 + hd) * 2 + dir) * MS_SCAN + (size_t)c * 8192;
#pragma unroll
            for (int pt = 0; pt < 4; ++pt)
#pragma unroll
                for (int rg = 0; rg < 4; ++rg) dst[(16 * pt + 4 * fq + rg) * 128 + 16 * wid + fr] = acc[pt][rg];
        }
    }
    __syncthreads();
}
DEVI void ph_mamba_scan(float* MS, const float* MD, int vb0, int vbs) {
    const int tid = opq((int)threadIdx.x);
    for (int idx = vb0 * NTHR + tid; idx < 64 * 2048; idx += vbs * NTHR) {
        const int scan = idx >> 11, e4 = idx & 2047; const int dir = scan & 1;
        float4* base = (float4*)(MS + (size_t)scan * MS_SCAN) + e4;
        const float* md = MD + (size_t)scan * 32;
        float4 h = make_float4(0.f, 0.f, 0.f, 0.f);
#pragma unroll 1
        for (int half = 0; half < 2; ++half) {
            const int c0 = (dir ? 1 - half : half) * 16;
            float4 d[16]; float dec[16];
#pragma unroll
            for (int i = 0; i < 16; ++i) { d[i] = base[(size_t)(c0 + i) * 2048]; dec[i] = md[c0 + i]; }
            if (dir == 0) {
#pragma unroll
                for (int i = 0; i < 16; ++i) { const float4 t = d[i]; d[i] = h; h.x = h.x * dec[i] + t.x; h.y = h.y * dec[i] + t.y; h.z = h.z * dec[i] + t.z; h.w = h.w * dec[i] + t.w; }
            } else {
#pragma unroll
                for (int i = 15; i >= 0; --i) { const float4 t = d[i]; d[i] = h; h.x = h.x * dec[i] + t.x; h.y = h.y * dec[i] + t.y; h.z = h.z * dec[i] + t.z; h.w = h.w * dec[i] + t.w; }
            }
#pragma unroll
            for (int i = 0; i < 16; ++i) base[(size_t)(c0 + i) * 2048] = d[i];
        }
    }
}
DEVI void ph_mamba_out(LAS unsigned char* lds, const bf16_t* u, const bf16_t* xconv, const bf16_t* XT, const float* dtraw, const float* A_log, const float* dt_bias, const float* Dskip, const float* b_norm,
                       const float* MS, bf16_t* ocat, int vb0, int vbs) {
    const int tid = opq((int)threadIdx.x), wid = __builtin_amdgcn_readfirstlane(tid >> 6), lane = tid & 63, fr = lane & 15, fq = lane >> 4;
    LAS float* tdt = (LAS float*)(lds + MB_DT); LAS float* tcs = (LAS float*)(lds + MB_CS);
    for (int unit = vb0; unit < NB * 2 * 32; unit += vbs) {
        const int c = unit & 31, g = (unit >> 5) & 1, b = unit >> 6;
        const size_t tok0 = (size_t)b * SEQ + c * 128;
        __syncthreads();
        stage_rows(lds + MB_XT, XT + ((size_t)b * 768 + g * 256) * SEQ + c * 128, SEQ, 256, tid);
        stage_rows(lds + MB_BX, xconv + tok0 * 1024 + 512 + g * 128, 1024, 128, tid);
        mamba_tables(lds, dtraw, A_log, dt_bias, b, g, c, wid, lane);
        const int tl = 16 * wid + fr;
        bf16x8 Cf[4];
#pragma unroll
        for (int ks = 0; ks < 4; ++ks) Cf[ks] = *(const bf16x8*)(xconv + (tok0 + tl) * 1024 + 768 + g * 128 + 32 * ks + 8 * fq);
        __syncthreads();
        f32x4 GT[8];
#pragma unroll
        for (int st = 0; st < 8; ++st) { GT[st] = (f32x4){0.f, 0.f, 0.f, 0.f};
#pragma unroll
            for (int ks = 0; ks < 4; ++ks) { const bf16x8 Af = *(const LAS bf16x8*)(lds + MB_BX + (16 * st + fr) * 272 + (32 * ks + 8 * fq) * 2);
                GT[st] = __builtin_amdgcn_mfma_f32_16x16x32_bf16(Af, Cf[ks], GT[st], 0, 0, 0); } }
        float ss = 0.f;
        __syncthreads();
        float4 hpre[4];
        { const float* hin0 = MS + ((size_t)(b * 8 + 4 * g) * 2) * MS_SCAN + (size_t)c * 8192;
#pragma unroll
          for (int q = 0; q < 4; ++q) hpre[q] = ((const float4*)hin0)[tid + q * NTHR]; }
#pragma unroll 1
        for (int r = 0; r < 4; ++r) {
            const int hd = 4 * g + r;
            f32x4 yv[4];
#pragma unroll
            for (int pt = 0; pt < 4; ++pt) yv[pt] = (f32x4){0.f, 0.f, 0.f, 0.f};
#pragma unroll 1
            for (int dir = 0; dir < 2; ++dir) {
                const int hdd = r * 2 + dir;
                const float cst = tcs[hdd * 128 + tl];
                LAS unsigned char* hbuf = lds + MB_BX + (hdd & 1) * 17408;
#pragma unroll
                for (int q = 0; q < 4; ++q) { const int e4 = tid + q * NTHR, pp = e4 >> 5, n4 = (e4 & 31) * 4;
                    u32x2 w; w.x = pk2(hpre[q].x, hpre[q].y); w.y = pk2(hpre[q].z, hpre[q].w); *(LAS u32x2*)(hbuf + pp * 272 + n4 * 2) = w; }
                if (hdd < 7) { const int hn = hdd + 1; const float* hinn = MS + ((size_t)(b * 8 + 4 * g + (hn >> 1)) * 2 + (hn & 1)) * MS_SCAN + (size_t)c * 8192;
#pragma unroll
                    for (int q = 0; q < 4; ++q) hpre[q] = ((const float4*)hinn)[tid + q * NTHR]; }
                __syncthreads();
                f32x4 yo[4];
#pragma unroll
                for (int pt = 0; pt < 4; ++pt) { yo[pt] = (f32x4){0.f, 0.f, 0.f, 0.f};
#pragma unroll
                    for (int ks = 0; ks < 4; ++ks) { const bf16x8 hf = *(const LAS bf16x8*)(hbuf + (16 * pt + fr) * 272 + (32 * ks + 8 * fq) * 2);
                        yo[pt] = __builtin_amdgcn_mfma_f32_16x16x32_bf16(hf, Cf[ks], yo[pt], 0, 0, 0); } }
                const float eo = __expf(cst);
#pragma unroll
                for (int pt = 0; pt < 4; ++pt) yv[pt] += yo[pt] * eo;
#pragma unroll
                for (int kp = 0; kp < 4; ++kp) {
                    const bool skip = dir ? (2 * kp + 1 < wid) : (2 * kp > wid);
                    if (!skip) {
                        float pv[8];
#pragma unroll
                        for (int hlf = 0; hlf < 2; ++hlf)
#pragma unroll
                            for (int rg = 0; rg < 4; ++rg) { const int st = 2 * kp + hlf, sl = 16 * st + 4 * fq + rg;
                                const bool ok = dir ? (sl >= tl) : (sl <= tl);
                                const float e = __expf(fminf(cst - tcs[hdd * 128 + sl], 0.f));
                                pv[hlf * 4 + rg] = ok ? GT[st][rg] * e * tdt[hdd * 128 + sl] : 0.f; }
                        const bf16x8 Pf = pack8(pv);
#pragma unroll
                        for (int pt = 0; pt < 4; ++pt) {
                            const LAS unsigned char* xr = lds + MB_XT + (r * 64 + 16 * pt + fr) * 272;
                            const u32x2 x0 = *(const LAS u32x2*)(xr + (32 * kp + 4 * fq) * 2), x1 = *(const LAS u32x2*)(xr + (32 * kp + 16 + 4 * fq) * 2);
                            u32x4 xa; xa.x = x0.x; xa.y = x0.y; xa.z = x1.x; xa.w = x1.y;
                            yv[pt] = __builtin_amdgcn_mfma_f32_16x16x32_bf16(__builtin_bit_cast(bf16x8, xa), Pf, yv[pt], 0, 0, 0);
                        }
                    }
                }
            }
            const float Dk = Dskip[hd];
#pragma unroll
            for (int pt = 0; pt < 4; ++pt) {
                const int p0 = 16 * pt + 4 * fq;
                const u32x2 xr = *(const u32x2*)(xconv + (tok0 + tl) * 1024 + hd * 64 + p0);
                const u32x2 zr = *(const u32x2*)(u + (tok0 + tl) * UW + 2560 + hd * 64 + p0);
                const float xs[4] = {bflo(xr.x), bfhi(xr.x), bflo(xr.y), bfhi(xr.y)}, zs[4] = {bflo(zr.x), bfhi(zr.x), bflo(zr.y), bfhi(zr.y)};
                float yy[4];
#pragma unroll
                for (int rg = 0; rg < 4; ++rg) { const float y = (yv[pt][rg] + Dk * xs[rg]) * silu_f(zs[rg]); yy[rg] = y; ss += y * y; }
                const unsigned long long o = (unsigned long long)pk2(yy[0], yy[1]) | ((unsigned long long)pk2(yy[2], yy[3]) << 32);
                __hip_atomic_store((unsigned long long*)(ocat + (tok0 + tl) * DM + 512 + g * 256 + r * 64 + p0), o, __ATOMIC_RELAXED, __HIP_MEMORY_SCOPE_AGENT);
            }
        }
        ss += __shfl_xor(ss, 16); ss += __shfl_xor(ss, 32);
        const float rn = rsqrtf(ss * (1.f / 256.f) + EPS);
        asm volatile("s_waitcnt vmcnt(0)" ::: "memory");
#pragma unroll 1
        for (int r = 0; r < 4; ++r)
#pragma unroll
            for (int pt = 0; pt < 4; ++pt) {
                const int cc = g * 256 + r * 64 + 16 * pt + 4 * fq;
                unsigned long long* op = (unsigned long long*)(ocat + (tok0 + tl) * DM + 512 + cc);
                const unsigned long long v = __hip_atomic_load(op, __ATOMIC_RELAXED, __HIP_MEMORY_SCOPE_AGENT);
                const unsigned vlo = (unsigned)v, vhi = (unsigned)(v >> 32);
                const float4 bn = *(const float4*)(b_norm + cc);
                const unsigned long long o = (unsigned long long)pk2(bflo(vlo) * rn * bn.x, bfhi(vlo) * rn * bn.y) | ((unsigned long long)pk2(bflo(vhi) * rn * bn.z, bfhi(vhi) * rn * bn.w) << 32);
                *op = o;
            }
    }
    __syncthreads();
}


constexpr int NA_RING = 12, NA_VT = 0, NA_VSTRIDE = NA_RING * 64 * 2 + 16, NA_BIAS = 64 * NA_VSTRIDE, NA_END = NA_BIAS + 480 * 4;
static_assert(NA_END <= 131072, "na lds");
DEVI void ph_na(LAS unsigned char* lds, const bf16_t* qkv, const float* rpb, bf16_t* oc, int vb0, int vbs) {
    const int tid = opq((int)threadIdx.x), wid = __builtin_amdgcn_readfirstlane(tid >> 6), lane = tid & 63, fr = lane & 15, fq = lane >> 4;
    LAS float* bl = (LAS float*)(lds + NA_BIAS);
    for (int chunk = vb0; chunk < NB * 16 * 4; chunk += vbs) {
        const int qr4 = chunk & 3, h = (chunk >> 2) & 15, b = chunk >> 6;
        __syncthreads();
        for (int e = tid; e < 465; e += NTHR) bl[e] = rpb[h * 465 + e];
        int staged_hi = -1;
#pragma unroll 1
        for (int ui = 0; ui < 8; ++ui) {
            const int rp = qr4 * 8 + ui;
            const int r0 = 2 * rp, rs0 = min(max(r0 - 4, 0), 56);
            const int need_hi = min(rs0 + 8, 63);
            const int lo = max(staged_hi + 1, rs0);
            for (int task = wid; task < (need_hi - lo + 1) * 8; task += 8) {
                const int kr = lo + (task >> 3), ch = task & 7, slot = kr % NA_RING;
                const u32x4 v = *(const u32x4*)(qkv + ((size_t)b * SEQ + kr * 64 + lane) * 3072 + 2048 + h * 64 + ch * 8);
                const unsigned vw[4] = {v.x, v.y, v.z, v.w};
#pragma unroll
                for (int i = 0; i < 8; ++i) *(LAS bf16_t*)(lds + NA_VT + (ch * 8 + i) * NA_VSTRIDE + (slot * 64 + lane) * 2) = (bf16_t)((i & 1) ? (vw[i >> 1] >> 16) : (vw[i >> 1] & 0xffffu));
            }
            staged_hi = need_hi > staged_hi ? need_hi : staged_hi;
            __syncthreads();
            const int r = r0 + (wid >> 2), j = wid & 3;
            const int rs = min(max(r - 4, 0), 56);
            const int bs = (j == 0) ? 0 : (j == 1) ? 8 : (j == 2) ? 24 : 32;
            const int c = 16 * j + fr, qs = min(max(c - 8, 0), 48);
            const size_t qtok = (size_t)b * SEQ + r * 64 + c;
            bf16x8 Qf[2];
#pragma unroll
            for (int ks = 0; ks < 2; ++ks) Qf[ks] = *(const bf16x8*)(qkv + qtok * 3072 + h * 64 + 32 * ks + 8 * fq);
            const bf16_t* kbase = qkv + ((size_t)b * SEQ + rs * 64 + bs + fr) * 3072 + 1024 + h * 64 + 8 * fq;
            bf16x8 kn[4];
#pragma unroll
            for (int q = 0; q < 4; ++q) kn[q] = *(const bf16x8*)(kbase + (size_t)((q >> 1) * 16) * 3072 + (q & 1) * 32);
            f32x4 O[4];
#pragma unroll
            for (int dt = 0; dt < 4; ++dt) O[dt] = (f32x4){0.f, 0.f, 0.f, 0.f};
            float mrun = -1e30f, lrun = 0.f;
#pragma unroll 1
            for (int dr = 0; dr < 8; ++dr) {
                bf16x8 kc[4];
#pragma unroll
                for (int q = 0; q < 4; ++q) kc[q] = kn[q];
                const int drn = dr < 7 ? dr + 1 : 7;
#pragma unroll
                for (int q = 0; q < 4; ++q) kn[q] = *(const bf16x8*)(kbase + ((size_t)drn * 64 + (q >> 1) * 16) * 3072 + (q & 1) * 32);
                float sv[8]; float mloc = -1e30f;
                const LAS float* brow = bl + (rs + dr - r + 7) * 31;
#pragma unroll
                for (int kg = 0; kg < 2; ++kg) {
                    f32x4 acc = {0.f, 0.f, 0.f, 0.f};
                    acc = __builtin_amdgcn_mfma_f32_16x16x32_bf16(kc[kg * 2], Qf[0], acc, 0, 0, 0);
                    acc = __builtin_amdgcn_mfma_f32_16x16x32_bf16(kc[kg * 2 + 1], Qf[1], acc, 0, 0, 0);
#pragma unroll
                    for (int rg = 0; rg < 4; ++rg) {
                        const int kcol = bs + 16 * kg + 4 * fq + rg;
                        const bool ok = (kcol >= qs) && (kcol < qs + 16);
                        const int dc = min(max(kcol - c + 15, 0), 30);
                        const float sc = ok ? acc[rg] * 0.125f + brow[dc] : -1e30f;
                        sv[kg * 4 + rg] = sc; mloc = fmaxf(mloc, sc);
                    }
                }
                mloc = fmaxf(mloc, __shfl_xor(mloc, 16)); mloc = fmaxf(mloc, __shfl_xor(mloc, 32));
                const float mnew = fmaxf(mrun, mloc);
                const float alpha = __expf(mrun - mnew);
                float psum = 0.f;
#pragma unroll
                for (int i = 0; i < 8; ++i) { const float p = __expf(sv[i] - mnew); sv[i] = p; psum += p; }
                psum += __shfl_xor(psum, 16); psum += __shfl_xor(psum, 32);
                lrun = lrun * alpha + psum; mrun = mnew;
                const bf16x8 Pf = pack8(sv);
                const int koff = (((rs + dr) % NA_RING) * 64 + bs + 4 * fq) * 2;
#pragma unroll
                for (int dt = 0; dt < 4; ++dt) {
                    const LAS unsigned char* vr = lds + NA_VT + (16 * dt + fr) * NA_VSTRIDE + koff;
                    const u32x2 v0 = *(const LAS u32x2*)vr, v1 = *(const LAS u32x2*)(vr + 32);
                    u32x4 va; va.x = v0.x; va.y = v0.y; va.z = v1.x; va.w = v1.y;
                    O[dt] = __builtin_amdgcn_mfma_f32_16x16x32_bf16(__builtin_bit_cast(bf16x8, va), Pf, O[dt] * alpha, 0, 0, 0);
                }
            }
            const float il = 1.f / lrun;
#pragma unroll
            for (int dt = 0; dt < 4; ++dt) {
                u32x2 o; o.x = pk2(O[dt][0] * il, O[dt][1] * il); o.y = pk2(O[dt][2] * il, O[dt][3] * il);
                *(u32x2*)(oc + qtok * DM + h * 64 + 16 * dt + 4 * fq) = o;
            }
        }
    }
    __syncthreads();
}

DEVI void ph_na_naive(const bf16_t* qkv, const float* rpb, bf16_t* oc, int vb0, int vbs) {
    for (int e4 = vb0 * NTHR + opq((int)threadIdx.x); e4 < MT * 16 * 4; e4 += vbs * NTHR) {
        const int dq = e4 & 3, e = e4 >> 2;
        const int hd = e / MT, tok = e % MT;
        const int b = tok >> 12, t = tok & 4095, r = t >> 6, c = t & 63;
        const int rs = min(max(r - 4, 0), 56), qs = min(max(c - 8, 0), 48);
        float q[16], o[16];
        const bf16_t* qp = qkv + (size_t)tok * 3072 + hd * 64 + dq * 16;
#pragma unroll
        for (int d = 0; d < 16; ++d) { q[d] = bf2f(qp[d]); o[d] = 0.f; }
        float m = -1e30f, l = 0.f;
        for (int dr = 0; dr < 8; ++dr)
            for (int dc = 0; dc < 16; ++dc) {
                const int kr = rs + dr, kc = qs + dc;
                const size_t kt = (size_t)b * SEQ + kr * 64 + kc;
                const bf16_t* kp = qkv + kt * 3072 + 1024 + hd * 64 + dq * 16;
                const bf16_t* vp = qkv + kt * 3072 + 2048 + hd * 64 + dq * 16;
                float s = 0.f;
#pragma unroll
                for (int d = 0; d < 16; ++d) s += q[d] * bf2f(kp[d]);
                s += __shfl_xor(s, 1); s += __shfl_xor(s, 2);
                s = s * 0.125f + rpb[hd * 465 + (kr - r + 7) * 31 + (kc - c + 15)];
                const float mn = fmaxf(m, s); const float al = __expf(m - mn), pe = __expf(s - mn);
                l = l * al + pe; m = mn;
#pragma unroll
                for (int d = 0; d < 16; ++d) o[d] = o[d] * al + pe * bf2f(vp[d]);
            }
        const float il = 1.f / l;
        bf16_t* op = oc + (size_t)tok * DM + hd * 64 + dq * 16;
#pragma unroll
        for (int d = 0; d < 16; ++d) op[d] = f2bf(o[d] * il);
    }
}

#define XB_TMO      128
#define XB_XCNT(j)  (256  + 64 * (j))
#define XB_XSUB(j)  (1280 + 64 * (j))
#define XB_XGEN(j)  (2304 + 64 * (j))
#define XB_TOP      3328
#define XB_TOPGEN   3392
#define XCD_BAR_WORDS 3456
#define XB_SPIN_CAP (1u << 18)

__device__ __forceinline__ unsigned xb_ld(unsigned* p)              { return __hip_atomic_load(p, __ATOMIC_RELAXED, __HIP_MEMORY_SCOPE_AGENT); }
__device__ __forceinline__ unsigned xb_add(unsigned* p, unsigned v) { return __hip_atomic_fetch_add(p, v, __ATOMIC_RELAXED, __HIP_MEMORY_SCOPE_AGENT); }
__device__ __forceinline__ unsigned xb_xcc_id() { return (unsigned)__builtin_amdgcn_s_getreg((3 << 11) | 20) & 0xFu; }
#define XB_SPIN(cond, bar) do { unsigned _sp = 0; while (cond) { __builtin_amdgcn_s_sleep(1); \
    if ((++_sp & 255u) == 0u) { if (xb_ld(&(bar)[XB_TMO])) break; if (_sp > XB_SPIN_CAP) { atomicAdd(&(bar)[XB_TMO], 1u); break; } } } } while (0)

struct XcdBarrier {
    unsigned* bar; unsigned x;
    volatile LAS unsigned* st;
};

__device__ __forceinline__ XcdBarrier xcd_barrier_post(unsigned* bar, volatile LAS unsigned* st) {
    XcdBarrier b; b.bar = bar; b.x = xb_xcc_id(); b.st = st;
    if (threadIdx.x == 0) (void)xb_add(&bar[XB_XCNT(b.x)], 1u);
    return b;
}
__device__ __forceinline__ void xcd_barrier_complete(unsigned* bar, unsigned x, unsigned& nloc, unsigned& nx) {
    const unsigned G = gridDim.x * gridDim.y * gridDim.z;
    unsigned sum, cnt, mine, sp = 0u;
    for (;;) {
        sum = 0u; cnt = 0u; mine = 0u;
#pragma unroll
        for (unsigned j = 0; j < 16; ++j) { const unsigned c = xb_ld(&bar[XB_XCNT(j)]); sum += c; cnt += (c > 0u) ? 1u : 0u; mine = (j == x) ? c : mine; }
        if (sum == G) break;
        __builtin_amdgcn_s_sleep(1);
        if ((++sp & 255u) == 0u) { if (xb_ld(&bar[XB_TMO])) break; if (sp > XB_SPIN_CAP) { atomicAdd(&bar[XB_TMO], 1u); break; } }
    }
    nloc = mine > 0u ? mine : 1u; nx = cnt > 0u ? cnt : 1u;
}

__device__ __forceinline__ void xcd_barrier(const XcdBarrier& b) {
    asm volatile("s_waitcnt vmcnt(0)" ::: "memory");
    __syncthreads();
    if (threadIdx.x == 0) {
        unsigned* bar = b.bar;
        __builtin_amdgcn_s_waitcnt(0);
        unsigned nloc = b.st[0], nx = b.st[1];
        if (nloc == 0u) { xcd_barrier_complete(bar, b.x, nloc, nx); b.st[0] = nloc; b.st[1] = nx; }
        const unsigned old = xb_add(&bar[XB_XSUB(b.x)], 1u);
        const unsigned gen = old / nloc;
        if (old + 1u == (gen + 1u) * nloc) {
            __builtin_amdgcn_fence(__ATOMIC_RELEASE, "agent");
            asm volatile("s_waitcnt vmcnt(0)" ::: "memory");
            const unsigned og = xb_add(&bar[XB_TOP], 1u);
            const unsigned tg = og / nx;
            if (og + 1u == (tg + 1u) * nx) xb_add(&bar[XB_TOPGEN], 1u);
            else XB_SPIN(xb_ld(&bar[XB_TOPGEN]) == tg, bar);
            __builtin_amdgcn_fence(__ATOMIC_ACQUIRE, "agent");
            xb_add(&bar[XB_XGEN(b.x)], 1u);
            asm volatile("s_waitcnt vmcnt(0)" ::: "memory");
        } else {
            XB_SPIN(xb_ld(&bar[XB_XGEN(b.x)]) == gen, bar);
            __builtin_amdgcn_fence(__ATOMIC_ACQUIRE, "agent");
            asm volatile("s_waitcnt vmcnt(0)" ::: "memory");
        }
    }
    __syncthreads();
}


struct Args { const float* in[34]; float* out; unsigned char* ws; int ph_lo, ph_hi; };
constexpr int N_PHASES = 22;

__global__ void __launch_bounds__(NTHR, 2) fwd(Args a) {
    extern __shared__ __attribute__((aligned(16))) unsigned char lds_raw[];
    float* lds = (float*)lds_raw;
    LAS unsigned char* ldsl = (LAS unsigned char*)lds_raw;
    const int vb0 = blockIdx.x, vbs = gridDim.x;
    const int lo = a.ph_lo, hi = a.ph_hi;
#define IN(k) (lo <= (k) && (k) < hi)
#define SEAM(k) do { if (IN(k) && IN((k) + 1)) xcd_barrier(bar); } while (0)
    volatile LAS unsigned* misc = (volatile LAS unsigned*)(ldsl + MISC_OFF);
    if (threadIdx.x < 4) misc[threadIdx.x] = 0u;
    __syncthreads();
    XcdBarrier bar = xcd_barrier_post((unsigned*)(a.ws + WS_CTL) + CW_BAR, misc);
    unsigned char* ws = a.ws;
    unsigned* ctl = (unsigned*)(ws + WS_CTL);
    unsigned* cnt = ctl + CW_CNT;
    int* list = (int*)(ws + WS_LIST); float* gatev = (float*)(ws + WS_GATE);
    float* dtraw = (float*)(ws + WS_DT); float* RS = (float*)(ws + WS_RS);
    bf16_t* XB = (bf16_t*)(ws + WS_XB); bf16_t* UB = (bf16_t*)(ws + WS_UB);
    bf16_t* YA = (bf16_t*)(ws + WS_YA); float* OF = (float*)(ws + WS_OF); bf16_t* OC = (bf16_t*)(ws + WS_OC);
    bf16_t* YP = (bf16_t*)(ws + WS_YP); bf16_t* YP1 = (bf16_t*)(ws + WS_YP1); bf16_t* XC = (bf16_t*)(ws + WS_YP);
    bf16_t* PB0 = (bf16_t*)(ws + WS_PB0); bf16_t* PB1 = (bf16_t*)(ws + WS_PB1);
    bf16_t* YB = (bf16_t*)(ws + WS_Y);
    float* MS = (float*)(ws + WS_MS); float* MD = (float*)(ws + WS_MD);
    float* HS = (float*)(ws + WS_HS); float* HD = (float*)(ws + WS_HD);
    bf16_t* XT = (bf16_t*)(ws + WS_XT); bf16_t* VT = (bf16_t*)(ws + WS_VT);
    const float* p_in = a.in[1];
    const int G = (int)gridDim.x, cb = (int)blockIdx.x;
    const NormB NB0{nullptr, XB, nullptr, nullptr, RS, nullptr, nullptr, nullptr, nullptr, nullptr, nullptr, nullptr, nullptr, nullptr, nullptr};
    unsigned char* XG8 = ws + WS_XG8;
    float* rsl = (float*)(ws + WS_DT);

    if (IN(0)) {
        ph_convert_weights(ldsl, a.in, ws, 0, ITEMS_DENSE, vb0, vbs);
        NormB A = NB0; A.xin = a.in[0]; A.gnext = a.in[3]; A.win = a.in[4]; A.dtraw = dtraw;
        ph_norm2<0, false, true, false>(A, vb0, vbs, (LAS float*)ldsl);
    }
    SEAM(0);
    if (IN(1)) { pg8::DenseOrder S; S.init(MT, UW, DM, (const bf16_t*)(ws + W_IN), G, cb); pg8::gemm_phase(ldsl, XB, DM, S, pg8::EpiBf16{UB, UW, RS}); }
    SEAM(1);
    if (IN(2)) { ph_prep(UB, a.in[5], a.in[6], XC, XT, VT, vb0, vbs); }
    SEAM(2);
    if (IN(3)) { ph_hgrn_states(ldsl, UB, VT, a.in[2], HS, HD, vb0, vbs); ph_mamba_states(ldsl, XT, dtraw, a.in[7], a.in[8], MS, MD, vb0, vbs); }
    SEAM(3);
    if (IN(4)) { ph_hgrn_scan(HS, HD, vb0, vbs); ph_mamba_scan(MS, MD, vb0, vbs); }
    SEAM(4);
    if (IN(5)) { ph_hgrn_out(ldsl, UB, VT, a.in[2], a.in[10], HS, OF, OC, vb0, vbs); ph_mamba_out(ldsl, UB, XC, XT, dtraw, a.in[7], a.in[8], a.in[9], a.in[11], MS, OC, vb0, vbs); }
    SEAM(5);
    if (IN(6)) { pg8::DenseOrder S; S.init(MT, DM, DM, (const bf16_t*)(ws + W_OUTE), G, cb); pg8::gemm_phase(ldsl, OC, DM, S, pg8::EpiBf16{YA, DM, nullptr}); }
    SEAM(6);
    if (IN(7)) {
        NormB A = NB0; A.y = YA; A.gpost = a.in[13];
        ph_norm2<1, false, false, false>(A, vb0, vbs);
        ph_cvt_rows(p_in, PB0, (size_t)MT * PDIM / 4, vb0, vbs);
        ph_convert_weights(ldsl, a.in, ws, ITEMS_DENSE, ITEMS_ALL, vb0, vbs);
    }
    SEAM(7);
    if (IN(8)) {
        { pg8::DenseOrder S; S.init(MT, 2 * DFF, DM, (const bf16_t*)(ws + W_GU), G, cb); pg8::gemm_phase(ldsl, XB, DM, S, pg8::EpiSwiglu{UB, DFF, RS, 0}); }
        { pg8::TailOrder S; S.init(MT, DM, PDIM, (const bf16_t*)(ws + W_PP), G, cb, (MT / 256) * (2 * DFF / 256) % G); pg8::gemm_phase(ldsl, PB0, PDIM, S, pg8::EpiBf16{YP, DM, nullptr}); }
    }
    SEAM(8);
    if (IN(9)) { pg8::DenseOrder S; S.init(MT, DM, DFF, (const bf16_t*)(ws + W_DN), G, cb); pg8::gemm_phase(ldsl, UB, DFF, S, pg8::EpiBf16{YA, DM, nullptr}); }
    SEAM(9);
    if (IN(10)) {
        NormB A = NB0; A.y = YA; A.gpost = a.in[18];
        ph_norm2<1, false, false, false>(A, vb0, vbs);
    }
    SEAM(10);
    if (IN(11)) { pg8::DenseOrder S; S.init(MT, DM, DM, (const bf16_t*)(ws + W_PG), G, cb); pg8::gemm_phase(ldsl, XB, DM, S, pg8::EpiPleGate{YP, DM, RS}); }
    SEAM(11);
    if (IN(12)) {
        NormB A = NB0; A.y = YP; A.gpost = a.in[33];
        ph_norm2<1, false, false, false>(A, vb0, vbs);
    }
    SEAM(12);
    if (IN(13)) { pg8::DenseOrder S; S.init(MT, 3072, DM, (const bf16_t*)(ws + W_QKV), G, cb); pg8::gemm_phase(ldsl, XB, DM, S, pg8::EpiBf16{UB, 3072, RS}); }
    SEAM(13);
    if (IN(14)) { ph_na(ldsl, UB, a.in[21], OC, vb0, vbs); }
    SEAM(14);
    if (IN(15)) { pg8::DenseOrder S; S.init(MT, DM, DM, (const bf16_t*)(ws + W_OUTO), G, cb); pg8::gemm_phase(ldsl, OC, DM, S, pg8::EpiBf16{YP1, DM, nullptr}); }
    SEAM(15);
    if (IN(16)) {
        NormB A = NB0; A.y = YP1; A.gpost = a.in[23]; A.gnext = a.in[24]; A.wr = a.in[25]; A.cnt = cnt; A.list = list; A.gatev = gatev; A.rsl = rsl; A.x8 = XG8;
        ph_norm2<1, false, false, true>(A, vb0, vbs, (LAS float*)ldsl);
        ph_cvt_rows(p_in + (size_t)MT * PDIM, PB1, (size_t)MT * PDIM / 4, vb0, vbs);
    }
    SEAM(16);
    if (IN(17)) { pg8::MoeOrder S; S.init(cnt, (volatile LAS int*)(ldsl + MISC_OFF + 64), 2 * DFFE, DM / 2, (const bf16_t*)(ws + W_EGU), (size_t)7 * MiB, true, G, cb);
        pg8::gemm_phase<pg8::EpiSwiglu8, pg8::MoeOrder, true>(ldsl, (const bf16_t*)XG8, DM / 2, S, pg8::EpiSwiglu8{(unsigned char*)UB, DFFE, rsl}); }
    SEAM(17);
    if (IN(18)) { pg8::MoeOrder S; S.init(cnt, (volatile LAS int*)(ldsl + MISC_OFF + 64), DM, DFFE / 2, (const bf16_t*)(ws + W_EDN), (size_t)(7 * MiB / 2), false, G, cb);
        pg8::gemm_phase<pg8::EpiMoeDown, pg8::MoeOrder, true>(ldsl, UB, DFFE / 2, S, pg8::EpiMoeDown{YB, list, gatev, 1.f / (pg8::W8_SCALE * pg8::ACT8_SCALE)});
        { pg8::TailOrder T; T.init(MT, DM, PDIM, (const bf16_t*)(ws + W_PP + 512 * 1024), G, cb, S.nwg % G); pg8::gemm_phase(ldsl, PB1, PDIM, T, pg8::EpiBf16{YP, DM, nullptr}); } }
    SEAM(18);
    if (IN(19)) {
        NormB A = NB0; A.y = YB; A.gpost = a.in[29];
        ph_norm2<2, false, false, false>(A, vb0, vbs);
    }
    SEAM(19);
    if (IN(20)) { pg8::DenseOrder S; S.init(MT, DM, DM, (const bf16_t*)(ws + W_PG + 2 * MiB), G, cb); pg8::gemm_phase(ldsl, XB, DM, S, pg8::EpiPleGate{YP, DM, RS}); }
    SEAM(20);
    if (IN(21)) {
        NormB A = NB0; A.y = YP; A.gpost = a.in[33] + DM; A.xout = a.out;
        ph_norm2<1, true, false, false>(A, vb0, vbs);
    }
#undef IN
#undef SEAM
}

extern "C" void kernel_launch(void* const* d_in, const int* in_sizes, int n_in, void* d_out, int out_size, void* d_ws, size_t ws_size, hipStream_t stream) {
    static int grid = 0;
    if (grid == 0) {
        if (n_in != 34 || out_size != MT * DM || ws_size < WS_END) { fprintf(stderr, "kernel_launch: unexpected shapes n_in %d out %d ws %zu (need %zu)\n", n_in, out_size, ws_size, (size_t)WS_END); grid = -1; return; }
        int dev = 0, cus = 0;
        if (hipGetDevice(&dev) != hipSuccess || hipDeviceGetAttribute(&cus, hipDeviceAttributeMultiprocessorCount, dev) != hipSuccess) { grid = -1; return; }
        if (hipFuncSetAttribute((const void*)fwd, hipFuncAttributeMaxDynamicSharedMemorySize, LDS_BYTES) != hipSuccess) { fprintf(stderr, "hipFuncSetAttribute failed\n"); grid = -1; return; }
        (void)hipGetLastError();
        grid = cus;
    }
    if (grid < 0) return;
    (void)hipMemsetAsync((char*)d_ws + WS_CTL, 0, CTL_ZERO_BYTES, stream);
    Args a{};
    for (int i = 0; i < 34; ++i) a.in[i] = (const float*)d_in[i];
    a.out = (float*)d_out; a.ws = (unsigned char*)d_ws;
#ifndef MK_PER_PHASE
    a.ph_lo = 0; a.ph_hi = N_PHASES;
    hipLaunchKernelGGL(fwd, dim3(grid), dim3(NTHR), LDS_BYTES, stream, a);
#else
    for (int ph = 0; ph < N_PHASES; ++ph) {
        a.ph_lo = ph; a.ph_hi = ph + 1;
        hipLaunchKernelGGL(fwd, dim3(grid), dim3(NTHR), LDS_BYTES, stream, a);
    }
#endif
}
```

```cpp
#include <hip/hip_runtime.h>
#include <stdint.h>
#include <stdio.h>

#define DEVI __device__ __forceinline__
#define LAS __attribute__((address_space(3)))
typedef unsigned short bf16_t;

constexpr int NB = 4, SEQ = 4096, DM = 1024, MT = NB * SEQ;
constexpr int EVEN_IN = 4112, UW = 4096, DFF = 2816, NEXP = 8, DFFE = 3584, PDIM = 256;
constexpr float EPS = 1e-6f;
constexpr int NTHR = 512;
constexpr int LDS_BYTES = 147456;
constexpr int MISC_OFF = 131072 + 320;
constexpr int MOE_ROWS = 2 * MT + NEXP * 256;

constexpr size_t MiB = 1u << 20;
constexpr size_t WS_CTL = 0, CTL_ZERO_BYTES = 1 * MiB;
constexpr size_t WS_LIST = 1 * MiB;
constexpr size_t WS_GATE = WS_LIST + 512 * 1024;
constexpr size_t WS_DT = 2 * MiB;
constexpr size_t WS_W = 3 * MiB;
constexpr size_t W_IN = WS_W, W_OUTE = W_IN + 8 * MiB, W_GU = W_OUTE + 2 * MiB, W_DN = W_GU + 11 * MiB, W_PG = W_DN + 6 * MiB, W_PP = W_PG + 4 * MiB,
                 W_QKV = W_PP + 1 * MiB, W_OUTO = W_QKV + 6 * MiB, W_EGU = W_OUTO + 2 * MiB, W_EDN = W_EGU + 112 * MiB, W_END = W_EDN + 56 * MiB;
constexpr size_t WS_XB = W_END;
constexpr size_t WS_R = WS_XB + 32 * MiB;
constexpr size_t WS_UB = WS_R;
constexpr size_t WS_PB0 = WS_R + 88 * MiB;
constexpr size_t WS_YA = WS_R + 128 * MiB;
constexpr size_t WS_OF = WS_R + 160 * MiB;
constexpr size_t WS_OC = WS_R + 192 * MiB;
constexpr size_t WS_YP = WS_R + 224 * MiB;
constexpr size_t WS_YP1 = WS_R;
constexpr size_t WS_PB1 = W_EDN + 32 * MiB;
constexpr size_t WS_XG8 = WS_R + 120 * MiB;
constexpr size_t WS_END = WS_R + 256 * MiB;
constexpr size_t WS_Y = W_EGU;
constexpr size_t WS_MS = W_EGU;
constexpr size_t WS_HS = W_EGU + 64 * MiB;
constexpr size_t WS_XT = W_EDN;
constexpr size_t WS_VT = W_EDN + 24 * MiB;
constexpr size_t WS_MD = W_EDN + 40 * MiB;
constexpr size_t WS_HD = W_EDN + 41 * MiB;
static_assert(WS_R + (size_t)MOE_ROWS * DFFE <= WS_XG8 && WS_XG8 + 128 * MiB <= WS_END && WS_END <= 510 * MiB, "ws map");
constexpr size_t WS_RS = WS_CTL + 512 * 1024;
constexpr int CW_CNT = 64;
constexpr int CW_BAR = 4096;

DEVI int opq(int x) { asm volatile("" : "+v"(x)); return x; }
DEVI float bf2f(bf16_t b) { return __uint_as_float(((unsigned)b) << 16); }
typedef float f32x2c __attribute__((ext_vector_type(2)));
typedef __bf16 bf16x2c __attribute__((ext_vector_type(2)));
DEVI unsigned cvt2bf(float lo, float hi) { const f32x2c v = {lo, hi}; return __builtin_bit_cast(unsigned, __builtin_convertvector(v, bf16x2c)); }
DEVI bf16_t f2bf(float f) { return (bf16_t)(cvt2bf(f, 0.f) & 0xffffu); }
DEVI float silu_f(float x) { return x * __builtin_amdgcn_rcpf(1.f + __builtin_amdgcn_exp2f(-1.44269504f * x)); }
DEVI float sigmoid_f(float x) { return __builtin_amdgcn_rcpf(1.f + __builtin_amdgcn_exp2f(-1.44269504f * x)); }
DEVI float softplus_f(float x) { return x > 20.f ? x : log1pf(__expf(x)); }
DEVI float wave_sum(float v) {
#pragma unroll
    for (int o = 1; o < 64; o <<= 1) v += __shfl_xor(v, o);
    return v;
}


typedef short bf16x8 __attribute__((ext_vector_type(8)));
typedef float f32x4 __attribute__((ext_vector_type(4)));
typedef unsigned u32x4 __attribute__((ext_vector_type(4)));
typedef unsigned u32x2 __attribute__((ext_vector_type(2)));
DEVI unsigned pk2(float lo, float hi) { return cvt2bf(lo, hi); }
DEVI float bflo(unsigned w) { return __uint_as_float(w << 16); }
DEVI float bfhi(unsigned w) { return __uint_as_float(w & 0xffff0000u); }

DEVI unsigned pg8_pk4(float a, float b, float c, float d) {
    a = __builtin_amdgcn_fmed3f(a, -448.f, 448.f); b = __builtin_amdgcn_fmed3f(b, -448.f, 448.f); c = __builtin_amdgcn_fmed3f(c, -448.f, 448.f); d = __builtin_amdgcn_fmed3f(d, -448.f, 448.f);
    int p = __builtin_amdgcn_cvt_pk_fp8_f32(a, b, 0, false); p = __builtin_amdgcn_cvt_pk_fp8_f32(c, d, p, true); return (unsigned)p; }
struct NormB { const float* xin; bf16_t* XB; const bf16_t* y; const float* gpost; float* rs; const float* gnext;
               const float* win; float* dtraw; const float* wr; unsigned* cnt; int* list; float* gatev; float* rsl; float* xout; unsigned char* x8; };
DEVI void unpack8(const u32x4 w, float* v) { v[0] = bflo(w.x); v[1] = bfhi(w.x); v[2] = bflo(w.y); v[3] = bfhi(w.y); v[4] = bflo(w.z); v[5] = bfhi(w.z); v[6] = bflo(w.w); v[7] = bfhi(w.w); }
template <int YMODE, bool FINAL, bool DT, bool ROUTE>
DEVI void ph_norm2(const NormB& A, int vb0, int vbs, LAS float* wl = nullptr) {
    const int tidq = opq((int)threadIdx.x); const int wid = tidq >> 6, lane = tidq & 63;
    if (DT || ROUTE) {
        constexpr int NJ = DT ? 16 : 8;
        __syncthreads();
        for (int e = tidq; e < DM * NJ / 4; e += NTHR) { const int k = e / (NJ / 4), j4 = (e % (NJ / 4)) * 4;
            const float4 w = DT ? *(const float4*)(A.win + (size_t)k * EVEN_IN + 4096 + j4) : *(const float4*)(A.wr + (size_t)k * 8 + j4);
            wl[(j4 + 0) * DM + k] = w.x; wl[(j4 + 1) * DM + k] = w.y; wl[(j4 + 2) * DM + k] = w.z; wl[(j4 + 3) * DM + k] = w.w; }
        __syncthreads();
    }
    constexpr int R = (DT || ROUTE) ? 2 : 4;
    for (int row0 = (vb0 * 8 + wid) * R; row0 < MT; row0 += vbs * 8 * R) {
        float xv[R][16]; float yv[R][16];
#pragma unroll
        for (int rr = 0; rr < R; ++rr) {
            const size_t ro = (size_t)(row0 + rr) * DM + lane * 8;
            if (YMODE == 0) {
#pragma unroll
                for (int i = 0; i < 2; ++i) { const float4 p0 = *(const float4*)(A.xin + ro + i * 512), p1 = *(const float4*)(A.xin + ro + i * 512 + 4);
                    xv[rr][i * 8 + 0] = p0.x; xv[rr][i * 8 + 1] = p0.y; xv[rr][i * 8 + 2] = p0.z; xv[rr][i * 8 + 3] = p0.w; xv[rr][i * 8 + 4] = p1.x; xv[rr][i * 8 + 5] = p1.y; xv[rr][i * 8 + 6] = p1.z; xv[rr][i * 8 + 7] = p1.w; }
            } else {
#pragma unroll
                for (int i = 0; i < 2; ++i) {
                    unpack8(*(const u32x4*)(A.XB + ro + i * 512), xv[rr] + i * 8);
                    unpack8(*(const u32x4*)(A.y + ro + i * 512), yv[rr] + i * 8);
                    if (YMODE == 2) { float y2[8]; unpack8(*(const u32x4*)(A.y + (size_t)MT * DM + ro + i * 512), y2);
#pragma unroll
                        for (int j = 0; j < 8; ++j) yv[rr][i * 8 + j] += y2[j]; }
                }
            }
        }
        if (YMODE != 0) {
            float gg[16];
#pragma unroll
            for (int i = 0; i < 2; ++i) { const float4 g0 = *(const float4*)(A.gpost + i * 512 + lane * 8), g1 = *(const float4*)(A.gpost + i * 512 + lane * 8 + 4);
                gg[i * 8 + 0] = g0.x; gg[i * 8 + 1] = g0.y; gg[i * 8 + 2] = g0.z; gg[i * 8 + 3] = g0.w; gg[i * 8 + 4] = g1.x; gg[i * 8 + 5] = g1.y; gg[i * 8 + 6] = g1.z; gg[i * 8 + 7] = g1.w; }
            float ss[R];
#pragma unroll
            for (int rr = 0; rr < R; ++rr) { ss[rr] = 0.f;
#pragma unroll
                for (int j = 0; j < 16; ++j) ss[rr] += yv[rr][j] * yv[rr][j]; }
#pragma unroll
            for (int o = 1; o < 64; o <<= 1)
#pragma unroll
                for (int rr = 0; rr < R; ++rr) ss[rr] += __shfl_xor(ss[rr], o);
#pragma unroll
            for (int rr = 0; rr < R; ++rr) { const float r = rsqrtf(ss[rr] * (1.f / DM) + EPS);
#pragma unroll
                for (int j = 0; j < 16; ++j) xv[rr][j] += yv[rr][j] * r * gg[j]; }
        }
        if (FINAL) {
#pragma unroll
            for (int rr = 0; rr < R; ++rr)
#pragma unroll
                for (int i = 0; i < 2; ++i) { float* op = A.xout + (size_t)(row0 + rr) * DM + i * 512 + lane * 8;
                    *(float4*)op = make_float4(xv[rr][i * 8], xv[rr][i * 8 + 1], xv[rr][i * 8 + 2], xv[rr][i * 8 + 3]); *(float4*)(op + 4) = make_float4(xv[rr][i * 8 + 4], xv[rr][i * 8 + 5], xv[rr][i * 8 + 6], xv[rr][i * 8 + 7]); }
        } else {
            float ss[R];
#pragma unroll
            for (int rr = 0; rr < R; ++rr) {
#pragma unroll
                for (int i = 0; i < 2; ++i) { u32x4 o; o.x = pk2(xv[rr][i * 8], xv[rr][i * 8 + 1]); o.y = pk2(xv[rr][i * 8 + 2], xv[rr][i * 8 + 3]); o.z = pk2(xv[rr][i * 8 + 4], xv[rr][i * 8 + 5]); o.w = pk2(xv[rr][i * 8 + 6], xv[rr][i * 8 + 7]);
                    *(u32x4*)(A.XB + (size_t)(row0 + rr) * DM + i * 512 + lane * 8) = o;
                }
                ss[rr] = 0.f;
#pragma unroll
                for (int j = 0; j < 16; ++j) ss[rr] += xv[rr][j] * xv[rr][j];
            }
#pragma unroll
            for (int o = 1; o < 64; o <<= 1)
#pragma unroll
                for (int rr = 0; rr < R; ++rr) ss[rr] += __shfl_xor(ss[rr], o);
            float r2[R];
#pragma unroll
            for (int rr = 0; rr < R; ++rr) { r2[rr] = rsqrtf(ss[rr] * (1.f / DM) + EPS); if (lane == 0) A.rs[row0 + rr] = r2[rr]; }
            if (DT || ROUTE) {
                float gn[16];
#pragma unroll
                for (int i = 0; i < 2; ++i) { const float4 g0 = *(const float4*)(A.gnext + i * 512 + lane * 8), g1 = *(const float4*)(A.gnext + i * 512 + lane * 8 + 4);
                    gn[i * 8 + 0] = g0.x; gn[i * 8 + 1] = g0.y; gn[i * 8 + 2] = g0.z; gn[i * 8 + 3] = g0.w; gn[i * 8 + 4] = g1.x; gn[i * 8 + 5] = g1.y; gn[i * 8 + 6] = g1.z; gn[i * 8 + 7] = g1.w; }
                int re1[R], re2[R], lr1[R], lr2[R]; float rw1[R], rw2[R];
                volatile LAS int* lcnt = (volatile LAS int*)((LAS unsigned char*)wl + 40960);
                if (ROUTE) { __syncthreads(); if (tidq < 8) lcnt[tidq] = 0; __syncthreads(); }
#pragma unroll
                for (int rr = 0; rr < R; ++rr) {
                    const int row = row0 + rr;
                    float hv[16];
#pragma unroll
                    for (int j = 0; j < 16; ++j) hv[j] = (rr == 0 ? xv[0][j] : xv[R - 1][j]) * (rr == 0 ? r2[0] : r2[R - 1]) * gn[j];
                    if (DT) {
                        float dk = 0.f;
#pragma unroll 1
                        for (int j = 0; j < 16; ++j) {
                            float p = 0.f;
#pragma unroll
                            for (int i = 0; i < 2; ++i) { const LAS float* wp = wl + j * DM + i * 512 + lane * 8;
                                const f32x4 w0 = *(const LAS f32x4*)wp, w1 = *(const LAS f32x4*)(wp + 4);
                                p += hv[i * 8 + 0] * w0[0] + hv[i * 8 + 1] * w0[1] + hv[i * 8 + 2] * w0[2] + hv[i * 8 + 3] * w0[3] + hv[i * 8 + 4] * w1[0] + hv[i * 8 + 5] * w1[1] + hv[i * 8 + 6] * w1[2] + hv[i * 8 + 7] * w1[3]; }
                            p = wave_sum(p);
                            dk = (lane == j) ? p : dk;
                        }
                        if (lane < 16) A.dtraw[(size_t)row * 16 + lane] = dk;
                    }
                    if (ROUTE) {
                        float lk = 0.f;
#pragma unroll 1
                        for (int e = 0; e < 8; ++e) {
                            float p = 0.f;
#pragma unroll
                            for (int i = 0; i < 2; ++i) { const LAS float* wp = wl + e * DM + i * 512 + lane * 8;
                                const f32x4 w0 = *(const LAS f32x4*)wp, w1 = *(const LAS f32x4*)(wp + 4);
                                p += hv[i * 8 + 0] * w0[0] + hv[i * 8 + 1] * w0[1] + hv[i * 8 + 2] * w0[2] + hv[i * 8 + 3] * w0[3] + hv[i * 8 + 4] * w1[0] + hv[i * 8 + 5] * w1[1] + hv[i * 8 + 6] * w1[2] + hv[i * 8 + 7] * w1[3]; }
                            p = wave_sum(p);
                            lk = (lane == e) ? p : lk;
                        }
                        float lg[8];
#pragma unroll
                        for (int e = 0; e < 8; ++e) lg[e] = __shfl(lk, e);
                        int e1 = 0; float v1 = lg[0];
#pragma unroll
                        for (int e = 1; e < 8; ++e) if (lg[e] > v1) { v1 = lg[e]; e1 = e; }
                        int e2 = 0; float v2 = -3.0e38f;
#pragma unroll
                        for (int e = 0; e < 8; ++e) if (e != e1 && lg[e] > v2) { v2 = lg[e]; e2 = e; }
                        const float ex = __expf(v2 - v1);
                        re1[rr] = e1; re2[rr] = e2; rw1[rr] = 1.f / (1.f + ex); rw2[rr] = ex / (1.f + ex);
                        if (lane == 0) { lr1[rr] = __hip_atomic_fetch_add((LAS int*)lcnt + e1, 1, __ATOMIC_RELAXED, __HIP_MEMORY_SCOPE_WORKGROUP); lr2[rr] = __hip_atomic_fetch_add((LAS int*)lcnt + e2, 1, __ATOMIC_RELAXED, __HIP_MEMORY_SCOPE_WORKGROUP); }
                    }
                }
                if (ROUTE) {
                    __syncthreads();
                    if (tidq < 8) lcnt[8 + tidq] = (int)atomicAdd(&A.cnt[tidq * 64], (unsigned)lcnt[tidq]);
                    __syncthreads();
#pragma unroll
                    for (int rr = 0; rr < R; ++rr) {
                        const int row = row0 + rr;
                        int dst1 = 0, dst2 = 0;
                        if (lane == 0) {
                            const int e1 = re1[rr], e2 = re2[rr];
                            const int p1 = lcnt[8 + e1] + lr1[rr], p2 = lcnt[8 + e2] + lr2[rr];
                            A.list[e1 * MT + p1] = row * 2; A.gatev[e1 * MT + p1] = rw1[rr]; A.rsl[e1 * MT + p1] = r2[rr];
                            A.list[e2 * MT + p2] = row * 2 + 1; A.gatev[e2 * MT + p2] = rw2[rr]; A.rsl[e2 * MT + p2] = r2[rr];
                            dst1 = e1 * MT + p1; dst2 = e2 * MT + p2;
                        }
                        dst1 = __builtin_amdgcn_readfirstlane(dst1); dst2 = __builtin_amdgcn_readfirstlane(dst2);
#pragma unroll
                        for (int i = 0; i < 2; ++i) { u32x2 o8;
                            const float* xs = xv[rr] + i * 8;
                            o8.x = pg8_pk4(xs[0], xs[1], xs[2], xs[3]); o8.y = pg8_pk4(xs[4], xs[5], xs[6], xs[7]);
                            *(u32x2*)(A.x8 + (size_t)dst1 * DM + i * 512 + lane * 8) = o8; *(u32x2*)(A.x8 + (size_t)dst2 * DM + i * 512 + lane * 8) = o8; }
                    }
                }
            }
        }
    }
}

DEVI void transpose_item(const float* W, int ldw, int K, int k0, int n0, bf16_t* WT, int drow0, LAS float* scr, int lane, const float* gain) {
    {
        const int ka = lane >> 3, n4 = (lane & 7) * 4;
        float4 wv[8];
#pragma unroll
        for (int i = 0; i < 8; ++i) wv[i] = *(const float4*)(W + (size_t)(k0 + i * 8 + ka) * ldw + n0 + n4);
#pragma unroll
        for (int i = 0; i < 8; ++i) { LAS float* d = scr + (i * 8 + ka) * 33 + n4; d[0] = wv[i].x; d[1] = wv[i].y; d[2] = wv[i].z; d[3] = wv[i].w; }
    }
    asm volatile("s_waitcnt lgkmcnt(0)" ::: "memory");
    const int c = lane & 7;
    float4 ga = make_float4(1.f, 1.f, 1.f, 1.f), gb = ga;
    if (gain) { ga = *(const float4*)(gain + k0 + 8 * c); gb = *(const float4*)(gain + k0 + 8 * c + 4); }
#pragma unroll
    for (int j = 0; j < 4; ++j) { const int n = (lane >> 3) + 8 * j; const LAS float* sp = scr + (8 * c) * 33 + n;
        u32x4 o; o.x = pk2(sp[0 * 33] * ga.x, sp[1 * 33] * ga.y); o.y = pk2(sp[2 * 33] * ga.z, sp[3 * 33] * ga.w); o.z = pk2(sp[4 * 33] * gb.x, sp[5 * 33] * gb.y); o.w = pk2(sp[6 * 33] * gb.z, sp[7 * 33] * gb.w);
        *(u32x4*)(WT + (size_t)(drow0 + n) * K + k0 + 8 * c) = o; }
    asm volatile("s_waitcnt lgkmcnt(0)" ::: "memory");
}
DEVI void transpose_item_fp8(const float* W, int ldw, int K, int k0, int n0, unsigned char* WT8, int drow0, LAS float* scr, int lane, const float* gain) {
    {
        const int ka = lane >> 3, n4 = (lane & 7) * 4;
        float4 wv[8];
#pragma unroll
        for (int i = 0; i < 8; ++i) wv[i] = *(const float4*)(W + (size_t)(k0 + i * 8 + ka) * ldw + n0 + n4);
#pragma unroll
        for (int i = 0; i < 8; ++i) { LAS float* d = scr + (i * 8 + ka) * 33 + n4; d[0] = wv[i].x; d[1] = wv[i].y; d[2] = wv[i].z; d[3] = wv[i].w; }
    }
    asm volatile("s_waitcnt lgkmcnt(0)" ::: "memory");
    const int c = lane & 7;
    float4 ga = make_float4(64.f, 64.f, 64.f, 64.f), gb = ga;
    if (gain) { ga = *(const float4*)(gain + k0 + 8 * c); gb = *(const float4*)(gain + k0 + 8 * c + 4); ga.x *= 64.f; ga.y *= 64.f; ga.z *= 64.f; ga.w *= 64.f; gb.x *= 64.f; gb.y *= 64.f; gb.z *= 64.f; gb.w *= 64.f; }
#pragma unroll
    for (int j = 0; j < 4; ++j) { const int n = (lane >> 3) + 8 * j; const LAS float* sp = scr + (8 * c) * 33 + n;
        u32x2 o; o.x = pg8_pk4(sp[0 * 33] * ga.x, sp[1 * 33] * ga.y, sp[2 * 33] * ga.z, sp[3 * 33] * ga.w); o.y = pg8_pk4(sp[4 * 33] * gb.x, sp[5 * 33] * gb.y, sp[6 * 33] * gb.z, sp[7 * 33] * gb.w);
        *(u32x2*)(WT8 + (size_t)(drow0 + n) * K + k0 + 8 * c) = o; }
    asm volatile("s_waitcnt lgkmcnt(0)" ::: "memory");
}
struct Job { int in_idx; unsigned src_off; int ldw; int K; int ncols; unsigned long long dst; int mode; int item0; int gain_idx; int gain_off; int fp8; };
constexpr int NJOBS = 11 + 24;
struct JobTable { Job j[NJOBS]; int total; };
constexpr JobTable make_jobs() {
    JobTable t{}; int n = 0, it = 0;
    auto add = [&](int idx, unsigned off, int ldw, int K, int ncols, unsigned long long dst, int mode, int gi, int go, int f8 = 0) { t.j[n] = Job{idx, off, ldw, K, ncols, dst, mode, it, gi, go, f8}; it += (K / 64) * (ncols / 32); ++n; };
    add(4, 0, EVEN_IN, DM, UW, W_IN, 0, 3, 0);
    add(12, 0, DM, DM, DM, W_OUTE, 0, -1, 0);
    add(15, 0, DFF, DM, DFF, W_GU, 1, 14, 0);
    add(16, 0, DFF, DM, DFF, W_GU, 2, 14, 0);
    add(17, 0, DM, DFF, DM, W_DN, 0, -1, 0);
    add(31, 0, DM, DM, DM, W_PG, 0, 30, 0);
    add(31, DM * DM, DM, DM, DM, W_PG + 2 * MiB, 0, 30, DM);
    add(32, 0, DM, PDIM, DM, W_PP, 0, -1, 0);
    add(32, PDIM * DM, DM, PDIM, DM, W_PP + 512 * 1024, 0, -1, 0);
    add(20, 0, 3072, DM, 3072, W_QKV, 0, 19, 0);
    add(22, 0, DM, DM, DM, W_OUTO, 0, -1, 0);
    for (int e = 0; e < NEXP; ++e) {
        add(26, (unsigned)e * DM * DFFE, DFFE, DM, DFFE, W_EGU + (unsigned long long)e * 7 * MiB, 1, 24, 0, 1);
        add(27, (unsigned)e * DM * DFFE, DFFE, DM, DFFE, W_EGU + (unsigned long long)e * 7 * MiB, 2, 24, 0, 1);
        add(28, (unsigned)e * DFFE * DM, DM, DFFE, DM, W_EDN + (unsigned long long)e * (7 * MiB / 2), 0, -1, 0, 1);
    }
    t.total = it; return t;
}
__device__ const JobTable g_jobs = make_jobs();
constexpr int ITEMS_DENSE = make_jobs().j[11].item0, ITEMS_ALL = make_jobs().total;
DEVI void ph_convert_weights(LAS unsigned char* lds, const float* const* in, unsigned char* ws, int it_lo, int it_hi, int vb0, int vbs) {
    const int tidq = opq((int)threadIdx.x); const int wid = __builtin_amdgcn_readfirstlane(tidq >> 6), lane = tidq & 63;
    LAS float* scr = (LAS float*)(lds + wid * 16384);
    int jb = 0;
    for (int it = it_lo + vb0 * 8 + wid; it < it_hi; it += vbs * 8) {
        while (jb + 1 < NJOBS && g_jobs.j[jb + 1].item0 <= it) ++jb;
        const Job J = g_jobs.j[jb];
        const int r = it - J.item0; const int nblk = J.ncols / 32; const int kb = r / nblk, nb = r % nblk;
        const int n0 = nb * 32; int drow0 = n0;
        if (J.mode != 0) drow0 = (n0 >> 7) * 256 + (n0 & 127) + (J.mode == 2 ? 128 : 0);
        const float* gp = J.gain_idx >= 0 ? in[J.gain_idx] + J.gain_off : nullptr;
        if (J.fp8) transpose_item_fp8(in[J.in_idx] + J.src_off, J.ldw, J.K, kb * 64, n0, ws + J.dst, drow0, scr, lane, gp);
        else transpose_item(in[J.in_idx] + J.src_off, J.ldw, J.K, kb * 64, n0, (bf16_t*)(ws + J.dst), drow0, scr, lane, gp);
    }
}
DEVI void ph_cvt_rows(const float* src, bf16_t* dst, size_t n4, int vb0, int vbs) {
    for (size_t e = (size_t)vb0 * NTHR + opq((int)threadIdx.x); e < n4; e += (size_t)vbs * NTHR) {
        const float4 v = ((const float4*)src)[e]; u32x2 o; o.x = pk2(v.x, v.y); o.y = pk2(v.z, v.w); ((u32x2*)dst)[e] = o; }
}

namespace pg8 {
constexpr int BM = 256, BK = 64, HALF = 128, HTB = HALF * BK * 2, STAGE_BYTES = 8 * HTB, NXCD = 8, WGM = 8;
__host__ __device__ __forceinline__ int lds_byte(int r, int c) { const int st = (r >> 4) * 2 + (c >> 5), rr = r & 15, cc = c & 31, ob = rr * 64 + cc * 2; return st * 1024 + (ob ^ (((ob >> 9) & 1) << 5)); }
__host__ __device__ __forceinline__ void stage_rc(int b, int& R, int& C) { const int st = b / 1024, sb = b % 1024, swz = sb ^ (((sb >> 9) & 1) << 5); R = (st >> 1) * 16 + swz / 64; C = (st & 1) * 32 + (swz % 64) / 2; }
__host__ __device__ __forceinline__ int perm32(int rho) { const int n = rho >> 4, i = rho & 15; return 8 * (i >> 2) + 4 * n + (i & 3); }
struct Unit { int pm, pn; int row0; int arow0; int mvalid; int e; int mbase; const char* B; };
DEVI void xcd_tile(int L, int nwg, int nM, int nN, int& pm, int& pn) {
    int wgid = L; { const int q = nwg / NXCD, r = nwg % NXCD, xcd = wgid % NXCD, off = wgid / NXCD; wgid = (xcd < r ? xcd * (q + 1) : r * (q + 1) + (xcd - r) * q) + off; }
    const int nig = WGM * nN, gid = wgid / nig, fm = gid * WGM, gsz = (nM - fm) < WGM ? (nM - fm) : WGM;
    pm = fm + ((wgid % nig) % gsz); pn = (wgid % nig) / gsz;
}
struct DenseOrder {
    int nM, nN, nwg, G, c; const char* Bt; size_t tstepB;
    DEVI void init(int M, int N, int K, const bf16_t* Bt_, int G_, int c_) { nM = M / BM; nN = N / BM; nwg = nM * nN; G = G_; c = c_; Bt = (const char*)Bt_; tstepB = (size_t)BM * K * 2; }
    DEVI bool next(int i, Unit& u) const { const long L = (long)i * G + c; if (L >= nwg) return false; xcd_tile((int)L, nwg, nM, nN, u.pm, u.pn); u.row0 = u.pm * BM; u.arow0 = u.row0; u.mvalid = BM; u.e = 0; u.mbase = 0; u.B = Bt + (size_t)u.pn * tstepB; return true; }
};
struct TailOrder {
    int nM, nN, nwg, nb, r; const char* Bt; size_t tstepB;
    DEVI void init(int M, int N, int K, const bf16_t* Bt_, int G_, int c_, int first) { nM = M / BM; nN = N / BM; nwg = nM * nN; Bt = (const char*)Bt_; tstepB = (size_t)BM * K * 2;
        if (first >= G_) first = 0; nb = G_ - first; r = c_ - first; }
    DEVI bool next(int i, Unit& u) const { if (r < 0) return false; const long L = (long)i * nb + r; if (L >= nwg) return false; u.pm = (int)L / nN; u.pn = (int)L % nN; u.row0 = u.pm * BM; u.arow0 = u.row0; u.mvalid = BM; u.e = 0; u.mbase = 0; u.B = Bt + (size_t)u.pn * tstepB; return true; }
};
struct MoeOrder {
    int nM, nN, nwg, G, c; const char* Bt; size_t estepB, tstepB; const volatile LAS int* tab; bool per_expert;
    DEVI void init(const unsigned* cnt, volatile LAS int* tab_, int N, int K, const bf16_t* Bt_, size_t estep_bytes, bool per_expert_, int G_, int c_) {
        __syncthreads();
        if (threadIdx.x < 8) tab_[16 + threadIdx.x] = (int)__hip_atomic_load(cnt + threadIdx.x * 64, __ATOMIC_RELAXED, __HIP_MEMORY_SCOPE_AGENT);
        __syncthreads();
        if (threadIdx.x == 0) { int t = 0;
            for (int e = 0; e < 8; ++e) { const int n = tab_[16 + e]; tab_[e] = t; t += (n + BM - 1) / BM; }
            tab_[8] = t; }
        __syncthreads();
        tab = tab_; nM = __builtin_amdgcn_readfirstlane(tab_[8]); nN = N / BM; nwg = nM * nN; G = G_; c = c_; Bt = (const char*)Bt_; estepB = estep_bytes; tstepB = (size_t)BM * K * 2; per_expert = per_expert_;
    }
    DEVI bool next(int i, Unit& u) const { const long L = (long)i * G + c; if (L >= nwg) return false; xcd_tile((int)L, nwg, nM, nN, u.pm, u.pn);
        int e = 0;
        for (int k = 1; k < 8; ++k) if (u.pm >= __builtin_amdgcn_readfirstlane(tab[k])) e = k;
        const int t0 = __builtin_amdgcn_readfirstlane(tab[e]), n = __builtin_amdgcn_readfirstlane(tab[16 + e]);
        u.e = e; u.row0 = u.pm * BM; const int m0 = (u.pm - t0) * BM; u.mbase = m0; u.arow0 = per_expert ? e * MT + m0 : u.row0; u.mvalid = (n - m0) < BM ? (n - m0) : BM; u.B = Bt + (size_t)e * estepB + (size_t)u.pn * tstepB; return true; }
};
DEVI unsigned cvt_pk_bf16(float lo, float hi) { return cvt2bf(lo, hi); }

struct Pre8 { float v[8]; };
struct Pre16 { float v[8]; int t[8]; };
struct EpiBf16 { static constexpr bool PERM = true; bf16_t* O; int ldc; const float* rs;
    typedef Pre8 Pre;
    DEVI void pre(Pre& P, const Unit& u, int wr, int fr) const {
#pragma unroll
        for (int q = 0; q < 8; ++q) P.v[q] = rs ? rs[u.row0 + wr * 64 + fr + (q >> 2) * HALF + (q & 3) * 16] : 1.f; }
    DEVI void operator()(const f32x4 (&acc)[2][2][4][2], const Unit& u, int wr, int wc, int fr, int fq, const Pre& P) const {
        const int row0 = u.row0 + wr * 64 + fr, col0 = u.pn * BM + wc * 32 + 8 * fq;
#pragma unroll
        for (int ai = 0; ai < 2; ++ai)
#pragma unroll
            for (int m = 0; m < 4; ++m) { const int row = row0 + ai * HALF + m * 16; bf16_t* rowp = O + (size_t)row * ldc + col0;
                const float sc = P.v[ai * 4 + m];
#pragma unroll
                for (int bj = 0; bj < 2; ++bj) { const f32x4 v0 = acc[ai][bj][m][0] * sc, v1 = acc[ai][bj][m][1] * sc;
                    u32x4 w; w.x = cvt_pk_bf16(v0[0], v0[1]); w.y = cvt_pk_bf16(v0[2], v0[3]); w.z = cvt_pk_bf16(v1[0], v1[1]); w.w = cvt_pk_bf16(v1[2], v1[3]);
                    *(u32x4*)(rowp + bj * HALF) = w; } }
    } };
struct EpiPleGate { static constexpr bool PERM = true; bf16_t* T; int ldc; const float* rs;
    typedef Pre8 Pre;
    DEVI void pre(Pre& P, const Unit& u, int wr, int fr) const {
#pragma unroll
        for (int q = 0; q < 8; ++q) P.v[q] = rs[u.row0 + wr * 64 + fr + (q >> 2) * HALF + (q & 3) * 16]; }
    DEVI void operator()(const f32x4 (&acc)[2][2][4][2], const Unit& u, int wr, int wc, int fr, int fq, const Pre& P) const {
        const int row0 = u.row0 + wr * 64 + fr, col0 = u.pn * BM + wc * 32 + 8 * fq;
#pragma unroll
        for (int ai = 0; ai < 2; ++ai)
#pragma unroll
            for (int m = 0; m < 4; ++m) { const int row = row0 + ai * HALF + m * 16; bf16_t* rowp = T + (size_t)row * ldc + col0;
                const float sc = P.v[ai * 4 + m];
#pragma unroll
                for (int bj = 0; bj < 2; ++bj) { const f32x4 v0 = acc[ai][bj][m][0] * sc, v1 = acc[ai][bj][m][1] * sc;
                    const u32x4 pp = *(const u32x4*)(rowp + bj * HALF);
                    u32x4 w; w.x = cvt_pk_bf16(sigmoid_f(v0[0]) * bflo(pp.x), sigmoid_f(v0[1]) * bfhi(pp.x)); w.y = cvt_pk_bf16(sigmoid_f(v0[2]) * bflo(pp.y), sigmoid_f(v0[3]) * bfhi(pp.y));
                    w.z = cvt_pk_bf16(sigmoid_f(v1[0]) * bflo(pp.z), sigmoid_f(v1[1]) * bfhi(pp.z)); w.w = cvt_pk_bf16(sigmoid_f(v1[2]) * bflo(pp.w), sigmoid_f(v1[3]) * bfhi(pp.w));
                    *(u32x4*)(rowp + bj * HALF) = w; } }
    } };
struct EpiSwiglu { static constexpr bool PERM = true; bf16_t* O; int ldc; const float* rs; int grouped;
    typedef Pre8 Pre;
    DEVI void pre(Pre& P, const Unit& u, int wr, int fr) const {
        const float* rsb = grouped ? rs + u.e * MT + u.mbase : rs + u.row0; const int vm1 = (grouped ? u.mvalid : BM) - 1;
#pragma unroll
        for (int q = 0; q < 8; ++q) { const int rl = wr * 64 + fr + (q >> 2) * HALF + (q & 3) * 16; P.v[q] = rsb[rl <= vm1 ? rl : vm1]; } }
    DEVI void operator()(const f32x4 (&acc)[2][2][4][2], const Unit& u, int wr, int wc, int fr, int fq, const Pre& P) const {
        const int row0 = u.row0 + wr * 64 + fr, col0 = u.pn * HALF + wc * 32 + 8 * fq; const int vm1e = (grouped ? u.mvalid : BM) - 1;
#pragma unroll
        for (int ai = 0; ai < 2; ++ai)
#pragma unroll
            for (int m = 0; m < 4; ++m) { const int rl = wr * 64 + fr + ai * HALF + m * 16; bf16_t* rowp = O + (size_t)(u.row0 + rl) * ldc + col0;
                const float sc = rl <= vm1e ? P.v[ai * 4 + m] : 0.f;
                const f32x4 g0 = acc[ai][0][m][0] * sc, g1 = acc[ai][0][m][1] * sc, u0 = acc[ai][1][m][0] * sc, u1 = acc[ai][1][m][1] * sc;
                u32x4 w; w.x = cvt_pk_bf16(silu_f(g0[0]) * u0[0], silu_f(g0[1]) * u0[1]); w.y = cvt_pk_bf16(silu_f(g0[2]) * u0[2], silu_f(g0[3]) * u0[3]);
                w.z = cvt_pk_bf16(silu_f(g1[0]) * u1[0], silu_f(g1[1]) * u1[1]); w.w = cvt_pk_bf16(silu_f(g1[2]) * u1[2], silu_f(g1[3]) * u1[3]);
                *(u32x4*)rowp = w; }
    } };
constexpr float W8_SCALE = 64.f, ACT8_SCALE = 8.f;
struct EpiSwiglu8 { static constexpr bool PERM = true; unsigned char* O; int ldc; const float* rs;
    typedef Pre8 Pre;
    DEVI void pre(Pre& P, const Unit& u, int wr, int fr) const {
        const float* rsb = rs + u.e * MT + u.mbase; const int vm1 = u.mvalid - 1;
#pragma unroll
        for (int q = 0; q < 8; ++q) { const int rl = wr * 64 + fr + (q >> 2) * HALF + (q & 3) * 16; P.v[q] = rsb[rl <= vm1 ? rl : vm1]; } }
    DEVI void operator()(const f32x4 (&acc)[2][2][4][2], const Unit& u, int wr, int wc, int fr, int fq, const Pre& P) const {
        const int col0 = u.pn * HALF + wc * 32 + 8 * fq;
#pragma unroll
        for (int ai = 0; ai < 2; ++ai)
#pragma unroll
            for (int m = 0; m < 4; ++m) { const int rl = wr * 64 + fr + ai * HALF + m * 16; unsigned char* rowp = O + (size_t)(u.row0 + rl) * ldc + col0;
                const float sc = rl < u.mvalid ? P.v[ai * 4 + m] * (1.f / W8_SCALE) : 0.f;
                const f32x4 g0 = acc[ai][0][m][0] * sc, g1 = acc[ai][0][m][1] * sc, u0 = acc[ai][1][m][0] * (sc * ACT8_SCALE), u1 = acc[ai][1][m][1] * (sc * ACT8_SCALE);
                u32x2 w; w.x = pg8_pk4(silu_f(g0[0]) * u0[0], silu_f(g0[1]) * u0[1], silu_f(g0[2]) * u0[2], silu_f(g0[3]) * u0[3]);
                w.y = pg8_pk4(silu_f(g1[0]) * u1[0], silu_f(g1[1]) * u1[1], silu_f(g1[2]) * u1[2], silu_f(g1[3]) * u1[3]);
                *(u32x2*)rowp = w; }
    } };
struct EpiMoeDown { static constexpr bool PERM = true; bf16_t* Y; const int* list; const float* gatev; float oscale;
    typedef Pre16 Pre;
    DEVI void pre(Pre& P, const Unit& u, int wr, int fr) const {
        const int* lb = list + u.e * MT + u.mbase; const float* gb = gatev + u.e * MT + u.mbase; const int vm1 = u.mvalid - 1;
#pragma unroll
        for (int q = 0; q < 8; ++q) { const int rl = wr * 64 + fr + (q >> 2) * HALF + (q & 3) * 16; const int ri = rl <= vm1 ? rl : vm1; P.t[q] = lb[ri]; P.v[q] = gb[ri]; } }
    DEVI void operator()(const f32x4 (&acc)[2][2][4][2], const Unit& u, int wr, int wc, int fr, int fq, const Pre& P) const {
        const int col0 = u.pn * BM + wc * 32 + 8 * fq;
        const int mbase = u.mbase;
#pragma unroll
        for (int ai = 0; ai < 2; ++ai)
#pragma unroll
            for (int m = 0; m < 4; ++m) { const int rl = wr * 64 + fr + ai * HALF + m * 16;
                const int tsl = P.t[ai * 4 + m]; const float gt = P.v[ai * 4 + m] * oscale;
                if (rl < u.mvalid) {
                    bf16_t* rowp = Y + (size_t)(tsl & 1) * ((size_t)MT * DM) + (size_t)(tsl >> 1) * DM + col0;
#pragma unroll
                    for (int bj = 0; bj < 2; ++bj) { const f32x4 v0 = acc[ai][bj][m][0], v1 = acc[ai][bj][m][1];
                        u32x4 w; w.x = cvt_pk_bf16(v0[0] * gt, v0[1] * gt); w.y = cvt_pk_bf16(v0[2] * gt, v0[3] * gt); w.z = cvt_pk_bf16(v1[0] * gt, v1[1] * gt); w.w = cvt_pk_bf16(v1[2] * gt, v1[3] * gt);
                        *(u32x4*)(rowp + bj * HALF) = w; } } }
    } };

typedef int v8i __attribute__((ext_vector_type(8)));
typedef int v4i __attribute__((ext_vector_type(4)));
DEVI v8i cat8(const bf16x8 lo, const bf16x8 hi) { const v4i a = __builtin_bit_cast(v4i, lo), b = __builtin_bit_cast(v4i, hi); return __builtin_shufflevector(a, b, 0, 1, 2, 3, 4, 5, 6, 7); }
struct Frag16 { bf16x8 k[2]; };
struct Frag8 { v8i v; };
template <bool F> struct FragSel { typedef Frag16 T; };
template <> struct FragSel<true> { typedef Frag8 T; };
template <class Epi, class Sched, bool FP8 = false>
DEVI void gemm_phase(LAS unsigned char* lds, const bf16_t* A, const int K, const Sched& S, const Epi& E) {
    const int tid = opq((int)threadIdx.x), wid = __builtin_amdgcn_readfirstlane(tid >> 6), lane = tid & 63, wr = wid >> 2, wc = wid & 3, fr = lane & 15, fq = lane >> 4;
    const int nt = K / BK;
    unsigned voffA[2], voffB[2];
#pragma unroll
    for (int i = 0; i < 2; ++i) { int R, C; stage_rc(tid * 16 + i * 8192, R, C); const int Rb = Epi::PERM ? ((R & ~31) + perm32(R & 31)) : R;
        voffA[i] = (unsigned)(R * K + C) * 2u; voffB[i] = (unsigned)(Rb * K + C) * 2u; }
    const size_t kstep = (size_t)(BK * 2);
    const size_t hstep = (size_t)HALF * K * 2;
    const size_t rstep = (size_t)K * 2;
    const unsigned ldsw = (unsigned)wid * 1024u;
    const int aoff = lds_byte(wr * 64 + fr, fq * 8), boff = lds_byte(wc * 32 + fr, fq * 8);
#define PG8_SA(b, h) (((b) * 2 + (h)) * HTB)
#define PG8_SB(b, h) ((4 + (b) * 2 + (h)) * HTB)
#define PG8_STAGE(bufoff, gbase, voff) do { _Pragma("unroll") for (int _i = 0; _i < 2; ++_i) \
        __builtin_amdgcn_global_load_lds((const unsigned*)((const char*)(gbase) + (voff)[_i]), (LAS unsigned*)(lds + (bufoff) + ldsw + _i * 8192), 16, 0, 0); } while (0)
#define PG8_LDA(dst, b, h) do { _Pragma("unroll") for (int m = 0; m < 4; ++m) { if constexpr (FP8) dst[m].v = cat8(*(const LAS bf16x8*)(lds + PG8_SA(b, h) + aoff + m * 2048), *(const LAS bf16x8*)(lds + PG8_SA(b, h) + aoff + m * 2048 + 1024)); \
        else { _Pragma("unroll") for (int k = 0; k < 2; ++k) dst[m].k[k] = *(const LAS bf16x8*)(lds + PG8_SA(b, h) + aoff + m * 2048 + k * 1024); } } } while (0)
#define PG8_LDB(dst, b, h) do { _Pragma("unroll") for (int n = 0; n < 2; ++n) { if constexpr (FP8) dst[n].v = cat8(*(const LAS bf16x8*)(lds + PG8_SB(b, h) + boff + n * 2048), *(const LAS bf16x8*)(lds + PG8_SB(b, h) + boff + n * 2048 + 1024)); \
        else { _Pragma("unroll") for (int k = 0; k < 2; ++k) dst[n].k[k] = *(const LAS bf16x8*)(lds + PG8_SB(b, h) + boff + n * 2048 + k * 1024); } } } while (0)
#define PG8_MMA(ai, bj, At, Bt) do { __builtin_amdgcn_s_setprio(1); _Pragma("unroll") for (int m = 0; m < 4; ++m) _Pragma("unroll") for (int n = 0; n < 2; ++n) { \
        if constexpr (FP8) asm volatile("s_nop 1\n\tv_mfma_scale_f32_16x16x128_f8f6f4 %0, %1, %2, %0, %3, %3 op_sel_hi:[0,0,0]" : "+v"(acc[ai][bj][m][n]) : "v"(Bt[n].v), "v"(At[m].v), "v"(sc1)); \
        else { _Pragma("unroll") for (int k = 0; k < 2; ++k) acc[ai][bj][m][n] = __builtin_amdgcn_mfma_f32_16x16x32_bf16(Bt[n].k[k], At[m].k[k], acc[ai][bj][m][n], 0, 0, 0); } } \
        __builtin_amdgcn_s_setprio(0); } while (0)
#define PG8_WAIT_V(n) asm volatile("s_waitcnt vmcnt(" #n ")" ::: "memory")
#define PG8_WAIT_L(n) asm volatile("s_waitcnt lgkmcnt(" #n ")" ::: "memory")
#define PG8_BAR __builtin_amdgcn_s_barrier()
#define PG8_SCHED __builtin_amdgcn_sched_barrier(0)
    Unit cur, nxt; int ui = 0;
    if (!S.next(0, cur)) return;
    int sc1 = 0x7F7F7F7F; asm volatile("" : "+v"(sc1));
    f32x4 acc[2][2][4][2];
#pragma unroll
    for (int a = 0; a < 2; ++a)
#pragma unroll
        for (int b = 0; b < 2; ++b)
#pragma unroll
            for (int m = 0; m < 4; ++m)
#pragma unroll
                for (int n = 0; n < 2; ++n) acc[a][b][m][n] = (f32x4){0.f, 0.f, 0.f, 0.f};
    typename FragSel<FP8>::T At[4], B0[2], B1[2];
    const char* cA = (const char*)A + (size_t)cur.arow0 * rstep;
    const char* cB = cur.B;
    typename Epi::Pre pre; E.pre(pre, cur, wr, fr);
    PG8_STAGE(PG8_SB(0, 0), cB, voffB); PG8_STAGE(PG8_SA(0, 0), cA, voffA); PG8_STAGE(PG8_SB(0, 1), cB + hstep, voffB); PG8_STAGE(PG8_SA(0, 1), cA + hstep, voffA);
    if (wr == 1) PG8_BAR;
    PG8_WAIT_V(4); PG8_BAR;
    PG8_STAGE(PG8_SB(1, 0), cB + kstep, voffB); PG8_STAGE(PG8_SA(1, 0), cA + kstep, voffA); PG8_STAGE(PG8_SB(1, 1), cB + hstep + kstep, voffB);
    PG8_WAIT_V(6); PG8_BAR;
    for (;;) {
        const bool has_next = S.next(ui + 1, nxt);
        const char* nA = has_next ? (const char*)A + (size_t)nxt.arow0 * rstep : cA; const char* nB = has_next ? nxt.B : cB;
#pragma unroll 1
        for (int t = 0; t < nt; t += 2) {
            const bool last = (t == nt - 2);
            const char* a1 = cA + (size_t)(t + 1) * kstep;
            const char* a2 = last ? nA : cA + (size_t)(t + 2) * kstep; const char* b2 = last ? nB : cB + (size_t)(t + 2) * kstep;
            const char* a3 = a2 + kstep; const char* b3 = b2 + kstep;
            PG8_LDB(B0, 0, 0); PG8_SCHED; PG8_LDA(At, 0, 0); PG8_STAGE(PG8_SA(1, 1), a1 + hstep, voffA);
            PG8_WAIT_L(8); PG8_BAR; PG8_WAIT_L(0); PG8_MMA(0, 0, At, B0); PG8_BAR; PG8_SCHED;
            PG8_LDB(B1, 0, 1); PG8_STAGE(PG8_SB(0, 0), b2, voffB);
            PG8_BAR; PG8_WAIT_L(0); PG8_MMA(0, 1, At, B1); PG8_BAR;
            PG8_LDA(At, 0, 1); PG8_STAGE(PG8_SA(0, 0), a2, voffA);
            PG8_BAR; PG8_WAIT_L(0); PG8_MMA(1, 0, At, B0); PG8_BAR; PG8_SCHED;
            PG8_STAGE(PG8_SB(0, 1), b2 + hstep, voffB);
            PG8_WAIT_V(6); PG8_BAR; PG8_MMA(1, 1, At, B1); PG8_BAR;
            PG8_LDB(B0, 1, 0); PG8_SCHED; PG8_LDA(At, 1, 0); PG8_STAGE(PG8_SA(0, 1), a2 + hstep, voffA);
            PG8_WAIT_L(8); PG8_BAR; PG8_WAIT_L(0); PG8_MMA(0, 0, At, B0); PG8_BAR; PG8_SCHED;
            PG8_LDB(B1, 1, 1); PG8_STAGE(PG8_SB(1, 0), b3, voffB);
            PG8_BAR; PG8_WAIT_L(0); PG8_MMA(0, 1, At, B1); PG8_BAR;
            PG8_LDA(At, 1, 1); PG8_STAGE(PG8_SA(1, 0), a3, voffA);
            PG8_BAR; PG8_WAIT_L(0); PG8_MMA(1, 0, At, B0); PG8_BAR; PG8_SCHED;
            PG8_STAGE(PG8_SB(1, 1), b3 + hstep, voffB);
            PG8_WAIT_V(6); PG8_BAR; PG8_MMA(1, 1, At, B1); PG8_BAR;
        }
        if constexpr (FP8) asm volatile("s_nop 15\n\ts_nop 15" ::: "memory");
        E(acc, cur, wr, wc, fr, fq, pre);
        if (!has_next) break;
#pragma unroll
        for (int a = 0; a < 2; ++a)
#pragma unroll
            for (int b = 0; b < 2; ++b)
#pragma unroll
                for (int m = 0; m < 4; ++m)
#pragma unroll
                    for (int n = 0; n < 2; ++n) acc[a][b][m][n] = (f32x4){0.f, 0.f, 0.f, 0.f};
        cur = nxt; cA = nA; cB = nB; ++ui;
        E.pre(pre, cur, wr, fr);
        if constexpr (FP8) asm volatile("s_nop 7" ::: "memory");
    }
    PG8_WAIT_V(0);
    if (wr == 0) PG8_BAR;
    PG8_BAR;
#undef PG8_SA
#undef PG8_SB
#undef PG8_STAGE
#undef PG8_LDA
#undef PG8_LDB
#undef PG8_MMA
#undef PG8_WAIT_V
#undef PG8_WAIT_L
#undef PG8_BAR
#undef PG8_SCHED
}
}

DEVI float lb_of(const float* lbraw, int ch) {
    const float r0 = lbraw[ch], r1 = lbraw[512 + ch], r2 = lbraw[1024 + ch];
    const float mx = fmaxf(r0, fmaxf(r1, r2));
    const float e0 = __expf(r0 - mx), e1 = __expf(r1 - mx), e2 = __expf(r2 - mx);
    return e0 / (e0 + e1 + e2);
}
DEVI void ph_hgrn_naive(float* lds, const bf16_t* u, const float* lbraw, float* oacc, int vb0, int vbs) {
    float* sq = lds; float* sk = lds + 2048; float* sf = lds + 4096; float* sv = lds + 6144;
    const int tid = opq((int)threadIdx.x), j = tid >> 2, kq = tid & 3;
    for (int vb = vb0; vb < 32; vb += vbs) {
        const int dir = vb & 1, h = (vb >> 1) & 3, b = vb >> 3;
        float st[32];
#pragma unroll
        for (int i = 0; i < 32; ++i) st[i] = 0.f;
        for (int tb = 0; tb < SEQ / 16; ++tb) {
            __syncthreads();
            for (int e = tid; e < 2048; e += NTHR) {
                const int i = e >> 7, c = e & 127;
                const int t = dir ? (SEQ - 1 - (tb * 16 + i)) : (tb * 16 + i);
                const bf16_t* ur = u + (size_t)(b * SEQ + t) * UW;
                const int ch = h * 128 + c;
                const float qr = bf2f(ur[ch]), fr = bf2f(ur[(dir ? 1024 : 512) + ch]), vr = bf2f(ur[1536 + ch]);
                const float lb = lb_of(lbraw, ch);
                const float f = lb + (1.f - lb) * sigmoid_f(fr);
                sq[e] = silu_f(qr); sk[e] = 1.f - f; sf[e] = f; sv[e] = vr;
            }
            __syncthreads();
            for (int i = 0; i < 16; ++i) {
                const float vj = sv[i * 128 + j]; float acc = 0.f;
#pragma unroll
                for (int kk = 0; kk < 32; ++kk) {
                    const int kidx = kk * 4 + kq;
                    st[kk] = sf[i * 128 + kidx] * st[kk] + sk[i * 128 + kidx] * vj;
                    acc += st[kk] * sq[i * 128 + kidx];
                }
                acc += __shfl_xor(acc, 1); acc += __shfl_xor(acc, 2);
                if (kq == 0) {
                    const int t = dir ? (SEQ - 1 - (tb * 16 + i)) : (tb * 16 + i);
                    atomicAdd(&oacc[(size_t)(b * SEQ + t) * DM + h * 128 + j], acc);
                }
            }
        }
    }
    __syncthreads();
}

DEVI void ph_mixfin_hgrn(const bf16_t* u, const float* oacc, const float* a_norm, bf16_t* ocat, int vb0, int vbs) {
    const int tidq = opq((int)threadIdx.x); const int hw = tidq >> 5, l32 = tidq & 31;
    for (int row = vb0 * 16 + hw; row < MT; row += vbs * 16) {
        const int c0 = l32 * 16; float v[16]; float ss = 0.f;
        const bf16_t* ur = u + (size_t)row * UW;
#pragma unroll
        for (int i = 0; i < 16; ++i) { v[i] = oacc[(size_t)row * DM + c0 + i]; ss += v[i] * v[i]; }
        ss += __shfl_xor(ss, 1); ss += __shfl_xor(ss, 2); ss += __shfl_xor(ss, 4);
        const float r = rsqrtf(ss * (1.f / 128.f) + EPS);
#pragma unroll
        for (int i = 0; i < 16; ++i) { const int c = c0 + i; ocat[(size_t)row * DM + c] = f2bf(v[i] * r * a_norm[c & 127] * silu_f(bf2f(ur[2048 + c]))); }
    }
}


constexpr int HQ = 0, HK = 17408, HKH = 34816, HV = 53248, HDV = 71680, HZERO = 73728, HOT = 75776, H_END = HOT + 64 * 528;
static_assert(H_END <= 131072, "hgrn lds");
constexpr size_t HS_SCAN = (size_t)16 * 16384;
struct HgrnRaw { unsigned qf[16]; u32x4 v0, v1; };
DEVI void hgrn_load(HgrnRaw& R, const bf16_t* u, const bf16_t* VT, int dir, int b, int h, int t0, int c, int I, int tid) {
    const bf16_t* up = u + ((size_t)b * SEQ + t0 + 16 * I) * UW + h * 128 + c;
    const int fcol = dir ? 1024 : 512;
#pragma unroll
    for (int j = 0; j < 16; ++j) R.qf[j] = (unsigned)up[(size_t)j * UW] | ((unsigned)up[(size_t)j * UW + fcol] << 16);
    { const int e = tid, r = e >> 3, cch = e & 7; R.v0 = *(const u32x4*)(VT + ((size_t)b * 512 + h * 128 + r) * SEQ + t0 + cch * 8); }
    { const int e = tid + NTHR, r = e >> 3, cch = e & 7; R.v1 = *(const u32x4*)(VT + ((size_t)b * 512 + h * 128 + r) * SEQ + t0 + cch * 8); }
}
DEVI void hgrn_prep(LAS unsigned char* lds, const HgrnRaw& R, float lbv, int dir, int c, int I, int tid) {
    float ff[16], kk[16], qq[16];
    { const int e = tid, r = e >> 3, cch = e & 7; *(LAS u32x4*)(lds + HV + r * 144 + cch * 16) = R.v0; }
    { const int e = tid + NTHR, r = e >> 3, cch = e & 7; *(LAS u32x4*)(lds + HV + r * 144 + cch * 16) = R.v1; }
#pragma unroll
    for (int j = 0; j < 16; ++j) {
        const float fr = bfhi(R.qf[j]), qr = bflo(R.qf[j]);
        const float f = lbv + (1.f - lbv) * sigmoid_f(fr);
        ff[j] = f; kk[j] = 1.f - f; qq[j] = silu_f(qr);
    }
    float run = 1.f;
#pragma unroll
    for (int jj = 0; jj < 16; ++jj) { const int j = dir ? 15 - jj : jj; run = fmaxf(run * ff[j], 1e-30f); ff[j] = run; }
    const float PG = run;
    float kh[16];
#pragma unroll
    for (int j = 0; j < 16; ++j) {
        const float kt = kk[j] * __builtin_amdgcn_rcpf(ff[j]);
        kh[j] = kt * PG;
        *(LAS bf16_t*)(lds + HQ + (16 * I + j) * 272 + c * 2) = f2bf(qq[j] * ff[j]);
        *(LAS bf16_t*)(lds + HK + (16 * I + j) * 272 + c * 2) = f2bf(kt);
    }
    u32x4 w0, w1;
    w0.x = pk2(kh[0], kh[1]); w0.y = pk2(kh[2], kh[3]); w0.z = pk2(kh[4], kh[5]); w0.w = pk2(kh[6], kh[7]);
    w1.x = pk2(kh[8], kh[9]); w1.y = pk2(kh[10], kh[11]); w1.z = pk2(kh[12], kh[13]); w1.w = pk2(kh[14], kh[15]);
    *(LAS u32x4*)(lds + HKH + c * 144 + I * 32) = w0; *(LAS u32x4*)(lds + HKH + c * 144 + I * 32 + 16) = w1;
    *(LAS float*)(lds + HDV + (I * 128 + c) * 4) = PG;
}
DEVI void hgrn_update(LAS unsigned char* lds, f32x4 (&Sacc)[8], int I, int wid, int fr, int fq) {
    const int voff = (fq < 2) ? HV + (16 * wid + fr) * 144 + (16 * I + 8 * fq) * 2 : HZERO;
    const int koff = (fq < 2) ? HKH + fr * 144 + (16 * I + 8 * fq) * 2 : HZERO;
    const int kstep = (fq < 2) ? 16 * 144 : 0;
    const bf16x8 vb = *(const LAS bf16x8*)(lds + voff);
    bf16x8 ka[8]; f32x4 dv[8];
#pragma unroll
    for (int m = 0; m < 8; ++m) { ka[m] = *(const LAS bf16x8*)(lds + koff + m * kstep); dv[m] = *(const LAS f32x4*)(lds + HDV + (I * 128 + 16 * m + 4 * fq) * 4); }
#pragma unroll
    for (int m = 0; m < 8; ++m) Sacc[m] = __builtin_amdgcn_mfma_f32_16x16x32_bf16(ka[m], vb, Sacc[m] * dv[m], 0, 0, 0);
}
DEVI void stage_vt(LAS unsigned char* lds, const bf16_t* VT, int b, int h, int t0, int tid) {
    for (int e = tid; e < 128 * 8; e += NTHR) { const int r = e >> 3, cch = e & 7; *(LAS u32x4*)(lds + HV + r * 144 + cch * 16) = *(const u32x4*)(VT + ((size_t)b * 512 + h * 128 + r) * SEQ + t0 + cch * 8); }
}
DEVI void ph_hgrn_states(LAS unsigned char* lds, const bf16_t* u, const bf16_t* VT, const float* lbraw, float* HS, float* HD, int vb0, int vbs) {
    const int tid = opq((int)threadIdx.x), wid = __builtin_amdgcn_readfirstlane(tid >> 6), lane = tid & 63, fr = lane & 15, fq = lane >> 4;
    const int pc = tid & 127, pI = tid >> 7;
    for (int unit = vb0; unit < NB * 4 * 2 * 16; unit += vbs) {
        const int seg = unit & 15, dir = (unit >> 4) & 1, h = (unit >> 5) & 3, b = unit >> 7;
        const float lbv = lb_of(lbraw, h * 128 + pc);
        f32x4 Sacc[8];
#pragma unroll
        for (int m = 0; m < 8; ++m) Sacc[m] = (f32x4){0.f, 0.f, 0.f, 0.f};
        float gprod = 1.f;
        if (tid < 4) *(LAS unsigned*)(lds + HZERO + tid * 4) = 0u;
        HgrnRaw R; hgrn_load(R, u, VT, dir, b, h, seg * 256 + (dir ? 3 : 0) * 64, pc, pI, tid);
#pragma unroll 1
        for (int sbi = 0; sbi < 4; ++sbi) {
            const int sb = dir ? 3 - sbi : sbi;
            const int t0 = seg * 256 + sb * 64;
            __syncthreads();
            hgrn_prep(lds, R, lbv, dir, pc, pI, tid);
            if (sbi < 3) { const int sbn = dir ? 3 - (sbi + 1) : sbi + 1; hgrn_load(R, u, VT, dir, b, h, seg * 256 + sbn * 64, pc, pI, tid); }
            __syncthreads();
            if (tid < 128) gprod *= (*(const LAS float*)(lds + HDV + tid * 4) * *(const LAS float*)(lds + HDV + (128 + tid) * 4)) * (*(const LAS float*)(lds + HDV + (256 + tid) * 4) * *(const LAS float*)(lds + HDV + (384 + tid) * 4));
#pragma unroll 1
            for (int ii = 0; ii < 4; ++ii) { const int I = dir ? 3 - ii : ii; hgrn_update(lds, Sacc, I, wid, fr, fq); }
        }
        const size_t scan = (size_t)(b * 4 + h) * 2 + dir;
        float* dst = HS + scan * HS_SCAN + (size_t)seg * 16384;
#pragma unroll
        for (int m = 0; m < 8; ++m)
#pragma unroll
            for (int rg = 0; rg < 4; ++rg) dst[(16 * m + 4 * fq + rg) * 128 + 16 * wid + fr] = Sacc[m][rg];
        if (tid < 128) HD[(scan * 16 + seg) * 128 + tid] = gprod;
    }
    __syncthreads();
}
DEVI void ph_hgrn_scan(float* HS, const float* HD, int vb0, int vbs) {
    const int tid = opq((int)threadIdx.x);
    for (int idx = vb0 * NTHR + tid; idx < 32 * 4096; idx += vbs * NTHR) {
        const int scan = idx >> 12, e4 = idx & 4095, kch = e4 >> 5; const int dir = scan & 1;
        float4* base = (float4*)(HS + (size_t)scan * HS_SCAN) + e4;
        const float* hd = HD + (size_t)scan * 16 * 128 + kch;
        float4 d[16]; float dec[16];
#pragma unroll
        for (int i = 0; i < 16; ++i) { d[i] = base[(size_t)i * 4096]; dec[i] = hd[i * 128]; }
        float4 st = make_float4(0.f, 0.f, 0.f, 0.f);
        if (dir == 0) {
#pragma unroll
            for (int i = 0; i < 16; ++i) { const float4 t = d[i]; d[i] = st; st.x = st.x * dec[i] + t.x; st.y = st.y * dec[i] + t.y; st.z = st.z * dec[i] + t.z; st.w = st.w * dec[i] + t.w; }
        } else {
#pragma unroll
            for (int i = 15; i >= 0; --i) { const float4 t = d[i]; d[i] = st; st.x = st.x * dec[i] + t.x; st.y = st.y * dec[i] + t.y; st.z = st.z * dec[i] + t.z; st.w = st.w * dec[i] + t.w; }
        }
#pragma unroll
        for (int i = 0; i < 16; ++i) base[(size_t)i * 4096] = d[i];
    }
}
DEVI void ph_hgrn_out(LAS unsigned char* lds, const bf16_t* u, const bf16_t* VT, const float* lbraw, const float* a_norm, const float* HS, float* OF, bf16_t* ocat, int vb0, int vbs) {
    const int tid = opq((int)threadIdx.x), wid = __builtin_amdgcn_readfirstlane(tid >> 6), lane = tid & 63, fr = lane & 15, fq = lane >> 4;
    const int pc = tid & 127, pI = tid >> 7;
    const int otok = tid >> 3, opart = tid & 7;
    for (int unit = vb0; unit < NB * 4 * 16; unit += vbs) {
        const int seg = unit & 15, h = (unit >> 4) & 3, b = unit >> 6;
        const float lbv = lb_of(lbraw, h * 128 + pc);
        if (tid < 4) *(LAS unsigned*)(lds + HZERO + tid * 4) = 0u;
#pragma unroll 1
        for (int dir = 0; dir < 2; ++dir) {
            const size_t scan = (size_t)(b * 4 + h) * 2 + dir;
            const float* src = HS + scan * HS_SCAN + (size_t)seg * 16384;
            f32x4 Sacc[8];
#pragma unroll
            for (int m = 0; m < 8; ++m)
#pragma unroll
                for (int rg = 0; rg < 4; ++rg) Sacc[m][rg] = src[(16 * m + 4 * fq + rg) * 128 + 16 * wid + fr];
            HgrnRaw R; hgrn_load(R, u, VT, dir, b, h, seg * 256 + (dir ? 3 : 0) * 64, pc, pI, tid);
#pragma unroll 1
            for (int sbi = 0; sbi < 4; ++sbi) {
                const int sb = dir ? 3 - sbi : sbi;
                const int t0 = seg * 256 + sb * 64;
                const size_t tokb = (size_t)b * SEQ + t0;
                __syncthreads();
                hgrn_prep(lds, R, lbv, dir, pc, pI, tid);
                if (sbi < 3) { const int sbn = dir ? 3 - (sbi + 1) : sbi + 1; hgrn_load(R, u, VT, dir, b, h, seg * 256 + sbn * 64, pc, pI, tid); }
                __syncthreads();
#pragma unroll 1
                for (int ii = 0; ii < 4; ++ii) {
                    const int I = dir ? 3 - ii : ii;
                    f32x4 oT = {0.f, 0.f, 0.f, 0.f};
                    const LAS unsigned char* qrow = lds + HQ + (16 * I + fr) * 272;
#pragma unroll
                    for (int ks = 0; ks < 4; ++ks) {
                        u32x4 sa; sa.x = pg8::cvt_pk_bf16(Sacc[2 * ks][0], Sacc[2 * ks][1]); sa.y = pg8::cvt_pk_bf16(Sacc[2 * ks][2], Sacc[2 * ks][3]);
                        sa.z = pg8::cvt_pk_bf16(Sacc[2 * ks + 1][0], Sacc[2 * ks + 1][1]); sa.w = pg8::cvt_pk_bf16(Sacc[2 * ks + 1][2], Sacc[2 * ks + 1][3]);
                        const u32x2 q0 = *(const LAS u32x2*)(qrow + (32 * ks + 4 * fq) * 2), q1 = *(const LAS u32x2*)(qrow + (32 * ks + 16 + 4 * fq) * 2);
                        u32x4 qb; qb.x = q0.x; qb.y = q0.y; qb.z = q1.x; qb.w = q1.y;
                        oT = __builtin_amdgcn_mfma_f32_16x16x32_bf16(__builtin_bit_cast(bf16x8, sa), __builtin_bit_cast(bf16x8, qb), oT, 0, 0, 0);
                    }
                    f32x4 sT = {0.f, 0.f, 0.f, 0.f};
                    const LAS unsigned char* krow = lds + HK + (16 * I + fr) * 272;
#pragma unroll
                    for (int ks = 0; ks < 4; ++ks) {
                        const bf16x8 ka = *(const LAS bf16x8*)(krow + (32 * ks + 8 * fq) * 2), qb = *(const LAS bf16x8*)(qrow + (32 * ks + 8 * fq) * 2);
                        sT = __builtin_amdgcn_mfma_f32_16x16x32_bf16(ka, qb, sT, 0, 0, 0);
                    }
                    float pv[4];
#pragma unroll
                    for (int rg = 0; rg < 4; ++rg) { const int sl = 4 * fq + rg; const bool ok = dir ? (sl >= fr) : (sl <= fr); pv[rg] = ok ? sT[rg] : 0.f; }
                    u32x4 pb; pb.x = pg8::cvt_pk_bf16(pv[0], pv[1]); pb.y = pg8::cvt_pk_bf16(pv[2], pv[3]); pb.z = 0u; pb.w = 0u;
                    const u32x2 v0 = *(const LAS u32x2*)(lds + HV + (16 * wid + fr) * 144 + (16 * I + 4 * fq) * 2);
                    u32x4 va; va.x = v0.x; va.y = v0.y; va.z = 0u; va.w = 0u;
                    oT = __builtin_amdgcn_mfma_f32_16x16x32_bf16(__builtin_bit_cast(bf16x8, va), __builtin_bit_cast(bf16x8, pb), oT, 0, 0, 0);
                    if (dir == 0) *(f32x4*)(OF + (tokb + 16 * I + fr) * 512 + h * 128 + 16 * wid + 4 * fq) = oT;
                    else *(LAS f32x4*)(lds + HOT + (16 * I + fr) * 528 + (16 * wid + 4 * fq) * 4) = oT;
                    hgrn_update(lds, Sacc, I, wid, fr, fq);
                }
                if (dir == 1) {
                    __syncthreads();
                    const LAS float* orow = (const LAS float*)(lds + HOT + otok * 528) + opart * 16;
                    float* ofp = OF + (tokb + otok) * 512 + h * 128 + opart * 16;
                    float v[16]; float ss = 0.f;
#pragma unroll
                    for (int q2 = 0; q2 < 8; ++q2) { const unsigned long long w = __hip_atomic_load((unsigned long long*)(ofp + q2 * 2), __ATOMIC_RELAXED, __HIP_MEMORY_SCOPE_AGENT);
                        v[2 * q2] = __uint_as_float((unsigned)w) + orow[2 * q2]; v[2 * q2 + 1] = __uint_as_float((unsigned)(w >> 32)) + orow[2 * q2 + 1];
                        ss += v[2 * q2] * v[2 * q2] + v[2 * q2 + 1] * v[2 * q2 + 1]; }
                    ss += __shfl_xor(ss, 1); ss += __shfl_xor(ss, 2); ss += __shfl_xor(ss, 4);
                    const float rn = rsqrtf(ss * (1.f / 128.f) + EPS);
                    const bf16_t* gp = u + (tokb + otok) * UW + 2048 + h * 128 + opart * 16;
                    const u32x4 g0 = *(const u32x4*)gp, g1 = *(const u32x4*)(gp + 8);
                    const unsigned gw[8] = {g0.x, g0.y, g0.z, g0.w, g1.x, g1.y, g1.z, g1.w};
                    unsigned ow[8];
#pragma unroll
                    for (int q2 = 0; q2 < 8; ++q2) { const float an0 = a_norm[opart * 16 + 2 * q2], an1 = a_norm[opart * 16 + 2 * q2 + 1];
                        ow[q2] = pk2(v[2 * q2] * rn * an0 * silu_f(bflo(gw[q2])), v[2 * q2 + 1] * rn * an1 * silu_f(bfhi(gw[q2]))); }
                    bf16_t* op = ocat + (tokb + otok) * DM + h * 128 + opart * 16;
                    u32x4 o0, o1; o0.x = ow[0]; o0.y = ow[1]; o0.z = ow[2]; o0.w = ow[3]; o1.x = ow[4]; o1.y = ow[5]; o1.z = ow[6]; o1.w = ow[7];
                    *(u32x4*)op = o0; *(u32x4*)(op + 8) = o1;
                }
            }
            asm volatile("s_waitcnt vmcnt(0)" ::: "memory");
        }
    }
    __syncthreads();
}

DEVI void ph_prep(const bf16_t* u, const float* cw, const float* cb, bf16_t* xconv, bf16_t* XT, bf16_t* VT, int vb0, int vbs) {
    const int tid = opq((int)threadIdx.x);
    for (int unit = vb0; unit < NB * 32 * 3; unit += vbs) {
        const int cg = unit % 3, tb = (unit / 3) & 31, b = unit / 96;
        const int t0 = tb * 128;
        if (cg < 2) {
            const int ch = cg * 512 + tid;
            float w[5];
#pragma unroll
            for (int j = 0; j < 5; ++j) w[j] = cw[j * 1024 + ch];
            const float bias = cb[ch];
            const bf16_t* up = u + (size_t)b * SEQ * UW + 3072 + ch;
            float v0, v1, v2, v3;
            v0 = (t0 - 2 >= 0) ? bf2f(up[(size_t)(t0 - 2) * UW]) : 0.f;
            v1 = (t0 - 1 >= 0) ? bf2f(up[(size_t)(t0 - 1) * UW]) : 0.f;
            v2 = bf2f(up[(size_t)t0 * UW]);
            v3 = bf2f(up[(size_t)(t0 + 1) * UW]);
            for (int t8 = 0; t8 < 128; t8 += 32) {
                float nx[32];
#pragma unroll
                for (int i = 0; i < 32; ++i) { const int tt = t0 + t8 + i + 2; nx[i] = (tt < SEQ) ? bf2f(up[(size_t)tt * UW]) : 0.f; }
                unsigned pk[16];
#pragma unroll
                for (int i = 0; i < 32; ++i) {
                    const float o = silu_f(bias + w[0] * v0 + w[1] * v1 + w[2] * v2 + w[3] * v3 + w[4] * nx[i]);
                    const bf16_t ob = f2bf(o);
                    xconv[(size_t)(b * SEQ + t0 + t8 + i) * 1024 + ch] = ob;
                    if (i & 1) pk[i >> 1] |= ((unsigned)ob << 16); else pk[i >> 1] = ob;
                    v0 = v1; v1 = v2; v2 = v3; v3 = nx[i];
                }
                if (ch < 768) {
#pragma unroll
                    for (int q = 0; q < 4; ++q) { u32x4 o4; o4.x = pk[4 * q]; o4.y = pk[4 * q + 1]; o4.z = pk[4 * q + 2]; o4.w = pk[4 * q + 3]; *(u32x4*)(XT + ((size_t)b * 768 + ch) * SEQ + t0 + t8 + 8 * q) = o4; } }
            }
        } else {
            const int ch = tid;
            const bf16_t* up = u + (size_t)b * SEQ * UW + 1536 + ch;
            for (int t8 = 0; t8 < 128; t8 += 32) {
                unsigned pk[16];
#pragma unroll
                for (int i = 0; i < 32; ++i) { const unsigned ob = up[(size_t)(t0 + t8 + i) * UW]; if (i & 1) pk[i >> 1] |= (ob << 16); else pk[i >> 1] = ob; }
#pragma unroll
                for (int q = 0; q < 4; ++q) { u32x4 o4; o4.x = pk[4 * q]; o4.y = pk[4 * q + 1]; o4.z = pk[4 * q + 2]; o4.w = pk[4 * q + 3]; *(u32x4*)(VT + ((size_t)b * 512 + ch) * SEQ + t0 + t8 + 8 * q) = o4; }
            }
        }
    }
}

constexpr int MB_XT = 0, MB_BX = 256 * 272, MB_DT = MB_BX + 128 * 272, MB_CS = MB_DT + 8 * 128 * 4, MB_TOT = MB_CS + 8 * 128 * 4, MB_END = MB_TOT + 64;
static_assert(MB_END <= 131072, "mamba lds");
constexpr size_t MS_SCAN = (size_t)32 * 8192;
DEVI bf16x8 pack8(const float* v) { u32x4 w; w.x = pg8::cvt_pk_bf16(v[0], v[1]); w.y = pg8::cvt_pk_bf16(v[2], v[3]); w.z = pg8::cvt_pk_bf16(v[4], v[5]); w.w = pg8::cvt_pk_bf16(v[6], v[7]); return __builtin_bit_cast(bf16x8, w); }
DEVI void mamba_tables(LAS unsigned char* lds, const float* dtraw, const float* A_log, const float* dt_bias, int b, int g, int c, int wid, int lane) {
    LAS float* tdt = (LAS float*)(lds + MB_DT); LAS float* tcs = (LAS float*)(lds + MB_CS); LAS float* ttot = (LAS float*)(lds + MB_TOT);
    const int r = wid >> 1, dir = wid & 1, hd = 4 * g + r;
    const float A = -__expf(A_log[dir * 8 + hd]), bias = dt_bias[dir * 8 + hd];
    const size_t tk = (size_t)b * SEQ + c * 128 + 2 * lane;
    const float dt0 = softplus_f(dtraw[tk * 16 + dir * 8 + hd] + bias), dt1 = softplus_f(dtraw[(tk + 1) * 16 + dir * 8 + hd] + bias);
    const float a0 = dt0 * A, a1 = dt1 * A;
    float sc = a0 + a1;
#pragma unroll
    for (int off = 1; off < 64; off <<= 1) { const float v = __shfl_up(sc, off); if (lane >= off) sc += v; }
    const float total = __shfl(sc, 63);
    const float pre0 = sc - a1, pre1 = sc;
    const float c0 = dir ? (total - pre0 + a0) : pre0, c1 = dir ? (total - pre1 + a1) : pre1;
    tdt[wid * 128 + 2 * lane] = dt0; tdt[wid * 128 + 2 * lane + 1] = dt1;
    tcs[wid * 128 + 2 * lane] = c0; tcs[wid * 128 + 2 * lane + 1] = c1;
    if (lane == 0) ttot[wid] = total;
}
DEVI void stage_rows(LAS unsigned char* dst, const bf16_t* src, size_t src_stride, int rows, int tid) {
    for (int e = tid; e < rows * 16; e += NTHR) { const int r = e >> 4, cch = e & 15; *(LAS u32x4*)(dst + r * 272 + cch * 16) = *(const u32x4*)(src + (size_t)r * src_stride + cch * 8); }
}
DEVI void ph_mamba_states(LAS unsigned char* lds, const bf16_t* XT, const float* dtraw, const float* A_log, const float* dt_bias, float* MS, float* MD, int vb0, int vbs) {
    const int tid = opq((int)threadIdx.x), wid = __builtin_amdgcn_readfirstlane(tid >> 6), lane = tid & 63, fr = lane & 15, fq = lane >> 4;
    LAS float* tdt = (LAS float*)(lds + MB_DT); LAS float* tcs = (LAS float*)(lds + MB_CS); LAS float* ttot = (LAS float*)(lds + MB_TOT);
    for (int unit = vb0; unit < NB * 2 * 32; unit += vbs) {
        const int c = unit & 31, g = (unit >> 5) & 1, b = unit >> 6;
        __syncthreads();
        stage_rows(lds + MB_XT, XT + ((size_t)b * 768 + g * 256) * SEQ + c * 128, SEQ, 256, tid);
        stage_rows(lds + MB_BX, XT + ((size_t)b * 768 + 512 + g * 128) * SEQ + c * 128, SEQ, 128, tid);
        mamba_tables(lds, dtraw, A_log, dt_bias, b, g, c, wid, lane);
        __syncthreads();
        if (lane == 0) MD[((size_t)(b * 8 + 4 * g + (wid >> 1)) * 2 + (wid & 1)) * 32 + c] = __expf(ttot[wid]);
        for (int hdd = 0; hdd < 8; ++hdd) {
            const int r = hdd >> 1, dir = hdd & 1, hd = 4 * g + r;
            const float tot = ttot[hdd];
            f32x4 acc[4];
#pragma unroll
            for (int pt = 0; pt < 4; ++pt) acc[pt] = (f32x4){0.f, 0.f, 0.f, 0.f};
#pragma unroll
            for (int ks = 0; ks < 4; ++ks) {
                const int s0 = 32 * ks + 8 * fq;
                const u32x4 braw = *(const LAS u32x4*)(lds + MB_BX + (16 * wid + fr) * 272 + s0 * 2);
                float bw[8];
                const unsigned bu[4] = {braw.x, braw.y, braw.z, braw.w};
#pragma unroll
                for (int j = 0; j < 8; ++j) { const float bv = (j & 1) ? bfhi(bu[j >> 1]) : bflo(bu[j >> 1]);
                    bw[j] = bv * tdt[hdd * 128 + s0 + j] * __expf(tot - tcs[hdd * 128 + s0 + j]); }
                const bf16x8 Bf = pack8(bw);
#pragma unroll
                for (int pt = 0; pt < 4; ++pt) {
                    const bf16x8 Af = *(const LAS bf16x8*)(lds + MB_XT + (r * 64 + 16 * pt + fr) * 272 + s0 * 2);
                    acc[pt] = __builtin_amdgcn_mfma_f32_16x16x32_bf16(Af, Bf, acc[pt], 0, 0, 0);
                }
            }
            float* dst = MS + ((size_t)(b * 8 + hd) * 2 + dir) * MS_SCAN + (size_t)c * 8192;
#pragma unroll
            for (int pt = 0; pt < 4; ++pt)
#pragma unroll
                for (int rg = 0; rg < 4; ++rg) dst[(16 * pt + 4 * fq + rg) * 128 + 16 * wid + fr] = acc[pt][rg];
        }
    }
    __syncthreads();
}
DEVI void ph_mamba_scan(float* MS, const float* MD, int vb0, int vbs) {
    const int tid = opq((int)threadIdx.x);
    for (int idx = vb0 * NTHR + tid; idx < 64 * 2048; idx += vbs * NTHR) {
        const int scan = idx >> 11, e4 = idx & 2047; const int dir = scan & 1;
        float4* base = (float4*)(MS + (size_t)scan * MS_SCAN) + e4;
        const float* md = MD + (size_t)scan * 32;
        float4 h = make_float4(0.f, 0.f, 0.f, 0.f);
#pragma unroll 1
        for (int half = 0; half < 2; ++half) {
            const int c0 = (dir ? 1 - half : half) * 16;
            float4 d[16]; float dec[16];
#pragma unroll
            for (int i = 0; i < 16; ++i) { d[i] = base[(size_t)(c0 + i) * 2048]; dec[i] = md[c0 + i]; }
            if (dir == 0) {
#pragma unroll
                for (int i = 0; i < 16; ++i) { const float4 t = d[i]; d[i] = h; h.x = h.x * dec[i] + t.x; h.y = h.y * dec[i] + t.y; h.z = h.z * dec[i] + t.z; h.w = h.w * dec[i] + t.w; }
            } else {
#pragma unroll
                for (int i = 15; i >= 0; --i) { const float4 t = d[i]; d[i] = h; h.x = h.x * dec[i] + t.x; h.y = h.y * dec[i] + t.y; h.z = h.z * dec[i] + t.z; h.w = h.w * dec[i] + t.w; }
            }
#pragma unroll
            for (int i = 0; i < 16; ++i) base[(size_t)(c0 + i) * 2048] = d[i];
        }
    }
}
DEVI void ph_mamba_out(LAS unsigned char* lds, const bf16_t* u, const bf16_t* xconv, const bf16_t* XT, const float* dtraw, const float* A_log, const float* dt_bias, const float* Dskip, const float* b_norm,
                       const float* MS, bf16_t* ocat, int vb0, int vbs) {
    const int tid = opq((int)threadIdx.x), wid = __builtin_amdgcn_readfirstlane(tid >> 6), lane = tid & 63, fr = lane & 15, fq = lane >> 4;
    LAS float* tdt = (LAS float*)(lds + MB_DT); LAS float* tcs = (LAS float*)(lds + MB_CS);
    for (int unit = vb0; unit < NB * 2 * 32; unit += vbs) {
        const int c = unit & 31, g = (unit >> 5) & 1, b = unit >> 6;
        const size_t tok0 = (size_t)b * SEQ + c * 128;
        __syncthreads();
        stage_rows(lds + MB_XT, XT + ((size_t)b * 768 + g * 256) * SEQ + c * 128, SEQ, 256, tid);
        stage_rows(lds + MB_BX, xconv + tok0 * 1024 + 512 + g * 128, 1024, 128, tid);
        mamba_tables(lds, dtraw, A_log, dt_bias, b, g, c, wid, lane);
        const int tl = 16 * wid + fr;
        bf16x8 Cf[4];
#pragma unroll
        for (int ks = 0; ks < 4; ++ks) Cf[ks] = *(const bf16x8*)(xconv + (tok0 + tl) * 1024 + 768 + g * 128 + 32 * ks + 8 * fq);
        __syncthreads();
        f32x4 GT[8];
#pragma unroll
        for (int st = 0; st < 8; ++st) { GT[st] = (f32x4){0.f, 0.f, 0.f, 0.f};
            bf16x8 Af[4];
#pragma unroll
            for (int ks = 0; ks < 4; ++ks) Af[ks] = *(const LAS bf16x8*)(lds + MB_BX + (16 * st + fr) * 272 + (32 * ks + 8 * fq) * 2);
#pragma unroll
            for (int ks = 0; ks < 4; ++ks) GT[st] = __builtin_amdgcn_mfma_f32_16x16x32_bf16(Af[ks], Cf[ks], GT[st], 0, 0, 0); }
        float ss = 0.f;
        __syncthreads();
        float4 hpre[4];
        { const float* hin0 = MS + ((size_t)(b * 8 + 4 * g) * 2) * MS_SCAN + (size_t)c * 8192;
#pragma unroll
          for (int q = 0; q < 4; ++q) hpre[q] = ((const float4*)hin0)[tid + q * NTHR]; }
#pragma unroll 1
        for (int r = 0; r < 4; ++r) {
            const int hd = 4 * g + r;
            f32x4 yv[4];
#pragma unroll
            for (int pt = 0; pt < 4; ++pt) yv[pt] = (f32x4){0.f, 0.f, 0.f, 0.f};
#pragma unroll 1
            for (int dir = 0; dir < 2; ++dir) {
                const int hdd = r * 2 + dir;
                const float cst = tcs[hdd * 128 + tl];
                LAS unsigned char* hbuf = lds + MB_BX + (hdd & 1) * 17408;
#pragma unroll
                for (int q = 0; q < 4; ++q) { const int e4 = tid + q * NTHR, pp = e4 >> 5, n4 = (e4 & 31) * 4;
                    u32x2 w; w.x = pk2(hpre[q].x, hpre[q].y); w.y = pk2(hpre[q].z, hpre[q].w); *(LAS u32x2*)(hbuf + pp * 272 + n4 * 2) = w; }
                if (hdd < 7) { const int hn = hdd + 1; const float* hinn = MS + ((size_t)(b * 8 + 4 * g + (hn >> 1)) * 2 + (hn & 1)) * MS_SCAN + (size_t)c * 8192;
#pragma unroll
                    for (int q = 0; q < 4; ++q) hpre[q] = ((const float4*)hinn)[tid + q * NTHR]; }
                __syncthreads();
                f32x4 yo[4];
#pragma unroll
                for (int pt = 0; pt < 4; ++pt) { yo[pt] = (f32x4){0.f, 0.f, 0.f, 0.f};
                    bf16x8 hf[4];
#pragma unroll
                    for (int ks = 0; ks < 4; ++ks) hf[ks] = *(const LAS bf16x8*)(hbuf + (16 * pt + fr) * 272 + (32 * ks + 8 * fq) * 2);
#pragma unroll
                    for (int ks = 0; ks < 4; ++ks) yo[pt] = __builtin_amdgcn_mfma_f32_16x16x32_bf16(hf[ks], Cf[ks], yo[pt], 0, 0, 0); }
                const float eo = __expf(cst);
#pragma unroll
                for (int pt = 0; pt < 4; ++pt) yv[pt] += yo[pt] * eo;
#pragma unroll
                for (int kp = 0; kp < 4; ++kp) {
                    const bool skip = dir ? (2 * kp + 1 < wid) : (2 * kp > wid);
                    if (!skip) {
                        float pv[8];
#pragma unroll
                        for (int hlf = 0; hlf < 2; ++hlf)
#pragma unroll
                            for (int rg = 0; rg < 4; ++rg) { const int st = 2 * kp + hlf, sl = 16 * st + 4 * fq + rg;
                                const bool ok = dir ? (sl >= tl) : (sl <= tl);
                                const float e = __expf(fminf(cst - tcs[hdd * 128 + sl], 0.f));
                                pv[hlf * 4 + rg] = ok ? GT[st][rg] * e * tdt[hdd * 128 + sl] : 0.f; }
                        u32x2 x0[4], x1[4];
#pragma unroll
                        for (int pt = 0; pt < 4; ++pt) { const LAS unsigned char* xr = lds + MB_XT + (r * 64 + 16 * pt + fr) * 272;
                            x0[pt] = *(const LAS u32x2*)(xr + (32 * kp + 4 * fq) * 2); x1[pt] = *(const LAS u32x2*)(xr + (32 * kp + 16 + 4 * fq) * 2); }
                        const bf16x8 Pf = pack8(pv);
#pragma unroll
                        for (int pt = 0; pt < 4; ++pt) {
                            u32x4 xa; xa.x = x0[pt].x; xa.y = x0[pt].y; xa.z = x1[pt].x; xa.w = x1[pt].y;
                            yv[pt] = __builtin_amdgcn_mfma_f32_16x16x32_bf16(__builtin_bit_cast(bf16x8, xa), Pf, yv[pt], 0, 0, 0);
                        }
                    }
                }
            }
            const float Dk = Dskip[hd];
#pragma unroll
            for (int pt = 0; pt < 4; ++pt) {
                const int p0 = 16 * pt + 4 * fq;
                const u32x2 xr = *(const u32x2*)(xconv + (tok0 + tl) * 1024 + hd * 64 + p0);
                const u32x2 zr = *(const u32x2*)(u + (tok0 + tl) * UW + 2560 + hd * 64 + p0);
                const float xs[4] = {bflo(xr.x), bfhi(xr.x), bflo(xr.y), bfhi(xr.y)}, zs[4] = {bflo(zr.x), bfhi(zr.x), bflo(zr.y), bfhi(zr.y)};
                float yy[4];
#pragma unroll
                for (int rg = 0; rg < 4; ++rg) { const float y = (yv[pt][rg] + Dk * xs[rg]) * silu_f(zs[rg]); yy[rg] = y; ss += y * y; }
                const unsigned long long o = (unsigned long long)pk2(yy[0], yy[1]) | ((unsigned long long)pk2(yy[2], yy[3]) << 32);
                __hip_atomic_store((unsigned long long*)(ocat + (tok0 + tl) * DM + 512 + g * 256 + r * 64 + p0), o, __ATOMIC_RELAXED, __HIP_MEMORY_SCOPE_AGENT);
            }
        }
        ss += __shfl_xor(ss, 16); ss += __shfl_xor(ss, 32);
        const float rn = rsqrtf(ss * (1.f / 256.f) + EPS);
        asm volatile("s_waitcnt vmcnt(0)" ::: "memory");
#pragma unroll 1
        for (int r = 0; r < 4; ++r)
#pragma unroll
            for (int pt = 0; pt < 4; ++pt) {
                const int cc = g * 256 + r * 64 + 16 * pt + 4 * fq;
                unsigned long long* op = (unsigned long long*)(ocat + (tok0 + tl) * DM + 512 + cc);
                const unsigned long long v = __hip_atomic_load(op, __ATOMIC_RELAXED, __HIP_MEMORY_SCOPE_AGENT);
                const unsigned vlo = (unsigned)v, vhi = (unsigned)(v >> 32);
                const float4 bn = *(const float4*)(b_norm + cc);
                const unsigned long long o = (unsigned long long)pk2(bflo(vlo) * rn * bn.x, bfhi(vlo) * rn * bn.y) | ((unsigned long long)pk2(bflo(vhi) * rn * bn.z, bfhi(vhi) * rn * bn.w) << 32);
                *op = o;
            }
    }
    __syncthreads();
}


constexpr int NA_RING = 12, NA_VT = 0, NA_VSTRIDE = NA_RING * 64 * 2 + 16, NA_BIAS = 64 * NA_VSTRIDE, NA_END = NA_BIAS + 480 * 4;
static_assert(NA_END <= 131072, "na lds");
DEVI void ph_na(LAS unsigned char* lds, const bf16_t* qkv, const float* rpb, bf16_t* oc, int vb0, int vbs) {
    const int tid = opq((int)threadIdx.x), wid = __builtin_amdgcn_readfirstlane(tid >> 6), lane = tid & 63, fr = lane & 15, fq = lane >> 4;
    LAS float* bl = (LAS float*)(lds + NA_BIAS);
    for (int chunk = vb0; chunk < NB * 16 * 4; chunk += vbs) {
        const int qr4 = chunk & 3, h = (chunk >> 2) & 15, b = chunk >> 6;
        __syncthreads();
        for (int e = tid; e < 465; e += NTHR) bl[e] = rpb[h * 465 + e];
        int staged_hi = -1;
#pragma unroll 1
        for (int ui = 0; ui < 8; ++ui) {
            const int rp = qr4 * 8 + ui;
            const int r0 = 2 * rp, rs0 = min(max(r0 - 4, 0), 56);
            const int need_hi = min(rs0 + 8, 63);
            const int lo = max(staged_hi + 1, rs0);
            for (int task = wid; task < (need_hi - lo + 1) * 8; task += 8) {
                const int kr = lo + (task >> 3), ch = task & 7, slot = kr % NA_RING;
                const u32x4 v = *(const u32x4*)(qkv + ((size_t)b * SEQ + kr * 64 + lane) * 3072 + 2048 + h * 64 + ch * 8);
                const unsigned vw[4] = {v.x, v.y, v.z, v.w};
#pragma unroll
                for (int i = 0; i < 8; ++i) *(LAS bf16_t*)(lds + NA_VT + (ch * 8 + i) * NA_VSTRIDE + (slot * 64 + lane) * 2) = (bf16_t)((i & 1) ? (vw[i >> 1] >> 16) : (vw[i >> 1] & 0xffffu));
            }
            staged_hi = need_hi > staged_hi ? need_hi : staged_hi;
            __syncthreads();
            const int r = r0 + (wid >> 2), j = wid & 3;
            const int rs = min(max(r - 4, 0), 56);
            const int bs = (j == 0) ? 0 : (j == 1) ? 8 : (j == 2) ? 24 : 32;
            const int c = 16 * j + fr, qs = min(max(c - 8, 0), 48);
            const size_t qtok = (size_t)b * SEQ + r * 64 + c;
            bf16x8 Qf[2];
#pragma unroll
            for (int ks = 0; ks < 2; ++ks) Qf[ks] = *(const bf16x8*)(qkv + qtok * 3072 + h * 64 + 32 * ks + 8 * fq);
            const bf16_t* kbase = qkv + ((size_t)b * SEQ + rs * 64 + bs + fr) * 3072 + 1024 + h * 64 + 8 * fq;
            bf16x8 kn[4];
#pragma unroll
            for (int q = 0; q < 4; ++q) kn[q] = *(const bf16x8*)(kbase + (size_t)((q >> 1) * 16) * 3072 + (q & 1) * 32);
            f32x4 O[4];
#pragma unroll
            for (int dt = 0; dt < 4; ++dt) O[dt] = (f32x4){0.f, 0.f, 0.f, 0.f};
            float mrun = -1e30f, lrun = 0.f;
#pragma unroll 1
            for (int dr = 0; dr < 8; ++dr) {
                bf16x8 kc[4];
#pragma unroll
                for (int q = 0; q < 4; ++q) kc[q] = kn[q];
                const int drn = dr < 7 ? dr + 1 : 7;
#pragma unroll
                for (int q = 0; q < 4; ++q) kn[q] = *(const bf16x8*)(kbase + ((size_t)drn * 64 + (q >> 1) * 16) * 3072 + (q & 1) * 32);
                float sv[8]; float mloc = -1e30f;
                const LAS float* brow = bl + (rs + dr - r + 7) * 31;
#pragma unroll
                for (int kg = 0; kg < 2; ++kg) {
                    f32x4 acc = {0.f, 0.f, 0.f, 0.f};
                    acc = __builtin_amdgcn_mfma_f32_16x16x32_bf16(kc[kg * 2], Qf[0], acc, 0, 0, 0);
                    acc = __builtin_amdgcn_mfma_f32_16x16x32_bf16(kc[kg * 2 + 1], Qf[1], acc, 0, 0, 0);
#pragma unroll
                    for (int rg = 0; rg < 4; ++rg) {
                        const int kcol = bs + 16 * kg + 4 * fq + rg;
                        const bool ok = (kcol >= qs) && (kcol < qs + 16);
                        const int dc = min(max(kcol - c + 15, 0), 30);
                        const float sc = ok ? acc[rg] * 0.125f + brow[dc] : -1e30f;
                        sv[kg * 4 + rg] = sc; mloc = fmaxf(mloc, sc);
                    }
                }
                mloc = fmaxf(mloc, __shfl_xor(mloc, 16)); mloc = fmaxf(mloc, __shfl_xor(mloc, 32));
                const float mnew = fmaxf(mrun, mloc);
                const float alpha = __expf(mrun - mnew);
                float psum = 0.f;
#pragma unroll
                for (int i = 0; i < 8; ++i) { const float p = __expf(sv[i] - mnew); sv[i] = p; psum += p; }
                psum += __shfl_xor(psum, 16); psum += __shfl_xor(psum, 32);
                lrun = lrun * alpha + psum; mrun = mnew;
                const bf16x8 Pf = pack8(sv);
                const int koff = (((rs + dr) % NA_RING) * 64 + bs + 4 * fq) * 2;
#pragma unroll
                for (int dt = 0; dt < 4; ++dt) {
                    const LAS unsigned char* vr = lds + NA_VT + (16 * dt + fr) * NA_VSTRIDE + koff;
                    const u32x2 v0 = *(const LAS u32x2*)vr, v1 = *(const LAS u32x2*)(vr + 32);
                    u32x4 va; va.x = v0.x; va.y = v0.y; va.z = v1.x; va.w = v1.y;
                    O[dt] = __builtin_amdgcn_mfma_f32_16x16x32_bf16(__builtin_bit_cast(bf16x8, va), Pf, O[dt] * alpha, 0, 0, 0);
                }
            }
            const float il = 1.f / lrun;
#pragma unroll
            for (int dt = 0; dt < 4; ++dt) {
                u32x2 o; o.x = pk2(O[dt][0] * il, O[dt][1] * il); o.y = pk2(O[dt][2] * il, O[dt][3] * il);
                *(u32x2*)(oc + qtok * DM + h * 64 + 16 * dt + 4 * fq) = o;
            }
        }
    }
    __syncthreads();
}

DEVI void ph_na_naive(const bf16_t* qkv, const float* rpb, bf16_t* oc, int vb0, int vbs) {
    for (int e4 = vb0 * NTHR + opq((int)threadIdx.x); e4 < MT * 16 * 4; e4 += vbs * NTHR) {
        const int dq = e4 & 3, e = e4 >> 2;
        const int hd = e / MT, tok = e % MT;
        const int b = tok >> 12, t = tok & 4095, r = t >> 6, c = t & 63;
        const int rs = min(max(r - 4, 0), 56), qs = min(max(c - 8, 0), 48);
        float q[16], o[16];
        const bf16_t* qp = qkv + (size_t)tok * 3072 + hd * 64 + dq * 16;
#pragma unroll
        for (int d = 0; d < 16; ++d) { q[d] = bf2f(qp[d]); o[d] = 0.f; }
        float m = -1e30f, l = 0.f;
        for (int dr = 0; dr < 8; ++dr)
            for (int dc = 0; dc < 16; ++dc) {
                const int kr = rs + dr, kc = qs + dc;
                const size_t kt = (size_t)b * SEQ + kr * 64 + kc;
                const bf16_t* kp = qkv + kt * 3072 + 1024 + hd * 64 + dq * 16;
                const bf16_t* vp = qkv + kt * 3072 + 2048 + hd * 64 + dq * 16;
                float s = 0.f;
#pragma unroll
                for (int d = 0; d < 16; ++d) s += q[d] * bf2f(kp[d]);
                s += __shfl_xor(s, 1); s += __shfl_xor(s, 2);
                s = s * 0.125f + rpb[hd * 465 + (kr - r + 7) * 31 + (kc - c + 15)];
                const float mn = fmaxf(m, s); const float al = __expf(m - mn), pe = __expf(s - mn);
                l = l * al + pe; m = mn;
#pragma unroll
                for (int d = 0; d < 16; ++d) o[d] = o[d] * al + pe * bf2f(vp[d]);
            }
        const float il = 1.f / l;
        bf16_t* op = oc + (size_t)tok * DM + hd * 64 + dq * 16;
#pragma unroll
        for (int d = 0; d < 16; ++d) op[d] = f2bf(o[d] * il);
    }
}

#define XB_TMO      128
#define XB_XCNT(j)  (256  + 64 * (j))
#define XB_XSUB(j)  (1280 + 64 * (j))
#define XB_XGEN(j)  (2304 + 64 * (j))
#define XB_TOP      3328
#define XB_TOPGEN   3392
#define XCD_BAR_WORDS 3456
#define XB_SPIN_CAP (1u << 18)

__device__ __forceinline__ unsigned xb_ld(unsigned* p)              { return __hip_atomic_load(p, __ATOMIC_RELAXED, __HIP_MEMORY_SCOPE_AGENT); }
__device__ __forceinline__ unsigned xb_add(unsigned* p, unsigned v) { return __hip_atomic_fetch_add(p, v, __ATOMIC_RELAXED, __HIP_MEMORY_SCOPE_AGENT); }
__device__ __forceinline__ unsigned xb_xcc_id() { return (unsigned)__builtin_amdgcn_s_getreg((3 << 11) | 20) & 0xFu; }
#define XB_SPIN(cond, bar) do { unsigned _sp = 0; while (cond) { __builtin_amdgcn_s_sleep(1); \
    if ((++_sp & 255u) == 0u) { if (xb_ld(&(bar)[XB_TMO])) break; if (_sp > XB_SPIN_CAP) { atomicAdd(&(bar)[XB_TMO], 1u); break; } } } } while (0)

struct XcdBarrier {
    unsigned* bar; unsigned x;
    volatile LAS unsigned* st;
};

__device__ __forceinline__ XcdBarrier xcd_barrier_post(unsigned* bar, volatile LAS unsigned* st) {
    XcdBarrier b; b.bar = bar; b.x = xb_xcc_id(); b.st = st;
    if (threadIdx.x == 0) (void)xb_add(&bar[XB_XCNT(b.x)], 1u);
    return b;
}
__device__ __forceinline__ void xcd_barrier_complete(unsigned* bar, unsigned x, unsigned& nloc, unsigned& nx) {
    const unsigned G = gridDim.x * gridDim.y * gridDim.z;
    unsigned sum, cnt, mine, sp = 0u;
    for (;;) {
        sum = 0u; cnt = 0u; mine = 0u;
#pragma unroll
        for (unsigned j = 0; j < 16; ++j) { const unsigned c = xb_ld(&bar[XB_XCNT(j)]); sum += c; cnt += (c > 0u) ? 1u : 0u; mine = (j == x) ? c : mine; }
        if (sum == G) break;
        __builtin_amdgcn_s_sleep(1);
        if ((++sp & 255u) == 0u) { if (xb_ld(&bar[XB_TMO])) break; if (sp > XB_SPIN_CAP) { atomicAdd(&bar[XB_TMO], 1u); break; } }
    }
    nloc = mine > 0u ? mine : 1u; nx = cnt > 0u ? cnt : 1u;
}

__device__ __forceinline__ void xcd_barrier(const XcdBarrier& b) {
    asm volatile("s_waitcnt vmcnt(0)" ::: "memory");
    __syncthreads();
    if (threadIdx.x == 0) {
        unsigned* bar = b.bar;
        __builtin_amdgcn_s_waitcnt(0);
        unsigned nloc = b.st[0], nx = b.st[1];
        if (nloc == 0u) { xcd_barrier_complete(bar, b.x, nloc, nx); b.st[0] = nloc; b.st[1] = nx; }
        const unsigned old = xb_add(&bar[XB_XSUB(b.x)], 1u);
        const unsigned gen = old / nloc;
        if (old + 1u == (gen + 1u) * nloc) {
            __builtin_amdgcn_fence(__ATOMIC_RELEASE, "agent");
            asm volatile("s_waitcnt vmcnt(0)" ::: "memory");
            const unsigned og = xb_add(&bar[XB_TOP], 1u);
            const unsigned tg = og / nx;
            if (og + 1u == (tg + 1u) * nx) xb_add(&bar[XB_TOPGEN], 1u);
            else XB_SPIN(xb_ld(&bar[XB_TOPGEN]) == tg, bar);
            __builtin_amdgcn_fence(__ATOMIC_ACQUIRE, "agent");
            xb_add(&bar[XB_XGEN(b.x)], 1u);
            asm volatile("s_waitcnt vmcnt(0)" ::: "memory");
        } else {
            XB_SPIN(xb_ld(&bar[XB_XGEN(b.x)]) == gen, bar);
            __builtin_amdgcn_fence(__ATOMIC_ACQUIRE, "agent");
            asm volatile("s_waitcnt vmcnt(0)" ::: "memory");
        }
    }
    __syncthreads();
}


struct Args { const float* in[34]; float* out; unsigned char* ws; int ph_lo, ph_hi; };
constexpr int N_PHASES = 22;

__global__ void __launch_bounds__(NTHR, 2) fwd(Args a) {
    extern __shared__ __attribute__((aligned(16))) unsigned char lds_raw[];
    float* lds = (float*)lds_raw;
    LAS unsigned char* ldsl = (LAS unsigned char*)lds_raw;
    const int vb0 = blockIdx.x, vbs = gridDim.x;
    const int lo = a.ph_lo, hi = a.ph_hi;
#define IN(k) (lo <= (k) && (k) < hi)
#define SEAM(k) do { if (IN(k) && IN((k) + 1)) xcd_barrier(bar); } while (0)
    volatile LAS unsigned* misc = (volatile LAS unsigned*)(ldsl + MISC_OFF);
    if (threadIdx.x < 4) misc[threadIdx.x] = 0u;
    __syncthreads();
    XcdBarrier bar = xcd_barrier_post((unsigned*)(a.ws + WS_CTL) + CW_BAR, misc);
    unsigned char* ws = a.ws;
    unsigned* ctl = (unsigned*)(ws + WS_CTL);
    unsigned* cnt = ctl + CW_CNT;
    int* list = (int*)(ws + WS_LIST); float* gatev = (float*)(ws + WS_GATE);
    float* dtraw = (float*)(ws + WS_DT); float* RS = (float*)(ws + WS_RS);
    bf16_t* XB = (bf16_t*)(ws + WS_XB); bf16_t* UB = (bf16_t*)(ws + WS_UB);
    bf16_t* YA = (bf16_t*)(ws + WS_YA); float* OF = (float*)(ws + WS_OF); bf16_t* OC = (bf16_t*)(ws + WS_OC);
    bf16_t* YP = (bf16_t*)(ws + WS_YP); bf16_t* YP1 = (bf16_t*)(ws + WS_YP1); bf16_t* XC = (bf16_t*)(ws + WS_YP);
    bf16_t* PB0 = (bf16_t*)(ws + WS_PB0); bf16_t* PB1 = (bf16_t*)(ws + WS_PB1);
    bf16_t* YB = (bf16_t*)(ws + WS_Y);
    float* MS = (float*)(ws + WS_MS); float* MD = (float*)(ws + WS_MD);
    float* HS = (float*)(ws + WS_HS); float* HD = (float*)(ws + WS_HD);
    bf16_t* XT = (bf16_t*)(ws + WS_XT); bf16_t* VT = (bf16_t*)(ws + WS_VT);
    const float* p_in = a.in[1];
    const int G = (int)gridDim.x, cb = (int)blockIdx.x;
    const NormB NB0{nullptr, XB, nullptr, nullptr, RS, nullptr, nullptr, nullptr, nullptr, nullptr, nullptr, nullptr, nullptr, nullptr, nullptr};
    unsigned char* XG8 = ws + WS_XG8;
    float* rsl = (float*)(ws + WS_DT);

    if (IN(0)) {
        ph_convert_weights(ldsl, a.in, ws, 0, ITEMS_DENSE, vb0, vbs);
        NormB A = NB0; A.xin = a.in[0]; A.gnext = a.in[3]; A.win = a.in[4]; A.dtraw = dtraw;
        ph_norm2<0, false, true, false>(A, vb0, vbs, (LAS float*)ldsl);
    }
    SEAM(0);
    if (IN(1)) { pg8::DenseOrder S; S.init(MT, UW, DM, (const bf16_t*)(ws + W_IN), G, cb); pg8::gemm_phase(ldsl, XB, DM, S, pg8::EpiBf16{UB, UW, RS}); }
    SEAM(1);
    if (IN(2)) { ph_prep(UB, a.in[5], a.in[6], XC, XT, VT, vb0, vbs); }
    SEAM(2);
    if (IN(3)) { ph_hgrn_states(ldsl, UB, VT, a.in[2], HS, HD, vb0, vbs); ph_mamba_states(ldsl, XT, dtraw, a.in[7], a.in[8], MS, MD, vb0, vbs); }
    SEAM(3);
    if (IN(4)) { ph_hgrn_scan(HS, HD, vb0, vbs); ph_mamba_scan(MS, MD, vb0, vbs); }
    SEAM(4);
    if (IN(5)) { ph_hgrn_out(ldsl, UB, VT, a.in[2], a.in[10], HS, OF, OC, vb0, vbs); ph_mamba_out(ldsl, UB, XC, XT, dtraw, a.in[7], a.in[8], a.in[9], a.in[11], MS, OC, vb0, vbs); }
    SEAM(5);
    if (IN(6)) { pg8::DenseOrder S; S.init(MT, DM, DM, (const bf16_t*)(ws + W_OUTE), G, cb); pg8::gemm_phase(ldsl, OC, DM, S, pg8::EpiBf16{YA, DM, nullptr}); }
    SEAM(6);
    if (IN(7)) {
        NormB A = NB0; A.y = YA; A.gpost = a.in[13];
        ph_norm2<1, false, false, false>(A, vb0, vbs);
        ph_cvt_rows(p_in, PB0, (size_t)MT * PDIM / 4, vb0, vbs);
        ph_convert_weights(ldsl, a.in, ws, ITEMS_DENSE, ITEMS_ALL, vb0, vbs);
    }
    SEAM(7);
    if (IN(8)) {
        { pg8::DenseOrder S; S.init(MT, 2 * DFF, DM, (const bf16_t*)(ws + W_GU), G, cb); pg8::gemm_phase(ldsl, XB, DM, S, pg8::EpiSwiglu{UB, DFF, RS, 0}); }
        { pg8::TailOrder S; S.init(MT, DM, PDIM, (const bf16_t*)(ws + W_PP), G, cb, (MT / 256) * (2 * DFF / 256) % G); pg8::gemm_phase(ldsl, PB0, PDIM, S, pg8::EpiBf16{YP, DM, nullptr}); }
    }
    SEAM(8);
    if (IN(9)) { pg8::DenseOrder S; S.init(MT, DM, DFF, (const bf16_t*)(ws + W_DN), G, cb); pg8::gemm_phase(ldsl, UB, DFF, S, pg8::EpiBf16{YA, DM, nullptr}); }
    SEAM(9);
    if (IN(10)) {
        NormB A = NB0; A.y = YA; A.gpost = a.in[18];
        ph_norm2<1, false, false, false>(A, vb0, vbs);
    }
    SEAM(10);
    if (IN(11)) { pg8::DenseOrder S; S.init(MT, DM, DM, (const bf16_t*)(ws + W_PG), G, cb); pg8::gemm_phase(ldsl, XB, DM, S, pg8::EpiPleGate{YP, DM, RS}); }
    SEAM(11);
    if (IN(12)) {
        NormB A = NB0; A.y = YP; A.gpost = a.in[33];
        ph_norm2<1, false, false, false>(A, vb0, vbs);
    }
    SEAM(12);
    if (IN(13)) { pg8::DenseOrder S; S.init(MT, 3072, DM, (const bf16_t*)(ws + W_QKV), G, cb); pg8::gemm_phase(ldsl, XB, DM, S, pg8::EpiBf16{UB, 3072, RS}); }
    SEAM(13);
    if (IN(14)) { ph_na(ldsl, UB, a.in[21], OC, vb0, vbs); }
    SEAM(14);
    if (IN(15)) { pg8::DenseOrder S; S.init(MT, DM, DM, (const bf16_t*)(ws + W_OUTO), G, cb); pg8::gemm_phase(ldsl, OC, DM, S, pg8::EpiBf16{YP1, DM, nullptr}); }
    SEAM(15);
    if (IN(16)) {
        NormB A = NB0; A.y = YP1; A.gpost = a.in[23]; A.gnext = a.in[24]; A.wr = a.in[25]; A.cnt = cnt; A.list = list; A.gatev = gatev; A.rsl = rsl; A.x8 = XG8;
        ph_norm2<1, false, false, true>(A, vb0, vbs, (LAS float*)ldsl);
        ph_cvt_rows(p_in + (size_t)MT * PDIM, PB1, (size_t)MT * PDIM / 4, vb0, vbs);
    }
    SEAM(16);
    if (IN(17)) { pg8::MoeOrder S; S.init(cnt, (volatile LAS int*)(ldsl + MISC_OFF + 64), 2 * DFFE, DM / 2, (const bf16_t*)(ws + W_EGU), (size_t)7 * MiB, true, G, cb);
        pg8::gemm_phase<pg8::EpiSwiglu8, pg8::MoeOrder, true>(ldsl, (const bf16_t*)XG8, DM / 2, S, pg8::EpiSwiglu8{(unsigned char*)UB, DFFE, rsl}); }
    SEAM(17);
    if (IN(18)) { pg8::MoeOrder S; S.init(cnt, (volatile LAS int*)(ldsl + MISC_OFF + 64), DM, DFFE / 2, (const bf16_t*)(ws + W_EDN), (size_t)(7 * MiB / 2), false, G, cb);
        pg8::gemm_phase<pg8::EpiMoeDown, pg8::MoeOrder, true>(ldsl, UB, DFFE / 2, S, pg8::EpiMoeDown{YB, list, gatev, 1.f / (pg8::W8_SCALE * pg8::ACT8_SCALE)});
        { pg8::TailOrder T; T.init(MT, DM, PDIM, (const bf16_t*)(ws + W_PP + 512 * 1024), G, cb, S.nwg % G); pg8::gemm_phase(ldsl, PB1, PDIM, T, pg8::EpiBf16{YP, DM, nullptr}); } }
    SEAM(18);
    if (IN(19)) {
        NormB A = NB0; A.y = YB; A.gpost = a.in[29];
        ph_norm2<2, false, false, false>(A, vb0, vbs);
    }
    SEAM(19);
    if (IN(20)) { pg8::DenseOrder S; S.init(MT, DM, DM, (const bf16_t*)(ws + W_PG + 2 * MiB), G, cb); pg8::gemm_phase(ldsl, XB, DM, S, pg8::EpiPleGate{YP, DM, RS}); }
    SEAM(20);
    if (IN(21)) {
        NormB A = NB0; A.y = YP; A.gpost = a.in[33] + DM; A.xout = a.out;
        ph_norm2<1, true, false, false>(A, vb0, vbs);
    }
#undef IN
#undef SEAM
}

extern "C" void kernel_launch(void* const* d_in, const int* in_sizes, int n_in, void* d_out, int out_size, void* d_ws, size_t ws_size, hipStream_t stream) {
    static int grid = 0;
    if (grid == 0) {
        if (n_in != 34 || out_size != MT * DM || ws_size < WS_END) { fprintf(stderr, "kernel_launch: unexpected shapes n_in %d out %d ws %zu (need %zu)\n", n_in, out_size, ws_size, (size_t)WS_END); grid = -1; return; }
        int dev = 0, cus = 0;
        if (hipGetDevice(&dev) != hipSuccess || hipDeviceGetAttribute(&cus, hipDeviceAttributeMultiprocessorCount, dev) != hipSuccess) { grid = -1; return; }
        if (hipFuncSetAttribute((const void*)fwd, hipFuncAttributeMaxDynamicSharedMemorySize, LDS_BYTES) != hipSuccess) { fprintf(stderr, "hipFuncSetAttribute failed\n"); grid = -1; return; }
        (void)hipGetLastError();
        grid = cus;
    }
    if (grid < 0) return;
    (void)hipMemsetAsync((char*)d_ws + WS_CTL, 0, CTL_ZERO_BYTES, stream);
    Args a{};
    for (int i = 0; i < 34; ++i) a.in[i] = (const float*)d_in[i];
    a.out = (float*)d_out; a.ws = (unsigned char*)d_ws;
#ifndef MK_PER_PHASE
    a.ph_lo = 0; a.ph_hi = N_PHASES;
    hipLaunchKernelGGL(fwd, dim3(grid), dim3(NTHR), LDS_BYTES, stream, a);
#else
    for (int ph = 0; ph < N_PHASES; ++ph) {
        a.ph_lo = ph; a.ph_hi = ph + 1;
        hipLaunchKernelGGL(fwd, dim3(grid), dim3(NTHR), LDS_BYTES, stream, a);
    }
#endif
}
```

```cpp
#include <hip/hip_runtime.h>
#include <stdint.h>
#include <stdio.h>

#define DEVI __device__ __forceinline__
#define LAS __attribute__((address_space(3)))
typedef unsigned short bf16_t;

constexpr int NB = 4, SEQ = 4096, DM = 1024, MT = NB * SEQ;
constexpr int EVEN_IN = 4112, UW = 4096, DFF = 2816, NEXP = 8, DFFE = 3584, PDIM = 256;
constexpr float EPS = 1e-6f;
constexpr int NTHR = 512;
constexpr int LDS_BYTES = 147456;
constexpr int MISC_OFF = 131072 + 320;
constexpr int MOE_ROWS = 2 * MT + NEXP * 256;

constexpr size_t MiB = 1u << 20;
constexpr size_t WS_CTL = 0, CTL_ZERO_BYTES = 1 * MiB;
constexpr size_t WS_LIST = 1 * MiB;
constexpr size_t WS_GATE = WS_LIST + 512 * 1024;
constexpr size_t WS_DT = 2 * MiB;
constexpr size_t WS_W = 3 * MiB;
constexpr size_t W_IN = WS_W, W_OUTE = W_IN + 8 * MiB, W_GU = W_OUTE + 2 * MiB, W_DN = W_GU + 11 * MiB, W_PG = W_DN + 6 * MiB, W_PP = W_PG + 4 * MiB,
                 W_QKV = W_PP + 1 * MiB, W_OUTO = W_QKV + 6 * MiB, W_EGU = W_OUTO + 2 * MiB, W_EDN = W_EGU + 112 * MiB, W_END = W_EDN + 56 * MiB;
constexpr size_t WS_XB = W_END;
constexpr size_t WS_R = WS_XB + 32 * MiB;
constexpr size_t WS_UB = WS_R;
constexpr size_t WS_PB0 = WS_R + 88 * MiB;
constexpr size_t WS_YA = WS_R + 128 * MiB;
constexpr size_t WS_OF = WS_R + 160 * MiB;
constexpr size_t WS_OC = WS_R + 192 * MiB;
constexpr size_t WS_YP = WS_R + 224 * MiB;
constexpr size_t WS_YP1 = WS_R;
constexpr size_t WS_PB1 = W_EDN + 32 * MiB;
constexpr size_t WS_XG8 = WS_R + 120 * MiB;
constexpr size_t WS_END = WS_R + 256 * MiB;
constexpr size_t WS_Y = W_EGU;
constexpr size_t WS_MS = W_EGU;
constexpr size_t WS_HS = W_EGU + 64 * MiB;
constexpr size_t WS_XT = W_EDN;
constexpr size_t WS_VT = W_EDN + 24 * MiB;
constexpr size_t WS_MD = W_EDN + 40 * MiB;
constexpr size_t WS_HD = W_EDN + 41 * MiB;
static_assert(WS_R + (size_t)MOE_ROWS * DFFE <= WS_XG8 && WS_XG8 + 128 * MiB <= WS_END && WS_END <= 510 * MiB, "ws map");
constexpr size_t WS_RS = WS_CTL + 512 * 1024;
constexpr int CW_CNT = 64;
constexpr int CW_BAR = 4096;

DEVI int opq(int x) { asm volatile("" : "+v"(x)); return x; }
DEVI float bf2f(bf16_t b) { return __uint_as_float(((unsigned)b) << 16); }
typedef float f32x2c __attribute__((ext_vector_type(2)));
typedef __bf16 bf16x2c __attribute__((ext_vector_type(2)));
DEVI unsigned cvt2bf(float lo, float hi) { const f32x2c v = {lo, hi}; return __builtin_bit_cast(unsigned, __builtin_convertvector(v, bf16x2c)); }
DEVI bf16_t f2bf(float f) { return (bf16_t)(cvt2bf(f, 0.f) & 0xffffu); }
DEVI float silu_f(float x) { return x * __builtin_amdgcn_rcpf(1.f + __builtin_amdgcn_exp2f(-1.44269504f * x)); }
DEVI float sigmoid_f(float x) { return __builtin_amdgcn_rcpf(1.f + __builtin_amdgcn_exp2f(-1.44269504f * x)); }
DEVI float softplus_f(float x) { return x > 20.f ? x : log1pf(__expf(x)); }
DEVI float wave_sum(float v) {
#pragma unroll
    for (int o = 1; o < 64; o <<= 1) v += __shfl_xor(v, o);
    return v;
}


typedef short bf16x8 __attribute__((ext_vector_type(8)));
typedef float f32x4 __attribute__((ext_vector_type(4)));
typedef unsigned u32x4 __attribute__((ext_vector_type(4)));
typedef unsigned u32x2 __attribute__((ext_vector_type(2)));
DEVI unsigned pk2(float lo, float hi) { return cvt2bf(lo, hi); }
DEVI float bflo(unsigned w) { return __uint_as_float(w << 16); }
DEVI float bfhi(unsigned w) { return __uint_as_float(w & 0xffff0000u); }

DEVI unsigned pg8_pk4(float a, float b, float c, float d) {
    a = __builtin_amdgcn_fmed3f(a, -448.f, 448.f); b = __builtin_amdgcn_fmed3f(b, -448.f, 448.f); c = __builtin_amdgcn_fmed3f(c, -448.f, 448.f); d = __builtin_amdgcn_fmed3f(d, -448.f, 448.f);
    int p = __builtin_amdgcn_cvt_pk_fp8_f32(a, b, 0, false); p = __builtin_amdgcn_cvt_pk_fp8_f32(c, d, p, true); return (unsigned)p; }
DEVI float wave_sum16(float (&v)[16], int lane) {
    const bool h5 = lane & 32, h4 = lane & 16, h3 = lane & 8, h2 = lane & 4;
#pragma unroll
    for (int i = 0; i < 8; ++i) { const float send = h5 ? v[i] : v[i + 8], keep = h5 ? v[i + 8] : v[i]; v[i] = keep + __shfl_xor(send, 32); }
#pragma unroll
    for (int i = 0; i < 4; ++i) { const float send = h4 ? v[i] : v[i + 4], keep = h4 ? v[i + 4] : v[i]; v[i] = keep + __shfl_xor(send, 16); }
#pragma unroll
    for (int i = 0; i < 2; ++i) { const float send = h3 ? v[i] : v[i + 2], keep = h3 ? v[i + 2] : v[i]; v[i] = keep + __shfl_xor(send, 8); }
    { const float send = h2 ? v[0] : v[1], keep = h2 ? v[1] : v[0]; v[0] = keep + __shfl_xor(send, 4); }
    float r = v[0]; r += __shfl_xor(r, 1); r += __shfl_xor(r, 2); return r;
}
DEVI float wave_sum8(float (&v)[8], int lane) {
    const bool h5 = lane & 32, h4 = lane & 16, h3 = lane & 8;
#pragma unroll
    for (int i = 0; i < 4; ++i) { const float send = h5 ? v[i] : v[i + 4], keep = h5 ? v[i + 4] : v[i]; v[i] = keep + __shfl_xor(send, 32); }
#pragma unroll
    for (int i = 0; i < 2; ++i) { const float send = h4 ? v[i] : v[i + 2], keep = h4 ? v[i + 2] : v[i]; v[i] = keep + __shfl_xor(send, 16); }
    { const float send = h3 ? v[0] : v[1], keep = h3 ? v[1] : v[0]; v[0] = keep + __shfl_xor(send, 8); }
    float r = v[0]; r += __shfl_xor(r, 1); r += __shfl_xor(r, 2); r += __shfl_xor(r, 4); return r;
}
struct NormB { const float* xin; bf16_t* XB; const bf16_t* y; const float* gpost; float* rs; const float* gnext;
               const float* win; float* dtraw; const float* wr; unsigned* cnt; int* list; float* gatev; float* rsl; float* xout; unsigned char* x8; };
DEVI void unpack8(const u32x4 w, float* v) { v[0] = bflo(w.x); v[1] = bfhi(w.x); v[2] = bflo(w.y); v[3] = bfhi(w.y); v[4] = bflo(w.z); v[5] = bfhi(w.z); v[6] = bflo(w.w); v[7] = bfhi(w.w); }
template <int YMODE, bool FINAL, bool DT, bool ROUTE>
DEVI void ph_norm2(const NormB& A, int vb0, int vbs, LAS float* wl = nullptr) {
    const int tidq = opq((int)threadIdx.x); const int wid = tidq >> 6, lane = tidq & 63;
    if (DT || ROUTE) {
        constexpr int NJ = DT ? 16 : 8;
        __syncthreads();
        for (int e = tidq; e < DM * NJ / 4; e += NTHR) { const int k = e / (NJ / 4), j4 = (e % (NJ / 4)) * 4;
            const float4 w = DT ? *(const float4*)(A.win + (size_t)k * EVEN_IN + 4096 + j4) : *(const float4*)(A.wr + (size_t)k * 8 + j4);
            wl[(j4 + 0) * DM + k] = w.x; wl[(j4 + 1) * DM + k] = w.y; wl[(j4 + 2) * DM + k] = w.z; wl[(j4 + 3) * DM + k] = w.w; }
        __syncthreads();
    }
    constexpr int R = (DT || ROUTE) ? 2 : 4;
    for (int row0 = (vb0 * 8 + wid) * R; row0 < MT; row0 += vbs * 8 * R) {
        float xv[R][16]; float yv[R][16];
#pragma unroll
        for (int rr = 0; rr < R; ++rr) {
            const size_t ro = (size_t)(row0 + rr) * DM + lane * 8;
            if (YMODE == 0) {
#pragma unroll
                for (int i = 0; i < 2; ++i) { const float4 p0 = *(const float4*)(A.xin + ro + i * 512), p1 = *(const float4*)(A.xin + ro + i * 512 + 4);
                    xv[rr][i * 8 + 0] = p0.x; xv[rr][i * 8 + 1] = p0.y; xv[rr][i * 8 + 2] = p0.z; xv[rr][i * 8 + 3] = p0.w; xv[rr][i * 8 + 4] = p1.x; xv[rr][i * 8 + 5] = p1.y; xv[rr][i * 8 + 6] = p1.z; xv[rr][i * 8 + 7] = p1.w; }
            } else {
#pragma unroll
                for (int i = 0; i < 2; ++i) {
                    unpack8(*(const u32x4*)(A.XB + ro + i * 512), xv[rr] + i * 8);
                    unpack8(*(const u32x4*)(A.y + ro + i * 512), yv[rr] + i * 8);
                    if (YMODE == 2) { float y2[8]; unpack8(*(const u32x4*)(A.y + (size_t)MT * DM + ro + i * 512), y2);
#pragma unroll
                        for (int j = 0; j < 8; ++j) yv[rr][i * 8 + j] += y2[j]; }
                }
            }
        }
        if (YMODE != 0) {
            float gg[16];
#pragma unroll
            for (int i = 0; i < 2; ++i) { const float4 g0 = *(const float4*)(A.gpost + i * 512 + lane * 8), g1 = *(const float4*)(A.gpost + i * 512 + lane * 8 + 4);
                gg[i * 8 + 0] = g0.x; gg[i * 8 + 1] = g0.y; gg[i * 8 + 2] = g0.z; gg[i * 8 + 3] = g0.w; gg[i * 8 + 4] = g1.x; gg[i * 8 + 5] = g1.y; gg[i * 8 + 6] = g1.z; gg[i * 8 + 7] = g1.w; }
            float ss[R];
#pragma unroll
            for (int rr = 0; rr < R; ++rr) { ss[rr] = 0.f;
#pragma unroll
                for (int j = 0; j < 16; ++j) ss[rr] += yv[rr][j] * yv[rr][j]; }
#pragma unroll
            for (int o = 1; o < 64; o <<= 1)
#pragma unroll
                for (int rr = 0; rr < R; ++rr) ss[rr] += __shfl_xor(ss[rr], o);
#pragma unroll
            for (int rr = 0; rr < R; ++rr) { const float r = rsqrtf(ss[rr] * (1.f / DM) + EPS);
#pragma unroll
                for (int j = 0; j < 16; ++j) xv[rr][j] += yv[rr][j] * r * gg[j]; }
        }
        if (FINAL) {
#pragma unroll
            for (int rr = 0; rr < R; ++rr)
#pragma unroll
                for (int i = 0; i < 2; ++i) { float* op = A.xout + (size_t)(row0 + rr) * DM + i * 512 + lane * 8;
                    *(float4*)op = make_float4(xv[rr][i * 8], xv[rr][i * 8 + 1], xv[rr][i * 8 + 2], xv[rr][i * 8 + 3]); *(float4*)(op + 4) = make_float4(xv[rr][i * 8 + 4], xv[rr][i * 8 + 5], xv[rr][i * 8 + 6], xv[rr][i * 8 + 7]); }
        } else {
            float ss[R];
#pragma unroll
            for (int rr = 0; rr < R; ++rr) {
#pragma unroll
                for (int i = 0; i < 2; ++i) { u32x4 o; o.x = pk2(xv[rr][i * 8], xv[rr][i * 8 + 1]); o.y = pk2(xv[rr][i * 8 + 2], xv[rr][i * 8 + 3]); o.z = pk2(xv[rr][i * 8 + 4], xv[rr][i * 8 + 5]); o.w = pk2(xv[rr][i * 8 + 6], xv[rr][i * 8 + 7]);
                    *(u32x4*)(A.XB + (size_t)(row0 + rr) * DM + i * 512 + lane * 8) = o;
                }
                ss[rr] = 0.f;
#pragma unroll
                for (int j = 0; j < 16; ++j) ss[rr] += xv[rr][j] * xv[rr][j];
            }
#pragma unroll
            for (int o = 1; o < 64; o <<= 1)
#pragma unroll
                for (int rr = 0; rr < R; ++rr) ss[rr] += __shfl_xor(ss[rr], o);
            float r2[R];
#pragma unroll
            for (int rr = 0; rr < R; ++rr) { r2[rr] = rsqrtf(ss[rr] * (1.f / DM) + EPS); if (lane == 0) A.rs[row0 + rr] = r2[rr]; }
            if (DT || ROUTE) {
                float gn[16];
#pragma unroll
                for (int i = 0; i < 2; ++i) { const float4 g0 = *(const float4*)(A.gnext + i * 512 + lane * 8), g1 = *(const float4*)(A.gnext + i * 512 + lane * 8 + 4);
                    gn[i * 8 + 0] = g0.x; gn[i * 8 + 1] = g0.y; gn[i * 8 + 2] = g0.z; gn[i * 8 + 3] = g0.w; gn[i * 8 + 4] = g1.x; gn[i * 8 + 5] = g1.y; gn[i * 8 + 6] = g1.z; gn[i * 8 + 7] = g1.w; }
                int re1[R], re2[R], lr1[R], lr2[R]; float rw1[R], rw2[R];
                volatile LAS int* lcnt = (volatile LAS int*)((LAS unsigned char*)wl + 40960);
                if (ROUTE) { __syncthreads(); if (tidq < 8) lcnt[tidq] = 0; __syncthreads(); }
#pragma unroll
                for (int rr = 0; rr < R; ++rr) {
                    const int row = row0 + rr;
                    float hv[16];
#pragma unroll
                    for (int j = 0; j < 16; ++j) hv[j] = (rr == 0 ? xv[0][j] : xv[R - 1][j]) * (rr == 0 ? r2[0] : r2[R - 1]) * gn[j];
                    if (DT) {
                        float pd[16];
#pragma unroll 4
                        for (int j = 0; j < 16; ++j) {
                            float p = 0.f;
#pragma unroll
                            for (int i = 0; i < 2; ++i) { const LAS float* wp = wl + j * DM + i * 512 + lane * 8;
                                const f32x4 w0 = *(const LAS f32x4*)wp, w1 = *(const LAS f32x4*)(wp + 4);
                                p += hv[i * 8 + 0] * w0[0] + hv[i * 8 + 1] * w0[1] + hv[i * 8 + 2] * w0[2] + hv[i * 8 + 3] * w0[3] + hv[i * 8 + 4] * w1[0] + hv[i * 8 + 5] * w1[1] + hv[i * 8 + 6] * w1[2] + hv[i * 8 + 7] * w1[3]; }
                            pd[j] = p;
                        }
                        const float dk = wave_sum16(pd, lane);
                        if ((lane & 3) == 0) A.dtraw[(size_t)row * 16 + (lane >> 2)] = dk;
                    }
                    if (ROUTE) {
                        float pl[8];
#pragma unroll 4
                        for (int e = 0; e < 8; ++e) {
                            float p = 0.f;
#pragma unroll
                            for (int i = 0; i < 2; ++i) { const LAS float* wp = wl + e * DM + i * 512 + lane * 8;
                                const f32x4 w0 = *(const LAS f32x4*)wp, w1 = *(const LAS f32x4*)(wp + 4);
                                p += hv[i * 8 + 0] * w0[0] + hv[i * 8 + 1] * w0[1] + hv[i * 8 + 2] * w0[2] + hv[i * 8 + 3] * w0[3] + hv[i * 8 + 4] * w1[0] + hv[i * 8 + 5] * w1[1] + hv[i * 8 + 6] * w1[2] + hv[i * 8 + 7] * w1[3]; }
                            pl[e] = p;
                        }
                        const float lk = wave_sum8(pl, lane);
                        float lg[8];
#pragma unroll
                        for (int e = 0; e < 8; ++e) lg[e] = __shfl(lk, e * 8);
                        int e1 = 0; float v1 = lg[0];
#pragma unroll
                        for (int e = 1; e < 8; ++e) if (lg[e] > v1) { v1 = lg[e]; e1 = e; }
                        int e2 = 0; float v2 = -3.0e38f;
#pragma unroll
                        for (int e = 0; e < 8; ++e) if (e != e1 && lg[e] > v2) { v2 = lg[e]; e2 = e; }
                        const float ex = __expf(v2 - v1);
                        re1[rr] = e1; re2[rr] = e2; rw1[rr] = 1.f / (1.f + ex); rw2[rr] = ex / (1.f + ex);
                        if (lane == 0) { lr1[rr] = __hip_atomic_fetch_add((LAS int*)lcnt + e1, 1, __ATOMIC_RELAXED, __HIP_MEMORY_SCOPE_WORKGROUP); lr2[rr] = __hip_atomic_fetch_add((LAS int*)lcnt + e2, 1, __ATOMIC_RELAXED, __HIP_MEMORY_SCOPE_WORKGROUP); }
                    }
                }
                if (ROUTE) {
                    __syncthreads();
                    if (tidq < 8) lcnt[8 + tidq] = (int)atomicAdd(&A.cnt[tidq * 64], (unsigned)lcnt[tidq]);
                    __syncthreads();
#pragma unroll
                    for (int rr = 0; rr < R; ++rr) {
                        const int row = row0 + rr;
                        int dst1 = 0, dst2 = 0;
                        if (lane == 0) {
                            const int e1 = re1[rr], e2 = re2[rr];
                            const int p1 = lcnt[8 + e1] + lr1[rr], p2 = lcnt[8 + e2] + lr2[rr];
                            A.list[e1 * MT + p1] = row * 2; A.gatev[e1 * MT + p1] = rw1[rr]; A.rsl[e1 * MT + p1] = r2[rr];
                            A.list[e2 * MT + p2] = row * 2 + 1; A.gatev[e2 * MT + p2] = rw2[rr]; A.rsl[e2 * MT + p2] = r2[rr];
                            dst1 = e1 * MT + p1; dst2 = e2 * MT + p2;
                        }
                        dst1 = __builtin_amdgcn_readfirstlane(dst1); dst2 = __builtin_amdgcn_readfirstlane(dst2);
#pragma unroll
                        for (int i = 0; i < 2; ++i) { u32x2 o8;
                            const float* xs = xv[rr] + i * 8;
                            o8.x = pg8_pk4(xs[0], xs[1], xs[2], xs[3]); o8.y = pg8_pk4(xs[4], xs[5], xs[6], xs[7]);
                            *(u32x2*)(A.x8 + (size_t)dst1 * DM + i * 512 + lane * 8) = o8; *(u32x2*)(A.x8 + (size_t)dst2 * DM + i * 512 + lane * 8) = o8; }
                    }
                }
            }
        }
    }
}

DEVI void transpose_item(const float* W, int ldw, int K, int k0, int n0, bf16_t* WT, int drow0, LAS float* scr, int lane, const float* gain) {
    {
        const int ka = lane >> 3, n4 = (lane & 7) * 4;
        float4 wv[8];
#pragma unroll
        for (int i = 0; i < 8; ++i) wv[i] = *(const float4*)(W + (size_t)(k0 + i * 8 + ka) * ldw + n0 + n4);
#pragma unroll
        for (int i = 0; i < 8; ++i) { LAS float* d = scr + (i * 8 + ka) * 33 + n4; d[0] = wv[i].x; d[1] = wv[i].y; d[2] = wv[i].z; d[3] = wv[i].w; }
    }
    asm volatile("s_waitcnt lgkmcnt(0)" ::: "memory");
    const int c = lane & 7;
    float4 ga = make_float4(1.f, 1.f, 1.f, 1.f), gb = ga;
    if (gain) { ga = *(const float4*)(gain + k0 + 8 * c); gb = *(const float4*)(gain + k0 + 8 * c + 4); }
#pragma unroll
    for (int j = 0; j < 4; ++j) { const int n = (lane >> 3) + 8 * j; const LAS float* sp = scr + (8 * c) * 33 + n;
        u32x4 o; o.x = pk2(sp[0 * 33] * ga.x, sp[1 * 33] * ga.y); o.y = pk2(sp[2 * 33] * ga.z, sp[3 * 33] * ga.w); o.z = pk2(sp[4 * 33] * gb.x, sp[5 * 33] * gb.y); o.w = pk2(sp[6 * 33] * gb.z, sp[7 * 33] * gb.w);
        *(u32x4*)(WT + (size_t)(drow0 + n) * K + k0 + 8 * c) = o; }
    asm volatile("s_waitcnt lgkmcnt(0)" ::: "memory");
}
DEVI void transpose_item_fp8(const float* W, int ldw, int K, int k0, int n0, unsigned char* WT8, int drow0, LAS float* scr, int lane, const float* gain) {
    {
        const int ka = lane >> 3, n4 = (lane & 7) * 4;
        float4 wv[8];
#pragma unroll
        for (int i = 0; i < 8; ++i) wv[i] = *(const float4*)(W + (size_t)(k0 + i * 8 + ka) * ldw + n0 + n4);
#pragma unroll
        for (int i = 0; i < 8; ++i) { LAS float* d = scr + (i * 8 + ka) * 33 + n4; d[0] = wv[i].x; d[1] = wv[i].y; d[2] = wv[i].z; d[3] = wv[i].w; }
    }
    asm volatile("s_waitcnt lgkmcnt(0)" ::: "memory");
    const int c = lane & 7;
    float4 ga = make_float4(64.f, 64.f, 64.f, 64.f), gb = ga;
    if (gain) { ga = *(const float4*)(gain + k0 + 8 * c); gb = *(const float4*)(gain + k0 + 8 * c + 4); ga.x *= 64.f; ga.y *= 64.f; ga.z *= 64.f; ga.w *= 64.f; gb.x *= 64.f; gb.y *= 64.f; gb.z *= 64.f; gb.w *= 64.f; }
#pragma unroll
    for (int j = 0; j < 4; ++j) { const int n = (lane >> 3) + 8 * j; const LAS float* sp = scr + (8 * c) * 33 + n;
        u32x2 o; o.x = pg8_pk4(sp[0 * 33] * ga.x, sp[1 * 33] * ga.y, sp[2 * 33] * ga.z, sp[3 * 33] * ga.w); o.y = pg8_pk4(sp[4 * 33] * gb.x, sp[5 * 33] * gb.y, sp[6 * 33] * gb.z, sp[7 * 33] * gb.w);
        *(u32x2*)(WT8 + (size_t)(drow0 + n) * K + k0 + 8 * c) = o; }
    asm volatile("s_waitcnt lgkmcnt(0)" ::: "memory");
}
struct Job { int in_idx; unsigned src_off; int ldw; int K; int ncols; unsigned long long dst; int mode; int item0; int gain_idx; int gain_off; int fp8; };
constexpr int NJOBS = 11 + 24;
struct JobTable { Job j[NJOBS]; int total; };
constexpr JobTable make_jobs() {
    JobTable t{}; int n = 0, it = 0;
    auto add = [&](int idx, unsigned off, int ldw, int K, int ncols, unsigned long long dst, int mode, int gi, int go, int f8 = 0) { t.j[n] = Job{idx, off, ldw, K, ncols, dst, mode, it, gi, go, f8}; it += (K / 64) * (ncols / 32); ++n; };
    add(4, 0, EVEN_IN, DM, UW, W_IN, 0, 3, 0);
    add(12, 0, DM, DM, DM, W_OUTE, 0, -1, 0);
    add(15, 0, DFF, DM, DFF, W_GU, 1, 14, 0);
    add(16, 0, DFF, DM, DFF, W_GU, 2, 14, 0);
    add(17, 0, DM, DFF, DM, W_DN, 0, -1, 0);
    add(31, 0, DM, DM, DM, W_PG, 0, 30, 0);
    add(31, DM * DM, DM, DM, DM, W_PG + 2 * MiB, 0, 30, DM);
    add(32, 0, DM, PDIM, DM, W_PP, 0, -1, 0);
    add(32, PDIM * DM, DM, PDIM, DM, W_PP + 512 * 1024, 0, -1, 0);
    add(20, 0, 3072, DM, 3072, W_QKV, 0, 19, 0);
    add(22, 0, DM, DM, DM, W_OUTO, 0, -1, 0);
    for (int e = 0; e < NEXP; ++e) {
        add(26, (unsigned)e * DM * DFFE, DFFE, DM, DFFE, W_EGU + (unsigned long long)e * 7 * MiB, 1, 24, 0, 1);
        add(27, (unsigned)e * DM * DFFE, DFFE, DM, DFFE, W_EGU + (unsigned long long)e * 7 * MiB, 2, 24, 0, 1);
        add(28, (unsigned)e * DFFE * DM, DM, DFFE, DM, W_EDN + (unsigned long long)e * (7 * MiB / 2), 0, -1, 0, 1);
    }
    t.total = it; return t;
}
__device__ const JobTable g_jobs = make_jobs();
constexpr int ITEMS_DENSE = make_jobs().j[11].item0, ITEMS_ALL = make_jobs().total;
DEVI void ph_convert_weights(LAS unsigned char* lds, const float* const* in, unsigned char* ws, int it_lo, int it_hi, int vb0, int vbs) {
    const int tidq = opq((int)threadIdx.x); const int wid = __builtin_amdgcn_readfirstlane(tidq >> 6), lane = tidq & 63;
    LAS float* scr = (LAS float*)(lds + wid * 16384);
    int jb = 0;
    for (int it = it_lo + vb0 * 8 + wid; it < it_hi; it += vbs * 8) {
        while (jb + 1 < NJOBS && g_jobs.j[jb + 1].item0 <= it) ++jb;
        const Job J = g_jobs.j[jb];
        const int r = it - J.item0; const int nblk = J.ncols / 32; const int kb = r / nblk, nb = r % nblk;
        const int n0 = nb * 32; int drow0 = n0;
        if (J.mode != 0) drow0 = (n0 >> 7) * 256 + (n0 & 127) + (J.mode == 2 ? 128 : 0);
        const float* gp = J.gain_idx >= 0 ? in[J.gain_idx] + J.gain_off : nullptr;
        if (J.fp8) transpose_item_fp8(in[J.in_idx] + J.src_off, J.ldw, J.K, kb * 64, n0, ws + J.dst, drow0, scr, lane, gp);
        else transpose_item(in[J.in_idx] + J.src_off, J.ldw, J.K, kb * 64, n0, (bf16_t*)(ws + J.dst), drow0, scr, lane, gp);
    }
}
DEVI void ph_cvt_rows(const float* src, bf16_t* dst, size_t n4, int vb0, int vbs) {
    for (size_t e = (size_t)vb0 * NTHR + opq((int)threadIdx.x); e < n4; e += (size_t)vbs * NTHR) {
        const float4 v = ((const float4*)src)[e]; u32x2 o; o.x = pk2(v.x, v.y); o.y = pk2(v.z, v.w); ((u32x2*)dst)[e] = o; }
}

namespace pg8 {
constexpr int BM = 256, BK = 64, HALF = 128, HTB = HALF * BK * 2, STAGE_BYTES = 8 * HTB, NXCD = 8, WGM = 8;
__host__ __device__ __forceinline__ int lds_byte(int r, int c) { const int st = (r >> 4) * 2 + (c >> 5), rr = r & 15, cc = c & 31, ob = rr * 64 + cc * 2; return st * 1024 + (ob ^ (((ob >> 9) & 1) << 5)); }
__host__ __device__ __forceinline__ void stage_rc(int b, int& R, int& C) { const int st = b / 1024, sb = b % 1024, swz = sb ^ (((sb >> 9) & 1) << 5); R = (st >> 1) * 16 + swz / 64; C = (st & 1) * 32 + (swz % 64) / 2; }
__host__ __device__ __forceinline__ int perm32(int rho) { const int n = rho >> 4, i = rho & 15; return 8 * (i >> 2) + 4 * n + (i & 3); }
struct Unit { int pm, pn; int row0; int arow0; int mvalid; int e; int mbase; const char* B; };
DEVI void xcd_tile(int L, int nwg, int nM, int nN, int& pm, int& pn) {
    int wgid = L; { const int q = nwg / NXCD, r = nwg % NXCD, xcd = wgid % NXCD, off = wgid / NXCD; wgid = (xcd < r ? xcd * (q + 1) : r * (q + 1) + (xcd - r) * q) + off; }
    const int nig = WGM * nN, gid = wgid / nig, fm = gid * WGM, gsz = (nM - fm) < WGM ? (nM - fm) : WGM;
    pm = fm + ((wgid % nig) % gsz); pn = (wgid % nig) / gsz;
}
struct DenseOrder {
    int nM, nN, nwg, G, c; const char* Bt; size_t tstepB;
    DEVI void init(int M, int N, int K, const bf16_t* Bt_, int G_, int c_) { nM = M / BM; nN = N / BM; nwg = nM * nN; G = G_; c = c_; Bt = (const char*)Bt_; tstepB = (size_t)BM * K * 2; }
    DEVI bool next(int i, Unit& u) const { const long L = (long)i * G + c; if (L >= nwg) return false; xcd_tile((int)L, nwg, nM, nN, u.pm, u.pn); u.row0 = u.pm * BM; u.arow0 = u.row0; u.mvalid = BM; u.e = 0; u.mbase = 0; u.B = Bt + (size_t)u.pn * tstepB; return true; }
};
struct TailOrder {
    int nM, nN, nwg, nb, r; const char* Bt; size_t tstepB;
    DEVI void init(int M, int N, int K, const bf16_t* Bt_, int G_, int c_, int first) { nM = M / BM; nN = N / BM; nwg = nM * nN; Bt = (const char*)Bt_; tstepB = (size_t)BM * K * 2;
        if (first >= G_) first = 0; nb = G_ - first; r = c_ - first; }
    DEVI bool next(int i, Unit& u) const { if (r < 0) return false; const long L = (long)i * nb + r; if (L >= nwg) return false; u.pm = (int)L / nN; u.pn = (int)L % nN; u.row0 = u.pm * BM; u.arow0 = u.row0; u.mvalid = BM; u.e = 0; u.mbase = 0; u.B = Bt + (size_t)u.pn * tstepB; return true; }
};
struct MoeOrder {
    int nM, nN, nwg, G, c; const char* Bt; size_t estepB, tstepB; const volatile LAS int* tab; bool per_expert;
    DEVI void init(const unsigned* cnt, volatile LAS int* tab_, int N, int K, const bf16_t* Bt_, size_t estep_bytes, bool per_expert_, int G_, int c_) {
        __syncthreads();
        if (threadIdx.x < 8) tab_[16 + threadIdx.x] = (int)__hip_atomic_load(cnt + threadIdx.x * 64, __ATOMIC_RELAXED, __HIP_MEMORY_SCOPE_AGENT);
        __syncthreads();
        if (threadIdx.x == 0) { int t = 0;
            for (int e = 0; e < 8; ++e) { const int n = tab_[16 + e]; tab_[e] = t; t += (n + BM - 1) / BM; }
            tab_[8] = t; }
        __syncthreads();
        tab = tab_; nM = __builtin_amdgcn_readfirstlane(tab_[8]); nN = N / BM; nwg = nM * nN; G = G_; c = c_; Bt = (const char*)Bt_; estepB = estep_bytes; tstepB = (size_t)BM * K * 2; per_expert = per_expert_;
    }
    DEVI bool next(int i, Unit& u) const { const long L = (long)i * G + c; if (L >= nwg) return false; xcd_tile((int)L, nwg, nM, nN, u.pm, u.pn);
        int e = 0;
        for (int k = 1; k < 8; ++k) if (u.pm >= __builtin_amdgcn_readfirstlane(tab[k])) e = k;
        const int t0 = __builtin_amdgcn_readfirstlane(tab[e]), n = __builtin_amdgcn_readfirstlane(tab[16 + e]);
        u.e = e; u.row0 = u.pm * BM; const int m0 = (u.pm - t0) * BM; u.mbase = m0; u.arow0 = per_expert ? e * MT + m0 : u.row0; u.mvalid = (n - m0) < BM ? (n - m0) : BM; u.B = Bt + (size_t)e * estepB + (size_t)u.pn * tstepB; return true; }
};
DEVI unsigned cvt_pk_bf16(float lo, float hi) { return cvt2bf(lo, hi); }

struct Pre8 { float v[8]; };
struct Pre16 { float v[8]; int t[8]; };
struct EpiBf16 { static constexpr bool PERM = true; bf16_t* O; int ldc; const float* rs;
    typedef Pre8 Pre;
    DEVI void pre(Pre& P, const Unit& u, int wr, int fr) const {
#pragma unroll
        for (int q = 0; q < 8; ++q) P.v[q] = rs ? rs[u.row0 + wr * 64 + fr + (q >> 2) * HALF + (q & 3) * 16] : 1.f; }
    DEVI void operator()(const f32x4 (&acc)[2][2][4][2], const Unit& u, int wr, int wc, int fr, int fq, const Pre& P) const {
        const int row0 = u.row0 + wr * 64 + fr, col0 = u.pn * BM + wc * 32 + 8 * fq;
#pragma unroll
        for (int ai = 0; ai < 2; ++ai)
#pragma unroll
            for (int m = 0; m < 4; ++m) { const int row = row0 + ai * HALF + m * 16; bf16_t* rowp = O + (size_t)row * ldc + col0;
                const float sc = P.v[ai * 4 + m];
#pragma unroll
                for (int bj = 0; bj < 2; ++bj) { const f32x4 v0 = acc[ai][bj][m][0] * sc, v1 = acc[ai][bj][m][1] * sc;
                    u32x4 w; w.x = cvt_pk_bf16(v0[0], v0[1]); w.y = cvt_pk_bf16(v0[2], v0[3]); w.z = cvt_pk_bf16(v1[0], v1[1]); w.w = cvt_pk_bf16(v1[2], v1[3]);
                    *(u32x4*)(rowp + bj * HALF) = w; } }
    } };
struct EpiPleGate { static constexpr bool PERM = true; bf16_t* T; int ldc; const float* rs;
    typedef Pre8 Pre;
    DEVI void pre(Pre& P, const Unit& u, int wr, int fr) const {
#pragma unroll
        for (int q = 0; q < 8; ++q) P.v[q] = rs[u.row0 + wr * 64 + fr + (q >> 2) * HALF + (q & 3) * 16]; }
    DEVI void operator()(const f32x4 (&acc)[2][2][4][2], const Unit& u, int wr, int wc, int fr, int fq, const Pre& P) const {
        const int row0 = u.row0 + wr * 64 + fr, col0 = u.pn * BM + wc * 32 + 8 * fq;
#pragma unroll
        for (int ai = 0; ai < 2; ++ai)
#pragma unroll
            for (int m = 0; m < 4; ++m) { const int row = row0 + ai * HALF + m * 16; bf16_t* rowp = T + (size_t)row * ldc + col0;
                const float sc = P.v[ai * 4 + m];
#pragma unroll
                for (int bj = 0; bj < 2; ++bj) { const f32x4 v0 = acc[ai][bj][m][0] * sc, v1 = acc[ai][bj][m][1] * sc;
                    const u32x4 pp = *(const u32x4*)(rowp + bj * HALF);
                    u32x4 w; w.x = cvt_pk_bf16(sigmoid_f(v0[0]) * bflo(pp.x), sigmoid_f(v0[1]) * bfhi(pp.x)); w.y = cvt_pk_bf16(sigmoid_f(v0[2]) * bflo(pp.y), sigmoid_f(v0[3]) * bfhi(pp.y));
                    w.z = cvt_pk_bf16(sigmoid_f(v1[0]) * bflo(pp.z), sigmoid_f(v1[1]) * bfhi(pp.z)); w.w = cvt_pk_bf16(sigmoid_f(v1[2]) * bflo(pp.w), sigmoid_f(v1[3]) * bfhi(pp.w));
                    *(u32x4*)(rowp + bj * HALF) = w; } }
    } };
struct EpiSwiglu { static constexpr bool PERM = true; bf16_t* O; int ldc; const float* rs; int grouped;
    typedef Pre8 Pre;
    DEVI void pre(Pre& P, const Unit& u, int wr, int fr) const {
        const float* rsb = grouped ? rs + u.e * MT + u.mbase : rs + u.row0; const int vm1 = (grouped ? u.mvalid : BM) - 1;
#pragma unroll
        for (int q = 0; q < 8; ++q) { const int rl = wr * 64 + fr + (q >> 2) * HALF + (q & 3) * 16; P.v[q] = rsb[rl <= vm1 ? rl : vm1]; } }
    DEVI void operator()(const f32x4 (&acc)[2][2][4][2], const Unit& u, int wr, int wc, int fr, int fq, const Pre& P) const {
        const int row0 = u.row0 + wr * 64 + fr, col0 = u.pn * HALF + wc * 32 + 8 * fq; const int vm1e = (grouped ? u.mvalid : BM) - 1;
#pragma unroll
        for (int ai = 0; ai < 2; ++ai)
#pragma unroll
            for (int m = 0; m < 4; ++m) { const int rl = wr * 64 + fr + ai * HALF + m * 16; bf16_t* rowp = O + (size_t)(u.row0 + rl) * ldc + col0;
                const float sc = rl <= vm1e ? P.v[ai * 4 + m] : 0.f;
                const f32x4 g0 = acc[ai][0][m][0] * sc, g1 = acc[ai][0][m][1] * sc, u0 = acc[ai][1][m][0] * sc, u1 = acc[ai][1][m][1] * sc;
                u32x4 w; w.x = cvt_pk_bf16(silu_f(g0[0]) * u0[0], silu_f(g0[1]) * u0[1]); w.y = cvt_pk_bf16(silu_f(g0[2]) * u0[2], silu_f(g0[3]) * u0[3]);
                w.z = cvt_pk_bf16(silu_f(g1[0]) * u1[0], silu_f(g1[1]) * u1[1]); w.w = cvt_pk_bf16(silu_f(g1[2]) * u1[2], silu_f(g1[3]) * u1[3]);
                *(u32x4*)rowp = w; }
    } };
constexpr float W8_SCALE = 64.f, ACT8_SCALE = 8.f;
struct EpiSwiglu8 { static constexpr bool PERM = true; unsigned char* O; int ldc; const float* rs;
    typedef Pre8 Pre;
    DEVI void pre(Pre& P, const Unit& u, int wr, int fr) const {
        const float* rsb = rs + u.e * MT + u.mbase; const int vm1 = u.mvalid - 1;
#pragma unroll
        for (int q = 0; q < 8; ++q) { const int rl = wr * 64 + fr + (q >> 2) * HALF + (q & 3) * 16; P.v[q] = rsb[rl <= vm1 ? rl : vm1]; } }
    DEVI void operator()(const f32x4 (&acc)[2][2][4][2], const Unit& u, int wr, int wc, int fr, int fq, const Pre& P) const {
        const int col0 = u.pn * HALF + wc * 32 + 8 * fq;
#pragma unroll
        for (int ai = 0; ai < 2; ++ai)
#pragma unroll
            for (int m = 0; m < 4; ++m) { const int rl = wr * 64 + fr + ai * HALF + m * 16; unsigned char* rowp = O + (size_t)(u.row0 + rl) * ldc + col0;
                const float sc = rl < u.mvalid ? P.v[ai * 4 + m] * (1.f / W8_SCALE) : 0.f;
                const f32x4 g0 = acc[ai][0][m][0] * sc, g1 = acc[ai][0][m][1] * sc, u0 = acc[ai][1][m][0] * (sc * ACT8_SCALE), u1 = acc[ai][1][m][1] * (sc * ACT8_SCALE);
                u32x2 w; w.x = pg8_pk4(silu_f(g0[0]) * u0[0], silu_f(g0[1]) * u0[1], silu_f(g0[2]) * u0[2], silu_f(g0[3]) * u0[3]);
                w.y = pg8_pk4(silu_f(g1[0]) * u1[0], silu_f(g1[1]) * u1[1], silu_f(g1[2]) * u1[2], silu_f(g1[3]) * u1[3]);
                *(u32x2*)rowp = w; }
    } };
struct EpiMoeDown { static constexpr bool PERM = true; bf16_t* Y; const int* list; const float* gatev; float oscale;
    typedef Pre16 Pre;
    DEVI void pre(Pre& P, const Unit& u, int wr, int fr) const {
        const int* lb = list + u.e * MT + u.mbase; const float* gb = gatev + u.e * MT + u.mbase; const int vm1 = u.mvalid - 1;
#pragma unroll
        for (int q = 0; q < 8; ++q) { const int rl = wr * 64 + fr + (q >> 2) * HALF + (q & 3) * 16; const int ri = rl <= vm1 ? rl : vm1; P.t[q] = lb[ri]; P.v[q] = gb[ri]; } }
    DEVI void operator()(const f32x4 (&acc)[2][2][4][2], const Unit& u, int wr, int wc, int fr, int fq, const Pre& P) const {
        const int col0 = u.pn * BM + wc * 32 + 8 * fq;
        const int mbase = u.mbase;
#pragma unroll
        for (int ai = 0; ai < 2; ++ai)
#pragma unroll
            for (int m = 0; m < 4; ++m) { const int rl = wr * 64 + fr + ai * HALF + m * 16;
                const int tsl = P.t[ai * 4 + m]; const float gt = P.v[ai * 4 + m] * oscale;
                if (rl < u.mvalid) {
                    bf16_t* rowp = Y + (size_t)(tsl & 1) * ((size_t)MT * DM) + (size_t)(tsl >> 1) * DM + col0;
#pragma unroll
                    for (int bj = 0; bj < 2; ++bj) { const f32x4 v0 = acc[ai][bj][m][0], v1 = acc[ai][bj][m][1];
                        u32x4 w; w.x = cvt_pk_bf16(v0[0] * gt, v0[1] * gt); w.y = cvt_pk_bf16(v0[2] * gt, v0[3] * gt); w.z = cvt_pk_bf16(v1[0] * gt, v1[1] * gt); w.w = cvt_pk_bf16(v1[2] * gt, v1[3] * gt);
                        *(u32x4*)(rowp + bj * HALF) = w; } } }
    } };

typedef int v8i __attribute__((ext_vector_type(8)));
typedef int v4i __attribute__((ext_vector_type(4)));
DEVI v8i cat8(const bf16x8 lo, const bf16x8 hi) { const v4i a = __builtin_bit_cast(v4i, lo), b = __builtin_bit_cast(v4i, hi); return __builtin_shufflevector(a, b, 0, 1, 2, 3, 4, 5, 6, 7); }
struct Frag16 { bf16x8 k[2]; };
struct Frag8 { v8i v; };
template <bool F> struct FragSel { typedef Frag16 T; };
template <> struct FragSel<true> { typedef Frag8 T; };
template <class Epi, class Sched, bool FP8 = false>
DEVI void gemm_phase(LAS unsigned char* lds, const bf16_t* A, const int K, const Sched& S, const Epi& E) {
    const int tid = opq((int)threadIdx.x), wid = __builtin_amdgcn_readfirstlane(tid >> 6), lane = tid & 63, wr = wid >> 2, wc = wid & 3, fr = lane & 15, fq = lane >> 4;
    const int nt = K / BK;
    unsigned voffA[2], voffB[2];
#pragma unroll
    for (int i = 0; i < 2; ++i) { int R, C; stage_rc(tid * 16 + i * 8192, R, C); const int Rb = Epi::PERM ? ((R & ~31) + perm32(R & 31)) : R;
        voffA[i] = (unsigned)(R * K + C) * 2u; voffB[i] = (unsigned)(Rb * K + C) * 2u; }
    const size_t kstep = (size_t)(BK * 2);
    const size_t hstep = (size_t)HALF * K * 2;
    const size_t rstep = (size_t)K * 2;
    const unsigned ldsw = (unsigned)wid * 1024u;
    const int aoff = lds_byte(wr * 64 + fr, fq * 8), boff = lds_byte(wc * 32 + fr, fq * 8);
#define PG8_SA(b, h) (((b) * 2 + (h)) * HTB)
#define PG8_SB(b, h) ((4 + (b) * 2 + (h)) * HTB)
#define PG8_STAGE(bufoff, gbase, voff) do { _Pragma("unroll") for (int _i = 0; _i < 2; ++_i) \
        __builtin_amdgcn_global_load_lds((const unsigned*)((const char*)(gbase) + (voff)[_i]), (LAS unsigned*)(lds + (bufoff) + ldsw + _i * 8192), 16, 0, 0); } while (0)
#define PG8_LDA(dst, b, h) do { _Pragma("unroll") for (int m = 0; m < 4; ++m) { if constexpr (FP8) dst[m].v = cat8(*(const LAS bf16x8*)(lds + PG8_SA(b, h) + aoff + m * 2048), *(const LAS bf16x8*)(lds + PG8_SA(b, h) + aoff + m * 2048 + 1024)); \
        else { _Pragma("unroll") for (int k = 0; k < 2; ++k) dst[m].k[k] = *(const LAS bf16x8*)(lds + PG8_SA(b, h) + aoff + m * 2048 + k * 1024); } } } while (0)
#define PG8_LDB(dst, b, h) do { _Pragma("unroll") for (int n = 0; n < 2; ++n) { if constexpr (FP8) dst[n].v = cat8(*(const LAS bf16x8*)(lds + PG8_SB(b, h) + boff + n * 2048), *(const LAS bf16x8*)(lds + PG8_SB(b, h) + boff + n * 2048 + 1024)); \
        else { _Pragma("unroll") for (int k = 0; k < 2; ++k) dst[n].k[k] = *(const LAS bf16x8*)(lds + PG8_SB(b, h) + boff + n * 2048 + k * 1024); } } } while (0)
#define PG8_MMA(ai, bj, At, Bt) do { __builtin_amdgcn_s_setprio(1); _Pragma("unroll") for (int m = 0; m < 4; ++m) _Pragma("unroll") for (int n = 0; n < 2; ++n) { \
        if constexpr (FP8) asm volatile("s_nop 1\n\tv_mfma_scale_f32_16x16x128_f8f6f4 %0, %1, %2, %0, %3, %3 op_sel_hi:[0,0,0]" : "+v"(acc[ai][bj][m][n]) : "v"(Bt[n].v), "v"(At[m].v), "v"(sc1)); \
        else { _Pragma("unroll") for (int k = 0; k < 2; ++k) acc[ai][bj][m][n] = __builtin_amdgcn_mfma_f32_16x16x32_bf16(Bt[n].k[k], At[m].k[k], acc[ai][bj][m][n], 0, 0, 0); } } \
        __builtin_amdgcn_s_setprio(0); } while (0)
#define PG8_WAIT_V(n) asm volatile("s_waitcnt vmcnt(" #n ")" ::: "memory")
#define PG8_WAIT_L(n) asm volatile("s_waitcnt lgkmcnt(" #n ")" ::: "memory")
#define PG8_BAR __builtin_amdgcn_s_barrier()
#define PG8_SCHED __builtin_amdgcn_sched_barrier(0)
    Unit cur, nxt; int ui = 0;
    if (!S.next(0, cur)) return;
    int sc1 = 0x7F7F7F7F; asm volatile("" : "+v"(sc1));
    f32x4 acc[2][2][4][2];
#pragma unroll
    for (int a = 0; a < 2; ++a)
#pragma unroll
        for (int b = 0; b < 2; ++b)
#pragma unroll
            for (int m = 0; m < 4; ++m)
#pragma unroll
                for (int n = 0; n < 2; ++n) acc[a][b][m][n] = (f32x4){0.f, 0.f, 0.f, 0.f};
    typename FragSel<FP8>::T At[4], B0[2], B1[2];
    const char* cA = (const char*)A + (size_t)cur.arow0 * rstep;
    const char* cB = cur.B;
    typename Epi::Pre pre; E.pre(pre, cur, wr, fr);
    PG8_STAGE(PG8_SB(0, 0), cB, voffB); PG8_STAGE(PG8_SA(0, 0), cA, voffA); PG8_STAGE(PG8_SB(0, 1), cB + hstep, voffB); PG8_STAGE(PG8_SA(0, 1), cA + hstep, voffA);
    if (wr == 1) PG8_BAR;
    PG8_WAIT_V(4); PG8_BAR;
    PG8_STAGE(PG8_SB(1, 0), cB + kstep, voffB); PG8_STAGE(PG8_SA(1, 0), cA + kstep, voffA); PG8_STAGE(PG8_SB(1, 1), cB + hstep + kstep, voffB);
    PG8_WAIT_V(6); PG8_BAR;
    for (;;) {
        const bool has_next = S.next(ui + 1, nxt);
        const char* nA = has_next ? (const char*)A + (size_t)nxt.arow0 * rstep : cA; const char* nB = has_next ? nxt.B : cB;
#pragma unroll 1
        for (int t = 0; t < nt; t += 2) {
            const bool last = (t == nt - 2);
            const char* a1 = cA + (size_t)(t + 1) * kstep;
            const char* a2 = last ? nA : cA + (size_t)(t + 2) * kstep; const char* b2 = last ? nB : cB + (size_t)(t + 2) * kstep;
            const char* a3 = a2 + kstep; const char* b3 = b2 + kstep;
            PG8_LDB(B0, 0, 0); PG8_SCHED; PG8_LDA(At, 0, 0); PG8_STAGE(PG8_SA(1, 1), a1 + hstep, voffA);
            PG8_WAIT_L(8); PG8_BAR; PG8_WAIT_L(0); PG8_MMA(0, 0, At, B0); PG8_BAR; PG8_SCHED;
            PG8_LDB(B1, 0, 1); PG8_STAGE(PG8_SB(0, 0), b2, voffB);
            PG8_BAR; PG8_WAIT_L(0); PG8_MMA(0, 1, At, B1); PG8_BAR;
            PG8_LDA(At, 0, 1); PG8_STAGE(PG8_SA(0, 0), a2, voffA);
            PG8_BAR; PG8_WAIT_L(0); PG8_MMA(1, 0, At, B0); PG8_BAR; PG8_SCHED;
            PG8_STAGE(PG8_SB(0, 1), b2 + hstep, voffB);
            PG8_WAIT_V(6); PG8_BAR; PG8_MMA(1, 1, At, B1); PG8_BAR;
            PG8_LDB(B0, 1, 0); PG8_SCHED; PG8_LDA(At, 1, 0); PG8_STAGE(PG8_SA(0, 1), a2 + hstep, voffA);
            PG8_WAIT_L(8); PG8_BAR; PG8_WAIT_L(0); PG8_MMA(0, 0, At, B0); PG8_BAR; PG8_SCHED;
            PG8_LDB(B1, 1, 1); PG8_STAGE(PG8_SB(1, 0), b3, voffB);
            PG8_BAR; PG8_WAIT_L(0); PG8_MMA(0, 1, At, B1); PG8_BAR;
            PG8_LDA(At, 1, 1); PG8_STAGE(PG8_SA(1, 0), a3, voffA);
            PG8_BAR; PG8_WAIT_L(0); PG8_MMA(1, 0, At, B0); PG8_BAR; PG8_SCHED;
            PG8_STAGE(PG8_SB(1, 1), b3 + hstep, voffB);
            PG8_WAIT_V(6); PG8_BAR; PG8_MMA(1, 1, At, B1); PG8_BAR;
        }
        if constexpr (FP8) asm volatile("s_nop 15\n\ts_nop 15" ::: "memory");
        E(acc, cur, wr, wc, fr, fq, pre);
        if (!has_next) break;
#pragma unroll
        for (int a = 0; a < 2; ++a)
#pragma unroll
            for (int b = 0; b < 2; ++b)
#pragma unroll
                for (int m = 0; m < 4; ++m)
#pragma unroll
                    for (int n = 0; n < 2; ++n) acc[a][b][m][n] = (f32x4){0.f, 0.f, 0.f, 0.f};
        cur = nxt; cA = nA; cB = nB; ++ui;
        E.pre(pre, cur, wr, fr);
        if constexpr (FP8) asm volatile("s_nop 7" ::: "memory");
    }
    PG8_WAIT_V(0);
    if (wr == 0) PG8_BAR;
    PG8_BAR;
#undef PG8_SA
#undef PG8_SB
#undef PG8_STAGE
#undef PG8_LDA
#undef PG8_LDB
#undef PG8_MMA
#undef PG8_WAIT_V
#undef PG8_WAIT_L
#undef PG8_BAR
#undef PG8_SCHED
}
}

DEVI float lb_of(const float* lbraw, int ch) {
    const float r0 = lbraw[ch], r1 = lbraw[512 + ch], r2 = lbraw[1024 + ch];
    const float mx = fmaxf(r0, fmaxf(r1, r2));
    const float e0 = __expf(r0 - mx), e1 = __expf(r1 - mx), e2 = __expf(r2 - mx);
    return e0 / (e0 + e1 + e2);
}
DEVI void ph_hgrn_naive(float* lds, const bf16_t* u, const float* lbraw, float* oacc, int vb0, int vbs) {
    float* sq = lds; float* sk = lds + 2048; float* sf = lds + 4096; float* sv = lds + 6144;
    const int tid = opq((int)threadIdx.x), j = tid >> 2, kq = tid & 3;
    for (int vb = vb0; vb < 32; vb += vbs) {
        const int dir = vb & 1, h = (vb >> 1) & 3, b = vb >> 3;
        float st[32];
#pragma unroll
        for (int i = 0; i < 32; ++i) st[i] = 0.f;
        for (int tb = 0; tb < SEQ / 16; ++tb) {
            __syncthreads();
            for (int e = tid; e < 2048; e += NTHR) {
                const int i = e >> 7, c = e & 127;
                const int t = dir ? (SEQ - 1 - (tb * 16 + i)) : (tb * 16 + i);
                const bf16_t* ur = u + (size_t)(b * SEQ + t) * UW;
                const int ch = h * 128 + c;
                const float qr = bf2f(ur[ch]), fr = bf2f(ur[(dir ? 1024 : 512) + ch]), vr = bf2f(ur[1536 + ch]);
                const float lb = lb_of(lbraw, ch);
                const float f = lb + (1.f - lb) * sigmoid_f(fr);
                sq[e] = silu_f(qr); sk[e] = 1.f - f; sf[e] = f; sv[e] = vr;
            }
            __syncthreads();
            for (int i = 0; i < 16; ++i) {
                const float vj = sv[i * 128 + j]; float acc = 0.f;
#pragma unroll
                for (int kk = 0; kk < 32; ++kk) {
                    const int kidx = kk * 4 + kq;
                    st[kk] = sf[i * 128 + kidx] * st[kk] + sk[i * 128 + kidx] * vj;
                    acc += st[kk] * sq[i * 128 + kidx];
                }
                acc += __shfl_xor(acc, 1); acc += __shfl_xor(acc, 2);
                if (kq == 0) {
                    const int t = dir ? (SEQ - 1 - (tb * 16 + i)) : (tb * 16 + i);
                    atomicAdd(&oacc[(size_t)(b * SEQ + t) * DM + h * 128 + j], acc);
                }
            }
        }
    }
    __syncthreads();
}

DEVI void ph_mixfin_hgrn(const bf16_t* u, const float* oacc, const float* a_norm, bf16_t* ocat, int vb0, int vbs) {
    const int tidq = opq((int)threadIdx.x); const int hw = tidq >> 5, l32 = tidq & 31;
    for (int row = vb0 * 16 + hw; row < MT; row += vbs * 16) {
        const int c0 = l32 * 16; float v[16]; float ss = 0.f;
        const bf16_t* ur = u + (size_t)row * UW;
#pragma unroll
        for (int i = 0; i < 16; ++i) { v[i] = oacc[(size_t)row * DM + c0 + i]; ss += v[i] * v[i]; }
        ss += __shfl_xor(ss, 1); ss += __shfl_xor(ss, 2); ss += __shfl_xor(ss, 4);
        const float r = rsqrtf(ss * (1.f / 128.f) + EPS);
#pragma unroll
        for (int i = 0; i < 16; ++i) { const int c = c0 + i; ocat[(size_t)row * DM + c] = f2bf(v[i] * r * a_norm[c & 127] * silu_f(bf2f(ur[2048 + c]))); }
    }
}


constexpr int HQ = 0, HK = 17408, HKH = 34816, HV = 53248, HDV = 71680, HZERO = 73728, HOT = 75776, H_END = HOT + 64 * 528;
static_assert(H_END <= 131072, "hgrn lds");
constexpr size_t HS_SCAN = (size_t)16 * 16384;
struct HgrnRaw { unsigned qf[16]; u32x4 v0, v1; };
DEVI void hgrn_load(HgrnRaw& R, const bf16_t* u, const bf16_t* VT, int dir, int b, int h, int t0, int c, int I, int tid) {
    const bf16_t* up = u + ((size_t)b * SEQ + t0 + 16 * I) * UW + h * 128 + c;
    const int fcol = dir ? 1024 : 512;
#pragma unroll
    for (int j = 0; j < 16; ++j) R.qf[j] = (unsigned)up[(size_t)j * UW] | ((unsigned)up[(size_t)j * UW + fcol] << 16);
    { const int e = tid, r = e >> 3, cch = e & 7; R.v0 = *(const u32x4*)(VT + ((size_t)b * 512 + h * 128 + r) * SEQ + t0 + cch * 8); }
    { const int e = tid + NTHR, r = e >> 3, cch = e & 7; R.v1 = *(const u32x4*)(VT + ((size_t)b * 512 + h * 128 + r) * SEQ + t0 + cch * 8); }
}
DEVI void hgrn_prep(LAS unsigned char* lds, const HgrnRaw& R, float lbv, int dir, int c, int I, int tid) {
    float ff[16], kk[16], qq[16];
    { const int e = tid, r = e >> 3, cch = e & 7; *(LAS u32x4*)(lds + HV + r * 144 + cch * 16) = R.v0; }
    { const int e = tid + NTHR, r = e >> 3, cch = e & 7; *(LAS u32x4*)(lds + HV + r * 144 + cch * 16) = R.v1; }
#pragma unroll
    for (int j = 0; j < 16; ++j) {
        const float fr = bfhi(R.qf[j]), qr = bflo(R.qf[j]);
        const float f = lbv + (1.f - lbv) * sigmoid_f(fr);
        ff[j] = f; kk[j] = 1.f - f; qq[j] = silu_f(qr);
    }
    float run = 1.f;
#pragma unroll
    for (int jj = 0; jj < 16; ++jj) { const int j = dir ? 15 - jj : jj; run = fmaxf(run * ff[j], 1e-30f); ff[j] = run; }
    const float PG = run;
    float kh[16];
#pragma unroll
    for (int j = 0; j < 16; ++j) {
        const float kt = kk[j] * __builtin_amdgcn_rcpf(ff[j]);
        kh[j] = kt * PG;
        *(LAS bf16_t*)(lds + HQ + (16 * I + j) * 272 + c * 2) = f2bf(qq[j] * ff[j]);
        *(LAS bf16_t*)(lds + HK + (16 * I + j) * 272 + c * 2) = f2bf(kt);
    }
    u32x4 w0, w1;
    w0.x = pk2(kh[0], kh[1]); w0.y = pk2(kh[2], kh[3]); w0.z = pk2(kh[4], kh[5]); w0.w = pk2(kh[6], kh[7]);
    w1.x = pk2(kh[8], kh[9]); w1.y = pk2(kh[10], kh[11]); w1.z = pk2(kh[12], kh[13]); w1.w = pk2(kh[14], kh[15]);
    *(LAS u32x4*)(lds + HKH + c * 144 + I * 32) = w0; *(LAS u32x4*)(lds + HKH + c * 144 + I * 32 + 16) = w1;
    *(LAS float*)(lds + HDV + (I * 128 + c) * 4) = PG;
}
DEVI void hgrn_update(LAS unsigned char* lds, f32x4 (&Sacc)[8], int I, int wid, int fr, int fq) {
    const int voff = (fq < 2) ? HV + (16 * wid + fr) * 144 + (16 * I + 8 * fq) * 2 : HZERO;
    const int koff = (fq < 2) ? HKH + fr * 144 + (16 * I + 8 * fq) * 2 : HZERO;
    const int kstep = (fq < 2) ? 16 * 144 : 0;
    const bf16x8 vb = *(const LAS bf16x8*)(lds + voff);
    bf16x8 ka[8]; f32x4 dv[8];
#pragma unroll
    for (int m = 0; m < 8; ++m) { ka[m] = *(const LAS bf16x8*)(lds + koff + m * kstep); dv[m] = *(const LAS f32x4*)(lds + HDV + (I * 128 + 16 * m + 4 * fq) * 4); }
#pragma unroll
    for (int m = 0; m < 8; ++m) Sacc[m] = __builtin_amdgcn_mfma_f32_16x16x32_bf16(ka[m], vb, Sacc[m] * dv[m], 0, 0, 0);
}
DEVI void stage_vt(LAS unsigned char* lds, const bf16_t* VT, int b, int h, int t0, int tid) {
    for (int e = tid; e < 128 * 8; e += NTHR) { const int r = e >> 3, cch = e & 7; *(LAS u32x4*)(lds + HV + r * 144 + cch * 16) = *(const u32x4*)(VT + ((size_t)b * 512 + h * 128 + r) * SEQ + t0 + cch * 8); }
}
DEVI void ph_hgrn_states(LAS unsigned char* lds, const bf16_t* u, const bf16_t* VT, const float* lbraw, float* HS, float* HD, int vb0, int vbs) {
    const int tid = opq((int)threadIdx.x), wid = __builtin_amdgcn_readfirstlane(tid >> 6), lane = tid & 63, fr = lane & 15, fq = lane >> 4;
    const int pc = tid & 127, pI = tid >> 7;
    for (int unit = vb0; unit < NB * 4 * 2 * 16; unit += vbs) {
        const int seg = unit & 15, dir = (unit >> 4) & 1, h = (unit >> 5) & 3, b = unit >> 7;
        const float lbv = lb_of(lbraw, h * 128 + pc);
        f32x4 Sacc[8];
#pragma unroll
        for (int m = 0; m < 8; ++m) Sacc[m] = (f32x4){0.f, 0.f, 0.f, 0.f};
        float gprod = 1.f;
        if (tid < 4) *(LAS unsigned*)(lds + HZERO + tid * 4) = 0u;
        HgrnRaw R; hgrn_load(R, u, VT, dir, b, h, seg * 256 + (dir ? 3 : 0) * 64, pc, pI, tid);
#pragma unroll 1
        for (int sbi = 0; sbi < 4; ++sbi) {
            const int sb = dir ? 3 - sbi : sbi;
            const int t0 = seg * 256 + sb * 64;
            __syncthreads();
            hgrn_prep(lds, R, lbv, dir, pc, pI, tid);
            if (sbi < 3) { const int sbn = dir ? 3 - (sbi + 1) : sbi + 1; hgrn_load(R, u, VT, dir, b, h, seg * 256 + sbn * 64, pc, pI, tid); }
            __syncthreads();
            if (tid < 128) gprod *= (*(const LAS float*)(lds + HDV + tid * 4) * *(const LAS float*)(lds + HDV + (128 + tid) * 4)) * (*(const LAS float*)(lds + HDV + (256 + tid) * 4) * *(const LAS float*)(lds + HDV + (384 + tid) * 4));
#pragma unroll 1
            for (int ii = 0; ii < 4; ++ii) { const int I = dir ? 3 - ii : ii; hgrn_update(lds, Sacc, I, wid, fr, fq); }
        }
        const size_t scan = (size_t)(b * 4 + h) * 2 + dir;
        float* dst = HS + scan * HS_SCAN + (size_t)seg * 16384;
#pragma unroll
        for (int m = 0; m < 8; ++m)
#pragma unroll
            for (int rg = 0; rg < 4; ++rg) dst[(16 * m + 4 * fq + rg) * 128 + 16 * wid + fr] = Sacc[m][rg];
        if (tid < 128) HD[(scan * 16 + seg) * 128 + tid] = gprod;
    }
    __syncthreads();
}
DEVI void ph_hgrn_scan(float* HS, const float* HD, int vb0, int vbs) {
    const int tid = opq((int)threadIdx.x);
    for (int idx = vb0 * NTHR + tid; idx < 32 * 4096; idx += vbs * NTHR) {
        const int scan = idx >> 12, e4 = idx & 4095, kch = e4 >> 5; const int dir = scan & 1;
        float4* base = (float4*)(HS + (size_t)scan * HS_SCAN) + e4;
        const float* hd = HD + (size_t)scan * 16 * 128 + kch;
        float4 d[16]; float dec[16];
#pragma unroll
        for (int i = 0; i < 16; ++i) { d[i] = base[(size_t)i * 4096]; dec[i] = hd[i * 128]; }
        float4 st = make_float4(0.f, 0.f, 0.f, 0.f);
        if (dir == 0) {
#pragma unroll
            for (int i = 0; i < 16; ++i) { const float4 t = d[i]; d[i] = st; st.x = st.x * dec[i] + t.x; st.y = st.y * dec[i] + t.y; st.z = st.z * dec[i] + t.z; st.w = st.w * dec[i] + t.w; }
        } else {
#pragma unroll
            for (int i = 15; i >= 0; --i) { const float4 t = d[i]; d[i] = st; st.x = st.x * dec[i] + t.x; st.y = st.y * dec[i] + t.y; st.z = st.z * dec[i] + t.z; st.w = st.w * dec[i] + t.w; }
        }
#pragma unroll
        for (int i = 0; i < 16; ++i) base[(size_t)i * 4096] = d[i];
    }
}
DEVI void ph_hgrn_out(LAS unsigned char* lds, const bf16_t* u, const bf16_t* VT, const float* lbraw, const float* a_norm, const float* HS, float* OF, bf16_t* ocat, int vb0, int vbs) {
    const int tid = opq((int)threadIdx.x), wid = __builtin_amdgcn_readfirstlane(tid >> 6), lane = tid & 63, fr = lane & 15, fq = lane >> 4;
    const int pc = tid & 127, pI = tid >> 7;
    const int otok = tid >> 3, opart = tid & 7;
    for (int unit = vb0; unit < NB * 4 * 16; unit += vbs) {
        const int seg = unit & 15, h = (unit >> 4) & 3, b = unit >> 6;
        const float lbv = lb_of(lbraw, h * 128 + pc);
        if (tid < 4) *(LAS unsigned*)(lds + HZERO + tid * 4) = 0u;
#pragma unroll 1
        for (int dir = 0; dir < 2; ++dir) {
            const size_t scan = (size_t)(b * 4 + h) * 2 + dir;
            const float* src = HS + scan * HS_SCAN + (size_t)seg * 16384;
            f32x4 Sacc[8];
#pragma unroll
            for (int m = 0; m < 8; ++m)
#pragma unroll
                for (int rg = 0; rg < 4; ++rg) Sacc[m][rg] = src[(16 * m + 4 * fq + rg) * 128 + 16 * wid + fr];
            HgrnRaw R; hgrn_load(R, u, VT, dir, b, h, seg * 256 + (dir ? 3 : 0) * 64, pc, pI, tid);
#pragma unroll 1
            for (int sbi = 0; sbi < 4; ++sbi) {
                const int sb = dir ? 3 - sbi : sbi;
                const int t0 = seg * 256 + sb * 64;
                const size_t tokb = (size_t)b * SEQ + t0;
                __syncthreads();
                hgrn_prep(lds, R, lbv, dir, pc, pI, tid);
                if (sbi < 3) { const int sbn = dir ? 3 - (sbi + 1) : sbi + 1; hgrn_load(R, u, VT, dir, b, h, seg * 256 + sbn * 64, pc, pI, tid); }
                __syncthreads();
#pragma unroll 1
                for (int ii = 0; ii < 4; ++ii) {
                    const int I = dir ? 3 - ii : ii;
                    f32x4 oT = {0.f, 0.f, 0.f, 0.f};
                    const LAS unsigned char* qrow = lds + HQ + (16 * I + fr) * 272;
#pragma unroll
                    for (int ks = 0; ks < 4; ++ks) {
                        u32x4 sa; sa.x = pg8::cvt_pk_bf16(Sacc[2 * ks][0], Sacc[2 * ks][1]); sa.y = pg8::cvt_pk_bf16(Sacc[2 * ks][2], Sacc[2 * ks][3]);
                        sa.z = pg8::cvt_pk_bf16(Sacc[2 * ks + 1][0], Sacc[2 * ks + 1][1]); sa.w = pg8::cvt_pk_bf16(Sacc[2 * ks + 1][2], Sacc[2 * ks + 1][3]);
                        const u32x2 q0 = *(const LAS u32x2*)(qrow + (32 * ks + 4 * fq) * 2), q1 = *(const LAS u32x2*)(qrow + (32 * ks + 16 + 4 * fq) * 2);
                        u32x4 qb; qb.x = q0.x; qb.y = q0.y; qb.z = q1.x; qb.w = q1.y;
                        oT = __builtin_amdgcn_mfma_f32_16x16x32_bf16(__builtin_bit_cast(bf16x8, sa), __builtin_bit_cast(bf16x8, qb), oT, 0, 0, 0);
                    }
                    f32x4 sT = {0.f, 0.f, 0.f, 0.f};
                    const LAS unsigned char* krow = lds + HK + (16 * I + fr) * 272;
#pragma unroll
                    for (int ks = 0; ks < 4; ++ks) {
                        const bf16x8 ka = *(const LAS bf16x8*)(krow + (32 * ks + 8 * fq) * 2), qb = *(const LAS bf16x8*)(qrow + (32 * ks + 8 * fq) * 2);
                        sT = __builtin_amdgcn_mfma_f32_16x16x32_bf16(ka, qb, sT, 0, 0, 0);
                    }
                    float pv[4];
#pragma unroll
                    for (int rg = 0; rg < 4; ++rg) { const int sl = 4 * fq + rg; const bool ok = dir ? (sl >= fr) : (sl <= fr); pv[rg] = ok ? sT[rg] : 0.f; }
                    u32x4 pb; pb.x = pg8::cvt_pk_bf16(pv[0], pv[1]); pb.y = pg8::cvt_pk_bf16(pv[2], pv[3]); pb.z = 0u; pb.w = 0u;
                    const u32x2 v0 = *(const LAS u32x2*)(lds + HV + (16 * wid + fr) * 144 + (16 * I + 4 * fq) * 2);
                    u32x4 va; va.x = v0.x; va.y = v0.y; va.z = 0u; va.w = 0u;
                    oT = __builtin_amdgcn_mfma_f32_16x16x32_bf16(__builtin_bit_cast(bf16x8, va), __builtin_bit_cast(bf16x8, pb), oT, 0, 0, 0);
                    if (dir == 0) *(f32x4*)(OF + (tokb + 16 * I + fr) * 512 + h * 128 + 16 * wid + 4 * fq) = oT;
                    else *(LAS f32x4*)(lds + HOT + (16 * I + fr) * 528 + (16 * wid + 4 * fq) * 4) = oT;
                    hgrn_update(lds, Sacc, I, wid, fr, fq);
                }
                if (dir == 1) {
                    __syncthreads();
                    const LAS float* orow = (const LAS float*)(lds + HOT + otok * 528) + opart * 16;
                    float* ofp = OF + (tokb + otok) * 512 + h * 128 + opart * 16;
                    float v[16]; float ss = 0.f;
#pragma unroll
                    for (int q2 = 0; q2 < 8; ++q2) { const unsigned long long w = __hip_atomic_load((unsigned long long*)(ofp + q2 * 2), __ATOMIC_RELAXED, __HIP_MEMORY_SCOPE_AGENT);
                        v[2 * q2] = __uint_as_float((unsigned)w) + orow[2 * q2]; v[2 * q2 + 1] = __uint_as_float((unsigned)(w >> 32)) + orow[2 * q2 + 1];
                        ss += v[2 * q2] * v[2 * q2] + v[2 * q2 + 1] * v[2 * q2 + 1]; }
                    ss += __shfl_xor(ss, 1); ss += __shfl_xor(ss, 2); ss += __shfl_xor(ss, 4);
                    const float rn = rsqrtf(ss * (1.f / 128.f) + EPS);
                    const bf16_t* gp = u + (tokb + otok) * UW + 2048 + h * 128 + opart * 16;
                    const u32x4 g0 = *(const u32x4*)gp, g1 = *(const u32x4*)(gp + 8);
                    const unsigned gw[8] = {g0.x, g0.y, g0.z, g0.w, g1.x, g1.y, g1.z, g1.w};
                    unsigned ow[8];
#pragma unroll
                    for (int q2 = 0; q2 < 8; ++q2) { const float an0 = a_norm[opart * 16 + 2 * q2], an1 = a_norm[opart * 16 + 2 * q2 + 1];
                        ow[q2] = pk2(v[2 * q2] * rn * an0 * silu_f(bflo(gw[q2])), v[2 * q2 + 1] * rn * an1 * silu_f(bfhi(gw[q2]))); }
                    bf16_t* op = ocat + (tokb + otok) * DM + h * 128 + opart * 16;
                    u32x4 o0, o1; o0.x = ow[0]; o0.y = ow[1]; o0.z = ow[2]; o0.w = ow[3]; o1.x = ow[4]; o1.y = ow[5]; o1.z = ow[6]; o1.w = ow[7];
                    *(u32x4*)op = o0; *(u32x4*)(op + 8) = o1;
                }
            }
            asm volatile("s_waitcnt vmcnt(0)" ::: "memory");
        }
    }
    __syncthreads();
}

DEVI void ph_prep(const bf16_t* u, const float* cw, const float* cb, bf16_t* xconv, bf16_t* XT, bf16_t* VT, int vb0, int vbs) {
    const int tid = opq((int)threadIdx.x);
    for (int unit = vb0; unit < NB * 32 * 3; unit += vbs) {
        const int cg = unit % 3, tb = (unit / 3) & 31, b = unit / 96;
        const int t0 = tb * 128;
        if (cg < 2) {
            const int ch = cg * 512 + tid;
            float w[5];
#pragma unroll
            for (int j = 0; j < 5; ++j) w[j] = cw[j * 1024 + ch];
            const float bias = cb[ch];
            const bf16_t* up = u + (size_t)b * SEQ * UW + 3072 + ch;
            float v0, v1, v2, v3;
            v0 = (t0 - 2 >= 0) ? bf2f(up[(size_t)(t0 - 2) * UW]) : 0.f;
            v1 = (t0 - 1 >= 0) ? bf2f(up[(size_t)(t0 - 1) * UW]) : 0.f;
            v2 = bf2f(up[(size_t)t0 * UW]);
            v3 = bf2f(up[(size_t)(t0 + 1) * UW]);
            for (int t8 = 0; t8 < 128; t8 += 32) {
                float nx[32];
#pragma unroll
                for (int i = 0; i < 32; ++i) { const int tt = t0 + t8 + i + 2; nx[i] = (tt < SEQ) ? bf2f(up[(size_t)tt * UW]) : 0.f; }
                unsigned pk[16];
#pragma unroll
                for (int i = 0; i < 32; ++i) {
                    const float o = silu_f(bias + w[0] * v0 + w[1] * v1 + w[2] * v2 + w[3] * v3 + w[4] * nx[i]);
                    const bf16_t ob = f2bf(o);
                    xconv[(size_t)(b * SEQ + t0 + t8 + i) * 1024 + ch] = ob;
                    if (i & 1) pk[i >> 1] |= ((unsigned)ob << 16); else pk[i >> 1] = ob;
                    v0 = v1; v1 = v2; v2 = v3; v3 = nx[i];
                }
                if (ch < 768) {
#pragma unroll
                    for (int q = 0; q < 4; ++q) { u32x4 o4; o4.x = pk[4 * q]; o4.y = pk[4 * q + 1]; o4.z = pk[4 * q + 2]; o4.w = pk[4 * q + 3]; *(u32x4*)(XT + ((size_t)b * 768 + ch) * SEQ + t0 + t8 + 8 * q) = o4; } }
            }
        } else {
            const int ch = tid;
            const bf16_t* up = u + (size_t)b * SEQ * UW + 1536 + ch;
            for (int t8 = 0; t8 < 128; t8 += 32) {
                unsigned pk[16];
#pragma unroll
                for (int i = 0; i < 32; ++i) { const unsigned ob = up[(size_t)(t0 + t8 + i) * UW]; if (i & 1) pk[i >> 1] |= (ob << 16); else pk[i >> 1] = ob; }
#pragma unroll
                for (int q = 0; q < 4; ++q) { u32x4 o4; o4.x = pk[4 * q]; o4.y = pk[4 * q + 1]; o4.z = pk[4 * q + 2]; o4.w = pk[4 * q + 3]; *(u32x4*)(VT + ((size_t)b * 512 + ch) * SEQ + t0 + t8 + 8 * q) = o4; }
            }
        }
    }
}

constexpr int MB_XT = 0, MB_BX = 256 * 272, MB_DT = MB_BX + 128 * 272, MB_CS = MB_DT + 8 * 128 * 4, MB_TOT = MB_CS + 8 * 128 * 4, MB_END = MB_TOT + 64;
static_assert(MB_END <= 131072, "mamba lds");
constexpr size_t MS_SCAN = (size_t)32 * 8192;
DEVI bf16x8 pack8(const float* v) { u32x4 w; w.x = pg8::cvt_pk_bf16(v[0], v[1]); w.y = pg8::cvt_pk_bf16(v[2], v[3]); w.z = pg8::cvt_pk_bf16(v[4], v[5]); w.w = pg8::cvt_pk_bf16(v[6], v[7]); return __builtin_bit_cast(bf16x8, w); }
DEVI void mamba_tables(LAS unsigned char* lds, const float* dtraw, const float* A_log, const float* dt_bias, int b, int g, int c, int wid, int lane) {
    LAS float* tdt = (LAS float*)(lds + MB_DT); LAS float* tcs = (LAS float*)(lds + MB_CS); LAS float* ttot = (LAS float*)(lds + MB_TOT);
    const int r = wid >> 1, dir = wid & 1, hd = 4 * g + r;
    const float A = -__expf(A_log[dir * 8 + hd]), bias = dt_bias[dir * 8 + hd];
    const size_t tk = (size_t)b * SEQ + c * 128 + 2 * lane;
    const float dt0 = softplus_f(dtraw[tk * 16 + dir * 8 + hd] + bias), dt1 = softplus_f(dtraw[(tk + 1) * 16 + dir * 8 + hd] + bias);
    const float a0 = dt0 * A, a1 = dt1 * A;
    float sc = a0 + a1;
#pragma unroll
    for (int off = 1; off < 64; off <<= 1) { const float v = __shfl_up(sc, off); if (lane >= off) sc += v; }
    const float total = __shfl(sc, 63);
    const float pre0 = sc - a1, pre1 = sc;
    const float c0 = dir ? (total - pre0 + a0) : pre0, c1 = dir ? (total - pre1 + a1) : pre1;
    tdt[wid * 128 + 2 * lane] = dt0; tdt[wid * 128 + 2 * lane + 1] = dt1;
    tcs[wid * 128 + 2 * lane] = c0; tcs[wid * 128 + 2 * lane + 1] = c1;
    if (lane == 0) ttot[wid] = total;
}
DEVI void stage_rows(LAS unsigned char* dst, const bf16_t* src, size_t src_stride, int rows, int tid) {
    for (int e = tid; e < rows * 16; e += NTHR) { const int r = e >> 4, cch = e & 15; *(LAS u32x4*)(dst + r * 272 + cch * 16) = *(const u32x4*)(src + (size_t)r * src_stride + cch * 8); }
}
DEVI void ph_mamba_states(LAS unsigned char* lds, const bf16_t* XT, const float* dtraw, const float* A_log, const float* dt_bias, float* MS, float* MD, int vb0, int vbs) {
    const int tid = opq((int)threadIdx.x), wid = __builtin_amdgcn_readfirstlane(tid >> 6), lane = tid & 63, fr = lane & 15, fq = lane >> 4;
    LAS float* tdt = (LAS float*)(lds + MB_DT); LAS float* tcs = (LAS float*)(lds + MB_CS); LAS float* ttot = (LAS float*)(lds + MB_TOT);
    for (int unit = vb0; unit < NB * 2 * 32; unit += vbs) {
        const int c = unit & 31, g = (unit >> 5) & 1, b = unit >> 6;
        __syncthreads();
        stage_rows(lds + MB_XT, XT + ((size_t)b * 768 + g * 256) * SEQ + c * 128, SEQ, 256, tid);
        stage_rows(lds + MB_BX, XT + ((size_t)b * 768 + 512 + g * 128) * SEQ + c * 128, SEQ, 128, tid);
        mamba_tables(lds, dtraw, A_log, dt_bias, b, g, c, wid, lane);
        __syncthreads();
        if (lane == 0) MD[((size_t)(b * 8 + 4 * g + (wid >> 1)) * 2 + (wid & 1)) * 32 + c] = __expf(ttot[wid]);
        for (int hdd = 0; hdd < 8; ++hdd) {
            const int r = hdd >> 1, dir = hdd & 1, hd = 4 * g + r;
            const float tot = ttot[hdd];
            f32x4 acc[4];
#pragma unroll
            for (int pt = 0; pt < 4; ++pt) acc[pt] = (f32x4){0.f, 0.f, 0.f, 0.f};
#pragma unroll
            for (int ks = 0; ks < 4; ++ks) {
                const int s0 = 32 * ks + 8 * fq;
                const u32x4 braw = *(const LAS u32x4*)(lds + MB_BX + (16 * wid + fr) * 272 + s0 * 2);
                float bw[8];
                const unsigned bu[4] = {braw.x, braw.y, braw.z, braw.w};
#pragma unroll
                for (int j = 0; j < 8; ++j) { const float bv = (j & 1) ? bfhi(bu[j >> 1]) : bflo(bu[j >> 1]);
                    bw[j] = bv * tdt[hdd * 128 + s0 + j] * __expf(tot - tcs[hdd * 128 + s0 + j]); }
                const bf16x8 Bf = pack8(bw);
#pragma unroll
                for (int pt = 0; pt < 4; ++pt) {
                    const bf16x8 Af = *(const LAS bf16x8*)(lds + MB_XT + (r * 64 + 16 * pt + fr) * 272 + s0 * 2);
                    acc[pt] = __builtin_amdgcn_mfma_f32_16x16x32_bf16(Af, Bf, acc[pt], 0, 0, 0);
                }
            }
            float* dst = MS + ((size_t)(b * 8 + hd) * 2 + dir) * MS_SCAN + (size_t)c * 8192;
#pragma unroll
            for (int pt = 0; pt < 4; ++pt)
#pragma unroll
                for (int rg = 0; rg < 4; ++rg) dst[(16 * pt + 4 * fq + rg) * 128 + 16 * wid + fr] = acc[pt][rg];
        }
    }
    __syncthreads();
}
DEVI void ph_mamba_scan(float* MS, const float* MD, int vb0, int vbs) {
    const int tid = opq((int)threadIdx.x);
    for (int idx = vb0 * NTHR + tid; idx < 64 * 2048; idx += vbs * NTHR) {
        const int scan = idx >> 11, e4 = idx & 2047; const int dir = scan & 1;
        float4* base = (float4*)(MS + (size_t)scan * MS_SCAN) + e4;
        const float* md = MD + (size_t)scan * 32;
        float4 h = make_float4(0.f, 0.f, 0.f, 0.f);
#pragma unroll 1
        for (int half = 0; half < 2; ++half) {
            const int c0 = (dir ? 1 - half : half) * 16;
            float4 d[16]; float dec[16];
#pragma unroll
            for (int i = 0; i < 16; ++i) { d[i] = base[(size_t)(c0 + i) * 2048]; dec[i] = md[c0 + i]; }
            if (dir == 0) {
#pragma unroll
                for (int i = 0; i < 16; ++i) { const float4 t = d[i]; d[i] = h; h.x = h.x * dec[i] + t.x; h.y = h.y * dec[i] + t.y; h.z = h.z * dec[i] + t.z; h.w = h.w * dec[i] + t.w; }
            } else {
#pragma unroll
                for (int i = 15; i >= 0; --i) { const float4 t = d[i]; d[i] = h; h.x = h.x * dec[i] + t.x; h.y = h.y * dec[i] + t.y; h.z = h.z * dec[i] + t.z; h.w = h.w * dec[i] + t.w; }
            }
#pragma unroll
            for (int i = 0; i < 16; ++i) base[(size_t)(c0 + i) * 2048] = d[i];
        }
    }
}
DEVI void ph_mamba_out(LAS unsigned char* lds, const bf16_t* u, const bf16_t* xconv, const bf16_t* XT, const float* dtraw, const float* A_log, const float* dt_bias, const float* Dskip, const float* b_norm,
                       const float* MS, bf16_t* ocat, int vb0, int vbs) {
    const int tid = opq((int)threadIdx.x), wid = __builtin_amdgcn_readfirstlane(tid >> 6), lane = tid & 63, fr = lane & 15, fq = lane >> 4;
    LAS float* tdt = (LAS float*)(lds + MB_DT); LAS float* tcs = (LAS float*)(lds + MB_CS);
    for (int unit = vb0; unit < NB * 2 * 32; unit += vbs) {
        const int c = unit & 31, g = (unit >> 5) & 1, b = unit >> 6;
        const size_t tok0 = (size_t)b * SEQ + c * 128;
        __syncthreads();
        stage_rows(lds + MB_XT, XT + ((size_t)b * 768 + g * 256) * SEQ + c * 128, SEQ, 256, tid);
        stage_rows(lds + MB_BX, xconv + tok0 * 1024 + 512 + g * 128, 1024, 128, tid);
        mamba_tables(lds, dtraw, A_log, dt_bias, b, g, c, wid, lane);
        const int tl = 16 * wid + fr;
        bf16x8 Cf[4];
#pragma unroll
        for (int ks = 0; ks < 4; ++ks) Cf[ks] = *(const bf16x8*)(xconv + (tok0 + tl) * 1024 + 768 + g * 128 + 32 * ks + 8 * fq);
        __syncthreads();
        f32x4 GT[8];
#pragma unroll
        for (int st = 0; st < 8; ++st) { GT[st] = (f32x4){0.f, 0.f, 0.f, 0.f};
            bf16x8 Af[4];
#pragma unroll
            for (int ks = 0; ks < 4; ++ks) Af[ks] = *(const LAS bf16x8*)(lds + MB_BX + (16 * st + fr) * 272 + (32 * ks + 8 * fq) * 2);
#pragma unroll
            for (int ks = 0; ks < 4; ++ks) GT[st] = __builtin_amdgcn_mfma_f32_16x16x32_bf16(Af[ks], Cf[ks], GT[st], 0, 0, 0); }
        float ss = 0.f;
        __syncthreads();
        float4 hpre[4];
        { const float* hin0 = MS + ((size_t)(b * 8 + 4 * g) * 2) * MS_SCAN + (size_t)c * 8192;
#pragma unroll
          for (int q = 0; q < 4; ++q) hpre[q] = ((const float4*)hin0)[tid + q * NTHR]; }
#pragma unroll 1
        for (int r = 0; r < 4; ++r) {
            const int hd = 4 * g + r;
            f32x4 yv[4];
#pragma unroll
            for (int pt = 0; pt < 4; ++pt) yv[pt] = (f32x4){0.f, 0.f, 0.f, 0.f};
#pragma unroll 1
            for (int dir = 0; dir < 2; ++dir) {
                const int hdd = r * 2 + dir;
                const float cst = tcs[hdd * 128 + tl];
                LAS unsigned char* hbuf = lds + MB_BX + (hdd & 1) * 17408;
#pragma unroll
                for (int q = 0; q < 4; ++q) { const int e4 = tid + q * NTHR, pp = e4 >> 5, n4 = (e4 & 31) * 4;
                    u32x2 w; w.x = pk2(hpre[q].x, hpre[q].y); w.y = pk2(hpre[q].z, hpre[q].w); *(LAS u32x2*)(hbuf + pp * 272 + n4 * 2) = w; }
                if (hdd < 7) { const int hn = hdd + 1; const float* hinn = MS + ((size_t)(b * 8 + 4 * g + (hn >> 1)) * 2 + (hn & 1)) * MS_SCAN + (size_t)c * 8192;
#pragma unroll
                    for (int q = 0; q < 4; ++q) hpre[q] = ((const float4*)hinn)[tid + q * NTHR]; }
                __syncthreads();
                f32x4 yo[4];
#pragma unroll
                for (int pt = 0; pt < 4; ++pt) { yo[pt] = (f32x4){0.f, 0.f, 0.f, 0.f};
                    bf16x8 hf[4];
#pragma unroll
                    for (int ks = 0; ks < 4; ++ks) hf[ks] = *(const LAS bf16x8*)(hbuf + (16 * pt + fr) * 272 + (32 * ks + 8 * fq) * 2);
#pragma unroll
                    for (int ks = 0; ks < 4; ++ks) yo[pt] = __builtin_amdgcn_mfma_f32_16x16x32_bf16(hf[ks], Cf[ks], yo[pt], 0, 0, 0); }
                const float eo = __expf(cst);
#pragma unroll
                for (int pt = 0; pt < 4; ++pt) yv[pt] += yo[pt] * eo;
#pragma unroll
                for (int kp = 0; kp < 4; ++kp) {
                    const bool skip = dir ? (2 * kp + 1 < wid) : (2 * kp > wid);
                    if (!skip) {
                        float pv[8];
#pragma unroll
                        for (int hlf = 0; hlf < 2; ++hlf) { const int st = 2 * kp + hlf;
                            const f32x4 cs4 = *(const LAS f32x4*)(tcs + hdd * 128 + 16 * st + 4 * fq), dt4 = *(const LAS f32x4*)(tdt + hdd * 128 + 16 * st + 4 * fq);
#pragma unroll
                            for (int rg = 0; rg < 4; ++rg) { const int sl = 16 * st + 4 * fq + rg;
                                const bool ok = dir ? (sl >= tl) : (sl <= tl);
                                const float e = __expf(fminf(cst - cs4[rg], 0.f));
                                pv[hlf * 4 + rg] = ok ? GT[st][rg] * e * dt4[rg] : 0.f; } }
                        u32x2 x0[4], x1[4];
#pragma unroll
                        for (int pt = 0; pt < 4; ++pt) { const LAS unsigned char* xr = lds + MB_XT + (r * 64 + 16 * pt + fr) * 272;
                            x0[pt] = *(const LAS u32x2*)(xr + (32 * kp + 4 * fq) * 2); x1[pt] = *(const LAS u32x2*)(xr + (32 * kp + 16 + 4 * fq) * 2); }
                        const bf16x8 Pf = pack8(pv);
#pragma unroll
                        for (int pt = 0; pt < 4; ++pt) {
                            u32x4 xa; xa.x = x0[pt].x; xa.y = x0[pt].y; xa.z = x1[pt].x; xa.w = x1[pt].y;
                            yv[pt] = __builtin_amdgcn_mfma_f32_16x16x32_bf16(__builtin_bit_cast(bf16x8, xa), Pf, yv[pt], 0, 0, 0);
                        }
                    }
                }
            }
            const float Dk = Dskip[hd];
#pragma unroll
            for (int pt = 0; pt < 4; ++pt) {
                const int p0 = 16 * pt + 4 * fq;
                const u32x2 xr = *(const u32x2*)(xconv + (tok0 + tl) * 1024 + hd * 64 + p0);
                const u32x2 zr = *(const u32x2*)(u + (tok0 + tl) * UW + 2560 + hd * 64 + p0);
                const float xs[4] = {bflo(xr.x), bfhi(xr.x), bflo(xr.y), bfhi(xr.y)}, zs[4] = {bflo(zr.x), bfhi(zr.x), bflo(zr.y), bfhi(zr.y)};
                float yy[4];
#pragma unroll
                for (int rg = 0; rg < 4; ++rg) { const float y = (yv[pt][rg] + Dk * xs[rg]) * silu_f(zs[rg]); yy[rg] = y; ss += y * y; }
                const unsigned long long o = (unsigned long long)pk2(yy[0], yy[1]) | ((unsigned long long)pk2(yy[2], yy[3]) << 32);
                __hip_atomic_store((unsigned long long*)(ocat + (tok0 + tl) * DM + 512 + g * 256 + r * 64 + p0), o, __ATOMIC_RELAXED, __HIP_MEMORY_SCOPE_AGENT);
            }
        }
        ss += __shfl_xor(ss, 16); ss += __shfl_xor(ss, 32);
        const float rn = rsqrtf(ss * (1.f / 256.f) + EPS);
        asm volatile("s_waitcnt vmcnt(0)" ::: "memory");
        unsigned long long pk[16];
#pragma unroll
        for (int q = 0; q < 16; ++q) pk[q] = __hip_atomic_load((unsigned long long*)(ocat + (tok0 + tl) * DM + 512 + g * 256 + (q >> 2) * 64 + 16 * (q & 3) + 4 * fq), __ATOMIC_RELAXED, __HIP_MEMORY_SCOPE_AGENT);
#pragma unroll
        for (int r = 0; r < 4; ++r)
#pragma unroll
            for (int pt = 0; pt < 4; ++pt) {
                const int cc = g * 256 + r * 64 + 16 * pt + 4 * fq;
                unsigned long long* op = (unsigned long long*)(ocat + (tok0 + tl) * DM + 512 + cc);
                const unsigned long long v = pk[r * 4 + pt];
                const unsigned vlo = (unsigned)v, vhi = (unsigned)(v >> 32);
                const float4 bn = *(const float4*)(b_norm + cc);
                const unsigned long long o = (unsigned long long)pk2(bflo(vlo) * rn * bn.x, bfhi(vlo) * rn * bn.y) | ((unsigned long long)pk2(bflo(vhi) * rn * bn.z, bfhi(vhi) * rn * bn.w) << 32);
                *op = o;
            }
    }
    __syncthreads();
}


constexpr int NA_RING = 12, NA_VT = 0, NA_VSTRIDE = NA_RING * 64 * 2 + 16, NA_BIAS = 64 * NA_VSTRIDE, NA_END = NA_BIAS + 480 * 4;
static_assert(NA_END <= 131072, "na lds");
DEVI void ph_na(LAS unsigned char* lds, const bf16_t* qkv, const float* rpb, bf16_t* oc, int vb0, int vbs) {
    const int tid = opq((int)threadIdx.x), wid = __builtin_amdgcn_readfirstlane(tid >> 6), lane = tid & 63, fr = lane & 15, fq = lane >> 4;
    LAS float* bl = (LAS float*)(lds + NA_BIAS);
    for (int chunk = vb0; chunk < NB * 16 * 4; chunk += vbs) {
        const int qr4 = chunk & 3, h = (chunk >> 2) & 15, b = chunk >> 6;
        __syncthreads();
        for (int e = tid; e < 465; e += NTHR) bl[e] = rpb[h * 465 + e];
        int staged_hi = -1;
#pragma unroll 1
        for (int ui = 0; ui < 8; ++ui) {
            const int rp = qr4 * 8 + ui;
            const int r0 = 2 * rp, rs0 = min(max(r0 - 4, 0), 56);
            const int need_hi = min(rs0 + 8, 63);
            const int lo = max(staged_hi + 1, rs0);
            for (int task = wid; task < (need_hi - lo + 1) * 8; task += 8) {
                const int kr = lo + (task >> 3), ch = task & 7, slot = kr % NA_RING;
                const u32x4 v = *(const u32x4*)(qkv + ((size_t)b * SEQ + kr * 64 + lane) * 3072 + 2048 + h * 64 + ch * 8);
                const unsigned vw[4] = {v.x, v.y, v.z, v.w};
#pragma unroll
                for (int i = 0; i < 8; ++i) *(LAS bf16_t*)(lds + NA_VT + (ch * 8 + i) * NA_VSTRIDE + (slot * 64 + lane) * 2) = (bf16_t)((i & 1) ? (vw[i >> 1] >> 16) : (vw[i >> 1] & 0xffffu));
            }
            staged_hi = need_hi > staged_hi ? need_hi : staged_hi;
            __syncthreads();
            const int r = r0 + (wid >> 2), j = wid & 3;
            const int rs = min(max(r - 4, 0), 56);
            const int bs = (j == 0) ? 0 : (j == 1) ? 8 : (j == 2) ? 24 : 32;
            const int c = 16 * j + fr, qs = min(max(c - 8, 0), 48);
            const size_t qtok = (size_t)b * SEQ + r * 64 + c;
            bf16x8 Qf[2];
#pragma unroll
            for (int ks = 0; ks < 2; ++ks) Qf[ks] = *(const bf16x8*)(qkv + qtok * 3072 + h * 64 + 32 * ks + 8 * fq);
            const bf16_t* kbase = qkv + ((size_t)b * SEQ + rs * 64 + bs + fr) * 3072 + 1024 + h * 64 + 8 * fq;
            bf16x8 kn[4];
#pragma unroll
            for (int q = 0; q < 4; ++q) kn[q] = *(const bf16x8*)(kbase + (size_t)((q >> 1) * 16) * 3072 + (q & 1) * 32);
            f32x4 O[4];
#pragma unroll
            for (int dt = 0; dt < 4; ++dt) O[dt] = (f32x4){0.f, 0.f, 0.f, 0.f};
            float mrun = -1e30f, lrun = 0.f;
#pragma unroll 1
            for (int dr = 0; dr < 8; ++dr) {
                bf16x8 kc[4];
#pragma unroll
                for (int q = 0; q < 4; ++q) kc[q] = kn[q];
                const int drn = dr < 7 ? dr + 1 : 7;
#pragma unroll
                for (int q = 0; q < 4; ++q) kn[q] = *(const bf16x8*)(kbase + ((size_t)drn * 64 + (q >> 1) * 16) * 3072 + (q & 1) * 32);
                float sv[8]; float mloc = -1e30f;
                const LAS float* brow = bl + (rs + dr - r + 7) * 31;
#pragma unroll
                for (int kg = 0; kg < 2; ++kg) {
                    f32x4 acc = {0.f, 0.f, 0.f, 0.f};
                    acc = __builtin_amdgcn_mfma_f32_16x16x32_bf16(kc[kg * 2], Qf[0], acc, 0, 0, 0);
                    acc = __builtin_amdgcn_mfma_f32_16x16x32_bf16(kc[kg * 2 + 1], Qf[1], acc, 0, 0, 0);
#pragma unroll
                    for (int rg = 0; rg < 4; ++rg) {
                        const int kcol = bs + 16 * kg + 4 * fq + rg;
                        const bool ok = (kcol >= qs) && (kcol < qs + 16);
                        const int dc = min(max(kcol - c + 15, 0), 30);
                        const float sc = ok ? acc[rg] * 0.125f + brow[dc] : -1e30f;
                        sv[kg * 4 + rg] = sc; mloc = fmaxf(mloc, sc);
                    }
                }
                mloc = fmaxf(mloc, __shfl_xor(mloc, 16)); mloc = fmaxf(mloc, __shfl_xor(mloc, 32));
                const float mnew = fmaxf(mrun, mloc);
                const float alpha = __expf(mrun - mnew);
                float psum = 0.f;
#pragma unroll
                for (int i = 0; i < 8; ++i) { const float p = __expf(sv[i] - mnew); sv[i] = p; psum += p; }
                psum += __shfl_xor(psum, 16); psum += __shfl_xor(psum, 32);
                lrun = lrun * alpha + psum; mrun = mnew;
                const bf16x8 Pf = pack8(sv);
                const int koff = (((rs + dr) % NA_RING) * 64 + bs + 4 * fq) * 2;
#pragma unroll
                for (int dt = 0; dt < 4; ++dt) {
                    const LAS unsigned char* vr = lds + NA_VT + (16 * dt + fr) * NA_VSTRIDE + koff;
                    const u32x2 v0 = *(const LAS u32x2*)vr, v1 = *(const LAS u32x2*)(vr + 32);
                    u32x4 va; va.x = v0.x; va.y = v0.y; va.z = v1.x; va.w = v1.y;
                    O[dt] = __builtin_amdgcn_mfma_f32_16x16x32_bf16(__builtin_bit_cast(bf16x8, va), Pf, O[dt] * alpha, 0, 0, 0);
                }
            }
            const float il = 1.f / lrun;
#pragma unroll
            for (int dt = 0; dt < 4; ++dt) {
                u32x2 o; o.x = pk2(O[dt][0] * il, O[dt][1] * il); o.y = pk2(O[dt][2] * il, O[dt][3] * il);
                *(u32x2*)(oc + qtok * DM + h * 64 + 16 * dt + 4 * fq) = o;
            }
        }
    }
    __syncthreads();
}

DEVI void ph_na_naive(const bf16_t* qkv, const float* rpb, bf16_t* oc, int vb0, int vbs) {
    for (int e4 = vb0 * NTHR + opq((int)threadIdx.x); e4 < MT * 16 * 4; e4 += vbs * NTHR) {
        const int dq = e4 & 3, e = e4 >> 2;
        const int hd = e / MT, tok = e % MT;
        const int b = tok >> 12, t = tok & 4095, r = t >> 6, c = t & 63;
        const int rs = min(max(r - 4, 0), 56), qs = min(max(c - 8, 0), 48);
        float q[16], o[16];
        const bf16_t* qp = qkv + (size_t)tok * 3072 + hd * 64 + dq * 16;
#pragma unroll
        for (int d = 0; d < 16; ++d) { q[d] = bf2f(qp[d]); o[d] = 0.f; }
        float m = -1e30f, l = 0.f;
        for (int dr = 0; dr < 8; ++dr)
            for (int dc = 0; dc < 16; ++dc) {
                const int kr = rs + dr, kc = qs + dc;
                const size_t kt = (size_t)b * SEQ + kr * 64 + kc;
                const bf16_t* kp = qkv + kt * 3072 + 1024 + hd * 64 + dq * 16;
                const bf16_t* vp = qkv + kt * 3072 + 2048 + hd * 64 + dq * 16;
                float s = 0.f;
#pragma unroll
                for (int d = 0; d < 16; ++d) s += q[d] * bf2f(kp[d]);
                s += __shfl_xor(s, 1); s += __shfl_xor(s, 2);
                s = s * 0.125f + rpb[hd * 465 + (kr - r + 7) * 31 + (kc - c + 15)];
                const float mn = fmaxf(m, s); const float al = __expf(m - mn), pe = __expf(s - mn);
                l = l * al + pe; m = mn;
#pragma unroll
                for (int d = 0; d < 16; ++d) o[d] = o[d] * al + pe * bf2f(vp[d]);
            }
        const float il = 1.f / l;
        bf16_t* op = oc + (size_t)tok * DM + hd * 64 + dq * 16;
#pragma unroll
        for (int d = 0; d < 16; ++d) op[d] = f2bf(o[d] * il);
    }
}

#define XB_TMO      128
#define XB_XCNT(j)  (256  + 64 * (j))
#define XB_XSUB(j)  (1280 + 64 * (j))
#define XB_XGEN(j)  (2304 + 64 * (j))
#define XB_TOP      3328
#define XB_TOPGEN   3392
#define XCD_BAR_WORDS 3456
#define XB_SPIN_CAP (1u << 18)

__device__ __forceinline__ unsigned xb_ld(unsigned* p)              { return __hip_atomic_load(p, __ATOMIC_RELAXED, __HIP_MEMORY_SCOPE_AGENT); }
__device__ __forceinline__ unsigned xb_add(unsigned* p, unsigned v) { return __hip_atomic_fetch_add(p, v, __ATOMIC_RELAXED, __HIP_MEMORY_SCOPE_AGENT); }
__device__ __forceinline__ unsigned xb_xcc_id() { return (unsigned)__builtin_amdgcn_s_getreg((3 << 11) | 20) & 0xFu; }
#define XB_SPIN(cond, bar) do { unsigned _sp = 0; while (cond) { __builtin_amdgcn_s_sleep(1); \
    if ((++_sp & 255u) == 0u) { if (xb_ld(&(bar)[XB_TMO])) break; if (_sp > XB_SPIN_CAP) { atomicAdd(&(bar)[XB_TMO], 1u); break; } } } } while (0)

struct XcdBarrier {
    unsigned* bar; unsigned x;
    volatile LAS unsigned* st;
};

__device__ __forceinline__ XcdBarrier xcd_barrier_post(unsigned* bar, volatile LAS unsigned* st) {
    XcdBarrier b; b.bar = bar; b.x = xb_xcc_id(); b.st = st;
    if (threadIdx.x == 0) (void)xb_add(&bar[XB_XCNT(b.x)], 1u);
    return b;
}
__device__ __forceinline__ void xcd_barrier_complete(unsigned* bar, unsigned x, unsigned& nloc, unsigned& nx) {
    const unsigned G = gridDim.x * gridDim.y * gridDim.z;
    unsigned sum, cnt, mine, sp = 0u;
    for (;;) {
        sum = 0u; cnt = 0u; mine = 0u;
#pragma unroll
        for (unsigned j = 0; j < 16; ++j) { const unsigned c = xb_ld(&bar[XB_XCNT(j)]); sum += c; cnt += (c > 0u) ? 1u : 0u; mine = (j == x) ? c : mine; }
        if (sum == G) break;
        __builtin_amdgcn_s_sleep(1);
        if ((++sp & 255u) == 0u) { if (xb_ld(&bar[XB_TMO])) break; if (sp > XB_SPIN_CAP) { atomicAdd(&bar[XB_TMO], 1u); break; } }
    }
    nloc = mine > 0u ? mine : 1u; nx = cnt > 0u ? cnt : 1u;
}

__device__ __forceinline__ void xcd_barrier(const XcdBarrier& b) {
    asm volatile("s_waitcnt vmcnt(0)" ::: "memory");
    __syncthreads();
    if (threadIdx.x == 0) {
        unsigned* bar = b.bar;
        __builtin_amdgcn_s_waitcnt(0);
        unsigned nloc = b.st[0], nx = b.st[1];
        if (nloc == 0u) { xcd_barrier_complete(bar, b.x, nloc, nx); b.st[0] = nloc; b.st[1] = nx; }
        const unsigned old = xb_add(&bar[XB_XSUB(b.x)], 1u);
        const unsigned gen = old / nloc;
        if (old + 1u == (gen + 1u) * nloc) {
            __builtin_amdgcn_fence(__ATOMIC_RELEASE, "agent");
            asm volatile("s_waitcnt vmcnt(0)" ::: "memory");
            const unsigned og = xb_add(&bar[XB_TOP], 1u);
            const unsigned tg = og / nx;
            if (og + 1u == (tg + 1u) * nx) xb_add(&bar[XB_TOPGEN], 1u);
            else XB_SPIN(xb_ld(&bar[XB_TOPGEN]) == tg, bar);
            __builtin_amdgcn_fence(__ATOMIC_ACQUIRE, "agent");
            xb_add(&bar[XB_XGEN(b.x)], 1u);
            asm volatile("s_waitcnt vmcnt(0)" ::: "memory");
        } else {
            XB_SPIN(xb_ld(&bar[XB_XGEN(b.x)]) == gen, bar);
            __builtin_amdgcn_fence(__ATOMIC_ACQUIRE, "agent");
            asm volatile("s_waitcnt vmcnt(0)" ::: "memory");
        }
    }
    __syncthreads();
}


struct Args { const float* in[34]; float* out; unsigned char* ws; int ph_lo, ph_hi; };
constexpr int N_PHASES = 22;

__global__ void __launch_bounds__(NTHR, 2) fwd(Args a) {
    extern __shared__ __attribute__((aligned(16))) unsigned char lds_raw[];
    float* lds = (float*)lds_raw;
    LAS unsigned char* ldsl = (LAS unsigned char*)lds_raw;
    const int vb0 = blockIdx.x, vbs = gridDim.x;
    const int lo = a.ph_lo, hi = a.ph_hi;
#define IN(k) (lo <= (k) && (k) < hi)
#define SEAM(k) do { if (IN(k) && IN((k) + 1)) xcd_barrier(bar); } while (0)
    volatile LAS unsigned* misc = (volatile LAS unsigned*)(ldsl + MISC_OFF);
    if (threadIdx.x < 4) misc[threadIdx.x] = 0u;
    __syncthreads();
    XcdBarrier bar = xcd_barrier_post((unsigned*)(a.ws + WS_CTL) + CW_BAR, misc);
    unsigned char* ws = a.ws;
    unsigned* ctl = (unsigned*)(ws + WS_CTL);
    unsigned* cnt = ctl + CW_CNT;
    int* list = (int*)(ws + WS_LIST); float* gatev = (float*)(ws + WS_GATE);
    float* dtraw = (float*)(ws + WS_DT); float* RS = (float*)(ws + WS_RS);
    bf16_t* XB = (bf16_t*)(ws + WS_XB); bf16_t* UB = (bf16_t*)(ws + WS_UB);
    bf16_t* YA = (bf16_t*)(ws + WS_YA); float* OF = (float*)(ws + WS_OF); bf16_t* OC = (bf16_t*)(ws + WS_OC);
    bf16_t* YP = (bf16_t*)(ws + WS_YP); bf16_t* YP1 = (bf16_t*)(ws + WS_YP1); bf16_t* XC = (bf16_t*)(ws + WS_YP);
    bf16_t* PB0 = (bf16_t*)(ws + WS_PB0); bf16_t* PB1 = (bf16_t*)(ws + WS_PB1);
    bf16_t* YB = (bf16_t*)(ws + WS_Y);
    float* MS = (float*)(ws + WS_MS); float* MD = (float*)(ws + WS_MD);
    float* HS = (float*)(ws + WS_HS); float* HD = (float*)(ws + WS_HD);
    bf16_t* XT = (bf16_t*)(ws + WS_XT); bf16_t* VT = (bf16_t*)(ws + WS_VT);
    const float* p_in = a.in[1];
    const int G = (int)gridDim.x, cb = (int)blockIdx.x;
    const NormB NB0{nullptr, XB, nullptr, nullptr, RS, nullptr, nullptr, nullptr, nullptr, nullptr, nullptr, nullptr, nullptr, nullptr, nullptr};
    unsigned char* XG8 = ws + WS_XG8;
    float* rsl = (float*)(ws + WS_DT);

    if (IN(0)) {
        ph_convert_weights(ldsl, a.in, ws, 0, ITEMS_DENSE, vb0, vbs);
        NormB A = NB0; A.xin = a.in[0]; A.gnext = a.in[3]; A.win = a.in[4]; A.dtraw = dtraw;
        ph_norm2<0, false, true, false>(A, vb0, vbs, (LAS float*)ldsl);
    }
    SEAM(0);
    if (IN(1)) { pg8::DenseOrder S; S.init(MT, UW, DM, (const bf16_t*)(ws + W_IN), G, cb); pg8::gemm_phase(ldsl, XB, DM, S, pg8::EpiBf16{UB, UW, RS}); }
    SEAM(1);
    if (IN(2)) { ph_prep(UB, a.in[5], a.in[6], XC, XT, VT, vb0, vbs); }
    SEAM(2);
    if (IN(3)) { ph_hgrn_states(ldsl, UB, VT, a.in[2], HS, HD, vb0, vbs); ph_mamba_states(ldsl, XT, dtraw, a.in[7], a.in[8], MS, MD, vb0, vbs); }
    SEAM(3);
    if (IN(4)) { ph_hgrn_scan(HS, HD, vb0, vbs); ph_mamba_scan(MS, MD, vb0, vbs); }
    SEAM(4);
    if (IN(5)) { ph_hgrn_out(ldsl, UB, VT, a.in[2], a.in[10], HS, OF, OC, vb0, vbs); ph_mamba_out(ldsl, UB, XC, XT, dtraw, a.in[7], a.in[8], a.in[9], a.in[11], MS, OC, vb0, vbs); }
    SEAM(5);
    if (IN(6)) { pg8::DenseOrder S; S.init(MT, DM, DM, (const bf16_t*)(ws + W_OUTE), G, cb); pg8::gemm_phase(ldsl, OC, DM, S, pg8::EpiBf16{YA, DM, nullptr}); }
    SEAM(6);
    if (IN(7)) {
        NormB A = NB0; A.y = YA; A.gpost = a.in[13];
        ph_norm2<1, false, false, false>(A, vb0, vbs);
        ph_cvt_rows(p_in, PB0, (size_t)MT * PDIM / 4, vb0, vbs);
        ph_convert_weights(ldsl, a.in, ws, ITEMS_DENSE, ITEMS_ALL, vb0, vbs);
    }
    SEAM(7);
    if (IN(8)) {
        { pg8::DenseOrder S; S.init(MT, 2 * DFF, DM, (const bf16_t*)(ws + W_GU), G, cb); pg8::gemm_phase(ldsl, XB, DM, S, pg8::EpiSwiglu{UB, DFF, RS, 0}); }
        { pg8::TailOrder S; S.init(MT, DM, PDIM, (const bf16_t*)(ws + W_PP), G, cb, (MT / 256) * (2 * DFF / 256) % G); pg8::gemm_phase(ldsl, PB0, PDIM, S, pg8::EpiBf16{YP, DM, nullptr}); }
    }
    SEAM(8);
    if (IN(9)) { pg8::DenseOrder S; S.init(MT, DM, DFF, (const bf16_t*)(ws + W_DN), G, cb); pg8::gemm_phase(ldsl, UB, DFF, S, pg8::EpiBf16{YA, DM, nullptr}); }
    SEAM(9);
    if (IN(10)) {
        NormB A = NB0; A.y = YA; A.gpost = a.in[18];
        ph_norm2<1, false, false, false>(A, vb0, vbs);
    }
    SEAM(10);
    if (IN(11)) { pg8::DenseOrder S; S.init(MT, DM, DM, (const bf16_t*)(ws + W_PG), G, cb); pg8::gemm_phase(ldsl, XB, DM, S, pg8::EpiPleGate{YP, DM, RS}); }
    SEAM(11);
    if (IN(12)) {
        NormB A = NB0; A.y = YP; A.gpost = a.in[33];
        ph_norm2<1, false, false, false>(A, vb0, vbs);
    }
    SEAM(12);
    if (IN(13)) { pg8::DenseOrder S; S.init(MT, 3072, DM, (const bf16_t*)(ws + W_QKV), G, cb); pg8::gemm_phase(ldsl, XB, DM, S, pg8::EpiBf16{UB, 3072, RS}); }
    SEAM(13);
    if (IN(14)) { ph_na(ldsl, UB, a.in[21], OC, vb0, vbs); }
    SEAM(14);
    if (IN(15)) { pg8::DenseOrder S; S.init(MT, DM, DM, (const bf16_t*)(ws + W_OUTO), G, cb); pg8::gemm_phase(ldsl, OC, DM, S, pg8::EpiBf16{YP1, DM, nullptr}); }
    SEAM(15);
    if (IN(16)) {
        NormB A = NB0; A.y = YP1; A.gpost = a.in[23]; A.gnext = a.in[24]; A.wr = a.in[25]; A.cnt = cnt; A.list = list; A.gatev = gatev; A.rsl = rsl; A.x8 = XG8;
        ph_norm2<1, false, false, true>(A, vb0, vbs, (LAS float*)ldsl);
        ph_cvt_rows(p_in + (size_t)MT * PDIM, PB1, (size_t)MT * PDIM / 4, vb0, vbs);
    }
    SEAM(16);
    if (IN(17)) { pg8::MoeOrder S; S.init(cnt, (volatile LAS int*)(ldsl + MISC_OFF + 64), 2 * DFFE, DM / 2, (const bf16_t*)(ws + W_EGU), (size_t)7 * MiB, true, G, cb);
        pg8::gemm_phase<pg8::EpiSwiglu8, pg8::MoeOrder, true>(ldsl, (const bf16_t*)XG8, DM / 2, S, pg8::EpiSwiglu8{(unsigned char*)UB, DFFE, rsl}); }
    SEAM(17);
    if (IN(18)) { pg8::MoeOrder S; S.init(cnt, (volatile LAS int*)(ldsl + MISC_OFF + 64), DM, DFFE / 2, (const bf16_t*)(ws + W_EDN), (size_t)(7 * MiB / 2), false, G, cb);
        pg8::gemm_phase<pg8::EpiMoeDown, pg8::MoeOrder, true>(ldsl, UB, DFFE / 2, S, pg8::EpiMoeDown{YB, list, gatev, 1.f / (pg8::W8_SCALE * pg8::ACT8_SCALE)});
        { pg8::TailOrder T; T.init(MT, DM, PDIM, (const bf16_t*)(ws + W_PP + 512 * 1024), G, cb, S.nwg % G); pg8::gemm_phase(ldsl, PB1, PDIM, T, pg8::EpiBf16{YP, DM, nullptr}); } }
    SEAM(18);
    if (IN(19)) {
        NormB A = NB0; A.y = YB; A.gpost = a.in[29];
        ph_norm2<2, false, false, false>(A, vb0, vbs);
    }
    SEAM(19);
    if (IN(20)) { pg8::DenseOrder S; S.init(MT, DM, DM, (const bf16_t*)(ws + W_PG + 2 * MiB), G, cb); pg8::gemm_phase(ldsl, XB, DM, S, pg8::EpiPleGate{YP, DM, RS}); }
    SEAM(20);
    if (IN(21)) {
        NormB A = NB0; A.y = YP; A.gpost = a.in[33] + DM; A.xout = a.out;
        ph_norm2<1, true, false, false>(A, vb0, vbs);
    }
#undef IN
#undef SEAM
}

extern "C" void kernel_launch(void* const* d_in, const int* in_sizes, int n_in, void* d_out, int out_size, void* d_ws, size_t ws_size, hipStream_t stream) {
    static int grid = 0;
    if (grid == 0) {
        if (n_in != 34 || out_size != MT * DM || ws_size < WS_END) { fprintf(stderr, "kernel_launch: unexpected shapes n_in %d out %d ws %zu (need %zu)\n", n_in, out_size, ws_size, (size_t)WS_END); grid = -1; return; }
        int dev = 0, cus = 0;
        if (hipGetDevice(&dev) != hipSuccess || hipDeviceGetAttribute(&cus, hipDeviceAttributeMultiprocessorCount, dev) != hipSuccess) { grid = -1; return; }
        if (hipFuncSetAttribute((const void*)fwd, hipFuncAttributeMaxDynamicSharedMemorySize, LDS_BYTES) != hipSuccess) { fprintf(stderr, "hipFuncSetAttribute failed\n"); grid = -1; return; }
        (void)hipGetLastError();
        grid = cus;
    }
    if (grid < 0) return;
    (void)hipMemsetAsync((char*)d_ws + WS_CTL, 0, CTL_ZERO_BYTES, stream);
    Args a{};
    for (int i = 0; i < 34; ++i) a.in[i] = (const float*)d_in[i];
    a.out = (float*)d_out; a.ws = (unsigned char*)d_ws;
#ifndef MK_PER_PHASE
    a.ph_lo = 0; a.ph_hi = N_PHASES;
    hipLaunchKernelGGL(fwd, dim3(grid), dim3(NTHR), LDS_BYTES, stream, a);
#else
    for (int ph = 0; ph < N_PHASES; ++ph) {
        a.ph_lo = ph; a.ph_hi = ph + 1;
        hipLaunchKernelGGL(fwd, dim3(grid), dim3(NTHR), LDS_BYTES, stream, a);
    }
#endif
}
```

```cpp
#include <hip/hip_runtime.h>
#include <stdint.h>
#include <stdio.h>

#define DEVI __device__ __forceinline__
#define LAS __attribute__((address_space(3)))
typedef unsigned short bf16_t;

constexpr int NB = 4, SEQ = 4096, DM = 1024, MT = NB * SEQ;
constexpr int EVEN_IN = 4112, UW = 4096, DFF = 2816, NEXP = 8, DFFE = 3584, PDIM = 256;
constexpr float EPS = 1e-6f;
constexpr int NTHR = 512;
constexpr int LDS_BYTES = 147456;
constexpr int MISC_OFF = 131072 + 320;
constexpr int MOE_ROWS = 2 * MT + NEXP * 256;

constexpr size_t MiB = 1u << 20;
constexpr size_t WS_CTL = 0, CTL_ZERO_BYTES = 1 * MiB;
constexpr size_t WS_LIST = 1 * MiB;
constexpr size_t WS_GATE = WS_LIST + 512 * 1024;
constexpr size_t WS_DT = 2 * MiB;
constexpr size_t WS_W = 3 * MiB;
constexpr size_t W_IN = WS_W, W_OUTE = W_IN + 8 * MiB, W_GU = W_OUTE + 2 * MiB, W_DN = W_GU + 11 * MiB, W_PG = W_DN + 6 * MiB, W_PP = W_PG + 4 * MiB,
                 W_QKV = W_PP + 1 * MiB, W_OUTO = W_QKV + 6 * MiB, W_EGU = W_OUTO + 2 * MiB, W_EDN = W_EGU + 112 * MiB, W_END = W_EDN + 56 * MiB;
constexpr size_t WS_XB = W_END;
constexpr size_t WS_R = WS_XB + 32 * MiB;
constexpr size_t WS_UB = WS_R;
constexpr size_t WS_PB0 = WS_R + 88 * MiB;
constexpr size_t WS_YA = WS_R + 128 * MiB;
constexpr size_t WS_OF = WS_R + 160 * MiB;
constexpr size_t WS_OC = WS_R + 192 * MiB;
constexpr size_t WS_YP = WS_R + 224 * MiB;
constexpr size_t WS_YP1 = WS_R;
constexpr size_t WS_PB1 = W_EDN + 32 * MiB;
constexpr size_t WS_XG8 = WS_R + 120 * MiB;
constexpr size_t WS_END = WS_R + 256 * MiB;
constexpr size_t WS_Y = W_EGU;
constexpr size_t WS_MS = W_EGU;
constexpr size_t WS_HS = W_EGU + 64 * MiB;
constexpr size_t WS_XT = W_EDN;
constexpr size_t WS_VT = W_EDN + 24 * MiB;
constexpr size_t WS_MD = W_EDN + 40 * MiB;
constexpr size_t WS_HD = W_EDN + 41 * MiB;
static_assert(WS_R + (size_t)MOE_ROWS * DFFE <= WS_XG8 && WS_XG8 + 128 * MiB <= WS_END && WS_END <= 510 * MiB, "ws map");
constexpr size_t WS_RS = WS_CTL + 512 * 1024;
constexpr int CW_CNT = 64;
constexpr int CW_BAR = 4096;

DEVI int opq(int x) { asm volatile("" : "+v"(x)); return x; }
DEVI float bf2f(bf16_t b) { return __uint_as_float(((unsigned)b) << 16); }
typedef float f32x2c __attribute__((ext_vector_type(2)));
typedef __bf16 bf16x2c __attribute__((ext_vector_type(2)));
DEVI unsigned cvt2bf(float lo, float hi) { const f32x2c v = {lo, hi}; return __builtin_bit_cast(unsigned, __builtin_convertvector(v, bf16x2c)); }
DEVI bf16_t f2bf(float f) { return (bf16_t)(cvt2bf(f, 0.f) & 0xffffu); }
DEVI float silu_f(float x) { return x * __builtin_amdgcn_rcpf(1.f + __builtin_amdgcn_exp2f(-1.44269504f * x)); }
DEVI float sigmoid_f(float x) { return __builtin_amdgcn_rcpf(1.f + __builtin_amdgcn_exp2f(-1.44269504f * x)); }
DEVI float softplus_f(float x) { return x > 20.f ? x : log1pf(__expf(x)); }
DEVI float wave_sum(float v) {
#pragma unroll
    for (int o = 1; o < 64; o <<= 1) v += __shfl_xor(v, o);
    return v;
}


typedef short bf16x8 __attribute__((ext_vector_type(8)));
typedef float f32x4 __attribute__((ext_vector_type(4)));
typedef unsigned u32x4 __attribute__((ext_vector_type(4)));
typedef unsigned u32x2 __attribute__((ext_vector_type(2)));
DEVI unsigned pk2(float lo, float hi) { return cvt2bf(lo, hi); }
DEVI float bflo(unsigned w) { return __uint_as_float(w << 16); }
DEVI float bfhi(unsigned w) { return __uint_as_float(w & 0xffff0000u); }

DEVI unsigned pg8_pk4(float a, float b, float c, float d) {
    a = __builtin_amdgcn_fmed3f(a, -448.f, 448.f); b = __builtin_amdgcn_fmed3f(b, -448.f, 448.f); c = __builtin_amdgcn_fmed3f(c, -448.f, 448.f); d = __builtin_amdgcn_fmed3f(d, -448.f, 448.f);
    int p = __builtin_amdgcn_cvt_pk_fp8_f32(a, b, 0, false); p = __builtin_amdgcn_cvt_pk_fp8_f32(c, d, p, true); return (unsigned)p; }
DEVI float wave_sum16(float (&v)[16], int lane) {
    const bool h5 = lane & 32, h4 = lane & 16, h3 = lane & 8, h2 = lane & 4;
#pragma unroll
    for (int i = 0; i < 8; ++i) { const float send = h5 ? v[i] : v[i + 8], keep = h5 ? v[i + 8] : v[i]; v[i] = keep + __shfl_xor(send, 32); }
#pragma unroll
    for (int i = 0; i < 4; ++i) { const float send = h4 ? v[i] : v[i + 4], keep = h4 ? v[i + 4] : v[i]; v[i] = keep + __shfl_xor(send, 16); }
#pragma unroll
    for (int i = 0; i < 2; ++i) { const float send = h3 ? v[i] : v[i + 2], keep = h3 ? v[i + 2] : v[i]; v[i] = keep + __shfl_xor(send, 8); }
    { const float send = h2 ? v[0] : v[1], keep = h2 ? v[1] : v[0]; v[0] = keep + __shfl_xor(send, 4); }
    float r = v[0]; r += __shfl_xor(r, 1); r += __shfl_xor(r, 2); return r;
}
DEVI float wave_sum8(float (&v)[8], int lane) {
    const bool h5 = lane & 32, h4 = lane & 16, h3 = lane & 8;
#pragma unroll
    for (int i = 0; i < 4; ++i) { const float send = h5 ? v[i] : v[i + 4], keep = h5 ? v[i + 4] : v[i]; v[i] = keep + __shfl_xor(send, 32); }
#pragma unroll
    for (int i = 0; i < 2; ++i) { const float send = h4 ? v[i] : v[i + 2], keep = h4 ? v[i + 2] : v[i]; v[i] = keep + __shfl_xor(send, 16); }
    { const float send = h3 ? v[0] : v[1], keep = h3 ? v[1] : v[0]; v[0] = keep + __shfl_xor(send, 8); }
    float r = v[0]; r += __shfl_xor(r, 1); r += __shfl_xor(r, 2); r += __shfl_xor(r, 4); return r;
}
struct NormB { const float* xin; bf16_t* XB; const bf16_t* y; const float* gpost; float* rs; const float* gnext;
               const float* win; float* dtraw; const float* wr; unsigned* cnt; int* list; float* gatev; float* rsl; float* xout; unsigned char* x8; };
DEVI void unpack8(const u32x4 w, float* v) { v[0] = bflo(w.x); v[1] = bfhi(w.x); v[2] = bflo(w.y); v[3] = bfhi(w.y); v[4] = bflo(w.z); v[5] = bfhi(w.z); v[6] = bflo(w.w); v[7] = bfhi(w.w); }
template <int YMODE, bool FINAL, bool DT, bool ROUTE>
DEVI void ph_norm2(const NormB& A, int vb0, int vbs, LAS float* wl = nullptr) {
    const int tidq = opq((int)threadIdx.x); const int wid = tidq >> 6, lane = tidq & 63;
    if (DT || ROUTE) {
        constexpr int NJ = DT ? 16 : 8;
        __syncthreads();
        for (int e = tidq; e < DM * NJ / 4; e += NTHR) { const int k = e / (NJ / 4), j4 = (e % (NJ / 4)) * 4;
            const float4 w = DT ? *(const float4*)(A.win + (size_t)k * EVEN_IN + 4096 + j4) : *(const float4*)(A.wr + (size_t)k * 8 + j4);
            wl[(j4 + 0) * DM + k] = w.x; wl[(j4 + 1) * DM + k] = w.y; wl[(j4 + 2) * DM + k] = w.z; wl[(j4 + 3) * DM + k] = w.w; }
        __syncthreads();
    }
    constexpr int R = (DT || ROUTE) ? 2 : 4;
    for (int row0 = (vb0 * 8 + wid) * R; row0 < MT; row0 += vbs * 8 * R) {
        float xv[R][16]; float yv[R][16];
#pragma unroll
        for (int rr = 0; rr < R; ++rr) {
            const size_t ro = (size_t)(row0 + rr) * DM + lane * 8;
            if (YMODE == 0) {
#pragma unroll
                for (int i = 0; i < 2; ++i) { const float4 p0 = *(const float4*)(A.xin + ro + i * 512), p1 = *(const float4*)(A.xin + ro + i * 512 + 4);
                    xv[rr][i * 8 + 0] = p0.x; xv[rr][i * 8 + 1] = p0.y; xv[rr][i * 8 + 2] = p0.z; xv[rr][i * 8 + 3] = p0.w; xv[rr][i * 8 + 4] = p1.x; xv[rr][i * 8 + 5] = p1.y; xv[rr][i * 8 + 6] = p1.z; xv[rr][i * 8 + 7] = p1.w; }
            } else {
#pragma unroll
                for (int i = 0; i < 2; ++i) {
                    unpack8(*(const u32x4*)(A.XB + ro + i * 512), xv[rr] + i * 8);
                    unpack8(*(const u32x4*)(A.y + ro + i * 512), yv[rr] + i * 8);
                    if (YMODE == 2) { float y2[8]; unpack8(*(const u32x4*)(A.y + (size_t)MT * DM + ro + i * 512), y2);
#pragma unroll
                        for (int j = 0; j < 8; ++j) yv[rr][i * 8 + j] += y2[j]; }
                }
            }
        }
        if (YMODE != 0) {
            float gg[16];
#pragma unroll
            for (int i = 0; i < 2; ++i) { const float4 g0 = *(const float4*)(A.gpost + i * 512 + lane * 8), g1 = *(const float4*)(A.gpost + i * 512 + lane * 8 + 4);
                gg[i * 8 + 0] = g0.x; gg[i * 8 + 1] = g0.y; gg[i * 8 + 2] = g0.z; gg[i * 8 + 3] = g0.w; gg[i * 8 + 4] = g1.x; gg[i * 8 + 5] = g1.y; gg[i * 8 + 6] = g1.z; gg[i * 8 + 7] = g1.w; }
            float ss[R];
#pragma unroll
            for (int rr = 0; rr < R; ++rr) { ss[rr] = 0.f;
#pragma unroll
                for (int j = 0; j < 16; ++j) ss[rr] += yv[rr][j] * yv[rr][j]; }
#pragma unroll
            for (int o = 1; o < 64; o <<= 1)
#pragma unroll
                for (int rr = 0; rr < R; ++rr) ss[rr] += __shfl_xor(ss[rr], o);
#pragma unroll
            for (int rr = 0; rr < R; ++rr) { const float r = rsqrtf(ss[rr] * (1.f / DM) + EPS);
#pragma unroll
                for (int j = 0; j < 16; ++j) xv[rr][j] += yv[rr][j] * r * gg[j]; }
        }
        if (FINAL) {
#pragma unroll
            for (int rr = 0; rr < R; ++rr)
#pragma unroll
                for (int i = 0; i < 2; ++i) { float* op = A.xout + (size_t)(row0 + rr) * DM + i * 512 + lane * 8;
                    *(float4*)op = make_float4(xv[rr][i * 8], xv[rr][i * 8 + 1], xv[rr][i * 8 + 2], xv[rr][i * 8 + 3]); *(float4*)(op + 4) = make_float4(xv[rr][i * 8 + 4], xv[rr][i * 8 + 5], xv[rr][i * 8 + 6], xv[rr][i * 8 + 7]); }
        } else {
            float ss[R];
#pragma unroll
            for (int rr = 0; rr < R; ++rr) {
#pragma unroll
                for (int i = 0; i < 2; ++i) { u32x4 o; o.x = pk2(xv[rr][i * 8], xv[rr][i * 8 + 1]); o.y = pk2(xv[rr][i * 8 + 2], xv[rr][i * 8 + 3]); o.z = pk2(xv[rr][i * 8 + 4], xv[rr][i * 8 + 5]); o.w = pk2(xv[rr][i * 8 + 6], xv[rr][i * 8 + 7]);
                    *(u32x4*)(A.XB + (size_t)(row0 + rr) * DM + i * 512 + lane * 8) = o;
                }
                ss[rr] = 0.f;
#pragma unroll
                for (int j = 0; j < 16; ++j) ss[rr] += xv[rr][j] * xv[rr][j];
            }
#pragma unroll
            for (int o = 1; o < 64; o <<= 1)
#pragma unroll
                for (int rr = 0; rr < R; ++rr) ss[rr] += __shfl_xor(ss[rr], o);
            float r2[R];
#pragma unroll
            for (int rr = 0; rr < R; ++rr) { r2[rr] = rsqrtf(ss[rr] * (1.f / DM) + EPS); if (lane == 0) A.rs[row0 + rr] = r2[rr]; }
            if (DT || ROUTE) {
                float gn[16];
#pragma unroll
                for (int i = 0; i < 2; ++i) { const float4 g0 = *(const float4*)(A.gnext + i * 512 + lane * 8), g1 = *(const float4*)(A.gnext + i * 512 + lane * 8 + 4);
                    gn[i * 8 + 0] = g0.x; gn[i * 8 + 1] = g0.y; gn[i * 8 + 2] = g0.z; gn[i * 8 + 3] = g0.w; gn[i * 8 + 4] = g1.x; gn[i * 8 + 5] = g1.y; gn[i * 8 + 6] = g1.z; gn[i * 8 + 7] = g1.w; }
                int re1[R], re2[R], lr1[R], lr2[R]; float rw1[R], rw2[R];
                volatile LAS int* lcnt = (volatile LAS int*)((LAS unsigned char*)wl + 40960);
                if (ROUTE) { __syncthreads(); if (tidq < 8) lcnt[tidq] = 0; __syncthreads(); }
#pragma unroll
                for (int rr = 0; rr < R; ++rr) {
                    const int row = row0 + rr;
                    float hv[16];
#pragma unroll
                    for (int j = 0; j < 16; ++j) hv[j] = (rr == 0 ? xv[0][j] : xv[R - 1][j]) * (rr == 0 ? r2[0] : r2[R - 1]) * gn[j];
                    if (DT) {
                        float pd[16];
#pragma unroll 4
                        for (int j = 0; j < 16; ++j) {
                            float p = 0.f;
#pragma unroll
                            for (int i = 0; i < 2; ++i) { const LAS float* wp = wl + j * DM + i * 512 + lane * 8;
                                const f32x4 w0 = *(const LAS f32x4*)wp, w1 = *(const LAS f32x4*)(wp + 4);
                                p += hv[i * 8 + 0] * w0[0] + hv[i * 8 + 1] * w0[1] + hv[i * 8 + 2] * w0[2] + hv[i * 8 + 3] * w0[3] + hv[i * 8 + 4] * w1[0] + hv[i * 8 + 5] * w1[1] + hv[i * 8 + 6] * w1[2] + hv[i * 8 + 7] * w1[3]; }
                            pd[j] = p;
                        }
                        const float dk = wave_sum16(pd, lane);
                        if ((lane & 3) == 0) A.dtraw[(size_t)row * 16 + (lane >> 2)] = dk;
                    }
                    if (ROUTE) {
                        float pl[8];
#pragma unroll 4
                        for (int e = 0; e < 8; ++e) {
                            float p = 0.f;
#pragma unroll
                            for (int i = 0; i < 2; ++i) { const LAS float* wp = wl + e * DM + i * 512 + lane * 8;
                                const f32x4 w0 = *(const LAS f32x4*)wp, w1 = *(const LAS f32x4*)(wp + 4);
                                p += hv[i * 8 + 0] * w0[0] + hv[i * 8 + 1] * w0[1] + hv[i * 8 + 2] * w0[2] + hv[i * 8 + 3] * w0[3] + hv[i * 8 + 4] * w1[0] + hv[i * 8 + 5] * w1[1] + hv[i * 8 + 6] * w1[2] + hv[i * 8 + 7] * w1[3]; }
                            pl[e] = p;
                        }
                        const float lk = wave_sum8(pl, lane);
                        float lg[8];
#pragma unroll
                        for (int e = 0; e < 8; ++e) lg[e] = __shfl(lk, e * 8);
                        int e1 = 0; float v1 = lg[0];
#pragma unroll
                        for (int e = 1; e < 8; ++e) if (lg[e] > v1) { v1 = lg[e]; e1 = e; }
                        int e2 = 0; float v2 = -3.0e38f;
#pragma unroll
                        for (int e = 0; e < 8; ++e) if (e != e1 && lg[e] > v2) { v2 = lg[e]; e2 = e; }
                        const float ex = __expf(v2 - v1);
                        re1[rr] = e1; re2[rr] = e2; rw1[rr] = 1.f / (1.f + ex); rw2[rr] = ex / (1.f + ex);
                        if (lane == 0) { lr1[rr] = __hip_atomic_fetch_add((LAS int*)lcnt + e1, 1, __ATOMIC_RELAXED, __HIP_MEMORY_SCOPE_WORKGROUP); lr2[rr] = __hip_atomic_fetch_add((LAS int*)lcnt + e2, 1, __ATOMIC_RELAXED, __HIP_MEMORY_SCOPE_WORKGROUP); }
                    }
                }
                if (ROUTE) {
                    __syncthreads();
                    if (tidq < 8) lcnt[8 + tidq] = (int)atomicAdd(&A.cnt[tidq * 64], (unsigned)lcnt[tidq]);
                    __syncthreads();
#pragma unroll
                    for (int rr = 0; rr < R; ++rr) {
                        const int row = row0 + rr;
                        int dst1 = 0, dst2 = 0;
                        if (lane == 0) {
                            const int e1 = re1[rr], e2 = re2[rr];
                            const int p1 = lcnt[8 + e1] + lr1[rr], p2 = lcnt[8 + e2] + lr2[rr];
                            A.list[e1 * MT + p1] = row * 2; A.gatev[e1 * MT + p1] = rw1[rr]; A.rsl[e1 * MT + p1] = r2[rr];
                            A.list[e2 * MT + p2] = row * 2 + 1; A.gatev[e2 * MT + p2] = rw2[rr]; A.rsl[e2 * MT + p2] = r2[rr];
                            dst1 = e1 * MT + p1; dst2 = e2 * MT + p2;
                        }
                        dst1 = __builtin_amdgcn_readfirstlane(dst1); dst2 = __builtin_amdgcn_readfirstlane(dst2);
#pragma unroll
                        for (int i = 0; i < 2; ++i) { u32x2 o8;
                            const float* xs = xv[rr] + i * 8;
                            o8.x = pg8_pk4(xs[0], xs[1], xs[2], xs[3]); o8.y = pg8_pk4(xs[4], xs[5], xs[6], xs[7]);
                            *(u32x2*)(A.x8 + (size_t)dst1 * DM + i * 512 + lane * 8) = o8; *(u32x2*)(A.x8 + (size_t)dst2 * DM + i * 512 + lane * 8) = o8; }
                    }
                }
            }
        }
    }
}

DEVI void transpose_item(const float* W, int ldw, int K, int k0, int n0, bf16_t* WT, int drow0, LAS float* scr, int lane, const float* gain) {
    {
        const int ka = lane >> 3, n4 = (lane & 7) * 4;
        float4 wv[8];
#pragma unroll
        for (int i = 0; i < 8; ++i) wv[i] = *(const float4*)(W + (size_t)(k0 + i * 8 + ka) * ldw + n0 + n4);
#pragma unroll
        for (int i = 0; i < 8; ++i) { LAS float* d = scr + (i * 8 + ka) * 33 + n4; d[0] = wv[i].x; d[1] = wv[i].y; d[2] = wv[i].z; d[3] = wv[i].w; }
    }
    asm volatile("s_waitcnt lgkmcnt(0)" ::: "memory");
    const int c = lane & 7;
    float4 ga = make_float4(1.f, 1.f, 1.f, 1.f), gb = ga;
    if (gain) { ga = *(const float4*)(gain + k0 + 8 * c); gb = *(const float4*)(gain + k0 + 8 * c + 4); }
#pragma unroll
    for (int j = 0; j < 4; ++j) { const int n = (lane >> 3) + 8 * j; const LAS float* sp = scr + (8 * c) * 33 + n;
        u32x4 o; o.x = pk2(sp[0 * 33] * ga.x, sp[1 * 33] * ga.y); o.y = pk2(sp[2 * 33] * ga.z, sp[3 * 33] * ga.w); o.z = pk2(sp[4 * 33] * gb.x, sp[5 * 33] * gb.y); o.w = pk2(sp[6 * 33] * gb.z, sp[7 * 33] * gb.w);
        *(u32x4*)(WT + (size_t)(drow0 + n) * K + k0 + 8 * c) = o; }
    asm volatile("s_waitcnt lgkmcnt(0)" ::: "memory");
}
DEVI void transpose_item_fp8(const float* W, int ldw, int K, int k0, int n0, unsigned char* WT8, int drow0, LAS float* scr, int lane, const float* gain) {
    {
        const int ka = lane >> 3, n4 = (lane & 7) * 4;
        float4 wv[8];
#pragma unroll
        for (int i = 0; i < 8; ++i) wv[i] = *(const float4*)(W + (size_t)(k0 + i * 8 + ka) * ldw + n0 + n4);
#pragma unroll
        for (int i = 0; i < 8; ++i) { LAS float* d = scr + (i * 8 + ka) * 33 + n4; d[0] = wv[i].x; d[1] = wv[i].y; d[2] = wv[i].z; d[3] = wv[i].w; }
    }
    asm volatile("s_waitcnt lgkmcnt(0)" ::: "memory");
    const int c = lane & 7;
    float4 ga = make_float4(64.f, 64.f, 64.f, 64.f), gb = ga;
    if (gain) { ga = *(const float4*)(gain + k0 + 8 * c); gb = *(const float4*)(gain + k0 + 8 * c + 4); ga.x *= 64.f; ga.y *= 64.f; ga.z *= 64.f; ga.w *= 64.f; gb.x *= 64.f; gb.y *= 64.f; gb.z *= 64.f; gb.w *= 64.f; }
#pragma unroll
    for (int j = 0; j < 4; ++j) { const int n = (lane >> 3) + 8 * j; const LAS float* sp = scr + (8 * c) * 33 + n;
        u32x2 o; o.x = pg8_pk4(sp[0 * 33] * ga.x, sp[1 * 33] * ga.y, sp[2 * 33] * ga.z, sp[3 * 33] * ga.w); o.y = pg8_pk4(sp[4 * 33] * gb.x, sp[5 * 33] * gb.y, sp[6 * 33] * gb.z, sp[7 * 33] * gb.w);
        *(u32x2*)(WT8 + (size_t)(drow0 + n) * K + k0 + 8 * c) = o; }
    asm volatile("s_waitcnt lgkmcnt(0)" ::: "memory");
}
struct Job { int in_idx; unsigned src_off; int ldw; int K; int ncols; unsigned long long dst; int mode; int item0; int gain_idx; int gain_off; int fp8; };
constexpr int NJOBS = 11 + 24;
struct JobTable { Job j[NJOBS]; int total; };
constexpr JobTable make_jobs() {
    JobTable t{}; int n = 0, it = 0;
    auto add = [&](int idx, unsigned off, int ldw, int K, int ncols, unsigned long long dst, int mode, int gi, int go, int f8 = 0) { t.j[n] = Job{idx, off, ldw, K, ncols, dst, mode, it, gi, go, f8}; it += (K / 64) * (ncols / 32); ++n; };
    add(4, 0, EVEN_IN, DM, UW, W_IN, 0, 3, 0);
    add(12, 0, DM, DM, DM, W_OUTE, 0, -1, 0);
    add(15, 0, DFF, DM, DFF, W_GU, 1, 14, 0);
    add(16, 0, DFF, DM, DFF, W_GU, 2, 14, 0);
    add(17, 0, DM, DFF, DM, W_DN, 0, -1, 0);
    add(31, 0, DM, DM, DM, W_PG, 0, 30, 0);
    add(31, DM * DM, DM, DM, DM, W_PG + 2 * MiB, 0, 30, DM);
    add(32, 0, DM, PDIM, DM, W_PP, 0, -1, 0);
    add(32, PDIM * DM, DM, PDIM, DM, W_PP + 512 * 1024, 0, -1, 0);
    add(20, 0, 3072, DM, 3072, W_QKV, 0, 19, 0);
    add(22, 0, DM, DM, DM, W_OUTO, 0, -1, 0);
    for (int e = 0; e < NEXP; ++e) {
        add(26, (unsigned)e * DM * DFFE, DFFE, DM, DFFE, W_EGU + (unsigned long long)e * 7 * MiB, 1, 24, 0, 1);
        add(27, (unsigned)e * DM * DFFE, DFFE, DM, DFFE, W_EGU + (unsigned long long)e * 7 * MiB, 2, 24, 0, 1);
        add(28, (unsigned)e * DFFE * DM, DM, DFFE, DM, W_EDN + (unsigned long long)e * (7 * MiB / 2), 0, -1, 0, 1);
    }
    t.total = it; return t;
}
__device__ const JobTable g_jobs = make_jobs();
constexpr int ITEMS_DENSE = make_jobs().j[11].item0, ITEMS_ALL = make_jobs().total;
DEVI void ph_convert_weights(LAS unsigned char* lds, const float* const* in, unsigned char* ws, int it_lo, int it_hi, int vb0, int vbs) {
    const int tidq = opq((int)threadIdx.x); const int wid = __builtin_amdgcn_readfirstlane(tidq >> 6), lane = tidq & 63;
    LAS float* scr = (LAS float*)(lds + wid * 16384);
    int jb = 0;
    for (int it = it_lo + vb0 * 8 + wid; it < it_hi; it += vbs * 8) {
        while (jb + 1 < NJOBS && g_jobs.j[jb + 1].item0 <= it) ++jb;
        const Job J = g_jobs.j[jb];
        const int r = it - J.item0; const int nblk = J.ncols / 32; const int kb = r / nblk, nb = r % nblk;
        const int n0 = nb * 32; int drow0 = n0;
        if (J.mode != 0) drow0 = (n0 >> 7) * 256 + (n0 & 127) + (J.mode == 2 ? 128 : 0);
        const float* gp = J.gain_idx >= 0 ? in[J.gain_idx] + J.gain_off : nullptr;
        if (J.fp8) transpose_item_fp8(in[J.in_idx] + J.src_off, J.ldw, J.K, kb * 64, n0, ws + J.dst, drow0, scr, lane, gp);
        else transpose_item(in[J.in_idx] + J.src_off, J.ldw, J.K, kb * 64, n0, (bf16_t*)(ws + J.dst), drow0, scr, lane, gp);
    }
}
DEVI void ph_cvt_rows(const float* src, bf16_t* dst, size_t n4, int vb0, int vbs) {
    for (size_t e = (size_t)vb0 * NTHR + opq((int)threadIdx.x); e < n4; e += (size_t)vbs * NTHR) {
        const float4 v = ((const float4*)src)[e]; u32x2 o; o.x = pk2(v.x, v.y); o.y = pk2(v.z, v.w); ((u32x2*)dst)[e] = o; }
}

namespace pg8 {
constexpr int BM = 256, BK = 64, HALF = 128, HTB = HALF * BK * 2, STAGE_BYTES = 8 * HTB, NXCD = 8, WGM = 8;
__host__ __device__ __forceinline__ int lds_byte(int r, int c) { const int st = (r >> 4) * 2 + (c >> 5), rr = r & 15, cc = c & 31, ob = rr * 64 + cc * 2; return st * 1024 + (ob ^ (((ob >> 9) & 1) << 5)); }
__host__ __device__ __forceinline__ void stage_rc(int b, int& R, int& C) { const int st = b / 1024, sb = b % 1024, swz = sb ^ (((sb >> 9) & 1) << 5); R = (st >> 1) * 16 + swz / 64; C = (st & 1) * 32 + (swz % 64) / 2; }
__host__ __device__ __forceinline__ int perm32(int rho) { const int n = rho >> 4, i = rho & 15; return 8 * (i >> 2) + 4 * n + (i & 3); }
struct Unit { int pm, pn; int row0; int arow0; int mvalid; int e; int mbase; const char* B; };
DEVI void xcd_tile(int L, int nwg, int nM, int nN, int& pm, int& pn) {
    int wgid = L; { const int q = nwg / NXCD, r = nwg % NXCD, xcd = wgid % NXCD, off = wgid / NXCD; wgid = (xcd < r ? xcd * (q + 1) : r * (q + 1) + (xcd - r) * q) + off; }
    const int nig = WGM * nN, gid = wgid / nig, fm = gid * WGM, gsz = (nM - fm) < WGM ? (nM - fm) : WGM;
    pm = fm + ((wgid % nig) % gsz); pn = (wgid % nig) / gsz;
}
struct DenseOrder {
    int nM, nN, nwg, G, c; const char* Bt; size_t tstepB;
    DEVI void init(int M, int N, int K, const bf16_t* Bt_, int G_, int c_) { nM = M / BM; nN = N / BM; nwg = nM * nN; G = G_; c = c_; Bt = (const char*)Bt_; tstepB = (size_t)BM * K * 2; }
    DEVI bool next(int i, Unit& u) const { const long L = (long)i * G + c; if (L >= nwg) return false; xcd_tile((int)L, nwg, nM, nN, u.pm, u.pn); u.row0 = u.pm * BM; u.arow0 = u.row0; u.mvalid = BM; u.e = 0; u.mbase = 0; u.B = Bt + (size_t)u.pn * tstepB; return true; }
};
struct TailOrder {
    int nM, nN, nwg, nb, r; const char* Bt; size_t tstepB;
    DEVI void init(int M, int N, int K, const bf16_t* Bt_, int G_, int c_, int first) { nM = M / BM; nN = N / BM; nwg = nM * nN; Bt = (const char*)Bt_; tstepB = (size_t)BM * K * 2;
        if (first >= G_) first = 0; nb = G_ - first; r = c_ - first; }
    DEVI bool next(int i, Unit& u) const { if (r < 0) return false; const long L = (long)i * nb + r; if (L >= nwg) return false; u.pm = (int)L / nN; u.pn = (int)L % nN; u.row0 = u.pm * BM; u.arow0 = u.row0; u.mvalid = BM; u.e = 0; u.mbase = 0; u.B = Bt + (size_t)u.pn * tstepB; return true; }
};
struct MoeOrder {
    int nM, nN, nwg, G, c; const char* Bt; size_t estepB, tstepB; const volatile LAS int* tab; bool per_expert;
    DEVI void init(const unsigned* cnt, volatile LAS int* tab_, int N, int K, const bf16_t* Bt_, size_t estep_bytes, bool per_expert_, int G_, int c_) {
        __syncthreads();
        if (threadIdx.x < 8) tab_[16 + threadIdx.x] = (int)__hip_atomic_load(cnt + threadIdx.x * 64, __ATOMIC_RELAXED, __HIP_MEMORY_SCOPE_AGENT);
        __syncthreads();
        if (threadIdx.x == 0) { int t = 0;
            for (int e = 0; e < 8; ++e) { const int n = tab_[16 + e]; tab_[e] = t; t += (n + BM - 1) / BM; }
            tab_[8] = t; }
        __syncthreads();
        tab = tab_; nM = __builtin_amdgcn_readfirstlane(tab_[8]); nN = N / BM; nwg = nM * nN; G = G_; c = c_; Bt = (const char*)Bt_; estepB = estep_bytes; tstepB = (size_t)BM * K * 2; per_expert = per_expert_;
    }
    DEVI bool next(int i, Unit& u) const { const long L = (long)i * G + c; if (L >= nwg) return false; xcd_tile((int)L, nwg, nM, nN, u.pm, u.pn);
        int e = 0;
        for (int k = 1; k < 8; ++k) if (u.pm >= __builtin_amdgcn_readfirstlane(tab[k])) e = k;
        const int t0 = __builtin_amdgcn_readfirstlane(tab[e]), n = __builtin_amdgcn_readfirstlane(tab[16 + e]);
        u.e = e; u.row0 = u.pm * BM; const int m0 = (u.pm - t0) * BM; u.mbase = m0; u.arow0 = per_expert ? e * MT + m0 : u.row0; u.mvalid = (n - m0) < BM ? (n - m0) : BM; u.B = Bt + (size_t)e * estepB + (size_t)u.pn * tstepB; return true; }
};
DEVI unsigned cvt_pk_bf16(float lo, float hi) { return cvt2bf(lo, hi); }

struct Pre8 { float v[8]; };
struct Pre16 { float v[8]; int t[8]; };
struct EpiBf16 { static constexpr bool PERM = true; bf16_t* O; int ldc; const float* rs;
    typedef Pre8 Pre;
    DEVI void pre(Pre& P, const Unit& u, int wr, int fr) const {
#pragma unroll
        for (int q = 0; q < 8; ++q) P.v[q] = rs ? rs[u.row0 + wr * 64 + fr + (q >> 2) * HALF + (q & 3) * 16] : 1.f; }
    DEVI void operator()(const f32x4 (&acc)[2][2][4][2], const Unit& u, int wr, int wc, int fr, int fq, const Pre& P) const {
        const int row0 = u.row0 + wr * 64 + fr, col0 = u.pn * BM + wc * 32 + 8 * fq;
#pragma unroll
        for (int ai = 0; ai < 2; ++ai)
#pragma unroll
            for (int m = 0; m < 4; ++m) { const int row = row0 + ai * HALF + m * 16; bf16_t* rowp = O + (size_t)row * ldc + col0;
                const float sc = P.v[ai * 4 + m];
#pragma unroll
                for (int bj = 0; bj < 2; ++bj) { const f32x4 v0 = acc[ai][bj][m][0] * sc, v1 = acc[ai][bj][m][1] * sc;
                    u32x4 w; w.x = cvt_pk_bf16(v0[0], v0[1]); w.y = cvt_pk_bf16(v0[2], v0[3]); w.z = cvt_pk_bf16(v1[0], v1[1]); w.w = cvt_pk_bf16(v1[2], v1[3]);
                    *(u32x4*)(rowp + bj * HALF) = w; } }
    } };
struct EpiPleGate { static constexpr bool PERM = true; bf16_t* T; int ldc; const float* rs;
    typedef Pre8 Pre;
    DEVI void pre(Pre& P, const Unit& u, int wr, int fr) const {
#pragma unroll
        for (int q = 0; q < 8; ++q) P.v[q] = rs[u.row0 + wr * 64 + fr + (q >> 2) * HALF + (q & 3) * 16]; }
    DEVI void operator()(const f32x4 (&acc)[2][2][4][2], const Unit& u, int wr, int wc, int fr, int fq, const Pre& P) const {
        const int row0 = u.row0 + wr * 64 + fr, col0 = u.pn * BM + wc * 32 + 8 * fq;
#pragma unroll
        for (int ai = 0; ai < 2; ++ai)
#pragma unroll
            for (int m = 0; m < 4; ++m) { const int row = row0 + ai * HALF + m * 16; bf16_t* rowp = T + (size_t)row * ldc + col0;
                const float sc = P.v[ai * 4 + m];
#pragma unroll
                for (int bj = 0; bj < 2; ++bj) { const f32x4 v0 = acc[ai][bj][m][0] * sc, v1 = acc[ai][bj][m][1] * sc;
                    const u32x4 pp = *(const u32x4*)(rowp + bj * HALF);
                    u32x4 w; w.x = cvt_pk_bf16(sigmoid_f(v0[0]) * bflo(pp.x), sigmoid_f(v0[1]) * bfhi(pp.x)); w.y = cvt_pk_bf16(sigmoid_f(v0[2]) * bflo(pp.y), sigmoid_f(v0[3]) * bfhi(pp.y));
                    w.z = cvt_pk_bf16(sigmoid_f(v1[0]) * bflo(pp.z), sigmoid_f(v1[1]) * bfhi(pp.z)); w.w = cvt_pk_bf16(sigmoid_f(v1[2]) * bflo(pp.w), sigmoid_f(v1[3]) * bfhi(pp.w));
                    *(u32x4*)(rowp + bj * HALF) = w; } }
    } };
struct EpiSwiglu { static constexpr bool PERM = true; bf16_t* O; int ldc; const float* rs; int grouped;
    typedef Pre8 Pre;
    DEVI void pre(Pre& P, const Unit& u, int wr, int fr) const {
        const float* rsb = grouped ? rs + u.e * MT + u.mbase : rs + u.row0; const int vm1 = (grouped ? u.mvalid : BM) - 1;
#pragma unroll
        for (int q = 0; q < 8; ++q) { const int rl = wr * 64 + fr + (q >> 2) * HALF + (q & 3) * 16; P.v[q] = rsb[rl <= vm1 ? rl : vm1]; } }
    DEVI void operator()(const f32x4 (&acc)[2][2][4][2], const Unit& u, int wr, int wc, int fr, int fq, const Pre& P) const {
        const int row0 = u.row0 + wr * 64 + fr, col0 = u.pn * HALF + wc * 32 + 8 * fq; const int vm1e = (grouped ? u.mvalid : BM) - 1;
#pragma unroll
        for (int ai = 0; ai < 2; ++ai)
#pragma unroll
            for (int m = 0; m < 4; ++m) { const int rl = wr * 64 + fr + ai * HALF + m * 16; bf16_t* rowp = O + (size_t)(u.row0 + rl) * ldc + col0;
                const float sc = rl <= vm1e ? P.v[ai * 4 + m] : 0.f;
                const f32x4 g0 = acc[ai][0][m][0] * sc, g1 = acc[ai][0][m][1] * sc, u0 = acc[ai][1][m][0] * sc, u1 = acc[ai][1][m][1] * sc;
                u32x4 w; w.x = cvt_pk_bf16(silu_f(g0[0]) * u0[0], silu_f(g0[1]) * u0[1]); w.y = cvt_pk_bf16(silu_f(g0[2]) * u0[2], silu_f(g0[3]) * u0[3]);
                w.z = cvt_pk_bf16(silu_f(g1[0]) * u1[0], silu_f(g1[1]) * u1[1]); w.w = cvt_pk_bf16(silu_f(g1[2]) * u1[2], silu_f(g1[3]) * u1[3]);
                *(u32x4*)rowp = w; }
    } };
constexpr float W8_SCALE = 64.f, ACT8_SCALE = 8.f;
struct EpiSwiglu8 { static constexpr bool PERM = true; unsigned char* O; int ldc; const float* rs;
    typedef Pre8 Pre;
    DEVI void pre(Pre& P, const Unit& u, int wr, int fr) const {
        const float* rsb = rs + u.e * MT + u.mbase; const int vm1 = u.mvalid - 1;
#pragma unroll
        for (int q = 0; q < 8; ++q) { const int rl = wr * 64 + fr + (q >> 2) * HALF + (q & 3) * 16; P.v[q] = rsb[rl <= vm1 ? rl : vm1]; } }
    DEVI void operator()(const f32x4 (&acc)[2][2][4][2], const Unit& u, int wr, int wc, int fr, int fq, const Pre& P) const {
        const int col0 = u.pn * HALF + wc * 32 + 8 * fq;
#pragma unroll
        for (int ai = 0; ai < 2; ++ai)
#pragma unroll
            for (int m = 0; m < 4; ++m) { const int rl = wr * 64 + fr + ai * HALF + m * 16; unsigned char* rowp = O + (size_t)(u.row0 + rl) * ldc + col0;
                const float sc = rl < u.mvalid ? P.v[ai * 4 + m] * (1.f / W8_SCALE) : 0.f;
                const f32x4 g0 = acc[ai][0][m][0] * sc, g1 = acc[ai][0][m][1] * sc, u0 = acc[ai][1][m][0] * (sc * ACT8_SCALE), u1 = acc[ai][1][m][1] * (sc * ACT8_SCALE);
                u32x2 w; w.x = pg8_pk4(silu_f(g0[0]) * u0[0], silu_f(g0[1]) * u0[1], silu_f(g0[2]) * u0[2], silu_f(g0[3]) * u0[3]);
                w.y = pg8_pk4(silu_f(g1[0]) * u1[0], silu_f(g1[1]) * u1[1], silu_f(g1[2]) * u1[2], silu_f(g1[3]) * u1[3]);
                *(u32x2*)rowp = w; }
    } };
struct EpiMoeDown { static constexpr bool PERM = true; bf16_t* Y; const int* list; const float* gatev; float oscale;
    typedef Pre16 Pre;
    DEVI void pre(Pre& P, const Unit& u, int wr, int fr) const {
        const int* lb = list + u.e * MT + u.mbase; const float* gb = gatev + u.e * MT + u.mbase; const int vm1 = u.mvalid - 1;
#pragma unroll
        for (int q = 0; q < 8; ++q) { const int rl = wr * 64 + fr + (q >> 2) * HALF + (q & 3) * 16; const int ri = rl <= vm1 ? rl : vm1; P.t[q] = lb[ri]; P.v[q] = gb[ri]; } }
    DEVI void operator()(const f32x4 (&acc)[2][2][4][2], const Unit& u, int wr, int wc, int fr, int fq, const Pre& P) const {
        const int col0 = u.pn * BM + wc * 32 + 8 * fq;
        const int mbase = u.mbase;
#pragma unroll
        for (int ai = 0; ai < 2; ++ai)
#pragma unroll
            for (int m = 0; m < 4; ++m) { const int rl = wr * 64 + fr + ai * HALF + m * 16;
                const int tsl = P.t[ai * 4 + m]; const float gt = P.v[ai * 4 + m] * oscale;
                if (rl < u.mvalid) {
                    bf16_t* rowp = Y + (size_t)(tsl & 1) * ((size_t)MT * DM) + (size_t)(tsl >> 1) * DM + col0;
#pragma unroll
                    for (int bj = 0; bj < 2; ++bj) { const f32x4 v0 = acc[ai][bj][m][0], v1 = acc[ai][bj][m][1];
                        u32x4 w; w.x = cvt_pk_bf16(v0[0] * gt, v0[1] * gt); w.y = cvt_pk_bf16(v0[2] * gt, v0[3] * gt); w.z = cvt_pk_bf16(v1[0] * gt, v1[1] * gt); w.w = cvt_pk_bf16(v1[2] * gt, v1[3] * gt);
                        *(u32x4*)(rowp + bj * HALF) = w; } } }
    } };

typedef int v8i __attribute__((ext_vector_type(8)));
typedef int v4i __attribute__((ext_vector_type(4)));
DEVI v8i cat8(const bf16x8 lo, const bf16x8 hi) { const v4i a = __builtin_bit_cast(v4i, lo), b = __builtin_bit_cast(v4i, hi); return __builtin_shufflevector(a, b, 0, 1, 2, 3, 4, 5, 6, 7); }
struct Frag16 { bf16x8 k[2]; };
struct Frag8 { v8i v; };
template <bool F> struct FragSel { typedef Frag16 T; };
template <> struct FragSel<true> { typedef Frag8 T; };
template <class Epi, class Sched, bool FP8 = false>
DEVI void gemm_phase(LAS unsigned char* lds, const bf16_t* A, const int K, const Sched& S, const Epi& E) {
    const int tid = opq((int)threadIdx.x), wid = __builtin_amdgcn_readfirstlane(tid >> 6), lane = tid & 63, wr = wid >> 2, wc = wid & 3, fr = lane & 15, fq = lane >> 4;
    const int nt = K / BK;
    unsigned voffA[2], voffB[2];
#pragma unroll
    for (int i = 0; i < 2; ++i) { int R, C; stage_rc(tid * 16 + i * 8192, R, C); const int Rb = Epi::PERM ? ((R & ~31) + perm32(R & 31)) : R;
        voffA[i] = (unsigned)(R * K + C) * 2u; voffB[i] = (unsigned)(Rb * K + C) * 2u; }
    const size_t kstep = (size_t)(BK * 2);
    const size_t hstep = (size_t)HALF * K * 2;
    const size_t rstep = (size_t)K * 2;
    const unsigned ldsw = (unsigned)wid * 1024u;
    const int aoff = lds_byte(wr * 64 + fr, fq * 8), boff = lds_byte(wc * 32 + fr, fq * 8);
#define PG8_SA(b, h) (((b) * 2 + (h)) * HTB)
#define PG8_SB(b, h) ((4 + (b) * 2 + (h)) * HTB)
#define PG8_STAGE(bufoff, gbase, voff) do { _Pragma("unroll") for (int _i = 0; _i < 2; ++_i) \
        __builtin_amdgcn_global_load_lds((const unsigned*)((const char*)(gbase) + (voff)[_i]), (LAS unsigned*)(lds + (bufoff) + ldsw + _i * 8192), 16, 0, 0); } while (0)
#define PG8_LDA(dst, b, h) do { _Pragma("unroll") for (int m = 0; m < 4; ++m) { if constexpr (FP8) dst[m].v = cat8(*(const LAS bf16x8*)(lds + PG8_SA(b, h) + aoff + m * 2048), *(const LAS bf16x8*)(lds + PG8_SA(b, h) + aoff + m * 2048 + 1024)); \
        else { _Pragma("unroll") for (int k = 0; k < 2; ++k) dst[m].k[k] = *(const LAS bf16x8*)(lds + PG8_SA(b, h) + aoff + m * 2048 + k * 1024); } } } while (0)
#define PG8_LDB(dst, b, h) do { _Pragma("unroll") for (int n = 0; n < 2; ++n) { if constexpr (FP8) dst[n].v = cat8(*(const LAS bf16x8*)(lds + PG8_SB(b, h) + boff + n * 2048), *(const LAS bf16x8*)(lds + PG8_SB(b, h) + boff + n * 2048 + 1024)); \
        else { _Pragma("unroll") for (int k = 0; k < 2; ++k) dst[n].k[k] = *(const LAS bf16x8*)(lds + PG8_SB(b, h) + boff + n * 2048 + k * 1024); } } } while (0)
#define PG8_MMA(ai, bj, At, Bt) do { __builtin_amdgcn_s_setprio(1); _Pragma("unroll") for (int m = 0; m < 4; ++m) _Pragma("unroll") for (int n = 0; n < 2; ++n) { \
        if constexpr (FP8) asm volatile("s_nop 1\n\tv_mfma_scale_f32_16x16x128_f8f6f4 %0, %1, %2, %0, %3, %3 op_sel_hi:[0,0,0]" : "+v"(acc[ai][bj][m][n]) : "v"(Bt[n].v), "v"(At[m].v), "v"(sc1)); \
        else { _Pragma("unroll") for (int k = 0; k < 2; ++k) acc[ai][bj][m][n] = __builtin_amdgcn_mfma_f32_16x16x32_bf16(Bt[n].k[k], At[m].k[k], acc[ai][bj][m][n], 0, 0, 0); } } \
        __builtin_amdgcn_s_setprio(0); } while (0)
#define PG8_WAIT_V(n) asm volatile("s_waitcnt vmcnt(" #n ")" ::: "memory")
#define PG8_WAIT_L(n) asm volatile("s_waitcnt lgkmcnt(" #n ")" ::: "memory")
#define PG8_BAR __builtin_amdgcn_s_barrier()
#define PG8_SCHED __builtin_amdgcn_sched_barrier(0)
    Unit cur, nxt; int ui = 0;
    if (!S.next(0, cur)) return;
    int sc1 = 0x7F7F7F7F; asm volatile("" : "+v"(sc1));
    f32x4 acc[2][2][4][2];
#pragma unroll
    for (int a = 0; a < 2; ++a)
#pragma unroll
        for (int b = 0; b < 2; ++b)
#pragma unroll
            for (int m = 0; m < 4; ++m)
#pragma unroll
                for (int n = 0; n < 2; ++n) acc[a][b][m][n] = (f32x4){0.f, 0.f, 0.f, 0.f};
    typename FragSel<FP8>::T At[4], B0[2], B1[2];
    const char* cA = (const char*)A + (size_t)cur.arow0 * rstep;
    const char* cB = cur.B;
    typename Epi::Pre pre; E.pre(pre, cur, wr, fr);
    PG8_STAGE(PG8_SB(0, 0), cB, voffB); PG8_STAGE(PG8_SA(0, 0), cA, voffA); PG8_STAGE(PG8_SB(0, 1), cB + hstep, voffB); PG8_STAGE(PG8_SA(0, 1), cA + hstep, voffA);
    if (wr == 1) PG8_BAR;
    PG8_WAIT_V(4); PG8_BAR;
    PG8_STAGE(PG8_SB(1, 0), cB + kstep, voffB); PG8_STAGE(PG8_SA(1, 0), cA + kstep, voffA); PG8_STAGE(PG8_SB(1, 1), cB + hstep + kstep, voffB);
    PG8_WAIT_V(6); PG8_BAR;
    for (;;) {
        const bool has_next = S.next(ui + 1, nxt);
        const char* nA = has_next ? (const char*)A + (size_t)nxt.arow0 * rstep : cA; const char* nB = has_next ? nxt.B : cB;
#pragma unroll 1
        for (int t = 0; t < nt; t += 2) {
            const bool last = (t == nt - 2);
            const char* a1 = cA + (size_t)(t + 1) * kstep;
            const char* a2 = last ? nA : cA + (size_t)(t + 2) * kstep; const char* b2 = last ? nB : cB + (size_t)(t + 2) * kstep;
            const char* a3 = a2 + kstep; const char* b3 = b2 + kstep;
            PG8_LDB(B0, 0, 0); PG8_SCHED; PG8_LDA(At, 0, 0); PG8_STAGE(PG8_SA(1, 1), a1 + hstep, voffA);
            PG8_WAIT_L(8); PG8_BAR; PG8_WAIT_L(0); PG8_MMA(0, 0, At, B0); PG8_BAR; PG8_SCHED;
            PG8_LDB(B1, 0, 1); PG8_STAGE(PG8_SB(0, 0), b2, voffB);
            PG8_BAR; PG8_WAIT_L(0); PG8_MMA(0, 1, At, B1); PG8_BAR;
            PG8_LDA(At, 0, 1); PG8_STAGE(PG8_SA(0, 0), a2, voffA);
            PG8_BAR; PG8_WAIT_L(0); PG8_MMA(1, 0, At, B0); PG8_BAR; PG8_SCHED;
            PG8_STAGE(PG8_SB(0, 1), b2 + hstep, voffB);
            PG8_WAIT_V(6); PG8_BAR; PG8_MMA(1, 1, At, B1); PG8_BAR;
            PG8_LDB(B0, 1, 0); PG8_SCHED; PG8_LDA(At, 1, 0); PG8_STAGE(PG8_SA(0, 1), a2 + hstep, voffA);
            PG8_WAIT_L(8); PG8_BAR; PG8_WAIT_L(0); PG8_MMA(0, 0, At, B0); PG8_BAR; PG8_SCHED;
            PG8_LDB(B1, 1, 1); PG8_STAGE(PG8_SB(1, 0), b3, voffB);
            PG8_BAR; PG8_WAIT_L(0); PG8_MMA(0, 1, At, B1); PG8_BAR;
            PG8_LDA(At, 1, 1); PG8_STAGE(PG8_SA(1, 0), a3, voffA);
            PG8_BAR; PG8_WAIT_L(0); PG8_MMA(1, 0, At, B0); PG8_BAR; PG8_SCHED;
            PG8_STAGE(PG8_SB(1, 1), b3 + hstep, voffB);
            PG8_WAIT_V(6); PG8_BAR; PG8_MMA(1, 1, At, B1); PG8_BAR;
        }
        if constexpr (FP8) asm volatile("s_nop 15\n\ts_nop 15" ::: "memory");
        E(acc, cur, wr, wc, fr, fq, pre);
        if (!has_next) break;
#pragma unroll
        for (int a = 0; a < 2; ++a)
#pragma unroll
            for (int b = 0; b < 2; ++b)
#pragma unroll
                for (int m = 0; m < 4; ++m)
#pragma unroll
                    for (int n = 0; n < 2; ++n) acc[a][b][m][n] = (f32x4){0.f, 0.f, 0.f, 0.f};
        cur = nxt; cA = nA; cB = nB; ++ui;
        E.pre(pre, cur, wr, fr);
        if constexpr (FP8) asm volatile("s_nop 7" ::: "memory");
    }
    PG8_WAIT_V(0);
    if (wr == 0) PG8_BAR;
    PG8_BAR;
#undef PG8_SA
#undef PG8_SB
#undef PG8_STAGE
#undef PG8_LDA
#undef PG8_LDB
#undef PG8_MMA
#undef PG8_WAIT_V
#undef PG8_WAIT_L
#undef PG8_BAR
#undef PG8_SCHED
}
}

DEVI float lb_of(const float* lbraw, int ch) {
    const float r0 = lbraw[ch], r1 = lbraw[512 + ch], r2 = lbraw[1024 + ch];
    const float mx = fmaxf(r0, fmaxf(r1, r2));
    const float e0 = __expf(r0 - mx), e1 = __expf(r1 - mx), e2 = __expf(r2 - mx);
    return e0 / (e0 + e1 + e2);
}
constexpr int HQ = 0, HK = 17408, HKH = 34816, HV = 53248, HDV = 71680, HZERO = 73728, HOT = 75776, H_END = HOT + 64 * 528;
static_assert(H_END <= 131072, "hgrn lds");
constexpr size_t HS_SCAN = (size_t)16 * 16384;
struct HgrnRaw { unsigned qf[16]; u32x4 v0, v1; };
DEVI void hgrn_load(HgrnRaw& R, const bf16_t* u, const bf16_t* VT, int dir, int b, int h, int t0, int c, int I, int tid) {
    const bf16_t* up = u + ((size_t)b * SEQ + t0 + 16 * I) * UW + h * 128 + c;
    const int fcol = dir ? 1024 : 512;
#pragma unroll
    for (int j = 0; j < 16; ++j) R.qf[j] = (unsigned)up[(size_t)j * UW] | ((unsigned)up[(size_t)j * UW + fcol] << 16);
    { const int e = tid, r = e >> 3, cch = e & 7; R.v0 = *(const u32x4*)(VT + ((size_t)b * 512 + h * 128 + r) * SEQ + t0 + cch * 8); }
    { const int e = tid + NTHR, r = e >> 3, cch = e & 7; R.v1 = *(const u32x4*)(VT + ((size_t)b * 512 + h * 128 + r) * SEQ + t0 + cch * 8); }
}
DEVI void hgrn_prep(LAS unsigned char* lds, const HgrnRaw& R, float lbv, int dir, int c, int I, int tid) {
    float ff[16], kk[16], qq[16];
    { const int e = tid, r = e >> 3, cch = e & 7; *(LAS u32x4*)(lds + HV + r * 144 + cch * 16) = R.v0; }
    { const int e = tid + NTHR, r = e >> 3, cch = e & 7; *(LAS u32x4*)(lds + HV + r * 144 + cch * 16) = R.v1; }
#pragma unroll
    for (int j = 0; j < 16; ++j) {
        const float fr = bfhi(R.qf[j]), qr = bflo(R.qf[j]);
        const float f = lbv + (1.f - lbv) * sigmoid_f(fr);
        ff[j] = f; kk[j] = 1.f - f; qq[j] = silu_f(qr);
    }
    float run = 1.f;
#pragma unroll
    for (int jj = 0; jj < 16; ++jj) { const int j = dir ? 15 - jj : jj; run = fmaxf(run * ff[j], 1e-30f); ff[j] = run; }
    const float PG = run;
    float kh[16];
#pragma unroll
    for (int j = 0; j < 16; ++j) {
        const float kt = kk[j] * __builtin_amdgcn_rcpf(ff[j]);
        kh[j] = kt * PG;
        *(LAS bf16_t*)(lds + HQ + (16 * I + j) * 272 + c * 2) = f2bf(qq[j] * ff[j]);
        *(LAS bf16_t*)(lds + HK + (16 * I + j) * 272 + c * 2) = f2bf(kt);
    }
    u32x4 w0, w1;
    w0.x = pk2(kh[0], kh[1]); w0.y = pk2(kh[2], kh[3]); w0.z = pk2(kh[4], kh[5]); w0.w = pk2(kh[6], kh[7]);
    w1.x = pk2(kh[8], kh[9]); w1.y = pk2(kh[10], kh[11]); w1.z = pk2(kh[12], kh[13]); w1.w = pk2(kh[14], kh[15]);
    *(LAS u32x4*)(lds + HKH + c * 144 + I * 32) = w0; *(LAS u32x4*)(lds + HKH + c * 144 + I * 32 + 16) = w1;
    *(LAS float*)(lds + HDV + (I * 128 + c) * 4) = PG;
}
DEVI void hgrn_update(LAS unsigned char* lds, f32x4 (&Sacc)[8], int I, int wid, int fr, int fq) {
    const int voff = (fq < 2) ? HV + (16 * wid + fr) * 144 + (16 * I + 8 * fq) * 2 : HZERO;
    const int koff = (fq < 2) ? HKH + fr * 144 + (16 * I + 8 * fq) * 2 : HZERO;
    const int kstep = (fq < 2) ? 16 * 144 : 0;
    const bf16x8 vb = *(const LAS bf16x8*)(lds + voff);
    bf16x8 ka[8]; f32x4 dv[8];
#pragma unroll
    for (int m = 0; m < 8; ++m) { ka[m] = *(const LAS bf16x8*)(lds + koff + m * kstep); dv[m] = *(const LAS f32x4*)(lds + HDV + (I * 128 + 16 * m + 4 * fq) * 4); }
#pragma unroll
    for (int m = 0; m < 8; ++m) Sacc[m] = __builtin_amdgcn_mfma_f32_16x16x32_bf16(ka[m], vb, Sacc[m] * dv[m], 0, 0, 0);
}
DEVI void ph_hgrn_states(LAS unsigned char* lds, const bf16_t* u, const bf16_t* VT, const float* lbraw, float* HS, float* HD, int vb0, int vbs) {
    const int tid = opq((int)threadIdx.x), wid = __builtin_amdgcn_readfirstlane(tid >> 6), lane = tid & 63, fr = lane & 15, fq = lane >> 4;
    const int pc = tid & 127, pI = tid >> 7;
    for (int unit = vb0; unit < NB * 4 * 2 * 16; unit += vbs) {
        const int seg = unit & 15, dir = (unit >> 4) & 1, h = (unit >> 5) & 3, b = unit >> 7;
        const float lbv = lb_of(lbraw, h * 128 + pc);
        f32x4 Sacc[8];
#pragma unroll
        for (int m = 0; m < 8; ++m) Sacc[m] = (f32x4){0.f, 0.f, 0.f, 0.f};
        float gprod = 1.f;
        if (tid < 4) *(LAS unsigned*)(lds + HZERO + tid * 4) = 0u;
        HgrnRaw R; hgrn_load(R, u, VT, dir, b, h, seg * 256 + (dir ? 3 : 0) * 64, pc, pI, tid);
#pragma unroll 1
        for (int sbi = 0; sbi < 4; ++sbi) {
            const int sb = dir ? 3 - sbi : sbi;
            const int t0 = seg * 256 + sb * 64;
            __syncthreads();
            hgrn_prep(lds, R, lbv, dir, pc, pI, tid);
            if (sbi < 3) { const int sbn = dir ? 3 - (sbi + 1) : sbi + 1; hgrn_load(R, u, VT, dir, b, h, seg * 256 + sbn * 64, pc, pI, tid); }
            __syncthreads();
            if (tid < 128) gprod *= (*(const LAS float*)(lds + HDV + tid * 4) * *(const LAS float*)(lds + HDV + (128 + tid) * 4)) * (*(const LAS float*)(lds + HDV + (256 + tid) * 4) * *(const LAS float*)(lds + HDV + (384 + tid) * 4));
#pragma unroll 1
            for (int ii = 0; ii < 4; ++ii) { const int I = dir ? 3 - ii : ii; hgrn_update(lds, Sacc, I, wid, fr, fq); }
        }
        const size_t scan = (size_t)(b * 4 + h) * 2 + dir;
        float* dst = HS + scan * HS_SCAN + (size_t)seg * 16384;
#pragma unroll
        for (int m = 0; m < 8; ++m)
#pragma unroll
            for (int rg = 0; rg < 4; ++rg) dst[(16 * m + 4 * fq + rg) * 128 + 16 * wid + fr] = Sacc[m][rg];
        if (tid < 128) HD[(scan * 16 + seg) * 128 + tid] = gprod;
    }
    __syncthreads();
}
DEVI void ph_hgrn_scan(float* HS, const float* HD, int vb0, int vbs) {
    const int tid = opq((int)threadIdx.x);
    for (int idx = vb0 * NTHR + tid; idx < 32 * 4096; idx += vbs * NTHR) {
        const int scan = idx >> 12, e4 = idx & 4095, kch = e4 >> 5; const int dir = scan & 1;
        float4* base = (float4*)(HS + (size_t)scan * HS_SCAN) + e4;
        const float* hd = HD + (size_t)scan * 16 * 128 + kch;
        float4 d[16]; float dec[16];
#pragma unroll
        for (int i = 0; i < 16; ++i) { d[i] = base[(size_t)i * 4096]; dec[i] = hd[i * 128]; }
        float4 st = make_float4(0.f, 0.f, 0.f, 0.f);
        if (dir == 0) {
#pragma unroll
            for (int i = 0; i < 16; ++i) { const float4 t = d[i]; d[i] = st; st.x = st.x * dec[i] + t.x; st.y = st.y * dec[i] + t.y; st.z = st.z * dec[i] + t.z; st.w = st.w * dec[i] + t.w; }
        } else {
#pragma unroll
            for (int i = 15; i >= 0; --i) { const float4 t = d[i]; d[i] = st; st.x = st.x * dec[i] + t.x; st.y = st.y * dec[i] + t.y; st.z = st.z * dec[i] + t.z; st.w = st.w * dec[i] + t.w; }
        }
#pragma unroll
        for (int i = 0; i < 16; ++i) base[(size_t)i * 4096] = d[i];
    }
}
DEVI void ph_hgrn_out(LAS unsigned char* lds, const bf16_t* u, const bf16_t* VT, const float* lbraw, const float* a_norm, const float* HS, float* OF, bf16_t* ocat, int vb0, int vbs) {
    const int tid = opq((int)threadIdx.x), wid = __builtin_amdgcn_readfirstlane(tid >> 6), lane = tid & 63, fr = lane & 15, fq = lane >> 4;
    const int pc = tid & 127, pI = tid >> 7;
    const int otok = tid >> 3, opart = tid & 7;
    for (int unit = vb0; unit < NB * 4 * 16; unit += vbs) {
        const int seg = unit & 15, h = (unit >> 4) & 3, b = unit >> 6;
        const float lbv = lb_of(lbraw, h * 128 + pc);
        if (tid < 4) *(LAS unsigned*)(lds + HZERO + tid * 4) = 0u;
#pragma unroll 1
        for (int dir = 0; dir < 2; ++dir) {
            const size_t scan = (size_t)(b * 4 + h) * 2 + dir;
            const float* src = HS + scan * HS_SCAN + (size_t)seg * 16384;
            f32x4 Sacc[8];
#pragma unroll
            for (int m = 0; m < 8; ++m)
#pragma unroll
                for (int rg = 0; rg < 4; ++rg) Sacc[m][rg] = src[(16 * m + 4 * fq + rg) * 128 + 16 * wid + fr];
            HgrnRaw R; hgrn_load(R, u, VT, dir, b, h, seg * 256 + (dir ? 3 : 0) * 64, pc, pI, tid);
#pragma unroll 1
            for (int sbi = 0; sbi < 4; ++sbi) {
                const int sb = dir ? 3 - sbi : sbi;
                const int t0 = seg * 256 + sb * 64;
                const size_t tokb = (size_t)b * SEQ + t0;
                __syncthreads();
                hgrn_prep(lds, R, lbv, dir, pc, pI, tid);
                if (sbi < 3) { const int sbn = dir ? 3 - (sbi + 1) : sbi + 1; hgrn_load(R, u, VT, dir, b, h, seg * 256 + sbn * 64, pc, pI, tid); }
                __syncthreads();
#pragma unroll 1
                for (int ii = 0; ii < 4; ++ii) {
                    const int I = dir ? 3 - ii : ii;
                    f32x4 oT = {0.f, 0.f, 0.f, 0.f};
                    const LAS unsigned char* qrow = lds + HQ + (16 * I + fr) * 272;
#pragma unroll
                    for (int ks = 0; ks < 4; ++ks) {
                        u32x4 sa; sa.x = pg8::cvt_pk_bf16(Sacc[2 * ks][0], Sacc[2 * ks][1]); sa.y = pg8::cvt_pk_bf16(Sacc[2 * ks][2], Sacc[2 * ks][3]);
                        sa.z = pg8::cvt_pk_bf16(Sacc[2 * ks + 1][0], Sacc[2 * ks + 1][1]); sa.w = pg8::cvt_pk_bf16(Sacc[2 * ks + 1][2], Sacc[2 * ks + 1][3]);
                        const u32x2 q0 = *(const LAS u32x2*)(qrow + (32 * ks + 4 * fq) * 2), q1 = *(const LAS u32x2*)(qrow + (32 * ks + 16 + 4 * fq) * 2);
                        u32x4 qb; qb.x = q0.x; qb.y = q0.y; qb.z = q1.x; qb.w = q1.y;
                        oT = __builtin_amdgcn_mfma_f32_16x16x32_bf16(__builtin_bit_cast(bf16x8, sa), __builtin_bit_cast(bf16x8, qb), oT, 0, 0, 0);
                    }
                    f32x4 sT = {0.f, 0.f, 0.f, 0.f};
                    const LAS unsigned char* krow = lds + HK + (16 * I + fr) * 272;
#pragma unroll
                    for (int ks = 0; ks < 4; ++ks) {
                        const bf16x8 ka = *(const LAS bf16x8*)(krow + (32 * ks + 8 * fq) * 2), qb = *(const LAS bf16x8*)(qrow + (32 * ks + 8 * fq) * 2);
                        sT = __builtin_amdgcn_mfma_f32_16x16x32_bf16(ka, qb, sT, 0, 0, 0);
                    }
                    float pv[4];
#pragma unroll
                    for (int rg = 0; rg < 4; ++rg) { const int sl = 4 * fq + rg; const bool ok = dir ? (sl >= fr) : (sl <= fr); pv[rg] = ok ? sT[rg] : 0.f; }
                    u32x4 pb; pb.x = pg8::cvt_pk_bf16(pv[0], pv[1]); pb.y = pg8::cvt_pk_bf16(pv[2], pv[3]); pb.z = 0u; pb.w = 0u;
                    const u32x2 v0 = *(const LAS u32x2*)(lds + HV + (16 * wid + fr) * 144 + (16 * I + 4 * fq) * 2);
                    u32x4 va; va.x = v0.x; va.y = v0.y; va.z = 0u; va.w = 0u;
                    oT = __builtin_amdgcn_mfma_f32_16x16x32_bf16(__builtin_bit_cast(bf16x8, va), __builtin_bit_cast(bf16x8, pb), oT, 0, 0, 0);
                    if (dir == 0) *(f32x4*)(OF + (tokb + 16 * I + fr) * 512 + h * 128 + 16 * wid + 4 * fq) = oT;
                    else *(LAS f32x4*)(lds + HOT + (16 * I + fr) * 528 + (16 * wid + 4 * fq) * 4) = oT;
                    hgrn_update(lds, Sacc, I, wid, fr, fq);
                }
                if (dir == 1) {
                    __syncthreads();
                    const LAS float* orow = (const LAS float*)(lds + HOT + otok * 528) + opart * 16;
                    float* ofp = OF + (tokb + otok) * 512 + h * 128 + opart * 16;
                    float v[16]; float ss = 0.f;
#pragma unroll
                    for (int q2 = 0; q2 < 8; ++q2) { const unsigned long long w = __hip_atomic_load((unsigned long long*)(ofp + q2 * 2), __ATOMIC_RELAXED, __HIP_MEMORY_SCOPE_AGENT);
                        v[2 * q2] = __uint_as_float((unsigned)w) + orow[2 * q2]; v[2 * q2 + 1] = __uint_as_float((unsigned)(w >> 32)) + orow[2 * q2 + 1];
                        ss += v[2 * q2] * v[2 * q2] + v[2 * q2 + 1] * v[2 * q2 + 1]; }
                    ss += __shfl_xor(ss, 1); ss += __shfl_xor(ss, 2); ss += __shfl_xor(ss, 4);
                    const float rn = rsqrtf(ss * (1.f / 128.f) + EPS);
                    const bf16_t* gp = u + (tokb + otok) * UW + 2048 + h * 128 + opart * 16;
                    const u32x4 g0 = *(const u32x4*)gp, g1 = *(const u32x4*)(gp + 8);
                    const unsigned gw[8] = {g0.x, g0.y, g0.z, g0.w, g1.x, g1.y, g1.z, g1.w};
                    unsigned ow[8];
#pragma unroll
                    for (int q2 = 0; q2 < 8; ++q2) { const float an0 = a_norm[opart * 16 + 2 * q2], an1 = a_norm[opart * 16 + 2 * q2 + 1];
                        ow[q2] = pk2(v[2 * q2] * rn * an0 * silu_f(bflo(gw[q2])), v[2 * q2 + 1] * rn * an1 * silu_f(bfhi(gw[q2]))); }
                    bf16_t* op = ocat + (tokb + otok) * DM + h * 128 + opart * 16;
                    u32x4 o0, o1; o0.x = ow[0]; o0.y = ow[1]; o0.z = ow[2]; o0.w = ow[3]; o1.x = ow[4]; o1.y = ow[5]; o1.z = ow[6]; o1.w = ow[7];
                    *(u32x4*)op = o0; *(u32x4*)(op + 8) = o1;
                }
            }
            asm volatile("s_waitcnt vmcnt(0)" ::: "memory");
        }
    }
    __syncthreads();
}

DEVI void ph_prep(const bf16_t* u, const float* cw, const float* cb, bf16_t* xconv, bf16_t* XT, bf16_t* VT, int vb0, int vbs) {
    const int tid = opq((int)threadIdx.x);
    for (int unit = vb0; unit < NB * 32 * 3; unit += vbs) {
        const int cg = unit % 3, tb = (unit / 3) & 31, b = unit / 96;
        const int t0 = tb * 128;
        if (cg < 2) {
            const int ch = cg * 512 + tid;
            float w[5];
#pragma unroll
            for (int j = 0; j < 5; ++j) w[j] = cw[j * 1024 + ch];
            const float bias = cb[ch];
            const bf16_t* up = u + (size_t)b * SEQ * UW + 3072 + ch;
            float v0, v1, v2, v3;
            v0 = (t0 - 2 >= 0) ? bf2f(up[(size_t)(t0 - 2) * UW]) : 0.f;
            v1 = (t0 - 1 >= 0) ? bf2f(up[(size_t)(t0 - 1) * UW]) : 0.f;
            v2 = bf2f(up[(size_t)t0 * UW]);
            v3 = bf2f(up[(size_t)(t0 + 1) * UW]);
            for (int t8 = 0; t8 < 128; t8 += 32) {
                float nx[32];
#pragma unroll
                for (int i = 0; i < 32; ++i) { const int tt = t0 + t8 + i + 2; nx[i] = (tt < SEQ) ? bf2f(up[(size_t)tt * UW]) : 0.f; }
                unsigned pk[16];
#pragma unroll
                for (int i = 0; i < 32; ++i) {
                    const float o = silu_f(bias + w[0] * v0 + w[1] * v1 + w[2] * v2 + w[3] * v3 + w[4] * nx[i]);
                    const bf16_t ob = f2bf(o);
                    xconv[(size_t)(b * SEQ + t0 + t8 + i) * 1024 + ch] = ob;
                    if (i & 1) pk[i >> 1] |= ((unsigned)ob << 16); else pk[i >> 1] = ob;
                    v0 = v1; v1 = v2; v2 = v3; v3 = nx[i];
                }
                if (ch < 768) {
#pragma unroll
                    for (int q = 0; q < 4; ++q) { u32x4 o4; o4.x = pk[4 * q]; o4.y = pk[4 * q + 1]; o4.z = pk[4 * q + 2]; o4.w = pk[4 * q + 3]; *(u32x4*)(XT + ((size_t)b * 768 + ch) * SEQ + t0 + t8 + 8 * q) = o4; } }
            }
        } else {
            const int ch = tid;
            const bf16_t* up = u + (size_t)b * SEQ * UW + 1536 + ch;
            for (int t8 = 0; t8 < 128; t8 += 32) {
                unsigned pk[16];
#pragma unroll
                for (int i = 0; i < 32; ++i) { const unsigned ob = up[(size_t)(t0 + t8 + i) * UW]; if (i & 1) pk[i >> 1] |= (ob << 16); else pk[i >> 1] = ob; }
#pragma unroll
                for (int q = 0; q < 4; ++q) { u32x4 o4; o4.x = pk[4 * q]; o4.y = pk[4 * q + 1]; o4.z = pk[4 * q + 2]; o4.w = pk[4 * q + 3]; *(u32x4*)(VT + ((size_t)b * 512 + ch) * SEQ + t0 + t8 + 8 * q) = o4; }
            }
        }
    }
}

constexpr int MB_XT = 0, MB_BX = 256 * 272, MB_DT = MB_BX + 128 * 272, MB_CS = MB_DT + 8 * 128 * 4, MB_TOT = MB_CS + 8 * 128 * 4, MB_END = MB_TOT + 64;
static_assert(MB_END <= 131072, "mamba lds");
constexpr size_t MS_SCAN = (size_t)32 * 8192;
DEVI bf16x8 pack8(const float* v) { u32x4 w; w.x = pg8::cvt_pk_bf16(v[0], v[1]); w.y = pg8::cvt_pk_bf16(v[2], v[3]); w.z = pg8::cvt_pk_bf16(v[4], v[5]); w.w = pg8::cvt_pk_bf16(v[6], v[7]); return __builtin_bit_cast(bf16x8, w); }
DEVI void mamba_tables(LAS unsigned char* lds, const float* dtraw, const float* A_log, const float* dt_bias, int b, int g, int c, int wid, int lane) {
    LAS float* tdt = (LAS float*)(lds + MB_DT); LAS float* tcs = (LAS float*)(lds + MB_CS); LAS float* ttot = (LAS float*)(lds + MB_TOT);
    const int r = wid >> 1, dir = wid & 1, hd = 4 * g + r;
    const float A = -__expf(A_log[dir * 8 + hd]), bias = dt_bias[dir * 8 + hd];
    const size_t tk = (size_t)b * SEQ + c * 128 + 2 * lane;
    const float dt0 = softplus_f(dtraw[tk * 16 + dir * 8 + hd] + bias), dt1 = softplus_f(dtraw[(tk + 1) * 16 + dir * 8 + hd] + bias);
    const float a0 = dt0 * A, a1 = dt1 * A;
    float sc = a0 + a1;
#pragma unroll
    for (int off = 1; off < 64; off <<= 1) { const float v = __shfl_up(sc, off); if (lane >= off) sc += v; }
    const float total = __shfl(sc, 63);
    const float pre0 = sc - a1, pre1 = sc;
    const float c0 = dir ? (total - pre0 + a0) : pre0, c1 = dir ? (total - pre1 + a1) : pre1;
    tdt[wid * 128 + 2 * lane] = dt0; tdt[wid * 128 + 2 * lane + 1] = dt1;
    tcs[wid * 128 + 2 * lane] = c0; tcs[wid * 128 + 2 * lane + 1] = c1;
    if (lane == 0) ttot[wid] = total;
}
DEVI void stage_rows(LAS unsigned char* dst, const bf16_t* src, size_t src_stride, int rows, int tid) {
    for (int e = tid; e < rows * 16; e += NTHR) { const int r = e >> 4, cch = e & 15; *(LAS u32x4*)(dst + r * 272 + cch * 16) = *(const u32x4*)(src + (size_t)r * src_stride + cch * 8); }
}
DEVI void ph_mamba_states(LAS unsigned char* lds, const bf16_t* XT, const float* dtraw, const float* A_log, const float* dt_bias, float* MS, float* MD, int vb0, int vbs) {
    const int tid = opq((int)threadIdx.x), wid = __builtin_amdgcn_readfirstlane(tid >> 6), lane = tid & 63, fr = lane & 15, fq = lane >> 4;
    LAS float* tdt = (LAS float*)(lds + MB_DT); LAS float* tcs = (LAS float*)(lds + MB_CS); LAS float* ttot = (LAS float*)(lds + MB_TOT);
    for (int unit = vb0; unit < NB * 2 * 32; unit += vbs) {
        const int c = unit & 31, g = (unit >> 5) & 1, b = unit >> 6;
        __syncthreads();
        stage_rows(lds + MB_XT, XT + ((size_t)b * 768 + g * 256) * SEQ + c * 128, SEQ, 256, tid);
        stage_rows(lds + MB_BX, XT + ((size_t)b * 768 + 512 + g * 128) * SEQ + c * 128, SEQ, 128, tid);
        mamba_tables(lds, dtraw, A_log, dt_bias, b, g, c, wid, lane);
        __syncthreads();
        if (lane == 0) MD[((size_t)(b * 8 + 4 * g + (wid >> 1)) * 2 + (wid & 1)) * 32 + c] = __expf(ttot[wid]);
        for (int hdd = 0; hdd < 8; ++hdd) {
            const int r = hdd >> 1, dir = hdd & 1, hd = 4 * g + r;
            const float tot = ttot[hdd];
            f32x4 acc[4];
#pragma unroll
            for (int pt = 0; pt < 4; ++pt) acc[pt] = (f32x4){0.f, 0.f, 0.f, 0.f};
#pragma unroll
            for (int ks = 0; ks < 4; ++ks) {
                const int s0 = 32 * ks + 8 * fq;
                const u32x4 braw = *(const LAS u32x4*)(lds + MB_BX + (16 * wid + fr) * 272 + s0 * 2);
                float bw[8];
                const unsigned bu[4] = {braw.x, braw.y, braw.z, braw.w};
#pragma unroll
                for (int j = 0; j < 8; ++j) { const float bv = (j & 1) ? bfhi(bu[j >> 1]) : bflo(bu[j >> 1]);
                    bw[j] = bv * tdt[hdd * 128 + s0 + j] * __expf(tot - tcs[hdd * 128 + s0 + j]); }
                const bf16x8 Bf = pack8(bw);
#pragma unroll
                for (int pt = 0; pt < 4; ++pt) {
                    const bf16x8 Af = *(const LAS bf16x8*)(lds + MB_XT + (r * 64 + 16 * pt + fr) * 272 + s0 * 2);
                    acc[pt] = __builtin_amdgcn_mfma_f32_16x16x32_bf16(Af, Bf, acc[pt], 0, 0, 0);
                }
            }
            float* dst = MS + ((size_t)(b * 8 + hd) * 2 + dir) * MS_SCAN + (size_t)c * 8192;
#pragma unroll
            for (int pt = 0; pt < 4; ++pt)
#pragma unroll
                for (int rg = 0; rg < 4; ++rg) dst[(16 * pt + 4 * fq + rg) * 128 + 16 * wid + fr] = acc[pt][rg];
        }
    }
    __syncthreads();
}
DEVI void ph_mamba_scan(float* MS, const float* MD, int vb0, int vbs) {
    const int tid = opq((int)threadIdx.x);
    for (int idx = vb0 * NTHR + tid; idx < 64 * 2048; idx += vbs * NTHR) {
        const int scan = idx >> 11, e4 = idx & 2047; const int dir = scan & 1;
        float4* base = (float4*)(MS + (size_t)scan * MS_SCAN) + e4;
        const float* md = MD + (size_t)scan * 32;
        float4 h = make_float4(0.f, 0.f, 0.f, 0.f);
#pragma unroll 1
        for (int half = 0; half < 2; ++half) {
            const int c0 = (dir ? 1 - half : half) * 16;
            float4 d[16]; float dec[16];
#pragma unroll
            for (int i = 0; i < 16; ++i) { d[i] = base[(size_t)(c0 + i) * 2048]; dec[i] = md[c0 + i]; }
            if (dir == 0) {
#pragma unroll
                for (int i = 0; i < 16; ++i) { const float4 t = d[i]; d[i] = h; h.x = h.x * dec[i] + t.x; h.y = h.y * dec[i] + t.y; h.z = h.z * dec[i] + t.z; h.w = h.w * dec[i] + t.w; }
            } else {
#pragma unroll
                for (int i = 15; i >= 0; --i) { const float4 t = d[i]; d[i] = h; h.x = h.x * dec[i] + t.x; h.y = h.y * dec[i] + t.y; h.z = h.z * dec[i] + t.z; h.w = h.w * dec[i] + t.w; }
            }
#pragma unroll
            for (int i = 0; i < 16; ++i) base[(size_t)(c0 + i) * 2048] = d[i];
        }
    }
}
DEVI void ph_mamba_out(LAS unsigned char* lds, const bf16_t* u, const bf16_t* xconv, const bf16_t* XT, const float* dtraw, const float* A_log, const float* dt_bias, const float* Dskip, const float* b_norm,
                       const float* MS, bf16_t* ocat, int vb0, int vbs) {
    const int tid = opq((int)threadIdx.x), wid = __builtin_amdgcn_readfirstlane(tid >> 6), lane = tid & 63, fr = lane & 15, fq = lane >> 4;
    LAS float* tdt = (LAS float*)(lds + MB_DT); LAS float* tcs = (LAS float*)(lds + MB_CS);
    for (int unit = vb0; unit < NB * 2 * 32; unit += vbs) {
        const int c = unit & 31, g = (unit >> 5) & 1, b = unit >> 6;
        const size_t tok0 = (size_t)b * SEQ + c * 128;
        __syncthreads();
        stage_rows(lds + MB_XT, XT + ((size_t)b * 768 + g * 256) * SEQ + c * 128, SEQ, 256, tid);
        stage_rows(lds + MB_BX, xconv + tok0 * 1024 + 512 + g * 128, 1024, 128, tid);
        mamba_tables(lds, dtraw, A_log, dt_bias, b, g, c, wid, lane);
        const int tl = 16 * wid + fr;
        bf16x8 Cf[4];
#pragma unroll
        for (int ks = 0; ks < 4; ++ks) Cf[ks] = *(const bf16x8*)(xconv + (tok0 + tl) * 1024 + 768 + g * 128 + 32 * ks + 8 * fq);
        __syncthreads();
        f32x4 GT[8];
#pragma unroll
        for (int st = 0; st < 8; ++st) { GT[st] = (f32x4){0.f, 0.f, 0.f, 0.f};
            bf16x8 Af[4];
#pragma unroll
            for (int ks = 0; ks < 4; ++ks) Af[ks] = *(const LAS bf16x8*)(lds + MB_BX + (16 * st + fr) * 272 + (32 * ks + 8 * fq) * 2);
#pragma unroll
            for (int ks = 0; ks < 4; ++ks) GT[st] = __builtin_amdgcn_mfma_f32_16x16x32_bf16(Af[ks], Cf[ks], GT[st], 0, 0, 0); }
        float ss = 0.f;
        __syncthreads();
        float4 hpre[4];
        { const float* hin0 = MS + ((size_t)(b * 8 + 4 * g) * 2) * MS_SCAN + (size_t)c * 8192;
#pragma unroll
          for (int q = 0; q < 4; ++q) hpre[q] = ((const float4*)hin0)[tid + q * NTHR]; }
#pragma unroll 1
        for (int r = 0; r < 4; ++r) {
            const int hd = 4 * g + r;
            f32x4 yv[4];
#pragma unroll
            for (int pt = 0; pt < 4; ++pt) yv[pt] = (f32x4){0.f, 0.f, 0.f, 0.f};
#pragma unroll 1
            for (int dir = 0; dir < 2; ++dir) {
                const int hdd = r * 2 + dir;
                const float cst = tcs[hdd * 128 + tl];
                LAS unsigned char* hbuf = lds + MB_BX + (hdd & 1) * 17408;
#pragma unroll
                for (int q = 0; q < 4; ++q) { const int e4 = tid + q * NTHR, pp = e4 >> 5, n4 = (e4 & 31) * 4;
                    u32x2 w; w.x = pk2(hpre[q].x, hpre[q].y); w.y = pk2(hpre[q].z, hpre[q].w); *(LAS u32x2*)(hbuf + pp * 272 + n4 * 2) = w; }
                if (hdd < 7) { const int hn = hdd + 1; const float* hinn = MS + ((size_t)(b * 8 + 4 * g + (hn >> 1)) * 2 + (hn & 1)) * MS_SCAN + (size_t)c * 8192;
#pragma unroll
                    for (int q = 0; q < 4; ++q) hpre[q] = ((const float4*)hinn)[tid + q * NTHR]; }
                __syncthreads();
                f32x4 yo[4];
#pragma unroll
                for (int pt = 0; pt < 4; ++pt) { yo[pt] = (f32x4){0.f, 0.f, 0.f, 0.f};
                    bf16x8 hf[4];
#pragma unroll
                    for (int ks = 0; ks < 4; ++ks) hf[ks] = *(const LAS bf16x8*)(hbuf + (16 * pt + fr) * 272 + (32 * ks + 8 * fq) * 2);
#pragma unroll
                    for (int ks = 0; ks < 4; ++ks) yo[pt] = __builtin_amdgcn_mfma_f32_16x16x32_bf16(hf[ks], Cf[ks], yo[pt], 0, 0, 0); }
                const float eo = __expf(cst);
#pragma unroll
                for (int pt = 0; pt < 4; ++pt) yv[pt] += yo[pt] * eo;
#pragma unroll
                for (int kp = 0; kp < 4; ++kp) {
                    const bool skip = dir ? (2 * kp + 1 < wid) : (2 * kp > wid);
                    if (!skip) {
                        float pv[8];
#pragma unroll
                        for (int hlf = 0; hlf < 2; ++hlf) { const int st = 2 * kp + hlf;
                            const f32x4 cs4 = *(const LAS f32x4*)(tcs + hdd * 128 + 16 * st + 4 * fq), dt4 = *(const LAS f32x4*)(tdt + hdd * 128 + 16 * st + 4 * fq);
#pragma unroll
                            for (int rg = 0; rg < 4; ++rg) { const int sl = 16 * st + 4 * fq + rg;
                                const bool ok = dir ? (sl >= tl) : (sl <= tl);
                                const float e = __expf(fminf(cst - cs4[rg], 0.f));
                                pv[hlf * 4 + rg] = ok ? GT[st][rg] * e * dt4[rg] : 0.f; } }
                        u32x2 x0[4], x1[4];
#pragma unroll
                        for (int pt = 0; pt < 4; ++pt) { const LAS unsigned char* xr = lds + MB_XT + (r * 64 + 16 * pt + fr) * 272;
                            x0[pt] = *(const LAS u32x2*)(xr + (32 * kp + 4 * fq) * 2); x1[pt] = *(const LAS u32x2*)(xr + (32 * kp + 16 + 4 * fq) * 2); }
                        const bf16x8 Pf = pack8(pv);
#pragma unroll
                        for (int pt = 0; pt < 4; ++pt) {
                            u32x4 xa; xa.x = x0[pt].x; xa.y = x0[pt].y; xa.z = x1[pt].x; xa.w = x1[pt].y;
                            yv[pt] = __builtin_amdgcn_mfma_f32_16x16x32_bf16(__builtin_bit_cast(bf16x8, xa), Pf, yv[pt], 0, 0, 0);
                        }
                    }
                }
            }
            const float Dk = Dskip[hd];
#pragma unroll
            for (int pt = 0; pt < 4; ++pt) {
                const int p0 = 16 * pt + 4 * fq;
                const u32x2 xr = *(const u32x2*)(xconv + (tok0 + tl) * 1024 + hd * 64 + p0);
                const u32x2 zr = *(const u32x2*)(u + (tok0 + tl) * UW + 2560 + hd * 64 + p0);
                const float xs[4] = {bflo(xr.x), bfhi(xr.x), bflo(xr.y), bfhi(xr.y)}, zs[4] = {bflo(zr.x), bfhi(zr.x), bflo(zr.y), bfhi(zr.y)};
                float yy[4];
#pragma unroll
                for (int rg = 0; rg < 4; ++rg) { const float y = (yv[pt][rg] + Dk * xs[rg]) * silu_f(zs[rg]); yy[rg] = y; ss += y * y; }
                const unsigned long long o = (unsigned long long)pk2(yy[0], yy[1]) | ((unsigned long long)pk2(yy[2], yy[3]) << 32);
                __hip_atomic_store((unsigned long long*)(ocat + (tok0 + tl) * DM + 512 + g * 256 + r * 64 + p0), o, __ATOMIC_RELAXED, __HIP_MEMORY_SCOPE_AGENT);
            }
        }
        ss += __shfl_xor(ss, 16); ss += __shfl_xor(ss, 32);
        const float rn = rsqrtf(ss * (1.f / 256.f) + EPS);
        asm volatile("s_waitcnt vmcnt(0)" ::: "memory");
        unsigned long long pk[16];
#pragma unroll
        for (int q = 0; q < 16; ++q) pk[q] = __hip_atomic_load((unsigned long long*)(ocat + (tok0 + tl) * DM + 512 + g * 256 + (q >> 2) * 64 + 16 * (q & 3) + 4 * fq), __ATOMIC_RELAXED, __HIP_MEMORY_SCOPE_AGENT);
#pragma unroll
        for (int r = 0; r < 4; ++r)
#pragma unroll
            for (int pt = 0; pt < 4; ++pt) {
                const int cc = g * 256 + r * 64 + 16 * pt + 4 * fq;
                unsigned long long* op = (unsigned long long*)(ocat + (tok0 + tl) * DM + 512 + cc);
                const unsigned long long v = pk[r * 4 + pt];
                const unsigned vlo = (unsigned)v, vhi = (unsigned)(v >> 32);
                const float4 bn = *(const float4*)(b_norm + cc);
                const unsigned long long o = (unsigned long long)pk2(bflo(vlo) * rn * bn.x, bfhi(vlo) * rn * bn.y) | ((unsigned long long)pk2(bflo(vhi) * rn * bn.z, bfhi(vhi) * rn * bn.w) << 32);
                *op = o;
            }
    }
    __syncthreads();
}


constexpr int NA_RING = 12, NA_VT = 0, NA_VSTRIDE = NA_RING * 64 * 2 + 16, NA_BIAS = 64 * NA_VSTRIDE, NA_END = NA_BIAS + 480 * 4;
static_assert(NA_END <= 131072, "na lds");
DEVI void ph_na(LAS unsigned char* lds, const bf16_t* qkv, const float* rpb, bf16_t* oc, int vb0, int vbs) {
    const int tid = opq((int)threadIdx.x), wid = __builtin_amdgcn_readfirstlane(tid >> 6), lane = tid & 63, fr = lane & 15, fq = lane >> 4;
    LAS float* bl = (LAS float*)(lds + NA_BIAS);
    for (int chunk = vb0; chunk < NB * 16 * 4; chunk += vbs) {
        const int qr4 = chunk & 3, h = (chunk >> 2) & 15, b = chunk >> 6;
        __syncthreads();
        for (int e = tid; e < 465; e += NTHR) bl[e] = rpb[h * 465 + e];
        int staged_hi = -1;
#pragma unroll 1
        for (int ui = 0; ui < 8; ++ui) {
            const int rp = qr4 * 8 + ui;
            const int r0 = 2 * rp, rs0 = min(max(r0 - 4, 0), 56);
            const int need_hi = min(rs0 + 8, 63);
            const int lo = max(staged_hi + 1, rs0);
            for (int task = wid; task < (need_hi - lo + 1) * 8; task += 8) {
                const int kr = lo + (task >> 3), ch = task & 7, slot = kr % NA_RING;
                const u32x4 v = *(const u32x4*)(qkv + ((size_t)b * SEQ + kr * 64 + lane) * 3072 + 2048 + h * 64 + ch * 8);
                const unsigned vw[4] = {v.x, v.y, v.z, v.w};
#pragma unroll
                for (int i = 0; i < 8; ++i) *(LAS bf16_t*)(lds + NA_VT + (ch * 8 + i) * NA_VSTRIDE + (slot * 64 + lane) * 2) = (bf16_t)((i & 1) ? (vw[i >> 1] >> 16) : (vw[i >> 1] & 0xffffu));
            }
            staged_hi = need_hi > staged_hi ? need_hi : staged_hi;
            __syncthreads();
            const int r = r0 + (wid >> 2), j = wid & 3;
            const int rs = min(max(r - 4, 0), 56);
            const int bs = (j == 0) ? 0 : (j == 1) ? 8 : (j == 2) ? 24 : 32;
            const int c = 16 * j + fr, qs = min(max(c - 8, 0), 48);
            const size_t qtok = (size_t)b * SEQ + r * 64 + c;
            bf16x8 Qf[2];
#pragma unroll
            for (int ks = 0; ks < 2; ++ks) Qf[ks] = *(const bf16x8*)(qkv + qtok * 3072 + h * 64 + 32 * ks + 8 * fq);
            const bf16_t* kbase = qkv + ((size_t)b * SEQ + rs * 64 + bs + fr) * 3072 + 1024 + h * 64 + 8 * fq;
            bf16x8 kn[4];
#pragma unroll
            for (int q = 0; q < 4; ++q) kn[q] = *(const bf16x8*)(kbase + (size_t)((q >> 1) * 16) * 3072 + (q & 1) * 32);
            f32x4 O[4];
#pragma unroll
            for (int dt = 0; dt < 4; ++dt) O[dt] = (f32x4){0.f, 0.f, 0.f, 0.f};
            float mrun = -1e30f, lrun = 0.f;
#pragma unroll 1
            for (int dr = 0; dr < 8; ++dr) {
                bf16x8 kc[4];
#pragma unroll
                for (int q = 0; q < 4; ++q) kc[q] = kn[q];
                const int drn = dr < 7 ? dr + 1 : 7;
#pragma unroll
                for (int q = 0; q < 4; ++q) kn[q] = *(const bf16x8*)(kbase + ((size_t)drn * 64 + (q >> 1) * 16) * 3072 + (q & 1) * 32);
                float sv[8]; float mloc = -1e30f;
                const LAS float* brow = bl + (rs + dr - r + 7) * 31;
#pragma unroll
                for (int kg = 0; kg < 2; ++kg) {
                    f32x4 acc = {0.f, 0.f, 0.f, 0.f};
                    acc = __builtin_amdgcn_mfma_f32_16x16x32_bf16(kc[kg * 2], Qf[0], acc, 0, 0, 0);
                    acc = __builtin_amdgcn_mfma_f32_16x16x32_bf16(kc[kg * 2 + 1], Qf[1], acc, 0, 0, 0);
#pragma unroll
                    for (int rg = 0; rg < 4; ++rg) {
                        const int kcol = bs + 16 * kg + 4 * fq + rg;
                        const bool ok = (kcol >= qs) && (kcol < qs + 16);
                        const int dc = min(max(kcol - c + 15, 0), 30);
                        const float sc = ok ? acc[rg] * 0.125f + brow[dc] : -1e30f;
                        sv[kg * 4 + rg] = sc; mloc = fmaxf(mloc, sc);
                    }
                }
                mloc = fmaxf(mloc, __shfl_xor(mloc, 16)); mloc = fmaxf(mloc, __shfl_xor(mloc, 32));
                const float mnew = fmaxf(mrun, mloc);
                const float alpha = __expf(mrun - mnew);
                float psum = 0.f;
#pragma unroll
                for (int i = 0; i < 8; ++i) { const float p = __expf(sv[i] - mnew); sv[i] = p; psum += p; }
                psum += __shfl_xor(psum, 16); psum += __shfl_xor(psum, 32);
                lrun = lrun * alpha + psum; mrun = mnew;
                const bf16x8 Pf = pack8(sv);
                const int koff = (((rs + dr) % NA_RING) * 64 + bs + 4 * fq) * 2;
#pragma unroll
                for (int dt = 0; dt < 4; ++dt) {
                    const LAS unsigned char* vr = lds + NA_VT + (16 * dt + fr) * NA_VSTRIDE + koff;
                    const u32x2 v0 = *(const LAS u32x2*)vr, v1 = *(const LAS u32x2*)(vr + 32);
                    u32x4 va; va.x = v0.x; va.y = v0.y; va.z = v1.x; va.w = v1.y;
                    O[dt] = __builtin_amdgcn_mfma_f32_16x16x32_bf16(__builtin_bit_cast(bf16x8, va), Pf, O[dt] * alpha, 0, 0, 0);
                }
            }
            const float il = 1.f / lrun;
#pragma unroll
            for (int dt = 0; dt < 4; ++dt) {
                u32x2 o; o.x = pk2(O[dt][0] * il, O[dt][1] * il); o.y = pk2(O[dt][2] * il, O[dt][3] * il);
                *(u32x2*)(oc + qtok * DM + h * 64 + 16 * dt + 4 * fq) = o;
            }
        }
    }
    __syncthreads();
}

#define XB_TMO      128
#define XB_XCNT(j)  (256  + 64 * (j))
#define XB_XSUB(j)  (1280 + 64 * (j))
#define XB_XGEN(j)  (2304 + 64 * (j))
#define XB_TOP      3328
#define XB_TOPGEN   3392
#define XCD_BAR_WORDS 3456
#define XB_SPIN_CAP (1u << 18)

__device__ __forceinline__ unsigned xb_ld(unsigned* p)              { return __hip_atomic_load(p, __ATOMIC_RELAXED, __HIP_MEMORY_SCOPE_AGENT); }
__device__ __forceinline__ unsigned xb_add(unsigned* p, unsigned v) { return __hip_atomic_fetch_add(p, v, __ATOMIC_RELAXED, __HIP_MEMORY_SCOPE_AGENT); }
__device__ __forceinline__ unsigned xb_xcc_id() { return (unsigned)__builtin_amdgcn_s_getreg((3 << 11) | 20) & 0xFu; }
#define XB_SPIN(cond, bar) do { unsigned _sp = 0; while (cond) { __builtin_amdgcn_s_sleep(1); \
    if ((++_sp & 255u) == 0u) { if (xb_ld(&(bar)[XB_TMO])) break; if (_sp > XB_SPIN_CAP) { atomicAdd(&(bar)[XB_TMO], 1u); break; } } } } while (0)

struct XcdBarrier {
    unsigned* bar; unsigned x;
    volatile LAS unsigned* st;
};

__device__ __forceinline__ XcdBarrier xcd_barrier_post(unsigned* bar, volatile LAS unsigned* st) {
    XcdBarrier b; b.bar = bar; b.x = xb_xcc_id(); b.st = st;
    if (threadIdx.x == 0) (void)xb_add(&bar[XB_XCNT(b.x)], 1u);
    return b;
}
__device__ __forceinline__ void xcd_barrier_complete(unsigned* bar, unsigned x, unsigned& nloc, unsigned& nx) {
    const unsigned G = gridDim.x * gridDim.y * gridDim.z;
    unsigned sum, cnt, mine, sp = 0u;
    for (;;) {
        sum = 0u; cnt = 0u; mine = 0u;
#pragma unroll
        for (unsigned j = 0; j < 16; ++j) { const unsigned c = xb_ld(&bar[XB_XCNT(j)]); sum += c; cnt += (c > 0u) ? 1u : 0u; mine = (j == x) ? c : mine; }
        if (sum == G) break;
        __builtin_amdgcn_s_sleep(1);
        if ((++sp & 255u) == 0u) { if (xb_ld(&bar[XB_TMO])) break; if (sp > XB_SPIN_CAP) { atomicAdd(&bar[XB_TMO], 1u); break; } }
    }
    nloc = mine > 0u ? mine : 1u; nx = cnt > 0u ? cnt : 1u;
}

__device__ __forceinline__ void xcd_barrier(const XcdBarrier& b) {
    asm volatile("s_waitcnt vmcnt(0)" ::: "memory");
    __syncthreads();
    if (threadIdx.x == 0) {
        unsigned* bar = b.bar;
        __builtin_amdgcn_s_waitcnt(0);
        unsigned nloc = b.st[0], nx = b.st[1];
        if (nloc == 0u) { xcd_barrier_complete(bar, b.x, nloc, nx); b.st[0] = nloc; b.st[1] = nx; }
        const unsigned old = xb_add(&bar[XB_XSUB(b.x)], 1u);
        const unsigned gen = old / nloc;
        if (old + 1u == (gen + 1u) * nloc) {
            __builtin_amdgcn_fence(__ATOMIC_RELEASE, "agent");
            asm volatile("s_waitcnt vmcnt(0)" ::: "memory");
            const unsigned og = xb_add(&bar[XB_TOP], 1u);
            const unsigned tg = og / nx;
            if (og + 1u == (tg + 1u) * nx) xb_add(&bar[XB_TOPGEN], 1u);
            else XB_SPIN(xb_ld(&bar[XB_TOPGEN]) == tg, bar);
            __builtin_amdgcn_fence(__ATOMIC_ACQUIRE, "agent");
            xb_add(&bar[XB_XGEN(b.x)], 1u);
            asm volatile("s_waitcnt vmcnt(0)" ::: "memory");
        } else {
            XB_SPIN(xb_ld(&bar[XB_XGEN(b.x)]) == gen, bar);
            __builtin_amdgcn_fence(__ATOMIC_ACQUIRE, "agent");
            asm volatile("s_waitcnt vmcnt(0)" ::: "memory");
        }
    }
    __syncthreads();
}


struct Args { const float* in[34]; float* out; unsigned char* ws; int ph_lo, ph_hi; };
constexpr int N_PHASES = 22;

__global__ void __launch_bounds__(NTHR, 2) fwd(Args a) {
    extern __shared__ __attribute__((aligned(16))) unsigned char lds_raw[];
    float* lds = (float*)lds_raw;
    LAS unsigned char* ldsl = (LAS unsigned char*)lds_raw;
    const int vb0 = blockIdx.x, vbs = gridDim.x;
    const int lo = a.ph_lo, hi = a.ph_hi;
#define IN(k) (lo <= (k) && (k) < hi)
#define SEAM(k) do { if (IN(k) && IN((k) + 1)) xcd_barrier(bar); } while (0)
    volatile LAS unsigned* misc = (volatile LAS unsigned*)(ldsl + MISC_OFF);
    if (threadIdx.x < 4) misc[threadIdx.x] = 0u;
    __syncthreads();
    XcdBarrier bar = xcd_barrier_post((unsigned*)(a.ws + WS_CTL) + CW_BAR, misc);
    unsigned char* ws = a.ws;
    unsigned* ctl = (unsigned*)(ws + WS_CTL);
    unsigned* cnt = ctl + CW_CNT;
    int* list = (int*)(ws + WS_LIST); float* gatev = (float*)(ws + WS_GATE);
    float* dtraw = (float*)(ws + WS_DT); float* RS = (float*)(ws + WS_RS);
    bf16_t* XB = (bf16_t*)(ws + WS_XB); bf16_t* UB = (bf16_t*)(ws + WS_UB);
    bf16_t* YA = (bf16_t*)(ws + WS_YA); float* OF = (float*)(ws + WS_OF); bf16_t* OC = (bf16_t*)(ws + WS_OC);
    bf16_t* YP = (bf16_t*)(ws + WS_YP); bf16_t* YP1 = (bf16_t*)(ws + WS_YP1); bf16_t* XC = (bf16_t*)(ws + WS_YP);
    bf16_t* PB0 = (bf16_t*)(ws + WS_PB0); bf16_t* PB1 = (bf16_t*)(ws + WS_PB1);
    bf16_t* YB = (bf16_t*)(ws + WS_Y);
    float* MS = (float*)(ws + WS_MS); float* MD = (float*)(ws + WS_MD);
    float* HS = (float*)(ws + WS_HS); float* HD = (float*)(ws + WS_HD);
    bf16_t* XT = (bf16_t*)(ws + WS_XT); bf16_t* VT = (bf16_t*)(ws + WS_VT);
    const float* p_in = a.in[1];
    const int G = (int)gridDim.x, cb = (int)blockIdx.x;
    const NormB NB0{nullptr, XB, nullptr, nullptr, RS, nullptr, nullptr, nullptr, nullptr, nullptr, nullptr, nullptr, nullptr, nullptr, nullptr};
    unsigned char* XG8 = ws + WS_XG8;
    float* rsl = (float*)(ws + WS_DT);

    if (IN(0)) {
        ph_convert_weights(ldsl, a.in, ws, 0, ITEMS_DENSE, vb0, vbs);
        NormB A = NB0; A.xin = a.in[0]; A.gnext = a.in[3]; A.win = a.in[4]; A.dtraw = dtraw;
        ph_norm2<0, false, true, false>(A, vb0, vbs, (LAS float*)ldsl);
    }
    SEAM(0);
    if (IN(1)) { pg8::DenseOrder S; S.init(MT, UW, DM, (const bf16_t*)(ws + W_IN), G, cb); pg8::gemm_phase(ldsl, XB, DM, S, pg8::EpiBf16{UB, UW, RS}); }
    SEAM(1);
    if (IN(2)) { ph_prep(UB, a.in[5], a.in[6], XC, XT, VT, vb0, vbs); }
    SEAM(2);
    if (IN(3)) { ph_hgrn_states(ldsl, UB, VT, a.in[2], HS, HD, vb0, vbs); ph_mamba_states(ldsl, XT, dtraw, a.in[7], a.in[8], MS, MD, vb0, vbs); }
    SEAM(3);
    if (IN(4)) { ph_hgrn_scan(HS, HD, vb0, vbs); ph_mamba_scan(MS, MD, vb0, vbs); }
    SEAM(4);
    if (IN(5)) { ph_hgrn_out(ldsl, UB, VT, a.in[2], a.in[10], HS, OF, OC, vb0, vbs); ph_mamba_out(ldsl, UB, XC, XT, dtraw, a.in[7], a.in[8], a.in[9], a.in[11], MS, OC, vb0, vbs); }
    SEAM(5);
    if (IN(6)) { pg8::DenseOrder S; S.init(MT, DM, DM, (const bf16_t*)(ws + W_OUTE), G, cb); pg8::gemm_phase(ldsl, OC, DM, S, pg8::EpiBf16{YA, DM, nullptr}); }
    SEAM(6);
    if (IN(7)) {
        NormB A = NB0; A.y = YA; A.gpost = a.in[13];
        ph_norm2<1, false, false, false>(A, vb0, vbs);
        ph_cvt_rows(p_in, PB0, (size_t)MT * PDIM / 4, vb0, vbs);
        ph_convert_weights(ldsl, a.in, ws, ITEMS_DENSE, ITEMS_ALL, vb0, vbs);
    }
    SEAM(7);
    if (IN(8)) {
        { pg8::DenseOrder S; S.init(MT, 2 * DFF, DM, (const bf16_t*)(ws + W_GU), G, cb); pg8::gemm_phase(ldsl, XB, DM, S, pg8::EpiSwiglu{UB, DFF, RS, 0}); }
        { pg8::TailOrder S; S.init(MT, DM, PDIM, (const bf16_t*)(ws + W_PP), G, cb, (MT / 256) * (2 * DFF / 256) % G); pg8::gemm_phase(ldsl, PB0, PDIM, S, pg8::EpiBf16{YP, DM, nullptr}); }
    }
    SEAM(8);
    if (IN(9)) { pg8::DenseOrder S; S.init(MT, DM, DFF, (const bf16_t*)(ws + W_DN), G, cb); pg8::gemm_phase(ldsl, UB, DFF, S, pg8::EpiBf16{YA, DM, nullptr}); }
    SEAM(9);
    if (IN(10)) {
        NormB A = NB0; A.y = YA; A.gpost = a.in[18];
        ph_norm2<1, false, false, false>(A, vb0, vbs);
    }
    SEAM(10);
    if (IN(11)) { pg8::DenseOrder S; S.init(MT, DM, DM, (const bf16_t*)(ws + W_PG), G, cb); pg8::gemm_phase(ldsl, XB, DM, S, pg8::EpiPleGate{YP, DM, RS}); }
    SEAM(11);
    if (IN(12)) {
        NormB A = NB0; A.y = YP; A.gpost = a.in[33];
        ph_norm2<1, false, false, false>(A, vb0, vbs);
    }
    SEAM(12);
    if (IN(13)) { pg8::DenseOrder S; S.init(MT, 3072, DM, (const bf16_t*)(ws + W_QKV), G, cb); pg8::gemm_phase(ldsl, XB, DM, S, pg8::EpiBf16{UB, 3072, RS}); }
    SEAM(13);
    if (IN(14)) { ph_na(ldsl, UB, a.in[21], OC, vb0, vbs); }
    SEAM(14);
    if (IN(15)) { pg8::DenseOrder S; S.init(MT, DM, DM, (const bf16_t*)(ws + W_OUTO), G, cb); pg8::gemm_phase(ldsl, OC, DM, S, pg8::EpiBf16{YP1, DM, nullptr}); }
    SEAM(15);
    if (IN(16)) {
        NormB A = NB0; A.y = YP1; A.gpost = a.in[23]; A.gnext = a.in[24]; A.wr = a.in[25]; A.cnt = cnt; A.list = list; A.gatev = gatev; A.rsl = rsl; A.x8 = XG8;
        ph_norm2<1, false, false, true>(A, vb0, vbs, (LAS float*)ldsl);
        ph_cvt_rows(p_in + (size_t)MT * PDIM, PB1, (size_t)MT * PDIM / 4, vb0, vbs);
    }
    SEAM(16);
    if (IN(17)) { pg8::MoeOrder S; S.init(cnt, (volatile LAS int*)(ldsl + MISC_OFF + 64), 2 * DFFE, DM / 2, (const bf16_t*)(ws + W_EGU), (size_t)7 * MiB, true, G, cb);
        pg8::gemm_phase<pg8::EpiSwiglu8, pg8::MoeOrder, true>(ldsl, (const bf16_t*)XG8, DM / 2, S, pg8::EpiSwiglu8{(unsigned char*)UB, DFFE, rsl}); }
    SEAM(17);
    if (IN(18)) { pg8::MoeOrder S; S.init(cnt, (volatile LAS int*)(ldsl + MISC_OFF + 64), DM, DFFE / 2, (const bf16_t*)(ws + W_EDN), (size_t)(7 * MiB / 2), false, G, cb);
        pg8::gemm_phase<pg8::EpiMoeDown, pg8::MoeOrder, true>(ldsl, UB, DFFE / 2, S, pg8::EpiMoeDown{YB, list, gatev, 1.f / (pg8::W8_SCALE * pg8::ACT8_SCALE)});
        { pg8::TailOrder T; T.init(MT, DM, PDIM, (const bf16_t*)(ws + W_PP + 512 * 1024), G, cb, S.nwg % G); pg8::gemm_phase(ldsl, PB1, PDIM, T, pg8::EpiBf16{YP, DM, nullptr}); } }
    SEAM(18);
    if (IN(19)) {
        NormB A = NB0; A.y = YB; A.gpost = a.in[29];
        ph_norm2<2, false, false, false>(A, vb0, vbs);
    }
    SEAM(19);
    if (IN(20)) { pg8::DenseOrder S; S.init(MT, DM, DM, (const bf16_t*)(ws + W_PG + 2 * MiB), G, cb); pg8::gemm_phase(ldsl, XB, DM, S, pg8::EpiPleGate{YP, DM, RS}); }
    SEAM(20);
    if (IN(21)) {
        NormB A = NB0; A.y = YP; A.gpost = a.in[33] + DM; A.xout = a.out;
        ph_norm2<1, true, false, false>(A, vb0, vbs);
    }
#undef IN
#undef SEAM
}

extern "C" void kernel_launch(void* const* d_in, const int* in_sizes, int n_in, void* d_out, int out_size, void* d_ws, size_t ws_size, hipStream_t stream) {
    static int grid = 0;
    if (grid == 0) {
        if (n_in != 34 || out_size != MT * DM || ws_size < WS_END) { fprintf(stderr, "kernel_launch: unexpected shapes n_in %d out %d ws %zu (need %zu)\n", n_in, out_size, ws_size, (size_t)WS_END); grid = -1; return; }
        int dev = 0, cus = 0;
        if (hipGetDevice(&dev) != hipSuccess || hipDeviceGetAttribute(&cus, hipDeviceAttributeMultiprocessorCount, dev) != hipSuccess) { grid = -1; return; }
        if (hipFuncSetAttribute((const void*)fwd, hipFuncAttributeMaxDynamicSharedMemorySize, LDS_BYTES) != hipSuccess) { fprintf(stderr, "hipFuncSetAttribute failed\n"); grid = -1; return; }
        (void)hipGetLastError();
        grid = cus;
    }
    if (grid < 0) return;
    (void)hipMemsetAsync((char*)d_ws + WS_CTL, 0, CTL_ZERO_BYTES, stream);
    Args a{};
    for (int i = 0; i < 34; ++i) a.in[i] = (const float*)d_in[i];
    a.out = (float*)d_out; a.ws = (unsigned char*)d_ws;
#ifndef MK_PER_PHASE
    a.ph_lo = 0; a.ph_hi = N_PHASES;
    hipLaunchKernelGGL(fwd, dim3(grid), dim3(NTHR), LDS_BYTES, stream, a);
#else
    for (int ph = 0; ph < N_PHASES; ++ph) {
        a.ph_lo = ph; a.ph_hi = ph + 1;
        hipLaunchKernelGGL(fwd, dim3(grid), dim3(NTHR), LDS_BYTES, stream, a);
    }
#endif
}
```

```cpp
#include <hip/hip_runtime.h>
#include <stdint.h>
#include <stdio.h>

#define DEVI __device__ __forceinline__
#define LAS __attribute__((address_space(3)))
typedef unsigned short bf16_t;

constexpr int NB = 4, SEQ = 4096, DM = 1024, MT = NB * SEQ;
constexpr int EVEN_IN = 4112, UW = 4096, DFF = 2816, NEXP = 8, DFFE = 3584, PDIM = 256;
constexpr float EPS = 1e-6f;
constexpr int NTHR = 512;
constexpr int LDS_BYTES = 147456;
constexpr int MISC_OFF = 131072 + 320;
constexpr int MOE_ROWS = 2 * MT + NEXP * 256;

constexpr size_t MiB = 1u << 20;
constexpr size_t WS_CTL = 0, CTL_ZERO_BYTES = 1 * MiB;
constexpr size_t WS_LIST = 1 * MiB;
constexpr size_t WS_GATE = WS_LIST + 512 * 1024;
constexpr size_t WS_DT = 2 * MiB;
constexpr size_t WS_W = 3 * MiB;
constexpr size_t W_IN = WS_W, W_OUTE = W_IN + 8 * MiB, W_GU = W_OUTE + 2 * MiB, W_DN = W_GU + 11 * MiB, W_PG = W_DN + 6 * MiB, W_PP = W_PG + 4 * MiB,
                 W_QKV = W_PP + 1 * MiB, W_OUTO = W_QKV + 6 * MiB, W_EGU = W_OUTO + 2 * MiB, W_EDN = W_EGU + 112 * MiB, W_END = W_EDN + 56 * MiB;
constexpr size_t WS_XB = W_END;
constexpr size_t WS_R = WS_XB + 32 * MiB;
constexpr size_t WS_UB = WS_R;
constexpr size_t WS_PB0 = WS_R + 88 * MiB;
constexpr size_t WS_YA = WS_R + 128 * MiB;
constexpr size_t WS_OF = WS_R + 160 * MiB;
constexpr size_t WS_OC = WS_R + 192 * MiB;
constexpr size_t WS_YP = WS_R + 224 * MiB;
constexpr size_t WS_YP1 = WS_R;
constexpr size_t WS_PB1 = W_EDN + 32 * MiB;
constexpr size_t WS_XG8 = WS_R + 120 * MiB;
constexpr size_t WS_END = WS_R + 256 * MiB;
constexpr size_t WS_Y = W_EGU;
constexpr size_t WS_MS = W_EGU;
constexpr size_t WS_HS = W_EGU + 64 * MiB;
constexpr size_t WS_XT = W_EDN;
constexpr size_t WS_VT = W_EDN + 24 * MiB;
constexpr size_t WS_MD = W_EDN + 40 * MiB;
constexpr size_t WS_HD = W_EDN + 41 * MiB;
static_assert(WS_R + (size_t)MOE_ROWS * DFFE <= WS_XG8 && WS_XG8 + 128 * MiB <= WS_END && WS_END <= 510 * MiB, "ws map");
constexpr size_t WS_RS = WS_CTL + 512 * 1024;
constexpr int CW_CNT = 64;
constexpr int CW_BAR = 4096;

DEVI int opq(int x) { asm volatile("" : "+v"(x)); return x; }
DEVI float bf2f(bf16_t b) { return __uint_as_float(((unsigned)b) << 16); }
typedef float f32x2c __attribute__((ext_vector_type(2)));
typedef __bf16 bf16x2c __attribute__((ext_vector_type(2)));
DEVI unsigned cvt2bf(float lo, float hi) { const f32x2c v = {lo, hi}; return __builtin_bit_cast(unsigned, __builtin_convertvector(v, bf16x2c)); }
DEVI bf16_t f2bf(float f) { return (bf16_t)(cvt2bf(f, 0.f) & 0xffffu); }
DEVI float silu_f(float x) { return x * __builtin_amdgcn_rcpf(1.f + __builtin_amdgcn_exp2f(-1.44269504f * x)); }
DEVI float sigmoid_f(float x) { return __builtin_amdgcn_rcpf(1.f + __builtin_amdgcn_exp2f(-1.44269504f * x)); }
DEVI float softplus_f(float x) { return x > 20.f ? x : log1pf(__expf(x)); }
DEVI float wave_sum(float v) {
#pragma unroll
    for (int o = 1; o < 64; o <<= 1) v += __shfl_xor(v, o);
    return v;
}


typedef short bf16x8 __attribute__((ext_vector_type(8)));
typedef float f32x4 __attribute__((ext_vector_type(4)));
typedef unsigned u32x4 __attribute__((ext_vector_type(4)));
typedef unsigned u32x2 __attribute__((ext_vector_type(2)));
DEVI unsigned pk2(float lo, float hi) { return cvt2bf(lo, hi); }
DEVI float bflo(unsigned w) { return __uint_as_float(w << 16); }
DEVI float bfhi(unsigned w) { return __uint_as_float(w & 0xffff0000u); }

DEVI unsigned pg8_pk4(float a, float b, float c, float d) {
    a = __builtin_amdgcn_fmed3f(a, -448.f, 448.f); b = __builtin_amdgcn_fmed3f(b, -448.f, 448.f); c = __builtin_amdgcn_fmed3f(c, -448.f, 448.f); d = __builtin_amdgcn_fmed3f(d, -448.f, 448.f);
    int p = __builtin_amdgcn_cvt_pk_fp8_f32(a, b, 0, false); p = __builtin_amdgcn_cvt_pk_fp8_f32(c, d, p, true); return (unsigned)p; }
DEVI float wave_sum16(float (&v)[16], int lane) {
    const bool h5 = lane & 32, h4 = lane & 16, h3 = lane & 8, h2 = lane & 4;
#pragma unroll
    for (int i = 0; i < 8; ++i) { const float send = h5 ? v[i] : v[i + 8], keep = h5 ? v[i + 8] : v[i]; v[i] = keep + __shfl_xor(send, 32); }
#pragma unroll
    for (int i = 0; i < 4; ++i) { const float send = h4 ? v[i] : v[i + 4], keep = h4 ? v[i + 4] : v[i]; v[i] = keep + __shfl_xor(send, 16); }
#pragma unroll
    for (int i = 0; i < 2; ++i) { const float send = h3 ? v[i] : v[i + 2], keep = h3 ? v[i + 2] : v[i]; v[i] = keep + __shfl_xor(send, 8); }
    { const float send = h2 ? v[0] : v[1], keep = h2 ? v[1] : v[0]; v[0] = keep + __shfl_xor(send, 4); }
    float r = v[0]; r += __shfl_xor(r, 1); r += __shfl_xor(r, 2); return r;
}
DEVI float wave_sum8(float (&v)[8], int lane) {
    const bool h5 = lane & 32, h4 = lane & 16, h3 = lane & 8;
#pragma unroll
    for (int i = 0; i < 4; ++i) { const float send = h5 ? v[i] : v[i + 4], keep = h5 ? v[i + 4] : v[i]; v[i] = keep + __shfl_xor(send, 32); }
#pragma unroll
    for (int i = 0; i < 2; ++i) { const float send = h4 ? v[i] : v[i + 2], keep = h4 ? v[i + 2] : v[i]; v[i] = keep + __shfl_xor(send, 16); }
    { const float send = h3 ? v[0] : v[1], keep = h3 ? v[1] : v[0]; v[0] = keep + __shfl_xor(send, 8); }
    float r = v[0]; r += __shfl_xor(r, 1); r += __shfl_xor(r, 2); r += __shfl_xor(r, 4); return r;
}
struct NormB { const float* xin; bf16_t* XB; const bf16_t* y; const float* gpost; float* rs; const float* gnext;
               const float* win; float* dtraw; const float* wr; unsigned* cnt; int* list; float* gatev; float* rsl; float* xout; unsigned char* x8; };
DEVI void unpack8(const u32x4 w, float* v) { v[0] = bflo(w.x); v[1] = bfhi(w.x); v[2] = bflo(w.y); v[3] = bfhi(w.y); v[4] = bflo(w.z); v[5] = bfhi(w.z); v[6] = bflo(w.w); v[7] = bfhi(w.w); }
template <int YMODE, bool FINAL, bool DT, bool ROUTE>
DEVI void ph_norm2(const NormB& A, int vb0, int vbs, LAS float* wl = nullptr) {
    const int tidq = opq((int)threadIdx.x); const int wid = tidq >> 6, lane = tidq & 63;
    if (DT || ROUTE) {
        constexpr int NJ = DT ? 16 : 8;
        __syncthreads();
        for (int e = tidq; e < DM * NJ / 4; e += NTHR) { const int k = e / (NJ / 4), j4 = (e % (NJ / 4)) * 4;
            const float4 w = DT ? *(const float4*)(A.win + (size_t)k * EVEN_IN + 4096 + j4) : *(const float4*)(A.wr + (size_t)k * 8 + j4);
            wl[(j4 + 0) * DM + k] = w.x; wl[(j4 + 1) * DM + k] = w.y; wl[(j4 + 2) * DM + k] = w.z; wl[(j4 + 3) * DM + k] = w.w; }
        __syncthreads();
    }
    constexpr int R = (DT || ROUTE) ? 2 : 4;
    for (int row0 = (vb0 * 8 + wid) * R; row0 < MT; row0 += vbs * 8 * R) {
        float xv[R][16]; float yv[R][16];
#pragma unroll
        for (int rr = 0; rr < R; ++rr) {
            const size_t ro = (size_t)(row0 + rr) * DM + lane * 8;
            if (YMODE == 0) {
#pragma unroll
                for (int i = 0; i < 2; ++i) { const float4 p0 = *(const float4*)(A.xin + ro + i * 512), p1 = *(const float4*)(A.xin + ro + i * 512 + 4);
                    xv[rr][i * 8 + 0] = p0.x; xv[rr][i * 8 + 1] = p0.y; xv[rr][i * 8 + 2] = p0.z; xv[rr][i * 8 + 3] = p0.w; xv[rr][i * 8 + 4] = p1.x; xv[rr][i * 8 + 5] = p1.y; xv[rr][i * 8 + 6] = p1.z; xv[rr][i * 8 + 7] = p1.w; }
            } else {
#pragma unroll
                for (int i = 0; i < 2; ++i) {
                    unpack8(*(const u32x4*)(A.XB + ro + i * 512), xv[rr] + i * 8);
                    unpack8(*(const u32x4*)(A.y + ro + i * 512), yv[rr] + i * 8);
                    if (YMODE == 2) { float y2[8]; unpack8(*(const u32x4*)(A.y + (size_t)MT * DM + ro + i * 512), y2);
#pragma unroll
                        for (int j = 0; j < 8; ++j) yv[rr][i * 8 + j] += y2[j]; }
                }
            }
        }
        if (YMODE != 0) {
            float gg[16];
#pragma unroll
            for (int i = 0; i < 2; ++i) { const float4 g0 = *(const float4*)(A.gpost + i * 512 + lane * 8), g1 = *(const float4*)(A.gpost + i * 512 + lane * 8 + 4);
                gg[i * 8 + 0] = g0.x; gg[i * 8 + 1] = g0.y; gg[i * 8 + 2] = g0.z; gg[i * 8 + 3] = g0.w; gg[i * 8 + 4] = g1.x; gg[i * 8 + 5] = g1.y; gg[i * 8 + 6] = g1.z; gg[i * 8 + 7] = g1.w; }
            float ss[R];
#pragma unroll
            for (int rr = 0; rr < R; ++rr) { ss[rr] = 0.f;
#pragma unroll
                for (int j = 0; j < 16; ++j) ss[rr] += yv[rr][j] * yv[rr][j]; }
#pragma unroll
            for (int o = 1; o < 64; o <<= 1)
#pragma unroll
                for (int rr = 0; rr < R; ++rr) ss[rr] += __shfl_xor(ss[rr], o);
#pragma unroll
            for (int rr = 0; rr < R; ++rr) { const float r = rsqrtf(ss[rr] * (1.f / DM) + EPS);
#pragma unroll
                for (int j = 0; j < 16; ++j) xv[rr][j] += yv[rr][j] * r * gg[j]; }
        }
        if (FINAL) {
#pragma unroll
            for (int rr = 0; rr < R; ++rr)
#pragma unroll
                for (int i = 0; i < 2; ++i) { float* op = A.xout + (size_t)(row0 + rr) * DM + i * 512 + lane * 8;
                    *(float4*)op = make_float4(xv[rr][i * 8], xv[rr][i * 8 + 1], xv[rr][i * 8 + 2], xv[rr][i * 8 + 3]); *(float4*)(op + 4) = make_float4(xv[rr][i * 8 + 4], xv[rr][i * 8 + 5], xv[rr][i * 8 + 6], xv[rr][i * 8 + 7]); }
        } else {
            float ss[R];
#pragma unroll
            for (int rr = 0; rr < R; ++rr) {
#pragma unroll
                for (int i = 0; i < 2; ++i) { u32x4 o; o.x = pk2(xv[rr][i * 8], xv[rr][i * 8 + 1]); o.y = pk2(xv[rr][i * 8 + 2], xv[rr][i * 8 + 3]); o.z = pk2(xv[rr][i * 8 + 4], xv[rr][i * 8 + 5]); o.w = pk2(xv[rr][i * 8 + 6], xv[rr][i * 8 + 7]);
                    *(u32x4*)(A.XB + (size_t)(row0 + rr) * DM + i * 512 + lane * 8) = o;
                }
                ss[rr] = 0.f;
#pragma unroll
                for (int j = 0; j < 16; ++j) ss[rr] += xv[rr][j] * xv[rr][j];
            }
#pragma unroll
            for (int o = 1; o < 64; o <<= 1)
#pragma unroll
                for (int rr = 0; rr < R; ++rr) ss[rr] += __shfl_xor(ss[rr], o);
            float r2[R];
#pragma unroll
            for (int rr = 0; rr < R; ++rr) { r2[rr] = rsqrtf(ss[rr] * (1.f / DM) + EPS); if (lane == 0) A.rs[row0 + rr] = r2[rr]; }
            if (DT || ROUTE) {
                float gn[16];
#pragma unroll
                for (int i = 0; i < 2; ++i) { const float4 g0 = *(const float4*)(A.gnext + i * 512 + lane * 8), g1 = *(const float4*)(A.gnext + i * 512 + lane * 8 + 4);
                    gn[i * 8 + 0] = g0.x; gn[i * 8 + 1] = g0.y; gn[i * 8 + 2] = g0.z; gn[i * 8 + 3] = g0.w; gn[i * 8 + 4] = g1.x; gn[i * 8 + 5] = g1.y; gn[i * 8 + 6] = g1.z; gn[i * 8 + 7] = g1.w; }
                int re1[R], re2[R], lr1[R], lr2[R]; float rw1[R], rw2[R];
                volatile LAS int* lcnt = (volatile LAS int*)((LAS unsigned char*)wl + 40960);
                if (ROUTE) { __syncthreads(); if (tidq < 8) lcnt[tidq] = 0; __syncthreads(); }
#pragma unroll
                for (int rr = 0; rr < R; ++rr) {
                    const int row = row0 + rr;
                    float hv[16];
#pragma unroll
                    for (int j = 0; j < 16; ++j) hv[j] = (rr == 0 ? xv[0][j] : xv[R - 1][j]) * (rr == 0 ? r2[0] : r2[R - 1]) * gn[j];
                    if (DT) {
                        float pd[16];
#pragma unroll 4
                        for (int j = 0; j < 16; ++j) {
                            float p = 0.f;
#pragma unroll
                            for (int i = 0; i < 2; ++i) { const LAS float* wp = wl + j * DM + i * 512 + lane * 8;
                                const f32x4 w0 = *(const LAS f32x4*)wp, w1 = *(const LAS f32x4*)(wp + 4);
                                p += hv[i * 8 + 0] * w0[0] + hv[i * 8 + 1] * w0[1] + hv[i * 8 + 2] * w0[2] + hv[i * 8 + 3] * w0[3] + hv[i * 8 + 4] * w1[0] + hv[i * 8 + 5] * w1[1] + hv[i * 8 + 6] * w1[2] + hv[i * 8 + 7] * w1[3]; }
                            pd[j] = p;
                        }
                        const float dk = wave_sum16(pd, lane);
                        if ((lane & 3) == 0) A.dtraw[(size_t)row * 16 + (lane >> 2)] = dk;
                    }
                    if (ROUTE) {
                        float pl[8];
#pragma unroll 4
                        for (int e = 0; e < 8; ++e) {
                            float p = 0.f;
#pragma unroll
                            for (int i = 0; i < 2; ++i) { const LAS float* wp = wl + e * DM + i * 512 + lane * 8;
                                const f32x4 w0 = *(const LAS f32x4*)wp, w1 = *(const LAS f32x4*)(wp + 4);
                                p += hv[i * 8 + 0] * w0[0] + hv[i * 8 + 1] * w0[1] + hv[i * 8 + 2] * w0[2] + hv[i * 8 + 3] * w0[3] + hv[i * 8 + 4] * w1[0] + hv[i * 8 + 5] * w1[1] + hv[i * 8 + 6] * w1[2] + hv[i * 8 + 7] * w1[3]; }
                            pl[e] = p;
                        }
                        const float lk = wave_sum8(pl, lane);
                        float lg[8];
#pragma unroll
                        for (int e = 0; e < 8; ++e) lg[e] = __shfl(lk, e * 8);
                        int e1 = 0; float v1 = lg[0];
#pragma unroll
                        for (int e = 1; e < 8; ++e) if (lg[e] > v1) { v1 = lg[e]; e1 = e; }
                        int e2 = 0; float v2 = -3.0e38f;
#pragma unroll
                        for (int e = 0; e < 8; ++e) if (e != e1 && lg[e] > v2) { v2 = lg[e]; e2 = e; }
                        const float ex = __expf(v2 - v1);
                        re1[rr] = e1; re2[rr] = e2; rw1[rr] = 1.f / (1.f + ex); rw2[rr] = ex / (1.f + ex);
                        if (lane == 0) { lr1[rr] = __hip_atomic_fetch_add((LAS int*)lcnt + e1, 1, __ATOMIC_RELAXED, __HIP_MEMORY_SCOPE_WORKGROUP); lr2[rr] = __hip_atomic_fetch_add((LAS int*)lcnt + e2, 1, __ATOMIC_RELAXED, __HIP_MEMORY_SCOPE_WORKGROUP); }
                    }
                }
                if (ROUTE) {
                    __syncthreads();
                    if (tidq < 8) lcnt[8 + tidq] = (int)atomicAdd(&A.cnt[tidq * 64], (unsigned)lcnt[tidq]);
                    __syncthreads();
#pragma unroll
                    for (int rr = 0; rr < R; ++rr) {
                        const int row = row0 + rr;
                        int dst1 = 0, dst2 = 0;
                        if (lane == 0) {
                            const int e1 = re1[rr], e2 = re2[rr];
                            const int p1 = lcnt[8 + e1] + lr1[rr], p2 = lcnt[8 + e2] + lr2[rr];
                            A.list[e1 * MT + p1] = row * 2; A.gatev[e1 * MT + p1] = rw1[rr]; A.rsl[e1 * MT + p1] = r2[rr];
                            A.list[e2 * MT + p2] = row * 2 + 1; A.gatev[e2 * MT + p2] = rw2[rr]; A.rsl[e2 * MT + p2] = r2[rr];
                            dst1 = e1 * MT + p1; dst2 = e2 * MT + p2;
                        }
                        dst1 = __builtin_amdgcn_readfirstlane(dst1); dst2 = __builtin_amdgcn_readfirstlane(dst2);
#pragma unroll
                        for (int i = 0; i < 2; ++i) { u32x2 o8;
                            const float* xs = xv[rr] + i * 8;
                            o8.x = pg8_pk4(xs[0], xs[1], xs[2], xs[3]); o8.y = pg8_pk4(xs[4], xs[5], xs[6], xs[7]);
                            *(u32x2*)(A.x8 + (size_t)dst1 * DM + i * 512 + lane * 8) = o8; *(u32x2*)(A.x8 + (size_t)dst2 * DM + i * 512 + lane * 8) = o8; }
                    }
                }
            }
        }
    }
}

DEVI void transpose_item(const float* W, int ldw, int K, int k0, int n0, bf16_t* WT, int drow0, LAS float* scr, int lane, const float* gain) {
    {
        const int ka = lane >> 3, n4 = (lane & 7) * 4;
        float4 wv[8];
#pragma unroll
        for (int i = 0; i < 8; ++i) wv[i] = *(const float4*)(W + (size_t)(k0 + i * 8 + ka) * ldw + n0 + n4);
#pragma unroll
        for (int i = 0; i < 8; ++i) { LAS float* d = scr + (i * 8 + ka) * 33 + n4; d[0] = wv[i].x; d[1] = wv[i].y; d[2] = wv[i].z; d[3] = wv[i].w; }
    }
    asm volatile("s_waitcnt lgkmcnt(0)" ::: "memory");
    const int c = lane & 7;
    float4 ga = make_float4(1.f, 1.f, 1.f, 1.f), gb = ga;
    if (gain) { ga = *(const float4*)(gain + k0 + 8 * c); gb = *(const float4*)(gain + k0 + 8 * c + 4); }
#pragma unroll
    for (int j = 0; j < 4; ++j) { const int n = (lane >> 3) + 8 * j; const LAS float* sp = scr + (8 * c) * 33 + n;
        u32x4 o; o.x = pk2(sp[0 * 33] * ga.x, sp[1 * 33] * ga.y); o.y = pk2(sp[2 * 33] * ga.z, sp[3 * 33] * ga.w); o.z = pk2(sp[4 * 33] * gb.x, sp[5 * 33] * gb.y); o.w = pk2(sp[6 * 33] * gb.z, sp[7 * 33] * gb.w);
        *(u32x4*)(WT + (size_t)(drow0 + n) * K + k0 + 8 * c) = o; }
    asm volatile("s_waitcnt lgkmcnt(0)" ::: "memory");
}
DEVI void transpose_item_fp8(const float* W, int ldw, int K, int k0, int n0, unsigned char* WT8, int drow0, LAS float* scr, int lane, const float* gain) {
    {
        const int ka = lane >> 3, n4 = (lane & 7) * 4;
        float4 wv[8];
#pragma unroll
        for (int i = 0; i < 8; ++i) wv[i] = *(const float4*)(W + (size_t)(k0 + i * 8 + ka) * ldw + n0 + n4);
#pragma unroll
        for (int i = 0; i < 8; ++i) { LAS float* d = scr + (i * 8 + ka) * 33 + n4; d[0] = wv[i].x; d[1] = wv[i].y; d[2] = wv[i].z; d[3] = wv[i].w; }
    }
    asm volatile("s_waitcnt lgkmcnt(0)" ::: "memory");
    const int c = lane & 7;
    float4 ga = make_float4(64.f, 64.f, 64.f, 64.f), gb = ga;
    if (gain) { ga = *(const float4*)(gain + k0 + 8 * c); gb = *(const float4*)(gain + k0 + 8 * c + 4); ga.x *= 64.f; ga.y *= 64.f; ga.z *= 64.f; ga.w *= 64.f; gb.x *= 64.f; gb.y *= 64.f; gb.z *= 64.f; gb.w *= 64.f; }
#pragma unroll
    for (int j = 0; j < 4; ++j) { const int n = (lane >> 3) + 8 * j; const LAS float* sp = scr + (8 * c) * 33 + n;
        u32x2 o; o.x = pg8_pk4(sp[0 * 33] * ga.x, sp[1 * 33] * ga.y, sp[2 * 33] * ga.z, sp[3 * 33] * ga.w); o.y = pg8_pk4(sp[4 * 33] * gb.x, sp[5 * 33] * gb.y, sp[6 * 33] * gb.z, sp[7 * 33] * gb.w);
        *(u32x2*)(WT8 + (size_t)(drow0 + n) * K + k0 + 8 * c) = o; }
    asm volatile("s_waitcnt lgkmcnt(0)" ::: "memory");
}
struct Job { int in_idx; unsigned src_off; int ldw; int K; int ncols; unsigned long long dst; int mode; int item0; int gain_idx; int gain_off; int fp8; };
constexpr int NJOBS = 11 + 24;
struct JobTable { Job j[NJOBS]; int total; };
constexpr JobTable make_jobs() {
    JobTable t{}; int n = 0, it = 0;
    auto add = [&](int idx, unsigned off, int ldw, int K, int ncols, unsigned long long dst, int mode, int gi, int go, int f8 = 0) { t.j[n] = Job{idx, off, ldw, K, ncols, dst, mode, it, gi, go, f8}; it += (K / 64) * (ncols / 32); ++n; };
    add(4, 0, EVEN_IN, DM, UW, W_IN, 0, 3, 0);
    add(12, 0, DM, DM, DM, W_OUTE, 0, -1, 0);
    add(15, 0, DFF, DM, DFF, W_GU, 1, 14, 0);
    add(16, 0, DFF, DM, DFF, W_GU, 2, 14, 0);
    add(17, 0, DM, DFF, DM, W_DN, 0, -1, 0);
    add(31, 0, DM, DM, DM, W_PG, 0, 30, 0);
    add(31, DM * DM, DM, DM, DM, W_PG + 2 * MiB, 0, 30, DM);
    add(32, 0, DM, PDIM, DM, W_PP, 0, -1, 0);
    add(32, PDIM * DM, DM, PDIM, DM, W_PP + 512 * 1024, 0, -1, 0);
    add(20, 0, 3072, DM, 3072, W_QKV, 0, 19, 0);
    add(22, 0, DM, DM, DM, W_OUTO, 0, -1, 0);
    for (int e = 0; e < NEXP; ++e) {
        add(26, (unsigned)e * DM * DFFE, DFFE, DM, DFFE, W_EGU + (unsigned long long)e * 7 * MiB, 1, 24, 0, 1);
        add(27, (unsigned)e * DM * DFFE, DFFE, DM, DFFE, W_EGU + (unsigned long long)e * 7 * MiB, 2, 24, 0, 1);
        add(28, (unsigned)e * DFFE * DM, DM, DFFE, DM, W_EDN + (unsigned long long)e * (7 * MiB / 2), 0, -1, 0, 1);
    }
    t.total = it; return t;
}
__device__ const JobTable g_jobs = make_jobs();
constexpr int ITEMS_DENSE = make_jobs().j[11].item0, ITEMS_ALL = make_jobs().total;
DEVI void ph_convert_weights(LAS unsigned char* lds, const float* const* in, unsigned char* ws, int it_lo, int it_hi, int vb0, int vbs) {
    const int tidq = opq((int)threadIdx.x); const int wid = __builtin_amdgcn_readfirstlane(tidq >> 6), lane = tidq & 63;
    LAS float* scr = (LAS float*)(lds + wid * 16384);
    int jb = 0;
    for (int it = it_lo + vb0 * 8 + wid; it < it_hi; it += vbs * 8) {
        while (jb + 1 < NJOBS && g_jobs.j[jb + 1].item0 <= it) ++jb;
        const Job J = g_jobs.j[jb];
        const int r = it - J.item0; const int nblk = J.ncols / 32; const int kb = r / nblk, nb = r % nblk;
        const int n0 = nb * 32; int drow0 = n0;
        if (J.mode != 0) drow0 = (n0 >> 7) * 256 + (n0 & 127) + (J.mode == 2 ? 128 : 0);
        const float* gp = J.gain_idx >= 0 ? in[J.gain_idx] + J.gain_off : nullptr;
        if (J.fp8) transpose_item_fp8(in[J.in_idx] + J.src_off, J.ldw, J.K, kb * 64, n0, ws + J.dst, drow0, scr, lane, gp);
        else transpose_item(in[J.in_idx] + J.src_off, J.ldw, J.K, kb * 64, n0, (bf16_t*)(ws + J.dst), drow0, scr, lane, gp);
    }
}
DEVI void ph_cvt_rows(const float* src, bf16_t* dst, size_t n4, int vb0, int vbs) {
    for (size_t e = (size_t)vb0 * NTHR + opq((int)threadIdx.x); e < n4; e += (size_t)vbs * NTHR) {
        const float4 v = ((const float4*)src)[e]; u32x2 o; o.x = pk2(v.x, v.y); o.y = pk2(v.z, v.w); ((u32x2*)dst)[e] = o; }
}

namespace pg8 {
constexpr int BM = 256, BK = 64, HALF = 128, HTB = HALF * BK * 2, STAGE_BYTES = 8 * HTB, NXCD = 8, WGM = 8;
__host__ __device__ __forceinline__ int lds_byte(int r, int c) { const int st = (r >> 4) * 2 + (c >> 5), rr = r & 15, cc = c & 31, ob = rr * 64 + cc * 2; return st * 1024 + (ob ^ (((ob >> 9) & 1) << 5)); }
__host__ __device__ __forceinline__ void stage_rc(int b, int& R, int& C) { const int st = b / 1024, sb = b % 1024, swz = sb ^ (((sb >> 9) & 1) << 5); R = (st >> 1) * 16 + swz / 64; C = (st & 1) * 32 + (swz % 64) / 2; }
__host__ __device__ __forceinline__ int perm32(int rho) { const int n = rho >> 4, i = rho & 15; return 8 * (i >> 2) + 4 * n + (i & 3); }
struct Unit { int pm, pn; int row0; int arow0; int mvalid; int e; int mbase; const char* B; };
DEVI void xcd_tile(int L, int nwg, int nM, int nN, int& pm, int& pn) {
    int wgid = L; { const int q = nwg / NXCD, r = nwg % NXCD, xcd = wgid % NXCD, off = wgid / NXCD; wgid = (xcd < r ? xcd * (q + 1) : r * (q + 1) + (xcd - r) * q) + off; }
    const int nig = WGM * nN, gid = wgid / nig, fm = gid * WGM, gsz = (nM - fm) < WGM ? (nM - fm) : WGM;
    pm = fm + ((wgid % nig) % gsz); pn = (wgid % nig) / gsz;
}
struct DenseOrder {
    int nM, nN, nwg, G, c; const char* Bt; size_t tstepB;
    DEVI void init(int M, int N, int K, const bf16_t* Bt_, int G_, int c_) { nM = M / BM; nN = N / BM; nwg = nM * nN; G = G_; c = c_; Bt = (const char*)Bt_; tstepB = (size_t)BM * K * 2; }
    DEVI bool next(int i, Unit& u) const { const long L = (long)i * G + c; if (L >= nwg) return false; xcd_tile((int)L, nwg, nM, nN, u.pm, u.pn); u.row0 = u.pm * BM; u.arow0 = u.row0; u.mvalid = BM; u.e = 0; u.mbase = 0; u.B = Bt + (size_t)u.pn * tstepB; return true; }
};
struct TailOrder {
    int nM, nN, nwg, nb, r; const char* Bt; size_t tstepB;
    DEVI void init(int M, int N, int K, const bf16_t* Bt_, int G_, int c_, int first) { nM = M / BM; nN = N / BM; nwg = nM * nN; Bt = (const char*)Bt_; tstepB = (size_t)BM * K * 2;
        if (first >= G_) first = 0; nb = G_ - first; r = c_ - first; }
    DEVI bool next(int i, Unit& u) const { if (r < 0) return false; const long L = (long)i * nb + r; if (L >= nwg) return false; u.pm = (int)L / nN; u.pn = (int)L % nN; u.row0 = u.pm * BM; u.arow0 = u.row0; u.mvalid = BM; u.e = 0; u.mbase = 0; u.B = Bt + (size_t)u.pn * tstepB; return true; }
};
struct MoeOrder {
    int nM, nN, nwg, G, c; const char* Bt; size_t estepB, tstepB; const volatile LAS int* tab; bool per_expert;
    DEVI void init(const unsigned* cnt, volatile LAS int* tab_, int N, int K, const bf16_t* Bt_, size_t estep_bytes, bool per_expert_, int G_, int c_) {
        __syncthreads();
        if (threadIdx.x < 8) tab_[16 + threadIdx.x] = (int)__hip_atomic_load(cnt + threadIdx.x * 64, __ATOMIC_RELAXED, __HIP_MEMORY_SCOPE_AGENT);
        __syncthreads();
        if (threadIdx.x == 0) { int t = 0;
            for (int e = 0; e < 8; ++e) { const int n = tab_[16 + e]; tab_[e] = t; t += (n + BM - 1) / BM; }
            tab_[8] = t; }
        __syncthreads();
        tab = tab_; nM = __builtin_amdgcn_readfirstlane(tab_[8]); nN = N / BM; nwg = nM * nN; G = G_; c = c_; Bt = (const char*)Bt_; estepB = estep_bytes; tstepB = (size_t)BM * K * 2; per_expert = per_expert_;
    }
    DEVI bool next(int i, Unit& u) const { const long L = (long)i * G + c; if (L >= nwg) return false; xcd_tile((int)L, nwg, nM, nN, u.pm, u.pn);
        int e = 0;
        for (int k = 1; k < 8; ++k) if (u.pm >= __builtin_amdgcn_readfirstlane(tab[k])) e = k;
        const int t0 = __builtin_amdgcn_readfirstlane(tab[e]), n = __builtin_amdgcn_readfirstlane(tab[16 + e]);
        u.e = e; u.row0 = u.pm * BM; const int m0 = (u.pm - t0) * BM; u.mbase = m0; u.arow0 = per_expert ? e * MT + m0 : u.row0; u.mvalid = (n - m0) < BM ? (n - m0) : BM; u.B = Bt + (size_t)e * estepB + (size_t)u.pn * tstepB; return true; }
};
DEVI unsigned cvt_pk_bf16(float lo, float hi) { return cvt2bf(lo, hi); }

struct Pre8 { float v[8]; };
struct Pre16 { float v[8]; int t[8]; };
struct EpiBf16 { static constexpr bool PERM = true; bf16_t* O; int ldc; const float* rs;
    typedef Pre8 Pre;
    DEVI void pre(Pre& P, const Unit& u, int wr, int fr) const {
#pragma unroll
        for (int q = 0; q < 8; ++q) P.v[q] = rs ? rs[u.row0 + wr * 64 + fr + (q >> 2) * HALF + (q & 3) * 16] : 1.f; }
    DEVI void operator()(const f32x4 (&acc)[2][2][4][2], const Unit& u, int wr, int wc, int fr, int fq, const Pre& P) const {
        const int row0 = u.row0 + wr * 64 + fr, col0 = u.pn * BM + wc * 32 + 8 * fq;
#pragma unroll
        for (int ai = 0; ai < 2; ++ai)
#pragma unroll
            for (int m = 0; m < 4; ++m) { const int row = row0 + ai * HALF + m * 16; bf16_t* rowp = O + (size_t)row * ldc + col0;
                const float sc = P.v[ai * 4 + m];
#pragma unroll
                for (int bj = 0; bj < 2; ++bj) { const f32x4 v0 = acc[ai][bj][m][0] * sc, v1 = acc[ai][bj][m][1] * sc;
                    u32x4 w; w.x = cvt_pk_bf16(v0[0], v0[1]); w.y = cvt_pk_bf16(v0[2], v0[3]); w.z = cvt_pk_bf16(v1[0], v1[1]); w.w = cvt_pk_bf16(v1[2], v1[3]);
                    *(u32x4*)(rowp + bj * HALF) = w; } }
    } };
struct EpiPleGate { static constexpr bool PERM = true; bf16_t* T; int ldc; const float* rs;
    typedef Pre8 Pre;
    DEVI void pre(Pre& P, const Unit& u, int wr, int fr) const {
#pragma unroll
        for (int q = 0; q < 8; ++q) P.v[q] = rs[u.row0 + wr * 64 + fr + (q >> 2) * HALF + (q & 3) * 16]; }
    DEVI void operator()(const f32x4 (&acc)[2][2][4][2], const Unit& u, int wr, int wc, int fr, int fq, const Pre& P) const {
        const int row0 = u.row0 + wr * 64 + fr, col0 = u.pn * BM + wc * 32 + 8 * fq;
#pragma unroll
        for (int ai = 0; ai < 2; ++ai)
#pragma unroll
            for (int m = 0; m < 4; ++m) { const int row = row0 + ai * HALF + m * 16; bf16_t* rowp = T + (size_t)row * ldc + col0;
                const float sc = P.v[ai * 4 + m];
#pragma unroll
                for (int bj = 0; bj < 2; ++bj) { const f32x4 v0 = acc[ai][bj][m][0] * sc, v1 = acc[ai][bj][m][1] * sc;
                    const u32x4 pp = *(const u32x4*)(rowp + bj * HALF);
                    u32x4 w; w.x = cvt_pk_bf16(sigmoid_f(v0[0]) * bflo(pp.x), sigmoid_f(v0[1]) * bfhi(pp.x)); w.y = cvt_pk_bf16(sigmoid_f(v0[2]) * bflo(pp.y), sigmoid_f(v0[3]) * bfhi(pp.y));
                    w.z = cvt_pk_bf16(sigmoid_f(v1[0]) * bflo(pp.z), sigmoid_f(v1[1]) * bfhi(pp.z)); w.w = cvt_pk_bf16(sigmoid_f(v1[2]) * bflo(pp.w), sigmoid_f(v1[3]) * bfhi(pp.w));
                    *(u32x4*)(rowp + bj * HALF) = w; } }
    } };
struct EpiSwiglu { static constexpr bool PERM = true; bf16_t* O; int ldc; const float* rs; int grouped;
    typedef Pre8 Pre;
    DEVI void pre(Pre& P, const Unit& u, int wr, int fr) const {
        const float* rsb = grouped ? rs + u.e * MT + u.mbase : rs + u.row0; const int vm1 = (grouped ? u.mvalid : BM) - 1;
#pragma unroll
        for (int q = 0; q < 8; ++q) { const int rl = wr * 64 + fr + (q >> 2) * HALF + (q & 3) * 16; P.v[q] = rsb[rl <= vm1 ? rl : vm1]; } }
    DEVI void operator()(const f32x4 (&acc)[2][2][4][2], const Unit& u, int wr, int wc, int fr, int fq, const Pre& P) const {
        const int row0 = u.row0 + wr * 64 + fr, col0 = u.pn * HALF + wc * 32 + 8 * fq; const int vm1e = (grouped ? u.mvalid : BM) - 1;
#pragma unroll
        for (int ai = 0; ai < 2; ++ai)
#pragma unroll
            for (int m = 0; m < 4; ++m) { const int rl = wr * 64 + fr + ai * HALF + m * 16; bf16_t* rowp = O + (size_t)(u.row0 + rl) * ldc + col0;
                const float sc = rl <= vm1e ? P.v[ai * 4 + m] : 0.f;
                const f32x4 g0 = acc[ai][0][m][0] * sc, g1 = acc[ai][0][m][1] * sc, u0 = acc[ai][1][m][0] * sc, u1 = acc[ai][1][m][1] * sc;
                u32x4 w; w.x = cvt_pk_bf16(silu_f(g0[0]) * u0[0], silu_f(g0[1]) * u0[1]); w.y = cvt_pk_bf16(silu_f(g0[2]) * u0[2], silu_f(g0[3]) * u0[3]);
                w.z = cvt_pk_bf16(silu_f(g1[0]) * u1[0], silu_f(g1[1]) * u1[1]); w.w = cvt_pk_bf16(silu_f(g1[2]) * u1[2], silu_f(g1[3]) * u1[3]);
                *(u32x4*)rowp = w; }
    } };
constexpr float W8_SCALE = 64.f, ACT8_SCALE = 8.f;
struct EpiSwiglu8 { static constexpr bool PERM = true; unsigned char* O; int ldc; const float* rs;
    typedef Pre8 Pre;
    DEVI void pre(Pre& P, const Unit& u, int wr, int fr) const {
        const float* rsb = rs + u.e * MT + u.mbase; const int vm1 = u.mvalid - 1;
#pragma unroll
        for (int q = 0; q < 8; ++q) { const int rl = wr * 64 + fr + (q >> 2) * HALF + (q & 3) * 16; P.v[q] = rsb[rl <= vm1 ? rl : vm1]; } }
    DEVI void operator()(const f32x4 (&acc)[2][2][4][2], const Unit& u, int wr, int wc, int fr, int fq, const Pre& P) const {
        const int col0 = u.pn * HALF + wc * 32 + 8 * fq;
#pragma unroll
        for (int ai = 0; ai < 2; ++ai)
#pragma unroll
            for (int m = 0; m < 4; ++m) { const int rl = wr * 64 + fr + ai * HALF + m * 16; unsigned char* rowp = O + (size_t)(u.row0 + rl) * ldc + col0;
                const float sc = rl < u.mvalid ? P.v[ai * 4 + m] * (1.f / W8_SCALE) : 0.f;
                const f32x4 g0 = acc[ai][0][m][0] * sc, g1 = acc[ai][0][m][1] * sc, u0 = acc[ai][1][m][0] * (sc * ACT8_SCALE), u1 = acc[ai][1][m][1] * (sc * ACT8_SCALE);
                u32x2 w; w.x = pg8_pk4(silu_f(g0[0]) * u0[0], silu_f(g0[1]) * u0[1], silu_f(g0[2]) * u0[2], silu_f(g0[3]) * u0[3]);
                w.y = pg8_pk4(silu_f(g1[0]) * u1[0], silu_f(g1[1]) * u1[1], silu_f(g1[2]) * u1[2], silu_f(g1[3]) * u1[3]);
                *(u32x2*)rowp = w; }
    } };
struct EpiMoeDown { static constexpr bool PERM = true; bf16_t* Y; const int* list; const float* gatev; float oscale;
    typedef Pre16 Pre;
    DEVI void pre(Pre& P, const Unit& u, int wr, int fr) const {
        const int* lb = list + u.e * MT + u.mbase; const float* gb = gatev + u.e * MT + u.mbase; const int vm1 = u.mvalid - 1;
#pragma unroll
        for (int q = 0; q < 8; ++q) { const int rl = wr * 64 + fr + (q >> 2) * HALF + (q & 3) * 16; const int ri = rl <= vm1 ? rl : vm1; P.t[q] = lb[ri]; P.v[q] = gb[ri]; } }
    DEVI void operator()(const f32x4 (&acc)[2][2][4][2], const Unit& u, int wr, int wc, int fr, int fq, const Pre& P) const {
        const int col0 = u.pn * BM + wc * 32 + 8 * fq;
        const int mbase = u.mbase;
#pragma unroll
        for (int ai = 0; ai < 2; ++ai)
#pragma unroll
            for (int m = 0; m < 4; ++m) { const int rl = wr * 64 + fr + ai * HALF + m * 16;
                const int tsl = P.t[ai * 4 + m]; const float gt = P.v[ai * 4 + m] * oscale;
                if (rl < u.mvalid) {
                    bf16_t* rowp = Y + (size_t)(tsl & 1) * ((size_t)MT * DM) + (size_t)(tsl >> 1) * DM + col0;
#pragma unroll
                    for (int bj = 0; bj < 2; ++bj) { const f32x4 v0 = acc[ai][bj][m][0], v1 = acc[ai][bj][m][1];
                        u32x4 w; w.x = cvt_pk_bf16(v0[0] * gt, v0[1] * gt); w.y = cvt_pk_bf16(v0[2] * gt, v0[3] * gt); w.z = cvt_pk_bf16(v1[0] * gt, v1[1] * gt); w.w = cvt_pk_bf16(v1[2] * gt, v1[3] * gt);
                        *(u32x4*)(rowp + bj * HALF) = w; } } }
    } };

typedef int v8i __attribute__((ext_vector_type(8)));
typedef int v4i __attribute__((ext_vector_type(4)));
DEVI v8i cat8(const bf16x8 lo, const bf16x8 hi) { const v4i a = __builtin_bit_cast(v4i, lo), b = __builtin_bit_cast(v4i, hi); return __builtin_shufflevector(a, b, 0, 1, 2, 3, 4, 5, 6, 7); }
struct Frag16 { bf16x8 k[2]; };
struct Frag8 { v8i v; };
template <bool F> struct FragSel { typedef Frag16 T; };
template <> struct FragSel<true> { typedef Frag8 T; };
template <class Epi, class Sched, bool FP8 = false>
DEVI void gemm_phase(LAS unsigned char* lds, const bf16_t* A, const int K, const Sched& S, const Epi& E) {
    const int tid = opq((int)threadIdx.x), wid = __builtin_amdgcn_readfirstlane(tid >> 6), lane = tid & 63, wr = wid >> 2, wc = wid & 3, fr = lane & 15, fq = lane >> 4;
    const int nt = K / BK;
    unsigned voffA[2], voffB[2];
#pragma unroll
    for (int i = 0; i < 2; ++i) { int R, C; stage_rc(tid * 16 + i * 8192, R, C); const int Rb = Epi::PERM ? ((R & ~31) + perm32(R & 31)) : R;
        voffA[i] = (unsigned)(R * K + C) * 2u; voffB[i] = (unsigned)(Rb * K + C) * 2u; }
    const size_t kstep = (size_t)(BK * 2);
    const size_t hstep = (size_t)HALF * K * 2;
    const size_t rstep = (size_t)K * 2;
    const unsigned ldsw = (unsigned)wid * 1024u;
    const int aoff = lds_byte(wr * 64 + fr, fq * 8), boff = lds_byte(wc * 32 + fr, fq * 8);
#define PG8_SA(b, h) (((b) * 2 + (h)) * HTB)
#define PG8_SB(b, h) ((4 + (b) * 2 + (h)) * HTB)
#define PG8_STAGE(bufoff, gbase, voff) do { _Pragma("unroll") for (int _i = 0; _i < 2; ++_i) \
        __builtin_amdgcn_global_load_lds((const unsigned*)((const char*)(gbase) + (voff)[_i]), (LAS unsigned*)(lds + (bufoff) + ldsw + _i * 8192), 16, 0, 0); } while (0)
#define PG8_LDA(dst, b, h) do { _Pragma("unroll") for (int m = 0; m < 4; ++m) { if constexpr (FP8) dst[m].v = cat8(*(const LAS bf16x8*)(lds + PG8_SA(b, h) + aoff + m * 2048), *(const LAS bf16x8*)(lds + PG8_SA(b, h) + aoff + m * 2048 + 1024)); \
        else { _Pragma("unroll") for (int k = 0; k < 2; ++k) dst[m].k[k] = *(const LAS bf16x8*)(lds + PG8_SA(b, h) + aoff + m * 2048 + k * 1024); } } } while (0)
#define PG8_LDB(dst, b, h) do { _Pragma("unroll") for (int n = 0; n < 2; ++n) { if constexpr (FP8) dst[n].v = cat8(*(const LAS bf16x8*)(lds + PG8_SB(b, h) + boff + n * 2048), *(const LAS bf16x8*)(lds + PG8_SB(b, h) + boff + n * 2048 + 1024)); \
        else { _Pragma("unroll") for (int k = 0; k < 2; ++k) dst[n].k[k] = *(const LAS bf16x8*)(lds + PG8_SB(b, h) + boff + n * 2048 + k * 1024); } } } while (0)
#define PG8_MMA(ai, bj, At, Bt) do { __builtin_amdgcn_s_setprio(1); _Pragma("unroll") for (int m = 0; m < 4; ++m) _Pragma("unroll") for (int n = 0; n < 2; ++n) { \
        if constexpr (FP8) asm volatile("s_nop 1\n\tv_mfma_scale_f32_16x16x128_f8f6f4 %0, %1, %2, %0, %3, %3 op_sel_hi:[0,0,0]" : "+v"(acc[ai][bj][m][n]) : "v"(Bt[n].v), "v"(At[m].v), "v"(sc1)); \
        else { _Pragma("unroll") for (int k = 0; k < 2; ++k) acc[ai][bj][m][n] = __builtin_amdgcn_mfma_f32_16x16x32_bf16(Bt[n].k[k], At[m].k[k], acc[ai][bj][m][n], 0, 0, 0); } } \
        __builtin_amdgcn_s_setprio(0); } while (0)
#define PG8_WAIT_V(n) asm volatile("s_waitcnt vmcnt(" #n ")" ::: "memory")
#define PG8_WAIT_L(n) asm volatile("s_waitcnt lgkmcnt(" #n ")" ::: "memory")
#define PG8_BAR __builtin_amdgcn_s_barrier()
#define PG8_SCHED __builtin_amdgcn_sched_barrier(0)
    Unit cur, nxt; int ui = 0;
    if (!S.next(0, cur)) return;
    int sc1 = 0x7F7F7F7F; asm volatile("" : "+v"(sc1));
    f32x4 acc[2][2][4][2];
#pragma unroll
    for (int a = 0; a < 2; ++a)
#pragma unroll
        for (int b = 0; b < 2; ++b)
#pragma unroll
            for (int m = 0; m < 4; ++m)
#pragma unroll
                for (int n = 0; n < 2; ++n) acc[a][b][m][n] = (f32x4){0.f, 0.f, 0.f, 0.f};
    typename FragSel<FP8>::T At[4], B0[2], B1[2];
    const char* cA = (const char*)A + (size_t)cur.arow0 * rstep;
    const char* cB = cur.B;
    typename Epi::Pre pre; E.pre(pre, cur, wr, fr);
    PG8_STAGE(PG8_SB(0, 0), cB, voffB); PG8_STAGE(PG8_SA(0, 0), cA, voffA); PG8_STAGE(PG8_SB(0, 1), cB + hstep, voffB); PG8_STAGE(PG8_SA(0, 1), cA + hstep, voffA);
    if (wr == 1) PG8_BAR;
    PG8_WAIT_V(4); PG8_BAR;
    PG8_STAGE(PG8_SB(1, 0), cB + kstep, voffB); PG8_STAGE(PG8_SA(1, 0), cA + kstep, voffA); PG8_STAGE(PG8_SB(1, 1), cB + hstep + kstep, voffB);
    PG8_WAIT_V(6); PG8_BAR;
    for (;;) {
        const bool has_next = S.next(ui + 1, nxt);
        const char* nA = has_next ? (const char*)A + (size_t)nxt.arow0 * rstep : cA; const char* nB = has_next ? nxt.B : cB;
#pragma unroll 1
        for (int t = 0; t < nt; t += 2) {
            const bool last = (t == nt - 2);
            const char* a1 = cA + (size_t)(t + 1) * kstep;
            const char* a2 = last ? nA : cA + (size_t)(t + 2) * kstep; const char* b2 = last ? nB : cB + (size_t)(t + 2) * kstep;
            const char* a3 = a2 + kstep; const char* b3 = b2 + kstep;
            PG8_LDB(B0, 0, 0); PG8_SCHED; PG8_LDA(At, 0, 0); PG8_STAGE(PG8_SA(1, 1), a1 + hstep, voffA);
            PG8_WAIT_L(8); PG8_BAR; PG8_WAIT_L(0); PG8_MMA(0, 0, At, B0); PG8_BAR; PG8_SCHED;
            PG8_LDB(B1, 0, 1); PG8_STAGE(PG8_SB(0, 0), b2, voffB);
            PG8_BAR; PG8_WAIT_L(0); PG8_MMA(0, 1, At, B1); PG8_BAR;
            PG8_LDA(At, 0, 1); PG8_STAGE(PG8_SA(0, 0), a2, voffA);
            PG8_BAR; PG8_WAIT_L(0); PG8_MMA(1, 0, At, B0); PG8_BAR; PG8_SCHED;
            PG8_STAGE(PG8_SB(0, 1), b2 + hstep, voffB);
            PG8_WAIT_V(6); PG8_BAR; PG8_MMA(1, 1, At, B1); PG8_BAR;
            PG8_LDB(B0, 1, 0); PG8_SCHED; PG8_LDA(At, 1, 0); PG8_STAGE(PG8_SA(0, 1), a2 + hstep, voffA);
            PG8_WAIT_L(8); PG8_BAR; PG8_WAIT_L(0); PG8_MMA(0, 0, At, B0); PG8_BAR; PG8_SCHED;
            PG8_LDB(B1, 1, 1); PG8_STAGE(PG8_SB(1, 0), b3, voffB);
            PG8_BAR; PG8_WAIT_L(0); PG8_MMA(0, 1, At, B1); PG8_BAR;
            PG8_LDA(At, 1, 1); PG8_STAGE(PG8_SA(1, 0), a3, voffA);
            PG8_BAR; PG8_WAIT_L(0); PG8_MMA(1, 0, At, B0); PG8_BAR; PG8_SCHED;
            PG8_STAGE(PG8_SB(1, 1), b3 + hstep, voffB);
            PG8_WAIT_V(6); PG8_BAR; PG8_MMA(1, 1, At, B1); PG8_BAR;
        }
        if constexpr (FP8) asm volatile("s_nop 15\n\ts_nop 15" ::: "memory");
        E(acc, cur, wr, wc, fr, fq, pre);
        if (!has_next) break;
#pragma unroll
        for (int a = 0; a < 2; ++a)
#pragma unroll
            for (int b = 0; b < 2; ++b)
#pragma unroll
                for (int m = 0; m < 4; ++m)
#pragma unroll
                    for (int n = 0; n < 2; ++n) acc[a][b][m][n] = (f32x4){0.f, 0.f, 0.f, 0.f};
        cur = nxt; cA = nA; cB = nB; ++ui;
        E.pre(pre, cur, wr, fr);
        if constexpr (FP8) asm volatile("s_nop 7" ::: "memory");
    }
    PG8_WAIT_V(0);
    if (wr == 0) PG8_BAR;
    PG8_BAR;
#undef PG8_SA
#undef PG8_SB
#undef PG8_STAGE
#undef PG8_LDA
#undef PG8_LDB
#undef PG8_MMA
#undef PG8_WAIT_V
#undef PG8_WAIT_L
#undef PG8_BAR
#undef PG8_SCHED
}
}

DEVI float lb_of(const float* lbraw, int ch) {
    const float r0 = lbraw[ch], r1 = lbraw[512 + ch], r2 = lbraw[1024 + ch];
    const float mx = fmaxf(r0, fmaxf(r1, r2));
    const float e0 = __expf(r0 - mx), e1 = __expf(r1 - mx), e2 = __expf(r2 - mx);
    return e0 / (e0 + e1 + e2);
}
constexpr int HQ = 0, HK = 17408, HKH = 34816, HV = 53248, HDV = 71680, HZERO = 73728, HOT = 75776, H_END = HOT + 64 * 528;
static_assert(H_END <= 131072, "hgrn lds");
constexpr size_t HS_SCAN = (size_t)16 * 16384;
struct HgrnRaw { unsigned qf[16]; u32x4 v0, v1; };
DEVI void hgrn_load(HgrnRaw& R, const bf16_t* u, const bf16_t* VT, int dir, int b, int h, int t0, int c, int I, int tid) {
    const bf16_t* up = u + ((size_t)b * SEQ + t0 + 16 * I) * UW + h * 128 + c;
    const int fcol = dir ? 1024 : 512;
#pragma unroll
    for (int j = 0; j < 16; ++j) R.qf[j] = (unsigned)up[(size_t)j * UW] | ((unsigned)up[(size_t)j * UW + fcol] << 16);
    { const int e = tid, r = e >> 3, cch = e & 7; R.v0 = *(const u32x4*)(VT + ((size_t)b * 512 + h * 128 + r) * SEQ + t0 + cch * 8); }
    { const int e = tid + NTHR, r = e >> 3, cch = e & 7; R.v1 = *(const u32x4*)(VT + ((size_t)b * 512 + h * 128 + r) * SEQ + t0 + cch * 8); }
}
DEVI void hgrn_prep(LAS unsigned char* lds, const HgrnRaw& R, float lbv, int dir, int c, int I, int tid) {
    float ff[16], kk[16], qq[16];
    { const int e = tid, r = e >> 3, cch = e & 7; *(LAS u32x4*)(lds + HV + r * 144 + cch * 16) = R.v0; }
    { const int e = tid + NTHR, r = e >> 3, cch = e & 7; *(LAS u32x4*)(lds + HV + r * 144 + cch * 16) = R.v1; }
#pragma unroll
    for (int j = 0; j < 16; ++j) {
        const float fr = bfhi(R.qf[j]), qr = bflo(R.qf[j]);
        const float f = lbv + (1.f - lbv) * sigmoid_f(fr);
        ff[j] = f; kk[j] = 1.f - f; qq[j] = silu_f(qr);
    }
    float run = 1.f;
#pragma unroll
    for (int jj = 0; jj < 16; ++jj) { const int j = dir ? 15 - jj : jj; run = fmaxf(run * ff[j], 1e-30f); ff[j] = run; }
    const float PG = run;
    float kh[16];
#pragma unroll
    for (int j = 0; j < 16; ++j) {
        const float kt = kk[j] * __builtin_amdgcn_rcpf(ff[j]);
        kh[j] = kt * PG;
        *(LAS bf16_t*)(lds + HQ + (16 * I + j) * 272 + c * 2) = f2bf(qq[j] * ff[j]);
        *(LAS bf16_t*)(lds + HK + (16 * I + j) * 272 + c * 2) = f2bf(kt);
    }
    u32x4 w0, w1;
    w0.x = pk2(kh[0], kh[1]); w0.y = pk2(kh[2], kh[3]); w0.z = pk2(kh[4], kh[5]); w0.w = pk2(kh[6], kh[7]);
    w1.x = pk2(kh[8], kh[9]); w1.y = pk2(kh[10], kh[11]); w1.z = pk2(kh[12], kh[13]); w1.w = pk2(kh[14], kh[15]);
    *(LAS u32x4*)(lds + HKH + c * 144 + I * 32) = w0; *(LAS u32x4*)(lds + HKH + c * 144 + I * 32 + 16) = w1;
    *(LAS float*)(lds + HDV + (I * 128 + c) * 4) = PG;
}
DEVI void hgrn_update(LAS unsigned char* lds, f32x4 (&Sacc)[8], int I, int wid, int fr, int fq) {
    const int voff = (fq < 2) ? HV + (16 * wid + fr) * 144 + (16 * I + 8 * fq) * 2 : HZERO;
    const int koff = (fq < 2) ? HKH + fr * 144 + (16 * I + 8 * fq) * 2 : HZERO;
    const int kstep = (fq < 2) ? 16 * 144 : 0;
    const bf16x8 vb = *(const LAS bf16x8*)(lds + voff);
    bf16x8 ka[8]; f32x4 dv[8];
#pragma unroll
    for (int m = 0; m < 8; ++m) { ka[m] = *(const LAS bf16x8*)(lds + koff + m * kstep); dv[m] = *(const LAS f32x4*)(lds + HDV + (I * 128 + 16 * m + 4 * fq) * 4); }
#pragma unroll
    for (int m = 0; m < 8; ++m) Sacc[m] = __builtin_amdgcn_mfma_f32_16x16x32_bf16(ka[m], vb, Sacc[m] * dv[m], 0, 0, 0);
}
DEVI void ph_hgrn_states(LAS unsigned char* lds, const bf16_t* u, const bf16_t* VT, const float* lbraw, bf16_t* HS, float* HD, int vb0, int vbs) {
    const int tid = opq((int)threadIdx.x), wid = __builtin_amdgcn_readfirstlane(tid >> 6), lane = tid & 63, fr = lane & 15, fq = lane >> 4;
    const int pc = tid & 127, pI = tid >> 7;
    for (int unit = vb0; unit < NB * 4 * 2 * 16; unit += vbs) {
        const int seg = unit & 15, dir = (unit >> 4) & 1, h = (unit >> 5) & 3, b = unit >> 7;
        const float lbv = lb_of(lbraw, h * 128 + pc);
        f32x4 Sacc[8];
#pragma unroll
        for (int m = 0; m < 8; ++m) Sacc[m] = (f32x4){0.f, 0.f, 0.f, 0.f};
        float gprod = 1.f;
        if (tid < 4) *(LAS unsigned*)(lds + HZERO + tid * 4) = 0u;
        HgrnRaw R; hgrn_load(R, u, VT, dir, b, h, seg * 256 + (dir ? 3 : 0) * 64, pc, pI, tid);
#pragma unroll 1
        for (int sbi = 0; sbi < 4; ++sbi) {
            const int sb = dir ? 3 - sbi : sbi;
            const int t0 = seg * 256 + sb * 64;
            __syncthreads();
            hgrn_prep(lds, R, lbv, dir, pc, pI, tid);
            if (sbi < 3) { const int sbn = dir ? 3 - (sbi + 1) : sbi + 1; hgrn_load(R, u, VT, dir, b, h, seg * 256 + sbn * 64, pc, pI, tid); }
            __syncthreads();
            if (tid < 128) gprod *= (*(const LAS float*)(lds + HDV + tid * 4) * *(const LAS float*)(lds + HDV + (128 + tid) * 4)) * (*(const LAS float*)(lds + HDV + (256 + tid) * 4) * *(const LAS float*)(lds + HDV + (384 + tid) * 4));
#pragma unroll 1
            for (int ii = 0; ii < 4; ++ii) { const int I = dir ? 3 - ii : ii; hgrn_update(lds, Sacc, I, wid, fr, fq); }
        }
        const size_t scan = (size_t)(b * 4 + h) * 2 + dir;
        bf16_t* dst = HS + scan * HS_SCAN + (size_t)seg * 16384;
#pragma unroll
        for (int m = 0; m < 8; ++m) { u32x2 w; w.x = pk2(Sacc[m][0], Sacc[m][1]); w.y = pk2(Sacc[m][2], Sacc[m][3]);
            *(u32x2*)(dst + (16 * wid + fr) * 128 + 16 * m + 4 * fq) = w; }
        if (tid < 128) HD[(scan * 16 + seg) * 128 + tid] = gprod;
    }
    __syncthreads();
}
DEVI void ph_hgrn_scan(bf16_t* HS, const float* HD, int vb0, int vbs) {
    const int tid = opq((int)threadIdx.x);
    for (int idx = vb0 * NTHR + tid; idx < 32 * 4096; idx += vbs * NTHR) {
        const int scan = idx >> 12, e4 = idx & 4095, k4 = (e4 & 31) * 4; const int dir = scan & 1;
        u32x2* base = (u32x2*)(HS + (size_t)scan * HS_SCAN) + e4;
        const float* hd = HD + (size_t)scan * 16 * 128 + k4;
        u32x2 d[16]; float4 dec[16];
#pragma unroll
        for (int i = 0; i < 16; ++i) { d[i] = base[(size_t)i * 4096]; dec[i] = *(const float4*)(hd + i * 128); }
        float s0 = 0.f, s1 = 0.f, s2 = 0.f, s3 = 0.f;
#define HSCAN_STEP(i) { const float t0 = bflo(d[i].x), t1 = bfhi(d[i].x), t2 = bflo(d[i].y), t3 = bfhi(d[i].y); d[i].x = pk2(s0, s1); d[i].y = pk2(s2, s3); \
            s0 = s0 * dec[i].x + t0; s1 = s1 * dec[i].y + t1; s2 = s2 * dec[i].z + t2; s3 = s3 * dec[i].w + t3; }
        if (dir == 0) {
#pragma unroll
            for (int i = 0; i < 16; ++i) HSCAN_STEP(i)
        } else {
#pragma unroll
            for (int i = 15; i >= 0; --i) HSCAN_STEP(i)
        }
#undef HSCAN_STEP
#pragma unroll
        for (int i = 0; i < 16; ++i) base[(size_t)i * 4096] = d[i];
    }
}
DEVI void ph_hgrn_out(LAS unsigned char* lds, const bf16_t* u, const bf16_t* VT, const float* lbraw, const float* a_norm, const bf16_t* HS, float* OF, bf16_t* ocat, int vb0, int vbs) {
    const int tid = opq((int)threadIdx.x), wid = __builtin_amdgcn_readfirstlane(tid >> 6), lane = tid & 63, fr = lane & 15, fq = lane >> 4;
    const int pc = tid & 127, pI = tid >> 7;
    const int otok = tid >> 3, opart = tid & 7;
    for (int unit = vb0; unit < NB * 4 * 16; unit += vbs) {
        const int seg = unit & 15, h = (unit >> 4) & 3, b = unit >> 6;
        const float lbv = lb_of(lbraw, h * 128 + pc);
        if (tid < 4) *(LAS unsigned*)(lds + HZERO + tid * 4) = 0u;
#pragma unroll 1
        for (int dir = 0; dir < 2; ++dir) {
            const size_t scan = (size_t)(b * 4 + h) * 2 + dir;
            const bf16_t* src = HS + scan * HS_SCAN + (size_t)seg * 16384;
            f32x4 Sacc[8];
#pragma unroll
            for (int m = 0; m < 8; ++m) { const u32x2 w = *(const u32x2*)(src + (16 * wid + fr) * 128 + 16 * m + 4 * fq);
                Sacc[m][0] = bflo(w.x); Sacc[m][1] = bfhi(w.x); Sacc[m][2] = bflo(w.y); Sacc[m][3] = bfhi(w.y); }
            HgrnRaw R; hgrn_load(R, u, VT, dir, b, h, seg * 256 + (dir ? 3 : 0) * 64, pc, pI, tid);
#pragma unroll 1
            for (int sbi = 0; sbi < 4; ++sbi) {
                const int sb = dir ? 3 - sbi : sbi;
                const int t0 = seg * 256 + sb * 64;
                const size_t tokb = (size_t)b * SEQ + t0;
                __syncthreads();
                hgrn_prep(lds, R, lbv, dir, pc, pI, tid);
                if (sbi < 3) { const int sbn = dir ? 3 - (sbi + 1) : sbi + 1; hgrn_load(R, u, VT, dir, b, h, seg * 256 + sbn * 64, pc, pI, tid); }
                __syncthreads();
#pragma unroll 1
                for (int ii = 0; ii < 4; ++ii) {
                    const int I = dir ? 3 - ii : ii;
                    f32x4 oT = {0.f, 0.f, 0.f, 0.f};
                    const LAS unsigned char* qrow = lds + HQ + (16 * I + fr) * 272;
#pragma unroll
                    for (int ks = 0; ks < 4; ++ks) {
                        u32x4 sa; sa.x = pg8::cvt_pk_bf16(Sacc[2 * ks][0], Sacc[2 * ks][1]); sa.y = pg8::cvt_pk_bf16(Sacc[2 * ks][2], Sacc[2 * ks][3]);
                        sa.z = pg8::cvt_pk_bf16(Sacc[2 * ks + 1][0], Sacc[2 * ks + 1][1]); sa.w = pg8::cvt_pk_bf16(Sacc[2 * ks + 1][2], Sacc[2 * ks + 1][3]);
                        const u32x2 q0 = *(const LAS u32x2*)(qrow + (32 * ks + 4 * fq) * 2), q1 = *(const LAS u32x2*)(qrow + (32 * ks + 16 + 4 * fq) * 2);
                        u32x4 qb; qb.x = q0.x; qb.y = q0.y; qb.z = q1.x; qb.w = q1.y;
                        oT = __builtin_amdgcn_mfma_f32_16x16x32_bf16(__builtin_bit_cast(bf16x8, sa), __builtin_bit_cast(bf16x8, qb), oT, 0, 0, 0);
                    }
                    f32x4 sT = {0.f, 0.f, 0.f, 0.f};
                    const LAS unsigned char* krow = lds + HK + (16 * I + fr) * 272;
#pragma unroll
                    for (int ks = 0; ks < 4; ++ks) {
                        const bf16x8 ka = *(const LAS bf16x8*)(krow + (32 * ks + 8 * fq) * 2), qb = *(const LAS bf16x8*)(qrow + (32 * ks + 8 * fq) * 2);
                        sT = __builtin_amdgcn_mfma_f32_16x16x32_bf16(ka, qb, sT, 0, 0, 0);
                    }
                    float pv[4];
#pragma unroll
                    for (int rg = 0; rg < 4; ++rg) { const int sl = 4 * fq + rg; const bool ok = dir ? (sl >= fr) : (sl <= fr); pv[rg] = ok ? sT[rg] : 0.f; }
                    u32x4 pb; pb.x = pg8::cvt_pk_bf16(pv[0], pv[1]); pb.y = pg8::cvt_pk_bf16(pv[2], pv[3]); pb.z = 0u; pb.w = 0u;
                    const u32x2 v0 = *(const LAS u32x2*)(lds + HV + (16 * wid + fr) * 144 + (16 * I + 4 * fq) * 2);
                    u32x4 va; va.x = v0.x; va.y = v0.y; va.z = 0u; va.w = 0u;
                    oT = __builtin_amdgcn_mfma_f32_16x16x32_bf16(__builtin_bit_cast(bf16x8, va), __builtin_bit_cast(bf16x8, pb), oT, 0, 0, 0);
                    if (dir == 0) *(f32x4*)(OF + (tokb + 16 * I + fr) * 512 + h * 128 + 16 * wid + 4 * fq) = oT;
                    else *(LAS f32x4*)(lds + HOT + (16 * I + fr) * 528 + (16 * wid + 4 * fq) * 4) = oT;
                    hgrn_update(lds, Sacc, I, wid, fr, fq);
                }
                if (dir == 1) {
                    __syncthreads();
                    const LAS float* orow = (const LAS float*)(lds + HOT + otok * 528) + opart * 16;
                    float* ofp = OF + (tokb + otok) * 512 + h * 128 + opart * 16;
                    float v[16]; float ss = 0.f;
#pragma unroll
                    for (int q2 = 0; q2 < 8; ++q2) { const unsigned long long w = __hip_atomic_load((unsigned long long*)(ofp + q2 * 2), __ATOMIC_RELAXED, __HIP_MEMORY_SCOPE_AGENT);
                        v[2 * q2] = __uint_as_float((unsigned)w) + orow[2 * q2]; v[2 * q2 + 1] = __uint_as_float((unsigned)(w >> 32)) + orow[2 * q2 + 1];
                        ss += v[2 * q2] * v[2 * q2] + v[2 * q2 + 1] * v[2 * q2 + 1]; }
                    ss += __shfl_xor(ss, 1); ss += __shfl_xor(ss, 2); ss += __shfl_xor(ss, 4);
                    const float rn = rsqrtf(ss * (1.f / 128.f) + EPS);
                    const bf16_t* gp = u + (tokb + otok) * UW + 2048 + h * 128 + opart * 16;
                    const u32x4 g0 = *(const u32x4*)gp, g1 = *(const u32x4*)(gp + 8);
                    const unsigned gw[8] = {g0.x, g0.y, g0.z, g0.w, g1.x, g1.y, g1.z, g1.w};
                    unsigned ow[8];
#pragma unroll
                    for (int q2 = 0; q2 < 8; ++q2) { const float an0 = a_norm[opart * 16 + 2 * q2], an1 = a_norm[opart * 16 + 2 * q2 + 1];
                        ow[q2] = pk2(v[2 * q2] * rn * an0 * silu_f(bflo(gw[q2])), v[2 * q2 + 1] * rn * an1 * silu_f(bfhi(gw[q2]))); }
                    bf16_t* op = ocat + (tokb + otok) * DM + h * 128 + opart * 16;
                    u32x4 o0, o1; o0.x = ow[0]; o0.y = ow[1]; o0.z = ow[2]; o0.w = ow[3]; o1.x = ow[4]; o1.y = ow[5]; o1.z = ow[6]; o1.w = ow[7];
                    *(u32x4*)op = o0; *(u32x4*)(op + 8) = o1;
                }
            }
            asm volatile("s_waitcnt vmcnt(0)" ::: "memory");
        }
    }
    __syncthreads();
}

DEVI void ph_prep(const bf16_t* u, const float* cw, const float* cb, bf16_t* xconv, bf16_t* XT, bf16_t* VT, int vb0, int vbs) {
    const int tid = opq((int)threadIdx.x);
    for (int unit = vb0; unit < NB * 32 * 3; unit += vbs) {
        const int cg = unit % 3, tb = (unit / 3) & 31, b = unit / 96;
        const int t0 = tb * 128;
        if (cg < 2) {
            const int ch = cg * 512 + tid;
            float w[5];
#pragma unroll
            for (int j = 0; j < 5; ++j) w[j] = cw[j * 1024 + ch];
            const float bias = cb[ch];
            const bf16_t* up = u + (size_t)b * SEQ * UW + 3072 + ch;
            float v0, v1, v2, v3;
            v0 = (t0 - 2 >= 0) ? bf2f(up[(size_t)(t0 - 2) * UW]) : 0.f;
            v1 = (t0 - 1 >= 0) ? bf2f(up[(size_t)(t0 - 1) * UW]) : 0.f;
            v2 = bf2f(up[(size_t)t0 * UW]);
            v3 = bf2f(up[(size_t)(t0 + 1) * UW]);
            for (int t8 = 0; t8 < 128; t8 += 32) {
                float nx[32];
#pragma unroll
                for (int i = 0; i < 32; ++i) { const int tt = t0 + t8 + i + 2; nx[i] = (tt < SEQ) ? bf2f(up[(size_t)tt * UW]) : 0.f; }
                unsigned pk[16];
#pragma unroll
                for (int i = 0; i < 32; ++i) {
                    const float o = silu_f(bias + w[0] * v0 + w[1] * v1 + w[2] * v2 + w[3] * v3 + w[4] * nx[i]);
                    const bf16_t ob = f2bf(o);
                    xconv[(size_t)(b * SEQ + t0 + t8 + i) * 1024 + ch] = ob;
                    if (i & 1) pk[i >> 1] |= ((unsigned)ob << 16); else pk[i >> 1] = ob;
                    v0 = v1; v1 = v2; v2 = v3; v3 = nx[i];
                }
                if (ch < 768) {
#pragma unroll
                    for (int q = 0; q < 4; ++q) { u32x4 o4; o4.x = pk[4 * q]; o4.y = pk[4 * q + 1]; o4.z = pk[4 * q + 2]; o4.w = pk[4 * q + 3]; *(u32x4*)(XT + ((size_t)b * 768 + ch) * SEQ + t0 + t8 + 8 * q) = o4; } }
            }
        } else {
            const int ch = tid;
            const bf16_t* up = u + (size_t)b * SEQ * UW + 1536 + ch;
            for (int t8 = 0; t8 < 128; t8 += 32) {
                unsigned pk[16];
#pragma unroll
                for (int i = 0; i < 32; ++i) { const unsigned ob = up[(size_t)(t0 + t8 + i) * UW]; if (i & 1) pk[i >> 1] |= (ob << 16); else pk[i >> 1] = ob; }
#pragma unroll
                for (int q = 0; q < 4; ++q) { u32x4 o4; o4.x = pk[4 * q]; o4.y = pk[4 * q + 1]; o4.z = pk[4 * q + 2]; o4.w = pk[4 * q + 3]; *(u32x4*)(VT + ((size_t)b * 512 + ch) * SEQ + t0 + t8 + 8 * q) = o4; }
            }
        }
    }
}

constexpr int MB_XT = 0, MB_BX = 256 * 272, MB_DT = MB_BX + 128 * 272, MB_CS = MB_DT + 8 * 128 * 4, MB_TOT = MB_CS + 8 * 128 * 4, MB_END = MB_TOT + 64;
static_assert(MB_END <= 131072, "mamba lds");
constexpr size_t MS_SCAN = (size_t)32 * 8192;
DEVI bf16x8 pack8(const float* v) { u32x4 w; w.x = pg8::cvt_pk_bf16(v[0], v[1]); w.y = pg8::cvt_pk_bf16(v[2], v[3]); w.z = pg8::cvt_pk_bf16(v[4], v[5]); w.w = pg8::cvt_pk_bf16(v[6], v[7]); return __builtin_bit_cast(bf16x8, w); }
DEVI void mamba_tables(LAS unsigned char* lds, const float* dtraw, const float* A_log, const float* dt_bias, int b, int g, int c, int wid, int lane) {
    LAS float* tdt = (LAS float*)(lds + MB_DT); LAS float* tcs = (LAS float*)(lds + MB_CS); LAS float* ttot = (LAS float*)(lds + MB_TOT);
    const int r = wid >> 1, dir = wid & 1, hd = 4 * g + r;
    const float A = -__expf(A_log[dir * 8 + hd]), bias = dt_bias[dir * 8 + hd];
    const size_t tk = (size_t)b * SEQ + c * 128 + 2 * lane;
    const float dt0 = softplus_f(dtraw[tk * 16 + dir * 8 + hd] + bias), dt1 = softplus_f(dtraw[(tk + 1) * 16 + dir * 8 + hd] + bias);
    const float a0 = dt0 * A, a1 = dt1 * A;
    float sc = a0 + a1;
#pragma unroll
    for (int off = 1; off < 64; off <<= 1) { const float v = __shfl_up(sc, off); if (lane >= off) sc += v; }
    const float total = __shfl(sc, 63);
    const float pre0 = sc - a1, pre1 = sc;
    const float c0 = dir ? (total - pre0 + a0) : pre0, c1 = dir ? (total - pre1 + a1) : pre1;
    tdt[wid * 128 + 2 * lane] = dt0; tdt[wid * 128 + 2 * lane + 1] = dt1;
    tcs[wid * 128 + 2 * lane] = c0; tcs[wid * 128 + 2 * lane + 1] = c1;
    if (lane == 0) ttot[wid] = total;
}
DEVI void stage_rows(LAS unsigned char* dst, const bf16_t* src, size_t src_stride, int rows, int tid) {
    for (int e = tid; e < rows * 16; e += NTHR) { const int r = e >> 4, cch = e & 15; *(LAS u32x4*)(dst + r * 272 + cch * 16) = *(const u32x4*)(src + (size_t)r * src_stride + cch * 8); }
}
DEVI void ph_mamba_states(LAS unsigned char* lds, const bf16_t* XT, const float* dtraw, const float* A_log, const float* dt_bias, bf16_t* MS, float* MD, int vb0, int vbs) {
    const int tid = opq((int)threadIdx.x), wid = __builtin_amdgcn_readfirstlane(tid >> 6), lane = tid & 63, fr = lane & 15, fq = lane >> 4;
    LAS float* tdt = (LAS float*)(lds + MB_DT); LAS float* tcs = (LAS float*)(lds + MB_CS); LAS float* ttot = (LAS float*)(lds + MB_TOT);
    for (int unit = vb0; unit < NB * 2 * 32; unit += vbs) {
        const int c = unit & 31, g = (unit >> 5) & 1, b = unit >> 6;
        __syncthreads();
        stage_rows(lds + MB_XT, XT + ((size_t)b * 768 + g * 256) * SEQ + c * 128, SEQ, 256, tid);
        stage_rows(lds + MB_BX, XT + ((size_t)b * 768 + 512 + g * 128) * SEQ + c * 128, SEQ, 128, tid);
        mamba_tables(lds, dtraw, A_log, dt_bias, b, g, c, wid, lane);
        __syncthreads();
        if (lane == 0) MD[((size_t)(b * 8 + 4 * g + (wid >> 1)) * 2 + (wid & 1)) * 32 + c] = __expf(ttot[wid]);
        for (int hdd = 0; hdd < 8; ++hdd) {
            const int r = hdd >> 1, dir = hdd & 1, hd = 4 * g + r;
            const float tot = ttot[hdd];
            f32x4 acc[4];
#pragma unroll
            for (int pt = 0; pt < 4; ++pt) acc[pt] = (f32x4){0.f, 0.f, 0.f, 0.f};
#pragma unroll
            for (int ks = 0; ks < 4; ++ks) {
                const int s0 = 32 * ks + 8 * fq;
                const u32x4 braw = *(const LAS u32x4*)(lds + MB_BX + (16 * wid + fr) * 272 + s0 * 2);
                float bw[8];
                const unsigned bu[4] = {braw.x, braw.y, braw.z, braw.w};
#pragma unroll
                for (int j = 0; j < 8; ++j) { const float bv = (j & 1) ? bfhi(bu[j >> 1]) : bflo(bu[j >> 1]);
                    bw[j] = bv * tdt[hdd * 128 + s0 + j] * __expf(tot - tcs[hdd * 128 + s0 + j]); }
                const bf16x8 Bf = pack8(bw);
#pragma unroll
                for (int pt = 0; pt < 4; ++pt) {
                    const bf16x8 Af = *(const LAS bf16x8*)(lds + MB_XT + (r * 64 + 16 * pt + fr) * 272 + s0 * 2);
                    acc[pt] = __builtin_amdgcn_mfma_f32_16x16x32_bf16(Bf, Af, acc[pt], 0, 0, 0);
                }
            }
            bf16_t* dst = MS + ((size_t)(b * 8 + hd) * 2 + dir) * MS_SCAN + (size_t)c * 8192;
#pragma unroll
            for (int pt = 0; pt < 4; ++pt) { u32x2 w; w.x = pk2(acc[pt][0], acc[pt][1]); w.y = pk2(acc[pt][2], acc[pt][3]);
                *(u32x2*)(dst + (16 * pt + fr) * 128 + 16 * wid + 4 * fq) = w; }
        }
    }
    __syncthreads();
}
DEVI void ph_mamba_scan(bf16_t* MS, const float* MD, int vb0, int vbs) {
    const int tid = opq((int)threadIdx.x);
    for (int idx = vb0 * NTHR + tid; idx < 64 * 2048; idx += vbs * NTHR) {
        const int scan = idx >> 11, e4 = idx & 2047; const int dir = scan & 1;
        u32x2* base = (u32x2*)(MS + (size_t)scan * MS_SCAN) + e4;
        const float* md = MD + (size_t)scan * 32;
        float h0 = 0.f, h1 = 0.f, h2 = 0.f, h3 = 0.f;
#pragma unroll 1
        for (int half = 0; half < 2; ++half) {
            const int c0 = (dir ? 1 - half : half) * 16;
            u32x2 d[16]; float dec[16];
#pragma unroll
            for (int i = 0; i < 16; ++i) { d[i] = base[(size_t)(c0 + i) * 2048]; dec[i] = md[c0 + i]; }
#define MSCAN_STEP(i) { const float t0 = bflo(d[i].x), t1 = bfhi(d[i].x), t2 = bflo(d[i].y), t3 = bfhi(d[i].y); d[i].x = pk2(h0, h1); d[i].y = pk2(h2, h3); \
                h0 = h0 * dec[i] + t0; h1 = h1 * dec[i] + t1; h2 = h2 * dec[i] + t2; h3 = h3 * dec[i] + t3; }
            if (dir == 0) {
#pragma unroll
                for (int i = 0; i < 16; ++i) MSCAN_STEP(i)
            } else {
#pragma unroll
                for (int i = 15; i >= 0; --i) MSCAN_STEP(i)
            }
#undef MSCAN_STEP
#pragma unroll
            for (int i = 0; i < 16; ++i) base[(size_t)(c0 + i) * 2048] = d[i];
        }
    }
}
DEVI void ph_mamba_out(LAS unsigned char* lds, const bf16_t* u, const bf16_t* xconv, const bf16_t* XT, const float* dtraw, const float* A_log, const float* dt_bias, const float* Dskip, const float* b_norm,
                       const bf16_t* MS, bf16_t* ocat, int vb0, int vbs) {
    const int tid = opq((int)threadIdx.x), wid = __builtin_amdgcn_readfirstlane(tid >> 6), lane = tid & 63, fr = lane & 15, fq = lane >> 4;
    LAS float* tdt = (LAS float*)(lds + MB_DT); LAS float* tcs = (LAS float*)(lds + MB_CS);
    for (int unit = vb0; unit < NB * 2 * 32; unit += vbs) {
        const int c = unit & 31, g = (unit >> 5) & 1, b = unit >> 6;
        const size_t tok0 = (size_t)b * SEQ + c * 128;
        __syncthreads();
        stage_rows(lds + MB_XT, XT + ((size_t)b * 768 + g * 256) * SEQ + c * 128, SEQ, 256, tid);
        stage_rows(lds + MB_BX, xconv + tok0 * 1024 + 512 + g * 128, 1024, 128, tid);
        mamba_tables(lds, dtraw, A_log, dt_bias, b, g, c, wid, lane);
        const int tl = 16 * wid + fr;
        bf16x8 Cf[4];
#pragma unroll
        for (int ks = 0; ks < 4; ++ks) Cf[ks] = *(const bf16x8*)(xconv + (tok0 + tl) * 1024 + 768 + g * 128 + 32 * ks + 8 * fq);
        __syncthreads();
        f32x4 GT[8];
#pragma unroll
        for (int st = 0; st < 8; ++st) { GT[st] = (f32x4){0.f, 0.f, 0.f, 0.f};
            bf16x8 Af[4];
#pragma unroll
            for (int ks = 0; ks < 4; ++ks) Af[ks] = *(const LAS bf16x8*)(lds + MB_BX + (16 * st + fr) * 272 + (32 * ks + 8 * fq) * 2);
#pragma unroll
            for (int ks = 0; ks < 4; ++ks) GT[st] = __builtin_amdgcn_mfma_f32_16x16x32_bf16(Af[ks], Cf[ks], GT[st], 0, 0, 0); }
        float ss = 0.f;
        __syncthreads();
        u32x2 hpre[4];
        { const bf16_t* hin0 = MS + ((size_t)(b * 8 + 4 * g) * 2) * MS_SCAN + (size_t)c * 8192;
#pragma unroll
          for (int q = 0; q < 4; ++q) hpre[q] = ((const u32x2*)hin0)[tid + q * NTHR]; }
#pragma unroll 1
        for (int r = 0; r < 4; ++r) {
            const int hd = 4 * g + r;
            f32x4 yv[4];
#pragma unroll
            for (int pt = 0; pt < 4; ++pt) yv[pt] = (f32x4){0.f, 0.f, 0.f, 0.f};
#pragma unroll 1
            for (int dir = 0; dir < 2; ++dir) {
                const int hdd = r * 2 + dir;
                const float cst = tcs[hdd * 128 + tl];
                LAS unsigned char* hbuf = lds + MB_BX + (hdd & 1) * 17408;
#pragma unroll
                for (int q = 0; q < 4; ++q) { const int e4 = tid + q * NTHR, pp = e4 >> 5, n4 = (e4 & 31) * 4;
                    *(LAS u32x2*)(hbuf + pp * 272 + n4 * 2) = hpre[q]; }
                if (hdd < 7) { const int hn = hdd + 1; const bf16_t* hinn = MS + ((size_t)(b * 8 + 4 * g + (hn >> 1)) * 2 + (hn & 1)) * MS_SCAN + (size_t)c * 8192;
#pragma unroll
                    for (int q = 0; q < 4; ++q) hpre[q] = ((const u32x2*)hinn)[tid + q * NTHR]; }
                __syncthreads();
                f32x4 yo[4];
#pragma unroll
                for (int pt = 0; pt < 4; ++pt) { yo[pt] = (f32x4){0.f, 0.f, 0.f, 0.f};
                    bf16x8 hf[4];
#pragma unroll
                    for (int ks = 0; ks < 4; ++ks) hf[ks] = *(const LAS bf16x8*)(hbuf + (16 * pt + fr) * 272 + (32 * ks + 8 * fq) * 2);
#pragma unroll
                    for (int ks = 0; ks < 4; ++ks) yo[pt] = __builtin_amdgcn_mfma_f32_16x16x32_bf16(hf[ks], Cf[ks], yo[pt], 0, 0, 0); }
                const float eo = __expf(cst);
#pragma unroll
                for (int pt = 0; pt < 4; ++pt) yv[pt] += yo[pt] * eo;
#pragma unroll
                for (int kp = 0; kp < 4; ++kp) {
                    const bool skip = dir ? (2 * kp + 1 < wid) : (2 * kp > wid);
                    if (!skip) {
                        float pv[8];
#pragma unroll
                        for (int hlf = 0; hlf < 2; ++hlf) { const int st = 2 * kp + hlf;
                            const f32x4 cs4 = *(const LAS f32x4*)(tcs + hdd * 128 + 16 * st + 4 * fq), dt4 = *(const LAS f32x4*)(tdt + hdd * 128 + 16 * st + 4 * fq);
#pragma unroll
                            for (int rg = 0; rg < 4; ++rg) { const int sl = 16 * st + 4 * fq + rg;
                                const bool ok = dir ? (sl >= tl) : (sl <= tl);
                                const float e = __expf(fminf(cst - cs4[rg], 0.f));
                                pv[hlf * 4 + rg] = ok ? GT[st][rg] * e * dt4[rg] : 0.f; } }
                        u32x2 x0[4], x1[4];
#pragma unroll
                        for (int pt = 0; pt < 4; ++pt) { const LAS unsigned char* xr = lds + MB_XT + (r * 64 + 16 * pt + fr) * 272;
                            x0[pt] = *(const LAS u32x2*)(xr + (32 * kp + 4 * fq) * 2); x1[pt] = *(const LAS u32x2*)(xr + (32 * kp + 16 + 4 * fq) * 2); }
                        const bf16x8 Pf = pack8(pv);
#pragma unroll
                        for (int pt = 0; pt < 4; ++pt) {
                            u32x4 xa; xa.x = x0[pt].x; xa.y = x0[pt].y; xa.z = x1[pt].x; xa.w = x1[pt].y;
                            yv[pt] = __builtin_amdgcn_mfma_f32_16x16x32_bf16(__builtin_bit_cast(bf16x8, xa), Pf, yv[pt], 0, 0, 0);
                        }
                    }
                }
            }
            const float Dk = Dskip[hd];
#pragma unroll
            for (int pt = 0; pt < 4; ++pt) {
                const int p0 = 16 * pt + 4 * fq;
                const u32x2 xr = *(const u32x2*)(xconv + (tok0 + tl) * 1024 + hd * 64 + p0);
                const u32x2 zr = *(const u32x2*)(u + (tok0 + tl) * UW + 2560 + hd * 64 + p0);
                const float xs[4] = {bflo(xr.x), bfhi(xr.x), bflo(xr.y), bfhi(xr.y)}, zs[4] = {bflo(zr.x), bfhi(zr.x), bflo(zr.y), bfhi(zr.y)};
                float yy[4];
#pragma unroll
                for (int rg = 0; rg < 4; ++rg) { const float y = (yv[pt][rg] + Dk * xs[rg]) * silu_f(zs[rg]); yy[rg] = y; ss += y * y; }
                const unsigned long long o = (unsigned long long)pk2(yy[0], yy[1]) | ((unsigned long long)pk2(yy[2], yy[3]) << 32);
                __hip_atomic_store((unsigned long long*)(ocat + (tok0 + tl) * DM + 512 + g * 256 + r * 64 + p0), o, __ATOMIC_RELAXED, __HIP_MEMORY_SCOPE_AGENT);
            }
        }
        ss += __shfl_xor(ss, 16); ss += __shfl_xor(ss, 32);
        const float rn = rsqrtf(ss * (1.f / 256.f) + EPS);
        asm volatile("s_waitcnt vmcnt(0)" ::: "memory");
        unsigned long long pk[16];
#pragma unroll
        for (int q = 0; q < 16; ++q) pk[q] = __hip_atomic_load((unsigned long long*)(ocat + (tok0 + tl) * DM + 512 + g * 256 + (q >> 2) * 64 + 16 * (q & 3) + 4 * fq), __ATOMIC_RELAXED, __HIP_MEMORY_SCOPE_AGENT);
#pragma unroll
        for (int r = 0; r < 4; ++r)
#pragma unroll
            for (int pt = 0; pt < 4; ++pt) {
                const int cc = g * 256 + r * 64 + 16 * pt + 4 * fq;
                unsigned long long* op = (unsigned long long*)(ocat + (tok0 + tl) * DM + 512 + cc);
                const unsigned long long v = pk[r * 4 + pt];
                const unsigned vlo = (unsigned)v, vhi = (unsigned)(v >> 32);
                const float4 bn = *(const float4*)(b_norm + cc);
                const unsigned long long o = (unsigned long long)pk2(bflo(vlo) * rn * bn.x, bfhi(vlo) * rn * bn.y) | ((unsigned long long)pk2(bflo(vhi) * rn * bn.z, bfhi(vhi) * rn * bn.w) << 32);
                *op = o;
            }
    }
    __syncthreads();
}


constexpr int NA_RING = 12, NA_VT = 0, NA_VSTRIDE = NA_RING * 64 * 2 + 16, NA_BIAS = 64 * NA_VSTRIDE, NA_END = NA_BIAS + 480 * 4;
static_assert(NA_END <= 131072, "na lds");
DEVI void ph_na(LAS unsigned char* lds, const bf16_t* qkv, const float* rpb, bf16_t* oc, int vb0, int vbs) {
    const int tid = opq((int)threadIdx.x), wid = __builtin_amdgcn_readfirstlane(tid >> 6), lane = tid & 63, fr = lane & 15, fq = lane >> 4;
    LAS float* bl = (LAS float*)(lds + NA_BIAS);
    for (int chunk = vb0; chunk < NB * 16 * 4; chunk += vbs) {
        const int qr4 = chunk & 3, h = (chunk >> 2) & 15, b = chunk >> 6;
        __syncthreads();
        for (int e = tid; e < 465; e += NTHR) bl[e] = rpb[h * 465 + e];
        int staged_hi = -1;
#pragma unroll 1
        for (int ui = 0; ui < 8; ++ui) {
            const int rp = qr4 * 8 + ui;
            const int r0 = 2 * rp, rs0 = min(max(r0 - 4, 0), 56);
            const int need_hi = min(rs0 + 8, 63);
            const int lo = max(staged_hi + 1, rs0);
            for (int task = wid; task < (need_hi - lo + 1) * 8; task += 8) {
                const int kr = lo + (task >> 3), ch = task & 7, slot = kr % NA_RING;
                const u32x4 v = *(const u32x4*)(qkv + ((size_t)b * SEQ + kr * 64 + lane) * 3072 + 2048 + h * 64 + ch * 8);
                const unsigned vw[4] = {v.x, v.y, v.z, v.w};
#pragma unroll
                for (int i = 0; i < 8; ++i) *(LAS bf16_t*)(lds + NA_VT + (ch * 8 + i) * NA_VSTRIDE + (slot * 64 + lane) * 2) = (bf16_t)((i & 1) ? (vw[i >> 1] >> 16) : (vw[i >> 1] & 0xffffu));
            }
            staged_hi = need_hi > staged_hi ? need_hi : staged_hi;
            __syncthreads();
            const int r = r0 + (wid >> 2), j = wid & 3;
            const int rs = min(max(r - 4, 0), 56);
            const int bs = (j == 0) ? 0 : (j == 1) ? 8 : (j == 2) ? 24 : 32;
            const int c = 16 * j + fr, qs = min(max(c - 8, 0), 48);
            const size_t qtok = (size_t)b * SEQ + r * 64 + c;
            bf16x8 Qf[2];
#pragma unroll
            for (int ks = 0; ks < 2; ++ks) Qf[ks] = *(const bf16x8*)(qkv + qtok * 3072 + h * 64 + 32 * ks + 8 * fq);
            const bf16_t* kbase = qkv + ((size_t)b * SEQ + rs * 64 + bs + fr) * 3072 + 1024 + h * 64 + 8 * fq;
            bf16x8 kn[4];
#pragma unroll
            for (int q = 0; q < 4; ++q) kn[q] = *(const bf16x8*)(kbase + (size_t)((q >> 1) * 16) * 3072 + (q & 1) * 32);
            f32x4 O[4];
#pragma unroll
            for (int dt = 0; dt < 4; ++dt) O[dt] = (f32x4){0.f, 0.f, 0.f, 0.f};
            float mrun = -1e30f, lrun = 0.f;
#pragma unroll 1
            for (int dr = 0; dr < 8; ++dr) {
                bf16x8 kc[4];
#pragma unroll
                for (int q = 0; q < 4; ++q) kc[q] = kn[q];
                const int drn = dr < 7 ? dr + 1 : 7;
#pragma unroll
                for (int q = 0; q < 4; ++q) kn[q] = *(const bf16x8*)(kbase + ((size_t)drn * 64 + (q >> 1) * 16) * 3072 + (q & 1) * 32);
                float sv[8]; float mloc = -1e30f;
                const LAS float* brow = bl + (rs + dr - r + 7) * 31;
#pragma unroll
                for (int kg = 0; kg < 2; ++kg) {
                    f32x4 acc = {0.f, 0.f, 0.f, 0.f};
                    acc = __builtin_amdgcn_mfma_f32_16x16x32_bf16(kc[kg * 2], Qf[0], acc, 0, 0, 0);
                    acc = __builtin_amdgcn_mfma_f32_16x16x32_bf16(kc[kg * 2 + 1], Qf[1], acc, 0, 0, 0);
#pragma unroll
                    for (int rg = 0; rg < 4; ++rg) {
                        const int kcol = bs + 16 * kg + 4 * fq + rg;
                        const bool ok = (kcol >= qs) && (kcol < qs + 16);
                        const int dc = min(max(kcol - c + 15, 0), 30);
                        const float sc = ok ? acc[rg] * 0.125f + brow[dc] : -1e30f;
                        sv[kg * 4 + rg] = sc; mloc = fmaxf(mloc, sc);
                    }
                }
                mloc = fmaxf(mloc, __shfl_xor(mloc, 16)); mloc = fmaxf(mloc, __shfl_xor(mloc, 32));
                const float mnew = fmaxf(mrun, mloc);
                const float alpha = __expf(mrun - mnew);
                float psum = 0.f;
#pragma unroll
                for (int i = 0; i < 8; ++i) { const float p = __expf(sv[i] - mnew); sv[i] = p; psum += p; }
                psum += __shfl_xor(psum, 16); psum += __shfl_xor(psum, 32);
                lrun = lrun * alpha + psum; mrun = mnew;
                const bf16x8 Pf = pack8(sv);
                const int koff = (((rs + dr) % NA_RING) * 64 + bs + 4 * fq) * 2;
#pragma unroll
                for (int dt = 0; dt < 4; ++dt) {
                    const LAS unsigned char* vr = lds + NA_VT + (16 * dt + fr) * NA_VSTRIDE + koff;
                    const u32x2 v0 = *(const LAS u32x2*)vr, v1 = *(const LAS u32x2*)(vr + 32);
                    u32x4 va; va.x = v0.x; va.y = v0.y; va.z = v1.x; va.w = v1.y;
                    O[dt] = __builtin_amdgcn_mfma_f32_16x16x32_bf16(__builtin_bit_cast(bf16x8, va), Pf, O[dt] * alpha, 0, 0, 0);
                }
            }
            const float il = 1.f / lrun;
#pragma unroll
            for (int dt = 0; dt < 4; ++dt) {
                u32x2 o; o.x = pk2(O[dt][0] * il, O[dt][1] * il); o.y = pk2(O[dt][2] * il, O[dt][3] * il);
                *(u32x2*)(oc + qtok * DM + h * 64 + 16 * dt + 4 * fq) = o;
            }
        }
    }
    __syncthreads();
}

#define XB_TMO      128
#define XB_XCNT(j)  (256  + 64 * (j))
#define XB_XSUB(j)  (1280 + 64 * (j))
#define XB_XGEN(j)  (2304 + 64 * (j))
#define XB_TOP      3328
#define XB_TOPGEN   3392
#define XCD_BAR_WORDS 3456
#define XB_SPIN_CAP (1u << 18)

__device__ __forceinline__ unsigned xb_ld(unsigned* p)              { return __hip_atomic_load(p, __ATOMIC_RELAXED, __HIP_MEMORY_SCOPE_AGENT); }
__device__ __forceinline__ unsigned xb_add(unsigned* p, unsigned v) { return __hip_atomic_fetch_add(p, v, __ATOMIC_RELAXED, __HIP_MEMORY_SCOPE_AGENT); }
__device__ __forceinline__ unsigned xb_xcc_id() { return (unsigned)__builtin_amdgcn_s_getreg((3 << 11) | 20) & 0xFu; }
#define XB_SPIN(cond, bar) do { unsigned _sp = 0; while (cond) { __builtin_amdgcn_s_sleep(1); \
    if ((++_sp & 255u) == 0u) { if (xb_ld(&(bar)[XB_TMO])) break; if (_sp > XB_SPIN_CAP) { atomicAdd(&(bar)[XB_TMO], 1u); break; } } } } while (0)

struct XcdBarrier {
    unsigned* bar; unsigned x;
    volatile LAS unsigned* st;
};

__device__ __forceinline__ XcdBarrier xcd_barrier_post(unsigned* bar, volatile LAS unsigned* st) {
    XcdBarrier b; b.bar = bar; b.x = xb_xcc_id(); b.st = st;
    if (threadIdx.x == 0) (void)xb_add(&bar[XB_XCNT(b.x)], 1u);
    return b;
}
__device__ __forceinline__ void xcd_barrier_complete(unsigned* bar, unsigned x, unsigned& nloc, unsigned& nx) {
    const unsigned G = gridDim.x * gridDim.y * gridDim.z;
    unsigned sum, cnt, mine, sp = 0u;
    for (;;) {
        sum = 0u; cnt = 0u; mine = 0u;
#pragma unroll
        for (unsigned j = 0; j < 16; ++j) { const unsigned c = xb_ld(&bar[XB_XCNT(j)]); sum += c; cnt += (c > 0u) ? 1u : 0u; mine = (j == x) ? c : mine; }
        if (sum == G) break;
        __builtin_amdgcn_s_sleep(1);
        if ((++sp & 255u) == 0u) { if (xb_ld(&bar[XB_TMO])) break; if (sp > XB_SPIN_CAP) { atomicAdd(&bar[XB_TMO], 1u); break; } }
    }
    nloc = mine > 0u ? mine : 1u; nx = cnt > 0u ? cnt : 1u;
}

__device__ __forceinline__ void xcd_barrier(const XcdBarrier& b) {
    asm volatile("s_waitcnt vmcnt(0)" ::: "memory");
    __syncthreads();
    if (threadIdx.x == 0) {
        unsigned* bar = b.bar;
        __builtin_amdgcn_s_waitcnt(0);
        unsigned nloc = b.st[0], nx = b.st[1];
        if (nloc == 0u) { xcd_barrier_complete(bar, b.x, nloc, nx); b.st[0] = nloc; b.st[1] = nx; }
        const unsigned old = xb_add(&bar[XB_XSUB(b.x)], 1u);
        const unsigned gen = old / nloc;
        if (old + 1u == (gen + 1u) * nloc) {
            __builtin_amdgcn_fence(__ATOMIC_RELEASE, "agent");
            asm volatile("s_waitcnt vmcnt(0)" ::: "memory");
            const unsigned og = xb_add(&bar[XB_TOP], 1u);
            const unsigned tg = og / nx;
            if (og + 1u == (tg + 1u) * nx) xb_add(&bar[XB_TOPGEN], 1u);
            else XB_SPIN(xb_ld(&bar[XB_TOPGEN]) == tg, bar);
            __builtin_amdgcn_fence(__ATOMIC_ACQUIRE, "agent");
            xb_add(&bar[XB_XGEN(b.x)], 1u);
            asm volatile("s_waitcnt vmcnt(0)" ::: "memory");
        } else {
            XB_SPIN(xb_ld(&bar[XB_XGEN(b.x)]) == gen, bar);
            __builtin_amdgcn_fence(__ATOMIC_ACQUIRE, "agent");
            asm volatile("s_waitcnt vmcnt(0)" ::: "memory");
        }
    }
    __syncthreads();
}


struct Args { const float* in[34]; float* out; unsigned char* ws; int ph_lo, ph_hi; };
constexpr int N_PHASES = 22;

__global__ void __launch_bounds__(NTHR, 2) fwd(Args a) {
    extern __shared__ __attribute__((aligned(16))) unsigned char lds_raw[];
    float* lds = (float*)lds_raw;
    LAS unsigned char* ldsl = (LAS unsigned char*)lds_raw;
    const int vb0 = blockIdx.x, vbs = gridDim.x;
    const int lo = a.ph_lo, hi = a.ph_hi;
#define IN(k) (lo <= (k) && (k) < hi)
#define SEAM(k) do { if (IN(k) && IN((k) + 1)) xcd_barrier(bar); } while (0)
    volatile LAS unsigned* misc = (volatile LAS unsigned*)(ldsl + MISC_OFF);
    if (threadIdx.x < 4) misc[threadIdx.x] = 0u;
    __syncthreads();
    XcdBarrier bar = xcd_barrier_post((unsigned*)(a.ws + WS_CTL) + CW_BAR, misc);
    unsigned char* ws = a.ws;
    unsigned* ctl = (unsigned*)(ws + WS_CTL);
    unsigned* cnt = ctl + CW_CNT;
    int* list = (int*)(ws + WS_LIST); float* gatev = (float*)(ws + WS_GATE);
    float* dtraw = (float*)(ws + WS_DT); float* RS = (float*)(ws + WS_RS);
    bf16_t* XB = (bf16_t*)(ws + WS_XB); bf16_t* UB = (bf16_t*)(ws + WS_UB);
    bf16_t* YA = (bf16_t*)(ws + WS_YA); float* OF = (float*)(ws + WS_OF); bf16_t* OC = (bf16_t*)(ws + WS_OC);
    bf16_t* YP = (bf16_t*)(ws + WS_YP); bf16_t* YP1 = (bf16_t*)(ws + WS_YP1); bf16_t* XC = (bf16_t*)(ws + WS_YP);
    bf16_t* PB0 = (bf16_t*)(ws + WS_PB0); bf16_t* PB1 = (bf16_t*)(ws + WS_PB1);
    bf16_t* YB = (bf16_t*)(ws + WS_Y);
    bf16_t* MS = (bf16_t*)(ws + WS_MS); float* MD = (float*)(ws + WS_MD);
    bf16_t* HS = (bf16_t*)(ws + WS_HS); float* HD = (float*)(ws + WS_HD);
    bf16_t* XT = (bf16_t*)(ws + WS_XT); bf16_t* VT = (bf16_t*)(ws + WS_VT);
    const float* p_in = a.in[1];
    const int G = (int)gridDim.x, cb = (int)blockIdx.x;
    const NormB NB0{nullptr, XB, nullptr, nullptr, RS, nullptr, nullptr, nullptr, nullptr, nullptr, nullptr, nullptr, nullptr, nullptr, nullptr};
    unsigned char* XG8 = ws + WS_XG8;
    float* rsl = (float*)(ws + WS_DT);

    if (IN(0)) {
        ph_convert_weights(ldsl, a.in, ws, 0, ITEMS_DENSE, vb0, vbs);
        NormB A = NB0; A.xin = a.in[0]; A.gnext = a.in[3]; A.win = a.in[4]; A.dtraw = dtraw;
        ph_norm2<0, false, true, false>(A, vb0, vbs, (LAS float*)ldsl);
    }
    SEAM(0);
    if (IN(1)) { pg8::DenseOrder S; S.init(MT, UW, DM, (const bf16_t*)(ws + W_IN), G, cb); pg8::gemm_phase(ldsl, XB, DM, S, pg8::EpiBf16{UB, UW, RS}); }
    SEAM(1);
    if (IN(2)) { ph_prep(UB, a.in[5], a.in[6], XC, XT, VT, vb0, vbs); }
    SEAM(2);
    if (IN(3)) { ph_hgrn_states(ldsl, UB, VT, a.in[2], HS, HD, vb0, vbs); ph_mamba_states(ldsl, XT, dtraw, a.in[7], a.in[8], MS, MD, vb0, vbs); }
    SEAM(3);
    if (IN(4)) { ph_hgrn_scan(HS, HD, vb0, vbs); ph_mamba_scan(MS, MD, vb0, vbs); }
    SEAM(4);
    if (IN(5)) { ph_hgrn_out(ldsl, UB, VT, a.in[2], a.in[10], HS, OF, OC, vb0, vbs); ph_mamba_out(ldsl, UB, XC, XT, dtraw, a.in[7], a.in[8], a.in[9], a.in[11], MS, OC, vb0, vbs); }
    SEAM(5);
    if (IN(6)) { pg8::DenseOrder S; S.init(MT, DM, DM, (const bf16_t*)(ws + W_OUTE), G, cb); pg8::gemm_phase(ldsl, OC, DM, S, pg8::EpiBf16{YA, DM, nullptr}); }
    SEAM(6);
    if (IN(7)) {
        NormB A = NB0; A.y = YA; A.gpost = a.in[13];
        ph_norm2<1, false, false, false>(A, vb0, vbs);
        ph_cvt_rows(p_in, PB0, (size_t)MT * PDIM / 4, vb0, vbs);
        ph_convert_weights(ldsl, a.in, ws, ITEMS_DENSE, ITEMS_ALL, vb0, vbs);
    }
    SEAM(7);
    if (IN(8)) {
        { pg8::DenseOrder S; S.init(MT, 2 * DFF, DM, (const bf16_t*)(ws + W_GU), G, cb); pg8::gemm_phase(ldsl, XB, DM, S, pg8::EpiSwiglu{UB, DFF, RS, 0}); }
        { pg8::TailOrder S; S.init(MT, DM, PDIM, (const bf16_t*)(ws + W_PP), G, cb, (MT / 256) * (2 * DFF / 256) % G); pg8::gemm_phase(ldsl, PB0, PDIM, S, pg8::EpiBf16{YP, DM, nullptr}); }
    }
    SEAM(8);
    if (IN(9)) { pg8::DenseOrder S; S.init(MT, DM, DFF, (const bf16_t*)(ws + W_DN), G, cb); pg8::gemm_phase(ldsl, UB, DFF, S, pg8::EpiBf16{YA, DM, nullptr}); }
    SEAM(9);
    if (IN(10)) {
        NormB A = NB0; A.y = YA; A.gpost = a.in[18];
        ph_norm2<1, false, false, false>(A, vb0, vbs);
    }
    SEAM(10);
    if (IN(11)) { pg8::DenseOrder S; S.init(MT, DM, DM, (const bf16_t*)(ws + W_PG), G, cb); pg8::gemm_phase(ldsl, XB, DM, S, pg8::EpiPleGate{YP, DM, RS}); }
    SEAM(11);
    if (IN(12)) {
        NormB A = NB0; A.y = YP; A.gpost = a.in[33];
        ph_norm2<1, false, false, false>(A, vb0, vbs);
    }
    SEAM(12);
    if (IN(13)) { pg8::DenseOrder S; S.init(MT, 3072, DM, (const bf16_t*)(ws + W_QKV), G, cb); pg8::gemm_phase(ldsl, XB, DM, S, pg8::EpiBf16{UB, 3072, RS}); }
    SEAM(13);
    if (IN(14)) { ph_na(ldsl, UB, a.in[21], OC, vb0, vbs); }
    SEAM(14);
    if (IN(15)) { pg8::DenseOrder S; S.init(MT, DM, DM, (const bf16_t*)(ws + W_OUTO), G, cb); pg8::gemm_phase(ldsl, OC, DM, S, pg8::EpiBf16{YP1, DM, nullptr}); }
    SEAM(15);
    if (IN(16)) {
        NormB A = NB0; A.y = YP1; A.gpost = a.in[23]; A.gnext = a.in[24]; A.wr = a.in[25]; A.cnt = cnt; A.list = list; A.gatev = gatev; A.rsl = rsl; A.x8 = XG8;
        ph_norm2<1, false, false, true>(A, vb0, vbs, (LAS float*)ldsl);
        ph_cvt_rows(p_in + (size_t)MT * PDIM, PB1, (size_t)MT * PDIM / 4, vb0, vbs);
    }
    SEAM(16);
    if (IN(17)) { pg8::MoeOrder S; S.init(cnt, (volatile LAS int*)(ldsl + MISC_OFF + 64), 2 * DFFE, DM / 2, (const bf16_t*)(ws + W_EGU), (size_t)7 * MiB, true, G, cb);
        pg8::gemm_phase<pg8::EpiSwiglu8, pg8::MoeOrder, true>(ldsl, (const bf16_t*)XG8, DM / 2, S, pg8::EpiSwiglu8{(unsigned char*)UB, DFFE, rsl}); }
    SEAM(17);
    if (IN(18)) { pg8::MoeOrder S; S.init(cnt, (volatile LAS int*)(ldsl + MISC_OFF + 64), DM, DFFE / 2, (const bf16_t*)(ws + W_EDN), (size_t)(7 * MiB / 2), false, G, cb);
        pg8::gemm_phase<pg8::EpiMoeDown, pg8::MoeOrder, true>(ldsl, UB, DFFE / 2, S, pg8::EpiMoeDown{YB, list, gatev, 1.f / (pg8::W8_SCALE * pg8::ACT8_SCALE)});
        { pg8::TailOrder T; T.init(MT, DM, PDIM, (const bf16_t*)(ws + W_PP + 512 * 1024), G, cb, S.nwg % G); pg8::gemm_phase(ldsl, PB1, PDIM, T, pg8::EpiBf16{YP, DM, nullptr}); } }
    SEAM(18);
    if (IN(19)) {
        NormB A = NB0; A.y = YB; A.gpost = a.in[29];
        ph_norm2<2, false, false, false>(A, vb0, vbs);
    }
    SEAM(19);
    if (IN(20)) { pg8::DenseOrder S; S.init(MT, DM, DM, (const bf16_t*)(ws + W_PG + 2 * MiB), G, cb); pg8::gemm_phase(ldsl, XB, DM, S, pg8::EpiPleGate{YP, DM, RS}); }
    SEAM(20);
    if (IN(21)) {
        NormB A = NB0; A.y = YP; A.gpost = a.in[33] + DM; A.xout = a.out;
        ph_norm2<1, true, false, false>(A, vb0, vbs);
    }
#undef IN
#undef SEAM
}

extern "C" void kernel_launch(void* const* d_in, const int* in_sizes, int n_in, void* d_out, int out_size, void* d_ws, size_t ws_size, hipStream_t stream) {
    static int grid = 0;
    if (grid == 0) {
        if (n_in != 34 || out_size != MT * DM || ws_size < WS_END) { fprintf(stderr, "kernel_launch: unexpected shapes n_in %d out %d ws %zu (need %zu)\n", n_in, out_size, ws_size, (size_t)WS_END); grid = -1; return; }
        int dev = 0, cus = 0;
        if (hipGetDevice(&dev) != hipSuccess || hipDeviceGetAttribute(&cus, hipDeviceAttributeMultiprocessorCount, dev) != hipSuccess) { grid = -1; return; }
        if (hipFuncSetAttribute((const void*)fwd, hipFuncAttributeMaxDynamicSharedMemorySize, LDS_BYTES) != hipSuccess) { fprintf(stderr, "hipFuncSetAttribute failed\n"); grid = -1; return; }
        (void)hipGetLastError();
        grid = cus;
    }
    if (grid < 0) return;
    (void)hipMemsetAsync((char*)d_ws + WS_CTL, 0, CTL_ZERO_BYTES, stream);
    Args a{};
    for (int i = 0; i < 34; ++i) a.in[i] = (const float*)d_in[i];
    a.out = (float*)d_out; a.ws = (unsigned char*)d_ws;
#ifndef MK_PER_PHASE
    a.ph_lo = 0; a.ph_hi = N_PHASES;
    hipLaunchKernelGGL(fwd, dim3(grid), dim3(NTHR), LDS_BYTES, stream, a);
#else
    for (int ph = 0; ph < N_PHASES; ++ph) {
        a.ph_lo = ph; a.ph_hi = ph + 1;
        hipLaunchKernelGGL(fwd, dim3(grid), dim3(NTHR), LDS_BYTES, stream, a);
    }
#endif
}
```

```cpp
#include <hip/hip_runtime.h>
#include <stdint.h>
#include <stdio.h>

#define DEVI __device__ __forceinline__
#define LAS __attribute__((address_space(3)))
typedef unsigned short bf16_t;

constexpr int NB = 4, SEQ = 4096, DM = 1024, MT = NB * SEQ;
constexpr int EVEN_IN = 4112, UW = 4096, DFF = 2816, NEXP = 8, DFFE = 3584, PDIM = 256;
constexpr float EPS = 1e-6f;
constexpr int NTHR = 512;
constexpr int LDS_BYTES = 147456;
constexpr int MISC_OFF = 131072 + 320;
constexpr int MOE_ROWS = 2 * MT + NEXP * 256;

constexpr size_t MiB = 1u << 20;
constexpr size_t WS_CTL = 0, CTL_ZERO_BYTES = 1 * MiB;
constexpr size_t WS_LIST = 1 * MiB;
constexpr size_t WS_GATE = WS_LIST + 512 * 1024;
constexpr size_t WS_DT = 2 * MiB;
constexpr size_t WS_W = 3 * MiB;
constexpr size_t W_IN = WS_W, W_OUTE = W_IN + 8 * MiB, W_GU = W_OUTE + 2 * MiB, W_DN = W_GU + 11 * MiB, W_PG = W_DN + 6 * MiB, W_PP = W_PG + 4 * MiB,
                 W_QKV = W_PP + 1 * MiB, W_OUTO = W_QKV + 6 * MiB, W_EGU = W_OUTO + 2 * MiB, W_EDN = W_EGU + 112 * MiB, W_END = W_EDN + 56 * MiB;
constexpr size_t WS_XB = W_END;
constexpr size_t WS_R = WS_XB + 32 * MiB;
constexpr size_t WS_UB = WS_R;
constexpr size_t WS_PB0 = WS_R + 88 * MiB;
constexpr size_t WS_YA = WS_R + 128 * MiB;
constexpr size_t WS_OF = WS_R + 160 * MiB;
constexpr size_t WS_OC = WS_R + 192 * MiB;
constexpr size_t WS_YP = WS_R + 224 * MiB;
constexpr size_t WS_YP1 = WS_R;
constexpr size_t WS_PB1 = W_EDN + 32 * MiB;
constexpr size_t WS_XG8 = WS_R + 120 * MiB;
constexpr size_t WS_END = WS_R + 256 * MiB;
constexpr size_t WS_Y = W_EGU;
constexpr size_t WS_MS = W_EGU;
constexpr size_t WS_HS = W_EGU + 64 * MiB;
constexpr size_t WS_XT = W_EDN;
constexpr size_t WS_VT = W_EDN + 24 * MiB;
constexpr size_t WS_MD = W_EDN + 40 * MiB;
constexpr size_t WS_HD = W_EDN + 41 * MiB;
static_assert(WS_R + (size_t)MOE_ROWS * DFFE <= WS_XG8 && WS_XG8 + 128 * MiB <= WS_END && WS_END <= 510 * MiB, "ws map");
constexpr size_t WS_RS = WS_CTL + 512 * 1024;
constexpr int CW_CNT = 64;
constexpr int CW_BAR = 4096;

DEVI int opq(int x) { asm volatile("" : "+v"(x)); return x; }
DEVI float bf2f(bf16_t b) { return __uint_as_float(((unsigned)b) << 16); }
typedef float f32x2c __attribute__((ext_vector_type(2)));
typedef __bf16 bf16x2c __attribute__((ext_vector_type(2)));
DEVI unsigned cvt2bf(float lo, float hi) { const f32x2c v = {lo, hi}; return __builtin_bit_cast(unsigned, __builtin_convertvector(v, bf16x2c)); }
DEVI bf16_t f2bf(float f) { return (bf16_t)(cvt2bf(f, 0.f) & 0xffffu); }
DEVI float silu_f(float x) { return x * __builtin_amdgcn_rcpf(1.f + __builtin_amdgcn_exp2f(-1.44269504f * x)); }
DEVI float sigmoid_f(float x) { return __builtin_amdgcn_rcpf(1.f + __builtin_amdgcn_exp2f(-1.44269504f * x)); }
DEVI float softplus_f(float x) { return x > 20.f ? x : log1pf(__expf(x)); }
DEVI float wave_sum(float v) {
#pragma unroll
    for (int o = 1; o < 64; o <<= 1) v += __shfl_xor(v, o);
    return v;
}


typedef short bf16x8 __attribute__((ext_vector_type(8)));
typedef float f32x4 __attribute__((ext_vector_type(4)));
typedef unsigned u32x4 __attribute__((ext_vector_type(4)));
typedef unsigned u32x2 __attribute__((ext_vector_type(2)));
DEVI unsigned pk2(float lo, float hi) { return cvt2bf(lo, hi); }
DEVI float bflo(unsigned w) { return __uint_as_float(w << 16); }
DEVI float bfhi(unsigned w) { return __uint_as_float(w & 0xffff0000u); }

DEVI unsigned pg8_pk4(float a, float b, float c, float d) {
    a = __builtin_amdgcn_fmed3f(a, -448.f, 448.f); b = __builtin_amdgcn_fmed3f(b, -448.f, 448.f); c = __builtin_amdgcn_fmed3f(c, -448.f, 448.f); d = __builtin_amdgcn_fmed3f(d, -448.f, 448.f);
    int p = __builtin_amdgcn_cvt_pk_fp8_f32(a, b, 0, false); p = __builtin_amdgcn_cvt_pk_fp8_f32(c, d, p, true); return (unsigned)p; }
DEVI float wave_sum16(float (&v)[16], int lane) {
    const bool h5 = lane & 32, h4 = lane & 16, h3 = lane & 8, h2 = lane & 4;
#pragma unroll
    for (int i = 0; i < 8; ++i) { const float send = h5 ? v[i] : v[i + 8], keep = h5 ? v[i + 8] : v[i]; v[i] = keep + __shfl_xor(send, 32); }
#pragma unroll
    for (int i = 0; i < 4; ++i) { const float send = h4 ? v[i] : v[i + 4], keep = h4 ? v[i + 4] : v[i]; v[i] = keep + __shfl_xor(send, 16); }
#pragma unroll
    for (int i = 0; i < 2; ++i) { const float send = h3 ? v[i] : v[i + 2], keep = h3 ? v[i + 2] : v[i]; v[i] = keep + __shfl_xor(send, 8); }
    { const float send = h2 ? v[0] : v[1], keep = h2 ? v[1] : v[0]; v[0] = keep + __shfl_xor(send, 4); }
    float r = v[0]; r += __shfl_xor(r, 1); r += __shfl_xor(r, 2); return r;
}
DEVI float wave_sum8(float (&v)[8], int lane) {
    const bool h5 = lane & 32, h4 = lane & 16, h3 = lane & 8;
#pragma unroll
    for (int i = 0; i < 4; ++i) { const float send = h5 ? v[i] : v[i + 4], keep = h5 ? v[i + 4] : v[i]; v[i] = keep + __shfl_xor(send, 32); }
#pragma unroll
    for (int i = 0; i < 2; ++i) { const float send = h4 ? v[i] : v[i + 2], keep = h4 ? v[i + 2] : v[i]; v[i] = keep + __shfl_xor(send, 16); }
    { const float send = h3 ? v[0] : v[1], keep = h3 ? v[1] : v[0]; v[0] = keep + __shfl_xor(send, 8); }
    float r = v[0]; r += __shfl_xor(r, 1); r += __shfl_xor(r, 2); r += __shfl_xor(r, 4); return r;
}
struct NormB { const float* xin; bf16_t* XB; const bf16_t* y; const float* gpost; float* rs; const float* gnext;
               const float* win; float* dtraw; const float* wr; unsigned* cnt; int* list; float* gatev; float* rsl; float* xout; unsigned char* x8; };
DEVI void unpack8(const u32x4 w, float* v) { v[0] = bflo(w.x); v[1] = bfhi(w.x); v[2] = bflo(w.y); v[3] = bfhi(w.y); v[4] = bflo(w.z); v[5] = bfhi(w.z); v[6] = bflo(w.w); v[7] = bfhi(w.w); }
template <int YMODE, bool FINAL, bool DT, bool ROUTE>
DEVI void ph_norm2(const NormB& A, int vb0, int vbs, LAS float* wl = nullptr) {
    const int tidq = opq((int)threadIdx.x); const int wid = tidq >> 6, lane = tidq & 63;
    if (DT || ROUTE) {
        constexpr int NJ = DT ? 16 : 8;
        __syncthreads();
        for (int e = tidq; e < DM * NJ / 4; e += NTHR) { const int k = e / (NJ / 4), j4 = (e % (NJ / 4)) * 4;
            const float4 w = DT ? *(const float4*)(A.win + (size_t)k * EVEN_IN + 4096 + j4) : *(const float4*)(A.wr + (size_t)k * 8 + j4);
            wl[(j4 + 0) * DM + k] = w.x; wl[(j4 + 1) * DM + k] = w.y; wl[(j4 + 2) * DM + k] = w.z; wl[(j4 + 3) * DM + k] = w.w; }
        __syncthreads();
    }
    constexpr int R = (DT || ROUTE) ? 2 : 4;
    for (int row0 = (vb0 * 8 + wid) * R; row0 < MT; row0 += vbs * 8 * R) {
        float xv[R][16]; float yv[R][16];
#pragma unroll
        for (int rr = 0; rr < R; ++rr) {
            const size_t ro = (size_t)(row0 + rr) * DM + lane * 8;
            if (YMODE == 0) {
#pragma unroll
                for (int i = 0; i < 2; ++i) { const float4 p0 = *(const float4*)(A.xin + ro + i * 512), p1 = *(const float4*)(A.xin + ro + i * 512 + 4);
                    xv[rr][i * 8 + 0] = p0.x; xv[rr][i * 8 + 1] = p0.y; xv[rr][i * 8 + 2] = p0.z; xv[rr][i * 8 + 3] = p0.w; xv[rr][i * 8 + 4] = p1.x; xv[rr][i * 8 + 5] = p1.y; xv[rr][i * 8 + 6] = p1.z; xv[rr][i * 8 + 7] = p1.w; }
            } else {
#pragma unroll
                for (int i = 0; i < 2; ++i) {
                    unpack8(*(const u32x4*)(A.XB + ro + i * 512), xv[rr] + i * 8);
                    unpack8(*(const u32x4*)(A.y + ro + i * 512), yv[rr] + i * 8);
                    if (YMODE == 2) { float y2[8]; unpack8(*(const u32x4*)(A.y + (size_t)MT * DM + ro + i * 512), y2);
#pragma unroll
                        for (int j = 0; j < 8; ++j) yv[rr][i * 8 + j] += y2[j]; }
                }
            }
        }
        if (YMODE != 0) {
            float gg[16];
#pragma unroll
            for (int i = 0; i < 2; ++i) { const float4 g0 = *(const float4*)(A.gpost + i * 512 + lane * 8), g1 = *(const float4*)(A.gpost + i * 512 + lane * 8 + 4);
                gg[i * 8 + 0] = g0.x; gg[i * 8 + 1] = g0.y; gg[i * 8 + 2] = g0.z; gg[i * 8 + 3] = g0.w; gg[i * 8 + 4] = g1.x; gg[i * 8 + 5] = g1.y; gg[i * 8 + 6] = g1.z; gg[i * 8 + 7] = g1.w; }
            float ss[R];
#pragma unroll
            for (int rr = 0; rr < R; ++rr) { ss[rr] = 0.f;
#pragma unroll
                for (int j = 0; j < 16; ++j) ss[rr] += yv[rr][j] * yv[rr][j]; }
#pragma unroll
            for (int o = 1; o < 64; o <<= 1)
#pragma unroll
                for (int rr = 0; rr < R; ++rr) ss[rr] += __shfl_xor(ss[rr], o);
#pragma unroll
            for (int rr = 0; rr < R; ++rr) { const float r = rsqrtf(ss[rr] * (1.f / DM) + EPS);
#pragma unroll
                for (int j = 0; j < 16; ++j) xv[rr][j] += yv[rr][j] * r * gg[j]; }
        }
        if (FINAL) {
#pragma unroll
            for (int rr = 0; rr < R; ++rr)
#pragma unroll
                for (int i = 0; i < 2; ++i) { float* op = A.xout + (size_t)(row0 + rr) * DM + i * 512 + lane * 8;
                    *(float4*)op = make_float4(xv[rr][i * 8], xv[rr][i * 8 + 1], xv[rr][i * 8 + 2], xv[rr][i * 8 + 3]); *(float4*)(op + 4) = make_float4(xv[rr][i * 8 + 4], xv[rr][i * 8 + 5], xv[rr][i * 8 + 6], xv[rr][i * 8 + 7]); }
        } else {
            float ss[R];
#pragma unroll
            for (int rr = 0; rr < R; ++rr) {
#pragma unroll
                for (int i = 0; i < 2; ++i) { u32x4 o; o.x = pk2(xv[rr][i * 8], xv[rr][i * 8 + 1]); o.y = pk2(xv[rr][i * 8 + 2], xv[rr][i * 8 + 3]); o.z = pk2(xv[rr][i * 8 + 4], xv[rr][i * 8 + 5]); o.w = pk2(xv[rr][i * 8 + 6], xv[rr][i * 8 + 7]);
                    *(u32x4*)(A.XB + (size_t)(row0 + rr) * DM + i * 512 + lane * 8) = o;
                }
                ss[rr] = 0.f;
#pragma unroll
                for (int j = 0; j < 16; ++j) ss[rr] += xv[rr][j] * xv[rr][j];
            }
#pragma unroll
            for (int o = 1; o < 64; o <<= 1)
#pragma unroll
                for (int rr = 0; rr < R; ++rr) ss[rr] += __shfl_xor(ss[rr], o);
            float r2[R];
#pragma unroll
            for (int rr = 0; rr < R; ++rr) { r2[rr] = rsqrtf(ss[rr] * (1.f / DM) + EPS); if (lane == 0) A.rs[row0 + rr] = r2[rr]; }
            if (DT || ROUTE) {
                float gn[16];
#pragma unroll
                for (int i = 0; i < 2; ++i) { const float4 g0 = *(const float4*)(A.gnext + i * 512 + lane * 8), g1 = *(const float4*)(A.gnext + i * 512 + lane * 8 + 4);
                    gn[i * 8 + 0] = g0.x; gn[i * 8 + 1] = g0.y; gn[i * 8 + 2] = g0.z; gn[i * 8 + 3] = g0.w; gn[i * 8 + 4] = g1.x; gn[i * 8 + 5] = g1.y; gn[i * 8 + 6] = g1.z; gn[i * 8 + 7] = g1.w; }
                int re1[R], re2[R], lr1[R], lr2[R]; float rw1[R], rw2[R];
                volatile LAS int* lcnt = (volatile LAS int*)((LAS unsigned char*)wl + 40960);
                if (ROUTE) { __syncthreads(); if (tidq < 8) lcnt[tidq] = 0; __syncthreads(); }
#pragma unroll
                for (int rr = 0; rr < R; ++rr) {
                    const int row = row0 + rr;
                    float hv[16];
#pragma unroll
                    for (int j = 0; j < 16; ++j) hv[j] = (rr == 0 ? xv[0][j] : xv[R - 1][j]) * (rr == 0 ? r2[0] : r2[R - 1]) * gn[j];
                    if (DT) {
                        float pd[16];
#pragma unroll 4
                        for (int j = 0; j < 16; ++j) {
                            float p = 0.f;
#pragma unroll
                            for (int i = 0; i < 2; ++i) { const LAS float* wp = wl + j * DM + i * 512 + lane * 8;
                                const f32x4 w0 = *(const LAS f32x4*)wp, w1 = *(const LAS f32x4*)(wp + 4);
                                p += hv[i * 8 + 0] * w0[0] + hv[i * 8 + 1] * w0[1] + hv[i * 8 + 2] * w0[2] + hv[i * 8 + 3] * w0[3] + hv[i * 8 + 4] * w1[0] + hv[i * 8 + 5] * w1[1] + hv[i * 8 + 6] * w1[2] + hv[i * 8 + 7] * w1[3]; }
                            pd[j] = p;
                        }
                        const float dk = wave_sum16(pd, lane);
                        if ((lane & 3) == 0) A.dtraw[(size_t)row * 16 + (lane >> 2)] = dk;
                    }
                    if (ROUTE) {
                        float pl[8];
#pragma unroll 4
                        for (int e = 0; e < 8; ++e) {
                            float p = 0.f;
#pragma unroll
                            for (int i = 0; i < 2; ++i) { const LAS float* wp = wl + e * DM + i * 512 + lane * 8;
                                const f32x4 w0 = *(const LAS f32x4*)wp, w1 = *(const LAS f32x4*)(wp + 4);
                                p += hv[i * 8 + 0] * w0[0] + hv[i * 8 + 1] * w0[1] + hv[i * 8 + 2] * w0[2] + hv[i * 8 + 3] * w0[3] + hv[i * 8 + 4] * w1[0] + hv[i * 8 + 5] * w1[1] + hv[i * 8 + 6] * w1[2] + hv[i * 8 + 7] * w1[3]; }
                            pl[e] = p;
                        }
                        const float lk = wave_sum8(pl, lane);
                        float lg[8];
#pragma unroll
                        for (int e = 0; e < 8; ++e) lg[e] = __shfl(lk, e * 8);
                        int e1 = 0; float v1 = lg[0];
#pragma unroll
                        for (int e = 1; e < 8; ++e) if (lg[e] > v1) { v1 = lg[e]; e1 = e; }
                        int e2 = 0; float v2 = -3.0e38f;
#pragma unroll
                        for (int e = 0; e < 8; ++e) if (e != e1 && lg[e] > v2) { v2 = lg[e]; e2 = e; }
                        const float ex = __expf(v2 - v1);
                        re1[rr] = e1; re2[rr] = e2; rw1[rr] = 1.f / (1.f + ex); rw2[rr] = ex / (1.f + ex);
                        if (lane == 0) { lr1[rr] = __hip_atomic_fetch_add((LAS int*)lcnt + e1, 1, __ATOMIC_RELAXED, __HIP_MEMORY_SCOPE_WORKGROUP); lr2[rr] = __hip_atomic_fetch_add((LAS int*)lcnt + e2, 1, __ATOMIC_RELAXED, __HIP_MEMORY_SCOPE_WORKGROUP); }
                    }
                }
                if (ROUTE) {
                    __syncthreads();
                    if (tidq < 8) lcnt[8 + tidq] = (int)atomicAdd(&A.cnt[tidq * 64], (unsigned)lcnt[tidq]);
                    __syncthreads();
#pragma unroll
                    for (int rr = 0; rr < R; ++rr) {
                        const int row = row0 + rr;
                        int dst1 = 0, dst2 = 0;
                        if (lane == 0) {
                            const int e1 = re1[rr], e2 = re2[rr];
                            const int p1 = lcnt[8 + e1] + lr1[rr], p2 = lcnt[8 + e2] + lr2[rr];
                            A.list[e1 * MT + p1] = row * 2; A.gatev[e1 * MT + p1] = rw1[rr]; A.rsl[e1 * MT + p1] = r2[rr];
                            A.list[e2 * MT + p2] = row * 2 + 1; A.gatev[e2 * MT + p2] = rw2[rr]; A.rsl[e2 * MT + p2] = r2[rr];
                            dst1 = e1 * MT + p1; dst2 = e2 * MT + p2;
                        }
                        dst1 = __builtin_amdgcn_readfirstlane(dst1); dst2 = __builtin_amdgcn_readfirstlane(dst2);
#pragma unroll
                        for (int i = 0; i < 2; ++i) { u32x2 o8;
                            const float* xs = xv[rr] + i * 8;
                            o8.x = pg8_pk4(xs[0], xs[1], xs[2], xs[3]); o8.y = pg8_pk4(xs[4], xs[5], xs[6], xs[7]);
                            *(u32x2*)(A.x8 + (size_t)dst1 * DM + i * 512 + lane * 8) = o8; *(u32x2*)(A.x8 + (size_t)dst2 * DM + i * 512 + lane * 8) = o8; }
                    }
                }
            }
        }
    }
}

DEVI void transpose_item(const float* W, int ldw, int K, int k0, int n0, bf16_t* WT, int drow0, LAS float* scr, int lane, const float* gain) {
    {
        const int ka = lane >> 3, n4 = (lane & 7) * 4;
        float4 wv[8];
#pragma unroll
        for (int i = 0; i < 8; ++i) wv[i] = *(const float4*)(W + (size_t)(k0 + i * 8 + ka) * ldw + n0 + n4);
#pragma unroll
        for (int i = 0; i < 8; ++i) { LAS float* d = scr + (i * 8 + ka) * 33 + n4; d[0] = wv[i].x; d[1] = wv[i].y; d[2] = wv[i].z; d[3] = wv[i].w; }
    }
    asm volatile("s_waitcnt lgkmcnt(0)" ::: "memory");
    const int c = lane & 7;
    float4 ga = make_float4(1.f, 1.f, 1.f, 1.f), gb = ga;
    if (gain) { ga = *(const float4*)(gain + k0 + 8 * c); gb = *(const float4*)(gain + k0 + 8 * c + 4); }
#pragma unroll
    for (int j = 0; j < 4; ++j) { const int n = (lane >> 3) + 8 * j; const LAS float* sp = scr + (8 * c) * 33 + n;
        u32x4 o; o.x = pk2(sp[0 * 33] * ga.x, sp[1 * 33] * ga.y); o.y = pk2(sp[2 * 33] * ga.z, sp[3 * 33] * ga.w); o.z = pk2(sp[4 * 33] * gb.x, sp[5 * 33] * gb.y); o.w = pk2(sp[6 * 33] * gb.z, sp[7 * 33] * gb.w);
        *(u32x4*)(WT + (size_t)(drow0 + n) * K + k0 + 8 * c) = o; }
    asm volatile("s_waitcnt lgkmcnt(0)" ::: "memory");
}
DEVI void transpose_item_fp8(const float* W, int ldw, int K, int k0, int n0, unsigned char* WT8, int drow0, LAS float* scr, int lane, const float* gain) {
    {
        const int ka = lane >> 3, n4 = (lane & 7) * 4;
        float4 wv[8];
#pragma unroll
        for (int i = 0; i < 8; ++i) wv[i] = *(const float4*)(W + (size_t)(k0 + i * 8 + ka) * ldw + n0 + n4);
#pragma unroll
        for (int i = 0; i < 8; ++i) { LAS float* d = scr + (i * 8 + ka) * 33 + n4; d[0] = wv[i].x; d[1] = wv[i].y; d[2] = wv[i].z; d[3] = wv[i].w; }
    }
    asm volatile("s_waitcnt lgkmcnt(0)" ::: "memory");
    const int c = lane & 7;
    float4 ga = make_float4(64.f, 64.f, 64.f, 64.f), gb = ga;
    if (gain) { ga = *(const float4*)(gain + k0 + 8 * c); gb = *(const float4*)(gain + k0 + 8 * c + 4); ga.x *= 64.f; ga.y *= 64.f; ga.z *= 64.f; ga.w *= 64.f; gb.x *= 64.f; gb.y *= 64.f; gb.z *= 64.f; gb.w *= 64.f; }
#pragma unroll
    for (int j = 0; j < 4; ++j) { const int n = (lane >> 3) + 8 * j; const LAS float* sp = scr + (8 * c) * 33 + n;
        u32x2 o; o.x = pg8_pk4(sp[0 * 33] * ga.x, sp[1 * 33] * ga.y, sp[2 * 33] * ga.z, sp[3 * 33] * ga.w); o.y = pg8_pk4(sp[4 * 33] * gb.x, sp[5 * 33] * gb.y, sp[6 * 33] * gb.z, sp[7 * 33] * gb.w);
        *(u32x2*)(WT8 + (size_t)(drow0 + n) * K + k0 + 8 * c) = o; }
    asm volatile("s_waitcnt lgkmcnt(0)" ::: "memory");
}
struct Job { int in_idx; unsigned src_off; int ldw; int K; int ncols; unsigned long long dst; int mode; int item0; int gain_idx; int gain_off; int fp8; };
constexpr int NJOBS = 11 + 24;
struct JobTable { Job j[NJOBS]; int total; };
constexpr JobTable make_jobs() {
    JobTable t{}; int n = 0, it = 0;
    auto add = [&](int idx, unsigned off, int ldw, int K, int ncols, unsigned long long dst, int mode, int gi, int go, int f8 = 0) { t.j[n] = Job{idx, off, ldw, K, ncols, dst, mode, it, gi, go, f8}; it += (K / 64) * (ncols / 32); ++n; };
    add(4, 0, EVEN_IN, DM, UW, W_IN, 0, 3, 0);
    add(12, 0, DM, DM, DM, W_OUTE, 0, -1, 0);
    add(15, 0, DFF, DM, DFF, W_GU, 1, 14, 0);
    add(16, 0, DFF, DM, DFF, W_GU, 2, 14, 0);
    add(17, 0, DM, DFF, DM, W_DN, 0, -1, 0);
    add(31, 0, DM, DM, DM, W_PG, 0, 30, 0);
    add(31, DM * DM, DM, DM, DM, W_PG + 2 * MiB, 0, 30, DM);
    add(32, 0, DM, PDIM, DM, W_PP, 0, -1, 0);
    add(32, PDIM * DM, DM, PDIM, DM, W_PP + 512 * 1024, 0, -1, 0);
    add(20, 0, 3072, DM, 3072, W_QKV, 0, 19, 0);
    add(22, 0, DM, DM, DM, W_OUTO, 0, -1, 0);
    for (int e = 0; e < NEXP; ++e) {
        add(26, (unsigned)e * DM * DFFE, DFFE, DM, DFFE, W_EGU + (unsigned long long)e * 7 * MiB, 1, 24, 0, 1);
        add(27, (unsigned)e * DM * DFFE, DFFE, DM, DFFE, W_EGU + (unsigned long long)e * 7 * MiB, 2, 24, 0, 1);
        add(28, (unsigned)e * DFFE * DM, DM, DFFE, DM, W_EDN + (unsigned long long)e * (7 * MiB / 2), 0, -1, 0, 1);
    }
    t.total = it; return t;
}
__device__ const JobTable g_jobs = make_jobs();
constexpr int ITEMS_DENSE = make_jobs().j[11].item0, ITEMS_ALL = make_jobs().total;
DEVI void ph_convert_weights(LAS unsigned char* lds, const float* const* in, unsigned char* ws, int it_lo, int it_hi, int vb0, int vbs) {
    const int tidq = opq((int)threadIdx.x); const int wid = __builtin_amdgcn_readfirstlane(tidq >> 6), lane = tidq & 63;
    LAS float* scr = (LAS float*)(lds + wid * 16384);
    int jb = 0;
    for (int it = it_lo + vb0 * 8 + wid; it < it_hi; it += vbs * 8) {
        while (jb + 1 < NJOBS && g_jobs.j[jb + 1].item0 <= it) ++jb;
        const Job J = g_jobs.j[jb];
        const int r = it - J.item0; const int nblk = J.ncols / 32; const int kb = r / nblk, nb = r % nblk;
        const int n0 = nb * 32; int drow0 = n0;
        if (J.mode != 0) drow0 = (n0 >> 7) * 256 + (n0 & 127) + (J.mode == 2 ? 128 : 0);
        const float* gp = J.gain_idx >= 0 ? in[J.gain_idx] + J.gain_off : nullptr;
        if (J.fp8) transpose_item_fp8(in[J.in_idx] + J.src_off, J.ldw, J.K, kb * 64, n0, ws + J.dst, drow0, scr, lane, gp);
        else transpose_item(in[J.in_idx] + J.src_off, J.ldw, J.K, kb * 64, n0, (bf16_t*)(ws + J.dst), drow0, scr, lane, gp);
    }
}
DEVI void ph_cvt_rows(const float* src, bf16_t* dst, size_t n4, int vb0, int vbs) {
    for (size_t e = (size_t)vb0 * NTHR + opq((int)threadIdx.x); e < n4; e += (size_t)vbs * NTHR) {
        const float4 v = ((const float4*)src)[e]; u32x2 o; o.x = pk2(v.x, v.y); o.y = pk2(v.z, v.w); ((u32x2*)dst)[e] = o; }
}

namespace pg8 {
constexpr int BM = 256, BK = 64, HALF = 128, HTB = HALF * BK * 2, STAGE_BYTES = 8 * HTB, NXCD = 8, WGM = 8;
__host__ __device__ __forceinline__ int lds_byte(int r, int c) { const int st = (r >> 4) * 2 + (c >> 5), rr = r & 15, cc = c & 31, ob = rr * 64 + cc * 2; return st * 1024 + (ob ^ (((ob >> 9) & 1) << 5)); }
__host__ __device__ __forceinline__ void stage_rc(int b, int& R, int& C) { const int st = b / 1024, sb = b % 1024, swz = sb ^ (((sb >> 9) & 1) << 5); R = (st >> 1) * 16 + swz / 64; C = (st & 1) * 32 + (swz % 64) / 2; }
__host__ __device__ __forceinline__ int perm32(int rho) { const int n = rho >> 4, i = rho & 15; return 8 * (i >> 2) + 4 * n + (i & 3); }
struct Unit { int pm, pn; int row0; int arow0; int mvalid; int e; int mbase; const char* B; };
DEVI void xcd_tile(int L, int nwg, int nM, int nN, int& pm, int& pn) {
    int wgid = L; { const int q = nwg / NXCD, r = nwg % NXCD, xcd = wgid % NXCD, off = wgid / NXCD; wgid = (xcd < r ? xcd * (q + 1) : r * (q + 1) + (xcd - r) * q) + off; }
    const int nig = WGM * nN, gid = wgid / nig, fm = gid * WGM, gsz = (nM - fm) < WGM ? (nM - fm) : WGM;
    pm = fm + ((wgid % nig) % gsz); pn = (wgid % nig) / gsz;
}
struct DenseOrder {
    int nM, nN, nwg, G, c; const char* Bt; size_t tstepB;
    DEVI void init(int M, int N, int K, const bf16_t* Bt_, int G_, int c_) { nM = M / BM; nN = N / BM; nwg = nM * nN; G = G_; c = c_; Bt = (const char*)Bt_; tstepB = (size_t)BM * K * 2; }
    DEVI bool next(int i, Unit& u) const { const long L = (long)i * G + c; if (L >= nwg) return false; xcd_tile((int)L, nwg, nM, nN, u.pm, u.pn); u.row0 = u.pm * BM; u.arow0 = u.row0; u.mvalid = BM; u.e = 0; u.mbase = 0; u.B = Bt + (size_t)u.pn * tstepB; return true; }
};
struct TailOrder {
    int nM, nN, nwg, nb, r; const char* Bt; size_t tstepB;
    DEVI void init(int M, int N, int K, const bf16_t* Bt_, int G_, int c_, int first) { nM = M / BM; nN = N / BM; nwg = nM * nN; Bt = (const char*)Bt_; tstepB = (size_t)BM * K * 2;
        if (first >= G_) first = 0; nb = G_ - first; r = c_ - first; }
    DEVI bool next(int i, Unit& u) const { if (r < 0) return false; const long L = (long)i * nb + r; if (L >= nwg) return false; u.pm = (int)L / nN; u.pn = (int)L % nN; u.row0 = u.pm * BM; u.arow0 = u.row0; u.mvalid = BM; u.e = 0; u.mbase = 0; u.B = Bt + (size_t)u.pn * tstepB; return true; }
};
struct MoeOrder {
    int nM, nN, nwg, G, c; const char* Bt; size_t estepB, tstepB; const volatile LAS int* tab; bool per_expert;
    DEVI void init(const unsigned* cnt, volatile LAS int* tab_, int N, int K, const bf16_t* Bt_, size_t estep_bytes, bool per_expert_, int G_, int c_) {
        __syncthreads();
        if (threadIdx.x < 8) tab_[16 + threadIdx.x] = (int)__hip_atomic_load(cnt + threadIdx.x * 64, __ATOMIC_RELAXED, __HIP_MEMORY_SCOPE_AGENT);
        __syncthreads();
        if (threadIdx.x == 0) { int t = 0;
            for (int e = 0; e < 8; ++e) { const int n = tab_[16 + e]; tab_[e] = t; t += (n + BM - 1) / BM; }
            tab_[8] = t; }
        __syncthreads();
        tab = tab_; nM = __builtin_amdgcn_readfirstlane(tab_[8]); nN = N / BM; nwg = nM * nN; G = G_; c = c_; Bt = (const char*)Bt_; estepB = estep_bytes; tstepB = (size_t)BM * K * 2; per_expert = per_expert_;
    }
    DEVI bool next(int i, Unit& u) const { const long L = (long)i * G + c; if (L >= nwg) return false; xcd_tile((int)L, nwg, nM, nN, u.pm, u.pn);
        int e = 0;
        for (int k = 1; k < 8; ++k) if (u.pm >= __builtin_amdgcn_readfirstlane(tab[k])) e = k;
        const int t0 = __builtin_amdgcn_readfirstlane(tab[e]), n = __builtin_amdgcn_readfirstlane(tab[16 + e]);
        u.e = e; u.row0 = u.pm * BM; const int m0 = (u.pm - t0) * BM; u.mbase = m0; u.arow0 = per_expert ? e * MT + m0 : u.row0; u.mvalid = (n - m0) < BM ? (n - m0) : BM; u.B = Bt + (size_t)e * estepB + (size_t)u.pn * tstepB; return true; }
};
DEVI unsigned cvt_pk_bf16(float lo, float hi) { return cvt2bf(lo, hi); }

constexpr int EPI_OFF = MISC_OFF + 1024, EPI_SLICE = 1024;
static_assert(EPI_OFF + 8 * EPI_SLICE <= LDS_BYTES, "epilogue scalar slices");
DEVI void epi_dma(const void* g, LAS unsigned char* dst) { __builtin_amdgcn_global_load_lds((const unsigned*)g, (LAS unsigned*)dst, 4, 0, 0); }
struct EpiBf16 { static constexpr bool PERM = true; bf16_t* O; int ldc; const float* rs;
    DEVI void pre(LAS unsigned char* esl, const Unit& u, int wr, int lane) const {
        if (rs) { epi_dma(rs + u.row0 + wr * 64 + lane, esl); epi_dma(rs + u.row0 + wr * 64 + HALF + lane, esl + 256); } }
    DEVI void operator()(const f32x4 (&acc)[2][2][4][2], const Unit& u, int wr, int wc, int fr, int fq, const LAS unsigned char* esl) const {
        float pv[8];
#pragma unroll
        for (int q = 0; q < 8; ++q) pv[q] = ((const LAS float*)esl)[(q >> 2) * 64 + (q & 3) * 16 + fr];
        const int row0 = u.row0 + wr * 64 + fr, col0 = u.pn * BM + wc * 32 + 8 * fq;
#pragma unroll
        for (int ai = 0; ai < 2; ++ai)
#pragma unroll
            for (int m = 0; m < 4; ++m) { const int row = row0 + ai * HALF + m * 16; bf16_t* rowp = O + (size_t)row * ldc + col0;
                const float sc = rs ? pv[ai * 4 + m] : 1.f;
#pragma unroll
                for (int bj = 0; bj < 2; ++bj) { const f32x4 v0 = acc[ai][bj][m][0] * sc, v1 = acc[ai][bj][m][1] * sc;
                    u32x4 w; w.x = cvt_pk_bf16(v0[0], v0[1]); w.y = cvt_pk_bf16(v0[2], v0[3]); w.z = cvt_pk_bf16(v1[0], v1[1]); w.w = cvt_pk_bf16(v1[2], v1[3]);
                    *(u32x4*)(rowp + bj * HALF) = w; } }
    } };
struct EpiPleGate { static constexpr bool PERM = true; bf16_t* T; int ldc; const float* rs;
    DEVI void pre(LAS unsigned char* esl, const Unit& u, int wr, int lane) const {
        epi_dma(rs + u.row0 + wr * 64 + lane, esl); epi_dma(rs + u.row0 + wr * 64 + HALF + lane, esl + 256); }
    DEVI void operator()(const f32x4 (&acc)[2][2][4][2], const Unit& u, int wr, int wc, int fr, int fq, const LAS unsigned char* esl) const {
        float pv[8];
#pragma unroll
        for (int q = 0; q < 8; ++q) pv[q] = ((const LAS float*)esl)[(q >> 2) * 64 + (q & 3) * 16 + fr];
        const int row0 = u.row0 + wr * 64 + fr, col0 = u.pn * BM + wc * 32 + 8 * fq;
#pragma unroll
        for (int ai = 0; ai < 2; ++ai)
#pragma unroll
            for (int m = 0; m < 4; ++m) { const int row = row0 + ai * HALF + m * 16; bf16_t* rowp = T + (size_t)row * ldc + col0;
                const float sc = pv[ai * 4 + m];
#pragma unroll
                for (int bj = 0; bj < 2; ++bj) { const f32x4 v0 = acc[ai][bj][m][0] * sc, v1 = acc[ai][bj][m][1] * sc;
                    const u32x4 pp = *(const u32x4*)(rowp + bj * HALF);
                    u32x4 w; w.x = cvt_pk_bf16(sigmoid_f(v0[0]) * bflo(pp.x), sigmoid_f(v0[1]) * bfhi(pp.x)); w.y = cvt_pk_bf16(sigmoid_f(v0[2]) * bflo(pp.y), sigmoid_f(v0[3]) * bfhi(pp.y));
                    w.z = cvt_pk_bf16(sigmoid_f(v1[0]) * bflo(pp.z), sigmoid_f(v1[1]) * bfhi(pp.z)); w.w = cvt_pk_bf16(sigmoid_f(v1[2]) * bflo(pp.w), sigmoid_f(v1[3]) * bfhi(pp.w));
                    *(u32x4*)(rowp + bj * HALF) = w; } }
    } };
struct EpiSwiglu { static constexpr bool PERM = true; bf16_t* O; int ldc; const float* rs; int grouped;
    DEVI void pre(LAS unsigned char* esl, const Unit& u, int wr, int lane) const {
        const float* rsb = grouped ? rs + u.e * MT + u.mbase : rs + u.row0; const int vm1 = (grouped ? u.mvalid : BM) - 1;
#pragma unroll
        for (int i = 0; i < 2; ++i) { const int rl = wr * 64 + lane + i * HALF; epi_dma(rsb + (rl <= vm1 ? rl : vm1), esl + i * 256); } }
    DEVI void operator()(const f32x4 (&acc)[2][2][4][2], const Unit& u, int wr, int wc, int fr, int fq, const LAS unsigned char* esl) const {
        float pv[8];
#pragma unroll
        for (int q = 0; q < 8; ++q) pv[q] = ((const LAS float*)esl)[(q >> 2) * 64 + (q & 3) * 16 + fr];
        const int row0 = u.row0 + wr * 64 + fr, col0 = u.pn * HALF + wc * 32 + 8 * fq; const int vm1e = (grouped ? u.mvalid : BM) - 1;
#pragma unroll
        for (int ai = 0; ai < 2; ++ai)
#pragma unroll
            for (int m = 0; m < 4; ++m) { const int rl = wr * 64 + fr + ai * HALF + m * 16; bf16_t* rowp = O + (size_t)(u.row0 + rl) * ldc + col0;
                const float sc = rl <= vm1e ? pv[ai * 4 + m] : 0.f;
                const f32x4 g0 = acc[ai][0][m][0] * sc, g1 = acc[ai][0][m][1] * sc, u0 = acc[ai][1][m][0] * sc, u1 = acc[ai][1][m][1] * sc;
                u32x4 w; w.x = cvt_pk_bf16(silu_f(g0[0]) * u0[0], silu_f(g0[1]) * u0[1]); w.y = cvt_pk_bf16(silu_f(g0[2]) * u0[2], silu_f(g0[3]) * u0[3]);
                w.z = cvt_pk_bf16(silu_f(g1[0]) * u1[0], silu_f(g1[1]) * u1[1]); w.w = cvt_pk_bf16(silu_f(g1[2]) * u1[2], silu_f(g1[3]) * u1[3]);
                *(u32x4*)rowp = w; }
    } };
constexpr float W8_SCALE = 64.f, ACT8_SCALE = 8.f;
struct EpiSwiglu8 { static constexpr bool PERM = true; unsigned char* O; int ldc; const float* rs;
    DEVI void pre(LAS unsigned char* esl, const Unit& u, int wr, int lane) const {
        const float* rsb = rs + u.e * MT + u.mbase; const int vm1 = u.mvalid - 1;
#pragma unroll
        for (int i = 0; i < 2; ++i) { const int rl = wr * 64 + lane + i * HALF; epi_dma(rsb + (rl <= vm1 ? rl : vm1), esl + i * 256); } }
    DEVI void operator()(const f32x4 (&acc)[2][2][4][2], const Unit& u, int wr, int wc, int fr, int fq, const LAS unsigned char* esl) const {
        float pv[8];
#pragma unroll
        for (int q = 0; q < 8; ++q) pv[q] = ((const LAS float*)esl)[(q >> 2) * 64 + (q & 3) * 16 + fr];
        const int col0 = u.pn * HALF + wc * 32 + 8 * fq;
#pragma unroll
        for (int ai = 0; ai < 2; ++ai)
#pragma unroll
            for (int m = 0; m < 4; ++m) { const int rl = wr * 64 + fr + ai * HALF + m * 16; unsigned char* rowp = O + (size_t)(u.row0 + rl) * ldc + col0;
                const float sc = rl < u.mvalid ? pv[ai * 4 + m] * (1.f / W8_SCALE) : 0.f;
                const f32x4 g0 = acc[ai][0][m][0] * sc, g1 = acc[ai][0][m][1] * sc, u0 = acc[ai][1][m][0] * (sc * ACT8_SCALE), u1 = acc[ai][1][m][1] * (sc * ACT8_SCALE);
                u32x2 w; w.x = pg8_pk4(silu_f(g0[0]) * u0[0], silu_f(g0[1]) * u0[1], silu_f(g0[2]) * u0[2], silu_f(g0[3]) * u0[3]);
                w.y = pg8_pk4(silu_f(g1[0]) * u1[0], silu_f(g1[1]) * u1[1], silu_f(g1[2]) * u1[2], silu_f(g1[3]) * u1[3]);
                *(u32x2*)rowp = w; }
    } };
struct EpiMoeDown { static constexpr bool PERM = true; bf16_t* Y; const int* list; const float* gatev; float oscale;
    DEVI void pre(LAS unsigned char* esl, const Unit& u, int wr, int lane) const {
        const int* lb = list + u.e * MT + u.mbase; const float* gb = gatev + u.e * MT + u.mbase; const int vm1 = u.mvalid - 1;
#pragma unroll
        for (int i = 0; i < 2; ++i) { const int rl = wr * 64 + lane + i * HALF; const int ri = rl <= vm1 ? rl : vm1; epi_dma(gb + ri, esl + i * 256); epi_dma(lb + ri, esl + 512 + i * 256); } }
    DEVI void operator()(const f32x4 (&acc)[2][2][4][2], const Unit& u, int wr, int wc, int fr, int fq, const LAS unsigned char* esl) const {
        float pv[8]; int pt[8];
#pragma unroll
        for (int q = 0; q < 8; ++q) { pv[q] = ((const LAS float*)esl)[(q >> 2) * 64 + (q & 3) * 16 + fr]; pt[q] = ((const LAS int*)(esl + 512))[(q >> 2) * 64 + (q & 3) * 16 + fr]; }
        const int col0 = u.pn * BM + wc * 32 + 8 * fq;
        const int mbase = u.mbase;
#pragma unroll
        for (int ai = 0; ai < 2; ++ai)
#pragma unroll
            for (int m = 0; m < 4; ++m) { const int rl = wr * 64 + fr + ai * HALF + m * 16;
                const int tsl = pt[ai * 4 + m]; const float gt = pv[ai * 4 + m] * oscale;
                if (rl < u.mvalid) {
                    bf16_t* rowp = Y + (size_t)(tsl & 1) * ((size_t)MT * DM) + (size_t)(tsl >> 1) * DM + col0;
#pragma unroll
                    for (int bj = 0; bj < 2; ++bj) { const f32x4 v0 = acc[ai][bj][m][0], v1 = acc[ai][bj][m][1];
                        u32x4 w; w.x = cvt_pk_bf16(v0[0] * gt, v0[1] * gt); w.y = cvt_pk_bf16(v0[2] * gt, v0[3] * gt); w.z = cvt_pk_bf16(v1[0] * gt, v1[1] * gt); w.w = cvt_pk_bf16(v1[2] * gt, v1[3] * gt);
                        *(u32x4*)(rowp + bj * HALF) = w; } } }
    } };

typedef int v8i __attribute__((ext_vector_type(8)));
typedef int v4i __attribute__((ext_vector_type(4)));
DEVI v8i cat8(const bf16x8 lo, const bf16x8 hi) { const v4i a = __builtin_bit_cast(v4i, lo), b = __builtin_bit_cast(v4i, hi); return __builtin_shufflevector(a, b, 0, 1, 2, 3, 4, 5, 6, 7); }
struct Frag16 { bf16x8 k[2]; };
struct Frag8 { v8i v; };
template <bool F> struct FragSel { typedef Frag16 T; };
template <> struct FragSel<true> { typedef Frag8 T; };
template <class Epi, class Sched, bool FP8 = false>
DEVI void gemm_phase(LAS unsigned char* lds, const bf16_t* A, const int K, const Sched& S, const Epi& E) {
    const int tid = opq((int)threadIdx.x), wid = __builtin_amdgcn_readfirstlane(tid >> 6), lane = tid & 63, wr = wid >> 2, wc = wid & 3, fr = lane & 15, fq = lane >> 4;
    const int nt = K / BK;
    unsigned voffA[2], voffB[2];
#pragma unroll
    for (int i = 0; i < 2; ++i) { int R, C; stage_rc(tid * 16 + i * 8192, R, C); const int Rb = Epi::PERM ? ((R & ~31) + perm32(R & 31)) : R;
        voffA[i] = (unsigned)(R * K + C) * 2u; voffB[i] = (unsigned)(Rb * K + C) * 2u; }
    const size_t kstep = (size_t)(BK * 2);
    const size_t hstep = (size_t)HALF * K * 2;
    const size_t rstep = (size_t)K * 2;
    const unsigned ldsw = (unsigned)wid * 1024u;
    const int aoff = lds_byte(wr * 64 + fr, fq * 8), boff = lds_byte(wc * 32 + fr, fq * 8);
#define PG8_SA(b, h) (((b) * 2 + (h)) * HTB)
#define PG8_SB(b, h) ((4 + (b) * 2 + (h)) * HTB)
#define PG8_STAGE(bufoff, gbase, voff) do { _Pragma("unroll") for (int _i = 0; _i < 2; ++_i) \
        __builtin_amdgcn_global_load_lds((const unsigned*)((const char*)(gbase) + (voff)[_i]), (LAS unsigned*)(lds + (bufoff) + ldsw + _i * 8192), 16, 0, 0); } while (0)
#define PG8_LDA(dst, b, h) do { _Pragma("unroll") for (int m = 0; m < 4; ++m) { if constexpr (FP8) dst[m].v = cat8(*(const LAS bf16x8*)(lds + PG8_SA(b, h) + aoff + m * 2048), *(const LAS bf16x8*)(lds + PG8_SA(b, h) + aoff + m * 2048 + 1024)); \
        else { _Pragma("unroll") for (int k = 0; k < 2; ++k) dst[m].k[k] = *(const LAS bf16x8*)(lds + PG8_SA(b, h) + aoff + m * 2048 + k * 1024); } } } while (0)
#define PG8_LDB(dst, b, h) do { _Pragma("unroll") for (int n = 0; n < 2; ++n) { if constexpr (FP8) dst[n].v = cat8(*(const LAS bf16x8*)(lds + PG8_SB(b, h) + boff + n * 2048), *(const LAS bf16x8*)(lds + PG8_SB(b, h) + boff + n * 2048 + 1024)); \
        else { _Pragma("unroll") for (int k = 0; k < 2; ++k) dst[n].k[k] = *(const LAS bf16x8*)(lds + PG8_SB(b, h) + boff + n * 2048 + k * 1024); } } } while (0)
#define PG8_MMA(ai, bj, At, Bt) do { __builtin_amdgcn_s_setprio(1); _Pragma("unroll") for (int m = 0; m < 4; ++m) _Pragma("unroll") for (int n = 0; n < 2; ++n) { \
        if constexpr (FP8) asm volatile("s_nop 1\n\tv_mfma_scale_f32_16x16x128_f8f6f4 %0, %1, %2, %0, %3, %3 op_sel_hi:[0,0,0]" : "+v"(acc[ai][bj][m][n]) : "v"(Bt[n].v), "v"(At[m].v), "v"(sc1)); \
        else { _Pragma("unroll") for (int k = 0; k < 2; ++k) acc[ai][bj][m][n] = __builtin_amdgcn_mfma_f32_16x16x32_bf16(Bt[n].k[k], At[m].k[k], acc[ai][bj][m][n], 0, 0, 0); } } \
        __builtin_amdgcn_s_setprio(0); } while (0)
#define PG8_WAIT_V(n) asm volatile("s_waitcnt vmcnt(" #n ")" ::: "memory")
#define PG8_WAIT_L(n) asm volatile("s_waitcnt lgkmcnt(" #n ")" ::: "memory")
#define PG8_BAR __builtin_amdgcn_s_barrier()
#define PG8_SCHED __builtin_amdgcn_sched_barrier(0)
    Unit cur, nxt; int ui = 0;
    if (!S.next(0, cur)) return;
    int sc1 = 0x7F7F7F7F; asm volatile("" : "+v"(sc1));
    f32x4 acc[2][2][4][2];
#pragma unroll
    for (int a = 0; a < 2; ++a)
#pragma unroll
        for (int b = 0; b < 2; ++b)
#pragma unroll
            for (int m = 0; m < 4; ++m)
#pragma unroll
                for (int n = 0; n < 2; ++n) acc[a][b][m][n] = (f32x4){0.f, 0.f, 0.f, 0.f};
    typename FragSel<FP8>::T At[4], B0[2], B1[2];
    const char* cA = (const char*)A + (size_t)cur.arow0 * rstep;
    const char* cB = cur.B;
    LAS unsigned char* const esl = lds + EPI_OFF + wid * EPI_SLICE;
    E.pre(esl, cur, wr, lane);
    PG8_STAGE(PG8_SB(0, 0), cB, voffB); PG8_STAGE(PG8_SA(0, 0), cA, voffA); PG8_STAGE(PG8_SB(0, 1), cB + hstep, voffB); PG8_STAGE(PG8_SA(0, 1), cA + hstep, voffA);
    if (wr == 1) PG8_BAR;
    PG8_WAIT_V(4); PG8_BAR;
    PG8_STAGE(PG8_SB(1, 0), cB + kstep, voffB); PG8_STAGE(PG8_SA(1, 0), cA + kstep, voffA); PG8_STAGE(PG8_SB(1, 1), cB + hstep + kstep, voffB);
    PG8_WAIT_V(6); PG8_BAR;
    for (;;) {
        const bool has_next = S.next(ui + 1, nxt);
        const char* nA = has_next ? (const char*)A + (size_t)nxt.arow0 * rstep : cA; const char* nB = has_next ? nxt.B : cB;
#pragma unroll 1
        for (int t = 0; t < nt; t += 2) {
            const bool last = (t == nt - 2);
            const char* a1 = cA + (size_t)(t + 1) * kstep;
            const char* a2 = last ? nA : cA + (size_t)(t + 2) * kstep; const char* b2 = last ? nB : cB + (size_t)(t + 2) * kstep;
            const char* a3 = a2 + kstep; const char* b3 = b2 + kstep;
            PG8_LDB(B0, 0, 0); PG8_SCHED; PG8_LDA(At, 0, 0); PG8_STAGE(PG8_SA(1, 1), a1 + hstep, voffA);
            PG8_WAIT_L(8); PG8_BAR; PG8_WAIT_L(0); PG8_MMA(0, 0, At, B0); PG8_BAR; PG8_SCHED;
            PG8_LDB(B1, 0, 1); PG8_STAGE(PG8_SB(0, 0), b2, voffB);
            PG8_BAR; PG8_WAIT_L(0); PG8_MMA(0, 1, At, B1); PG8_BAR;
            PG8_LDA(At, 0, 1); PG8_STAGE(PG8_SA(0, 0), a2, voffA);
            PG8_BAR; PG8_WAIT_L(0); PG8_MMA(1, 0, At, B0); PG8_BAR; PG8_SCHED;
            PG8_STAGE(PG8_SB(0, 1), b2 + hstep, voffB);
            PG8_WAIT_V(6); PG8_BAR; PG8_MMA(1, 1, At, B1); PG8_BAR;
            PG8_LDB(B0, 1, 0); PG8_SCHED; PG8_LDA(At, 1, 0); PG8_STAGE(PG8_SA(0, 1), a2 + hstep, voffA);
            PG8_WAIT_L(8); PG8_BAR; PG8_WAIT_L(0); PG8_MMA(0, 0, At, B0); PG8_BAR; PG8_SCHED;
            PG8_LDB(B1, 1, 1); PG8_STAGE(PG8_SB(1, 0), b3, voffB);
            PG8_BAR; PG8_WAIT_L(0); PG8_MMA(0, 1, At, B1); PG8_BAR;
            PG8_LDA(At, 1, 1); PG8_STAGE(PG8_SA(1, 0), a3, voffA);
            PG8_BAR; PG8_WAIT_L(0); PG8_MMA(1, 0, At, B0); PG8_BAR; PG8_SCHED;
            PG8_STAGE(PG8_SB(1, 1), b3 + hstep, voffB);
            PG8_WAIT_V(6); PG8_BAR; PG8_MMA(1, 1, At, B1); PG8_BAR;
        }
        if constexpr (FP8) asm volatile("s_nop 15\n\ts_nop 15" ::: "memory");
        E(acc, cur, wr, wc, fr, fq, esl);
        if (!has_next) break;
#pragma unroll
        for (int a = 0; a < 2; ++a)
#pragma unroll
            for (int b = 0; b < 2; ++b)
#pragma unroll
                for (int m = 0; m < 4; ++m)
#pragma unroll
                    for (int n = 0; n < 2; ++n) acc[a][b][m][n] = (f32x4){0.f, 0.f, 0.f, 0.f};
        cur = nxt; cA = nA; cB = nB; ++ui;
        E.pre(esl, cur, wr, lane);
        if constexpr (FP8) asm volatile("s_nop 7" ::: "memory");
    }
    PG8_WAIT_V(0);
    if (wr == 0) PG8_BAR;
    PG8_BAR;
#undef PG8_SA
#undef PG8_SB
#undef PG8_STAGE
#undef PG8_LDA
#undef PG8_LDB
#undef PG8_MMA
#undef PG8_WAIT_V
#undef PG8_WAIT_L
#undef PG8_BAR
#undef PG8_SCHED
}
}

DEVI float lb_of(const float* lbraw, int ch) {
    const float r0 = lbraw[ch], r1 = lbraw[512 + ch], r2 = lbraw[1024 + ch];
    const float mx = fmaxf(r0, fmaxf(r1, r2));
    const float e0 = __expf(r0 - mx), e1 = __expf(r1 - mx), e2 = __expf(r2 - mx);
    return e0 / (e0 + e1 + e2);
}
constexpr int HQ = 0, HK = 17408, HKH = 34816, HV = 53248, HDV = 71680, HZERO = 73728, HOT = 75776, H_END = HOT + 64 * 528;
static_assert(H_END <= 131072, "hgrn lds");
constexpr size_t HS_SCAN = (size_t)16 * 16384;
struct HgrnRaw { unsigned qf[16]; u32x4 v0, v1; };
DEVI void hgrn_load(HgrnRaw& R, const bf16_t* u, const bf16_t* VT, int dir, int b, int h, int t0, int c, int I, int tid) {
    const bf16_t* up = u + ((size_t)b * SEQ + t0 + 16 * I) * UW + h * 128 + c;
    const int fcol = dir ? 1024 : 512;
#pragma unroll
    for (int j = 0; j < 16; ++j) R.qf[j] = (unsigned)up[(size_t)j * UW] | ((unsigned)up[(size_t)j * UW + fcol] << 16);
    { const int e = tid, r = e >> 3, cch = e & 7; R.v0 = *(const u32x4*)(VT + ((size_t)b * 512 + h * 128 + r) * SEQ + t0 + cch * 8); }
    { const int e = tid + NTHR, r = e >> 3, cch = e & 7; R.v1 = *(const u32x4*)(VT + ((size_t)b * 512 + h * 128 + r) * SEQ + t0 + cch * 8); }
}
DEVI void hgrn_prep(LAS unsigned char* lds, const HgrnRaw& R, float lbv, int dir, int c, int I, int tid) {
    float ff[16], kk[16], qq[16];
    { const int e = tid, r = e >> 3, cch = e & 7; *(LAS u32x4*)(lds + HV + r * 144 + cch * 16) = R.v0; }
    { const int e = tid + NTHR, r = e >> 3, cch = e & 7; *(LAS u32x4*)(lds + HV + r * 144 + cch * 16) = R.v1; }
#pragma unroll
    for (int j = 0; j < 16; ++j) {
        const float fr = bfhi(R.qf[j]), qr = bflo(R.qf[j]);
        const float f = lbv + (1.f - lbv) * sigmoid_f(fr);
        ff[j] = f; kk[j] = 1.f - f; qq[j] = silu_f(qr);
    }
    float run = 1.f;
#pragma unroll
    for (int jj = 0; jj < 16; ++jj) { const int j = dir ? 15 - jj : jj; run = fmaxf(run * ff[j], 1e-30f); ff[j] = run; }
    const float PG = run;
    float kh[16];
#pragma unroll
    for (int j = 0; j < 16; ++j) {
        const float kt = kk[j] * __builtin_amdgcn_rcpf(ff[j]);
        kh[j] = kt * PG;
        *(LAS bf16_t*)(lds + HQ + (16 * I + j) * 272 + c * 2) = f2bf(qq[j] * ff[j]);
        *(LAS bf16_t*)(lds + HK + (16 * I + j) * 272 + c * 2) = f2bf(kt);
    }
    u32x4 w0, w1;
    w0.x = pk2(kh[0], kh[1]); w0.y = pk2(kh[2], kh[3]); w0.z = pk2(kh[4], kh[5]); w0.w = pk2(kh[6], kh[7]);
    w1.x = pk2(kh[8], kh[9]); w1.y = pk2(kh[10], kh[11]); w1.z = pk2(kh[12], kh[13]); w1.w = pk2(kh[14], kh[15]);
    *(LAS u32x4*)(lds + HKH + c * 144 + I * 32) = w0; *(LAS u32x4*)(lds + HKH + c * 144 + I * 32 + 16) = w1;
    *(LAS float*)(lds + HDV + (I * 128 + c) * 4) = PG;
}
DEVI void hgrn_update(LAS unsigned char* lds, f32x4 (&Sacc)[8], int I, int wid, int fr, int fq) {
    const int voff = (fq < 2) ? HV + (16 * wid + fr) * 144 + (16 * I + 8 * fq) * 2 : HZERO;
    const int koff = (fq < 2) ? HKH + fr * 144 + (16 * I + 8 * fq) * 2 : HZERO;
    const int kstep = (fq < 2) ? 16 * 144 : 0;
    const bf16x8 vb = *(const LAS bf16x8*)(lds + voff);
    bf16x8 ka[8]; f32x4 dv[8];
#pragma unroll
    for (int m = 0; m < 8; ++m) { ka[m] = *(const LAS bf16x8*)(lds + koff + m * kstep); dv[m] = *(const LAS f32x4*)(lds + HDV + (I * 128 + 16 * m + 4 * fq) * 4); }
#pragma unroll
    for (int m = 0; m < 8; ++m) Sacc[m] = __builtin_amdgcn_mfma_f32_16x16x32_bf16(ka[m], vb, Sacc[m] * dv[m], 0, 0, 0);
}
DEVI void ph_hgrn_states(LAS unsigned char* lds, const bf16_t* u, const bf16_t* VT, const float* lbraw, bf16_t* HS, float* HD, int vb0, int vbs) {
    const int tid = opq((int)threadIdx.x), wid = __builtin_amdgcn_readfirstlane(tid >> 6), lane = tid & 63, fr = lane & 15, fq = lane >> 4;
    const int pc = tid & 127, pI = tid >> 7;
    for (int unit = vb0; unit < NB * 4 * 2 * 16; unit += vbs) {
        const int seg = unit & 15, dir = (unit >> 4) & 1, h = (unit >> 5) & 3, b = unit >> 7;
        const float lbv = lb_of(lbraw, h * 128 + pc);
        f32x4 Sacc[8];
#pragma unroll
        for (int m = 0; m < 8; ++m) Sacc[m] = (f32x4){0.f, 0.f, 0.f, 0.f};
        float gprod = 1.f;
        if (tid < 4) *(LAS unsigned*)(lds + HZERO + tid * 4) = 0u;
        HgrnRaw R; hgrn_load(R, u, VT, dir, b, h, seg * 256 + (dir ? 3 : 0) * 64, pc, pI, tid);
#pragma unroll 1
        for (int sbi = 0; sbi < 4; ++sbi) {
            const int sb = dir ? 3 - sbi : sbi;
            const int t0 = seg * 256 + sb * 64;
            __syncthreads();
            hgrn_prep(lds, R, lbv, dir, pc, pI, tid);
            if (sbi < 3) { const int sbn = dir ? 3 - (sbi + 1) : sbi + 1; hgrn_load(R, u, VT, dir, b, h, seg * 256 + sbn * 64, pc, pI, tid); }
            __syncthreads();
            if (tid < 128) gprod *= (*(const LAS float*)(lds + HDV + tid * 4) * *(const LAS float*)(lds + HDV + (128 + tid) * 4)) * (*(const LAS float*)(lds + HDV + (256 + tid) * 4) * *(const LAS float*)(lds + HDV + (384 + tid) * 4));
#pragma unroll 1
            for (int ii = 0; ii < 4; ++ii) { const int I = dir ? 3 - ii : ii; hgrn_update(lds, Sacc, I, wid, fr, fq); }
        }
        const size_t scan = (size_t)(b * 4 + h) * 2 + dir;
        bf16_t* dst = HS + scan * HS_SCAN + (size_t)seg * 16384;
#pragma unroll
        for (int m = 0; m < 8; ++m) { u32x2 w; w.x = pk2(Sacc[m][0], Sacc[m][1]); w.y = pk2(Sacc[m][2], Sacc[m][3]);
            *(u32x2*)(dst + (16 * wid + fr) * 128 + 16 * m + 4 * fq) = w; }
        if (tid < 128) HD[(scan * 16 + seg) * 128 + tid] = gprod;
    }
    __syncthreads();
}
DEVI void ph_hgrn_scan(bf16_t* HS, const float* HD, int vb0, int vbs) {
    const int tid = opq((int)threadIdx.x);
    for (int idx = vb0 * NTHR + tid; idx < 32 * 4096; idx += vbs * NTHR) {
        const int scan = idx >> 12, e4 = idx & 4095, k4 = (e4 & 31) * 4; const int dir = scan & 1;
        u32x2* base = (u32x2*)(HS + (size_t)scan * HS_SCAN) + e4;
        const float* hd = HD + (size_t)scan * 16 * 128 + k4;
        u32x2 d[16]; float4 dec[16];
#pragma unroll
        for (int i = 0; i < 16; ++i) { d[i] = base[(size_t)i * 4096]; dec[i] = *(const float4*)(hd + i * 128); }
        float s0 = 0.f, s1 = 0.f, s2 = 0.f, s3 = 0.f;
#define HSCAN_STEP(i) { const float t0 = bflo(d[i].x), t1 = bfhi(d[i].x), t2 = bflo(d[i].y), t3 = bfhi(d[i].y); d[i].x = pk2(s0, s1); d[i].y = pk2(s2, s3); \
            s0 = s0 * dec[i].x + t0; s1 = s1 * dec[i].y + t1; s2 = s2 * dec[i].z + t2; s3 = s3 * dec[i].w + t3; }
        if (dir == 0) {
#pragma unroll
            for (int i = 0; i < 16; ++i) HSCAN_STEP(i)
        } else {
#pragma unroll
            for (int i = 15; i >= 0; --i) HSCAN_STEP(i)
        }
#undef HSCAN_STEP
#pragma unroll
        for (int i = 0; i < 16; ++i) base[(size_t)i * 4096] = d[i];
    }
}
DEVI void ph_hgrn_out(LAS unsigned char* lds, const bf16_t* u, const bf16_t* VT, const float* lbraw, const float* a_norm, const bf16_t* HS, float* OF, bf16_t* ocat, int vb0, int vbs) {
    const int tid = opq((int)threadIdx.x), wid = __builtin_amdgcn_readfirstlane(tid >> 6), lane = tid & 63, fr = lane & 15, fq = lane >> 4;
    const int pc = tid & 127, pI = tid >> 7;
    const int otok = tid >> 3, opart = tid & 7;
    for (int unit = vb0; unit < NB * 4 * 16; unit += vbs) {
        const int seg = unit & 15, h = (unit >> 4) & 3, b = unit >> 6;
        const float lbv = lb_of(lbraw, h * 128 + pc);
        if (tid < 4) *(LAS unsigned*)(lds + HZERO + tid * 4) = 0u;
#pragma unroll 1
        for (int dir = 0; dir < 2; ++dir) {
            const size_t scan = (size_t)(b * 4 + h) * 2 + dir;
            const bf16_t* src = HS + scan * HS_SCAN + (size_t)seg * 16384;
            f32x4 Sacc[8];
#pragma unroll
            for (int m = 0; m < 8; ++m) { const u32x2 w = *(const u32x2*)(src + (16 * wid + fr) * 128 + 16 * m + 4 * fq);
                Sacc[m][0] = bflo(w.x); Sacc[m][1] = bfhi(w.x); Sacc[m][2] = bflo(w.y); Sacc[m][3] = bfhi(w.y); }
            HgrnRaw R; hgrn_load(R, u, VT, dir, b, h, seg * 256 + (dir ? 3 : 0) * 64, pc, pI, tid);
#pragma unroll 1
            for (int sbi = 0; sbi < 4; ++sbi) {
                const int sb = dir ? 3 - sbi : sbi;
                const int t0 = seg * 256 + sb * 64;
                const size_t tokb = (size_t)b * SEQ + t0;
                __syncthreads();
                hgrn_prep(lds, R, lbv, dir, pc, pI, tid);
                if (sbi < 3) { const int sbn = dir ? 3 - (sbi + 1) : sbi + 1; hgrn_load(R, u, VT, dir, b, h, seg * 256 + sbn * 64, pc, pI, tid); }
                __syncthreads();
#pragma unroll 1
                for (int ii = 0; ii < 4; ++ii) {
                    const int I = dir ? 3 - ii : ii;
                    f32x4 oT = {0.f, 0.f, 0.f, 0.f};
                    const LAS unsigned char* qrow = lds + HQ + (16 * I + fr) * 272;
#pragma unroll
                    for (int ks = 0; ks < 4; ++ks) {
                        u32x4 sa; sa.x = pg8::cvt_pk_bf16(Sacc[2 * ks][0], Sacc[2 * ks][1]); sa.y = pg8::cvt_pk_bf16(Sacc[2 * ks][2], Sacc[2 * ks][3]);
                        sa.z = pg8::cvt_pk_bf16(Sacc[2 * ks + 1][0], Sacc[2 * ks + 1][1]); sa.w = pg8::cvt_pk_bf16(Sacc[2 * ks + 1][2], Sacc[2 * ks + 1][3]);
                        const u32x2 q0 = *(const LAS u32x2*)(qrow + (32 * ks + 4 * fq) * 2), q1 = *(const LAS u32x2*)(qrow + (32 * ks + 16 + 4 * fq) * 2);
                        u32x4 qb; qb.x = q0.x; qb.y = q0.y; qb.z = q1.x; qb.w = q1.y;
                        oT = __builtin_amdgcn_mfma_f32_16x16x32_bf16(__builtin_bit_cast(bf16x8, sa), __builtin_bit_cast(bf16x8, qb), oT, 0, 0, 0);
                    }
                    f32x4 sT = {0.f, 0.f, 0.f, 0.f};
                    const LAS unsigned char* krow = lds + HK + (16 * I + fr) * 272;
#pragma unroll
                    for (int ks = 0; ks < 4; ++ks) {
                        const bf16x8 ka = *(const LAS bf16x8*)(krow + (32 * ks + 8 * fq) * 2), qb = *(const LAS bf16x8*)(qrow + (32 * ks + 8 * fq) * 2);
                        sT = __builtin_amdgcn_mfma_f32_16x16x32_bf16(ka, qb, sT, 0, 0, 0);
                    }
                    float pv[4];
#pragma unroll
                    for (int rg = 0; rg < 4; ++rg) { const int sl = 4 * fq + rg; const bool ok = dir ? (sl >= fr) : (sl <= fr); pv[rg] = ok ? sT[rg] : 0.f; }
                    u32x4 pb; pb.x = pg8::cvt_pk_bf16(pv[0], pv[1]); pb.y = pg8::cvt_pk_bf16(pv[2], pv[3]); pb.z = 0u; pb.w = 0u;
                    const u32x2 v0 = *(const LAS u32x2*)(lds + HV + (16 * wid + fr) * 144 + (16 * I + 4 * fq) * 2);
                    u32x4 va; va.x = v0.x; va.y = v0.y; va.z = 0u; va.w = 0u;
                    oT = __builtin_amdgcn_mfma_f32_16x16x32_bf16(__builtin_bit_cast(bf16x8, va), __builtin_bit_cast(bf16x8, pb), oT, 0, 0, 0);
                    if (dir == 0) *(f32x4*)(OF + (tokb + 16 * I + fr) * 512 + h * 128 + 16 * wid + 4 * fq) = oT;
                    else *(LAS f32x4*)(lds + HOT + (16 * I + fr) * 528 + (16 * wid + 4 * fq) * 4) = oT;
                    hgrn_update(lds, Sacc, I, wid, fr, fq);
                }
                if (dir == 1) {
                    __syncthreads();
                    const LAS float* orow = (const LAS float*)(lds + HOT + otok * 528) + opart * 16;
                    float* ofp = OF + (tokb + otok) * 512 + h * 128 + opart * 16;
                    float v[16]; float ss = 0.f;
#pragma unroll
                    for (int q2 = 0; q2 < 8; ++q2) { const unsigned long long w = __hip_atomic_load((unsigned long long*)(ofp + q2 * 2), __ATOMIC_RELAXED, __HIP_MEMORY_SCOPE_AGENT);
                        v[2 * q2] = __uint_as_float((unsigned)w) + orow[2 * q2]; v[2 * q2 + 1] = __uint_as_float((unsigned)(w >> 32)) + orow[2 * q2 + 1];
                        ss += v[2 * q2] * v[2 * q2] + v[2 * q2 + 1] * v[2 * q2 + 1]; }
                    ss += __shfl_xor(ss, 1); ss += __shfl_xor(ss, 2); ss += __shfl_xor(ss, 4);
                    const float rn = rsqrtf(ss * (1.f / 128.f) + EPS);
                    const bf16_t* gp = u + (tokb + otok) * UW + 2048 + h * 128 + opart * 16;
                    const u32x4 g0 = *(const u32x4*)gp, g1 = *(const u32x4*)(gp + 8);
                    const unsigned gw[8] = {g0.x, g0.y, g0.z, g0.w, g1.x, g1.y, g1.z, g1.w};
                    unsigned ow[8];
#pragma unroll
                    for (int q2 = 0; q2 < 8; ++q2) { const float an0 = a_norm[opart * 16 + 2 * q2], an1 = a_norm[opart * 16 + 2 * q2 + 1];
                        ow[q2] = pk2(v[2 * q2] * rn * an0 * silu_f(bflo(gw[q2])), v[2 * q2 + 1] * rn * an1 * silu_f(bfhi(gw[q2]))); }
                    bf16_t* op = ocat + (tokb + otok) * DM + h * 128 + opart * 16;
                    u32x4 o0, o1; o0.x = ow[0]; o0.y = ow[1]; o0.z = ow[2]; o0.w = ow[3]; o1.x = ow[4]; o1.y = ow[5]; o1.z = ow[6]; o1.w = ow[7];
                    *(u32x4*)op = o0; *(u32x4*)(op + 8) = o1;
                }
            }
            asm volatile("s_waitcnt vmcnt(0)" ::: "memory");
        }
    }
    __syncthreads();
}

DEVI void ph_prep(const bf16_t* u, const float* cw, const float* cb, bf16_t* xconv, bf16_t* XT, bf16_t* VT, int vb0, int vbs) {
    const int tid = opq((int)threadIdx.x);
    for (int unit = vb0; unit < NB * 32 * 3; unit += vbs) {
        const int cg = unit % 3, tb = (unit / 3) & 31, b = unit / 96;
        const int t0 = tb * 128;
        if (cg < 2) {
            const int ch = cg * 512 + tid;
            float w[5];
#pragma unroll
            for (int j = 0; j < 5; ++j) w[j] = cw[j * 1024 + ch];
            const float bias = cb[ch];
            const bf16_t* up = u + (size_t)b * SEQ * UW + 3072 + ch;
            float v0, v1, v2, v3;
            v0 = (t0 - 2 >= 0) ? bf2f(up[(size_t)(t0 - 2) * UW]) : 0.f;
            v1 = (t0 - 1 >= 0) ? bf2f(up[(size_t)(t0 - 1) * UW]) : 0.f;
            v2 = bf2f(up[(size_t)t0 * UW]);
            v3 = bf2f(up[(size_t)(t0 + 1) * UW]);
            for (int t8 = 0; t8 < 128; t8 += 32) {
                float nx[32];
#pragma unroll
                for (int i = 0; i < 32; ++i) { const int tt = t0 + t8 + i + 2; nx[i] = (tt < SEQ) ? bf2f(up[(size_t)tt * UW]) : 0.f; }
                unsigned pk[16];
#pragma unroll
                for (int i = 0; i < 32; ++i) {
                    const float o = silu_f(bias + w[0] * v0 + w[1] * v1 + w[2] * v2 + w[3] * v3 + w[4] * nx[i]);
                    const bf16_t ob = f2bf(o);
                    xconv[(size_t)(b * SEQ + t0 + t8 + i) * 1024 + ch] = ob;
                    if (i & 1) pk[i >> 1] |= ((unsigned)ob << 16); else pk[i >> 1] = ob;
                    v0 = v1; v1 = v2; v2 = v3; v3 = nx[i];
                }
                if (ch < 768) {
#pragma unroll
                    for (int q = 0; q < 4; ++q) { u32x4 o4; o4.x = pk[4 * q]; o4.y = pk[4 * q + 1]; o4.z = pk[4 * q + 2]; o4.w = pk[4 * q + 3]; *(u32x4*)(XT + ((size_t)b * 768 + ch) * SEQ + t0 + t8 + 8 * q) = o4; } }
            }
        } else {
            const int ch = tid;
            const bf16_t* up = u + (size_t)b * SEQ * UW + 1536 + ch;
            for (int t8 = 0; t8 < 128; t8 += 32) {
                unsigned pk[16];
#pragma unroll
                for (int i = 0; i < 32; ++i) { const unsigned ob = up[(size_t)(t0 + t8 + i) * UW]; if (i & 1) pk[i >> 1] |= (ob << 16); else pk[i >> 1] = ob; }
#pragma unroll
                for (int q = 0; q < 4; ++q) { u32x4 o4; o4.x = pk[4 * q]; o4.y = pk[4 * q + 1]; o4.z = pk[4 * q + 2]; o4.w = pk[4 * q + 3]; *(u32x4*)(VT + ((size_t)b * 512 + ch) * SEQ + t0 + t8 + 8 * q) = o4; }
            }
        }
    }
}

constexpr int MB_XT = 0, MB_BX = 256 * 272, MB_DT = MB_BX + 128 * 272, MB_CS = MB_DT + 8 * 128 * 4, MB_TOT = MB_CS + 8 * 128 * 4, MB_END = MB_TOT + 64;
static_assert(MB_END <= 131072, "mamba lds");
constexpr size_t MS_SCAN = (size_t)32 * 8192;
DEVI bf16x8 pack8(const float* v) { u32x4 w; w.x = pg8::cvt_pk_bf16(v[0], v[1]); w.y = pg8::cvt_pk_bf16(v[2], v[3]); w.z = pg8::cvt_pk_bf16(v[4], v[5]); w.w = pg8::cvt_pk_bf16(v[6], v[7]); return __builtin_bit_cast(bf16x8, w); }
DEVI void mamba_tables(LAS unsigned char* lds, const float* dtraw, const float* A_log, const float* dt_bias, int b, int g, int c, int wid, int lane) {
    LAS float* tdt = (LAS float*)(lds + MB_DT); LAS float* tcs = (LAS float*)(lds + MB_CS); LAS float* ttot = (LAS float*)(lds + MB_TOT);
    const int r = wid >> 1, dir = wid & 1, hd = 4 * g + r;
    const float A = -__expf(A_log[dir * 8 + hd]), bias = dt_bias[dir * 8 + hd];
    const size_t tk = (size_t)b * SEQ + c * 128 + 2 * lane;
    const float dt0 = softplus_f(dtraw[tk * 16 + dir * 8 + hd] + bias), dt1 = softplus_f(dtraw[(tk + 1) * 16 + dir * 8 + hd] + bias);
    const float a0 = dt0 * A, a1 = dt1 * A;
    float sc = a0 + a1;
#pragma unroll
    for (int off = 1; off < 64; off <<= 1) { const float v = __shfl_up(sc, off); if (lane >= off) sc += v; }
    const float total = __shfl(sc, 63);
    const float pre0 = sc - a1, pre1 = sc;
    const float c0 = dir ? (total - pre0 + a0) : pre0, c1 = dir ? (total - pre1 + a1) : pre1;
    tdt[wid * 128 + 2 * lane] = dt0; tdt[wid * 128 + 2 * lane + 1] = dt1;
    tcs[wid * 128 + 2 * lane] = c0; tcs[wid * 128 + 2 * lane + 1] = c1;
    if (lane == 0) ttot[wid] = total;
}
DEVI void stage_rows(LAS unsigned char* dst, const bf16_t* src, size_t src_stride, int rows, int tid) {
    for (int e = tid; e < rows * 16; e += NTHR) { const int r = e >> 4, cch = e & 15; *(LAS u32x4*)(dst + r * 272 + cch * 16) = *(const u32x4*)(src + (size_t)r * src_stride + cch * 8); }
}
DEVI void ph_mamba_states(LAS unsigned char* lds, const bf16_t* XT, const float* dtraw, const float* A_log, const float* dt_bias, bf16_t* MS, float* MD, int vb0, int vbs) {
    const int tid = opq((int)threadIdx.x), wid = __builtin_amdgcn_readfirstlane(tid >> 6), lane = tid & 63, fr = lane & 15, fq = lane >> 4;
    LAS float* tdt = (LAS float*)(lds + MB_DT); LAS float* tcs = (LAS float*)(lds + MB_CS); LAS float* ttot = (LAS float*)(lds + MB_TOT);
    for (int unit = vb0; unit < NB * 2 * 32; unit += vbs) {
        const int c = unit & 31, g = (unit >> 5) & 1, b = unit >> 6;
        __syncthreads();
        stage_rows(lds + MB_XT, XT + ((size_t)b * 768 + g * 256) * SEQ + c * 128, SEQ, 256, tid);
        stage_rows(lds + MB_BX, XT + ((size_t)b * 768 + 512 + g * 128) * SEQ + c * 128, SEQ, 128, tid);
        mamba_tables(lds, dtraw, A_log, dt_bias, b, g, c, wid, lane);
        __syncthreads();
        if (lane == 0) MD[((size_t)(b * 8 + 4 * g + (wid >> 1)) * 2 + (wid & 1)) * 32 + c] = __expf(ttot[wid]);
        for (int hdd = 0; hdd < 8; ++hdd) {
            const int r = hdd >> 1, dir = hdd & 1, hd = 4 * g + r;
            const float tot = ttot[hdd];
            f32x4 acc[4];
#pragma unroll
            for (int pt = 0; pt < 4; ++pt) acc[pt] = (f32x4){0.f, 0.f, 0.f, 0.f};
#pragma unroll
            for (int ks = 0; ks < 4; ++ks) {
                const int s0 = 32 * ks + 8 * fq;
                const u32x4 braw = *(const LAS u32x4*)(lds + MB_BX + (16 * wid + fr) * 272 + s0 * 2);
                float bw[8];
                const unsigned bu[4] = {braw.x, braw.y, braw.z, braw.w};
#pragma unroll
                for (int j = 0; j < 8; ++j) { const float bv = (j & 1) ? bfhi(bu[j >> 1]) : bflo(bu[j >> 1]);
                    bw[j] = bv * tdt[hdd * 128 + s0 + j] * __expf(tot - tcs[hdd * 128 + s0 + j]); }
                const bf16x8 Bf = pack8(bw);
#pragma unroll
                for (int pt = 0; pt < 4; ++pt) {
                    const bf16x8 Af = *(const LAS bf16x8*)(lds + MB_XT + (r * 64 + 16 * pt + fr) * 272 + s0 * 2);
                    acc[pt] = __builtin_amdgcn_mfma_f32_16x16x32_bf16(Bf, Af, acc[pt], 0, 0, 0);
                }
            }
            bf16_t* dst = MS + ((size_t)(b * 8 + hd) * 2 + dir) * MS_SCAN + (size_t)c * 8192;
#pragma unroll
            for (int pt = 0; pt < 4; ++pt) { u32x2 w; w.x = pk2(acc[pt][0], acc[pt][1]); w.y = pk2(acc[pt][2], acc[pt][3]);
                *(u32x2*)(dst + (16 * pt + fr) * 128 + 16 * wid + 4 * fq) = w; }
        }
    }
    __syncthreads();
}
DEVI void ph_mamba_scan(bf16_t* MS, const float* MD, int vb0, int vbs) {
    const int tid = opq((int)threadIdx.x);
    for (int idx = vb0 * NTHR + tid; idx < 64 * 2048; idx += vbs * NTHR) {
        const int scan = idx >> 11, e4 = idx & 2047; const int dir = scan & 1;
        u32x2* base = (u32x2*)(MS + (size_t)scan * MS_SCAN) + e4;
        const float* md = MD + (size_t)scan * 32;
        float h0 = 0.f, h1 = 0.f, h2 = 0.f, h3 = 0.f;
#pragma unroll 1
        for (int half = 0; half < 2; ++half) {
            const int c0 = (dir ? 1 - half : half) * 16;
            u32x2 d[16]; float dec[16];
#pragma unroll
            for (int i = 0; i < 16; ++i) { d[i] = base[(size_t)(c0 + i) * 2048]; dec[i] = md[c0 + i]; }
#define MSCAN_STEP(i) { const float t0 = bflo(d[i].x), t1 = bfhi(d[i].x), t2 = bflo(d[i].y), t3 = bfhi(d[i].y); d[i].x = pk2(h0, h1); d[i].y = pk2(h2, h3); \
                h0 = h0 * dec[i] + t0; h1 = h1 * dec[i] + t1; h2 = h2 * dec[i] + t2; h3 = h3 * dec[i] + t3; }
            if (dir == 0) {
#pragma unroll
                for (int i = 0; i < 16; ++i) MSCAN_STEP(i)
            } else {
#pragma unroll
                for (int i = 15; i >= 0; --i) MSCAN_STEP(i)
            }
#undef MSCAN_STEP
#pragma unroll
            for (int i = 0; i < 16; ++i) base[(size_t)(c0 + i) * 2048] = d[i];
        }
    }
}
DEVI void ph_mamba_out(LAS unsigned char* lds, const bf16_t* u, const bf16_t* xconv, const bf16_t* XT, const float* dtraw, const float* A_log, const float* dt_bias, const float* Dskip, const float* b_norm,
                       const bf16_t* MS, bf16_t* ocat, int vb0, int vbs) {
    const int tid = opq((int)threadIdx.x), wid = __builtin_amdgcn_readfirstlane(tid >> 6), lane = tid & 63, fr = lane & 15, fq = lane >> 4;
    LAS float* tdt = (LAS float*)(lds + MB_DT); LAS float* tcs = (LAS float*)(lds + MB_CS);
    for (int unit = vb0; unit < NB * 2 * 32; unit += vbs) {
        const int c = unit & 31, g = (unit >> 5) & 1, b = unit >> 6;
        const size_t tok0 = (size_t)b * SEQ + c * 128;
        __syncthreads();
        stage_rows(lds + MB_XT, XT + ((size_t)b * 768 + g * 256) * SEQ + c * 128, SEQ, 256, tid);
        stage_rows(lds + MB_BX, xconv + tok0 * 1024 + 512 + g * 128, 1024, 128, tid);
        mamba_tables(lds, dtraw, A_log, dt_bias, b, g, c, wid, lane);
        const int tl = 16 * wid + fr;
        bf16x8 Cf[4];
#pragma unroll
        for (int ks = 0; ks < 4; ++ks) Cf[ks] = *(const bf16x8*)(xconv + (tok0 + tl) * 1024 + 768 + g * 128 + 32 * ks + 8 * fq);
        __syncthreads();
        f32x4 GT[8];
#pragma unroll
        for (int st = 0; st < 8; ++st) { GT[st] = (f32x4){0.f, 0.f, 0.f, 0.f};
            bf16x8 Af[4];
#pragma unroll
            for (int ks = 0; ks < 4; ++ks) Af[ks] = *(const LAS bf16x8*)(lds + MB_BX + (16 * st + fr) * 272 + (32 * ks + 8 * fq) * 2);
#pragma unroll
            for (int ks = 0; ks < 4; ++ks) GT[st] = __builtin_amdgcn_mfma_f32_16x16x32_bf16(Af[ks], Cf[ks], GT[st], 0, 0, 0); }
        float ss = 0.f;
        __syncthreads();
        u32x2 hpre[4];
        { const bf16_t* hin0 = MS + ((size_t)(b * 8 + 4 * g) * 2) * MS_SCAN + (size_t)c * 8192;
#pragma unroll
          for (int q = 0; q < 4; ++q) hpre[q] = ((const u32x2*)hin0)[tid + q * NTHR]; }
#pragma unroll 1
        for (int r = 0; r < 4; ++r) {
            const int hd = 4 * g + r;
            f32x4 yv[4];
#pragma unroll
            for (int pt = 0; pt < 4; ++pt) yv[pt] = (f32x4){0.f, 0.f, 0.f, 0.f};
#pragma unroll 1
            for (int dir = 0; dir < 2; ++dir) {
                const int hdd = r * 2 + dir;
                const float cst = tcs[hdd * 128 + tl];
                LAS unsigned char* hbuf = lds + MB_BX + (hdd & 1) * 17408;
#pragma unroll
                for (int q = 0; q < 4; ++q) { const int e4 = tid + q * NTHR, pp = e4 >> 5, n4 = (e4 & 31) * 4;
                    *(LAS u32x2*)(hbuf + pp * 272 + n4 * 2) = hpre[q]; }
                if (hdd < 7) { const int hn = hdd + 1; const bf16_t* hinn = MS + ((size_t)(b * 8 + 4 * g + (hn >> 1)) * 2 + (hn & 1)) * MS_SCAN + (size_t)c * 8192;
#pragma unroll
                    for (int q = 0; q < 4; ++q) hpre[q] = ((const u32x2*)hinn)[tid + q * NTHR]; }
                __syncthreads();
                f32x4 yo[4];
#pragma unroll
                for (int pt = 0; pt < 4; ++pt) { yo[pt] = (f32x4){0.f, 0.f, 0.f, 0.f};
                    bf16x8 hf[4];
#pragma unroll
                    for (int ks = 0; ks < 4; ++ks) hf[ks] = *(const LAS bf16x8*)(hbuf + (16 * pt + fr) * 272 + (32 * ks + 8 * fq) * 2);
#pragma unroll
                    for (int ks = 0; ks < 4; ++ks) yo[pt] = __builtin_amdgcn_mfma_f32_16x16x32_bf16(hf[ks], Cf[ks], yo[pt], 0, 0, 0); }
                const float eo = __expf(cst);
#pragma unroll
                for (int pt = 0; pt < 4; ++pt) yv[pt] += yo[pt] * eo;
#pragma unroll
                for (int kp = 0; kp < 4; ++kp) {
                    const bool skip = dir ? (2 * kp + 1 < wid) : (2 * kp > wid);
                    if (!skip) {
                        float pv[8];
#pragma unroll
                        for (int hlf = 0; hlf < 2; ++hlf) { const int st = 2 * kp + hlf;
                            const f32x4 cs4 = *(const LAS f32x4*)(tcs + hdd * 128 + 16 * st + 4 * fq), dt4 = *(const LAS f32x4*)(tdt + hdd * 128 + 16 * st + 4 * fq);
#pragma unroll
                            for (int rg = 0; rg < 4; ++rg) { const int sl = 16 * st + 4 * fq + rg;
                                const bool ok = dir ? (sl >= tl) : (sl <= tl);
                                const float e = __expf(fminf(cst - cs4[rg], 0.f));
                                pv[hlf * 4 + rg] = ok ? GT[st][rg] * e * dt4[rg] : 0.f; } }
                        u32x2 x0[4], x1[4];
#pragma unroll
                        for (int pt = 0; pt < 4; ++pt) { const LAS unsigned char* xr = lds + MB_XT + (r * 64 + 16 * pt + fr) * 272;
                            x0[pt] = *(const LAS u32x2*)(xr + (32 * kp + 4 * fq) * 2); x1[pt] = *(const LAS u32x2*)(xr + (32 * kp + 16 + 4 * fq) * 2); }
                        const bf16x8 Pf = pack8(pv);
#pragma unroll
                        for (int pt = 0; pt < 4; ++pt) {
                            u32x4 xa; xa.x = x0[pt].x; xa.y = x0[pt].y; xa.z = x1[pt].x; xa.w = x1[pt].y;
                            yv[pt] = __builtin_amdgcn_mfma_f32_16x16x32_bf16(__builtin_bit_cast(bf16x8, xa), Pf, yv[pt], 0, 0, 0);
                        }
                    }
                }
            }
            const float Dk = Dskip[hd];
#pragma unroll
            for (int pt = 0; pt < 4; ++pt) {
                const int p0 = 16 * pt + 4 * fq;
                const u32x2 xr = *(const u32x2*)(xconv + (tok0 + tl) * 1024 + hd * 64 + p0);
                const u32x2 zr = *(const u32x2*)(u + (tok0 + tl) * UW + 2560 + hd * 64 + p0);
                const float xs[4] = {bflo(xr.x), bfhi(xr.x), bflo(xr.y), bfhi(xr.y)}, zs[4] = {bflo(zr.x), bfhi(zr.x), bflo(zr.y), bfhi(zr.y)};
                float yy[4];
#pragma unroll
                for (int rg = 0; rg < 4; ++rg) { const float y = (yv[pt][rg] + Dk * xs[rg]) * silu_f(zs[rg]); yy[rg] = y; ss += y * y; }
                const unsigned long long o = (unsigned long long)pk2(yy[0], yy[1]) | ((unsigned long long)pk2(yy[2], yy[3]) << 32);
                __hip_atomic_store((unsigned long long*)(ocat + (tok0 + tl) * DM + 512 + g * 256 + r * 64 + p0), o, __ATOMIC_RELAXED, __HIP_MEMORY_SCOPE_AGENT);
            }
        }
        ss += __shfl_xor(ss, 16); ss += __shfl_xor(ss, 32);
        const float rn = rsqrtf(ss * (1.f / 256.f) + EPS);
        asm volatile("s_waitcnt vmcnt(0)" ::: "memory");
        unsigned long long pk[16];
#pragma unroll
        for (int q = 0; q < 16; ++q) pk[q] = __hip_atomic_load((unsigned long long*)(ocat + (tok0 + tl) * DM + 512 + g * 256 + (q >> 2) * 64 + 16 * (q & 3) + 4 * fq), __ATOMIC_RELAXED, __HIP_MEMORY_SCOPE_AGENT);
#pragma unroll
        for (int r = 0; r < 4; ++r)
#pragma unroll
            for (int pt = 0; pt < 4; ++pt) {
                const int cc = g * 256 + r * 64 + 16 * pt + 4 * fq;
                unsigned long long* op = (unsigned long long*)(ocat + (tok0 + tl) * DM + 512 + cc);
                const unsigned long long v = pk[r * 4 + pt];
                const unsigned vlo = (unsigned)v, vhi = (unsigned)(v >> 32);
                const float4 bn = *(const float4*)(b_norm + cc);
                const unsigned long long o = (unsigned long long)pk2(bflo(vlo) * rn * bn.x, bfhi(vlo) * rn * bn.y) | ((unsigned long long)pk2(bflo(vhi) * rn * bn.z, bfhi(vhi) * rn * bn.w) << 32);
                *op = o;
            }
    }
    __syncthreads();
}


constexpr int NA_RING = 12, NA_VT = 0, NA_VSTRIDE = NA_RING * 64 * 2 + 16, NA_BIAS = 64 * NA_VSTRIDE, NA_END = NA_BIAS + 480 * 4;
static_assert(NA_END <= 131072, "na lds");
DEVI void ph_na(LAS unsigned char* lds, const bf16_t* qkv, const float* rpb, bf16_t* oc, int vb0, int vbs) {
    const int tid = opq((int)threadIdx.x), wid = __builtin_amdgcn_readfirstlane(tid >> 6), lane = tid & 63, fr = lane & 15, fq = lane >> 4;
    LAS float* bl = (LAS float*)(lds + NA_BIAS);
    for (int chunk = vb0; chunk < NB * 16 * 4; chunk += vbs) {
        const int qr4 = chunk & 3, h = (chunk >> 2) & 15, b = chunk >> 6;
        __syncthreads();
        for (int e = tid; e < 465; e += NTHR) bl[e] = rpb[h * 465 + e];
        int staged_hi = -1;
#pragma unroll 1
        for (int ui = 0; ui < 8; ++ui) {
            const int rp = qr4 * 8 + ui;
            const int r0 = 2 * rp, rs0 = min(max(r0 - 4, 0), 56);
            const int need_hi = min(rs0 + 8, 63);
            const int lo = max(staged_hi + 1, rs0);
            for (int task = wid; task < (need_hi - lo + 1) * 8; task += 8) {
                const int kr = lo + (task >> 3), ch = task & 7, slot = kr % NA_RING;
                const u32x4 v = *(const u32x4*)(qkv + ((size_t)b * SEQ + kr * 64 + lane) * 3072 + 2048 + h * 64 + ch * 8);
                const unsigned vw[4] = {v.x, v.y, v.z, v.w};
#pragma unroll
                for (int i = 0; i < 8; ++i) *(LAS bf16_t*)(lds + NA_VT + (ch * 8 + i) * NA_VSTRIDE + (slot * 64 + lane) * 2) = (bf16_t)((i & 1) ? (vw[i >> 1] >> 16) : (vw[i >> 1] & 0xffffu));
            }
            staged_hi = need_hi > staged_hi ? need_hi : staged_hi;
            __syncthreads();
            const int r = r0 + (wid >> 2), j = wid & 3;
            const int rs = min(max(r - 4, 0), 56);
            const int bs = (j == 0) ? 0 : (j == 1) ? 8 : (j == 2) ? 24 : 32;
            const int c = 16 * j + fr, qs = min(max(c - 8, 0), 48);
            const size_t qtok = (size_t)b * SEQ + r * 64 + c;
            bf16x8 Qf[2];
#pragma unroll
            for (int ks = 0; ks < 2; ++ks) Qf[ks] = *(const bf16x8*)(qkv + qtok * 3072 + h * 64 + 32 * ks + 8 * fq);
            const bf16_t* kbase = qkv + ((size_t)b * SEQ + rs * 64 + bs + fr) * 3072 + 1024 + h * 64 + 8 * fq;
            bf16x8 kn[4];
#pragma unroll
            for (int q = 0; q < 4; ++q) kn[q] = *(const bf16x8*)(kbase + (size_t)((q >> 1) * 16) * 3072 + (q & 1) * 32);
            f32x4 O[4];
#pragma unroll
            for (int dt = 0; dt < 4; ++dt) O[dt] = (f32x4){0.f, 0.f, 0.f, 0.f};
            float mrun = -1e30f, lrun = 0.f;
#pragma unroll 1
            for (int dr = 0; dr < 8; ++dr) {
                bf16x8 kc[4];
#pragma unroll
                for (int q = 0; q < 4; ++q) kc[q] = kn[q];
                const int drn = dr < 7 ? dr + 1 : 7;
#pragma unroll
                for (int q = 0; q < 4; ++q) kn[q] = *(const bf16x8*)(kbase + ((size_t)drn * 64 + (q >> 1) * 16) * 3072 + (q & 1) * 32);
                float sv[8]; float mloc = -1e30f;
                const LAS float* brow = bl + (rs + dr - r + 7) * 31;
#pragma unroll
                for (int kg = 0; kg < 2; ++kg) {
                    f32x4 acc = {0.f, 0.f, 0.f, 0.f};
                    acc = __builtin_amdgcn_mfma_f32_16x16x32_bf16(kc[kg * 2], Qf[0], acc, 0, 0, 0);
                    acc = __builtin_amdgcn_mfma_f32_16x16x32_bf16(kc[kg * 2 + 1], Qf[1], acc, 0, 0, 0);
#pragma unroll
                    for (int rg = 0; rg < 4; ++rg) {
                        const int kcol = bs + 16 * kg + 4 * fq + rg;
                        const bool ok = (kcol >= qs) && (kcol < qs + 16);
                        const int dc = min(max(kcol - c + 15, 0), 30);
                        const float sc = ok ? acc[rg] * 0.125f + brow[dc] : -1e30f;
                        sv[kg * 4 + rg] = sc; mloc = fmaxf(mloc, sc);
                    }
                }
                mloc = fmaxf(mloc, __shfl_xor(mloc, 16)); mloc = fmaxf(mloc, __shfl_xor(mloc, 32));
                const float mnew = fmaxf(mrun, mloc);
                const float alpha = __expf(mrun - mnew);
                float psum = 0.f;
#pragma unroll
                for (int i = 0; i < 8; ++i) { const float p = __expf(sv[i] - mnew); sv[i] = p; psum += p; }
                psum += __shfl_xor(psum, 16); psum += __shfl_xor(psum, 32);
                lrun = lrun * alpha + psum; mrun = mnew;
                const bf16x8 Pf = pack8(sv);
                const int koff = (((rs + dr) % NA_RING) * 64 + bs + 4 * fq) * 2;
#pragma unroll
                for (int dt = 0; dt < 4; ++dt) {
                    const LAS unsigned char* vr = lds + NA_VT + (16 * dt + fr) * NA_VSTRIDE + koff;
                    const u32x2 v0 = *(const LAS u32x2*)vr, v1 = *(const LAS u32x2*)(vr + 32);
                    u32x4 va; va.x = v0.x; va.y = v0.y; va.z = v1.x; va.w = v1.y;
                    O[dt] = __builtin_amdgcn_mfma_f32_16x16x32_bf16(__builtin_bit_cast(bf16x8, va), Pf, O[dt] * alpha, 0, 0, 0);
                }
            }
            const float il = 1.f / lrun;
#pragma unroll
            for (int dt = 0; dt < 4; ++dt) {
                u32x2 o; o.x = pk2(O[dt][0] * il, O[dt][1] * il); o.y = pk2(O[dt][2] * il, O[dt][3] * il);
                *(u32x2*)(oc + qtok * DM + h * 64 + 16 * dt + 4 * fq) = o;
            }
        }
    }
    __syncthreads();
}

#define XB_TMO      128
#define XB_XCNT(j)  (256  + 64 * (j))
#define XB_XSUB(j)  (1280 + 64 * (j))
#define XB_XGEN(j)  (2304 + 64 * (j))
#define XB_TOP      3328
#define XB_TOPGEN   3392
#define XCD_BAR_WORDS 3456
#define XB_SPIN_CAP (1u << 18)

__device__ __forceinline__ unsigned xb_ld(unsigned* p)              { return __hip_atomic_load(p, __ATOMIC_RELAXED, __HIP_MEMORY_SCOPE_AGENT); }
__device__ __forceinline__ unsigned xb_add(unsigned* p, unsigned v) { return __hip_atomic_fetch_add(p, v, __ATOMIC_RELAXED, __HIP_MEMORY_SCOPE_AGENT); }
__device__ __forceinline__ unsigned xb_xcc_id() { return (unsigned)__builtin_amdgcn_s_getreg((3 << 11) | 20) & 0xFu; }
#define XB_SPIN(cond, bar) do { unsigned _sp = 0; while (cond) { __builtin_amdgcn_s_sleep(1); \
    if ((++_sp & 255u) == 0u) { if (xb_ld(&(bar)[XB_TMO])) break; if (_sp > XB_SPIN_CAP) { atomicAdd(&(bar)[XB_TMO], 1u); break; } } } } while (0)

struct XcdBarrier {
    unsigned* bar; unsigned x;
    volatile LAS unsigned* st;
};

__device__ __forceinline__ XcdBarrier xcd_barrier_post(unsigned* bar, volatile LAS unsigned* st) {
    XcdBarrier b; b.bar = bar; b.x = xb_xcc_id(); b.st = st;
    if (threadIdx.x == 0) (void)xb_add(&bar[XB_XCNT(b.x)], 1u);
    return b;
}
__device__ __forceinline__ void xcd_barrier_complete(unsigned* bar, unsigned x, unsigned& nloc, unsigned& nx) {
    const unsigned G = gridDim.x * gridDim.y * gridDim.z;
    unsigned sum, cnt, mine, sp = 0u;
    for (;;) {
        sum = 0u; cnt = 0u; mine = 0u;
#pragma unroll
        for (unsigned j = 0; j < 16; ++j) { const unsigned c = xb_ld(&bar[XB_XCNT(j)]); sum += c; cnt += (c > 0u) ? 1u : 0u; mine = (j == x) ? c : mine; }
        if (sum == G) break;
        __builtin_amdgcn_s_sleep(1);
        if ((++sp & 255u) == 0u) { if (xb_ld(&bar[XB_TMO])) break; if (sp > XB_SPIN_CAP) { atomicAdd(&bar[XB_TMO], 1u); break; } }
    }
    nloc = mine > 0u ? mine : 1u; nx = cnt > 0u ? cnt : 1u;
}

__device__ __forceinline__ void xcd_barrier(const XcdBarrier& b) {
    asm volatile("s_waitcnt vmcnt(0)" ::: "memory");
    __syncthreads();
    if (threadIdx.x == 0) {
        unsigned* bar = b.bar;
        __builtin_amdgcn_s_waitcnt(0);
        unsigned nloc = b.st[0], nx = b.st[1];
        if (nloc == 0u) { xcd_barrier_complete(bar, b.x, nloc, nx); b.st[0] = nloc; b.st[1] = nx; }
        const unsigned old = xb_add(&bar[XB_XSUB(b.x)], 1u);
        const unsigned gen = old / nloc;
        if (old + 1u == (gen + 1u) * nloc) {
            __builtin_amdgcn_fence(__ATOMIC_RELEASE, "agent");
            asm volatile("s_waitcnt vmcnt(0)" ::: "memory");
            const unsigned og = xb_add(&bar[XB_TOP], 1u);
            const unsigned tg = og / nx;
            if (og + 1u == (tg + 1u) * nx) xb_add(&bar[XB_TOPGEN], 1u);
            else XB_SPIN(xb_ld(&bar[XB_TOPGEN]) == tg, bar);
            __builtin_amdgcn_fence(__ATOMIC_ACQUIRE, "agent");
            xb_add(&bar[XB_XGEN(b.x)], 1u);
            asm volatile("s_waitcnt vmcnt(0)" ::: "memory");
        } else {
            XB_SPIN(xb_ld(&bar[XB_XGEN(b.x)]) == gen, bar);
            __builtin_amdgcn_fence(__ATOMIC_ACQUIRE, "agent");
            asm volatile("s_waitcnt vmcnt(0)" ::: "memory");
        }
    }
    __syncthreads();
}


struct Args { const float* in[34]; float* out; unsigned char* ws; int ph_lo, ph_hi; };
constexpr int N_PHASES = 22;

__global__ void __launch_bounds__(NTHR, 2) fwd(Args a) {
    extern __shared__ __attribute__((aligned(16))) unsigned char lds_raw[];
    float* lds = (float*)lds_raw;
    LAS unsigned char* ldsl = (LAS unsigned char*)lds_raw;
    const int vb0 = blockIdx.x, vbs = gridDim.x;
    const int lo = a.ph_lo, hi = a.ph_hi;
#define IN(k) (lo <= (k) && (k) < hi)
#define SEAM(k) do { if (IN(k) && IN((k) + 1)) xcd_barrier(bar); } while (0)
    volatile LAS unsigned* misc = (volatile LAS unsigned*)(ldsl + MISC_OFF);
    if (threadIdx.x < 4) misc[threadIdx.x] = 0u;
    __syncthreads();
    XcdBarrier bar = xcd_barrier_post((unsigned*)(a.ws + WS_CTL) + CW_BAR, misc);
    unsigned char* ws = a.ws;
    unsigned* ctl = (unsigned*)(ws + WS_CTL);
    unsigned* cnt = ctl + CW_CNT;
    int* list = (int*)(ws + WS_LIST); float* gatev = (float*)(ws + WS_GATE);
    float* dtraw = (float*)(ws + WS_DT); float* RS = (float*)(ws + WS_RS);
    bf16_t* XB = (bf16_t*)(ws + WS_XB); bf16_t* UB = (bf16_t*)(ws + WS_UB);
    bf16_t* YA = (bf16_t*)(ws + WS_YA); float* OF = (float*)(ws + WS_OF); bf16_t* OC = (bf16_t*)(ws + WS_OC);
    bf16_t* YP = (bf16_t*)(ws + WS_YP); bf16_t* YP1 = (bf16_t*)(ws + WS_YP1); bf16_t* XC = (bf16_t*)(ws + WS_YP);
    bf16_t* PB0 = (bf16_t*)(ws + WS_PB0); bf16_t* PB1 = (bf16_t*)(ws + WS_PB1);
    bf16_t* YB = (bf16_t*)(ws + WS_Y);
    bf16_t* MS = (bf16_t*)(ws + WS_MS); float* MD = (float*)(ws + WS_MD);
    bf16_t* HS = (bf16_t*)(ws + WS_HS); float* HD = (float*)(ws + WS_HD);
    bf16_t* XT = (bf16_t*)(ws + WS_XT); bf16_t* VT = (bf16_t*)(ws + WS_VT);
    const float* p_in = a.in[1];
    const int G = (int)gridDim.x, cb = (int)blockIdx.x;
    const NormB NB0{nullptr, XB, nullptr, nullptr, RS, nullptr, nullptr, nullptr, nullptr, nullptr, nullptr, nullptr, nullptr, nullptr, nullptr};
    unsigned char* XG8 = ws + WS_XG8;
    float* rsl = (float*)(ws + WS_DT);

    if (IN(0)) {
        ph_convert_weights(ldsl, a.in, ws, 0, ITEMS_DENSE, vb0, vbs);
        NormB A = NB0; A.xin = a.in[0]; A.gnext = a.in[3]; A.win = a.in[4]; A.dtraw = dtraw;
        ph_norm2<0, false, true, false>(A, vb0, vbs, (LAS float*)ldsl);
    }
    SEAM(0);
    if (IN(1)) { pg8::DenseOrder S; S.init(MT, UW, DM, (const bf16_t*)(ws + W_IN), G, cb); pg8::gemm_phase(ldsl, XB, DM, S, pg8::EpiBf16{UB, UW, RS}); }
    SEAM(1);
    if (IN(2)) { ph_prep(UB, a.in[5], a.in[6], XC, XT, VT, vb0, vbs); }
    SEAM(2);
    if (IN(3)) { ph_hgrn_states(ldsl, UB, VT, a.in[2], HS, HD, vb0, vbs); ph_mamba_states(ldsl, XT, dtraw, a.in[7], a.in[8], MS, MD, vb0, vbs); }
    SEAM(3);
    if (IN(4)) { ph_hgrn_scan(HS, HD, vb0, vbs); ph_mamba_scan(MS, MD, vb0, vbs); }
    SEAM(4);
    if (IN(5)) { ph_hgrn_out(ldsl, UB, VT, a.in[2], a.in[10], HS, OF, OC, vb0, vbs); ph_mamba_out(ldsl, UB, XC, XT, dtraw, a.in[7], a.in[8], a.in[9], a.in[11], MS, OC, vb0, vbs); }
    SEAM(5);
    if (IN(6)) { pg8::DenseOrder S; S.init(MT, DM, DM, (const bf16_t*)(ws + W_OUTE), G, cb); pg8::gemm_phase(ldsl, OC, DM, S, pg8::EpiBf16{YA, DM, nullptr}); }
    SEAM(6);
    if (IN(7)) {
        NormB A = NB0; A.y = YA; A.gpost = a.in[13];
        ph_norm2<1, false, false, false>(A, vb0, vbs);
        ph_cvt_rows(p_in, PB0, (size_t)MT * PDIM / 4, vb0, vbs);
        ph_convert_weights(ldsl, a.in, ws, ITEMS_DENSE, ITEMS_ALL, vb0, vbs);
    }
    SEAM(7);
    if (IN(8)) {
        { pg8::DenseOrder S; S.init(MT, 2 * DFF, DM, (const bf16_t*)(ws + W_GU), G, cb); pg8::gemm_phase(ldsl, XB, DM, S, pg8::EpiSwiglu{UB, DFF, RS, 0}); }
        { pg8::TailOrder S; S.init(MT, DM, PDIM, (const bf16_t*)(ws + W_PP), G, cb, (MT / 256) * (2 * DFF / 256) % G); pg8::gemm_phase(ldsl, PB0, PDIM, S, pg8::EpiBf16{YP, DM, nullptr}); }
    }
    SEAM(8);
    if (IN(9)) { pg8::DenseOrder S; S.init(MT, DM, DFF, (const bf16_t*)(ws + W_DN), G, cb); pg8::gemm_phase(ldsl, UB, DFF, S, pg8::EpiBf16{YA, DM, nullptr}); }
    SEAM(9);
    if (IN(10)) {
        NormB A = NB0; A.y = YA; A.gpost = a.in[18];
        ph_norm2<1, false, false, false>(A, vb0, vbs);
    }
    SEAM(10);
    if (IN(11)) { pg8::DenseOrder S; S.init(MT, DM, DM, (const bf16_t*)(ws + W_PG), G, cb); pg8::gemm_phase(ldsl, XB, DM, S, pg8::EpiPleGate{YP, DM, RS}); }
    SEAM(11);
    if (IN(12)) {
        NormB A = NB0; A.y = YP; A.gpost = a.in[33];
        ph_norm2<1, false, false, false>(A, vb0, vbs);
    }
    SEAM(12);
    if (IN(13)) { pg8::DenseOrder S; S.init(MT, 3072, DM, (const bf16_t*)(ws + W_QKV), G, cb); pg8::gemm_phase(ldsl, XB, DM, S, pg8::EpiBf16{UB, 3072, RS}); }
    SEAM(13);
    if (IN(14)) { ph_na(ldsl, UB, a.in[21], OC, vb0, vbs); }
    SEAM(14);
    if (IN(15)) { pg8::DenseOrder S; S.init(MT, DM, DM, (const bf16_t*)(ws + W_OUTO), G, cb); pg8::gemm_phase(ldsl, OC, DM, S, pg8::EpiBf16{YP1, DM, nullptr}); }
    SEAM(15);
    if (IN(16)) {
        NormB A = NB0; A.y = YP1; A.gpost = a.in[23]; A.gnext = a.in[24]; A.wr = a.in[25]; A.cnt = cnt; A.list = list; A.gatev = gatev; A.rsl = rsl; A.x8 = XG8;
        ph_norm2<1, false, false, true>(A, vb0, vbs, (LAS float*)ldsl);
        ph_cvt_rows(p_in + (size_t)MT * PDIM, PB1, (size_t)MT * PDIM / 4, vb0, vbs);
    }
    SEAM(16);
    if (IN(17)) { pg8::MoeOrder S; S.init(cnt, (volatile LAS int*)(ldsl + MISC_OFF + 64), 2 * DFFE, DM / 2, (const bf16_t*)(ws + W_EGU), (size_t)7 * MiB, true, G, cb);
        pg8::gemm_phase<pg8::EpiSwiglu8, pg8::MoeOrder, true>(ldsl, (const bf16_t*)XG8, DM / 2, S, pg8::EpiSwiglu8{(unsigned char*)UB, DFFE, rsl}); }
    SEAM(17);
    if (IN(18)) { pg8::MoeOrder S; S.init(cnt, (volatile LAS int*)(ldsl + MISC_OFF + 64), DM, DFFE / 2, (const bf16_t*)(ws + W_EDN), (size_t)(7 * MiB / 2), false, G, cb);
        pg8::gemm_phase<pg8::EpiMoeDown, pg8::MoeOrder, true>(ldsl, UB, DFFE / 2, S, pg8::EpiMoeDown{YB, list, gatev, 1.f / (pg8::W8_SCALE * pg8::ACT8_SCALE)});
        { pg8::TailOrder T; T.init(MT, DM, PDIM, (const bf16_t*)(ws + W_PP + 512 * 1024), G, cb, S.nwg % G); pg8::gemm_phase(ldsl, PB1, PDIM, T, pg8::EpiBf16{YP, DM, nullptr}); } }
    SEAM(18);
    if (IN(19)) {
        NormB A = NB0; A.y = YB; A.gpost = a.in[29];
        ph_norm2<2, false, false, false>(A, vb0, vbs);
    }
    SEAM(19);
    if (IN(20)) { pg8::DenseOrder S; S.init(MT, DM, DM, (const bf16_t*)(ws + W_PG + 2 * MiB), G, cb); pg8::gemm_phase(ldsl, XB, DM, S, pg8::EpiPleGate{YP, DM, RS}); }
    SEAM(20);
    if (IN(21)) {
        NormB A = NB0; A.y = YP; A.gpost = a.in[33] + DM; A.xout = a.out;
        ph_norm2<1, true, false, false>(A, vb0, vbs);
    }
#undef IN
#undef SEAM
}

extern "C" void kernel_launch(void* const* d_in, const int* in_sizes, int n_in, void* d_out, int out_size, void* d_ws, size_t ws_size, hipStream_t stream) {
    static int grid = 0;
    if (grid == 0) {
        if (n_in != 34 || out_size != MT * DM || ws_size < WS_END) { fprintf(stderr, "kernel_launch: unexpected shapes n_in %d out %d ws %zu (need %zu)\n", n_in, out_size, ws_size, (size_t)WS_END); grid = -1; return; }
        int dev = 0, cus = 0;
        if (hipGetDevice(&dev) != hipSuccess || hipDeviceGetAttribute(&cus, hipDeviceAttributeMultiprocessorCount, dev) != hipSuccess) { grid = -1; return; }
        if (hipFuncSetAttribute((const void*)fwd, hipFuncAttributeMaxDynamicSharedMemorySize, LDS_BYTES) != hipSuccess) { fprintf(stderr, "hipFuncSetAttribute failed\n"); grid = -1; return; }
        (void)hipGetLastError();
        grid = cus;
    }
    if (grid < 0) return;
    (void)hipMemsetAsync((char*)d_ws + WS_CTL, 0, CTL_ZERO_BYTES, stream);
    Args a{};
    for (int i = 0; i < 34; ++i) a.in[i] = (const float*)d_in[i];
    a.out = (float*)d_out; a.ws = (unsigned char*)d_ws;
#ifndef MK_PER_PHASE
    a.ph_lo = 0; a.ph_hi = N_PHASES;
    hipLaunchKernelGGL(fwd, dim3(grid), dim3(NTHR), LDS_BYTES, stream, a);
#else
    for (int ph = 0; ph < N_PHASES; ++ph) {
        a.ph_lo = ph; a.ph_hi = ph + 1;
        hipLaunchKernelGGL(fwd, dim3(grid), dim3(NTHR), LDS_BYTES, stream, a);
    }
#endif
}
```

```cpp
#include <hip/hip_runtime.h>
#include <stdint.h>
#include <stdio.h>

#define DEVI __device__ __forceinline__
#define LAS __attribute__((address_space(3)))
typedef unsigned short bf16_t;

constexpr int NB = 4, SEQ = 4096, DM = 1024, MT = NB * SEQ;
constexpr int EVEN_IN = 4112, UW = 4096, DFF = 2816, NEXP = 8, DFFE = 3584, PDIM = 256;
constexpr float EPS = 1e-6f;
constexpr int NTHR = 512;
constexpr int LDS_BYTES = 147456;
constexpr int MISC_OFF = 131072 + 320;
constexpr int MOE_ROWS = 2 * MT + NEXP * 256;

constexpr size_t MiB = 1u << 20;
constexpr size_t WS_CTL = 0, CTL_ZERO_BYTES = 1 * MiB;
constexpr size_t WS_LIST = 1 * MiB;
constexpr size_t WS_GATE = WS_LIST + 512 * 1024;
constexpr size_t WS_DT = 2 * MiB;
constexpr size_t WS_W = 3 * MiB;
constexpr size_t W_IN = WS_W, W_OUTE = W_IN + 8 * MiB, W_GU = W_OUTE + 2 * MiB, W_DN = W_GU + 11 * MiB, W_PG = W_DN + 6 * MiB, W_PP = W_PG + 4 * MiB,
                 W_QKV = W_PP + 1 * MiB, W_OUTO = W_QKV + 6 * MiB, W_EGU = W_OUTO + 2 * MiB, W_EDN = W_EGU + 112 * MiB, W_END = W_EDN + 56 * MiB;
constexpr size_t WS_XB = W_END;
constexpr size_t WS_R = WS_XB + 32 * MiB;
constexpr size_t WS_UB = WS_R;
constexpr size_t WS_PB0 = WS_R + 88 * MiB;
constexpr size_t WS_YA = WS_R + 128 * MiB;
constexpr size_t WS_OF = WS_R + 160 * MiB;
constexpr size_t WS_OC = WS_R + 192 * MiB;
constexpr size_t WS_YP = WS_R + 224 * MiB;
constexpr size_t WS_YP1 = WS_R;
constexpr size_t WS_PB1 = W_EDN + 32 * MiB;
constexpr size_t WS_XG8 = WS_R + 120 * MiB;
constexpr size_t WS_END = WS_R + 256 * MiB;
constexpr size_t WS_Y2 = WS_R + 120 * MiB;
constexpr size_t WS_YFLAG = WS_CTL + 256 * 1024;
constexpr size_t WS_Y = W_EGU;
constexpr size_t WS_MS = W_EGU;
constexpr size_t WS_HS = W_EGU + 64 * MiB;
constexpr size_t WS_XT = W_EDN;
constexpr size_t WS_VT = W_EDN + 24 * MiB;
constexpr size_t WS_MD = W_EDN + 40 * MiB;
constexpr size_t WS_HD = W_EDN + 41 * MiB;
static_assert(WS_R + (size_t)MOE_ROWS * DFFE <= WS_XG8 && WS_XG8 + 128 * MiB <= WS_END && WS_END <= 510 * MiB, "ws map");
constexpr size_t WS_RS = WS_CTL + 512 * 1024;
constexpr int CW_CNT = 64;
constexpr int CW_BAR = 4096;

DEVI int opq(int x) { asm volatile("" : "+v"(x)); return x; }
DEVI float bf2f(bf16_t b) { return __uint_as_float(((unsigned)b) << 16); }
typedef float f32x2c __attribute__((ext_vector_type(2)));
typedef __bf16 bf16x2c __attribute__((ext_vector_type(2)));
DEVI unsigned cvt2bf(float lo, float hi) { const f32x2c v = {lo, hi}; return __builtin_bit_cast(unsigned, __builtin_convertvector(v, bf16x2c)); }
DEVI bf16_t f2bf(float f) { return (bf16_t)(cvt2bf(f, 0.f) & 0xffffu); }
DEVI float silu_f(float x) { return x * __builtin_amdgcn_rcpf(1.f + __builtin_amdgcn_exp2f(-1.44269504f * x)); }
DEVI float sigmoid_f(float x) { return __builtin_amdgcn_rcpf(1.f + __builtin_amdgcn_exp2f(-1.44269504f * x)); }
DEVI float softplus_f(float x) { return x > 20.f ? x : log1pf(__expf(x)); }
DEVI float wave_sum(float v) {
#pragma unroll
    for (int o = 1; o < 64; o <<= 1) v += __shfl_xor(v, o);
    return v;
}


typedef short bf16x8 __attribute__((ext_vector_type(8)));
typedef float f32x4 __attribute__((ext_vector_type(4)));
typedef unsigned u32x4 __attribute__((ext_vector_type(4)));
typedef unsigned u32x2 __attribute__((ext_vector_type(2)));
DEVI unsigned pk2(float lo, float hi) { return cvt2bf(lo, hi); }
DEVI float bflo(unsigned w) { return __uint_as_float(w << 16); }
DEVI float bfhi(unsigned w) { return __uint_as_float(w & 0xffff0000u); }

DEVI unsigned pg8_pk4(float a, float b, float c, float d) {
    a = __builtin_amdgcn_fmed3f(a, -448.f, 448.f); b = __builtin_amdgcn_fmed3f(b, -448.f, 448.f); c = __builtin_amdgcn_fmed3f(c, -448.f, 448.f); d = __builtin_amdgcn_fmed3f(d, -448.f, 448.f);
    int p = __builtin_amdgcn_cvt_pk_fp8_f32(a, b, 0, false); p = __builtin_amdgcn_cvt_pk_fp8_f32(c, d, p, true); return (unsigned)p; }
DEVI float wave_sum16(float (&v)[16], int lane) {
    const bool h5 = lane & 32, h4 = lane & 16, h3 = lane & 8, h2 = lane & 4;
#pragma unroll
    for (int i = 0; i < 8; ++i) { const float send = h5 ? v[i] : v[i + 8], keep = h5 ? v[i + 8] : v[i]; v[i] = keep + __shfl_xor(send, 32); }
#pragma unroll
    for (int i = 0; i < 4; ++i) { const float send = h4 ? v[i] : v[i + 4], keep = h4 ? v[i + 4] : v[i]; v[i] = keep + __shfl_xor(send, 16); }
#pragma unroll
    for (int i = 0; i < 2; ++i) { const float send = h3 ? v[i] : v[i + 2], keep = h3 ? v[i + 2] : v[i]; v[i] = keep + __shfl_xor(send, 8); }
    { const float send = h2 ? v[0] : v[1], keep = h2 ? v[1] : v[0]; v[0] = keep + __shfl_xor(send, 4); }
    float r = v[0]; r += __shfl_xor(r, 1); r += __shfl_xor(r, 2); return r;
}
DEVI float wave_sum8(float (&v)[8], int lane) {
    const bool h5 = lane & 32, h4 = lane & 16, h3 = lane & 8;
#pragma unroll
    for (int i = 0; i < 4; ++i) { const float send = h5 ? v[i] : v[i + 4], keep = h5 ? v[i + 4] : v[i]; v[i] = keep + __shfl_xor(send, 32); }
#pragma unroll
    for (int i = 0; i < 2; ++i) { const float send = h4 ? v[i] : v[i + 2], keep = h4 ? v[i + 2] : v[i]; v[i] = keep + __shfl_xor(send, 16); }
    { const float send = h3 ? v[0] : v[1], keep = h3 ? v[1] : v[0]; v[0] = keep + __shfl_xor(send, 8); }
    float r = v[0]; r += __shfl_xor(r, 1); r += __shfl_xor(r, 2); r += __shfl_xor(r, 4); return r;
}
struct NormB { const float* xin; bf16_t* XB; const bf16_t* y; const float* gpost; float* rs; const float* gnext;
               const float* win; float* dtraw; const float* wr; unsigned* cnt; int* list; float* gatev; float* rsl; float* xout; unsigned char* x8; const bf16_t* y2; const unsigned char* yflag; };
DEVI void unpack8(const u32x4 w, float* v) { v[0] = bflo(w.x); v[1] = bfhi(w.x); v[2] = bflo(w.y); v[3] = bfhi(w.y); v[4] = bflo(w.z); v[5] = bfhi(w.z); v[6] = bflo(w.w); v[7] = bfhi(w.w); }
template <int YMODE, bool FINAL, bool DT, bool ROUTE>
DEVI void ph_norm2(const NormB& A, int vb0, int vbs, LAS float* wl = nullptr) {
    const int tidq = opq((int)threadIdx.x); const int wid = tidq >> 6, lane = tidq & 63;
    if (DT || ROUTE) {
        constexpr int NJ = DT ? 16 : 8;
        __syncthreads();
        for (int e = tidq; e < DM * NJ / 4; e += NTHR) { const int k = e / (NJ / 4), j4 = (e % (NJ / 4)) * 4;
            const float4 w = DT ? *(const float4*)(A.win + (size_t)k * EVEN_IN + 4096 + j4) : *(const float4*)(A.wr + (size_t)k * 8 + j4);
            wl[(j4 + 0) * DM + k] = w.x; wl[(j4 + 1) * DM + k] = w.y; wl[(j4 + 2) * DM + k] = w.z; wl[(j4 + 3) * DM + k] = w.w; }
        __syncthreads();
    }
    constexpr int R = (DT || ROUTE) ? 2 : 4;
    for (int row0 = (vb0 * 8 + wid) * R; row0 < MT; row0 += vbs * 8 * R) {
        float xv[R][16]; float yv[R][16];
#pragma unroll
        for (int rr = 0; rr < R; ++rr) {
            const size_t ro = (size_t)(row0 + rr) * DM + lane * 8;
            if (YMODE == 0) {
#pragma unroll
                for (int i = 0; i < 2; ++i) { const float4 p0 = *(const float4*)(A.xin + ro + i * 512), p1 = *(const float4*)(A.xin + ro + i * 512 + 4);
                    xv[rr][i * 8 + 0] = p0.x; xv[rr][i * 8 + 1] = p0.y; xv[rr][i * 8 + 2] = p0.z; xv[rr][i * 8 + 3] = p0.w; xv[rr][i * 8 + 4] = p1.x; xv[rr][i * 8 + 5] = p1.y; xv[rr][i * 8 + 6] = p1.z; xv[rr][i * 8 + 7] = p1.w; }
            } else {
#pragma unroll
                for (int i = 0; i < 2; ++i) {
                    unpack8(*(const u32x4*)(A.XB + ro + i * 512), xv[rr] + i * 8);
                    unpack8(*(const u32x4*)(A.y + ro + i * 512), yv[rr] + i * 8);
                    if (YMODE == 2) { float y2[8]; unpack8(*(const u32x4*)(A.y + (size_t)MT * DM + ro + i * 512), y2);
#pragma unroll
                        for (int j = 0; j < 8; ++j) yv[rr][i * 8 + j] += y2[j]; }
                }
            }
        }
        if (YMODE == 2) {
#pragma unroll
            for (int rr = 0; rr < R; ++rr) { const u32x2 fw = *(const u32x2*)(A.yflag + (size_t)(row0 + rr) * 8);
                const unsigned f0 = __builtin_amdgcn_readfirstlane(fw.x), f1 = __builtin_amdgcn_readfirstlane(fw.y);
                if (f0 | f1) { const size_t ro = (size_t)(row0 + rr) * DM + lane * 8;
#pragma unroll
                    for (int sl = 0; sl < 2; ++sl) { const unsigned fs = sl ? f1 : f0;
#pragma unroll
                        for (int i = 0; i < 2; ++i) if ((fs >> (8 * ((lane >> 5) + 2 * i))) & 0xff) { float y2[8]; unpack8(*(const u32x4*)(A.y2 + (size_t)sl * MT * DM + ro + i * 512), y2);
#pragma unroll
                            for (int j = 0; j < 8; ++j) yv[rr][i * 8 + j] += y2[j]; } } } }
        }
        if (YMODE != 0) {
            float gg[16];
#pragma unroll
            for (int i = 0; i < 2; ++i) { const float4 g0 = *(const float4*)(A.gpost + i * 512 + lane * 8), g1 = *(const float4*)(A.gpost + i * 512 + lane * 8 + 4);
                gg[i * 8 + 0] = g0.x; gg[i * 8 + 1] = g0.y; gg[i * 8 + 2] = g0.z; gg[i * 8 + 3] = g0.w; gg[i * 8 + 4] = g1.x; gg[i * 8 + 5] = g1.y; gg[i * 8 + 6] = g1.z; gg[i * 8 + 7] = g1.w; }
            float ss[R];
#pragma unroll
            for (int rr = 0; rr < R; ++rr) { ss[rr] = 0.f;
#pragma unroll
                for (int j = 0; j < 16; ++j) ss[rr] += yv[rr][j] * yv[rr][j]; }
#pragma unroll
            for (int o = 1; o < 64; o <<= 1)
#pragma unroll
                for (int rr = 0; rr < R; ++rr) ss[rr] += __shfl_xor(ss[rr], o);
#pragma unroll
            for (int rr = 0; rr < R; ++rr) { const float r = rsqrtf(ss[rr] * (1.f / DM) + EPS);
#pragma unroll
                for (int j = 0; j < 16; ++j) xv[rr][j] += yv[rr][j] * r * gg[j]; }
        }
        if (FINAL) {
#pragma unroll
            for (int rr = 0; rr < R; ++rr)
#pragma unroll
                for (int i = 0; i < 2; ++i) { float* op = A.xout + (size_t)(row0 + rr) * DM + i * 512 + lane * 8;
                    *(float4*)op = make_float4(xv[rr][i * 8], xv[rr][i * 8 + 1], xv[rr][i * 8 + 2], xv[rr][i * 8 + 3]); *(float4*)(op + 4) = make_float4(xv[rr][i * 8 + 4], xv[rr][i * 8 + 5], xv[rr][i * 8 + 6], xv[rr][i * 8 + 7]); }
        } else {
            float ss[R];
#pragma unroll
            for (int rr = 0; rr < R; ++rr) {
#pragma unroll
                for (int i = 0; i < 2; ++i) { u32x4 o; o.x = pk2(xv[rr][i * 8], xv[rr][i * 8 + 1]); o.y = pk2(xv[rr][i * 8 + 2], xv[rr][i * 8 + 3]); o.z = pk2(xv[rr][i * 8 + 4], xv[rr][i * 8 + 5]); o.w = pk2(xv[rr][i * 8 + 6], xv[rr][i * 8 + 7]);
                    *(u32x4*)(A.XB + (size_t)(row0 + rr) * DM + i * 512 + lane * 8) = o;
                }
                ss[rr] = 0.f;
#pragma unroll
                for (int j = 0; j < 16; ++j) ss[rr] += xv[rr][j] * xv[rr][j];
            }
#pragma unroll
            for (int o = 1; o < 64; o <<= 1)
#pragma unroll
                for (int rr = 0; rr < R; ++rr) ss[rr] += __shfl_xor(ss[rr], o);
            float r2[R];
#pragma unroll
            for (int rr = 0; rr < R; ++rr) { r2[rr] = rsqrtf(ss[rr] * (1.f / DM) + EPS); if (lane == 0) A.rs[row0 + rr] = r2[rr]; }
            if (DT || ROUTE) {
                float gn[16];
#pragma unroll
                for (int i = 0; i < 2; ++i) { const float4 g0 = *(const float4*)(A.gnext + i * 512 + lane * 8), g1 = *(const float4*)(A.gnext + i * 512 + lane * 8 + 4);
                    gn[i * 8 + 0] = g0.x; gn[i * 8 + 1] = g0.y; gn[i * 8 + 2] = g0.z; gn[i * 8 + 3] = g0.w; gn[i * 8 + 4] = g1.x; gn[i * 8 + 5] = g1.y; gn[i * 8 + 6] = g1.z; gn[i * 8 + 7] = g1.w; }
                int re1[R], re2[R], lr1[R], lr2[R]; float rw1[R], rw2[R];
                volatile LAS int* lcnt = (volatile LAS int*)((LAS unsigned char*)wl + 40960);
                if (ROUTE) { __syncthreads(); if (tidq < 8) lcnt[tidq] = 0; __syncthreads(); }
#pragma unroll
                for (int rr = 0; rr < R; ++rr) {
                    const int row = row0 + rr;
                    float hv[16];
#pragma unroll
                    for (int j = 0; j < 16; ++j) hv[j] = (rr == 0 ? xv[0][j] : xv[R - 1][j]) * (rr == 0 ? r2[0] : r2[R - 1]) * gn[j];
                    if (DT) {
                        float pd[16];
#pragma unroll 4
                        for (int j = 0; j < 16; ++j) {
                            float p = 0.f;
#pragma unroll
                            for (int i = 0; i < 2; ++i) { const LAS float* wp = wl + j * DM + i * 512 + lane * 8;
                                const f32x4 w0 = *(const LAS f32x4*)wp, w1 = *(const LAS f32x4*)(wp + 4);
                                p += hv[i * 8 + 0] * w0[0] + hv[i * 8 + 1] * w0[1] + hv[i * 8 + 2] * w0[2] + hv[i * 8 + 3] * w0[3] + hv[i * 8 + 4] * w1[0] + hv[i * 8 + 5] * w1[1] + hv[i * 8 + 6] * w1[2] + hv[i * 8 + 7] * w1[3]; }
                            pd[j] = p;
                        }
                        const float dk = wave_sum16(pd, lane);
                        if ((lane & 3) == 0) A.dtraw[(size_t)row * 16 + (lane >> 2)] = dk;
                    }
                    if (ROUTE) {
                        float pl[8];
#pragma unroll 4
                        for (int e = 0; e < 8; ++e) {
                            float p = 0.f;
#pragma unroll
                            for (int i = 0; i < 2; ++i) { const LAS float* wp = wl + e * DM + i * 512 + lane * 8;
                                const f32x4 w0 = *(const LAS f32x4*)wp, w1 = *(const LAS f32x4*)(wp + 4);
                                p += hv[i * 8 + 0] * w0[0] + hv[i * 8 + 1] * w0[1] + hv[i * 8 + 2] * w0[2] + hv[i * 8 + 3] * w0[3] + hv[i * 8 + 4] * w1[0] + hv[i * 8 + 5] * w1[1] + hv[i * 8 + 6] * w1[2] + hv[i * 8 + 7] * w1[3]; }
                            pl[e] = p;
                        }
                        const float lk = wave_sum8(pl, lane);
                        float lg[8];
#pragma unroll
                        for (int e = 0; e < 8; ++e) lg[e] = __shfl(lk, e * 8);
                        int e1 = 0; float v1 = lg[0];
#pragma unroll
                        for (int e = 1; e < 8; ++e) if (lg[e] > v1) { v1 = lg[e]; e1 = e; }
                        int e2 = 0; float v2 = -3.0e38f;
#pragma unroll
                        for (int e = 0; e < 8; ++e) if (e != e1 && lg[e] > v2) { v2 = lg[e]; e2 = e; }
                        const float ex = __expf(v2 - v1);
                        re1[rr] = e1; re2[rr] = e2; rw1[rr] = 1.f / (1.f + ex); rw2[rr] = ex / (1.f + ex);
                        if (lane == 0) { lr1[rr] = __hip_atomic_fetch_add((LAS int*)lcnt + e1, 1, __ATOMIC_RELAXED, __HIP_MEMORY_SCOPE_WORKGROUP); lr2[rr] = __hip_atomic_fetch_add((LAS int*)lcnt + e2, 1, __ATOMIC_RELAXED, __HIP_MEMORY_SCOPE_WORKGROUP); }
                    }
                }
                if (ROUTE) {
                    __syncthreads();
                    if (tidq < 8) lcnt[8 + tidq] = (int)atomicAdd(&A.cnt[tidq * 64], (unsigned)lcnt[tidq]);
                    __syncthreads();
#pragma unroll
                    for (int rr = 0; rr < R; ++rr) {
                        const int row = row0 + rr;
                        int dst1 = 0, dst2 = 0;
                        if (lane == 0) {
                            const int e1 = re1[rr], e2 = re2[rr];
                            const int p1 = lcnt[8 + e1] + lr1[rr], p2 = lcnt[8 + e2] + lr2[rr];
                            A.list[e1 * MT + p1] = row * 2; A.gatev[e1 * MT + p1] = rw1[rr]; A.rsl[e1 * MT + p1] = r2[rr];
                            A.list[e2 * MT + p2] = row * 2 + 1; A.gatev[e2 * MT + p2] = rw2[rr]; A.rsl[e2 * MT + p2] = r2[rr];
                            dst1 = e1 * MT + p1; dst2 = e2 * MT + p2;
                        }
                        dst1 = __builtin_amdgcn_readfirstlane(dst1); dst2 = __builtin_amdgcn_readfirstlane(dst2);
#pragma unroll
                        for (int i = 0; i < 2; ++i) { u32x2 o8;
                            const float* xs = xv[rr] + i * 8;
                            o8.x = pg8_pk4(xs[0], xs[1], xs[2], xs[3]); o8.y = pg8_pk4(xs[4], xs[5], xs[6], xs[7]);
                            *(u32x2*)(A.x8 + (size_t)dst1 * DM + i * 512 + lane * 8) = o8; *(u32x2*)(A.x8 + (size_t)dst2 * DM + i * 512 + lane * 8) = o8; }
                    }
                }
            }
        }
    }
}

DEVI void transpose_item(const float* W, int ldw, int K, int k0, int n0, bf16_t* WT, int drow0, LAS float* scr, int lane, const float* gain) {
    {
        const int ka = lane >> 3, n4 = (lane & 7) * 4;
        float4 wv[8];
#pragma unroll
        for (int i = 0; i < 8; ++i) wv[i] = *(const float4*)(W + (size_t)(k0 + i * 8 + ka) * ldw + n0 + n4);
#pragma unroll
        for (int i = 0; i < 8; ++i) { LAS float* d = scr + (i * 8 + ka) * 33 + n4; d[0] = wv[i].x; d[1] = wv[i].y; d[2] = wv[i].z; d[3] = wv[i].w; }
    }
    asm volatile("s_waitcnt lgkmcnt(0)" ::: "memory");
    const int c = lane & 7;
    float4 ga = make_float4(1.f, 1.f, 1.f, 1.f), gb = ga;
    if (gain) { ga = *(const float4*)(gain + k0 + 8 * c); gb = *(const float4*)(gain + k0 + 8 * c + 4); }
#pragma unroll
    for (int j = 0; j < 4; ++j) { const int n = (lane >> 3) + 8 * j; const LAS float* sp = scr + (8 * c) * 33 + n;
        u32x4 o; o.x = pk2(sp[0 * 33] * ga.x, sp[1 * 33] * ga.y); o.y = pk2(sp[2 * 33] * ga.z, sp[3 * 33] * ga.w); o.z = pk2(sp[4 * 33] * gb.x, sp[5 * 33] * gb.y); o.w = pk2(sp[6 * 33] * gb.z, sp[7 * 33] * gb.w);
        *(u32x4*)(WT + (size_t)(drow0 + n) * K + k0 + 8 * c) = o; }
    asm volatile("s_waitcnt lgkmcnt(0)" ::: "memory");
}
DEVI void transpose_item_fp8(const float* W, int ldw, int K, int k0, int n0, unsigned char* WT8, int drow0, LAS float* scr, int lane, const float* gain) {
    {
        const int ka = lane >> 3, n4 = (lane & 7) * 4;
        float4 wv[8];
#pragma unroll
        for (int i = 0; i < 8; ++i) wv[i] = *(const float4*)(W + (size_t)(k0 + i * 8 + ka) * ldw + n0 + n4);
#pragma unroll
        for (int i = 0; i < 8; ++i) { LAS float* d = scr + (i * 8 + ka) * 33 + n4; d[0] = wv[i].x; d[1] = wv[i].y; d[2] = wv[i].z; d[3] = wv[i].w; }
    }
    asm volatile("s_waitcnt lgkmcnt(0)" ::: "memory");
    const int c = lane & 7;
    float4 ga = make_float4(64.f, 64.f, 64.f, 64.f), gb = ga;
    if (gain) { ga = *(const float4*)(gain + k0 + 8 * c); gb = *(const float4*)(gain + k0 + 8 * c + 4); ga.x *= 64.f; ga.y *= 64.f; ga.z *= 64.f; ga.w *= 64.f; gb.x *= 64.f; gb.y *= 64.f; gb.z *= 64.f; gb.w *= 64.f; }
#pragma unroll
    for (int j = 0; j < 4; ++j) { const int n = (lane >> 3) + 8 * j; const LAS float* sp = scr + (8 * c) * 33 + n;
        u32x2 o; o.x = pg8_pk4(sp[0 * 33] * ga.x, sp[1 * 33] * ga.y, sp[2 * 33] * ga.z, sp[3 * 33] * ga.w); o.y = pg8_pk4(sp[4 * 33] * gb.x, sp[5 * 33] * gb.y, sp[6 * 33] * gb.z, sp[7 * 33] * gb.w);
        *(u32x2*)(WT8 + (size_t)(drow0 + n) * K + k0 + 8 * c) = o; }
    asm volatile("s_waitcnt lgkmcnt(0)" ::: "memory");
}
struct Job { int in_idx; unsigned src_off; int ldw; int K; int ncols; unsigned long long dst; int mode; int item0; int gain_idx; int gain_off; int fp8; };
constexpr int NJOBS = 11 + 24;
struct JobTable { Job j[NJOBS]; int total; };
constexpr JobTable make_jobs() {
    JobTable t{}; int n = 0, it = 0;
    auto add = [&](int idx, unsigned off, int ldw, int K, int ncols, unsigned long long dst, int mode, int gi, int go, int f8 = 0) { t.j[n] = Job{idx, off, ldw, K, ncols, dst, mode, it, gi, go, f8}; it += (K / 64) * (ncols / 32); ++n; };
    add(4, 0, EVEN_IN, DM, UW, W_IN, 0, 3, 0);
    add(12, 0, DM, DM, DM, W_OUTE, 0, -1, 0);
    add(15, 0, DFF, DM, DFF, W_GU, 1, 14, 0);
    add(16, 0, DFF, DM, DFF, W_GU, 2, 14, 0);
    add(17, 0, DM, DFF, DM, W_DN, 0, -1, 0);
    add(31, 0, DM, DM, DM, W_PG, 0, 30, 0);
    add(31, DM * DM, DM, DM, DM, W_PG + 2 * MiB, 0, 30, DM);
    add(32, 0, DM, PDIM, DM, W_PP, 0, -1, 0);
    add(32, PDIM * DM, DM, PDIM, DM, W_PP + 512 * 1024, 0, -1, 0);
    add(20, 0, 3072, DM, 3072, W_QKV, 0, 19, 0);
    add(22, 0, DM, DM, DM, W_OUTO, 0, -1, 0);
    for (int e = 0; e < NEXP; ++e) {
        add(26, (unsigned)e * DM * DFFE, DFFE, DM, DFFE, W_EGU + (unsigned long long)e * 7 * MiB, 1, 24, 0, 1);
        add(27, (unsigned)e * DM * DFFE, DFFE, DM, DFFE, W_EGU + (unsigned long long)e * 7 * MiB, 2, 24, 0, 1);
        add(28, (unsigned)e * DFFE * DM, DM, DFFE, DM, W_EDN + (unsigned long long)e * (7 * MiB / 2), 0, -1, 0, 1);
    }
    t.total = it; return t;
}
__device__ const JobTable g_jobs = make_jobs();
constexpr int ITEMS_DENSE = make_jobs().j[11].item0, ITEMS_ALL = make_jobs().total;
DEVI void ph_convert_weights(LAS unsigned char* lds, const float* const* in, unsigned char* ws, int it_lo, int it_hi, int vb0, int vbs) {
    const int tidq = opq((int)threadIdx.x); const int wid = __builtin_amdgcn_readfirstlane(tidq >> 6), lane = tidq & 63;
    LAS float* scr = (LAS float*)(lds + wid * 16384);
    int jb = 0;
    for (int it = it_lo + vb0 * 8 + wid; it < it_hi; it += vbs * 8) {
        while (jb + 1 < NJOBS && g_jobs.j[jb + 1].item0 <= it) ++jb;
        const Job J = g_jobs.j[jb];
        const int r = it - J.item0; const int nblk = J.ncols / 32; const int kb = r / nblk, nb = r % nblk;
        const int n0 = nb * 32; int drow0 = n0;
        if (J.mode != 0) drow0 = (n0 >> 7) * 256 + (n0 & 127) + (J.mode == 2 ? 128 : 0);
        const float* gp = J.gain_idx >= 0 ? in[J.gain_idx] + J.gain_off : nullptr;
        if (J.fp8) transpose_item_fp8(in[J.in_idx] + J.src_off, J.ldw, J.K, kb * 64, n0, ws + J.dst, drow0, scr, lane, gp);
        else transpose_item(in[J.in_idx] + J.src_off, J.ldw, J.K, kb * 64, n0, (bf16_t*)(ws + J.dst), drow0, scr, lane, gp);
    }
}
DEVI void ph_cvt_rows(const float* src, bf16_t* dst, size_t n4, int vb0, int vbs) {
    for (size_t e = (size_t)vb0 * NTHR + opq((int)threadIdx.x); e < n4; e += (size_t)vbs * NTHR) {
        const float4 v = ((const float4*)src)[e]; u32x2 o; o.x = pk2(v.x, v.y); o.y = pk2(v.z, v.w); ((u32x2*)dst)[e] = o; }
}

namespace pg8 {
constexpr int BM = 256, BK = 64, HALF = 128, HTB = HALF * BK * 2, STAGE_BYTES = 8 * HTB, NXCD = 8, WGM = 8;
__host__ __device__ __forceinline__ int lds_byte(int r, int c) { const int st = (r >> 4) * 2 + (c >> 5), rr = r & 15, cc = c & 31, ob = rr * 64 + cc * 2; return st * 1024 + (ob ^ (((ob >> 9) & 1) << 5)); }
__host__ __device__ __forceinline__ void stage_rc(int b, int& R, int& C) { const int st = b / 1024, sb = b % 1024, swz = sb ^ (((sb >> 9) & 1) << 5); R = (st >> 1) * 16 + swz / 64; C = (st & 1) * 32 + (swz % 64) / 2; }
__host__ __device__ __forceinline__ int perm32(int rho) { const int n = rho >> 4, i = rho & 15; return 8 * (i >> 2) + 4 * n + (i & 3); }
struct Unit { int pm, pn; int row0; int arow0; int mvalid; int e; int mbase; int akoff; const char* B; };
DEVI void xcd_tile(int L, int nwg, int nM, int nN, int& pm, int& pn) {
    int wgid = L; { const int q = nwg / NXCD, r = nwg % NXCD, xcd = wgid % NXCD, off = wgid / NXCD; wgid = (xcd < r ? xcd * (q + 1) : r * (q + 1) + (xcd - r) * q) + off; }
    const int nig = WGM * nN, gid = wgid / nig, fm = gid * WGM, gsz = (nM - fm) < WGM ? (nM - fm) : WGM;
    pm = fm + ((wgid % nig) % gsz); pn = (wgid % nig) / gsz;
}
struct DenseOrder {
    int nM, nN, nwg, G, c; const char* Bt; size_t tstepB;
    DEVI void init(int M, int N, int K, const bf16_t* Bt_, int G_, int c_) { nM = M / BM; nN = N / BM; nwg = nM * nN; G = G_; c = c_; Bt = (const char*)Bt_; tstepB = (size_t)BM * K * 2; }
    DEVI bool next(int i, Unit& u) const { const long L = (long)i * G + c; if (L >= nwg) return false; xcd_tile((int)L, nwg, nM, nN, u.pm, u.pn); u.row0 = u.pm * BM; u.arow0 = u.row0; u.mvalid = BM; u.e = 0; u.mbase = 0; u.akoff = 0; u.B = Bt + (size_t)u.pn * tstepB; return true; }
};
struct TailOrder {
    int nM, nN, nwg, nb, r; const char* Bt; size_t tstepB;
    DEVI void init(int M, int N, int K, const bf16_t* Bt_, int G_, int c_, int first) { nM = M / BM; nN = N / BM; nwg = nM * nN; Bt = (const char*)Bt_; tstepB = (size_t)BM * K * 2;
        if (first >= G_) first = 0; nb = G_ - first; r = c_ - first; }
    DEVI bool next(int i, Unit& u) const { if (r < 0) return false; const long L = (long)i * nb + r; if (L >= nwg) return false; u.pm = (int)L / nN; u.pn = (int)L % nN; u.row0 = u.pm * BM; u.arow0 = u.row0; u.mvalid = BM; u.e = 0; u.mbase = 0; u.akoff = 0; u.B = Bt + (size_t)u.pn * tstepB; return true; }
};
struct MoeOrder {
    int nM, nN, nwg, G, c; const char* Bt; size_t estepB, tstepB; const volatile LAS int* tab; bool per_expert;
    DEVI void init(const unsigned* cnt, volatile LAS int* tab_, int N, int K, const bf16_t* Bt_, size_t estep_bytes, bool per_expert_, int G_, int c_) {
        __syncthreads();
        if (threadIdx.x < 8) tab_[16 + threadIdx.x] = (int)__hip_atomic_load(cnt + threadIdx.x * 64, __ATOMIC_RELAXED, __HIP_MEMORY_SCOPE_AGENT);
        __syncthreads();
        if (threadIdx.x == 0) { int t = 0;
            for (int e = 0; e < 8; ++e) { const int n = tab_[16 + e]; tab_[e] = t; t += (n + BM - 1) / BM; }
            tab_[8] = t; }
        __syncthreads();
        tab = tab_; nM = __builtin_amdgcn_readfirstlane(tab_[8]); nN = N / BM; nwg = nM * nN; G = G_; c = c_; Bt = (const char*)Bt_; estepB = estep_bytes; tstepB = (size_t)BM * K * 2; per_expert = per_expert_; nmain = nwg; split_phase = false; khalfB = 0;
    }
    int nmain; bool split_phase; int khalfB;
    DEVI void set_split(bool ksplit, bool phase2, int khalf_bytes) { const int r = nwg % G; const bool can = ksplit && r > 0 && 2 * r <= G; nmain = can ? nwg - r : nwg; split_phase = phase2; khalfB = khalf_bytes; }
    DEVI int tail_first() const { return nmain == nwg ? nwg % G : 2 * (nwg - nmain); }
    DEVI bool next(int i, Unit& u) const {
        long L; int kh = 0;
        if (!split_phase) { L = (long)i * G + c; if (L >= nmain) return false; }
        else { if (i > 0 || c >= 2 * (nwg - nmain)) return false; L = nmain + (c >> 1); kh = c & 1; }
        xcd_tile((int)L, nwg, nM, nN, u.pm, u.pn);
        int e = 0;
        for (int k = 1; k < 8; ++k) if (u.pm >= __builtin_amdgcn_readfirstlane(tab[k])) e = k;
        const int t0 = __builtin_amdgcn_readfirstlane(tab[e]), n = __builtin_amdgcn_readfirstlane(tab[16 + e]);
        u.e = e; u.row0 = u.pm * BM; const int m0 = (u.pm - t0) * BM; u.mbase = m0; u.arow0 = per_expert ? e * MT + m0 : u.row0; u.mvalid = (n - m0) < BM ? (n - m0) : BM;
        u.akoff = kh * khalfB; u.B = Bt + (size_t)e * estepB + (size_t)u.pn * tstepB + u.akoff; return true; }
};
DEVI unsigned cvt_pk_bf16(float lo, float hi) { return cvt2bf(lo, hi); }

constexpr int EPI_OFF = MISC_OFF + 1024, EPI_SLICE = 1024;
static_assert(EPI_OFF + 8 * EPI_SLICE <= LDS_BYTES, "epilogue scalar slices");
DEVI void epi_dma(const void* g, LAS unsigned char* dst) { __builtin_amdgcn_global_load_lds((const unsigned*)g, (LAS unsigned*)dst, 4, 0, 0); }
struct EpiBf16 { static constexpr bool PERM = true; bf16_t* O; int ldc; const float* rs;
    DEVI void pre(LAS unsigned char* esl, const Unit& u, int wr, int lane) const {
        if (rs) { epi_dma(rs + u.row0 + wr * 64 + lane, esl); epi_dma(rs + u.row0 + wr * 64 + HALF + lane, esl + 256); } }
    DEVI void operator()(const f32x4 (&acc)[2][2][4][2], const Unit& u, int wr, int wc, int fr, int fq, const LAS unsigned char* esl) const {
        float pv[8];
#pragma unroll
        for (int q = 0; q < 8; ++q) pv[q] = ((const LAS float*)esl)[(q >> 2) * 64 + (q & 3) * 16 + fr];
        const int row0 = u.row0 + wr * 64 + fr, col0 = u.pn * BM + wc * 32 + 8 * fq;
#pragma unroll
        for (int ai = 0; ai < 2; ++ai)
#pragma unroll
            for (int m = 0; m < 4; ++m) { const int row = row0 + ai * HALF + m * 16; bf16_t* rowp = O + (size_t)row * ldc + col0;
                const float sc = rs ? pv[ai * 4 + m] : 1.f;
#pragma unroll
                for (int bj = 0; bj < 2; ++bj) { const f32x4 v0 = acc[ai][bj][m][0] * sc, v1 = acc[ai][bj][m][1] * sc;
                    u32x4 w; w.x = cvt_pk_bf16(v0[0], v0[1]); w.y = cvt_pk_bf16(v0[2], v0[3]); w.z = cvt_pk_bf16(v1[0], v1[1]); w.w = cvt_pk_bf16(v1[2], v1[3]);
                    *(u32x4*)(rowp + bj * HALF) = w; } }
    } };
struct EpiPleGate { static constexpr bool PERM = true; bf16_t* T; int ldc; const float* rs;
    DEVI void pre(LAS unsigned char* esl, const Unit& u, int wr, int lane) const {
        epi_dma(rs + u.row0 + wr * 64 + lane, esl); epi_dma(rs + u.row0 + wr * 64 + HALF + lane, esl + 256); }
    DEVI void operator()(const f32x4 (&acc)[2][2][4][2], const Unit& u, int wr, int wc, int fr, int fq, const LAS unsigned char* esl) const {
        float pv[8];
#pragma unroll
        for (int q = 0; q < 8; ++q) pv[q] = ((const LAS float*)esl)[(q >> 2) * 64 + (q & 3) * 16 + fr];
        const int row0 = u.row0 + wr * 64 + fr, col0 = u.pn * BM + wc * 32 + 8 * fq;
#pragma unroll
        for (int ai = 0; ai < 2; ++ai)
#pragma unroll
            for (int m = 0; m < 4; ++m) { const int row = row0 + ai * HALF + m * 16; bf16_t* rowp = T + (size_t)row * ldc + col0;
                const float sc = pv[ai * 4 + m];
#pragma unroll
                for (int bj = 0; bj < 2; ++bj) { const f32x4 v0 = acc[ai][bj][m][0] * sc, v1 = acc[ai][bj][m][1] * sc;
                    const u32x4 pp = *(const u32x4*)(rowp + bj * HALF);
                    u32x4 w; w.x = cvt_pk_bf16(sigmoid_f(v0[0]) * bflo(pp.x), sigmoid_f(v0[1]) * bfhi(pp.x)); w.y = cvt_pk_bf16(sigmoid_f(v0[2]) * bflo(pp.y), sigmoid_f(v0[3]) * bfhi(pp.y));
                    w.z = cvt_pk_bf16(sigmoid_f(v1[0]) * bflo(pp.z), sigmoid_f(v1[1]) * bfhi(pp.z)); w.w = cvt_pk_bf16(sigmoid_f(v1[2]) * bflo(pp.w), sigmoid_f(v1[3]) * bfhi(pp.w));
                    *(u32x4*)(rowp + bj * HALF) = w; } }
    } };
struct EpiSwiglu { static constexpr bool PERM = true; bf16_t* O; int ldc; const float* rs; int grouped;
    DEVI void pre(LAS unsigned char* esl, const Unit& u, int wr, int lane) const {
        const float* rsb = grouped ? rs + u.e * MT + u.mbase : rs + u.row0; const int vm1 = (grouped ? u.mvalid : BM) - 1;
#pragma unroll
        for (int i = 0; i < 2; ++i) { const int rl = wr * 64 + lane + i * HALF; epi_dma(rsb + (rl <= vm1 ? rl : vm1), esl + i * 256); } }
    DEVI void operator()(const f32x4 (&acc)[2][2][4][2], const Unit& u, int wr, int wc, int fr, int fq, const LAS unsigned char* esl) const {
        float pv[8];
#pragma unroll
        for (int q = 0; q < 8; ++q) pv[q] = ((const LAS float*)esl)[(q >> 2) * 64 + (q & 3) * 16 + fr];
        const int row0 = u.row0 + wr * 64 + fr, col0 = u.pn * HALF + wc * 32 + 8 * fq; const int vm1e = (grouped ? u.mvalid : BM) - 1;
#pragma unroll
        for (int ai = 0; ai < 2; ++ai)
#pragma unroll
            for (int m = 0; m < 4; ++m) { const int rl = wr * 64 + fr + ai * HALF + m * 16; bf16_t* rowp = O + (size_t)(u.row0 + rl) * ldc + col0;
                const float sc = rl <= vm1e ? pv[ai * 4 + m] : 0.f;
                const f32x4 g0 = acc[ai][0][m][0] * sc, g1 = acc[ai][0][m][1] * sc, u0 = acc[ai][1][m][0] * sc, u1 = acc[ai][1][m][1] * sc;
                u32x4 w; w.x = cvt_pk_bf16(silu_f(g0[0]) * u0[0], silu_f(g0[1]) * u0[1]); w.y = cvt_pk_bf16(silu_f(g0[2]) * u0[2], silu_f(g0[3]) * u0[3]);
                w.z = cvt_pk_bf16(silu_f(g1[0]) * u1[0], silu_f(g1[1]) * u1[1]); w.w = cvt_pk_bf16(silu_f(g1[2]) * u1[2], silu_f(g1[3]) * u1[3]);
                *(u32x4*)rowp = w; }
    } };
constexpr float W8_SCALE = 64.f, ACT8_SCALE = 8.f;
struct EpiSwiglu8 { static constexpr bool PERM = true; unsigned char* O; int ldc; const float* rs;
    DEVI void pre(LAS unsigned char* esl, const Unit& u, int wr, int lane) const {
        const float* rsb = rs + u.e * MT + u.mbase; const int vm1 = u.mvalid - 1;
#pragma unroll
        for (int i = 0; i < 2; ++i) { const int rl = wr * 64 + lane + i * HALF; epi_dma(rsb + (rl <= vm1 ? rl : vm1), esl + i * 256); } }
    DEVI void operator()(const f32x4 (&acc)[2][2][4][2], const Unit& u, int wr, int wc, int fr, int fq, const LAS unsigned char* esl) const {
        float pv[8];
#pragma unroll
        for (int q = 0; q < 8; ++q) pv[q] = ((const LAS float*)esl)[(q >> 2) * 64 + (q & 3) * 16 + fr];
        const int col0 = u.pn * HALF + wc * 32 + 8 * fq;
#pragma unroll
        for (int ai = 0; ai < 2; ++ai)
#pragma unroll
            for (int m = 0; m < 4; ++m) { const int rl = wr * 64 + fr + ai * HALF + m * 16; unsigned char* rowp = O + (size_t)(u.row0 + rl) * ldc + col0;
                const float sc = rl < u.mvalid ? pv[ai * 4 + m] * (1.f / W8_SCALE) : 0.f;
                const f32x4 g0 = acc[ai][0][m][0] * sc, g1 = acc[ai][0][m][1] * sc, u0 = acc[ai][1][m][0] * (sc * ACT8_SCALE), u1 = acc[ai][1][m][1] * (sc * ACT8_SCALE);
                u32x2 w; w.x = pg8_pk4(silu_f(g0[0]) * u0[0], silu_f(g0[1]) * u0[1], silu_f(g0[2]) * u0[2], silu_f(g0[3]) * u0[3]);
                w.y = pg8_pk4(silu_f(g1[0]) * u1[0], silu_f(g1[1]) * u1[1], silu_f(g1[2]) * u1[2], silu_f(g1[3]) * u1[3]);
                *(u32x2*)rowp = w; }
    } };
struct EpiMoeDown { static constexpr bool PERM = true; bf16_t* Y; const int* list; const float* gatev; float oscale; size_t y2off; unsigned char* flag;
    DEVI void pre(LAS unsigned char* esl, const Unit& u, int wr, int lane) const {
        const int* lb = list + u.e * MT + u.mbase; const float* gb = gatev + u.e * MT + u.mbase; const int vm1 = u.mvalid - 1;
#pragma unroll
        for (int i = 0; i < 2; ++i) { const int rl = wr * 64 + lane + i * HALF; const int ri = rl <= vm1 ? rl : vm1; epi_dma(gb + ri, esl + i * 256); epi_dma(lb + ri, esl + 512 + i * 256); } }
    DEVI void operator()(const f32x4 (&acc)[2][2][4][2], const Unit& u, int wr, int wc, int fr, int fq, const LAS unsigned char* esl) const {
        float pv[8]; int pt[8];
#pragma unroll
        for (int q = 0; q < 8; ++q) { pv[q] = ((const LAS float*)esl)[(q >> 2) * 64 + (q & 3) * 16 + fr]; pt[q] = ((const LAS int*)(esl + 512))[(q >> 2) * 64 + (q & 3) * 16 + fr]; }
        const int col0 = u.pn * BM + wc * 32 + 8 * fq;
        const bool second = u.akoff != 0; bf16_t* const Yb = Y + (second ? y2off : (size_t)0);
#pragma unroll
        for (int ai = 0; ai < 2; ++ai)
#pragma unroll
            for (int m = 0; m < 4; ++m) { const int rl = wr * 64 + fr + ai * HALF + m * 16;
                const int tsl = pt[ai * 4 + m]; const float gt = pv[ai * 4 + m] * oscale;
                if (rl < u.mvalid) {
                    bf16_t* rowp = Yb + (size_t)(tsl & 1) * ((size_t)MT * DM) + (size_t)(tsl >> 1) * DM + col0;
                    if (second && wc == 0 && fq == 0) flag[tsl * 4 + u.pn] = 1;
#pragma unroll
                    for (int bj = 0; bj < 2; ++bj) { const f32x4 v0 = acc[ai][bj][m][0], v1 = acc[ai][bj][m][1];
                        u32x4 w; w.x = cvt_pk_bf16(v0[0] * gt, v0[1] * gt); w.y = cvt_pk_bf16(v0[2] * gt, v0[3] * gt); w.z = cvt_pk_bf16(v1[0] * gt, v1[1] * gt); w.w = cvt_pk_bf16(v1[2] * gt, v1[3] * gt);
                        *(u32x4*)(rowp + bj * HALF) = w; } } }
    } };

typedef int v8i __attribute__((ext_vector_type(8)));
typedef int v4i __attribute__((ext_vector_type(4)));
DEVI v8i cat8(const bf16x8 lo, const bf16x8 hi) { const v4i a = __builtin_bit_cast(v4i, lo), b = __builtin_bit_cast(v4i, hi); return __builtin_shufflevector(a, b, 0, 1, 2, 3, 4, 5, 6, 7); }
struct Frag16 { bf16x8 k[2]; };
struct Frag8 { v8i v; };
template <bool F> struct FragSel { typedef Frag16 T; };
template <> struct FragSel<true> { typedef Frag8 T; };
template <class Epi, class Sched, bool FP8 = false>
DEVI void gemm_phase(LAS unsigned char* lds, const bf16_t* A, const int K, const Sched& S, const Epi& E, const int Kloop = 0) {
    const int tid = opq((int)threadIdx.x), wid = __builtin_amdgcn_readfirstlane(tid >> 6), lane = tid & 63, wr = wid >> 2, wc = wid & 3, fr = lane & 15, fq = lane >> 4;
    const int nt = (Kloop ? Kloop : K) / BK;
    unsigned voffA[2], voffB[2];
#pragma unroll
    for (int i = 0; i < 2; ++i) { int R, C; stage_rc(tid * 16 + i * 8192, R, C); const int Rb = Epi::PERM ? ((R & ~31) + perm32(R & 31)) : R;
        voffA[i] = (unsigned)(R * K + C) * 2u; voffB[i] = (unsigned)(Rb * K + C) * 2u; }
    const size_t kstep = (size_t)(BK * 2);
    const size_t hstep = (size_t)HALF * K * 2;
    const size_t rstep = (size_t)K * 2;
    const unsigned ldsw = (unsigned)wid * 1024u;
    const int aoff = lds_byte(wr * 64 + fr, fq * 8), boff = lds_byte(wc * 32 + fr, fq * 8);
#define PG8_SA(b, h) (((b) * 2 + (h)) * HTB)
#define PG8_SB(b, h) ((4 + (b) * 2 + (h)) * HTB)
#define PG8_STAGE(bufoff, gbase, voff) do { _Pragma("unroll") for (int _i = 0; _i < 2; ++_i) \
        __builtin_amdgcn_global_load_lds((const unsigned*)((const char*)(gbase) + (voff)[_i]), (LAS unsigned*)(lds + (bufoff) + ldsw + _i * 8192), 16, 0, 0); } while (0)
#define PG8_LDA(dst, b, h) do { _Pragma("unroll") for (int m = 0; m < 4; ++m) { if constexpr (FP8) dst[m].v = cat8(*(const LAS bf16x8*)(lds + PG8_SA(b, h) + aoff + m * 2048), *(const LAS bf16x8*)(lds + PG8_SA(b, h) + aoff + m * 2048 + 1024)); \
        else { _Pragma("unroll") for (int k = 0; k < 2; ++k) dst[m].k[k] = *(const LAS bf16x8*)(lds + PG8_SA(b, h) + aoff + m * 2048 + k * 1024); } } } while (0)
#define PG8_LDB(dst, b, h) do { _Pragma("unroll") for (int n = 0; n < 2; ++n) { if constexpr (FP8) dst[n].v = cat8(*(const LAS bf16x8*)(lds + PG8_SB(b, h) + boff + n * 2048), *(const LAS bf16x8*)(lds + PG8_SB(b, h) + boff + n * 2048 + 1024)); \
        else { _Pragma("unroll") for (int k = 0; k < 2; ++k) dst[n].k[k] = *(const LAS bf16x8*)(lds + PG8_SB(b, h) + boff + n * 2048 + k * 1024); } } } while (0)
#define PG8_MMA(ai, bj, At, Bt) do { __builtin_amdgcn_s_setprio(1); _Pragma("unroll") for (int m = 0; m < 4; ++m) _Pragma("unroll") for (int n = 0; n < 2; ++n) { \
        if constexpr (FP8) asm volatile("s_nop 1\n\tv_mfma_scale_f32_16x16x128_f8f6f4 %0, %1, %2, %0, %3, %3 op_sel_hi:[0,0,0]" : "+v"(acc[ai][bj][m][n]) : "v"(Bt[n].v), "v"(At[m].v), "v"(sc1)); \
        else { _Pragma("unroll") for (int k = 0; k < 2; ++k) acc[ai][bj][m][n] = __builtin_amdgcn_mfma_f32_16x16x32_bf16(Bt[n].k[k], At[m].k[k], acc[ai][bj][m][n], 0, 0, 0); } } \
        __builtin_amdgcn_s_setprio(0); } while (0)
#define PG8_WAIT_V(n) asm volatile("s_waitcnt vmcnt(" #n ")" ::: "memory")
#define PG8_WAIT_L(n) asm volatile("s_waitcnt lgkmcnt(" #n ")" ::: "memory")
#define PG8_BAR __builtin_amdgcn_s_barrier()
#define PG8_SCHED __builtin_amdgcn_sched_barrier(0)
    Unit cur, nxt; int ui = 0;
    if (!S.next(0, cur)) return;
    int sc1 = 0x7F7F7F7F; asm volatile("" : "+v"(sc1));
    f32x4 acc[2][2][4][2];
#pragma unroll
    for (int a = 0; a < 2; ++a)
#pragma unroll
        for (int b = 0; b < 2; ++b)
#pragma unroll
            for (int m = 0; m < 4; ++m)
#pragma unroll
                for (int n = 0; n < 2; ++n) acc[a][b][m][n] = (f32x4){0.f, 0.f, 0.f, 0.f};
    typename FragSel<FP8>::T At[4], B0[2], B1[2];
    const char* cA = (const char*)A + (size_t)cur.arow0 * rstep + cur.akoff;
    const char* cB = cur.B;
    LAS unsigned char* const esl = lds + EPI_OFF + wid * EPI_SLICE;
    E.pre(esl, cur, wr, lane);
    PG8_STAGE(PG8_SB(0, 0), cB, voffB); PG8_STAGE(PG8_SA(0, 0), cA, voffA); PG8_STAGE(PG8_SB(0, 1), cB + hstep, voffB); PG8_STAGE(PG8_SA(0, 1), cA + hstep, voffA);
    if (wr == 1) PG8_BAR;
    PG8_WAIT_V(4); PG8_BAR;
    PG8_STAGE(PG8_SB(1, 0), cB + kstep, voffB); PG8_STAGE(PG8_SA(1, 0), cA + kstep, voffA); PG8_STAGE(PG8_SB(1, 1), cB + hstep + kstep, voffB);
    PG8_WAIT_V(6); PG8_BAR;
    for (;;) {
        const bool has_next = S.next(ui + 1, nxt);
        const char* nA = has_next ? (const char*)A + (size_t)nxt.arow0 * rstep + nxt.akoff : cA; const char* nB = has_next ? nxt.B : cB;
#pragma unroll 1
        for (int t = 0; t < nt; t += 2) {
            const bool last = (t == nt - 2);
            const char* a1 = cA + (size_t)(t + 1) * kstep;
            const char* a2 = last ? nA : cA + (size_t)(t + 2) * kstep; const char* b2 = last ? nB : cB + (size_t)(t + 2) * kstep;
            const char* a3 = a2 + kstep; const char* b3 = b2 + kstep;
            PG8_LDB(B0, 0, 0); PG8_SCHED; PG8_LDA(At, 0, 0); PG8_STAGE(PG8_SA(1, 1), a1 + hstep, voffA);
            PG8_WAIT_L(8); PG8_BAR; PG8_WAIT_L(0); PG8_MMA(0, 0, At, B0); PG8_BAR; PG8_SCHED;
            PG8_LDB(B1, 0, 1); PG8_STAGE(PG8_SB(0, 0), b2, voffB);
            PG8_BAR; PG8_WAIT_L(0); PG8_MMA(0, 1, At, B1); PG8_BAR;
            PG8_LDA(At, 0, 1); PG8_STAGE(PG8_SA(0, 0), a2, voffA);
            PG8_BAR; PG8_WAIT_L(0); PG8_MMA(1, 0, At, B0); PG8_BAR; PG8_SCHED;
            PG8_STAGE(PG8_SB(0, 1), b2 + hstep, voffB);
            PG8_WAIT_V(6); PG8_BAR; PG8_MMA(1, 1, At, B1); PG8_BAR;
            PG8_LDB(B0, 1, 0); PG8_SCHED; PG8_LDA(At, 1, 0); PG8_STAGE(PG8_SA(0, 1), a2 + hstep, voffA);
            PG8_WAIT_L(8); PG8_BAR; PG8_WAIT_L(0); PG8_MMA(0, 0, At, B0); PG8_BAR; PG8_SCHED;
            PG8_LDB(B1, 1, 1); PG8_STAGE(PG8_SB(1, 0), b3, voffB);
            PG8_BAR; PG8_WAIT_L(0); PG8_MMA(0, 1, At, B1); PG8_BAR;
            PG8_LDA(At, 1, 1); PG8_STAGE(PG8_SA(1, 0), a3, voffA);
            PG8_BAR; PG8_WAIT_L(0); PG8_MMA(1, 0, At, B0); PG8_BAR; PG8_SCHED;
            PG8_STAGE(PG8_SB(1, 1), b3 + hstep, voffB);
            PG8_WAIT_V(6); PG8_BAR; PG8_MMA(1, 1, At, B1); PG8_BAR;
        }
        if constexpr (FP8) asm volatile("s_nop 15\n\ts_nop 15" ::: "memory");
        E(acc, cur, wr, wc, fr, fq, esl);
        if (!has_next) break;
#pragma unroll
        for (int a = 0; a < 2; ++a)
#pragma unroll
            for (int b = 0; b < 2; ++b)
#pragma unroll
                for (int m = 0; m < 4; ++m)
#pragma unroll
                    for (int n = 0; n < 2; ++n) acc[a][b][m][n] = (f32x4){0.f, 0.f, 0.f, 0.f};
        cur = nxt; cA = nA; cB = nB; ++ui;
        E.pre(esl, cur, wr, lane);
        if constexpr (FP8) asm volatile("s_nop 7" ::: "memory");
    }
    PG8_WAIT_V(0);
    if (wr == 0) PG8_BAR;
    PG8_BAR;
#undef PG8_SA
#undef PG8_SB
#undef PG8_STAGE
#undef PG8_LDA
#undef PG8_LDB
#undef PG8_MMA
#undef PG8_WAIT_V
#undef PG8_WAIT_L
#undef PG8_BAR
#undef PG8_SCHED
}
}

DEVI float lb_of(const float* lbraw, int ch) {
    const float r0 = lbraw[ch], r1 = lbraw[512 + ch], r2 = lbraw[1024 + ch];
    const float mx = fmaxf(r0, fmaxf(r1, r2));
    const float e0 = __expf(r0 - mx), e1 = __expf(r1 - mx), e2 = __expf(r2 - mx);
    return e0 / (e0 + e1 + e2);
}
constexpr int HQ = 0, HK = 17408, HKH = 34816, HV = 53248, HDV = 71680, HZERO = 73728, HOT = 75776, H_END = HOT + 64 * 528;
static_assert(H_END <= 131072, "hgrn lds");
constexpr size_t HS_SCAN = (size_t)16 * 16384;
struct HgrnRaw { unsigned qf[16]; u32x4 v0, v1; };
DEVI void hgrn_load(HgrnRaw& R, const bf16_t* u, const bf16_t* VT, int dir, int b, int h, int t0, int c, int I, int tid) {
    const bf16_t* up = u + ((size_t)b * SEQ + t0 + 16 * I) * UW + h * 128 + c;
    const int fcol = dir ? 1024 : 512;
#pragma unroll
    for (int j = 0; j < 16; ++j) R.qf[j] = (unsigned)up[(size_t)j * UW] | ((unsigned)up[(size_t)j * UW + fcol] << 16);
    { const int e = tid, r = e >> 3, cch = e & 7; R.v0 = *(const u32x4*)(VT + ((size_t)b * 512 + h * 128 + r) * SEQ + t0 + cch * 8); }
    { const int e = tid + NTHR, r = e >> 3, cch = e & 7; R.v1 = *(const u32x4*)(VT + ((size_t)b * 512 + h * 128 + r) * SEQ + t0 + cch * 8); }
}
DEVI void hgrn_prep(LAS unsigned char* lds, const HgrnRaw& R, float lbv, int dir, int c, int I, int tid) {
    float ff[16], kk[16], qq[16];
    { const int e = tid, r = e >> 3, cch = e & 7; *(LAS u32x4*)(lds + HV + r * 144 + cch * 16) = R.v0; }
    { const int e = tid + NTHR, r = e >> 3, cch = e & 7; *(LAS u32x4*)(lds + HV + r * 144 + cch * 16) = R.v1; }
#pragma unroll
    for (int j = 0; j < 16; ++j) {
        const float fr = bfhi(R.qf[j]), qr = bflo(R.qf[j]);
        const float f = lbv + (1.f - lbv) * sigmoid_f(fr);
        ff[j] = f; kk[j] = 1.f - f; qq[j] = silu_f(qr);
    }
    float run = 1.f;
#pragma unroll
    for (int jj = 0; jj < 16; ++jj) { const int j = dir ? 15 - jj : jj; run = fmaxf(run * ff[j], 1e-30f); ff[j] = run; }
    const float PG = run;
    float kh[16];
#pragma unroll
    for (int j = 0; j < 16; ++j) {
        const float kt = kk[j] * __builtin_amdgcn_rcpf(ff[j]);
        kh[j] = kt * PG;
        *(LAS bf16_t*)(lds + HQ + (16 * I + j) * 272 + c * 2) = f2bf(qq[j] * ff[j]);
        *(LAS bf16_t*)(lds + HK + (16 * I + j) * 272 + c * 2) = f2bf(kt);
    }
    u32x4 w0, w1;
    w0.x = pk2(kh[0], kh[1]); w0.y = pk2(kh[2], kh[3]); w0.z = pk2(kh[4], kh[5]); w0.w = pk2(kh[6], kh[7]);
    w1.x = pk2(kh[8], kh[9]); w1.y = pk2(kh[10], kh[11]); w1.z = pk2(kh[12], kh[13]); w1.w = pk2(kh[14], kh[15]);
    *(LAS u32x4*)(lds + HKH + c * 144 + I * 32) = w0; *(LAS u32x4*)(lds + HKH + c * 144 + I * 32 + 16) = w1;
    *(LAS float*)(lds + HDV + (I * 128 + c) * 4) = PG;
}
DEVI void hgrn_update(LAS unsigned char* lds, f32x4 (&Sacc)[8], int I, int wid, int fr, int fq) {
    const int voff = (fq < 2) ? HV + (16 * wid + fr) * 144 + (16 * I + 8 * fq) * 2 : HZERO;
    const int koff = (fq < 2) ? HKH + fr * 144 + (16 * I + 8 * fq) * 2 : HZERO;
    const int kstep = (fq < 2) ? 16 * 144 : 0;
    const bf16x8 vb = *(const LAS bf16x8*)(lds + voff);
    bf16x8 ka[8]; f32x4 dv[8];
#pragma unroll
    for (int m = 0; m < 8; ++m) { ka[m] = *(const LAS bf16x8*)(lds + koff + m * kstep); dv[m] = *(const LAS f32x4*)(lds + HDV + (I * 128 + 16 * m + 4 * fq) * 4); }
#pragma unroll
    for (int m = 0; m < 8; ++m) Sacc[m] = __builtin_amdgcn_mfma_f32_16x16x32_bf16(ka[m], vb, Sacc[m] * dv[m], 0, 0, 0);
}
DEVI void ph_hgrn_states(LAS unsigned char* lds, const bf16_t* u, const bf16_t* VT, const float* lbraw, bf16_t* HS, float* HD, int vb0, int vbs) {
    const int tid = opq((int)threadIdx.x), wid = __builtin_amdgcn_readfirstlane(tid >> 6), lane = tid & 63, fr = lane & 15, fq = lane >> 4;
    const int pc = tid & 127, pI = tid >> 7;
    for (int unit = vb0; unit < NB * 4 * 2 * 16; unit += vbs) {
        const int seg = unit & 15, dir = (unit >> 4) & 1, h = (unit >> 5) & 3, b = unit >> 7;
        const float lbv = lb_of(lbraw, h * 128 + pc);
        f32x4 Sacc[8];
#pragma unroll
        for (int m = 0; m < 8; ++m) Sacc[m] = (f32x4){0.f, 0.f, 0.f, 0.f};
        float gprod = 1.f;
        if (tid < 4) *(LAS unsigned*)(lds + HZERO + tid * 4) = 0u;
        HgrnRaw R; hgrn_load(R, u, VT, dir, b, h, seg * 256 + (dir ? 3 : 0) * 64, pc, pI, tid);
#pragma unroll 1
        for (int sbi = 0; sbi < 4; ++sbi) {
            const int sb = dir ? 3 - sbi : sbi;
            const int t0 = seg * 256 + sb * 64;
            __syncthreads();
            hgrn_prep(lds, R, lbv, dir, pc, pI, tid);
            if (sbi < 3) { const int sbn = dir ? 3 - (sbi + 1) : sbi + 1; hgrn_load(R, u, VT, dir, b, h, seg * 256 + sbn * 64, pc, pI, tid); }
            __syncthreads();
            if (tid < 128) gprod *= (*(const LAS float*)(lds + HDV + tid * 4) * *(const LAS float*)(lds + HDV + (128 + tid) * 4)) * (*(const LAS float*)(lds + HDV + (256 + tid) * 4) * *(const LAS float*)(lds + HDV + (384 + tid) * 4));
#pragma unroll 1
            for (int ii = 0; ii < 4; ++ii) { const int I = dir ? 3 - ii : ii; hgrn_update(lds, Sacc, I, wid, fr, fq); }
        }
        const size_t scan = (size_t)(b * 4 + h) * 2 + dir;
        bf16_t* dst = HS + scan * HS_SCAN + (size_t)seg * 16384;
#pragma unroll
        for (int m = 0; m < 8; ++m) { u32x2 w; w.x = pk2(Sacc[m][0], Sacc[m][1]); w.y = pk2(Sacc[m][2], Sacc[m][3]);
            *(u32x2*)(dst + (16 * wid + fr) * 128 + 16 * m + 4 * fq) = w; }
        if (tid < 128) HD[(scan * 16 + seg) * 128 + tid] = gprod;
    }
    __syncthreads();
}
DEVI void ph_hgrn_scan(bf16_t* HS, const float* HD, int vb0, int vbs) {
    const int tid = opq((int)threadIdx.x);
    for (int idx = vb0 * NTHR + tid; idx < 32 * 4096; idx += vbs * NTHR) {
        const int scan = idx >> 12, e4 = idx & 4095, k4 = (e4 & 31) * 4; const int dir = scan & 1;
        u32x2* base = (u32x2*)(HS + (size_t)scan * HS_SCAN) + e4;
        const float* hd = HD + (size_t)scan * 16 * 128 + k4;
        u32x2 d[16]; float4 dec[16];
#pragma unroll
        for (int i = 0; i < 16; ++i) { d[i] = base[(size_t)i * 4096]; dec[i] = *(const float4*)(hd + i * 128); }
        float s0 = 0.f, s1 = 0.f, s2 = 0.f, s3 = 0.f;
#define HSCAN_STEP(i) { const float t0 = bflo(d[i].x), t1 = bfhi(d[i].x), t2 = bflo(d[i].y), t3 = bfhi(d[i].y); d[i].x = pk2(s0, s1); d[i].y = pk2(s2, s3); \
            s0 = s0 * dec[i].x + t0; s1 = s1 * dec[i].y + t1; s2 = s2 * dec[i].z + t2; s3 = s3 * dec[i].w + t3; }
        if (dir == 0) {
#pragma unroll
            for (int i = 0; i < 16; ++i) HSCAN_STEP(i)
        } else {
#pragma unroll
            for (int i = 15; i >= 0; --i) HSCAN_STEP(i)
        }
#undef HSCAN_STEP
#pragma unroll
        for (int i = 0; i < 16; ++i) base[(size_t)i * 4096] = d[i];
    }
}
DEVI void ph_hgrn_out(LAS unsigned char* lds, const bf16_t* u, const bf16_t* VT, const float* lbraw, const float* a_norm, const bf16_t* HS, float* OF, bf16_t* ocat, int vb0, int vbs) {
    const int tid = opq((int)threadIdx.x), wid = __builtin_amdgcn_readfirstlane(tid >> 6), lane = tid & 63, fr = lane & 15, fq = lane >> 4;
    const int pc = tid & 127, pI = tid >> 7;
    const int otok = tid >> 3, opart = tid & 7;
    for (int unit = vb0; unit < NB * 4 * 16; unit += vbs) {
        const int seg = unit & 15, h = (unit >> 4) & 3, b = unit >> 6;
        const float lbv = lb_of(lbraw, h * 128 + pc);
        if (tid < 4) *(LAS unsigned*)(lds + HZERO + tid * 4) = 0u;
#pragma unroll 1
        for (int dir = 0; dir < 2; ++dir) {
            const size_t scan = (size_t)(b * 4 + h) * 2 + dir;
            const bf16_t* src = HS + scan * HS_SCAN + (size_t)seg * 16384;
            f32x4 Sacc[8];
#pragma unroll
            for (int m = 0; m < 8; ++m) { const u32x2 w = *(const u32x2*)(src + (16 * wid + fr) * 128 + 16 * m + 4 * fq);
                Sacc[m][0] = bflo(w.x); Sacc[m][1] = bfhi(w.x); Sacc[m][2] = bflo(w.y); Sacc[m][3] = bfhi(w.y); }
            HgrnRaw R; hgrn_load(R, u, VT, dir, b, h, seg * 256 + (dir ? 3 : 0) * 64, pc, pI, tid);
#pragma unroll 1
            for (int sbi = 0; sbi < 4; ++sbi) {
                const int sb = dir ? 3 - sbi : sbi;
                const int t0 = seg * 256 + sb * 64;
                const size_t tokb = (size_t)b * SEQ + t0;
                __syncthreads();
                hgrn_prep(lds, R, lbv, dir, pc, pI, tid);
                if (sbi < 3) { const int sbn = dir ? 3 - (sbi + 1) : sbi + 1; hgrn_load(R, u, VT, dir, b, h, seg * 256 + sbn * 64, pc, pI, tid); }
                __syncthreads();
#pragma unroll 1
                for (int ii = 0; ii < 4; ++ii) {
                    const int I = dir ? 3 - ii : ii;
                    f32x4 oT = {0.f, 0.f, 0.f, 0.f};
                    const LAS unsigned char* qrow = lds + HQ + (16 * I + fr) * 272;
#pragma unroll
                    for (int ks = 0; ks < 4; ++ks) {
                        u32x4 sa; sa.x = pg8::cvt_pk_bf16(Sacc[2 * ks][0], Sacc[2 * ks][1]); sa.y = pg8::cvt_pk_bf16(Sacc[2 * ks][2], Sacc[2 * ks][3]);
                        sa.z = pg8::cvt_pk_bf16(Sacc[2 * ks + 1][0], Sacc[2 * ks + 1][1]); sa.w = pg8::cvt_pk_bf16(Sacc[2 * ks + 1][2], Sacc[2 * ks + 1][3]);
                        const u32x2 q0 = *(const LAS u32x2*)(qrow + (32 * ks + 4 * fq) * 2), q1 = *(const LAS u32x2*)(qrow + (32 * ks + 16 + 4 * fq) * 2);
                        u32x4 qb; qb.x = q0.x; qb.y = q0.y; qb.z = q1.x; qb.w = q1.y;
                        oT = __builtin_amdgcn_mfma_f32_16x16x32_bf16(__builtin_bit_cast(bf16x8, sa), __builtin_bit_cast(bf16x8, qb), oT, 0, 0, 0);
                    }
                    f32x4 sT = {0.f, 0.f, 0.f, 0.f};
                    const LAS unsigned char* krow = lds + HK + (16 * I + fr) * 272;
#pragma unroll
                    for (int ks = 0; ks < 4; ++ks) {
                        const bf16x8 ka = *(const LAS bf16x8*)(krow + (32 * ks + 8 * fq) * 2), qb = *(const LAS bf16x8*)(qrow + (32 * ks + 8 * fq) * 2);
                        sT = __builtin_amdgcn_mfma_f32_16x16x32_bf16(ka, qb, sT, 0, 0, 0);
                    }
                    float pv[4];
#pragma unroll
                    for (int rg = 0; rg < 4; ++rg) { const int sl = 4 * fq + rg; const bool ok = dir ? (sl >= fr) : (sl <= fr); pv[rg] = ok ? sT[rg] : 0.f; }
                    u32x4 pb; pb.x = pg8::cvt_pk_bf16(pv[0], pv[1]); pb.y = pg8::cvt_pk_bf16(pv[2], pv[3]); pb.z = 0u; pb.w = 0u;
                    const u32x2 v0 = *(const LAS u32x2*)(lds + HV + (16 * wid + fr) * 144 + (16 * I + 4 * fq) * 2);
                    u32x4 va; va.x = v0.x; va.y = v0.y; va.z = 0u; va.w = 0u;
                    oT = __builtin_amdgcn_mfma_f32_16x16x32_bf16(__builtin_bit_cast(bf16x8, va), __builtin_bit_cast(bf16x8, pb), oT, 0, 0, 0);
                    if (dir == 0) *(f32x4*)(OF + (tokb + 16 * I + fr) * 512 + h * 128 + 16 * wid + 4 * fq) = oT;
                    else *(LAS f32x4*)(lds + HOT + (16 * I + fr) * 528 + (16 * wid + 4 * fq) * 4) = oT;
                    hgrn_update(lds, Sacc, I, wid, fr, fq);
                }
                if (dir == 1) {
                    __syncthreads();
                    const LAS float* orow = (const LAS float*)(lds + HOT + otok * 528) + opart * 16;
                    float* ofp = OF + (tokb + otok) * 512 + h * 128 + opart * 16;
                    float v[16]; float ss = 0.f;
#pragma unroll
                    for (int q2 = 0; q2 < 8; ++q2) { const unsigned long long w = __hip_atomic_load((unsigned long long*)(ofp + q2 * 2), __ATOMIC_RELAXED, __HIP_MEMORY_SCOPE_AGENT);
                        v[2 * q2] = __uint_as_float((unsigned)w) + orow[2 * q2]; v[2 * q2 + 1] = __uint_as_float((unsigned)(w >> 32)) + orow[2 * q2 + 1];
                        ss += v[2 * q2] * v[2 * q2] + v[2 * q2 + 1] * v[2 * q2 + 1]; }
                    ss += __shfl_xor(ss, 1); ss += __shfl_xor(ss, 2); ss += __shfl_xor(ss, 4);
                    const float rn = rsqrtf(ss * (1.f / 128.f) + EPS);
                    const bf16_t* gp = u + (tokb + otok) * UW + 2048 + h * 128 + opart * 16;
                    const u32x4 g0 = *(const u32x4*)gp, g1 = *(const u32x4*)(gp + 8);
                    const unsigned gw[8] = {g0.x, g0.y, g0.z, g0.w, g1.x, g1.y, g1.z, g1.w};
                    unsigned ow[8];
#pragma unroll
                    for (int q2 = 0; q2 < 8; ++q2) { const float an0 = a_norm[opart * 16 + 2 * q2], an1 = a_norm[opart * 16 + 2 * q2 + 1];
                        ow[q2] = pk2(v[2 * q2] * rn * an0 * silu_f(bflo(gw[q2])), v[2 * q2 + 1] * rn * an1 * silu_f(bfhi(gw[q2]))); }
                    bf16_t* op = ocat + (tokb + otok) * DM + h * 128 + opart * 16;
                    u32x4 o0, o1; o0.x = ow[0]; o0.y = ow[1]; o0.z = ow[2]; o0.w = ow[3]; o1.x = ow[4]; o1.y = ow[5]; o1.z = ow[6]; o1.w = ow[7];
                    *(u32x4*)op = o0; *(u32x4*)(op + 8) = o1;
                }
            }
            asm volatile("s_waitcnt vmcnt(0)" ::: "memory");
        }
    }
    __syncthreads();
}

DEVI void ph_prep(const bf16_t* u, const float* cw, const float* cb, bf16_t* xconv, bf16_t* XT, bf16_t* VT, int vb0, int vbs) {
    const int tid = opq((int)threadIdx.x);
    for (int unit = vb0; unit < NB * 32 * 3; unit += vbs) {
        const int cg = unit % 3, tb = (unit / 3) & 31, b = unit / 96;
        const int t0 = tb * 128;
        if (cg < 2) {
            const int ch = cg * 512 + tid;
            float w[5];
#pragma unroll
            for (int j = 0; j < 5; ++j) w[j] = cw[j * 1024 + ch];
            const float bias = cb[ch];
            const bf16_t* up = u + (size_t)b * SEQ * UW + 3072 + ch;
            float v0, v1, v2, v3;
            v0 = (t0 - 2 >= 0) ? bf2f(up[(size_t)(t0 - 2) * UW]) : 0.f;
            v1 = (t0 - 1 >= 0) ? bf2f(up[(size_t)(t0 - 1) * UW]) : 0.f;
            v2 = bf2f(up[(size_t)t0 * UW]);
            v3 = bf2f(up[(size_t)(t0 + 1) * UW]);
            for (int t8 = 0; t8 < 128; t8 += 32) {
                float nx[32];
#pragma unroll
                for (int i = 0; i < 32; ++i) { const int tt = t0 + t8 + i + 2; nx[i] = (tt < SEQ) ? bf2f(up[(size_t)tt * UW]) : 0.f; }
                unsigned pk[16];
#pragma unroll
                for (int i = 0; i < 32; ++i) {
                    const float o = silu_f(bias + w[0] * v0 + w[1] * v1 + w[2] * v2 + w[3] * v3 + w[4] * nx[i]);
                    const bf16_t ob = f2bf(o);
                    xconv[(size_t)(b * SEQ + t0 + t8 + i) * 1024 + ch] = ob;
                    if (i & 1) pk[i >> 1] |= ((unsigned)ob << 16); else pk[i >> 1] = ob;
                    v0 = v1; v1 = v2; v2 = v3; v3 = nx[i];
                }
                if (ch < 768) {
#pragma unroll
                    for (int q = 0; q < 4; ++q) { u32x4 o4; o4.x = pk[4 * q]; o4.y = pk[4 * q + 1]; o4.z = pk[4 * q + 2]; o4.w = pk[4 * q + 3]; *(u32x4*)(XT + ((size_t)b * 768 + ch) * SEQ + t0 + t8 + 8 * q) = o4; } }
            }
        } else {
            const int ch = tid;
            const bf16_t* up = u + (size_t)b * SEQ * UW + 1536 + ch;
            for (int t8 = 0; t8 < 128; t8 += 32) {
                unsigned pk[16];
#pragma unroll
                for (int i = 0; i < 32; ++i) { const unsigned ob = up[(size_t)(t0 + t8 + i) * UW]; if (i & 1) pk[i >> 1] |= (ob << 16); else pk[i >> 1] = ob; }
#pragma unroll
                for (int q = 0; q < 4; ++q) { u32x4 o4; o4.x = pk[4 * q]; o4.y = pk[4 * q + 1]; o4.z = pk[4 * q + 2]; o4.w = pk[4 * q + 3]; *(u32x4*)(VT + ((size_t)b * 512 + ch) * SEQ + t0 + t8 + 8 * q) = o4; }
            }
        }
    }
}

constexpr int MB_XT = 0, MB_BX = 256 * 272, MB_DT = MB_BX + 128 * 272, MB_CS = MB_DT + 8 * 128 * 4, MB_TOT = MB_CS + 8 * 128 * 4, MB_END = MB_TOT + 64;
static_assert(MB_END <= 131072, "mamba lds");
constexpr size_t MS_SCAN = (size_t)32 * 8192;
DEVI bf16x8 pack8(const float* v) { u32x4 w; w.x = pg8::cvt_pk_bf16(v[0], v[1]); w.y = pg8::cvt_pk_bf16(v[2], v[3]); w.z = pg8::cvt_pk_bf16(v[4], v[5]); w.w = pg8::cvt_pk_bf16(v[6], v[7]); return __builtin_bit_cast(bf16x8, w); }
DEVI void mamba_tables(LAS unsigned char* lds, const float* dtraw, const float* A_log, const float* dt_bias, int b, int g, int c, int wid, int lane) {
    LAS float* tdt = (LAS float*)(lds + MB_DT); LAS float* tcs = (LAS float*)(lds + MB_CS); LAS float* ttot = (LAS float*)(lds + MB_TOT);
    const int r = wid >> 1, dir = wid & 1, hd = 4 * g + r;
    const float A = -__expf(A_log[dir * 8 + hd]), bias = dt_bias[dir * 8 + hd];
    const size_t tk = (size_t)b * SEQ + c * 128 + 2 * lane;
    const float dt0 = softplus_f(dtraw[tk * 16 + dir * 8 + hd] + bias), dt1 = softplus_f(dtraw[(tk + 1) * 16 + dir * 8 + hd] + bias);
    const float a0 = dt0 * A, a1 = dt1 * A;
    float sc = a0 + a1;
#pragma unroll
    for (int off = 1; off < 64; off <<= 1) { const float v = __shfl_up(sc, off); if (lane >= off) sc += v; }
    const float total = __shfl(sc, 63);
    const float pre0 = sc - a1, pre1 = sc;
    const float c0 = dir ? (total - pre0 + a0) : pre0, c1 = dir ? (total - pre1 + a1) : pre1;
    tdt[wid * 128 + 2 * lane] = dt0; tdt[wid * 128 + 2 * lane + 1] = dt1;
    tcs[wid * 128 + 2 * lane] = c0; tcs[wid * 128 + 2 * lane + 1] = c1;
    if (lane == 0) ttot[wid] = total;
}
DEVI void stage_rows(LAS unsigned char* dst, const bf16_t* src, size_t src_stride, int rows, int tid) {
    for (int e = tid; e < rows * 16; e += NTHR) { const int r = e >> 4, cch = e & 15; *(LAS u32x4*)(dst + r * 272 + cch * 16) = *(const u32x4*)(src + (size_t)r * src_stride + cch * 8); }
}
DEVI void ph_mamba_states(LAS unsigned char* lds, const bf16_t* XT, const float* dtraw, const float* A_log, const float* dt_bias, bf16_t* MS, float* MD, int vb0, int vbs) {
    const int tid = opq((int)threadIdx.x), wid = __builtin_amdgcn_readfirstlane(tid >> 6), lane = tid & 63, fr = lane & 15, fq = lane >> 4;
    LAS float* tdt = (LAS float*)(lds + MB_DT); LAS float* tcs = (LAS float*)(lds + MB_CS); LAS float* ttot = (LAS float*)(lds + MB_TOT);
    for (int unit = vb0; unit < NB * 2 * 32; unit += vbs) {
        const int c = unit & 31, g = (unit >> 5) & 1, b = unit >> 6;
        __syncthreads();
        stage_rows(lds + MB_XT, XT + ((size_t)b * 768 + g * 256) * SEQ + c * 128, SEQ, 256, tid);
        stage_rows(lds + MB_BX, XT + ((size_t)b * 768 + 512 + g * 128) * SEQ + c * 128, SEQ, 128, tid);
        mamba_tables(lds, dtraw, A_log, dt_bias, b, g, c, wid, lane);
        __syncthreads();
        if (lane == 0) MD[((size_t)(b * 8 + 4 * g + (wid >> 1)) * 2 + (wid & 1)) * 32 + c] = __expf(ttot[wid]);
        for (int hdd = 0; hdd < 8; ++hdd) {
            const int r = hdd >> 1, dir = hdd & 1, hd = 4 * g + r;
            const float tot = ttot[hdd];
            f32x4 acc[4];
#pragma unroll
            for (int pt = 0; pt < 4; ++pt) acc[pt] = (f32x4){0.f, 0.f, 0.f, 0.f};
#pragma unroll
            for (int ks = 0; ks < 4; ++ks) {
                const int s0 = 32 * ks + 8 * fq;
                const u32x4 braw = *(const LAS u32x4*)(lds + MB_BX + (16 * wid + fr) * 272 + s0 * 2);
                float bw[8];
                const unsigned bu[4] = {braw.x, braw.y, braw.z, braw.w};
#pragma unroll
                for (int j = 0; j < 8; ++j) { const float bv = (j & 1) ? bfhi(bu[j >> 1]) : bflo(bu[j >> 1]);
                    bw[j] = bv * tdt[hdd * 128 + s0 + j] * __expf(tot - tcs[hdd * 128 + s0 + j]); }
                const bf16x8 Bf = pack8(bw);
#pragma unroll
                for (int pt = 0; pt < 4; ++pt) {
                    const bf16x8 Af = *(const LAS bf16x8*)(lds + MB_XT + (r * 64 + 16 * pt + fr) * 272 + s0 * 2);
                    acc[pt] = __builtin_amdgcn_mfma_f32_16x16x32_bf16(Bf, Af, acc[pt], 0, 0, 0);
                }
            }
            bf16_t* dst = MS + ((size_t)(b * 8 + hd) * 2 + dir) * MS_SCAN + (size_t)c * 8192;
#pragma unroll
            for (int pt = 0; pt < 4; ++pt) { u32x2 w; w.x = pk2(acc[pt][0], acc[pt][1]); w.y = pk2(acc[pt][2], acc[pt][3]);
                *(u32x2*)(dst + (16 * pt + fr) * 128 + 16 * wid + 4 * fq) = w; }
        }
    }
    __syncthreads();
}
DEVI void ph_mamba_scan(bf16_t* MS, const float* MD, int vb0, int vbs) {
    const int tid = opq((int)threadIdx.x);
    for (int idx = vb0 * NTHR + tid; idx < 64 * 2048; idx += vbs * NTHR) {
        const int scan = idx >> 11, e4 = idx & 2047; const int dir = scan & 1;
        u32x2* base = (u32x2*)(MS + (size_t)scan * MS_SCAN) + e4;
        const float* md = MD + (size_t)scan * 32;
        float h0 = 0.f, h1 = 0.f, h2 = 0.f, h3 = 0.f;
#pragma unroll 1
        for (int half = 0; half < 2; ++half) {
            const int c0 = (dir ? 1 - half : half) * 16;
            u32x2 d[16]; float dec[16];
#pragma unroll
            for (int i = 0; i < 16; ++i) { d[i] = base[(size_t)(c0 + i) * 2048]; dec[i] = md[c0 + i]; }
#define MSCAN_STEP(i) { const float t0 = bflo(d[i].x), t1 = bfhi(d[i].x), t2 = bflo(d[i].y), t3 = bfhi(d[i].y); d[i].x = pk2(h0, h1); d[i].y = pk2(h2, h3); \
                h0 = h0 * dec[i] + t0; h1 = h1 * dec[i] + t1; h2 = h2 * dec[i] + t2; h3 = h3 * dec[i] + t3; }
            if (dir == 0) {
#pragma unroll
                for (int i = 0; i < 16; ++i) MSCAN_STEP(i)
            } else {
#pragma unroll
                for (int i = 15; i >= 0; --i) MSCAN_STEP(i)
            }
#undef MSCAN_STEP
#pragma unroll
            for (int i = 0; i < 16; ++i) base[(size_t)(c0 + i) * 2048] = d[i];
        }
    }
}
DEVI void ph_mamba_out(LAS unsigned char* lds, const bf16_t* u, const bf16_t* xconv, const bf16_t* XT, const float* dtraw, const float* A_log, const float* dt_bias, const float* Dskip, const float* b_norm,
                       const bf16_t* MS, bf16_t* ocat, int vb0, int vbs) {
    const int tid = opq((int)threadIdx.x), wid = __builtin_amdgcn_readfirstlane(tid >> 6), lane = tid & 63, fr = lane & 15, fq = lane >> 4;
    LAS float* tdt = (LAS float*)(lds + MB_DT); LAS float* tcs = (LAS float*)(lds + MB_CS);
    for (int unit = vb0; unit < NB * 2 * 32; unit += vbs) {
        const int c = unit & 31, g = (unit >> 5) & 1, b = unit >> 6;
        const size_t tok0 = (size_t)b * SEQ + c * 128;
        __syncthreads();
        stage_rows(lds + MB_XT, XT + ((size_t)b * 768 + g * 256) * SEQ + c * 128, SEQ, 256, tid);
        stage_rows(lds + MB_BX, xconv + tok0 * 1024 + 512 + g * 128, 1024, 128, tid);
        mamba_tables(lds, dtraw, A_log, dt_bias, b, g, c, wid, lane);
        const int tl = 16 * wid + fr;
        bf16x8 Cf[4];
#pragma unroll
        for (int ks = 0; ks < 4; ++ks) Cf[ks] = *(const bf16x8*)(xconv + (tok0 + tl) * 1024 + 768 + g * 128 + 32 * ks + 8 * fq);
        __syncthreads();
        f32x4 GT[8];
#pragma unroll
        for (int st = 0; st < 8; ++st) { GT[st] = (f32x4){0.f, 0.f, 0.f, 0.f};
            bf16x8 Af[4];
#pragma unroll
            for (int ks = 0; ks < 4; ++ks) Af[ks] = *(const LAS bf16x8*)(lds + MB_BX + (16 * st + fr) * 272 + (32 * ks + 8 * fq) * 2);
#pragma unroll
            for (int ks = 0; ks < 4; ++ks) GT[st] = __builtin_amdgcn_mfma_f32_16x16x32_bf16(Af[ks], Cf[ks], GT[st], 0, 0, 0); }
        float ss = 0.f;
        __syncthreads();
        u32x2 hpre[4];
        { const bf16_t* hin0 = MS + ((size_t)(b * 8 + 4 * g) * 2) * MS_SCAN + (size_t)c * 8192;
#pragma unroll
          for (int q = 0; q < 4; ++q) hpre[q] = ((const u32x2*)hin0)[tid + q * NTHR]; }
#pragma unroll 1
        for (int r = 0; r < 4; ++r) {
            const int hd = 4 * g + r;
            f32x4 yv[4];
#pragma unroll
            for (int pt = 0; pt < 4; ++pt) yv[pt] = (f32x4){0.f, 0.f, 0.f, 0.f};
#pragma unroll 1
            for (int dir = 0; dir < 2; ++dir) {
                const int hdd = r * 2 + dir;
                const float cst = tcs[hdd * 128 + tl];
                LAS unsigned char* hbuf = lds + MB_BX + (hdd & 1) * 17408;
#pragma unroll
                for (int q = 0; q < 4; ++q) { const int e4 = tid + q * NTHR, pp = e4 >> 5, n4 = (e4 & 31) * 4;
                    *(LAS u32x2*)(hbuf + pp * 272 + n4 * 2) = hpre[q]; }
                if (hdd < 7) { const int hn = hdd + 1; const bf16_t* hinn = MS + ((size_t)(b * 8 + 4 * g + (hn >> 1)) * 2 + (hn & 1)) * MS_SCAN + (size_t)c * 8192;
#pragma unroll
                    for (int q = 0; q < 4; ++q) hpre[q] = ((const u32x2*)hinn)[tid + q * NTHR]; }
                __syncthreads();
                f32x4 yo[4];
#pragma unroll
                for (int pt = 0; pt < 4; ++pt) { yo[pt] = (f32x4){0.f, 0.f, 0.f, 0.f};
                    bf16x8 hf[4];
#pragma unroll
                    for (int ks = 0; ks < 4; ++ks) hf[ks] = *(const LAS bf16x8*)(hbuf + (16 * pt + fr) * 272 + (32 * ks + 8 * fq) * 2);
#pragma unroll
                    for (int ks = 0; ks < 4; ++ks) yo[pt] = __builtin_amdgcn_mfma_f32_16x16x32_bf16(hf[ks], Cf[ks], yo[pt], 0, 0, 0); }
                const float eo = __expf(cst);
#pragma unroll
                for (int pt = 0; pt < 4; ++pt) yv[pt] += yo[pt] * eo;
#pragma unroll
                for (int kp = 0; kp < 4; ++kp) {
                    const bool skip = dir ? (2 * kp + 1 < wid) : (2 * kp > wid);
                    if (!skip) {
                        float pv[8];
#pragma unroll
                        for (int hlf = 0; hlf < 2; ++hlf) { const int st = 2 * kp + hlf;
                            const f32x4 cs4 = *(const LAS f32x4*)(tcs + hdd * 128 + 16 * st + 4 * fq), dt4 = *(const LAS f32x4*)(tdt + hdd * 128 + 16 * st + 4 * fq);
#pragma unroll
                            for (int rg = 0; rg < 4; ++rg) { const int sl = 16 * st + 4 * fq + rg;
                                const bool ok = dir ? (sl >= tl) : (sl <= tl);
                                const float e = __expf(fminf(cst - cs4[rg], 0.f));
                                pv[hlf * 4 + rg] = ok ? GT[st][rg] * e * dt4[rg] : 0.f; } }
                        u32x2 x0[4], x1[4];
#pragma unroll
                        for (int pt = 0; pt < 4; ++pt) { const LAS unsigned char* xr = lds + MB_XT + (r * 64 + 16 * pt + fr) * 272;
                            x0[pt] = *(const LAS u32x2*)(xr + (32 * kp + 4 * fq) * 2); x1[pt] = *(const LAS u32x2*)(xr + (32 * kp + 16 + 4 * fq) * 2); }
                        const bf16x8 Pf = pack8(pv);
#pragma unroll
                        for (int pt = 0; pt < 4; ++pt) {
                            u32x4 xa; xa.x = x0[pt].x; xa.y = x0[pt].y; xa.z = x1[pt].x; xa.w = x1[pt].y;
                            yv[pt] = __builtin_amdgcn_mfma_f32_16x16x32_bf16(__builtin_bit_cast(bf16x8, xa), Pf, yv[pt], 0, 0, 0);
                        }
                    }
                }
            }
            const float Dk = Dskip[hd];
#pragma unroll
            for (int pt = 0; pt < 4; ++pt) {
                const int p0 = 16 * pt + 4 * fq;
                const u32x2 xr = *(const u32x2*)(xconv + (tok0 + tl) * 1024 + hd * 64 + p0);
                const u32x2 zr = *(const u32x2*)(u + (tok0 + tl) * UW + 2560 + hd * 64 + p0);
                const float xs[4] = {bflo(xr.x), bfhi(xr.x), bflo(xr.y), bfhi(xr.y)}, zs[4] = {bflo(zr.x), bfhi(zr.x), bflo(zr.y), bfhi(zr.y)};
                float yy[4];
#pragma unroll
                for (int rg = 0; rg < 4; ++rg) { const float y = (yv[pt][rg] + Dk * xs[rg]) * silu_f(zs[rg]); yy[rg] = y; ss += y * y; }
                const unsigned long long o = (unsigned long long)pk2(yy[0], yy[1]) | ((unsigned long long)pk2(yy[2], yy[3]) << 32);
                __hip_atomic_store((unsigned long long*)(ocat + (tok0 + tl) * DM + 512 + g * 256 + r * 64 + p0), o, __ATOMIC_RELAXED, __HIP_MEMORY_SCOPE_AGENT);
            }
        }
        ss += __shfl_xor(ss, 16); ss += __shfl_xor(ss, 32);
        const float rn = rsqrtf(ss * (1.f / 256.f) + EPS);
        asm volatile("s_waitcnt vmcnt(0)" ::: "memory");
        unsigned long long pk[16];
#pragma unroll
        for (int q = 0; q < 16; ++q) pk[q] = __hip_atomic_load((unsigned long long*)(ocat + (tok0 + tl) * DM + 512 + g * 256 + (q >> 2) * 64 + 16 * (q & 3) + 4 * fq), __ATOMIC_RELAXED, __HIP_MEMORY_SCOPE_AGENT);
#pragma unroll
        for (int r = 0; r < 4; ++r)
#pragma unroll
            for (int pt = 0; pt < 4; ++pt) {
                const int cc = g * 256 + r * 64 + 16 * pt + 4 * fq;
                unsigned long long* op = (unsigned long long*)(ocat + (tok0 + tl) * DM + 512 + cc);
                const unsigned long long v = pk[r * 4 + pt];
                const unsigned vlo = (unsigned)v, vhi = (unsigned)(v >> 32);
                const float4 bn = *(const float4*)(b_norm + cc);
                const unsigned long long o = (unsigned long long)pk2(bflo(vlo) * rn * bn.x, bfhi(vlo) * rn * bn.y) | ((unsigned long long)pk2(bflo(vhi) * rn * bn.z, bfhi(vhi) * rn * bn.w) << 32);
                *op = o;
            }
    }
    __syncthreads();
}


constexpr int NA_RING = 12, NA_VT = 0, NA_VSTRIDE = NA_RING * 64 * 2 + 16, NA_BIAS = 64 * NA_VSTRIDE, NA_END = NA_BIAS + 480 * 4;
static_assert(NA_END <= 131072, "na lds");
DEVI void ph_na(LAS unsigned char* lds, const bf16_t* qkv, const float* rpb, bf16_t* oc, int vb0, int vbs) {
    const int tid = opq((int)threadIdx.x), wid = __builtin_amdgcn_readfirstlane(tid >> 6), lane = tid & 63, fr = lane & 15, fq = lane >> 4;
    LAS float* bl = (LAS float*)(lds + NA_BIAS);
    for (int chunk = vb0; chunk < NB * 16 * 4; chunk += vbs) {
        const int qr4 = chunk & 3, h = (chunk >> 2) & 15, b = chunk >> 6;
        __syncthreads();
        for (int e = tid; e < 465; e += NTHR) bl[e] = rpb[h * 465 + e];
        int staged_hi = -1;
#pragma unroll 1
        for (int ui = 0; ui < 8; ++ui) {
            const int rp = qr4 * 8 + ui;
            const int r0 = 2 * rp, rs0 = min(max(r0 - 4, 0), 56);
            const int need_hi = min(rs0 + 8, 63);
            const int lo = max(staged_hi + 1, rs0);
            for (int task = wid; task < (need_hi - lo + 1) * 8; task += 8) {
                const int kr = lo + (task >> 3), ch = task & 7, slot = kr % NA_RING;
                const u32x4 v = *(const u32x4*)(qkv + ((size_t)b * SEQ + kr * 64 + lane) * 3072 + 2048 + h * 64 + ch * 8);
                const unsigned vw[4] = {v.x, v.y, v.z, v.w};
#pragma unroll
                for (int i = 0; i < 8; ++i) *(LAS bf16_t*)(lds + NA_VT + (ch * 8 + i) * NA_VSTRIDE + (slot * 64 + lane) * 2) = (bf16_t)((i & 1) ? (vw[i >> 1] >> 16) : (vw[i >> 1] & 0xffffu));
            }
            staged_hi = need_hi > staged_hi ? need_hi : staged_hi;
            __syncthreads();
            const int r = r0 + (wid >> 2), j = wid & 3;
            const int rs = min(max(r - 4, 0), 56);
            const int bs = (j == 0) ? 0 : (j == 1) ? 8 : (j == 2) ? 24 : 32;
            const int c = 16 * j + fr, qs = min(max(c - 8, 0), 48);
            const size_t qtok = (size_t)b * SEQ + r * 64 + c;
            bf16x8 Qf[2];
#pragma unroll
            for (int ks = 0; ks < 2; ++ks) Qf[ks] = *(const bf16x8*)(qkv + qtok * 3072 + h * 64 + 32 * ks + 8 * fq);
            const bf16_t* kbase = qkv + ((size_t)b * SEQ + rs * 64 + bs + fr) * 3072 + 1024 + h * 64 + 8 * fq;
            bf16x8 kn[4];
#pragma unroll
            for (int q = 0; q < 4; ++q) kn[q] = *(const bf16x8*)(kbase + (size_t)((q >> 1) * 16) * 3072 + (q & 1) * 32);
            f32x4 O[4];
#pragma unroll
            for (int dt = 0; dt < 4; ++dt) O[dt] = (f32x4){0.f, 0.f, 0.f, 0.f};
            float mrun = -1e30f, lrun = 0.f;
#pragma unroll 1
            for (int dr = 0; dr < 8; ++dr) {
                bf16x8 kc[4];
#pragma unroll
                for (int q = 0; q < 4; ++q) kc[q] = kn[q];
                const int drn = dr < 7 ? dr + 1 : 7;
#pragma unroll
                for (int q = 0; q < 4; ++q) kn[q] = *(const bf16x8*)(kbase + ((size_t)drn * 64 + (q >> 1) * 16) * 3072 + (q & 1) * 32);
                float sv[8]; float mloc = -1e30f;
                const LAS float* brow = bl + (rs + dr - r + 7) * 31;
#pragma unroll
                for (int kg = 0; kg < 2; ++kg) {
                    f32x4 acc = {0.f, 0.f, 0.f, 0.f};
                    acc = __builtin_amdgcn_mfma_f32_16x16x32_bf16(kc[kg * 2], Qf[0], acc, 0, 0, 0);
                    acc = __builtin_amdgcn_mfma_f32_16x16x32_bf16(kc[kg * 2 + 1], Qf[1], acc, 0, 0, 0);
#pragma unroll
                    for (int rg = 0; rg < 4; ++rg) {
                        const int kcol = bs + 16 * kg + 4 * fq + rg;
                        const bool ok = (kcol >= qs) && (kcol < qs + 16);
                        const int dc = min(max(kcol - c + 15, 0), 30);
                        const float sc = ok ? acc[rg] * 0.125f + brow[dc] : -1e30f;
                        sv[kg * 4 + rg] = sc; mloc = fmaxf(mloc, sc);
                    }
                }
                mloc = fmaxf(mloc, __shfl_xor(mloc, 16)); mloc = fmaxf(mloc, __shfl_xor(mloc, 32));
                const float mnew = fmaxf(mrun, mloc);
                const float alpha = __expf(mrun - mnew);
                float psum = 0.f;
#pragma unroll
                for (int i = 0; i < 8; ++i) { const float p = __expf(sv[i] - mnew); sv[i] = p; psum += p; }
                psum += __shfl_xor(psum, 16); psum += __shfl_xor(psum, 32);
                lrun = lrun * alpha + psum; mrun = mnew;
                const bf16x8 Pf = pack8(sv);
                const int koff = (((rs + dr) % NA_RING) * 64 + bs + 4 * fq) * 2;
#pragma unroll
                for (int dt = 0; dt < 4; ++dt) {
                    const LAS unsigned char* vr = lds + NA_VT + (16 * dt + fr) * NA_VSTRIDE + koff;
                    const u32x2 v0 = *(const LAS u32x2*)vr, v1 = *(const LAS u32x2*)(vr + 32);
                    u32x4 va; va.x = v0.x; va.y = v0.y; va.z = v1.x; va.w = v1.y;
                    O[dt] = __builtin_amdgcn_mfma_f32_16x16x32_bf16(__builtin_bit_cast(bf16x8, va), Pf, O[dt] * alpha, 0, 0, 0);
                }
            }
            const float il = 1.f / lrun;
#pragma unroll
            for (int dt = 0; dt < 4; ++dt) {
                u32x2 o; o.x = pk2(O[dt][0] * il, O[dt][1] * il); o.y = pk2(O[dt][2] * il, O[dt][3] * il);
                *(u32x2*)(oc + qtok * DM + h * 64 + 16 * dt + 4 * fq) = o;
            }
        }
    }
    __syncthreads();
}

#define XB_TMO      128
#define XB_XCNT(j)  (256  + 64 * (j))
#define XB_XSUB(j)  (1280 + 64 * (j))
#define XB_XGEN(j)  (2304 + 64 * (j))
#define XB_TOP      3328
#define XB_TOPGEN   3392
#define XCD_BAR_WORDS 3456
#define XB_SPIN_CAP (1u << 18)

__device__ __forceinline__ unsigned xb_ld(unsigned* p)              { return __hip_atomic_load(p, __ATOMIC_RELAXED, __HIP_MEMORY_SCOPE_AGENT); }
__device__ __forceinline__ unsigned xb_add(unsigned* p, unsigned v) { return __hip_atomic_fetch_add(p, v, __ATOMIC_RELAXED, __HIP_MEMORY_SCOPE_AGENT); }
__device__ __forceinline__ unsigned xb_xcc_id() { return (unsigned)__builtin_amdgcn_s_getreg((3 << 11) | 20) & 0xFu; }
#define XB_SPIN(cond, bar) do { unsigned _sp = 0; while (cond) { __builtin_amdgcn_s_sleep(1); \
    if ((++_sp & 255u) == 0u) { if (xb_ld(&(bar)[XB_TMO])) break; if (_sp > XB_SPIN_CAP) { atomicAdd(&(bar)[XB_TMO], 1u); break; } } } } while (0)

struct XcdBarrier {
    unsigned* bar; unsigned x;
    volatile LAS unsigned* st;
};

__device__ __forceinline__ XcdBarrier xcd_barrier_post(unsigned* bar, volatile LAS unsigned* st) {
    XcdBarrier b; b.bar = bar; b.x = xb_xcc_id(); b.st = st;
    if (threadIdx.x == 0) (void)xb_add(&bar[XB_XCNT(b.x)], 1u);
    return b;
}
__device__ __forceinline__ void xcd_barrier_complete(unsigned* bar, unsigned x, unsigned& nloc, unsigned& nx) {
    const unsigned G = gridDim.x * gridDim.y * gridDim.z;
    unsigned sum, cnt, mine, sp = 0u;
    for (;;) {
        sum = 0u; cnt = 0u; mine = 0u;
#pragma unroll
        for (unsigned j = 0; j < 16; ++j) { const unsigned c = xb_ld(&bar[XB_XCNT(j)]); sum += c; cnt += (c > 0u) ? 1u : 0u; mine = (j == x) ? c : mine; }
        if (sum == G) break;
        __builtin_amdgcn_s_sleep(1);
        if ((++sp & 255u) == 0u) { if (xb_ld(&bar[XB_TMO])) break; if (sp > XB_SPIN_CAP) { atomicAdd(&bar[XB_TMO], 1u); break; } }
    }
    nloc = mine > 0u ? mine : 1u; nx = cnt > 0u ? cnt : 1u;
}

__device__ __forceinline__ void xcd_barrier(const XcdBarrier& b) {
    asm volatile("s_waitcnt vmcnt(0)" ::: "memory");
    __syncthreads();
    if (threadIdx.x == 0) {
        unsigned* bar = b.bar;
        __builtin_amdgcn_s_waitcnt(0);
        unsigned nloc = b.st[0], nx = b.st[1];
        if (nloc == 0u) { xcd_barrier_complete(bar, b.x, nloc, nx); b.st[0] = nloc; b.st[1] = nx; }
        const unsigned old = xb_add(&bar[XB_XSUB(b.x)], 1u);
        const unsigned gen = old / nloc;
        if (old + 1u == (gen + 1u) * nloc) {
            __builtin_amdgcn_fence(__ATOMIC_RELEASE, "agent");
            asm volatile("s_waitcnt vmcnt(0)" ::: "memory");
            const unsigned og = xb_add(&bar[XB_TOP], 1u);
            const unsigned tg = og / nx;
            if (og + 1u == (tg + 1u) * nx) xb_add(&bar[XB_TOPGEN], 1u);
            else XB_SPIN(xb_ld(&bar[XB_TOPGEN]) == tg, bar);
            __builtin_amdgcn_fence(__ATOMIC_ACQUIRE, "agent");
            xb_add(&bar[XB_XGEN(b.x)], 1u);
            asm volatile("s_waitcnt vmcnt(0)" ::: "memory");
        } else {
            XB_SPIN(xb_ld(&bar[XB_XGEN(b.x)]) == gen, bar);
            __builtin_amdgcn_fence(__ATOMIC_ACQUIRE, "agent");
            asm volatile("s_waitcnt vmcnt(0)" ::: "memory");
        }
    }
    __syncthreads();
}


struct Args { const float* in[34]; float* out; unsigned char* ws; int ph_lo, ph_hi; };
constexpr int N_PHASES = 22;

__global__ void __launch_bounds__(NTHR, 2) fwd(Args a) {
    extern __shared__ __attribute__((aligned(16))) unsigned char lds_raw[];
    float* lds = (float*)lds_raw;
    LAS unsigned char* ldsl = (LAS unsigned char*)lds_raw;
    const int vb0 = blockIdx.x, vbs = gridDim.x;
    const int lo = a.ph_lo, hi = a.ph_hi;
#define IN(k) (lo <= (k) && (k) < hi)
#define SEAM(k) do { if (IN(k) && IN((k) + 1)) xcd_barrier(bar); } while (0)
    volatile LAS unsigned* misc = (volatile LAS unsigned*)(ldsl + MISC_OFF);
    if (threadIdx.x < 4) misc[threadIdx.x] = 0u;
    __syncthreads();
    XcdBarrier bar = xcd_barrier_post((unsigned*)(a.ws + WS_CTL) + CW_BAR, misc);
    unsigned char* ws = a.ws;
    unsigned* ctl = (unsigned*)(ws + WS_CTL);
    unsigned* cnt = ctl + CW_CNT;
    int* list = (int*)(ws + WS_LIST); float* gatev = (float*)(ws + WS_GATE);
    float* dtraw = (float*)(ws + WS_DT); float* RS = (float*)(ws + WS_RS);
    bf16_t* XB = (bf16_t*)(ws + WS_XB); bf16_t* UB = (bf16_t*)(ws + WS_UB);
    bf16_t* YA = (bf16_t*)(ws + WS_YA); float* OF = (float*)(ws + WS_OF); bf16_t* OC = (bf16_t*)(ws + WS_OC);
    bf16_t* YP = (bf16_t*)(ws + WS_YP); bf16_t* YP1 = (bf16_t*)(ws + WS_YP1); bf16_t* XC = (bf16_t*)(ws + WS_YP);
    bf16_t* PB0 = (bf16_t*)(ws + WS_PB0); bf16_t* PB1 = (bf16_t*)(ws + WS_PB1);
    bf16_t* YB = (bf16_t*)(ws + WS_Y);
    bf16_t* Y2 = (bf16_t*)(ws + WS_Y2); unsigned char* yflag = ws + WS_YFLAG;
    bf16_t* MS = (bf16_t*)(ws + WS_MS); float* MD = (float*)(ws + WS_MD);
    bf16_t* HS = (bf16_t*)(ws + WS_HS); float* HD = (float*)(ws + WS_HD);
    bf16_t* XT = (bf16_t*)(ws + WS_XT); bf16_t* VT = (bf16_t*)(ws + WS_VT);
    const float* p_in = a.in[1];
    const int G = (int)gridDim.x, cb = (int)blockIdx.x;
    const NormB NB0{nullptr, XB, nullptr, nullptr, RS, nullptr, nullptr, nullptr, nullptr, nullptr, nullptr, nullptr, nullptr, nullptr, nullptr};
    unsigned char* XG8 = ws + WS_XG8;
    float* rsl = (float*)(ws + WS_DT);

    if (IN(0)) {
        ph_convert_weights(ldsl, a.in, ws, 0, ITEMS_DENSE, vb0, vbs);
        NormB A = NB0; A.xin = a.in[0]; A.gnext = a.in[3]; A.win = a.in[4]; A.dtraw = dtraw;
        ph_norm2<0, false, true, false>(A, vb0, vbs, (LAS float*)ldsl);
    }
    SEAM(0);
    if (IN(1)) { pg8::DenseOrder S; S.init(MT, UW, DM, (const bf16_t*)(ws + W_IN), G, cb); pg8::gemm_phase(ldsl, XB, DM, S, pg8::EpiBf16{UB, UW, RS}); }
    SEAM(1);
    if (IN(2)) { ph_prep(UB, a.in[5], a.in[6], XC, XT, VT, vb0, vbs); }
    SEAM(2);
    if (IN(3)) { ph_hgrn_states(ldsl, UB, VT, a.in[2], HS, HD, vb0, vbs); ph_mamba_states(ldsl, XT, dtraw, a.in[7], a.in[8], MS, MD, vb0, vbs); }
    SEAM(3);
    if (IN(4)) { ph_hgrn_scan(HS, HD, vb0, vbs); ph_mamba_scan(MS, MD, vb0, vbs); }
    SEAM(4);
    if (IN(5)) { ph_hgrn_out(ldsl, UB, VT, a.in[2], a.in[10], HS, OF, OC, vb0, vbs); ph_mamba_out(ldsl, UB, XC, XT, dtraw, a.in[7], a.in[8], a.in[9], a.in[11], MS, OC, vb0, vbs); }
    SEAM(5);
    if (IN(6)) { pg8::DenseOrder S; S.init(MT, DM, DM, (const bf16_t*)(ws + W_OUTE), G, cb); pg8::gemm_phase(ldsl, OC, DM, S, pg8::EpiBf16{YA, DM, nullptr}); }
    SEAM(6);
    if (IN(7)) {
        NormB A = NB0; A.y = YA; A.gpost = a.in[13];
        ph_norm2<1, false, false, false>(A, vb0, vbs);
        ph_cvt_rows(p_in, PB0, (size_t)MT * PDIM / 4, vb0, vbs);
        ph_convert_weights(ldsl, a.in, ws, ITEMS_DENSE, ITEMS_ALL, vb0, vbs);
    }
    SEAM(7);
    if (IN(8)) {
        { pg8::DenseOrder S; S.init(MT, 2 * DFF, DM, (const bf16_t*)(ws + W_GU), G, cb); pg8::gemm_phase(ldsl, XB, DM, S, pg8::EpiSwiglu{UB, DFF, RS, 0}); }
        { pg8::TailOrder S; S.init(MT, DM, PDIM, (const bf16_t*)(ws + W_PP), G, cb, (MT / 256) * (2 * DFF / 256) % G); pg8::gemm_phase(ldsl, PB0, PDIM, S, pg8::EpiBf16{YP, DM, nullptr}); }
    }
    SEAM(8);
    if (IN(9)) { pg8::DenseOrder S; S.init(MT, DM, DFF, (const bf16_t*)(ws + W_DN), G, cb); pg8::gemm_phase(ldsl, UB, DFF, S, pg8::EpiBf16{YA, DM, nullptr}); }
    SEAM(9);
    if (IN(10)) {
        NormB A = NB0; A.y = YA; A.gpost = a.in[18];
        ph_norm2<1, false, false, false>(A, vb0, vbs);
    }
    SEAM(10);
    if (IN(11)) { pg8::DenseOrder S; S.init(MT, DM, DM, (const bf16_t*)(ws + W_PG), G, cb); pg8::gemm_phase(ldsl, XB, DM, S, pg8::EpiPleGate{YP, DM, RS}); }
    SEAM(11);
    if (IN(12)) {
        NormB A = NB0; A.y = YP; A.gpost = a.in[33];
        ph_norm2<1, false, false, false>(A, vb0, vbs);
    }
    SEAM(12);
    if (IN(13)) { pg8::DenseOrder S; S.init(MT, 3072, DM, (const bf16_t*)(ws + W_QKV), G, cb); pg8::gemm_phase(ldsl, XB, DM, S, pg8::EpiBf16{UB, 3072, RS}); }
    SEAM(13);
    if (IN(14)) { ph_na(ldsl, UB, a.in[21], OC, vb0, vbs); }
    SEAM(14);
    if (IN(15)) { pg8::DenseOrder S; S.init(MT, DM, DM, (const bf16_t*)(ws + W_OUTO), G, cb); pg8::gemm_phase(ldsl, OC, DM, S, pg8::EpiBf16{YP1, DM, nullptr}); }
    SEAM(15);
    if (IN(16)) {
        NormB A = NB0; A.y = YP1; A.gpost = a.in[23]; A.gnext = a.in[24]; A.wr = a.in[25]; A.cnt = cnt; A.list = list; A.gatev = gatev; A.rsl = rsl; A.x8 = XG8;
        ph_norm2<1, false, false, true>(A, vb0, vbs, (LAS float*)ldsl);
        ph_cvt_rows(p_in + (size_t)MT * PDIM, PB1, (size_t)MT * PDIM / 4, vb0, vbs);
    }
    SEAM(16);
    if (IN(17)) { pg8::MoeOrder S; S.init(cnt, (volatile LAS int*)(ldsl + MISC_OFF + 64), 2 * DFFE, DM / 2, (const bf16_t*)(ws + W_EGU), (size_t)7 * MiB, true, G, cb);
        pg8::gemm_phase<pg8::EpiSwiglu8, pg8::MoeOrder, true>(ldsl, (const bf16_t*)XG8, DM / 2, S, pg8::EpiSwiglu8{(unsigned char*)UB, DFFE, rsl}); }
    SEAM(17);
    if (IN(18)) { pg8::MoeOrder S; S.init(cnt, (volatile LAS int*)(ldsl + MISC_OFF + 64), DM, DFFE / 2, (const bf16_t*)(ws + W_EDN), (size_t)(7 * MiB / 2), false, G, cb);
        const pg8::EpiMoeDown E{YB, list, gatev, 1.f / (pg8::W8_SCALE * pg8::ACT8_SCALE), (size_t)(Y2 - YB), yflag};
        S.set_split(true, false, DFFE / 2);
        pg8::gemm_phase<pg8::EpiMoeDown, pg8::MoeOrder, true>(ldsl, UB, DFFE / 2, S, E);
        S.set_split(true, true, DFFE / 2);
        pg8::gemm_phase<pg8::EpiMoeDown, pg8::MoeOrder, true>(ldsl, UB, DFFE / 2, S, E, DFFE / 4);
        { pg8::TailOrder T; T.init(MT, DM, PDIM, (const bf16_t*)(ws + W_PP + 512 * 1024), G, cb, S.tail_first()); pg8::gemm_phase(ldsl, PB1, PDIM, T, pg8::EpiBf16{YP, DM, nullptr}); } }
    SEAM(18);
    if (IN(19)) {
        NormB A = NB0; A.y = YB; A.gpost = a.in[29]; A.y2 = Y2; A.yflag = yflag;
        ph_norm2<2, false, false, false>(A, vb0, vbs);
    }
    SEAM(19);
    if (IN(20)) { pg8::DenseOrder S; S.init(MT, DM, DM, (const bf16_t*)(ws + W_PG + 2 * MiB), G, cb); pg8::gemm_phase(ldsl, XB, DM, S, pg8::EpiPleGate{YP, DM, RS}); }
    SEAM(20);
    if (IN(21)) {
        NormB A = NB0; A.y = YP; A.gpost = a.in[33] + DM; A.xout = a.out;
        ph_norm2<1, true, false, false>(A, vb0, vbs);
    }
#undef IN
#undef SEAM
}

extern "C" void kernel_launch(void* const* d_in, const int* in_sizes, int n_in, void* d_out, int out_size, void* d_ws, size_t ws_size, hipStream_t stream) {
    static int grid = 0;
    if (grid == 0) {
        if (n_in != 34 || out_size != MT * DM || ws_size < WS_END) { fprintf(stderr, "kernel_launch: unexpected shapes n_in %d out %d ws %zu (need %zu)\n", n_in, out_size, ws_size, (size_t)WS_END); grid = -1; return; }
        int dev = 0, cus = 0;
        if (hipGetDevice(&dev) != hipSuccess || hipDeviceGetAttribute(&cus, hipDeviceAttributeMultiprocessorCount, dev) != hipSuccess) { grid = -1; return; }
        if (hipFuncSetAttribute((const void*)fwd, hipFuncAttributeMaxDynamicSharedMemorySize, LDS_BYTES) != hipSuccess) { fprintf(stderr, "hipFuncSetAttribute failed\n"); grid = -1; return; }
        (void)hipGetLastError();
        grid = cus;
    }
    if (grid < 0) return;
    (void)hipMemsetAsync((char*)d_ws + WS_CTL, 0, CTL_ZERO_BYTES, stream);
    Args a{};
    for (int i = 0; i < 34; ++i) a.in[i] = (const float*)d_in[i];
    a.out = (float*)d_out; a.ws = (unsigned char*)d_ws;
#ifndef MK_PER_PHASE
    a.ph_lo = 0; a.ph_hi = N_PHASES;
    hipLaunchKernelGGL(fwd, dim3(grid), dim3(NTHR), LDS_BYTES, stream, a);
#else
    for (int ph = 0; ph < N_PHASES; ++ph) {
        a.ph_lo = ph; a.ph_hi = ph + 1;
        hipLaunchKernelGGL(fwd, dim3(grid), dim3(NTHR), LDS_BYTES, stream, a);
    }
#endif
}
```

```cpp
#include <hip/hip_runtime.h>
#include <stdint.h>
#include <stdio.h>

#define DEVI __device__ __forceinline__
#define LAS __attribute__((address_space(3)))
typedef unsigned short bf16_t;

constexpr int NB = 4, SEQ = 4096, DM = 1024, MT = NB * SEQ;
constexpr int EVEN_IN = 4112, UW = 4096, DFF = 2816, NEXP = 8, DFFE = 3584, PDIM = 256;
constexpr float EPS = 1e-6f;
constexpr int NTHR = 512;
constexpr int LDS_BYTES = 147456;
constexpr int MISC_OFF = 131072 + 320;
constexpr int MOE_ROWS = 2 * MT + NEXP * 256;

constexpr size_t MiB = 1u << 20;
constexpr size_t WS_CTL = 0, CTL_ZERO_BYTES = 1 * MiB;
constexpr size_t WS_LIST = 1 * MiB;
constexpr size_t WS_GATE = WS_LIST + 512 * 1024;
constexpr size_t WS_DT = 2 * MiB;
constexpr size_t WS_W = 3 * MiB;
constexpr size_t W_IN = WS_W, W_OUTE = W_IN + 8 * MiB, W_GU = W_OUTE + 2 * MiB, W_DN = W_GU + 11 * MiB, W_PG = W_DN + 6 * MiB, W_PP = W_PG + 4 * MiB,
                 W_QKV = W_PP + 1 * MiB, W_OUTO = W_QKV + 6 * MiB, W_EGU = W_OUTO + 2 * MiB, W_EDN = W_EGU + 112 * MiB, W_END = W_EDN + 56 * MiB;
constexpr size_t WS_XB = W_END;
constexpr size_t WS_R = WS_XB + 32 * MiB;
constexpr size_t WS_UB = WS_R;
constexpr size_t WS_PB0 = WS_R + 88 * MiB;
constexpr size_t WS_YA = WS_R + 128 * MiB;
constexpr size_t WS_OF = WS_R + 160 * MiB;
constexpr size_t WS_OC = WS_R + 192 * MiB;
constexpr size_t WS_YP = WS_R + 224 * MiB;
constexpr size_t WS_YP1 = WS_R;
constexpr size_t WS_PB1 = W_EDN + 32 * MiB;
constexpr size_t WS_XG8 = WS_R + 120 * MiB;
constexpr size_t WS_END = WS_R + 256 * MiB;
constexpr size_t WS_Y2 = WS_R + 120 * MiB;
constexpr size_t WS_YFLAG = WS_CTL + 256 * 1024;
constexpr size_t WS_Y = W_EGU;
constexpr size_t WS_MS = W_EGU;
constexpr size_t WS_HS = W_EGU + 64 * MiB;
constexpr size_t WS_XT = W_EDN;
constexpr size_t WS_VT = W_EDN + 24 * MiB;
constexpr size_t WS_MD = W_EDN + 40 * MiB;
constexpr size_t WS_HD = W_EDN + 41 * MiB;
static_assert(WS_R + (size_t)MOE_ROWS * DFFE <= WS_XG8 && WS_XG8 + 128 * MiB <= WS_END && WS_END <= 510 * MiB, "ws map");
constexpr size_t WS_RS = WS_CTL + 512 * 1024;
constexpr int CW_CNT = 64;
constexpr int CW_BAR = 4096;

DEVI int opq(int x) { asm volatile("" : "+v"(x)); return x; }
DEVI float bf2f(bf16_t b) { return __uint_as_float(((unsigned)b) << 16); }
typedef float f32x2c __attribute__((ext_vector_type(2)));
typedef __bf16 bf16x2c __attribute__((ext_vector_type(2)));
DEVI unsigned cvt2bf(float lo, float hi) { const f32x2c v = {lo, hi}; return __builtin_bit_cast(unsigned, __builtin_convertvector(v, bf16x2c)); }
DEVI bf16_t f2bf(float f) { return (bf16_t)(cvt2bf(f, 0.f) & 0xffffu); }
DEVI float silu_f(float x) { return x * __builtin_amdgcn_rcpf(1.f + __builtin_amdgcn_exp2f(-1.44269504f * x)); }
DEVI float sigmoid_f(float x) { return __builtin_amdgcn_rcpf(1.f + __builtin_amdgcn_exp2f(-1.44269504f * x)); }
DEVI float softplus_f(float x) { return x > 20.f ? x : log1pf(__expf(x)); }
DEVI float wave_sum(float v) {
#pragma unroll
    for (int o = 1; o < 64; o <<= 1) v += __shfl_xor(v, o);
    return v;
}


typedef short bf16x8 __attribute__((ext_vector_type(8)));
typedef float f32x4 __attribute__((ext_vector_type(4)));
typedef unsigned u32x4 __attribute__((ext_vector_type(4)));
typedef unsigned u32x2 __attribute__((ext_vector_type(2)));
DEVI unsigned pk2(float lo, float hi) { return cvt2bf(lo, hi); }
DEVI float bflo(unsigned w) { return __uint_as_float(w << 16); }
DEVI float bfhi(unsigned w) { return __uint_as_float(w & 0xffff0000u); }

DEVI unsigned pg8_pk4(float a, float b, float c, float d) {
    a = __builtin_amdgcn_fmed3f(a, -448.f, 448.f); b = __builtin_amdgcn_fmed3f(b, -448.f, 448.f); c = __builtin_amdgcn_fmed3f(c, -448.f, 448.f); d = __builtin_amdgcn_fmed3f(d, -448.f, 448.f);
    int p = __builtin_amdgcn_cvt_pk_fp8_f32(a, b, 0, false); p = __builtin_amdgcn_cvt_pk_fp8_f32(c, d, p, true); return (unsigned)p; }
DEVI float wave_sum16(float (&v)[16], int lane) {
    const bool h5 = lane & 32, h4 = lane & 16, h3 = lane & 8, h2 = lane & 4;
#pragma unroll
    for (int i = 0; i < 8; ++i) { const float send = h5 ? v[i] : v[i + 8], keep = h5 ? v[i + 8] : v[i]; v[i] = keep + __shfl_xor(send, 32); }
#pragma unroll
    for (int i = 0; i < 4; ++i) { const float send = h4 ? v[i] : v[i + 4], keep = h4 ? v[i + 4] : v[i]; v[i] = keep + __shfl_xor(send, 16); }
#pragma unroll
    for (int i = 0; i < 2; ++i) { const float send = h3 ? v[i] : v[i + 2], keep = h3 ? v[i + 2] : v[i]; v[i] = keep + __shfl_xor(send, 8); }
    { const float send = h2 ? v[0] : v[1], keep = h2 ? v[1] : v[0]; v[0] = keep + __shfl_xor(send, 4); }
    float r = v[0]; r += __shfl_xor(r, 1); r += __shfl_xor(r, 2); return r;
}
DEVI float wave_sum8(float (&v)[8], int lane) {
    const bool h5 = lane & 32, h4 = lane & 16, h3 = lane & 8;
#pragma unroll
    for (int i = 0; i < 4; ++i) { const float send = h5 ? v[i] : v[i + 4], keep = h5 ? v[i + 4] : v[i]; v[i] = keep + __shfl_xor(send, 32); }
#pragma unroll
    for (int i = 0; i < 2; ++i) { const float send = h4 ? v[i] : v[i + 2], keep = h4 ? v[i + 2] : v[i]; v[i] = keep + __shfl_xor(send, 16); }
    { const float send = h3 ? v[0] : v[1], keep = h3 ? v[1] : v[0]; v[0] = keep + __shfl_xor(send, 8); }
    float r = v[0]; r += __shfl_xor(r, 1); r += __shfl_xor(r, 2); r += __shfl_xor(r, 4); return r;
}
struct NormB { const float* xin; bf16_t* XB; const bf16_t* y; const float* gpost; float* rs; const float* gnext;
               const float* win; float* dtraw; const float* wr; unsigned* cnt; int* list; float* gatev; float* rsl; float* xout; unsigned char* x8; const bf16_t* y2; const unsigned char* yflag; };
DEVI void unpack8(const u32x4 w, float* v) { v[0] = bflo(w.x); v[1] = bfhi(w.x); v[2] = bflo(w.y); v[3] = bfhi(w.y); v[4] = bflo(w.z); v[5] = bfhi(w.z); v[6] = bflo(w.w); v[7] = bfhi(w.w); }
template <int YMODE, bool FINAL, bool DT, bool ROUTE>
DEVI void ph_norm2(const NormB& A, int vb0, int vbs, LAS float* wl = nullptr) {
    const int tidq = opq((int)threadIdx.x); const int wid = tidq >> 6, lane = tidq & 63;
    if (DT || ROUTE) {
        constexpr int NJ = DT ? 16 : 8;
        __syncthreads();
        for (int e = tidq; e < DM * NJ / 4; e += NTHR) { const int k = e / (NJ / 4), j4 = (e % (NJ / 4)) * 4;
            const float4 w = DT ? *(const float4*)(A.win + (size_t)k * EVEN_IN + 4096 + j4) : *(const float4*)(A.wr + (size_t)k * 8 + j4);
            wl[(j4 + 0) * DM + k] = w.x; wl[(j4 + 1) * DM + k] = w.y; wl[(j4 + 2) * DM + k] = w.z; wl[(j4 + 3) * DM + k] = w.w; }
        __syncthreads();
    }
    constexpr int R = (DT || ROUTE) ? 2 : 4;
    for (int row0 = (vb0 * 8 + wid) * R; row0 < MT; row0 += vbs * 8 * R) {
        float xv[R][16]; float yv[R][16];
#pragma unroll
        for (int rr = 0; rr < R; ++rr) {
            const size_t ro = (size_t)(row0 + rr) * DM + lane * 8;
            if (YMODE == 0) {
#pragma unroll
                for (int i = 0; i < 2; ++i) { const float4 p0 = *(const float4*)(A.xin + ro + i * 512), p1 = *(const float4*)(A.xin + ro + i * 512 + 4);
                    xv[rr][i * 8 + 0] = p0.x; xv[rr][i * 8 + 1] = p0.y; xv[rr][i * 8 + 2] = p0.z; xv[rr][i * 8 + 3] = p0.w; xv[rr][i * 8 + 4] = p1.x; xv[rr][i * 8 + 5] = p1.y; xv[rr][i * 8 + 6] = p1.z; xv[rr][i * 8 + 7] = p1.w; }
            } else {
#pragma unroll
                for (int i = 0; i < 2; ++i) {
                    unpack8(*(const u32x4*)(A.XB + ro + i * 512), xv[rr] + i * 8);
                    unpack8(*(const u32x4*)(A.y + ro + i * 512), yv[rr] + i * 8);
                    if (YMODE == 2) { float y2[8]; unpack8(*(const u32x4*)(A.y + (size_t)MT * DM + ro + i * 512), y2);
#pragma unroll
                        for (int j = 0; j < 8; ++j) yv[rr][i * 8 + j] += y2[j]; }
                }
            }
        }
        if (YMODE == 2) {
#pragma unroll
            for (int rr = 0; rr < R; ++rr) { const u32x2 fw = *(const u32x2*)(A.yflag + (size_t)(row0 + rr) * 8);
                const unsigned f0 = __builtin_amdgcn_readfirstlane(fw.x), f1 = __builtin_amdgcn_readfirstlane(fw.y);
                if (f0 | f1) { const size_t ro = (size_t)(row0 + rr) * DM + lane * 8;
#pragma unroll
                    for (int sl = 0; sl < 2; ++sl) { const unsigned fs = sl ? f1 : f0;
#pragma unroll
                        for (int i = 0; i < 2; ++i) if ((fs >> (8 * ((lane >> 5) + 2 * i))) & 0xff) { float y2[8]; unpack8(*(const u32x4*)(A.y2 + (size_t)sl * MT * DM + ro + i * 512), y2);
#pragma unroll
                            for (int j = 0; j < 8; ++j) yv[rr][i * 8 + j] += y2[j]; } } } }
        }
        if (YMODE != 0) {
            float gg[16];
#pragma unroll
            for (int i = 0; i < 2; ++i) { const float4 g0 = *(const float4*)(A.gpost + i * 512 + lane * 8), g1 = *(const float4*)(A.gpost + i * 512 + lane * 8 + 4);
                gg[i * 8 + 0] = g0.x; gg[i * 8 + 1] = g0.y; gg[i * 8 + 2] = g0.z; gg[i * 8 + 3] = g0.w; gg[i * 8 + 4] = g1.x; gg[i * 8 + 5] = g1.y; gg[i * 8 + 6] = g1.z; gg[i * 8 + 7] = g1.w; }
            float ss[R];
#pragma unroll
            for (int rr = 0; rr < R; ++rr) { ss[rr] = 0.f;
#pragma unroll
                for (int j = 0; j < 16; ++j) ss[rr] += yv[rr][j] * yv[rr][j]; }
#pragma unroll
            for (int o = 1; o < 64; o <<= 1)
#pragma unroll
                for (int rr = 0; rr < R; ++rr) ss[rr] += __shfl_xor(ss[rr], o);
#pragma unroll
            for (int rr = 0; rr < R; ++rr) { const float r = rsqrtf(ss[rr] * (1.f / DM) + EPS);
#pragma unroll
                for (int j = 0; j < 16; ++j) xv[rr][j] += yv[rr][j] * r * gg[j]; }
        }
        if (FINAL) {
#pragma unroll
            for (int rr = 0; rr < R; ++rr)
#pragma unroll
                for (int i = 0; i < 2; ++i) { float* op = A.xout + (size_t)(row0 + rr) * DM + i * 512 + lane * 8;
                    *(float4*)op = make_float4(xv[rr][i * 8], xv[rr][i * 8 + 1], xv[rr][i * 8 + 2], xv[rr][i * 8 + 3]); *(float4*)(op + 4) = make_float4(xv[rr][i * 8 + 4], xv[rr][i * 8 + 5], xv[rr][i * 8 + 6], xv[rr][i * 8 + 7]); }
        } else {
            float ss[R];
#pragma unroll
            for (int rr = 0; rr < R; ++rr) {
#pragma unroll
                for (int i = 0; i < 2; ++i) { u32x4 o; o.x = pk2(xv[rr][i * 8], xv[rr][i * 8 + 1]); o.y = pk2(xv[rr][i * 8 + 2], xv[rr][i * 8 + 3]); o.z = pk2(xv[rr][i * 8 + 4], xv[rr][i * 8 + 5]); o.w = pk2(xv[rr][i * 8 + 6], xv[rr][i * 8 + 7]);
                    *(u32x4*)(A.XB + (size_t)(row0 + rr) * DM + i * 512 + lane * 8) = o;
                }
                ss[rr] = 0.f;
#pragma unroll
                for (int j = 0; j < 16; ++j) ss[rr] += xv[rr][j] * xv[rr][j];
            }
#pragma unroll
            for (int o = 1; o < 64; o <<= 1)
#pragma unroll
                for (int rr = 0; rr < R; ++rr) ss[rr] += __shfl_xor(ss[rr], o);
            float r2[R];
#pragma unroll
            for (int rr = 0; rr < R; ++rr) { r2[rr] = rsqrtf(ss[rr] * (1.f / DM) + EPS); if (lane == 0) A.rs[row0 + rr] = r2[rr]; }
            if (DT || ROUTE) {
                float gn[16];
#pragma unroll
                for (int i = 0; i < 2; ++i) { const float4 g0 = *(const float4*)(A.gnext + i * 512 + lane * 8), g1 = *(const float4*)(A.gnext + i * 512 + lane * 8 + 4);
                    gn[i * 8 + 0] = g0.x; gn[i * 8 + 1] = g0.y; gn[i * 8 + 2] = g0.z; gn[i * 8 + 3] = g0.w; gn[i * 8 + 4] = g1.x; gn[i * 8 + 5] = g1.y; gn[i * 8 + 6] = g1.z; gn[i * 8 + 7] = g1.w; }
                int re1[R], re2[R], lr1[R], lr2[R]; float rw1[R], rw2[R];
                volatile LAS int* lcnt = (volatile LAS int*)((LAS unsigned char*)wl + 40960);
                if (ROUTE) { __syncthreads(); if (tidq < 8) lcnt[tidq] = 0; __syncthreads(); }
#pragma unroll
                for (int rr = 0; rr < R; ++rr) {
                    const int row = row0 + rr;
                    float hv[16];
#pragma unroll
                    for (int j = 0; j < 16; ++j) hv[j] = (rr == 0 ? xv[0][j] : xv[R - 1][j]) * (rr == 0 ? r2[0] : r2[R - 1]) * gn[j];
                    if (DT) {
                        float pd[16];
#pragma unroll 4
                        for (int j = 0; j < 16; ++j) {
                            float p = 0.f;
#pragma unroll
                            for (int i = 0; i < 2; ++i) { const LAS float* wp = wl + j * DM + i * 512 + lane * 8;
                                const f32x4 w0 = *(const LAS f32x4*)wp, w1 = *(const LAS f32x4*)(wp + 4);
                                p += hv[i * 8 + 0] * w0[0] + hv[i * 8 + 1] * w0[1] + hv[i * 8 + 2] * w0[2] + hv[i * 8 + 3] * w0[3] + hv[i * 8 + 4] * w1[0] + hv[i * 8 + 5] * w1[1] + hv[i * 8 + 6] * w1[2] + hv[i * 8 + 7] * w1[3]; }
                            pd[j] = p;
                        }
                        const float dk = wave_sum16(pd, lane);
                        if ((lane & 3) == 0) A.dtraw[(size_t)row * 16 + (lane >> 2)] = dk;
                    }
                    if (ROUTE) {
                        float pl[8];
#pragma unroll 4
                        for (int e = 0; e < 8; ++e) {
                            float p = 0.f;
#pragma unroll
                            for (int i = 0; i < 2; ++i) { const LAS float* wp = wl + e * DM + i * 512 + lane * 8;
                                const f32x4 w0 = *(const LAS f32x4*)wp, w1 = *(const LAS f32x4*)(wp + 4);
                                p += hv[i * 8 + 0] * w0[0] + hv[i * 8 + 1] * w0[1] + hv[i * 8 + 2] * w0[2] + hv[i * 8 + 3] * w0[3] + hv[i * 8 + 4] * w1[0] + hv[i * 8 + 5] * w1[1] + hv[i * 8 + 6] * w1[2] + hv[i * 8 + 7] * w1[3]; }
                            pl[e] = p;
                        }
                        const float lk = wave_sum8(pl, lane);
                        float lg[8];
#pragma unroll
                        for (int e = 0; e < 8; ++e) lg[e] = __shfl(lk, e * 8);
                        int e1 = 0; float v1 = lg[0];
#pragma unroll
                        for (int e = 1; e < 8; ++e) if (lg[e] > v1) { v1 = lg[e]; e1 = e; }
                        int e2 = 0; float v2 = -3.0e38f;
#pragma unroll
                        for (int e = 0; e < 8; ++e) if (e != e1 && lg[e] > v2) { v2 = lg[e]; e2 = e; }
                        const float ex = __expf(v2 - v1);
                        re1[rr] = e1; re2[rr] = e2; rw1[rr] = 1.f / (1.f + ex); rw2[rr] = ex / (1.f + ex);
                        if (lane == 0) { lr1[rr] = __hip_atomic_fetch_add((LAS int*)lcnt + e1, 1, __ATOMIC_RELAXED, __HIP_MEMORY_SCOPE_WORKGROUP); lr2[rr] = __hip_atomic_fetch_add((LAS int*)lcnt + e2, 1, __ATOMIC_RELAXED, __HIP_MEMORY_SCOPE_WORKGROUP); }
                    }
                }
                if (ROUTE) {
                    __syncthreads();
                    if (tidq < 8) lcnt[8 + tidq] = (int)atomicAdd(&A.cnt[tidq * 64], (unsigned)lcnt[tidq]);
                    __syncthreads();
#pragma unroll
                    for (int rr = 0; rr < R; ++rr) {
                        const int row = row0 + rr;
                        int dst1 = 0, dst2 = 0;
                        if (lane == 0) {
                            const int e1 = re1[rr], e2 = re2[rr];
                            const int p1 = lcnt[8 + e1] + lr1[rr], p2 = lcnt[8 + e2] + lr2[rr];
                            A.list[e1 * MT + p1] = row * 2; A.gatev[e1 * MT + p1] = rw1[rr]; A.rsl[e1 * MT + p1] = r2[rr];
                            A.list[e2 * MT + p2] = row * 2 + 1; A.gatev[e2 * MT + p2] = rw2[rr]; A.rsl[e2 * MT + p2] = r2[rr];
                            dst1 = e1 * MT + p1; dst2 = e2 * MT + p2;
                        }
                        dst1 = __builtin_amdgcn_readfirstlane(dst1); dst2 = __builtin_amdgcn_readfirstlane(dst2);
#pragma unroll
                        for (int i = 0; i < 2; ++i) { u32x2 o8;
                            const float* xs = xv[rr] + i * 8;
                            o8.x = pg8_pk4(xs[0], xs[1], xs[2], xs[3]); o8.y = pg8_pk4(xs[4], xs[5], xs[6], xs[7]);
                            *(u32x2*)(A.x8 + (size_t)dst1 * DM + i * 512 + lane * 8) = o8; *(u32x2*)(A.x8 + (size_t)dst2 * DM + i * 512 + lane * 8) = o8; }
                    }
                }
            }
        }
    }
}

DEVI void transpose_item(const float* W, int ldw, int K, int k0, int n0, bf16_t* WT, int drow0, LAS float* scr, int lane, const float* gain) {
    {
        const int ka = lane >> 3, n4 = (lane & 7) * 4;
        float4 wv[8];
#pragma unroll
        for (int i = 0; i < 8; ++i) wv[i] = *(const float4*)(W + (size_t)(k0 + i * 8 + ka) * ldw + n0 + n4);
#pragma unroll
        for (int i = 0; i < 8; ++i) { LAS float* d = scr + (i * 8 + ka) * 33 + n4; d[0] = wv[i].x; d[1] = wv[i].y; d[2] = wv[i].z; d[3] = wv[i].w; }
    }
    asm volatile("s_waitcnt lgkmcnt(0)" ::: "memory");
    const int c = lane & 7;
    float4 ga = make_float4(1.f, 1.f, 1.f, 1.f), gb = ga;
    if (gain) { ga = *(const float4*)(gain + k0 + 8 * c); gb = *(const float4*)(gain + k0 + 8 * c + 4); }
#pragma unroll
    for (int j = 0; j < 4; ++j) { const int n = (lane >> 3) + 8 * j; const LAS float* sp = scr + (8 * c) * 33 + n;
        u32x4 o; o.x = pk2(sp[0 * 33] * ga.x, sp[1 * 33] * ga.y); o.y = pk2(sp[2 * 33] * ga.z, sp[3 * 33] * ga.w); o.z = pk2(sp[4 * 33] * gb.x, sp[5 * 33] * gb.y); o.w = pk2(sp[6 * 33] * gb.z, sp[7 * 33] * gb.w);
        *(u32x4*)(WT + (size_t)(drow0 + n) * K + k0 + 8 * c) = o; }
    asm volatile("s_waitcnt lgkmcnt(0)" ::: "memory");
}
DEVI void transpose_item_fp8(const float* W, int ldw, int K, int k0, int n0, unsigned char* WT8, int drow0, LAS float* scr, int lane, const float* gain) {
    {
        const int ka = lane >> 3, n4 = (lane & 7) * 4;
        float4 wv[8];
#pragma unroll
        for (int i = 0; i < 8; ++i) wv[i] = *(const float4*)(W + (size_t)(k0 + i * 8 + ka) * ldw + n0 + n4);
#pragma unroll
        for (int i = 0; i < 8; ++i) { LAS float* d = scr + (i * 8 + ka) * 33 + n4; d[0] = wv[i].x; d[1] = wv[i].y; d[2] = wv[i].z; d[3] = wv[i].w; }
    }
    asm volatile("s_waitcnt lgkmcnt(0)" ::: "memory");
    const int c = lane & 7;
    float4 ga = make_float4(64.f, 64.f, 64.f, 64.f), gb = ga;
    if (gain) { ga = *(const float4*)(gain + k0 + 8 * c); gb = *(const float4*)(gain + k0 + 8 * c + 4); ga.x *= 64.f; ga.y *= 64.f; ga.z *= 64.f; ga.w *= 64.f; gb.x *= 64.f; gb.y *= 64.f; gb.z *= 64.f; gb.w *= 64.f; }
#pragma unroll
    for (int j = 0; j < 4; ++j) { const int n = (lane >> 3) + 8 * j; const LAS float* sp = scr + (8 * c) * 33 + n;
        u32x2 o; o.x = pg8_pk4(sp[0 * 33] * ga.x, sp[1 * 33] * ga.y, sp[2 * 33] * ga.z, sp[3 * 33] * ga.w); o.y = pg8_pk4(sp[4 * 33] * gb.x, sp[5 * 33] * gb.y, sp[6 * 33] * gb.z, sp[7 * 33] * gb.w);
        *(u32x2*)(WT8 + (size_t)(drow0 + n) * K + k0 + 8 * c) = o; }
    asm volatile("s_waitcnt lgkmcnt(0)" ::: "memory");
}
struct Job { int in_idx; unsigned src_off; int ldw; int K; int ncols; unsigned long long dst; int mode; int item0; int gain_idx; int gain_off; int fp8; };
constexpr int NJOBS = 11 + 24;
struct JobTable { Job j[NJOBS]; int total; };
constexpr JobTable make_jobs() {
    JobTable t{}; int n = 0, it = 0;
    auto add = [&](int idx, unsigned off, int ldw, int K, int ncols, unsigned long long dst, int mode, int gi, int go, int f8 = 0) { t.j[n] = Job{idx, off, ldw, K, ncols, dst, mode, it, gi, go, f8}; it += (K / 64) * (ncols / 32); ++n; };
    add(4, 0, EVEN_IN, DM, UW, W_IN, 0, 3, 0);
    add(12, 0, DM, DM, DM, W_OUTE, 0, -1, 0);
    add(15, 0, DFF, DM, DFF, W_GU, 1, 14, 0);
    add(16, 0, DFF, DM, DFF, W_GU, 2, 14, 0);
    add(17, 0, DM, DFF, DM, W_DN, 0, -1, 0);
    add(31, 0, DM, DM, DM, W_PG, 0, 30, 0);
    add(31, DM * DM, DM, DM, DM, W_PG + 2 * MiB, 0, 30, DM);
    add(32, 0, DM, PDIM, DM, W_PP, 0, -1, 0);
    add(32, PDIM * DM, DM, PDIM, DM, W_PP + 512 * 1024, 0, -1, 0);
    add(20, 0, 3072, DM, 3072, W_QKV, 0, 19, 0);
    add(22, 0, DM, DM, DM, W_OUTO, 0, -1, 0);
    for (int e = 0; e < NEXP; ++e) {
        add(26, (unsigned)e * DM * DFFE, DFFE, DM, DFFE, W_EGU + (unsigned long long)e * 7 * MiB, 1, 24, 0, 1);
        add(27, (unsigned)e * DM * DFFE, DFFE, DM, DFFE, W_EGU + (unsigned long long)e * 7 * MiB, 2, 24, 0, 1);
        add(28, (unsigned)e * DFFE * DM, DM, DFFE, DM, W_EDN + (unsigned long long)e * (7 * MiB / 2), 0, -1, 0, 1);
    }
    t.total = it; return t;
}
__device__ const JobTable g_jobs = make_jobs();
constexpr int ITEMS_DENSE = make_jobs().j[11].item0, ITEMS_ALL = make_jobs().total;
struct CvtIt { const float* src; unsigned char* dst; const float* gp; int ldw, K, k0, n0, drow0; };
DEVI void cvt_decode(CvtIt& c, int it, int& jb, const float* const* in, unsigned char* ws) {
    while (jb + 1 < NJOBS && g_jobs.j[jb + 1].item0 <= it) ++jb;
    const Job J = g_jobs.j[jb];
    const int r = it - J.item0; const int nblk = J.ncols / 32; const int kb = r / nblk, nb = r % nblk;
    const int n0 = nb * 32; int drow0 = n0;
    if (J.mode != 0) drow0 = (n0 >> 7) * 256 + (n0 & 127) + (J.mode == 2 ? 128 : 0);
    c.src = in[J.in_idx] + J.src_off; c.dst = ws + J.dst; c.gp = J.gain_idx >= 0 ? in[J.gain_idx] + J.gain_off : nullptr; c.ldw = J.ldw; c.K = J.K; c.k0 = kb * 64; c.n0 = n0; c.drow0 = drow0;
}
DEVI void fp8_item_load(float4 (&wv)[8], float4& ga, float4& gb, const CvtIt& c, int lane) {
    const int ka = lane >> 3, n4 = (lane & 7) * 4;
    ga = make_float4(1.f, 1.f, 1.f, 1.f); gb = ga;
    if (c.gp) { ga = *(const float4*)(c.gp + c.k0 + 8 * (lane & 7)); gb = *(const float4*)(c.gp + c.k0 + 8 * (lane & 7) + 4); }
#pragma unroll
    for (int i = 0; i < 8; ++i) wv[i] = *(const float4*)(c.src + (size_t)(c.k0 + i * 8 + ka) * c.ldw + c.n0 + n4);
}
DEVI void fp8_item_finish(const float4 (&wv)[8], float4 ga, float4 gb, const CvtIt& c, LAS float* scr, int lane) {
    { const int ka = lane >> 3, n4 = (lane & 7) * 4;
#pragma unroll
        for (int i = 0; i < 8; ++i) { LAS float* d = scr + (i * 8 + ka) * 33 + n4; d[0] = wv[i].x; d[1] = wv[i].y; d[2] = wv[i].z; d[3] = wv[i].w; } }
    asm volatile("s_waitcnt lgkmcnt(0)" ::: "memory");
    const int cc = lane & 7;
    ga.x *= 64.f; ga.y *= 64.f; ga.z *= 64.f; ga.w *= 64.f; gb.x *= 64.f; gb.y *= 64.f; gb.z *= 64.f; gb.w *= 64.f;
#pragma unroll
    for (int j = 0; j < 4; ++j) { const int n = (lane >> 3) + 8 * j; const LAS float* sp = scr + (8 * cc) * 33 + n;
        u32x2 o; o.x = pg8_pk4(sp[0 * 33] * ga.x, sp[1 * 33] * ga.y, sp[2 * 33] * ga.z, sp[3 * 33] * ga.w); o.y = pg8_pk4(sp[4 * 33] * gb.x, sp[5 * 33] * gb.y, sp[6 * 33] * gb.z, sp[7 * 33] * gb.w);
        *(u32x2*)(c.dst + (size_t)(c.drow0 + n) * c.K + c.k0 + 8 * cc) = o; }
    asm volatile("s_waitcnt lgkmcnt(0)" ::: "memory");
}
DEVI void ph_convert_experts(LAS unsigned char* lds, const float* const* in, unsigned char* ws, int it_lo, int it_hi, int vb0, int vbs) {
    const int tidq = opq((int)threadIdx.x); const int wid = __builtin_amdgcn_readfirstlane(tidq >> 6), lane = tidq & 63;
    LAS float* scr = (LAS float*)(lds + wid * 16384);
    int jb = 11; int it = it_lo + vb0 * 8 + wid; if (it >= it_hi) return;
    CvtIt cur, nxt; float4 wc[8], wn[8], gca, gcb, gna, gnb;
    cvt_decode(cur, it, jb, in, ws); fp8_item_load(wc, gca, gcb, cur, lane);
    for (;;) {
        const int itn = it + vbs * 8; const bool hn = itn < it_hi;
        if (hn) { cvt_decode(nxt, itn, jb, in, ws); fp8_item_load(wn, gna, gnb, nxt, lane); }
        fp8_item_finish(wc, gca, gcb, cur, scr, lane);
        if (!hn) break;
        cur = nxt; it = itn; gca = gna; gcb = gnb;
#pragma unroll
        for (int i = 0; i < 8; ++i) wc[i] = wn[i];
    }
}
DEVI void ph_convert_weights(LAS unsigned char* lds, const float* const* in, unsigned char* ws, int it_lo, int it_hi, int vb0, int vbs) {
    const int tidq = opq((int)threadIdx.x); const int wid = __builtin_amdgcn_readfirstlane(tidq >> 6), lane = tidq & 63;
    LAS float* scr = (LAS float*)(lds + wid * 16384);
    int jb = 0;
    for (int it = it_lo + vb0 * 8 + wid; it < it_hi; it += vbs * 8) {
        while (jb + 1 < NJOBS && g_jobs.j[jb + 1].item0 <= it) ++jb;
        const Job J = g_jobs.j[jb];
        const int r = it - J.item0; const int nblk = J.ncols / 32; const int kb = r / nblk, nb = r % nblk;
        const int n0 = nb * 32; int drow0 = n0;
        if (J.mode != 0) drow0 = (n0 >> 7) * 256 + (n0 & 127) + (J.mode == 2 ? 128 : 0);
        const float* gp = J.gain_idx >= 0 ? in[J.gain_idx] + J.gain_off : nullptr;
        if (J.fp8) transpose_item_fp8(in[J.in_idx] + J.src_off, J.ldw, J.K, kb * 64, n0, ws + J.dst, drow0, scr, lane, gp);
        else transpose_item(in[J.in_idx] + J.src_off, J.ldw, J.K, kb * 64, n0, (bf16_t*)(ws + J.dst), drow0, scr, lane, gp);
    }
}
DEVI void ph_cvt_rows(const float* src, bf16_t* dst, size_t n4, int vb0, int vbs) {
    for (size_t e = (size_t)vb0 * NTHR + opq((int)threadIdx.x); e < n4; e += (size_t)vbs * NTHR) {
        const float4 v = ((const float4*)src)[e]; u32x2 o; o.x = pk2(v.x, v.y); o.y = pk2(v.z, v.w); ((u32x2*)dst)[e] = o; }
}

namespace pg8 {
constexpr int BM = 256, BK = 64, HALF = 128, HTB = HALF * BK * 2, STAGE_BYTES = 8 * HTB, NXCD = 8, WGM = 8;
__host__ __device__ __forceinline__ int lds_byte(int r, int c) { const int st = (r >> 4) * 2 + (c >> 5), rr = r & 15, cc = c & 31, ob = rr * 64 + cc * 2; return st * 1024 + (ob ^ (((ob >> 9) & 1) << 5)); }
__host__ __device__ __forceinline__ void stage_rc(int b, int& R, int& C) { const int st = b / 1024, sb = b % 1024, swz = sb ^ (((sb >> 9) & 1) << 5); R = (st >> 1) * 16 + swz / 64; C = (st & 1) * 32 + (swz % 64) / 2; }
__host__ __device__ __forceinline__ int perm32(int rho) { const int n = rho >> 4, i = rho & 15; return 8 * (i >> 2) + 4 * n + (i & 3); }
struct Unit { int pm, pn; int row0; int arow0; int mvalid; int e; int mbase; int akoff; const char* B; };
DEVI void xcd_tile(int L, int nwg, int nM, int nN, int& pm, int& pn) {
    int wgid = L; { const int q = nwg / NXCD, r = nwg % NXCD, xcd = wgid % NXCD, off = wgid / NXCD; wgid = (xcd < r ? xcd * (q + 1) : r * (q + 1) + (xcd - r) * q) + off; }
    const int nig = WGM * nN, gid = wgid / nig, fm = gid * WGM, gsz = (nM - fm) < WGM ? (nM - fm) : WGM;
    pm = fm + ((wgid % nig) % gsz); pn = (wgid % nig) / gsz;
}
struct DenseOrder {
    int nM, nN, nwg, G, c; const char* Bt; size_t tstepB;
    DEVI void init(int M, int N, int K, const bf16_t* Bt_, int G_, int c_) { nM = M / BM; nN = N / BM; nwg = nM * nN; G = G_; c = c_; Bt = (const char*)Bt_; tstepB = (size_t)BM * K * 2; }
    DEVI bool next(int i, Unit& u) const { const long L = (long)i * G + c; if (L >= nwg) return false; xcd_tile((int)L, nwg, nM, nN, u.pm, u.pn); u.row0 = u.pm * BM; u.arow0 = u.row0; u.mvalid = BM; u.e = 0; u.mbase = 0; u.akoff = 0; u.B = Bt + (size_t)u.pn * tstepB; return true; }
};
struct TailOrder {
    int nM, nN, nwg, nb, r; const char* Bt; size_t tstepB;
    DEVI void init(int M, int N, int K, const bf16_t* Bt_, int G_, int c_, int first) { nM = M / BM; nN = N / BM; nwg = nM * nN; Bt = (const char*)Bt_; tstepB = (size_t)BM * K * 2;
        if (first >= G_) first = 0; nb = G_ - first; r = c_ - first; }
    DEVI bool next(int i, Unit& u) const { if (r < 0) return false; const long L = (long)i * nb + r; if (L >= nwg) return false; u.pm = (int)L / nN; u.pn = (int)L % nN; u.row0 = u.pm * BM; u.arow0 = u.row0; u.mvalid = BM; u.e = 0; u.mbase = 0; u.akoff = 0; u.B = Bt + (size_t)u.pn * tstepB; return true; }
};
struct MoeOrder {
    int nM, nN, nwg, G, c; const char* Bt; size_t estepB, tstepB; const volatile LAS int* tab; bool per_expert;
    DEVI void init(const unsigned* cnt, volatile LAS int* tab_, int N, int K, const bf16_t* Bt_, size_t estep_bytes, bool per_expert_, int G_, int c_) {
        __syncthreads();
        if (threadIdx.x < 8) tab_[16 + threadIdx.x] = (int)__hip_atomic_load(cnt + threadIdx.x * 64, __ATOMIC_RELAXED, __HIP_MEMORY_SCOPE_AGENT);
        __syncthreads();
        if (threadIdx.x == 0) { int t = 0;
            for (int e = 0; e < 8; ++e) { const int n = tab_[16 + e]; tab_[e] = t; t += (n + BM - 1) / BM; }
            tab_[8] = t; }
        __syncthreads();
        tab = tab_; nM = __builtin_amdgcn_readfirstlane(tab_[8]); nN = N / BM; nwg = nM * nN; G = G_; c = c_; Bt = (const char*)Bt_; estepB = estep_bytes; tstepB = (size_t)BM * K * 2; per_expert = per_expert_; nmain = nwg; split_phase = false; khalfB = 0;
    }
    int nmain; bool split_phase; int khalfB;
    DEVI void set_split(bool ksplit, bool phase2, int khalf_bytes) { const int r = nwg % G; const bool can = ksplit && r > 0 && 2 * r <= G; nmain = can ? nwg - r : nwg; split_phase = phase2; khalfB = khalf_bytes; }
    DEVI int tail_first() const { return nmain == nwg ? nwg % G : 2 * (nwg - nmain); }
    DEVI bool next(int i, Unit& u) const {
        long L; int kh = 0;
        if (!split_phase) { L = (long)i * G + c; if (L >= nmain) return false; }
        else { if (i > 0 || c >= 2 * (nwg - nmain)) return false; L = nmain + (c >> 1); kh = c & 1; }
        xcd_tile((int)L, nwg, nM, nN, u.pm, u.pn);
        int e = 0;
        for (int k = 1; k < 8; ++k) if (u.pm >= __builtin_amdgcn_readfirstlane(tab[k])) e = k;
        const int t0 = __builtin_amdgcn_readfirstlane(tab[e]), n = __builtin_amdgcn_readfirstlane(tab[16 + e]);
        u.e = e; u.row0 = u.pm * BM; const int m0 = (u.pm - t0) * BM; u.mbase = m0; u.arow0 = per_expert ? e * MT + m0 : u.row0; u.mvalid = (n - m0) < BM ? (n - m0) : BM;
        u.akoff = kh * khalfB; u.B = Bt + (size_t)e * estepB + (size_t)u.pn * tstepB + u.akoff; return true; }
};
DEVI unsigned cvt_pk_bf16(float lo, float hi) { return cvt2bf(lo, hi); }

constexpr int EPI_OFF = MISC_OFF + 1024, EPI_SLICE = 1024;
static_assert(EPI_OFF + 8 * EPI_SLICE <= LDS_BYTES, "epilogue scalar slices");
DEVI void epi_dma(const void* g, LAS unsigned char* dst) { __builtin_amdgcn_global_load_lds((const unsigned*)g, (LAS unsigned*)dst, 4, 0, 0); }
struct EpiBf16 { static constexpr bool PERM = true; bf16_t* O; int ldc; const float* rs;
    DEVI void pre(LAS unsigned char* esl, const Unit& u, int wr, int lane) const {
        if (rs) { epi_dma(rs + u.row0 + wr * 64 + lane, esl); epi_dma(rs + u.row0 + wr * 64 + HALF + lane, esl + 256); } }
    DEVI void operator()(const f32x4 (&acc)[2][2][4][2], const Unit& u, int wr, int wc, int fr, int fq, const LAS unsigned char* esl) const {
        float pv[8];
#pragma unroll
        for (int q = 0; q < 8; ++q) pv[q] = ((const LAS float*)esl)[(q >> 2) * 64 + (q & 3) * 16 + fr];
        const int row0 = u.row0 + wr * 64 + fr, col0 = u.pn * BM + wc * 32 + 8 * fq;
#pragma unroll
        for (int ai = 0; ai < 2; ++ai)
#pragma unroll
            for (int m = 0; m < 4; ++m) { const int row = row0 + ai * HALF + m * 16; bf16_t* rowp = O + (size_t)row * ldc + col0;
                const float sc = rs ? pv[ai * 4 + m] : 1.f;
#pragma unroll
                for (int bj = 0; bj < 2; ++bj) { const f32x4 v0 = acc[ai][bj][m][0] * sc, v1 = acc[ai][bj][m][1] * sc;
                    u32x4 w; w.x = cvt_pk_bf16(v0[0], v0[1]); w.y = cvt_pk_bf16(v0[2], v0[3]); w.z = cvt_pk_bf16(v1[0], v1[1]); w.w = cvt_pk_bf16(v1[2], v1[3]);
                    *(u32x4*)(rowp + bj * HALF) = w; } }
    } };
struct EpiPleGate { static constexpr bool PERM = true; bf16_t* T; int ldc; const float* rs;
    DEVI void pre(LAS unsigned char* esl, const Unit& u, int wr, int lane) const {
        epi_dma(rs + u.row0 + wr * 64 + lane, esl); epi_dma(rs + u.row0 + wr * 64 + HALF + lane, esl + 256); }
    DEVI void operator()(const f32x4 (&acc)[2][2][4][2], const Unit& u, int wr, int wc, int fr, int fq, const LAS unsigned char* esl) const {
        float pv[8];
#pragma unroll
        for (int q = 0; q < 8; ++q) pv[q] = ((const LAS float*)esl)[(q >> 2) * 64 + (q & 3) * 16 + fr];
        const int row0 = u.row0 + wr * 64 + fr, col0 = u.pn * BM + wc * 32 + 8 * fq;
#pragma unroll
        for (int ai = 0; ai < 2; ++ai)
#pragma unroll
            for (int m = 0; m < 4; ++m) { const int row = row0 + ai * HALF + m * 16; bf16_t* rowp = T + (size_t)row * ldc + col0;
                const float sc = pv[ai * 4 + m];
#pragma unroll
                for (int bj = 0; bj < 2; ++bj) { const f32x4 v0 = acc[ai][bj][m][0] * sc, v1 = acc[ai][bj][m][1] * sc;
                    const u32x4 pp = *(const u32x4*)(rowp + bj * HALF);
                    u32x4 w; w.x = cvt_pk_bf16(sigmoid_f(v0[0]) * bflo(pp.x), sigmoid_f(v0[1]) * bfhi(pp.x)); w.y = cvt_pk_bf16(sigmoid_f(v0[2]) * bflo(pp.y), sigmoid_f(v0[3]) * bfhi(pp.y));
                    w.z = cvt_pk_bf16(sigmoid_f(v1[0]) * bflo(pp.z), sigmoid_f(v1[1]) * bfhi(pp.z)); w.w = cvt_pk_bf16(sigmoid_f(v1[2]) * bflo(pp.w), sigmoid_f(v1[3]) * bfhi(pp.w));
                    *(u32x4*)(rowp + bj * HALF) = w; } }
    } };
struct EpiSwiglu { static constexpr bool PERM = true; bf16_t* O; int ldc; const float* rs; int grouped;
    DEVI void pre(LAS unsigned char* esl, const Unit& u, int wr, int lane) const {
        const float* rsb = grouped ? rs + u.e * MT + u.mbase : rs + u.row0; const int vm1 = (grouped ? u.mvalid : BM) - 1;
#pragma unroll
        for (int i = 0; i < 2; ++i) { const int rl = wr * 64 + lane + i * HALF; epi_dma(rsb + (rl <= vm1 ? rl : vm1), esl + i * 256); } }
    DEVI void operator()(const f32x4 (&acc)[2][2][4][2], const Unit& u, int wr, int wc, int fr, int fq, const LAS unsigned char* esl) const {
        float pv[8];
#pragma unroll
        for (int q = 0; q < 8; ++q) pv[q] = ((const LAS float*)esl)[(q >> 2) * 64 + (q & 3) * 16 + fr];
        const int row0 = u.row0 + wr * 64 + fr, col0 = u.pn * HALF + wc * 32 + 8 * fq; const int vm1e = (grouped ? u.mvalid : BM) - 1;
#pragma unroll
        for (int ai = 0; ai < 2; ++ai)
#pragma unroll
            for (int m = 0; m < 4; ++m) { const int rl = wr * 64 + fr + ai * HALF + m * 16; bf16_t* rowp = O + (size_t)(u.row0 + rl) * ldc + col0;
                const float sc = rl <= vm1e ? pv[ai * 4 + m] : 0.f;
                const f32x4 g0 = acc[ai][0][m][0] * sc, g1 = acc[ai][0][m][1] * sc, u0 = acc[ai][1][m][0] * sc, u1 = acc[ai][1][m][1] * sc;
                u32x4 w; w.x = cvt_pk_bf16(silu_f(g0[0]) * u0[0], silu_f(g0[1]) * u0[1]); w.y = cvt_pk_bf16(silu_f(g0[2]) * u0[2], silu_f(g0[3]) * u0[3]);
                w.z = cvt_pk_bf16(silu_f(g1[0]) * u1[0], silu_f(g1[1]) * u1[1]); w.w = cvt_pk_bf16(silu_f(g1[2]) * u1[2], silu_f(g1[3]) * u1[3]);
                *(u32x4*)rowp = w; }
    } };
constexpr float W8_SCALE = 64.f, ACT8_SCALE = 8.f;
struct EpiSwiglu8 { static constexpr bool PERM = true; unsigned char* O; int ldc; const float* rs;
    DEVI void pre(LAS unsigned char* esl, const Unit& u, int wr, int lane) const {
        const float* rsb = rs + u.e * MT + u.mbase; const int vm1 = u.mvalid - 1;
#pragma unroll
        for (int i = 0; i < 2; ++i) { const int rl = wr * 64 + lane + i * HALF; epi_dma(rsb + (rl <= vm1 ? rl : vm1), esl + i * 256); } }
    DEVI void operator()(const f32x4 (&acc)[2][2][4][2], const Unit& u, int wr, int wc, int fr, int fq, const LAS unsigned char* esl) const {
        float pv[8];
#pragma unroll
        for (int q = 0; q < 8; ++q) pv[q] = ((const LAS float*)esl)[(q >> 2) * 64 + (q & 3) * 16 + fr];
        const int col0 = u.pn * HALF + wc * 32 + 8 * fq;
#pragma unroll
        for (int ai = 0; ai < 2; ++ai)
#pragma unroll
            for (int m = 0; m < 4; ++m) { const int rl = wr * 64 + fr + ai * HALF + m * 16; unsigned char* rowp = O + (size_t)(u.row0 + rl) * ldc + col0;
                const float sc = rl < u.mvalid ? pv[ai * 4 + m] * (1.f / W8_SCALE) : 0.f;
                const f32x4 g0 = acc[ai][0][m][0] * sc, g1 = acc[ai][0][m][1] * sc, u0 = acc[ai][1][m][0] * (sc * ACT8_SCALE), u1 = acc[ai][1][m][1] * (sc * ACT8_SCALE);
                u32x2 w; w.x = pg8_pk4(silu_f(g0[0]) * u0[0], silu_f(g0[1]) * u0[1], silu_f(g0[2]) * u0[2], silu_f(g0[3]) * u0[3]);
                w.y = pg8_pk4(silu_f(g1[0]) * u1[0], silu_f(g1[1]) * u1[1], silu_f(g1[2]) * u1[2], silu_f(g1[3]) * u1[3]);
                *(u32x2*)rowp = w; }
    } };
struct EpiMoeDown { static constexpr bool PERM = true; bf16_t* Y; const int* list; const float* gatev; float oscale; size_t y2off; unsigned char* flag;
    DEVI void pre(LAS unsigned char* esl, const Unit& u, int wr, int lane) const {
        const int* lb = list + u.e * MT + u.mbase; const float* gb = gatev + u.e * MT + u.mbase; const int vm1 = u.mvalid - 1;
#pragma unroll
        for (int i = 0; i < 2; ++i) { const int rl = wr * 64 + lane + i * HALF; const int ri = rl <= vm1 ? rl : vm1; epi_dma(gb + ri, esl + i * 256); epi_dma(lb + ri, esl + 512 + i * 256); } }
    DEVI void operator()(const f32x4 (&acc)[2][2][4][2], const Unit& u, int wr, int wc, int fr, int fq, const LAS unsigned char* esl) const {
        float pv[8]; int pt[8];
#pragma unroll
        for (int q = 0; q < 8; ++q) { pv[q] = ((const LAS float*)esl)[(q >> 2) * 64 + (q & 3) * 16 + fr]; pt[q] = ((const LAS int*)(esl + 512))[(q >> 2) * 64 + (q & 3) * 16 + fr]; }
        const int col0 = u.pn * BM + wc * 32 + 8 * fq;
        const bool second = u.akoff != 0; bf16_t* const Yb = Y + (second ? y2off : (size_t)0);
#pragma unroll
        for (int ai = 0; ai < 2; ++ai)
#pragma unroll
            for (int m = 0; m < 4; ++m) { const int rl = wr * 64 + fr + ai * HALF + m * 16;
                const int tsl = pt[ai * 4 + m]; const float gt = pv[ai * 4 + m] * oscale;
                if (rl < u.mvalid) {
                    bf16_t* rowp = Yb + (size_t)(tsl & 1) * ((size_t)MT * DM) + (size_t)(tsl >> 1) * DM + col0;
                    if (second && wc == 0 && fq == 0) flag[tsl * 4 + u.pn] = 1;
#pragma unroll
                    for (int bj = 0; bj < 2; ++bj) { const f32x4 v0 = acc[ai][bj][m][0], v1 = acc[ai][bj][m][1];
                        u32x4 w; w.x = cvt_pk_bf16(v0[0] * gt, v0[1] * gt); w.y = cvt_pk_bf16(v0[2] * gt, v0[3] * gt); w.z = cvt_pk_bf16(v1[0] * gt, v1[1] * gt); w.w = cvt_pk_bf16(v1[2] * gt, v1[3] * gt);
                        *(u32x4*)(rowp + bj * HALF) = w; } } }
    } };

typedef int v8i __attribute__((ext_vector_type(8)));
typedef int v4i __attribute__((ext_vector_type(4)));
DEVI v8i cat8(const bf16x8 lo, const bf16x8 hi) { const v4i a = __builtin_bit_cast(v4i, lo), b = __builtin_bit_cast(v4i, hi); return __builtin_shufflevector(a, b, 0, 1, 2, 3, 4, 5, 6, 7); }
struct Frag16 { bf16x8 k[2]; };
struct Frag8 { v8i v; };
template <bool F> struct FragSel { typedef Frag16 T; };
template <> struct FragSel<true> { typedef Frag8 T; };
template <class Epi, class Sched, bool FP8 = false>
DEVI void gemm_phase(LAS unsigned char* lds, const bf16_t* A, const int K, const Sched& S, const Epi& E, const int Kloop = 0) {
    const int tid = opq((int)threadIdx.x), wid = __builtin_amdgcn_readfirstlane(tid >> 6), lane = tid & 63, wr = wid >> 2, wc = wid & 3, fr = lane & 15, fq = lane >> 4;
    const int nt = (Kloop ? Kloop : K) / BK;
    unsigned voffA[2], voffB[2];
#pragma unroll
    for (int i = 0; i < 2; ++i) { int R, C; stage_rc(tid * 16 + i * 8192, R, C); const int Rb = Epi::PERM ? ((R & ~31) + perm32(R & 31)) : R;
        voffA[i] = (unsigned)(R * K + C) * 2u; voffB[i] = (unsigned)(Rb * K + C) * 2u; }
    const size_t kstep = (size_t)(BK * 2);
    const size_t hstep = (size_t)HALF * K * 2;
    const size_t rstep = (size_t)K * 2;
    const unsigned ldsw = (unsigned)wid * 1024u;
    const int aoff = lds_byte(wr * 64 + fr, fq * 8), boff = lds_byte(wc * 32 + fr, fq * 8);
#define PG8_SA(b, h) (((b) * 2 + (h)) * HTB)
#define PG8_SB(b, h) ((4 + (b) * 2 + (h)) * HTB)
#define PG8_STAGE(bufoff, gbase, voff) do { _Pragma("unroll") for (int _i = 0; _i < 2; ++_i) \
        __builtin_amdgcn_global_load_lds((const unsigned*)((const char*)(gbase) + (voff)[_i]), (LAS unsigned*)(lds + (bufoff) + ldsw + _i * 8192), 16, 0, 0); } while (0)
#define PG8_LDA(dst, b, h) do { _Pragma("unroll") for (int m = 0; m < 4; ++m) { if constexpr (FP8) dst[m].v = cat8(*(const LAS bf16x8*)(lds + PG8_SA(b, h) + aoff + m * 2048), *(const LAS bf16x8*)(lds + PG8_SA(b, h) + aoff + m * 2048 + 1024)); \
        else { _Pragma("unroll") for (int k = 0; k < 2; ++k) dst[m].k[k] = *(const LAS bf16x8*)(lds + PG8_SA(b, h) + aoff + m * 2048 + k * 1024); } } } while (0)
#define PG8_LDB(dst, b, h) do { _Pragma("unroll") for (int n = 0; n < 2; ++n) { if constexpr (FP8) dst[n].v = cat8(*(const LAS bf16x8*)(lds + PG8_SB(b, h) + boff + n * 2048), *(const LAS bf16x8*)(lds + PG8_SB(b, h) + boff + n * 2048 + 1024)); \
        else { _Pragma("unroll") for (int k = 0; k < 2; ++k) dst[n].k[k] = *(const LAS bf16x8*)(lds + PG8_SB(b, h) + boff + n * 2048 + k * 1024); } } } while (0)
#define PG8_MMA(ai, bj, At, Bt) do { __builtin_amdgcn_s_setprio(1); _Pragma("unroll") for (int m = 0; m < 4; ++m) _Pragma("unroll") for (int n = 0; n < 2; ++n) { \
        if constexpr (FP8) asm volatile("s_nop 1\n\tv_mfma_scale_f32_16x16x128_f8f6f4 %0, %1, %2, %0, %3, %3 op_sel_hi:[0,0,0]" : "+v"(acc[ai][bj][m][n]) : "v"(Bt[n].v), "v"(At[m].v), "v"(sc1)); \
        else { _Pragma("unroll") for (int k = 0; k < 2; ++k) acc[ai][bj][m][n] = __builtin_amdgcn_mfma_f32_16x16x32_bf16(Bt[n].k[k], At[m].k[k], acc[ai][bj][m][n], 0, 0, 0); } } \
        __builtin_amdgcn_s_setprio(0); } while (0)
#define PG8_WAIT_V(n) asm volatile("s_waitcnt vmcnt(" #n ")" ::: "memory")
#define PG8_WAIT_L(n) asm volatile("s_waitcnt lgkmcnt(" #n ")" ::: "memory")
#define PG8_BAR __builtin_amdgcn_s_barrier()
#define PG8_SCHED __builtin_amdgcn_sched_barrier(0)
    Unit cur, nxt; int ui = 0;
    if (!S.next(0, cur)) return;
    int sc1 = 0x7F7F7F7F; asm volatile("" : "+v"(sc1));
    f32x4 acc[2][2][4][2];
#pragma unroll
    for (int a = 0; a < 2; ++a)
#pragma unroll
        for (int b = 0; b < 2; ++b)
#pragma unroll
            for (int m = 0; m < 4; ++m)
#pragma unroll
                for (int n = 0; n < 2; ++n) acc[a][b][m][n] = (f32x4){0.f, 0.f, 0.f, 0.f};
    typename FragSel<FP8>::T At[4], B0[2], B1[2];
    const char* cA = (const char*)A + (size_t)cur.arow0 * rstep + cur.akoff;
    const char* cB = cur.B;
    LAS unsigned char* const esl = lds + EPI_OFF + wid * EPI_SLICE;
    E.pre(esl, cur, wr, lane);
    PG8_STAGE(PG8_SB(0, 0), cB, voffB); PG8_STAGE(PG8_SA(0, 0), cA, voffA); PG8_STAGE(PG8_SB(0, 1), cB + hstep, voffB); PG8_STAGE(PG8_SA(0, 1), cA + hstep, voffA);
    if (wr == 1) PG8_BAR;
    PG8_WAIT_V(4); PG8_BAR;
    PG8_STAGE(PG8_SB(1, 0), cB + kstep, voffB); PG8_STAGE(PG8_SA(1, 0), cA + kstep, voffA); PG8_STAGE(PG8_SB(1, 1), cB + hstep + kstep, voffB);
    PG8_WAIT_V(6); PG8_BAR;
    for (;;) {
        const bool has_next = S.next(ui + 1, nxt);
        const char* nA = has_next ? (const char*)A + (size_t)nxt.arow0 * rstep + nxt.akoff : cA; const char* nB = has_next ? nxt.B : cB;
#pragma unroll 1
        for (int t = 0; t < nt; t += 2) {
            const bool last = (t == nt - 2);
            const char* a1 = cA + (size_t)(t + 1) * kstep;
            const char* a2 = last ? nA : cA + (size_t)(t + 2) * kstep; const char* b2 = last ? nB : cB + (size_t)(t + 2) * kstep;
            const char* a3 = a2 + kstep; const char* b3 = b2 + kstep;
            PG8_LDB(B0, 0, 0); PG8_SCHED; PG8_LDA(At, 0, 0); PG8_STAGE(PG8_SA(1, 1), a1 + hstep, voffA);
            PG8_WAIT_L(8); PG8_BAR; PG8_WAIT_L(0); PG8_MMA(0, 0, At, B0); PG8_BAR; PG8_SCHED;
            PG8_LDB(B1, 0, 1); PG8_STAGE(PG8_SB(0, 0), b2, voffB);
            PG8_BAR; PG8_WAIT_L(0); PG8_MMA(0, 1, At, B1); PG8_BAR;
            PG8_LDA(At, 0, 1); PG8_STAGE(PG8_SA(0, 0), a2, voffA);
            PG8_BAR; PG8_WAIT_L(0); PG8_MMA(1, 0, At, B0); PG8_BAR; PG8_SCHED;
            PG8_STAGE(PG8_SB(0, 1), b2 + hstep, voffB);
            PG8_WAIT_V(6); PG8_BAR; PG8_MMA(1, 1, At, B1); PG8_BAR;
            PG8_LDB(B0, 1, 0); PG8_SCHED; PG8_LDA(At, 1, 0); PG8_STAGE(PG8_SA(0, 1), a2 + hstep, voffA);
            PG8_WAIT_L(8); PG8_BAR; PG8_WAIT_L(0); PG8_MMA(0, 0, At, B0); PG8_BAR; PG8_SCHED;
            PG8_LDB(B1, 1, 1); PG8_STAGE(PG8_SB(1, 0), b3, voffB);
            PG8_BAR; PG8_WAIT_L(0); PG8_MMA(0, 1, At, B1); PG8_BAR;
            PG8_LDA(At, 1, 1); PG8_STAGE(PG8_SA(1, 0), a3, voffA);
            PG8_BAR; PG8_WAIT_L(0); PG8_MMA(1, 0, At, B0); PG8_BAR; PG8_SCHED;
            PG8_STAGE(PG8_SB(1, 1), b3 + hstep, voffB);
            PG8_WAIT_V(6); PG8_BAR; PG8_MMA(1, 1, At, B1); PG8_BAR;
        }
        if constexpr (FP8) asm volatile("s_nop 15\n\ts_nop 15" ::: "memory");
        E(acc, cur, wr, wc, fr, fq, esl);
        if (!has_next) break;
#pragma unroll
        for (int a = 0; a < 2; ++a)
#pragma unroll
            for (int b = 0; b < 2; ++b)
#pragma unroll
                for (int m = 0; m < 4; ++m)
#pragma unroll
                    for (int n = 0; n < 2; ++n) acc[a][b][m][n] = (f32x4){0.f, 0.f, 0.f, 0.f};
        cur = nxt; cA = nA; cB = nB; ++ui;
        E.pre(esl, cur, wr, lane);
        if constexpr (FP8) asm volatile("s_nop 7" ::: "memory");
    }
    PG8_WAIT_V(0);
    if (wr == 0) PG8_BAR;
    PG8_BAR;
#undef PG8_SA
#undef PG8_SB
#undef PG8_STAGE
#undef PG8_LDA
#undef PG8_LDB
#undef PG8_MMA
#undef PG8_WAIT_V
#undef PG8_WAIT_L
#undef PG8_BAR
#undef PG8_SCHED
}
}

DEVI float lb_of(const float* lbraw, int ch) {
    const float r0 = lbraw[ch], r1 = lbraw[512 + ch], r2 = lbraw[1024 + ch];
    const float mx = fmaxf(r0, fmaxf(r1, r2));
    const float e0 = __expf(r0 - mx), e1 = __expf(r1 - mx), e2 = __expf(r2 - mx);
    return e0 / (e0 + e1 + e2);
}
constexpr int HQ = 0, HK = 17408, HKH = 34816, HV = 53248, HDV = 71680, HZERO = 73728, HOT = 75776, H_END = HOT + 64 * 528;
static_assert(H_END <= 131072, "hgrn lds");
constexpr size_t HS_SCAN = (size_t)16 * 16384;
struct HgrnRaw { unsigned qf[16]; u32x4 v0, v1; };
DEVI void hgrn_load(HgrnRaw& R, const bf16_t* u, const bf16_t* VT, int dir, int b, int h, int t0, int c, int I, int tid) {
    const bf16_t* up = u + ((size_t)b * SEQ + t0 + 16 * I) * UW + h * 128 + c;
    const int fcol = dir ? 1024 : 512;
#pragma unroll
    for (int j = 0; j < 16; ++j) R.qf[j] = (unsigned)up[(size_t)j * UW] | ((unsigned)up[(size_t)j * UW + fcol] << 16);
    { const int e = tid, r = e >> 3, cch = e & 7; R.v0 = *(const u32x4*)(VT + ((size_t)b * 512 + h * 128 + r) * SEQ + t0 + cch * 8); }
    { const int e = tid + NTHR, r = e >> 3, cch = e & 7; R.v1 = *(const u32x4*)(VT + ((size_t)b * 512 + h * 128 + r) * SEQ + t0 + cch * 8); }
}
DEVI void hgrn_prep(LAS unsigned char* lds, const HgrnRaw& R, float lbv, int dir, int c, int I, int tid) {
    float ff[16], kk[16], qq[16];
    { const int e = tid, r = e >> 3, cch = e & 7; *(LAS u32x4*)(lds + HV + r * 144 + cch * 16) = R.v0; }
    { const int e = tid + NTHR, r = e >> 3, cch = e & 7; *(LAS u32x4*)(lds + HV + r * 144 + cch * 16) = R.v1; }
#pragma unroll
    for (int j = 0; j < 16; ++j) {
        const float fr = bfhi(R.qf[j]), qr = bflo(R.qf[j]);
        const float f = lbv + (1.f - lbv) * sigmoid_f(fr);
        ff[j] = f; kk[j] = 1.f - f; qq[j] = silu_f(qr);
    }
    float run = 1.f;
#pragma unroll
    for (int jj = 0; jj < 16; ++jj) { const int j = dir ? 15 - jj : jj; run = fmaxf(run * ff[j], 1e-30f); ff[j] = run; }
    const float PG = run;
    float kh[16];
#pragma unroll
    for (int j = 0; j < 16; ++j) {
        const float kt = kk[j] * __builtin_amdgcn_rcpf(ff[j]);
        kh[j] = kt * PG;
        *(LAS bf16_t*)(lds + HQ + (16 * I + j) * 272 + c * 2) = f2bf(qq[j] * ff[j]);
        *(LAS bf16_t*)(lds + HK + (16 * I + j) * 272 + c * 2) = f2bf(kt);
    }
    u32x4 w0, w1;
    w0.x = pk2(kh[0], kh[1]); w0.y = pk2(kh[2], kh[3]); w0.z = pk2(kh[4], kh[5]); w0.w = pk2(kh[6], kh[7]);
    w1.x = pk2(kh[8], kh[9]); w1.y = pk2(kh[10], kh[11]); w1.z = pk2(kh[12], kh[13]); w1.w = pk2(kh[14], kh[15]);
    *(LAS u32x4*)(lds + HKH + c * 144 + I * 32) = w0; *(LAS u32x4*)(lds + HKH + c * 144 + I * 32 + 16) = w1;
    *(LAS float*)(lds + HDV + (I * 128 + c) * 4) = PG;
}
DEVI void hgrn_update(LAS unsigned char* lds, f32x4 (&Sacc)[8], int I, int wid, int fr, int fq) {
    const int voff = (fq < 2) ? HV + (16 * wid + fr) * 144 + (16 * I + 8 * fq) * 2 : HZERO;
    const int koff = (fq < 2) ? HKH + fr * 144 + (16 * I + 8 * fq) * 2 : HZERO;
    const int kstep = (fq < 2) ? 16 * 144 : 0;
    const bf16x8 vb = *(const LAS bf16x8*)(lds + voff);
    bf16x8 ka[8]; f32x4 dv[8];
#pragma unroll
    for (int m = 0; m < 8; ++m) { ka[m] = *(const LAS bf16x8*)(lds + koff + m * kstep); dv[m] = *(const LAS f32x4*)(lds + HDV + (I * 128 + 16 * m + 4 * fq) * 4); }
#pragma unroll
    for (int m = 0; m < 8; ++m) Sacc[m] = __builtin_amdgcn_mfma_f32_16x16x32_bf16(ka[m], vb, Sacc[m] * dv[m], 0, 0, 0);
}
DEVI void ph_hgrn_states(LAS unsigned char* lds, const bf16_t* u, const bf16_t* VT, const float* lbraw, bf16_t* HS, float* HD, int vb0, int vbs) {
    const int tid = opq((int)threadIdx.x), wid = __builtin_amdgcn_readfirstlane(tid >> 6), lane = tid & 63, fr = lane & 15, fq = lane >> 4;
    const int pc = tid & 127, pI = tid >> 7;
    for (int unit = vb0; unit < NB * 4 * 2 * 16; unit += vbs) {
        const int seg = unit & 15, dir = (unit >> 4) & 1, h = (unit >> 5) & 3, b = unit >> 7;
        const float lbv = lb_of(lbraw, h * 128 + pc);
        f32x4 Sacc[8];
#pragma unroll
        for (int m = 0; m < 8; ++m) Sacc[m] = (f32x4){0.f, 0.f, 0.f, 0.f};
        float gprod = 1.f;
        if (tid < 4) *(LAS unsigned*)(lds + HZERO + tid * 4) = 0u;
        HgrnRaw R; hgrn_load(R, u, VT, dir, b, h, seg * 256 + (dir ? 3 : 0) * 64, pc, pI, tid);
#pragma unroll 1
        for (int sbi = 0; sbi < 4; ++sbi) {
            const int sb = dir ? 3 - sbi : sbi;
            const int t0 = seg * 256 + sb * 64;
            __syncthreads();
            hgrn_prep(lds, R, lbv, dir, pc, pI, tid);
            if (sbi < 3) { const int sbn = dir ? 3 - (sbi + 1) : sbi + 1; hgrn_load(R, u, VT, dir, b, h, seg * 256 + sbn * 64, pc, pI, tid); }
            __syncthreads();
            if (tid < 128) gprod *= (*(const LAS float*)(lds + HDV + tid * 4) * *(const LAS float*)(lds + HDV + (128 + tid) * 4)) * (*(const LAS float*)(lds + HDV + (256 + tid) * 4) * *(const LAS float*)(lds + HDV + (384 + tid) * 4));
#pragma unroll 1
            for (int ii = 0; ii < 4; ++ii) { const int I = dir ? 3 - ii : ii; hgrn_update(lds, Sacc, I, wid, fr, fq); }
        }
        const size_t scan = (size_t)(b * 4 + h) * 2 + dir;
        bf16_t* dst = HS + scan * HS_SCAN + (size_t)seg * 16384;
#pragma unroll
        for (int m = 0; m < 8; ++m) { u32x2 w; w.x = pk2(Sacc[m][0], Sacc[m][1]); w.y = pk2(Sacc[m][2], Sacc[m][3]);
            *(u32x2*)(dst + (16 * wid + fr) * 128 + 16 * m + 4 * fq) = w; }
        if (tid < 128) HD[(scan * 16 + seg) * 128 + tid] = gprod;
    }
    __syncthreads();
}
DEVI void ph_hgrn_scan(bf16_t* HS, const float* HD, int vb0, int vbs) {
    const int tid = opq((int)threadIdx.x);
    for (int idx = vb0 * NTHR + tid; idx < 32 * 4096; idx += vbs * NTHR) {
        const int scan = idx >> 12, e4 = idx & 4095, k4 = (e4 & 31) * 4; const int dir = scan & 1;
        u32x2* base = (u32x2*)(HS + (size_t)scan * HS_SCAN) + e4;
        const float* hd = HD + (size_t)scan * 16 * 128 + k4;
        u32x2 d[16]; float4 dec[16];
#pragma unroll
        for (int i = 0; i < 16; ++i) { d[i] = base[(size_t)i * 4096]; dec[i] = *(const float4*)(hd + i * 128); }
        float s0 = 0.f, s1 = 0.f, s2 = 0.f, s3 = 0.f;
#define HSCAN_STEP(i) { const float t0 = bflo(d[i].x), t1 = bfhi(d[i].x), t2 = bflo(d[i].y), t3 = bfhi(d[i].y); d[i].x = pk2(s0, s1); d[i].y = pk2(s2, s3); \
            s0 = s0 * dec[i].x + t0; s1 = s1 * dec[i].y + t1; s2 = s2 * dec[i].z + t2; s3 = s3 * dec[i].w + t3; }
        if (dir == 0) {
#pragma unroll
            for (int i = 0; i < 16; ++i) HSCAN_STEP(i)
        } else {
#pragma unroll
            for (int i = 15; i >= 0; --i) HSCAN_STEP(i)
        }
#undef HSCAN_STEP
#pragma unroll
        for (int i = 0; i < 16; ++i) base[(size_t)i * 4096] = d[i];
    }
}
DEVI void ph_hgrn_out(LAS unsigned char* lds, const bf16_t* u, const bf16_t* VT, const float* lbraw, const float* a_norm, const bf16_t* HS, float* OF, bf16_t* ocat, int vb0, int vbs) {
    const int tid = opq((int)threadIdx.x), wid = __builtin_amdgcn_readfirstlane(tid >> 6), lane = tid & 63, fr = lane & 15, fq = lane >> 4;
    const int pc = tid & 127, pI = tid >> 7;
    const int otok = tid >> 3, opart = tid & 7;
    for (int unit = vb0; unit < NB * 4 * 16; unit += vbs) {
        const int seg = unit & 15, h = (unit >> 4) & 3, b = unit >> 6;
        const float lbv = lb_of(lbraw, h * 128 + pc);
        if (tid < 4) *(LAS unsigned*)(lds + HZERO + tid * 4) = 0u;
#pragma unroll 1
        for (int dir = 0; dir < 2; ++dir) {
            const size_t scan = (size_t)(b * 4 + h) * 2 + dir;
            const bf16_t* src = HS + scan * HS_SCAN + (size_t)seg * 16384;
            f32x4 Sacc[8];
#pragma unroll
            for (int m = 0; m < 8; ++m) { const u32x2 w = *(const u32x2*)(src + (16 * wid + fr) * 128 + 16 * m + 4 * fq);
                Sacc[m][0] = bflo(w.x); Sacc[m][1] = bfhi(w.x); Sacc[m][2] = bflo(w.y); Sacc[m][3] = bfhi(w.y); }
            HgrnRaw R; hgrn_load(R, u, VT, dir, b, h, seg * 256 + (dir ? 3 : 0) * 64, pc, pI, tid);
#pragma unroll 1
            for (int sbi = 0; sbi < 4; ++sbi) {
                const int sb = dir ? 3 - sbi : sbi;
                const int t0 = seg * 256 + sb * 64;
                const size_t tokb = (size_t)b * SEQ + t0;
                __syncthreads();
                hgrn_prep(lds, R, lbv, dir, pc, pI, tid);
                if (sbi < 3) { const int sbn = dir ? 3 - (sbi + 1) : sbi + 1; hgrn_load(R, u, VT, dir, b, h, seg * 256 + sbn * 64, pc, pI, tid); }
                __syncthreads();
#pragma unroll 1
                for (int ii = 0; ii < 4; ++ii) {
                    const int I = dir ? 3 - ii : ii;
                    f32x4 oT = {0.f, 0.f, 0.f, 0.f};
                    const LAS unsigned char* qrow = lds + HQ + (16 * I + fr) * 272;
#pragma unroll
                    for (int ks = 0; ks < 4; ++ks) {
                        u32x4 sa; sa.x = pg8::cvt_pk_bf16(Sacc[2 * ks][0], Sacc[2 * ks][1]); sa.y = pg8::cvt_pk_bf16(Sacc[2 * ks][2], Sacc[2 * ks][3]);
                        sa.z = pg8::cvt_pk_bf16(Sacc[2 * ks + 1][0], Sacc[2 * ks + 1][1]); sa.w = pg8::cvt_pk_bf16(Sacc[2 * ks + 1][2], Sacc[2 * ks + 1][3]);
                        const u32x2 q0 = *(const LAS u32x2*)(qrow + (32 * ks + 4 * fq) * 2), q1 = *(const LAS u32x2*)(qrow + (32 * ks + 16 + 4 * fq) * 2);
                        u32x4 qb; qb.x = q0.x; qb.y = q0.y; qb.z = q1.x; qb.w = q1.y;
                        oT = __builtin_amdgcn_mfma_f32_16x16x32_bf16(__builtin_bit_cast(bf16x8, sa), __builtin_bit_cast(bf16x8, qb), oT, 0, 0, 0);
                    }
                    f32x4 sT = {0.f, 0.f, 0.f, 0.f};
                    const LAS unsigned char* krow = lds + HK + (16 * I + fr) * 272;
#pragma unroll
                    for (int ks = 0; ks < 4; ++ks) {
                        const bf16x8 ka = *(const LAS bf16x8*)(krow + (32 * ks + 8 * fq) * 2), qb = *(const LAS bf16x8*)(qrow + (32 * ks + 8 * fq) * 2);
                        sT = __builtin_amdgcn_mfma_f32_16x16x32_bf16(ka, qb, sT, 0, 0, 0);
                    }
                    float pv[4];
#pragma unroll
                    for (int rg = 0; rg < 4; ++rg) { const int sl = 4 * fq + rg; const bool ok = dir ? (sl >= fr) : (sl <= fr); pv[rg] = ok ? sT[rg] : 0.f; }
                    u32x4 pb; pb.x = pg8::cvt_pk_bf16(pv[0], pv[1]); pb.y = pg8::cvt_pk_bf16(pv[2], pv[3]); pb.z = 0u; pb.w = 0u;
                    const u32x2 v0 = *(const LAS u32x2*)(lds + HV + (16 * wid + fr) * 144 + (16 * I + 4 * fq) * 2);
                    u32x4 va; va.x = v0.x; va.y = v0.y; va.z = 0u; va.w = 0u;
                    oT = __builtin_amdgcn_mfma_f32_16x16x32_bf16(__builtin_bit_cast(bf16x8, va), __builtin_bit_cast(bf16x8, pb), oT, 0, 0, 0);
                    if (dir == 0) *(f32x4*)(OF + (tokb + 16 * I + fr) * 512 + h * 128 + 16 * wid + 4 * fq) = oT;
                    else *(LAS f32x4*)(lds + HOT + (16 * I + fr) * 528 + (16 * wid + 4 * fq) * 4) = oT;
                    hgrn_update(lds, Sacc, I, wid, fr, fq);
                }
                if (dir == 1) {
                    __syncthreads();
                    const LAS float* orow = (const LAS float*)(lds + HOT + otok * 528) + opart * 16;
                    float* ofp = OF + (tokb + otok) * 512 + h * 128 + opart * 16;
                    float v[16]; float ss = 0.f;
#pragma unroll
                    for (int q2 = 0; q2 < 8; ++q2) { const unsigned long long w = __hip_atomic_load((unsigned long long*)(ofp + q2 * 2), __ATOMIC_RELAXED, __HIP_MEMORY_SCOPE_AGENT);
                        v[2 * q2] = __uint_as_float((unsigned)w) + orow[2 * q2]; v[2 * q2 + 1] = __uint_as_float((unsigned)(w >> 32)) + orow[2 * q2 + 1];
                        ss += v[2 * q2] * v[2 * q2] + v[2 * q2 + 1] * v[2 * q2 + 1]; }
                    ss += __shfl_xor(ss, 1); ss += __shfl_xor(ss, 2); ss += __shfl_xor(ss, 4);
                    const float rn = rsqrtf(ss * (1.f / 128.f) + EPS);
                    const bf16_t* gp = u + (tokb + otok) * UW + 2048 + h * 128 + opart * 16;
                    const u32x4 g0 = *(const u32x4*)gp, g1 = *(const u32x4*)(gp + 8);
                    const unsigned gw[8] = {g0.x, g0.y, g0.z, g0.w, g1.x, g1.y, g1.z, g1.w};
                    unsigned ow[8];
#pragma unroll
                    for (int q2 = 0; q2 < 8; ++q2) { const float an0 = a_norm[opart * 16 + 2 * q2], an1 = a_norm[opart * 16 + 2 * q2 + 1];
                        ow[q2] = pk2(v[2 * q2] * rn * an0 * silu_f(bflo(gw[q2])), v[2 * q2 + 1] * rn * an1 * silu_f(bfhi(gw[q2]))); }
                    bf16_t* op = ocat + (tokb + otok) * DM + h * 128 + opart * 16;
                    u32x4 o0, o1; o0.x = ow[0]; o0.y = ow[1]; o0.z = ow[2]; o0.w = ow[3]; o1.x = ow[4]; o1.y = ow[5]; o1.z = ow[6]; o1.w = ow[7];
                    *(u32x4*)op = o0; *(u32x4*)(op + 8) = o1;
                }
            }
            asm volatile("s_waitcnt vmcnt(0)" ::: "memory");
        }
    }
    __syncthreads();
}

DEVI void ph_prep(const bf16_t* u, const float* cw, const float* cb, bf16_t* xconv, bf16_t* XT, bf16_t* VT, int vb0, int vbs) {
    const int tid = opq((int)threadIdx.x);
    for (int unit = vb0; unit < NB * 32 * 3; unit += vbs) {
        const int cg = unit % 3, tb = (unit / 3) & 31, b = unit / 96;
        const int t0 = tb * 128;
        if (cg < 2) {
            const int ch = cg * 512 + tid;
            float w[5];
#pragma unroll
            for (int j = 0; j < 5; ++j) w[j] = cw[j * 1024 + ch];
            const float bias = cb[ch];
            const bf16_t* up = u + (size_t)b * SEQ * UW + 3072 + ch;
            float v0, v1, v2, v3;
            v0 = (t0 - 2 >= 0) ? bf2f(up[(size_t)(t0 - 2) * UW]) : 0.f;
            v1 = (t0 - 1 >= 0) ? bf2f(up[(size_t)(t0 - 1) * UW]) : 0.f;
            v2 = bf2f(up[(size_t)t0 * UW]);
            v3 = bf2f(up[(size_t)(t0 + 1) * UW]);
            for (int t8 = 0; t8 < 128; t8 += 32) {
                float nx[32];
#pragma unroll
                for (int i = 0; i < 32; ++i) { const int tt = t0 + t8 + i + 2; nx[i] = (tt < SEQ) ? bf2f(up[(size_t)tt * UW]) : 0.f; }
                unsigned pk[16];
#pragma unroll
                for (int i = 0; i < 32; ++i) {
                    const float o = silu_f(bias + w[0] * v0 + w[1] * v1 + w[2] * v2 + w[3] * v3 + w[4] * nx[i]);
                    const bf16_t ob = f2bf(o);
                    xconv[(size_t)(b * SEQ + t0 + t8 + i) * 1024 + ch] = ob;
                    if (i & 1) pk[i >> 1] |= ((unsigned)ob << 16); else pk[i >> 1] = ob;
                    v0 = v1; v1 = v2; v2 = v3; v3 = nx[i];
                }
                if (ch < 768) {
#pragma unroll
                    for (int q = 0; q < 4; ++q) { u32x4 o4; o4.x = pk[4 * q]; o4.y = pk[4 * q + 1]; o4.z = pk[4 * q + 2]; o4.w = pk[4 * q + 3]; *(u32x4*)(XT + ((size_t)b * 768 + ch) * SEQ + t0 + t8 + 8 * q) = o4; } }
            }
        } else {
            const int ch = tid;
            const bf16_t* up = u + (size_t)b * SEQ * UW + 1536 + ch;
            for (int t8 = 0; t8 < 128; t8 += 32) {
                unsigned pk[16];
#pragma unroll
                for (int i = 0; i < 32; ++i) { const unsigned ob = up[(size_t)(t0 + t8 + i) * UW]; if (i & 1) pk[i >> 1] |= (ob << 16); else pk[i >> 1] = ob; }
#pragma unroll
                for (int q = 0; q < 4; ++q) { u32x4 o4; o4.x = pk[4 * q]; o4.y = pk[4 * q + 1]; o4.z = pk[4 * q + 2]; o4.w = pk[4 * q + 3]; *(u32x4*)(VT + ((size_t)b * 512 + ch) * SEQ + t0 + t8 + 8 * q) = o4; }
            }
        }
    }
}

constexpr int MB_XT = 0, MB_BX = 256 * 272, MB_DT = MB_BX + 128 * 272, MB_CS = MB_DT + 8 * 128 * 4, MB_TOT = MB_CS + 8 * 128 * 4, MB_END = MB_TOT + 64;
static_assert(MB_END <= 131072, "mamba lds");
constexpr size_t MS_SCAN = (size_t)32 * 8192;
DEVI bf16x8 pack8(const float* v) { u32x4 w; w.x = pg8::cvt_pk_bf16(v[0], v[1]); w.y = pg8::cvt_pk_bf16(v[2], v[3]); w.z = pg8::cvt_pk_bf16(v[4], v[5]); w.w = pg8::cvt_pk_bf16(v[6], v[7]); return __builtin_bit_cast(bf16x8, w); }
DEVI void mamba_tables(LAS unsigned char* lds, const float* dtraw, const float* A_log, const float* dt_bias, int b, int g, int c, int wid, int lane) {
    LAS float* tdt = (LAS float*)(lds + MB_DT); LAS float* tcs = (LAS float*)(lds + MB_CS); LAS float* ttot = (LAS float*)(lds + MB_TOT);
    const int r = wid >> 1, dir = wid & 1, hd = 4 * g + r;
    const float A = -__expf(A_log[dir * 8 + hd]), bias = dt_bias[dir * 8 + hd];
    const size_t tk = (size_t)b * SEQ + c * 128 + 2 * lane;
    const float dt0 = softplus_f(dtraw[tk * 16 + dir * 8 + hd] + bias), dt1 = softplus_f(dtraw[(tk + 1) * 16 + dir * 8 + hd] + bias);
    const float a0 = dt0 * A, a1 = dt1 * A;
    float sc = a0 + a1;
#pragma unroll
    for (int off = 1; off < 64; off <<= 1) { const float v = __shfl_up(sc, off); if (lane >= off) sc += v; }
    const float total = __shfl(sc, 63);
    const float pre0 = sc - a1, pre1 = sc;
    const float c0 = dir ? (total - pre0 + a0) : pre0, c1 = dir ? (total - pre1 + a1) : pre1;
    tdt[wid * 128 + 2 * lane] = dt0; tdt[wid * 128 + 2 * lane + 1] = dt1;
    tcs[wid * 128 + 2 * lane] = c0; tcs[wid * 128 + 2 * lane + 1] = c1;
    if (lane == 0) ttot[wid] = total;
}
DEVI void stage_rows(LAS unsigned char* dst, const bf16_t* src, size_t src_stride, int rows, int tid) {
    for (int e = tid; e < rows * 16; e += NTHR) { const int r = e >> 4, cch = e & 15; *(LAS u32x4*)(dst + r * 272 + cch * 16) = *(const u32x4*)(src + (size_t)r * src_stride + cch * 8); }
}
DEVI void ph_mamba_states(LAS unsigned char* lds, const bf16_t* XT, const float* dtraw, const float* A_log, const float* dt_bias, bf16_t* MS, float* MD, int vb0, int vbs) {
    const int tid = opq((int)threadIdx.x), wid = __builtin_amdgcn_readfirstlane(tid >> 6), lane = tid & 63, fr = lane & 15, fq = lane >> 4;
    LAS float* tdt = (LAS float*)(lds + MB_DT); LAS float* tcs = (LAS float*)(lds + MB_CS); LAS float* ttot = (LAS float*)(lds + MB_TOT);
    for (int unit = vb0; unit < NB * 2 * 32; unit += vbs) {
        const int c = unit & 31, g = (unit >> 5) & 1, b = unit >> 6;
        __syncthreads();
        stage_rows(lds + MB_XT, XT + ((size_t)b * 768 + g * 256) * SEQ + c * 128, SEQ, 256, tid);
        stage_rows(lds + MB_BX, XT + ((size_t)b * 768 + 512 + g * 128) * SEQ + c * 128, SEQ, 128, tid);
        mamba_tables(lds, dtraw, A_log, dt_bias, b, g, c, wid, lane);
        __syncthreads();
        if (lane == 0) MD[((size_t)(b * 8 + 4 * g + (wid >> 1)) * 2 + (wid & 1)) * 32 + c] = __expf(ttot[wid]);
        for (int hdd = 0; hdd < 8; ++hdd) {
            const int r = hdd >> 1, dir = hdd & 1, hd = 4 * g + r;
            const float tot = ttot[hdd];
            f32x4 acc[4];
#pragma unroll
            for (int pt = 0; pt < 4; ++pt) acc[pt] = (f32x4){0.f, 0.f, 0.f, 0.f};
#pragma unroll
            for (int ks = 0; ks < 4; ++ks) {
                const int s0 = 32 * ks + 8 * fq;
                const u32x4 braw = *(const LAS u32x4*)(lds + MB_BX + (16 * wid + fr) * 272 + s0 * 2);
                float bw[8];
                const unsigned bu[4] = {braw.x, braw.y, braw.z, braw.w};
#pragma unroll
                for (int j = 0; j < 8; ++j) { const float bv = (j & 1) ? bfhi(bu[j >> 1]) : bflo(bu[j >> 1]);
                    bw[j] = bv * tdt[hdd * 128 + s0 + j] * __expf(tot - tcs[hdd * 128 + s0 + j]); }
                const bf16x8 Bf = pack8(bw);
#pragma unroll
                for (int pt = 0; pt < 4; ++pt) {
                    const bf16x8 Af = *(const LAS bf16x8*)(lds + MB_XT + (r * 64 + 16 * pt + fr) * 272 + s0 * 2);
                    acc[pt] = __builtin_amdgcn_mfma_f32_16x16x32_bf16(Bf, Af, acc[pt], 0, 0, 0);
                }
            }
            bf16_t* dst = MS + ((size_t)(b * 8 + hd) * 2 + dir) * MS_SCAN + (size_t)c * 8192;
#pragma unroll
            for (int pt = 0; pt < 4; ++pt) { u32x2 w; w.x = pk2(acc[pt][0], acc[pt][1]); w.y = pk2(acc[pt][2], acc[pt][3]);
                *(u32x2*)(dst + (16 * pt + fr) * 128 + 16 * wid + 4 * fq) = w; }
        }
    }
    __syncthreads();
}
DEVI void ph_mamba_scan(bf16_t* MS, const float* MD, int vb0, int vbs) {
    const int tid = opq((int)threadIdx.x);
    for (int idx = vb0 * NTHR + tid; idx < 64 * 2048; idx += vbs * NTHR) {
        const int scan = idx >> 11, e4 = idx & 2047; const int dir = scan & 1;
        u32x2* base = (u32x2*)(MS + (size_t)scan * MS_SCAN) + e4;
        const float* md = MD + (size_t)scan * 32;
        float h0 = 0.f, h1 = 0.f, h2 = 0.f, h3 = 0.f;
#pragma unroll 1
        for (int half = 0; half < 2; ++half) {
            const int c0 = (dir ? 1 - half : half) * 16;
            u32x2 d[16]; float dec[16];
#pragma unroll
            for (int i = 0; i < 16; ++i) { d[i] = base[(size_t)(c0 + i) * 2048]; dec[i] = md[c0 + i]; }
#define MSCAN_STEP(i) { const float t0 = bflo(d[i].x), t1 = bfhi(d[i].x), t2 = bflo(d[i].y), t3 = bfhi(d[i].y); d[i].x = pk2(h0, h1); d[i].y = pk2(h2, h3); \
                h0 = h0 * dec[i] + t0; h1 = h1 * dec[i] + t1; h2 = h2 * dec[i] + t2; h3 = h3 * dec[i] + t3; }
            if (dir == 0) {
#pragma unroll
                for (int i = 0; i < 16; ++i) MSCAN_STEP(i)
            } else {
#pragma unroll
                for (int i = 15; i >= 0; --i) MSCAN_STEP(i)
            }
#undef MSCAN_STEP
#pragma unroll
            for (int i = 0; i < 16; ++i) base[(size_t)(c0 + i) * 2048] = d[i];
        }
    }
}
DEVI void ph_mamba_out(LAS unsigned char* lds, const bf16_t* u, const bf16_t* xconv, const bf16_t* XT, const float* dtraw, const float* A_log, const float* dt_bias, const float* Dskip, const float* b_norm,
                       const bf16_t* MS, bf16_t* ocat, int vb0, int vbs) {
    const int tid = opq((int)threadIdx.x), wid = __builtin_amdgcn_readfirstlane(tid >> 6), lane = tid & 63, fr = lane & 15, fq = lane >> 4;
    LAS float* tdt = (LAS float*)(lds + MB_DT); LAS float* tcs = (LAS float*)(lds + MB_CS);
    for (int unit = vb0; unit < NB * 2 * 32; unit += vbs) {
        const int c = unit & 31, g = (unit >> 5) & 1, b = unit >> 6;
        const size_t tok0 = (size_t)b * SEQ + c * 128;
        __syncthreads();
        stage_rows(lds + MB_XT, XT + ((size_t)b * 768 + g * 256) * SEQ + c * 128, SEQ, 256, tid);
        stage_rows(lds + MB_BX, xconv + tok0 * 1024 + 512 + g * 128, 1024, 128, tid);
        mamba_tables(lds, dtraw, A_log, dt_bias, b, g, c, wid, lane);
        const int tl = 16 * wid + fr;
        bf16x8 Cf[4];
#pragma unroll
        for (int ks = 0; ks < 4; ++ks) Cf[ks] = *(const bf16x8*)(xconv + (tok0 + tl) * 1024 + 768 + g * 128 + 32 * ks + 8 * fq);
        __syncthreads();
        f32x4 GT[8];
#pragma unroll
        for (int st = 0; st < 8; ++st) { GT[st] = (f32x4){0.f, 0.f, 0.f, 0.f};
            bf16x8 Af[4];
#pragma unroll
            for (int ks = 0; ks < 4; ++ks) Af[ks] = *(const LAS bf16x8*)(lds + MB_BX + (16 * st + fr) * 272 + (32 * ks + 8 * fq) * 2);
#pragma unroll
            for (int ks = 0; ks < 4; ++ks) GT[st] = __builtin_amdgcn_mfma_f32_16x16x32_bf16(Af[ks], Cf[ks], GT[st], 0, 0, 0); }
        float ss = 0.f;
        __syncthreads();
        u32x2 hpre[4];
        { const bf16_t* hin0 = MS + ((size_t)(b * 8 + 4 * g) * 2) * MS_SCAN + (size_t)c * 8192;
#pragma unroll
          for (int q = 0; q < 4; ++q) hpre[q] = ((const u32x2*)hin0)[tid + q * NTHR]; }
#pragma unroll 1
        for (int r = 0; r < 4; ++r) {
            const int hd = 4 * g + r;
            f32x4 yv[4];
#pragma unroll
            for (int pt = 0; pt < 4; ++pt) yv[pt] = (f32x4){0.f, 0.f, 0.f, 0.f};
#pragma unroll 1
            for (int dir = 0; dir < 2; ++dir) {
                const int hdd = r * 2 + dir;
                const float cst = tcs[hdd * 128 + tl];
                LAS unsigned char* hbuf = lds + MB_BX + (hdd & 1) * 17408;
#pragma unroll
                for (int q = 0; q < 4; ++q) { const int e4 = tid + q * NTHR, pp = e4 >> 5, n4 = (e4 & 31) * 4;
                    *(LAS u32x2*)(hbuf + pp * 272 + n4 * 2) = hpre[q]; }
                if (hdd < 7) { const int hn = hdd + 1; const bf16_t* hinn = MS + ((size_t)(b * 8 + 4 * g + (hn >> 1)) * 2 + (hn & 1)) * MS_SCAN + (size_t)c * 8192;
#pragma unroll
                    for (int q = 0; q < 4; ++q) hpre[q] = ((const u32x2*)hinn)[tid + q * NTHR]; }
                __syncthreads();
                f32x4 yo[4];
#pragma unroll
                for (int pt = 0; pt < 4; ++pt) { yo[pt] = (f32x4){0.f, 0.f, 0.f, 0.f};
                    bf16x8 hf[4];
#pragma unroll
                    for (int ks = 0; ks < 4; ++ks) hf[ks] = *(const LAS bf16x8*)(hbuf + (16 * pt + fr) * 272 + (32 * ks + 8 * fq) * 2);
#pragma unroll
                    for (int ks = 0; ks < 4; ++ks) yo[pt] = __builtin_amdgcn_mfma_f32_16x16x32_bf16(hf[ks], Cf[ks], yo[pt], 0, 0, 0); }
                const float eo = __expf(cst);
#pragma unroll
                for (int pt = 0; pt < 4; ++pt) yv[pt] += yo[pt] * eo;
#pragma unroll
                for (int kp = 0; kp < 4; ++kp) {
                    const bool skip = dir ? (2 * kp + 1 < wid) : (2 * kp > wid);
                    if (!skip) {
                        float pv[8];
#pragma unroll
                        for (int hlf = 0; hlf < 2; ++hlf) { const int st = 2 * kp + hlf;
                            const f32x4 cs4 = *(const LAS f32x4*)(tcs + hdd * 128 + 16 * st + 4 * fq), dt4 = *(const LAS f32x4*)(tdt + hdd * 128 + 16 * st + 4 * fq);
#pragma unroll
                            for (int rg = 0; rg < 4; ++rg) { const int sl = 16 * st + 4 * fq + rg;
                                const bool ok = dir ? (sl >= tl) : (sl <= tl);
                                const float e = __expf(fminf(cst - cs4[rg], 0.f));
                                pv[hlf * 4 + rg] = ok ? GT[st][rg] * e * dt4[rg] : 0.f; } }
                        u32x2 x0[4], x1[4];
#pragma unroll
                        for (int pt = 0; pt < 4; ++pt) { const LAS unsigned char* xr = lds + MB_XT + (r * 64 + 16 * pt + fr) * 272;
                            x0[pt] = *(const LAS u32x2*)(xr + (32 * kp + 4 * fq) * 2); x1[pt] = *(const LAS u32x2*)(xr + (32 * kp + 16 + 4 * fq) * 2); }
                        const bf16x8 Pf = pack8(pv);
#pragma unroll
                        for (int pt = 0; pt < 4; ++pt) {
                            u32x4 xa; xa.x = x0[pt].x; xa.y = x0[pt].y; xa.z = x1[pt].x; xa.w = x1[pt].y;
                            yv[pt] = __builtin_amdgcn_mfma_f32_16x16x32_bf16(__builtin_bit_cast(bf16x8, xa), Pf, yv[pt], 0, 0, 0);
                        }
                    }
                }
            }
            const float Dk = Dskip[hd];
#pragma unroll
            for (int pt = 0; pt < 4; ++pt) {
                const int p0 = 16 * pt + 4 * fq;
                const u32x2 xr = *(const u32x2*)(xconv + (tok0 + tl) * 1024 + hd * 64 + p0);
                const u32x2 zr = *(const u32x2*)(u + (tok0 + tl) * UW + 2560 + hd * 64 + p0);
                const float xs[4] = {bflo(xr.x), bfhi(xr.x), bflo(xr.y), bfhi(xr.y)}, zs[4] = {bflo(zr.x), bfhi(zr.x), bflo(zr.y), bfhi(zr.y)};
                float yy[4];
#pragma unroll
                for (int rg = 0; rg < 4; ++rg) { const float y = (yv[pt][rg] + Dk * xs[rg]) * silu_f(zs[rg]); yy[rg] = y; ss += y * y; }
                const unsigned long long o = (unsigned long long)pk2(yy[0], yy[1]) | ((unsigned long long)pk2(yy[2], yy[3]) << 32);
                __hip_atomic_store((unsigned long long*)(ocat + (tok0 + tl) * DM + 512 + g * 256 + r * 64 + p0), o, __ATOMIC_RELAXED, __HIP_MEMORY_SCOPE_AGENT);
            }
        }
        ss += __shfl_xor(ss, 16); ss += __shfl_xor(ss, 32);
        const float rn = rsqrtf(ss * (1.f / 256.f) + EPS);
        asm volatile("s_waitcnt vmcnt(0)" ::: "memory");
        unsigned long long pk[16];
#pragma unroll
        for (int q = 0; q < 16; ++q) pk[q] = __hip_atomic_load((unsigned long long*)(ocat + (tok0 + tl) * DM + 512 + g * 256 + (q >> 2) * 64 + 16 * (q & 3) + 4 * fq), __ATOMIC_RELAXED, __HIP_MEMORY_SCOPE_AGENT);
#pragma unroll
        for (int r = 0; r < 4; ++r)
#pragma unroll
            for (int pt = 0; pt < 4; ++pt) {
                const int cc = g * 256 + r * 64 + 16 * pt + 4 * fq;
                unsigned long long* op = (unsigned long long*)(ocat + (tok0 + tl) * DM + 512 + cc);
                const unsigned long long v = pk[r * 4 + pt];
                const unsigned vlo = (unsigned)v, vhi = (unsigned)(v >> 32);
                const float4 bn = *(const float4*)(b_norm + cc);
                const unsigned long long o = (unsigned long long)pk2(bflo(vlo) * rn * bn.x, bfhi(vlo) * rn * bn.y) | ((unsigned long long)pk2(bflo(vhi) * rn * bn.z, bfhi(vhi) * rn * bn.w) << 32);
                *op = o;
            }
    }
    __syncthreads();
}


constexpr int NA_RING = 12, NA_VT = 0, NA_VSTRIDE = NA_RING * 64 * 2 + 16, NA_BIAS = 64 * NA_VSTRIDE, NA_END = NA_BIAS + 480 * 4;
static_assert(NA_END <= 131072, "na lds");
DEVI void ph_na(LAS unsigned char* lds, const bf16_t* qkv, const float* rpb, bf16_t* oc, int vb0, int vbs) {
    const int tid = opq((int)threadIdx.x), wid = __builtin_amdgcn_readfirstlane(tid >> 6), lane = tid & 63, fr = lane & 15, fq = lane >> 4;
    LAS float* bl = (LAS float*)(lds + NA_BIAS);
    for (int chunk = vb0; chunk < NB * 16 * 4; chunk += vbs) {
        const int qr4 = chunk & 3, h = (chunk >> 2) & 15, b = chunk >> 6;
        __syncthreads();
        for (int e = tid; e < 465; e += NTHR) bl[e] = rpb[h * 465 + e];
        int staged_hi = -1;
#pragma unroll 1
        for (int ui = 0; ui < 8; ++ui) {
            const int rp = qr4 * 8 + ui;
            const int r0 = 2 * rp, rs0 = min(max(r0 - 4, 0), 56);
            const int need_hi = min(rs0 + 8, 63);
            const int lo = max(staged_hi + 1, rs0);
            for (int task = wid; task < (need_hi - lo + 1) * 8; task += 8) {
                const int kr = lo + (task >> 3), ch = task & 7, slot = kr % NA_RING;
                const u32x4 v = *(const u32x4*)(qkv + ((size_t)b * SEQ + kr * 64 + lane) * 3072 + 2048 + h * 64 + ch * 8);
                const unsigned vw[4] = {v.x, v.y, v.z, v.w};
#pragma unroll
                for (int i = 0; i < 8; ++i) *(LAS bf16_t*)(lds + NA_VT + (ch * 8 + i) * NA_VSTRIDE + (slot * 64 + lane) * 2) = (bf16_t)((i & 1) ? (vw[i >> 1] >> 16) : (vw[i >> 1] & 0xffffu));
            }
            staged_hi = need_hi > staged_hi ? need_hi : staged_hi;
            __syncthreads();
            const int r = r0 + (wid >> 2), j = wid & 3;
            const int rs = min(max(r - 4, 0), 56);
            const int bs = (j == 0) ? 0 : (j == 1) ? 8 : (j == 2) ? 24 : 32;
            const int c = 16 * j + fr, qs = min(max(c - 8, 0), 48);
            const size_t qtok = (size_t)b * SEQ + r * 64 + c;
            bf16x8 Qf[2];
#pragma unroll
            for (int ks = 0; ks < 2; ++ks) Qf[ks] = *(const bf16x8*)(qkv + qtok * 3072 + h * 64 + 32 * ks + 8 * fq);
            const bf16_t* kbase = qkv + ((size_t)b * SEQ + rs * 64 + bs + fr) * 3072 + 1024 + h * 64 + 8 * fq;
            bf16x8 kn[4];
#pragma unroll
            for (int q = 0; q < 4; ++q) kn[q] = *(const bf16x8*)(kbase + (size_t)((q >> 1) * 16) * 3072 + (q & 1) * 32);
            f32x4 O[4];
#pragma unroll
            for (int dt = 0; dt < 4; ++dt) O[dt] = (f32x4){0.f, 0.f, 0.f, 0.f};
            float mrun = -1e30f, lrun = 0.f;
#pragma unroll 1
            for (int dr = 0; dr < 8; ++dr) {
                bf16x8 kc[4];
#pragma unroll
                for (int q = 0; q < 4; ++q) kc[q] = kn[q];
                const int drn = dr < 7 ? dr + 1 : 7;
#pragma unroll
                for (int q = 0; q < 4; ++q) kn[q] = *(const bf16x8*)(kbase + ((size_t)drn * 64 + (q >> 1) * 16) * 3072 + (q & 1) * 32);
                float sv[8]; float mloc = -1e30f;
                const LAS float* brow = bl + (rs + dr - r + 7) * 31;
#pragma unroll
                for (int kg = 0; kg < 2; ++kg) {
                    f32x4 acc = {0.f, 0.f, 0.f, 0.f};
                    acc = __builtin_amdgcn_mfma_f32_16x16x32_bf16(kc[kg * 2], Qf[0], acc, 0, 0, 0);
                    acc = __builtin_amdgcn_mfma_f32_16x16x32_bf16(kc[kg * 2 + 1], Qf[1], acc, 0, 0, 0);
#pragma unroll
                    for (int rg = 0; rg < 4; ++rg) {
                        const int kcol = bs + 16 * kg + 4 * fq + rg;
                        const bool ok = (kcol >= qs) && (kcol < qs + 16);
                        const int dc = min(max(kcol - c + 15, 0), 30);
                        const float sc = ok ? acc[rg] * 0.125f + brow[dc] : -1e30f;
                        sv[kg * 4 + rg] = sc; mloc = fmaxf(mloc, sc);
                    }
                }
                mloc = fmaxf(mloc, __shfl_xor(mloc, 16)); mloc = fmaxf(mloc, __shfl_xor(mloc, 32));
                const float mnew = fmaxf(mrun, mloc);
                const float alpha = __expf(mrun - mnew);
                float psum = 0.f;
#pragma unroll
                for (int i = 0; i < 8; ++i) { const float p = __expf(sv[i] - mnew); sv[i] = p; psum += p; }
                psum += __shfl_xor(psum, 16); psum += __shfl_xor(psum, 32);
                lrun = lrun * alpha + psum; mrun = mnew;
                const bf16x8 Pf = pack8(sv);
                const int koff = (((rs + dr) % NA_RING) * 64 + bs + 4 * fq) * 2;
#pragma unroll
                for (int dt = 0; dt < 4; ++dt) {
                    const LAS unsigned char* vr = lds + NA_VT + (16 * dt + fr) * NA_VSTRIDE + koff;
                    const u32x2 v0 = *(const LAS u32x2*)vr, v1 = *(const LAS u32x2*)(vr + 32);
                    u32x4 va; va.x = v0.x; va.y = v0.y; va.z = v1.x; va.w = v1.y;
                    O[dt] = __builtin_amdgcn_mfma_f32_16x16x32_bf16(__builtin_bit_cast(bf16x8, va), Pf, O[dt] * alpha, 0, 0, 0);
                }
            }
            const float il = 1.f / lrun;
#pragma unroll
            for (int dt = 0; dt < 4; ++dt) {
                u32x2 o; o.x = pk2(O[dt][0] * il, O[dt][1] * il); o.y = pk2(O[dt][2] * il, O[dt][3] * il);
                *(u32x2*)(oc + qtok * DM + h * 64 + 16 * dt + 4 * fq) = o;
            }
        }
    }
    __syncthreads();
}

#define XB_TMO      128
#define XB_XCNT(j)  (256  + 64 * (j))
#define XB_XSUB(j)  (1280 + 64 * (j))
#define XB_XGEN(j)  (2304 + 64 * (j))
#define XB_TOP      3328
#define XB_TOPGEN   3392
#define XCD_BAR_WORDS 3456
#define XB_SPIN_CAP (1u << 18)

__device__ __forceinline__ unsigned xb_ld(unsigned* p)              { return __hip_atomic_load(p, __ATOMIC_RELAXED, __HIP_MEMORY_SCOPE_AGENT); }
__device__ __forceinline__ unsigned xb_add(unsigned* p, unsigned v) { return __hip_atomic_fetch_add(p, v, __ATOMIC_RELAXED, __HIP_MEMORY_SCOPE_AGENT); }
__device__ __forceinline__ unsigned xb_xcc_id() { return (unsigned)__builtin_amdgcn_s_getreg((3 << 11) | 20) & 0xFu; }
#define XB_SPIN(cond, bar) do { unsigned _sp = 0; while (cond) { __builtin_amdgcn_s_sleep(1); \
    if ((++_sp & 255u) == 0u) { if (xb_ld(&(bar)[XB_TMO])) break; if (_sp > XB_SPIN_CAP) { atomicAdd(&(bar)[XB_TMO], 1u); break; } } } } while (0)

struct XcdBarrier {
    unsigned* bar; unsigned x;
    volatile LAS unsigned* st;
};

__device__ __forceinline__ XcdBarrier xcd_barrier_post(unsigned* bar, volatile LAS unsigned* st) {
    XcdBarrier b; b.bar = bar; b.x = xb_xcc_id(); b.st = st;
    if (threadIdx.x == 0) (void)xb_add(&bar[XB_XCNT(b.x)], 1u);
    return b;
}
__device__ __forceinline__ void xcd_barrier_complete(unsigned* bar, unsigned x, unsigned& nloc, unsigned& nx) {
    const unsigned G = gridDim.x * gridDim.y * gridDim.z;
    unsigned sum, cnt, mine, sp = 0u;
    for (;;) {
        sum = 0u; cnt = 0u; mine = 0u;
#pragma unroll
        for (unsigned j = 0; j < 16; ++j) { const unsigned c = xb_ld(&bar[XB_XCNT(j)]); sum += c; cnt += (c > 0u) ? 1u : 0u; mine = (j == x) ? c : mine; }
        if (sum == G) break;
        __builtin_amdgcn_s_sleep(1);
        if ((++sp & 255u) == 0u) { if (xb_ld(&bar[XB_TMO])) break; if (sp > XB_SPIN_CAP) { atomicAdd(&bar[XB_TMO], 1u); break; } }
    }
    nloc = mine > 0u ? mine : 1u; nx = cnt > 0u ? cnt : 1u;
}

__device__ __forceinline__ void xcd_barrier(const XcdBarrier& b) {
    asm volatile("s_waitcnt vmcnt(0)" ::: "memory");
    __syncthreads();
    if (threadIdx.x == 0) {
        unsigned* bar = b.bar;
        __builtin_amdgcn_s_waitcnt(0);
        unsigned nloc = b.st[0], nx = b.st[1];
        if (nloc == 0u) { xcd_barrier_complete(bar, b.x, nloc, nx); b.st[0] = nloc; b.st[1] = nx; }
        const unsigned old = xb_add(&bar[XB_XSUB(b.x)], 1u);
        const unsigned gen = old / nloc;
        if (old + 1u == (gen + 1u) * nloc) {
            __builtin_amdgcn_fence(__ATOMIC_RELEASE, "agent");
            asm volatile("s_waitcnt vmcnt(0)" ::: "memory");
            const unsigned og = xb_add(&bar[XB_TOP], 1u);
            const unsigned tg = og / nx;
            if (og + 1u == (tg + 1u) * nx) xb_add(&bar[XB_TOPGEN], 1u);
            else XB_SPIN(xb_ld(&bar[XB_TOPGEN]) == tg, bar);
            __builtin_amdgcn_fence(__ATOMIC_ACQUIRE, "agent");
            xb_add(&bar[XB_XGEN(b.x)], 1u);
            asm volatile("s_waitcnt vmcnt(0)" ::: "memory");
        } else {
            XB_SPIN(xb_ld(&bar[XB_XGEN(b.x)]) == gen, bar);
            __builtin_amdgcn_fence(__ATOMIC_ACQUIRE, "agent");
            asm volatile("s_waitcnt vmcnt(0)" ::: "memory");
        }
    }
    __syncthreads();
}


struct Args { const float* in[34]; float* out; unsigned char* ws; int ph_lo, ph_hi; };
constexpr int N_PHASES = 22;

__global__ void __launch_bounds__(NTHR, 2) fwd(Args a) {
    extern __shared__ __attribute__((aligned(16))) unsigned char lds_raw[];
    float* lds = (float*)lds_raw;
    LAS unsigned char* ldsl = (LAS unsigned char*)lds_raw;
    const int vb0 = blockIdx.x, vbs = gridDim.x;
    const int lo = a.ph_lo, hi = a.ph_hi;
#define IN(k) (lo <= (k) && (k) < hi)
#define SEAM(k) do { if (IN(k) && IN((k) + 1)) xcd_barrier(bar); } while (0)
    volatile LAS unsigned* misc = (volatile LAS unsigned*)(ldsl + MISC_OFF);
    if (threadIdx.x < 4) misc[threadIdx.x] = 0u;
    __syncthreads();
    XcdBarrier bar = xcd_barrier_post((unsigned*)(a.ws + WS_CTL) + CW_BAR, misc);
    unsigned char* ws = a.ws;
    unsigned* ctl = (unsigned*)(ws + WS_CTL);
    unsigned* cnt = ctl + CW_CNT;
    int* list = (int*)(ws + WS_LIST); float* gatev = (float*)(ws + WS_GATE);
    float* dtraw = (float*)(ws + WS_DT); float* RS = (float*)(ws + WS_RS);
    bf16_t* XB = (bf16_t*)(ws + WS_XB); bf16_t* UB = (bf16_t*)(ws + WS_UB);
    bf16_t* YA = (bf16_t*)(ws + WS_YA); float* OF = (float*)(ws + WS_OF); bf16_t* OC = (bf16_t*)(ws + WS_OC);
    bf16_t* YP = (bf16_t*)(ws + WS_YP); bf16_t* YP1 = (bf16_t*)(ws + WS_YP1); bf16_t* XC = (bf16_t*)(ws + WS_YP);
    bf16_t* PB0 = (bf16_t*)(ws + WS_PB0); bf16_t* PB1 = (bf16_t*)(ws + WS_PB1);
    bf16_t* YB = (bf16_t*)(ws + WS_Y);
    bf16_t* Y2 = (bf16_t*)(ws + WS_Y2); unsigned char* yflag = ws + WS_YFLAG;
    bf16_t* MS = (bf16_t*)(ws + WS_MS); float* MD = (float*)(ws + WS_MD);
    bf16_t* HS = (bf16_t*)(ws + WS_HS); float* HD = (float*)(ws + WS_HD);
    bf16_t* XT = (bf16_t*)(ws + WS_XT); bf16_t* VT = (bf16_t*)(ws + WS_VT);
    const float* p_in = a.in[1];
    const int G = (int)gridDim.x, cb = (int)blockIdx.x;
    const NormB NB0{nullptr, XB, nullptr, nullptr, RS, nullptr, nullptr, nullptr, nullptr, nullptr, nullptr, nullptr, nullptr, nullptr, nullptr};
    unsigned char* XG8 = ws + WS_XG8;
    float* rsl = (float*)(ws + WS_DT);

    if (IN(0)) {
        ph_convert_weights(ldsl, a.in, ws, 0, ITEMS_DENSE, vb0, vbs);
        NormB A = NB0; A.xin = a.in[0]; A.gnext = a.in[3]; A.win = a.in[4]; A.dtraw = dtraw;
        ph_norm2<0, false, true, false>(A, vb0, vbs, (LAS float*)ldsl);
    }
    SEAM(0);
    if (IN(1)) { pg8::DenseOrder S; S.init(MT, UW, DM, (const bf16_t*)(ws + W_IN), G, cb); pg8::gemm_phase(ldsl, XB, DM, S, pg8::EpiBf16{UB, UW, RS}); }
    SEAM(1);
    if (IN(2)) { ph_prep(UB, a.in[5], a.in[6], XC, XT, VT, vb0, vbs); }
    SEAM(2);
    if (IN(3)) { ph_hgrn_states(ldsl, UB, VT, a.in[2], HS, HD, vb0, vbs); ph_mamba_states(ldsl, XT, dtraw, a.in[7], a.in[8], MS, MD, vb0, vbs); }
    SEAM(3);
    if (IN(4)) { ph_hgrn_scan(HS, HD, vb0, vbs); ph_mamba_scan(MS, MD, vb0, vbs); }
    SEAM(4);
    if (IN(5)) { ph_hgrn_out(ldsl, UB, VT, a.in[2], a.in[10], HS, OF, OC, vb0, vbs); ph_mamba_out(ldsl, UB, XC, XT, dtraw, a.in[7], a.in[8], a.in[9], a.in[11], MS, OC, vb0, vbs); }
    SEAM(5);
    if (IN(6)) { pg8::DenseOrder S; S.init(MT, DM, DM, (const bf16_t*)(ws + W_OUTE), G, cb); pg8::gemm_phase(ldsl, OC, DM, S, pg8::EpiBf16{YA, DM, nullptr}); }
    SEAM(6);
    if (IN(7)) {
        NormB A = NB0; A.y = YA; A.gpost = a.in[13];
        ph_norm2<1, false, false, false>(A, vb0, vbs);
        ph_cvt_rows(p_in, PB0, (size_t)MT * PDIM / 4, vb0, vbs);
        ph_convert_experts(ldsl, a.in, ws, ITEMS_DENSE, ITEMS_ALL, vb0, vbs);
    }
    SEAM(7);
    if (IN(8)) {
        { pg8::DenseOrder S; S.init(MT, 2 * DFF, DM, (const bf16_t*)(ws + W_GU), G, cb); pg8::gemm_phase(ldsl, XB, DM, S, pg8::EpiSwiglu{UB, DFF, RS, 0}); }
        { pg8::TailOrder S; S.init(MT, DM, PDIM, (const bf16_t*)(ws + W_PP), G, cb, (MT / 256) * (2 * DFF / 256) % G); pg8::gemm_phase(ldsl, PB0, PDIM, S, pg8::EpiBf16{YP, DM, nullptr}); }
    }
    SEAM(8);
    if (IN(9)) { pg8::DenseOrder S; S.init(MT, DM, DFF, (const bf16_t*)(ws + W_DN), G, cb); pg8::gemm_phase(ldsl, UB, DFF, S, pg8::EpiBf16{YA, DM, nullptr}); }
    SEAM(9);
    if (IN(10)) {
        NormB A = NB0; A.y = YA; A.gpost = a.in[18];
        ph_norm2<1, false, false, false>(A, vb0, vbs);
    }
    SEAM(10);
    if (IN(11)) { pg8::DenseOrder S; S.init(MT, DM, DM, (const bf16_t*)(ws + W_PG), G, cb); pg8::gemm_phase(ldsl, XB, DM, S, pg8::EpiPleGate{YP, DM, RS}); }
    SEAM(11);
    if (IN(12)) {
        NormB A = NB0; A.y = YP; A.gpost = a.in[33];
        ph_norm2<1, false, false, false>(A, vb0, vbs);
    }
    SEAM(12);
    if (IN(13)) { pg8::DenseOrder S; S.init(MT, 3072, DM, (const bf16_t*)(ws + W_QKV), G, cb); pg8::gemm_phase(ldsl, XB, DM, S, pg8::EpiBf16{UB, 3072, RS}); }
    SEAM(13);
    if (IN(14)) { ph_na(ldsl, UB, a.in[21], OC, vb0, vbs); }
    SEAM(14);
    if (IN(15)) { pg8::DenseOrder S; S.init(MT, DM, DM, (const bf16_t*)(ws + W_OUTO), G, cb); pg8::gemm_phase(ldsl, OC, DM, S, pg8::EpiBf16{YP1, DM, nullptr}); }
    SEAM(15);
    if (IN(16)) {
        NormB A = NB0; A.y = YP1; A.gpost = a.in[23]; A.gnext = a.in[24]; A.wr = a.in[25]; A.cnt = cnt; A.list = list; A.gatev = gatev; A.rsl = rsl; A.x8 = XG8;
        ph_norm2<1, false, false, true>(A, vb0, vbs, (LAS float*)ldsl);
        ph_cvt_rows(p_in + (size_t)MT * PDIM, PB1, (size_t)MT * PDIM / 4, vb0, vbs);
    }
    SEAM(16);
    if (IN(17)) { pg8::MoeOrder S; S.init(cnt, (volatile LAS int*)(ldsl + MISC_OFF + 64), 2 * DFFE, DM / 2, (const bf16_t*)(ws + W_EGU), (size_t)7 * MiB, true, G, cb);
        pg8::gemm_phase<pg8::EpiSwiglu8, pg8::MoeOrder, true>(ldsl, (const bf16_t*)XG8, DM / 2, S, pg8::EpiSwiglu8{(unsigned char*)UB, DFFE, rsl}); }
    SEAM(17);
    if (IN(18)) { pg8::MoeOrder S; S.init(cnt, (volatile LAS int*)(ldsl + MISC_OFF + 64), DM, DFFE / 2, (const bf16_t*)(ws + W_EDN), (size_t)(7 * MiB / 2), false, G, cb);
        const pg8::EpiMoeDown E{YB, list, gatev, 1.f / (pg8::W8_SCALE * pg8::ACT8_SCALE), (size_t)(Y2 - YB), yflag};
        S.set_split(true, false, DFFE / 2);
        pg8::gemm_phase<pg8::EpiMoeDown, pg8::MoeOrder, true>(ldsl, UB, DFFE / 2, S, E);
        S.set_split(true, true, DFFE / 2);
        pg8::gemm_phase<pg8::EpiMoeDown, pg8::MoeOrder, true>(ldsl, UB, DFFE / 2, S, E, DFFE / 4);
        { pg8::TailOrder T; T.init(MT, DM, PDIM, (const bf16_t*)(ws + W_PP + 512 * 1024), G, cb, S.tail_first()); pg8::gemm_phase(ldsl, PB1, PDIM, T, pg8::EpiBf16{YP, DM, nullptr}); } }
    SEAM(18);
    if (IN(19)) {
        NormB A = NB0; A.y = YB; A.gpost = a.in[29]; A.y2 = Y2; A.yflag = yflag;
        ph_norm2<2, false, false, false>(A, vb0, vbs);
    }
    SEAM(19);
    if (IN(20)) { pg8::DenseOrder S; S.init(MT, DM, DM, (const bf16_t*)(ws + W_PG + 2 * MiB), G, cb); pg8::gemm_phase(ldsl, XB, DM, S, pg8::EpiPleGate{YP, DM, RS}); }
    SEAM(20);
    if (IN(21)) {
        NormB A = NB0; A.y = YP; A.gpost = a.in[33] + DM; A.xout = a.out;
        ph_norm2<1, true, false, false>(A, vb0, vbs);
    }
#undef IN
#undef SEAM
}

extern "C" void kernel_launch(void* const* d_in, const int* in_sizes, int n_in, void* d_out, int out_size, void* d_ws, size_t ws_size, hipStream_t stream) {
    static int grid = 0;
    if (grid == 0) {
        if (n_in != 34 || out_size != MT * DM || ws_size < WS_END) { fprintf(stderr, "kernel_launch: unexpected shapes n_in %d out %d ws %zu (need %zu)\n", n_in, out_size, ws_size, (size_t)WS_END); grid = -1; return; }
        int dev = 0, cus = 0;
        if (hipGetDevice(&dev) != hipSuccess || hipDeviceGetAttribute(&cus, hipDeviceAttributeMultiprocessorCount, dev) != hipSuccess) { grid = -1; return; }
        if (hipFuncSetAttribute((const void*)fwd, hipFuncAttributeMaxDynamicSharedMemorySize, LDS_BYTES) != hipSuccess) { fprintf(stderr, "hipFuncSetAttribute failed\n"); grid = -1; return; }
        (void)hipGetLastError();
        grid = cus;
    }
    if (grid < 0) return;
    (void)hipMemsetAsync((char*)d_ws + WS_CTL, 0, CTL_ZERO_BYTES, stream);
    Args a{};
    for (int i = 0; i < 34; ++i) a.in[i] = (const float*)d_in[i];
    a.out = (float*)d_out; a.ws = (unsigned char*)d_ws;
#ifndef MK_PER_PHASE
    a.ph_lo = 0; a.ph_hi = N_PHASES;
    hipLaunchKernelGGL(fwd, dim3(grid), dim3(NTHR), LDS_BYTES, stream, a);
#else
    for (int ph = 0; ph < N_PHASES; ++ph) {
        a.ph_lo = ph; a.ph_hi = ph + 1;
        hipLaunchKernelGGL(fwd, dim3(grid), dim3(NTHR), LDS_BYTES, stream, a);
    }
#endif
}
```

```cpp
#include <hip/hip_runtime.h>
#include <stdint.h>
#include <stdio.h>

#define DEVI __device__ __forceinline__
#define LAS __attribute__((address_space(3)))
typedef unsigned short bf16_t;

constexpr int NB = 4, SEQ = 4096, DM = 1024, MT = NB * SEQ;
constexpr int EVEN_IN = 4112, UW = 4096, DFF = 2816, NEXP = 8, DFFE = 3584, PDIM = 256;
constexpr float EPS = 1e-6f;
constexpr int NTHR = 512;
constexpr int LDS_BYTES = 147456;
constexpr int MISC_OFF = 131072 + 320;
constexpr int MOE_ROWS = 2 * MT + NEXP * 256;

constexpr size_t MiB = 1u << 20;
constexpr size_t WS_CTL = 0, CTL_ZERO_BYTES = 1 * MiB;
constexpr size_t WS_LIST = 1 * MiB;
constexpr size_t WS_GATE = WS_LIST + 512 * 1024;
constexpr size_t WS_DT = 2 * MiB;
constexpr size_t WS_W = 3 * MiB;
constexpr size_t W_IN = WS_W, W_OUTE = W_IN + 8 * MiB, W_GU = W_OUTE + 2 * MiB, W_DN = W_GU + 11 * MiB, W_PG = W_DN + 6 * MiB, W_PP = W_PG + 4 * MiB,
                 W_QKV = W_PP + 1 * MiB, W_OUTO = W_QKV + 6 * MiB, W_EGU = W_OUTO + 2 * MiB, W_EDN = W_EGU + 112 * MiB, W_END = W_EDN + 56 * MiB;
constexpr size_t WS_XB = W_END;
constexpr size_t WS_R = WS_XB + 32 * MiB;
constexpr size_t WS_UB = WS_R;
constexpr size_t WS_PB0 = WS_R + 88 * MiB;
constexpr size_t WS_YA = WS_R + 128 * MiB;
constexpr size_t WS_OF = WS_R + 160 * MiB;
constexpr size_t WS_OC = WS_R + 192 * MiB;
constexpr size_t WS_YP = WS_R + 224 * MiB;
constexpr size_t WS_YP1 = WS_R;
constexpr size_t WS_PB1 = W_EDN + 32 * MiB;
constexpr size_t WS_XG8 = WS_R + 120 * MiB;
constexpr size_t WS_END = WS_R + 256 * MiB;
constexpr size_t WS_Y2 = WS_R + 120 * MiB;
constexpr size_t WS_YFLAG = WS_CTL + 256 * 1024;
constexpr size_t WS_Y = W_EGU;
constexpr size_t WS_MS = W_EGU;
constexpr size_t WS_HS = W_EGU + 64 * MiB;
constexpr size_t WS_XT = W_EDN;
constexpr size_t WS_VT = W_EDN + 24 * MiB;
constexpr size_t WS_MD = W_EDN + 40 * MiB;
constexpr size_t WS_HD = W_EDN + 41 * MiB;
static_assert(WS_R + (size_t)MOE_ROWS * DFFE <= WS_XG8 && WS_XG8 + 128 * MiB <= WS_END && WS_END <= 510 * MiB, "ws map");
constexpr size_t WS_RS = WS_CTL + 512 * 1024;
constexpr int CW_CNT = 64;
constexpr int CW_BAR = 4096;

DEVI int opq(int x) { asm volatile("" : "+v"(x)); return x; }
DEVI float bf2f(bf16_t b) { return __uint_as_float(((unsigned)b) << 16); }
typedef float f32x2c __attribute__((ext_vector_type(2)));
typedef __bf16 bf16x2c __attribute__((ext_vector_type(2)));
DEVI unsigned cvt2bf(float lo, float hi) { const f32x2c v = {lo, hi}; return __builtin_bit_cast(unsigned, __builtin_convertvector(v, bf16x2c)); }
DEVI bf16_t f2bf(float f) { return (bf16_t)(cvt2bf(f, 0.f) & 0xffffu); }
DEVI float silu_f(float x) { return x * __builtin_amdgcn_rcpf(1.f + __builtin_amdgcn_exp2f(-1.44269504f * x)); }
DEVI float sigmoid_f(float x) { return __builtin_amdgcn_rcpf(1.f + __builtin_amdgcn_exp2f(-1.44269504f * x)); }
DEVI float softplus_f(float x) { return x > 20.f ? x : log1pf(__expf(x)); }
DEVI float wave_sum(float v) {
#pragma unroll
    for (int o = 1; o < 64; o <<= 1) v += __shfl_xor(v, o);
    return v;
}


typedef short bf16x8 __attribute__((ext_vector_type(8)));
typedef float f32x4 __attribute__((ext_vector_type(4)));
typedef unsigned u32x4 __attribute__((ext_vector_type(4)));
typedef unsigned u32x2 __attribute__((ext_vector_type(2)));
DEVI unsigned pk2(float lo, float hi) { return cvt2bf(lo, hi); }
DEVI float bflo(unsigned w) { return __uint_as_float(w << 16); }
DEVI float bfhi(unsigned w) { return __uint_as_float(w & 0xffff0000u); }

DEVI unsigned pg8_pk4(float a, float b, float c, float d) {
    a = __builtin_amdgcn_fmed3f(a, -448.f, 448.f); b = __builtin_amdgcn_fmed3f(b, -448.f, 448.f); c = __builtin_amdgcn_fmed3f(c, -448.f, 448.f); d = __builtin_amdgcn_fmed3f(d, -448.f, 448.f);
    int p = __builtin_amdgcn_cvt_pk_fp8_f32(a, b, 0, false); p = __builtin_amdgcn_cvt_pk_fp8_f32(c, d, p, true); return (unsigned)p; }
DEVI float wave_sum16(float (&v)[16], int lane) {
    const bool h5 = lane & 32, h4 = lane & 16, h3 = lane & 8, h2 = lane & 4;
#pragma unroll
    for (int i = 0; i < 8; ++i) { const float send = h5 ? v[i] : v[i + 8], keep = h5 ? v[i + 8] : v[i]; v[i] = keep + __shfl_xor(send, 32); }
#pragma unroll
    for (int i = 0; i < 4; ++i) { const float send = h4 ? v[i] : v[i + 4], keep = h4 ? v[i + 4] : v[i]; v[i] = keep + __shfl_xor(send, 16); }
#pragma unroll
    for (int i = 0; i < 2; ++i) { const float send = h3 ? v[i] : v[i + 2], keep = h3 ? v[i + 2] : v[i]; v[i] = keep + __shfl_xor(send, 8); }
    { const float send = h2 ? v[0] : v[1], keep = h2 ? v[1] : v[0]; v[0] = keep + __shfl_xor(send, 4); }
    float r = v[0]; r += __shfl_xor(r, 1); r += __shfl_xor(r, 2); return r;
}
DEVI float wave_sum8(float (&v)[8], int lane) {
    const bool h5 = lane & 32, h4 = lane & 16, h3 = lane & 8;
#pragma unroll
    for (int i = 0; i < 4; ++i) { const float send = h5 ? v[i] : v[i + 4], keep = h5 ? v[i + 4] : v[i]; v[i] = keep + __shfl_xor(send, 32); }
#pragma unroll
    for (int i = 0; i < 2; ++i) { const float send = h4 ? v[i] : v[i + 2], keep = h4 ? v[i + 2] : v[i]; v[i] = keep + __shfl_xor(send, 16); }
    { const float send = h3 ? v[0] : v[1], keep = h3 ? v[1] : v[0]; v[0] = keep + __shfl_xor(send, 8); }
    float r = v[0]; r += __shfl_xor(r, 1); r += __shfl_xor(r, 2); r += __shfl_xor(r, 4); return r;
}
struct NormB { const float* xin; bf16_t* XB; const bf16_t* y; const float* gpost; float* rs; const float* gnext;
               const float* win; float* dtraw; const float* wr; unsigned* cnt; int* list; float* gatev; float* rsl; float* xout; unsigned char* x8; const bf16_t* y2; const unsigned char* yflag; };
DEVI void unpack8(const u32x4 w, float* v) { v[0] = bflo(w.x); v[1] = bfhi(w.x); v[2] = bflo(w.y); v[3] = bfhi(w.y); v[4] = bflo(w.z); v[5] = bfhi(w.z); v[6] = bflo(w.w); v[7] = bfhi(w.w); }
template <int YMODE, bool FINAL, bool DT, bool ROUTE>
DEVI void ph_norm2(const NormB& A, int vb0, int vbs, LAS float* wl = nullptr) {
    const int tidq = opq((int)threadIdx.x); const int wid = tidq >> 6, lane = tidq & 63;
    if (DT || ROUTE) {
        constexpr int NJ = DT ? 16 : 8;
        __syncthreads();
        for (int e = tidq; e < DM * NJ / 4; e += NTHR) { const int k = e / (NJ / 4), j4 = (e % (NJ / 4)) * 4;
            const float4 w = DT ? *(const float4*)(A.win + (size_t)k * EVEN_IN + 4096 + j4) : *(const float4*)(A.wr + (size_t)k * 8 + j4);
            wl[(j4 + 0) * DM + k] = w.x; wl[(j4 + 1) * DM + k] = w.y; wl[(j4 + 2) * DM + k] = w.z; wl[(j4 + 3) * DM + k] = w.w; }
        __syncthreads();
    }
    constexpr int R = (DT || ROUTE) ? 2 : 4;
    for (int row0 = (vb0 * 8 + wid) * R; row0 < MT; row0 += vbs * 8 * R) {
        float xv[R][16]; float yv[R][16];
#pragma unroll
        for (int rr = 0; rr < R; ++rr) {
            const size_t ro = (size_t)(row0 + rr) * DM + lane * 8;
            if (YMODE == 0) {
#pragma unroll
                for (int i = 0; i < 2; ++i) { const float4 p0 = *(const float4*)(A.xin + ro + i * 512), p1 = *(const float4*)(A.xin + ro + i * 512 + 4);
                    xv[rr][i * 8 + 0] = p0.x; xv[rr][i * 8 + 1] = p0.y; xv[rr][i * 8 + 2] = p0.z; xv[rr][i * 8 + 3] = p0.w; xv[rr][i * 8 + 4] = p1.x; xv[rr][i * 8 + 5] = p1.y; xv[rr][i * 8 + 6] = p1.z; xv[rr][i * 8 + 7] = p1.w; }
            } else {
#pragma unroll
                for (int i = 0; i < 2; ++i) {
                    unpack8(*(const u32x4*)(A.XB + ro + i * 512), xv[rr] + i * 8);
                    unpack8(*(const u32x4*)(A.y + ro + i * 512), yv[rr] + i * 8);
                    if (YMODE == 2) { float y2[8]; unpack8(*(const u32x4*)(A.y + (size_t)MT * DM + ro + i * 512), y2);
#pragma unroll
                        for (int j = 0; j < 8; ++j) yv[rr][i * 8 + j] += y2[j]; }
                }
            }
        }
        if (YMODE == 2) {
#pragma unroll
            for (int rr = 0; rr < R; ++rr) { const u32x2 fw = *(const u32x2*)(A.yflag + (size_t)(row0 + rr) * 8);
                const unsigned f0 = __builtin_amdgcn_readfirstlane(fw.x), f1 = __builtin_amdgcn_readfirstlane(fw.y);
                if (f0 | f1) { const size_t ro = (size_t)(row0 + rr) * DM + lane * 8;
#pragma unroll
                    for (int sl = 0; sl < 2; ++sl) { const unsigned fs = sl ? f1 : f0;
#pragma unroll
                        for (int i = 0; i < 2; ++i) if ((fs >> (8 * ((lane >> 5) + 2 * i))) & 0xff) { float y2[8]; unpack8(*(const u32x4*)(A.y2 + (size_t)sl * MT * DM + ro + i * 512), y2);
#pragma unroll
                            for (int j = 0; j < 8; ++j) yv[rr][i * 8 + j] += y2[j]; } } } }
        }
        if (YMODE != 0) {
            float gg[16];
#pragma unroll
            for (int i = 0; i < 2; ++i) { const float4 g0 = *(const float4*)(A.gpost + i * 512 + lane * 8), g1 = *(const float4*)(A.gpost + i * 512 + lane * 8 + 4);
                gg[i * 8 + 0] = g0.x; gg[i * 8 + 1] = g0.y; gg[i * 8 + 2] = g0.z; gg[i * 8 + 3] = g0.w; gg[i * 8 + 4] = g1.x; gg[i * 8 + 5] = g1.y; gg[i * 8 + 6] = g1.z; gg[i * 8 + 7] = g1.w; }
            float ss[R];
#pragma unroll
            for (int rr = 0; rr < R; ++rr) { ss[rr] = 0.f;
#pragma unroll
                for (int j = 0; j < 16; ++j) ss[rr] += yv[rr][j] * yv[rr][j]; }
#pragma unroll
            for (int o = 1; o < 64; o <<= 1)
#pragma unroll
                for (int rr = 0; rr < R; ++rr) ss[rr] += __shfl_xor(ss[rr], o);
#pragma unroll
            for (int rr = 0; rr < R; ++rr) { const float r = rsqrtf(ss[rr] * (1.f / DM) + EPS);
#pragma unroll
                for (int j = 0; j < 16; ++j) xv[rr][j] += yv[rr][j] * r * gg[j]; }
        }
        if (FINAL) {
#pragma unroll
            for (int rr = 0; rr < R; ++rr)
#pragma unroll
                for (int i = 0; i < 2; ++i) { float* op = A.xout + (size_t)(row0 + rr) * DM + i * 512 + lane * 8;
                    *(float4*)op = make_float4(xv[rr][i * 8], xv[rr][i * 8 + 1], xv[rr][i * 8 + 2], xv[rr][i * 8 + 3]); *(float4*)(op + 4) = make_float4(xv[rr][i * 8 + 4], xv[rr][i * 8 + 5], xv[rr][i * 8 + 6], xv[rr][i * 8 + 7]); }
        } else {
            float ss[R];
#pragma unroll
            for (int rr = 0; rr < R; ++rr) {
#pragma unroll
                for (int i = 0; i < 2; ++i) { u32x4 o; o.x = pk2(xv[rr][i * 8], xv[rr][i * 8 + 1]); o.y = pk2(xv[rr][i * 8 + 2], xv[rr][i * 8 + 3]); o.z = pk2(xv[rr][i * 8 + 4], xv[rr][i * 8 + 5]); o.w = pk2(xv[rr][i * 8 + 6], xv[rr][i * 8 + 7]);
                    *(u32x4*)(A.XB + (size_t)(row0 + rr) * DM + i * 512 + lane * 8) = o;
                }
                ss[rr] = 0.f;
#pragma unroll
                for (int j = 0; j < 16; ++j) ss[rr] += xv[rr][j] * xv[rr][j];
            }
#pragma unroll
            for (int o = 1; o < 64; o <<= 1)
#pragma unroll
                for (int rr = 0; rr < R; ++rr) ss[rr] += __shfl_xor(ss[rr], o);
            float r2[R];
#pragma unroll
            for (int rr = 0; rr < R; ++rr) { r2[rr] = rsqrtf(ss[rr] * (1.f / DM) + EPS); if (lane == 0) A.rs[row0 + rr] = r2[rr]; }
            if (DT || ROUTE) {
                float gn[16];
#pragma unroll
                for (int i = 0; i < 2; ++i) { const float4 g0 = *(const float4*)(A.gnext + i * 512 + lane * 8), g1 = *(const float4*)(A.gnext + i * 512 + lane * 8 + 4);
                    gn[i * 8 + 0] = g0.x; gn[i * 8 + 1] = g0.y; gn[i * 8 + 2] = g0.z; gn[i * 8 + 3] = g0.w; gn[i * 8 + 4] = g1.x; gn[i * 8 + 5] = g1.y; gn[i * 8 + 6] = g1.z; gn[i * 8 + 7] = g1.w; }
                int re1[R], re2[R], lr1[R], lr2[R]; float rw1[R], rw2[R];
                volatile LAS int* lcnt = (volatile LAS int*)((LAS unsigned char*)wl + 40960);
                if (ROUTE) { __syncthreads(); if (tidq < 8) lcnt[tidq] = 0; __syncthreads(); }
#pragma unroll
                for (int rr = 0; rr < R; ++rr) {
                    const int row = row0 + rr;
                    float hv[16];
#pragma unroll
                    for (int j = 0; j < 16; ++j) hv[j] = (rr == 0 ? xv[0][j] : xv[R - 1][j]) * (rr == 0 ? r2[0] : r2[R - 1]) * gn[j];
                    if (DT) {
                        float pd[16];
#pragma unroll 4
                        for (int j = 0; j < 16; ++j) {
                            float p = 0.f;
#pragma unroll
                            for (int i = 0; i < 2; ++i) { const LAS float* wp = wl + j * DM + i * 512 + lane * 8;
                                const f32x4 w0 = *(const LAS f32x4*)wp, w1 = *(const LAS f32x4*)(wp + 4);
                                p += hv[i * 8 + 0] * w0[0] + hv[i * 8 + 1] * w0[1] + hv[i * 8 + 2] * w0[2] + hv[i * 8 + 3] * w0[3] + hv[i * 8 + 4] * w1[0] + hv[i * 8 + 5] * w1[1] + hv[i * 8 + 6] * w1[2] + hv[i * 8 + 7] * w1[3]; }
                            pd[j] = p;
                        }
                        const float dk = wave_sum16(pd, lane);
                        if ((lane & 3) == 0) A.dtraw[(size_t)row * 16 + (lane >> 2)] = dk;
                    }
                    if (ROUTE) {
                        float pl[8];
#pragma unroll 4
                        for (int e = 0; e < 8; ++e) {
                            float p = 0.f;
#pragma unroll
                            for (int i = 0; i < 2; ++i) { const LAS float* wp = wl + e * DM + i * 512 + lane * 8;
                                const f32x4 w0 = *(const LAS f32x4*)wp, w1 = *(const LAS f32x4*)(wp + 4);
                                p += hv[i * 8 + 0] * w0[0] + hv[i * 8 + 1] * w0[1] + hv[i * 8 + 2] * w0[2] + hv[i * 8 + 3] * w0[3] + hv[i * 8 + 4] * w1[0] + hv[i * 8 + 5] * w1[1] + hv[i * 8 + 6] * w1[2] + hv[i * 8 + 7] * w1[3]; }
                            pl[e] = p;
                        }
                        const float lk = wave_sum8(pl, lane);
                        float lg[8];
#pragma unroll
                        for (int e = 0; e < 8; ++e) lg[e] = __shfl(lk, e * 8);
                        int e1 = 0; float v1 = lg[0];
#pragma unroll
                        for (int e = 1; e < 8; ++e) if (lg[e] > v1) { v1 = lg[e]; e1 = e; }
                        int e2 = 0; float v2 = -3.0e38f;
#pragma unroll
                        for (int e = 0; e < 8; ++e) if (e != e1 && lg[e] > v2) { v2 = lg[e]; e2 = e; }
                        const float ex = __expf(v2 - v1);
                        re1[rr] = e1; re2[rr] = e2; rw1[rr] = 1.f / (1.f + ex); rw2[rr] = ex / (1.f + ex);
                        if (lane == 0) { lr1[rr] = __hip_atomic_fetch_add((LAS int*)lcnt + e1, 1, __ATOMIC_RELAXED, __HIP_MEMORY_SCOPE_WORKGROUP); lr2[rr] = __hip_atomic_fetch_add((LAS int*)lcnt + e2, 1, __ATOMIC_RELAXED, __HIP_MEMORY_SCOPE_WORKGROUP); }
                    }
                }
                if (ROUTE) {
                    __syncthreads();
                    if (tidq < 8) lcnt[8 + tidq] = (int)atomicAdd(&A.cnt[tidq * 64], (unsigned)lcnt[tidq]);
                    __syncthreads();
#pragma unroll
                    for (int rr = 0; rr < R; ++rr) {
                        const int row = row0 + rr;
                        int dst1 = 0, dst2 = 0;
                        if (lane == 0) {
                            const int e1 = re1[rr], e2 = re2[rr];
                            const int p1 = lcnt[8 + e1] + lr1[rr], p2 = lcnt[8 + e2] + lr2[rr];
                            A.list[e1 * MT + p1] = row * 2; A.gatev[e1 * MT + p1] = rw1[rr]; A.rsl[e1 * MT + p1] = r2[rr];
                            A.list[e2 * MT + p2] = row * 2 + 1; A.gatev[e2 * MT + p2] = rw2[rr]; A.rsl[e2 * MT + p2] = r2[rr];
                            dst1 = e1 * MT + p1; dst2 = e2 * MT + p2;
                        }
                        dst1 = __builtin_amdgcn_readfirstlane(dst1); dst2 = __builtin_amdgcn_readfirstlane(dst2);
#pragma unroll
                        for (int i = 0; i < 2; ++i) { u32x2 o8;
                            const float* xs = xv[rr] + i * 8;
                            o8.x = pg8_pk4(xs[0], xs[1], xs[2], xs[3]); o8.y = pg8_pk4(xs[4], xs[5], xs[6], xs[7]);
                            *(u32x2*)(A.x8 + (size_t)dst1 * DM + i * 512 + lane * 8) = o8; *(u32x2*)(A.x8 + (size_t)dst2 * DM + i * 512 + lane * 8) = o8; }
                    }
                }
            }
        }
    }
}

constexpr int DTW_LD = (DM + 8) * 2;
DEVI void ph_norm0_dt(const NormB& A, int vb0, int vbs, LAS unsigned char* lds) {
    const int tidq = opq((int)threadIdx.x); const int wid = tidq >> 6, lane = tidq & 63, fr = lane & 15, fq = lane >> 4;
    __syncthreads();
    for (int e = tidq; e < DM * 4; e += NTHR) { const int k = e >> 2, j4 = (e & 3) * 4;
        const float4 w = *(const float4*)(A.win + (size_t)k * EVEN_IN + 4096 + j4); const float g = A.gnext[k];
        const float wv[4] = {w.x * g, w.y * g, w.z * g, w.w * g};
#pragma unroll
        for (int i = 0; i < 4; ++i) { const unsigned short hi = f2bf(wv[i]); const unsigned short lo = f2bf(wv[i] - bf2f(hi));
            *(LAS unsigned short*)(lds + (j4 + i) * DTW_LD + k * 2) = hi; *(LAS unsigned short*)(lds + (16 + j4 + i) * DTW_LD + k * 2) = lo; } }
    __syncthreads();
    for (int row0 = (vb0 * 8 + wid) * 8; row0 < MT; row0 += vbs * 64) {
        const int row = row0 + (fr & 7);
        const float* xp = A.xin + (size_t)row * DM + fq * 8;
        bf16_t* xbp = A.XB + (size_t)row * DM + fq * 8;
        const LAS unsigned char* wp = lds + fr * DTW_LD + fq * 16;
        f32x4 acc = {0.f, 0.f, 0.f, 0.f}; float ss = 0.f;
        float4 cu[8][2], nx[8][2];
#pragma unroll
        for (int s2 = 0; s2 < 8; ++s2) { cu[s2][0] = *(const float4*)(xp + s2 * 32); cu[s2][1] = *(const float4*)(xp + s2 * 32 + 4); }
#pragma unroll 1
        for (int c = 0; c < 4; ++c) {
            if (c < 3) {
#pragma unroll
                for (int s2 = 0; s2 < 8; ++s2) { nx[s2][0] = *(const float4*)(xp + (c + 1) * 256 + s2 * 32); nx[s2][1] = *(const float4*)(xp + (c + 1) * 256 + s2 * 32 + 4); } }
#pragma unroll
            for (int s2 = 0; s2 < 8; ++s2) { const int kk = c * 8 + s2;
                const float v[8] = {cu[s2][0].x, cu[s2][0].y, cu[s2][0].z, cu[s2][0].w, cu[s2][1].x, cu[s2][1].y, cu[s2][1].z, cu[s2][1].w};
                u32x4 hw, lw;
                hw.x = cvt2bf(v[0], v[1]); hw.y = cvt2bf(v[2], v[3]); hw.z = cvt2bf(v[4], v[5]); hw.w = cvt2bf(v[6], v[7]);
                lw.x = cvt2bf(v[0] - bflo(hw.x), v[1] - bfhi(hw.x)); lw.y = cvt2bf(v[2] - bflo(hw.y), v[3] - bfhi(hw.y)); lw.z = cvt2bf(v[4] - bflo(hw.z), v[5] - bfhi(hw.z)); lw.w = cvt2bf(v[6] - bflo(hw.w), v[7] - bfhi(hw.w));
#pragma unroll
                for (int i = 0; i < 8; ++i) ss += v[i] * v[i];
                if (fr < 8) *(u32x4*)(xbp + kk * 32) = hw;
                const bf16x8 xh = __builtin_bit_cast(bf16x8, hw), xl = __builtin_bit_cast(bf16x8, lw);
                const bf16x8 wh = *(const LAS bf16x8*)(wp + kk * 64), wl = *(const LAS bf16x8*)(wp + 16 * DTW_LD + kk * 64);
                acc = __builtin_amdgcn_mfma_f32_16x16x32_bf16(xh, wh, acc, 0, 0, 0);
                acc = __builtin_amdgcn_mfma_f32_16x16x32_bf16(xl, wh, acc, 0, 0, 0);
                acc = __builtin_amdgcn_mfma_f32_16x16x32_bf16(xh, wl, acc, 0, 0, 0); }
#pragma unroll
            for (int s2 = 0; s2 < 8; ++s2) { cu[s2][0] = nx[s2][0]; cu[s2][1] = nx[s2][1]; }
        }
        ss += __shfl_xor(ss, 16); ss += __shfl_xor(ss, 32);
        const float r = rsqrtf(ss * (1.f / DM) + EPS);
        if (lane < 8) A.rs[row0 + lane] = r;
#pragma unroll
        for (int v = 0; v < 4; ++v) { const float rm = __shfl(r, (4 * fq + v) & 7);
            if (fq < 2) A.dtraw[(size_t)(row0 + 4 * fq + v) * 16 + fr] = acc[v] * rm; }
    }
}
DEVI void transpose_item(const float* W, int ldw, int K, int k0, int n0, bf16_t* WT, int drow0, LAS float* scr, int lane, const float* gain) {
    {
        const int ka = lane >> 3, n4 = (lane & 7) * 4;
        float4 wv[8];
#pragma unroll
        for (int i = 0; i < 8; ++i) wv[i] = *(const float4*)(W + (size_t)(k0 + i * 8 + ka) * ldw + n0 + n4);
#pragma unroll
        for (int i = 0; i < 8; ++i) { LAS float* d = scr + (i * 8 + ka) * 33 + n4; d[0] = wv[i].x; d[1] = wv[i].y; d[2] = wv[i].z; d[3] = wv[i].w; }
    }
    asm volatile("s_waitcnt lgkmcnt(0)" ::: "memory");
    const int c = lane & 7;
    float4 ga = make_float4(1.f, 1.f, 1.f, 1.f), gb = ga;
    if (gain) { ga = *(const float4*)(gain + k0 + 8 * c); gb = *(const float4*)(gain + k0 + 8 * c + 4); }
#pragma unroll
    for (int j = 0; j < 4; ++j) { const int n = (lane >> 3) + 8 * j; const LAS float* sp = scr + (8 * c) * 33 + n;
        u32x4 o; o.x = pk2(sp[0 * 33] * ga.x, sp[1 * 33] * ga.y); o.y = pk2(sp[2 * 33] * ga.z, sp[3 * 33] * ga.w); o.z = pk2(sp[4 * 33] * gb.x, sp[5 * 33] * gb.y); o.w = pk2(sp[6 * 33] * gb.z, sp[7 * 33] * gb.w);
        *(u32x4*)(WT + (size_t)(drow0 + n) * K + k0 + 8 * c) = o; }
    asm volatile("s_waitcnt lgkmcnt(0)" ::: "memory");
}
DEVI void transpose_item_fp8(const float* W, int ldw, int K, int k0, int n0, unsigned char* WT8, int drow0, LAS float* scr, int lane, const float* gain) {
    {
        const int ka = lane >> 3, n4 = (lane & 7) * 4;
        float4 wv[8];
#pragma unroll
        for (int i = 0; i < 8; ++i) wv[i] = *(const float4*)(W + (size_t)(k0 + i * 8 + ka) * ldw + n0 + n4);
#pragma unroll
        for (int i = 0; i < 8; ++i) { LAS float* d = scr + (i * 8 + ka) * 33 + n4; d[0] = wv[i].x; d[1] = wv[i].y; d[2] = wv[i].z; d[3] = wv[i].w; }
    }
    asm volatile("s_waitcnt lgkmcnt(0)" ::: "memory");
    const int c = lane & 7;
    float4 ga = make_float4(64.f, 64.f, 64.f, 64.f), gb = ga;
    if (gain) { ga = *(const float4*)(gain + k0 + 8 * c); gb = *(const float4*)(gain + k0 + 8 * c + 4); ga.x *= 64.f; ga.y *= 64.f; ga.z *= 64.f; ga.w *= 64.f; gb.x *= 64.f; gb.y *= 64.f; gb.z *= 64.f; gb.w *= 64.f; }
#pragma unroll
    for (int j = 0; j < 4; ++j) { const int n = (lane >> 3) + 8 * j; const LAS float* sp = scr + (8 * c) * 33 + n;
        u32x2 o; o.x = pg8_pk4(sp[0 * 33] * ga.x, sp[1 * 33] * ga.y, sp[2 * 33] * ga.z, sp[3 * 33] * ga.w); o.y = pg8_pk4(sp[4 * 33] * gb.x, sp[5 * 33] * gb.y, sp[6 * 33] * gb.z, sp[7 * 33] * gb.w);
        *(u32x2*)(WT8 + (size_t)(drow0 + n) * K + k0 + 8 * c) = o; }
    asm volatile("s_waitcnt lgkmcnt(0)" ::: "memory");
}
struct Job { int in_idx; unsigned src_off; int ldw; int K; int ncols; unsigned long long dst; int mode; int item0; int gain_idx; int gain_off; int fp8; };
constexpr int NJOBS = 11 + 24;
struct JobTable { Job j[NJOBS]; int total; };
constexpr JobTable make_jobs() {
    JobTable t{}; int n = 0, it = 0;
    auto add = [&](int idx, unsigned off, int ldw, int K, int ncols, unsigned long long dst, int mode, int gi, int go, int f8 = 0) { t.j[n] = Job{idx, off, ldw, K, ncols, dst, mode, it, gi, go, f8}; it += (K / 64) * (ncols / 32); ++n; };
    add(4, 0, EVEN_IN, DM, UW, W_IN, 0, 3, 0);
    add(12, 0, DM, DM, DM, W_OUTE, 0, -1, 0);
    add(15, 0, DFF, DM, DFF, W_GU, 1, 14, 0);
    add(16, 0, DFF, DM, DFF, W_GU, 2, 14, 0);
    add(17, 0, DM, DFF, DM, W_DN, 0, -1, 0);
    add(31, 0, DM, DM, DM, W_PG, 0, 30, 0);
    add(31, DM * DM, DM, DM, DM, W_PG + 2 * MiB, 0, 30, DM);
    add(32, 0, DM, PDIM, DM, W_PP, 0, -1, 0);
    add(32, PDIM * DM, DM, PDIM, DM, W_PP + 512 * 1024, 0, -1, 0);
    add(20, 0, 3072, DM, 3072, W_QKV, 0, 19, 0);
    add(22, 0, DM, DM, DM, W_OUTO, 0, -1, 0);
    for (int e = 0; e < NEXP; ++e) {
        add(26, (unsigned)e * DM * DFFE, DFFE, DM, DFFE, W_EGU + (unsigned long long)e * 7 * MiB, 1, 24, 0, 1);
        add(27, (unsigned)e * DM * DFFE, DFFE, DM, DFFE, W_EGU + (unsigned long long)e * 7 * MiB, 2, 24, 0, 1);
        add(28, (unsigned)e * DFFE * DM, DM, DFFE, DM, W_EDN + (unsigned long long)e * (7 * MiB / 2), 0, -1, 0, 1);
    }
    t.total = it; return t;
}
__device__ const JobTable g_jobs = make_jobs();
constexpr int ITEMS_DENSE = make_jobs().j[11].item0, ITEMS_ALL = make_jobs().total;
struct CvtIt { const float* src; unsigned char* dst; const float* gp; int ldw, K, k0, n0, drow0; };
DEVI void cvt_decode(CvtIt& c, int it, int& jb, const float* const* in, unsigned char* ws) {
    while (jb + 1 < NJOBS && g_jobs.j[jb + 1].item0 <= it) ++jb;
    const Job J = g_jobs.j[jb];
    const int r = it - J.item0; const int nblk = J.ncols / 32; const int kb = r / nblk, nb = r % nblk;
    const int n0 = nb * 32; int drow0 = n0;
    if (J.mode != 0) drow0 = (n0 >> 7) * 256 + (n0 & 127) + (J.mode == 2 ? 128 : 0);
    c.src = in[J.in_idx] + J.src_off; c.dst = ws + J.dst; c.gp = J.gain_idx >= 0 ? in[J.gain_idx] + J.gain_off : nullptr; c.ldw = J.ldw; c.K = J.K; c.k0 = kb * 64; c.n0 = n0; c.drow0 = drow0;
}
DEVI void fp8_item_load(float4 (&wv)[8], float4& ga, float4& gb, const CvtIt& c, int lane) {
    const int ka = lane >> 3, n4 = (lane & 7) * 4;
    ga = make_float4(1.f, 1.f, 1.f, 1.f); gb = ga;
    if (c.gp) { ga = *(const float4*)(c.gp + c.k0 + 8 * (lane & 7)); gb = *(const float4*)(c.gp + c.k0 + 8 * (lane & 7) + 4); }
#pragma unroll
    for (int i = 0; i < 8; ++i) wv[i] = *(const float4*)(c.src + (size_t)(c.k0 + i * 8 + ka) * c.ldw + c.n0 + n4);
}
DEVI void fp8_item_finish(const float4 (&wv)[8], float4 ga, float4 gb, const CvtIt& c, LAS float* scr, int lane) {
    { const int ka = lane >> 3, n4 = (lane & 7) * 4;
#pragma unroll
        for (int i = 0; i < 8; ++i) { LAS float* d = scr + (i * 8 + ka) * 33 + n4; d[0] = wv[i].x; d[1] = wv[i].y; d[2] = wv[i].z; d[3] = wv[i].w; } }
    asm volatile("s_waitcnt lgkmcnt(0)" ::: "memory");
    const int cc = lane & 7;
    ga.x *= 64.f; ga.y *= 64.f; ga.z *= 64.f; ga.w *= 64.f; gb.x *= 64.f; gb.y *= 64.f; gb.z *= 64.f; gb.w *= 64.f;
#pragma unroll
    for (int j = 0; j < 4; ++j) { const int n = (lane >> 3) + 8 * j; const LAS float* sp = scr + (8 * cc) * 33 + n;
        u32x2 o; o.x = pg8_pk4(sp[0 * 33] * ga.x, sp[1 * 33] * ga.y, sp[2 * 33] * ga.z, sp[3 * 33] * ga.w); o.y = pg8_pk4(sp[4 * 33] * gb.x, sp[5 * 33] * gb.y, sp[6 * 33] * gb.z, sp[7 * 33] * gb.w);
        *(u32x2*)(c.dst + (size_t)(c.drow0 + n) * c.K + c.k0 + 8 * cc) = o; }
    asm volatile("s_waitcnt lgkmcnt(0)" ::: "memory");
}
DEVI void ph_convert_experts(LAS unsigned char* lds, const float* const* in, unsigned char* ws, int it_lo, int it_hi, int vb0, int vbs) {
    const int tidq = opq((int)threadIdx.x); const int wid = __builtin_amdgcn_readfirstlane(tidq >> 6), lane = tidq & 63;
    LAS float* scr = (LAS float*)(lds + wid * 16384);
    int jb = 11; int it = it_lo + vb0 * 8 + wid; if (it >= it_hi) return;
    CvtIt cur, nxt; float4 wc[8], wn[8], gca, gcb, gna, gnb;
    cvt_decode(cur, it, jb, in, ws); fp8_item_load(wc, gca, gcb, cur, lane);
    for (;;) {
        const int itn = it + vbs * 8; const bool hn = itn < it_hi;
        if (hn) { cvt_decode(nxt, itn, jb, in, ws); fp8_item_load(wn, gna, gnb, nxt, lane); }
        fp8_item_finish(wc, gca, gcb, cur, scr, lane);
        if (!hn) break;
        cur = nxt; it = itn; gca = gna; gcb = gnb;
#pragma unroll
        for (int i = 0; i < 8; ++i) wc[i] = wn[i];
    }
}
DEVI void ph_convert_weights(LAS unsigned char* lds, const float* const* in, unsigned char* ws, int it_lo, int it_hi, int vb0, int vbs) {
    const int tidq = opq((int)threadIdx.x); const int wid = __builtin_amdgcn_readfirstlane(tidq >> 6), lane = tidq & 63;
    LAS float* scr = (LAS float*)(lds + wid * 16384);
    int jb = 0;
    for (int it = it_lo + vb0 * 8 + wid; it < it_hi; it += vbs * 8) {
        while (jb + 1 < NJOBS && g_jobs.j[jb + 1].item0 <= it) ++jb;
        const Job J = g_jobs.j[jb];
        const int r = it - J.item0; const int nblk = J.ncols / 32; const int kb = r / nblk, nb = r % nblk;
        const int n0 = nb * 32; int drow0 = n0;
        if (J.mode != 0) drow0 = (n0 >> 7) * 256 + (n0 & 127) + (J.mode == 2 ? 128 : 0);
        const float* gp = J.gain_idx >= 0 ? in[J.gain_idx] + J.gain_off : nullptr;
        if (J.fp8) transpose_item_fp8(in[J.in_idx] + J.src_off, J.ldw, J.K, kb * 64, n0, ws + J.dst, drow0, scr, lane, gp);
        else transpose_item(in[J.in_idx] + J.src_off, J.ldw, J.K, kb * 64, n0, (bf16_t*)(ws + J.dst), drow0, scr, lane, gp);
    }
}
DEVI void ph_cvt_rows(const float* src, bf16_t* dst, size_t n4, int vb0, int vbs) {
    for (size_t e = (size_t)vb0 * NTHR + opq((int)threadIdx.x); e < n4; e += (size_t)vbs * NTHR) {
        const float4 v = ((const float4*)src)[e]; u32x2 o; o.x = pk2(v.x, v.y); o.y = pk2(v.z, v.w); ((u32x2*)dst)[e] = o; }
}

namespace pg8 {
constexpr int BM = 256, BK = 64, HALF = 128, HTB = HALF * BK * 2, STAGE_BYTES = 8 * HTB, NXCD = 8, WGM = 8;
__host__ __device__ __forceinline__ int lds_byte(int r, int c) { const int st = (r >> 4) * 2 + (c >> 5), rr = r & 15, cc = c & 31, ob = rr * 64 + cc * 2; return st * 1024 + (ob ^ (((ob >> 9) & 1) << 5)); }
__host__ __device__ __forceinline__ void stage_rc(int b, int& R, int& C) { const int st = b / 1024, sb = b % 1024, swz = sb ^ (((sb >> 9) & 1) << 5); R = (st >> 1) * 16 + swz / 64; C = (st & 1) * 32 + (swz % 64) / 2; }
__host__ __device__ __forceinline__ int perm32(int rho) { const int n = rho >> 4, i = rho & 15; return 8 * (i >> 2) + 4 * n + (i & 3); }
struct Unit { int pm, pn; int row0; int arow0; int mvalid; int e; int mbase; int akoff; const char* B; };
DEVI void xcd_tile(int L, int nwg, int nM, int nN, int& pm, int& pn) {
    int wgid = L; { const int q = nwg / NXCD, r = nwg % NXCD, xcd = wgid % NXCD, off = wgid / NXCD; wgid = (xcd < r ? xcd * (q + 1) : r * (q + 1) + (xcd - r) * q) + off; }
    const int nig = WGM * nN, gid = wgid / nig, fm = gid * WGM, gsz = (nM - fm) < WGM ? (nM - fm) : WGM;
    pm = fm + ((wgid % nig) % gsz); pn = (wgid % nig) / gsz;
}
struct DenseOrder {
    int nM, nN, nwg, G, c; const char* Bt; size_t tstepB;
    DEVI void init(int M, int N, int K, const bf16_t* Bt_, int G_, int c_) { nM = M / BM; nN = N / BM; nwg = nM * nN; G = G_; c = c_; Bt = (const char*)Bt_; tstepB = (size_t)BM * K * 2; }
    DEVI bool next(int i, Unit& u) const { const long L = (long)i * G + c; if (L >= nwg) return false; xcd_tile((int)L, nwg, nM, nN, u.pm, u.pn); u.row0 = u.pm * BM; u.arow0 = u.row0; u.mvalid = BM; u.e = 0; u.mbase = 0; u.akoff = 0; u.B = Bt + (size_t)u.pn * tstepB; return true; }
};
struct TailOrder {
    int nM, nN, nwg, nb, r; const char* Bt; size_t tstepB;
    DEVI void init(int M, int N, int K, const bf16_t* Bt_, int G_, int c_, int first) { nM = M / BM; nN = N / BM; nwg = nM * nN; Bt = (const char*)Bt_; tstepB = (size_t)BM * K * 2;
        if (first >= G_) first = 0; nb = G_ - first; r = c_ - first; }
    DEVI bool next(int i, Unit& u) const { if (r < 0) return false; const long L = (long)i * nb + r; if (L >= nwg) return false; u.pm = (int)L / nN; u.pn = (int)L % nN; u.row0 = u.pm * BM; u.arow0 = u.row0; u.mvalid = BM; u.e = 0; u.mbase = 0; u.akoff = 0; u.B = Bt + (size_t)u.pn * tstepB; return true; }
};
struct MoeOrder {
    int nM, nN, nwg, G, c; const char* Bt; size_t estepB, tstepB; const volatile LAS int* tab; bool per_expert;
    DEVI void init(const unsigned* cnt, volatile LAS int* tab_, int N, int K, const bf16_t* Bt_, size_t estep_bytes, bool per_expert_, int G_, int c_) {
        __syncthreads();
        if (threadIdx.x < 8) tab_[16 + threadIdx.x] = (int)__hip_atomic_load(cnt + threadIdx.x * 64, __ATOMIC_RELAXED, __HIP_MEMORY_SCOPE_AGENT);
        __syncthreads();
        if (threadIdx.x == 0) { int t = 0;
            for (int e = 0; e < 8; ++e) { const int n = tab_[16 + e]; tab_[e] = t; t += (n + BM - 1) / BM; }
            tab_[8] = t; }
        __syncthreads();
        tab = tab_; nM = __builtin_amdgcn_readfirstlane(tab_[8]); nN = N / BM; nwg = nM * nN; G = G_; c = c_; Bt = (const char*)Bt_; estepB = estep_bytes; tstepB = (size_t)BM * K * 2; per_expert = per_expert_; nmain = nwg; split_phase = false; khalfB = 0;
    }
    int nmain; bool split_phase; int khalfB;
    DEVI void set_split(bool ksplit, bool phase2, int khalf_bytes) { const int r = nwg % G; const bool can = ksplit && r > 0 && 2 * r <= G; nmain = can ? nwg - r : nwg; split_phase = phase2; khalfB = khalf_bytes; }
    DEVI int tail_first() const { return nmain == nwg ? nwg % G : 2 * (nwg - nmain); }
    DEVI bool next(int i, Unit& u) const {
        long L; int kh = 0;
        if (!split_phase) { L = (long)i * G + c; if (L >= nmain) return false; }
        else { if (i > 0 || c >= 2 * (nwg - nmain)) return false; L = nmain + (c >> 1); kh = c & 1; }
        xcd_tile((int)L, nwg, nM, nN, u.pm, u.pn);
        int e = 0;
        for (int k = 1; k < 8; ++k) if (u.pm >= __builtin_amdgcn_readfirstlane(tab[k])) e = k;
        const int t0 = __builtin_amdgcn_readfirstlane(tab[e]), n = __builtin_amdgcn_readfirstlane(tab[16 + e]);
        u.e = e; u.row0 = u.pm * BM; const int m0 = (u.pm - t0) * BM; u.mbase = m0; u.arow0 = per_expert ? e * MT + m0 : u.row0; u.mvalid = (n - m0) < BM ? (n - m0) : BM;
        u.akoff = kh * khalfB; u.B = Bt + (size_t)e * estepB + (size_t)u.pn * tstepB + u.akoff; return true; }
};
DEVI unsigned cvt_pk_bf16(float lo, float hi) { return cvt2bf(lo, hi); }

constexpr int EPI_OFF = MISC_OFF + 1024, EPI_SLICE = 1024;
static_assert(EPI_OFF + 8 * EPI_SLICE <= LDS_BYTES, "epilogue scalar slices");
DEVI void epi_dma(const void* g, LAS unsigned char* dst) { __builtin_amdgcn_global_load_lds((const unsigned*)g, (LAS unsigned*)dst, 4, 0, 0); }
struct EpiBf16 { static constexpr bool PERM = true; bf16_t* O; int ldc; const float* rs;
    DEVI void pre(LAS unsigned char* esl, const Unit& u, int wr, int lane) const {
        if (rs) { epi_dma(rs + u.row0 + wr * 64 + lane, esl); epi_dma(rs + u.row0 + wr * 64 + HALF + lane, esl + 256); } }
    DEVI void operator()(const f32x4 (&acc)[2][2][4][2], const Unit& u, int wr, int wc, int fr, int fq, const LAS unsigned char* esl) const {
        float pv[8];
#pragma unroll
        for (int q = 0; q < 8; ++q) pv[q] = ((const LAS float*)esl)[(q >> 2) * 64 + (q & 3) * 16 + fr];
        const int row0 = u.row0 + wr * 64 + fr, col0 = u.pn * BM + wc * 32 + 8 * fq;
#pragma unroll
        for (int ai = 0; ai < 2; ++ai)
#pragma unroll
            for (int m = 0; m < 4; ++m) { const int row = row0 + ai * HALF + m * 16; bf16_t* rowp = O + (size_t)row * ldc + col0;
                const float sc = rs ? pv[ai * 4 + m] : 1.f;
#pragma unroll
                for (int bj = 0; bj < 2; ++bj) { const f32x4 v0 = acc[ai][bj][m][0] * sc, v1 = acc[ai][bj][m][1] * sc;
                    u32x4 w; w.x = cvt_pk_bf16(v0[0], v0[1]); w.y = cvt_pk_bf16(v0[2], v0[3]); w.z = cvt_pk_bf16(v1[0], v1[1]); w.w = cvt_pk_bf16(v1[2], v1[3]);
                    *(u32x4*)(rowp + bj * HALF) = w; } }
    } };
struct EpiPleGate { static constexpr bool PERM = true; bf16_t* T; int ldc; const float* rs;
    DEVI void pre(LAS unsigned char* esl, const Unit& u, int wr, int lane) const {
        epi_dma(rs + u.row0 + wr * 64 + lane, esl); epi_dma(rs + u.row0 + wr * 64 + HALF + lane, esl + 256); }
    DEVI void operator()(const f32x4 (&acc)[2][2][4][2], const Unit& u, int wr, int wc, int fr, int fq, const LAS unsigned char* esl) const {
        float pv[8];
#pragma unroll
        for (int q = 0; q < 8; ++q) pv[q] = ((const LAS float*)esl)[(q >> 2) * 64 + (q & 3) * 16 + fr];
        const int row0 = u.row0 + wr * 64 + fr, col0 = u.pn * BM + wc * 32 + 8 * fq;
#pragma unroll
        for (int ai = 0; ai < 2; ++ai)
#pragma unroll
            for (int m = 0; m < 4; ++m) { const int row = row0 + ai * HALF + m * 16; bf16_t* rowp = T + (size_t)row * ldc + col0;
                const float sc = pv[ai * 4 + m];
#pragma unroll
                for (int bj = 0; bj < 2; ++bj) { const f32x4 v0 = acc[ai][bj][m][0] * sc, v1 = acc[ai][bj][m][1] * sc;
                    const u32x4 pp = *(const u32x4*)(rowp + bj * HALF);
                    u32x4 w; w.x = cvt_pk_bf16(sigmoid_f(v0[0]) * bflo(pp.x), sigmoid_f(v0[1]) * bfhi(pp.x)); w.y = cvt_pk_bf16(sigmoid_f(v0[2]) * bflo(pp.y), sigmoid_f(v0[3]) * bfhi(pp.y));
                    w.z = cvt_pk_bf16(sigmoid_f(v1[0]) * bflo(pp.z), sigmoid_f(v1[1]) * bfhi(pp.z)); w.w = cvt_pk_bf16(sigmoid_f(v1[2]) * bflo(pp.w), sigmoid_f(v1[3]) * bfhi(pp.w));
                    *(u32x4*)(rowp + bj * HALF) = w; } }
    } };
struct EpiSwiglu { static constexpr bool PERM = true; bf16_t* O; int ldc; const float* rs; int grouped;
    DEVI void pre(LAS unsigned char* esl, const Unit& u, int wr, int lane) const {
        const float* rsb = grouped ? rs + u.e * MT + u.mbase : rs + u.row0; const int vm1 = (grouped ? u.mvalid : BM) - 1;
#pragma unroll
        for (int i = 0; i < 2; ++i) { const int rl = wr * 64 + lane + i * HALF; epi_dma(rsb + (rl <= vm1 ? rl : vm1), esl + i * 256); } }
    DEVI void operator()(const f32x4 (&acc)[2][2][4][2], const Unit& u, int wr, int wc, int fr, int fq, const LAS unsigned char* esl) const {
        float pv[8];
#pragma unroll
        for (int q = 0; q < 8; ++q) pv[q] = ((const LAS float*)esl)[(q >> 2) * 64 + (q & 3) * 16 + fr];
        const int row0 = u.row0 + wr * 64 + fr, col0 = u.pn * HALF + wc * 32 + 8 * fq; const int vm1e = (grouped ? u.mvalid : BM) - 1;
#pragma unroll
        for (int ai = 0; ai < 2; ++ai)
#pragma unroll
            for (int m = 0; m < 4; ++m) { const int rl = wr * 64 + fr + ai * HALF + m * 16; bf16_t* rowp = O + (size_t)(u.row0 + rl) * ldc + col0;
                const float sc = rl <= vm1e ? pv[ai * 4 + m] : 0.f;
                const f32x4 g0 = acc[ai][0][m][0] * sc, g1 = acc[ai][0][m][1] * sc, u0 = acc[ai][1][m][0] * sc, u1 = acc[ai][1][m][1] * sc;
                u32x4 w; w.x = cvt_pk_bf16(silu_f(g0[0]) * u0[0], silu_f(g0[1]) * u0[1]); w.y = cvt_pk_bf16(silu_f(g0[2]) * u0[2], silu_f(g0[3]) * u0[3]);
                w.z = cvt_pk_bf16(silu_f(g1[0]) * u1[0], silu_f(g1[1]) * u1[1]); w.w = cvt_pk_bf16(silu_f(g1[2]) * u1[2], silu_f(g1[3]) * u1[3]);
                *(u32x4*)rowp = w; }
    } };
constexpr float W8_SCALE = 64.f, ACT8_SCALE = 8.f;
struct EpiSwiglu8 { static constexpr bool PERM = true; unsigned char* O; int ldc; const float* rs;
    DEVI void pre(LAS unsigned char* esl, const Unit& u, int wr, int lane) const {
        const float* rsb = rs + u.e * MT + u.mbase; const int vm1 = u.mvalid - 1;
#pragma unroll
        for (int i = 0; i < 2; ++i) { const int rl = wr * 64 + lane + i * HALF; epi_dma(rsb + (rl <= vm1 ? rl : vm1), esl + i * 256); } }
    DEVI void operator()(const f32x4 (&acc)[2][2][4][2], const Unit& u, int wr, int wc, int fr, int fq, const LAS unsigned char* esl) const {
        float pv[8];
#pragma unroll
        for (int q = 0; q < 8; ++q) pv[q] = ((const LAS float*)esl)[(q >> 2) * 64 + (q & 3) * 16 + fr];
        const int col0 = u.pn * HALF + wc * 32 + 8 * fq;
#pragma unroll
        for (int ai = 0; ai < 2; ++ai)
#pragma unroll
            for (int m = 0; m < 4; ++m) { const int rl = wr * 64 + fr + ai * HALF + m * 16; unsigned char* rowp = O + (size_t)(u.row0 + rl) * ldc + col0;
                const float sc = rl < u.mvalid ? pv[ai * 4 + m] * (1.f / W8_SCALE) : 0.f;
                const f32x4 g0 = acc[ai][0][m][0] * sc, g1 = acc[ai][0][m][1] * sc, u0 = acc[ai][1][m][0] * (sc * ACT8_SCALE), u1 = acc[ai][1][m][1] * (sc * ACT8_SCALE);
                u32x2 w; w.x = pg8_pk4(silu_f(g0[0]) * u0[0], silu_f(g0[1]) * u0[1], silu_f(g0[2]) * u0[2], silu_f(g0[3]) * u0[3]);
                w.y = pg8_pk4(silu_f(g1[0]) * u1[0], silu_f(g1[1]) * u1[1], silu_f(g1[2]) * u1[2], silu_f(g1[3]) * u1[3]);
                *(u32x2*)rowp = w; }
    } };
struct EpiMoeDown { static constexpr bool PERM = true; bf16_t* Y; const int* list; const float* gatev; float oscale; size_t y2off; unsigned char* flag;
    DEVI void pre(LAS unsigned char* esl, const Unit& u, int wr, int lane) const {
        const int* lb = list + u.e * MT + u.mbase; const float* gb = gatev + u.e * MT + u.mbase; const int vm1 = u.mvalid - 1;
#pragma unroll
        for (int i = 0; i < 2; ++i) { const int rl = wr * 64 + lane + i * HALF; const int ri = rl <= vm1 ? rl : vm1; epi_dma(gb + ri, esl + i * 256); epi_dma(lb + ri, esl + 512 + i * 256); } }
    DEVI void operator()(const f32x4 (&acc)[2][2][4][2], const Unit& u, int wr, int wc, int fr, int fq, const LAS unsigned char* esl) const {
        float pv[8]; int pt[8];
#pragma unroll
        for (int q = 0; q < 8; ++q) { pv[q] = ((const LAS float*)esl)[(q >> 2) * 64 + (q & 3) * 16 + fr]; pt[q] = ((const LAS int*)(esl + 512))[(q >> 2) * 64 + (q & 3) * 16 + fr]; }
        const int col0 = u.pn * BM + wc * 32 + 8 * fq;
        const bool second = u.akoff != 0; bf16_t* const Yb = Y + (second ? y2off : (size_t)0);
#pragma unroll
        for (int ai = 0; ai < 2; ++ai)
#pragma unroll
            for (int m = 0; m < 4; ++m) { const int rl = wr * 64 + fr + ai * HALF + m * 16;
                const int tsl = pt[ai * 4 + m]; const float gt = pv[ai * 4 + m] * oscale;
                if (rl < u.mvalid) {
                    bf16_t* rowp = Yb + (size_t)(tsl & 1) * ((size_t)MT * DM) + (size_t)(tsl >> 1) * DM + col0;
                    if (second && wc == 0 && fq == 0) flag[tsl * 4 + u.pn] = 1;
#pragma unroll
                    for (int bj = 0; bj < 2; ++bj) { const f32x4 v0 = acc[ai][bj][m][0], v1 = acc[ai][bj][m][1];
                        u32x4 w; w.x = cvt_pk_bf16(v0[0] * gt, v0[1] * gt); w.y = cvt_pk_bf16(v0[2] * gt, v0[3] * gt); w.z = cvt_pk_bf16(v1[0] * gt, v1[1] * gt); w.w = cvt_pk_bf16(v1[2] * gt, v1[3] * gt);
                        *(u32x4*)(rowp + bj * HALF) = w; } } }
    } };

typedef int v8i __attribute__((ext_vector_type(8)));
typedef int v4i __attribute__((ext_vector_type(4)));
DEVI v8i cat8(const bf16x8 lo, const bf16x8 hi) { const v4i a = __builtin_bit_cast(v4i, lo), b = __builtin_bit_cast(v4i, hi); return __builtin_shufflevector(a, b, 0, 1, 2, 3, 4, 5, 6, 7); }
struct Frag16 { bf16x8 k[2]; };
struct Frag8 { v8i v; };
template <bool F> struct FragSel { typedef Frag16 T; };
template <> struct FragSel<true> { typedef Frag8 T; };
template <class Epi, class Sched, bool FP8 = false>
DEVI void gemm_phase(LAS unsigned char* lds, const bf16_t* A, const int K, const Sched& S, const Epi& E, const int Kloop = 0) {
    const int tid = opq((int)threadIdx.x), wid = __builtin_amdgcn_readfirstlane(tid >> 6), lane = tid & 63, wr = wid >> 2, wc = wid & 3, fr = lane & 15, fq = lane >> 4;
    const int nt = (Kloop ? Kloop : K) / BK;
    unsigned voffA[2], voffB[2];
#pragma unroll
    for (int i = 0; i < 2; ++i) { int R, C; stage_rc(tid * 16 + i * 8192, R, C); const int Rb = Epi::PERM ? ((R & ~31) + perm32(R & 31)) : R;
        voffA[i] = (unsigned)(R * K + C) * 2u; voffB[i] = (unsigned)(Rb * K + C) * 2u; }
    const size_t kstep = (size_t)(BK * 2);
    const size_t hstep = (size_t)HALF * K * 2;
    const size_t rstep = (size_t)K * 2;
    const unsigned ldsw = (unsigned)wid * 1024u;
    const int aoff = lds_byte(wr * 64 + fr, fq * 8), boff = lds_byte(wc * 32 + fr, fq * 8);
#define PG8_SA(b, h) (((b) * 2 + (h)) * HTB)
#define PG8_SB(b, h) ((4 + (b) * 2 + (h)) * HTB)
#define PG8_STAGE(bufoff, gbase, voff) do { _Pragma("unroll") for (int _i = 0; _i < 2; ++_i) \
        __builtin_amdgcn_global_load_lds((const unsigned*)((const char*)(gbase) + (voff)[_i]), (LAS unsigned*)(lds + (bufoff) + ldsw + _i * 8192), 16, 0, 0); } while (0)
#define PG8_LDA(dst, b, h) do { _Pragma("unroll") for (int m = 0; m < 4; ++m) { if constexpr (FP8) dst[m].v = cat8(*(const LAS bf16x8*)(lds + PG8_SA(b, h) + aoff + m * 2048), *(const LAS bf16x8*)(lds + PG8_SA(b, h) + aoff + m * 2048 + 1024)); \
        else { _Pragma("unroll") for (int k = 0; k < 2; ++k) dst[m].k[k] = *(const LAS bf16x8*)(lds + PG8_SA(b, h) + aoff + m * 2048 + k * 1024); } } } while (0)
#define PG8_LDB(dst, b, h) do { _Pragma("unroll") for (int n = 0; n < 2; ++n) { if constexpr (FP8) dst[n].v = cat8(*(const LAS bf16x8*)(lds + PG8_SB(b, h) + boff + n * 2048), *(const LAS bf16x8*)(lds + PG8_SB(b, h) + boff + n * 2048 + 1024)); \
        else { _Pragma("unroll") for (int k = 0; k < 2; ++k) dst[n].k[k] = *(const LAS bf16x8*)(lds + PG8_SB(b, h) + boff + n * 2048 + k * 1024); } } } while (0)
#define PG8_MMA(ai, bj, At, Bt) do { __builtin_amdgcn_s_setprio(1); _Pragma("unroll") for (int m = 0; m < 4; ++m) _Pragma("unroll") for (int n = 0; n < 2; ++n) { \
        if constexpr (FP8) asm volatile("s_nop 1\n\tv_mfma_scale_f32_16x16x128_f8f6f4 %0, %1, %2, %0, %3, %3 op_sel_hi:[0,0,0]" : "+v"(acc[ai][bj][m][n]) : "v"(Bt[n].v), "v"(At[m].v), "v"(sc1)); \
        else { _Pragma("unroll") for (int k = 0; k < 2; ++k) acc[ai][bj][m][n] = __builtin_amdgcn_mfma_f32_16x16x32_bf16(Bt[n].k[k], At[m].k[k], acc[ai][bj][m][n], 0, 0, 0); } } \
        __builtin_amdgcn_s_setprio(0); } while (0)
#define PG8_WAIT_V(n) asm volatile("s_waitcnt vmcnt(" #n ")" ::: "memory")
#define PG8_WAIT_L(n) asm volatile("s_waitcnt lgkmcnt(" #n ")" ::: "memory")
#define PG8_BAR __builtin_amdgcn_s_barrier()
#define PG8_SCHED __builtin_amdgcn_sched_barrier(0)
    Unit cur, nxt; int ui = 0;
    if (!S.next(0, cur)) return;
    int sc1 = 0x7F7F7F7F; asm volatile("" : "+v"(sc1));
    f32x4 acc[2][2][4][2];
#pragma unroll
    for (int a = 0; a < 2; ++a)
#pragma unroll
        for (int b = 0; b < 2; ++b)
#pragma unroll
            for (int m = 0; m < 4; ++m)
#pragma unroll
                for (int n = 0; n < 2; ++n) acc[a][b][m][n] = (f32x4){0.f, 0.f, 0.f, 0.f};
    typename FragSel<FP8>::T At[4], B0[2], B1[2];
    const char* cA = (const char*)A + (size_t)cur.arow0 * rstep + cur.akoff;
    const char* cB = cur.B;
    LAS unsigned char* const esl = lds + EPI_OFF + wid * EPI_SLICE;
    E.pre(esl, cur, wr, lane);
    PG8_STAGE(PG8_SB(0, 0), cB, voffB); PG8_STAGE(PG8_SA(0, 0), cA, voffA); PG8_STAGE(PG8_SB(0, 1), cB + hstep, voffB); PG8_STAGE(PG8_SA(0, 1), cA + hstep, voffA);
    if (wr == 1) PG8_BAR;
    PG8_WAIT_V(4); PG8_BAR;
    PG8_STAGE(PG8_SB(1, 0), cB + kstep, voffB); PG8_STAGE(PG8_SA(1, 0), cA + kstep, voffA); PG8_STAGE(PG8_SB(1, 1), cB + hstep + kstep, voffB);
    PG8_WAIT_V(6); PG8_BAR;
    for (;;) {
        const bool has_next = S.next(ui + 1, nxt);
        const char* nA = has_next ? (const char*)A + (size_t)nxt.arow0 * rstep + nxt.akoff : cA; const char* nB = has_next ? nxt.B : cB;
#pragma unroll 1
        for (int t = 0; t < nt; t += 2) {
            const bool last = (t == nt - 2);
            const char* a1 = cA + (size_t)(t + 1) * kstep;
            const char* a2 = last ? nA : cA + (size_t)(t + 2) * kstep; const char* b2 = last ? nB : cB + (size_t)(t + 2) * kstep;
            const char* a3 = a2 + kstep; const char* b3 = b2 + kstep;
            PG8_LDB(B0, 0, 0); PG8_SCHED; PG8_LDA(At, 0, 0); PG8_STAGE(PG8_SA(1, 1), a1 + hstep, voffA);
            PG8_WAIT_L(8); PG8_BAR; PG8_WAIT_L(0); PG8_MMA(0, 0, At, B0); PG8_BAR; PG8_SCHED;
            PG8_LDB(B1, 0, 1); PG8_STAGE(PG8_SB(0, 0), b2, voffB);
            PG8_BAR; PG8_WAIT_L(0); PG8_MMA(0, 1, At, B1); PG8_BAR;
            PG8_LDA(At, 0, 1); PG8_STAGE(PG8_SA(0, 0), a2, voffA);
            PG8_BAR; PG8_WAIT_L(0); PG8_MMA(1, 0, At, B0); PG8_BAR; PG8_SCHED;
            PG8_STAGE(PG8_SB(0, 1), b2 + hstep, voffB);
            PG8_WAIT_V(6); PG8_BAR; PG8_MMA(1, 1, At, B1); PG8_BAR;
            PG8_LDB(B0, 1, 0); PG8_SCHED; PG8_LDA(At, 1, 0); PG8_STAGE(PG8_SA(0, 1), a2 + hstep, voffA);
            PG8_WAIT_L(8); PG8_BAR; PG8_WAIT_L(0); PG8_MMA(0, 0, At, B0); PG8_BAR; PG8_SCHED;
            PG8_LDB(B1, 1, 1); PG8_STAGE(PG8_SB(1, 0), b3, voffB);
            PG8_BAR; PG8_WAIT_L(0); PG8_MMA(0, 1, At, B1); PG8_BAR;
            PG8_LDA(At, 1, 1); PG8_STAGE(PG8_SA(1, 0), a3, voffA);
            PG8_BAR; PG8_WAIT_L(0); PG8_MMA(1, 0, At, B0); PG8_BAR; PG8_SCHED;
            PG8_STAGE(PG8_SB(1, 1), b3 + hstep, voffB);
            PG8_WAIT_V(6); PG8_BAR; PG8_MMA(1, 1, At, B1); PG8_BAR;
        }
        if constexpr (FP8) asm volatile("s_nop 15\n\ts_nop 15" ::: "memory");
        E(acc, cur, wr, wc, fr, fq, esl);
        if (!has_next) break;
#pragma unroll
        for (int a = 0; a < 2; ++a)
#pragma unroll
            for (int b = 0; b < 2; ++b)
#pragma unroll
                for (int m = 0; m < 4; ++m)
#pragma unroll
                    for (int n = 0; n < 2; ++n) acc[a][b][m][n] = (f32x4){0.f, 0.f, 0.f, 0.f};
        cur = nxt; cA = nA; cB = nB; ++ui;
        E.pre(esl, cur, wr, lane);
        if constexpr (FP8) asm volatile("s_nop 7" ::: "memory");
    }
    PG8_WAIT_V(0);
    if (wr == 0) PG8_BAR;
    PG8_BAR;
#undef PG8_SA
#undef PG8_SB
#undef PG8_STAGE
#undef PG8_LDA
#undef PG8_LDB
#undef PG8_MMA
#undef PG8_WAIT_V
#undef PG8_WAIT_L
#undef PG8_BAR
#undef PG8_SCHED
}
}

DEVI float lb_of(const float* lbraw, int ch) {
    const float r0 = lbraw[ch], r1 = lbraw[512 + ch], r2 = lbraw[1024 + ch];
    const float mx = fmaxf(r0, fmaxf(r1, r2));
    const float e0 = __expf(r0 - mx), e1 = __expf(r1 - mx), e2 = __expf(r2 - mx);
    return e0 / (e0 + e1 + e2);
}
constexpr int HQ = 0, HK = 17408, HKH = 34816, HV = 53248, HDV = 71680, HZERO = 73728, HOT = 75776, H_END = HOT + 64 * 528;
static_assert(H_END <= 131072, "hgrn lds");
constexpr size_t HS_SCAN = (size_t)16 * 16384;
struct HgrnRaw { unsigned qf[16]; u32x4 v0, v1; };
DEVI void hgrn_load(HgrnRaw& R, const bf16_t* u, const bf16_t* VT, int dir, int b, int h, int t0, int c, int I, int tid) {
    const bf16_t* up = u + ((size_t)b * SEQ + t0 + 16 * I) * UW + h * 128 + c;
    const int fcol = dir ? 1024 : 512;
#pragma unroll
    for (int j = 0; j < 16; ++j) R.qf[j] = (unsigned)up[(size_t)j * UW] | ((unsigned)up[(size_t)j * UW + fcol] << 16);
    { const int e = tid, r = e >> 3, cch = e & 7; R.v0 = *(const u32x4*)(VT + ((size_t)b * 512 + h * 128 + r) * SEQ + t0 + cch * 8); }
    { const int e = tid + NTHR, r = e >> 3, cch = e & 7; R.v1 = *(const u32x4*)(VT + ((size_t)b * 512 + h * 128 + r) * SEQ + t0 + cch * 8); }
}
DEVI void hgrn_prep(LAS unsigned char* lds, const HgrnRaw& R, float lbv, int dir, int c, int I, int tid) {
    float ff[16], kk[16], qq[16];
    { const int e = tid, r = e >> 3, cch = e & 7; *(LAS u32x4*)(lds + HV + r * 144 + cch * 16) = R.v0; }
    { const int e = tid + NTHR, r = e >> 3, cch = e & 7; *(LAS u32x4*)(lds + HV + r * 144 + cch * 16) = R.v1; }
#pragma unroll
    for (int j = 0; j < 16; ++j) {
        const float fr = bfhi(R.qf[j]), qr = bflo(R.qf[j]);
        const float f = lbv + (1.f - lbv) * sigmoid_f(fr);
        ff[j] = f; kk[j] = 1.f - f; qq[j] = silu_f(qr);
    }
    float run = 1.f;
#pragma unroll
    for (int jj = 0; jj < 16; ++jj) { const int j = dir ? 15 - jj : jj; run = fmaxf(run * ff[j], 1e-30f); ff[j] = run; }
    const float PG = run;
    float kh[16];
#pragma unroll
    for (int j = 0; j < 16; ++j) {
        const float kt = kk[j] * __builtin_amdgcn_rcpf(ff[j]);
        kh[j] = kt * PG;
        *(LAS bf16_t*)(lds + HQ + (16 * I + j) * 272 + c * 2) = f2bf(qq[j] * ff[j]);
        *(LAS bf16_t*)(lds + HK + (16 * I + j) * 272 + c * 2) = f2bf(kt);
    }
    u32x4 w0, w1;
    w0.x = pk2(kh[0], kh[1]); w0.y = pk2(kh[2], kh[3]); w0.z = pk2(kh[4], kh[5]); w0.w = pk2(kh[6], kh[7]);
    w1.x = pk2(kh[8], kh[9]); w1.y = pk2(kh[10], kh[11]); w1.z = pk2(kh[12], kh[13]); w1.w = pk2(kh[14], kh[15]);
    *(LAS u32x4*)(lds + HKH + c * 144 + I * 32) = w0; *(LAS u32x4*)(lds + HKH + c * 144 + I * 32 + 16) = w1;
    *(LAS float*)(lds + HDV + (I * 128 + c) * 4) = PG;
}
DEVI void hgrn_update(LAS unsigned char* lds, f32x4 (&Sacc)[8], int I, int wid, int fr, int fq) {
    const int voff = (fq < 2) ? HV + (16 * wid + fr) * 144 + (16 * I + 8 * fq) * 2 : HZERO;
    const int koff = (fq < 2) ? HKH + fr * 144 + (16 * I + 8 * fq) * 2 : HZERO;
    const int kstep = (fq < 2) ? 16 * 144 : 0;
    const bf16x8 vb = *(const LAS bf16x8*)(lds + voff);
    bf16x8 ka[8]; f32x4 dv[8];
#pragma unroll
    for (int m = 0; m < 8; ++m) { ka[m] = *(const LAS bf16x8*)(lds + koff + m * kstep); dv[m] = *(const LAS f32x4*)(lds + HDV + (I * 128 + 16 * m + 4 * fq) * 4); }
#pragma unroll
    for (int m = 0; m < 8; ++m) Sacc[m] = __builtin_amdgcn_mfma_f32_16x16x32_bf16(ka[m], vb, Sacc[m] * dv[m], 0, 0, 0);
}
DEVI void ph_hgrn_states(LAS unsigned char* lds, const bf16_t* u, const bf16_t* VT, const float* lbraw, bf16_t* HS, float* HD, int vb0, int vbs) {
    const int tid = opq((int)threadIdx.x), wid = __builtin_amdgcn_readfirstlane(tid >> 6), lane = tid & 63, fr = lane & 15, fq = lane >> 4;
    const int pc = tid & 127, pI = tid >> 7;
    for (int unit = vb0; unit < NB * 4 * 2 * 16; unit += vbs) {
        const int seg = unit & 15, dir = (unit >> 4) & 1, h = (unit >> 5) & 3, b = unit >> 7;
        const float lbv = lb_of(lbraw, h * 128 + pc);
        f32x4 Sacc[8];
#pragma unroll
        for (int m = 0; m < 8; ++m) Sacc[m] = (f32x4){0.f, 0.f, 0.f, 0.f};
        float gprod = 1.f;
        if (tid < 4) *(LAS unsigned*)(lds + HZERO + tid * 4) = 0u;
        HgrnRaw R; hgrn_load(R, u, VT, dir, b, h, seg * 256 + (dir ? 3 : 0) * 64, pc, pI, tid);
#pragma unroll 1
        for (int sbi = 0; sbi < 4; ++sbi) {
            const int sb = dir ? 3 - sbi : sbi;
            const int t0 = seg * 256 + sb * 64;
            __syncthreads();
            hgrn_prep(lds, R, lbv, dir, pc, pI, tid);
            if (sbi < 3) { const int sbn = dir ? 3 - (sbi + 1) : sbi + 1; hgrn_load(R, u, VT, dir, b, h, seg * 256 + sbn * 64, pc, pI, tid); }
            __syncthreads();
            if (tid < 128) gprod *= (*(const LAS float*)(lds + HDV + tid * 4) * *(const LAS float*)(lds + HDV + (128 + tid) * 4)) * (*(const LAS float*)(lds + HDV + (256 + tid) * 4) * *(const LAS float*)(lds + HDV + (384 + tid) * 4));
#pragma unroll 1
            for (int ii = 0; ii < 4; ++ii) { const int I = dir ? 3 - ii : ii; hgrn_update(lds, Sacc, I, wid, fr, fq); }
        }
        const size_t scan = (size_t)(b * 4 + h) * 2 + dir;
        bf16_t* dst = HS + scan * HS_SCAN + (size_t)seg * 16384;
#pragma unroll
        for (int m = 0; m < 8; ++m) { u32x2 w; w.x = pk2(Sacc[m][0], Sacc[m][1]); w.y = pk2(Sacc[m][2], Sacc[m][3]);
            *(u32x2*)(dst + (16 * wid + fr) * 128 + 16 * m + 4 * fq) = w; }
        if (tid < 128) HD[(scan * 16 + seg) * 128 + tid] = gprod;
    }
    __syncthreads();
}
DEVI void ph_hgrn_scan(bf16_t* HS, const float* HD, int vb0, int vbs) {
    const int tid = opq((int)threadIdx.x);
    for (int idx = vb0 * NTHR + tid; idx < 32 * 4096; idx += vbs * NTHR) {
        const int scan = idx >> 12, e4 = idx & 4095, k4 = (e4 & 31) * 4; const int dir = scan & 1;
        u32x2* base = (u32x2*)(HS + (size_t)scan * HS_SCAN) + e4;
        const float* hd = HD + (size_t)scan * 16 * 128 + k4;
        u32x2 d[16]; float4 dec[16];
#pragma unroll
        for (int i = 0; i < 16; ++i) { d[i] = base[(size_t)i * 4096]; dec[i] = *(const float4*)(hd + i * 128); }
        float s0 = 0.f, s1 = 0.f, s2 = 0.f, s3 = 0.f;
#define HSCAN_STEP(i) { const float t0 = bflo(d[i].x), t1 = bfhi(d[i].x), t2 = bflo(d[i].y), t3 = bfhi(d[i].y); d[i].x = pk2(s0, s1); d[i].y = pk2(s2, s3); \
            s0 = s0 * dec[i].x + t0; s1 = s1 * dec[i].y + t1; s2 = s2 * dec[i].z + t2; s3 = s3 * dec[i].w + t3; }
        if (dir == 0) {
#pragma unroll
            for (int i = 0; i < 16; ++i) HSCAN_STEP(i)
        } else {
#pragma unroll
            for (int i = 15; i >= 0; --i) HSCAN_STEP(i)
        }
#undef HSCAN_STEP
#pragma unroll
        for (int i = 0; i < 16; ++i) base[(size_t)i * 4096] = d[i];
    }
}
DEVI void ph_hgrn_out(LAS unsigned char* lds, const bf16_t* u, const bf16_t* VT, const float* lbraw, const float* a_norm, const bf16_t* HS, float* OF, bf16_t* ocat, int vb0, int vbs) {
    const int tid = opq((int)threadIdx.x), wid = __builtin_amdgcn_readfirstlane(tid >> 6), lane = tid & 63, fr = lane & 15, fq = lane >> 4;
    const int pc = tid & 127, pI = tid >> 7;
    const int otok = tid >> 3, opart = tid & 7;
    for (int unit = vb0; unit < NB * 4 * 16; unit += vbs) {
        const int seg = unit & 15, h = (unit >> 4) & 3, b = unit >> 6;
        const float lbv = lb_of(lbraw, h * 128 + pc);
        if (tid < 4) *(LAS unsigned*)(lds + HZERO + tid * 4) = 0u;
#pragma unroll 1
        for (int dir = 0; dir < 2; ++dir) {
            const size_t scan = (size_t)(b * 4 + h) * 2 + dir;
            const bf16_t* src = HS + scan * HS_SCAN + (size_t)seg * 16384;
            f32x4 Sacc[8];
#pragma unroll
            for (int m = 0; m < 8; ++m) { const u32x2 w = *(const u32x2*)(src + (16 * wid + fr) * 128 + 16 * m + 4 * fq);
                Sacc[m][0] = bflo(w.x); Sacc[m][1] = bfhi(w.x); Sacc[m][2] = bflo(w.y); Sacc[m][3] = bfhi(w.y); }
            HgrnRaw R; hgrn_load(R, u, VT, dir, b, h, seg * 256 + (dir ? 3 : 0) * 64, pc, pI, tid);
#pragma unroll 1
            for (int sbi = 0; sbi < 4; ++sbi) {
                const int sb = dir ? 3 - sbi : sbi;
                const int t0 = seg * 256 + sb * 64;
                const size_t tokb = (size_t)b * SEQ + t0;
                __syncthreads();
                hgrn_prep(lds, R, lbv, dir, pc, pI, tid);
                if (sbi < 3) { const int sbn = dir ? 3 - (sbi + 1) : sbi + 1; hgrn_load(R, u, VT, dir, b, h, seg * 256 + sbn * 64, pc, pI, tid); }
                __syncthreads();
#pragma unroll 1
                for (int ii = 0; ii < 4; ++ii) {
                    const int I = dir ? 3 - ii : ii;
                    f32x4 oT = {0.f, 0.f, 0.f, 0.f};
                    const LAS unsigned char* qrow = lds + HQ + (16 * I + fr) * 272;
#pragma unroll
                    for (int ks = 0; ks < 4; ++ks) {
                        u32x4 sa; sa.x = pg8::cvt_pk_bf16(Sacc[2 * ks][0], Sacc[2 * ks][1]); sa.y = pg8::cvt_pk_bf16(Sacc[2 * ks][2], Sacc[2 * ks][3]);
                        sa.z = pg8::cvt_pk_bf16(Sacc[2 * ks + 1][0], Sacc[2 * ks + 1][1]); sa.w = pg8::cvt_pk_bf16(Sacc[2 * ks + 1][2], Sacc[2 * ks + 1][3]);
                        const u32x2 q0 = *(const LAS u32x2*)(qrow + (32 * ks + 4 * fq) * 2), q1 = *(const LAS u32x2*)(qrow + (32 * ks + 16 + 4 * fq) * 2);
                        u32x4 qb; qb.x = q0.x; qb.y = q0.y; qb.z = q1.x; qb.w = q1.y;
                        oT = __builtin_amdgcn_mfma_f32_16x16x32_bf16(__builtin_bit_cast(bf16x8, sa), __builtin_bit_cast(bf16x8, qb), oT, 0, 0, 0);
                    }
                    f32x4 sT = {0.f, 0.f, 0.f, 0.f};
                    const LAS unsigned char* krow = lds + HK + (16 * I + fr) * 272;
#pragma unroll
                    for (int ks = 0; ks < 4; ++ks) {
                        const bf16x8 ka = *(const LAS bf16x8*)(krow + (32 * ks + 8 * fq) * 2), qb = *(const LAS bf16x8*)(qrow + (32 * ks + 8 * fq) * 2);
                        sT = __builtin_amdgcn_mfma_f32_16x16x32_bf16(ka, qb, sT, 0, 0, 0);
                    }
                    float pv[4];
#pragma unroll
                    for (int rg = 0; rg < 4; ++rg) { const int sl = 4 * fq + rg; const bool ok = dir ? (sl >= fr) : (sl <= fr); pv[rg] = ok ? sT[rg] : 0.f; }
                    u32x4 pb; pb.x = pg8::cvt_pk_bf16(pv[0], pv[1]); pb.y = pg8::cvt_pk_bf16(pv[2], pv[3]); pb.z = 0u; pb.w = 0u;
                    const u32x2 v0 = *(const LAS u32x2*)(lds + HV + (16 * wid + fr) * 144 + (16 * I + 4 * fq) * 2);
                    u32x4 va; va.x = v0.x; va.y = v0.y; va.z = 0u; va.w = 0u;
                    oT = __builtin_amdgcn_mfma_f32_16x16x32_bf16(__builtin_bit_cast(bf16x8, va), __builtin_bit_cast(bf16x8, pb), oT, 0, 0, 0);
                    if (dir == 0) *(f32x4*)(OF + (tokb + 16 * I + fr) * 512 + h * 128 + 16 * wid + 4 * fq) = oT;
                    else *(LAS f32x4*)(lds + HOT + (16 * I + fr) * 528 + (16 * wid + 4 * fq) * 4) = oT;
                    hgrn_update(lds, Sacc, I, wid, fr, fq);
                }
                if (dir == 1) {
                    __syncthreads();
                    const LAS float* orow = (const LAS float*)(lds + HOT + otok * 528) + opart * 16;
                    float* ofp = OF + (tokb + otok) * 512 + h * 128 + opart * 16;
                    float v[16]; float ss = 0.f;
#pragma unroll
                    for (int q2 = 0; q2 < 8; ++q2) { const unsigned long long w = __hip_atomic_load((unsigned long long*)(ofp + q2 * 2), __ATOMIC_RELAXED, __HIP_MEMORY_SCOPE_AGENT);
                        v[2 * q2] = __uint_as_float((unsigned)w) + orow[2 * q2]; v[2 * q2 + 1] = __uint_as_float((unsigned)(w >> 32)) + orow[2 * q2 + 1];
                        ss += v[2 * q2] * v[2 * q2] + v[2 * q2 + 1] * v[2 * q2 + 1]; }
                    ss += __shfl_xor(ss, 1); ss += __shfl_xor(ss, 2); ss += __shfl_xor(ss, 4);
                    const float rn = rsqrtf(ss * (1.f / 128.f) + EPS);
                    const bf16_t* gp = u + (tokb + otok) * UW + 2048 + h * 128 + opart * 16;
                    const u32x4 g0 = *(const u32x4*)gp, g1 = *(const u32x4*)(gp + 8);
                    const unsigned gw[8] = {g0.x, g0.y, g0.z, g0.w, g1.x, g1.y, g1.z, g1.w};
                    unsigned ow[8];
#pragma unroll
                    for (int q2 = 0; q2 < 8; ++q2) { const float an0 = a_norm[opart * 16 + 2 * q2], an1 = a_norm[opart * 16 + 2 * q2 + 1];
                        ow[q2] = pk2(v[2 * q2] * rn * an0 * silu_f(bflo(gw[q2])), v[2 * q2 + 1] * rn * an1 * silu_f(bfhi(gw[q2]))); }
                    bf16_t* op = ocat + (tokb + otok) * DM + h * 128 + opart * 16;
                    u32x4 o0, o1; o0.x = ow[0]; o0.y = ow[1]; o0.z = ow[2]; o0.w = ow[3]; o1.x = ow[4]; o1.y = ow[5]; o1.z = ow[6]; o1.w = ow[7];
                    *(u32x4*)op = o0; *(u32x4*)(op + 8) = o1;
                }
            }
            asm volatile("s_waitcnt vmcnt(0)" ::: "memory");
        }
    }
    __syncthreads();
}

DEVI void ph_prep(const bf16_t* u, const float* cw, const float* cb, bf16_t* xconv, bf16_t* XT, bf16_t* VT, int vb0, int vbs) {
    const int tid = opq((int)threadIdx.x);
    for (int unit = vb0; unit < NB * 32 * 3; unit += vbs) {
        const int cg = unit % 3, tb = (unit / 3) & 31, b = unit / 96;
        const int t0 = tb * 128;
        if (cg < 2) {
            const int ch = cg * 512 + tid;
            float w[5];
#pragma unroll
            for (int j = 0; j < 5; ++j) w[j] = cw[j * 1024 + ch];
            const float bias = cb[ch];
            const bf16_t* up = u + (size_t)b * SEQ * UW + 3072 + ch;
            float v0, v1, v2, v3;
            v0 = (t0 - 2 >= 0) ? bf2f(up[(size_t)(t0 - 2) * UW]) : 0.f;
            v1 = (t0 - 1 >= 0) ? bf2f(up[(size_t)(t0 - 1) * UW]) : 0.f;
            v2 = bf2f(up[(size_t)t0 * UW]);
            v3 = bf2f(up[(size_t)(t0 + 1) * UW]);
            for (int t8 = 0; t8 < 128; t8 += 32) {
                float nx[32];
#pragma unroll
                for (int i = 0; i < 32; ++i) { const int tt = t0 + t8 + i + 2; nx[i] = (tt < SEQ) ? bf2f(up[(size_t)tt * UW]) : 0.f; }
                unsigned pk[16];
#pragma unroll
                for (int i = 0; i < 32; ++i) {
                    const float o = silu_f(bias + w[0] * v0 + w[1] * v1 + w[2] * v2 + w[3] * v3 + w[4] * nx[i]);
                    const bf16_t ob = f2bf(o);
                    xconv[(size_t)(b * SEQ + t0 + t8 + i) * 1024 + ch] = ob;
                    if (i & 1) pk[i >> 1] |= ((unsigned)ob << 16); else pk[i >> 1] = ob;
                    v0 = v1; v1 = v2; v2 = v3; v3 = nx[i];
                }
                if (ch < 768) {
#pragma unroll
                    for (int q = 0; q < 4; ++q) { u32x4 o4; o4.x = pk[4 * q]; o4.y = pk[4 * q + 1]; o4.z = pk[4 * q + 2]; o4.w = pk[4 * q + 3]; *(u32x4*)(XT + ((size_t)b * 768 + ch) * SEQ + t0 + t8 + 8 * q) = o4; } }
            }
        } else {
            const int ch = tid;
            const bf16_t* up = u + (size_t)b * SEQ * UW + 1536 + ch;
            for (int t8 = 0; t8 < 128; t8 += 32) {
                unsigned pk[16];
#pragma unroll
                for (int i = 0; i < 32; ++i) { const unsigned ob = up[(size_t)(t0 + t8 + i) * UW]; if (i & 1) pk[i >> 1] |= (ob << 16); else pk[i >> 1] = ob; }
#pragma unroll
                for (int q = 0; q < 4; ++q) { u32x4 o4; o4.x = pk[4 * q]; o4.y = pk[4 * q + 1]; o4.z = pk[4 * q + 2]; o4.w = pk[4 * q + 3]; *(u32x4*)(VT + ((size_t)b * 512 + ch) * SEQ + t0 + t8 + 8 * q) = o4; }
            }
        }
    }
}

constexpr int MB_XT = 0, MB_BX = 256 * 272, MB_DT = MB_BX + 128 * 272, MB_CS = MB_DT + 8 * 128 * 4, MB_TOT = MB_CS + 8 * 128 * 4, MB_END = MB_TOT + 64;
static_assert(MB_END <= 131072, "mamba lds");
constexpr size_t MS_SCAN = (size_t)32 * 8192;
DEVI bf16x8 pack8(const float* v) { u32x4 w; w.x = pg8::cvt_pk_bf16(v[0], v[1]); w.y = pg8::cvt_pk_bf16(v[2], v[3]); w.z = pg8::cvt_pk_bf16(v[4], v[5]); w.w = pg8::cvt_pk_bf16(v[6], v[7]); return __builtin_bit_cast(bf16x8, w); }
DEVI void mamba_tables(LAS unsigned char* lds, const float* dtraw, const float* A_log, const float* dt_bias, int b, int g, int c, int wid, int lane) {
    LAS float* tdt = (LAS float*)(lds + MB_DT); LAS float* tcs = (LAS float*)(lds + MB_CS); LAS float* ttot = (LAS float*)(lds + MB_TOT);
    const int r = wid >> 1, dir = wid & 1, hd = 4 * g + r;
    const float A = -__expf(A_log[dir * 8 + hd]), bias = dt_bias[dir * 8 + hd];
    const size_t tk = (size_t)b * SEQ + c * 128 + 2 * lane;
    const float dt0 = softplus_f(dtraw[tk * 16 + dir * 8 + hd] + bias), dt1 = softplus_f(dtraw[(tk + 1) * 16 + dir * 8 + hd] + bias);
    const float a0 = dt0 * A, a1 = dt1 * A;
    float sc = a0 + a1;
#pragma unroll
    for (int off = 1; off < 64; off <<= 1) { const float v = __shfl_up(sc, off); if (lane >= off) sc += v; }
    const float total = __shfl(sc, 63);
    const float pre0 = sc - a1, pre1 = sc;
    const float c0 = dir ? (total - pre0 + a0) : pre0, c1 = dir ? (total - pre1 + a1) : pre1;
    tdt[wid * 128 + 2 * lane] = dt0; tdt[wid * 128 + 2 * lane + 1] = dt1;
    tcs[wid * 128 + 2 * lane] = c0; tcs[wid * 128 + 2 * lane + 1] = c1;
    if (lane == 0) ttot[wid] = total;
}
DEVI void stage_rows(LAS unsigned char* dst, const bf16_t* src, size_t src_stride, int rows, int tid) {
    for (int e = tid; e < rows * 16; e += NTHR) { const int r = e >> 4, cch = e & 15; *(LAS u32x4*)(dst + r * 272 + cch * 16) = *(const u32x4*)(src + (size_t)r * src_stride + cch * 8); }
}
DEVI void ph_mamba_states(LAS unsigned char* lds, const bf16_t* XT, const float* dtraw, const float* A_log, const float* dt_bias, bf16_t* MS, float* MD, int vb0, int vbs) {
    const int tid = opq((int)threadIdx.x), wid = __builtin_amdgcn_readfirstlane(tid >> 6), lane = tid & 63, fr = lane & 15, fq = lane >> 4;
    LAS float* tdt = (LAS float*)(lds + MB_DT); LAS float* tcs = (LAS float*)(lds + MB_CS); LAS float* ttot = (LAS float*)(lds + MB_TOT);
    for (int unit = vb0; unit < NB * 2 * 32; unit += vbs) {
        const int c = unit & 31, g = (unit >> 5) & 1, b = unit >> 6;
        __syncthreads();
        stage_rows(lds + MB_XT, XT + ((size_t)b * 768 + g * 256) * SEQ + c * 128, SEQ, 256, tid);
        stage_rows(lds + MB_BX, XT + ((size_t)b * 768 + 512 + g * 128) * SEQ + c * 128, SEQ, 128, tid);
        mamba_tables(lds, dtraw, A_log, dt_bias, b, g, c, wid, lane);
        __syncthreads();
        if (lane == 0) MD[((size_t)(b * 8 + 4 * g + (wid >> 1)) * 2 + (wid & 1)) * 32 + c] = __expf(ttot[wid]);
        for (int hdd = 0; hdd < 8; ++hdd) {
            const int r = hdd >> 1, dir = hdd & 1, hd = 4 * g + r;
            const float tot = ttot[hdd];
            f32x4 acc[4];
#pragma unroll
            for (int pt = 0; pt < 4; ++pt) acc[pt] = (f32x4){0.f, 0.f, 0.f, 0.f};
#pragma unroll
            for (int ks = 0; ks < 4; ++ks) {
                const int s0 = 32 * ks + 8 * fq;
                const u32x4 braw = *(const LAS u32x4*)(lds + MB_BX + (16 * wid + fr) * 272 + s0 * 2);
                float bw[8];
                const unsigned bu[4] = {braw.x, braw.y, braw.z, braw.w};
#pragma unroll
                for (int j = 0; j < 8; ++j) { const float bv = (j & 1) ? bfhi(bu[j >> 1]) : bflo(bu[j >> 1]);
                    bw[j] = bv * tdt[hdd * 128 + s0 + j] * __expf(tot - tcs[hdd * 128 + s0 + j]); }
                const bf16x8 Bf = pack8(bw);
#pragma unroll
                for (int pt = 0; pt < 4; ++pt) {
                    const bf16x8 Af = *(const LAS bf16x8*)(lds + MB_XT + (r * 64 + 16 * pt + fr) * 272 + s0 * 2);
                    acc[pt] = __builtin_amdgcn_mfma_f32_16x16x32_bf16(Bf, Af, acc[pt], 0, 0, 0);
                }
            }
            bf16_t* dst = MS + ((size_t)(b * 8 + hd) * 2 + dir) * MS_SCAN + (size_t)c * 8192;
#pragma unroll
            for (int pt = 0; pt < 4; ++pt) { u32x2 w; w.x = pk2(acc[pt][0], acc[pt][1]); w.y = pk2(acc[pt][2], acc[pt][3]);
                *(u32x2*)(dst + (16 * pt + fr) * 128 + 16 * wid + 4 * fq) = w; }
        }
    }
    __syncthreads();
}
DEVI void ph_mamba_scan(bf16_t* MS, const float* MD, int vb0, int vbs) {
    const int tid = opq((int)threadIdx.x);
    for (int idx = vb0 * NTHR + tid; idx < 64 * 2048; idx += vbs * NTHR) {
        const int scan = idx >> 11, e4 = idx & 2047; const int dir = scan & 1;
        u32x2* base = (u32x2*)(MS + (size_t)scan * MS_SCAN) + e4;
        const float* md = MD + (size_t)scan * 32;
        float h0 = 0.f, h1 = 0.f, h2 = 0.f, h3 = 0.f;
#pragma unroll 1
        for (int half = 0; half < 2; ++half) {
            const int c0 = (dir ? 1 - half : half) * 16;
            u32x2 d[16]; float dec[16];
#pragma unroll
            for (int i = 0; i < 16; ++i) { d[i] = base[(size_t)(c0 + i) * 2048]; dec[i] = md[c0 + i]; }
#define MSCAN_STEP(i) { const float t0 = bflo(d[i].x), t1 = bfhi(d[i].x), t2 = bflo(d[i].y), t3 = bfhi(d[i].y); d[i].x = pk2(h0, h1); d[i].y = pk2(h2, h3); \
                h0 = h0 * dec[i] + t0; h1 = h1 * dec[i] + t1; h2 = h2 * dec[i] + t2; h3 = h3 * dec[i] + t3; }
            if (dir == 0) {
#pragma unroll
                for (int i = 0; i < 16; ++i) MSCAN_STEP(i)
            } else {
#pragma unroll
                for (int i = 15; i >= 0; --i) MSCAN_STEP(i)
            }
#undef MSCAN_STEP
#pragma unroll
            for (int i = 0; i < 16; ++i) base[(size_t)(c0 + i) * 2048] = d[i];
        }
    }
}
DEVI void ph_mamba_out(LAS unsigned char* lds, const bf16_t* u, const bf16_t* xconv, const bf16_t* XT, const float* dtraw, const float* A_log, const float* dt_bias, const float* Dskip, const float* b_norm,
                       const bf16_t* MS, bf16_t* ocat, int vb0, int vbs) {
    const int tid = opq((int)threadIdx.x), wid = __builtin_amdgcn_readfirstlane(tid >> 6), lane = tid & 63, fr = lane & 15, fq = lane >> 4;
    LAS float* tdt = (LAS float*)(lds + MB_DT); LAS float* tcs = (LAS float*)(lds + MB_CS);
    for (int unit = vb0; unit < NB * 2 * 32; unit += vbs) {
        const int c = unit & 31, g = (unit >> 5) & 1, b = unit >> 6;
        const size_t tok0 = (size_t)b * SEQ + c * 128;
        __syncthreads();
        stage_rows(lds + MB_XT, XT + ((size_t)b * 768 + g * 256) * SEQ + c * 128, SEQ, 256, tid);
        stage_rows(lds + MB_BX, xconv + tok0 * 1024 + 512 + g * 128, 1024, 128, tid);
        mamba_tables(lds, dtraw, A_log, dt_bias, b, g, c, wid, lane);
        const int tl = 16 * wid + fr;
        bf16x8 Cf[4];
#pragma unroll
        for (int ks = 0; ks < 4; ++ks) Cf[ks] = *(const bf16x8*)(xconv + (tok0 + tl) * 1024 + 768 + g * 128 + 32 * ks + 8 * fq);
        __syncthreads();
        f32x4 GT[8];
#pragma unroll
        for (int st = 0; st < 8; ++st) { GT[st] = (f32x4){0.f, 0.f, 0.f, 0.f};
            bf16x8 Af[4];
#pragma unroll
            for (int ks = 0; ks < 4; ++ks) Af[ks] = *(const LAS bf16x8*)(lds + MB_BX + (16 * st + fr) * 272 + (32 * ks + 8 * fq) * 2);
#pragma unroll
            for (int ks = 0; ks < 4; ++ks) GT[st] = __builtin_amdgcn_mfma_f32_16x16x32_bf16(Af[ks], Cf[ks], GT[st], 0, 0, 0); }
        float ss = 0.f;
        __syncthreads();
        u32x2 hpre[4];
        { const bf16_t* hin0 = MS + ((size_t)(b * 8 + 4 * g) * 2) * MS_SCAN + (size_t)c * 8192;
#pragma unroll
          for (int q = 0; q < 4; ++q) hpre[q] = ((const u32x2*)hin0)[tid + q * NTHR]; }
#pragma unroll 1
        for (int r = 0; r < 4; ++r) {
            const int hd = 4 * g + r;
            f32x4 yv[4];
#pragma unroll
            for (int pt = 0; pt < 4; ++pt) yv[pt] = (f32x4){0.f, 0.f, 0.f, 0.f};
#pragma unroll 1
            for (int dir = 0; dir < 2; ++dir) {
                const int hdd = r * 2 + dir;
                const float cst = tcs[hdd * 128 + tl];
                LAS unsigned char* hbuf = lds + MB_BX + (hdd & 1) * 17408;
#pragma unroll
                for (int q = 0; q < 4; ++q) { const int e4 = tid + q * NTHR, pp = e4 >> 5, n4 = (e4 & 31) * 4;
                    *(LAS u32x2*)(hbuf + pp * 272 + n4 * 2) = hpre[q]; }
                if (hdd < 7) { const int hn = hdd + 1; const bf16_t* hinn = MS + ((size_t)(b * 8 + 4 * g + (hn >> 1)) * 2 + (hn & 1)) * MS_SCAN + (size_t)c * 8192;
#pragma unroll
                    for (int q = 0; q < 4; ++q) hpre[q] = ((const u32x2*)hinn)[tid + q * NTHR]; }
                __syncthreads();
                f32x4 yo[4];
#pragma unroll
                for (int pt = 0; pt < 4; ++pt) { yo[pt] = (f32x4){0.f, 0.f, 0.f, 0.f};
                    bf16x8 hf[4];
#pragma unroll
                    for (int ks = 0; ks < 4; ++ks) hf[ks] = *(const LAS bf16x8*)(hbuf + (16 * pt + fr) * 272 + (32 * ks + 8 * fq) * 2);
#pragma unroll
                    for (int ks = 0; ks < 4; ++ks) yo[pt] = __builtin_amdgcn_mfma_f32_16x16x32_bf16(hf[ks], Cf[ks], yo[pt], 0, 0, 0); }
                const float eo = __expf(cst);
#pragma unroll
                for (int pt = 0; pt < 4; ++pt) yv[pt] += yo[pt] * eo;
#pragma unroll
                for (int kp = 0; kp < 4; ++kp) {
                    const bool skip = dir ? (2 * kp + 1 < wid) : (2 * kp > wid);
                    if (!skip) {
                        float pv[8];
#pragma unroll
                        for (int hlf = 0; hlf < 2; ++hlf) { const int st = 2 * kp + hlf;
                            const f32x4 cs4 = *(const LAS f32x4*)(tcs + hdd * 128 + 16 * st + 4 * fq), dt4 = *(const LAS f32x4*)(tdt + hdd * 128 + 16 * st + 4 * fq);
#pragma unroll
                            for (int rg = 0; rg < 4; ++rg) { const int sl = 16 * st + 4 * fq + rg;
                                const bool ok = dir ? (sl >= tl) : (sl <= tl);
                                const float e = __expf(fminf(cst - cs4[rg], 0.f));
                                pv[hlf * 4 + rg] = ok ? GT[st][rg] * e * dt4[rg] : 0.f; } }
                        u32x2 x0[4], x1[4];
#pragma unroll
                        for (int pt = 0; pt < 4; ++pt) { const LAS unsigned char* xr = lds + MB_XT + (r * 64 + 16 * pt + fr) * 272;
                            x0[pt] = *(const LAS u32x2*)(xr + (32 * kp + 4 * fq) * 2); x1[pt] = *(const LAS u32x2*)(xr + (32 * kp + 16 + 4 * fq) * 2); }
                        const bf16x8 Pf = pack8(pv);
#pragma unroll
                        for (int pt = 0; pt < 4; ++pt) {
                            u32x4 xa; xa.x = x0[pt].x; xa.y = x0[pt].y; xa.z = x1[pt].x; xa.w = x1[pt].y;
                            yv[pt] = __builtin_amdgcn_mfma_f32_16x16x32_bf16(__builtin_bit_cast(bf16x8, xa), Pf, yv[pt], 0, 0, 0);
                        }
                    }
                }
            }
            const float Dk = Dskip[hd];
#pragma unroll
            for (int pt = 0; pt < 4; ++pt) {
                const int p0 = 16 * pt + 4 * fq;
                const u32x2 xr = *(const u32x2*)(xconv + (tok0 + tl) * 1024 + hd * 64 + p0);
                const u32x2 zr = *(const u32x2*)(u + (tok0 + tl) * UW + 2560 + hd * 64 + p0);
                const float xs[4] = {bflo(xr.x), bfhi(xr.x), bflo(xr.y), bfhi(xr.y)}, zs[4] = {bflo(zr.x), bfhi(zr.x), bflo(zr.y), bfhi(zr.y)};
                float yy[4];
#pragma unroll
                for (int rg = 0; rg < 4; ++rg) { const float y = (yv[pt][rg] + Dk * xs[rg]) * silu_f(zs[rg]); yy[rg] = y; ss += y * y; }
                const unsigned long long o = (unsigned long long)pk2(yy[0], yy[1]) | ((unsigned long long)pk2(yy[2], yy[3]) << 32);
                __hip_atomic_store((unsigned long long*)(ocat + (tok0 + tl) * DM + 512 + g * 256 + r * 64 + p0), o, __ATOMIC_RELAXED, __HIP_MEMORY_SCOPE_AGENT);
            }
        }
        ss += __shfl_xor(ss, 16); ss += __shfl_xor(ss, 32);
        const float rn = rsqrtf(ss * (1.f / 256.f) + EPS);
        asm volatile("s_waitcnt vmcnt(0)" ::: "memory");
        unsigned long long pk[16];
#pragma unroll
        for (int q = 0; q < 16; ++q) pk[q] = __hip_atomic_load((unsigned long long*)(ocat + (tok0 + tl) * DM + 512 + g * 256 + (q >> 2) * 64 + 16 * (q & 3) + 4 * fq), __ATOMIC_RELAXED, __HIP_MEMORY_SCOPE_AGENT);
#pragma unroll
        for (int r = 0; r < 4; ++r)
#pragma unroll
            for (int pt = 0; pt < 4; ++pt) {
                const int cc = g * 256 + r * 64 + 16 * pt + 4 * fq;
                unsigned long long* op = (unsigned long long*)(ocat + (tok0 + tl) * DM + 512 + cc);
                const unsigned long long v = pk[r * 4 + pt];
                const unsigned vlo = (unsigned)v, vhi = (unsigned)(v >> 32);
                const float4 bn = *(const float4*)(b_norm + cc);
                const unsigned long long o = (unsigned long long)pk2(bflo(vlo) * rn * bn.x, bfhi(vlo) * rn * bn.y) | ((unsigned long long)pk2(bflo(vhi) * rn * bn.z, bfhi(vhi) * rn * bn.w) << 32);
                *op = o;
            }
    }
    __syncthreads();
}


constexpr int NA_RING = 12, NA_VT = 0, NA_VSTRIDE = NA_RING * 64 * 2 + 16, NA_BIAS = 64 * NA_VSTRIDE, NA_END = NA_BIAS + 480 * 4;
static_assert(NA_END <= 131072, "na lds");
DEVI void ph_na(LAS unsigned char* lds, const bf16_t* qkv, const float* rpb, bf16_t* oc, int vb0, int vbs) {
    const int tid = opq((int)threadIdx.x), wid = __builtin_amdgcn_readfirstlane(tid >> 6), lane = tid & 63, fr = lane & 15, fq = lane >> 4;
    LAS float* bl = (LAS float*)(lds + NA_BIAS);
    for (int chunk = vb0; chunk < NB * 16 * 4; chunk += vbs) {
        const int qr4 = chunk & 3, h = (chunk >> 2) & 15, b = chunk >> 6;
        __syncthreads();
        for (int e = tid; e < 465; e += NTHR) bl[e] = rpb[h * 465 + e];
        int staged_hi = -1;
#pragma unroll 1
        for (int ui = 0; ui < 8; ++ui) {
            const int rp = qr4 * 8 + ui;
            const int r0 = 2 * rp, rs0 = min(max(r0 - 4, 0), 56);
            const int need_hi = min(rs0 + 8, 63);
            const int lo = max(staged_hi + 1, rs0);
            for (int task = wid; task < (need_hi - lo + 1) * 8; task += 8) {
                const int kr = lo + (task >> 3), ch = task & 7, slot = kr % NA_RING;
                const u32x4 v = *(const u32x4*)(qkv + ((size_t)b * SEQ + kr * 64 + lane) * 3072 + 2048 + h * 64 + ch * 8);
                const unsigned vw[4] = {v.x, v.y, v.z, v.w};
#pragma unroll
                for (int i = 0; i < 8; ++i) *(LAS bf16_t*)(lds + NA_VT + (ch * 8 + i) * NA_VSTRIDE + (slot * 64 + lane) * 2) = (bf16_t)((i & 1) ? (vw[i >> 1] >> 16) : (vw[i >> 1] & 0xffffu));
            }
            staged_hi = need_hi > staged_hi ? need_hi : staged_hi;
            __syncthreads();
            const int r = r0 + (wid >> 2), j = wid & 3;
            const int rs = min(max(r - 4, 0), 56);
            const int bs = (j == 0) ? 0 : (j == 1) ? 8 : (j == 2) ? 24 : 32;
            const int c = 16 * j + fr, qs = min(max(c - 8, 0), 48);
            const size_t qtok = (size_t)b * SEQ + r * 64 + c;
            bf16x8 Qf[2];
#pragma unroll
            for (int ks = 0; ks < 2; ++ks) Qf[ks] = *(const bf16x8*)(qkv + qtok * 3072 + h * 64 + 32 * ks + 8 * fq);
            const bf16_t* kbase = qkv + ((size_t)b * SEQ + rs * 64 + bs + fr) * 3072 + 1024 + h * 64 + 8 * fq;
            bf16x8 kn[4];
#pragma unroll
            for (int q = 0; q < 4; ++q) kn[q] = *(const bf16x8*)(kbase + (size_t)((q >> 1) * 16) * 3072 + (q & 1) * 32);
            f32x4 O[4];
#pragma unroll
            for (int dt = 0; dt < 4; ++dt) O[dt] = (f32x4){0.f, 0.f, 0.f, 0.f};
            float mrun = -1e30f, lrun = 0.f;
#pragma unroll 1
            for (int dr = 0; dr < 8; ++dr) {
                bf16x8 kc[4];
#pragma unroll
                for (int q = 0; q < 4; ++q) kc[q] = kn[q];
                const int drn = dr < 7 ? dr + 1 : 7;
#pragma unroll
                for (int q = 0; q < 4; ++q) kn[q] = *(const bf16x8*)(kbase + ((size_t)drn * 64 + (q >> 1) * 16) * 3072 + (q & 1) * 32);
                float sv[8]; float mloc = -1e30f;
                const LAS float* brow = bl + (rs + dr - r + 7) * 31;
#pragma unroll
                for (int kg = 0; kg < 2; ++kg) {
                    f32x4 acc = {0.f, 0.f, 0.f, 0.f};
                    acc = __builtin_amdgcn_mfma_f32_16x16x32_bf16(kc[kg * 2], Qf[0], acc, 0, 0, 0);
                    acc = __builtin_amdgcn_mfma_f32_16x16x32_bf16(kc[kg * 2 + 1], Qf[1], acc, 0, 0, 0);
#pragma unroll
                    for (int rg = 0; rg < 4; ++rg) {
                        const int kcol = bs + 16 * kg + 4 * fq + rg;
                        const bool ok = (kcol >= qs) && (kcol < qs + 16);
                        const int dc = min(max(kcol - c + 15, 0), 30);
                        const float sc = ok ? acc[rg] * 0.125f + brow[dc] : -1e30f;
                        sv[kg * 4 + rg] = sc; mloc = fmaxf(mloc, sc);
                    }
                }
                mloc = fmaxf(mloc, __shfl_xor(mloc, 16)); mloc = fmaxf(mloc, __shfl_xor(mloc, 32));
                const float mnew = fmaxf(mrun, mloc);
                const float alpha = __expf(mrun - mnew);
                float psum = 0.f;
#pragma unroll
                for (int i = 0; i < 8; ++i) { const float p = __expf(sv[i] - mnew); sv[i] = p; psum += p; }
                psum += __shfl_xor(psum, 16); psum += __shfl_xor(psum, 32);
                lrun = lrun * alpha + psum; mrun = mnew;
                const bf16x8 Pf = pack8(sv);
                const int koff = (((rs + dr) % NA_RING) * 64 + bs + 4 * fq) * 2;
#pragma unroll
                for (int dt = 0; dt < 4; ++dt) {
                    const LAS unsigned char* vr = lds + NA_VT + (16 * dt + fr) * NA_VSTRIDE + koff;
                    const u32x2 v0 = *(const LAS u32x2*)vr, v1 = *(const LAS u32x2*)(vr + 32);
                    u32x4 va; va.x = v0.x; va.y = v0.y; va.z = v1.x; va.w = v1.y;
                    O[dt] = __builtin_amdgcn_mfma_f32_16x16x32_bf16(__builtin_bit_cast(bf16x8, va), Pf, O[dt] * alpha, 0, 0, 0);
                }
            }
            const float il = 1.f / lrun;
#pragma unroll
            for (int dt = 0; dt < 4; ++dt) {
                u32x2 o; o.x = pk2(O[dt][0] * il, O[dt][1] * il); o.y = pk2(O[dt][2] * il, O[dt][3] * il);
                *(u32x2*)(oc + qtok * DM + h * 64 + 16 * dt + 4 * fq) = o;
            }
        }
    }
    __syncthreads();
}

#define XB_TMO      128
#define XB_XCNT(j)  (256  + 64 * (j))
#define XB_XSUB(j)  (1280 + 64 * (j))
#define XB_XGEN(j)  (2304 + 64 * (j))
#define XB_TOP      3328
#define XB_TOPGEN   3392
#define XCD_BAR_WORDS 3456
#define XB_SPIN_CAP (1u << 18)

__device__ __forceinline__ unsigned xb_ld(unsigned* p)              { return __hip_atomic_load(p, __ATOMIC_RELAXED, __HIP_MEMORY_SCOPE_AGENT); }
__device__ __forceinline__ unsigned xb_add(unsigned* p, unsigned v) { return __hip_atomic_fetch_add(p, v, __ATOMIC_RELAXED, __HIP_MEMORY_SCOPE_AGENT); }
__device__ __forceinline__ unsigned xb_xcc_id() { return (unsigned)__builtin_amdgcn_s_getreg((3 << 11) | 20) & 0xFu; }
#define XB_SPIN(cond, bar) do { unsigned _sp = 0; while (cond) { __builtin_amdgcn_s_sleep(1); \
    if ((++_sp & 255u) == 0u) { if (xb_ld(&(bar)[XB_TMO])) break; if (_sp > XB_SPIN_CAP) { atomicAdd(&(bar)[XB_TMO], 1u); break; } } } } while (0)

struct XcdBarrier {
    unsigned* bar; unsigned x;
    volatile LAS unsigned* st;
};

__device__ __forceinline__ XcdBarrier xcd_barrier_post(unsigned* bar, volatile LAS unsigned* st) {
    XcdBarrier b; b.bar = bar; b.x = xb_xcc_id(); b.st = st;
    if (threadIdx.x == 0) (void)xb_add(&bar[XB_XCNT(b.x)], 1u);
    return b;
}
__device__ __forceinline__ void xcd_barrier_complete(unsigned* bar, unsigned x, unsigned& nloc, unsigned& nx) {
    const unsigned G = gridDim.x * gridDim.y * gridDim.z;
    unsigned sum, cnt, mine, sp = 0u;
    for (;;) {
        sum = 0u; cnt = 0u; mine = 0u;
#pragma unroll
        for (unsigned j = 0; j < 16; ++j) { const unsigned c = xb_ld(&bar[XB_XCNT(j)]); sum += c; cnt += (c > 0u) ? 1u : 0u; mine = (j == x) ? c : mine; }
        if (sum == G) break;
        __builtin_amdgcn_s_sleep(1);
        if ((++sp & 255u) == 0u) { if (xb_ld(&bar[XB_TMO])) break; if (sp > XB_SPIN_CAP) { atomicAdd(&bar[XB_TMO], 1u); break; } }
    }
    nloc = mine > 0u ? mine : 1u; nx = cnt > 0u ? cnt : 1u;
}

__device__ __forceinline__ void xcd_barrier(const XcdBarrier& b) {
    asm volatile("s_waitcnt vmcnt(0)" ::: "memory");
    __syncthreads();
    if (threadIdx.x == 0) {
        unsigned* bar = b.bar;
        __builtin_amdgcn_s_waitcnt(0);
        unsigned nloc = b.st[0], nx = b.st[1];
        if (nloc == 0u) { xcd_barrier_complete(bar, b.x, nloc, nx); b.st[0] = nloc; b.st[1] = nx; }
        const unsigned old = xb_add(&bar[XB_XSUB(b.x)], 1u);
        const unsigned gen = old / nloc;
        if (old + 1u == (gen + 1u) * nloc) {
            __builtin_amdgcn_fence(__ATOMIC_RELEASE, "agent");
            asm volatile("s_waitcnt vmcnt(0)" ::: "memory");
            const unsigned og = xb_add(&bar[XB_TOP], 1u);
            const unsigned tg = og / nx;
            if (og + 1u == (tg + 1u) * nx) xb_add(&bar[XB_TOPGEN], 1u);
            else XB_SPIN(xb_ld(&bar[XB_TOPGEN]) == tg, bar);
            __builtin_amdgcn_fence(__ATOMIC_ACQUIRE, "agent");
            xb_add(&bar[XB_XGEN(b.x)], 1u);
            asm volatile("s_waitcnt vmcnt(0)" ::: "memory");
        } else {
            XB_SPIN(xb_ld(&bar[XB_XGEN(b.x)]) == gen, bar);
            __builtin_amdgcn_fence(__ATOMIC_ACQUIRE, "agent");
            asm volatile("s_waitcnt vmcnt(0)" ::: "memory");
        }
    }
    __syncthreads();
}


struct Args { const float* in[34]; float* out; unsigned char* ws; int ph_lo, ph_hi; };
constexpr int N_PHASES = 22;

__global__ void __launch_bounds__(NTHR, 2) fwd(Args a) {
    extern __shared__ __attribute__((aligned(16))) unsigned char lds_raw[];
    float* lds = (float*)lds_raw;
    LAS unsigned char* ldsl = (LAS unsigned char*)lds_raw;
    const int vb0 = blockIdx.x, vbs = gridDim.x;
    const int lo = a.ph_lo, hi = a.ph_hi;
#define IN(k) (lo <= (k) && (k) < hi)
#define SEAM(k) do { if (IN(k) && IN((k) + 1)) xcd_barrier(bar); } while (0)
    volatile LAS unsigned* misc = (volatile LAS unsigned*)(ldsl + MISC_OFF);
    if (threadIdx.x < 4) misc[threadIdx.x] = 0u;
    __syncthreads();
    XcdBarrier bar = xcd_barrier_post((unsigned*)(a.ws + WS_CTL) + CW_BAR, misc);
    unsigned char* ws = a.ws;
    unsigned* ctl = (unsigned*)(ws + WS_CTL);
    unsigned* cnt = ctl + CW_CNT;
    int* list = (int*)(ws + WS_LIST); float* gatev = (float*)(ws + WS_GATE);
    float* dtraw = (float*)(ws + WS_DT); float* RS = (float*)(ws + WS_RS);
    bf16_t* XB = (bf16_t*)(ws + WS_XB); bf16_t* UB = (bf16_t*)(ws + WS_UB);
    bf16_t* YA = (bf16_t*)(ws + WS_YA); float* OF = (float*)(ws + WS_OF); bf16_t* OC = (bf16_t*)(ws + WS_OC);
    bf16_t* YP = (bf16_t*)(ws + WS_YP); bf16_t* YP1 = (bf16_t*)(ws + WS_YP1); bf16_t* XC = (bf16_t*)(ws + WS_YP);
    bf16_t* PB0 = (bf16_t*)(ws + WS_PB0); bf16_t* PB1 = (bf16_t*)(ws + WS_PB1);
    bf16_t* YB = (bf16_t*)(ws + WS_Y);
    bf16_t* Y2 = (bf16_t*)(ws + WS_Y2); unsigned char* yflag = ws + WS_YFLAG;
    bf16_t* MS = (bf16_t*)(ws + WS_MS); float* MD = (float*)(ws + WS_MD);
    bf16_t* HS = (bf16_t*)(ws + WS_HS); float* HD = (float*)(ws + WS_HD);
    bf16_t* XT = (bf16_t*)(ws + WS_XT); bf16_t* VT = (bf16_t*)(ws + WS_VT);
    const float* p_in = a.in[1];
    const int G = (int)gridDim.x, cb = (int)blockIdx.x;
    const NormB NB0{nullptr, XB, nullptr, nullptr, RS, nullptr, nullptr, nullptr, nullptr, nullptr, nullptr, nullptr, nullptr, nullptr, nullptr};
    unsigned char* XG8 = ws + WS_XG8;
    float* rsl = (float*)(ws + WS_DT);

    if (IN(0)) {
        ph_convert_weights(ldsl, a.in, ws, 0, ITEMS_DENSE, vb0, vbs);
        NormB A = NB0; A.xin = a.in[0]; A.gnext = a.in[3]; A.win = a.in[4]; A.dtraw = dtraw;
        ph_norm0_dt(A, vb0, vbs, ldsl);
    }
    SEAM(0);
    if (IN(1)) { pg8::DenseOrder S; S.init(MT, UW, DM, (const bf16_t*)(ws + W_IN), G, cb); pg8::gemm_phase(ldsl, XB, DM, S, pg8::EpiBf16{UB, UW, RS}); }
    SEAM(1);
    if (IN(2)) { ph_prep(UB, a.in[5], a.in[6], XC, XT, VT, vb0, vbs); }
    SEAM(2);
    if (IN(3)) { ph_hgrn_states(ldsl, UB, VT, a.in[2], HS, HD, vb0, vbs); ph_mamba_states(ldsl, XT, dtraw, a.in[7], a.in[8], MS, MD, vb0, vbs); }
    SEAM(3);
    if (IN(4)) { ph_hgrn_scan(HS, HD, vb0, vbs); ph_mamba_scan(MS, MD, vb0, vbs); }
    SEAM(4);
    if (IN(5)) { ph_hgrn_out(ldsl, UB, VT, a.in[2], a.in[10], HS, OF, OC, vb0, vbs); ph_mamba_out(ldsl, UB, XC, XT, dtraw, a.in[7], a.in[8], a.in[9], a.in[11], MS, OC, vb0, vbs); }
    SEAM(5);
    if (IN(6)) { pg8::DenseOrder S; S.init(MT, DM, DM, (const bf16_t*)(ws + W_OUTE), G, cb); pg8::gemm_phase(ldsl, OC, DM, S, pg8::EpiBf16{YA, DM, nullptr}); }
    SEAM(6);
    if (IN(7)) {
        NormB A = NB0; A.y = YA; A.gpost = a.in[13];
        ph_norm2<1, false, false, false>(A, vb0, vbs);
        ph_cvt_rows(p_in, PB0, (size_t)MT * PDIM / 4, vb0, vbs);
        ph_convert_experts(ldsl, a.in, ws, ITEMS_DENSE, ITEMS_ALL, vb0, vbs);
    }
    SEAM(7);
    if (IN(8)) {
        { pg8::DenseOrder S; S.init(MT, 2 * DFF, DM, (const bf16_t*)(ws + W_GU), G, cb); pg8::gemm_phase(ldsl, XB, DM, S, pg8::EpiSwiglu{UB, DFF, RS, 0}); }
        { pg8::TailOrder S; S.init(MT, DM, PDIM, (const bf16_t*)(ws + W_PP), G, cb, (MT / 256) * (2 * DFF / 256) % G); pg8::gemm_phase(ldsl, PB0, PDIM, S, pg8::EpiBf16{YP, DM, nullptr}); }
    }
    SEAM(8);
    if (IN(9)) { pg8::DenseOrder S; S.init(MT, DM, DFF, (const bf16_t*)(ws + W_DN), G, cb); pg8::gemm_phase(ldsl, UB, DFF, S, pg8::EpiBf16{YA, DM, nullptr}); }
    SEAM(9);
    if (IN(10)) {
        NormB A = NB0; A.y = YA; A.gpost = a.in[18];
        ph_norm2<1, false, false, false>(A, vb0, vbs);
    }
    SEAM(10);
    if (IN(11)) { pg8::DenseOrder S; S.init(MT, DM, DM, (const bf16_t*)(ws + W_PG), G, cb); pg8::gemm_phase(ldsl, XB, DM, S, pg8::EpiPleGate{YP, DM, RS}); }
    SEAM(11);
    if (IN(12)) {
        NormB A = NB0; A.y = YP; A.gpost = a.in[33];
        ph_norm2<1, false, false, false>(A, vb0, vbs);
    }
    SEAM(12);
    if (IN(13)) { pg8::DenseOrder S; S.init(MT, 3072, DM, (const bf16_t*)(ws + W_QKV), G, cb); pg8::gemm_phase(ldsl, XB, DM, S, pg8::EpiBf16{UB, 3072, RS}); }
    SEAM(13);
    if (IN(14)) { ph_na(ldsl, UB, a.in[21], OC, vb0, vbs); }
    SEAM(14);
    if (IN(15)) { pg8::DenseOrder S; S.init(MT, DM, DM, (const bf16_t*)(ws + W_OUTO), G, cb); pg8::gemm_phase(ldsl, OC, DM, S, pg8::EpiBf16{YP1, DM, nullptr}); }
    SEAM(15);
    if (IN(16)) {
        NormB A = NB0; A.y = YP1; A.gpost = a.in[23]; A.gnext = a.in[24]; A.wr = a.in[25]; A.cnt = cnt; A.list = list; A.gatev = gatev; A.rsl = rsl; A.x8 = XG8;
        ph_norm2<1, false, false, true>(A, vb0, vbs, (LAS float*)ldsl);
        ph_cvt_rows(p_in + (size_t)MT * PDIM, PB1, (size_t)MT * PDIM / 4, vb0, vbs);
    }
    SEAM(16);
    if (IN(17)) { pg8::MoeOrder S; S.init(cnt, (volatile LAS int*)(ldsl + MISC_OFF + 64), 2 * DFFE, DM / 2, (const bf16_t*)(ws + W_EGU), (size_t)7 * MiB, true, G, cb);
        pg8::gemm_phase<pg8::EpiSwiglu8, pg8::MoeOrder, true>(ldsl, (const bf16_t*)XG8, DM / 2, S, pg8::EpiSwiglu8{(unsigned char*)UB, DFFE, rsl}); }
    SEAM(17);
    if (IN(18)) { pg8::MoeOrder S; S.init(cnt, (volatile LAS int*)(ldsl + MISC_OFF + 64), DM, DFFE / 2, (const bf16_t*)(ws + W_EDN), (size_t)(7 * MiB / 2), false, G, cb);
        const pg8::EpiMoeDown E{YB, list, gatev, 1.f / (pg8::W8_SCALE * pg8::ACT8_SCALE), (size_t)(Y2 - YB), yflag};
        S.set_split(true, false, DFFE / 2);
        pg8::gemm_phase<pg8::EpiMoeDown, pg8::MoeOrder, true>(ldsl, UB, DFFE / 2, S, E);
        S.set_split(true, true, DFFE / 2);
        pg8::gemm_phase<pg8::EpiMoeDown, pg8::MoeOrder, true>(ldsl, UB, DFFE / 2, S, E, DFFE / 4);
        { pg8::TailOrder T; T.init(MT, DM, PDIM, (const bf16_t*)(ws + W_PP + 512 * 1024), G, cb, S.tail_first()); pg8::gemm_phase(ldsl, PB1, PDIM, T, pg8::EpiBf16{YP, DM, nullptr}); } }
    SEAM(18);
    if (IN(19)) {
        NormB A = NB0; A.y = YB; A.gpost = a.in[29]; A.y2 = Y2; A.yflag = yflag;
        ph_norm2<2, false, false, false>(A, vb0, vbs);
    }
    SEAM(19);
    if (IN(20)) { pg8::DenseOrder S; S.init(MT, DM, DM, (const bf16_t*)(ws + W_PG + 2 * MiB), G, cb); pg8::gemm_phase(ldsl, XB, DM, S, pg8::EpiPleGate{YP, DM, RS}); }
    SEAM(20);
    if (IN(21)) {
        NormB A = NB0; A.y = YP; A.gpost = a.in[33] + DM; A.xout = a.out;
        ph_norm2<1, true, false, false>(A, vb0, vbs);
    }
#undef IN
#undef SEAM
}

extern "C" void kernel_launch(void* const* d_in, const int* in_sizes, int n_in, void* d_out, int out_size, void* d_ws, size_t ws_size, hipStream_t stream) {
    static int grid = 0;
    if (grid == 0) {
        if (n_in != 34 || out_size != MT * DM || ws_size < WS_END) { fprintf(stderr, "kernel_launch: unexpected shapes n_in %d out %d ws %zu (need %zu)\n", n_in, out_size, ws_size, (size_t)WS_END); grid = -1; return; }
        int dev = 0, cus = 0;
        if (hipGetDevice(&dev) != hipSuccess || hipDeviceGetAttribute(&cus, hipDeviceAttributeMultiprocessorCount, dev) != hipSuccess) { grid = -1; return; }
        if (hipFuncSetAttribute((const void*)fwd, hipFuncAttributeMaxDynamicSharedMemorySize, LDS_BYTES) != hipSuccess) { fprintf(stderr, "hipFuncSetAttribute failed\n"); grid = -1; return; }
        (void)hipGetLastError();
        grid = cus;
    }
    if (grid < 0) return;
    (void)hipMemsetAsync((char*)d_ws + WS_CTL, 0, CTL_ZERO_BYTES, stream);
    Args a{};
    for (int i = 0; i < 34; ++i) a.in[i] = (const float*)d_in[i];
    a.out = (float*)d_out; a.ws = (unsigned char*)d_ws;
#ifndef MK_PER_PHASE
    a.ph_lo = 0; a.ph_hi = N_PHASES;
    hipLaunchKernelGGL(fwd, dim3(grid), dim3(NTHR), LDS_BYTES, stream, a);
#else
    for (int ph = 0; ph < N_PHASES; ++ph) {
        a.ph_lo = ph; a.ph_hi = ph + 1;
        hipLaunchKernelGGL(fwd, dim3(grid), dim3(NTHR), LDS_BYTES, stream, a);
    }
#endif
}
```

```cpp
#include <hip/hip_runtime.h>
#include <stdint.h>
#include <stdio.h>

#define DEVI __device__ __forceinline__
#define LAS __attribute__((address_space(3)))
typedef unsigned short bf16_t;

constexpr int NB = 4, SEQ = 4096, DM = 1024, MT = NB * SEQ;
constexpr int EVEN_IN = 4112, UW = 4096, DFF = 2816, NEXP = 8, DFFE = 3584, PDIM = 256;
constexpr float EPS = 1e-6f;
constexpr int NTHR = 512;
constexpr int LDS_BYTES = 147456;
constexpr int MISC_OFF = 131072 + 320;
constexpr int MOE_ROWS = 2 * MT + NEXP * 256;

constexpr size_t MiB = 1u << 20;
constexpr size_t WS_CTL = 0, CTL_ZERO_BYTES = 1 * MiB;
constexpr size_t WS_LIST = 1 * MiB;
constexpr size_t WS_GATE = WS_LIST + 512 * 1024;
constexpr size_t WS_DT = 2 * MiB;
constexpr size_t WS_W = 3 * MiB;
constexpr size_t W_IN = WS_W, W_OUTE = W_IN + 8 * MiB, W_GU = W_OUTE + 2 * MiB, W_DN = W_GU + 11 * MiB, W_PG = W_DN + 6 * MiB, W_PP = W_PG + 4 * MiB,
                 W_QKV = W_PP + 1 * MiB, W_OUTO = W_QKV + 6 * MiB, W_EGU = W_OUTO + 2 * MiB, W_EDN = W_EGU + 112 * MiB, W_END = W_EDN + 56 * MiB;
constexpr size_t WS_XB = W_END;
constexpr size_t WS_R = WS_XB + 32 * MiB;
constexpr size_t WS_UB = WS_R;
constexpr size_t WS_PB0 = WS_R + 88 * MiB;
constexpr size_t WS_YA = WS_R + 128 * MiB;
constexpr size_t WS_OF = WS_R + 160 * MiB;
constexpr size_t WS_OC = WS_R + 192 * MiB;
constexpr size_t WS_YP = WS_R + 224 * MiB;
constexpr size_t WS_YP1 = WS_R;
constexpr size_t WS_PB1 = W_EDN + 32 * MiB;
constexpr size_t WS_XG8 = WS_R + 120 * MiB;
constexpr size_t WS_END = WS_R + 256 * MiB;
constexpr size_t WS_Y2 = WS_R + 120 * MiB;
constexpr size_t WS_YFLAG = WS_CTL + 256 * 1024;
constexpr size_t WS_Y = W_EGU;
constexpr size_t WS_MS = W_EGU;
constexpr size_t WS_HS = W_EGU + 64 * MiB;
constexpr size_t WS_XT = W_EDN;
constexpr size_t WS_VT = W_EDN + 24 * MiB;
constexpr size_t WS_MD = W_EDN + 40 * MiB;
constexpr size_t WS_HD = W_EDN + 41 * MiB;
static_assert(WS_R + (size_t)MOE_ROWS * DFFE <= WS_XG8 && WS_XG8 + 128 * MiB <= WS_END && WS_END <= 510 * MiB, "ws map");
constexpr size_t WS_RS = WS_CTL + 512 * 1024;
constexpr int CW_CNT = 64;
constexpr int CW_BAR = 4096;

DEVI int opq(int x) { asm volatile("" : "+v"(x)); return x; }
DEVI float bf2f(bf16_t b) { return __uint_as_float(((unsigned)b) << 16); }
typedef float f32x2c __attribute__((ext_vector_type(2)));
typedef __bf16 bf16x2c __attribute__((ext_vector_type(2)));
DEVI unsigned cvt2bf(float lo, float hi) { const f32x2c v = {lo, hi}; return __builtin_bit_cast(unsigned, __builtin_convertvector(v, bf16x2c)); }
DEVI bf16_t f2bf(float f) { return (bf16_t)(cvt2bf(f, 0.f) & 0xffffu); }
DEVI float silu_f(float x) { return x * __builtin_amdgcn_rcpf(1.f + __builtin_amdgcn_exp2f(-1.44269504f * x)); }
DEVI float sigmoid_f(float x) { return __builtin_amdgcn_rcpf(1.f + __builtin_amdgcn_exp2f(-1.44269504f * x)); }
DEVI float softplus_f(float x) { return x > 20.f ? x : log1pf(__expf(x)); }
DEVI float wave_sum(float v) {
#pragma unroll
    for (int o = 1; o < 64; o <<= 1) v += __shfl_xor(v, o);
    return v;
}


typedef short bf16x8 __attribute__((ext_vector_type(8)));
typedef float f32x4 __attribute__((ext_vector_type(4)));
typedef unsigned u32x4 __attribute__((ext_vector_type(4)));
typedef unsigned u32x2 __attribute__((ext_vector_type(2)));
DEVI unsigned pk2(float lo, float hi) { return cvt2bf(lo, hi); }
DEVI float bflo(unsigned w) { return __uint_as_float(w << 16); }
DEVI float bfhi(unsigned w) { return __uint_as_float(w & 0xffff0000u); }

DEVI unsigned pg8_pk4(float a, float b, float c, float d) {
    a = __builtin_amdgcn_fmed3f(a, -448.f, 448.f); b = __builtin_amdgcn_fmed3f(b, -448.f, 448.f); c = __builtin_amdgcn_fmed3f(c, -448.f, 448.f); d = __builtin_amdgcn_fmed3f(d, -448.f, 448.f);
    int p = __builtin_amdgcn_cvt_pk_fp8_f32(a, b, 0, false); p = __builtin_amdgcn_cvt_pk_fp8_f32(c, d, p, true); return (unsigned)p; }
DEVI float wave_sum16(float (&v)[16], int lane) {
    const bool h5 = lane & 32, h4 = lane & 16, h3 = lane & 8, h2 = lane & 4;
#pragma unroll
    for (int i = 0; i < 8; ++i) { const float send = h5 ? v[i] : v[i + 8], keep = h5 ? v[i + 8] : v[i]; v[i] = keep + __shfl_xor(send, 32); }
#pragma unroll
    for (int i = 0; i < 4; ++i) { const float send = h4 ? v[i] : v[i + 4], keep = h4 ? v[i + 4] : v[i]; v[i] = keep + __shfl_xor(send, 16); }
#pragma unroll
    for (int i = 0; i < 2; ++i) { const float send = h3 ? v[i] : v[i + 2], keep = h3 ? v[i + 2] : v[i]; v[i] = keep + __shfl_xor(send, 8); }
    { const float send = h2 ? v[0] : v[1], keep = h2 ? v[1] : v[0]; v[0] = keep + __shfl_xor(send, 4); }
    float r = v[0]; r += __shfl_xor(r, 1); r += __shfl_xor(r, 2); return r;
}
DEVI float wave_sum8(float (&v)[8], int lane) {
    const bool h5 = lane & 32, h4 = lane & 16, h3 = lane & 8;
#pragma unroll
    for (int i = 0; i < 4; ++i) { const float send = h5 ? v[i] : v[i + 4], keep = h5 ? v[i + 4] : v[i]; v[i] = keep + __shfl_xor(send, 32); }
#pragma unroll
    for (int i = 0; i < 2; ++i) { const float send = h4 ? v[i] : v[i + 2], keep = h4 ? v[i + 2] : v[i]; v[i] = keep + __shfl_xor(send, 16); }
    { const float send = h3 ? v[0] : v[1], keep = h3 ? v[1] : v[0]; v[0] = keep + __shfl_xor(send, 8); }
    float r = v[0]; r += __shfl_xor(r, 1); r += __shfl_xor(r, 2); r += __shfl_xor(r, 4); return r;
}
struct NormB { const float* xin; bf16_t* XB; const bf16_t* y; const float* gpost; float* rs; const float* gnext;
               const float* win; float* dtraw; const float* wr; unsigned* cnt; int* list; float* gatev; float* rsl; float* xout; unsigned char* x8; const bf16_t* y2; const unsigned char* yflag; };
DEVI void unpack8(const u32x4 w, float* v) { v[0] = bflo(w.x); v[1] = bfhi(w.x); v[2] = bflo(w.y); v[3] = bfhi(w.y); v[4] = bflo(w.z); v[5] = bfhi(w.z); v[6] = bflo(w.w); v[7] = bfhi(w.w); }
template <int YMODE, bool FINAL, bool DT, bool ROUTE>
DEVI void ph_norm2(const NormB& A, int vb0, int vbs, LAS float* wl = nullptr) {
    const int tidq = opq((int)threadIdx.x); const int wid = tidq >> 6, lane = tidq & 63;
    if (DT || ROUTE) {
        constexpr int NJ = DT ? 16 : 8;
        __syncthreads();
        for (int e = tidq; e < DM * NJ / 4; e += NTHR) { const int k = e / (NJ / 4), j4 = (e % (NJ / 4)) * 4;
            const float4 w = DT ? *(const float4*)(A.win + (size_t)k * EVEN_IN + 4096 + j4) : *(const float4*)(A.wr + (size_t)k * 8 + j4);
            wl[(j4 + 0) * DM + k] = w.x; wl[(j4 + 1) * DM + k] = w.y; wl[(j4 + 2) * DM + k] = w.z; wl[(j4 + 3) * DM + k] = w.w; }
        __syncthreads();
    }
    constexpr int R = (DT || ROUTE) ? 2 : 4;
    for (int row0 = (vb0 * 8 + wid) * R; row0 < MT; row0 += vbs * 8 * R) {
        float xv[R][16]; float yv[R][16];
#pragma unroll
        for (int rr = 0; rr < R; ++rr) {
            const size_t ro = (size_t)(row0 + rr) * DM + lane * 8;
            if (YMODE == 0) {
#pragma unroll
                for (int i = 0; i < 2; ++i) { const float4 p0 = *(const float4*)(A.xin + ro + i * 512), p1 = *(const float4*)(A.xin + ro + i * 512 + 4);
                    xv[rr][i * 8 + 0] = p0.x; xv[rr][i * 8 + 1] = p0.y; xv[rr][i * 8 + 2] = p0.z; xv[rr][i * 8 + 3] = p0.w; xv[rr][i * 8 + 4] = p1.x; xv[rr][i * 8 + 5] = p1.y; xv[rr][i * 8 + 6] = p1.z; xv[rr][i * 8 + 7] = p1.w; }
            } else {
#pragma unroll
                for (int i = 0; i < 2; ++i) {
                    unpack8(*(const u32x4*)(A.XB + ro + i * 512), xv[rr] + i * 8);
                    unpack8(*(const u32x4*)(A.y + ro + i * 512), yv[rr] + i * 8);
                    if (YMODE == 2) { float y2[8]; unpack8(*(const u32x4*)(A.y + (size_t)MT * DM + ro + i * 512), y2);
#pragma unroll
                        for (int j = 0; j < 8; ++j) yv[rr][i * 8 + j] += y2[j]; }
                }
            }
        }
        if (YMODE == 2) {
#pragma unroll
            for (int rr = 0; rr < R; ++rr) { const u32x2 fw = *(const u32x2*)(A.yflag + (size_t)(row0 + rr) * 8);
                const unsigned f0 = __builtin_amdgcn_readfirstlane(fw.x), f1 = __builtin_amdgcn_readfirstlane(fw.y);
                if (f0 | f1) { const size_t ro = (size_t)(row0 + rr) * DM + lane * 8;
#pragma unroll
                    for (int sl = 0; sl < 2; ++sl) { const unsigned fs = sl ? f1 : f0;
#pragma unroll
                        for (int i = 0; i < 2; ++i) if ((fs >> (8 * ((lane >> 5) + 2 * i))) & 0xff) { float y2[8]; unpack8(*(const u32x4*)(A.y2 + (size_t)sl * MT * DM + ro + i * 512), y2);
#pragma unroll
                            for (int j = 0; j < 8; ++j) yv[rr][i * 8 + j] += y2[j]; } } } }
        }
        if (YMODE != 0) {
            float gg[16];
#pragma unroll
            for (int i = 0; i < 2; ++i) { const float4 g0 = *(const float4*)(A.gpost + i * 512 + lane * 8), g1 = *(const float4*)(A.gpost + i * 512 + lane * 8 + 4);
                gg[i * 8 + 0] = g0.x; gg[i * 8 + 1] = g0.y; gg[i * 8 + 2] = g0.z; gg[i * 8 + 3] = g0.w; gg[i * 8 + 4] = g1.x; gg[i * 8 + 5] = g1.y; gg[i * 8 + 6] = g1.z; gg[i * 8 + 7] = g1.w; }
            float ss[R];
#pragma unroll
            for (int rr = 0; rr < R; ++rr) { ss[rr] = 0.f;
#pragma unroll
                for (int j = 0; j < 16; ++j) ss[rr] += yv[rr][j] * yv[rr][j]; }
#pragma unroll
            for (int o = 1; o < 64; o <<= 1)
#pragma unroll
                for (int rr = 0; rr < R; ++rr) ss[rr] += __shfl_xor(ss[rr], o);
#pragma unroll
            for (int rr = 0; rr < R; ++rr) { const float r = rsqrtf(ss[rr] * (1.f / DM) + EPS);
#pragma unroll
                for (int j = 0; j < 16; ++j) xv[rr][j] += yv[rr][j] * r * gg[j]; }
        }
        if (FINAL) {
#pragma unroll
            for (int rr = 0; rr < R; ++rr)
#pragma unroll
                for (int i = 0; i < 2; ++i) { float* op = A.xout + (size_t)(row0 + rr) * DM + i * 512 + lane * 8;
                    *(float4*)op = make_float4(xv[rr][i * 8], xv[rr][i * 8 + 1], xv[rr][i * 8 + 2], xv[rr][i * 8 + 3]); *(float4*)(op + 4) = make_float4(xv[rr][i * 8 + 4], xv[rr][i * 8 + 5], xv[rr][i * 8 + 6], xv[rr][i * 8 + 7]); }
        } else {
            float ss[R];
#pragma unroll
            for (int rr = 0; rr < R; ++rr) {
#pragma unroll
                for (int i = 0; i < 2; ++i) { u32x4 o; o.x = pk2(xv[rr][i * 8], xv[rr][i * 8 + 1]); o.y = pk2(xv[rr][i * 8 + 2], xv[rr][i * 8 + 3]); o.z = pk2(xv[rr][i * 8 + 4], xv[rr][i * 8 + 5]); o.w = pk2(xv[rr][i * 8 + 6], xv[rr][i * 8 + 7]);
                    *(u32x4*)(A.XB + (size_t)(row0 + rr) * DM + i * 512 + lane * 8) = o;
                }
                ss[rr] = 0.f;
#pragma unroll
                for (int j = 0; j < 16; ++j) ss[rr] += xv[rr][j] * xv[rr][j];
            }
#pragma unroll
            for (int o = 1; o < 64; o <<= 1)
#pragma unroll
                for (int rr = 0; rr < R; ++rr) ss[rr] += __shfl_xor(ss[rr], o);
            float r2[R];
#pragma unroll
            for (int rr = 0; rr < R; ++rr) { r2[rr] = rsqrtf(ss[rr] * (1.f / DM) + EPS); if (lane == 0) A.rs[row0 + rr] = r2[rr]; }
            if (DT || ROUTE) {
                float gn[16];
#pragma unroll
                for (int i = 0; i < 2; ++i) { const float4 g0 = *(const float4*)(A.gnext + i * 512 + lane * 8), g1 = *(const float4*)(A.gnext + i * 512 + lane * 8 + 4);
                    gn[i * 8 + 0] = g0.x; gn[i * 8 + 1] = g0.y; gn[i * 8 + 2] = g0.z; gn[i * 8 + 3] = g0.w; gn[i * 8 + 4] = g1.x; gn[i * 8 + 5] = g1.y; gn[i * 8 + 6] = g1.z; gn[i * 8 + 7] = g1.w; }
                int re1[R], re2[R], lr1[R], lr2[R]; float rw1[R], rw2[R];
                volatile LAS int* lcnt = (volatile LAS int*)((LAS unsigned char*)wl + 40960);
                if (ROUTE) { __syncthreads(); if (tidq < 8) lcnt[tidq] = 0; __syncthreads(); }
#pragma unroll
                for (int rr = 0; rr < R; ++rr) {
                    const int row = row0 + rr;
                    float hv[16];
#pragma unroll
                    for (int j = 0; j < 16; ++j) hv[j] = (rr == 0 ? xv[0][j] : xv[R - 1][j]) * (rr == 0 ? r2[0] : r2[R - 1]) * gn[j];
                    if (DT) {
                        float pd[16];
#pragma unroll 4
                        for (int j = 0; j < 16; ++j) {
                            float p = 0.f;
#pragma unroll
                            for (int i = 0; i < 2; ++i) { const LAS float* wp = wl + j * DM + i * 512 + lane * 8;
                                const f32x4 w0 = *(const LAS f32x4*)wp, w1 = *(const LAS f32x4*)(wp + 4);
                                p += hv[i * 8 + 0] * w0[0] + hv[i * 8 + 1] * w0[1] + hv[i * 8 + 2] * w0[2] + hv[i * 8 + 3] * w0[3] + hv[i * 8 + 4] * w1[0] + hv[i * 8 + 5] * w1[1] + hv[i * 8 + 6] * w1[2] + hv[i * 8 + 7] * w1[3]; }
                            pd[j] = p;
                        }
                        const float dk = wave_sum16(pd, lane);
                        if ((lane & 3) == 0) A.dtraw[(size_t)row * 16 + (lane >> 2)] = dk;
                    }
                    if (ROUTE) {
                        float pl[8];
#pragma unroll 4
                        for (int e = 0; e < 8; ++e) {
                            float p = 0.f;
#pragma unroll
                            for (int i = 0; i < 2; ++i) { const LAS float* wp = wl + e * DM + i * 512 + lane * 8;
                                const f32x4 w0 = *(const LAS f32x4*)wp, w1 = *(const LAS f32x4*)(wp + 4);
                                p += hv[i * 8 + 0] * w0[0] + hv[i * 8 + 1] * w0[1] + hv[i * 8 + 2] * w0[2] + hv[i * 8 + 3] * w0[3] + hv[i * 8 + 4] * w1[0] + hv[i * 8 + 5] * w1[1] + hv[i * 8 + 6] * w1[2] + hv[i * 8 + 7] * w1[3]; }
                            pl[e] = p;
                        }
                        const float lk = wave_sum8(pl, lane);
                        float lg[8];
#pragma unroll
                        for (int e = 0; e < 8; ++e) lg[e] = __shfl(lk, e * 8);
                        int e1 = 0; float v1 = lg[0];
#pragma unroll
                        for (int e = 1; e < 8; ++e) if (lg[e] > v1) { v1 = lg[e]; e1 = e; }
                        int e2 = 0; float v2 = -3.0e38f;
#pragma unroll
                        for (int e = 0; e < 8; ++e) if (e != e1 && lg[e] > v2) { v2 = lg[e]; e2 = e; }
                        const float ex = __expf(v2 - v1);
                        re1[rr] = e1; re2[rr] = e2; rw1[rr] = 1.f / (1.f + ex); rw2[rr] = ex / (1.f + ex);
                        if (lane == 0) { lr1[rr] = __hip_atomic_fetch_add((LAS int*)lcnt + e1, 1, __ATOMIC_RELAXED, __HIP_MEMORY_SCOPE_WORKGROUP); lr2[rr] = __hip_atomic_fetch_add((LAS int*)lcnt + e2, 1, __ATOMIC_RELAXED, __HIP_MEMORY_SCOPE_WORKGROUP); }
                    }
                }
                if (ROUTE) {
                    __syncthreads();
                    if (tidq < 8) lcnt[8 + tidq] = (int)atomicAdd(&A.cnt[tidq * 64], (unsigned)lcnt[tidq]);
                    __syncthreads();
#pragma unroll
                    for (int rr = 0; rr < R; ++rr) {
                        const int row = row0 + rr;
                        int dst1 = 0, dst2 = 0;
                        if (lane == 0) {
                            const int e1 = re1[rr], e2 = re2[rr];
                            const int p1 = lcnt[8 + e1] + lr1[rr], p2 = lcnt[8 + e2] + lr2[rr];
                            A.list[e1 * MT + p1] = row * 2; A.gatev[e1 * MT + p1] = rw1[rr]; A.rsl[e1 * MT + p1] = r2[rr];
                            A.list[e2 * MT + p2] = row * 2 + 1; A.gatev[e2 * MT + p2] = rw2[rr]; A.rsl[e2 * MT + p2] = r2[rr];
                            dst1 = e1 * MT + p1; dst2 = e2 * MT + p2;
                        }
                        dst1 = __builtin_amdgcn_readfirstlane(dst1); dst2 = __builtin_amdgcn_readfirstlane(dst2);
#pragma unroll
                        for (int i = 0; i < 2; ++i) { u32x2 o8;
                            const float* xs = xv[rr] + i * 8;
                            o8.x = pg8_pk4(xs[0], xs[1], xs[2], xs[3]); o8.y = pg8_pk4(xs[4], xs[5], xs[6], xs[7]);
                            *(u32x2*)(A.x8 + (size_t)dst1 * DM + i * 512 + lane * 8) = o8; *(u32x2*)(A.x8 + (size_t)dst2 * DM + i * 512 + lane * 8) = o8; }
                    }
                }
            }
        }
    }
}

constexpr int DTW_LD = (DM + 8) * 2;
DEVI void ph_norm0_dt(const NormB& A, int vb0, int vbs, LAS unsigned char* lds) {
    const int tidq = opq((int)threadIdx.x); const int wid = tidq >> 6, lane = tidq & 63, fr = lane & 15, fq = lane >> 4;
    __syncthreads();
    for (int e = tidq; e < DM * 4; e += NTHR) { const int k = e >> 2, j4 = (e & 3) * 4;
        const float4 w = *(const float4*)(A.win + (size_t)k * EVEN_IN + 4096 + j4); const float g = A.gnext[k];
        const float wv[4] = {w.x * g, w.y * g, w.z * g, w.w * g};
#pragma unroll
        for (int i = 0; i < 4; ++i) { const unsigned short hi = f2bf(wv[i]); const unsigned short lo = f2bf(wv[i] - bf2f(hi));
            *(LAS unsigned short*)(lds + (j4 + i) * DTW_LD + k * 2) = hi; *(LAS unsigned short*)(lds + (16 + j4 + i) * DTW_LD + k * 2) = lo; } }
    __syncthreads();
    for (int row0 = (vb0 * 8 + wid) * 8; row0 < MT; row0 += vbs * 64) {
        const int row = row0 + (fr & 7);
        const float* xp = A.xin + (size_t)row * DM + fq * 8;
        bf16_t* xbp = A.XB + (size_t)row * DM + fq * 8;
        const LAS unsigned char* wp = lds + fr * DTW_LD + fq * 16;
        f32x4 acc = {0.f, 0.f, 0.f, 0.f}; float ss = 0.f;
        float4 cu[8][2], nx[8][2];
#pragma unroll
        for (int s2 = 0; s2 < 8; ++s2) { cu[s2][0] = *(const float4*)(xp + s2 * 32); cu[s2][1] = *(const float4*)(xp + s2 * 32 + 4); }
#pragma unroll 1
        for (int c = 0; c < 4; ++c) {
            if (c < 3) {
#pragma unroll
                for (int s2 = 0; s2 < 8; ++s2) { nx[s2][0] = *(const float4*)(xp + (c + 1) * 256 + s2 * 32); nx[s2][1] = *(const float4*)(xp + (c + 1) * 256 + s2 * 32 + 4); } }
#pragma unroll
            for (int s2 = 0; s2 < 8; ++s2) { const int kk = c * 8 + s2;
                const float v[8] = {cu[s2][0].x, cu[s2][0].y, cu[s2][0].z, cu[s2][0].w, cu[s2][1].x, cu[s2][1].y, cu[s2][1].z, cu[s2][1].w};
                u32x4 hw, lw;
                hw.x = cvt2bf(v[0], v[1]); hw.y = cvt2bf(v[2], v[3]); hw.z = cvt2bf(v[4], v[5]); hw.w = cvt2bf(v[6], v[7]);
                lw.x = cvt2bf(v[0] - bflo(hw.x), v[1] - bfhi(hw.x)); lw.y = cvt2bf(v[2] - bflo(hw.y), v[3] - bfhi(hw.y)); lw.z = cvt2bf(v[4] - bflo(hw.z), v[5] - bfhi(hw.z)); lw.w = cvt2bf(v[6] - bflo(hw.w), v[7] - bfhi(hw.w));
#pragma unroll
                for (int i = 0; i < 8; ++i) ss += v[i] * v[i];
                if (fr < 8) *(u32x4*)(xbp + kk * 32) = hw;
                const bf16x8 xh = __builtin_bit_cast(bf16x8, hw), xl = __builtin_bit_cast(bf16x8, lw);
                const bf16x8 wh = *(const LAS bf16x8*)(wp + kk * 64), wl = *(const LAS bf16x8*)(wp + 16 * DTW_LD + kk * 64);
                acc = __builtin_amdgcn_mfma_f32_16x16x32_bf16(xh, wh, acc, 0, 0, 0);
                acc = __builtin_amdgcn_mfma_f32_16x16x32_bf16(xl, wh, acc, 0, 0, 0);
                acc = __builtin_amdgcn_mfma_f32_16x16x32_bf16(xh, wl, acc, 0, 0, 0); }
#pragma unroll
            for (int s2 = 0; s2 < 8; ++s2) { cu[s2][0] = nx[s2][0]; cu[s2][1] = nx[s2][1]; }
        }
        ss += __shfl_xor(ss, 16); ss += __shfl_xor(ss, 32);
        const float r = rsqrtf(ss * (1.f / DM) + EPS);
        if (lane < 8) A.rs[row0 + lane] = r;
#pragma unroll
        for (int v = 0; v < 4; ++v) { const float rm = __shfl(r, (4 * fq + v) & 7);
            if (fq < 2) A.dtraw[(size_t)(row0 + 4 * fq + v) * 16 + fr] = acc[v] * rm; }
    }
}
DEVI void transpose_item(const float* W, int ldw, int K, int k0, int n0, bf16_t* WT, int drow0, LAS float* scr, int lane, const float* gain) {
    {
        const int ka = lane >> 3, n4 = (lane & 7) * 4;
        float4 wv[8];
#pragma unroll
        for (int i = 0; i < 8; ++i) wv[i] = *(const float4*)(W + (size_t)(k0 + i * 8 + ka) * ldw + n0 + n4);
#pragma unroll
        for (int i = 0; i < 8; ++i) { LAS float* d = scr + (i * 8 + ka) * 33 + n4; d[0] = wv[i].x; d[1] = wv[i].y; d[2] = wv[i].z; d[3] = wv[i].w; }
    }
    asm volatile("s_waitcnt lgkmcnt(0)" ::: "memory");
    const int c = lane & 7;
    float4 ga = make_float4(1.f, 1.f, 1.f, 1.f), gb = ga;
    if (gain) { ga = *(const float4*)(gain + k0 + 8 * c); gb = *(const float4*)(gain + k0 + 8 * c + 4); }
#pragma unroll
    for (int j = 0; j < 4; ++j) { const int n = (lane >> 3) + 8 * j; const LAS float* sp = scr + (8 * c) * 33 + n;
        u32x4 o; o.x = pk2(sp[0 * 33] * ga.x, sp[1 * 33] * ga.y); o.y = pk2(sp[2 * 33] * ga.z, sp[3 * 33] * ga.w); o.z = pk2(sp[4 * 33] * gb.x, sp[5 * 33] * gb.y); o.w = pk2(sp[6 * 33] * gb.z, sp[7 * 33] * gb.w);
        *(u32x4*)(WT + (size_t)(drow0 + n) * K + k0 + 8 * c) = o; }
    asm volatile("s_waitcnt lgkmcnt(0)" ::: "memory");
}
DEVI void transpose_item_fp8(const float* W, int ldw, int K, int k0, int n0, unsigned char* WT8, int drow0, LAS float* scr, int lane, const float* gain) {
    {
        const int ka = lane >> 3, n4 = (lane & 7) * 4;
        float4 wv[8];
#pragma unroll
        for (int i = 0; i < 8; ++i) wv[i] = *(const float4*)(W + (size_t)(k0 + i * 8 + ka) * ldw + n0 + n4);
#pragma unroll
        for (int i = 0; i < 8; ++i) { LAS float* d = scr + (i * 8 + ka) * 33 + n4; d[0] = wv[i].x; d[1] = wv[i].y; d[2] = wv[i].z; d[3] = wv[i].w; }
    }
    asm volatile("s_waitcnt lgkmcnt(0)" ::: "memory");
    const int c = lane & 7;
    float4 ga = make_float4(64.f, 64.f, 64.f, 64.f), gb = ga;
    if (gain) { ga = *(const float4*)(gain + k0 + 8 * c); gb = *(const float4*)(gain + k0 + 8 * c + 4); ga.x *= 64.f; ga.y *= 64.f; ga.z *= 64.f; ga.w *= 64.f; gb.x *= 64.f; gb.y *= 64.f; gb.z *= 64.f; gb.w *= 64.f; }
#pragma unroll
    for (int j = 0; j < 4; ++j) { const int n = (lane >> 3) + 8 * j; const LAS float* sp = scr + (8 * c) * 33 + n;
        u32x2 o; o.x = pg8_pk4(sp[0 * 33] * ga.x, sp[1 * 33] * ga.y, sp[2 * 33] * ga.z, sp[3 * 33] * ga.w); o.y = pg8_pk4(sp[4 * 33] * gb.x, sp[5 * 33] * gb.y, sp[6 * 33] * gb.z, sp[7 * 33] * gb.w);
        *(u32x2*)(WT8 + (size_t)(drow0 + n) * K + k0 + 8 * c) = o; }
    asm volatile("s_waitcnt lgkmcnt(0)" ::: "memory");
}
struct Job { int in_idx; unsigned src_off; int ldw; int K; int ncols; unsigned long long dst; int mode; int item0; int gain_idx; int gain_off; int fp8; };
constexpr int NJOBS = 11 + 24;
struct JobTable { Job j[NJOBS]; int total; };
constexpr JobTable make_jobs() {
    JobTable t{}; int n = 0, it = 0;
    auto add = [&](int idx, unsigned off, int ldw, int K, int ncols, unsigned long long dst, int mode, int gi, int go, int f8 = 0) { t.j[n] = Job{idx, off, ldw, K, ncols, dst, mode, it, gi, go, f8}; it += (K / 64) * (ncols / 32); ++n; };
    add(4, 0, EVEN_IN, DM, UW, W_IN, 0, 3, 0);
    add(12, 0, DM, DM, DM, W_OUTE, 0, -1, 0);
    add(15, 0, DFF, DM, DFF, W_GU, 1, 14, 0);
    add(16, 0, DFF, DM, DFF, W_GU, 2, 14, 0);
    add(17, 0, DM, DFF, DM, W_DN, 0, -1, 0);
    add(31, 0, DM, DM, DM, W_PG, 0, 30, 0);
    add(31, DM * DM, DM, DM, DM, W_PG + 2 * MiB, 0, 30, DM);
    add(32, 0, DM, PDIM, DM, W_PP, 0, -1, 0);
    add(32, PDIM * DM, DM, PDIM, DM, W_PP + 512 * 1024, 0, -1, 0);
    add(20, 0, 3072, DM, 3072, W_QKV, 0, 19, 0);
    add(22, 0, DM, DM, DM, W_OUTO, 0, -1, 0);
    for (int e = 0; e < NEXP; ++e) {
        add(26, (unsigned)e * DM * DFFE, DFFE, DM, DFFE, W_EGU + (unsigned long long)e * 7 * MiB, 1, 24, 0, 1);
        add(27, (unsigned)e * DM * DFFE, DFFE, DM, DFFE, W_EGU + (unsigned long long)e * 7 * MiB, 2, 24, 0, 1);
        add(28, (unsigned)e * DFFE * DM, DM, DFFE, DM, W_EDN + (unsigned long long)e * (7 * MiB / 2), 0, -1, 0, 1);
    }
    t.total = it; return t;
}
__device__ const JobTable g_jobs = make_jobs();
constexpr int ITEMS_DENSE = make_jobs().j[11].item0, ITEMS_ALL = make_jobs().total;
struct CvtIt { const float* src; unsigned char* dst; const float* gp; int ldw, K, k0, n0, drow0; };
DEVI void cvt_decode(CvtIt& c, int it, int& jb, const float* const* in, unsigned char* ws) {
    while (jb + 1 < NJOBS && g_jobs.j[jb + 1].item0 <= it) ++jb;
    const Job J = g_jobs.j[jb];
    const int r = it - J.item0; const int nblk = J.ncols / 32; const int kb = r / nblk, nb = r % nblk;
    const int n0 = nb * 32; int drow0 = n0;
    if (J.mode != 0) drow0 = (n0 >> 7) * 256 + (n0 & 127) + (J.mode == 2 ? 128 : 0);
    c.src = in[J.in_idx] + J.src_off; c.dst = ws + J.dst; c.gp = J.gain_idx >= 0 ? in[J.gain_idx] + J.gain_off : nullptr; c.ldw = J.ldw; c.K = J.K; c.k0 = kb * 64; c.n0 = n0; c.drow0 = drow0;
}
DEVI void fp8_item_load(float4 (&wv)[8], float4& ga, float4& gb, const CvtIt& c, int lane) {
    const int ka = lane >> 3, n4 = (lane & 7) * 4;
    ga = make_float4(1.f, 1.f, 1.f, 1.f); gb = ga;
    if (c.gp) { ga = *(const float4*)(c.gp + c.k0 + 8 * (lane & 7)); gb = *(const float4*)(c.gp + c.k0 + 8 * (lane & 7) + 4); }
#pragma unroll
    for (int i = 0; i < 8; ++i) wv[i] = *(const float4*)(c.src + (size_t)(c.k0 + i * 8 + ka) * c.ldw + c.n0 + n4);
}
DEVI void fp8_item_finish(const float4 (&wv)[8], float4 ga, float4 gb, const CvtIt& c, LAS float* scr, int lane) {
    { const int ka = lane >> 3, n4 = (lane & 7) * 4;
#pragma unroll
        for (int i = 0; i < 8; ++i) { LAS float* d = scr + (i * 8 + ka) * 33 + n4; d[0] = wv[i].x; d[1] = wv[i].y; d[2] = wv[i].z; d[3] = wv[i].w; } }
    asm volatile("s_waitcnt lgkmcnt(0)" ::: "memory");
    const int cc = lane & 7;
    ga.x *= 64.f; ga.y *= 64.f; ga.z *= 64.f; ga.w *= 64.f; gb.x *= 64.f; gb.y *= 64.f; gb.z *= 64.f; gb.w *= 64.f;
#pragma unroll
    for (int j = 0; j < 4; ++j) { const int n = (lane >> 3) + 8 * j; const LAS float* sp = scr + (8 * cc) * 33 + n;
        u32x2 o; o.x = pg8_pk4(sp[0 * 33] * ga.x, sp[1 * 33] * ga.y, sp[2 * 33] * ga.z, sp[3 * 33] * ga.w); o.y = pg8_pk4(sp[4 * 33] * gb.x, sp[5 * 33] * gb.y, sp[6 * 33] * gb.z, sp[7 * 33] * gb.w);
        *(u32x2*)(c.dst + (size_t)(c.drow0 + n) * c.K + c.k0 + 8 * cc) = o; }
    asm volatile("s_waitcnt lgkmcnt(0)" ::: "memory");
}
DEVI void ph_convert_experts(LAS unsigned char* lds, const float* const* in, unsigned char* ws, int it_lo, int it_hi, int vb0, int vbs) {
    const int tidq = opq((int)threadIdx.x); const int wid = __builtin_amdgcn_readfirstlane(tidq >> 6), lane = tidq & 63;
    LAS float* scr = (LAS float*)(lds + wid * 16384);
    int jb = 11; int it = it_lo + vb0 * 8 + wid; if (it >= it_hi) return;
    CvtIt cur, nxt; float4 wc[8], wn[8], gca, gcb, gna, gnb;
    cvt_decode(cur, it, jb, in, ws); fp8_item_load(wc, gca, gcb, cur, lane);
    for (;;) {
        const int itn = it + vbs * 8; const bool hn = itn < it_hi;
        if (hn) { cvt_decode(nxt, itn, jb, in, ws); fp8_item_load(wn, gna, gnb, nxt, lane); }
        fp8_item_finish(wc, gca, gcb, cur, scr, lane);
        if (!hn) break;
        cur = nxt; it = itn; gca = gna; gcb = gnb;
#pragma unroll
        for (int i = 0; i < 8; ++i) wc[i] = wn[i];
    }
}
DEVI void ph_convert_weights(LAS unsigned char* lds, const float* const* in, unsigned char* ws, int it_lo, int it_hi, int vb0, int vbs) {
    const int tidq = opq((int)threadIdx.x); const int wid = __builtin_amdgcn_readfirstlane(tidq >> 6), lane = tidq & 63;
    LAS float* scr = (LAS float*)(lds + wid * 16384);
    int jb = 0;
    for (int it = it_lo + vb0 * 8 + wid; it < it_hi; it += vbs * 8) {
        while (jb + 1 < NJOBS && g_jobs.j[jb + 1].item0 <= it) ++jb;
        const Job J = g_jobs.j[jb];
        const int r = it - J.item0; const int nblk = J.ncols / 32; const int kb = r / nblk, nb = r % nblk;
        const int n0 = nb * 32; int drow0 = n0;
        if (J.mode != 0) drow0 = (n0 >> 7) * 256 + (n0 & 127) + (J.mode == 2 ? 128 : 0);
        const float* gp = J.gain_idx >= 0 ? in[J.gain_idx] + J.gain_off : nullptr;
        if (J.fp8) transpose_item_fp8(in[J.in_idx] + J.src_off, J.ldw, J.K, kb * 64, n0, ws + J.dst, drow0, scr, lane, gp);
        else transpose_item(in[J.in_idx] + J.src_off, J.ldw, J.K, kb * 64, n0, (bf16_t*)(ws + J.dst), drow0, scr, lane, gp);
    }
}
DEVI void ph_cvt_rows(const float* src, bf16_t* dst, size_t n4, int vb0, int vbs) {
    for (size_t e = (size_t)vb0 * NTHR + opq((int)threadIdx.x); e < n4; e += (size_t)vbs * NTHR) {
        const float4 v = ((const float4*)src)[e]; u32x2 o; o.x = pk2(v.x, v.y); o.y = pk2(v.z, v.w); ((u32x2*)dst)[e] = o; }
}

namespace pg8 {
constexpr int BM = 256, BK = 64, HALF = 128, HTB = HALF * BK * 2, STAGE_BYTES = 8 * HTB, NXCD = 8, WGM = 8;
__host__ __device__ __forceinline__ int lds_byte(int r, int c) { const int st = (r >> 4) * 2 + (c >> 5), rr = r & 15, cc = c & 31, ob = rr * 64 + cc * 2; return st * 1024 + (ob ^ (((ob >> 9) & 1) << 5)); }
__host__ __device__ __forceinline__ void stage_rc(int b, int& R, int& C) { const int st = b / 1024, sb = b % 1024, swz = sb ^ (((sb >> 9) & 1) << 5); R = (st >> 1) * 16 + swz / 64; C = (st & 1) * 32 + (swz % 64) / 2; }
__host__ __device__ __forceinline__ int perm32(int rho) { const int n = rho >> 4, i = rho & 15; return 8 * (i >> 2) + 4 * n + (i & 3); }
struct Unit { int pm, pn; int row0; int arow0; int mvalid; int e; int mbase; int akoff; const char* B; };
DEVI void xcd_tile(int L, int nwg, int nM, int nN, int& pm, int& pn) {
    int wgid = L; { const int q = nwg / NXCD, r = nwg % NXCD, xcd = wgid % NXCD, off = wgid / NXCD; wgid = (xcd < r ? xcd * (q + 1) : r * (q + 1) + (xcd - r) * q) + off; }
    const int nig = WGM * nN, gid = wgid / nig, fm = gid * WGM, gsz = (nM - fm) < WGM ? (nM - fm) : WGM;
    pm = fm + ((wgid % nig) % gsz); pn = (wgid % nig) / gsz;
}
struct DenseOrder {
    int nM, nN, nwg, G, c; const char* Bt; size_t tstepB;
    DEVI void init(int M, int N, int K, const bf16_t* Bt_, int G_, int c_) { nM = M / BM; nN = N / BM; nwg = nM * nN; G = G_; c = c_; Bt = (const char*)Bt_; tstepB = (size_t)BM * K * 2; }
    DEVI bool next(int i, Unit& u) const { const long L = (long)i * G + c; if (L >= nwg) return false; xcd_tile((int)L, nwg, nM, nN, u.pm, u.pn); u.row0 = u.pm * BM; u.arow0 = u.row0; u.mvalid = BM; u.e = 0; u.mbase = 0; u.akoff = 0; u.B = Bt + (size_t)u.pn * tstepB; return true; }
};
struct TailOrder {
    int nM, nN, nwg, nb, r; const char* Bt; size_t tstepB;
    DEVI void init(int M, int N, int K, const bf16_t* Bt_, int G_, int c_, int first) { nM = M / BM; nN = N / BM; nwg = nM * nN; Bt = (const char*)Bt_; tstepB = (size_t)BM * K * 2;
        if (first >= G_) first = 0; nb = G_ - first; r = c_ - first; }
    DEVI bool next(int i, Unit& u) const { if (r < 0) return false; const long L = (long)i * nb + r; if (L >= nwg) return false; u.pm = (int)L / nN; u.pn = (int)L % nN; u.row0 = u.pm * BM; u.arow0 = u.row0; u.mvalid = BM; u.e = 0; u.mbase = 0; u.akoff = 0; u.B = Bt + (size_t)u.pn * tstepB; return true; }
};
struct MoeOrder {
    int nM, nN, nwg, G, c; const char* Bt; size_t estepB, tstepB; const volatile LAS int* tab; bool per_expert;
    DEVI void init(const unsigned* cnt, volatile LAS int* tab_, int N, int K, const bf16_t* Bt_, size_t estep_bytes, bool per_expert_, int G_, int c_) {
        __syncthreads();
        if (threadIdx.x < 8) tab_[16 + threadIdx.x] = (int)__hip_atomic_load(cnt + threadIdx.x * 64, __ATOMIC_RELAXED, __HIP_MEMORY_SCOPE_AGENT);
        __syncthreads();
        if (threadIdx.x == 0) { int t = 0;
            for (int e = 0; e < 8; ++e) { const int n = tab_[16 + e]; tab_[e] = t; t += (n + BM - 1) / BM; }
            tab_[8] = t; }
        __syncthreads();
        tab = tab_; nM = __builtin_amdgcn_readfirstlane(tab_[8]); nN = N / BM; nwg = nM * nN; G = G_; c = c_; Bt = (const char*)Bt_; estepB = estep_bytes; tstepB = (size_t)BM * K * 2; per_expert = per_expert_; nmain = nwg; split_phase = false; khalfB = 0;
    }
    int nmain; bool split_phase; int khalfB;
    DEVI void set_split(bool ksplit, bool phase2, int khalf_bytes) { const int r = nwg % G; const bool can = ksplit && r > 0 && 2 * r <= G; nmain = can ? nwg - r : nwg; split_phase = phase2; khalfB = khalf_bytes; }
    DEVI int tail_first() const { return nmain == nwg ? nwg % G : 2 * (nwg - nmain); }
    DEVI bool next(int i, Unit& u) const {
        long L; int kh = 0;
        if (!split_phase) { L = (long)i * G + c; if (L >= nmain) return false; }
        else { if (i > 0 || c >= 2 * (nwg - nmain)) return false; L = nmain + (c >> 1); kh = c & 1; }
        xcd_tile((int)L, nwg, nM, nN, u.pm, u.pn);
        int e = 0;
        for (int k = 1; k < 8; ++k) if (u.pm >= __builtin_amdgcn_readfirstlane(tab[k])) e = k;
        const int t0 = __builtin_amdgcn_readfirstlane(tab[e]), n = __builtin_amdgcn_readfirstlane(tab[16 + e]);
        u.e = e; u.row0 = u.pm * BM; const int m0 = (u.pm - t0) * BM; u.mbase = m0; u.arow0 = per_expert ? e * MT + m0 : u.row0; u.mvalid = (n - m0) < BM ? (n - m0) : BM;
        u.akoff = kh * khalfB; u.B = Bt + (size_t)e * estepB + (size_t)u.pn * tstepB + u.akoff; return true; }
};
DEVI unsigned cvt_pk_bf16(float lo, float hi) { return cvt2bf(lo, hi); }

constexpr int EPI_OFF = MISC_OFF + 1024, EPI_SLICE = 1024;
static_assert(EPI_OFF + 8 * EPI_SLICE <= LDS_BYTES, "epilogue scalar slices");
DEVI void epi_dma(const void* g, LAS unsigned char* dst) { __builtin_amdgcn_global_load_lds((const unsigned*)g, (LAS unsigned*)dst, 4, 0, 0); }
struct EpiBf16 { static constexpr bool PERM = true; bf16_t* O; int ldc; const float* rs;
    DEVI void pre(LAS unsigned char* esl, const Unit& u, int wr, int lane) const {
        if (rs) { epi_dma(rs + u.row0 + wr * 64 + lane, esl); epi_dma(rs + u.row0 + wr * 64 + HALF + lane, esl + 256); } }
    DEVI void operator()(const f32x4 (&acc)[2][2][4][2], const Unit& u, int wr, int wc, int fr, int fq, const LAS unsigned char* esl) const {
        float pv[8];
#pragma unroll
        for (int q = 0; q < 8; ++q) pv[q] = ((const LAS float*)esl)[(q >> 2) * 64 + (q & 3) * 16 + fr];
        const int row0 = u.row0 + wr * 64 + fr, col0 = u.pn * BM + wc * 32 + 8 * fq;
#pragma unroll
        for (int ai = 0; ai < 2; ++ai)
#pragma unroll
            for (int m = 0; m < 4; ++m) { const int row = row0 + ai * HALF + m * 16; bf16_t* rowp = O + (size_t)row * ldc + col0;
                const float sc = rs ? pv[ai * 4 + m] : 1.f;
#pragma unroll
                for (int bj = 0; bj < 2; ++bj) { const f32x4 v0 = acc[ai][bj][m][0] * sc, v1 = acc[ai][bj][m][1] * sc;
                    u32x4 w; w.x = cvt_pk_bf16(v0[0], v0[1]); w.y = cvt_pk_bf16(v0[2], v0[3]); w.z = cvt_pk_bf16(v1[0], v1[1]); w.w = cvt_pk_bf16(v1[2], v1[3]);
                    *(u32x4*)(rowp + bj * HALF) = w; } }
    } };
struct EpiPleGate { static constexpr bool PERM = true; bf16_t* T; int ldc; const float* rs;
    DEVI void pre(LAS unsigned char* esl, const Unit& u, int wr, int lane) const {
        epi_dma(rs + u.row0 + wr * 64 + lane, esl); epi_dma(rs + u.row0 + wr * 64 + HALF + lane, esl + 256); }
    DEVI void operator()(const f32x4 (&acc)[2][2][4][2], const Unit& u, int wr, int wc, int fr, int fq, const LAS unsigned char* esl) const {
        float pv[8];
#pragma unroll
        for (int q = 0; q < 8; ++q) pv[q] = ((const LAS float*)esl)[(q >> 2) * 64 + (q & 3) * 16 + fr];
        const int row0 = u.row0 + wr * 64 + fr, col0 = u.pn * BM + wc * 32 + 8 * fq;
#pragma unroll
        for (int ai = 0; ai < 2; ++ai)
#pragma unroll
            for (int m = 0; m < 4; ++m) { const int row = row0 + ai * HALF + m * 16; bf16_t* rowp = T + (size_t)row * ldc + col0;
                const float sc = pv[ai * 4 + m];
#pragma unroll
                for (int bj = 0; bj < 2; ++bj) { const f32x4 v0 = acc[ai][bj][m][0] * sc, v1 = acc[ai][bj][m][1] * sc;
                    const u32x4 pp = *(const u32x4*)(rowp + bj * HALF);
                    u32x4 w; w.x = cvt_pk_bf16(sigmoid_f(v0[0]) * bflo(pp.x), sigmoid_f(v0[1]) * bfhi(pp.x)); w.y = cvt_pk_bf16(sigmoid_f(v0[2]) * bflo(pp.y), sigmoid_f(v0[3]) * bfhi(pp.y));
                    w.z = cvt_pk_bf16(sigmoid_f(v1[0]) * bflo(pp.z), sigmoid_f(v1[1]) * bfhi(pp.z)); w.w = cvt_pk_bf16(sigmoid_f(v1[2]) * bflo(pp.w), sigmoid_f(v1[3]) * bfhi(pp.w));
                    *(u32x4*)(rowp + bj * HALF) = w; } }
    } };
DEVI f32x4 swiglu4(const f32x4 ag, const f32x4 au, const float tneg, const float k2) {
    const f32x4 t = ag * tneg; f32x4 d;
    d[0] = __builtin_amdgcn_exp2f(t[0]); d[1] = __builtin_amdgcn_exp2f(t[1]); d[2] = __builtin_amdgcn_exp2f(t[2]); d[3] = __builtin_amdgcn_exp2f(t[3]);
    d = d + 1.0f; f32x4 rc;
    rc[0] = __builtin_amdgcn_rcpf(d[0]); rc[1] = __builtin_amdgcn_rcpf(d[1]); rc[2] = __builtin_amdgcn_rcpf(d[2]); rc[3] = __builtin_amdgcn_rcpf(d[3]);
    return (ag * au) * (rc * k2);
}
struct EpiSwiglu { static constexpr bool PERM = true; bf16_t* O; int ldc; const float* rs; int grouped;
    DEVI void pre(LAS unsigned char* esl, const Unit& u, int wr, int lane) const {
        const float* rsb = grouped ? rs + u.e * MT + u.mbase : rs + u.row0; const int vm1 = (grouped ? u.mvalid : BM) - 1;
#pragma unroll
        for (int i = 0; i < 2; ++i) { const int rl = wr * 64 + lane + i * HALF; epi_dma(rsb + (rl <= vm1 ? rl : vm1), esl + i * 256); } }
    DEVI void operator()(const f32x4 (&acc)[2][2][4][2], const Unit& u, int wr, int wc, int fr, int fq, const LAS unsigned char* esl) const {
        float pv[8];
#pragma unroll
        for (int q = 0; q < 8; ++q) pv[q] = ((const LAS float*)esl)[(q >> 2) * 64 + (q & 3) * 16 + fr];
        const int row0 = u.row0 + wr * 64 + fr, col0 = u.pn * HALF + wc * 32 + 8 * fq; const int vm1e = (grouped ? u.mvalid : BM) - 1;
#pragma unroll
        for (int ai = 0; ai < 2; ++ai)
#pragma unroll
            for (int m = 0; m < 4; ++m) { const int rl = wr * 64 + fr + ai * HALF + m * 16; bf16_t* rowp = O + (size_t)(u.row0 + rl) * ldc + col0;
                const float sc = rl <= vm1e ? pv[ai * 4 + m] : 0.f;
                const f32x4 o0 = swiglu4(acc[ai][0][m][0], acc[ai][1][m][0], sc * -1.44269504f, sc * sc), o1 = swiglu4(acc[ai][0][m][1], acc[ai][1][m][1], sc * -1.44269504f, sc * sc);
                u32x4 w; w.x = cvt_pk_bf16(o0[0], o0[1]); w.y = cvt_pk_bf16(o0[2], o0[3]); w.z = cvt_pk_bf16(o1[0], o1[1]); w.w = cvt_pk_bf16(o1[2], o1[3]);
                *(u32x4*)rowp = w; }
    } };
constexpr float W8_SCALE = 64.f, ACT8_SCALE = 8.f;
struct EpiSwiglu8 { static constexpr bool PERM = true; unsigned char* O; int ldc; const float* rs;
    DEVI void pre(LAS unsigned char* esl, const Unit& u, int wr, int lane) const {
        const float* rsb = rs + u.e * MT + u.mbase; const int vm1 = u.mvalid - 1;
#pragma unroll
        for (int i = 0; i < 2; ++i) { const int rl = wr * 64 + lane + i * HALF; epi_dma(rsb + (rl <= vm1 ? rl : vm1), esl + i * 256); } }
    DEVI void operator()(const f32x4 (&acc)[2][2][4][2], const Unit& u, int wr, int wc, int fr, int fq, const LAS unsigned char* esl) const {
        float pv[8];
#pragma unroll
        for (int q = 0; q < 8; ++q) pv[q] = ((const LAS float*)esl)[(q >> 2) * 64 + (q & 3) * 16 + fr];
        const int col0 = u.pn * HALF + wc * 32 + 8 * fq;
#pragma unroll
        for (int ai = 0; ai < 2; ++ai)
#pragma unroll
            for (int m = 0; m < 4; ++m) { const int rl = wr * 64 + fr + ai * HALF + m * 16; unsigned char* rowp = O + (size_t)(u.row0 + rl) * ldc + col0;
                const float sc = rl < u.mvalid ? pv[ai * 4 + m] * (1.f / W8_SCALE) : 0.f;
                const f32x4 o0 = swiglu4(acc[ai][0][m][0], acc[ai][1][m][0], sc * -1.44269504f, sc * sc * ACT8_SCALE), o1 = swiglu4(acc[ai][0][m][1], acc[ai][1][m][1], sc * -1.44269504f, sc * sc * ACT8_SCALE);
                u32x2 w; w.x = pg8_pk4(o0[0], o0[1], o0[2], o0[3]); w.y = pg8_pk4(o1[0], o1[1], o1[2], o1[3]);
                *(u32x2*)rowp = w; }
    } };
struct EpiMoeDown { static constexpr bool PERM = true; bf16_t* Y; const int* list; const float* gatev; float oscale; size_t y2off; unsigned char* flag;
    DEVI void pre(LAS unsigned char* esl, const Unit& u, int wr, int lane) const {
        const int* lb = list + u.e * MT + u.mbase; const float* gb = gatev + u.e * MT + u.mbase; const int vm1 = u.mvalid - 1;
#pragma unroll
        for (int i = 0; i < 2; ++i) { const int rl = wr * 64 + lane + i * HALF; const int ri = rl <= vm1 ? rl : vm1; epi_dma(gb + ri, esl + i * 256); epi_dma(lb + ri, esl + 512 + i * 256); } }
    DEVI void operator()(const f32x4 (&acc)[2][2][4][2], const Unit& u, int wr, int wc, int fr, int fq, const LAS unsigned char* esl) const {
        float pv[8]; int pt[8];
#pragma unroll
        for (int q = 0; q < 8; ++q) { pv[q] = ((const LAS float*)esl)[(q >> 2) * 64 + (q & 3) * 16 + fr]; pt[q] = ((const LAS int*)(esl + 512))[(q >> 2) * 64 + (q & 3) * 16 + fr]; }
        const int col0 = u.pn * BM + wc * 32 + 8 * fq;
        const bool second = u.akoff != 0; bf16_t* const Yb = Y + (second ? y2off : (size_t)0);
#pragma unroll
        for (int ai = 0; ai < 2; ++ai)
#pragma unroll
            for (int m = 0; m < 4; ++m) { const int rl = wr * 64 + fr + ai * HALF + m * 16;
                const int tsl = pt[ai * 4 + m]; const float gt = pv[ai * 4 + m] * oscale;
                if (rl < u.mvalid) {
                    bf16_t* rowp = Yb + (size_t)(tsl & 1) * ((size_t)MT * DM) + (size_t)(tsl >> 1) * DM + col0;
                    if (second && wc == 0 && fq == 0) flag[tsl * 4 + u.pn] = 1;
#pragma unroll
                    for (int bj = 0; bj < 2; ++bj) { const f32x4 v0 = acc[ai][bj][m][0], v1 = acc[ai][bj][m][1];
                        u32x4 w; w.x = cvt_pk_bf16(v0[0] * gt, v0[1] * gt); w.y = cvt_pk_bf16(v0[2] * gt, v0[3] * gt); w.z = cvt_pk_bf16(v1[0] * gt, v1[1] * gt); w.w = cvt_pk_bf16(v1[2] * gt, v1[3] * gt);
                        *(u32x4*)(rowp + bj * HALF) = w; } } }
    } };

typedef int v8i __attribute__((ext_vector_type(8)));
typedef int v4i __attribute__((ext_vector_type(4)));
DEVI v8i cat8(const bf16x8 lo, const bf16x8 hi) { const v4i a = __builtin_bit_cast(v4i, lo), b = __builtin_bit_cast(v4i, hi); return __builtin_shufflevector(a, b, 0, 1, 2, 3, 4, 5, 6, 7); }
struct Frag16 { bf16x8 k[2]; };
struct Frag8 { v8i v; };
template <bool F> struct FragSel { typedef Frag16 T; };
template <> struct FragSel<true> { typedef Frag8 T; };
template <class Epi, class Sched, bool FP8 = false>
DEVI void gemm_phase(LAS unsigned char* lds, const bf16_t* A, const int K, const Sched& S, const Epi& E, const int Kloop = 0) {
    const int tid = opq((int)threadIdx.x), wid = __builtin_amdgcn_readfirstlane(tid >> 6), lane = tid & 63, wr = wid >> 2, wc = wid & 3, fr = lane & 15, fq = lane >> 4;
    const int nt = (Kloop ? Kloop : K) / BK;
    unsigned voffA[2], voffB[2];
#pragma unroll
    for (int i = 0; i < 2; ++i) { int R, C; stage_rc(tid * 16 + i * 8192, R, C); const int Rb = Epi::PERM ? ((R & ~31) + perm32(R & 31)) : R;
        voffA[i] = (unsigned)(R * K + C) * 2u; voffB[i] = (unsigned)(Rb * K + C) * 2u; }
    const size_t kstep = (size_t)(BK * 2);
    const size_t hstep = (size_t)HALF * K * 2;
    const size_t rstep = (size_t)K * 2;
    const unsigned ldsw = (unsigned)wid * 1024u;
    const int aoff = lds_byte(wr * 64 + fr, fq * 8), boff = lds_byte(wc * 32 + fr, fq * 8);
#define PG8_SA(b, h) (((b) * 2 + (h)) * HTB)
#define PG8_SB(b, h) ((4 + (b) * 2 + (h)) * HTB)
#define PG8_STAGE(bufoff, gbase, voff) do { _Pragma("unroll") for (int _i = 0; _i < 2; ++_i) \
        __builtin_amdgcn_global_load_lds((const unsigned*)((const char*)(gbase) + (voff)[_i]), (LAS unsigned*)(lds + (bufoff) + ldsw + _i * 8192), 16, 0, 0); } while (0)
#define PG8_LDA(dst, b, h) do { _Pragma("unroll") for (int m = 0; m < 4; ++m) { if constexpr (FP8) dst[m].v = cat8(*(const LAS bf16x8*)(lds + PG8_SA(b, h) + aoff + m * 2048), *(const LAS bf16x8*)(lds + PG8_SA(b, h) + aoff + m * 2048 + 1024)); \
        else { _Pragma("unroll") for (int k = 0; k < 2; ++k) dst[m].k[k] = *(const LAS bf16x8*)(lds + PG8_SA(b, h) + aoff + m * 2048 + k * 1024); } } } while (0)
#define PG8_LDB(dst, b, h) do { _Pragma("unroll") for (int n = 0; n < 2; ++n) { if constexpr (FP8) dst[n].v = cat8(*(const LAS bf16x8*)(lds + PG8_SB(b, h) + boff + n * 2048), *(const LAS bf16x8*)(lds + PG8_SB(b, h) + boff + n * 2048 + 1024)); \
        else { _Pragma("unroll") for (int k = 0; k < 2; ++k) dst[n].k[k] = *(const LAS bf16x8*)(lds + PG8_SB(b, h) + boff + n * 2048 + k * 1024); } } } while (0)
#define PG8_MMA(ai, bj, At, Bt) do { __builtin_amdgcn_s_setprio(1); _Pragma("unroll") for (int m = 0; m < 4; ++m) _Pragma("unroll") for (int n = 0; n < 2; ++n) { \
        if constexpr (FP8) asm volatile("s_nop 1\n\tv_mfma_scale_f32_16x16x128_f8f6f4 %0, %1, %2, %0, %3, %3 op_sel_hi:[0,0,0]" : "+v"(acc[ai][bj][m][n]) : "v"(Bt[n].v), "v"(At[m].v), "v"(sc1)); \
        else { _Pragma("unroll") for (int k = 0; k < 2; ++k) acc[ai][bj][m][n] = __builtin_amdgcn_mfma_f32_16x16x32_bf16(Bt[n].k[k], At[m].k[k], acc[ai][bj][m][n], 0, 0, 0); } } \
        __builtin_amdgcn_s_setprio(0); } while (0)
#define PG8_WAIT_V(n) asm volatile("s_waitcnt vmcnt(" #n ")" ::: "memory")
#define PG8_WAIT_L(n) asm volatile("s_waitcnt lgkmcnt(" #n ")" ::: "memory")
#define PG8_BAR __builtin_amdgcn_s_barrier()
#define PG8_SCHED __builtin_amdgcn_sched_barrier(0)
    Unit cur, nxt; int ui = 0;
    if (!S.next(0, cur)) return;
    int sc1 = 0x7F7F7F7F; asm volatile("" : "+v"(sc1));
    f32x4 acc[2][2][4][2];
#pragma unroll
    for (int a = 0; a < 2; ++a)
#pragma unroll
        for (int b = 0; b < 2; ++b)
#pragma unroll
            for (int m = 0; m < 4; ++m)
#pragma unroll
                for (int n = 0; n < 2; ++n) acc[a][b][m][n] = (f32x4){0.f, 0.f, 0.f, 0.f};
    typename FragSel<FP8>::T At[4], B0[2], B1[2];
    const char* cA = (const char*)A + (size_t)cur.arow0 * rstep + cur.akoff;
    const char* cB = cur.B;
    LAS unsigned char* const esl = lds + EPI_OFF + wid * EPI_SLICE;
    E.pre(esl, cur, wr, lane);
    PG8_STAGE(PG8_SB(0, 0), cB, voffB); PG8_STAGE(PG8_SA(0, 0), cA, voffA); PG8_STAGE(PG8_SB(0, 1), cB + hstep, voffB); PG8_STAGE(PG8_SA(0, 1), cA + hstep, voffA);
    if (wr == 1) PG8_BAR;
    PG8_WAIT_V(4); PG8_BAR;
    PG8_STAGE(PG8_SB(1, 0), cB + kstep, voffB); PG8_STAGE(PG8_SA(1, 0), cA + kstep, voffA); PG8_STAGE(PG8_SB(1, 1), cB + hstep + kstep, voffB);
    PG8_WAIT_V(6); PG8_BAR;
    for (;;) {
        const bool has_next = S.next(ui + 1, nxt);
        const char* nA = has_next ? (const char*)A + (size_t)nxt.arow0 * rstep + nxt.akoff : cA; const char* nB = has_next ? nxt.B : cB;
#pragma unroll 1
        for (int t = 0; t < nt; t += 2) {
            const bool last = (t == nt - 2);
            const char* a1 = cA + (size_t)(t + 1) * kstep;
            const char* a2 = last ? nA : cA + (size_t)(t + 2) * kstep; const char* b2 = last ? nB : cB + (size_t)(t + 2) * kstep;
            const char* a3 = a2 + kstep; const char* b3 = b2 + kstep;
            PG8_LDB(B0, 0, 0); PG8_SCHED; PG8_LDA(At, 0, 0); PG8_STAGE(PG8_SA(1, 1), a1 + hstep, voffA);
            PG8_WAIT_L(8); PG8_BAR; PG8_WAIT_L(0); PG8_MMA(0, 0, At, B0); PG8_BAR; PG8_SCHED;
            PG8_LDB(B1, 0, 1); PG8_STAGE(PG8_SB(0, 0), b2, voffB);
            PG8_BAR; PG8_WAIT_L(0); PG8_MMA(0, 1, At, B1); PG8_BAR;
            PG8_LDA(At, 0, 1); PG8_STAGE(PG8_SA(0, 0), a2, voffA);
            PG8_BAR; PG8_WAIT_L(0); PG8_MMA(1, 0, At, B0); PG8_BAR; PG8_SCHED;
            PG8_STAGE(PG8_SB(0, 1), b2 + hstep, voffB);
            PG8_WAIT_V(6); PG8_BAR; PG8_MMA(1, 1, At, B1); PG8_BAR;
            PG8_LDB(B0, 1, 0); PG8_SCHED; PG8_LDA(At, 1, 0); PG8_STAGE(PG8_SA(0, 1), a2 + hstep, voffA);
            PG8_WAIT_L(8); PG8_BAR; PG8_WAIT_L(0); PG8_MMA(0, 0, At, B0); PG8_BAR; PG8_SCHED;
            PG8_LDB(B1, 1, 1); PG8_STAGE(PG8_SB(1, 0), b3, voffB);
            PG8_BAR; PG8_WAIT_L(0); PG8_MMA(0, 1, At, B1); PG8_BAR;
            PG8_LDA(At, 1, 1); PG8_STAGE(PG8_SA(1, 0), a3, voffA);
            PG8_BAR; PG8_WAIT_L(0); PG8_MMA(1, 0, At, B0); PG8_BAR; PG8_SCHED;
            PG8_STAGE(PG8_SB(1, 1), b3 + hstep, voffB);
            PG8_WAIT_V(6); PG8_BAR; PG8_MMA(1, 1, At, B1); PG8_BAR;
        }
        if constexpr (FP8) asm volatile("s_nop 15\n\ts_nop 15" ::: "memory");
        E(acc, cur, wr, wc, fr, fq, esl);
        if (!has_next) break;
#pragma unroll
        for (int a = 0; a < 2; ++a)
#pragma unroll
            for (int b = 0; b < 2; ++b)
#pragma unroll
                for (int m = 0; m < 4; ++m)
#pragma unroll
                    for (int n = 0; n < 2; ++n) acc[a][b][m][n] = (f32x4){0.f, 0.f, 0.f, 0.f};
        cur = nxt; cA = nA; cB = nB; ++ui;
        E.pre(esl, cur, wr, lane);
        if constexpr (FP8) asm volatile("s_nop 7" ::: "memory");
    }
    PG8_WAIT_V(0);
    if (wr == 0) PG8_BAR;
    PG8_BAR;
#undef PG8_SA
#undef PG8_SB
#undef PG8_STAGE
#undef PG8_LDA
#undef PG8_LDB
#undef PG8_MMA
#undef PG8_WAIT_V
#undef PG8_WAIT_L
#undef PG8_BAR
#undef PG8_SCHED
}
}

DEVI float lb_of(const float* lbraw, int ch) {
    const float r0 = lbraw[ch], r1 = lbraw[512 + ch], r2 = lbraw[1024 + ch];
    const float mx = fmaxf(r0, fmaxf(r1, r2));
    const float e0 = __expf(r0 - mx), e1 = __expf(r1 - mx), e2 = __expf(r2 - mx);
    return e0 / (e0 + e1 + e2);
}
constexpr int HQ = 0, HK = 17408, HKH = 34816, HV = 53248, HDV = 71680, HZERO = 73728, HOT = 75776, H_END = HOT + 64 * 528;
static_assert(H_END <= 131072, "hgrn lds");
constexpr size_t HS_SCAN = (size_t)16 * 16384;
struct HgrnRaw { unsigned qf[16]; u32x4 v0, v1; };
DEVI void hgrn_load(HgrnRaw& R, const bf16_t* u, const bf16_t* VT, int dir, int b, int h, int t0, int c, int I, int tid) {
    const bf16_t* up = u + ((size_t)b * SEQ + t0 + 16 * I) * UW + h * 128 + c;
    const int fcol = dir ? 1024 : 512;
#pragma unroll
    for (int j = 0; j < 16; ++j) R.qf[j] = (unsigned)up[(size_t)j * UW] | ((unsigned)up[(size_t)j * UW + fcol] << 16);
    { const int e = tid, r = e >> 3, cch = e & 7; R.v0 = *(const u32x4*)(VT + ((size_t)b * 512 + h * 128 + r) * SEQ + t0 + cch * 8); }
    { const int e = tid + NTHR, r = e >> 3, cch = e & 7; R.v1 = *(const u32x4*)(VT + ((size_t)b * 512 + h * 128 + r) * SEQ + t0 + cch * 8); }
}
DEVI void hgrn_prep(LAS unsigned char* lds, const HgrnRaw& R, float lbv, int dir, int c, int I, int tid) {
    float ff[16], kk[16], qq[16];
    { const int e = tid, r = e >> 3, cch = e & 7; *(LAS u32x4*)(lds + HV + r * 144 + cch * 16) = R.v0; }
    { const int e = tid + NTHR, r = e >> 3, cch = e & 7; *(LAS u32x4*)(lds + HV + r * 144 + cch * 16) = R.v1; }
#pragma unroll
    for (int j = 0; j < 16; ++j) {
        const float fr = bfhi(R.qf[j]), qr = bflo(R.qf[j]);
        const float f = lbv + (1.f - lbv) * sigmoid_f(fr);
        ff[j] = f; kk[j] = 1.f - f; qq[j] = silu_f(qr);
    }
    float run = 1.f;
#pragma unroll
    for (int jj = 0; jj < 16; ++jj) { const int j = dir ? 15 - jj : jj; run = fmaxf(run * ff[j], 1e-30f); ff[j] = run; }
    const float PG = run;
    float kh[16];
#pragma unroll
    for (int j = 0; j < 16; ++j) {
        const float kt = kk[j] * __builtin_amdgcn_rcpf(ff[j]);
        kh[j] = kt * PG;
        *(LAS bf16_t*)(lds + HQ + (16 * I + j) * 272 + c * 2) = f2bf(qq[j] * ff[j]);
        *(LAS bf16_t*)(lds + HK + (16 * I + j) * 272 + c * 2) = f2bf(kt);
    }
    u32x4 w0, w1;
    w0.x = pk2(kh[0], kh[1]); w0.y = pk2(kh[2], kh[3]); w0.z = pk2(kh[4], kh[5]); w0.w = pk2(kh[6], kh[7]);
    w1.x = pk2(kh[8], kh[9]); w1.y = pk2(kh[10], kh[11]); w1.z = pk2(kh[12], kh[13]); w1.w = pk2(kh[14], kh[15]);
    *(LAS u32x4*)(lds + HKH + c * 144 + I * 32) = w0; *(LAS u32x4*)(lds + HKH + c * 144 + I * 32 + 16) = w1;
    *(LAS float*)(lds + HDV + (I * 128 + c) * 4) = PG;
}
DEVI void hgrn_update(LAS unsigned char* lds, f32x4 (&Sacc)[8], int I, int wid, int fr, int fq) {
    const int voff = (fq < 2) ? HV + (16 * wid + fr) * 144 + (16 * I + 8 * fq) * 2 : HZERO;
    const int koff = (fq < 2) ? HKH + fr * 144 + (16 * I + 8 * fq) * 2 : HZERO;
    const int kstep = (fq < 2) ? 16 * 144 : 0;
    const bf16x8 vb = *(const LAS bf16x8*)(lds + voff);
    bf16x8 ka[8]; f32x4 dv[8];
#pragma unroll
    for (int m = 0; m < 8; ++m) { ka[m] = *(const LAS bf16x8*)(lds + koff + m * kstep); dv[m] = *(const LAS f32x4*)(lds + HDV + (I * 128 + 16 * m + 4 * fq) * 4); }
#pragma unroll
    for (int m = 0; m < 8; ++m) Sacc[m] = __builtin_amdgcn_mfma_f32_16x16x32_bf16(ka[m], vb, Sacc[m] * dv[m], 0, 0, 0);
}
DEVI void ph_hgrn_states(LAS unsigned char* lds, const bf16_t* u, const bf16_t* VT, const float* lbraw, bf16_t* HS, float* HD, int vb0, int vbs) {
    const int tid = opq((int)threadIdx.x), wid = __builtin_amdgcn_readfirstlane(tid >> 6), lane = tid & 63, fr = lane & 15, fq = lane >> 4;
    const int pc = tid & 127, pI = tid >> 7;
    for (int unit = vb0; unit < NB * 4 * 2 * 16; unit += vbs) {
        const int seg = unit & 15, dir = (unit >> 4) & 1, h = (unit >> 5) & 3, b = unit >> 7;
        const float lbv = lb_of(lbraw, h * 128 + pc);
        f32x4 Sacc[8];
#pragma unroll
        for (int m = 0; m < 8; ++m) Sacc[m] = (f32x4){0.f, 0.f, 0.f, 0.f};
        float gprod = 1.f;
        if (tid < 4) *(LAS unsigned*)(lds + HZERO + tid * 4) = 0u;
        HgrnRaw R; hgrn_load(R, u, VT, dir, b, h, seg * 256 + (dir ? 3 : 0) * 64, pc, pI, tid);
#pragma unroll 1
        for (int sbi = 0; sbi < 4; ++sbi) {
            const int sb = dir ? 3 - sbi : sbi;
            const int t0 = seg * 256 + sb * 64;
            __syncthreads();
            hgrn_prep(lds, R, lbv, dir, pc, pI, tid);
            if (sbi < 3) { const int sbn = dir ? 3 - (sbi + 1) : sbi + 1; hgrn_load(R, u, VT, dir, b, h, seg * 256 + sbn * 64, pc, pI, tid); }
            __syncthreads();
            if (tid < 128) gprod *= (*(const LAS float*)(lds + HDV + tid * 4) * *(const LAS float*)(lds + HDV + (128 + tid) * 4)) * (*(const LAS float*)(lds + HDV + (256 + tid) * 4) * *(const LAS float*)(lds + HDV + (384 + tid) * 4));
#pragma unroll 1
            for (int ii = 0; ii < 4; ++ii) { const int I = dir ? 3 - ii : ii; hgrn_update(lds, Sacc, I, wid, fr, fq); }
        }
        const size_t scan = (size_t)(b * 4 + h) * 2 + dir;
        bf16_t* dst = HS + scan * HS_SCAN + (size_t)seg * 16384;
#pragma unroll
        for (int m = 0; m < 8; ++m) { u32x2 w; w.x = pk2(Sacc[m][0], Sacc[m][1]); w.y = pk2(Sacc[m][2], Sacc[m][3]);
            *(u32x2*)(dst + (16 * wid + fr) * 128 + 16 * m + 4 * fq) = w; }
        if (tid < 128) HD[(scan * 16 + seg) * 128 + tid] = gprod;
    }
    __syncthreads();
}
DEVI void ph_hgrn_scan(bf16_t* HS, const float* HD, int vb0, int vbs) {
    const int tid = opq((int)threadIdx.x);
    for (int idx = vb0 * NTHR + tid; idx < 32 * 4096; idx += vbs * NTHR) {
        const int scan = idx >> 12, e4 = idx & 4095, k4 = (e4 & 31) * 4; const int dir = scan & 1;
        u32x2* base = (u32x2*)(HS + (size_t)scan * HS_SCAN) + e4;
        const float* hd = HD + (size_t)scan * 16 * 128 + k4;
        u32x2 d[16]; float4 dec[16];
#pragma unroll
        for (int i = 0; i < 16; ++i) { d[i] = base[(size_t)i * 4096]; dec[i] = *(const float4*)(hd + i * 128); }
        float s0 = 0.f, s1 = 0.f, s2 = 0.f, s3 = 0.f;
#define HSCAN_STEP(i) { const float t0 = bflo(d[i].x), t1 = bfhi(d[i].x), t2 = bflo(d[i].y), t3 = bfhi(d[i].y); d[i].x = pk2(s0, s1); d[i].y = pk2(s2, s3); \
            s0 = s0 * dec[i].x + t0; s1 = s1 * dec[i].y + t1; s2 = s2 * dec[i].z + t2; s3 = s3 * dec[i].w + t3; }
        if (dir == 0) {
#pragma unroll
            for (int i = 0; i < 16; ++i) HSCAN_STEP(i)
        } else {
#pragma unroll
            for (int i = 15; i >= 0; --i) HSCAN_STEP(i)
        }
#undef HSCAN_STEP
#pragma unroll
        for (int i = 0; i < 16; ++i) base[(size_t)i * 4096] = d[i];
    }
}
DEVI void ph_hgrn_out(LAS unsigned char* lds, const bf16_t* u, const bf16_t* VT, const float* lbraw, const float* a_norm, const bf16_t* HS, float* OF, bf16_t* ocat, int vb0, int vbs) {
    const int tid = opq((int)threadIdx.x), wid = __builtin_amdgcn_readfirstlane(tid >> 6), lane = tid & 63, fr = lane & 15, fq = lane >> 4;
    const int pc = tid & 127, pI = tid >> 7;
    const int otok = tid >> 3, opart = tid & 7;
    for (int unit = vb0; unit < NB * 4 * 16; unit += vbs) {
        const int seg = unit & 15, h = (unit >> 4) & 3, b = unit >> 6;
        const float lbv = lb_of(lbraw, h * 128 + pc);
        if (tid < 4) *(LAS unsigned*)(lds + HZERO + tid * 4) = 0u;
#pragma unroll 1
        for (int dir = 0; dir < 2; ++dir) {
            const size_t scan = (size_t)(b * 4 + h) * 2 + dir;
            const bf16_t* src = HS + scan * HS_SCAN + (size_t)seg * 16384;
            f32x4 Sacc[8];
#pragma unroll
            for (int m = 0; m < 8; ++m) { const u32x2 w = *(const u32x2*)(src + (16 * wid + fr) * 128 + 16 * m + 4 * fq);
                Sacc[m][0] = bflo(w.x); Sacc[m][1] = bfhi(w.x); Sacc[m][2] = bflo(w.y); Sacc[m][3] = bfhi(w.y); }
            HgrnRaw R; hgrn_load(R, u, VT, dir, b, h, seg * 256 + (dir ? 3 : 0) * 64, pc, pI, tid);
#pragma unroll 1
            for (int sbi = 0; sbi < 4; ++sbi) {
                const int sb = dir ? 3 - sbi : sbi;
                const int t0 = seg * 256 + sb * 64;
                const size_t tokb = (size_t)b * SEQ + t0;
                __syncthreads();
                hgrn_prep(lds, R, lbv, dir, pc, pI, tid);
                if (sbi < 3) { const int sbn = dir ? 3 - (sbi + 1) : sbi + 1; hgrn_load(R, u, VT, dir, b, h, seg * 256 + sbn * 64, pc, pI, tid); }
                __syncthreads();
#pragma unroll 1
                for (int ii = 0; ii < 4; ++ii) {
                    const int I = dir ? 3 - ii : ii;
                    f32x4 oT = {0.f, 0.f, 0.f, 0.f};
                    const LAS unsigned char* qrow = lds + HQ + (16 * I + fr) * 272;
#pragma unroll
                    for (int ks = 0; ks < 4; ++ks) {
                        u32x4 sa; sa.x = pg8::cvt_pk_bf16(Sacc[2 * ks][0], Sacc[2 * ks][1]); sa.y = pg8::cvt_pk_bf16(Sacc[2 * ks][2], Sacc[2 * ks][3]);
                        sa.z = pg8::cvt_pk_bf16(Sacc[2 * ks + 1][0], Sacc[2 * ks + 1][1]); sa.w = pg8::cvt_pk_bf16(Sacc[2 * ks + 1][2], Sacc[2 * ks + 1][3]);
                        const u32x2 q0 = *(const LAS u32x2*)(qrow + (32 * ks + 4 * fq) * 2), q1 = *(const LAS u32x2*)(qrow + (32 * ks + 16 + 4 * fq) * 2);
                        u32x4 qb; qb.x = q0.x; qb.y = q0.y; qb.z = q1.x; qb.w = q1.y;
                        oT = __builtin_amdgcn_mfma_f32_16x16x32_bf16(__builtin_bit_cast(bf16x8, sa), __builtin_bit_cast(bf16x8, qb), oT, 0, 0, 0);
                    }
                    f32x4 sT = {0.f, 0.f, 0.f, 0.f};
                    const LAS unsigned char* krow = lds + HK + (16 * I + fr) * 272;
#pragma unroll
                    for (int ks = 0; ks < 4; ++ks) {
                        const bf16x8 ka = *(const LAS bf16x8*)(krow + (32 * ks + 8 * fq) * 2), qb = *(const LAS bf16x8*)(qrow + (32 * ks + 8 * fq) * 2);
                        sT = __builtin_amdgcn_mfma_f32_16x16x32_bf16(ka, qb, sT, 0, 0, 0);
                    }
                    float pv[4];
#pragma unroll
                    for (int rg = 0; rg < 4; ++rg) { const int sl = 4 * fq + rg; const bool ok = dir ? (sl >= fr) : (sl <= fr); pv[rg] = ok ? sT[rg] : 0.f; }
                    u32x4 pb; pb.x = pg8::cvt_pk_bf16(pv[0], pv[1]); pb.y = pg8::cvt_pk_bf16(pv[2], pv[3]); pb.z = 0u; pb.w = 0u;
                    const u32x2 v0 = *(const LAS u32x2*)(lds + HV + (16 * wid + fr) * 144 + (16 * I + 4 * fq) * 2);
                    u32x4 va; va.x = v0.x; va.y = v0.y; va.z = 0u; va.w = 0u;
                    oT = __builtin_amdgcn_mfma_f32_16x16x32_bf16(__builtin_bit_cast(bf16x8, va), __builtin_bit_cast(bf16x8, pb), oT, 0, 0, 0);
                    if (dir == 0) *(f32x4*)(OF + (tokb + 16 * I + fr) * 512 + h * 128 + 16 * wid + 4 * fq) = oT;
                    else *(LAS f32x4*)(lds + HOT + (16 * I + fr) * 528 + (16 * wid + 4 * fq) * 4) = oT;
                    hgrn_update(lds, Sacc, I, wid, fr, fq);
                }
                if (dir == 1) {
                    __syncthreads();
                    const LAS float* orow = (const LAS float*)(lds + HOT + otok * 528) + opart * 16;
                    float* ofp = OF + (tokb + otok) * 512 + h * 128 + opart * 16;
                    float v[16]; float ss = 0.f;
#pragma unroll
                    for (int q2 = 0; q2 < 8; ++q2) { const unsigned long long w = __hip_atomic_load((unsigned long long*)(ofp + q2 * 2), __ATOMIC_RELAXED, __HIP_MEMORY_SCOPE_AGENT);
                        v[2 * q2] = __uint_as_float((unsigned)w) + orow[2 * q2]; v[2 * q2 + 1] = __uint_as_float((unsigned)(w >> 32)) + orow[2 * q2 + 1];
                        ss += v[2 * q2] * v[2 * q2] + v[2 * q2 + 1] * v[2 * q2 + 1]; }
                    ss += __shfl_xor(ss, 1); ss += __shfl_xor(ss, 2); ss += __shfl_xor(ss, 4);
                    const float rn = rsqrtf(ss * (1.f / 128.f) + EPS);
                    const bf16_t* gp = u + (tokb + otok) * UW + 2048 + h * 128 + opart * 16;
                    const u32x4 g0 = *(const u32x4*)gp, g1 = *(const u32x4*)(gp + 8);
                    const unsigned gw[8] = {g0.x, g0.y, g0.z, g0.w, g1.x, g1.y, g1.z, g1.w};
                    unsigned ow[8];
#pragma unroll
                    for (int q2 = 0; q2 < 8; ++q2) { const float an0 = a_norm[opart * 16 + 2 * q2], an1 = a_norm[opart * 16 + 2 * q2 + 1];
                        ow[q2] = pk2(v[2 * q2] * rn * an0 * silu_f(bflo(gw[q2])), v[2 * q2 + 1] * rn * an1 * silu_f(bfhi(gw[q2]))); }
                    bf16_t* op = ocat + (tokb + otok) * DM + h * 128 + opart * 16;
                    u32x4 o0, o1; o0.x = ow[0]; o0.y = ow[1]; o0.z = ow[2]; o0.w = ow[3]; o1.x = ow[4]; o1.y = ow[5]; o1.z = ow[6]; o1.w = ow[7];
                    *(u32x4*)op = o0; *(u32x4*)(op + 8) = o1;
                }
            }
            asm volatile("s_waitcnt vmcnt(0)" ::: "memory");
        }
    }
    __syncthreads();
}

DEVI void ph_prep(const bf16_t* u, const float* cw, const float* cb, bf16_t* xconv, bf16_t* XT, bf16_t* VT, int vb0, int vbs) {
    const int tid = opq((int)threadIdx.x);
    for (int unit = vb0; unit < NB * 32 * 3; unit += vbs) {
        const int cg = unit % 3, tb = (unit / 3) & 31, b = unit / 96;
        const int t0 = tb * 128;
        if (cg < 2) {
            const int ch = cg * 512 + tid;
            float w[5];
#pragma unroll
            for (int j = 0; j < 5; ++j) w[j] = cw[j * 1024 + ch];
            const float bias = cb[ch];
            const bf16_t* up = u + (size_t)b * SEQ * UW + 3072 + ch;
            float v0, v1, v2, v3;
            v0 = (t0 - 2 >= 0) ? bf2f(up[(size_t)(t0 - 2) * UW]) : 0.f;
            v1 = (t0 - 1 >= 0) ? bf2f(up[(size_t)(t0 - 1) * UW]) : 0.f;
            v2 = bf2f(up[(size_t)t0 * UW]);
            v3 = bf2f(up[(size_t)(t0 + 1) * UW]);
            for (int t8 = 0; t8 < 128; t8 += 32) {
                float nx[32];
#pragma unroll
                for (int i = 0; i < 32; ++i) { const int tt = t0 + t8 + i + 2; nx[i] = (tt < SEQ) ? bf2f(up[(size_t)tt * UW]) : 0.f; }
                unsigned pk[16];
#pragma unroll
                for (int i = 0; i < 32; ++i) {
                    const float o = silu_f(bias + w[0] * v0 + w[1] * v1 + w[2] * v2 + w[3] * v3 + w[4] * nx[i]);
                    const bf16_t ob = f2bf(o);
                    xconv[(size_t)(b * SEQ + t0 + t8 + i) * 1024 + ch] = ob;
                    if (i & 1) pk[i >> 1] |= ((unsigned)ob << 16); else pk[i >> 1] = ob;
                    v0 = v1; v1 = v2; v2 = v3; v3 = nx[i];
                }
                if (ch < 768) {
#pragma unroll
                    for (int q = 0; q < 4; ++q) { u32x4 o4; o4.x = pk[4 * q]; o4.y = pk[4 * q + 1]; o4.z = pk[4 * q + 2]; o4.w = pk[4 * q + 3]; *(u32x4*)(XT + ((size_t)b * 768 + ch) * SEQ + t0 + t8 + 8 * q) = o4; } }
            }
        } else {
            const int ch = tid;
            const bf16_t* up = u + (size_t)b * SEQ * UW + 1536 + ch;
            for (int t8 = 0; t8 < 128; t8 += 32) {
                unsigned pk[16];
#pragma unroll
                for (int i = 0; i < 32; ++i) { const unsigned ob = up[(size_t)(t0 + t8 + i) * UW]; if (i & 1) pk[i >> 1] |= (ob << 16); else pk[i >> 1] = ob; }
#pragma unroll
                for (int q = 0; q < 4; ++q) { u32x4 o4; o4.x = pk[4 * q]; o4.y = pk[4 * q + 1]; o4.z = pk[4 * q + 2]; o4.w = pk[4 * q + 3]; *(u32x4*)(VT + ((size_t)b * 512 + ch) * SEQ + t0 + t8 + 8 * q) = o4; }
            }
        }
    }
}

constexpr int MB_XT = 0, MB_BX = 256 * 272, MB_DT = MB_BX + 128 * 272, MB_CS = MB_DT + 8 * 128 * 4, MB_TOT = MB_CS + 8 * 128 * 4, MB_END = MB_TOT + 64;
static_assert(MB_END <= 131072, "mamba lds");
constexpr size_t MS_SCAN = (size_t)32 * 8192;
DEVI bf16x8 pack8(const float* v) { u32x4 w; w.x = pg8::cvt_pk_bf16(v[0], v[1]); w.y = pg8::cvt_pk_bf16(v[2], v[3]); w.z = pg8::cvt_pk_bf16(v[4], v[5]); w.w = pg8::cvt_pk_bf16(v[6], v[7]); return __builtin_bit_cast(bf16x8, w); }
DEVI void mamba_tables(LAS unsigned char* lds, const float* dtraw, const float* A_log, const float* dt_bias, int b, int g, int c, int wid, int lane) {
    LAS float* tdt = (LAS float*)(lds + MB_DT); LAS float* tcs = (LAS float*)(lds + MB_CS); LAS float* ttot = (LAS float*)(lds + MB_TOT);
    const int r = wid >> 1, dir = wid & 1, hd = 4 * g + r;
    const float A = -__expf(A_log[dir * 8 + hd]), bias = dt_bias[dir * 8 + hd];
    const size_t tk = (size_t)b * SEQ + c * 128 + 2 * lane;
    const float dt0 = softplus_f(dtraw[tk * 16 + dir * 8 + hd] + bias), dt1 = softplus_f(dtraw[(tk + 1) * 16 + dir * 8 + hd] + bias);
    const float a0 = dt0 * A, a1 = dt1 * A;
    float sc = a0 + a1;
#pragma unroll
    for (int off = 1; off < 64; off <<= 1) { const float v = __shfl_up(sc, off); if (lane >= off) sc += v; }
    const float total = __shfl(sc, 63);
    const float pre0 = sc - a1, pre1 = sc;
    const float c0 = dir ? (total - pre0 + a0) : pre0, c1 = dir ? (total - pre1 + a1) : pre1;
    tdt[wid * 128 + 2 * lane] = dt0; tdt[wid * 128 + 2 * lane + 1] = dt1;
    tcs[wid * 128 + 2 * lane] = c0; tcs[wid * 128 + 2 * lane + 1] = c1;
    if (lane == 0) ttot[wid] = total;
}
DEVI void stage_rows(LAS unsigned char* dst, const bf16_t* src, size_t src_stride, int rows, int tid) {
    for (int e = tid; e < rows * 16; e += NTHR) { const int r = e >> 4, cch = e & 15; *(LAS u32x4*)(dst + r * 272 + cch * 16) = *(const u32x4*)(src + (size_t)r * src_stride + cch * 8); }
}
DEVI void ph_mamba_states(LAS unsigned char* lds, const bf16_t* XT, const float* dtraw, const float* A_log, const float* dt_bias, bf16_t* MS, float* MD, int vb0, int vbs) {
    const int tid = opq((int)threadIdx.x), wid = __builtin_amdgcn_readfirstlane(tid >> 6), lane = tid & 63, fr = lane & 15, fq = lane >> 4;
    LAS float* tdt = (LAS float*)(lds + MB_DT); LAS float* tcs = (LAS float*)(lds + MB_CS); LAS float* ttot = (LAS float*)(lds + MB_TOT);
    for (int unit = vb0; unit < NB * 2 * 32; unit += vbs) {
        const int c = unit & 31, g = (unit >> 5) & 1, b = unit >> 6;
        __syncthreads();
        stage_rows(lds + MB_XT, XT + ((size_t)b * 768 + g * 256) * SEQ + c * 128, SEQ, 256, tid);
        stage_rows(lds + MB_BX, XT + ((size_t)b * 768 + 512 + g * 128) * SEQ + c * 128, SEQ, 128, tid);
        mamba_tables(lds, dtraw, A_log, dt_bias, b, g, c, wid, lane);
        __syncthreads();
        if (lane == 0) MD[((size_t)(b * 8 + 4 * g + (wid >> 1)) * 2 + (wid & 1)) * 32 + c] = __expf(ttot[wid]);
        for (int hdd = 0; hdd < 8; ++hdd) {
            const int r = hdd >> 1, dir = hdd & 1, hd = 4 * g + r;
            const float tot = ttot[hdd];
            f32x4 acc[4];
#pragma unroll
            for (int pt = 0; pt < 4; ++pt) acc[pt] = (f32x4){0.f, 0.f, 0.f, 0.f};
#pragma unroll
            for (int ks = 0; ks < 4; ++ks) {
                const int s0 = 32 * ks + 8 * fq;
                const u32x4 braw = *(const LAS u32x4*)(lds + MB_BX + (16 * wid + fr) * 272 + s0 * 2);
                float bw[8];
                const unsigned bu[4] = {braw.x, braw.y, braw.z, braw.w};
#pragma unroll
                for (int j = 0; j < 8; ++j) { const float bv = (j & 1) ? bfhi(bu[j >> 1]) : bflo(bu[j >> 1]);
                    bw[j] = bv * tdt[hdd * 128 + s0 + j] * __expf(tot - tcs[hdd * 128 + s0 + j]); }
                const bf16x8 Bf = pack8(bw);
#pragma unroll
                for (int pt = 0; pt < 4; ++pt) {
                    const bf16x8 Af = *(const LAS bf16x8*)(lds + MB_XT + (r * 64 + 16 * pt + fr) * 272 + s0 * 2);
                    acc[pt] = __builtin_amdgcn_mfma_f32_16x16x32_bf16(Bf, Af, acc[pt], 0, 0, 0);
                }
            }
            bf16_t* dst = MS + ((size_t)(b * 8 + hd) * 2 + dir) * MS_SCAN + (size_t)c * 8192;
#pragma unroll
            for (int pt = 0; pt < 4; ++pt) { u32x2 w; w.x = pk2(acc[pt][0], acc[pt][1]); w.y = pk2(acc[pt][2], acc[pt][3]);
                *(u32x2*)(dst + (16 * pt + fr) * 128 + 16 * wid + 4 * fq) = w; }
        }
    }
    __syncthreads();
}
DEVI void ph_mamba_scan(bf16_t* MS, const float* MD, int vb0, int vbs) {
    const int tid = opq((int)threadIdx.x);
    for (int idx = vb0 * NTHR + tid; idx < 64 * 2048; idx += vbs * NTHR) {
        const int scan = idx >> 11, e4 = idx & 2047; const int dir = scan & 1;
        u32x2* base = (u32x2*)(MS + (size_t)scan * MS_SCAN) + e4;
        const float* md = MD + (size_t)scan * 32;
        float h0 = 0.f, h1 = 0.f, h2 = 0.f, h3 = 0.f;
#pragma unroll 1
        for (int half = 0; half < 2; ++half) {
            const int c0 = (dir ? 1 - half : half) * 16;
            u32x2 d[16]; float dec[16];
#pragma unroll
            for (int i = 0; i < 16; ++i) { d[i] = base[(size_t)(c0 + i) * 2048]; dec[i] = md[c0 + i]; }
#define MSCAN_STEP(i) { const float t0 = bflo(d[i].x), t1 = bfhi(d[i].x), t2 = bflo(d[i].y), t3 = bfhi(d[i].y); d[i].x = pk2(h0, h1); d[i].y = pk2(h2, h3); \
                h0 = h0 * dec[i] + t0; h1 = h1 * dec[i] + t1; h2 = h2 * dec[i] + t2; h3 = h3 * dec[i] + t3; }
            if (dir == 0) {
#pragma unroll
                for (int i = 0; i < 16; ++i) MSCAN_STEP(i)
            } else {
#pragma unroll
                for (int i = 15; i >= 0; --i) MSCAN_STEP(i)
            }
#undef MSCAN_STEP
#pragma unroll
            for (int i = 0; i < 16; ++i) base[(size_t)(c0 + i) * 2048] = d[i];
        }
    }
}
DEVI void ph_mamba_out(LAS unsigned char* lds, const bf16_t* u, const bf16_t* xconv, const bf16_t* XT, const float* dtraw, const float* A_log, const float* dt_bias, const float* Dskip, const float* b_norm,
                       const bf16_t* MS, bf16_t* ocat, int vb0, int vbs) {
    const int tid = opq((int)threadIdx.x), wid = __builtin_amdgcn_readfirstlane(tid >> 6), lane = tid & 63, fr = lane & 15, fq = lane >> 4;
    LAS float* tdt = (LAS float*)(lds + MB_DT); LAS float* tcs = (LAS float*)(lds + MB_CS);
    for (int unit = vb0; unit < NB * 2 * 32; unit += vbs) {
        const int c = unit & 31, g = (unit >> 5) & 1, b = unit >> 6;
        const size_t tok0 = (size_t)b * SEQ + c * 128;
        __syncthreads();
        stage_rows(lds + MB_XT, XT + ((size_t)b * 768 + g * 256) * SEQ + c * 128, SEQ, 256, tid);
        stage_rows(lds + MB_BX, xconv + tok0 * 1024 + 512 + g * 128, 1024, 128, tid);
        mamba_tables(lds, dtraw, A_log, dt_bias, b, g, c, wid, lane);
        const int tl = 16 * wid + fr;
        bf16x8 Cf[4];
#pragma unroll
        for (int ks = 0; ks < 4; ++ks) Cf[ks] = *(const bf16x8*)(xconv + (tok0 + tl) * 1024 + 768 + g * 128 + 32 * ks + 8 * fq);
        __syncthreads();
        f32x4 GT[8];
#pragma unroll
        for (int st = 0; st < 8; ++st) { GT[st] = (f32x4){0.f, 0.f, 0.f, 0.f};
            bf16x8 Af[4];
#pragma unroll
            for (int ks = 0; ks < 4; ++ks) Af[ks] = *(const LAS bf16x8*)(lds + MB_BX + (16 * st + fr) * 272 + (32 * ks + 8 * fq) * 2);
#pragma unroll
            for (int ks = 0; ks < 4; ++ks) GT[st] = __builtin_amdgcn_mfma_f32_16x16x32_bf16(Af[ks], Cf[ks], GT[st], 0, 0, 0); }
        float ss = 0.f;
        __syncthreads();
        u32x2 hpre[4];
        { const bf16_t* hin0 = MS + ((size_t)(b * 8 + 4 * g) * 2) * MS_SCAN + (size_t)c * 8192;
#pragma unroll
          for (int q = 0; q < 4; ++q) hpre[q] = ((const u32x2*)hin0)[tid + q * NTHR]; }
#pragma unroll 1
        for (int r = 0; r < 4; ++r) {
            const int hd = 4 * g + r;
            f32x4 yv[4];
#pragma unroll
            for (int pt = 0; pt < 4; ++pt) yv[pt] = (f32x4){0.f, 0.f, 0.f, 0.f};
#pragma unroll 1
            for (int dir = 0; dir < 2; ++dir) {
                const int hdd = r * 2 + dir;
                const float cst = tcs[hdd * 128 + tl];
                LAS unsigned char* hbuf = lds + MB_BX + (hdd & 1) * 17408;
#pragma unroll
                for (int q = 0; q < 4; ++q) { const int e4 = tid + q * NTHR, pp = e4 >> 5, n4 = (e4 & 31) * 4;
                    *(LAS u32x2*)(hbuf + pp * 272 + n4 * 2) = hpre[q]; }
                if (hdd < 7) { const int hn = hdd + 1; const bf16_t* hinn = MS + ((size_t)(b * 8 + 4 * g + (hn >> 1)) * 2 + (hn & 1)) * MS_SCAN + (size_t)c * 8192;
#pragma unroll
                    for (int q = 0; q < 4; ++q) hpre[q] = ((const u32x2*)hinn)[tid + q * NTHR]; }
                __syncthreads();
                f32x4 yo[4];
#pragma unroll
                for (int pt = 0; pt < 4; ++pt) { yo[pt] = (f32x4){0.f, 0.f, 0.f, 0.f};
                    bf16x8 hf[4];
#pragma unroll
                    for (int ks = 0; ks < 4; ++ks) hf[ks] = *(const LAS bf16x8*)(hbuf + (16 * pt + fr) * 272 + (32 * ks + 8 * fq) * 2);
#pragma unroll
                    for (int ks = 0; ks < 4; ++ks) yo[pt] = __builtin_amdgcn_mfma_f32_16x16x32_bf16(hf[ks], Cf[ks], yo[pt], 0, 0, 0); }
                const float eo = __expf(cst);
#pragma unroll
                for (int pt = 0; pt < 4; ++pt) yv[pt] += yo[pt] * eo;
#pragma unroll
                for (int kp = 0; kp < 4; ++kp) {
                    const bool skip = dir ? (2 * kp + 1 < wid) : (2 * kp > wid);
                    if (!skip) {
                        float pv[8];
#pragma unroll
                        for (int hlf = 0; hlf < 2; ++hlf) { const int st = 2 * kp + hlf;
                            const f32x4 cs4 = *(const LAS f32x4*)(tcs + hdd * 128 + 16 * st + 4 * fq), dt4 = *(const LAS f32x4*)(tdt + hdd * 128 + 16 * st + 4 * fq);
#pragma unroll
                            for (int rg = 0; rg < 4; ++rg) { const int sl = 16 * st + 4 * fq + rg;
                                const bool ok = dir ? (sl >= tl) : (sl <= tl);
                                const float e = __expf(fminf(cst - cs4[rg], 0.f));
                                pv[hlf * 4 + rg] = ok ? GT[st][rg] * e * dt4[rg] : 0.f; } }
                        u32x2 x0[4], x1[4];
#pragma unroll
                        for (int pt = 0; pt < 4; ++pt) { const LAS unsigned char* xr = lds + MB_XT + (r * 64 + 16 * pt + fr) * 272;
                            x0[pt] = *(const LAS u32x2*)(xr + (32 * kp + 4 * fq) * 2); x1[pt] = *(const LAS u32x2*)(xr + (32 * kp + 16 + 4 * fq) * 2); }
                        const bf16x8 Pf = pack8(pv);
#pragma unroll
                        for (int pt = 0; pt < 4; ++pt) {
                            u32x4 xa; xa.x = x0[pt].x; xa.y = x0[pt].y; xa.z = x1[pt].x; xa.w = x1[pt].y;
                            yv[pt] = __builtin_amdgcn_mfma_f32_16x16x32_bf16(__builtin_bit_cast(bf16x8, xa), Pf, yv[pt], 0, 0, 0);
                        }
                    }
                }
            }
            const float Dk = Dskip[hd];
#pragma unroll
            for (int pt = 0; pt < 4; ++pt) {
                const int p0 = 16 * pt + 4 * fq;
                const u32x2 xr = *(const u32x2*)(xconv + (tok0 + tl) * 1024 + hd * 64 + p0);
                const u32x2 zr = *(const u32x2*)(u + (tok0 + tl) * UW + 2560 + hd * 64 + p0);
                const float xs[4] = {bflo(xr.x), bfhi(xr.x), bflo(xr.y), bfhi(xr.y)}, zs[4] = {bflo(zr.x), bfhi(zr.x), bflo(zr.y), bfhi(zr.y)};
                float yy[4];
#pragma unroll
                for (int rg = 0; rg < 4; ++rg) { const float y = (yv[pt][rg] + Dk * xs[rg]) * silu_f(zs[rg]); yy[rg] = y; ss += y * y; }
                const unsigned long long o = (unsigned long long)pk2(yy[0], yy[1]) | ((unsigned long long)pk2(yy[2], yy[3]) << 32);
                __hip_atomic_store((unsigned long long*)(ocat + (tok0 + tl) * DM + 512 + g * 256 + r * 64 + p0), o, __ATOMIC_RELAXED, __HIP_MEMORY_SCOPE_AGENT);
            }
        }
        ss += __shfl_xor(ss, 16); ss += __shfl_xor(ss, 32);
        const float rn = rsqrtf(ss * (1.f / 256.f) + EPS);
        asm volatile("s_waitcnt vmcnt(0)" ::: "memory");
        unsigned long long pk[16];
#pragma unroll
        for (int q = 0; q < 16; ++q) pk[q] = __hip_atomic_load((unsigned long long*)(ocat + (tok0 + tl) * DM + 512 + g * 256 + (q >> 2) * 64 + 16 * (q & 3) + 4 * fq), __ATOMIC_RELAXED, __HIP_MEMORY_SCOPE_AGENT);
#pragma unroll
        for (int r = 0; r < 4; ++r)
#pragma unroll
            for (int pt = 0; pt < 4; ++pt) {
                const int cc = g * 256 + r * 64 + 16 * pt + 4 * fq;
                unsigned long long* op = (unsigned long long*)(ocat + (tok0 + tl) * DM + 512 + cc);
                const unsigned long long v = pk[r * 4 + pt];
                const unsigned vlo = (unsigned)v, vhi = (unsigned)(v >> 32);
                const float4 bn = *(const float4*)(b_norm + cc);
                const unsigned long long o = (unsigned long long)pk2(bflo(vlo) * rn * bn.x, bfhi(vlo) * rn * bn.y) | ((unsigned long long)pk2(bflo(vhi) * rn * bn.z, bfhi(vhi) * rn * bn.w) << 32);
                *op = o;
            }
    }
    __syncthreads();
}


constexpr int NA_RING = 12, NA_VT = 0, NA_VSTRIDE = NA_RING * 64 * 2 + 16, NA_BIAS = 64 * NA_VSTRIDE, NA_END = NA_BIAS + 480 * 4;
static_assert(NA_END <= 131072, "na lds");
DEVI void ph_na(LAS unsigned char* lds, const bf16_t* qkv, const float* rpb, bf16_t* oc, int vb0, int vbs) {
    const int tid = opq((int)threadIdx.x), wid = __builtin_amdgcn_readfirstlane(tid >> 6), lane = tid & 63, fr = lane & 15, fq = lane >> 4;
    LAS float* bl = (LAS float*)(lds + NA_BIAS);
    for (int chunk = vb0; chunk < NB * 16 * 4; chunk += vbs) {
        const int qr4 = chunk & 3, h = (chunk >> 2) & 15, b = chunk >> 6;
        __syncthreads();
        for (int e = tid; e < 465; e += NTHR) bl[e] = rpb[h * 465 + e];
        int staged_hi = -1;
#pragma unroll 1
        for (int ui = 0; ui < 8; ++ui) {
            const int rp = qr4 * 8 + ui;
            const int r0 = 2 * rp, rs0 = min(max(r0 - 4, 0), 56);
            const int need_hi = min(rs0 + 8, 63);
            const int lo = max(staged_hi + 1, rs0);
            for (int task = wid; task < (need_hi - lo + 1) * 8; task += 8) {
                const int kr = lo + (task >> 3), ch = task & 7, slot = kr % NA_RING;
                const u32x4 v = *(const u32x4*)(qkv + ((size_t)b * SEQ + kr * 64 + lane) * 3072 + 2048 + h * 64 + ch * 8);
                const unsigned vw[4] = {v.x, v.y, v.z, v.w};
#pragma unroll
                for (int i = 0; i < 8; ++i) *(LAS bf16_t*)(lds + NA_VT + (ch * 8 + i) * NA_VSTRIDE + (slot * 64 + lane) * 2) = (bf16_t)((i & 1) ? (vw[i >> 1] >> 16) : (vw[i >> 1] & 0xffffu));
            }
            staged_hi = need_hi > staged_hi ? need_hi : staged_hi;
            __syncthreads();
            const int r = r0 + (wid >> 2), j = wid & 3;
            const int rs = min(max(r - 4, 0), 56);
            const int bs = (j == 0) ? 0 : (j == 1) ? 8 : (j == 2) ? 24 : 32;
            const int c = 16 * j + fr, qs = min(max(c - 8, 0), 48);
            const size_t qtok = (size_t)b * SEQ + r * 64 + c;
            bf16x8 Qf[2];
#pragma unroll
            for (int ks = 0; ks < 2; ++ks) Qf[ks] = *(const bf16x8*)(qkv + qtok * 3072 + h * 64 + 32 * ks + 8 * fq);
            const bf16_t* kbase = qkv + ((size_t)b * SEQ + rs * 64 + bs + fr) * 3072 + 1024 + h * 64 + 8 * fq;
            bf16x8 kn[4];
#pragma unroll
            for (int q = 0; q < 4; ++q) kn[q] = *(const bf16x8*)(kbase + (size_t)((q >> 1) * 16) * 3072 + (q & 1) * 32);
            f32x4 O[4];
#pragma unroll
            for (int dt = 0; dt < 4; ++dt) O[dt] = (f32x4){0.f, 0.f, 0.f, 0.f};
            float mrun = -1e30f, lrun = 0.f;
#pragma unroll 1
            for (int dr = 0; dr < 8; ++dr) {
                bf16x8 kc[4];
#pragma unroll
                for (int q = 0; q < 4; ++q) kc[q] = kn[q];
                const int drn = dr < 7 ? dr + 1 : 7;
#pragma unroll
                for (int q = 0; q < 4; ++q) kn[q] = *(const bf16x8*)(kbase + ((size_t)drn * 64 + (q >> 1) * 16) * 3072 + (q & 1) * 32);
                float sv[8]; float mloc = -1e30f;
                const LAS float* brow = bl + (rs + dr - r + 7) * 31;
#pragma unroll
                for (int kg = 0; kg < 2; ++kg) {
                    f32x4 acc = {0.f, 0.f, 0.f, 0.f};
                    acc = __builtin_amdgcn_mfma_f32_16x16x32_bf16(kc[kg * 2], Qf[0], acc, 0, 0, 0);
                    acc = __builtin_amdgcn_mfma_f32_16x16x32_bf16(kc[kg * 2 + 1], Qf[1], acc, 0, 0, 0);
#pragma unroll
                    for (int rg = 0; rg < 4; ++rg) {
                        const int kcol = bs + 16 * kg + 4 * fq + rg;
                        const bool ok = (kcol >= qs) && (kcol < qs + 16);
                        const int dc = min(max(kcol - c + 15, 0), 30);
                        const float sc = ok ? acc[rg] * 0.125f + brow[dc] : -1e30f;
                        sv[kg * 4 + rg] = sc; mloc = fmaxf(mloc, sc);
                    }
                }
                mloc = fmaxf(mloc, __shfl_xor(mloc, 16)); mloc = fmaxf(mloc, __shfl_xor(mloc, 32));
                const float mnew = fmaxf(mrun, mloc);
                const float alpha = __expf(mrun - mnew);
                float psum = 0.f;
#pragma unroll
                for (int i = 0; i < 8; ++i) { const float p = __expf(sv[i] - mnew); sv[i] = p; psum += p; }
                psum += __shfl_xor(psum, 16); psum += __shfl_xor(psum, 32);
                lrun = lrun * alpha + psum; mrun = mnew;
                const bf16x8 Pf = pack8(sv);
                const int koff = (((rs + dr) % NA_RING) * 64 + bs + 4 * fq) * 2;
#pragma unroll
                for (int dt = 0; dt < 4; ++dt) {
                    const LAS unsigned char* vr = lds + NA_VT + (16 * dt + fr) * NA_VSTRIDE + koff;
                    const u32x2 v0 = *(const LAS u32x2*)vr, v1 = *(const LAS u32x2*)(vr + 32);
                    u32x4 va; va.x = v0.x; va.y = v0.y; va.z = v1.x; va.w = v1.y;
                    O[dt] = __builtin_amdgcn_mfma_f32_16x16x32_bf16(__builtin_bit_cast(bf16x8, va), Pf, O[dt] * alpha, 0, 0, 0);
                }
            }
            const float il = 1.f / lrun;
#pragma unroll
            for (int dt = 0; dt < 4; ++dt) {
                u32x2 o; o.x = pk2(O[dt][0] * il, O[dt][1] * il); o.y = pk2(O[dt][2] * il, O[dt][3] * il);
                *(u32x2*)(oc + qtok * DM + h * 64 + 16 * dt + 4 * fq) = o;
            }
        }
    }
    __syncthreads();
}

#define XB_TMO      128
#define XB_XCNT(j)  (256  + 64 * (j))
#define XB_XSUB(j)  (1280 + 64 * (j))
#define XB_XGEN(j)  (2304 + 64 * (j))
#define XB_TOP      3328
#define XB_TOPGEN   3392
#define XCD_BAR_WORDS 3456
#define XB_SPIN_CAP (1u << 18)

__device__ __forceinline__ unsigned xb_ld(unsigned* p)              { return __hip_atomic_load(p, __ATOMIC_RELAXED, __HIP_MEMORY_SCOPE_AGENT); }
__device__ __forceinline__ unsigned xb_add(unsigned* p, unsigned v) { return __hip_atomic_fetch_add(p, v, __ATOMIC_RELAXED, __HIP_MEMORY_SCOPE_AGENT); }
__device__ __forceinline__ unsigned xb_xcc_id() { return (unsigned)__builtin_amdgcn_s_getreg((3 << 11) | 20) & 0xFu; }
#define XB_SPIN(cond, bar) do { unsigned _sp = 0; while (cond) { __builtin_amdgcn_s_sleep(1); \
    if ((++_sp & 255u) == 0u) { if (xb_ld(&(bar)[XB_TMO])) break; if (_sp > XB_SPIN_CAP) { atomicAdd(&(bar)[XB_TMO], 1u); break; } } } } while (0)

struct XcdBarrier {
    unsigned* bar; unsigned x;
    volatile LAS unsigned* st;
};

__device__ __forceinline__ XcdBarrier xcd_barrier_post(unsigned* bar, volatile LAS unsigned* st) {
    XcdBarrier b; b.bar = bar; b.x = xb_xcc_id(); b.st = st;
    if (threadIdx.x == 0) (void)xb_add(&bar[XB_XCNT(b.x)], 1u);
    return b;
}
__device__ __forceinline__ void xcd_barrier_complete(unsigned* bar, unsigned x, unsigned& nloc, unsigned& nx) {
    const unsigned G = gridDim.x * gridDim.y * gridDim.z;
    unsigned sum, cnt, mine, sp = 0u;
    for (;;) {
        sum = 0u; cnt = 0u; mine = 0u;
#pragma unroll
        for (unsigned j = 0; j < 16; ++j) { const unsigned c = xb_ld(&bar[XB_XCNT(j)]); sum += c; cnt += (c > 0u) ? 1u : 0u; mine = (j == x) ? c : mine; }
        if (sum == G) break;
        __builtin_amdgcn_s_sleep(1);
        if ((++sp & 255u) == 0u) { if (xb_ld(&bar[XB_TMO])) break; if (sp > XB_SPIN_CAP) { atomicAdd(&bar[XB_TMO], 1u); break; } }
    }
    nloc = mine > 0u ? mine : 1u; nx = cnt > 0u ? cnt : 1u;
}

__device__ __forceinline__ void xcd_barrier(const XcdBarrier& b) {
    asm volatile("s_waitcnt vmcnt(0)" ::: "memory");
    __syncthreads();
    if (threadIdx.x == 0) {
        unsigned* bar = b.bar;
        __builtin_amdgcn_s_waitcnt(0);
        unsigned nloc = b.st[0], nx = b.st[1];
        if (nloc == 0u) { xcd_barrier_complete(bar, b.x, nloc, nx); b.st[0] = nloc; b.st[1] = nx; }
        const unsigned old = xb_add(&bar[XB_XSUB(b.x)], 1u);
        const unsigned gen = old / nloc;
        if (old + 1u == (gen + 1u) * nloc) {
            __builtin_amdgcn_fence(__ATOMIC_RELEASE, "agent");
            asm volatile("s_waitcnt vmcnt(0)" ::: "memory");
            const unsigned og = xb_add(&bar[XB_TOP], 1u);
            const unsigned tg = og / nx;
            if (og + 1u == (tg + 1u) * nx) xb_add(&bar[XB_TOPGEN], 1u);
            else XB_SPIN(xb_ld(&bar[XB_TOPGEN]) == tg, bar);
            __builtin_amdgcn_fence(__ATOMIC_ACQUIRE, "agent");
            xb_add(&bar[XB_XGEN(b.x)], 1u);
            asm volatile("s_waitcnt vmcnt(0)" ::: "memory");
        } else {
            XB_SPIN(xb_ld(&bar[XB_XGEN(b.x)]) == gen, bar);
            __builtin_amdgcn_fence(__ATOMIC_ACQUIRE, "agent");
            asm volatile("s_waitcnt vmcnt(0)" ::: "memory");
        }
    }
    __syncthreads();
}


struct Args { const float* in[34]; float* out; unsigned char* ws; int ph_lo, ph_hi; };
constexpr int N_PHASES = 22;

__global__ void __launch_bounds__(NTHR, 2) fwd(Args a) {
    extern __shared__ __attribute__((aligned(16))) unsigned char lds_raw[];
    float* lds = (float*)lds_raw;
    LAS unsigned char* ldsl = (LAS unsigned char*)lds_raw;
    const int vb0 = blockIdx.x, vbs = gridDim.x;
    const int lo = a.ph_lo, hi = a.ph_hi;
#define IN(k) (lo <= (k) && (k) < hi)
#define SEAM(k) do { if (IN(k) && IN((k) + 1)) xcd_barrier(bar); } while (0)
    volatile LAS unsigned* misc = (volatile LAS unsigned*)(ldsl + MISC_OFF);
    if (threadIdx.x < 4) misc[threadIdx.x] = 0u;
    __syncthreads();
    XcdBarrier bar = xcd_barrier_post((unsigned*)(a.ws + WS_CTL) + CW_BAR, misc);
    unsigned char* ws = a.ws;
    unsigned* ctl = (unsigned*)(ws + WS_CTL);
    unsigned* cnt = ctl + CW_CNT;
    int* list = (int*)(ws + WS_LIST); float* gatev = (float*)(ws + WS_GATE);
    float* dtraw = (float*)(ws + WS_DT); float* RS = (float*)(ws + WS_RS);
    bf16_t* XB = (bf16_t*)(ws + WS_XB); bf16_t* UB = (bf16_t*)(ws + WS_UB);
    bf16_t* YA = (bf16_t*)(ws + WS_YA); float* OF = (float*)(ws + WS_OF); bf16_t* OC = (bf16_t*)(ws + WS_OC);
    bf16_t* YP = (bf16_t*)(ws + WS_YP); bf16_t* YP1 = (bf16_t*)(ws + WS_YP1); bf16_t* XC = (bf16_t*)(ws + WS_YP);
    bf16_t* PB0 = (bf16_t*)(ws + WS_PB0); bf16_t* PB1 = (bf16_t*)(ws + WS_PB1);
    bf16_t* YB = (bf16_t*)(ws + WS_Y);
    bf16_t* Y2 = (bf16_t*)(ws + WS_Y2); unsigned char* yflag = ws + WS_YFLAG;
    bf16_t* MS = (bf16_t*)(ws + WS_MS); float* MD = (float*)(ws + WS_MD);
    bf16_t* HS = (bf16_t*)(ws + WS_HS); float* HD = (float*)(ws + WS_HD);
    bf16_t* XT = (bf16_t*)(ws + WS_XT); bf16_t* VT = (bf16_t*)(ws + WS_VT);
    const float* p_in = a.in[1];
    const int G = (int)gridDim.x, cb = (int)blockIdx.x;
    const NormB NB0{nullptr, XB, nullptr, nullptr, RS, nullptr, nullptr, nullptr, nullptr, nullptr, nullptr, nullptr, nullptr, nullptr, nullptr};
    unsigned char* XG8 = ws + WS_XG8;
    float* rsl = (float*)(ws + WS_DT);

    if (IN(0)) {
        ph_convert_weights(ldsl, a.in, ws, 0, ITEMS_DENSE, vb0, vbs);
        NormB A = NB0; A.xin = a.in[0]; A.gnext = a.in[3]; A.win = a.in[4]; A.dtraw = dtraw;
        ph_norm0_dt(A, vb0, vbs, ldsl);
    }
    SEAM(0);
    if (IN(1)) { pg8::DenseOrder S; S.init(MT, UW, DM, (const bf16_t*)(ws + W_IN), G, cb); pg8::gemm_phase(ldsl, XB, DM, S, pg8::EpiBf16{UB, UW, RS}); }
    SEAM(1);
    if (IN(2)) { ph_prep(UB, a.in[5], a.in[6], XC, XT, VT, vb0, vbs); }
    SEAM(2);
    if (IN(3)) { ph_hgrn_states(ldsl, UB, VT, a.in[2], HS, HD, vb0, vbs); ph_mamba_states(ldsl, XT, dtraw, a.in[7], a.in[8], MS, MD, vb0, vbs); }
    SEAM(3);
    if (IN(4)) { ph_hgrn_scan(HS, HD, vb0, vbs); ph_mamba_scan(MS, MD, vb0, vbs); }
    SEAM(4);
    if (IN(5)) { ph_hgrn_out(ldsl, UB, VT, a.in[2], a.in[10], HS, OF, OC, vb0, vbs); ph_mamba_out(ldsl, UB, XC, XT, dtraw, a.in[7], a.in[8], a.in[9], a.in[11], MS, OC, vb0, vbs); }
    SEAM(5);
    if (IN(6)) { pg8::DenseOrder S; S.init(MT, DM, DM, (const bf16_t*)(ws + W_OUTE), G, cb); pg8::gemm_phase(ldsl, OC, DM, S, pg8::EpiBf16{YA, DM, nullptr}); }
    SEAM(6);
    if (IN(7)) {
        NormB A = NB0; A.y = YA; A.gpost = a.in[13];
        ph_norm2<1, false, false, false>(A, vb0, vbs);
        ph_cvt_rows(p_in, PB0, (size_t)MT * PDIM / 4, vb0, vbs);
        ph_convert_experts(ldsl, a.in, ws, ITEMS_DENSE, ITEMS_ALL, vb0, vbs);
    }
    SEAM(7);
    if (IN(8)) {
        { pg8::DenseOrder S; S.init(MT, 2 * DFF, DM, (const bf16_t*)(ws + W_GU), G, cb); pg8::gemm_phase(ldsl, XB, DM, S, pg8::EpiSwiglu{UB, DFF, RS, 0}); }
        { pg8::TailOrder S; S.init(MT, DM, PDIM, (const bf16_t*)(ws + W_PP), G, cb, (MT / 256) * (2 * DFF / 256) % G); pg8::gemm_phase(ldsl, PB0, PDIM, S, pg8::EpiBf16{YP, DM, nullptr}); }
    }
    SEAM(8);
    if (IN(9)) { pg8::DenseOrder S; S.init(MT, DM, DFF, (const bf16_t*)(ws + W_DN), G, cb); pg8::gemm_phase(ldsl, UB, DFF, S, pg8::EpiBf16{YA, DM, nullptr}); }
    SEAM(9);
    if (IN(10)) {
        NormB A = NB0; A.y = YA; A.gpost = a.in[18];
        ph_norm2<1, false, false, false>(A, vb0, vbs);
    }
    SEAM(10);
    if (IN(11)) { pg8::DenseOrder S; S.init(MT, DM, DM, (const bf16_t*)(ws + W_PG), G, cb); pg8::gemm_phase(ldsl, XB, DM, S, pg8::EpiPleGate{YP, DM, RS}); }
    SEAM(11);
    if (IN(12)) {
        NormB A = NB0; A.y = YP; A.gpost = a.in[33];
        ph_norm2<1, false, false, false>(A, vb0, vbs);
    }
    SEAM(12);
    if (IN(13)) { pg8::DenseOrder S; S.init(MT, 3072, DM, (const bf16_t*)(ws + W_QKV), G, cb); pg8::gemm_phase(ldsl, XB, DM, S, pg8::EpiBf16{UB, 3072, RS}); }
    SEAM(13);
    if (IN(14)) { ph_na(ldsl, UB, a.in[21], OC, vb0, vbs); }
    SEAM(14);
    if (IN(15)) { pg8::DenseOrder S; S.init(MT, DM, DM, (const bf16_t*)(ws + W_OUTO), G, cb); pg8::gemm_phase(ldsl, OC, DM, S, pg8::EpiBf16{YP1, DM, nullptr}); }
    SEAM(15);
    if (IN(16)) {
        NormB A = NB0; A.y = YP1; A.gpost = a.in[23]; A.gnext = a.in[24]; A.wr = a.in[25]; A.cnt = cnt; A.list = list; A.gatev = gatev; A.rsl = rsl; A.x8 = XG8;
        ph_norm2<1, false, false, true>(A, vb0, vbs, (LAS float*)ldsl);
        ph_cvt_rows(p_in + (size_t)MT * PDIM, PB1, (size_t)MT * PDIM / 4, vb0, vbs);
    }
    SEAM(16);
    if (IN(17)) { pg8::MoeOrder S; S.init(cnt, (volatile LAS int*)(ldsl + MISC_OFF + 64), 2 * DFFE, DM / 2, (const bf16_t*)(ws + W_EGU), (size_t)7 * MiB, true, G, cb);
        pg8::gemm_phase<pg8::EpiSwiglu8, pg8::MoeOrder, true>(ldsl, (const bf16_t*)XG8, DM / 2, S, pg8::EpiSwiglu8{(unsigned char*)UB, DFFE, rsl}); }
    SEAM(17);
    if (IN(18)) { pg8::MoeOrder S; S.init(cnt, (volatile LAS int*)(ldsl + MISC_OFF + 64), DM, DFFE / 2, (const bf16_t*)(ws + W_EDN), (size_t)(7 * MiB / 2), false, G, cb);
        const pg8::EpiMoeDown E{YB, list, gatev, 1.f / (pg8::W8_SCALE * pg8::ACT8_SCALE), (size_t)(Y2 - YB), yflag};
        S.set_split(true, false, DFFE / 2);
        pg8::gemm_phase<pg8::EpiMoeDown, pg8::MoeOrder, true>(ldsl, UB, DFFE / 2, S, E);
        S.set_split(true, true, DFFE / 2);
        pg8::gemm_phase<pg8::EpiMoeDown, pg8::MoeOrder, true>(ldsl, UB, DFFE / 2, S, E, DFFE / 4);
        { pg8::TailOrder T; T.init(MT, DM, PDIM, (const bf16_t*)(ws + W_PP + 512 * 1024), G, cb, S.tail_first()); pg8::gemm_phase(ldsl, PB1, PDIM, T, pg8::EpiBf16{YP, DM, nullptr}); } }
    SEAM(18);
    if (IN(19)) {
        NormB A = NB0; A.y = YB; A.gpost = a.in[29]; A.y2 = Y2; A.yflag = yflag;
        ph_norm2<2, false, false, false>(A, vb0, vbs);
    }
    SEAM(19);
    if (IN(20)) { pg8::DenseOrder S; S.init(MT, DM, DM, (const bf16_t*)(ws + W_PG + 2 * MiB), G, cb); pg8::gemm_phase(ldsl, XB, DM, S, pg8::EpiPleGate{YP, DM, RS}); }
    SEAM(20);
    if (IN(21)) {
        NormB A = NB0; A.y = YP; A.gpost = a.in[33] + DM; A.xout = a.out;
        ph_norm2<1, true, false, false>(A, vb0, vbs);
    }
#undef IN
#undef SEAM
}

extern "C" void kernel_launch(void* const* d_in, const int* in_sizes, int n_in, void* d_out, int out_size, void* d_ws, size_t ws_size, hipStream_t stream) {
    static int grid = 0;
    if (grid == 0) {
        if (n_in != 34 || out_size != MT * DM || ws_size < WS_END) { fprintf(stderr, "kernel_launch: unexpected shapes n_in %d out %d ws %zu (need %zu)\n", n_in, out_size, ws_size, (size_t)WS_END); grid = -1; return; }
        int dev = 0, cus = 0;
        if (hipGetDevice(&dev) != hipSuccess || hipDeviceGetAttribute(&cus, hipDeviceAttributeMultiprocessorCount, dev) != hipSuccess) { grid = -1; return; }
        if (hipFuncSetAttribute((const void*)fwd, hipFuncAttributeMaxDynamicSharedMemorySize, LDS_BYTES) != hipSuccess) { fprintf(stderr, "hipFuncSetAttribute failed\n"); grid = -1; return; }
        (void)hipGetLastError();
        grid = cus;
    }
    if (grid < 0) return;
    (void)hipMemsetAsync((char*)d_ws + WS_CTL, 0, CTL_ZERO_BYTES, stream);
    Args a{};
    for (int i = 0; i < 34; ++i) a.in[i] = (const float*)d_in[i];
    a.out = (float*)d_out; a.ws = (unsigned char*)d_ws;
#ifndef MK_PER_PHASE
    a.ph_lo = 0; a.ph_hi = N_PHASES;
    hipLaunchKernelGGL(fwd, dim3(grid), dim3(NTHR), LDS_BYTES, stream, a);
#else
    for (int ph = 0; ph < N_PHASES; ++ph) {
        a.ph_lo = ph; a.ph_hi = ph + 1;
        hipLaunchKernelGGL(fwd, dim3(grid), dim3(NTHR), LDS_BYTES, stream, a);
    }
#endif
}
```

```cpp
#include <hip/hip_runtime.h>
#include <stdint.h>
#include <stdio.h>

#define DEVI __device__ __forceinline__
#define LAS __attribute__((address_space(3)))
typedef unsigned short bf16_t;

constexpr int NB = 4, SEQ = 4096, DM = 1024, MT = NB * SEQ;
constexpr int EVEN_IN = 4112, UW = 4096, DFF = 2816, NEXP = 8, DFFE = 3584, PDIM = 256;
constexpr float EPS = 1e-6f;
constexpr int NTHR = 512;
constexpr int LDS_BYTES = 147456;
constexpr int MISC_OFF = 131072 + 320;
constexpr int MOE_ROWS = 2 * MT + NEXP * 256;

constexpr size_t MiB = 1u << 20;
constexpr size_t WS_CTL = 0, CTL_ZERO_BYTES = 1 * MiB;
constexpr size_t WS_LIST = 1 * MiB;
constexpr size_t WS_GATE = WS_LIST + 512 * 1024;
constexpr size_t WS_DT = 2 * MiB;
constexpr size_t WS_W = 3 * MiB;
constexpr size_t W_IN = WS_W, W_OUTE = W_IN + 8 * MiB, W_GU = W_OUTE + 2 * MiB, W_DN = W_GU + 11 * MiB, W_PG = W_DN + 6 * MiB, W_PP = W_PG + 4 * MiB,
                 W_QKV = W_PP + 1 * MiB, W_OUTO = W_QKV + 6 * MiB, W_EGU = W_OUTO + 2 * MiB, W_EDN = W_EGU + 112 * MiB, W_END = W_EDN + 56 * MiB;
constexpr size_t WS_XB = W_END;
constexpr size_t WS_R = WS_XB + 32 * MiB;
constexpr size_t WS_UB = WS_R;
constexpr size_t WS_PB0 = WS_R + 88 * MiB;
constexpr size_t WS_YA = WS_R + 128 * MiB;
constexpr size_t WS_OF = WS_R + 160 * MiB;
constexpr size_t WS_OC = WS_R + 192 * MiB;
constexpr size_t WS_YP = WS_R + 224 * MiB;
constexpr size_t WS_YP1 = WS_R;
constexpr size_t WS_PB1 = W_EDN + 32 * MiB;
constexpr size_t WS_XG8 = WS_R + 120 * MiB;
constexpr size_t WS_END = WS_R + 256 * MiB;
constexpr size_t WS_Y2 = WS_R + 120 * MiB;
constexpr size_t WS_YFLAG = WS_CTL + 256 * 1024;
constexpr size_t WS_Y = W_EGU;
constexpr size_t WS_MS = W_EGU;
constexpr size_t WS_HS = W_EGU + 64 * MiB;
constexpr size_t WS_XT = W_EDN;
constexpr size_t WS_VT = W_EDN + 24 * MiB;
constexpr size_t WS_MD = W_EDN + 40 * MiB;
constexpr size_t WS_HD = W_EDN + 41 * MiB;
static_assert(WS_R + (size_t)MOE_ROWS * DFFE <= WS_XG8 && WS_XG8 + 128 * MiB <= WS_END && WS_END <= 510 * MiB, "ws map");
constexpr size_t WS_RS = WS_CTL + 512 * 1024;
constexpr int CW_CNT = 64;
constexpr int CW_BAR = 4096;

DEVI int opq(int x) { asm volatile("" : "+v"(x)); return x; }
DEVI float bf2f(bf16_t b) { return __uint_as_float(((unsigned)b) << 16); }
typedef float f32x2c __attribute__((ext_vector_type(2)));
typedef __bf16 bf16x2c __attribute__((ext_vector_type(2)));
DEVI unsigned cvt2bf(float lo, float hi) { const f32x2c v = {lo, hi}; return __builtin_bit_cast(unsigned, __builtin_convertvector(v, bf16x2c)); }
DEVI bf16_t f2bf(float f) { return (bf16_t)(cvt2bf(f, 0.f) & 0xffffu); }
DEVI float silu_f(float x) { return x * __builtin_amdgcn_rcpf(1.f + __builtin_amdgcn_exp2f(-1.44269504f * x)); }
DEVI float sigmoid_f(float x) { return __builtin_amdgcn_rcpf(1.f + __builtin_amdgcn_exp2f(-1.44269504f * x)); }
DEVI float softplus_f(float x) { return x > 20.f ? x : log1pf(__expf(x)); }
DEVI float wave_sum(float v) {
#pragma unroll
    for (int o = 1; o < 64; o <<= 1) v += __shfl_xor(v, o);
    return v;
}


typedef short bf16x8 __attribute__((ext_vector_type(8)));
typedef float f32x4 __attribute__((ext_vector_type(4)));
typedef unsigned u32x4 __attribute__((ext_vector_type(4)));
typedef unsigned u32x2 __attribute__((ext_vector_type(2)));
DEVI unsigned pk2(float lo, float hi) { return cvt2bf(lo, hi); }
DEVI float bflo(unsigned w) { return __uint_as_float(w << 16); }
DEVI float bfhi(unsigned w) { return __uint_as_float(w & 0xffff0000u); }

DEVI unsigned pg8_pk4(float a, float b, float c, float d) {
    a = __builtin_amdgcn_fmed3f(a, -448.f, 448.f); b = __builtin_amdgcn_fmed3f(b, -448.f, 448.f); c = __builtin_amdgcn_fmed3f(c, -448.f, 448.f); d = __builtin_amdgcn_fmed3f(d, -448.f, 448.f);
    int p = __builtin_amdgcn_cvt_pk_fp8_f32(a, b, 0, false); p = __builtin_amdgcn_cvt_pk_fp8_f32(c, d, p, true); return (unsigned)p; }
DEVI float wave_sum16(float (&v)[16], int lane) {
    const bool h5 = lane & 32, h4 = lane & 16, h3 = lane & 8, h2 = lane & 4;
#pragma unroll
    for (int i = 0; i < 8; ++i) { const float send = h5 ? v[i] : v[i + 8], keep = h5 ? v[i + 8] : v[i]; v[i] = keep + __shfl_xor(send, 32); }
#pragma unroll
    for (int i = 0; i < 4; ++i) { const float send = h4 ? v[i] : v[i + 4], keep = h4 ? v[i + 4] : v[i]; v[i] = keep + __shfl_xor(send, 16); }
#pragma unroll
    for (int i = 0; i < 2; ++i) { const float send = h3 ? v[i] : v[i + 2], keep = h3 ? v[i + 2] : v[i]; v[i] = keep + __shfl_xor(send, 8); }
    { const float send = h2 ? v[0] : v[1], keep = h2 ? v[1] : v[0]; v[0] = keep + __shfl_xor(send, 4); }
    float r = v[0]; r += __shfl_xor(r, 1); r += __shfl_xor(r, 2); return r;
}
DEVI float wave_sum8(float (&v)[8], int lane) {
    const bool h5 = lane & 32, h4 = lane & 16, h3 = lane & 8;
#pragma unroll
    for (int i = 0; i < 4; ++i) { const float send = h5 ? v[i] : v[i + 4], keep = h5 ? v[i + 4] : v[i]; v[i] = keep + __shfl_xor(send, 32); }
#pragma unroll
    for (int i = 0; i < 2; ++i) { const float send = h4 ? v[i] : v[i + 2], keep = h4 ? v[i + 2] : v[i]; v[i] = keep + __shfl_xor(send, 16); }
    { const float send = h3 ? v[0] : v[1], keep = h3 ? v[1] : v[0]; v[0] = keep + __shfl_xor(send, 8); }
    float r = v[0]; r += __shfl_xor(r, 1); r += __shfl_xor(r, 2); r += __shfl_xor(r, 4); return r;
}
struct NormB { const float* xin; bf16_t* XB; const bf16_t* y; const float* gpost; float* rs; const float* gnext;
               const float* win; float* dtraw; const float* wr; unsigned* cnt; int* list; float* gatev; float* rsl; float* xout; unsigned char* x8; const bf16_t* y2; const unsigned char* yflag; };
DEVI void unpack8(const u32x4 w, float* v) { v[0] = bflo(w.x); v[1] = bfhi(w.x); v[2] = bflo(w.y); v[3] = bfhi(w.y); v[4] = bflo(w.z); v[5] = bfhi(w.z); v[6] = bflo(w.w); v[7] = bfhi(w.w); }
template <int YMODE, bool FINAL, bool DT, bool ROUTE>
DEVI void ph_norm2(const NormB& A, int vb0, int vbs, LAS float* wl = nullptr) {
    const int tidq = opq((int)threadIdx.x); const int wid = tidq >> 6, lane = tidq & 63;
    if (DT || ROUTE) {
        constexpr int NJ = DT ? 16 : 8;
        __syncthreads();
        for (int e = tidq; e < DM * NJ / 4; e += NTHR) { const int k = e / (NJ / 4), j4 = (e % (NJ / 4)) * 4;
            const float4 w = DT ? *(const float4*)(A.win + (size_t)k * EVEN_IN + 4096 + j4) : *(const float4*)(A.wr + (size_t)k * 8 + j4);
            wl[(j4 + 0) * DM + k] = w.x; wl[(j4 + 1) * DM + k] = w.y; wl[(j4 + 2) * DM + k] = w.z; wl[(j4 + 3) * DM + k] = w.w; }
        __syncthreads();
    }
    constexpr int R = (DT || ROUTE) ? 2 : 4;
    for (int row0 = (vb0 * 8 + wid) * R; row0 < MT; row0 += vbs * 8 * R) {
        float xv[R][16]; float yv[R][16];
#pragma unroll
        for (int rr = 0; rr < R; ++rr) {
            const size_t ro = (size_t)(row0 + rr) * DM + lane * 8;
            if (YMODE == 0) {
#pragma unroll
                for (int i = 0; i < 2; ++i) { const float4 p0 = *(const float4*)(A.xin + ro + i * 512), p1 = *(const float4*)(A.xin + ro + i * 512 + 4);
                    xv[rr][i * 8 + 0] = p0.x; xv[rr][i * 8 + 1] = p0.y; xv[rr][i * 8 + 2] = p0.z; xv[rr][i * 8 + 3] = p0.w; xv[rr][i * 8 + 4] = p1.x; xv[rr][i * 8 + 5] = p1.y; xv[rr][i * 8 + 6] = p1.z; xv[rr][i * 8 + 7] = p1.w; }
            } else {
#pragma unroll
                for (int i = 0; i < 2; ++i) {
                    unpack8(*(const u32x4*)(A.XB + ro + i * 512), xv[rr] + i * 8);
                    unpack8(*(const u32x4*)(A.y + ro + i * 512), yv[rr] + i * 8);
                    if (YMODE == 2) { float y2[8]; unpack8(*(const u32x4*)(A.y + (size_t)MT * DM + ro + i * 512), y2);
#pragma unroll
                        for (int j = 0; j < 8; ++j) yv[rr][i * 8 + j] += y2[j]; }
                }
            }
        }
        if (YMODE == 2) {
#pragma unroll
            for (int rr = 0; rr < R; ++rr) { const u32x2 fw = *(const u32x2*)(A.yflag + (size_t)(row0 + rr) * 8);
                const unsigned f0 = __builtin_amdgcn_readfirstlane(fw.x), f1 = __builtin_amdgcn_readfirstlane(fw.y);
                if (f0 | f1) { const size_t ro = (size_t)(row0 + rr) * DM + lane * 8;
#pragma unroll
                    for (int sl = 0; sl < 2; ++sl) { const unsigned fs = sl ? f1 : f0;
#pragma unroll
                        for (int i = 0; i < 2; ++i) if ((fs >> (8 * ((lane >> 5) + 2 * i))) & 0xff) { float y2[8]; unpack8(*(const u32x4*)(A.y2 + (size_t)sl * MT * DM + ro + i * 512), y2);
#pragma unroll
                            for (int j = 0; j < 8; ++j) yv[rr][i * 8 + j] += y2[j]; } } } }
        }
        if (YMODE != 0) {
            float gg[16];
#pragma unroll
            for (int i = 0; i < 2; ++i) { const float4 g0 = *(const float4*)(A.gpost + i * 512 + lane * 8), g1 = *(const float4*)(A.gpost + i * 512 + lane * 8 + 4);
                gg[i * 8 + 0] = g0.x; gg[i * 8 + 1] = g0.y; gg[i * 8 + 2] = g0.z; gg[i * 8 + 3] = g0.w; gg[i * 8 + 4] = g1.x; gg[i * 8 + 5] = g1.y; gg[i * 8 + 6] = g1.z; gg[i * 8 + 7] = g1.w; }
            float ss[R];
#pragma unroll
            for (int rr = 0; rr < R; ++rr) { ss[rr] = 0.f;
#pragma unroll
                for (int j = 0; j < 16; ++j) ss[rr] += yv[rr][j] * yv[rr][j]; }
#pragma unroll
            for (int o = 1; o < 64; o <<= 1)
#pragma unroll
                for (int rr = 0; rr < R; ++rr) ss[rr] += __shfl_xor(ss[rr], o);
#pragma unroll
            for (int rr = 0; rr < R; ++rr) { const float r = rsqrtf(ss[rr] * (1.f / DM) + EPS);
#pragma unroll
                for (int j = 0; j < 16; ++j) xv[rr][j] += yv[rr][j] * r * gg[j]; }
        }
        if (FINAL) {
#pragma unroll
            for (int rr = 0; rr < R; ++rr)
#pragma unroll
                for (int i = 0; i < 2; ++i) { float* op = A.xout + (size_t)(row0 + rr) * DM + i * 512 + lane * 8;
                    *(float4*)op = make_float4(xv[rr][i * 8], xv[rr][i * 8 + 1], xv[rr][i * 8 + 2], xv[rr][i * 8 + 3]); *(float4*)(op + 4) = make_float4(xv[rr][i * 8 + 4], xv[rr][i * 8 + 5], xv[rr][i * 8 + 6], xv[rr][i * 8 + 7]); }
        } else {
            float ss[R];
#pragma unroll
            for (int rr = 0; rr < R; ++rr) {
#pragma unroll
                for (int i = 0; i < 2; ++i) { u32x4 o; o.x = pk2(xv[rr][i * 8], xv[rr][i * 8 + 1]); o.y = pk2(xv[rr][i * 8 + 2], xv[rr][i * 8 + 3]); o.z = pk2(xv[rr][i * 8 + 4], xv[rr][i * 8 + 5]); o.w = pk2(xv[rr][i * 8 + 6], xv[rr][i * 8 + 7]);
                    *(u32x4*)(A.XB + (size_t)(row0 + rr) * DM + i * 512 + lane * 8) = o;
                }
                ss[rr] = 0.f;
#pragma unroll
                for (int j = 0; j < 16; ++j) ss[rr] += xv[rr][j] * xv[rr][j];
            }
#pragma unroll
            for (int o = 1; o < 64; o <<= 1)
#pragma unroll
                for (int rr = 0; rr < R; ++rr) ss[rr] += __shfl_xor(ss[rr], o);
            float r2[R];
#pragma unroll
            for (int rr = 0; rr < R; ++rr) { r2[rr] = rsqrtf(ss[rr] * (1.f / DM) + EPS); if (lane == 0) A.rs[row0 + rr] = r2[rr]; }
            if (DT || ROUTE) {
                float gn[16];
#pragma unroll
                for (int i = 0; i < 2; ++i) { const float4 g0 = *(const float4*)(A.gnext + i * 512 + lane * 8), g1 = *(const float4*)(A.gnext + i * 512 + lane * 8 + 4);
                    gn[i * 8 + 0] = g0.x; gn[i * 8 + 1] = g0.y; gn[i * 8 + 2] = g0.z; gn[i * 8 + 3] = g0.w; gn[i * 8 + 4] = g1.x; gn[i * 8 + 5] = g1.y; gn[i * 8 + 6] = g1.z; gn[i * 8 + 7] = g1.w; }
                int re1[R], re2[R], lr1[R], lr2[R]; float rw1[R], rw2[R];
                volatile LAS int* lcnt = (volatile LAS int*)((LAS unsigned char*)wl + 40960);
                if (ROUTE) { __syncthreads(); if (tidq < 8) lcnt[tidq] = 0; __syncthreads(); }
#pragma unroll
                for (int rr = 0; rr < R; ++rr) {
                    const int row = row0 + rr;
                    float hv[16];
#pragma unroll
                    for (int j = 0; j < 16; ++j) hv[j] = (rr == 0 ? xv[0][j] : xv[R - 1][j]) * (rr == 0 ? r2[0] : r2[R - 1]) * gn[j];
                    if (DT) {
                        float pd[16];
#pragma unroll 4
                        for (int j = 0; j < 16; ++j) {
                            float p = 0.f;
#pragma unroll
                            for (int i = 0; i < 2; ++i) { const LAS float* wp = wl + j * DM + i * 512 + lane * 8;
                                const f32x4 w0 = *(const LAS f32x4*)wp, w1 = *(const LAS f32x4*)(wp + 4);
                                p += hv[i * 8 + 0] * w0[0] + hv[i * 8 + 1] * w0[1] + hv[i * 8 + 2] * w0[2] + hv[i * 8 + 3] * w0[3] + hv[i * 8 + 4] * w1[0] + hv[i * 8 + 5] * w1[1] + hv[i * 8 + 6] * w1[2] + hv[i * 8 + 7] * w1[3]; }
                            pd[j] = p;
                        }
                        const float dk = wave_sum16(pd, lane);
                        if ((lane & 3) == 0) A.dtraw[(size_t)row * 16 + (lane >> 2)] = dk;
                    }
                    if (ROUTE) {
                        float pl[8];
#pragma unroll 4
                        for (int e = 0; e < 8; ++e) {
                            float p = 0.f;
#pragma unroll
                            for (int i = 0; i < 2; ++i) { const LAS float* wp = wl + e * DM + i * 512 + lane * 8;
                                const f32x4 w0 = *(const LAS f32x4*)wp, w1 = *(const LAS f32x4*)(wp + 4);
                                p += hv[i * 8 + 0] * w0[0] + hv[i * 8 + 1] * w0[1] + hv[i * 8 + 2] * w0[2] + hv[i * 8 + 3] * w0[3] + hv[i * 8 + 4] * w1[0] + hv[i * 8 + 5] * w1[1] + hv[i * 8 + 6] * w1[2] + hv[i * 8 + 7] * w1[3]; }
                            pl[e] = p;
                        }
                        const float lk = wave_sum8(pl, lane);
                        float lg[8];
#pragma unroll
                        for (int e = 0; e < 8; ++e) lg[e] = __shfl(lk, e * 8);
                        int e1 = 0; float v1 = lg[0];
#pragma unroll
                        for (int e = 1; e < 8; ++e) if (lg[e] > v1) { v1 = lg[e]; e1 = e; }
                        int e2 = 0; float v2 = -3.0e38f;
#pragma unroll
                        for (int e = 0; e < 8; ++e) if (e != e1 && lg[e] > v2) { v2 = lg[e]; e2 = e; }
                        const float ex = __expf(v2 - v1);
                        re1[rr] = e1; re2[rr] = e2; rw1[rr] = 1.f / (1.f + ex); rw2[rr] = ex / (1.f + ex);
                        if (lane == 0) { lr1[rr] = __hip_atomic_fetch_add((LAS int*)lcnt + e1, 1, __ATOMIC_RELAXED, __HIP_MEMORY_SCOPE_WORKGROUP); lr2[rr] = __hip_atomic_fetch_add((LAS int*)lcnt + e2, 1, __ATOMIC_RELAXED, __HIP_MEMORY_SCOPE_WORKGROUP); }
                    }
                }
                if (ROUTE) {
                    __syncthreads();
                    if (tidq < 8) lcnt[8 + tidq] = (int)atomicAdd(&A.cnt[tidq * 64], (unsigned)lcnt[tidq]);
                    __syncthreads();
#pragma unroll
                    for (int rr = 0; rr < R; ++rr) {
                        const int row = row0 + rr;
                        int dst1 = 0, dst2 = 0;
                        if (lane == 0) {
                            const int e1 = re1[rr], e2 = re2[rr];
                            const int p1 = lcnt[8 + e1] + lr1[rr], p2 = lcnt[8 + e2] + lr2[rr];
                            A.list[e1 * MT + p1] = row * 2; A.gatev[e1 * MT + p1] = rw1[rr]; A.rsl[e1 * MT + p1] = r2[rr];
                            A.list[e2 * MT + p2] = row * 2 + 1; A.gatev[e2 * MT + p2] = rw2[rr]; A.rsl[e2 * MT + p2] = r2[rr];
                            dst1 = e1 * MT + p1; dst2 = e2 * MT + p2;
                        }
                        dst1 = __builtin_amdgcn_readfirstlane(dst1); dst2 = __builtin_amdgcn_readfirstlane(dst2);
#pragma unroll
                        for (int i = 0; i < 2; ++i) { u32x2 o8;
                            const float* xs = xv[rr] + i * 8;
                            o8.x = pg8_pk4(xs[0], xs[1], xs[2], xs[3]); o8.y = pg8_pk4(xs[4], xs[5], xs[6], xs[7]);
                            *(u32x2*)(A.x8 + (size_t)dst1 * DM + i * 512 + lane * 8) = o8; *(u32x2*)(A.x8 + (size_t)dst2 * DM + i * 512 + lane * 8) = o8; }
                    }
                }
            }
        }
    }
}

constexpr int DTW_LD = (DM + 8) * 2;
DEVI void ph_norm0_dt(const NormB& A, int vb0, int vbs, LAS unsigned char* lds) {
    const int tidq = opq((int)threadIdx.x); const int wid = tidq >> 6, lane = tidq & 63, fr = lane & 15, fq = lane >> 4;
    __syncthreads();
    for (int e = tidq; e < DM * 4; e += NTHR) { const int k = e >> 2, j4 = (e & 3) * 4;
        const float4 w = *(const float4*)(A.win + (size_t)k * EVEN_IN + 4096 + j4); const float g = A.gnext[k];
        const float wv[4] = {w.x * g, w.y * g, w.z * g, w.w * g};
#pragma unroll
        for (int i = 0; i < 4; ++i) { const unsigned short hi = f2bf(wv[i]); const unsigned short lo = f2bf(wv[i] - bf2f(hi));
            *(LAS unsigned short*)(lds + (j4 + i) * DTW_LD + k * 2) = hi; *(LAS unsigned short*)(lds + (16 + j4 + i) * DTW_LD + k * 2) = lo; } }
    __syncthreads();
    for (int row0 = (vb0 * 8 + wid) * 8; row0 < MT; row0 += vbs * 64) {
        const int row = row0 + (fr & 7);
        const float* xp = A.xin + (size_t)row * DM + fq * 8;
        bf16_t* xbp = A.XB + (size_t)row * DM + fq * 8;
        const LAS unsigned char* wp = lds + fr * DTW_LD + fq * 16;
        f32x4 acc = {0.f, 0.f, 0.f, 0.f}; float ss = 0.f;
        float4 cu[8][2], nx[8][2];
#pragma unroll
        for (int s2 = 0; s2 < 8; ++s2) { cu[s2][0] = *(const float4*)(xp + s2 * 32); cu[s2][1] = *(const float4*)(xp + s2 * 32 + 4); }
#pragma unroll 1
        for (int c = 0; c < 4; ++c) {
            if (c < 3) {
#pragma unroll
                for (int s2 = 0; s2 < 8; ++s2) { nx[s2][0] = *(const float4*)(xp + (c + 1) * 256 + s2 * 32); nx[s2][1] = *(const float4*)(xp + (c + 1) * 256 + s2 * 32 + 4); } }
#pragma unroll
            for (int s2 = 0; s2 < 8; ++s2) { const int kk = c * 8 + s2;
                const float v[8] = {cu[s2][0].x, cu[s2][0].y, cu[s2][0].z, cu[s2][0].w, cu[s2][1].x, cu[s2][1].y, cu[s2][1].z, cu[s2][1].w};
                u32x4 hw, lw;
                hw.x = cvt2bf(v[0], v[1]); hw.y = cvt2bf(v[2], v[3]); hw.z = cvt2bf(v[4], v[5]); hw.w = cvt2bf(v[6], v[7]);
                lw.x = cvt2bf(v[0] - bflo(hw.x), v[1] - bfhi(hw.x)); lw.y = cvt2bf(v[2] - bflo(hw.y), v[3] - bfhi(hw.y)); lw.z = cvt2bf(v[4] - bflo(hw.z), v[5] - bfhi(hw.z)); lw.w = cvt2bf(v[6] - bflo(hw.w), v[7] - bfhi(hw.w));
#pragma unroll
                for (int i = 0; i < 8; ++i) ss += v[i] * v[i];
                if (fr < 8) *(u32x4*)(xbp + kk * 32) = hw;
                const bf16x8 xh = __builtin_bit_cast(bf16x8, hw), xl = __builtin_bit_cast(bf16x8, lw);
                const bf16x8 wh = *(const LAS bf16x8*)(wp + kk * 64), wl = *(const LAS bf16x8*)(wp + 16 * DTW_LD + kk * 64);
                acc = __builtin_amdgcn_mfma_f32_16x16x32_bf16(xh, wh, acc, 0, 0, 0);
                acc = __builtin_amdgcn_mfma_f32_16x16x32_bf16(xl, wh, acc, 0, 0, 0);
                acc = __builtin_amdgcn_mfma_f32_16x16x32_bf16(xh, wl, acc, 0, 0, 0); }
#pragma unroll
            for (int s2 = 0; s2 < 8; ++s2) { cu[s2][0] = nx[s2][0]; cu[s2][1] = nx[s2][1]; }
        }
        ss += __shfl_xor(ss, 16); ss += __shfl_xor(ss, 32);
        const float r = rsqrtf(ss * (1.f / DM) + EPS);
        if (lane < 8) A.rs[row0 + lane] = r;
#pragma unroll
        for (int v = 0; v < 4; ++v) { const float rm = __shfl(r, (4 * fq + v) & 7);
            if (fq < 2) A.dtraw[(size_t)(row0 + 4 * fq + v) * 16 + fr] = acc[v] * rm; }
    }
}
DEVI void transpose_item(const float* W, int ldw, int K, int k0, int n0, bf16_t* WT, int drow0, LAS float* scr, int lane, const float* gain) {
    {
        const int ka = lane >> 3, n4 = (lane & 7) * 4;
        float4 wv[8];
#pragma unroll
        for (int i = 0; i < 8; ++i) wv[i] = *(const float4*)(W + (size_t)(k0 + i * 8 + ka) * ldw + n0 + n4);
#pragma unroll
        for (int i = 0; i < 8; ++i) { LAS float* d = scr + (i * 8 + ka) * 33 + n4; d[0] = wv[i].x; d[1] = wv[i].y; d[2] = wv[i].z; d[3] = wv[i].w; }
    }
    asm volatile("s_waitcnt lgkmcnt(0)" ::: "memory");
    const int c = lane & 7;
    float4 ga = make_float4(1.f, 1.f, 1.f, 1.f), gb = ga;
    if (gain) { ga = *(const float4*)(gain + k0 + 8 * c); gb = *(const float4*)(gain + k0 + 8 * c + 4); }
#pragma unroll
    for (int j = 0; j < 4; ++j) { const int n = (lane >> 3) + 8 * j; const LAS float* sp = scr + (8 * c) * 33 + n;
        u32x4 o; o.x = pk2(sp[0 * 33] * ga.x, sp[1 * 33] * ga.y); o.y = pk2(sp[2 * 33] * ga.z, sp[3 * 33] * ga.w); o.z = pk2(sp[4 * 33] * gb.x, sp[5 * 33] * gb.y); o.w = pk2(sp[6 * 33] * gb.z, sp[7 * 33] * gb.w);
        *(u32x4*)(WT + (size_t)(drow0 + n) * K + k0 + 8 * c) = o; }
    asm volatile("s_waitcnt lgkmcnt(0)" ::: "memory");
}
DEVI void transpose_item_fp8(const float* W, int ldw, int K, int k0, int n0, unsigned char* WT8, int drow0, LAS float* scr, int lane, const float* gain) {
    {
        const int ka = lane >> 3, n4 = (lane & 7) * 4;
        float4 wv[8];
#pragma unroll
        for (int i = 0; i < 8; ++i) wv[i] = *(const float4*)(W + (size_t)(k0 + i * 8 + ka) * ldw + n0 + n4);
#pragma unroll
        for (int i = 0; i < 8; ++i) { LAS float* d = scr + (i * 8 + ka) * 33 + n4; d[0] = wv[i].x; d[1] = wv[i].y; d[2] = wv[i].z; d[3] = wv[i].w; }
    }
    asm volatile("s_waitcnt lgkmcnt(0)" ::: "memory");
    const int c = lane & 7;
    float4 ga = make_float4(64.f, 64.f, 64.f, 64.f), gb = ga;
    if (gain) { ga = *(const float4*)(gain + k0 + 8 * c); gb = *(const float4*)(gain + k0 + 8 * c + 4); ga.x *= 64.f; ga.y *= 64.f; ga.z *= 64.f; ga.w *= 64.f; gb.x *= 64.f; gb.y *= 64.f; gb.z *= 64.f; gb.w *= 64.f; }
#pragma unroll
    for (int j = 0; j < 4; ++j) { const int n = (lane >> 3) + 8 * j; const LAS float* sp = scr + (8 * c) * 33 + n;
        u32x2 o; o.x = pg8_pk4(sp[0 * 33] * ga.x, sp[1 * 33] * ga.y, sp[2 * 33] * ga.z, sp[3 * 33] * ga.w); o.y = pg8_pk4(sp[4 * 33] * gb.x, sp[5 * 33] * gb.y, sp[6 * 33] * gb.z, sp[7 * 33] * gb.w);
        *(u32x2*)(WT8 + (size_t)(drow0 + n) * K + k0 + 8 * c) = o; }
    asm volatile("s_waitcnt lgkmcnt(0)" ::: "memory");
}
struct Job { int in_idx; unsigned src_off; int ldw; int K; int ncols; unsigned long long dst; int mode; int item0; int gain_idx; int gain_off; int fp8; };
constexpr int NJOBS = 11 + 24;
struct JobTable { Job j[NJOBS]; int total; };
constexpr JobTable make_jobs() {
    JobTable t{}; int n = 0, it = 0;
    auto add = [&](int idx, unsigned off, int ldw, int K, int ncols, unsigned long long dst, int mode, int gi, int go, int f8 = 0) { t.j[n] = Job{idx, off, ldw, K, ncols, dst, mode, it, gi, go, f8}; it += (K / 64) * (ncols / 32); ++n; };
    add(4, 0, EVEN_IN, DM, UW, W_IN, 0, 3, 0);
    add(12, 0, DM, DM, DM, W_OUTE, 0, -1, 0);
    add(15, 0, DFF, DM, DFF, W_GU, 1, 14, 0);
    add(16, 0, DFF, DM, DFF, W_GU, 2, 14, 0);
    add(17, 0, DM, DFF, DM, W_DN, 0, -1, 0);
    add(31, 0, DM, DM, DM, W_PG, 0, 30, 0);
    add(31, DM * DM, DM, DM, DM, W_PG + 2 * MiB, 0, 30, DM);
    add(32, 0, DM, PDIM, DM, W_PP, 0, -1, 0);
    add(32, PDIM * DM, DM, PDIM, DM, W_PP + 512 * 1024, 0, -1, 0);
    add(20, 0, 3072, DM, 3072, W_QKV, 0, 19, 0);
    add(22, 0, DM, DM, DM, W_OUTO, 0, -1, 0);
    for (int e = 0; e < NEXP; ++e) {
        add(26, (unsigned)e * DM * DFFE, DFFE, DM, DFFE, W_EGU + (unsigned long long)e * 7 * MiB, 1, 24, 0, 1);
        add(27, (unsigned)e * DM * DFFE, DFFE, DM, DFFE, W_EGU + (unsigned long long)e * 7 * MiB, 2, 24, 0, 1);
        add(28, (unsigned)e * DFFE * DM, DM, DFFE, DM, W_EDN + (unsigned long long)e * (7 * MiB / 2), 0, -1, 0, 1);
    }
    t.total = it; return t;
}
__device__ const JobTable g_jobs = make_jobs();
constexpr int ITEMS_DENSE = make_jobs().j[11].item0, ITEMS_ALL = make_jobs().total;
struct CvtIt { const float* src; unsigned char* dst; const float* gp; int ldw, K, k0, n0, drow0; };
DEVI void cvt_decode(CvtIt& c, int it, int& jb, const float* const* in, unsigned char* ws) {
    while (jb + 1 < NJOBS && g_jobs.j[jb + 1].item0 <= it) ++jb;
    const Job J = g_jobs.j[jb];
    const int r = it - J.item0; const int nblk = J.ncols / 32; const int kb = r / nblk, nb = r % nblk;
    const int n0 = nb * 32; int drow0 = n0;
    if (J.mode != 0) drow0 = (n0 >> 7) * 256 + (n0 & 127) + (J.mode == 2 ? 128 : 0);
    c.src = in[J.in_idx] + J.src_off; c.dst = ws + J.dst; c.gp = J.gain_idx >= 0 ? in[J.gain_idx] + J.gain_off : nullptr; c.ldw = J.ldw; c.K = J.K; c.k0 = kb * 64; c.n0 = n0; c.drow0 = drow0;
}
DEVI void fp8_item_load(float4 (&wv)[8], float4& ga, float4& gb, const CvtIt& c, int lane) {
    const int ka = lane >> 3, n4 = (lane & 7) * 4;
    ga = make_float4(1.f, 1.f, 1.f, 1.f); gb = ga;
    if (c.gp) { ga = *(const float4*)(c.gp + c.k0 + 8 * (lane & 7)); gb = *(const float4*)(c.gp + c.k0 + 8 * (lane & 7) + 4); }
#pragma unroll
    for (int i = 0; i < 8; ++i) wv[i] = *(const float4*)(c.src + (size_t)(c.k0 + i * 8 + ka) * c.ldw + c.n0 + n4);
}
DEVI void fp8_item_finish(const float4 (&wv)[8], float4 ga, float4 gb, const CvtIt& c, LAS float* scr, int lane) {
    { const int ka = lane >> 3, n4 = (lane & 7) * 4;
#pragma unroll
        for (int i = 0; i < 8; ++i) { LAS float* d = scr + (i * 8 + ka) * 33 + n4; d[0] = wv[i].x; d[1] = wv[i].y; d[2] = wv[i].z; d[3] = wv[i].w; } }
    asm volatile("s_waitcnt lgkmcnt(0)" ::: "memory");
    const int cc = lane & 7;
    ga.x *= 64.f; ga.y *= 64.f; ga.z *= 64.f; ga.w *= 64.f; gb.x *= 64.f; gb.y *= 64.f; gb.z *= 64.f; gb.w *= 64.f;
#pragma unroll
    for (int j = 0; j < 4; ++j) { const int n = (lane >> 3) + 8 * j; const LAS float* sp = scr + (8 * cc) * 33 + n;
        u32x2 o; o.x = pg8_pk4(sp[0 * 33] * ga.x, sp[1 * 33] * ga.y, sp[2 * 33] * ga.z, sp[3 * 33] * ga.w); o.y = pg8_pk4(sp[4 * 33] * gb.x, sp[5 * 33] * gb.y, sp[6 * 33] * gb.z, sp[7 * 33] * gb.w);
        *(u32x2*)(c.dst + (size_t)(c.drow0 + n) * c.K + c.k0 + 8 * cc) = o; }
    asm volatile("s_waitcnt lgkmcnt(0)" ::: "memory");
}
DEVI void ph_convert_experts(LAS unsigned char* lds, const float* const* in, unsigned char* ws, int it_lo, int it_hi, int vb0, int vbs) {
    const int tidq = opq((int)threadIdx.x); const int wid = __builtin_amdgcn_readfirstlane(tidq >> 6), lane = tidq & 63;
    LAS float* scr = (LAS float*)(lds + wid * 16384);
    int jb = 11; int it = it_lo + vb0 * 8 + wid; if (it >= it_hi) return;
    CvtIt cur, nxt; float4 wc[8], wn[8], gca, gcb, gna, gnb;
    cvt_decode(cur, it, jb, in, ws); fp8_item_load(wc, gca, gcb, cur, lane);
    for (;;) {
        const int itn = it + vbs * 8; const bool hn = itn < it_hi;
        if (hn) { cvt_decode(nxt, itn, jb, in, ws); fp8_item_load(wn, gna, gnb, nxt, lane); }
        fp8_item_finish(wc, gca, gcb, cur, scr, lane);
        if (!hn) break;
        cur = nxt; it = itn; gca = gna; gcb = gnb;
#pragma unroll
        for (int i = 0; i < 8; ++i) wc[i] = wn[i];
    }
}
DEVI void ph_convert_weights(LAS unsigned char* lds, const float* const* in, unsigned char* ws, int it_lo, int it_hi, int vb0, int vbs) {
    const int tidq = opq((int)threadIdx.x); const int wid = __builtin_amdgcn_readfirstlane(tidq >> 6), lane = tidq & 63;
    LAS float* scr = (LAS float*)(lds + wid * 16384);
    int jb = 0;
    for (int it = it_lo + vb0 * 8 + wid; it < it_hi; it += vbs * 8) {
        while (jb + 1 < NJOBS && g_jobs.j[jb + 1].item0 <= it) ++jb;
        const Job J = g_jobs.j[jb];
        const int r = it - J.item0; const int nblk = J.ncols / 32; const int kb = r / nblk, nb = r % nblk;
        const int n0 = nb * 32; int drow0 = n0;
        if (J.mode != 0) drow0 = (n0 >> 7) * 256 + (n0 & 127) + (J.mode == 2 ? 128 : 0);
        const float* gp = J.gain_idx >= 0 ? in[J.gain_idx] + J.gain_off : nullptr;
        if (J.fp8) transpose_item_fp8(in[J.in_idx] + J.src_off, J.ldw, J.K, kb * 64, n0, ws + J.dst, drow0, scr, lane, gp);
        else transpose_item(in[J.in_idx] + J.src_off, J.ldw, J.K, kb * 64, n0, (bf16_t*)(ws + J.dst), drow0, scr, lane, gp);
    }
}
DEVI void ph_cvt_rows(const float* src, bf16_t* dst, size_t n4, int vb0, int vbs) {
    for (size_t e = (size_t)vb0 * NTHR + opq((int)threadIdx.x); e < n4; e += (size_t)vbs * NTHR) {
        const float4 v = ((const float4*)src)[e]; u32x2 o; o.x = pk2(v.x, v.y); o.y = pk2(v.z, v.w); ((u32x2*)dst)[e] = o; }
}

namespace pg8 {
constexpr int BM = 256, BK = 64, HALF = 128, HTB = HALF * BK * 2, STAGE_BYTES = 8 * HTB, NXCD = 8, WGM = 8;
__host__ __device__ __forceinline__ int lds_byte(int r, int c) { const int st = (r >> 4) * 2 + (c >> 5), rr = r & 15, cc = c & 31, ob = rr * 64 + cc * 2; return st * 1024 + (ob ^ (((ob >> 9) & 1) << 5)); }
__host__ __device__ __forceinline__ void stage_rc(int b, int& R, int& C) { const int st = b / 1024, sb = b % 1024, swz = sb ^ (((sb >> 9) & 1) << 5); R = (st >> 1) * 16 + swz / 64; C = (st & 1) * 32 + (swz % 64) / 2; }
__host__ __device__ __forceinline__ int perm32(int rho) { const int n = rho >> 4, i = rho & 15; return 8 * (i >> 2) + 4 * n + (i & 3); }
struct Unit { int pm, pn; int row0; int arow0; int mvalid; int e; int mbase; int akoff; const char* B; };
DEVI void xcd_tile(int L, int nwg, int nM, int nN, int& pm, int& pn) {
    int wgid = L; { const int q = nwg / NXCD, r = nwg % NXCD, xcd = wgid % NXCD, off = wgid / NXCD; wgid = (xcd < r ? xcd * (q + 1) : r * (q + 1) + (xcd - r) * q) + off; }
    const int nig = WGM * nN, gid = wgid / nig, fm = gid * WGM, gsz = (nM - fm) < WGM ? (nM - fm) : WGM;
    pm = fm + ((wgid % nig) % gsz); pn = (wgid % nig) / gsz;
}
struct DenseOrder {
    int nM, nN, nwg, G, c; const char* Bt; size_t tstepB;
    DEVI void init(int M, int N, int K, const bf16_t* Bt_, int G_, int c_) { nM = M / BM; nN = N / BM; nwg = nM * nN; G = G_; c = c_; Bt = (const char*)Bt_; tstepB = (size_t)BM * K * 2; }
    DEVI bool next(int i, Unit& u) const { const long L = (long)i * G + c; if (L >= nwg) return false; xcd_tile((int)L, nwg, nM, nN, u.pm, u.pn); u.row0 = u.pm * BM; u.arow0 = u.row0; u.mvalid = BM; u.e = 0; u.mbase = 0; u.akoff = 0; u.B = Bt + (size_t)u.pn * tstepB; return true; }
};
struct TailOrder {
    int nM, nN, nwg, nb, r; const char* Bt; size_t tstepB;
    DEVI void init(int M, int N, int K, const bf16_t* Bt_, int G_, int c_, int first) { nM = M / BM; nN = N / BM; nwg = nM * nN; Bt = (const char*)Bt_; tstepB = (size_t)BM * K * 2;
        if (first >= G_) first = 0; nb = G_ - first; r = c_ - first; }
    DEVI bool next(int i, Unit& u) const { if (r < 0) return false; const long L = (long)i * nb + r; if (L >= nwg) return false; u.pm = (int)L / nN; u.pn = (int)L % nN; u.row0 = u.pm * BM; u.arow0 = u.row0; u.mvalid = BM; u.e = 0; u.mbase = 0; u.akoff = 0; u.B = Bt + (size_t)u.pn * tstepB; return true; }
};
struct MoeOrder {
    int nM, nN, nwg, G, c; const char* Bt; size_t estepB, tstepB; const volatile LAS int* tab; bool per_expert;
    DEVI void init(const unsigned* cnt, volatile LAS int* tab_, int N, int K, const bf16_t* Bt_, size_t estep_bytes, bool per_expert_, int G_, int c_) {
        __syncthreads();
        if (threadIdx.x < 8) tab_[16 + threadIdx.x] = (int)__hip_atomic_load(cnt + threadIdx.x * 64, __ATOMIC_RELAXED, __HIP_MEMORY_SCOPE_AGENT);
        __syncthreads();
        if (threadIdx.x == 0) { int t = 0;
            for (int e = 0; e < 8; ++e) { const int n = tab_[16 + e]; tab_[e] = t; t += (n + BM - 1) / BM; }
            tab_[8] = t; }
        __syncthreads();
        tab = tab_; nM = __builtin_amdgcn_readfirstlane(tab_[8]); nN = N / BM; nwg = nM * nN; G = G_; c = c_; Bt = (const char*)Bt_; estepB = estep_bytes; tstepB = (size_t)BM * K * 2; per_expert = per_expert_; nmain = nwg; split_phase = false; khalfB = 0;
    }
    int nmain; bool split_phase; int khalfB;
    DEVI void set_split(bool ksplit, bool phase2, int khalf_bytes) { const int r = nwg % G; const bool can = ksplit && r > 0 && 2 * r <= G; nmain = can ? nwg - r : nwg; split_phase = phase2; khalfB = khalf_bytes; }
    DEVI int tail_first() const { return nmain == nwg ? nwg % G : 2 * (nwg - nmain); }
    DEVI bool next(int i, Unit& u) const {
        long L; int kh = 0;
        if (!split_phase) { L = (long)i * G + c; if (L >= nmain) return false; }
        else { if (i > 0 || c >= 2 * (nwg - nmain)) return false; L = nmain + (c >> 1); kh = c & 1; }
        xcd_tile((int)L, nwg, nM, nN, u.pm, u.pn);
        int e = 0;
        for (int k = 1; k < 8; ++k) if (u.pm >= __builtin_amdgcn_readfirstlane(tab[k])) e = k;
        const int t0 = __builtin_amdgcn_readfirstlane(tab[e]), n = __builtin_amdgcn_readfirstlane(tab[16 + e]);
        u.e = e; u.row0 = u.pm * BM; const int m0 = (u.pm - t0) * BM; u.mbase = m0; u.arow0 = per_expert ? e * MT + m0 : u.row0; u.mvalid = (n - m0) < BM ? (n - m0) : BM;
        u.akoff = kh * khalfB; u.B = Bt + (size_t)e * estepB + (size_t)u.pn * tstepB + u.akoff; return true; }
};
DEVI unsigned cvt_pk_bf16(float lo, float hi) { return cvt2bf(lo, hi); }

constexpr int EPI_OFF = MISC_OFF + 1024, EPI_SLICE = 1024;
static_assert(EPI_OFF + 8 * EPI_SLICE <= LDS_BYTES, "epilogue scalar slices");
DEVI void epi_dma(const void* g, LAS unsigned char* dst) { __builtin_amdgcn_global_load_lds((const unsigned*)g, (LAS unsigned*)dst, 4, 0, 0); }
struct EpiBf16 { static constexpr bool PERM = true; bf16_t* O; int ldc; const float* rs;
    DEVI void pre(LAS unsigned char* esl, const Unit& u, int wr, int lane) const {
        if (rs) { epi_dma(rs + u.row0 + wr * 64 + lane, esl); epi_dma(rs + u.row0 + wr * 64 + HALF + lane, esl + 256); } }
    DEVI void operator()(const f32x4 (&acc)[2][2][4][2], const Unit& u, int wr, int wc, int fr, int fq, const LAS unsigned char* esl) const {
        float pv[8];
#pragma unroll
        for (int q = 0; q < 8; ++q) pv[q] = ((const LAS float*)esl)[(q >> 2) * 64 + (q & 3) * 16 + fr];
        const int row0 = u.row0 + wr * 64 + fr, col0 = u.pn * BM + wc * 32 + 8 * fq;
#pragma unroll
        for (int ai = 0; ai < 2; ++ai)
#pragma unroll
            for (int m = 0; m < 4; ++m) { const int row = row0 + ai * HALF + m * 16; bf16_t* rowp = O + (size_t)row * ldc + col0;
                const float sc = rs ? pv[ai * 4 + m] : 1.f;
#pragma unroll
                for (int bj = 0; bj < 2; ++bj) { const f32x4 v0 = acc[ai][bj][m][0] * sc, v1 = acc[ai][bj][m][1] * sc;
                    u32x4 w; w.x = cvt_pk_bf16(v0[0], v0[1]); w.y = cvt_pk_bf16(v0[2], v0[3]); w.z = cvt_pk_bf16(v1[0], v1[1]); w.w = cvt_pk_bf16(v1[2], v1[3]);
                    *(u32x4*)(rowp + bj * HALF) = w; } }
    } };
struct EpiPleGate { static constexpr bool PERM = true; bf16_t* T; int ldc; const float* rs;
    DEVI void pre(LAS unsigned char* esl, const Unit& u, int wr, int lane) const {
        epi_dma(rs + u.row0 + wr * 64 + lane, esl); epi_dma(rs + u.row0 + wr * 64 + HALF + lane, esl + 256); }
    DEVI void operator()(const f32x4 (&acc)[2][2][4][2], const Unit& u, int wr, int wc, int fr, int fq, const LAS unsigned char* esl) const {
        float pv[8];
#pragma unroll
        for (int q = 0; q < 8; ++q) pv[q] = ((const LAS float*)esl)[(q >> 2) * 64 + (q & 3) * 16 + fr];
        const int row0 = u.row0 + wr * 64 + fr, col0 = u.pn * BM + wc * 32 + 8 * fq;
#pragma unroll
        for (int ai = 0; ai < 2; ++ai)
#pragma unroll
            for (int m = 0; m < 4; ++m) { const int row = row0 + ai * HALF + m * 16; bf16_t* rowp = T + (size_t)row * ldc + col0;
                const float sc = pv[ai * 4 + m];
#pragma unroll
                for (int bj = 0; bj < 2; ++bj) { const f32x4 v0 = acc[ai][bj][m][0] * sc, v1 = acc[ai][bj][m][1] * sc;
                    const u32x4 pp = *(const u32x4*)(rowp + bj * HALF);
                    u32x4 w; w.x = cvt_pk_bf16(sigmoid_f(v0[0]) * bflo(pp.x), sigmoid_f(v0[1]) * bfhi(pp.x)); w.y = cvt_pk_bf16(sigmoid_f(v0[2]) * bflo(pp.y), sigmoid_f(v0[3]) * bfhi(pp.y));
                    w.z = cvt_pk_bf16(sigmoid_f(v1[0]) * bflo(pp.z), sigmoid_f(v1[1]) * bfhi(pp.z)); w.w = cvt_pk_bf16(sigmoid_f(v1[2]) * bflo(pp.w), sigmoid_f(v1[3]) * bfhi(pp.w));
                    *(u32x4*)(rowp + bj * HALF) = w; } }
    } };
DEVI f32x4 swiglu4(const f32x4 ag, const f32x4 au, const float tneg, const float k2) {
    const f32x4 t = ag * tneg; f32x4 d;
    d[0] = __builtin_amdgcn_exp2f(t[0]); d[1] = __builtin_amdgcn_exp2f(t[1]); d[2] = __builtin_amdgcn_exp2f(t[2]); d[3] = __builtin_amdgcn_exp2f(t[3]);
    d = d + 1.0f; f32x4 rc;
    rc[0] = __builtin_amdgcn_rcpf(d[0]); rc[1] = __builtin_amdgcn_rcpf(d[1]); rc[2] = __builtin_amdgcn_rcpf(d[2]); rc[3] = __builtin_amdgcn_rcpf(d[3]);
    return (ag * au) * (rc * k2);
}
struct EpiSwiglu { static constexpr bool PERM = true; bf16_t* O; int ldc; const float* rs; int grouped;
    DEVI void pre(LAS unsigned char* esl, const Unit& u, int wr, int lane) const {
        const float* rsb = grouped ? rs + u.e * MT + u.mbase : rs + u.row0; const int vm1 = (grouped ? u.mvalid : BM) - 1;
#pragma unroll
        for (int i = 0; i < 2; ++i) { const int rl = wr * 64 + lane + i * HALF; epi_dma(rsb + (rl <= vm1 ? rl : vm1), esl + i * 256); } }
    DEVI void operator()(const f32x4 (&acc)[2][2][4][2], const Unit& u, int wr, int wc, int fr, int fq, const LAS unsigned char* esl) const {
        float pv[8];
#pragma unroll
        for (int q = 0; q < 8; ++q) pv[q] = ((const LAS float*)esl)[(q >> 2) * 64 + (q & 3) * 16 + fr];
        const int row0 = u.row0 + wr * 64 + fr, col0 = u.pn * HALF + wc * 32 + 8 * fq; const int vm1e = (grouped ? u.mvalid : BM) - 1;
#pragma unroll
        for (int ai = 0; ai < 2; ++ai)
#pragma unroll
            for (int m = 0; m < 4; ++m) { const int rl = wr * 64 + fr + ai * HALF + m * 16; bf16_t* rowp = O + (size_t)(u.row0 + rl) * ldc + col0;
                const float sc = rl <= vm1e ? pv[ai * 4 + m] : 0.f;
                const f32x4 o0 = swiglu4(acc[ai][0][m][0], acc[ai][1][m][0], sc * -1.44269504f, sc * sc), o1 = swiglu4(acc[ai][0][m][1], acc[ai][1][m][1], sc * -1.44269504f, sc * sc);
                u32x4 w; w.x = cvt_pk_bf16(o0[0], o0[1]); w.y = cvt_pk_bf16(o0[2], o0[3]); w.z = cvt_pk_bf16(o1[0], o1[1]); w.w = cvt_pk_bf16(o1[2], o1[3]);
                *(u32x4*)rowp = w; }
    } };
constexpr float W8_SCALE = 64.f, ACT8_SCALE = 8.f;
struct EpiSwiglu8 { static constexpr bool PERM = true; unsigned char* O; int ldc; const float* rs;
    DEVI void pre(LAS unsigned char* esl, const Unit& u, int wr, int lane) const {
        const float* rsb = rs + u.e * MT + u.mbase; const int vm1 = u.mvalid - 1;
#pragma unroll
        for (int i = 0; i < 2; ++i) { const int rl = wr * 64 + lane + i * HALF; epi_dma(rsb + (rl <= vm1 ? rl : vm1), esl + i * 256); } }
    DEVI void operator()(const f32x4 (&acc)[2][2][4][2], const Unit& u, int wr, int wc, int fr, int fq, const LAS unsigned char* esl) const {
        float pv[8];
#pragma unroll
        for (int q = 0; q < 8; ++q) pv[q] = ((const LAS float*)esl)[(q >> 2) * 64 + (q & 3) * 16 + fr];
        const int col0 = u.pn * HALF + wc * 32 + 8 * fq;
#pragma unroll
        for (int ai = 0; ai < 2; ++ai)
#pragma unroll
            for (int m = 0; m < 4; ++m) { const int rl = wr * 64 + fr + ai * HALF + m * 16; unsigned char* rowp = O + (size_t)(u.row0 + rl) * ldc + col0;
                const float sc = rl < u.mvalid ? pv[ai * 4 + m] * (1.f / W8_SCALE) : 0.f;
                const f32x4 o0 = swiglu4(acc[ai][0][m][0], acc[ai][1][m][0], sc * -1.44269504f, sc * sc * ACT8_SCALE), o1 = swiglu4(acc[ai][0][m][1], acc[ai][1][m][1], sc * -1.44269504f, sc * sc * ACT8_SCALE);
                u32x2 w; w.x = pg8_pk4(o0[0], o0[1], o0[2], o0[3]); w.y = pg8_pk4(o1[0], o1[1], o1[2], o1[3]);
                *(u32x2*)rowp = w; }
    } };
struct EpiMoeDown { static constexpr bool PERM = true; bf16_t* Y; const int* list; const float* gatev; float oscale; size_t y2off; unsigned char* flag;
    DEVI void pre(LAS unsigned char* esl, const Unit& u, int wr, int lane) const {
        const int* lb = list + u.e * MT + u.mbase; const float* gb = gatev + u.e * MT + u.mbase; const int vm1 = u.mvalid - 1;
#pragma unroll
        for (int i = 0; i < 2; ++i) { const int rl = wr * 64 + lane + i * HALF; const int ri = rl <= vm1 ? rl : vm1; epi_dma(gb + ri, esl + i * 256); epi_dma(lb + ri, esl + 512 + i * 256); } }
    DEVI void operator()(const f32x4 (&acc)[2][2][4][2], const Unit& u, int wr, int wc, int fr, int fq, const LAS unsigned char* esl) const {
        float pv[8]; int pt[8];
#pragma unroll
        for (int q = 0; q < 8; ++q) { pv[q] = ((const LAS float*)esl)[(q >> 2) * 64 + (q & 3) * 16 + fr]; pt[q] = ((const LAS int*)(esl + 512))[(q >> 2) * 64 + (q & 3) * 16 + fr]; }
        const int col0 = u.pn * BM + wc * 32 + 8 * fq;
        const bool second = u.akoff != 0; bf16_t* const Yb = Y + (second ? y2off : (size_t)0);
#pragma unroll
        for (int ai = 0; ai < 2; ++ai)
#pragma unroll
            for (int m = 0; m < 4; ++m) { const int rl = wr * 64 + fr + ai * HALF + m * 16;
                const int tsl = pt[ai * 4 + m]; const float gt = pv[ai * 4 + m] * oscale;
                if (rl < u.mvalid) {
                    bf16_t* rowp = Yb + (size_t)(tsl & 1) * ((size_t)MT * DM) + (size_t)(tsl >> 1) * DM + col0;
                    if (second && wc == 0 && fq == 0) flag[tsl * 4 + u.pn] = 1;
#pragma unroll
                    for (int bj = 0; bj < 2; ++bj) { const f32x4 v0 = acc[ai][bj][m][0], v1 = acc[ai][bj][m][1];
                        u32x4 w; w.x = cvt_pk_bf16(v0[0] * gt, v0[1] * gt); w.y = cvt_pk_bf16(v0[2] * gt, v0[3] * gt); w.z = cvt_pk_bf16(v1[0] * gt, v1[1] * gt); w.w = cvt_pk_bf16(v1[2] * gt, v1[3] * gt);
                        *(u32x4*)(rowp + bj * HALF) = w; } } }
    } };

typedef int v8i __attribute__((ext_vector_type(8)));
typedef int v4i __attribute__((ext_vector_type(4)));
DEVI v8i cat8(const bf16x8 lo, const bf16x8 hi) { const v4i a = __builtin_bit_cast(v4i, lo), b = __builtin_bit_cast(v4i, hi); return __builtin_shufflevector(a, b, 0, 1, 2, 3, 4, 5, 6, 7); }
struct Frag16 { bf16x8 k[2]; };
struct Frag8 { v8i v; };
template <bool F> struct FragSel { typedef Frag16 T; };
template <> struct FragSel<true> { typedef Frag8 T; };
template <class Epi, class Sched, bool FP8 = false>
DEVI void gemm_phase(LAS unsigned char* lds, const bf16_t* A, const int K, const Sched& S, const Epi& E, const int Kloop = 0) {
    const int tid = opq((int)threadIdx.x), wid = __builtin_amdgcn_readfirstlane(tid >> 6), lane = tid & 63, wr = wid >> 2, wc = wid & 3, fr = lane & 15, fq = lane >> 4;
    const int nt = (Kloop ? Kloop : K) / BK;
    unsigned voffA[2], voffB[2];
#pragma unroll
    for (int i = 0; i < 2; ++i) { int R, C; stage_rc(tid * 16 + i * 8192, R, C); const int Rb = Epi::PERM ? ((R & ~31) + perm32(R & 31)) : R;
        voffA[i] = (unsigned)(R * K + C) * 2u; voffB[i] = (unsigned)(Rb * K + C) * 2u; }
    const size_t kstep = (size_t)(BK * 2);
    const size_t hstep = (size_t)HALF * K * 2;
    const size_t rstep = (size_t)K * 2;
    const unsigned ldsw = (unsigned)wid * 1024u;
    const int aoff = lds_byte(wr * 64 + fr, fq * 8), boff = lds_byte(wc * 32 + fr, fq * 8);
#define PG8_SA(b, h) (((b) * 2 + (h)) * HTB)
#define PG8_SB(b, h) ((4 + (b) * 2 + (h)) * HTB)
#define PG8_STAGE(bufoff, gbase, voff) do { _Pragma("unroll") for (int _i = 0; _i < 2; ++_i) \
        __builtin_amdgcn_global_load_lds((const unsigned*)((const char*)(gbase) + (voff)[_i]), (LAS unsigned*)(lds + (bufoff) + ldsw + _i * 8192), 16, 0, 0); } while (0)
#define PG8_LDA(dst, b, h) do { _Pragma("unroll") for (int m = 0; m < 4; ++m) { if constexpr (FP8) dst[m].v = cat8(*(const LAS bf16x8*)(lds + PG8_SA(b, h) + aoff + m * 2048), *(const LAS bf16x8*)(lds + PG8_SA(b, h) + aoff + m * 2048 + 1024)); \
        else { _Pragma("unroll") for (int k = 0; k < 2; ++k) dst[m].k[k] = *(const LAS bf16x8*)(lds + PG8_SA(b, h) + aoff + m * 2048 + k * 1024); } } } while (0)
#define PG8_LDB(dst, b, h) do { _Pragma("unroll") for (int n = 0; n < 2; ++n) { if constexpr (FP8) dst[n].v = cat8(*(const LAS bf16x8*)(lds + PG8_SB(b, h) + boff + n * 2048), *(const LAS bf16x8*)(lds + PG8_SB(b, h) + boff + n * 2048 + 1024)); \
        else { _Pragma("unroll") for (int k = 0; k < 2; ++k) dst[n].k[k] = *(const LAS bf16x8*)(lds + PG8_SB(b, h) + boff + n * 2048 + k * 1024); } } } while (0)
#define PG8_MMA(ai, bj, At, Bt) do { __builtin_amdgcn_s_setprio(1); _Pragma("unroll") for (int m = 0; m < 4; ++m) _Pragma("unroll") for (int n = 0; n < 2; ++n) { \
        if constexpr (FP8) asm volatile("s_nop 1\n\tv_mfma_scale_f32_16x16x128_f8f6f4 %0, %1, %2, %0, %3, %3 op_sel_hi:[0,0,0]" : "+v"(acc[ai][bj][m][n]) : "v"(Bt[n].v), "v"(At[m].v), "v"(sc1)); \
        else { _Pragma("unroll") for (int k = 0; k < 2; ++k) acc[ai][bj][m][n] = __builtin_amdgcn_mfma_f32_16x16x32_bf16(Bt[n].k[k], At[m].k[k], acc[ai][bj][m][n], 0, 0, 0); } } \
        __builtin_amdgcn_s_setprio(0); } while (0)
#define PG8_WAIT_V(n) asm volatile("s_waitcnt vmcnt(" #n ")" ::: "memory")
#define PG8_WAIT_L(n) asm volatile("s_waitcnt lgkmcnt(" #n ")" ::: "memory")
#define PG8_BAR __builtin_amdgcn_s_barrier()
#define PG8_SCHED __builtin_amdgcn_sched_barrier(0)
    Unit cur, nxt; int ui = 0;
    if (!S.next(0, cur)) return;
    int sc1 = 0x7F7F7F7F; asm volatile("" : "+v"(sc1));
    f32x4 acc[2][2][4][2];
#pragma unroll
    for (int a = 0; a < 2; ++a)
#pragma unroll
        for (int b = 0; b < 2; ++b)
#pragma unroll
            for (int m = 0; m < 4; ++m)
#pragma unroll
                for (int n = 0; n < 2; ++n) acc[a][b][m][n] = (f32x4){0.f, 0.f, 0.f, 0.f};
    typename FragSel<FP8>::T At[4], B0[2], B1[2];
    const char* cA = (const char*)A + (size_t)cur.arow0 * rstep + cur.akoff;
    const char* cB = cur.B;
    LAS unsigned char* const esl = lds + EPI_OFF + wid * EPI_SLICE;
    E.pre(esl, cur, wr, lane);
    PG8_STAGE(PG8_SB(0, 0), cB, voffB); PG8_STAGE(PG8_SA(0, 0), cA, voffA); PG8_STAGE(PG8_SB(0, 1), cB + hstep, voffB); PG8_STAGE(PG8_SA(0, 1), cA + hstep, voffA);
    if (wr == 1) PG8_BAR;
    PG8_WAIT_V(4); PG8_BAR;
    PG8_STAGE(PG8_SB(1, 0), cB + kstep, voffB); PG8_STAGE(PG8_SA(1, 0), cA + kstep, voffA); PG8_STAGE(PG8_SB(1, 1), cB + hstep + kstep, voffB);
    PG8_WAIT_V(6); PG8_BAR;
    for (;;) {
        const bool has_next = S.next(ui + 1, nxt);
        const char* nA = has_next ? (const char*)A + (size_t)nxt.arow0 * rstep + nxt.akoff : cA; const char* nB = has_next ? nxt.B : cB;
#pragma unroll 1
        for (int t = 0; t < nt; t += 2) {
            const bool last = (t == nt - 2);
            const char* a1 = cA + (size_t)(t + 1) * kstep;
            const char* a2 = last ? nA : cA + (size_t)(t + 2) * kstep; const char* b2 = last ? nB : cB + (size_t)(t + 2) * kstep;
            const char* a3 = a2 + kstep; const char* b3 = b2 + kstep;
            PG8_LDB(B0, 0, 0); PG8_SCHED; PG8_LDA(At, 0, 0); PG8_STAGE(PG8_SA(1, 1), a1 + hstep, voffA);
            PG8_WAIT_L(8); PG8_BAR; PG8_WAIT_L(0); PG8_MMA(0, 0, At, B0); PG8_BAR; PG8_SCHED;
            PG8_LDB(B1, 0, 1); PG8_STAGE(PG8_SB(0, 0), b2, voffB);
            PG8_BAR; PG8_WAIT_L(0); PG8_MMA(0, 1, At, B1); PG8_BAR;
            PG8_LDA(At, 0, 1); PG8_STAGE(PG8_SA(0, 0), a2, voffA);
            PG8_BAR; PG8_WAIT_L(0); PG8_MMA(1, 0, At, B0); PG8_BAR; PG8_SCHED;
            PG8_STAGE(PG8_SB(0, 1), b2 + hstep, voffB);
            PG8_WAIT_V(6); PG8_BAR; PG8_MMA(1, 1, At, B1); PG8_BAR;
            PG8_LDB(B0, 1, 0); PG8_SCHED; PG8_LDA(At, 1, 0); PG8_STAGE(PG8_SA(0, 1), a2 + hstep, voffA);
            PG8_WAIT_L(8); PG8_BAR; PG8_WAIT_L(0); PG8_MMA(0, 0, At, B0); PG8_BAR; PG8_SCHED;
            PG8_LDB(B1, 1, 1); PG8_STAGE(PG8_SB(1, 0), b3, voffB);
            PG8_BAR; PG8_WAIT_L(0); PG8_MMA(0, 1, At, B1); PG8_BAR;
            PG8_LDA(At, 1, 1); PG8_STAGE(PG8_SA(1, 0), a3, voffA);
            PG8_BAR; PG8_WAIT_L(0); PG8_MMA(1, 0, At, B0); PG8_BAR; PG8_SCHED;
            PG8_STAGE(PG8_SB(1, 1), b3 + hstep, voffB);
            PG8_WAIT_V(6); PG8_BAR; PG8_MMA(1, 1, At, B1); PG8_BAR;
        }
        if constexpr (FP8) asm volatile("s_nop 15\n\ts_nop 15" ::: "memory");
        E(acc, cur, wr, wc, fr, fq, esl);
        if (!has_next) break;
#pragma unroll
        for (int a = 0; a < 2; ++a)
#pragma unroll
            for (int b = 0; b < 2; ++b)
#pragma unroll
                for (int m = 0; m < 4; ++m)
#pragma unroll
                    for (int n = 0; n < 2; ++n) acc[a][b][m][n] = (f32x4){0.f, 0.f, 0.f, 0.f};
        cur = nxt; cA = nA; cB = nB; ++ui;
        E.pre(esl, cur, wr, lane);
        if constexpr (FP8) asm volatile("s_nop 7" ::: "memory");
    }
    PG8_WAIT_V(0);
    if (wr == 0) PG8_BAR;
    PG8_BAR;
#undef PG8_SA
#undef PG8_SB
#undef PG8_STAGE
#undef PG8_LDA
#undef PG8_LDB
#undef PG8_MMA
#undef PG8_WAIT_V
#undef PG8_WAIT_L
#undef PG8_BAR
#undef PG8_SCHED
}
}

DEVI float lb_of(const float* lbraw, int ch) {
    const float r0 = lbraw[ch], r1 = lbraw[512 + ch], r2 = lbraw[1024 + ch];
    const float mx = fmaxf(r0, fmaxf(r1, r2));
    const float e0 = __expf(r0 - mx), e1 = __expf(r1 - mx), e2 = __expf(r2 - mx);
    return e0 / (e0 + e1 + e2);
}
constexpr int HQ = 0, HK = 17408, HKH = 34816, HV = 53248, HDV = 71680, HZERO = 73728, HOT = 75776, H_END = HOT + 64 * 528;
static_assert(H_END <= 131072, "hgrn lds");
constexpr size_t HS_SCAN = (size_t)16 * 16384;
struct HgrnRaw { unsigned qf[16]; u32x4 v0, v1; };
DEVI void hgrn_load(HgrnRaw& R, const bf16_t* u, const bf16_t* VT, int dir, int b, int h, int t0, int c, int I, int tid) {
    const bf16_t* up = u + ((size_t)b * SEQ + t0 + 16 * I) * UW + h * 128 + c;
    const int fcol = dir ? 1024 : 512;
#pragma unroll
    for (int j = 0; j < 16; ++j) R.qf[j] = (unsigned)up[(size_t)j * UW] | ((unsigned)up[(size_t)j * UW + fcol] << 16);
    { const int e = tid, r = e >> 3, cch = e & 7; R.v0 = *(const u32x4*)(VT + ((size_t)b * 512 + h * 128 + r) * SEQ + t0 + cch * 8); }
    { const int e = tid + NTHR, r = e >> 3, cch = e & 7; R.v1 = *(const u32x4*)(VT + ((size_t)b * 512 + h * 128 + r) * SEQ + t0 + cch * 8); }
}
DEVI void hgrn_prep(LAS unsigned char* lds, const HgrnRaw& R, float lbv, int dir, int c, int I, int tid) {
    float ff[16], kk[16], qq[16];
    { const int e = tid, r = e >> 3, cch = e & 7; *(LAS u32x4*)(lds + HV + r * 144 + cch * 16) = R.v0; }
    { const int e = tid + NTHR, r = e >> 3, cch = e & 7; *(LAS u32x4*)(lds + HV + r * 144 + cch * 16) = R.v1; }
#pragma unroll
    for (int j = 0; j < 16; ++j) {
        const float fr = bfhi(R.qf[j]), qr = bflo(R.qf[j]);
        const float f = lbv + (1.f - lbv) * sigmoid_f(fr);
        ff[j] = f; kk[j] = 1.f - f; qq[j] = silu_f(qr);
    }
    float run = 1.f;
#pragma unroll
    for (int jj = 0; jj < 16; ++jj) { const int j = dir ? 15 - jj : jj; run = fmaxf(run * ff[j], 1e-30f); ff[j] = run; }
    const float PG = run;
    float kh[16];
#pragma unroll
    for (int j = 0; j < 16; ++j) {
        const float kt = kk[j] * __builtin_amdgcn_rcpf(ff[j]);
        kh[j] = kt * PG;
        *(LAS bf16_t*)(lds + HQ + (16 * I + j) * 272 + c * 2) = f2bf(qq[j] * ff[j]);
        *(LAS bf16_t*)(lds + HK + (16 * I + j) * 272 + c * 2) = f2bf(kt);
    }
    u32x4 w0, w1;
    w0.x = pk2(kh[0], kh[1]); w0.y = pk2(kh[2], kh[3]); w0.z = pk2(kh[4], kh[5]); w0.w = pk2(kh[6], kh[7]);
    w1.x = pk2(kh[8], kh[9]); w1.y = pk2(kh[10], kh[11]); w1.z = pk2(kh[12], kh[13]); w1.w = pk2(kh[14], kh[15]);
    *(LAS u32x4*)(lds + HKH + c * 144 + I * 32) = w0; *(LAS u32x4*)(lds + HKH + c * 144 + I * 32 + 16) = w1;
    *(LAS float*)(lds + HDV + (I * 128 + c) * 4) = PG;
}
DEVI void hgrn_update(LAS unsigned char* lds, f32x4 (&Sacc)[8], int I, int wid, int fr, int fq) {
    const int voff = (fq < 2) ? HV + (16 * wid + fr) * 144 + (16 * I + 8 * fq) * 2 : HZERO;
    const int koff = (fq < 2) ? HKH + fr * 144 + (16 * I + 8 * fq) * 2 : HZERO;
    const int kstep = (fq < 2) ? 16 * 144 : 0;
    const bf16x8 vb = *(const LAS bf16x8*)(lds + voff);
    bf16x8 ka[8]; f32x4 dv[8];
#pragma unroll
    for (int m = 0; m < 8; ++m) { ka[m] = *(const LAS bf16x8*)(lds + koff + m * kstep); dv[m] = *(const LAS f32x4*)(lds + HDV + (I * 128 + 16 * m + 4 * fq) * 4); }
#pragma unroll
    for (int m = 0; m < 8; ++m) Sacc[m] = __builtin_amdgcn_mfma_f32_16x16x32_bf16(ka[m], vb, Sacc[m] * dv[m], 0, 0, 0);
}
DEVI void ph_hgrn_states(LAS unsigned char* lds, const bf16_t* u, const bf16_t* VT, const float* lbraw, bf16_t* HS, float* HD, int vb0, int vbs) {
    const int tid = opq((int)threadIdx.x), wid = __builtin_amdgcn_readfirstlane(tid >> 6), lane = tid & 63, fr = lane & 15, fq = lane >> 4;
    const int pc = tid & 127, pI = tid >> 7;
    for (int unit = vb0; unit < NB * 4 * 2 * 16; unit += vbs) {
        const int seg = unit & 15, dir = (unit >> 4) & 1, h = (unit >> 5) & 3, b = unit >> 7;
        const float lbv = lb_of(lbraw, h * 128 + pc);
        f32x4 Sacc[8];
#pragma unroll
        for (int m = 0; m < 8; ++m) Sacc[m] = (f32x4){0.f, 0.f, 0.f, 0.f};
        float gprod = 1.f;
        if (tid < 4) *(LAS unsigned*)(lds + HZERO + tid * 4) = 0u;
        HgrnRaw R; hgrn_load(R, u, VT, dir, b, h, seg * 256 + (dir ? 3 : 0) * 64, pc, pI, tid);
#pragma unroll 1
        for (int sbi = 0; sbi < 4; ++sbi) {
            const int sb = dir ? 3 - sbi : sbi;
            const int t0 = seg * 256 + sb * 64;
            __syncthreads();
            hgrn_prep(lds, R, lbv, dir, pc, pI, tid);
            if (sbi < 3) { const int sbn = dir ? 3 - (sbi + 1) : sbi + 1; hgrn_load(R, u, VT, dir, b, h, seg * 256 + sbn * 64, pc, pI, tid); }
            __syncthreads();
            if (tid < 128) gprod *= (*(const LAS float*)(lds + HDV + tid * 4) * *(const LAS float*)(lds + HDV + (128 + tid) * 4)) * (*(const LAS float*)(lds + HDV + (256 + tid) * 4) * *(const LAS float*)(lds + HDV + (384 + tid) * 4));
#pragma unroll 1
            for (int ii = 0; ii < 4; ++ii) { const int I = dir ? 3 - ii : ii; hgrn_update(lds, Sacc, I, wid, fr, fq); }
        }
        const size_t scan = (size_t)(b * 4 + h) * 2 + dir;
        bf16_t* dst = HS + scan * HS_SCAN + (size_t)seg * 16384;
#pragma unroll
        for (int m = 0; m < 8; ++m) { u32x2 w; w.x = pk2(Sacc[m][0], Sacc[m][1]); w.y = pk2(Sacc[m][2], Sacc[m][3]);
            *(u32x2*)(dst + (16 * wid + fr) * 128 + 16 * m + 4 * fq) = w; }
        if (tid < 128) HD[(scan * 16 + seg) * 128 + tid] = gprod;
    }
    __syncthreads();
}
DEVI void ph_hgrn_scan(bf16_t* HS, const float* HD, int vb0, int vbs) {
    const int tid = opq((int)threadIdx.x);
    for (int idx = vb0 * NTHR + tid; idx < 32 * 4096; idx += vbs * NTHR) {
        const int scan = idx >> 12, e4 = idx & 4095, k4 = (e4 & 31) * 4; const int dir = scan & 1;
        u32x2* base = (u32x2*)(HS + (size_t)scan * HS_SCAN) + e4;
        const float* hd = HD + (size_t)scan * 16 * 128 + k4;
        u32x2 d[16]; float4 dec[16];
#pragma unroll
        for (int i = 0; i < 16; ++i) { d[i] = base[(size_t)i * 4096]; dec[i] = *(const float4*)(hd + i * 128); }
        float s0 = 0.f, s1 = 0.f, s2 = 0.f, s3 = 0.f;
#define HSCAN_STEP(i) { const float t0 = bflo(d[i].x), t1 = bfhi(d[i].x), t2 = bflo(d[i].y), t3 = bfhi(d[i].y); d[i].x = pk2(s0, s1); d[i].y = pk2(s2, s3); \
            s0 = s0 * dec[i].x + t0; s1 = s1 * dec[i].y + t1; s2 = s2 * dec[i].z + t2; s3 = s3 * dec[i].w + t3; }
        if (dir == 0) {
#pragma unroll
            for (int i = 0; i < 16; ++i) HSCAN_STEP(i)
        } else {
#pragma unroll
            for (int i = 15; i >= 0; --i) HSCAN_STEP(i)
        }
#undef HSCAN_STEP
#pragma unroll
        for (int i = 0; i < 16; ++i) base[(size_t)i * 4096] = d[i];
    }
}
DEVI void ph_hgrn_out(LAS unsigned char* lds, const bf16_t* u, const bf16_t* VT, const float* lbraw, const float* a_norm, const bf16_t* HS, float* OF, bf16_t* ocat, int vb0, int vbs) {
    const int tid = opq((int)threadIdx.x), wid = __builtin_amdgcn_readfirstlane(tid >> 6), lane = tid & 63, fr = lane & 15, fq = lane >> 4;
    const int pc = tid & 127, pI = tid >> 7;
    const int otok = tid >> 3, opart = tid & 7;
    for (int unit = vb0; unit < NB * 4 * 16; unit += vbs) {
        const int seg = unit & 15, h = (unit >> 4) & 3, b = unit >> 6;
        const float lbv = lb_of(lbraw, h * 128 + pc);
        if (tid < 4) *(LAS unsigned*)(lds + HZERO + tid * 4) = 0u;
#pragma unroll 1
        for (int dir = 0; dir < 2; ++dir) {
            const size_t scan = (size_t)(b * 4 + h) * 2 + dir;
            const bf16_t* src = HS + scan * HS_SCAN + (size_t)seg * 16384;
            f32x4 Sacc[8];
#pragma unroll
            for (int m = 0; m < 8; ++m) { const u32x2 w = *(const u32x2*)(src + (16 * wid + fr) * 128 + 16 * m + 4 * fq);
                Sacc[m][0] = bflo(w.x); Sacc[m][1] = bfhi(w.x); Sacc[m][2] = bflo(w.y); Sacc[m][3] = bfhi(w.y); }
            HgrnRaw R; hgrn_load(R, u, VT, dir, b, h, seg * 256 + (dir ? 3 : 0) * 64, pc, pI, tid);
#pragma unroll 1
            for (int sbi = 0; sbi < 4; ++sbi) {
                const int sb = dir ? 3 - sbi : sbi;
                const int t0 = seg * 256 + sb * 64;
                const size_t tokb = (size_t)b * SEQ + t0;
                __syncthreads();
                hgrn_prep(lds, R, lbv, dir, pc, pI, tid);
                if (sbi < 3) { const int sbn = dir ? 3 - (sbi + 1) : sbi + 1; hgrn_load(R, u, VT, dir, b, h, seg * 256 + sbn * 64, pc, pI, tid); }
                __syncthreads();
#pragma unroll 1
                for (int ii = 0; ii < 4; ++ii) {
                    const int I = dir ? 3 - ii : ii;
                    f32x4 oT = {0.f, 0.f, 0.f, 0.f};
                    const LAS unsigned char* qrow = lds + HQ + (16 * I + fr) * 272;
#pragma unroll
                    for (int ks = 0; ks < 4; ++ks) {
                        u32x4 sa; sa.x = pg8::cvt_pk_bf16(Sacc[2 * ks][0], Sacc[2 * ks][1]); sa.y = pg8::cvt_pk_bf16(Sacc[2 * ks][2], Sacc[2 * ks][3]);
                        sa.z = pg8::cvt_pk_bf16(Sacc[2 * ks + 1][0], Sacc[2 * ks + 1][1]); sa.w = pg8::cvt_pk_bf16(Sacc[2 * ks + 1][2], Sacc[2 * ks + 1][3]);
                        const u32x2 q0 = *(const LAS u32x2*)(qrow + (32 * ks + 4 * fq) * 2), q1 = *(const LAS u32x2*)(qrow + (32 * ks + 16 + 4 * fq) * 2);
                        u32x4 qb; qb.x = q0.x; qb.y = q0.y; qb.z = q1.x; qb.w = q1.y;
                        oT = __builtin_amdgcn_mfma_f32_16x16x32_bf16(__builtin_bit_cast(bf16x8, sa), __builtin_bit_cast(bf16x8, qb), oT, 0, 0, 0);
                    }
                    f32x4 sT = {0.f, 0.f, 0.f, 0.f};
                    const LAS unsigned char* krow = lds + HK + (16 * I + fr) * 272;
#pragma unroll
                    for (int ks = 0; ks < 4; ++ks) {
                        const bf16x8 ka = *(const LAS bf16x8*)(krow + (32 * ks + 8 * fq) * 2), qb = *(const LAS bf16x8*)(qrow + (32 * ks + 8 * fq) * 2);
                        sT = __builtin_amdgcn_mfma_f32_16x16x32_bf16(ka, qb, sT, 0, 0, 0);
                    }
                    float pv[4];
#pragma unroll
                    for (int rg = 0; rg < 4; ++rg) { const int sl = 4 * fq + rg; const bool ok = dir ? (sl >= fr) : (sl <= fr); pv[rg] = ok ? sT[rg] : 0.f; }
                    u32x4 pb; pb.x = pg8::cvt_pk_bf16(pv[0], pv[1]); pb.y = pg8::cvt_pk_bf16(pv[2], pv[3]); pb.z = 0u; pb.w = 0u;
                    const u32x2 v0 = *(const LAS u32x2*)(lds + HV + (16 * wid + fr) * 144 + (16 * I + 4 * fq) * 2);
                    u32x4 va; va.x = v0.x; va.y = v0.y; va.z = 0u; va.w = 0u;
                    oT = __builtin_amdgcn_mfma_f32_16x16x32_bf16(__builtin_bit_cast(bf16x8, va), __builtin_bit_cast(bf16x8, pb), oT, 0, 0, 0);
                    if (dir == 0) *(f32x4*)(OF + (tokb + 16 * I + fr) * 512 + h * 128 + 16 * wid + 4 * fq) = oT;
                    else *(LAS f32x4*)(lds + HOT + (16 * I + fr) * 528 + (16 * wid + 4 * fq) * 4) = oT;
                    hgrn_update(lds, Sacc, I, wid, fr, fq);
                }
                if (dir == 1) {
                    __syncthreads();
                    const LAS float* orow = (const LAS float*)(lds + HOT + otok * 528) + opart * 16;
                    float* ofp = OF + (tokb + otok) * 512 + h * 128 + opart * 16;
                    float v[16]; float ss = 0.f;
#pragma unroll
                    for (int q2 = 0; q2 < 8; ++q2) { const unsigned long long w = __hip_atomic_load((unsigned long long*)(ofp + q2 * 2), __ATOMIC_RELAXED, __HIP_MEMORY_SCOPE_AGENT);
                        v[2 * q2] = __uint_as_float((unsigned)w) + orow[2 * q2]; v[2 * q2 + 1] = __uint_as_float((unsigned)(w >> 32)) + orow[2 * q2 + 1];
                        ss += v[2 * q2] * v[2 * q2] + v[2 * q2 + 1] * v[2 * q2 + 1]; }
                    ss += __shfl_xor(ss, 1); ss += __shfl_xor(ss, 2); ss += __shfl_xor(ss, 4);
                    const float rn = rsqrtf(ss * (1.f / 128.f) + EPS);
                    const bf16_t* gp = u + (tokb + otok) * UW + 2048 + h * 128 + opart * 16;
                    const u32x4 g0 = *(const u32x4*)gp, g1 = *(const u32x4*)(gp + 8);
                    const unsigned gw[8] = {g0.x, g0.y, g0.z, g0.w, g1.x, g1.y, g1.z, g1.w};
                    unsigned ow[8];
#pragma unroll
                    for (int q2 = 0; q2 < 8; ++q2) { const float an0 = a_norm[opart * 16 + 2 * q2], an1 = a_norm[opart * 16 + 2 * q2 + 1];
                        ow[q2] = pk2(v[2 * q2] * rn * an0 * silu_f(bflo(gw[q2])), v[2 * q2 + 1] * rn * an1 * silu_f(bfhi(gw[q2]))); }
                    bf16_t* op = ocat + (tokb + otok) * DM + h * 128 + opart * 16;
                    u32x4 o0, o1; o0.x = ow[0]; o0.y = ow[1]; o0.z = ow[2]; o0.w = ow[3]; o1.x = ow[4]; o1.y = ow[5]; o1.z = ow[6]; o1.w = ow[7];
                    *(u32x4*)op = o0; *(u32x4*)(op + 8) = o1;
                }
            }
            asm volatile("s_waitcnt vmcnt(0)" ::: "memory");
        }
    }
    __syncthreads();
}

DEVI void ph_prep(const bf16_t* u, const float* cw, const float* cb, bf16_t* xconv, bf16_t* XT, bf16_t* VT, int vb0, int vbs) {
    const int tid = opq((int)threadIdx.x);
    for (int unit = vb0; unit < NB * 32 * 3; unit += vbs) {
        const int cg = unit % 3, tb = (unit / 3) & 31, b = unit / 96;
        const int t0 = tb * 128;
        if (cg < 2) {
            const int ch = cg * 512 + tid;
            float w[5];
#pragma unroll
            for (int j = 0; j < 5; ++j) w[j] = cw[j * 1024 + ch];
            const float bias = cb[ch];
            const bf16_t* up = u + (size_t)b * SEQ * UW + 3072 + ch;
            float v0, v1, v2, v3;
            v0 = (t0 - 2 >= 0) ? bf2f(up[(size_t)(t0 - 2) * UW]) : 0.f;
            v1 = (t0 - 1 >= 0) ? bf2f(up[(size_t)(t0 - 1) * UW]) : 0.f;
            v2 = bf2f(up[(size_t)t0 * UW]);
            v3 = bf2f(up[(size_t)(t0 + 1) * UW]);
            for (int t8 = 0; t8 < 128; t8 += 32) {
                float nx[32];
#pragma unroll
                for (int i = 0; i < 32; ++i) { const int tt = t0 + t8 + i + 2; nx[i] = (tt < SEQ) ? bf2f(up[(size_t)tt * UW]) : 0.f; }
                unsigned pk[16];
#pragma unroll
                for (int i = 0; i < 32; ++i) {
                    const float o = silu_f(bias + w[0] * v0 + w[1] * v1 + w[2] * v2 + w[3] * v3 + w[4] * nx[i]);
                    const bf16_t ob = f2bf(o);
                    xconv[(size_t)(b * SEQ + t0 + t8 + i) * 1024 + ch] = ob;
                    if (i & 1) pk[i >> 1] |= ((unsigned)ob << 16); else pk[i >> 1] = ob;
                    v0 = v1; v1 = v2; v2 = v3; v3 = nx[i];
                }
                if (ch < 768) {
#pragma unroll
                    for (int q = 0; q < 4; ++q) { u32x4 o4; o4.x = pk[4 * q]; o4.y = pk[4 * q + 1]; o4.z = pk[4 * q + 2]; o4.w = pk[4 * q + 3]; *(u32x4*)(XT + ((size_t)b * 768 + ch) * SEQ + t0 + t8 + 8 * q) = o4; } }
            }
        } else {
            const int ch = tid;
            const bf16_t* up = u + (size_t)b * SEQ * UW + 1536 + ch;
            for (int t8 = 0; t8 < 128; t8 += 32) {
                unsigned pk[16];
#pragma unroll
                for (int i = 0; i < 32; ++i) { const unsigned ob = up[(size_t)(t0 + t8 + i) * UW]; if (i & 1) pk[i >> 1] |= (ob << 16); else pk[i >> 1] = ob; }
#pragma unroll
                for (int q = 0; q < 4; ++q) { u32x4 o4; o4.x = pk[4 * q]; o4.y = pk[4 * q + 1]; o4.z = pk[4 * q + 2]; o4.w = pk[4 * q + 3]; *(u32x4*)(VT + ((size_t)b * 512 + ch) * SEQ + t0 + t8 + 8 * q) = o4; }
            }
        }
    }
}

constexpr int MB_XT = 0, MB_BX = 256 * 272, MB_DT = MB_BX + 128 * 272, MB_CS = MB_DT + 8 * 128 * 4, MB_TOT = MB_CS + 8 * 128 * 4, MB_END = MB_TOT + 64;
static_assert(MB_END <= 131072, "mamba lds");
constexpr size_t MS_SCAN = (size_t)32 * 8192;
DEVI bf16x8 pack8(const float* v) { u32x4 w; w.x = pg8::cvt_pk_bf16(v[0], v[1]); w.y = pg8::cvt_pk_bf16(v[2], v[3]); w.z = pg8::cvt_pk_bf16(v[4], v[5]); w.w = pg8::cvt_pk_bf16(v[6], v[7]); return __builtin_bit_cast(bf16x8, w); }
DEVI void mamba_tables(LAS unsigned char* lds, const float* dtraw, const float* A_log, const float* dt_bias, int b, int g, int c, int wid, int lane) {
    LAS float* tdt = (LAS float*)(lds + MB_DT); LAS float* tcs = (LAS float*)(lds + MB_CS); LAS float* ttot = (LAS float*)(lds + MB_TOT);
    const int r = wid >> 1, dir = wid & 1, hd = 4 * g + r;
    const float A = -__expf(A_log[dir * 8 + hd]), bias = dt_bias[dir * 8 + hd];
    const size_t tk = (size_t)b * SEQ + c * 128 + 2 * lane;
    const float dt0 = softplus_f(dtraw[tk * 16 + dir * 8 + hd] + bias), dt1 = softplus_f(dtraw[(tk + 1) * 16 + dir * 8 + hd] + bias);
    const float a0 = dt0 * A, a1 = dt1 * A;
    float sc = a0 + a1;
#pragma unroll
    for (int off = 1; off < 64; off <<= 1) { const float v = __shfl_up(sc, off); if (lane >= off) sc += v; }
    const float total = __shfl(sc, 63);
    const float pre0 = sc - a1, pre1 = sc;
    const float c0 = dir ? (total - pre0 + a0) : pre0, c1 = dir ? (total - pre1 + a1) : pre1;
    tdt[wid * 128 + 2 * lane] = dt0; tdt[wid * 128 + 2 * lane + 1] = dt1;
    tcs[wid * 128 + 2 * lane] = c0; tcs[wid * 128 + 2 * lane + 1] = c1;
    if (lane == 0) ttot[wid] = total;
}
DEVI void stage_rows(LAS unsigned char* dst, const bf16_t* src, size_t src_stride, int rows, int tid) {
    for (int e = tid; e < rows * 16; e += NTHR) { const int r = e >> 4, cch = e & 15; *(LAS u32x4*)(dst + r * 272 + cch * 16) = *(const u32x4*)(src + (size_t)r * src_stride + cch * 8); }
}
DEVI void ph_mamba_states(LAS unsigned char* lds, const bf16_t* XT, const float* dtraw, const float* A_log, const float* dt_bias, bf16_t* MS, float* MD, int vb0, int vbs) {
    const int tid = opq((int)threadIdx.x), wid = __builtin_amdgcn_readfirstlane(tid >> 6), lane = tid & 63, fr = lane & 15, fq = lane >> 4;
    LAS float* tdt = (LAS float*)(lds + MB_DT); LAS float* tcs = (LAS float*)(lds + MB_CS); LAS float* ttot = (LAS float*)(lds + MB_TOT);
    for (int unit = vb0; unit < NB * 2 * 32; unit += vbs) {
        const int c = unit & 31, g = (unit >> 5) & 1, b = unit >> 6;
        __syncthreads();
        stage_rows(lds + MB_XT, XT + ((size_t)b * 768 + g * 256) * SEQ + c * 128, SEQ, 256, tid);
        stage_rows(lds + MB_BX, XT + ((size_t)b * 768 + 512 + g * 128) * SEQ + c * 128, SEQ, 128, tid);
        mamba_tables(lds, dtraw, A_log, dt_bias, b, g, c, wid, lane);
        __syncthreads();
        if (lane == 0) MD[((size_t)(b * 8 + 4 * g + (wid >> 1)) * 2 + (wid & 1)) * 32 + c] = __expf(ttot[wid]);
        for (int hdd = 0; hdd < 8; ++hdd) {
            const int r = hdd >> 1, dir = hdd & 1, hd = 4 * g + r;
            const float tot = ttot[hdd];
            f32x4 acc[4];
#pragma unroll
            for (int pt = 0; pt < 4; ++pt) acc[pt] = (f32x4){0.f, 0.f, 0.f, 0.f};
#pragma unroll
            for (int ks = 0; ks < 4; ++ks) {
                const int s0 = 32 * ks + 8 * fq;
                const u32x4 braw = *(const LAS u32x4*)(lds + MB_BX + (16 * wid + fr) * 272 + s0 * 2);
                float bw[8];
                const unsigned bu[4] = {braw.x, braw.y, braw.z, braw.w};
#pragma unroll
                for (int j = 0; j < 8; ++j) { const float bv = (j & 1) ? bfhi(bu[j >> 1]) : bflo(bu[j >> 1]);
                    bw[j] = bv * tdt[hdd * 128 + s0 + j] * __expf(tot - tcs[hdd * 128 + s0 + j]); }
                const bf16x8 Bf = pack8(bw);
#pragma unroll
                for (int pt = 0; pt < 4; ++pt) {
                    const bf16x8 Af = *(const LAS bf16x8*)(lds + MB_XT + (r * 64 + 16 * pt + fr) * 272 + s0 * 2);
                    acc[pt] = __builtin_amdgcn_mfma_f32_16x16x32_bf16(Bf, Af, acc[pt], 0, 0, 0);
                }
            }
            bf16_t* dst = MS + ((size_t)(b * 8 + hd) * 2 + dir) * MS_SCAN + (size_t)c * 8192;
#pragma unroll
            for (int pt = 0; pt < 4; ++pt) { u32x2 w; w.x = pk2(acc[pt][0], acc[pt][1]); w.y = pk2(acc[pt][2], acc[pt][3]);
                *(u32x2*)(dst + (16 * pt + fr) * 128 + 16 * wid + 4 * fq) = w; }
        }
    }
    __syncthreads();
}
DEVI void ph_mamba_scan(bf16_t* MS, const float* MD, int vb0, int vbs) {
    const int tid = opq((int)threadIdx.x);
    for (int idx = vb0 * NTHR + tid; idx < 64 * 2048; idx += vbs * NTHR) {
        const int scan = idx >> 11, e4 = idx & 2047; const int dir = scan & 1;
        u32x2* base = (u32x2*)(MS + (size_t)scan * MS_SCAN) + e4;
        const float* md = MD + (size_t)scan * 32;
        float h0 = 0.f, h1 = 0.f, h2 = 0.f, h3 = 0.f;
#pragma unroll 1
        for (int half = 0; half < 2; ++half) {
            const int c0 = (dir ? 1 - half : half) * 16;
            u32x2 d[16]; float dec[16];
#pragma unroll
            for (int i = 0; i < 16; ++i) { d[i] = base[(size_t)(c0 + i) * 2048]; dec[i] = md[c0 + i]; }
#define MSCAN_STEP(i) { const float t0 = bflo(d[i].x), t1 = bfhi(d[i].x), t2 = bflo(d[i].y), t3 = bfhi(d[i].y); d[i].x = pk2(h0, h1); d[i].y = pk2(h2, h3); \
                h0 = h0 * dec[i] + t0; h1 = h1 * dec[i] + t1; h2 = h2 * dec[i] + t2; h3 = h3 * dec[i] + t3; }
            if (dir == 0) {
#pragma unroll
                for (int i = 0; i < 16; ++i) MSCAN_STEP(i)
            } else {
#pragma unroll
                for (int i = 15; i >= 0; --i) MSCAN_STEP(i)
            }
#undef MSCAN_STEP
#pragma unroll
            for (int i = 0; i < 16; ++i) base[(size_t)(c0 + i) * 2048] = d[i];
        }
    }
}
DEVI void ph_mamba_out(LAS unsigned char* lds, const bf16_t* u, const bf16_t* xconv, const bf16_t* XT, const float* dtraw, const float* A_log, const float* dt_bias, const float* Dskip, const float* b_norm,
                       const bf16_t* MS, bf16_t* ocat, int vb0, int vbs) {
    const int tid = opq((int)threadIdx.x), wid = __builtin_amdgcn_readfirstlane(tid >> 6), lane = tid & 63, fr = lane & 15, fq = lane >> 4;
    LAS float* tdt = (LAS float*)(lds + MB_DT); LAS float* tcs = (LAS float*)(lds + MB_CS);
    for (int unit = vb0; unit < NB * 2 * 32; unit += vbs) {
        const int c = unit & 31, g = (unit >> 5) & 1, b = unit >> 6;
        const size_t tok0 = (size_t)b * SEQ + c * 128;
        __syncthreads();
        stage_rows(lds + MB_XT, XT + ((size_t)b * 768 + g * 256) * SEQ + c * 128, SEQ, 256, tid);
        stage_rows(lds + MB_BX, xconv + tok0 * 1024 + 512 + g * 128, 1024, 128, tid);
        mamba_tables(lds, dtraw, A_log, dt_bias, b, g, c, wid, lane);
        const int tl = 16 * wid + fr;
        bf16x8 Cf[4];
#pragma unroll
        for (int ks = 0; ks < 4; ++ks) Cf[ks] = *(const bf16x8*)(xconv + (tok0 + tl) * 1024 + 768 + g * 128 + 32 * ks + 8 * fq);
        __syncthreads();
        f32x4 GT[8];
#pragma unroll
        for (int st = 0; st < 8; ++st) { GT[st] = (f32x4){0.f, 0.f, 0.f, 0.f};
            bf16x8 Af[4];
#pragma unroll
            for (int ks = 0; ks < 4; ++ks) Af[ks] = *(const LAS bf16x8*)(lds + MB_BX + (16 * st + fr) * 272 + (32 * ks + 8 * fq) * 2);
#pragma unroll
            for (int ks = 0; ks < 4; ++ks) GT[st] = __builtin_amdgcn_mfma_f32_16x16x32_bf16(Af[ks], Cf[ks], GT[st], 0, 0, 0); }
        float ss = 0.f;
        __syncthreads();
        u32x2 hpre[4];
        { const bf16_t* hin0 = MS + ((size_t)(b * 8 + 4 * g) * 2) * MS_SCAN + (size_t)c * 8192;
#pragma unroll
          for (int q = 0; q < 4; ++q) hpre[q] = ((const u32x2*)hin0)[tid + q * NTHR]; }
#pragma unroll 1
        for (int r = 0; r < 4; ++r) {
            const int hd = 4 * g + r;
            f32x4 yv[4];
#pragma unroll
            for (int pt = 0; pt < 4; ++pt) yv[pt] = (f32x4){0.f, 0.f, 0.f, 0.f};
#pragma unroll 1
            for (int dir = 0; dir < 2; ++dir) {
                const int hdd = r * 2 + dir;
                const float cst = tcs[hdd * 128 + tl];
                LAS unsigned char* hbuf = lds + MB_BX + (hdd & 1) * 17408;
#pragma unroll
                for (int q = 0; q < 4; ++q) { const int e4 = tid + q * NTHR, pp = e4 >> 5, n4 = (e4 & 31) * 4;
                    *(LAS u32x2*)(hbuf + pp * 272 + n4 * 2) = hpre[q]; }
                if (hdd < 7) { const int hn = hdd + 1; const bf16_t* hinn = MS + ((size_t)(b * 8 + 4 * g + (hn >> 1)) * 2 + (hn & 1)) * MS_SCAN + (size_t)c * 8192;
#pragma unroll
                    for (int q = 0; q < 4; ++q) hpre[q] = ((const u32x2*)hinn)[tid + q * NTHR]; }
                __syncthreads();
                f32x4 yo[4];
#pragma unroll
                for (int pt = 0; pt < 4; ++pt) { yo[pt] = (f32x4){0.f, 0.f, 0.f, 0.f};
                    bf16x8 hf[4];
#pragma unroll
                    for (int ks = 0; ks < 4; ++ks) hf[ks] = *(const LAS bf16x8*)(hbuf + (16 * pt + fr) * 272 + (32 * ks + 8 * fq) * 2);
#pragma unroll
                    for (int ks = 0; ks < 4; ++ks) yo[pt] = __builtin_amdgcn_mfma_f32_16x16x32_bf16(hf[ks], Cf[ks], yo[pt], 0, 0, 0); }
                const float eo = __expf(cst);
#pragma unroll
                for (int pt = 0; pt < 4; ++pt) yv[pt] += yo[pt] * eo;
#pragma unroll
                for (int kp = 0; kp < 4; ++kp) {
                    const bool skip = dir ? (2 * kp + 1 < wid) : (2 * kp > wid);
                    if (!skip) {
                        float pv[8];
#pragma unroll
                        for (int hlf = 0; hlf < 2; ++hlf) { const int st = 2 * kp + hlf;
                            const f32x4 cs4 = *(const LAS f32x4*)(tcs + hdd * 128 + 16 * st + 4 * fq), dt4 = *(const LAS f32x4*)(tdt + hdd * 128 + 16 * st + 4 * fq);
#pragma unroll
                            for (int rg = 0; rg < 4; ++rg) { const int sl = 16 * st + 4 * fq + rg;
                                const bool ok = dir ? (sl >= tl) : (sl <= tl);
                                const float e = __expf(fminf(cst - cs4[rg], 0.f));
                                pv[hlf * 4 + rg] = ok ? GT[st][rg] * e * dt4[rg] : 0.f; } }
                        u32x2 x0[4], x1[4];
#pragma unroll
                        for (int pt = 0; pt < 4; ++pt) { const LAS unsigned char* xr = lds + MB_XT + (r * 64 + 16 * pt + fr) * 272;
                            x0[pt] = *(const LAS u32x2*)(xr + (32 * kp + 4 * fq) * 2); x1[pt] = *(const LAS u32x2*)(xr + (32 * kp + 16 + 4 * fq) * 2); }
                        const bf16x8 Pf = pack8(pv);
#pragma unroll
                        for (int pt = 0; pt < 4; ++pt) {
                            u32x4 xa; xa.x = x0[pt].x; xa.y = x0[pt].y; xa.z = x1[pt].x; xa.w = x1[pt].y;
                            yv[pt] = __builtin_amdgcn_mfma_f32_16x16x32_bf16(__builtin_bit_cast(bf16x8, xa), Pf, yv[pt], 0, 0, 0);
                        }
                    }
                }
            }
            const float Dk = Dskip[hd];
#pragma unroll
            for (int pt = 0; pt < 4; ++pt) {
                const int p0 = 16 * pt + 4 * fq;
                const u32x2 xr = *(const u32x2*)(xconv + (tok0 + tl) * 1024 + hd * 64 + p0);
                const u32x2 zr = *(const u32x2*)(u + (tok0 + tl) * UW + 2560 + hd * 64 + p0);
                const float xs[4] = {bflo(xr.x), bfhi(xr.x), bflo(xr.y), bfhi(xr.y)}, zs[4] = {bflo(zr.x), bfhi(zr.x), bflo(zr.y), bfhi(zr.y)};
                float yy[4];
#pragma unroll
                for (int rg = 0; rg < 4; ++rg) { const float y = (yv[pt][rg] + Dk * xs[rg]) * silu_f(zs[rg]); yy[rg] = y; ss += y * y; }
                const unsigned long long o = (unsigned long long)pk2(yy[0], yy[1]) | ((unsigned long long)pk2(yy[2], yy[3]) << 32);
                __hip_atomic_store((unsigned long long*)(ocat + (tok0 + tl) * DM + 512 + g * 256 + r * 64 + p0), o, __ATOMIC_RELAXED, __HIP_MEMORY_SCOPE_AGENT);
            }
        }
        ss += __shfl_xor(ss, 16); ss += __shfl_xor(ss, 32);
        const float rn = rsqrtf(ss * (1.f / 256.f) + EPS);
        asm volatile("s_waitcnt vmcnt(0)" ::: "memory");
        unsigned long long pk[16];
#pragma unroll
        for (int q = 0; q < 16; ++q) pk[q] = __hip_atomic_load((unsigned long long*)(ocat + (tok0 + tl) * DM + 512 + g * 256 + (q >> 2) * 64 + 16 * (q & 3) + 4 * fq), __ATOMIC_RELAXED, __HIP_MEMORY_SCOPE_AGENT);
#pragma unroll
        for (int r = 0; r < 4; ++r)
#pragma unroll
            for (int pt = 0; pt < 4; ++pt) {
                const int cc = g * 256 + r * 64 + 16 * pt + 4 * fq;
                unsigned long long* op = (unsigned long long*)(ocat + (tok0 + tl) * DM + 512 + cc);
                const unsigned long long v = pk[r * 4 + pt];
                const unsigned vlo = (unsigned)v, vhi = (unsigned)(v >> 32);
                const float4 bn = *(const float4*)(b_norm + cc);
                const unsigned long long o = (unsigned long long)pk2(bflo(vlo) * rn * bn.x, bfhi(vlo) * rn * bn.y) | ((unsigned long long)pk2(bflo(vhi) * rn * bn.z, bfhi(vhi) * rn * bn.w) << 32);
                *op = o;
            }
    }
    __syncthreads();
}


constexpr int NA_RING = 12, NA_VT = 0, NA_VSTRIDE = NA_RING * 64 * 2 + 16, NA_BIAS = 64 * NA_VSTRIDE, NA_END = NA_BIAS + 480 * 4;
static_assert(NA_END <= 131072, "na lds");
DEVI void ph_na(LAS unsigned char* lds, const bf16_t* qkv, const float* rpb, bf16_t* oc, int vb0, int vbs) {
    const int tid = opq((int)threadIdx.x), wid = __builtin_amdgcn_readfirstlane(tid >> 6), lane = tid & 63, fr = lane & 15, fq = lane >> 4;
    LAS float* bl = (LAS float*)(lds + NA_BIAS);
    for (int chunk = vb0; chunk < NB * 16 * 4; chunk += vbs) {
        const int qr4 = chunk & 3, h = (chunk >> 2) & 15, b = chunk >> 6;
        __syncthreads();
        for (int e = tid; e < 465; e += NTHR) bl[e] = rpb[h * 465 + e];
        auto v_load = [&](int kr) { return *(const u32x4*)(qkv + ((size_t)b * SEQ + kr * 64 + lane) * 3072 + 2048 + h * 64 + wid * 8); };
        auto v_store = [&](int kr, const u32x4 v) { const int slot = kr % NA_RING; const unsigned vw[4] = {v.x, v.y, v.z, v.w};
#pragma unroll
            for (int i = 0; i < 8; ++i) *(LAS bf16_t*)(lds + NA_VT + (wid * 8 + i) * NA_VSTRIDE + (slot * 64 + lane) * 2) = (bf16_t)((i & 1) ? (vw[i >> 1] >> 16) : (vw[i >> 1] & 0xffffu)); };
        int staged_hi;
        { const int r00 = 2 * (qr4 * 8), rs00 = min(max(r00 - 4, 0), 56), hi0 = min(rs00 + 8, 63), n0 = hi0 - rs00 + 1;
            u32x4 pv[9];
#pragma unroll
            for (int t = 0; t < 9; ++t) if (t < n0) pv[t] = v_load(rs00 + t);
#pragma unroll
            for (int t = 0; t < 9; ++t) if (t < n0) v_store(rs00 + t, pv[t]);
            staged_hi = hi0; }
#pragma unroll 1
        for (int ui = 0; ui < 8; ++ui) {
            const int rp = qr4 * 8 + ui;
            const int r0 = 2 * rp;
            __syncthreads();
            int lo2 = 0, nn = 0;
            if (ui < 7) { const int r0n = r0 + 2, rs0n = min(max(r0n - 4, 0), 56), hin = min(rs0n + 8, 63); lo2 = max(staged_hi + 1, rs0n); nn = hin - lo2 + 1; staged_hi = hin > staged_hi ? hin : staged_hi; }
            u32x4 nv0 = {0u, 0u, 0u, 0u}, nv1 = nv0;
            if (nn > 0) nv0 = v_load(lo2);
            if (nn > 1) nv1 = v_load(lo2 + 1);
            const int r = r0 + (wid >> 2), j = wid & 3;
            const int rs = min(max(r - 4, 0), 56);
            const int bs = (j == 0) ? 0 : (j == 1) ? 8 : (j == 2) ? 24 : 32;
            const int c = 16 * j + fr, qs = min(max(c - 8, 0), 48);
            const size_t qtok = (size_t)b * SEQ + r * 64 + c;
            bf16x8 Qf[2];
#pragma unroll
            for (int ks = 0; ks < 2; ++ks) Qf[ks] = *(const bf16x8*)(qkv + qtok * 3072 + h * 64 + 32 * ks + 8 * fq);
            const bf16_t* kbase = qkv + ((size_t)b * SEQ + rs * 64 + bs + fr) * 3072 + 1024 + h * 64 + 8 * fq;
            float sv[8][8]; float mloc = -1e30f;
#pragma unroll
            for (int hb = 0; hb < 2; ++hb) {
                bf16x8 kc[4][4];
#pragma unroll
                for (int d4 = 0; d4 < 4; ++d4)
#pragma unroll
                    for (int q = 0; q < 4; ++q) kc[d4][q] = *(const bf16x8*)(kbase + ((size_t)(hb * 4 + d4) * 64 + (q >> 1) * 16) * 3072 + (q & 1) * 32);
#pragma unroll
                for (int d4 = 0; d4 < 4; ++d4) { const int dr = hb * 4 + d4;
                    const LAS float* brow = bl + (rs + dr - r + 7) * 31;
#pragma unroll
                    for (int kg = 0; kg < 2; ++kg) {
                        f32x4 acc = {0.f, 0.f, 0.f, 0.f};
                        acc = __builtin_amdgcn_mfma_f32_16x16x32_bf16(kc[d4][kg * 2], Qf[0], acc, 0, 0, 0);
                        acc = __builtin_amdgcn_mfma_f32_16x16x32_bf16(kc[d4][kg * 2 + 1], Qf[1], acc, 0, 0, 0);
#pragma unroll
                        for (int rg = 0; rg < 4; ++rg) {
                            const int kcol = bs + 16 * kg + 4 * fq + rg;
                            const bool ok = (kcol >= qs) && (kcol < qs + 16);
                            const int dc = min(max(kcol - c + 15, 0), 30);
                            const float sc = ok ? acc[rg] * 0.125f + brow[dc] : -1e30f;
                            sv[dr][kg * 4 + rg] = sc; mloc = fmaxf(mloc, sc);
                        }
                    }
                }
            }
            mloc = fmaxf(mloc, __shfl_xor(mloc, 16)); mloc = fmaxf(mloc, __shfl_xor(mloc, 32));
            float lrun = 0.f;
#pragma unroll
            for (int dr = 0; dr < 8; ++dr)
#pragma unroll
                for (int i = 0; i < 8; ++i) { const float p = __expf(sv[dr][i] - mloc); sv[dr][i] = p; lrun += p; }
            lrun += __shfl_xor(lrun, 16); lrun += __shfl_xor(lrun, 32);
            f32x4 O[4];
#pragma unroll
            for (int dt = 0; dt < 4; ++dt) O[dt] = (f32x4){0.f, 0.f, 0.f, 0.f};
#pragma unroll
            for (int dr = 0; dr < 8; ++dr) {
                const bf16x8 Pf = pack8(sv[dr]);
                const int koff = (((rs + dr) % NA_RING) * 64 + bs + 4 * fq) * 2;
#pragma unroll
                for (int dt = 0; dt < 4; ++dt) {
                    const LAS unsigned char* vr = lds + NA_VT + (16 * dt + fr) * NA_VSTRIDE + koff;
                    const u32x2 v0 = *(const LAS u32x2*)vr, v1 = *(const LAS u32x2*)(vr + 32);
                    u32x4 va; va.x = v0.x; va.y = v0.y; va.z = v1.x; va.w = v1.y;
                    O[dt] = __builtin_amdgcn_mfma_f32_16x16x32_bf16(__builtin_bit_cast(bf16x8, va), Pf, O[dt], 0, 0, 0);
                }
            }
            const float il = 1.f / lrun;
#pragma unroll
            for (int dt = 0; dt < 4; ++dt) {
                u32x2 o; o.x = pk2(O[dt][0] * il, O[dt][1] * il); o.y = pk2(O[dt][2] * il, O[dt][3] * il);
                *(u32x2*)(oc + qtok * DM + h * 64 + 16 * dt + 4 * fq) = o;
            }
            if (nn > 0) v_store(lo2, nv0);
            if (nn > 1) v_store(lo2 + 1, nv1);
        }
    }
    __syncthreads();
}

#define XB_TMO      128
#define XB_XCNT(j)  (256  + 64 * (j))
#define XB_XSUB(j)  (1280 + 64 * (j))
#define XB_XGEN(j)  (2304 + 64 * (j))
#define XB_TOP      3328
#define XB_TOPGEN   3392
#define XCD_BAR_WORDS 3456
#define XB_SPIN_CAP (1u << 18)

__device__ __forceinline__ unsigned xb_ld(unsigned* p)              { return __hip_atomic_load(p, __ATOMIC_RELAXED, __HIP_MEMORY_SCOPE_AGENT); }
__device__ __forceinline__ unsigned xb_add(unsigned* p, unsigned v) { return __hip_atomic_fetch_add(p, v, __ATOMIC_RELAXED, __HIP_MEMORY_SCOPE_AGENT); }
__device__ __forceinline__ unsigned xb_xcc_id() { return (unsigned)__builtin_amdgcn_s_getreg((3 << 11) | 20) & 0xFu; }
#define XB_SPIN(cond, bar) do { unsigned _sp = 0; while (cond) { __builtin_amdgcn_s_sleep(1); \
    if ((++_sp & 255u) == 0u) { if (xb_ld(&(bar)[XB_TMO])) break; if (_sp > XB_SPIN_CAP) { atomicAdd(&(bar)[XB_TMO], 1u); break; } } } } while (0)

struct XcdBarrier {
    unsigned* bar; unsigned x;
    volatile LAS unsigned* st;
};

__device__ __forceinline__ XcdBarrier xcd_barrier_post(unsigned* bar, volatile LAS unsigned* st) {
    XcdBarrier b; b.bar = bar; b.x = xb_xcc_id(); b.st = st;
    if (threadIdx.x == 0) (void)xb_add(&bar[XB_XCNT(b.x)], 1u);
    return b;
}
__device__ __forceinline__ void xcd_barrier_complete(unsigned* bar, unsigned x, unsigned& nloc, unsigned& nx) {
    const unsigned G = gridDim.x * gridDim.y * gridDim.z;
    unsigned sum, cnt, mine, sp = 0u;
    for (;;) {
        sum = 0u; cnt = 0u; mine = 0u;
#pragma unroll
        for (unsigned j = 0; j < 16; ++j) { const unsigned c = xb_ld(&bar[XB_XCNT(j)]); sum += c; cnt += (c > 0u) ? 1u : 0u; mine = (j == x) ? c : mine; }
        if (sum == G) break;
        __builtin_amdgcn_s_sleep(1);
        if ((++sp & 255u) == 0u) { if (xb_ld(&bar[XB_TMO])) break; if (sp > XB_SPIN_CAP) { atomicAdd(&bar[XB_TMO], 1u); break; } }
    }
    nloc = mine > 0u ? mine : 1u; nx = cnt > 0u ? cnt : 1u;
}

__device__ __forceinline__ void xcd_barrier(const XcdBarrier& b) {
    asm volatile("s_waitcnt vmcnt(0)" ::: "memory");
    __syncthreads();
    if (threadIdx.x == 0) {
        unsigned* bar = b.bar;
        __builtin_amdgcn_s_waitcnt(0);
        unsigned nloc = b.st[0], nx = b.st[1];
        if (nloc == 0u) { xcd_barrier_complete(bar, b.x, nloc, nx); b.st[0] = nloc; b.st[1] = nx; }
        const unsigned old = xb_add(&bar[XB_XSUB(b.x)], 1u);
        const unsigned gen = old / nloc;
        if (old + 1u == (gen + 1u) * nloc) {
            __builtin_amdgcn_fence(__ATOMIC_RELEASE, "agent");
            asm volatile("s_waitcnt vmcnt(0)" ::: "memory");
            const unsigned og = xb_add(&bar[XB_TOP], 1u);
            const unsigned tg = og / nx;
            if (og + 1u == (tg + 1u) * nx) xb_add(&bar[XB_TOPGEN], 1u);
            else XB_SPIN(xb_ld(&bar[XB_TOPGEN]) == tg, bar);
            __builtin_amdgcn_fence(__ATOMIC_ACQUIRE, "agent");
            xb_add(&bar[XB_XGEN(b.x)], 1u);
            asm volatile("s_waitcnt vmcnt(0)" ::: "memory");
        } else {
            XB_SPIN(xb_ld(&bar[XB_XGEN(b.x)]) == gen, bar);
            __builtin_amdgcn_fence(__ATOMIC_ACQUIRE, "agent");
            asm volatile("s_waitcnt vmcnt(0)" ::: "memory");
        }
    }
    __syncthreads();
}


struct Args { const float* in[34]; float* out; unsigned char* ws; int ph_lo, ph_hi; };
constexpr int N_PHASES = 22;

__global__ void __launch_bounds__(NTHR, 2) fwd(Args a) {
    extern __shared__ __attribute__((aligned(16))) unsigned char lds_raw[];
    float* lds = (float*)lds_raw;
    LAS unsigned char* ldsl = (LAS unsigned char*)lds_raw;
    const int vb0 = blockIdx.x, vbs = gridDim.x;
    const int lo = a.ph_lo, hi = a.ph_hi;
#define IN(k) (lo <= (k) && (k) < hi)
#define SEAM(k) do { if (IN(k) && IN((k) + 1)) xcd_barrier(bar); } while (0)
    volatile LAS unsigned* misc = (volatile LAS unsigned*)(ldsl + MISC_OFF);
    if (threadIdx.x < 4) misc[threadIdx.x] = 0u;
    __syncthreads();
    XcdBarrier bar = xcd_barrier_post((unsigned*)(a.ws + WS_CTL) + CW_BAR, misc);
    unsigned char* ws = a.ws;
    unsigned* ctl = (unsigned*)(ws + WS_CTL);
    unsigned* cnt = ctl + CW_CNT;
    int* list = (int*)(ws + WS_LIST); float* gatev = (float*)(ws + WS_GATE);
    float* dtraw = (float*)(ws + WS_DT); float* RS = (float*)(ws + WS_RS);
    bf16_t* XB = (bf16_t*)(ws + WS_XB); bf16_t* UB = (bf16_t*)(ws + WS_UB);
    bf16_t* YA = (bf16_t*)(ws + WS_YA); float* OF = (float*)(ws + WS_OF); bf16_t* OC = (bf16_t*)(ws + WS_OC);
    bf16_t* YP = (bf16_t*)(ws + WS_YP); bf16_t* YP1 = (bf16_t*)(ws + WS_YP1); bf16_t* XC = (bf16_t*)(ws + WS_YP);
    bf16_t* PB0 = (bf16_t*)(ws + WS_PB0); bf16_t* PB1 = (bf16_t*)(ws + WS_PB1);
    bf16_t* YB = (bf16_t*)(ws + WS_Y);
    bf16_t* Y2 = (bf16_t*)(ws + WS_Y2); unsigned char* yflag = ws + WS_YFLAG;
    bf16_t* MS = (bf16_t*)(ws + WS_MS); float* MD = (float*)(ws + WS_MD);
    bf16_t* HS = (bf16_t*)(ws + WS_HS); float* HD = (float*)(ws + WS_HD);
    bf16_t* XT = (bf16_t*)(ws + WS_XT); bf16_t* VT = (bf16_t*)(ws + WS_VT);
    const float* p_in = a.in[1];
    const int G = (int)gridDim.x, cb = (int)blockIdx.x;
    const NormB NB0{nullptr, XB, nullptr, nullptr, RS, nullptr, nullptr, nullptr, nullptr, nullptr, nullptr, nullptr, nullptr, nullptr, nullptr};
    unsigned char* XG8 = ws + WS_XG8;
    float* rsl = (float*)(ws + WS_DT);

    if (IN(0)) {
        ph_convert_weights(ldsl, a.in, ws, 0, ITEMS_DENSE, vb0, vbs);
        NormB A = NB0; A.xin = a.in[0]; A.gnext = a.in[3]; A.win = a.in[4]; A.dtraw = dtraw;
        ph_norm0_dt(A, vb0, vbs, ldsl);
    }
    SEAM(0);
    if (IN(1)) { pg8::DenseOrder S; S.init(MT, UW, DM, (const bf16_t*)(ws + W_IN), G, cb); pg8::gemm_phase(ldsl, XB, DM, S, pg8::EpiBf16{UB, UW, RS}); }
    SEAM(1);
    if (IN(2)) { ph_prep(UB, a.in[5], a.in[6], XC, XT, VT, vb0, vbs); }
    SEAM(2);
    if (IN(3)) { ph_hgrn_states(ldsl, UB, VT, a.in[2], HS, HD, vb0, vbs); ph_mamba_states(ldsl, XT, dtraw, a.in[7], a.in[8], MS, MD, vb0, vbs); }
    SEAM(3);
    if (IN(4)) { ph_hgrn_scan(HS, HD, vb0, vbs); ph_mamba_scan(MS, MD, vb0, vbs); }
    SEAM(4);
    if (IN(5)) { ph_hgrn_out(ldsl, UB, VT, a.in[2], a.in[10], HS, OF, OC, vb0, vbs); ph_mamba_out(ldsl, UB, XC, XT, dtraw, a.in[7], a.in[8], a.in[9], a.in[11], MS, OC, vb0, vbs); }
    SEAM(5);
    if (IN(6)) { pg8::DenseOrder S; S.init(MT, DM, DM, (const bf16_t*)(ws + W_OUTE), G, cb); pg8::gemm_phase(ldsl, OC, DM, S, pg8::EpiBf16{YA, DM, nullptr}); }
    SEAM(6);
    if (IN(7)) {
        NormB A = NB0; A.y = YA; A.gpost = a.in[13];
        ph_norm2<1, false, false, false>(A, vb0, vbs);
        ph_cvt_rows(p_in, PB0, (size_t)MT * PDIM / 4, vb0, vbs);
        ph_convert_experts(ldsl, a.in, ws, ITEMS_DENSE, ITEMS_ALL, vb0, vbs);
    }
    SEAM(7);
    if (IN(8)) {
        { pg8::DenseOrder S; S.init(MT, 2 * DFF, DM, (const bf16_t*)(ws + W_GU), G, cb); pg8::gemm_phase(ldsl, XB, DM, S, pg8::EpiSwiglu{UB, DFF, RS, 0}); }
        { pg8::TailOrder S; S.init(MT, DM, PDIM, (const bf16_t*)(ws + W_PP), G, cb, (MT / 256) * (2 * DFF / 256) % G); pg8::gemm_phase(ldsl, PB0, PDIM, S, pg8::EpiBf16{YP, DM, nullptr}); }
    }
    SEAM(8);
    if (IN(9)) { pg8::DenseOrder S; S.init(MT, DM, DFF, (const bf16_t*)(ws + W_DN), G, cb); pg8::gemm_phase(ldsl, UB, DFF, S, pg8::EpiBf16{YA, DM, nullptr}); }
    SEAM(9);
    if (IN(10)) {
        NormB A = NB0; A.y = YA; A.gpost = a.in[18];
        ph_norm2<1, false, false, false>(A, vb0, vbs);
    }
    SEAM(10);
    if (IN(11)) { pg8::DenseOrder S; S.init(MT, DM, DM, (const bf16_t*)(ws + W_PG), G, cb); pg8::gemm_phase(ldsl, XB, DM, S, pg8::EpiPleGate{YP, DM, RS}); }
    SEAM(11);
    if (IN(12)) {
        NormB A = NB0; A.y = YP; A.gpost = a.in[33];
        ph_norm2<1, false, false, false>(A, vb0, vbs);
    }
    SEAM(12);
    if (IN(13)) { pg8::DenseOrder S; S.init(MT, 3072, DM, (const bf16_t*)(ws + W_QKV), G, cb); pg8::gemm_phase(ldsl, XB, DM, S, pg8::EpiBf16{UB, 3072, RS}); }
    SEAM(13);
    if (IN(14)) { ph_na(ldsl, UB, a.in[21], OC, vb0, vbs); }
    SEAM(14);
    if (IN(15)) { pg8::DenseOrder S; S.init(MT, DM, DM, (const bf16_t*)(ws + W_OUTO), G, cb); pg8::gemm_phase(ldsl, OC, DM, S, pg8::EpiBf16{YP1, DM, nullptr}); }
    SEAM(15);
    if (IN(16)) {
        NormB A = NB0; A.y = YP1; A.gpost = a.in[23]; A.gnext = a.in[24]; A.wr = a.in[25]; A.cnt = cnt; A.list = list; A.gatev = gatev; A.rsl = rsl; A.x8 = XG8;
        ph_norm2<1, false, false, true>(A, vb0, vbs, (LAS float*)ldsl);
        ph_cvt_rows(p_in + (size_t)MT * PDIM, PB1, (size_t)MT * PDIM / 4, vb0, vbs);
    }
    SEAM(16);
    if (IN(17)) { pg8::MoeOrder S; S.init(cnt, (volatile LAS int*)(ldsl + MISC_OFF + 64), 2 * DFFE, DM / 2, (const bf16_t*)(ws + W_EGU), (size_t)7 * MiB, true, G, cb);
        pg8::gemm_phase<pg8::EpiSwiglu8, pg8::MoeOrder, true>(ldsl, (const bf16_t*)XG8, DM / 2, S, pg8::EpiSwiglu8{(unsigned char*)UB, DFFE, rsl}); }
    SEAM(17);
    if (IN(18)) { pg8::MoeOrder S; S.init(cnt, (volatile LAS int*)(ldsl + MISC_OFF + 64), DM, DFFE / 2, (const bf16_t*)(ws + W_EDN), (size_t)(7 * MiB / 2), false, G, cb);
        const pg8::EpiMoeDown E{YB, list, gatev, 1.f / (pg8::W8_SCALE * pg8::ACT8_SCALE), (size_t)(Y2 - YB), yflag};
        S.set_split(true, false, DFFE / 2);
        pg8::gemm_phase<pg8::EpiMoeDown, pg8::MoeOrder, true>(ldsl, UB, DFFE / 2, S, E);
        S.set_split(true, true, DFFE / 2);
        pg8::gemm_phase<pg8::EpiMoeDown, pg8::MoeOrder, true>(ldsl, UB, DFFE / 2, S, E, DFFE / 4);
        { pg8::TailOrder T; T.init(MT, DM, PDIM, (const bf16_t*)(ws + W_PP + 512 * 1024), G, cb, S.tail_first()); pg8::gemm_phase(ldsl, PB1, PDIM, T, pg8::EpiBf16{YP, DM, nullptr}); } }
    SEAM(18);
    if (IN(19)) {
        NormB A = NB0; A.y = YB; A.gpost = a.in[29]; A.y2 = Y2; A.yflag = yflag;
        ph_norm2<2, false, false, false>(A, vb0, vbs);
    }
    SEAM(19);
    if (IN(20)) { pg8::DenseOrder S; S.init(MT, DM, DM, (const bf16_t*)(ws + W_PG + 2 * MiB), G, cb); pg8::gemm_phase(ldsl, XB, DM, S, pg8::EpiPleGate{YP, DM, RS}); }
    SEAM(20);
    if (IN(21)) {
        NormB A = NB0; A.y = YP; A.gpost = a.in[33] + DM; A.xout = a.out;
        ph_norm2<1, true, false, false>(A, vb0, vbs);
    }
#undef IN
#undef SEAM
}

extern "C" void kernel_launch(void* const* d_in, const int* in_sizes, int n_in, void* d_out, int out_size, void* d_ws, size_t ws_size, hipStream_t stream) {
    static int grid = 0;
    if (grid == 0) {
        if (n_in != 34 || out_size != MT * DM || ws_size < WS_END) { fprintf(stderr, "kernel_launch: unexpected shapes n_in %d out %d ws %zu (need %zu)\n", n_in, out_size, ws_size, (size_t)WS_END); grid = -1; return; }
        int dev = 0, cus = 0;
        if (hipGetDevice(&dev) != hipSuccess || hipDeviceGetAttribute(&cus, hipDeviceAttributeMultiprocessorCount, dev) != hipSuccess) { grid = -1; return; }
        if (hipFuncSetAttribute((const void*)fwd, hipFuncAttributeMaxDynamicSharedMemorySize, LDS_BYTES) != hipSuccess) { fprintf(stderr, "hipFuncSetAttribute failed\n"); grid = -1; return; }
        (void)hipGetLastError();
        grid = cus;
    }
    if (grid < 0) return;
    (void)hipMemsetAsync((char*)d_ws + WS_CTL, 0, CTL_ZERO_BYTES, stream);
    Args a{};
    for (int i = 0; i < 34; ++i) a.in[i] = (const float*)d_in[i];
    a.out = (float*)d_out; a.ws = (unsigned char*)d_ws;
#ifndef MK_PER_PHASE
    a.ph_lo = 0; a.ph_hi = N_PHASES;
    hipLaunchKernelGGL(fwd, dim3(grid), dim3(NTHR), LDS_BYTES, stream, a);
#else
    for (int ph = 0; ph < N_PHASES; ++ph) {
        a.ph_lo = ph; a.ph_hi = ph + 1;
        hipLaunchKernelGGL(fwd, dim3(grid), dim3(NTHR), LDS_BYTES, stream, a);
    }
#endif
}
```

```cpp
#include <hip/hip_runtime.h>
#include <stdint.h>
#include <stdio.h>

#define DEVI __device__ __forceinline__
#define LAS __attribute__((address_space(3)))
typedef unsigned short bf16_t;

constexpr int NB = 4, SEQ = 4096, DM = 1024, MT = NB * SEQ;
constexpr int EVEN_IN = 4112, UW = 4096, DFF = 2816, NEXP = 8, DFFE = 3584, PDIM = 256;
constexpr float EPS = 1e-6f;
constexpr int NTHR = 512;
constexpr int LDS_BYTES = 147456;
constexpr int MISC_OFF = 131072 + 320;
constexpr int MOE_ROWS = 2 * MT + NEXP * 256;

constexpr size_t MiB = 1u << 20;
constexpr size_t WS_CTL = 0, CTL_ZERO_BYTES = 1 * MiB;
constexpr size_t WS_LIST = 1 * MiB;
constexpr size_t WS_GATE = WS_LIST + 512 * 1024;
constexpr size_t WS_DT = 2 * MiB;
constexpr size_t WS_W = 3 * MiB;
constexpr size_t W_IN = WS_W, W_OUTE = W_IN + 8 * MiB, W_GU = W_OUTE + 2 * MiB, W_DN = W_GU + 11 * MiB, W_PG = W_DN + 6 * MiB, W_PP = W_PG + 4 * MiB,
                 W_QKV = W_PP + 1 * MiB, W_OUTO = W_QKV + 6 * MiB, W_EGU = W_OUTO + 2 * MiB, W_EDN = W_EGU + 112 * MiB, W_END = W_EDN + 56 * MiB;
constexpr size_t WS_XB = W_END;
constexpr size_t WS_R = WS_XB + 32 * MiB;
constexpr size_t WS_UB = WS_R;
constexpr size_t WS_PB0 = WS_R + 88 * MiB;
constexpr size_t WS_YA = WS_R + 128 * MiB;
constexpr size_t WS_OF = WS_R + 160 * MiB;
constexpr size_t WS_OC = WS_R + 192 * MiB;
constexpr size_t WS_YP = WS_R + 224 * MiB;
constexpr size_t WS_YP1 = WS_R;
constexpr size_t WS_PB1 = W_EDN + 32 * MiB;
constexpr size_t WS_XG8 = WS_R + 120 * MiB;
constexpr size_t WS_END = WS_R + 256 * MiB;
constexpr size_t WS_Y2 = WS_R + 120 * MiB;
constexpr size_t WS_YFLAG = WS_CTL + 256 * 1024;
constexpr size_t WS_Y = W_EGU;
constexpr size_t WS_MS = W_EGU;
constexpr size_t WS_HS = W_EGU + 64 * MiB;
constexpr size_t WS_XT = W_EDN;
constexpr size_t WS_VT = W_EDN + 24 * MiB;
constexpr size_t WS_MD = W_EDN + 40 * MiB;
constexpr size_t WS_HD = W_EDN + 41 * MiB;
static_assert(WS_R + (size_t)MOE_ROWS * DFFE <= WS_XG8 && WS_XG8 + 128 * MiB <= WS_END && WS_END <= 510 * MiB, "ws map");
constexpr size_t WS_RS = WS_CTL + 512 * 1024;
constexpr int CW_CNT = 64;
constexpr int CW_BAR = 4096;

DEVI int opq(int x) { asm volatile("" : "+v"(x)); return x; }
DEVI float bf2f(bf16_t b) { return __uint_as_float(((unsigned)b) << 16); }
typedef float f32x2c __attribute__((ext_vector_type(2)));
typedef __bf16 bf16x2c __attribute__((ext_vector_type(2)));
DEVI unsigned cvt2bf(float lo, float hi) { const f32x2c v = {lo, hi}; return __builtin_bit_cast(unsigned, __builtin_convertvector(v, bf16x2c)); }
DEVI bf16_t f2bf(float f) { return (bf16_t)(cvt2bf(f, 0.f) & 0xffffu); }
DEVI float silu_f(float x) { return x * __builtin_amdgcn_rcpf(1.f + __builtin_amdgcn_exp2f(-1.44269504f * x)); }
DEVI float sigmoid_f(float x) { return __builtin_amdgcn_rcpf(1.f + __builtin_amdgcn_exp2f(-1.44269504f * x)); }
DEVI float softplus_f(float x) { return x > 20.f ? x : log1pf(__expf(x)); }
DEVI float wave_sum(float v) {
#pragma unroll
    for (int o = 1; o < 64; o <<= 1) v += __shfl_xor(v, o);
    return v;
}


typedef short bf16x8 __attribute__((ext_vector_type(8)));
typedef float f32x4 __attribute__((ext_vector_type(4)));
typedef unsigned u32x4 __attribute__((ext_vector_type(4)));
typedef unsigned u32x2 __attribute__((ext_vector_type(2)));
DEVI unsigned pk2(float lo, float hi) { return cvt2bf(lo, hi); }
DEVI float bflo(unsigned w) { return __uint_as_float(w << 16); }
DEVI float bfhi(unsigned w) { return __uint_as_float(w & 0xffff0000u); }

DEVI unsigned pg8_pk4(float a, float b, float c, float d) {
    a = __builtin_amdgcn_fmed3f(a, -448.f, 448.f); b = __builtin_amdgcn_fmed3f(b, -448.f, 448.f); c = __builtin_amdgcn_fmed3f(c, -448.f, 448.f); d = __builtin_amdgcn_fmed3f(d, -448.f, 448.f);
    int p = __builtin_amdgcn_cvt_pk_fp8_f32(a, b, 0, false); p = __builtin_amdgcn_cvt_pk_fp8_f32(c, d, p, true); return (unsigned)p; }
DEVI float wave_sum16(float (&v)[16], int lane) {
    const bool h5 = lane & 32, h4 = lane & 16, h3 = lane & 8, h2 = lane & 4;
#pragma unroll
    for (int i = 0; i < 8; ++i) { const float send = h5 ? v[i] : v[i + 8], keep = h5 ? v[i + 8] : v[i]; v[i] = keep + __shfl_xor(send, 32); }
#pragma unroll
    for (int i = 0; i < 4; ++i) { const float send = h4 ? v[i] : v[i + 4], keep = h4 ? v[i + 4] : v[i]; v[i] = keep + __shfl_xor(send, 16); }
#pragma unroll
    for (int i = 0; i < 2; ++i) { const float send = h3 ? v[i] : v[i + 2], keep = h3 ? v[i + 2] : v[i]; v[i] = keep + __shfl_xor(send, 8); }
    { const float send = h2 ? v[0] : v[1], keep = h2 ? v[1] : v[0]; v[0] = keep + __shfl_xor(send, 4); }
    float r = v[0]; r += __shfl_xor(r, 1); r += __shfl_xor(r, 2); return r;
}
DEVI float wave_sum8(float (&v)[8], int lane) {
    const bool h5 = lane & 32, h4 = lane & 16, h3 = lane & 8;
#pragma unroll
    for (int i = 0; i < 4; ++i) { const float send = h5 ? v[i] : v[i + 4], keep = h5 ? v[i + 4] : v[i]; v[i] = keep + __shfl_xor(send, 32); }
#pragma unroll
    for (int i = 0; i < 2; ++i) { const float send = h4 ? v[i] : v[i + 2], keep = h4 ? v[i + 2] : v[i]; v[i] = keep + __shfl_xor(send, 16); }
    { const float send = h3 ? v[0] : v[1], keep = h3 ? v[1] : v[0]; v[0] = keep + __shfl_xor(send, 8); }
    float r = v[0]; r += __shfl_xor(r, 1); r += __shfl_xor(r, 2); r += __shfl_xor(r, 4); return r;
}
struct NormB { const float* xin; bf16_t* XB; const bf16_t* y; const float* gpost; float* rs; const float* gnext;
               const float* win; float* dtraw; const float* wr; unsigned* cnt; int* list; float* gatev; float* rsl; float* xout; unsigned char* x8; const bf16_t* y2; const unsigned char* yflag; };
DEVI void unpack8(const u32x4 w, float* v) { v[0] = bflo(w.x); v[1] = bfhi(w.x); v[2] = bflo(w.y); v[3] = bfhi(w.y); v[4] = bflo(w.z); v[5] = bfhi(w.z); v[6] = bflo(w.w); v[7] = bfhi(w.w); }
template <int YMODE, bool FINAL, bool DT, bool ROUTE>
DEVI void ph_norm2(const NormB& A, int vb0, int vbs, LAS float* wl = nullptr) {
    const int tidq = opq((int)threadIdx.x); const int wid = tidq >> 6, lane = tidq & 63;
    if (DT || ROUTE) {
        constexpr int NJ = DT ? 16 : 8;
        __syncthreads();
        for (int e = tidq; e < DM * NJ / 4; e += NTHR) { const int k = e / (NJ / 4), j4 = (e % (NJ / 4)) * 4;
            const float4 w = DT ? *(const float4*)(A.win + (size_t)k * EVEN_IN + 4096 + j4) : *(const float4*)(A.wr + (size_t)k * 8 + j4);
            wl[(j4 + 0) * DM + k] = w.x; wl[(j4 + 1) * DM + k] = w.y; wl[(j4 + 2) * DM + k] = w.z; wl[(j4 + 3) * DM + k] = w.w; }
        __syncthreads();
    }
    constexpr int R = (DT || ROUTE) ? 2 : 4;
    for (int row0 = (vb0 * 8 + wid) * R; row0 < MT; row0 += vbs * 8 * R) {
        float xv[R][16]; float yv[R][16];
#pragma unroll
        for (int rr = 0; rr < R; ++rr) {
            const size_t ro = (size_t)(row0 + rr) * DM + lane * 8;
            if (YMODE == 0) {
#pragma unroll
                for (int i = 0; i < 2; ++i) { const float4 p0 = *(const float4*)(A.xin + ro + i * 512), p1 = *(const float4*)(A.xin + ro + i * 512 + 4);
                    xv[rr][i * 8 + 0] = p0.x; xv[rr][i * 8 + 1] = p0.y; xv[rr][i * 8 + 2] = p0.z; xv[rr][i * 8 + 3] = p0.w; xv[rr][i * 8 + 4] = p1.x; xv[rr][i * 8 + 5] = p1.y; xv[rr][i * 8 + 6] = p1.z; xv[rr][i * 8 + 7] = p1.w; }
            } else {
#pragma unroll
                for (int i = 0; i < 2; ++i) {
                    unpack8(*(const u32x4*)(A.XB + ro + i * 512), xv[rr] + i * 8);
                    unpack8(*(const u32x4*)(A.y + ro + i * 512), yv[rr] + i * 8);
                    if (YMODE == 2) { float y2[8]; unpack8(*(const u32x4*)(A.y + (size_t)MT * DM + ro + i * 512), y2);
#pragma unroll
                        for (int j = 0; j < 8; ++j) yv[rr][i * 8 + j] += y2[j]; }
                }
            }
        }
        if (YMODE == 2) {
#pragma unroll
            for (int rr = 0; rr < R; ++rr) { const u32x2 fw = *(const u32x2*)(A.yflag + (size_t)(row0 + rr) * 8);
                const unsigned f0 = __builtin_amdgcn_readfirstlane(fw.x), f1 = __builtin_amdgcn_readfirstlane(fw.y);
                if (f0 | f1) { const size_t ro = (size_t)(row0 + rr) * DM + lane * 8;
#pragma unroll
                    for (int sl = 0; sl < 2; ++sl) { const unsigned fs = sl ? f1 : f0;
#pragma unroll
                        for (int i = 0; i < 2; ++i) if ((fs >> (8 * ((lane >> 5) + 2 * i))) & 0xff) { float y2[8]; unpack8(*(const u32x4*)(A.y2 + (size_t)sl * MT * DM + ro + i * 512), y2);
#pragma unroll
                            for (int j = 0; j < 8; ++j) yv[rr][i * 8 + j] += y2[j]; } } } }
        }
        if (YMODE != 0) {
            float gg[16];
#pragma unroll
            for (int i = 0; i < 2; ++i) { const float4 g0 = *(const float4*)(A.gpost + i * 512 + lane * 8), g1 = *(const float4*)(A.gpost + i * 512 + lane * 8 + 4);
                gg[i * 8 + 0] = g0.x; gg[i * 8 + 1] = g0.y; gg[i * 8 + 2] = g0.z; gg[i * 8 + 3] = g0.w; gg[i * 8 + 4] = g1.x; gg[i * 8 + 5] = g1.y; gg[i * 8 + 6] = g1.z; gg[i * 8 + 7] = g1.w; }
            float ss[R];
#pragma unroll
            for (int rr = 0; rr < R; ++rr) { ss[rr] = 0.f;
#pragma unroll
                for (int j = 0; j < 16; ++j) ss[rr] += yv[rr][j] * yv[rr][j]; }
#pragma unroll
            for (int o = 1; o < 64; o <<= 1)
#pragma unroll
                for (int rr = 0; rr < R; ++rr) ss[rr] += __shfl_xor(ss[rr], o);
#pragma unroll
            for (int rr = 0; rr < R; ++rr) { const float r = rsqrtf(ss[rr] * (1.f / DM) + EPS);
#pragma unroll
                for (int j = 0; j < 16; ++j) xv[rr][j] += yv[rr][j] * r * gg[j]; }
        }
        if (FINAL) {
#pragma unroll
            for (int rr = 0; rr < R; ++rr)
#pragma unroll
                for (int i = 0; i < 2; ++i) { float* op = A.xout + (size_t)(row0 + rr) * DM + i * 512 + lane * 8;
                    *(float4*)op = make_float4(xv[rr][i * 8], xv[rr][i * 8 + 1], xv[rr][i * 8 + 2], xv[rr][i * 8 + 3]); *(float4*)(op + 4) = make_float4(xv[rr][i * 8 + 4], xv[rr][i * 8 + 5], xv[rr][i * 8 + 6], xv[rr][i * 8 + 7]); }
        } else {
            float ss[R];
#pragma unroll
            for (int rr = 0; rr < R; ++rr) {
#pragma unroll
                for (int i = 0; i < 2; ++i) { u32x4 o; o.x = pk2(xv[rr][i * 8], xv[rr][i * 8 + 1]); o.y = pk2(xv[rr][i * 8 + 2], xv[rr][i * 8 + 3]); o.z = pk2(xv[rr][i * 8 + 4], xv[rr][i * 8 + 5]); o.w = pk2(xv[rr][i * 8 + 6], xv[rr][i * 8 + 7]);
                    *(u32x4*)(A.XB + (size_t)(row0 + rr) * DM + i * 512 + lane * 8) = o;
                }
                ss[rr] = 0.f;
#pragma unroll
                for (int j = 0; j < 16; ++j) ss[rr] += xv[rr][j] * xv[rr][j];
            }
#pragma unroll
            for (int o = 1; o < 64; o <<= 1)
#pragma unroll
                for (int rr = 0; rr < R; ++rr) ss[rr] += __shfl_xor(ss[rr], o);
            float r2[R];
#pragma unroll
            for (int rr = 0; rr < R; ++rr) { r2[rr] = rsqrtf(ss[rr] * (1.f / DM) + EPS); if (lane == 0) A.rs[row0 + rr] = r2[rr]; }
            if (DT || ROUTE) {
                float gn[16];
#pragma unroll
                for (int i = 0; i < 2; ++i) { const float4 g0 = *(const float4*)(A.gnext + i * 512 + lane * 8), g1 = *(const float4*)(A.gnext + i * 512 + lane * 8 + 4);
                    gn[i * 8 + 0] = g0.x; gn[i * 8 + 1] = g0.y; gn[i * 8 + 2] = g0.z; gn[i * 8 + 3] = g0.w; gn[i * 8 + 4] = g1.x; gn[i * 8 + 5] = g1.y; gn[i * 8 + 6] = g1.z; gn[i * 8 + 7] = g1.w; }
                int re1[R], re2[R], lr1[R], lr2[R]; float rw1[R], rw2[R];
                volatile LAS int* lcnt = (volatile LAS int*)((LAS unsigned char*)wl + 40960);
                if (ROUTE) { __syncthreads(); if (tidq < 8) lcnt[tidq] = 0; __syncthreads(); }
#pragma unroll
                for (int rr = 0; rr < R; ++rr) {
                    const int row = row0 + rr;
                    float hv[16];
#pragma unroll
                    for (int j = 0; j < 16; ++j) hv[j] = (rr == 0 ? xv[0][j] : xv[R - 1][j]) * (rr == 0 ? r2[0] : r2[R - 1]) * gn[j];
                    if (DT) {
                        float pd[16];
#pragma unroll 4
                        for (int j = 0; j < 16; ++j) {
                            float p = 0.f;
#pragma unroll
                            for (int i = 0; i < 2; ++i) { const LAS float* wp = wl + j * DM + i * 512 + lane * 8;
                                const f32x4 w0 = *(const LAS f32x4*)wp, w1 = *(const LAS f32x4*)(wp + 4);
                                p += hv[i * 8 + 0] * w0[0] + hv[i * 8 + 1] * w0[1] + hv[i * 8 + 2] * w0[2] + hv[i * 8 + 3] * w0[3] + hv[i * 8 + 4] * w1[0] + hv[i * 8 + 5] * w1[1] + hv[i * 8 + 6] * w1[2] + hv[i * 8 + 7] * w1[3]; }
                            pd[j] = p;
                        }
                        const float dk = wave_sum16(pd, lane);
                        if ((lane & 3) == 0) A.dtraw[(size_t)row * 16 + (lane >> 2)] = dk;
                    }
                    if (ROUTE) {
                        float pl[8];
#pragma unroll 4
                        for (int e = 0; e < 8; ++e) {
                            float p = 0.f;
#pragma unroll
                            for (int i = 0; i < 2; ++i) { const LAS float* wp = wl + e * DM + i * 512 + lane * 8;
                                const f32x4 w0 = *(const LAS f32x4*)wp, w1 = *(const LAS f32x4*)(wp + 4);
                                p += hv[i * 8 + 0] * w0[0] + hv[i * 8 + 1] * w0[1] + hv[i * 8 + 2] * w0[2] + hv[i * 8 + 3] * w0[3] + hv[i * 8 + 4] * w1[0] + hv[i * 8 + 5] * w1[1] + hv[i * 8 + 6] * w1[2] + hv[i * 8 + 7] * w1[3]; }
                            pl[e] = p;
                        }
                        const float lk = wave_sum8(pl, lane);
                        float lg[8];
#pragma unroll
                        for (int e = 0; e < 8; ++e) lg[e] = __shfl(lk, e * 8);
                        int e1 = 0; float v1 = lg[0];
#pragma unroll
                        for (int e = 1; e < 8; ++e) if (lg[e] > v1) { v1 = lg[e]; e1 = e; }
                        int e2 = 0; float v2 = -3.0e38f;
#pragma unroll
                        for (int e = 0; e < 8; ++e) if (e != e1 && lg[e] > v2) { v2 = lg[e]; e2 = e; }
                        const float ex = __expf(v2 - v1);
                        re1[rr] = e1; re2[rr] = e2; rw1[rr] = 1.f / (1.f + ex); rw2[rr] = ex / (1.f + ex);
                        if (lane == 0) { lr1[rr] = __hip_atomic_fetch_add((LAS int*)lcnt + e1, 1, __ATOMIC_RELAXED, __HIP_MEMORY_SCOPE_WORKGROUP); lr2[rr] = __hip_atomic_fetch_add((LAS int*)lcnt + e2, 1, __ATOMIC_RELAXED, __HIP_MEMORY_SCOPE_WORKGROUP); }
                    }
                }
                if (ROUTE) {
                    __syncthreads();
                    if (tidq < 8) lcnt[8 + tidq] = (int)atomicAdd(&A.cnt[tidq * 64], (unsigned)lcnt[tidq]);
                    __syncthreads();
#pragma unroll
                    for (int rr = 0; rr < R; ++rr) {
                        const int row = row0 + rr;
                        int dst1 = 0, dst2 = 0;
                        if (lane == 0) {
                            const int e1 = re1[rr], e2 = re2[rr];
                            const int p1 = lcnt[8 + e1] + lr1[rr], p2 = lcnt[8 + e2] + lr2[rr];
                            A.list[e1 * MT + p1] = row * 2; A.gatev[e1 * MT + p1] = rw1[rr]; A.rsl[e1 * MT + p1] = r2[rr];
                            A.list[e2 * MT + p2] = row * 2 + 1; A.gatev[e2 * MT + p2] = rw2[rr]; A.rsl[e2 * MT + p2] = r2[rr];
                            dst1 = e1 * MT + p1; dst2 = e2 * MT + p2;
                        }
                        dst1 = __builtin_amdgcn_readfirstlane(dst1); dst2 = __builtin_amdgcn_readfirstlane(dst2);
#pragma unroll
                        for (int i = 0; i < 2; ++i) { u32x2 o8;
                            const float* xs = xv[rr] + i * 8;
                            o8.x = pg8_pk4(xs[0], xs[1], xs[2], xs[3]); o8.y = pg8_pk4(xs[4], xs[5], xs[6], xs[7]);
                            *(u32x2*)(A.x8 + (size_t)dst1 * DM + i * 512 + lane * 8) = o8; *(u32x2*)(A.x8 + (size_t)dst2 * DM + i * 512 + lane * 8) = o8; }
                    }
                }
            }
        }
    }
}

constexpr int DTW_LD = (DM + 8) * 2;
DEVI void ph_norm0_dt(const NormB& A, int vb0, int vbs, LAS unsigned char* lds) {
    const int tidq = opq((int)threadIdx.x); const int wid = tidq >> 6, lane = tidq & 63, fr = lane & 15, fq = lane >> 4;
    __syncthreads();
    for (int e = tidq; e < DM * 4; e += NTHR) { const int k = e >> 2, j4 = (e & 3) * 4;
        const float4 w = *(const float4*)(A.win + (size_t)k * EVEN_IN + 4096 + j4); const float g = A.gnext[k];
        const float wv[4] = {w.x * g, w.y * g, w.z * g, w.w * g};
#pragma unroll
        for (int i = 0; i < 4; ++i) { const unsigned short hi = f2bf(wv[i]); const unsigned short lo = f2bf(wv[i] - bf2f(hi));
            *(LAS unsigned short*)(lds + (j4 + i) * DTW_LD + k * 2) = hi; *(LAS unsigned short*)(lds + (16 + j4 + i) * DTW_LD + k * 2) = lo; } }
    __syncthreads();
    for (int row0 = (vb0 * 8 + wid) * 8; row0 < MT; row0 += vbs * 64) {
        const int row = row0 + (fr & 7);
        const float* xp = A.xin + (size_t)row * DM + fq * 8;
        bf16_t* xbp = A.XB + (size_t)row * DM + fq * 8;
        const LAS unsigned char* wp = lds + fr * DTW_LD + fq * 16;
        f32x4 acc = {0.f, 0.f, 0.f, 0.f}; float ss = 0.f;
        float4 cu[8][2], nx[8][2];
#pragma unroll
        for (int s2 = 0; s2 < 8; ++s2) { cu[s2][0] = *(const float4*)(xp + s2 * 32); cu[s2][1] = *(const float4*)(xp + s2 * 32 + 4); }
#pragma unroll 1
        for (int c = 0; c < 4; ++c) {
            if (c < 3) {
#pragma unroll
                for (int s2 = 0; s2 < 8; ++s2) { nx[s2][0] = *(const float4*)(xp + (c + 1) * 256 + s2 * 32); nx[s2][1] = *(const float4*)(xp + (c + 1) * 256 + s2 * 32 + 4); } }
#pragma unroll
            for (int s2 = 0; s2 < 8; ++s2) { const int kk = c * 8 + s2;
                const float v[8] = {cu[s2][0].x, cu[s2][0].y, cu[s2][0].z, cu[s2][0].w, cu[s2][1].x, cu[s2][1].y, cu[s2][1].z, cu[s2][1].w};
                u32x4 hw, lw;
                hw.x = cvt2bf(v[0], v[1]); hw.y = cvt2bf(v[2], v[3]); hw.z = cvt2bf(v[4], v[5]); hw.w = cvt2bf(v[6], v[7]);
                lw.x = cvt2bf(v[0] - bflo(hw.x), v[1] - bfhi(hw.x)); lw.y = cvt2bf(v[2] - bflo(hw.y), v[3] - bfhi(hw.y)); lw.z = cvt2bf(v[4] - bflo(hw.z), v[5] - bfhi(hw.z)); lw.w = cvt2bf(v[6] - bflo(hw.w), v[7] - bfhi(hw.w));
#pragma unroll
                for (int i = 0; i < 8; ++i) ss += v[i] * v[i];
                if (fr < 8) *(u32x4*)(xbp + kk * 32) = hw;
                const bf16x8 xh = __builtin_bit_cast(bf16x8, hw), xl = __builtin_bit_cast(bf16x8, lw);
                const bf16x8 wh = *(const LAS bf16x8*)(wp + kk * 64), wl = *(const LAS bf16x8*)(wp + 16 * DTW_LD + kk * 64);
                acc = __builtin_amdgcn_mfma_f32_16x16x32_bf16(xh, wh, acc, 0, 0, 0);
                acc = __builtin_amdgcn_mfma_f32_16x16x32_bf16(xl, wh, acc, 0, 0, 0);
                acc = __builtin_amdgcn_mfma_f32_16x16x32_bf16(xh, wl, acc, 0, 0, 0); }
#pragma unroll
            for (int s2 = 0; s2 < 8; ++s2) { cu[s2][0] = nx[s2][0]; cu[s2][1] = nx[s2][1]; }
        }
        ss += __shfl_xor(ss, 16); ss += __shfl_xor(ss, 32);
        const float r = rsqrtf(ss * (1.f / DM) + EPS);
        if (lane < 8) A.rs[row0 + lane] = r;
#pragma unroll
        for (int v = 0; v < 4; ++v) { const float rm = __shfl(r, (4 * fq + v) & 7);
            if (fq < 2) A.dtraw[(size_t)(row0 + 4 * fq + v) * 16 + fr] = acc[v] * rm; }
    }
}
DEVI void transpose_item(const float* W, int ldw, int K, int k0, int n0, bf16_t* WT, int drow0, LAS float* scr, int lane, const float* gain) {
    {
        const int ka = lane >> 3, n4 = (lane & 7) * 4;
        float4 wv[8];
#pragma unroll
        for (int i = 0; i < 8; ++i) wv[i] = *(const float4*)(W + (size_t)(k0 + i * 8 + ka) * ldw + n0 + n4);
#pragma unroll
        for (int i = 0; i < 8; ++i) { LAS float* d = scr + (i * 8 + ka) * 33 + n4; d[0] = wv[i].x; d[1] = wv[i].y; d[2] = wv[i].z; d[3] = wv[i].w; }
    }
    asm volatile("s_waitcnt lgkmcnt(0)" ::: "memory");
    const int c = lane & 7;
    float4 ga = make_float4(1.f, 1.f, 1.f, 1.f), gb = ga;
    if (gain) { ga = *(const float4*)(gain + k0 + 8 * c); gb = *(const float4*)(gain + k0 + 8 * c + 4); }
#pragma unroll
    for (int j = 0; j < 4; ++j) { const int n = (lane >> 3) + 8 * j; const LAS float* sp = scr + (8 * c) * 33 + n;
        u32x4 o; o.x = pk2(sp[0 * 33] * ga.x, sp[1 * 33] * ga.y); o.y = pk2(sp[2 * 33] * ga.z, sp[3 * 33] * ga.w); o.z = pk2(sp[4 * 33] * gb.x, sp[5 * 33] * gb.y); o.w = pk2(sp[6 * 33] * gb.z, sp[7 * 33] * gb.w);
        *(u32x4*)(WT + (size_t)(drow0 + n) * K + k0 + 8 * c) = o; }
    asm volatile("s_waitcnt lgkmcnt(0)" ::: "memory");
}
DEVI void transpose_item_fp8(const float* W, int ldw, int K, int k0, int n0, unsigned char* WT8, int drow0, LAS float* scr, int lane, const float* gain) {
    {
        const int ka = lane >> 3, n4 = (lane & 7) * 4;
        float4 wv[8];
#pragma unroll
        for (int i = 0; i < 8; ++i) wv[i] = *(const float4*)(W + (size_t)(k0 + i * 8 + ka) * ldw + n0 + n4);
#pragma unroll
        for (int i = 0; i < 8; ++i) { LAS float* d = scr + (i * 8 + ka) * 33 + n4; d[0] = wv[i].x; d[1] = wv[i].y; d[2] = wv[i].z; d[3] = wv[i].w; }
    }
    asm volatile("s_waitcnt lgkmcnt(0)" ::: "memory");
    const int c = lane & 7;
    float4 ga = make_float4(64.f, 64.f, 64.f, 64.f), gb = ga;
    if (gain) { ga = *(const float4*)(gain + k0 + 8 * c); gb = *(const float4*)(gain + k0 + 8 * c + 4); ga.x *= 64.f; ga.y *= 64.f; ga.z *= 64.f; ga.w *= 64.f; gb.x *= 64.f; gb.y *= 64.f; gb.z *= 64.f; gb.w *= 64.f; }
#pragma unroll
    for (int j = 0; j < 4; ++j) { const int n = (lane >> 3) + 8 * j; const LAS float* sp = scr + (8 * c) * 33 + n;
        u32x2 o; o.x = pg8_pk4(sp[0 * 33] * ga.x, sp[1 * 33] * ga.y, sp[2 * 33] * ga.z, sp[3 * 33] * ga.w); o.y = pg8_pk4(sp[4 * 33] * gb.x, sp[5 * 33] * gb.y, sp[6 * 33] * gb.z, sp[7 * 33] * gb.w);
        *(u32x2*)(WT8 + (size_t)(drow0 + n) * K + k0 + 8 * c) = o; }
    asm volatile("s_waitcnt lgkmcnt(0)" ::: "memory");
}
struct Job { int in_idx; unsigned src_off; int ldw; int K; int ncols; unsigned long long dst; int mode; int item0; int gain_idx; int gain_off; int fp8; };
constexpr int NJOBS = 11 + 24;
struct JobTable { Job j[NJOBS]; int total; };
constexpr JobTable make_jobs() {
    JobTable t{}; int n = 0, it = 0;
    auto add = [&](int idx, unsigned off, int ldw, int K, int ncols, unsigned long long dst, int mode, int gi, int go, int f8 = 0) { t.j[n] = Job{idx, off, ldw, K, ncols, dst, mode, it, gi, go, f8}; it += (K / 64) * (ncols / 32); ++n; };
    add(4, 0, EVEN_IN, DM, UW, W_IN, 0, 3, 0);
    add(12, 0, DM, DM, DM, W_OUTE, 0, -1, 0);
    add(15, 0, DFF, DM, DFF, W_GU, 1, 14, 0);
    add(16, 0, DFF, DM, DFF, W_GU, 2, 14, 0);
    add(17, 0, DM, DFF, DM, W_DN, 0, -1, 0);
    add(31, 0, DM, DM, DM, W_PG, 0, 30, 0);
    add(31, DM * DM, DM, DM, DM, W_PG + 2 * MiB, 0, 30, DM);
    add(32, 0, DM, PDIM, DM, W_PP, 0, -1, 0);
    add(32, PDIM * DM, DM, PDIM, DM, W_PP + 512 * 1024, 0, -1, 0);
    add(20, 0, 3072, DM, 3072, W_QKV, 0, 19, 0);
    add(22, 0, DM, DM, DM, W_OUTO, 0, -1, 0);
    for (int e = 0; e < NEXP; ++e) {
        add(26, (unsigned)e * DM * DFFE, DFFE, DM, DFFE, W_EGU + (unsigned long long)e * 7 * MiB, 1, 24, 0, 1);
        add(27, (unsigned)e * DM * DFFE, DFFE, DM, DFFE, W_EGU + (unsigned long long)e * 7 * MiB, 2, 24, 0, 1);
        add(28, (unsigned)e * DFFE * DM, DM, DFFE, DM, W_EDN + (unsigned long long)e * (7 * MiB / 2), 0, -1, 0, 1);
    }
    t.total = it; return t;
}
__device__ const JobTable g_jobs = make_jobs();
constexpr int ITEMS_DENSE = make_jobs().j[11].item0, ITEMS_ALL = make_jobs().total;
struct CvtIt { const float* src; unsigned char* dst; const float* gp; int ldw, K, k0, n0, drow0; };
DEVI void cvt_decode(CvtIt& c, int it, int& jb, const float* const* in, unsigned char* ws) {
    while (jb + 1 < NJOBS && g_jobs.j[jb + 1].item0 <= it) ++jb;
    const Job J = g_jobs.j[jb];
    const int r = it - J.item0; const int nblk = J.ncols / 32; const int kb = r / nblk, nb = r % nblk;
    const int n0 = nb * 32; int drow0 = n0;
    if (J.mode != 0) drow0 = (n0 >> 7) * 256 + (n0 & 127) + (J.mode == 2 ? 128 : 0);
    c.src = in[J.in_idx] + J.src_off; c.dst = ws + J.dst; c.gp = J.gain_idx >= 0 ? in[J.gain_idx] + J.gain_off : nullptr; c.ldw = J.ldw; c.K = J.K; c.k0 = kb * 64; c.n0 = n0; c.drow0 = drow0;
}
DEVI void fp8_item_load(float4 (&wv)[8], float4& ga, float4& gb, const CvtIt& c, int lane) {
    const int ka = lane >> 3, n4 = (lane & 7) * 4;
    ga = make_float4(1.f, 1.f, 1.f, 1.f); gb = ga;
    if (c.gp) { ga = *(const float4*)(c.gp + c.k0 + 8 * (lane & 7)); gb = *(const float4*)(c.gp + c.k0 + 8 * (lane & 7) + 4); }
#pragma unroll
    for (int i = 0; i < 8; ++i) wv[i] = *(const float4*)(c.src + (size_t)(c.k0 + i * 8 + ka) * c.ldw + c.n0 + n4);
}
DEVI void fp8_item_finish(const float4 (&wv)[8], float4 ga, float4 gb, const CvtIt& c, LAS float* scr, int lane) {
    { const int ka = lane >> 3, n4 = (lane & 7) * 4;
#pragma unroll
        for (int i = 0; i < 8; ++i) { LAS float* d = scr + (i * 8 + ka) * 33 + n4; d[0] = wv[i].x; d[1] = wv[i].y; d[2] = wv[i].z; d[3] = wv[i].w; } }
    asm volatile("s_waitcnt lgkmcnt(0)" ::: "memory");
    const int cc = lane & 7;
    ga.x *= 64.f; ga.y *= 64.f; ga.z *= 64.f; ga.w *= 64.f; gb.x *= 64.f; gb.y *= 64.f; gb.z *= 64.f; gb.w *= 64.f;
#pragma unroll
    for (int j = 0; j < 4; ++j) { const int n = (lane >> 3) + 8 * j; const LAS float* sp = scr + (8 * cc) * 33 + n;
        u32x2 o; o.x = pg8_pk4(sp[0 * 33] * ga.x, sp[1 * 33] * ga.y, sp[2 * 33] * ga.z, sp[3 * 33] * ga.w); o.y = pg8_pk4(sp[4 * 33] * gb.x, sp[5 * 33] * gb.y, sp[6 * 33] * gb.z, sp[7 * 33] * gb.w);
        *(u32x2*)(c.dst + (size_t)(c.drow0 + n) * c.K + c.k0 + 8 * cc) = o; }
    asm volatile("s_waitcnt lgkmcnt(0)" ::: "memory");
}
DEVI void ph_convert_experts(LAS unsigned char* lds, const float* const* in, unsigned char* ws, int it_lo, int it_hi, int vb0, int vbs) {
    const int tidq = opq((int)threadIdx.x); const int wid = __builtin_amdgcn_readfirstlane(tidq >> 6), lane = tidq & 63;
    LAS float* scr = (LAS float*)(lds + wid * 16384);
    int jb = 11; int it = it_lo + vb0 * 8 + wid; if (it >= it_hi) return;
    CvtIt cur, nxt; float4 wc[8], wn[8], gca, gcb, gna, gnb;
    cvt_decode(cur, it, jb, in, ws); fp8_item_load(wc, gca, gcb, cur, lane);
    for (;;) {
        const int itn = it + vbs * 8; const bool hn = itn < it_hi;
        if (hn) { cvt_decode(nxt, itn, jb, in, ws); fp8_item_load(wn, gna, gnb, nxt, lane); }
        fp8_item_finish(wc, gca, gcb, cur, scr, lane);
        if (!hn) break;
        cur = nxt; it = itn; gca = gna; gcb = gnb;
#pragma unroll
        for (int i = 0; i < 8; ++i) wc[i] = wn[i];
    }
}
DEVI void ph_convert_weights(LAS unsigned char* lds, const float* const* in, unsigned char* ws, int it_lo, int it_hi, int vb0, int vbs) {
    const int tidq = opq((int)threadIdx.x); const int wid = __builtin_amdgcn_readfirstlane(tidq >> 6), lane = tidq & 63;
    LAS float* scr = (LAS float*)(lds + wid * 16384);
    int jb = 0;
    for (int it = it_lo + vb0 * 8 + wid; it < it_hi; it += vbs * 8) {
        while (jb + 1 < NJOBS && g_jobs.j[jb + 1].item0 <= it) ++jb;
        const Job J = g_jobs.j[jb];
        const int r = it - J.item0; const int nblk = J.ncols / 32; const int kb = r / nblk, nb = r % nblk;
        const int n0 = nb * 32; int drow0 = n0;
        if (J.mode != 0) drow0 = (n0 >> 7) * 256 + (n0 & 127) + (J.mode == 2 ? 128 : 0);
        const float* gp = J.gain_idx >= 0 ? in[J.gain_idx] + J.gain_off : nullptr;
        if (J.fp8) transpose_item_fp8(in[J.in_idx] + J.src_off, J.ldw, J.K, kb * 64, n0, ws + J.dst, drow0, scr, lane, gp);
        else transpose_item(in[J.in_idx] + J.src_off, J.ldw, J.K, kb * 64, n0, (bf16_t*)(ws + J.dst), drow0, scr, lane, gp);
    }
}
DEVI void ph_cvt_rows(const float* src, bf16_t* dst, size_t n4, int vb0, int vbs) {
    for (size_t e = (size_t)vb0 * NTHR + opq((int)threadIdx.x); e < n4; e += (size_t)vbs * NTHR) {
        const float4 v = ((const float4*)src)[e]; u32x2 o; o.x = pk2(v.x, v.y); o.y = pk2(v.z, v.w); ((u32x2*)dst)[e] = o; }
}

namespace pg8 {
constexpr int BM = 256, BK = 64, HALF = 128, HTB = HALF * BK * 2, STAGE_BYTES = 8 * HTB, NXCD = 8, WGM = 8;
__host__ __device__ __forceinline__ int lds_byte(int r, int c) { const int st = (r >> 4) * 2 + (c >> 5), rr = r & 15, cc = c & 31, ob = rr * 64 + cc * 2; return st * 1024 + (ob ^ (((ob >> 9) & 1) << 5)); }
__host__ __device__ __forceinline__ void stage_rc(int b, int& R, int& C) { const int st = b / 1024, sb = b % 1024, swz = sb ^ (((sb >> 9) & 1) << 5); R = (st >> 1) * 16 + swz / 64; C = (st & 1) * 32 + (swz % 64) / 2; }
__host__ __device__ __forceinline__ int perm32(int rho) { const int n = rho >> 4, i = rho & 15; return 8 * (i >> 2) + 4 * n + (i & 3); }
struct Unit { int pm, pn; int row0; int arow0; int mvalid; int e; int mbase; int akoff; const char* B; };
DEVI void xcd_tile(int L, int nwg, int nM, int nN, int& pm, int& pn) {
    int wgid = L; { const int q = nwg / NXCD, r = nwg % NXCD, xcd = wgid % NXCD, off = wgid / NXCD; wgid = (xcd < r ? xcd * (q + 1) : r * (q + 1) + (xcd - r) * q) + off; }
    const int nig = WGM * nN, gid = wgid / nig, fm = gid * WGM, gsz = (nM - fm) < WGM ? (nM - fm) : WGM;
    pm = fm + ((wgid % nig) % gsz); pn = (wgid % nig) / gsz;
}
struct DenseOrder {
    int nM, nN, nwg, G, c; const char* Bt; size_t tstepB;
    DEVI void init(int M, int N, int K, const bf16_t* Bt_, int G_, int c_) { nM = M / BM; nN = N / BM; nwg = nM * nN; G = G_; c = c_; Bt = (const char*)Bt_; tstepB = (size_t)BM * K * 2; }
    DEVI bool next(int i, Unit& u) const { const long L = (long)i * G + c; if (L >= nwg) return false; xcd_tile((int)L, nwg, nM, nN, u.pm, u.pn); u.row0 = u.pm * BM; u.arow0 = u.row0; u.mvalid = BM; u.e = 0; u.mbase = 0; u.akoff = 0; u.B = Bt + (size_t)u.pn * tstepB; return true; }
};
struct TailOrder {
    int nM, nN, nwg, nb, r; const char* Bt; size_t tstepB;
    DEVI void init(int M, int N, int K, const bf16_t* Bt_, int G_, int c_, int first) { nM = M / BM; nN = N / BM; nwg = nM * nN; Bt = (const char*)Bt_; tstepB = (size_t)BM * K * 2;
        if (first >= G_) first = 0; nb = G_ - first; r = c_ - first; }
    DEVI bool next(int i, Unit& u) const { if (r < 0) return false; const long L = (long)i * nb + r; if (L >= nwg) return false; u.pm = (int)L / nN; u.pn = (int)L % nN; u.row0 = u.pm * BM; u.arow0 = u.row0; u.mvalid = BM; u.e = 0; u.mbase = 0; u.akoff = 0; u.B = Bt + (size_t)u.pn * tstepB; return true; }
};
struct MoeOrder {
    int nM, nN, nwg, G, c; const char* Bt; size_t estepB, tstepB; const volatile LAS int* tab; bool per_expert;
    DEVI void init(const unsigned* cnt, volatile LAS int* tab_, int N, int K, const bf16_t* Bt_, size_t estep_bytes, bool per_expert_, int G_, int c_) {
        __syncthreads();
        if (threadIdx.x < 8) tab_[16 + threadIdx.x] = (int)__hip_atomic_load(cnt + threadIdx.x * 64, __ATOMIC_RELAXED, __HIP_MEMORY_SCOPE_AGENT);
        __syncthreads();
        if (threadIdx.x == 0) { int t = 0;
            for (int e = 0; e < 8; ++e) { const int n = tab_[16 + e]; tab_[e] = t; t += (n + BM - 1) / BM; }
            tab_[8] = t; }
        __syncthreads();
        tab = tab_; nM = __builtin_amdgcn_readfirstlane(tab_[8]); nN = N / BM; nwg = nM * nN; G = G_; c = c_; Bt = (const char*)Bt_; estepB = estep_bytes; tstepB = (size_t)BM * K * 2; per_expert = per_expert_; nmain = nwg; split_phase = false; khalfB = 0;
    }
    int nmain; bool split_phase; int khalfB;
    DEVI void set_split(bool ksplit, bool phase2, int khalf_bytes) { const int r = nwg % G; const bool can = ksplit && r > 0 && 2 * r <= G; nmain = can ? nwg - r : nwg; split_phase = phase2; khalfB = khalf_bytes; }
    DEVI int tail_first() const { return nmain == nwg ? nwg % G : 2 * (nwg - nmain); }
    DEVI bool next(int i, Unit& u) const {
        long L; int kh = 0;
        if (!split_phase) { L = (long)i * G + c; if (L >= nmain) return false; }
        else { if (i > 0 || c >= 2 * (nwg - nmain)) return false; L = nmain + (c >> 1); kh = c & 1; }
        xcd_tile((int)L, nwg, nM, nN, u.pm, u.pn);
        int e = 0;
        for (int k = 1; k < 8; ++k) if (u.pm >= __builtin_amdgcn_readfirstlane(tab[k])) e = k;
        const int t0 = __builtin_amdgcn_readfirstlane(tab[e]), n = __builtin_amdgcn_readfirstlane(tab[16 + e]);
        u.e = e; u.row0 = u.pm * BM; const int m0 = (u.pm - t0) * BM; u.mbase = m0; u.arow0 = per_expert ? e * MT + m0 : u.row0; u.mvalid = (n - m0) < BM ? (n - m0) : BM;
        u.akoff = kh * khalfB; u.B = Bt + (size_t)e * estepB + (size_t)u.pn * tstepB + u.akoff; return true; }
};
DEVI unsigned cvt_pk_bf16(float lo, float hi) { return cvt2bf(lo, hi); }

constexpr int EPI_OFF = MISC_OFF + 1024, EPI_SLICE = 1024;
static_assert(EPI_OFF + 8 * EPI_SLICE <= LDS_BYTES, "epilogue scalar slices");
DEVI void epi_dma(const void* g, LAS unsigned char* dst) { __builtin_amdgcn_global_load_lds((const unsigned*)g, (LAS unsigned*)dst, 4, 0, 0); }
struct EpiBf16 { static constexpr bool PERM = true; bf16_t* O; int ldc; const float* rs;
    DEVI void pre(LAS unsigned char* esl, const Unit& u, int wr, int lane) const {
        if (rs) { epi_dma(rs + u.row0 + wr * 64 + lane, esl); epi_dma(rs + u.row0 + wr * 64 + HALF + lane, esl + 256); } }
    DEVI void operator()(const f32x4 (&acc)[2][2][4][2], const Unit& u, int wr, int wc, int fr, int fq, const LAS unsigned char* esl) const {
        float pv[8];
#pragma unroll
        for (int q = 0; q < 8; ++q) pv[q] = ((const LAS float*)esl)[(q >> 2) * 64 + (q & 3) * 16 + fr];
        const int row0 = u.row0 + wr * 64 + fr, col0 = u.pn * BM + wc * 32 + 8 * fq;
#pragma unroll
        for (int ai = 0; ai < 2; ++ai)
#pragma unroll
            for (int m = 0; m < 4; ++m) { const int row = row0 + ai * HALF + m * 16; bf16_t* rowp = O + (size_t)row * ldc + col0;
                const float sc = rs ? pv[ai * 4 + m] : 1.f;
#pragma unroll
                for (int bj = 0; bj < 2; ++bj) { const f32x4 v0 = acc[ai][bj][m][0] * sc, v1 = acc[ai][bj][m][1] * sc;
                    u32x4 w; w.x = cvt_pk_bf16(v0[0], v0[1]); w.y = cvt_pk_bf16(v0[2], v0[3]); w.z = cvt_pk_bf16(v1[0], v1[1]); w.w = cvt_pk_bf16(v1[2], v1[3]);
                    *(u32x4*)(rowp + bj * HALF) = w; } }
    } };
struct EpiPleGate { static constexpr bool PERM = true; bf16_t* T; int ldc; const float* rs;
    DEVI void pre(LAS unsigned char* esl, const Unit& u, int wr, int lane) const {
        epi_dma(rs + u.row0 + wr * 64 + lane, esl); epi_dma(rs + u.row0 + wr * 64 + HALF + lane, esl + 256); }
    DEVI void operator()(const f32x4 (&acc)[2][2][4][2], const Unit& u, int wr, int wc, int fr, int fq, const LAS unsigned char* esl) const {
        float pv[8];
#pragma unroll
        for (int q = 0; q < 8; ++q) pv[q] = ((const LAS float*)esl)[(q >> 2) * 64 + (q & 3) * 16 + fr];
        const int row0 = u.row0 + wr * 64 + fr, col0 = u.pn * BM + wc * 32 + 8 * fq;
#pragma unroll
        for (int ai = 0; ai < 2; ++ai)
#pragma unroll
            for (int m = 0; m < 4; ++m) { const int row = row0 + ai * HALF + m * 16; bf16_t* rowp = T + (size_t)row * ldc + col0;
                const float sc = pv[ai * 4 + m];
#pragma unroll
                for (int bj = 0; bj < 2; ++bj) { const f32x4 v0 = acc[ai][bj][m][0] * sc, v1 = acc[ai][bj][m][1] * sc;
                    const u32x4 pp = *(const u32x4*)(rowp + bj * HALF);
                    u32x4 w; w.x = cvt_pk_bf16(sigmoid_f(v0[0]) * bflo(pp.x), sigmoid_f(v0[1]) * bfhi(pp.x)); w.y = cvt_pk_bf16(sigmoid_f(v0[2]) * bflo(pp.y), sigmoid_f(v0[3]) * bfhi(pp.y));
                    w.z = cvt_pk_bf16(sigmoid_f(v1[0]) * bflo(pp.z), sigmoid_f(v1[1]) * bfhi(pp.z)); w.w = cvt_pk_bf16(sigmoid_f(v1[2]) * bflo(pp.w), sigmoid_f(v1[3]) * bfhi(pp.w));
                    *(u32x4*)(rowp + bj * HALF) = w; } }
    } };
DEVI f32x4 swiglu4(const f32x4 ag, const f32x4 au, const float tneg, const float k2) {
    const f32x4 t = ag * tneg; f32x4 d;
    d[0] = __builtin_amdgcn_exp2f(t[0]); d[1] = __builtin_amdgcn_exp2f(t[1]); d[2] = __builtin_amdgcn_exp2f(t[2]); d[3] = __builtin_amdgcn_exp2f(t[3]);
    d = d + 1.0f; f32x4 rc;
    rc[0] = __builtin_amdgcn_rcpf(d[0]); rc[1] = __builtin_amdgcn_rcpf(d[1]); rc[2] = __builtin_amdgcn_rcpf(d[2]); rc[3] = __builtin_amdgcn_rcpf(d[3]);
    return (ag * au) * (rc * k2);
}
struct EpiSwiglu { static constexpr bool PERM = true; bf16_t* O; int ldc; const float* rs; int grouped;
    DEVI void pre(LAS unsigned char* esl, const Unit& u, int wr, int lane) const {
        const float* rsb = grouped ? rs + u.e * MT + u.mbase : rs + u.row0; const int vm1 = (grouped ? u.mvalid : BM) - 1;
#pragma unroll
        for (int i = 0; i < 2; ++i) { const int rl = wr * 64 + lane + i * HALF; epi_dma(rsb + (rl <= vm1 ? rl : vm1), esl + i * 256); } }
    DEVI void operator()(const f32x4 (&acc)[2][2][4][2], const Unit& u, int wr, int wc, int fr, int fq, const LAS unsigned char* esl) const {
        float pv[8];
#pragma unroll
        for (int q = 0; q < 8; ++q) pv[q] = ((const LAS float*)esl)[(q >> 2) * 64 + (q & 3) * 16 + fr];
        const int row0 = u.row0 + wr * 64 + fr, col0 = u.pn * HALF + wc * 32 + 8 * fq; const int vm1e = (grouped ? u.mvalid : BM) - 1;
#pragma unroll
        for (int ai = 0; ai < 2; ++ai)
#pragma unroll
            for (int m = 0; m < 4; ++m) { const int rl = wr * 64 + fr + ai * HALF + m * 16; bf16_t* rowp = O + (size_t)(u.row0 + rl) * ldc + col0;
                const float sc = rl <= vm1e ? pv[ai * 4 + m] : 0.f;
                const f32x4 o0 = swiglu4(acc[ai][0][m][0], acc[ai][1][m][0], sc * -1.44269504f, sc * sc), o1 = swiglu4(acc[ai][0][m][1], acc[ai][1][m][1], sc * -1.44269504f, sc * sc);
                u32x4 w; w.x = cvt_pk_bf16(o0[0], o0[1]); w.y = cvt_pk_bf16(o0[2], o0[3]); w.z = cvt_pk_bf16(o1[0], o1[1]); w.w = cvt_pk_bf16(o1[2], o1[3]);
                *(u32x4*)rowp = w; }
    } };
constexpr float W8_SCALE = 64.f, ACT8_SCALE = 8.f;
struct EpiSwiglu8 { static constexpr bool PERM = true; unsigned char* O; int ldc; const float* rs;
    DEVI void pre(LAS unsigned char* esl, const Unit& u, int wr, int lane) const {
        const float* rsb = rs + u.e * MT + u.mbase; const int vm1 = u.mvalid - 1;
#pragma unroll
        for (int i = 0; i < 2; ++i) { const int rl = wr * 64 + lane + i * HALF; epi_dma(rsb + (rl <= vm1 ? rl : vm1), esl + i * 256); } }
    DEVI void operator()(const f32x4 (&acc)[2][2][4][2], const Unit& u, int wr, int wc, int fr, int fq, const LAS unsigned char* esl) const {
        float pv[8];
#pragma unroll
        for (int q = 0; q < 8; ++q) pv[q] = ((const LAS float*)esl)[(q >> 2) * 64 + (q & 3) * 16 + fr];
        const int col0 = u.pn * HALF + wc * 32 + 8 * fq;
#pragma unroll
        for (int ai = 0; ai < 2; ++ai)
#pragma unroll
            for (int m = 0; m < 4; ++m) { const int rl = wr * 64 + fr + ai * HALF + m * 16; unsigned char* rowp = O + (size_t)(u.row0 + rl) * ldc + col0;
                const float sc = rl < u.mvalid ? pv[ai * 4 + m] * (1.f / W8_SCALE) : 0.f;
                const f32x4 o0 = swiglu4(acc[ai][0][m][0], acc[ai][1][m][0], sc * -1.44269504f, sc * sc * ACT8_SCALE), o1 = swiglu4(acc[ai][0][m][1], acc[ai][1][m][1], sc * -1.44269504f, sc * sc * ACT8_SCALE);
                u32x2 w; w.x = pg8_pk4(o0[0], o0[1], o0[2], o0[3]); w.y = pg8_pk4(o1[0], o1[1], o1[2], o1[3]);
                *(u32x2*)rowp = w; }
    } };
struct EpiMoeDown { static constexpr bool PERM = true; bf16_t* Y; const int* list; const float* gatev; float oscale; size_t y2off; unsigned char* flag;
    DEVI void pre(LAS unsigned char* esl, const Unit& u, int wr, int lane) const {
        const int* lb = list + u.e * MT + u.mbase; const float* gb = gatev + u.e * MT + u.mbase; const int vm1 = u.mvalid - 1;
#pragma unroll
        for (int i = 0; i < 2; ++i) { const int rl = wr * 64 + lane + i * HALF; const int ri = rl <= vm1 ? rl : vm1; epi_dma(gb + ri, esl + i * 256); epi_dma(lb + ri, esl + 512 + i * 256); } }
    DEVI void operator()(const f32x4 (&acc)[2][2][4][2], const Unit& u, int wr, int wc, int fr, int fq, const LAS unsigned char* esl) const {
        float pv[8]; int pt[8];
#pragma unroll
        for (int q = 0; q < 8; ++q) { pv[q] = ((const LAS float*)esl)[(q >> 2) * 64 + (q & 3) * 16 + fr]; pt[q] = ((const LAS int*)(esl + 512))[(q >> 2) * 64 + (q & 3) * 16 + fr]; }
        const int col0 = u.pn * BM + wc * 32 + 8 * fq;
        const bool second = u.akoff != 0; bf16_t* const Yb = Y + (second ? y2off : (size_t)0);
#pragma unroll
        for (int ai = 0; ai < 2; ++ai)
#pragma unroll
            for (int m = 0; m < 4; ++m) { const int rl = wr * 64 + fr + ai * HALF + m * 16;
                const int tsl = pt[ai * 4 + m]; const float gt = pv[ai * 4 + m] * oscale;
                if (rl < u.mvalid) {
                    bf16_t* rowp = Yb + (size_t)(tsl & 1) * ((size_t)MT * DM) + (size_t)(tsl >> 1) * DM + col0;
                    if (second && wc == 0 && fq == 0) flag[tsl * 4 + u.pn] = 1;
#pragma unroll
                    for (int bj = 0; bj < 2; ++bj) { const f32x4 v0 = acc[ai][bj][m][0], v1 = acc[ai][bj][m][1];
                        u32x4 w; w.x = cvt_pk_bf16(v0[0] * gt, v0[1] * gt); w.y = cvt_pk_bf16(v0[2] * gt, v0[3] * gt); w.z = cvt_pk_bf16(v1[0] * gt, v1[1] * gt); w.w = cvt_pk_bf16(v1[2] * gt, v1[3] * gt);
                        *(u32x4*)(rowp + bj * HALF) = w; } } }
    } };

typedef int v8i __attribute__((ext_vector_type(8)));
typedef int v4i __attribute__((ext_vector_type(4)));
DEVI v8i cat8(const bf16x8 lo, const bf16x8 hi) { const v4i a = __builtin_bit_cast(v4i, lo), b = __builtin_bit_cast(v4i, hi); return __builtin_shufflevector(a, b, 0, 1, 2, 3, 4, 5, 6, 7); }
struct Frag16 { bf16x8 k[2]; };
struct Frag8 { v8i v; };
template <bool F> struct FragSel { typedef Frag16 T; };
template <> struct FragSel<true> { typedef Frag8 T; };
template <class Epi, class Sched, bool FP8 = false>
DEVI void gemm_phase(LAS unsigned char* lds, const bf16_t* A, const int K, const Sched& S, const Epi& E, const int Kloop = 0) {
    const int tid = opq((int)threadIdx.x), wid = __builtin_amdgcn_readfirstlane(tid >> 6), lane = tid & 63, wr = wid >> 2, wc = wid & 3, fr = lane & 15, fq = lane >> 4;
    const int nt = (Kloop ? Kloop : K) / BK;
    unsigned voffA[2], voffB[2];
#pragma unroll
    for (int i = 0; i < 2; ++i) { int R, C; stage_rc(tid * 16 + i * 8192, R, C); const int Rb = Epi::PERM ? ((R & ~31) + perm32(R & 31)) : R;
        voffA[i] = (unsigned)(R * K + C) * 2u; voffB[i] = (unsigned)(Rb * K + C) * 2u; }
    const size_t kstep = (size_t)(BK * 2);
    const size_t hstep = (size_t)HALF * K * 2;
    const size_t rstep = (size_t)K * 2;
    const unsigned ldsw = (unsigned)wid * 1024u;
    const int aoff = lds_byte(wr * 64 + fr, fq * 8), boff = lds_byte(wc * 32 + fr, fq * 8);
#define PG8_SA(b, h) (((b) * 2 + (h)) * HTB)
#define PG8_SB(b, h) ((4 + (b) * 2 + (h)) * HTB)
#define PG8_STAGE(bufoff, gbase, voff) do { _Pragma("unroll") for (int _i = 0; _i < 2; ++_i) \
        __builtin_amdgcn_global_load_lds((const unsigned*)((const char*)(gbase) + (voff)[_i]), (LAS unsigned*)(lds + (bufoff) + ldsw + _i * 8192), 16, 0, 0); } while (0)
#define PG8_LDA(dst, b, h) do { _Pragma("unroll") for (int m = 0; m < 4; ++m) { if constexpr (FP8) dst[m].v = cat8(*(const LAS bf16x8*)(lds + PG8_SA(b, h) + aoff + m * 2048), *(const LAS bf16x8*)(lds + PG8_SA(b, h) + aoff + m * 2048 + 1024)); \
        else { _Pragma("unroll") for (int k = 0; k < 2; ++k) dst[m].k[k] = *(const LAS bf16x8*)(lds + PG8_SA(b, h) + aoff + m * 2048 + k * 1024); } } } while (0)
#define PG8_LDB(dst, b, h) do { _Pragma("unroll") for (int n = 0; n < 2; ++n) { if constexpr (FP8) dst[n].v = cat8(*(const LAS bf16x8*)(lds + PG8_SB(b, h) + boff + n * 2048), *(const LAS bf16x8*)(lds + PG8_SB(b, h) + boff + n * 2048 + 1024)); \
        else { _Pragma("unroll") for (int k = 0; k < 2; ++k) dst[n].k[k] = *(const LAS bf16x8*)(lds + PG8_SB(b, h) + boff + n * 2048 + k * 1024); } } } while (0)
#define PG8_MMA(ai, bj, At, Bt) do { __builtin_amdgcn_s_setprio(1); _Pragma("unroll") for (int m = 0; m < 4; ++m) _Pragma("unroll") for (int n = 0; n < 2; ++n) { \
        if constexpr (FP8) asm volatile("s_nop 1\n\tv_mfma_scale_f32_16x16x128_f8f6f4 %0, %1, %2, %0, %3, %3 op_sel_hi:[0,0,0]" : "+v"(acc[ai][bj][m][n]) : "v"(Bt[n].v), "v"(At[m].v), "v"(sc1)); \
        else { _Pragma("unroll") for (int k = 0; k < 2; ++k) acc[ai][bj][m][n] = __builtin_amdgcn_mfma_f32_16x16x32_bf16(Bt[n].k[k], At[m].k[k], acc[ai][bj][m][n], 0, 0, 0); } } \
        __builtin_amdgcn_s_setprio(0); } while (0)
#define PG8_WAIT_V(n) asm volatile("s_waitcnt vmcnt(" #n ")" ::: "memory")
#define PG8_WAIT_L(n) asm volatile("s_waitcnt lgkmcnt(" #n ")" ::: "memory")
#define PG8_BAR __builtin_amdgcn_s_barrier()
#define PG8_SCHED __builtin_amdgcn_sched_barrier(0)
    Unit cur, nxt; int ui = 0;
    if (!S.next(0, cur)) return;
    int sc1 = 0x7F7F7F7F; asm volatile("" : "+v"(sc1));
    f32x4 acc[2][2][4][2];
#pragma unroll
    for (int a = 0; a < 2; ++a)
#pragma unroll
        for (int b = 0; b < 2; ++b)
#pragma unroll
            for (int m = 0; m < 4; ++m)
#pragma unroll
                for (int n = 0; n < 2; ++n) acc[a][b][m][n] = (f32x4){0.f, 0.f, 0.f, 0.f};
    typename FragSel<FP8>::T At[4], B0[2], B1[2];
    const char* cA = (const char*)A + (size_t)cur.arow0 * rstep + cur.akoff;
    const char* cB = cur.B;
    LAS unsigned char* const esl = lds + EPI_OFF + wid * EPI_SLICE;
    E.pre(esl, cur, wr, lane);
    PG8_STAGE(PG8_SB(0, 0), cB, voffB); PG8_STAGE(PG8_SA(0, 0), cA, voffA); PG8_STAGE(PG8_SB(0, 1), cB + hstep, voffB); PG8_STAGE(PG8_SA(0, 1), cA + hstep, voffA);
    if (wr == 1) PG8_BAR;
    PG8_WAIT_V(4); PG8_BAR;
    PG8_STAGE(PG8_SB(1, 0), cB + kstep, voffB); PG8_STAGE(PG8_SA(1, 0), cA + kstep, voffA); PG8_STAGE(PG8_SB(1, 1), cB + hstep + kstep, voffB);
    PG8_WAIT_V(6); PG8_BAR;
    for (;;) {
        const bool has_next = S.next(ui + 1, nxt);
        const char* nA = has_next ? (const char*)A + (size_t)nxt.arow0 * rstep + nxt.akoff : cA; const char* nB = has_next ? nxt.B : cB;
#pragma unroll 1
        for (int t = 0; t < nt; t += 2) {
            const bool last = (t == nt - 2);
            const char* a1 = cA + (size_t)(t + 1) * kstep;
            const char* a2 = last ? nA : cA + (size_t)(t + 2) * kstep; const char* b2 = last ? nB : cB + (size_t)(t + 2) * kstep;
            const char* a3 = a2 + kstep; const char* b3 = b2 + kstep;
            PG8_LDB(B0, 0, 0); PG8_SCHED; PG8_LDA(At, 0, 0); PG8_STAGE(PG8_SA(1, 1), a1 + hstep, voffA);
            PG8_WAIT_L(8); PG8_BAR; PG8_WAIT_L(0); PG8_MMA(0, 0, At, B0); PG8_BAR; PG8_SCHED;
            PG8_LDB(B1, 0, 1); PG8_STAGE(PG8_SB(0, 0), b2, voffB);
            PG8_BAR; PG8_WAIT_L(0); PG8_MMA(0, 1, At, B1); PG8_BAR;
            PG8_LDA(At, 0, 1); PG8_STAGE(PG8_SA(0, 0), a2, voffA);
            PG8_BAR; PG8_WAIT_L(0); PG8_MMA(1, 0, At, B0); PG8_BAR; PG8_SCHED;
            PG8_STAGE(PG8_SB(0, 1), b2 + hstep, voffB);
            PG8_WAIT_V(6); PG8_BAR; PG8_MMA(1, 1, At, B1); PG8_BAR;
            PG8_LDB(B0, 1, 0); PG8_SCHED; PG8_LDA(At, 1, 0); PG8_STAGE(PG8_SA(0, 1), a2 + hstep, voffA);
            PG8_WAIT_L(8); PG8_BAR; PG8_WAIT_L(0); PG8_MMA(0, 0, At, B0); PG8_BAR; PG8_SCHED;
            PG8_LDB(B1, 1, 1); PG8_STAGE(PG8_SB(1, 0), b3, voffB);
            PG8_BAR; PG8_WAIT_L(0); PG8_MMA(0, 1, At, B1); PG8_BAR;
            PG8_LDA(At, 1, 1); PG8_STAGE(PG8_SA(1, 0), a3, voffA);
            PG8_BAR; PG8_WAIT_L(0); PG8_MMA(1, 0, At, B0); PG8_BAR; PG8_SCHED;
            PG8_STAGE(PG8_SB(1, 1), b3 + hstep, voffB);
            PG8_WAIT_V(6); PG8_BAR; PG8_MMA(1, 1, At, B1); PG8_BAR;
        }
        if constexpr (FP8) asm volatile("s_nop 15\n\ts_nop 15" ::: "memory");
        E(acc, cur, wr, wc, fr, fq, esl);
        if (!has_next) break;
#pragma unroll
        for (int a = 0; a < 2; ++a)
#pragma unroll
            for (int b = 0; b < 2; ++b)
#pragma unroll
                for (int m = 0; m < 4; ++m)
#pragma unroll
                    for (int n = 0; n < 2; ++n) acc[a][b][m][n] = (f32x4){0.f, 0.f, 0.f, 0.f};
        cur = nxt; cA = nA; cB = nB; ++ui;
        E.pre(esl, cur, wr, lane);
        if constexpr (FP8) asm volatile("s_nop 7" ::: "memory");
    }
    PG8_WAIT_V(0);
    if (wr == 0) PG8_BAR;
    PG8_BAR;
#undef PG8_SA
#undef PG8_SB
#undef PG8_STAGE
#undef PG8_LDA
#undef PG8_LDB
#undef PG8_MMA
#undef PG8_WAIT_V
#undef PG8_WAIT_L
#undef PG8_BAR
#undef PG8_SCHED
}
}

DEVI float lb_of(const float* lbraw, int ch) {
    const float r0 = lbraw[ch], r1 = lbraw[512 + ch], r2 = lbraw[1024 + ch];
    const float mx = fmaxf(r0, fmaxf(r1, r2));
    const float e0 = __expf(r0 - mx), e1 = __expf(r1 - mx), e2 = __expf(r2 - mx);
    return e0 / (e0 + e1 + e2);
}
constexpr int HQ = 0, HK = 17408, HKH = 34816, HV = 53248, HDV = 71680, HZERO = 73728, HOT = 75776, H_END = HOT + 64 * 528;
static_assert(H_END <= 131072, "hgrn lds");
constexpr size_t HS_SCAN = (size_t)16 * 16384;
struct HgrnRaw { unsigned qf[16]; u32x4 v0, v1; };
DEVI void hgrn_load(HgrnRaw& R, const bf16_t* u, const bf16_t* VT, int dir, int b, int h, int t0, int c, int I, int tid) {
    const bf16_t* up = u + ((size_t)b * SEQ + t0 + 16 * I) * UW + h * 128 + c;
    const int fcol = dir ? 1024 : 512;
#pragma unroll
    for (int j = 0; j < 16; ++j) R.qf[j] = (unsigned)up[(size_t)j * UW] | ((unsigned)up[(size_t)j * UW + fcol] << 16);
    { const int e = tid, r = e >> 3, cch = e & 7; R.v0 = *(const u32x4*)(VT + ((size_t)b * 512 + h * 128 + r) * SEQ + t0 + cch * 8); }
    { const int e = tid + NTHR, r = e >> 3, cch = e & 7; R.v1 = *(const u32x4*)(VT + ((size_t)b * 512 + h * 128 + r) * SEQ + t0 + cch * 8); }
}
DEVI void hgrn_prep(LAS unsigned char* lds, const HgrnRaw& R, float lbv, int dir, int c, int I, int tid) {
    float ff[16], kk[16], qq[16];
    { const int e = tid, r = e >> 3, cch = e & 7; *(LAS u32x4*)(lds + HV + r * 144 + cch * 16) = R.v0; }
    { const int e = tid + NTHR, r = e >> 3, cch = e & 7; *(LAS u32x4*)(lds + HV + r * 144 + cch * 16) = R.v1; }
#pragma unroll
    for (int j = 0; j < 16; ++j) {
        const float fr = bfhi(R.qf[j]), qr = bflo(R.qf[j]);
        const float f = lbv + (1.f - lbv) * sigmoid_f(fr);
        ff[j] = f; kk[j] = 1.f - f; qq[j] = silu_f(qr);
    }
    float run = 1.f;
#pragma unroll
    for (int jj = 0; jj < 16; ++jj) { const int j = dir ? 15 - jj : jj; run = fmaxf(run * ff[j], 1e-30f); ff[j] = run; }
    const float PG = run;
    float kh[16];
#pragma unroll
    for (int j = 0; j < 16; ++j) {
        const float kt = kk[j] * __builtin_amdgcn_rcpf(ff[j]);
        kh[j] = kt * PG;
        *(LAS bf16_t*)(lds + HQ + (16 * I + j) * 272 + c * 2) = f2bf(qq[j] * ff[j]);
        *(LAS bf16_t*)(lds + HK + (16 * I + j) * 272 + c * 2) = f2bf(kt);
    }
    u32x4 w0, w1;
    w0.x = pk2(kh[0], kh[1]); w0.y = pk2(kh[2], kh[3]); w0.z = pk2(kh[4], kh[5]); w0.w = pk2(kh[6], kh[7]);
    w1.x = pk2(kh[8], kh[9]); w1.y = pk2(kh[10], kh[11]); w1.z = pk2(kh[12], kh[13]); w1.w = pk2(kh[14], kh[15]);
    *(LAS u32x4*)(lds + HKH + c * 144 + I * 32) = w0; *(LAS u32x4*)(lds + HKH + c * 144 + I * 32 + 16) = w1;
    *(LAS float*)(lds + HDV + (I * 128 + c) * 4) = PG;
}
DEVI void hgrn_update(LAS unsigned char* lds, f32x4 (&Sacc)[8], int I, int wid, int fr, int fq) {
    const int voff = (fq < 2) ? HV + (16 * wid + fr) * 144 + (16 * I + 8 * fq) * 2 : HZERO;
    const int koff = (fq < 2) ? HKH + fr * 144 + (16 * I + 8 * fq) * 2 : HZERO;
    const int kstep = (fq < 2) ? 16 * 144 : 0;
    const bf16x8 vb = *(const LAS bf16x8*)(lds + voff);
    bf16x8 ka[8]; f32x4 dv[8];
#pragma unroll
    for (int m = 0; m < 8; ++m) { ka[m] = *(const LAS bf16x8*)(lds + koff + m * kstep); dv[m] = *(const LAS f32x4*)(lds + HDV + (I * 128 + 16 * m + 4 * fq) * 4); }
#pragma unroll
    for (int m = 0; m < 8; ++m) Sacc[m] = __builtin_amdgcn_mfma_f32_16x16x32_bf16(ka[m], vb, Sacc[m] * dv[m], 0, 0, 0);
}
DEVI void ph_hgrn_states(LAS unsigned char* lds, const bf16_t* u, const bf16_t* VT, const float* lbraw, bf16_t* HS, float* HD, int vb0, int vbs) {
    const int tid = opq((int)threadIdx.x), wid = __builtin_amdgcn_readfirstlane(tid >> 6), lane = tid & 63, fr = lane & 15, fq = lane >> 4;
    const int pc = tid & 127, pI = tid >> 7;
    for (int unit = vb0; unit < NB * 4 * 2 * 16; unit += vbs) {
        const int seg = unit & 15, dir = (unit >> 4) & 1, h = (unit >> 5) & 3, b = unit >> 7;
        const float lbv = lb_of(lbraw, h * 128 + pc);
        f32x4 Sacc[8];
#pragma unroll
        for (int m = 0; m < 8; ++m) Sacc[m] = (f32x4){0.f, 0.f, 0.f, 0.f};
        float gprod = 1.f;
        if (tid < 4) *(LAS unsigned*)(lds + HZERO + tid * 4) = 0u;
        HgrnRaw R; hgrn_load(R, u, VT, dir, b, h, seg * 256 + (dir ? 3 : 0) * 64, pc, pI, tid);
#pragma unroll 1
        for (int sbi = 0; sbi < 4; ++sbi) {
            const int sb = dir ? 3 - sbi : sbi;
            const int t0 = seg * 256 + sb * 64;
            __syncthreads();
            hgrn_prep(lds, R, lbv, dir, pc, pI, tid);
            if (sbi < 3) { const int sbn = dir ? 3 - (sbi + 1) : sbi + 1; hgrn_load(R, u, VT, dir, b, h, seg * 256 + sbn * 64, pc, pI, tid); }
            __syncthreads();
            if (tid < 128) gprod *= (*(const LAS float*)(lds + HDV + tid * 4) * *(const LAS float*)(lds + HDV + (128 + tid) * 4)) * (*(const LAS float*)(lds + HDV + (256 + tid) * 4) * *(const LAS float*)(lds + HDV + (384 + tid) * 4));
#pragma unroll 1
            for (int ii = 0; ii < 4; ++ii) { const int I = dir ? 3 - ii : ii; hgrn_update(lds, Sacc, I, wid, fr, fq); }
        }
        const size_t scan = (size_t)(b * 4 + h) * 2 + dir;
        bf16_t* dst = HS + scan * HS_SCAN + (size_t)seg * 16384;
#pragma unroll
        for (int m = 0; m < 8; ++m) { u32x2 w; w.x = pk2(Sacc[m][0], Sacc[m][1]); w.y = pk2(Sacc[m][2], Sacc[m][3]);
            *(u32x2*)(dst + (16 * wid + fr) * 128 + 16 * m + 4 * fq) = w; }
        if (tid < 128) HD[(scan * 16 + seg) * 128 + tid] = gprod;
    }
    __syncthreads();
}
DEVI void ph_hgrn_scan(bf16_t* HS, const float* HD, int vb0, int vbs) {
    const int tid = opq((int)threadIdx.x);
    for (int idx = vb0 * NTHR + tid; idx < 32 * 4096; idx += vbs * NTHR) {
        const int scan = idx >> 12, e4 = idx & 4095, k4 = (e4 & 31) * 4; const int dir = scan & 1;
        u32x2* base = (u32x2*)(HS + (size_t)scan * HS_SCAN) + e4;
        const float* hd = HD + (size_t)scan * 16 * 128 + k4;
        u32x2 d[16]; float4 dec[16];
#pragma unroll
        for (int i = 0; i < 16; ++i) { d[i] = base[(size_t)i * 4096]; dec[i] = *(const float4*)(hd + i * 128); }
        float s0 = 0.f, s1 = 0.f, s2 = 0.f, s3 = 0.f;
#define HSCAN_STEP(i) { const float t0 = bflo(d[i].x), t1 = bfhi(d[i].x), t2 = bflo(d[i].y), t3 = bfhi(d[i].y); d[i].x = pk2(s0, s1); d[i].y = pk2(s2, s3); \
            s0 = s0 * dec[i].x + t0; s1 = s1 * dec[i].y + t1; s2 = s2 * dec[i].z + t2; s3 = s3 * dec[i].w + t3; }
        if (dir == 0) {
#pragma unroll
            for (int i = 0; i < 16; ++i) HSCAN_STEP(i)
        } else {
#pragma unroll
            for (int i = 15; i >= 0; --i) HSCAN_STEP(i)
        }
#undef HSCAN_STEP
#pragma unroll
        for (int i = 0; i < 16; ++i) base[(size_t)i * 4096] = d[i];
    }
}
DEVI void ph_hgrn_out(LAS unsigned char* lds, const bf16_t* u, const bf16_t* VT, const float* lbraw, const float* a_norm, const bf16_t* HS, float* OF, bf16_t* ocat, int vb0, int vbs) {
    const int tid = opq((int)threadIdx.x), wid = __builtin_amdgcn_readfirstlane(tid >> 6), lane = tid & 63, fr = lane & 15, fq = lane >> 4;
    const int pc = tid & 127, pI = tid >> 7;
    const int otok = tid >> 3, opart = tid & 7;
    for (int unit = vb0; unit < NB * 4 * 16; unit += vbs) {
        const int seg = unit & 15, h = (unit >> 4) & 3, b = unit >> 6;
        const float lbv = lb_of(lbraw, h * 128 + pc);
        if (tid < 4) *(LAS unsigned*)(lds + HZERO + tid * 4) = 0u;
#pragma unroll 1
        for (int dir = 0; dir < 2; ++dir) {
            const size_t scan = (size_t)(b * 4 + h) * 2 + dir;
            const bf16_t* src = HS + scan * HS_SCAN + (size_t)seg * 16384;
            f32x4 Sacc[8];
#pragma unroll
            for (int m = 0; m < 8; ++m) { const u32x2 w = *(const u32x2*)(src + (16 * wid + fr) * 128 + 16 * m + 4 * fq);
                Sacc[m][0] = bflo(w.x); Sacc[m][1] = bfhi(w.x); Sacc[m][2] = bflo(w.y); Sacc[m][3] = bfhi(w.y); }
            HgrnRaw R; hgrn_load(R, u, VT, dir, b, h, seg * 256 + (dir ? 3 : 0) * 64, pc, pI, tid);
#pragma unroll 1
            for (int sbi = 0; sbi < 4; ++sbi) {
                const int sb = dir ? 3 - sbi : sbi;
                const int t0 = seg * 256 + sb * 64;
                const size_t tokb = (size_t)b * SEQ + t0;
                __syncthreads();
                hgrn_prep(lds, R, lbv, dir, pc, pI, tid);
                if (sbi < 3) { const int sbn = dir ? 3 - (sbi + 1) : sbi + 1; hgrn_load(R, u, VT, dir, b, h, seg * 256 + sbn * 64, pc, pI, tid); }
                __syncthreads();
#pragma unroll 1
                for (int ii = 0; ii < 4; ++ii) {
                    const int I = dir ? 3 - ii : ii;
                    f32x4 oT = {0.f, 0.f, 0.f, 0.f};
                    const LAS unsigned char* qrow = lds + HQ + (16 * I + fr) * 272;
#pragma unroll
                    for (int ks = 0; ks < 4; ++ks) {
                        u32x4 sa; sa.x = pg8::cvt_pk_bf16(Sacc[2 * ks][0], Sacc[2 * ks][1]); sa.y = pg8::cvt_pk_bf16(Sacc[2 * ks][2], Sacc[2 * ks][3]);
                        sa.z = pg8::cvt_pk_bf16(Sacc[2 * ks + 1][0], Sacc[2 * ks + 1][1]); sa.w = pg8::cvt_pk_bf16(Sacc[2 * ks + 1][2], Sacc[2 * ks + 1][3]);
                        const u32x2 q0 = *(const LAS u32x2*)(qrow + (32 * ks + 4 * fq) * 2), q1 = *(const LAS u32x2*)(qrow + (32 * ks + 16 + 4 * fq) * 2);
                        u32x4 qb; qb.x = q0.x; qb.y = q0.y; qb.z = q1.x; qb.w = q1.y;
                        oT = __builtin_amdgcn_mfma_f32_16x16x32_bf16(__builtin_bit_cast(bf16x8, sa), __builtin_bit_cast(bf16x8, qb), oT, 0, 0, 0);
                    }
                    f32x4 sT = {0.f, 0.f, 0.f, 0.f};
                    const LAS unsigned char* krow = lds + HK + (16 * I + fr) * 272;
#pragma unroll
                    for (int ks = 0; ks < 4; ++ks) {
                        const bf16x8 ka = *(const LAS bf16x8*)(krow + (32 * ks + 8 * fq) * 2), qb = *(const LAS bf16x8*)(qrow + (32 * ks + 8 * fq) * 2);
                        sT = __builtin_amdgcn_mfma_f32_16x16x32_bf16(ka, qb, sT, 0, 0, 0);
                    }
                    float pv[4];
#pragma unroll
                    for (int rg = 0; rg < 4; ++rg) { const int sl = 4 * fq + rg; const bool ok = dir ? (sl >= fr) : (sl <= fr); pv[rg] = ok ? sT[rg] : 0.f; }
                    u32x4 pb; pb.x = pg8::cvt_pk_bf16(pv[0], pv[1]); pb.y = pg8::cvt_pk_bf16(pv[2], pv[3]); pb.z = 0u; pb.w = 0u;
                    const u32x2 v0 = *(const LAS u32x2*)(lds + HV + (16 * wid + fr) * 144 + (16 * I + 4 * fq) * 2);
                    u32x4 va; va.x = v0.x; va.y = v0.y; va.z = 0u; va.w = 0u;
                    oT = __builtin_amdgcn_mfma_f32_16x16x32_bf16(__builtin_bit_cast(bf16x8, va), __builtin_bit_cast(bf16x8, pb), oT, 0, 0, 0);
                    if (dir == 0) *(f32x4*)(OF + (tokb + 16 * I + fr) * 512 + h * 128 + 16 * wid + 4 * fq) = oT;
                    else *(LAS f32x4*)(lds + HOT + (16 * I + fr) * 528 + (16 * wid + 4 * fq) * 4) = oT;
                    hgrn_update(lds, Sacc, I, wid, fr, fq);
                }
                if (dir == 1) {
                    __syncthreads();
                    const LAS float* orow = (const LAS float*)(lds + HOT + otok * 528) + opart * 16;
                    float* ofp = OF + (tokb + otok) * 512 + h * 128 + opart * 16;
                    float v[16]; float ss = 0.f;
#pragma unroll
                    for (int q2 = 0; q2 < 8; ++q2) { const unsigned long long w = __hip_atomic_load((unsigned long long*)(ofp + q2 * 2), __ATOMIC_RELAXED, __HIP_MEMORY_SCOPE_AGENT);
                        v[2 * q2] = __uint_as_float((unsigned)w) + orow[2 * q2]; v[2 * q2 + 1] = __uint_as_float((unsigned)(w >> 32)) + orow[2 * q2 + 1];
                        ss += v[2 * q2] * v[2 * q2] + v[2 * q2 + 1] * v[2 * q2 + 1]; }
                    ss += __shfl_xor(ss, 1); ss += __shfl_xor(ss, 2); ss += __shfl_xor(ss, 4);
                    const float rn = rsqrtf(ss * (1.f / 128.f) + EPS);
                    const bf16_t* gp = u + (tokb + otok) * UW + 2048 + h * 128 + opart * 16;
                    const u32x4 g0 = *(const u32x4*)gp, g1 = *(const u32x4*)(gp + 8);
                    const unsigned gw[8] = {g0.x, g0.y, g0.z, g0.w, g1.x, g1.y, g1.z, g1.w};
                    unsigned ow[8];
#pragma unroll
                    for (int q2 = 0; q2 < 8; ++q2) { const float an0 = a_norm[opart * 16 + 2 * q2], an1 = a_norm[opart * 16 + 2 * q2 + 1];
                        ow[q2] = pk2(v[2 * q2] * rn * an0 * silu_f(bflo(gw[q2])), v[2 * q2 + 1] * rn * an1 * silu_f(bfhi(gw[q2]))); }
                    bf16_t* op = ocat + (tokb + otok) * DM + h * 128 + opart * 16;
                    u32x4 o0, o1; o0.x = ow[0]; o0.y = ow[1]; o0.z = ow[2]; o0.w = ow[3]; o1.x = ow[4]; o1.y = ow[5]; o1.z = ow[6]; o1.w = ow[7];
                    *(u32x4*)op = o0; *(u32x4*)(op + 8) = o1;
                }
            }
            asm volatile("s_waitcnt vmcnt(0)" ::: "memory");
        }
    }
    __syncthreads();
}

DEVI void ph_prep(const bf16_t* u, const float* cw, const float* cb, bf16_t* xconv, bf16_t* XT, bf16_t* VT, int vb0, int vbs) {
    const int tid = opq((int)threadIdx.x);
    for (int unit = vb0; unit < NB * 32 * 3; unit += vbs) {
        const int cg = unit % 3, tb = (unit / 3) & 31, b = unit / 96;
        const int t0 = tb * 128;
        if (cg < 2) {
            const int ch = cg * 512 + tid;
            float w[5];
#pragma unroll
            for (int j = 0; j < 5; ++j) w[j] = cw[j * 1024 + ch];
            const float bias = cb[ch];
            const bf16_t* up = u + (size_t)b * SEQ * UW + 3072 + ch;
            float v0, v1, v2, v3;
            v0 = (t0 - 2 >= 0) ? bf2f(up[(size_t)(t0 - 2) * UW]) : 0.f;
            v1 = (t0 - 1 >= 0) ? bf2f(up[(size_t)(t0 - 1) * UW]) : 0.f;
            v2 = bf2f(up[(size_t)t0 * UW]);
            v3 = bf2f(up[(size_t)(t0 + 1) * UW]);
            for (int t8 = 0; t8 < 128; t8 += 32) {
                float nx[32];
#pragma unroll
                for (int i = 0; i < 32; ++i) { const int tt = t0 + t8 + i + 2; nx[i] = (tt < SEQ) ? bf2f(up[(size_t)tt * UW]) : 0.f; }
                unsigned pk[16];
#pragma unroll
                for (int i = 0; i < 32; ++i) {
                    const float o = silu_f(bias + w[0] * v0 + w[1] * v1 + w[2] * v2 + w[3] * v3 + w[4] * nx[i]);
                    const bf16_t ob = f2bf(o);
                    xconv[(size_t)(b * SEQ + t0 + t8 + i) * 1024 + ch] = ob;
                    if (i & 1) pk[i >> 1] |= ((unsigned)ob << 16); else pk[i >> 1] = ob;
                    v0 = v1; v1 = v2; v2 = v3; v3 = nx[i];
                }
                if (ch < 768) {
#pragma unroll
                    for (int q = 0; q < 4; ++q) { u32x4 o4; o4.x = pk[4 * q]; o4.y = pk[4 * q + 1]; o4.z = pk[4 * q + 2]; o4.w = pk[4 * q + 3]; *(u32x4*)(XT + ((size_t)b * 768 + ch) * SEQ + t0 + t8 + 8 * q) = o4; } }
            }
        } else {
            const int ch = tid;
            const bf16_t* up = u + (size_t)b * SEQ * UW + 1536 + ch;
            for (int t8 = 0; t8 < 128; t8 += 32) {
                unsigned pk[16];
#pragma unroll
                for (int i = 0; i < 32; ++i) { const unsigned ob = up[(size_t)(t0 + t8 + i) * UW]; if (i & 1) pk[i >> 1] |= (ob << 16); else pk[i >> 1] = ob; }
#pragma unroll
                for (int q = 0; q < 4; ++q) { u32x4 o4; o4.x = pk[4 * q]; o4.y = pk[4 * q + 1]; o4.z = pk[4 * q + 2]; o4.w = pk[4 * q + 3]; *(u32x4*)(VT + ((size_t)b * 512 + ch) * SEQ + t0 + t8 + 8 * q) = o4; }
            }
        }
    }
}

constexpr int MB_XT = 0, MB_BX = 256 * 272, MB_DT = MB_BX + 128 * 272, MB_CS = MB_DT + 8 * 128 * 4, MB_TOT = MB_CS + 8 * 128 * 4, MB_END = MB_TOT + 64;
static_assert(MB_END <= 131072, "mamba lds");
constexpr size_t MS_SCAN = (size_t)32 * 8192;
DEVI bf16x8 pack8(const float* v) { u32x4 w; w.x = pg8::cvt_pk_bf16(v[0], v[1]); w.y = pg8::cvt_pk_bf16(v[2], v[3]); w.z = pg8::cvt_pk_bf16(v[4], v[5]); w.w = pg8::cvt_pk_bf16(v[6], v[7]); return __builtin_bit_cast(bf16x8, w); }
DEVI void mamba_tables(LAS unsigned char* lds, const float* dtraw, const float* A_log, const float* dt_bias, int b, int g, int c, int wid, int lane) {
    LAS float* tdt = (LAS float*)(lds + MB_DT); LAS float* tcs = (LAS float*)(lds + MB_CS); LAS float* ttot = (LAS float*)(lds + MB_TOT);
    const int r = wid >> 1, dir = wid & 1, hd = 4 * g + r;
    const float A = -__expf(A_log[dir * 8 + hd]), bias = dt_bias[dir * 8 + hd];
    const size_t tk = (size_t)b * SEQ + c * 128 + 2 * lane;
    const float dt0 = softplus_f(dtraw[tk * 16 + dir * 8 + hd] + bias), dt1 = softplus_f(dtraw[(tk + 1) * 16 + dir * 8 + hd] + bias);
    const float a0 = dt0 * A, a1 = dt1 * A;
    float sc = a0 + a1;
#pragma unroll
    for (int off = 1; off < 64; off <<= 1) { const float v = __shfl_up(sc, off); if (lane >= off) sc += v; }
    const float total = __shfl(sc, 63);
    const float pre0 = sc - a1, pre1 = sc;
    const float c0 = dir ? (total - pre0 + a0) : pre0, c1 = dir ? (total - pre1 + a1) : pre1;
    tdt[wid * 128 + 2 * lane] = dt0; tdt[wid * 128 + 2 * lane + 1] = dt1;
    tcs[wid * 128 + 2 * lane] = c0; tcs[wid * 128 + 2 * lane + 1] = c1;
    if (lane == 0) ttot[wid] = total;
}
DEVI void stage_rows(LAS unsigned char* dst, const bf16_t* src, size_t src_stride, int rows, int tid) {
    for (int e = tid; e < rows * 16; e += NTHR) { const int r = e >> 4, cch = e & 15; *(LAS u32x4*)(dst + r * 272 + cch * 16) = *(const u32x4*)(src + (size_t)r * src_stride + cch * 8); }
}
DEVI void ph_mamba_states(LAS unsigned char* lds, const bf16_t* XT, const float* dtraw, const float* A_log, const float* dt_bias, bf16_t* MS, float* MD, int vb0, int vbs) {
    const int tid = opq((int)threadIdx.x), wid = __builtin_amdgcn_readfirstlane(tid >> 6), lane = tid & 63, fr = lane & 15, fq = lane >> 4;
    LAS float* tdt = (LAS float*)(lds + MB_DT); LAS float* tcs = (LAS float*)(lds + MB_CS); LAS float* ttot = (LAS float*)(lds + MB_TOT);
    for (int unit = vb0; unit < NB * 2 * 32; unit += vbs) {
        const int c = unit & 31, g = (unit >> 5) & 1, b = unit >> 6;
        __syncthreads();
        stage_rows(lds + MB_XT, XT + ((size_t)b * 768 + g * 256) * SEQ + c * 128, SEQ, 256, tid);
        stage_rows(lds + MB_BX, XT + ((size_t)b * 768 + 512 + g * 128) * SEQ + c * 128, SEQ, 128, tid);
        mamba_tables(lds, dtraw, A_log, dt_bias, b, g, c, wid, lane);
        __syncthreads();
        if (lane == 0) MD[((size_t)(b * 8 + 4 * g + (wid >> 1)) * 2 + (wid & 1)) * 32 + c] = __expf(ttot[wid]);
        for (int hdd = 0; hdd < 8; ++hdd) {
            const int r = hdd >> 1, dir = hdd & 1, hd = 4 * g + r;
            const float tot = ttot[hdd];
            f32x4 acc[4];
#pragma unroll
            for (int pt = 0; pt < 4; ++pt) acc[pt] = (f32x4){0.f, 0.f, 0.f, 0.f};
#pragma unroll
            for (int ks = 0; ks < 4; ++ks) {
                const int s0 = 32 * ks + 8 * fq;
                const u32x4 braw = *(const LAS u32x4*)(lds + MB_BX + (16 * wid + fr) * 272 + s0 * 2);
                float bw[8];
                const unsigned bu[4] = {braw.x, braw.y, braw.z, braw.w};
#pragma unroll
                for (int j = 0; j < 8; ++j) { const float bv = (j & 1) ? bfhi(bu[j >> 1]) : bflo(bu[j >> 1]);
                    bw[j] = bv * tdt[hdd * 128 + s0 + j] * __expf(tot - tcs[hdd * 128 + s0 + j]); }
                const bf16x8 Bf = pack8(bw);
#pragma unroll
                for (int pt = 0; pt < 4; ++pt) {
                    const bf16x8 Af = *(const LAS bf16x8*)(lds + MB_XT + (r * 64 + 16 * pt + fr) * 272 + s0 * 2);
                    acc[pt] = __builtin_amdgcn_mfma_f32_16x16x32_bf16(Bf, Af, acc[pt], 0, 0, 0);
                }
            }
            bf16_t* dst = MS + ((size_t)(b * 8 + hd) * 2 + dir) * MS_SCAN + (size_t)c * 8192;
#pragma unroll
            for (int pt = 0; pt < 4; ++pt) { u32x2 w; w.x = pk2(acc[pt][0], acc[pt][1]); w.y = pk2(acc[pt][2], acc[pt][3]);
                *(u32x2*)(dst + (16 * pt + fr) * 128 + 16 * wid + 4 * fq) = w; }
        }
    }
    __syncthreads();
}
DEVI void ph_mamba_scan(bf16_t* MS, const float* MD, int vb0, int vbs) {
    const int tid = opq((int)threadIdx.x);
    for (int idx = vb0 * NTHR + tid; idx < 64 * 2048; idx += vbs * NTHR) {
        const int scan = idx >> 11, e4 = idx & 2047; const int dir = scan & 1;
        u32x2* base = (u32x2*)(MS + (size_t)scan * MS_SCAN) + e4;
        const float* md = MD + (size_t)scan * 32;
        float h0 = 0.f, h1 = 0.f, h2 = 0.f, h3 = 0.f;
#pragma unroll 1
        for (int half = 0; half < 2; ++half) {
            const int c0 = (dir ? 1 - half : half) * 16;
            u32x2 d[16]; float dec[16];
#pragma unroll
            for (int i = 0; i < 16; ++i) { d[i] = base[(size_t)(c0 + i) * 2048]; dec[i] = md[c0 + i]; }
#define MSCAN_STEP(i) { const float t0 = bflo(d[i].x), t1 = bfhi(d[i].x), t2 = bflo(d[i].y), t3 = bfhi(d[i].y); d[i].x = pk2(h0, h1); d[i].y = pk2(h2, h3); \
                h0 = h0 * dec[i] + t0; h1 = h1 * dec[i] + t1; h2 = h2 * dec[i] + t2; h3 = h3 * dec[i] + t3; }
            if (dir == 0) {
#pragma unroll
                for (int i = 0; i < 16; ++i) MSCAN_STEP(i)
            } else {
#pragma unroll
                for (int i = 15; i >= 0; --i) MSCAN_STEP(i)
            }
#undef MSCAN_STEP
#pragma unroll
            for (int i = 0; i < 16; ++i) base[(size_t)(c0 + i) * 2048] = d[i];
        }
    }
}
DEVI void ph_mamba_out(LAS unsigned char* lds, const bf16_t* u, const bf16_t* xconv, const bf16_t* XT, const float* dtraw, const float* A_log, const float* dt_bias, const float* Dskip, const float* b_norm,
                       const bf16_t* MS, bf16_t* ocat, int vb0, int vbs) {
    const int tid = opq((int)threadIdx.x), wid = __builtin_amdgcn_readfirstlane(tid >> 6), lane = tid & 63, fr = lane & 15, fq = lane >> 4;
    LAS float* tdt = (LAS float*)(lds + MB_DT); LAS float* tcs = (LAS float*)(lds + MB_CS);
    for (int unit = vb0; unit < NB * 2 * 32; unit += vbs) {
        const int c = unit & 31, g = (unit >> 5) & 1, b = unit >> 6;
        const size_t tok0 = (size_t)b * SEQ + c * 128;
        __syncthreads();
        stage_rows(lds + MB_XT, XT + ((size_t)b * 768 + g * 256) * SEQ + c * 128, SEQ, 256, tid);
        stage_rows(lds + MB_BX, xconv + tok0 * 1024 + 512 + g * 128, 1024, 128, tid);
        mamba_tables(lds, dtraw, A_log, dt_bias, b, g, c, wid, lane);
        const int tl = 16 * wid + fr;
        bf16x8 Cf[4];
#pragma unroll
        for (int ks = 0; ks < 4; ++ks) Cf[ks] = *(const bf16x8*)(xconv + (tok0 + tl) * 1024 + 768 + g * 128 + 32 * ks + 8 * fq);
        __syncthreads();
        f32x4 GT[8];
#pragma unroll
        for (int st = 0; st < 8; ++st) { GT[st] = (f32x4){0.f, 0.f, 0.f, 0.f};
            bf16x8 Af[4];
#pragma unroll
            for (int ks = 0; ks < 4; ++ks) Af[ks] = *(const LAS bf16x8*)(lds + MB_BX + (16 * st + fr) * 272 + (32 * ks + 8 * fq) * 2);
#pragma unroll
            for (int ks = 0; ks < 4; ++ks) GT[st] = __builtin_amdgcn_mfma_f32_16x16x32_bf16(Af[ks], Cf[ks], GT[st], 0, 0, 0); }
        float ss = 0.f;
        __syncthreads();
        u32x2 hpre[4];
        { const bf16_t* hin0 = MS + ((size_t)(b * 8 + 4 * g) * 2) * MS_SCAN + (size_t)c * 8192;
#pragma unroll
          for (int q = 0; q < 4; ++q) hpre[q] = ((const u32x2*)hin0)[tid + q * NTHR]; }
#pragma unroll 1
        for (int r = 0; r < 4; ++r) {
            const int hd = 4 * g + r;
            f32x4 yv[4];
#pragma unroll
            for (int pt = 0; pt < 4; ++pt) yv[pt] = (f32x4){0.f, 0.f, 0.f, 0.f};
#pragma unroll 1
            for (int dir = 0; dir < 2; ++dir) {
                const int hdd = r * 2 + dir;
                const float cst = tcs[hdd * 128 + tl];
                LAS unsigned char* hbuf = lds + MB_BX + (hdd & 1) * 17408;
#pragma unroll
                for (int q = 0; q < 4; ++q) { const int e4 = tid + q * NTHR, pp = e4 >> 5, n4 = (e4 & 31) * 4;
                    *(LAS u32x2*)(hbuf + pp * 272 + n4 * 2) = hpre[q]; }
                if (hdd < 7) { const int hn = hdd + 1; const bf16_t* hinn = MS + ((size_t)(b * 8 + 4 * g + (hn >> 1)) * 2 + (hn & 1)) * MS_SCAN + (size_t)c * 8192;
#pragma unroll
                    for (int q = 0; q < 4; ++q) hpre[q] = ((const u32x2*)hinn)[tid + q * NTHR]; }
                __syncthreads();
                f32x4 yo[4];
#pragma unroll
                for (int pt = 0; pt < 4; ++pt) { yo[pt] = (f32x4){0.f, 0.f, 0.f, 0.f};
                    bf16x8 hf[4];
#pragma unroll
                    for (int ks = 0; ks < 4; ++ks) hf[ks] = *(const LAS bf16x8*)(hbuf + (16 * pt + fr) * 272 + (32 * ks + 8 * fq) * 2);
#pragma unroll
                    for (int ks = 0; ks < 4; ++ks) yo[pt] = __builtin_amdgcn_mfma_f32_16x16x32_bf16(hf[ks], Cf[ks], yo[pt], 0, 0, 0); }
                const float eo = __expf(cst);
#pragma unroll
                for (int pt = 0; pt < 4; ++pt) yv[pt] += yo[pt] * eo;
#pragma unroll
                for (int kp = 0; kp < 4; ++kp) {
                    const bool skip = dir ? (2 * kp + 1 < wid) : (2 * kp > wid);
                    if (!skip) {
                        float pv[8];
#pragma unroll
                        for (int hlf = 0; hlf < 2; ++hlf) { const int st = 2 * kp + hlf;
                            const f32x4 cs4 = *(const LAS f32x4*)(tcs + hdd * 128 + 16 * st + 4 * fq), dt4 = *(const LAS f32x4*)(tdt + hdd * 128 + 16 * st + 4 * fq);
#pragma unroll
                            for (int rg = 0; rg < 4; ++rg) { const int sl = 16 * st + 4 * fq + rg;
                                const bool ok = dir ? (sl >= tl) : (sl <= tl);
                                const float e = __expf(fminf(cst - cs4[rg], 0.f));
                                pv[hlf * 4 + rg] = ok ? GT[st][rg] * e * dt4[rg] : 0.f; } }
                        u32x2 x0[4], x1[4];
#pragma unroll
                        for (int pt = 0; pt < 4; ++pt) { const LAS unsigned char* xr = lds + MB_XT + (r * 64 + 16 * pt + fr) * 272;
                            x0[pt] = *(const LAS u32x2*)(xr + (32 * kp + 4 * fq) * 2); x1[pt] = *(const LAS u32x2*)(xr + (32 * kp + 16 + 4 * fq) * 2); }
                        const bf16x8 Pf = pack8(pv);
#pragma unroll
                        for (int pt = 0; pt < 4; ++pt) {
                            u32x4 xa; xa.x = x0[pt].x; xa.y = x0[pt].y; xa.z = x1[pt].x; xa.w = x1[pt].y;
                            yv[pt] = __builtin_amdgcn_mfma_f32_16x16x32_bf16(__builtin_bit_cast(bf16x8, xa), Pf, yv[pt], 0, 0, 0);
                        }
                    }
                }
            }
            const float Dk = Dskip[hd];
#pragma unroll
            for (int pt = 0; pt < 4; ++pt) {
                const int p0 = 16 * pt + 4 * fq;
                const u32x2 xr = *(const u32x2*)(xconv + (tok0 + tl) * 1024 + hd * 64 + p0);
                const u32x2 zr = *(const u32x2*)(u + (tok0 + tl) * UW + 2560 + hd * 64 + p0);
                const float xs[4] = {bflo(xr.x), bfhi(xr.x), bflo(xr.y), bfhi(xr.y)}, zs[4] = {bflo(zr.x), bfhi(zr.x), bflo(zr.y), bfhi(zr.y)};
                float yy[4];
#pragma unroll
                for (int rg = 0; rg < 4; ++rg) { const float y = (yv[pt][rg] + Dk * xs[rg]) * silu_f(zs[rg]); yy[rg] = y; ss += y * y; }
                const unsigned long long o = (unsigned long long)pk2(yy[0], yy[1]) | ((unsigned long long)pk2(yy[2], yy[3]) << 32);
                __hip_atomic_store((unsigned long long*)(ocat + (tok0 + tl) * DM + 512 + g * 256 + r * 64 + p0), o, __ATOMIC_RELAXED, __HIP_MEMORY_SCOPE_AGENT);
            }
        }
        ss += __shfl_xor(ss, 16); ss += __shfl_xor(ss, 32);
        const float rn = rsqrtf(ss * (1.f / 256.f) + EPS);
        asm volatile("s_waitcnt vmcnt(0)" ::: "memory");
        unsigned long long pk[16];
#pragma unroll
        for (int q = 0; q < 16; ++q) pk[q] = __hip_atomic_load((unsigned long long*)(ocat + (tok0 + tl) * DM + 512 + g * 256 + (q >> 2) * 64 + 16 * (q & 3) + 4 * fq), __ATOMIC_RELAXED, __HIP_MEMORY_SCOPE_AGENT);
#pragma unroll
        for (int r = 0; r < 4; ++r)
#pragma unroll
            for (int pt = 0; pt < 4; ++pt) {
                const int cc = g * 256 + r * 64 + 16 * pt + 4 * fq;
                unsigned long long* op = (unsigned long long*)(ocat + (tok0 + tl) * DM + 512 + cc);
                const unsigned long long v = pk[r * 4 + pt];
                const unsigned vlo = (unsigned)v, vhi = (unsigned)(v >> 32);
                const float4 bn = *(const float4*)(b_norm + cc);
                const unsigned long long o = (unsigned long long)pk2(bflo(vlo) * rn * bn.x, bfhi(vlo) * rn * bn.y) | ((unsigned long long)pk2(bflo(vhi) * rn * bn.z, bfhi(vhi) * rn * bn.w) << 32);
                *op = o;
            }
    }
    __syncthreads();
}


constexpr int NA_RING = 12, NA_VT = 0, NA_VSTRIDE = NA_RING * 64 * 2 + 16, NA_BIAS = 64 * NA_VSTRIDE, NA_END = NA_BIAS + 480 * 4;
static_assert(NA_END <= 131072, "na lds");
DEVI void ph_na(LAS unsigned char* lds, const bf16_t* qkv, const float* rpb, bf16_t* oc, int vb0, int vbs) {
    const int tid = opq((int)threadIdx.x), wid = __builtin_amdgcn_readfirstlane(tid >> 6), lane = tid & 63, fr = lane & 15, fq = lane >> 4;
    LAS float* bl = (LAS float*)(lds + NA_BIAS);
    for (int chunk = vb0; chunk < NB * 16 * 4; chunk += vbs) {
        const int qr4 = chunk & 3, h = (chunk >> 2) & 15, b = chunk >> 6;
        __syncthreads();
        for (int e = tid; e < 465; e += NTHR) bl[e] = rpb[h * 465 + e];
        auto v_load = [&](int kr) { return *(const u32x4*)(qkv + ((size_t)b * SEQ + kr * 64 + lane) * 3072 + 2048 + h * 64 + wid * 8); };
        auto v_store = [&](int kr, const u32x4 v) { const int slot = kr % NA_RING; const unsigned vw[4] = {v.x, v.y, v.z, v.w};
#pragma unroll
            for (int i = 0; i < 8; ++i) *(LAS bf16_t*)(lds + NA_VT + (wid * 8 + i) * NA_VSTRIDE + (slot * 64 + lane) * 2) = (bf16_t)((i & 1) ? (vw[i >> 1] >> 16) : (vw[i >> 1] & 0xffffu)); };
        int staged_hi;
        { const int r00 = 2 * (qr4 * 8), rs00 = min(max(r00 - 4, 0), 56), hi0 = min(rs00 + 8, 63), n0 = hi0 - rs00 + 1;
            u32x4 pv[9];
#pragma unroll
            for (int t = 0; t < 9; ++t) if (t < n0) pv[t] = v_load(rs00 + t);
#pragma unroll
            for (int t = 0; t < 9; ++t) if (t < n0) v_store(rs00 + t, pv[t]);
            staged_hi = hi0; }
        const int j = wid & 3, bs = (j == 0) ? 0 : (j == 1) ? 8 : (j == 2) ? 24 : 32, c = 16 * j + fr, qs = min(max(c - 8, 0), 48);
        auto q_ptr = [&](int rr) { return qkv + ((size_t)b * SEQ + rr * 64 + c) * 3072 + h * 64 + 8 * fq; };
        auto k_ptr = [&](int rr) { const int rsx = min(max(rr - 4, 0), 56); return qkv + ((size_t)b * SEQ + rsx * 64 + bs + fr) * 3072 + 1024 + h * 64 + 8 * fq; };
        bf16x8 Qf[2], k0[4][4];
        { const int rr = 2 * (qr4 * 8) + (wid >> 2); const bf16_t* qp = q_ptr(rr); const bf16_t* kp = k_ptr(rr);
            Qf[0] = *(const bf16x8*)qp; Qf[1] = *(const bf16x8*)(qp + 32);
#pragma unroll
            for (int d4 = 0; d4 < 4; ++d4)
#pragma unroll
                for (int q = 0; q < 4; ++q) k0[d4][q] = *(const bf16x8*)(kp + ((size_t)d4 * 64 + (q >> 1) * 16) * 3072 + (q & 1) * 32); }
#pragma unroll 1
        for (int ui = 0; ui < 8; ++ui) {
            const int rp = qr4 * 8 + ui;
            const int r0 = 2 * rp;
            __syncthreads();
            int lo2 = 0, nn = 0;
            if (ui < 7) { const int r0n = r0 + 2, rs0n = min(max(r0n - 4, 0), 56), hin = min(rs0n + 8, 63); lo2 = max(staged_hi + 1, rs0n); nn = hin - lo2 + 1; staged_hi = hin > staged_hi ? hin : staged_hi; }
            u32x4 nv0 = {0u, 0u, 0u, 0u}, nv1 = nv0;
            if (nn > 0) nv0 = v_load(lo2);
            if (nn > 1) nv1 = v_load(lo2 + 1);
            const int r = r0 + (wid >> 2);
            const int rs = min(max(r - 4, 0), 56);
            const size_t qtok = (size_t)b * SEQ + r * 64 + c;
            const bf16_t* kbase = k_ptr(r);
            float sv[8][8]; float mloc = -1e30f;
            bf16x8 k1[4][4];
#pragma unroll
            for (int d4 = 0; d4 < 4; ++d4)
#pragma unroll
                for (int q = 0; q < 4; ++q) k1[d4][q] = *(const bf16x8*)(kbase + ((size_t)(4 + d4) * 64 + (q >> 1) * 16) * 3072 + (q & 1) * 32);
#pragma unroll
            for (int hb = 0; hb < 2; ++hb) {
                bf16x8 (&kc)[4][4] = hb ? k1 : k0;
#pragma unroll
                for (int d4 = 0; d4 < 4; ++d4) { const int dr = hb * 4 + d4;
                    const LAS float* brow = bl + (rs + dr - r + 7) * 31;
#pragma unroll
                    for (int kg = 0; kg < 2; ++kg) {
                        f32x4 acc = {0.f, 0.f, 0.f, 0.f};
                        acc = __builtin_amdgcn_mfma_f32_16x16x32_bf16(kc[d4][kg * 2], Qf[0], acc, 0, 0, 0);
                        acc = __builtin_amdgcn_mfma_f32_16x16x32_bf16(kc[d4][kg * 2 + 1], Qf[1], acc, 0, 0, 0);
#pragma unroll
                        for (int rg = 0; rg < 4; ++rg) {
                            const int kcol = bs + 16 * kg + 4 * fq + rg;
                            const bool ok = (kcol >= qs) && (kcol < qs + 16);
                            const int dc = min(max(kcol - c + 15, 0), 30);
                            const float sc = ok ? acc[rg] * 0.125f + brow[dc] : -1e30f;
                            sv[dr][kg * 4 + rg] = sc; mloc = fmaxf(mloc, sc);
                        }
                    }
                }
            }
            mloc = fmaxf(mloc, __shfl_xor(mloc, 16)); mloc = fmaxf(mloc, __shfl_xor(mloc, 32));
            float lrun = 0.f;
#pragma unroll
            for (int dr = 0; dr < 8; ++dr)
#pragma unroll
                for (int i = 0; i < 8; ++i) { const float p = __expf(sv[dr][i] - mloc); sv[dr][i] = p; lrun += p; }
            lrun += __shfl_xor(lrun, 16); lrun += __shfl_xor(lrun, 32);
            f32x4 O[4];
#pragma unroll
            for (int dt = 0; dt < 4; ++dt) O[dt] = (f32x4){0.f, 0.f, 0.f, 0.f};
#pragma unroll
            for (int dr = 0; dr < 8; ++dr) {
                const bf16x8 Pf = pack8(sv[dr]);
                const int koff = (((rs + dr) % NA_RING) * 64 + bs + 4 * fq) * 2;
#pragma unroll
                for (int dt = 0; dt < 4; ++dt) {
                    const LAS unsigned char* vr = lds + NA_VT + (16 * dt + fr) * NA_VSTRIDE + koff;
                    const u32x2 v0 = *(const LAS u32x2*)vr, v1 = *(const LAS u32x2*)(vr + 32);
                    u32x4 va; va.x = v0.x; va.y = v0.y; va.z = v1.x; va.w = v1.y;
                    O[dt] = __builtin_amdgcn_mfma_f32_16x16x32_bf16(__builtin_bit_cast(bf16x8, va), Pf, O[dt], 0, 0, 0);
                }
            }
            if (ui < 7) { const int rn = r + 2; const bf16_t* qp = q_ptr(rn); const bf16_t* kp = k_ptr(rn);
                Qf[0] = *(const bf16x8*)qp; Qf[1] = *(const bf16x8*)(qp + 32);
#pragma unroll
                for (int d4 = 0; d4 < 4; ++d4)
#pragma unroll
                    for (int q = 0; q < 4; ++q) k0[d4][q] = *(const bf16x8*)(kp + ((size_t)d4 * 64 + (q >> 1) * 16) * 3072 + (q & 1) * 32); }
            const float il = 1.f / lrun;
#pragma unroll
            for (int dt = 0; dt < 4; ++dt) {
                u32x2 o; o.x = pk2(O[dt][0] * il, O[dt][1] * il); o.y = pk2(O[dt][2] * il, O[dt][3] * il);
                *(u32x2*)(oc + qtok * DM + h * 64 + 16 * dt + 4 * fq) = o;
            }
            if (nn > 0) v_store(lo2, nv0);
            if (nn > 1) v_store(lo2 + 1, nv1);
        }
    }
    __syncthreads();
}

#define XB_TMO      128
#define XB_XCNT(j)  (256  + 64 * (j))
#define XB_XSUB(j)  (1280 + 64 * (j))
#define XB_XGEN(j)  (2304 + 64 * (j))
#define XB_TOP      3328
#define XB_TOPGEN   3392
#define XCD_BAR_WORDS 3456
#define XB_SPIN_CAP (1u << 18)

__device__ __forceinline__ unsigned xb_ld(unsigned* p)              { return __hip_atomic_load(p, __ATOMIC_RELAXED, __HIP_MEMORY_SCOPE_AGENT); }
__device__ __forceinline__ unsigned xb_add(unsigned* p, unsigned v) { return __hip_atomic_fetch_add(p, v, __ATOMIC_RELAXED, __HIP_MEMORY_SCOPE_AGENT); }
__device__ __forceinline__ unsigned xb_xcc_id() { return (unsigned)__builtin_amdgcn_s_getreg((3 << 11) | 20) & 0xFu; }
#define XB_SPIN(cond, bar) do { unsigned _sp = 0; while (cond) { __builtin_amdgcn_s_sleep(1); \
    if ((++_sp & 255u) == 0u) { if (xb_ld(&(bar)[XB_TMO])) break; if (_sp > XB_SPIN_CAP) { atomicAdd(&(bar)[XB_TMO], 1u); break; } } } } while (0)

struct XcdBarrier {
    unsigned* bar; unsigned x;
    volatile LAS unsigned* st;
};

__device__ __forceinline__ XcdBarrier xcd_barrier_post(unsigned* bar, volatile LAS unsigned* st) {
    XcdBarrier b; b.bar = bar; b.x = xb_xcc_id(); b.st = st;
    if (threadIdx.x == 0) (void)xb_add(&bar[XB_XCNT(b.x)], 1u);
    return b;
}
__device__ __forceinline__ void xcd_barrier_complete(unsigned* bar, unsigned x, unsigned& nloc, unsigned& nx) {
    const unsigned G = gridDim.x * gridDim.y * gridDim.z;
    unsigned sum, cnt, mine, sp = 0u;
    for (;;) {
        sum = 0u; cnt = 0u; mine = 0u;
#pragma unroll
        for (unsigned j = 0; j < 16; ++j) { const unsigned c = xb_ld(&bar[XB_XCNT(j)]); sum += c; cnt += (c > 0u) ? 1u : 0u; mine = (j == x) ? c : mine; }
        if (sum == G) break;
        __builtin_amdgcn_s_sleep(1);
        if ((++sp & 255u) == 0u) { if (xb_ld(&bar[XB_TMO])) break; if (sp > XB_SPIN_CAP) { atomicAdd(&bar[XB_TMO], 1u); break; } }
    }
    nloc = mine > 0u ? mine : 1u; nx = cnt > 0u ? cnt : 1u;
}

__device__ __forceinline__ void xcd_barrier(const XcdBarrier& b) {
    asm volatile("s_waitcnt vmcnt(0)" ::: "memory");
    __syncthreads();
    if (threadIdx.x == 0) {
        unsigned* bar = b.bar;
        __builtin_amdgcn_s_waitcnt(0);
        unsigned nloc = b.st[0], nx = b.st[1];
        if (nloc == 0u) { xcd_barrier_complete(bar, b.x, nloc, nx); b.st[0] = nloc; b.st[1] = nx; }
        const unsigned old = xb_add(&bar[XB_XSUB(b.x)], 1u);
        const unsigned gen = old / nloc;
        if (old + 1u == (gen + 1u) * nloc) {
            __builtin_amdgcn_fence(__ATOMIC_RELEASE, "agent");
            asm volatile("s_waitcnt vmcnt(0)" ::: "memory");
            const unsigned og = xb_add(&bar[XB_TOP], 1u);
            const unsigned tg = og / nx;
            if (og + 1u == (tg + 1u) * nx) xb_add(&bar[XB_TOPGEN], 1u);
            else XB_SPIN(xb_ld(&bar[XB_TOPGEN]) == tg, bar);
            __builtin_amdgcn_fence(__ATOMIC_ACQUIRE, "agent");
            xb_add(&bar[XB_XGEN(b.x)], 1u);
            asm volatile("s_waitcnt vmcnt(0)" ::: "memory");
        } else {
            XB_SPIN(xb_ld(&bar[XB_XGEN(b.x)]) == gen, bar);
            __builtin_amdgcn_fence(__ATOMIC_ACQUIRE, "agent");
            asm volatile("s_waitcnt vmcnt(0)" ::: "memory");
        }
    }
    __syncthreads();
}


struct Args { const float* in[34]; float* out; unsigned char* ws; int ph_lo, ph_hi; };
constexpr int N_PHASES = 22;

__global__ void __launch_bounds__(NTHR, 2) fwd(Args a) {
    extern __shared__ __attribute__((aligned(16))) unsigned char lds_raw[];
    float* lds = (float*)lds_raw;
    LAS unsigned char* ldsl = (LAS unsigned char*)lds_raw;
    const int vb0 = blockIdx.x, vbs = gridDim.x;
    const int lo = a.ph_lo, hi = a.ph_hi;
#define IN(k) (lo <= (k) && (k) < hi)
#define SEAM(k) do { if (IN(k) && IN((k) + 1)) xcd_barrier(bar); } while (0)
    volatile LAS unsigned* misc = (volatile LAS unsigned*)(ldsl + MISC_OFF);
    if (threadIdx.x < 4) misc[threadIdx.x] = 0u;
    __syncthreads();
    XcdBarrier bar = xcd_barrier_post((unsigned*)(a.ws + WS_CTL) + CW_BAR, misc);
    unsigned char* ws = a.ws;
    unsigned* ctl = (unsigned*)(ws + WS_CTL);
    unsigned* cnt = ctl + CW_CNT;
    int* list = (int*)(ws + WS_LIST); float* gatev = (float*)(ws + WS_GATE);
    float* dtraw = (float*)(ws + WS_DT); float* RS = (float*)(ws + WS_RS);
    bf16_t* XB = (bf16_t*)(ws + WS_XB); bf16_t* UB = (bf16_t*)(ws + WS_UB);
    bf16_t* YA = (bf16_t*)(ws + WS_YA); float* OF = (float*)(ws + WS_OF); bf16_t* OC = (bf16_t*)(ws + WS_OC);
    bf16_t* YP = (bf16_t*)(ws + WS_YP); bf16_t* YP1 = (bf16_t*)(ws + WS_YP1); bf16_t* XC = (bf16_t*)(ws + WS_YP);
    bf16_t* PB0 = (bf16_t*)(ws + WS_PB0); bf16_t* PB1 = (bf16_t*)(ws + WS_PB1);
    bf16_t* YB = (bf16_t*)(ws + WS_Y);
    bf16_t* Y2 = (bf16_t*)(ws + WS_Y2); unsigned char* yflag = ws + WS_YFLAG;
    bf16_t* MS = (bf16_t*)(ws + WS_MS); float* MD = (float*)(ws + WS_MD);
    bf16_t* HS = (bf16_t*)(ws + WS_HS); float* HD = (float*)(ws + WS_HD);
    bf16_t* XT = (bf16_t*)(ws + WS_XT); bf16_t* VT = (bf16_t*)(ws + WS_VT);
    const float* p_in = a.in[1];
    const int G = (int)gridDim.x, cb = (int)blockIdx.x;
    const NormB NB0{nullptr, XB, nullptr, nullptr, RS, nullptr, nullptr, nullptr, nullptr, nullptr, nullptr, nullptr, nullptr, nullptr, nullptr};
    unsigned char* XG8 = ws + WS_XG8;
    float* rsl = (float*)(ws + WS_DT);

    if (IN(0)) {
        ph_convert_weights(ldsl, a.in, ws, 0, ITEMS_DENSE, vb0, vbs);
        NormB A = NB0; A.xin = a.in[0]; A.gnext = a.in[3]; A.win = a.in[4]; A.dtraw = dtraw;
        ph_norm0_dt(A, vb0, vbs, ldsl);
    }
    SEAM(0);
    if (IN(1)) { pg8::DenseOrder S; S.init(MT, UW, DM, (const bf16_t*)(ws + W_IN), G, cb); pg8::gemm_phase(ldsl, XB, DM, S, pg8::EpiBf16{UB, UW, RS}); }
    SEAM(1);
    if (IN(2)) { ph_prep(UB, a.in[5], a.in[6], XC, XT, VT, vb0, vbs); }
    SEAM(2);
    if (IN(3)) { ph_hgrn_states(ldsl, UB, VT, a.in[2], HS, HD, vb0, vbs); ph_mamba_states(ldsl, XT, dtraw, a.in[7], a.in[8], MS, MD, vb0, vbs); }
    SEAM(3);
    if (IN(4)) { ph_hgrn_scan(HS, HD, vb0, vbs); ph_mamba_scan(MS, MD, vb0, vbs); }
    SEAM(4);
    if (IN(5)) { ph_hgrn_out(ldsl, UB, VT, a.in[2], a.in[10], HS, OF, OC, vb0, vbs); ph_mamba_out(ldsl, UB, XC, XT, dtraw, a.in[7], a.in[8], a.in[9], a.in[11], MS, OC, vb0, vbs); }
    SEAM(5);
    if (IN(6)) { pg8::DenseOrder S; S.init(MT, DM, DM, (const bf16_t*)(ws + W_OUTE), G, cb); pg8::gemm_phase(ldsl, OC, DM, S, pg8::EpiBf16{YA, DM, nullptr}); }
    SEAM(6);
    if (IN(7)) {
        NormB A = NB0; A.y = YA; A.gpost = a.in[13];
        ph_norm2<1, false, false, false>(A, vb0, vbs);
        ph_cvt_rows(p_in, PB0, (size_t)MT * PDIM / 4, vb0, vbs);
        ph_convert_experts(ldsl, a.in, ws, ITEMS_DENSE, ITEMS_ALL, vb0, vbs);
    }
    SEAM(7);
    if (IN(8)) {
        { pg8::DenseOrder S; S.init(MT, 2 * DFF, DM, (const bf16_t*)(ws + W_GU), G, cb); pg8::gemm_phase(ldsl, XB, DM, S, pg8::EpiSwiglu{UB, DFF, RS, 0}); }
        { pg8::TailOrder S; S.init(MT, DM, PDIM, (const bf16_t*)(ws + W_PP), G, cb, (MT / 256) * (2 * DFF / 256) % G); pg8::gemm_phase(ldsl, PB0, PDIM, S, pg8::EpiBf16{YP, DM, nullptr}); }
    }
    SEAM(8);
    if (IN(9)) { pg8::DenseOrder S; S.init(MT, DM, DFF, (const bf16_t*)(ws + W_DN), G, cb); pg8::gemm_phase(ldsl, UB, DFF, S, pg8::EpiBf16{YA, DM, nullptr}); }
    SEAM(9);
    if (IN(10)) {
        NormB A = NB0; A.y = YA; A.gpost = a.in[18];
        ph_norm2<1, false, false, false>(A, vb0, vbs);
    }
    SEAM(10);
    if (IN(11)) { pg8::DenseOrder S; S.init(MT, DM, DM, (const bf16_t*)(ws + W_PG), G, cb); pg8::gemm_phase(ldsl, XB, DM, S, pg8::EpiPleGate{YP, DM, RS}); }
    SEAM(11);
    if (IN(12)) {
        NormB A = NB0; A.y = YP; A.gpost = a.in[33];
        ph_norm2<1, false, false, false>(A, vb0, vbs);
    }
    SEAM(12);
    if (IN(13)) { pg8::DenseOrder S; S.init(MT, 3072, DM, (const bf16_t*)(ws + W_QKV), G, cb); pg8::gemm_phase(ldsl, XB, DM, S, pg8::EpiBf16{UB, 3072, RS}); }
    SEAM(13);
    if (IN(14)) { ph_na(ldsl, UB, a.in[21], OC, vb0, vbs); }
    SEAM(14);
    if (IN(15)) { pg8::DenseOrder S; S.init(MT, DM, DM, (const bf16_t*)(ws + W_OUTO), G, cb); pg8::gemm_phase(ldsl, OC, DM, S, pg8::EpiBf16{YP1, DM, nullptr}); }
    SEAM(15);
    if (IN(16)) {
        NormB A = NB0; A.y = YP1; A.gpost = a.in[23]; A.gnext = a.in[24]; A.wr = a.in[25]; A.cnt = cnt; A.list = list; A.gatev = gatev; A.rsl = rsl; A.x8 = XG8;
        ph_norm2<1, false, false, true>(A, vb0, vbs, (LAS float*)ldsl);
        ph_cvt_rows(p_in + (size_t)MT * PDIM, PB1, (size_t)MT * PDIM / 4, vb0, vbs);
    }
    SEAM(16);
    if (IN(17)) { pg8::MoeOrder S; S.init(cnt, (volatile LAS int*)(ldsl + MISC_OFF + 64), 2 * DFFE, DM / 2, (const bf16_t*)(ws + W_EGU), (size_t)7 * MiB, true, G, cb);
        pg8::gemm_phase<pg8::EpiSwiglu8, pg8::MoeOrder, true>(ldsl, (const bf16_t*)XG8, DM / 2, S, pg8::EpiSwiglu8{(unsigned char*)UB, DFFE, rsl}); }
    SEAM(17);
    if (IN(18)) { pg8::MoeOrder S; S.init(cnt, (volatile LAS int*)(ldsl + MISC_OFF + 64), DM, DFFE / 2, (const bf16_t*)(ws + W_EDN), (size_t)(7 * MiB / 2), false, G, cb);
        const pg8::EpiMoeDown E{YB, list, gatev, 1.f / (pg8::W8_SCALE * pg8::ACT8_SCALE), (size_t)(Y2 - YB), yflag};
        S.set_split(true, false, DFFE / 2);
        pg8::gemm_phase<pg8::EpiMoeDown, pg8::MoeOrder, true>(ldsl, UB, DFFE / 2, S, E);
        S.set_split(true, true, DFFE / 2);
        pg8::gemm_phase<pg8::EpiMoeDown, pg8::MoeOrder, true>(ldsl, UB, DFFE / 2, S, E, DFFE / 4);
        { pg8::TailOrder T; T.init(MT, DM, PDIM, (const bf16_t*)(ws + W_PP + 512 * 1024), G, cb, S.tail_first()); pg8::gemm_phase(ldsl, PB1, PDIM, T, pg8::EpiBf16{YP, DM, nullptr}); } }
    SEAM(18);
    if (IN(19)) {
        NormB A = NB0; A.y = YB; A.gpost = a.in[29]; A.y2 = Y2; A.yflag = yflag;
        ph_norm2<2, false, false, false>(A, vb0, vbs);
    }
    SEAM(19);
    if (IN(20)) { pg8::DenseOrder S; S.init(MT, DM, DM, (const bf16_t*)(ws + W_PG + 2 * MiB), G, cb); pg8::gemm_phase(ldsl, XB, DM, S, pg8::EpiPleGate{YP, DM, RS}); }
    SEAM(20);
    if (IN(21)) {
        NormB A = NB0; A.y = YP; A.gpost = a.in[33] + DM; A.xout = a.out;
        ph_norm2<1, true, false, false>(A, vb0, vbs);
    }
#undef IN
#undef SEAM
}

extern "C" void kernel_launch(void* const* d_in, const int* in_sizes, int n_in, void* d_out, int out_size, void* d_ws, size_t ws_size, hipStream_t stream) {
    static int grid = 0;
    if (grid == 0) {
        if (n_in != 34 || out_size != MT * DM || ws_size < WS_END) { fprintf(stderr, "kernel_launch: unexpected shapes n_in %d out %d ws %zu (need %zu)\n", n_in, out_size, ws_size, (size_t)WS_END); grid = -1; return; }
        int dev = 0, cus = 0;
        if (hipGetDevice(&dev) != hipSuccess || hipDeviceGetAttribute(&cus, hipDeviceAttributeMultiprocessorCount, dev) != hipSuccess) { grid = -1; return; }
        if (hipFuncSetAttribute((const void*)fwd, hipFuncAttributeMaxDynamicSharedMemorySize, LDS_BYTES) != hipSuccess) { fprintf(stderr, "hipFuncSetAttribute failed\n"); grid = -1; return; }
        (void)hipGetLastError();
        grid = cus;
    }
    if (grid < 0) return;
    (void)hipMemsetAsync((char*)d_ws + WS_CTL, 0, CTL_ZERO_BYTES, stream);
    Args a{};
    for (int i = 0; i < 34; ++i) a.in[i] = (const float*)d_in[i];
    a.out = (float*)d_out; a.ws = (unsigned char*)d_ws;
#ifndef MK_PER_PHASE
    a.ph_lo = 0; a.ph_hi = N_PHASES;
    hipLaunchKernelGGL(fwd, dim3(grid), dim3(NTHR), LDS_BYTES, stream, a);
#else
    for (int ph = 0; ph < N_PHASES; ++ph) {
        a.ph_lo = ph; a.ph_hi = ph + 1;
        hipLaunchKernelGGL(fwd, dim3(grid), dim3(NTHR), LDS_BYTES, stream, a);
    }
#endif
}
```
